# Optimizing an MI355X kernel written in HIP

```python
import math
import jax, jax.numpy as jnp
from jax import lax
import numpy as np

D_MODEL = 2048
BATCH = 1
SEQ = 8192
DEPTH = 4

CHUNK = 64
N_A_LAYERS = DEPTH // 2
N_B_LAYERS = DEPTH - N_A_LAYERS
HEAD_DIM = 128
MEM_TOKENS = 256
MEM_HEADS = 4
MEM_W = MEM_HEADS * HEAD_DIM
MIX_W = D_MODEL - MEM_W
SGU_CHUNK = 128
SGU_GROUPS = 4
SGU_GROUP_W = MIX_W // SGU_GROUPS
DIFF_HEADS = MIX_W // (2 * HEAD_DIM)
DIFF_QK_W = 2 * DIFF_HEADS * HEAD_DIM
DIFF_V_DIM = 2 * HEAD_DIM
DIFF_BLOCK = 128
REL_BUCKETS = 32
REL_MAX_DIST = 128
N_GROUPS = 4
EXPERTS_PER_GROUP = 8
N_EXPERTS = N_GROUPS * EXPERTS_PER_GROUP
TOP_K = 2
EXPERT_FF = 512
MOE_BLOCK = 128
DN_ALPHA = (2 * DEPTH) ** 0.25
DN_BETA = (8 * DEPTH) ** -0.25
LN_EPS = 1e-5

kernel_name = 'hybrid_gmlp_diffattn_hmoe'


def layer_norm(x, g, b):
    xf = x.astype(jnp.float32)
    mu = jnp.mean(xf, -1, keepdims=True)
    var = jnp.mean(jnp.square(xf - mu), -1, keepdims=True)
    y = (xf - mu) * lax.rsqrt(var + LN_EPS)
    return (y * g.astype(jnp.float32) + b.astype(jnp.float32)).astype(x.dtype)


def rms_norm(x, g):
    xf = x.astype(jnp.float32)
    y = xf * lax.rsqrt(jnp.mean(jnp.square(xf), -1, keepdims=True) + LN_EPS)
    return (y * g.astype(jnp.float32)).astype(x.dtype)


def relative_bucket(rel):
    n = REL_BUCKETS // 2
    max_exact = n // 2
    ret = jnp.where(rel > 0, n, 0)
    a = jnp.abs(rel)
    af = jnp.maximum(a, 1).astype(jnp.float32)
    large = max_exact + (jnp.log(af / max_exact) / math.log(REL_MAX_DIST / max_exact)
                         * (n - max_exact)).astype(jnp.int32)
    large = jnp.minimum(large, n - 1)
    return ret + jnp.where(a < max_exact, a, large)


def spatial_gating(z, ln_g, ln_b, ws, bs):
    b_, s_, _ = z.shape
    u, v = jnp.split(z, 2, axis=-1)
    v = layer_norm(v, ln_g, ln_b)
    v = v.reshape(b_, s_ // SGU_CHUNK, SGU_CHUNK, SGU_GROUPS, SGU_GROUP_W)
    pos = jnp.arange(SGU_CHUNK)
    mask = (pos[None, :] // CHUNK) <= (pos[:, None] // CHUNK)
    w = jnp.where(mask[None], ws, jnp.zeros_like(ws))
    gate = jnp.einsum('gij,bnjgc->bnigc', w, v) + jnp.transpose(bs)[None, None, :, :, None]
    return u * gate.reshape(b_, s_, MIX_W)


def memory_attention(q, mem, w_kv):
    b_, s_, _ = q.shape
    kv = jnp.einsum('bmd,de->bme', mem, w_kv)
    k, v = jnp.split(kv, 2, axis=-1)
    q = q.reshape(b_, s_, MEM_HEADS, HEAD_DIM)
    k = k.reshape(b_, -1, MEM_HEADS, HEAD_DIM)
    v = v.reshape(b_, -1, MEM_HEADS, HEAD_DIM)
    s = jnp.einsum('bqhd,bkhd->bhqk', q, k).astype(jnp.float32) * (HEAD_DIM ** -0.5)
    p = jax.nn.softmax(s, axis=-1).astype(v.dtype)
    o = jnp.einsum('bhqk,bkhd->bqhd', p, v)
    return o.reshape(b_, s_, MEM_W)


def diff_attention(q, k, v, lam_params, subln_g, rel_bias, layer_idx):
    b_, s_, _ = q.shape
    lambda_init = 0.8 - 0.6 * math.exp(-0.3 * layer_idx)
    lp = lam_params.astype(jnp.float32)
    lam = jnp.exp(jnp.sum(lp[0] * lp[1])) - jnp.exp(jnp.sum(lp[2] * lp[3])) + lambda_init
    nqb = s_ // DIFF_BLOCK
    qb = q.reshape(b_, nqb, DIFF_BLOCK, DIFF_HEADS, 2, HEAD_DIM).transpose(1, 0, 2, 3, 4, 5)
    kpos = jnp.arange(s_)
    scale = HEAD_DIM ** -0.5

    def block(args):
        qblk, bi = args
        qpos = bi * DIFF_BLOCK + jnp.arange(DIFF_BLOCK)
        bias = rel_bias[relative_bucket(kpos[None, :] - qpos[:, None])]
        bias = jnp.transpose(bias, (2, 0, 1)).astype(jnp.float32)
        mask = (kpos[None, :] // CHUNK) <= (qpos[:, None] // CHUNK)
        s = jnp.einsum('bqhmd,bkhmd->bmhqk', qblk, k).astype(jnp.float32) * scale + bias
        s = jnp.where(mask, s, -jnp.inf)
        p = jax.nn.softmax(s, axis=-1)
        a = (p[:, 0] - lam * p[:, 1]).astype(v.dtype)
        return jnp.einsum('bhqk,bkhe->bqhe', a, v)

    o = lax.map(block, (qb, jnp.arange(nqb)))
    o = o.transpose(1, 0, 2, 3, 4).reshape(b_, s_, DIFF_HEADS, DIFF_V_DIM)
    o = rms_norm(o, subln_g) * (1.0 - lambda_init)
    return o.reshape(b_, s_, MIX_W)


def hierarchical_moe(x, wg1, bg1, wg2, bg2, w1, w3, w2):
    b_, s_, d_ = x.shape
    t = b_ * s_
    xt = x.reshape(t, d_)
    lg1 = jnp.einsum('td,dg->tg', xt, wg1).astype(jnp.float32) + bg1.astype(jnp.float32)
    pg = jax.nn.softmax(lg1, axis=-1)
    grp = jnp.argmax(lg1, axis=-1)
    p_sel = jnp.take_along_axis(pg, grp[:, None], axis=1)[:, 0]
    lg2_all = jnp.einsum('td,gde->tge', xt, wg2).astype(jnp.float32) + bg2.astype(jnp.float32)
    lg2 = jnp.take_along_axis(lg2_all, grp[:, None, None], axis=1)[:, 0]
    top_v, top_i = lax.top_k(lg2, TOP_K)
    gate = p_sel[:, None] * jax.nn.softmax(top_v, axis=-1)
    expert = grp[:, None] * EXPERTS_PER_GROUP + top_i
    n_assign = t * TOP_K
    flat_e = expert.reshape(-1)
    flat_w = gate.reshape(-1)
    flat_tok = jnp.repeat(jnp.arange(t, dtype=jnp.int32), TOP_K)
    order = jnp.argsort(flat_e)
    e_s, tok_s, w_s = flat_e[order], flat_tok[order], flat_w[order]
    counts = jnp.bincount(flat_e, length=N_EXPERTS)
    start = jnp.cumsum(counts) - counts
    padded = ((counts + MOE_BLOCK - 1) // MOE_BLOCK) * MOE_BLOCK
    pend = jnp.cumsum(padded)
    pstart = pend - padded
    dest = pstart[e_s] + (jnp.arange(n_assign) - start[e_s])
    n_blocks = n_assign // MOE_BLOCK + N_EXPERTS
    p_rows = n_blocks * MOE_BLOCK
    x_buf = jnp.zeros((p_rows, d_), x.dtype).at[dest].set(xt[tok_s])
    tok_buf = jnp.zeros((p_rows,), jnp.int32).at[dest].set(tok_s)
    w_buf = jnp.zeros((p_rows,), jnp.float32).at[dest].set(w_s)
    blk_e = jnp.minimum(jnp.searchsorted(pend, jnp.arange(n_blocks) * MOE_BLOCK, side='right'),
                        N_EXPERTS - 1)

    def expert_block(args):
        xb, e = args
        h = jax.nn.silu(xb @ w1[e]) * (xb @ w3[e])
        return h @ w2[e]

    yb = lax.map(expert_block, (x_buf.reshape(n_blocks, MOE_BLOCK, d_), blk_e)).reshape(p_rows, d_)
    y = jnp.zeros((t, d_), x.dtype).at[tok_buf].add(yb * w_buf[:, None].astype(yb.dtype))
    return y.reshape(b_, s_, d_)


def setup_inputs(seed: int = 0) -> dict:
    key = jax.random.key(seed)
    ks = jax.random.split(key, 24)
    f32 = jnp.float32

    def nrm(k, shape, scale):
        return jax.random.normal(k, shape, f32) * scale

    inv_d = D_MODEL ** -0.5
    return {
        'x': nrm(ks[0], (BATCH, SEQ, D_MODEL), 1.0),
        'mem': nrm(ks[1], (BATCH, MEM_TOKENS, D_MODEL), 1.0),
        'a_w_in': nrm(ks[2], (N_A_LAYERS, D_MODEL, 2 * MIX_W + MEM_W), inv_d),
        'a_sgu_ln_g': 1.0 + nrm(ks[3], (N_A_LAYERS, MIX_W), 0.02),
        'a_sgu_ln_b': nrm(ks[4], (N_A_LAYERS, MIX_W), 0.02),
        'a_ws': nrm(ks[5], (N_A_LAYERS, SGU_GROUPS, SGU_CHUNK, SGU_CHUNK), SGU_CHUNK ** -0.5),
        'a_bs': 1.0 + nrm(ks[6], (N_A_LAYERS, SGU_GROUPS, SGU_CHUNK), 0.1),
        'a_w_out': nrm(ks[7], (N_A_LAYERS, MIX_W + MEM_W, D_MODEL), (MIX_W + MEM_W) ** -0.5 * DN_BETA),
        'b_w_in': nrm(ks[8], (N_B_LAYERS, D_MODEL, DIFF_QK_W + MEM_W), inv_d),
        'b_lambda': nrm(ks[9], (N_B_LAYERS, 4, HEAD_DIM), 0.1),
        'b_subln_g': 1.0 + nrm(ks[10], (N_B_LAYERS, DIFF_V_DIM), 0.02),
        'b_w_out': nrm(ks[11], (N_B_LAYERS, MIX_W + MEM_W, D_MODEL), (MIX_W + MEM_W) ** -0.5 * DN_BETA),
        'shared_w_kv': nrm(ks[12], (D_MODEL, DIFF_QK_W + DIFF_HEADS * DIFF_V_DIM), inv_d),
        'rel_bias': nrm(ks[13], (REL_BUCKETS, DIFF_HEADS), 0.5),
        'mem_w_kv': nrm(ks[14], (DEPTH, D_MODEL, 2 * MEM_W), inv_d),
        'ln_g': 1.0 + nrm(ks[15], (DEPTH, 2, D_MODEL), 0.02),
        'ln_b': nrm(ks[16], (DEPTH, 2, D_MODEL), 0.02),
        'moe_wg1': nrm(ks[17], (DEPTH, D_MODEL, N_GROUPS), inv_d),
        'moe_bg1': nrm(ks[18], (DEPTH, N_GROUPS), 0.01),
        'moe_wg2': nrm(ks[19], (DEPTH, N_GROUPS, D_MODEL, EXPERTS_PER_GROUP), inv_d),
        'moe_bg2': nrm(ks[20], (DEPTH, N_GROUPS, EXPERTS_PER_GROUP), 0.01),
        'moe_w1': nrm(ks[21], (DEPTH, N_EXPERTS, D_MODEL, EXPERT_FF), inv_d),
        'moe_w3': nrm(ks[22], (DEPTH, N_EXPERTS, D_MODEL, EXPERT_FF), inv_d),
        'moe_w2': nrm(ks[23], (DEPTH, N_EXPERTS, EXPERT_FF, D_MODEL), EXPERT_FF ** -0.5 * DN_BETA),
    }


def reference(x, mem, a_w_in, a_sgu_ln_g, a_sgu_ln_b, a_ws, a_bs, a_w_out, b_w_in, b_lambda,
              b_subln_g, b_w_out, shared_w_kv, rel_bias, mem_w_kv, ln_g, ln_b, moe_wg1, moe_bg1,
              moe_wg2, moe_bg2, moe_w1, moe_w3, moe_w2):
    b_, s_, _ = x.shape
    shared_k = None
    shared_v = None
    for l in range(DEPTH):
        if l < N_A_LAYERS:
            i = l
            z = jnp.einsum('bsd,de->bse', x, a_w_in[i])
            z_mix, q_mem = z[..., :2 * MIX_W], z[..., 2 * MIX_W:]
            mix_out = spatial_gating(jax.nn.gelu(z_mix, approximate=False),
                                     a_sgu_ln_g[i], a_sgu_ln_b[i], a_ws[i], a_bs[i])
            w_out = a_w_out[i]
        else:
            i = l - N_A_LAYERS
            z = jnp.einsum('bsd,de->bse', x, b_w_in[i])
            q_diff, q_mem = z[..., :DIFF_QK_W], z[..., DIFF_QK_W:]
            mix_out = diff_attention(q_diff, shared_k, shared_v, b_lambda[i], b_subln_g[i], rel_bias, l)
            w_out = b_w_out[i]
        mem_out = memory_attention(q_mem, mem, mem_w_kv[l])
        t = jnp.einsum('bse,ed->bsd', jnp.concatenate([mix_out, mem_out], axis=-1), w_out)
        x = layer_norm(DN_ALPHA * x + t, ln_g[l, 0], ln_b[l, 0])
        f = hierarchical_moe(x, moe_wg1[l], moe_bg1[l], moe_wg2[l], moe_bg2[l],
                             moe_w1[l], moe_w3[l], moe_w2[l])
        x = layer_norm(DN_ALPHA * x + f, ln_g[l, 1], ln_b[l, 1])
        if l == N_A_LAYERS - 1:
            kv = jnp.einsum('bsd,de->bse', x, shared_w_kv)
            shared_k = kv[..., :DIFF_QK_W].reshape(b_, s_, DIFF_HEADS, 2, HEAD_DIM)
            shared_v = kv[..., DIFF_QK_W:].reshape(b_, s_, DIFF_HEADS, DIFF_V_DIM)
    return x
```

```cpp
#include <hip/hip_runtime.h>
#include <cstdio>
#include <cstdint>
namespace pg8 {
#define PG8_LAS __attribute__((address_space(3)))
typedef unsigned short bf16_t;
typedef short bf16x8 __attribute__((ext_vector_type(8)));
typedef float f32x4 __attribute__((ext_vector_type(4)));
typedef unsigned u32x4 __attribute__((ext_vector_type(4)));
constexpr int BM = 256, BK = 64, HALF = 128, HTB = HALF * BK * 2  , STAGE_BYTES = 8 * HTB, NXCD = 8, WGM = 8;

__host__ __device__ __forceinline__ int lds_byte(int r, int c) { const int st = (r >> 4) * 2 + (c >> 5), rr = r & 15, cc = c & 31, ob = rr * 64 + cc * 2; return st * 1024 + (ob ^ (((ob >> 9) & 1) << 5)); }
__host__ __device__ __forceinline__ void stage_rc(int b, int& R, int& C) { const int st = b / 1024, sb = b % 1024, swz = sb ^ (((sb >> 9) & 1) << 5); R = (st >> 1) * 16 + swz / 64; C = (st & 1) * 32 + (swz % 64) / 2; }
__host__ __device__ __forceinline__ int perm32(int rho) { const int n = rho >> 4, i = rho & 15; return 8 * (i >> 2) + 4 * n + (i & 3); }

struct Unit { int pm, pn, e; };
struct Gemm { const bf16_t* A; const bf16_t* Bt; int M, N, K; };

struct StaticOrder {
    int nM, nN, nwg, G, c;
    __host__ __device__ void init(int M, int N, int G_, int c_) { nM = M / BM; nN = N / BM; nwg = nM * nN; G = G_; c = c_; }
    __host__ __device__ bool next(int i, Unit& u) const {
        const long L = (long)i * G + c; if (L >= nwg) return false;
        int wgid = (int)L; { const int q = nwg / NXCD, r = nwg % NXCD, xcd = wgid % NXCD, off = wgid / NXCD; wgid = (xcd < r ? xcd * (q + 1) : r * (q + 1) + (xcd - r) * q) + off; }
        const int nig = WGM * nN, gid = wgid / nig, fm = gid * WGM, gsz = (nM - fm) < WGM ? (nM - fm) : WGM;
        u.pm = fm + ((wgid % nig) % gsz); u.pn = (wgid % nig) / gsz; return true;
    }
    __device__ __forceinline__ void a_ready(const Unit&) const {}
    __device__ __forceinline__ void done(const Unit&) const {}
};

__device__ __forceinline__ unsigned cvt_pk_bf16(float lo, float hi) { unsigned r; asm volatile("v_cvt_pk_bf16_f32 %0, %1, %2" : "=v"(r) : "v"(lo), "v"(hi)); return r; }
typedef float f32x2 __attribute__((ext_vector_type(2)));
__device__ __forceinline__ f32x2 gelu_pk(f32x2 v) {
    const f32x2 av = __builtin_elementwise_abs(v), d = av * 0.2316418882f + 1.0f;
    f32x2 t; t.x = __builtin_amdgcn_rcpf(d.x); t.y = __builtin_amdgcn_rcpf(d.y);
    f32x2 q = t * 0.5307027145f + (-0.7265760135f); q = q * t + 0.7107068705f; q = q * t + (-0.142248368f); q = q * t + 0.127414796f; q = q * t;
    const f32x2 s = (v * v) * (-0.72134752044f);
    f32x2 e; e.x = __builtin_amdgcn_exp2f(s.x); e.y = __builtin_amdgcn_exp2f(s.y);
    const f32x2 m = v * (q * e), r = v - m;
    f32x2 o; o.x = v.x < 0.f ? m.x : r.x; o.y = v.y < 0.f ? m.y : r.y; return o;
}

template <class Epi, class Sched, bool ALIGN_EPI = false, bool SP2 = false>
__device__ __forceinline__ void gemm_phase(PG8_LAS unsigned char* lds, const Gemm g, const Sched& S, const Epi& E) {
    int tid_ = threadIdx.x; asm volatile("" : "+v"(tid_));
    const int tid = tid_, wid = __builtin_amdgcn_readfirstlane(tid >> 6), lane = tid & 63, wr = wid >> 2, wc = wid & 3, fr = lane & 15, fq = lane >> 4;
    const int K = g.K, nt = K / BK;
    unsigned voffA[2], voffB[2];
#pragma unroll
    for (int i = 0; i < 2; ++i) { int R, C; stage_rc(tid * 16 + i * 8192, R, C); const int Rb = Epi::PERM ? ((R & ~31) + perm32(R & 31)) : R;
        voffA[i] = (unsigned)(R * K + C) * 2u; voffB[i] = (unsigned)(Rb * K + C) * 2u; }
    const size_t kstep = (size_t)(BK * 2);
    const size_t hstep = (size_t)HALF * K * 2;
        const unsigned ldsw = (unsigned)wid * 1024u;
    const int aoff = lds_byte(wr * 64 + fr, fq * 8), boff = lds_byte(wc * 32 + fr, fq * 8);
#define PG8_SA(b, h) (((b) * 2 + (h)) * HTB)
#define PG8_SB(b, h) ((4 + (b) * 2 + (h)) * HTB)
#define PG8_STAGE(bufoff, gbase, voff) do { _Pragma("unroll") for (int _i = 0; _i < 2; ++_i) \
        __builtin_amdgcn_global_load_lds((const unsigned*)((const char*)(gbase) + (voff)[_i]), (PG8_LAS unsigned*)(lds + (bufoff) + ldsw + _i * 8192), 16, 0, 0); } while (0)
#define PG8_LDA(dst, b, h) do { _Pragma("unroll") for (int m = 0; m < 4; ++m) _Pragma("unroll") for (int k = 0; k < 2; ++k) dst[m][k] = *(const PG8_LAS bf16x8*)(lds + PG8_SA(b, h) + aoff + m * 2048 + k * 1024); } while (0)
#define PG8_LDB(dst, b, h) do { _Pragma("unroll") for (int n = 0; n < 2; ++n) _Pragma("unroll") for (int k = 0; k < 2; ++k) dst[n][k] = *(const PG8_LAS bf16x8*)(lds + PG8_SB(b, h) + boff + n * 2048 + k * 1024); } while (0)
#define PG8_MMA(ai, bj, At, Bt) do { __builtin_amdgcn_s_setprio(1); _Pragma("unroll") for (int m = 0; m < 4; ++m) _Pragma("unroll") for (int n = 0; n < 2; ++n) _Pragma("unroll") for (int k = 0; k < 2; ++k) \
        acc[ai][bj][m][n] = __builtin_amdgcn_mfma_f32_16x16x32_bf16(Bt[n][k], At[m][k], acc[ai][bj][m][n], 0, 0, 0); __builtin_amdgcn_s_setprio(0); } while (0)
#define PG8_WAIT_V(n) asm volatile("s_waitcnt vmcnt(" #n ")" ::: "memory")
#define PG8_WAIT_L(n) asm volatile("s_waitcnt lgkmcnt(" #n ")" ::: "memory")
#define PG8_BAR __builtin_amdgcn_s_barrier()
#define PG8_SCHED __builtin_amdgcn_sched_barrier(0)
    Unit cur, nxt; int ui = 0;
    if (!S.next(0, cur)) return;
    f32x4 acc[2][2][4][2];
#pragma unroll
    for (int a = 0; a < 2; ++a)
#pragma unroll
        for (int b = 0; b < 2; ++b)
#pragma unroll
            for (int m = 0; m < 4; ++m)
#pragma unroll
                for (int n = 0; n < 2; ++n) acc[a][b][m][n] = (f32x4){0.f, 0.f, 0.f, 0.f};
    bf16x8 At[4][2], B0[2][2], B1[2][2];
    const char* cA = S.aptr(cur); const char* cB = S.bptr(cur);
    S.a_ready(cur);
    if constexpr (SP2) {
        PG8_STAGE(PG8_SB(0, 0), cB, voffB); PG8_STAGE(PG8_SB(0, 1), cB + hstep, voffB); PG8_STAGE(PG8_SA(0, 0), cA, voffA); PG8_STAGE(PG8_SA(0, 1), cA + hstep, voffA);
        if (wr == 1) PG8_BAR;
        PG8_WAIT_V(2); PG8_BAR;
        PG8_STAGE(PG8_SB(1, 0), cB + kstep, voffB); PG8_STAGE(PG8_SA(1, 0), cA + kstep, voffA); PG8_STAGE(PG8_SB(1, 1), cB + hstep + kstep, voffB);
        PG8_WAIT_V(6); PG8_BAR;
    } else {
        PG8_STAGE(PG8_SB(0, 0), cB, voffB); PG8_STAGE(PG8_SA(0, 0), cA, voffA); PG8_STAGE(PG8_SB(0, 1), cB + hstep, voffB); PG8_STAGE(PG8_SA(0, 1), cA + hstep, voffA);
        if (wr == 1) PG8_BAR;
        PG8_WAIT_V(4); PG8_BAR;
        PG8_STAGE(PG8_SB(1, 0), cB + kstep, voffB); PG8_STAGE(PG8_SA(1, 0), cA + kstep, voffA); PG8_STAGE(PG8_SB(1, 1), cB + hstep + kstep, voffB);
        PG8_WAIT_V(6); PG8_BAR;
    }
    for (;;) {
        const bool has_next = S.next(ui + 1, nxt);
        const char* nA = has_next ? S.aptr(nxt) : cA; const char* nB = has_next ? S.bptr(nxt) : cB;
        for (int t = 0; t < nt; t += 2) {
            const bool last = (t == nt - 2);
            const char* a1 = cA + (size_t)(t + 1) * kstep;
            const char* a2 = last ? nA : cA + (size_t)(t + 2) * kstep; const char* b2 = last ? nB : cB + (size_t)(t + 2) * kstep;
            const char* a3 = a2 + kstep; const char* b3 = b2 + kstep;
            if (last && has_next) S.a_ready(nxt);
            if constexpr (SP2) {
            PG8_LDB(B0, 0, 0); PG8_LDB(B1, 0, 1); PG8_SCHED; PG8_LDA(At, 0, 0); PG8_STAGE(PG8_SA(1, 1), a1 + hstep, voffA);
            PG8_WAIT_V(8); PG8_WAIT_L(0); PG8_BAR; PG8_MMA(0, 0, At, B0); PG8_MMA(0, 1, At, B1); PG8_BAR; PG8_SCHED;
            PG8_LDA(At, 0, 1); PG8_STAGE(PG8_SB(0, 0), b2, voffB); PG8_STAGE(PG8_SB(0, 1), b2 + hstep, voffB); PG8_STAGE(PG8_SA(0, 0), a2, voffA);
            PG8_WAIT_V(8); PG8_WAIT_L(0); PG8_BAR; PG8_MMA(1, 0, At, B0); PG8_MMA(1, 1, At, B1); PG8_BAR; PG8_SCHED;
            PG8_LDB(B0, 1, 0); PG8_LDB(B1, 1, 1); PG8_SCHED; PG8_LDA(At, 1, 0); PG8_STAGE(PG8_SA(0, 1), a2 + hstep, voffA);
            PG8_WAIT_V(8); PG8_WAIT_L(0); PG8_BAR; PG8_MMA(0, 0, At, B0); PG8_MMA(0, 1, At, B1); PG8_BAR; PG8_SCHED;
            PG8_LDA(At, 1, 1); PG8_STAGE(PG8_SB(1, 0), b3, voffB); PG8_STAGE(PG8_SB(1, 1), b3 + hstep, voffB); PG8_STAGE(PG8_SA(1, 0), a3, voffA);
            PG8_WAIT_V(8); PG8_WAIT_L(0); PG8_BAR; PG8_MMA(1, 0, At, B0); PG8_MMA(1, 1, At, B1); PG8_BAR; PG8_SCHED;
            } else {
            PG8_LDB(B0, 0, 0); PG8_SCHED; PG8_LDA(At, 0, 0); PG8_STAGE(PG8_SA(1, 1), a1 + hstep, voffA);
            PG8_WAIT_L(8); PG8_BAR; PG8_WAIT_L(0); PG8_MMA(0, 0, At, B0); PG8_BAR; PG8_SCHED;
            PG8_LDB(B1, 0, 1); PG8_STAGE(PG8_SB(0, 0), b2, voffB);
            PG8_BAR; PG8_WAIT_L(0); PG8_MMA(0, 1, At, B1); PG8_BAR;
            PG8_LDA(At, 0, 1); PG8_STAGE(PG8_SA(0, 0), a2, voffA);
            PG8_BAR; PG8_WAIT_L(0); PG8_MMA(1, 0, At, B0); PG8_BAR; PG8_SCHED;
            PG8_STAGE(PG8_SB(0, 1), b2 + hstep, voffB);
            PG8_WAIT_V(6); PG8_BAR; PG8_MMA(1, 1, At, B1); PG8_BAR;
            PG8_LDB(B0, 1, 0); PG8_SCHED; PG8_LDA(At, 1, 0); PG8_STAGE(PG8_SA(0, 1), a2 + hstep, voffA);
            PG8_WAIT_L(8); PG8_BAR; PG8_WAIT_L(0); PG8_MMA(0, 0, At, B0); PG8_BAR; PG8_SCHED;
            PG8_LDB(B1, 1, 1); PG8_STAGE(PG8_SB(1, 0), b3, voffB);
            PG8_BAR; PG8_WAIT_L(0); PG8_MMA(0, 1, At, B1); PG8_BAR;
            PG8_LDA(At, 1, 1); PG8_STAGE(PG8_SA(1, 0), a3, voffA);
            PG8_BAR; PG8_WAIT_L(0); PG8_MMA(1, 0, At, B0); PG8_BAR; PG8_SCHED;
            PG8_STAGE(PG8_SB(1, 1), b3 + hstep, voffB);
            PG8_WAIT_V(6); PG8_BAR; PG8_MMA(1, 1, At, B1); PG8_BAR;
            }
        }
        if constexpr (ALIGN_EPI) { if (wr == 0) PG8_BAR; }
        if constexpr (!Epi::AFTER_DRAIN) { E(acc, cur, wr, wc, fr, fq); S.done(cur); }
        if (!has_next) break;
#pragma unroll
        for (int a = 0; a < 2; ++a)
#pragma unroll
            for (int b = 0; b < 2; ++b)
#pragma unroll
                for (int m = 0; m < 4; ++m)
#pragma unroll
                    for (int n = 0; n < 2; ++n) acc[a][b][m][n] = (f32x4){0.f, 0.f, 0.f, 0.f};
        cur = nxt; cA = nA; cB = nB; ++ui;
        if constexpr (ALIGN_EPI) { if (wr == 1) PG8_BAR; }
    }
    PG8_WAIT_V(0);
    if constexpr (!ALIGN_EPI) { if (wr == 0) PG8_BAR; }
    PG8_BAR;
    if constexpr (Epi::AFTER_DRAIN) { E.fused(acc, cur, wr, wc, fr, fq, lds, wid, lane); S.done(cur); }
#undef PG8_SA
#undef PG8_SB
#undef PG8_STAGE
#undef PG8_LDA
#undef PG8_LDB
#undef PG8_MMA
#undef PG8_WAIT_V
#undef PG8_WAIT_L
#undef PG8_BAR
#undef PG8_SCHED
}
}

constexpr int T = 8192, D = 2048, MIXW = 1536, MEMW = 512, NINA = 3584, DEPTH = 4, NE = 32, FF = 512, MEMT = 256;
constexpr int SLOTS = 24576;
constexpr float LN_EPS = 1e-5f;
constexpr float DN_ALPHA = 1.6817928305074292f;
constexpr float LOG2E = 1.4426950408889634f;
constexpr float QSCALE = 0.08838834764831845f * LOG2E;
constexpr int NWAVES = 8;

constexpr size_t MiB = 1u << 20;
constexpr size_t WS_CTL = 0, CTL_ZERO_BYTES = 1 * MiB;
constexpr size_t WS_WAIN = 2 * MiB, WS_WAOUT = 30 * MiB, WS_WBIN0 = 46 * MiB, WS_WKV = 54 * MiB, WS_WBIN1 = 66 * MiB, WS_WBOUT = 74 * MiB, WS_WMKV = 90 * MiB;
constexpr size_t WS_W13 = 106 * MiB, WS_W2 = 618 * MiB;
constexpr size_t WS_XB = 874 * MiB, WS_MEMB = 906 * MiB, WS_MEMKV = 907 * MiB, WS_Z = 910 * MiB, WS_KD = 966 * MiB, WS_VD = 990 * MiB, WS_CAT = 1014 * MiB;
constexpr size_t WS_Y = 1046 * MiB, WS_X1F = 1110 * MiB, WS_X1B = 1174 * MiB, WS_XF = 1206 * MiB, WS_XG = 1270 * MiB, WS_H = 1366 * MiB, WS_YB = 1390 * MiB, WS_OP = 1486 * MiB;
constexpr size_t WS_ROUTE = 1582 * MiB, WS_END = 1583 * MiB;
constexpr int CW_TMO = 0, CW_BAR = 4096, CW_CNT = 16384;

constexpr int RING_OFF = 0, RING_BYTES = 131072;
constexpr int LDSCTL_OFF = 146432, MISC_OFF = LDSCTL_OFF + 320, TAB_OFF = LDSCTL_OFF + 512;
constexpr int LDS_BYTES = 147456;

#define GAS __attribute__((address_space(1)))
#define LAS __attribute__((address_space(3)))
typedef unsigned short bf16;
typedef unsigned v4u __attribute__((ext_vector_type(4)));
typedef unsigned v2u __attribute__((ext_vector_type(2)));
typedef float f32x4 __attribute__((ext_vector_type(4)));
typedef short bf16x8 __attribute__((ext_vector_type(8)));
typedef GAS unsigned gu32;
#define RLX_AGENT __ATOMIC_RELAXED, __HIP_MEMORY_SCOPE_AGENT
#define LDS_WAIT() asm volatile("s_waitcnt lgkmcnt(0)" ::: "memory")
#define VM_WAIT() asm volatile("s_waitcnt vmcnt(0)" ::: "memory")
__device__ __forceinline__ unsigned f2bf(float f) { unsigned u = __builtin_bit_cast(unsigned, f); return (u + 0x7fffu + ((u >> 16) & 1u)) >> 16; }
__device__ __forceinline__ unsigned pk2(float lo, float hi) { return f2bf(lo) | (f2bf(hi) << 16); }
__device__ __forceinline__ float bf2f(unsigned short b) { return __builtin_bit_cast(float, (unsigned)b << 16); }
__device__ __forceinline__ float bflo(unsigned w) { return __builtin_bit_cast(float, w << 16); }
__device__ __forceinline__ float bfhi(unsigned w) { return __builtin_bit_cast(float, w & 0xffff0000u); }
__device__ __forceinline__ float wave_sum(float v) {
#pragma unroll
    for (int o = 1; o < 64; o <<= 1) v += __shfl_xor(v, o);
    return v;
}

namespace pg8 {
struct DenseOrder {
    StaticOrder so; const char* A; const char* B; size_t astep, bstep;
    __device__ void init(const void* A_, const void* B_, int M, int N, int K, int G, int c) { so.init(M, N, G, c); A = (const char*)A_; B = (const char*)B_; astep = (size_t)256 * K * 2; bstep = astep; }
    __device__ __forceinline__ bool next(int i, Unit& u) const { u.e = 0; return so.next(i, u); }
    __device__ __forceinline__ const char* aptr(const Unit& u) const { return A + (size_t)u.pm * astep; }
    __device__ __forceinline__ const char* bptr(const Unit& u) const { return B + (size_t)u.pn * bstep; }
    __device__ __forceinline__ void a_ready(const Unit&) const {}
    __device__ __forceinline__ void done(const Unit&) const {}
};
struct DualOrder {
    StaticOrder so; int nwg2; const char* A; const char* B; const char* A2; const char* B2; size_t step;
    __device__ void init(const void* A_, const void* B_, int M, int N, int K, int G, int c, const void* A2_, const void* B2_, int nwg2_) { so.init(M, N, G, c); A = (const char*)A_; B = (const char*)B_; A2 = (const char*)A2_; B2 = (const char*)B2_; nwg2 = nwg2_; step = (size_t)256 * K * 2; }
    __device__ __forceinline__ bool next(int i, Unit& u) const { const int L = i * so.G + so.c; if (L < so.nwg) { u.e = 0; return so.next(i, u); } if (L - so.nwg >= nwg2) return false; u.e = 1; u.pm = 0; u.pn = L - so.nwg; return true; }
    __device__ __forceinline__ const char* aptr(const Unit& u) const { return u.e ? A2 : A + (size_t)u.pm * step; }
    __device__ __forceinline__ const char* bptr(const Unit& u) const { return (u.e ? B2 : B) + (size_t)u.pn * step; }
    __device__ __forceinline__ void a_ready(const Unit&) const {}
    __device__ __forceinline__ void done(const Unit&) const {}
};
struct MoeOrder {
    const PG8_LAS int* tstart; int ntn, G, c; const char* A; const char* W; size_t astep, wexp, wtile;
    __device__ __forceinline__ bool next(int i, Unit& u) const {
        const int L = i * G + c, total = tstart[32] * ntn; if (L >= total) return false;
        u.pm = L / ntn; u.pn = L - u.pm * ntn; int e = 0;
#pragma unroll
        for (int k = 1; k <= 31; ++k) e += (tstart[k] <= u.pm) ? 1 : 0;
        u.e = e; return true;
    }
    __device__ __forceinline__ const char* aptr(const Unit& u) const { return A + (size_t)u.pm * astep; }
    __device__ __forceinline__ const char* bptr(const Unit& u) const { return W + (size_t)u.e * wexp + (size_t)u.pn * wtile; }
    __device__ __forceinline__ void a_ready(const Unit&) const {}
    __device__ __forceinline__ void done(const Unit&) const {}
};

struct EpiBf16X {
    static constexpr bool PERM = true, AFTER_DRAIN = false;
    int mode; bf16_t* p0; bf16_t* p1; bf16_t* p2; bf16_t* p3;
    __device__ __forceinline__ void operator()(const f32x4 (&acc)[2][2][4][2], const Unit& u, int wr, int wc, int fr, int fq) const {
        bf16_t* base; int ldc, colt; bool act = false; float sc = 1.f;
        if (u.e && mode < 2) { base = p3 + (size_t)(u.pn >> 2) * (256 * 1024); ldc = 1024; colt = (u.pn & 3) * BM; }
        else if (mode == 0) { base = p0; ldc = 3584; colt = u.pn * BM; act = u.pn < 12; if (u.pn >= 12) sc = QSCALE; }
        else if (mode == 1) { if (u.pn < 8) { base = p0; ldc = 2048; colt = u.pn * BM; sc = QSCALE; }
                              else if (u.pn < 14) { base = p1; ldc = 1536; colt = (u.pn - 8) * BM; } else { base = p2; ldc = 1536; colt = (u.pn - 14) * BM; } }
        else { base = p0; ldc = 2048; colt = u.pn * BM; }
        const int row0 = u.pm * BM + wr * 64 + fr, col0 = colt + wc * 32 + 8 * fq;
#pragma unroll
        for (int ai = 0; ai < 2; ++ai)
#pragma unroll
            for (int m = 0; m < 4; ++m) { bf16_t* rowp = base + (size_t)(row0 + ai * HALF + m * 16) * ldc + col0;
#pragma unroll
                for (int bj = 0; bj < 2; ++bj) { f32x4 v0 = acc[ai][bj][m][0], v1 = acc[ai][bj][m][1];
                    if (act) { f32x2 a = gelu_pk((f32x2){v0[0], v0[1]}), b = gelu_pk((f32x2){v0[2], v0[3]}), c = gelu_pk((f32x2){v1[0], v1[1]}), d = gelu_pk((f32x2){v1[2], v1[3]});
                        v0 = (f32x4){a.x, a.y, b.x, b.y}; v1 = (f32x4){c.x, c.y, d.x, d.y}; }
                    v0 = v0 * sc; v1 = v1 * sc; u32x4 w; w.x = cvt_pk_bf16(v0[0], v0[1]); w.y = cvt_pk_bf16(v0[2], v0[3]); w.z = cvt_pk_bf16(v1[0], v1[1]); w.w = cvt_pk_bf16(v1[2], v1[3]);
                    *(u32x4*)(rowp + bj * HALF) = w; } }
    }
};
struct EpiResF32 {
    static constexpr bool PERM = false, AFTER_DRAIN = false;
    const float* xres; float* y; float alpha;
    __device__ __forceinline__ void operator()(const f32x4 (&acc)[2][2][4][2], const Unit& u, int wr, int wc, int fr, int fq) const {
        const int row0 = u.pm * BM + wr * 64 + fr, col0 = u.pn * BM + wc * 32 + 4 * fq;
#pragma unroll
        for (int ai = 0; ai < 2; ++ai)
#pragma unroll
            for (int m = 0; m < 4; ++m) { const size_t off = (size_t)(row0 + ai * HALF + m * 16) * 2048 + col0;
#pragma unroll
                for (int bj = 0; bj < 2; ++bj)
#pragma unroll
                    for (int n = 0; n < 2; ++n) { const f32x4 xr = *(const f32x4*)(xres + off + bj * HALF + n * 16); *(f32x4*)(y + off + bj * HALF + n * 16) = xr * alpha + acc[ai][bj][m][n]; } }
    }
};
struct EpiMoe1 {
    static constexpr bool PERM = true, AFTER_DRAIN = false;
    bf16_t* h;
    __device__ __forceinline__ void operator()(const f32x4 (&acc)[2][2][4][2], const Unit& u, int wr, int wc, int fr, int fq) const {
        const int row0 = u.pm * BM + wr * 64 + fr, col0 = u.pn * HALF + wc * 32 + 8 * fq;
#pragma unroll
        for (int ai = 0; ai < 2; ++ai)
#pragma unroll
            for (int m = 0; m < 4; ++m) { bf16_t* rowp = h + (size_t)(row0 + ai * HALF + m * 16) * 512 + col0; float o[8];
#pragma unroll
                for (int n = 0; n < 2; ++n)
#pragma unroll
                    for (int x = 0; x < 4; ++x) { const float a = acc[ai][0][m][n][x], b = acc[ai][1][m][n][x];
                        o[n * 4 + x] = a * __builtin_amdgcn_rcpf(1.0f + __builtin_amdgcn_exp2f(-a * LOG2E)) * b; }
                u32x4 w; w.x = cvt_pk_bf16(o[0], o[1]); w.y = cvt_pk_bf16(o[2], o[3]); w.z = cvt_pk_bf16(o[4], o[5]); w.w = cvt_pk_bf16(o[6], o[7]);
                *(u32x4*)rowp = w; }
    }
};
}

namespace att {
using bf16x8 = __attribute__((ext_vector_type(8))) short;
using s16x4  = __attribute__((ext_vector_type(4))) short;
using f32x16 = __attribute__((ext_vector_type(16))) float;
using u32x4  = __attribute__((ext_vector_type(4))) unsigned;
constexpr int DH = 128, QBLK = 32, KVBLK = 64;
constexpr float THR2 = 8.f * 1.4426950408889634f;
constexpr size_t SHM_V = KVBLK * DH * 2, SHM_K = KVBLK * DH * 2, SHM_ATTN = 2 * SHM_V + 2 * SHM_K + NWAVES * 64 * 4;
constexpr int TAB_N = 160;
#define KSWZ(row, colB) ((row) * 256 + ((colB) ^ (((row) & 7) << 4)))
#define SBAR() __builtin_amdgcn_sched_barrier(0)
__device__ __forceinline__ int crow(int r, int hi) { return (r & 3) + 8 * (r >> 2) + 4 * hi; }
__device__ __forceinline__ unsigned cvtpk(float lo, float hi) { unsigned r; asm volatile("v_cvt_pk_bf16_f32 %0, %1, %2" : "=v"(r) : "v"(lo), "v"(hi)); return r; }

__device__ __forceinline__ void partialSM(f32x16& p0, f32x16& p1, float& m_reg, float& mn, float& alpha) {
  float pmax = p0[0];
#pragma unroll
  for (int r = 1; r < 16; ++r) pmax = fmaxf(pmax, p0[r]);
#pragma unroll
  for (int r = 0; r < 16; ++r) pmax = fmaxf(pmax, p1[r]);
  { auto rr = __builtin_amdgcn_permlane32_swap(__float_as_uint(pmax), __float_as_uint(pmax), false, false);
    pmax = fmaxf(__uint_as_float(rr[0]), __uint_as_float(rr[1])); }
  if (__builtin_expect(__all(pmax - m_reg <= THR2), 1)) { mn = m_reg; alpha = 1.f; }
  else { mn = fmaxf(m_reg, pmax); alpha = __builtin_amdgcn_exp2f(m_reg - mn); m_reg = mn; }
#pragma unroll
  for (int r = 0; r < 16; ++r) p0[r] = p0[r] - mn;
#pragma unroll
  for (int r = 0; r < 16; ++r) p1[r] = p1[r] - mn;
#pragma unroll
  for (int r = 0; r < 16; ++r) p0[r] = __builtin_amdgcn_exp2f(p0[r]);
}
__device__ __forceinline__ void finishSM(f32x16& p0, f32x16& p1, float alpha, float& l_reg, bf16x8& pa0, bf16x8& pa1, bf16x8& pa2, bf16x8& pa3) {
#pragma unroll
  for (int r = 0; r < 16; ++r) p1[r] = __builtin_amdgcn_exp2f(p1[r]);
  float ps = 0;
#pragma unroll
  for (int r = 0; r < 16; ++r) ps += p0[r];
#pragma unroll
  for (int r = 0; r < 16; ++r) ps += p1[r];
  { auto rr = __builtin_amdgcn_permlane32_swap(__float_as_uint(ps), __float_as_uint(ps), false, false);
    ps = __uint_as_float(rr[0]) + __uint_as_float(rr[1]); }
  l_reg = l_reg * alpha + ps;
#define PK4(P, BASE, OUT) do { unsigned a0 = cvtpk(P[BASE + 0], P[BASE + 1]), a1 = cvtpk(P[BASE + 2], P[BASE + 3]);   \
    unsigned b0 = cvtpk(P[BASE + 4], P[BASE + 5]), b1 = cvtpk(P[BASE + 6], P[BASE + 7]);                              \
    auto r0 = __builtin_amdgcn_permlane32_swap(a0, b0, false, false); auto r1 = __builtin_amdgcn_permlane32_swap(a1, b1, false, false); \
    u32x4 w = {r0[0], r1[0], r0[1], r1[1]}; OUT = *reinterpret_cast<bf16x8*>(&w); } while (0)
  PK4(p0, 0, pa0); PK4(p0, 8, pa1); PK4(p1, 0, pa2); PK4(p1, 8, pa3);
#undef PK4
}
__device__ __forceinline__ void qkt(f32x16& p0, f32x16& p1, const char* Ks, const bf16x8* qr, int r32, int hi) {
  p0 = f32x16{}; p1 = f32x16{};
#pragma unroll
  for (int d0 = 0; d0 < 8; ++d0) { const int cb = (d0 * 16 + hi * 8) * 2;
    bf16x8 b0 = *reinterpret_cast<const bf16x8*>(Ks + KSWZ(r32, cb));
    bf16x8 b1 = *reinterpret_cast<const bf16x8*>(Ks + KSWZ(32 + r32, cb));
    p0 = __builtin_amdgcn_mfma_f32_32x32x16_bf16(b0, qr[d0], p0, 0, 0, 0);
    p1 = __builtin_amdgcn_mfma_f32_32x32x16_bf16(b1, qr[d0], p1, 0, 0, 0); }
}
__device__ __forceinline__ int v_st(int k, int c) { const int kk = (k & ~0xC) | ((k & 4) << 1) | ((k & 8) >> 1); return ((kk >> 3) * 4 + (c >> 5)) * 512 + ((kk & 7) * 32 + (c & 31)) * 2; }
__device__ __forceinline__ int v_rd_base(int lane) { return ((lane & 3) << 3) | (((lane >> 2) & 3) << 6) | (((lane >> 4) & 1) << 5) | (((lane >> 5) & 1) << 8); }
constexpr int v_rd_off(int d0, int ks, int half) { return d0 * 512 + ks * 4096 + half * 2048; }
template <int OFF> __device__ __forceinline__ s16x4 tr_read(int vb) {
  s16x4 r; asm volatile("ds_read_b64_tr_b16 %0, %1 offset:%2" : "=&v"(r) : "v"(vb), "i"(OFF) : "memory"); return r;
}
template <int D0> __device__ __forceinline__ void pv_one(f32x16& od, int vb, bf16x8 pa0, bf16x8 pa1, bf16x8 pa2, bf16x8 pa3) {
  const s16x4 l0 = tr_read<v_rd_off(D0, 0, 0)>(vb), h0 = tr_read<v_rd_off(D0, 0, 1)>(vb), l1 = tr_read<v_rd_off(D0, 1, 0)>(vb), h1 = tr_read<v_rd_off(D0, 1, 1)>(vb);
  const s16x4 l2 = tr_read<v_rd_off(D0, 2, 0)>(vb), h2 = tr_read<v_rd_off(D0, 2, 1)>(vb), l3 = tr_read<v_rd_off(D0, 3, 0)>(vb), h3 = tr_read<v_rd_off(D0, 3, 1)>(vb);
  asm volatile("s_waitcnt lgkmcnt(0)" ::: "memory"); SBAR();
#define PK(L, H) (bf16x8){L[0], L[1], L[2], L[3], H[0], H[1], H[2], H[3]}
  od = __builtin_amdgcn_mfma_f32_32x32x16_bf16(pa0, PK(l0, h0), od, 0, 0, 0);
  od = __builtin_amdgcn_mfma_f32_32x32x16_bf16(pa1, PK(l1, h1), od, 0, 0, 0);
  od = __builtin_amdgcn_mfma_f32_32x32x16_bf16(pa2, PK(l2, h2), od, 0, 0, 0);
  od = __builtin_amdgcn_mfma_f32_32x32x16_bf16(pa3, PK(l3, h3), od, 0, 0, 0);
#undef PK
}
__device__ __forceinline__ void pv_d0(f32x16* o, int vb, bf16x8 pa0, bf16x8 pa1, bf16x8 pa2, bf16x8 pa3) {
  pv_one<0>(o[0], vb, pa0, pa1, pa2, pa3); pv_one<1>(o[1], vb, pa0, pa1, pa2, pa3); pv_one<2>(o[2], vb, pa0, pa1, pa2, pa3); pv_one<3>(o[3], vb, pa0, pa1, pa2, pa3);
}
template <int MODE> __device__ __forceinline__ void post_scores(f32x16& p0, f32x16& p1, int t, int qrow0, int r32, int hi, const float* tab, float cfar) {
  if constexpr (MODE == 1) {
    const int cw = qrow0 >> 6;
    if (t > cw) {
#pragma unroll
      for (int r = 0; r < 16; ++r) { p0[r] = -INFINITY; p1[r] = -INFINITY; }
    } else if (qrow0 - (64 * t + 63) >= 91) {
#pragma unroll
      for (int r = 0; r < 16; ++r) { p0[r] += cfar; p1[r] += cfar; }
    } else {
      const int base = qrow0 + r32 - 64 * t + 63;
#pragma unroll
      for (int r = 0; r < 16; ++r) { const int i0 = base - crow(r, hi); const int i1 = i0 - 32;
        p0[r] += tab[i0 < TAB_N - 1 ? i0 : TAB_N - 1]; p1[r] += tab[i1 < TAB_N - 1 ? i1 : TAB_N - 1]; }
    }
  }
}

template <int MODE>
__device__ __forceinline__ void attn_body(const bf16* __restrict__ Qb, int ldq, const bf16* __restrict__ Kh, const bf16* __restrict__ Vh, int ldk,
                                          bf16* Ob, float* Of, int ldo, int NT, int q0abs, const float* tab, float cfar, char* lds) {
  int tid_ = threadIdx.x; asm volatile("" : "+v"(tid_));
  const int tid = tid_, wid = tid >> 6, lane = tid & 63, r32 = lane & 31, hi = lane >> 5;
  char* V_lds = lds; char* K_lds = lds + 2 * SHM_V;
  float* ws = (float*)(lds + 2 * SHM_V + 2 * SHM_K) + wid * 64; float* li_l = ws; float* al_l = ws + 32;
  float m_reg = -1e30f, l_reg = 0; f32x16 o[4] = {}; bf16x8 qr[8];
  const int qrow0 = q0abs + wid * QBLK;
  const bf16* Qw = Qb + (long)(wid * QBLK + r32) * ldq + hi * 8;
#pragma unroll
  for (int d0 = 0; d0 < 8; ++d0) qr[d0] = *reinterpret_cast<const bf16x8*>(Qw + d0 * 16);
  const int sr = tid >> 4, sc = (tid & 15) * 8, vst0 = v_st(sr, sc), vst1 = v_st(32 + sr, sc);
  const int vb0 = (int)(uintptr_t)V_lds + v_rd_base(lane);
  struct { bf16x8 vs0, vs1, ks0, ks1; } sr_[2];
#define SLOAD(i, k0) do { sr_[i].vs0 = *reinterpret_cast<const bf16x8*>(&Vh[(long)((k0) + sr) * ldk + sc]); sr_[i].vs1 = *reinterpret_cast<const bf16x8*>(&Vh[(long)((k0) + 32 + sr) * ldk + sc]); \
    sr_[i].ks0 = *reinterpret_cast<const bf16x8*>(&Kh[(long)((k0) + sr) * ldk + sc]); sr_[i].ks1 = *reinterpret_cast<const bf16x8*>(&Kh[(long)((k0) + 32 + sr) * ldk + sc]); } while (0)
#define SWRITE(b, i) do { *(bf16x8*)(V_lds + (b) * SHM_V + vst0) = sr_[i].vs0;          \
    *(bf16x8*)(V_lds + (b) * SHM_V + vst1) = sr_[i].vs1; const int kc = sc * 2;               \
    *(bf16x8*)(K_lds + (b) * SHM_K + KSWZ(sr, kc)) = sr_[i].ks0;                       \
    *(bf16x8*)(K_lds + (b) * SHM_K + KSWZ(32 + sr, kc)) = sr_[i].ks1; } while (0)
#define SWAIT() asm volatile("s_waitcnt vmcnt(4)" ::: "memory")
#define RESC(a) do { if (__any((a) < 1.f)) { if (hi == 0) al_l[r32] = (a); asm volatile("s_waitcnt lgkmcnt(0)" ::: "memory"); \
    _Pragma("unroll") for (int d = 0; d < 4; ++d) _Pragma("unroll") for (int r = 0; r < 16; ++r) o[d][r] *= al_l[crow(r, hi)]; } } while (0)
  f32x16 pA0, pA1, pB0, pB1; float mnA, mnB, alA, alB; bf16x8 pa0, pa1, pa2, pa3;
  constexpr int SE = 0, SO = 1;
  SLOAD(SE, 0); asm volatile("s_waitcnt vmcnt(0)" ::: "memory"); SWRITE(0, SE); __syncthreads();
  qkt(pA0, pA1, K_lds, qr, r32, hi); post_scores<MODE>(pA0, pA1, 0, qrow0, r32, hi, tab, cfar); partialSM(pA0, pA1, m_reg, mnA, alA);
  SLOAD(SO, KVBLK); if (2 < NT) SLOAD(SE, 2 * KVBLK);
  SWAIT(); SWRITE(1, SO); __syncthreads();
  for (int j = 1; j + 1 < NT; j += 2) {
    SBAR(); qkt(pB0, pB1, K_lds + SHM_K, qr, r32, hi); post_scores<MODE>(pB0, pB1, j, qrow0, r32, hi, tab, cfar);
    finishSM(pA0, pA1, alA, l_reg, pa0, pa1, pa2, pa3); SBAR();
    SLOAD(SO, (j + 2) * KVBLK); SBAR();
    pv_d0(o, vb0, pa0, pa1, pa2, pa3); partialSM(pB0, pB1, m_reg, mnB, alB);
    __syncthreads(); SWAIT(); SWRITE(0, SE);
    RESC(alB); __syncthreads();
    SBAR(); qkt(pA0, pA1, K_lds, qr, r32, hi); post_scores<MODE>(pA0, pA1, j + 1, qrow0, r32, hi, tab, cfar);
    finishSM(pB0, pB1, alB, l_reg, pa0, pa1, pa2, pa3); SBAR();
    if (j + 3 < NT) SLOAD(SE, (j + 3) * KVBLK); SBAR();
    pv_d0(o, vb0 + (int)SHM_V, pa0, pa1, pa2, pa3); partialSM(pA0, pA1, m_reg, mnA, alA);
    __syncthreads(); SWAIT(); SWRITE(1, SO);
    RESC(alA); __syncthreads();
  }
  SBAR(); qkt(pB0, pB1, K_lds + SHM_K, qr, r32, hi); post_scores<MODE>(pB0, pB1, NT - 1, qrow0, r32, hi, tab, cfar);
  finishSM(pA0, pA1, alA, l_reg, pa0, pa1, pa2, pa3); SBAR();
  pv_d0(o, vb0, pa0, pa1, pa2, pa3); partialSM(pB0, pB1, m_reg, mnB, alB);
  __syncthreads(); RESC(alB);
  finishSM(pB0, pB1, alB, l_reg, pa0, pa1, pa2, pa3); SBAR();
  pv_d0(o, vb0 + (int)SHM_V, pa0, pa1, pa2, pa3);
  if (hi == 0) li_l[r32] = l_reg; asm volatile("s_waitcnt lgkmcnt(0)" ::: "memory");
  float rli[16];
#pragma unroll
  for (int r = 0; r < 16; ++r) rli[r] = __builtin_amdgcn_rcpf(li_l[crow(r, hi)]);
  if constexpr (MODE == 0) {
    bf16* Ow = Ob + (long)(wid * QBLK) * ldo;
#pragma unroll
    for (int r = 0; r < 16; ++r) { const int orow = crow(r, hi);
#pragma unroll
      for (int d0 = 0; d0 < 4; ++d0) Ow[(long)orow * ldo + d0 * 32 + r32] = (bf16)f2bf(o[d0][r] * rli[r]); }
  } else {
    float* Ow = Of + (long)(wid * QBLK) * ldo;
#pragma unroll
    for (int r = 0; r < 16; ++r) { const int orow = crow(r, hi);
#pragma unroll
      for (int d0 = 0; d0 < 4; ++d0) Ow[(long)orow * ldo + d0 * 32 + r32] = o[d0][r] * rli[r]; }
  }
  __syncthreads();
#undef SLOAD
#undef SWRITE
#undef SWAIT
#undef RESC
}
__device__ __forceinline__ void attn_body_diff(const bf16* __restrict__ Qb, int ldq, const bf16* __restrict__ Kh, const bf16* __restrict__ Vh, int ldk,
                                               float* Of, int ldo, int NT, int q0abs, const float* tab, float cfar, char* lds) {
  int tid_ = threadIdx.x; asm volatile("" : "+v"(tid_));
  const int tid = tid_, wid = tid >> 6, lane = tid & 63, r32 = lane & 31, hi = lane >> 5;
  char* V_lds = lds; char* K_lds = lds + 2 * SHM_V;
  float* ws = (float*)(lds + 2 * SHM_V + 2 * SHM_K) + wid * 64; float* li_l = ws; float* al_l = ws + 32;
  float m_reg = -1e30f, l_reg = 0; f32x16 o[4] = {}; bf16x8 qr[8];
  const int qrow0 = q0abs + wid * QBLK;
  const bf16* Qw = Qb + (long)(wid * QBLK + r32) * ldq + hi * 8;
#pragma unroll
  for (int d0 = 0; d0 < 8; ++d0) qr[d0] = *reinterpret_cast<const bf16x8*>(Qw + d0 * 16);
  const int sr = tid >> 4, sc = (tid & 15) * 8, vst0 = v_st(sr, sc), vst1 = v_st(32 + sr, sc);
  const int vb0 = (int)(uintptr_t)V_lds + v_rd_base(lane);
  bf16x8 vs0, vs1, ks0, ks1;
#define SLOAD1(k0) do { vs0 = *reinterpret_cast<const bf16x8*>(&Vh[(long)((k0) + sr) * ldk + sc]); vs1 = *reinterpret_cast<const bf16x8*>(&Vh[(long)((k0) + 32 + sr) * ldk + sc]); \
    ks0 = *reinterpret_cast<const bf16x8*>(&Kh[(long)((k0) + sr) * ldk + sc]); ks1 = *reinterpret_cast<const bf16x8*>(&Kh[(long)((k0) + 32 + sr) * ldk + sc]); } while (0)
#define SWRITE1(b) do { *(bf16x8*)(V_lds + (b) * SHM_V + vst0) = vs0; *(bf16x8*)(V_lds + (b) * SHM_V + vst1) = vs1; const int kc = sc * 2; \
    *(bf16x8*)(K_lds + (b) * SHM_K + KSWZ(sr, kc)) = ks0; *(bf16x8*)(K_lds + (b) * SHM_K + KSWZ(32 + sr, kc)) = ks1; } while (0)
  SLOAD1(0); asm volatile("s_waitcnt vmcnt(0)" ::: "memory"); SWRITE1(0); __syncthreads();
  for (int t = 0; t < NT; ++t) {
    const int b = t & 1;
    if (t + 1 < NT) SLOAD1((t + 1) * KVBLK);
    f32x16 p0, p1; float mn, al; bf16x8 pa0, pa1, pa2, pa3;
    qkt(p0, p1, K_lds + b * SHM_K, qr, r32, hi); post_scores<1>(p0, p1, t, qrow0, r32, hi, tab, cfar);
    partialSM(p0, p1, m_reg, mn, al); finishSM(p0, p1, al, l_reg, pa0, pa1, pa2, pa3);
    if (__any(al < 1.f)) { if (hi == 0) al_l[r32] = al; asm volatile("s_waitcnt lgkmcnt(0)" ::: "memory");
#pragma unroll
      for (int d = 0; d < 4; ++d)
#pragma unroll
        for (int r = 0; r < 16; ++r) o[d][r] *= al_l[crow(r, hi)]; }
    SBAR(); pv_d0(o, vb0 + b * (int)SHM_V, pa0, pa1, pa2, pa3);
    if (t + 1 < NT) { asm volatile("s_waitcnt vmcnt(0)" ::: "memory"); SWRITE1(b ^ 1); }
    __syncthreads();
  }
  if (hi == 0) li_l[r32] = l_reg; asm volatile("s_waitcnt lgkmcnt(0)" ::: "memory");
  float rli[16];
#pragma unroll
  for (int r = 0; r < 16; ++r) rli[r] = __builtin_amdgcn_rcpf(li_l[crow(r, hi)]);
  float* Ow = Of + (long)(wid * QBLK) * ldo;
#pragma unroll
  for (int r = 0; r < 16; ++r) { const int orow = crow(r, hi);
#pragma unroll
    for (int d0 = 0; d0 < 4; ++d0) Ow[(long)orow * ldo + d0 * 32 + r32] = o[d0][r] * rli[r]; }
  __syncthreads();
#undef SLOAD1
#undef SWRITE1
}
}

#define XB_TMO      128
#define XB_XCNT(j)  (256  + 64 * (j))
#define XB_XSUB(j)  (1280 + 64 * (j))
#define XB_XGEN(j)  (2304 + 64 * (j))
#define XB_TOP      3328
#define XB_TOPGEN   3392
#define XCD_BAR_WORDS 3456
#define XB_SPIN_CAP (1u << 18)

__device__ __forceinline__ unsigned xb_ld(unsigned* p)              { return __hip_atomic_load(p, __ATOMIC_RELAXED, __HIP_MEMORY_SCOPE_AGENT); }
__device__ __forceinline__ unsigned xb_add(unsigned* p, unsigned v) { return __hip_atomic_fetch_add(p, v, __ATOMIC_RELAXED, __HIP_MEMORY_SCOPE_AGENT); }
__device__ __forceinline__ unsigned xb_xcc_id() { return (unsigned)__builtin_amdgcn_s_getreg((3 << 11) | 20) & 0xFu; }
#define XB_SPIN(cond, bar) do { unsigned _sp = 0; while (cond) { __builtin_amdgcn_s_sleep(1); \
    if ((++_sp & 255u) == 0u) { if (xb_ld(&(bar)[XB_TMO])) break; if (_sp > XB_SPIN_CAP) { atomicAdd(&(bar)[XB_TMO], 1u); break; } } } } while (0)

struct XcdBarrier {
    unsigned* bar; unsigned x;
    volatile LAS unsigned* st;
};

__device__ __forceinline__ XcdBarrier xcd_barrier_post(unsigned* bar, volatile LAS unsigned* st) {
    XcdBarrier b; b.bar = bar; b.x = xb_xcc_id(); b.st = st;
    if (threadIdx.x == 0) (void)xb_add(&bar[XB_XCNT(b.x)], 1u);
    return b;
}
__device__ __forceinline__ void xcd_barrier_complete(unsigned* bar, unsigned x, unsigned& nloc, unsigned& nx) {
    const unsigned G = gridDim.x * gridDim.y * gridDim.z;
    unsigned sum, cnt, mine, sp = 0u;
    for (;;) {
        sum = 0u; cnt = 0u; mine = 0u;
#pragma unroll
        for (unsigned j = 0; j < 16; ++j) { const unsigned c = xb_ld(&bar[XB_XCNT(j)]); sum += c; cnt += (c > 0u) ? 1u : 0u; mine = (j == x) ? c : mine; }
        if (sum == G) break;
        __builtin_amdgcn_s_sleep(1);
        if ((++sp & 255u) == 0u) { if (xb_ld(&bar[XB_TMO])) break; if (sp > XB_SPIN_CAP) { atomicAdd(&bar[XB_TMO], 1u); break; } }
    }
    nloc = mine > 0u ? mine : 1u; nx = cnt > 0u ? cnt : 1u;
}

__device__ __forceinline__ void xcd_barrier(const XcdBarrier& b) {
    asm volatile("s_waitcnt vmcnt(0)" ::: "memory");
    __syncthreads();
    if (threadIdx.x == 0) {
        unsigned* bar = b.bar;
        __builtin_amdgcn_s_waitcnt(0);
        unsigned nloc = b.st[0], nx = b.st[1];
        if (nloc == 0u) { xcd_barrier_complete(bar, b.x, nloc, nx); b.st[0] = nloc; b.st[1] = nx; }
        const unsigned old = xb_add(&bar[XB_XSUB(b.x)], 1u);
        const unsigned gen = old / nloc;
        if (old + 1u == (gen + 1u) * nloc) {
            __builtin_amdgcn_fence(__ATOMIC_RELEASE, "agent");
            asm volatile("s_waitcnt vmcnt(0)" ::: "memory");
            const unsigned og = xb_add(&bar[XB_TOP], 1u);
            const unsigned tg = og / nx;
            if (og + 1u == (tg + 1u) * nx) xb_add(&bar[XB_TOPGEN], 1u);
            else XB_SPIN(xb_ld(&bar[XB_TOPGEN]) == tg, bar);
            __builtin_amdgcn_fence(__ATOMIC_ACQUIRE, "agent");
            xb_add(&bar[XB_XGEN(b.x)], 1u);
            asm volatile("s_waitcnt vmcnt(0)" ::: "memory");
        } else {
            XB_SPIN(xb_ld(&bar[XB_XGEN(b.x)]) == gen, bar);
            __builtin_amdgcn_fence(__ATOMIC_ACQUIRE, "agent");
            asm volatile("s_waitcnt vmcnt(0)" ::: "memory");
        }
    }
    __syncthreads();
}


struct Args { const float* in[24]; float* out; unsigned char* ws; int ph_lo, ph_hi; };
enum { I_X = 0, I_MEM, I_AWIN, I_ALNG, I_ALNB, I_AWS, I_ABS, I_AWOUT, I_BWIN, I_BLAM, I_BSUBG, I_BWOUT, I_WKV, I_RELB, I_MEMWKV, I_LNG, I_LNB,
       I_WG1, I_BG1, I_WG2, I_BG2, I_W1, I_W3, I_W2 };
constexpr int NPH_LAYER = 9, NPHASES = 1 + DEPTH * NPH_LAYER;

struct Frame {
    LAS unsigned char* lds; char* ldsg;
    gu32* ctl; unsigned char* ws;
    int tid, lane, wave, G, c;
};

__device__ __forceinline__ void transpose_item(const float* W, int K, int N, bf16* WT, int drow0, LAS float* scr, int k0, int n0, int lane) {
#pragma unroll 8
    for (int i = 0; i < 32; ++i) { const int kk = 2 * i + (lane >> 5); scr[kk * 33 + (lane & 31)] = W[(size_t)(k0 + kk) * N + n0 + (lane & 31)]; }
    LDS_WAIT(); asm volatile("" ::: "memory");
    const int c = lane & 7;
#pragma unroll
    for (int j = 0; j < 4; ++j) { const int n = (lane >> 3) + 8 * j; const LAS float* s = scr + (8 * c) * 33 + n;
        v4u o; o.x = pk2(s[0 * 33], s[1 * 33]); o.y = pk2(s[2 * 33], s[3 * 33]); o.z = pk2(s[4 * 33], s[5 * 33]); o.w = pk2(s[6 * 33], s[7 * 33]);
        *(GAS v4u*)(WT + (size_t)(drow0 + n) * K + k0 + 8 * c) = o; }
    LDS_WAIT(); asm volatile("" ::: "memory");
}
__device__ __forceinline__ void prologue_phase(Frame& F, const Args& a) {
    LAS float* scr = (LAS float*)(F.lds + RING_OFF + F.wave * 16384);
    const int gw = F.c * NWAVES + F.wave, NGW = F.G * NWAVES;
    unsigned char* ws = F.ws;
    constexpr int S0 = 2 * 3584, S1 = 2 * 2048, S2 = 2 * 2048, S3 = 2 * 2048, S4 = 3072, S5 = 4 * 1024, S6 = 128 * 512, S7 = 128 * 512, S8 = 128 * 512;
    constexpr int NITEMS = S0 + S1 + S2 + S3 + S4 + S5 + S6 + S7 + S8;
    for (int it = gw; it < NITEMS; it += NGW) {
        int r = it; const float* src; bf16* dst; int K, N, nblk, mat, per; int dmode = 0;
        if (r < S0) { per = 3584; mat = r / per; r -= mat * per; K = 2048; N = 3584; src = a.in[I_AWIN] + (size_t)mat * K * N; dst = (bf16*)(ws + WS_WAIN) + (size_t)mat * K * N; }
        else if ((r -= S0) < S1) { per = 2048; mat = r / per; r -= mat * per; K = 2048; N = 2048; src = a.in[I_AWOUT] + (size_t)mat * K * N; dst = (bf16*)(ws + WS_WAOUT) + (size_t)mat * K * N; }
        else if ((r -= S1) < S2) { per = 2048; mat = r / per; r -= mat * per; K = 2048; N = 2048; src = a.in[I_BWIN] + (size_t)mat * K * N; dst = (bf16*)(ws + (mat ? WS_WBIN1 : WS_WBIN0)); }
        else if ((r -= S2) < S3) { per = 2048; mat = r / per; r -= mat * per; K = 2048; N = 2048; src = a.in[I_BWOUT] + (size_t)mat * K * N; dst = (bf16*)(ws + WS_WBOUT) + (size_t)mat * K * N; }
        else if ((r -= S3) < S4) { K = 2048; N = 3072; src = a.in[I_WKV]; dst = (bf16*)(ws + WS_WKV); }
        else if ((r -= S4) < S5) { per = 1024; mat = r / per; r -= mat * per; K = 2048; N = 1024; src = a.in[I_MEMWKV] + (size_t)mat * K * N; dst = (bf16*)(ws + WS_WMKV) + (size_t)mat * K * N; }
        else if ((r -= S5) < S6) { per = 512; mat = r / per; r -= mat * per; K = 2048; N = 512; src = a.in[I_W1] + (size_t)mat * K * N; dst = (bf16*)(ws + WS_W13) + (size_t)mat * 1024 * 2048; dmode = 1; }
        else if ((r -= S6) < S7) { per = 512; mat = r / per; r -= mat * per; K = 2048; N = 512; src = a.in[I_W3] + (size_t)mat * K * N; dst = (bf16*)(ws + WS_W13) + (size_t)mat * 1024 * 2048; dmode = 2; }
        else { r -= S7; per = 512; mat = r / per; r -= mat * per; K = 512; N = 2048; src = a.in[I_W2] + (size_t)mat * K * N; dst = (bf16*)(ws + WS_W2) + (size_t)mat * K * N; }
        nblk = N / 32; const int kb = r / nblk, nb = r - kb * nblk, n0 = 32 * nb;
        int drow0 = n0; if (dmode) drow0 = (n0 >> 7) * 256 + (n0 & 127) + (dmode == 2 ? 128 : 0);
        transpose_item(src, K, N, dst, drow0, scr, 64 * kb, n0, F.lane);
    }
    const long nthr = (long)F.G * 512, gt = (long)F.c * 512 + F.tid;
    { const float* x = a.in[I_X]; bf16* xb = (bf16*)(ws + WS_XB);
      for (long i = gt; i < (long)T * D / 8; i += nthr) { const f32x4 v0 = *(const GAS f32x4*)(x + i * 8), v1 = *(const GAS f32x4*)(x + i * 8 + 4);
          v4u o; o.x = pk2(v0.x, v0.y); o.y = pk2(v0.z, v0.w); o.z = pk2(v1.x, v1.y); o.w = pk2(v1.z, v1.w); *(GAS v4u*)(xb + i * 8) = o; } }
    { const float* x = a.in[I_MEM]; bf16* xb = (bf16*)(ws + WS_MEMB);
      for (long i = gt; i < (long)MEMT * D / 8; i += nthr) { const f32x4 v0 = *(const GAS f32x4*)(x + i * 8), v1 = *(const GAS f32x4*)(x + i * 8 + 4);
          v4u o; o.x = pk2(v0.x, v0.y); o.y = pk2(v0.z, v0.w); o.z = pk2(v1.x, v1.y); o.w = pk2(v1.z, v1.w); *(GAS v4u*)(xb + i * 8) = o; } }
}

__device__ __forceinline__ void sgu_unit(Frame& F, const Args& a, int l, int n, int g) {
    constexpr int LDW = 136;
    LAS float* stats = (LAS float*)(F.lds); LAS bf16* Wl = (LAS bf16*)(F.lds + 1024); LAS bf16* Vt = (LAS bf16*)(F.lds + 35840);
    const bf16* z = (const bf16*)(F.ws + WS_Z); bf16* cat = (bf16*)(F.ws + WS_CAT);
    const int tok0 = n * 128;
    for (int i = 0; i < 16; ++i) { const int tk = F.wave * 16 + i; const GAS v4u* rp = (const GAS v4u*)(z + (size_t)(tok0 + tk) * NINA + MIXW) + F.lane;
        v4u w[3]; float s = 0.f;
#pragma unroll
        for (int j = 0; j < 3; ++j) { w[j] = rp[64 * j]; s += (bflo(w[j].x) + bfhi(w[j].x)) + (bflo(w[j].y) + bfhi(w[j].y)) + (bflo(w[j].z) + bfhi(w[j].z)) + (bflo(w[j].w) + bfhi(w[j].w)); }
        const float mean = wave_sum(s) * (1.f / MIXW); float q = 0.f;
#pragma unroll
        for (int j = 0; j < 3; ++j) { float d;
            d = bflo(w[j].x) - mean; q += d * d; d = bfhi(w[j].x) - mean; q += d * d; d = bflo(w[j].y) - mean; q += d * d; d = bfhi(w[j].y) - mean; q += d * d;
            d = bflo(w[j].z) - mean; q += d * d; d = bfhi(w[j].z) - mean; q += d * d; d = bflo(w[j].w) - mean; q += d * d; d = bfhi(w[j].w) - mean; q += d * d; }
        const float rstd = 1.f / sqrtf(wave_sum(q) * (1.f / MIXW) + LN_EPS);
        if (F.lane == 0) { stats[2 * tk] = mean; stats[2 * tk + 1] = rstd; } }
    { const float* wsrc = a.in[I_AWS] + ((size_t)l * 4 + g) * 128 * 128;
      for (int p = F.tid; p < 128 * 32; p += 512) { const int i = p >> 5, j4 = (p & 31) * 4; f32x4 v = *(const GAS f32x4*)(wsrc + i * 128 + j4);
          if ((j4 >> 6) > (i >> 6)) v = (f32x4){0.f, 0.f, 0.f, 0.f};
          v2u o; o.x = pk2(v.x, v.y); o.y = pk2(v.z, v.w); *(LAS v2u*)(Wl + i * LDW + j4) = o; } }
    __syncthreads();
    { const float* lg = a.in[I_ALNG] + (size_t)l * MIXW + g * 384; const float* lb = a.in[I_ALNB] + (size_t)l * MIXW + g * 384;
      for (int p = F.tid; p < 128 * 48; p += 512) { const int j = p & 127, c8 = (p >> 7) * 8;
          const v4u w = *(const GAS v4u*)(z + (size_t)(tok0 + j) * NINA + MIXW + g * 384 + c8);
          const float mean = stats[2 * j], rstd = stats[2 * j + 1];
          const f32x4 g0 = *(const GAS f32x4*)(lg + c8), g1 = *(const GAS f32x4*)(lg + c8 + 4), b0 = *(const GAS f32x4*)(lb + c8), b1 = *(const GAS f32x4*)(lb + c8 + 4);
          float v[8] = {bflo(w.x), bfhi(w.x), bflo(w.y), bfhi(w.y), bflo(w.z), bfhi(w.z), bflo(w.w), bfhi(w.w)};
          const float gg[8] = {g0.x, g0.y, g0.z, g0.w, g1.x, g1.y, g1.z, g1.w}, bb[8] = {b0.x, b0.y, b0.z, b0.w, b1.x, b1.y, b1.z, b1.w};
#pragma unroll
          for (int e = 0; e < 8; ++e) Vt[(c8 + e) * LDW + j] = (bf16)f2bf((v[e] - mean) * rstd * gg[e] + bb[e]); } }
    __syncthreads();
    const int fr = F.lane & 15, fq = F.lane >> 4;
    f32x4 acc[8][3];
#pragma unroll
    for (int mb = 0; mb < 8; ++mb)
#pragma unroll
        for (int nb = 0; nb < 3; ++nb) acc[mb][nb] = (f32x4){0.f, 0.f, 0.f, 0.f};
#pragma unroll
    for (int ks = 0; ks < 4; ++ks) { bf16x8 bfr[3];
#pragma unroll
        for (int nb = 0; nb < 3; ++nb) bfr[nb] = *(const LAS bf16x8*)(Vt + (F.wave * 48 + nb * 16 + fr) * LDW + ks * 32 + fq * 8);
#pragma unroll
        for (int mb = 0; mb < 8; ++mb) { const bf16x8 afr = *(const LAS bf16x8*)(Wl + (mb * 16 + fr) * LDW + ks * 32 + fq * 8);
#pragma unroll
            for (int nb = 0; nb < 3; ++nb) acc[mb][nb] = __builtin_amdgcn_mfma_f32_16x16x32_bf16(bfr[nb], afr, acc[mb][nb], 0, 0, 0); } }
    const float* bs = a.in[I_ABS] + ((size_t)l * 4 + g) * 128;
#pragma unroll
    for (int mb = 0; mb < 8; ++mb) { const int i = mb * 16 + fr; const float bsv = bs[i]; const size_t tk = (size_t)(tok0 + i);
#pragma unroll
        for (int nb = 0; nb < 3; ++nb) { const int c = g * 384 + F.wave * 48 + nb * 16 + 4 * fq;
            const v2u uw = *(const GAS v2u*)(z + tk * NINA + c); const f32x4 gt = acc[mb][nb] + bsv;
            v2u o; o.x = pk2(bflo(uw.x) * gt.x, bfhi(uw.x) * gt.y); o.y = pk2(bflo(uw.y) * gt.z, bfhi(uw.y) * gt.w);
            *(GAS v2u*)(cat + tk * D + c) = o; } }
    __syncthreads();
}

__device__ __forceinline__ void memattn_unit(Frame& F, int l, int hm, int qb, int ldz, int qoff) {
    const bf16* z = (const bf16*)(F.ws + WS_Z); const bf16* kv = (const bf16*)(F.ws + WS_MEMKV) + (size_t)l * 256 * 1024; bf16* cat = (bf16*)(F.ws + WS_CAT);
    att::attn_body<0>(z + (size_t)qb * 256 * ldz + qoff + hm * 128, ldz, kv + hm * 128, kv + 512 + hm * 128, 1024,
                      cat + (size_t)qb * 256 * D + MIXW + hm * 128, nullptr, D, 4, 0, nullptr, 0.f, F.ldsg);
}

__device__ __forceinline__ int t5_bucket(int rel) {
    const int a = rel < 0 ? -rel : rel; int f;
    if (a < 8) f = a; else if (a < 12) f = 8; else if (a < 16) f = 9; else if (a < 23) f = 10; else if (a < 32) f = 11; else if (a < 46) f = 12; else if (a < 64) f = 13; else if (a < 91) f = 14; else f = 15;
    return (rel > 0 ? 16 : 0) + f;
}
__device__ __forceinline__ void diffattn_unit(Frame& F, const Args& a, int h, int qb, int m, int vh) {
    const bf16* q = (const bf16*)(F.ws + WS_Z); const bf16* kd = (const bf16*)(F.ws + WS_KD); const bf16* vd = (const bf16*)(F.ws + WS_VD); float* op = (float*)(F.ws + WS_OP);
    float* tab = (float*)(F.ldsg + att::SHM_ATTN);
    if (F.tid < att::TAB_N) { const int d = F.tid - 63; tab[F.tid] = a.in[I_RELB][t5_bucket(-d) * 6 + h] * LOG2E; }
    const float cfar = a.in[I_RELB][15 * 6 + h] * LOG2E;
    att::attn_body_diff(q + (size_t)qb * 256 * 2048 + h * 256 + m * 128, 2048, kd + h * 256 + m * 128, vd + h * 256 + vh * 128, 1536,
                      op + (size_t)qb * 256 * 3072 + (h * 2 + m) * 256 + vh * 128, 3072, 4 * (qb + 1), qb * 256, tab, cfar, F.ldsg);
}

__device__ __forceinline__ void diffcombine_phase(Frame& F, const Args& a, int l) {
    const int i = l - 2; const float* lp = a.in[I_BLAM] + (size_t)i * 4 * 128;
    float s1 = lp[F.lane] * lp[128 + F.lane] + lp[64 + F.lane] * lp[128 + 64 + F.lane], s2 = lp[256 + F.lane] * lp[384 + F.lane] + lp[256 + 64 + F.lane] * lp[384 + 64 + F.lane];
    s1 = wave_sum(s1); s2 = wave_sum(s2);
    const float lam_init = 0.8f - 0.6f * expf(-0.3f * (float)l);
    const float lam = expf(s1) - expf(s2) + lam_init;
    const float* op = (const float*)(F.ws + WS_OP); bf16* cat = (bf16*)(F.ws + WS_CAT);
    const f32x4 gsub = *(const GAS f32x4*)(a.in[I_BSUBG] + (size_t)i * 256 + 4 * F.lane);
    const int gw = F.c * NWAVES + F.wave, NGW = F.G * NWAVES;
    for (int it = gw; it < T * 6; it += NGW) { const int tk = it / 6, h = it - tk * 6;
        const f32x4 o1 = *(const GAS f32x4*)(op + ((size_t)tk * 6 + h) * 512 + 4 * F.lane), o2 = *(const GAS f32x4*)(op + ((size_t)tk * 6 + h) * 512 + 256 + 4 * F.lane);
        const f32x4 o = o1 - o2 * lam; const float ss = wave_sum((o.x * o.x + o.y * o.y) + (o.z * o.z + o.w * o.w));
        const float r = (1.f - lam_init) / sqrtf(ss * (1.f / 256.f) + LN_EPS);
        v2u w; w.x = pk2(o.x * r * gsub.x, o.y * r * gsub.y); w.y = pk2(o.z * r * gsub.z, o.w * r * gsub.w);
        *(GAS v2u*)(cat + (size_t)tk * D + h * 256 + 4 * F.lane) = w; }
}

__device__ __forceinline__ void ln1_router_phase(Frame& F, const Args& a, int l) {
    const float* y = (const float*)(F.ws + WS_Y); float* x1f = (float*)(F.ws + WS_X1F); bf16* x1b = (bf16*)(F.ws + WS_X1B);
    const float* lng = a.in[I_LNG] + ((size_t)l * 2 + 0) * D; const float* lnb = a.in[I_LNB] + ((size_t)l * 2 + 0) * D;
    const float* wg1 = a.in[I_WG1] + (size_t)l * D * 4; const float* bg1 = a.in[I_BG1] + l * 4;
    const float* wg2 = a.in[I_WG2] + (size_t)l * 4 * D * 8; const float* bg2 = a.in[I_BG2] + l * 32;
    int* tok_e = (int*)(F.ws + WS_ROUTE); int* tok_rank = tok_e + 2 * T; float* tok_gate = (float*)(tok_rank + 2 * T);
    gu32* cnt = F.ctl + CW_CNT + 64 * l;
    const int gw = F.c * NWAVES + F.wave, NGW = F.G * NWAVES;
    for (int tk = gw; tk < T; tk += NGW) {
        const GAS f32x4* yr = (const GAS f32x4*)(y + (size_t)tk * D) + F.lane;
        f32x4 v[8]; float s = 0.f;
#pragma unroll
        for (int j = 0; j < 8; ++j) { v[j] = yr[64 * j]; s += (v[j].x + v[j].y) + (v[j].z + v[j].w); }
        const float mean = wave_sum(s) * (1.f / D); float s2 = 0.f;
#pragma unroll
        for (int j = 0; j < 8; ++j) { v[j] = v[j] - mean; s2 += (v[j].x * v[j].x + v[j].y * v[j].y) + (v[j].z * v[j].z + v[j].w * v[j].w); }
        const float rstd = 1.f / sqrtf(wave_sum(s2) * (1.f / D) + LN_EPS);
        f32x4 l1 = (f32x4){0.f, 0.f, 0.f, 0.f};
#pragma unroll
        for (int j = 0; j < 8; ++j) { const int d0 = 4 * F.lane + 256 * j; const f32x4 gg = *(const GAS f32x4*)(lng + d0), bb = *(const GAS f32x4*)(lnb + d0);
            v[j] = v[j] * rstd * gg + bb;
            *(GAS f32x4*)(x1f + (size_t)tk * D + d0) = v[j];
            v2u w; w.x = pk2(v[j].x, v[j].y); w.y = pk2(v[j].z, v[j].w); *(GAS v2u*)(x1b + (size_t)tk * D + d0) = w;
            const GAS f32x4* wr = (const GAS f32x4*)(wg1 + (size_t)d0 * 4);
            l1 += wr[0] * v[j].x; l1 += wr[1] * v[j].y; l1 += wr[2] * v[j].z; l1 += wr[3] * v[j].w; }
        float lg1[4] = {wave_sum(l1.x) + bg1[0], wave_sum(l1.y) + bg1[1], wave_sum(l1.z) + bg1[2], wave_sum(l1.w) + bg1[3]};
        int grp = 0; float mx = lg1[0];
#pragma unroll
        for (int g = 1; g < 4; ++g) if (lg1[g] > mx) { mx = lg1[g]; grp = g; }
        float den = 0.f;
#pragma unroll
        for (int g = 0; g < 4; ++g) den += expf(lg1[g] - mx);
        const float psel = 1.f / den;
        grp = __builtin_amdgcn_readfirstlane(grp);
        const float* w2 = wg2 + (size_t)grp * D * 8;
        f32x4 la = (f32x4){0.f, 0.f, 0.f, 0.f}, lb = la;
#pragma unroll
        for (int j = 0; j < 8; ++j) { const int d0 = 4 * F.lane + 256 * j; const GAS f32x4* wr = (const GAS f32x4*)(w2 + (size_t)d0 * 8);
            la += wr[0] * v[j].x; lb += wr[1] * v[j].x; la += wr[2] * v[j].y; lb += wr[3] * v[j].y; la += wr[4] * v[j].z; lb += wr[5] * v[j].z; la += wr[6] * v[j].w; lb += wr[7] * v[j].w; }
        float lg2[8] = {wave_sum(la.x), wave_sum(la.y), wave_sum(la.z), wave_sum(la.w), wave_sum(lb.x), wave_sum(lb.y), wave_sum(lb.z), wave_sum(lb.w)};
#pragma unroll
        for (int e = 0; e < 8; ++e) lg2[e] += bg2[grp * 8 + e];
        int i0 = 0; float v0 = lg2[0];
#pragma unroll
        for (int e = 1; e < 8; ++e) if (lg2[e] > v0) { v0 = lg2[e]; i0 = e; }
        int i1 = -1; float v1 = -INFINITY;
#pragma unroll
        for (int e = 0; e < 8; ++e) if (e != i0 && lg2[e] > v1) { v1 = lg2[e]; i1 = e; }
        const float e1 = expf(v1 - v0), g0 = psel / (1.f + e1), g1 = psel * e1 / (1.f + e1);
        if (F.lane == 0) { const int ex0 = grp * 8 + i0, ex1 = grp * 8 + i1;
            const unsigned r0 = __hip_atomic_fetch_add(cnt + ex0, 1u, RLX_AGENT), r1 = __hip_atomic_fetch_add(cnt + ex1, 1u, RLX_AGENT);
            tok_e[2 * tk] = ex0; tok_e[2 * tk + 1] = ex1; tok_rank[2 * tk] = (int)r0; tok_rank[2 * tk + 1] = (int)r1; tok_gate[2 * tk] = g0; tok_gate[2 * tk + 1] = g1; }
    }
}
__device__ __forceinline__ void moe_table(Frame& F, int l) {
    LAS int* tstart = (LAS int*)(F.lds + TAB_OFF);
    if (F.tid == 0) { int acc = 0;
        for (int e = 0; e < 32; ++e) { tstart[e] = acc; const unsigned c = __hip_atomic_load(F.ctl + CW_CNT + 64 * l + e, RLX_AGENT); acc += (int)((c + 255u) >> 8); }
        tstart[32] = acc; }
    __syncthreads();
}
__device__ __forceinline__ void gather_phase(Frame& F, int l) {
    moe_table(F, l);
    const LAS int* tstart = (const LAS int*)(F.lds + TAB_OFF);
    const bf16* x1b = (const bf16*)(F.ws + WS_X1B); bf16* xg = (bf16*)(F.ws + WS_XG);
    const int* tok_e = (const int*)(F.ws + WS_ROUTE); const int* tok_rank = tok_e + 2 * T; int* tok_slot = (int*)(F.ws + WS_ROUTE) + 6 * T;
    const int gw = F.c * NWAVES + F.wave, NGW = F.G * NWAVES;
    for (int as = gw; as < 2 * T; as += NGW) { const int tk = as >> 1; const int e = tok_e[as], rk = tok_rank[as]; const int slot = tstart[e] * 256 + rk;
        const GAS v4u* src = (const GAS v4u*)(x1b + (size_t)tk * D) + F.lane; GAS v4u* dst = (GAS v4u*)(xg + (size_t)slot * D) + F.lane;
#pragma unroll
        for (int j = 0; j < 4; ++j) dst[64 * j] = src[64 * j];
        if (F.lane == 0) tok_slot[as] = slot; }
}
__device__ __forceinline__ void ln2_phase(Frame& F, const Args& a, int l) {
    const float* x1f = (const float*)(F.ws + WS_X1F); const bf16* yb = (const bf16*)(F.ws + WS_YB);
    float* xo = (l == DEPTH - 1) ? a.out : (float*)(F.ws + WS_XF); bf16* xb = (bf16*)(F.ws + WS_XB);
    const float* lng = a.in[I_LNG] + ((size_t)l * 2 + 1) * D; const float* lnb = a.in[I_LNB] + ((size_t)l * 2 + 1) * D;
    const int* tok_slot = (const int*)(F.ws + WS_ROUTE) + 6 * T; const float* tok_gate = (const float*)(F.ws + WS_ROUTE) + 4 * T;
    const int gw = F.c * NWAVES + F.wave, NGW = F.G * NWAVES;
    for (int tk = gw; tk < T; tk += NGW) {
        const int s0 = tok_slot[2 * tk], s1 = tok_slot[2 * tk + 1]; const float g0 = tok_gate[2 * tk], g1 = tok_gate[2 * tk + 1];
        f32x4 v[8]; float s = 0.f;
#pragma unroll
        for (int j = 0; j < 8; ++j) { const int d0 = 4 * F.lane + 256 * j; const f32x4 xr = *(const GAS f32x4*)(x1f + (size_t)tk * D + d0);
            const v2u ya = *(const GAS v2u*)(yb + (size_t)s0 * D + d0), yc = *(const GAS v2u*)(yb + (size_t)s1 * D + d0);
            f32x4 f; f.x = g0 * bflo(ya.x) + g1 * bflo(yc.x); f.y = g0 * bfhi(ya.x) + g1 * bfhi(yc.x); f.z = g0 * bflo(ya.y) + g1 * bflo(yc.y); f.w = g0 * bfhi(ya.y) + g1 * bfhi(yc.y);
            v[j] = xr * DN_ALPHA + f; s += (v[j].x + v[j].y) + (v[j].z + v[j].w); }
        const float mean = wave_sum(s) * (1.f / D); float s2 = 0.f;
#pragma unroll
        for (int j = 0; j < 8; ++j) { v[j] = v[j] - mean; s2 += (v[j].x * v[j].x + v[j].y * v[j].y) + (v[j].z * v[j].z + v[j].w * v[j].w); }
        const float rstd = 1.f / sqrtf(wave_sum(s2) * (1.f / D) + LN_EPS);
#pragma unroll
        for (int j = 0; j < 8; ++j) { const int d0 = 4 * F.lane + 256 * j; const f32x4 gg = *(const GAS f32x4*)(lng + d0), bb = *(const GAS f32x4*)(lnb + d0);
            const f32x4 o = v[j] * rstd * gg + bb; *(GAS f32x4*)(xo + (size_t)tk * D + d0) = o;
            v2u w; w.x = pk2(o.x, o.y); w.y = pk2(o.z, o.w); *(GAS v2u*)(xb + (size_t)tk * D + d0) = w; }
    }
}

__global__ void __launch_bounds__(NWAVES * 64, 2) fwd_kernel(Args args) {
    extern __shared__ __attribute__((aligned(16))) unsigned char lds[];
    Frame F;
    F.lds = (LAS unsigned char*)lds; F.ldsg = (char*)lds;
    F.tid = threadIdx.x; F.lane = F.tid & 63; F.wave = __builtin_amdgcn_readfirstlane(F.tid >> 6);
    F.G = gridDim.x; F.c = blockIdx.x; F.ws = args.ws; F.ctl = (gu32*)(args.ws + WS_CTL);
    volatile LAS unsigned* MISC = (volatile LAS unsigned*)(F.lds + MISC_OFF);
    for (int u = F.tid; u < (LDS_BYTES - LDSCTL_OFF) / 4; u += NWAVES * 64) ((LAS unsigned*)(F.lds + LDSCTL_OFF))[u] = 0u;
    __syncthreads();
    const int lo = args.ph_lo, hi = args.ph_hi;
    const bool multi = (hi - lo) > 1;
    XcdBarrier bar; bar.bar = (unsigned*)(F.ctl + CW_BAR); bar.x = 0; bar.st = nullptr;
    if (multi) bar = xcd_barrier_post((unsigned*)(F.ctl + CW_BAR), MISC + 8);
#define IN(p) (lo <= (p) && (p) < hi)
#define SEAM(p) do { if ((p) + 1 < hi) xcd_barrier(bar); } while (0)
#define FRESH() do { int t_ = threadIdx.x; asm volatile("" : "+v"(t_)); F.tid = t_; F.lane = t_ & 63; F.wave = __builtin_amdgcn_readfirstlane(t_ >> 6); \
    unsigned char* w_ = args.ws; asm volatile("" : "+s"(w_)); F.ws = w_; F.ctl = (gu32*)(w_ + WS_CTL); } while (0)

    if (IN(0)) { FRESH(); prologue_phase(F, args); SEAM(0); }

    for (int l = 0; l < DEPTH; ++l) {
        const int pb = 1 + NPH_LAYER * l;
        if (IN(pb + 0)) { FRESH();
            const int N = (l < 2) ? NINA : (l == 2 ? 5120 : 2048);
            const unsigned char* Bt = F.ws + ((l < 2) ? WS_WAIN + (size_t)l * NINA * D * 2 : (l == 2 ? WS_WBIN0 : WS_WBIN1));
            pg8::Gemm g{nullptr, nullptr, T, N, D}; pg8::DualOrder S; S.init(F.ws + WS_XB, Bt, T, N, D, F.G, F.c, F.ws + WS_MEMB, F.ws + WS_WMKV, l == 0 ? 16 : 0);
            pg8::EpiBf16X E{l < 2 ? 0 : 1, (bf16*)(F.ws + WS_Z), (bf16*)(F.ws + WS_KD), (bf16*)(F.ws + WS_VD), (bf16*)(F.ws + WS_MEMKV)};
            pg8::gemm_phase<pg8::EpiBf16X, pg8::DualOrder, true, true>(F.lds + RING_OFF, g, S, E);
            SEAM(pb + 0);
        }
        if (IN(pb + 1)) { FRESH();
            if (l < 2) {
                for (int u = F.c; u < 256 + 128; u += F.G) {
                    if (u < 256) sgu_unit(F, args, l, u >> 2, u & 3);
                    else { const int r = u - 256; memattn_unit(F, l, r & 3, r >> 2, NINA, 2 * MIXW); }
                }
            } else {
                for (int u = F.c; u < 768 + 128; u += F.G) {
                    if (u < 768) { const int qb = 31 - u / 24, r = u % 24; diffattn_unit(F, args, r >> 2, qb, (r >> 1) & 1, r & 1); }
                    else { const int r = u - 768; memattn_unit(F, l, r & 3, r >> 2, 2048, MIXW); }
                }
            }
            SEAM(pb + 1);
        }
        if (IN(pb + 2)) { FRESH(); if (l >= 2) diffcombine_phase(F, args, l); SEAM(pb + 2); }
        if (IN(pb + 3)) { FRESH();
            pg8::Gemm g{nullptr, nullptr, T, D, D}; pg8::DenseOrder S; S.init(F.ws + WS_CAT, F.ws + (l < 2 ? WS_WAOUT + (size_t)l * D * D * 2 : WS_WBOUT + (size_t)(l - 2) * D * D * 2), T, D, D, F.G, F.c);
            pg8::EpiResF32 E{(l == 0) ? args.in[I_X] : (const float*)(F.ws + WS_XF), (float*)(F.ws + WS_Y), DN_ALPHA};
            pg8::gemm_phase<pg8::EpiResF32, pg8::DenseOrder, true, true>(F.lds + RING_OFF, g, S, E);
            SEAM(pb + 3);
        }
        if (IN(pb + 4)) { FRESH(); ln1_router_phase(F, args, l); SEAM(pb + 4); }
        if (IN(pb + 5)) { FRESH(); gather_phase(F, l); SEAM(pb + 5); }
        if (IN(pb + 6)) { FRESH();
            moe_table(F, l);
            pg8::Gemm g{nullptr, nullptr, SLOTS, 1024, D};
            pg8::MoeOrder S{(const PG8_LAS int*)(F.lds + TAB_OFF), 4, F.G, F.c, (const char*)(F.ws + WS_XG), (const char*)(F.ws + WS_W13) + (size_t)l * NE * 1024 * 2048 * 2, (size_t)256 * D * 2, (size_t)1024 * 2048 * 2, (size_t)256 * 2048 * 2};
            pg8::EpiMoe1 E{(bf16*)(F.ws + WS_H)};
            pg8::gemm_phase<pg8::EpiMoe1, pg8::MoeOrder, true, true>(F.lds + RING_OFF, g, S, E);
            SEAM(pb + 6);
        }
        if (IN(pb + 7)) { FRESH();
            moe_table(F, l);
            pg8::Gemm g{nullptr, nullptr, SLOTS, D, FF};
            pg8::MoeOrder S{(const PG8_LAS int*)(F.lds + TAB_OFF), 8, F.G, F.c, (const char*)(F.ws + WS_H), (const char*)(F.ws + WS_W2) + (size_t)l * NE * 2048 * 512 * 2, (size_t)256 * FF * 2, (size_t)2048 * 512 * 2, (size_t)256 * 512 * 2};
            pg8::EpiBf16X E{3, (bf16*)(F.ws + WS_YB), nullptr, nullptr, nullptr};
            pg8::gemm_phase<pg8::EpiBf16X, pg8::MoeOrder, true, true>(F.lds + RING_OFF, g, S, E);
            SEAM(pb + 7);
        }
        if (IN(pb + 8)) { FRESH(); ln2_phase(F, args, l); SEAM(pb + 8); }
    }
#undef IN
#undef SEAM
}

#ifndef MK_ONE_LAUNCH
#define MK_ONE_LAUNCH 0
#endif
extern "C" void kernel_launch(void* const* d_in, const int* in_sizes, int n_in, void* d_out, int out_size, void* d_ws, size_t ws_size, hipStream_t stream) {
    static int grid = 0;
    if (grid == 0) {
        if (n_in != 24 || in_sizes[0] != T * D || out_size != T * D || ws_size < WS_END) { fprintf(stderr, "kernel_launch: unexpected shapes (n_in %d, in0 %d, out %d, ws %zu < %zu)\n", n_in, n_in > 0 ? in_sizes[0] : -1, out_size, ws_size, (size_t)WS_END); grid = -1; return; }
        int dev = 0, cus = 0, per_cu = 0;
        if (hipGetDevice(&dev) != hipSuccess || hipDeviceGetAttribute(&cus, hipDeviceAttributeMultiprocessorCount, dev) != hipSuccess) { grid = -1; return; }
        if (hipFuncSetAttribute((const void*)fwd_kernel, hipFuncAttributeMaxDynamicSharedMemorySize, LDS_BYTES) != hipSuccess) { fprintf(stderr, "kernel_launch: hipFuncSetAttribute failed\n"); grid = -1; return; }
        if (hipOccupancyMaxActiveBlocksPerMultiprocessor(&per_cu, (const void*)fwd_kernel, NWAVES * 64, LDS_BYTES) != hipSuccess || per_cu < 1) fprintf(stderr, "kernel_launch: occupancy query reports %d\n", per_cu);
        (void)hipGetLastError();
        grid = cus;
    }
    if (grid < 0) return;
    if (hipMemsetAsync((char*)d_ws + WS_CTL, 0, CTL_ZERO_BYTES, stream) != hipSuccess) return;
    Args a{};
    for (int i = 0; i < 24; ++i) a.in[i] = (const float*)d_in[i];
    a.out = (float*)d_out; a.ws = (unsigned char*)d_ws;
#if MK_ONE_LAUNCH
    a.ph_lo = 0; a.ph_hi = NPHASES;
    hipLaunchKernelGGL(fwd_kernel, dim3(grid), dim3(NWAVES * 64), LDS_BYTES, stream, a);
#else
    for (int p = 0; p < NPHASES; ++p) {
        const int k = (p - 1) % NPH_LAYER, l = (p - 1) / NPH_LAYER;
        if (p > 0 && k == 2 && l < 2) continue;
        a.ph_lo = p; a.ph_hi = p + 1;
        hipLaunchKernelGGL(fwd_kernel, dim3(grid), dim3(NWAVES * 64), LDS_BYTES, stream, a);
    }
#endif
    const hipError_t le = hipPeekAtLastError();
    if (le != hipSuccess) fprintf(stderr, "kernel_launch: launch failed: %s\n", hipGetErrorName(le));
}
```

```cpp
#include <hip/hip_runtime.h>
#include <cstdio>
#include <cstdint>
namespace pg8 {
#define PG8_LAS __attribute__((address_space(3)))
typedef unsigned short bf16_t;
typedef short bf16x8 __attribute__((ext_vector_type(8)));
typedef float f32x4 __attribute__((ext_vector_type(4)));
typedef unsigned u32x4 __attribute__((ext_vector_type(4)));
constexpr int BM = 256, BK = 64, HALF = 128, HTB = HALF * BK * 2  , STAGE_BYTES = 8 * HTB, NXCD = 8, WGM = 8;

__host__ __device__ __forceinline__ int lds_byte(int r, int c) { const int st = (r >> 4) * 2 + (c >> 5), rr = r & 15, cc = c & 31, ob = rr * 64 + cc * 2; return st * 1024 + (ob ^ (((ob >> 9) & 1) << 5)); }
__host__ __device__ __forceinline__ void stage_rc(int b, int& R, int& C) { const int st = b / 1024, sb = b % 1024, swz = sb ^ (((sb >> 9) & 1) << 5); R = (st >> 1) * 16 + swz / 64; C = (st & 1) * 32 + (swz % 64) / 2; }
__host__ __device__ __forceinline__ int perm32(int rho) { const int n = rho >> 4, i = rho & 15; return 8 * (i >> 2) + 4 * n + (i & 3); }

struct Unit { int pm, pn, e; };
struct Gemm { const bf16_t* A; const bf16_t* Bt; int M, N, K; };

struct StaticOrder {
    int nM, nN, nwg, G, c;
    __host__ __device__ void init(int M, int N, int G_, int c_) { nM = M / BM; nN = N / BM; nwg = nM * nN; G = G_; c = c_; }
    __host__ __device__ bool next(int i, Unit& u) const {
        const long L = (long)i * G + c; if (L >= nwg) return false;
        int wgid = (int)L; { const int q = nwg / NXCD, r = nwg % NXCD, xcd = wgid % NXCD, off = wgid / NXCD; wgid = (xcd < r ? xcd * (q + 1) : r * (q + 1) + (xcd - r) * q) + off; }
        const int nig = WGM * nN, gid = wgid / nig, fm = gid * WGM, gsz = (nM - fm) < WGM ? (nM - fm) : WGM;
        u.pm = fm + ((wgid % nig) % gsz); u.pn = (wgid % nig) / gsz; return true;
    }
    __device__ __forceinline__ void a_ready(const Unit&) const {}
    __device__ __forceinline__ void done(const Unit&) const {}
};

__device__ __forceinline__ unsigned cvt_pk_bf16(float lo, float hi) { unsigned r; asm volatile("v_cvt_pk_bf16_f32 %0, %1, %2" : "=v"(r) : "v"(lo), "v"(hi)); return r; }
typedef float f32x2 __attribute__((ext_vector_type(2)));
__device__ __forceinline__ f32x2 gelu_pk(f32x2 v) {
    const f32x2 av = __builtin_elementwise_abs(v), d = av * 0.2316418882f + 1.0f;
    f32x2 t; t.x = __builtin_amdgcn_rcpf(d.x); t.y = __builtin_amdgcn_rcpf(d.y);
    f32x2 q = t * 0.5307027145f + (-0.7265760135f); q = q * t + 0.7107068705f; q = q * t + (-0.142248368f); q = q * t + 0.127414796f; q = q * t;
    const f32x2 s = (v * v) * (-0.72134752044f);
    f32x2 e; e.x = __builtin_amdgcn_exp2f(s.x); e.y = __builtin_amdgcn_exp2f(s.y);
    const f32x2 m = v * (q * e), r = v - m;
    f32x2 o; o.x = v.x < 0.f ? m.x : r.x; o.y = v.y < 0.f ? m.y : r.y; return o;
}

template <class Epi, class Sched, bool ALIGN_EPI = false, bool SP2 = false>
__device__ __forceinline__ void gemm_phase(PG8_LAS unsigned char* lds, const Gemm g, const Sched& S, const Epi& E) {
    int tid_ = threadIdx.x; asm volatile("" : "+v"(tid_));
    const int tid = tid_, wid = __builtin_amdgcn_readfirstlane(tid >> 6), lane = tid & 63, wr = wid >> 2, wc = wid & 3, fr = lane & 15, fq = lane >> 4;
    const int K = g.K, nt = K / BK;
    unsigned voffA[2], voffB[2];
#pragma unroll
    for (int i = 0; i < 2; ++i) { int R, C; stage_rc(tid * 16 + i * 8192, R, C); const int Rb = Epi::PERM ? ((R & ~31) + perm32(R & 31)) : R;
        voffA[i] = (unsigned)(R * K + C) * 2u; voffB[i] = (unsigned)(Rb * K + C) * 2u; }
    const size_t kstep = (size_t)(BK * 2);
    const size_t hstep = (size_t)HALF * K * 2;
        const unsigned ldsw = (unsigned)wid * 1024u;
    const int aoff = lds_byte(wr * 64 + fr, fq * 8), boff = lds_byte(wc * 32 + fr, fq * 8);
#define PG8_SA(b, h) (((b) * 2 + (h)) * HTB)
#define PG8_SB(b, h) ((4 + (b) * 2 + (h)) * HTB)
#define PG8_STAGE(bufoff, gbase, voff) do { _Pragma("unroll") for (int _i = 0; _i < 2; ++_i) \
        __builtin_amdgcn_global_load_lds((const unsigned*)((const char*)(gbase) + (voff)[_i]), (PG8_LAS unsigned*)(lds + (bufoff) + ldsw + _i * 8192), 16, 0, 0); } while (0)
#define PG8_LDA(dst, b, h) do { _Pragma("unroll") for (int m = 0; m < 4; ++m) _Pragma("unroll") for (int k = 0; k < 2; ++k) dst[m][k] = *(const PG8_LAS bf16x8*)(lds + PG8_SA(b, h) + aoff + m * 2048 + k * 1024); } while (0)
#define PG8_LDB(dst, b, h) do { _Pragma("unroll") for (int n = 0; n < 2; ++n) _Pragma("unroll") for (int k = 0; k < 2; ++k) dst[n][k] = *(const PG8_LAS bf16x8*)(lds + PG8_SB(b, h) + boff + n * 2048 + k * 1024); } while (0)
#define PG8_MMA(ai, bj, At, Bt) do { __builtin_amdgcn_s_setprio(1); _Pragma("unroll") for (int m = 0; m < 4; ++m) _Pragma("unroll") for (int n = 0; n < 2; ++n) _Pragma("unroll") for (int k = 0; k < 2; ++k) \
        acc[ai][bj][m][n] = __builtin_amdgcn_mfma_f32_16x16x32_bf16(Bt[n][k], At[m][k], acc[ai][bj][m][n], 0, 0, 0); __builtin_amdgcn_s_setprio(0); } while (0)
#define PG8_WAIT_V(n) asm volatile("s_waitcnt vmcnt(" #n ")" ::: "memory")
#define PG8_WAIT_L(n) asm volatile("s_waitcnt lgkmcnt(" #n ")" ::: "memory")
#define PG8_BAR __builtin_amdgcn_s_barrier()
#define PG8_SCHED __builtin_amdgcn_sched_barrier(0)
    Unit cur, nxt; int ui = 0;
    if (!S.next(0, cur)) return;
    f32x4 acc[2][2][4][2];
#pragma unroll
    for (int a = 0; a < 2; ++a)
#pragma unroll
        for (int b = 0; b < 2; ++b)
#pragma unroll
            for (int m = 0; m < 4; ++m)
#pragma unroll
                for (int n = 0; n < 2; ++n) acc[a][b][m][n] = (f32x4){0.f, 0.f, 0.f, 0.f};
    bf16x8 At[4][2], B0[2][2], B1[2][2];
    const char* cA = S.aptr(cur); const char* cB = S.bptr(cur);
    S.a_ready(cur);
    if constexpr (SP2) {
        PG8_STAGE(PG8_SB(0, 0), cB, voffB); PG8_STAGE(PG8_SB(0, 1), cB + hstep, voffB); PG8_STAGE(PG8_SA(0, 0), cA, voffA); PG8_STAGE(PG8_SA(0, 1), cA + hstep, voffA);
        if (wr == 1) PG8_BAR;
        PG8_WAIT_V(2); PG8_BAR;
        PG8_STAGE(PG8_SB(1, 0), cB + kstep, voffB); PG8_STAGE(PG8_SA(1, 0), cA + kstep, voffA); PG8_STAGE(PG8_SB(1, 1), cB + hstep + kstep, voffB);
        PG8_WAIT_V(6); PG8_BAR;
    } else {
        PG8_STAGE(PG8_SB(0, 0), cB, voffB); PG8_STAGE(PG8_SA(0, 0), cA, voffA); PG8_STAGE(PG8_SB(0, 1), cB + hstep, voffB); PG8_STAGE(PG8_SA(0, 1), cA + hstep, voffA);
        if (wr == 1) PG8_BAR;
        PG8_WAIT_V(4); PG8_BAR;
        PG8_STAGE(PG8_SB(1, 0), cB + kstep, voffB); PG8_STAGE(PG8_SA(1, 0), cA + kstep, voffA); PG8_STAGE(PG8_SB(1, 1), cB + hstep + kstep, voffB);
        PG8_WAIT_V(6); PG8_BAR;
    }
    for (;;) {
        const bool has_next = S.next(ui + 1, nxt);
        const char* nA = has_next ? S.aptr(nxt) : cA; const char* nB = has_next ? S.bptr(nxt) : cB;
        for (int t = 0; t < nt; t += 2) {
            const bool last = (t == nt - 2);
            const char* a1 = cA + (size_t)(t + 1) * kstep;
            const char* a2 = last ? nA : cA + (size_t)(t + 2) * kstep; const char* b2 = last ? nB : cB + (size_t)(t + 2) * kstep;
            const char* a3 = a2 + kstep; const char* b3 = b2 + kstep;
            if (last && has_next) S.a_ready(nxt);
            if constexpr (SP2) {
            PG8_LDB(B0, 0, 0); PG8_LDB(B1, 0, 1); PG8_SCHED; PG8_LDA(At, 0, 0); PG8_STAGE(PG8_SA(1, 1), a1 + hstep, voffA);
            PG8_WAIT_V(8); PG8_WAIT_L(0); PG8_BAR; PG8_MMA(0, 0, At, B0); PG8_MMA(0, 1, At, B1); PG8_BAR; PG8_SCHED;
            PG8_LDA(At, 0, 1); PG8_STAGE(PG8_SB(0, 0), b2, voffB); PG8_STAGE(PG8_SB(0, 1), b2 + hstep, voffB); PG8_STAGE(PG8_SA(0, 0), a2, voffA);
            PG8_WAIT_V(8); PG8_WAIT_L(0); PG8_BAR; PG8_MMA(1, 0, At, B0); PG8_MMA(1, 1, At, B1); PG8_BAR; PG8_SCHED;
            PG8_LDB(B0, 1, 0); PG8_LDB(B1, 1, 1); PG8_SCHED; PG8_LDA(At, 1, 0); PG8_STAGE(PG8_SA(0, 1), a2 + hstep, voffA);
            PG8_WAIT_V(8); PG8_WAIT_L(0); PG8_BAR; PG8_MMA(0, 0, At, B0); PG8_MMA(0, 1, At, B1); PG8_BAR; PG8_SCHED;
            PG8_LDA(At, 1, 1); PG8_STAGE(PG8_SB(1, 0), b3, voffB); PG8_STAGE(PG8_SB(1, 1), b3 + hstep, voffB); PG8_STAGE(PG8_SA(1, 0), a3, voffA);
            PG8_WAIT_V(8); PG8_WAIT_L(0); PG8_BAR; PG8_MMA(1, 0, At, B0); PG8_MMA(1, 1, At, B1); PG8_BAR; PG8_SCHED;
            } else {
            PG8_LDB(B0, 0, 0); PG8_SCHED; PG8_LDA(At, 0, 0); PG8_STAGE(PG8_SA(1, 1), a1 + hstep, voffA);
            PG8_WAIT_L(8); PG8_BAR; PG8_WAIT_L(0); PG8_MMA(0, 0, At, B0); PG8_BAR; PG8_SCHED;
            PG8_LDB(B1, 0, 1); PG8_STAGE(PG8_SB(0, 0), b2, voffB);
            PG8_BAR; PG8_WAIT_L(0); PG8_MMA(0, 1, At, B1); PG8_BAR;
            PG8_LDA(At, 0, 1); PG8_STAGE(PG8_SA(0, 0), a2, voffA);
            PG8_BAR; PG8_WAIT_L(0); PG8_MMA(1, 0, At, B0); PG8_BAR; PG8_SCHED;
            PG8_STAGE(PG8_SB(0, 1), b2 + hstep, voffB);
            PG8_WAIT_V(6); PG8_BAR; PG8_MMA(1, 1, At, B1); PG8_BAR;
            PG8_LDB(B0, 1, 0); PG8_SCHED; PG8_LDA(At, 1, 0); PG8_STAGE(PG8_SA(0, 1), a2 + hstep, voffA);
            PG8_WAIT_L(8); PG8_BAR; PG8_WAIT_L(0); PG8_MMA(0, 0, At, B0); PG8_BAR; PG8_SCHED;
            PG8_LDB(B1, 1, 1); PG8_STAGE(PG8_SB(1, 0), b3, voffB);
            PG8_BAR; PG8_WAIT_L(0); PG8_MMA(0, 1, At, B1); PG8_BAR;
            PG8_LDA(At, 1, 1); PG8_STAGE(PG8_SA(1, 0), a3, voffA);
            PG8_BAR; PG8_WAIT_L(0); PG8_MMA(1, 0, At, B0); PG8_BAR; PG8_SCHED;
            PG8_STAGE(PG8_SB(1, 1), b3 + hstep, voffB);
            PG8_WAIT_V(6); PG8_BAR; PG8_MMA(1, 1, At, B1); PG8_BAR;
            }
        }
        if constexpr (ALIGN_EPI) { if (wr == 0) PG8_BAR; }
        if constexpr (!Epi::AFTER_DRAIN) { E(acc, cur, wr, wc, fr, fq); S.done(cur); }
        if (!has_next) break;
#pragma unroll
        for (int a = 0; a < 2; ++a)
#pragma unroll
            for (int b = 0; b < 2; ++b)
#pragma unroll
                for (int m = 0; m < 4; ++m)
#pragma unroll
                    for (int n = 0; n < 2; ++n) acc[a][b][m][n] = (f32x4){0.f, 0.f, 0.f, 0.f};
        cur = nxt; cA = nA; cB = nB; ++ui;
        if constexpr (ALIGN_EPI) { if (wr == 1) PG8_BAR; }
    }
    PG8_WAIT_V(0);
    if constexpr (!ALIGN_EPI) { if (wr == 0) PG8_BAR; }
    PG8_BAR;
    if constexpr (Epi::AFTER_DRAIN) { E.fused(acc, cur, wr, wc, fr, fq, lds, wid, lane); S.done(cur); }
#undef PG8_SA
#undef PG8_SB
#undef PG8_STAGE
#undef PG8_LDA
#undef PG8_LDB
#undef PG8_MMA
#undef PG8_WAIT_V
#undef PG8_WAIT_L
#undef PG8_BAR
#undef PG8_SCHED
}
}

constexpr int T = 8192, D = 2048, MIXW = 1536, MEMW = 512, NINA = 3584, DEPTH = 4, NE = 32, FF = 512, MEMT = 256;
constexpr int SLOTS = 24576;
constexpr float LN_EPS = 1e-5f;
constexpr float DN_ALPHA = 1.6817928305074292f;
constexpr float LOG2E = 1.4426950408889634f;
constexpr float QSCALE = 0.08838834764831845f * LOG2E;
constexpr int NWAVES = 8;

constexpr size_t MiB = 1u << 20;
constexpr size_t WS_CTL = 0, CTL_ZERO_BYTES = 1 * MiB;
constexpr size_t WS_WAIN = 2 * MiB, WS_WAOUT = 30 * MiB, WS_WBIN0 = 46 * MiB, WS_WKV = 54 * MiB, WS_WBIN1 = 66 * MiB, WS_WBOUT = 74 * MiB, WS_WMKV = 90 * MiB;
constexpr size_t WS_W13 = 106 * MiB, WS_W2 = 618 * MiB;
constexpr size_t WS_XB = 874 * MiB, WS_MEMB = 906 * MiB, WS_MEMKV = 907 * MiB, WS_Z = 910 * MiB, WS_KD = 966 * MiB, WS_VD = 990 * MiB, WS_CAT = 1014 * MiB;
constexpr size_t WS_Y = 1046 * MiB, WS_X1F = 1110 * MiB, WS_X1B = 1174 * MiB, WS_XF = 1206 * MiB, WS_XG = 1270 * MiB, WS_H = 1366 * MiB, WS_YB = 1390 * MiB, WS_OP = 1486 * MiB;
constexpr size_t WS_ROUTE = 1582 * MiB, WS_END = 1583 * MiB;
constexpr int CW_TMO = 0, CW_BAR = 4096, CW_CNT = 16384;

constexpr int RING_OFF = 0, RING_BYTES = 131072;
constexpr int LDSCTL_OFF = 146432, MISC_OFF = LDSCTL_OFF + 320, TAB_OFF = LDSCTL_OFF + 512;
constexpr int LDS_BYTES = 147456;

#define GAS __attribute__((address_space(1)))
#define LAS __attribute__((address_space(3)))
typedef unsigned short bf16;
typedef unsigned v4u __attribute__((ext_vector_type(4)));
typedef unsigned v2u __attribute__((ext_vector_type(2)));
typedef float f32x4 __attribute__((ext_vector_type(4)));
typedef short bf16x8 __attribute__((ext_vector_type(8)));
typedef GAS unsigned gu32;
#define RLX_AGENT __ATOMIC_RELAXED, __HIP_MEMORY_SCOPE_AGENT
#define LDS_WAIT() asm volatile("s_waitcnt lgkmcnt(0)" ::: "memory")
#define VM_WAIT() asm volatile("s_waitcnt vmcnt(0)" ::: "memory")
__device__ __forceinline__ unsigned f2bf(float f) { unsigned u = __builtin_bit_cast(unsigned, f); return (u + 0x7fffu + ((u >> 16) & 1u)) >> 16; }
__device__ __forceinline__ unsigned pk2(float lo, float hi) { return f2bf(lo) | (f2bf(hi) << 16); }
__device__ __forceinline__ float bf2f(unsigned short b) { return __builtin_bit_cast(float, (unsigned)b << 16); }
__device__ __forceinline__ float bflo(unsigned w) { return __builtin_bit_cast(float, w << 16); }
__device__ __forceinline__ float bfhi(unsigned w) { return __builtin_bit_cast(float, w & 0xffff0000u); }
__device__ __forceinline__ float wave_sum(float v) {
#pragma unroll
    for (int o = 1; o < 64; o <<= 1) v += __shfl_xor(v, o);
    return v;
}

namespace pg8 {
struct DenseOrder {
    StaticOrder so; const char* A; const char* B; size_t astep, bstep;
    __device__ void init(const void* A_, const void* B_, int M, int N, int K, int G, int c) { so.init(M, N, G, c); A = (const char*)A_; B = (const char*)B_; astep = (size_t)256 * K * 2; bstep = astep; }
    __device__ __forceinline__ bool next(int i, Unit& u) const { u.e = 0; return so.next(i, u); }
    __device__ __forceinline__ const char* aptr(const Unit& u) const { return A + (size_t)u.pm * astep; }
    __device__ __forceinline__ const char* bptr(const Unit& u) const { return B + (size_t)u.pn * bstep; }
    __device__ __forceinline__ void a_ready(const Unit&) const {}
    __device__ __forceinline__ void done(const Unit&) const {}
};
struct DualOrder {
    StaticOrder so; int nwg2; const char* A; const char* B; const char* A2; const char* B2; size_t step;
    __device__ void init(const void* A_, const void* B_, int M, int N, int K, int G, int c, const void* A2_, const void* B2_, int nwg2_) { so.init(M, N, G, c); A = (const char*)A_; B = (const char*)B_; A2 = (const char*)A2_; B2 = (const char*)B2_; nwg2 = nwg2_; step = (size_t)256 * K * 2; }
    __device__ __forceinline__ bool next(int i, Unit& u) const { const int L = i * so.G + so.c; if (L < so.nwg) { u.e = 0; return so.next(i, u); } if (L - so.nwg >= nwg2) return false; u.e = 1; u.pm = 0; u.pn = L - so.nwg; return true; }
    __device__ __forceinline__ const char* aptr(const Unit& u) const { return u.e ? A2 : A + (size_t)u.pm * step; }
    __device__ __forceinline__ const char* bptr(const Unit& u) const { return (u.e ? B2 : B) + (size_t)u.pn * step; }
    __device__ __forceinline__ void a_ready(const Unit&) const {}
    __device__ __forceinline__ void done(const Unit&) const {}
};
struct MoeOrder {
    const PG8_LAS int* tstart; int ntn, G, c; const char* A; const char* W; size_t astep, wexp, wtile;
    __device__ __forceinline__ bool next(int i, Unit& u) const {
        const int L = i * G + c, total = tstart[32] * ntn; if (L >= total) return false;
        u.pm = L / ntn; u.pn = L - u.pm * ntn; int e = 0;
#pragma unroll
        for (int k = 1; k <= 31; ++k) e += (tstart[k] <= u.pm) ? 1 : 0;
        u.e = e; return true;
    }
    __device__ __forceinline__ const char* aptr(const Unit& u) const { return A + (size_t)u.pm * astep; }
    __device__ __forceinline__ const char* bptr(const Unit& u) const { return W + (size_t)u.e * wexp + (size_t)u.pn * wtile; }
    __device__ __forceinline__ void a_ready(const Unit&) const {}
    __device__ __forceinline__ void done(const Unit&) const {}
};

struct EpiBf16X {
    static constexpr bool PERM = true, AFTER_DRAIN = false;
    int mode; bf16_t* p0; bf16_t* p1; bf16_t* p2; bf16_t* p3;
    __device__ __forceinline__ void operator()(const f32x4 (&acc)[2][2][4][2], const Unit& u, int wr, int wc, int fr, int fq) const {
        bf16_t* base; int ldc, colt; bool act = false; float sc = 1.f;
        if (u.e && mode < 2) { base = p3 + (size_t)(u.pn >> 2) * (256 * 1024); ldc = 1024; colt = (u.pn & 3) * BM; }
        else if (mode == 0) { base = p0; ldc = 3584; colt = u.pn * BM; act = u.pn < 12; if (u.pn >= 12) sc = QSCALE; }
        else if (mode == 1) { if (u.pn < 8) { base = p0; ldc = 2048; colt = u.pn * BM; sc = QSCALE; }
                              else if (u.pn < 14) { base = p1; ldc = 1536; colt = (u.pn - 8) * BM; } else { base = p2; ldc = 1536; colt = (u.pn - 14) * BM; } }
        else { base = p0; ldc = 2048; colt = u.pn * BM; }
        const int row0 = u.pm * BM + wr * 64 + fr, col0 = colt + wc * 32 + 8 * fq;
#pragma unroll
        for (int ai = 0; ai < 2; ++ai)
#pragma unroll
            for (int m = 0; m < 4; ++m) { bf16_t* rowp = base + (size_t)(row0 + ai * HALF + m * 16) * ldc + col0;
#pragma unroll
                for (int bj = 0; bj < 2; ++bj) { f32x4 v0 = acc[ai][bj][m][0], v1 = acc[ai][bj][m][1];
                    if (act) { f32x2 a = gelu_pk((f32x2){v0[0], v0[1]}), b = gelu_pk((f32x2){v0[2], v0[3]}), c = gelu_pk((f32x2){v1[0], v1[1]}), d = gelu_pk((f32x2){v1[2], v1[3]});
                        v0 = (f32x4){a.x, a.y, b.x, b.y}; v1 = (f32x4){c.x, c.y, d.x, d.y}; }
                    v0 = v0 * sc; v1 = v1 * sc; u32x4 w; w.x = cvt_pk_bf16(v0[0], v0[1]); w.y = cvt_pk_bf16(v0[2], v0[3]); w.z = cvt_pk_bf16(v1[0], v1[1]); w.w = cvt_pk_bf16(v1[2], v1[3]);
                    *(u32x4*)(rowp + bj * HALF) = w; } }
    }
};
struct EpiResF32 {
    static constexpr bool PERM = false, AFTER_DRAIN = false;
    const float* xres; float* y; float alpha;
    __device__ __forceinline__ void operator()(const f32x4 (&acc)[2][2][4][2], const Unit& u, int wr, int wc, int fr, int fq) const {
        const int row0 = u.pm * BM + wr * 64 + fr, col0 = u.pn * BM + wc * 32 + 4 * fq;
#pragma unroll
        for (int ai = 0; ai < 2; ++ai)
#pragma unroll
            for (int m = 0; m < 4; ++m) { const size_t off = (size_t)(row0 + ai * HALF + m * 16) * 2048 + col0;
#pragma unroll
                for (int bj = 0; bj < 2; ++bj)
#pragma unroll
                    for (int n = 0; n < 2; ++n) { const f32x4 xr = *(const f32x4*)(xres + off + bj * HALF + n * 16); *(f32x4*)(y + off + bj * HALF + n * 16) = xr * alpha + acc[ai][bj][m][n]; } }
    }
};
struct EpiMoe1 {
    static constexpr bool PERM = true, AFTER_DRAIN = false;
    bf16_t* h;
    __device__ __forceinline__ void operator()(const f32x4 (&acc)[2][2][4][2], const Unit& u, int wr, int wc, int fr, int fq) const {
        const int row0 = u.pm * BM + wr * 64 + fr, col0 = u.pn * HALF + wc * 32 + 8 * fq;
#pragma unroll
        for (int ai = 0; ai < 2; ++ai)
#pragma unroll
            for (int m = 0; m < 4; ++m) { bf16_t* rowp = h + (size_t)(row0 + ai * HALF + m * 16) * 512 + col0; float o[8];
#pragma unroll
                for (int n = 0; n < 2; ++n)
#pragma unroll
                    for (int x = 0; x < 4; ++x) { const float a = acc[ai][0][m][n][x], b = acc[ai][1][m][n][x];
                        o[n * 4 + x] = a * __builtin_amdgcn_rcpf(1.0f + __builtin_amdgcn_exp2f(-a * LOG2E)) * b; }
                u32x4 w; w.x = cvt_pk_bf16(o[0], o[1]); w.y = cvt_pk_bf16(o[2], o[3]); w.z = cvt_pk_bf16(o[4], o[5]); w.w = cvt_pk_bf16(o[6], o[7]);
                *(u32x4*)rowp = w; }
    }
};
}

namespace att {
using bf16x8 = __attribute__((ext_vector_type(8))) short;
using s16x4  = __attribute__((ext_vector_type(4))) short;
using f32x16 = __attribute__((ext_vector_type(16))) float;
using u32x4  = __attribute__((ext_vector_type(4))) unsigned;
constexpr int DH = 128, QBLK = 32, KVBLK = 64;
constexpr float THR2 = 8.f * 1.4426950408889634f;
constexpr size_t SHM_V = KVBLK * DH * 2, SHM_K = KVBLK * DH * 2, SHM_ATTN = 2 * SHM_V + 2 * SHM_K + NWAVES * 64 * 4;
constexpr int TAB_N = 160;
#define KSWZ(row, colB) ((row) * 256 + ((colB) ^ (((row) & 7) << 4)))
#define SBAR() __builtin_amdgcn_sched_barrier(0)
__device__ __forceinline__ int crow(int r, int hi) { return (r & 3) + 8 * (r >> 2) + 4 * hi; }
__device__ __forceinline__ unsigned cvtpk(float lo, float hi) { unsigned r; asm volatile("v_cvt_pk_bf16_f32 %0, %1, %2" : "=v"(r) : "v"(lo), "v"(hi)); return r; }

__device__ __forceinline__ void partialSM(f32x16& p0, f32x16& p1, float& m_reg, float& mn, float& alpha) {
  float pmax = p0[0];
#pragma unroll
  for (int r = 1; r < 16; ++r) pmax = fmaxf(pmax, p0[r]);
#pragma unroll
  for (int r = 0; r < 16; ++r) pmax = fmaxf(pmax, p1[r]);
  { auto rr = __builtin_amdgcn_permlane32_swap(__float_as_uint(pmax), __float_as_uint(pmax), false, false);
    pmax = fmaxf(__uint_as_float(rr[0]), __uint_as_float(rr[1])); }
  if (__builtin_expect(__all(pmax - m_reg <= THR2), 1)) { mn = m_reg; alpha = 1.f; }
  else { mn = fmaxf(m_reg, pmax); alpha = __builtin_amdgcn_exp2f(m_reg - mn); m_reg = mn; }
#pragma unroll
  for (int r = 0; r < 16; ++r) p0[r] = p0[r] - mn;
#pragma unroll
  for (int r = 0; r < 16; ++r) p1[r] = p1[r] - mn;
#pragma unroll
  for (int r = 0; r < 16; ++r) p0[r] = __builtin_amdgcn_exp2f(p0[r]);
}
__device__ __forceinline__ void finishSM(f32x16& p0, f32x16& p1, float alpha, float& l_reg, bf16x8& pa0, bf16x8& pa1, bf16x8& pa2, bf16x8& pa3) {
#pragma unroll
  for (int r = 0; r < 16; ++r) p1[r] = __builtin_amdgcn_exp2f(p1[r]);
  float ps = 0;
#pragma unroll
  for (int r = 0; r < 16; ++r) ps += p0[r];
#pragma unroll
  for (int r = 0; r < 16; ++r) ps += p1[r];
  { auto rr = __builtin_amdgcn_permlane32_swap(__float_as_uint(ps), __float_as_uint(ps), false, false);
    ps = __uint_as_float(rr[0]) + __uint_as_float(rr[1]); }
  l_reg = l_reg * alpha + ps;
#define PK4(P, BASE, OUT) do { unsigned a0 = cvtpk(P[BASE + 0], P[BASE + 1]), a1 = cvtpk(P[BASE + 2], P[BASE + 3]);   \
    unsigned b0 = cvtpk(P[BASE + 4], P[BASE + 5]), b1 = cvtpk(P[BASE + 6], P[BASE + 7]);                              \
    auto r0 = __builtin_amdgcn_permlane32_swap(a0, b0, false, false); auto r1 = __builtin_amdgcn_permlane32_swap(a1, b1, false, false); \
    u32x4 w = {r0[0], r1[0], r0[1], r1[1]}; OUT = *reinterpret_cast<bf16x8*>(&w); } while (0)
  PK4(p0, 0, pa0); PK4(p0, 8, pa1); PK4(p1, 0, pa2); PK4(p1, 8, pa3);
#undef PK4
}
__device__ __forceinline__ void qkt(f32x16& p0, f32x16& p1, const char* Ks, const bf16x8* qr, int r32, int hi) {
  p0 = f32x16{}; p1 = f32x16{};
#pragma unroll
  for (int d0 = 0; d0 < 8; ++d0) { const int cb = (d0 * 16 + hi * 8) * 2;
    bf16x8 b0 = *reinterpret_cast<const bf16x8*>(Ks + KSWZ(r32, cb));
    bf16x8 b1 = *reinterpret_cast<const bf16x8*>(Ks + KSWZ(32 + r32, cb));
    p0 = __builtin_amdgcn_mfma_f32_32x32x16_bf16(b0, qr[d0], p0, 0, 0, 0);
    p1 = __builtin_amdgcn_mfma_f32_32x32x16_bf16(b1, qr[d0], p1, 0, 0, 0); }
}
__device__ __forceinline__ int v_st(int k, int c) { const int kk = (k & ~0xC) | ((k & 4) << 1) | ((k & 8) >> 1); return ((kk >> 3) * 4 + (c >> 5)) * 512 + ((kk & 7) * 32 + (c & 31)) * 2; }
__device__ __forceinline__ int v_rd_base(int lane) { return ((lane & 3) << 3) | (((lane >> 2) & 3) << 6) | (((lane >> 4) & 1) << 5) | (((lane >> 5) & 1) << 8); }
constexpr int v_rd_off(int d0, int ks, int half) { return d0 * 512 + ks * 4096 + half * 2048; }
template <int OFF> __device__ __forceinline__ s16x4 tr_read(int vb) {
  s16x4 r; asm volatile("ds_read_b64_tr_b16 %0, %1 offset:%2" : "=&v"(r) : "v"(vb), "i"(OFF) : "memory"); return r;
}
template <int D0> __device__ __forceinline__ void pv_one(f32x16& od, int vb, bf16x8 pa0, bf16x8 pa1, bf16x8 pa2, bf16x8 pa3) {
  const s16x4 l0 = tr_read<v_rd_off(D0, 0, 0)>(vb), h0 = tr_read<v_rd_off(D0, 0, 1)>(vb), l1 = tr_read<v_rd_off(D0, 1, 0)>(vb), h1 = tr_read<v_rd_off(D0, 1, 1)>(vb);
  const s16x4 l2 = tr_read<v_rd_off(D0, 2, 0)>(vb), h2 = tr_read<v_rd_off(D0, 2, 1)>(vb), l3 = tr_read<v_rd_off(D0, 3, 0)>(vb), h3 = tr_read<v_rd_off(D0, 3, 1)>(vb);
  asm volatile("s_waitcnt lgkmcnt(0)" ::: "memory"); SBAR();
#define PK(L, H) (bf16x8){L[0], L[1], L[2], L[3], H[0], H[1], H[2], H[3]}
  od = __builtin_amdgcn_mfma_f32_32x32x16_bf16(pa0, PK(l0, h0), od, 0, 0, 0);
  od = __builtin_amdgcn_mfma_f32_32x32x16_bf16(pa1, PK(l1, h1), od, 0, 0, 0);
  od = __builtin_amdgcn_mfma_f32_32x32x16_bf16(pa2, PK(l2, h2), od, 0, 0, 0);
  od = __builtin_amdgcn_mfma_f32_32x32x16_bf16(pa3, PK(l3, h3), od, 0, 0, 0);
#undef PK
}
__device__ __forceinline__ void pv_d0(f32x16* o, int vb, bf16x8 pa0, bf16x8 pa1, bf16x8 pa2, bf16x8 pa3) {
  pv_one<0>(o[0], vb, pa0, pa1, pa2, pa3); pv_one<1>(o[1], vb, pa0, pa1, pa2, pa3); pv_one<2>(o[2], vb, pa0, pa1, pa2, pa3); pv_one<3>(o[3], vb, pa0, pa1, pa2, pa3);
}
template <int MODE> __device__ __forceinline__ void post_scores(f32x16& p0, f32x16& p1, int t, int qrow0, int r32, int hi, const float* tab, float cfar) {
  if constexpr (MODE == 1) {
    const int cw = qrow0 >> 6;
    if (t > cw) {
#pragma unroll
      for (int r = 0; r < 16; ++r) { p0[r] = -INFINITY; p1[r] = -INFINITY; }
    } else if (qrow0 - (64 * t + 63) >= 91) {
#pragma unroll
      for (int r = 0; r < 16; ++r) { p0[r] += cfar; p1[r] += cfar; }
    } else {
      const int base = qrow0 + r32 - 64 * t + 63;
#pragma unroll
      for (int r = 0; r < 16; ++r) { const int i0 = base - crow(r, hi); const int i1 = i0 - 32;
        p0[r] += tab[i0 < TAB_N - 1 ? i0 : TAB_N - 1]; p1[r] += tab[i1 < TAB_N - 1 ? i1 : TAB_N - 1]; }
    }
  }
}

template <int MODE>
__device__ __forceinline__ void attn_body(const bf16* __restrict__ Qb, int ldq, const bf16* __restrict__ Kh, const bf16* __restrict__ Vh, int ldk,
                                          bf16* Ob, float* Of, int ldo, int NT, int q0abs, const float* tab, float cfar, char* lds) {
  int tid_ = threadIdx.x; asm volatile("" : "+v"(tid_));
  const int tid = tid_, wid = tid >> 6, lane = tid & 63, r32 = lane & 31, hi = lane >> 5;
  char* V_lds = lds; char* K_lds = lds + 2 * SHM_V;
  float* ws = (float*)(lds + 2 * SHM_V + 2 * SHM_K) + wid * 64; float* li_l = ws; float* al_l = ws + 32;
  float m_reg = -1e30f, l_reg = 0; f32x16 o[4] = {}; bf16x8 qr[8];
  const int qrow0 = q0abs + wid * QBLK;
  const bf16* Qw = Qb + (long)(wid * QBLK + r32) * ldq + hi * 8;
#pragma unroll
  for (int d0 = 0; d0 < 8; ++d0) qr[d0] = *reinterpret_cast<const bf16x8*>(Qw + d0 * 16);
  const int sr = tid >> 4, sc = (tid & 15) * 8, vst0 = v_st(sr, sc), vst1 = v_st(32 + sr, sc);
  const int vb0 = (int)(uintptr_t)V_lds + v_rd_base(lane);
  struct { bf16x8 vs0, vs1, ks0, ks1; } sr_[2];
#define SLOAD(i, k0) do { sr_[i].vs0 = *reinterpret_cast<const bf16x8*>(&Vh[(long)((k0) + sr) * ldk + sc]); sr_[i].vs1 = *reinterpret_cast<const bf16x8*>(&Vh[(long)((k0) + 32 + sr) * ldk + sc]); \
    sr_[i].ks0 = *reinterpret_cast<const bf16x8*>(&Kh[(long)((k0) + sr) * ldk + sc]); sr_[i].ks1 = *reinterpret_cast<const bf16x8*>(&Kh[(long)((k0) + 32 + sr) * ldk + sc]); } while (0)
#define SWRITE(b, i) do { *(bf16x8*)(V_lds + (b) * SHM_V + vst0) = sr_[i].vs0;          \
    *(bf16x8*)(V_lds + (b) * SHM_V + vst1) = sr_[i].vs1; const int kc = sc * 2;               \
    *(bf16x8*)(K_lds + (b) * SHM_K + KSWZ(sr, kc)) = sr_[i].ks0;                       \
    *(bf16x8*)(K_lds + (b) * SHM_K + KSWZ(32 + sr, kc)) = sr_[i].ks1; } while (0)
#define SWAIT() asm volatile("s_waitcnt vmcnt(4)" ::: "memory")
#define RESC(a) do { if (__any((a) < 1.f)) { if (hi == 0) al_l[r32] = (a); asm volatile("s_waitcnt lgkmcnt(0)" ::: "memory"); \
    _Pragma("unroll") for (int d = 0; d < 4; ++d) _Pragma("unroll") for (int r = 0; r < 16; ++r) o[d][r] *= al_l[crow(r, hi)]; } } while (0)
  f32x16 pA0, pA1, pB0, pB1; float mnA, mnB, alA, alB; bf16x8 pa0, pa1, pa2, pa3;
  constexpr int SE = 0, SO = 1;
  SLOAD(SE, 0); asm volatile("s_waitcnt vmcnt(0)" ::: "memory"); SWRITE(0, SE); __syncthreads();
  qkt(pA0, pA1, K_lds, qr, r32, hi); post_scores<MODE>(pA0, pA1, 0, qrow0, r32, hi, tab, cfar); partialSM(pA0, pA1, m_reg, mnA, alA);
  SLOAD(SO, KVBLK); if (2 < NT) SLOAD(SE, 2 * KVBLK);
  SWAIT(); SWRITE(1, SO); __syncthreads();
  for (int j = 1; j + 1 < NT; j += 2) {
    SBAR(); qkt(pB0, pB1, K_lds + SHM_K, qr, r32, hi); post_scores<MODE>(pB0, pB1, j, qrow0, r32, hi, tab, cfar);
    finishSM(pA0, pA1, alA, l_reg, pa0, pa1, pa2, pa3); SBAR();
    SLOAD(SO, (j + 2) * KVBLK); SBAR();
    pv_d0(o, vb0, pa0, pa1, pa2, pa3); partialSM(pB0, pB1, m_reg, mnB, alB);
    __syncthreads(); SWAIT(); SWRITE(0, SE);
    RESC(alB); __syncthreads();
    SBAR(); qkt(pA0, pA1, K_lds, qr, r32, hi); post_scores<MODE>(pA0, pA1, j + 1, qrow0, r32, hi, tab, cfar);
    finishSM(pB0, pB1, alB, l_reg, pa0, pa1, pa2, pa3); SBAR();
    if (j + 3 < NT) SLOAD(SE, (j + 3) * KVBLK); SBAR();
    pv_d0(o, vb0 + (int)SHM_V, pa0, pa1, pa2, pa3); partialSM(pA0, pA1, m_reg, mnA, alA);
    __syncthreads(); SWAIT(); SWRITE(1, SO);
    RESC(alA); __syncthreads();
  }
  SBAR(); qkt(pB0, pB1, K_lds + SHM_K, qr, r32, hi); post_scores<MODE>(pB0, pB1, NT - 1, qrow0, r32, hi, tab, cfar);
  finishSM(pA0, pA1, alA, l_reg, pa0, pa1, pa2, pa3); SBAR();
  pv_d0(o, vb0, pa0, pa1, pa2, pa3); partialSM(pB0, pB1, m_reg, mnB, alB);
  __syncthreads(); RESC(alB);
  finishSM(pB0, pB1, alB, l_reg, pa0, pa1, pa2, pa3); SBAR();
  pv_d0(o, vb0 + (int)SHM_V, pa0, pa1, pa2, pa3);
  if (hi == 0) li_l[r32] = l_reg; asm volatile("s_waitcnt lgkmcnt(0)" ::: "memory");
  float rli[16];
#pragma unroll
  for (int r = 0; r < 16; ++r) rli[r] = __builtin_amdgcn_rcpf(li_l[crow(r, hi)]);
  if constexpr (MODE == 0) {
    bf16* Ow = Ob + (long)(wid * QBLK) * ldo;
#pragma unroll
    for (int r = 0; r < 16; ++r) { const int orow = crow(r, hi);
#pragma unroll
      for (int d0 = 0; d0 < 4; ++d0) Ow[(long)orow * ldo + d0 * 32 + r32] = (bf16)f2bf(o[d0][r] * rli[r]); }
  } else {
    float* Ow = Of + (long)(wid * QBLK) * ldo;
#pragma unroll
    for (int r = 0; r < 16; ++r) { const int orow = crow(r, hi);
#pragma unroll
      for (int d0 = 0; d0 < 4; ++d0) Ow[(long)orow * ldo + d0 * 32 + r32] = o[d0][r] * rli[r]; }
  }
  __syncthreads();
#undef SLOAD
#undef SWRITE
#undef SWAIT
#undef RESC
}
__device__ __forceinline__ void attn_body_diff(const bf16* __restrict__ Qb, int ldq, const bf16* __restrict__ Kh, const bf16* __restrict__ Vh, int ldk,
                                               float* Of, int ldo, int NT, int q0abs, const float* tab, float cfar, char* lds) {
  int tid_ = threadIdx.x; asm volatile("" : "+v"(tid_));
  const int tid = tid_, wid = tid >> 6, lane = tid & 63, r32 = lane & 31, hi = lane >> 5;
  char* V_lds = lds; char* K_lds = lds + 2 * SHM_V;
  float* ws = (float*)(lds + 2 * SHM_V + 2 * SHM_K) + wid * 64; float* li_l = ws; float* al_l = ws + 32;
  float m_reg = -1e30f, l_reg = 0; f32x16 o[4] = {}; bf16x8 qr[8];
  const int qrow0 = q0abs + wid * QBLK;
  const bf16* Qw = Qb + (long)(wid * QBLK + r32) * ldq + hi * 8;
#pragma unroll
  for (int d0 = 0; d0 < 8; ++d0) qr[d0] = *reinterpret_cast<const bf16x8*>(Qw + d0 * 16);
  const int sr = tid >> 4, sc = (tid & 15) * 8, vst0 = v_st(sr, sc), vst1 = v_st(32 + sr, sc);
  const int vb0 = (int)(uintptr_t)V_lds + v_rd_base(lane);
  bf16x8 vs0, vs1, ks0, ks1;
#define SLOAD1(k0) do { vs0 = *reinterpret_cast<const bf16x8*>(&Vh[(long)((k0) + sr) * ldk + sc]); vs1 = *reinterpret_cast<const bf16x8*>(&Vh[(long)((k0) + 32 + sr) * ldk + sc]); \
    ks0 = *reinterpret_cast<const bf16x8*>(&Kh[(long)((k0) + sr) * ldk + sc]); ks1 = *reinterpret_cast<const bf16x8*>(&Kh[(long)((k0) + 32 + sr) * ldk + sc]); } while (0)
#define SWRITE1(b) do { *(bf16x8*)(V_lds + (b) * SHM_V + vst0) = vs0; *(bf16x8*)(V_lds + (b) * SHM_V + vst1) = vs1; const int kc = sc * 2; \
    *(bf16x8*)(K_lds + (b) * SHM_K + KSWZ(sr, kc)) = ks0; *(bf16x8*)(K_lds + (b) * SHM_K + KSWZ(32 + sr, kc)) = ks1; } while (0)
  SLOAD1(0); asm volatile("s_waitcnt vmcnt(0)" ::: "memory"); SWRITE1(0); __syncthreads();
  for (int t = 0; t < NT; ++t) {
    const int b = t & 1;
    if (t + 1 < NT) SLOAD1((t + 1) * KVBLK);
    f32x16 p0, p1; float mn, al; bf16x8 pa0, pa1, pa2, pa3;
    qkt(p0, p1, K_lds + b * SHM_K, qr, r32, hi); post_scores<1>(p0, p1, t, qrow0, r32, hi, tab, cfar);
    partialSM(p0, p1, m_reg, mn, al); finishSM(p0, p1, al, l_reg, pa0, pa1, pa2, pa3);
    if (__any(al < 1.f)) { if (hi == 0) al_l[r32] = al; asm volatile("s_waitcnt lgkmcnt(0)" ::: "memory");
#pragma unroll
      for (int d = 0; d < 4; ++d)
#pragma unroll
        for (int r = 0; r < 16; ++r) o[d][r] *= al_l[crow(r, hi)]; }
    SBAR(); pv_d0(o, vb0 + b * (int)SHM_V, pa0, pa1, pa2, pa3);
    if (t + 1 < NT) { asm volatile("s_waitcnt vmcnt(0)" ::: "memory"); SWRITE1(b ^ 1); }
    __syncthreads();
  }
  if (hi == 0) li_l[r32] = l_reg; asm volatile("s_waitcnt lgkmcnt(0)" ::: "memory");
  float rli[16];
#pragma unroll
  for (int r = 0; r < 16; ++r) rli[r] = __builtin_amdgcn_rcpf(li_l[crow(r, hi)]);
  float* Ow = Of + (long)(wid * QBLK) * ldo;
#pragma unroll
  for (int r = 0; r < 16; ++r) { const int orow = crow(r, hi);
#pragma unroll
    for (int d0 = 0; d0 < 4; ++d0) Ow[(long)orow * ldo + d0 * 32 + r32] = o[d0][r] * rli[r]; }
  __syncthreads();
#undef SLOAD1
#undef SWRITE1
}
}

#define XB_TMO      128
#define XB_XCNT(j)  (256  + 64 * (j))
#define XB_XSUB(j)  (1280 + 64 * (j))
#define XB_XGEN(j)  (2304 + 64 * (j))
#define XB_TOP      3328
#define XB_TOPGEN   3392
#define XCD_BAR_WORDS 3456
#define XB_SPIN_CAP (1u << 18)

__device__ __forceinline__ unsigned xb_ld(unsigned* p)              { return __hip_atomic_load(p, __ATOMIC_RELAXED, __HIP_MEMORY_SCOPE_AGENT); }
__device__ __forceinline__ unsigned xb_add(unsigned* p, unsigned v) { return __hip_atomic_fetch_add(p, v, __ATOMIC_RELAXED, __HIP_MEMORY_SCOPE_AGENT); }
__device__ __forceinline__ unsigned xb_xcc_id() { return (unsigned)__builtin_amdgcn_s_getreg((3 << 11) | 20) & 0xFu; }
#define XB_SPIN(cond, bar) do { unsigned _sp = 0; while (cond) { __builtin_amdgcn_s_sleep(1); \
    if ((++_sp & 255u) == 0u) { if (xb_ld(&(bar)[XB_TMO])) break; if (_sp > XB_SPIN_CAP) { atomicAdd(&(bar)[XB_TMO], 1u); break; } } } } while (0)

struct XcdBarrier {
    unsigned* bar; unsigned x;
    volatile LAS unsigned* st;
};

__device__ __forceinline__ XcdBarrier xcd_barrier_post(unsigned* bar, volatile LAS unsigned* st) {
    XcdBarrier b; b.bar = bar; b.x = xb_xcc_id(); b.st = st;
    if (threadIdx.x == 0) (void)xb_add(&bar[XB_XCNT(b.x)], 1u);
    return b;
}
__device__ __forceinline__ void xcd_barrier_complete(unsigned* bar, unsigned x, unsigned& nloc, unsigned& nx) {
    const unsigned G = gridDim.x * gridDim.y * gridDim.z;
    unsigned sum, cnt, mine, sp = 0u;
    for (;;) {
        sum = 0u; cnt = 0u; mine = 0u;
#pragma unroll
        for (unsigned j = 0; j < 16; ++j) { const unsigned c = xb_ld(&bar[XB_XCNT(j)]); sum += c; cnt += (c > 0u) ? 1u : 0u; mine = (j == x) ? c : mine; }
        if (sum == G) break;
        __builtin_amdgcn_s_sleep(1);
        if ((++sp & 255u) == 0u) { if (xb_ld(&bar[XB_TMO])) break; if (sp > XB_SPIN_CAP) { atomicAdd(&bar[XB_TMO], 1u); break; } }
    }
    nloc = mine > 0u ? mine : 1u; nx = cnt > 0u ? cnt : 1u;
}

__device__ __forceinline__ void xcd_barrier(const XcdBarrier& b) {
    asm volatile("s_waitcnt vmcnt(0)" ::: "memory");
    __syncthreads();
    if (threadIdx.x == 0) {
        unsigned* bar = b.bar;
        __builtin_amdgcn_s_waitcnt(0);
        unsigned nloc = b.st[0], nx = b.st[1];
        if (nloc == 0u) { xcd_barrier_complete(bar, b.x, nloc, nx); b.st[0] = nloc; b.st[1] = nx; }
        const unsigned old = xb_add(&bar[XB_XSUB(b.x)], 1u);
        const unsigned gen = old / nloc;
        if (old + 1u == (gen + 1u) * nloc) {
            __builtin_amdgcn_fence(__ATOMIC_RELEASE, "agent");
            asm volatile("s_waitcnt vmcnt(0)" ::: "memory");
            const unsigned og = xb_add(&bar[XB_TOP], 1u);
            const unsigned tg = og / nx;
            if (og + 1u == (tg + 1u) * nx) xb_add(&bar[XB_TOPGEN], 1u);
            else XB_SPIN(xb_ld(&bar[XB_TOPGEN]) == tg, bar);
            __builtin_amdgcn_fence(__ATOMIC_ACQUIRE, "agent");
            xb_add(&bar[XB_XGEN(b.x)], 1u);
            asm volatile("s_waitcnt vmcnt(0)" ::: "memory");
        } else {
            XB_SPIN(xb_ld(&bar[XB_XGEN(b.x)]) == gen, bar);
            __builtin_amdgcn_fence(__ATOMIC_ACQUIRE, "agent");
            asm volatile("s_waitcnt vmcnt(0)" ::: "memory");
        }
    }
    __syncthreads();
}


struct Args { const float* in[24]; float* out; unsigned char* ws; int ph_lo, ph_hi; };
enum { I_X = 0, I_MEM, I_AWIN, I_ALNG, I_ALNB, I_AWS, I_ABS, I_AWOUT, I_BWIN, I_BLAM, I_BSUBG, I_BWOUT, I_WKV, I_RELB, I_MEMWKV, I_LNG, I_LNB,
       I_WG1, I_BG1, I_WG2, I_BG2, I_W1, I_W3, I_W2 };
constexpr int NPH_LAYER = 9, NPHASES = 1 + DEPTH * NPH_LAYER;

struct Frame {
    LAS unsigned char* lds; char* ldsg;
    gu32* ctl; unsigned char* ws;
    int tid, lane, wave, G, c;
};

__device__ __forceinline__ void transpose_item(const float* W, int K, int N, bf16* WT, int drow0, LAS float* scr, int k0, int n0, int lane) {
#pragma unroll 8
    for (int i = 0; i < 32; ++i) { const int kk = 2 * i + (lane >> 5); scr[kk * 33 + (lane & 31)] = W[(size_t)(k0 + kk) * N + n0 + (lane & 31)]; }
    LDS_WAIT(); asm volatile("" ::: "memory");
    const int c = lane & 7;
#pragma unroll
    for (int j = 0; j < 4; ++j) { const int n = (lane >> 3) + 8 * j; const LAS float* s = scr + (8 * c) * 33 + n;
        v4u o; o.x = pk2(s[0 * 33], s[1 * 33]); o.y = pk2(s[2 * 33], s[3 * 33]); o.z = pk2(s[4 * 33], s[5 * 33]); o.w = pk2(s[6 * 33], s[7 * 33]);
        *(GAS v4u*)(WT + (size_t)(drow0 + n) * K + k0 + 8 * c) = o; }
    LDS_WAIT(); asm volatile("" ::: "memory");
}
__device__ __forceinline__ void prologue_phase(Frame& F, const Args& a) {
    LAS float* scr = (LAS float*)(F.lds + RING_OFF + F.wave * 16384);
    const int gw = F.c * NWAVES + F.wave, NGW = F.G * NWAVES;
    unsigned char* ws = F.ws;
    constexpr int S0 = 2 * 3584, S1 = 2 * 2048, S2 = 2 * 2048, S3 = 2 * 2048, S4 = 3072, S5 = 4 * 1024, S6 = 128 * 512, S7 = 128 * 512, S8 = 128 * 512;
    constexpr int NITEMS = S0 + S1 + S2 + S3 + S4 + S5 + S6 + S7 + S8;
    for (int it = gw; it < NITEMS; it += NGW) {
        int r = it; const float* src; bf16* dst; int K, N, nblk, mat, per; int dmode = 0;
        if (r < S0) { per = 3584; mat = r / per; r -= mat * per; K = 2048; N = 3584; src = a.in[I_AWIN] + (size_t)mat * K * N; dst = (bf16*)(ws + WS_WAIN) + (size_t)mat * K * N; }
        else if ((r -= S0) < S1) { per = 2048; mat = r / per; r -= mat * per; K = 2048; N = 2048; src = a.in[I_AWOUT] + (size_t)mat * K * N; dst = (bf16*)(ws + WS_WAOUT) + (size_t)mat * K * N; }
        else if ((r -= S1) < S2) { per = 2048; mat = r / per; r -= mat * per; K = 2048; N = 2048; src = a.in[I_BWIN] + (size_t)mat * K * N; dst = (bf16*)(ws + (mat ? WS_WBIN1 : WS_WBIN0)); }
        else if ((r -= S2) < S3) { per = 2048; mat = r / per; r -= mat * per; K = 2048; N = 2048; src = a.in[I_BWOUT] + (size_t)mat * K * N; dst = (bf16*)(ws + WS_WBOUT) + (size_t)mat * K * N; }
        else if ((r -= S3) < S4) { K = 2048; N = 3072; src = a.in[I_WKV]; dst = (bf16*)(ws + WS_WKV); }
        else if ((r -= S4) < S5) { per = 1024; mat = r / per; r -= mat * per; K = 2048; N = 1024; src = a.in[I_MEMWKV] + (size_t)mat * K * N; dst = (bf16*)(ws + WS_WMKV) + (size_t)mat * K * N; }
        else if ((r -= S5) < S6) { per = 512; mat = r / per; r -= mat * per; K = 2048; N = 512; src = a.in[I_W1] + (size_t)mat * K * N; dst = (bf16*)(ws + WS_W13) + (size_t)mat * 1024 * 2048; dmode = 1; }
        else if ((r -= S6) < S7) { per = 512; mat = r / per; r -= mat * per; K = 2048; N = 512; src = a.in[I_W3] + (size_t)mat * K * N; dst = (bf16*)(ws + WS_W13) + (size_t)mat * 1024 * 2048; dmode = 2; }
        else { r -= S7; per = 512; mat = r / per; r -= mat * per; K = 512; N = 2048; src = a.in[I_W2] + (size_t)mat * K * N; dst = (bf16*)(ws + WS_W2) + (size_t)mat * K * N; }
        nblk = N / 32; const int kb = r / nblk, nb = r - kb * nblk, n0 = 32 * nb;
        int drow0 = n0; if (dmode) drow0 = (n0 >> 7) * 256 + (n0 & 127) + (dmode == 2 ? 128 : 0);
        transpose_item(src, K, N, dst, drow0, scr, 64 * kb, n0, F.lane);
    }
    const long nthr = (long)F.G * 512, gt = (long)F.c * 512 + F.tid;
    { const float* x = a.in[I_X]; bf16* xb = (bf16*)(ws + WS_XB);
      for (long i = gt; i < (long)T * D / 8; i += nthr) { const f32x4 v0 = *(const GAS f32x4*)(x + i * 8), v1 = *(const GAS f32x4*)(x + i * 8 + 4);
          v4u o; o.x = pk2(v0.x, v0.y); o.y = pk2(v0.z, v0.w); o.z = pk2(v1.x, v1.y); o.w = pk2(v1.z, v1.w); *(GAS v4u*)(xb + i * 8) = o; } }
    { const float* x = a.in[I_MEM]; bf16* xb = (bf16*)(ws + WS_MEMB);
      for (long i = gt; i < (long)MEMT * D / 8; i += nthr) { const f32x4 v0 = *(const GAS f32x4*)(x + i * 8), v1 = *(const GAS f32x4*)(x + i * 8 + 4);
          v4u o; o.x = pk2(v0.x, v0.y); o.y = pk2(v0.z, v0.w); o.z = pk2(v1.x, v1.y); o.w = pk2(v1.z, v1.w); *(GAS v4u*)(xb + i * 8) = o; } }
}

__device__ __forceinline__ void sgu_unit(Frame& F, const Args& a, int l, int n, int g) {
    constexpr int LDW = 136;
    LAS float* stats = (LAS float*)(F.lds); LAS bf16* Wl = (LAS bf16*)(F.lds + 1024); LAS bf16* Vt = (LAS bf16*)(F.lds + 35840);
    const bf16* z = (const bf16*)(F.ws + WS_Z); bf16* cat = (bf16*)(F.ws + WS_CAT);
    const int tok0 = n * 128;
    for (int i = 0; i < 16; ++i) { const int tk = F.wave * 16 + i; const GAS v4u* rp = (const GAS v4u*)(z + (size_t)(tok0 + tk) * NINA + MIXW) + F.lane;
        v4u w[3]; float s = 0.f;
#pragma unroll
        for (int j = 0; j < 3; ++j) { w[j] = rp[64 * j]; s += (bflo(w[j].x) + bfhi(w[j].x)) + (bflo(w[j].y) + bfhi(w[j].y)) + (bflo(w[j].z) + bfhi(w[j].z)) + (bflo(w[j].w) + bfhi(w[j].w)); }
        const float mean = wave_sum(s) * (1.f / MIXW); float q = 0.f;
#pragma unroll
        for (int j = 0; j < 3; ++j) { float d;
            d = bflo(w[j].x) - mean; q += d * d; d = bfhi(w[j].x) - mean; q += d * d; d = bflo(w[j].y) - mean; q += d * d; d = bfhi(w[j].y) - mean; q += d * d;
            d = bflo(w[j].z) - mean; q += d * d; d = bfhi(w[j].z) - mean; q += d * d; d = bflo(w[j].w) - mean; q += d * d; d = bfhi(w[j].w) - mean; q += d * d; }
        const float rstd = 1.f / sqrtf(wave_sum(q) * (1.f / MIXW) + LN_EPS);
        if (F.lane == 0) { stats[2 * tk] = mean; stats[2 * tk + 1] = rstd; } }
    { const float* wsrc = a.in[I_AWS] + ((size_t)l * 4 + g) * 128 * 128;
      for (int p = F.tid; p < 128 * 32; p += 512) { const int i = p >> 5, j4 = (p & 31) * 4; f32x4 v = *(const GAS f32x4*)(wsrc + i * 128 + j4);
          if ((j4 >> 6) > (i >> 6)) v = (f32x4){0.f, 0.f, 0.f, 0.f};
          v2u o; o.x = pk2(v.x, v.y); o.y = pk2(v.z, v.w); *(LAS v2u*)(Wl + i * LDW + j4) = o; } }
    __syncthreads();
    { const float* lg = a.in[I_ALNG] + (size_t)l * MIXW + g * 384; const float* lb = a.in[I_ALNB] + (size_t)l * MIXW + g * 384;
      for (int p = F.tid; p < 128 * 48; p += 512) { const int j = p & 127, c8 = (p >> 7) * 8;
          const v4u w = *(const GAS v4u*)(z + (size_t)(tok0 + j) * NINA + MIXW + g * 384 + c8);
          const float mean = stats[2 * j], rstd = stats[2 * j + 1];
          const f32x4 g0 = *(const GAS f32x4*)(lg + c8), g1 = *(const GAS f32x4*)(lg + c8 + 4), b0 = *(const GAS f32x4*)(lb + c8), b1 = *(const GAS f32x4*)(lb + c8 + 4);
          float v[8] = {bflo(w.x), bfhi(w.x), bflo(w.y), bfhi(w.y), bflo(w.z), bfhi(w.z), bflo(w.w), bfhi(w.w)};
          const float gg[8] = {g0.x, g0.y, g0.z, g0.w, g1.x, g1.y, g1.z, g1.w}, bb[8] = {b0.x, b0.y, b0.z, b0.w, b1.x, b1.y, b1.z, b1.w};
#pragma unroll
          for (int e = 0; e < 8; ++e) Vt[(c8 + e) * LDW + j] = (bf16)f2bf((v[e] - mean) * rstd * gg[e] + bb[e]); } }
    __syncthreads();
    const int fr = F.lane & 15, fq = F.lane >> 4;
    f32x4 acc[8][3];
#pragma unroll
    for (int mb = 0; mb < 8; ++mb)
#pragma unroll
        for (int nb = 0; nb < 3; ++nb) acc[mb][nb] = (f32x4){0.f, 0.f, 0.f, 0.f};
#pragma unroll
    for (int ks = 0; ks < 4; ++ks) { bf16x8 bfr[3];
#pragma unroll
        for (int nb = 0; nb < 3; ++nb) bfr[nb] = *(const LAS bf16x8*)(Vt + (F.wave * 48 + nb * 16 + fr) * LDW + ks * 32 + fq * 8);
#pragma unroll
        for (int mb = 0; mb < 8; ++mb) { const bf16x8 afr = *(const LAS bf16x8*)(Wl + (mb * 16 + fr) * LDW + ks * 32 + fq * 8);
#pragma unroll
            for (int nb = 0; nb < 3; ++nb) acc[mb][nb] = __builtin_amdgcn_mfma_f32_16x16x32_bf16(bfr[nb], afr, acc[mb][nb], 0, 0, 0); } }
    const float* bs = a.in[I_ABS] + ((size_t)l * 4 + g) * 128;
#pragma unroll
    for (int mb = 0; mb < 8; ++mb) { const int i = mb * 16 + fr; const float bsv = bs[i]; const size_t tk = (size_t)(tok0 + i);
#pragma unroll
        for (int nb = 0; nb < 3; ++nb) { const int c = g * 384 + F.wave * 48 + nb * 16 + 4 * fq;
            const v2u uw = *(const GAS v2u*)(z + tk * NINA + c); const f32x4 gt = acc[mb][nb] + bsv;
            v2u o; o.x = pk2(bflo(uw.x) * gt.x, bfhi(uw.x) * gt.y); o.y = pk2(bflo(uw.y) * gt.z, bfhi(uw.y) * gt.w);
            *(GAS v2u*)(cat + tk * D + c) = o; } }
    __syncthreads();
}

__device__ __forceinline__ void memattn_unit(Frame& F, int l, int hm, int qb, int ldz, int qoff) {
    const bf16* z = (const bf16*)(F.ws + WS_Z); const bf16* kv = (const bf16*)(F.ws + WS_MEMKV) + (size_t)l * 256 * 1024; bf16* cat = (bf16*)(F.ws + WS_CAT);
    att::attn_body<0>(z + (size_t)qb * 256 * ldz + qoff + hm * 128, ldz, kv + hm * 128, kv + 512 + hm * 128, 1024,
                      cat + (size_t)qb * 256 * D + MIXW + hm * 128, nullptr, D, 4, 0, nullptr, 0.f, F.ldsg);
}

__device__ __forceinline__ int t5_bucket(int rel) {
    const int a = rel < 0 ? -rel : rel; int f;
    if (a < 8) f = a; else if (a < 12) f = 8; else if (a < 16) f = 9; else if (a < 23) f = 10; else if (a < 32) f = 11; else if (a < 46) f = 12; else if (a < 64) f = 13; else if (a < 91) f = 14; else f = 15;
    return (rel > 0 ? 16 : 0) + f;
}
__device__ __forceinline__ void diffattn_unit(Frame& F, const Args& a, int h, int qb, int m, int vh) {
    const bf16* q = (const bf16*)(F.ws + WS_Z); const bf16* kd = (const bf16*)(F.ws + WS_KD); const bf16* vd = (const bf16*)(F.ws + WS_VD); float* op = (float*)(F.ws + WS_OP);
    float* tab = (float*)(F.ldsg + att::SHM_ATTN);
    if (F.tid < att::TAB_N) { const int d = F.tid - 63; tab[F.tid] = a.in[I_RELB][t5_bucket(-d) * 6 + h] * LOG2E; }
    const float cfar = a.in[I_RELB][15 * 6 + h] * LOG2E;
    att::attn_body_diff(q + (size_t)qb * 256 * 2048 + h * 256 + m * 128, 2048, kd + h * 256 + m * 128, vd + h * 256 + vh * 128, 1536,
                      op + (size_t)qb * 256 * 3072 + (h * 2 + m) * 256 + vh * 128, 3072, 4 * (qb + 1), qb * 256, tab, cfar, F.ldsg);
}

__device__ __forceinline__ void diffcombine_phase(Frame& F, const Args& a, int l) {
    const int i = l - 2; const float* lp = a.in[I_BLAM] + (size_t)i * 4 * 128;
    float s1 = lp[F.lane] * lp[128 + F.lane] + lp[64 + F.lane] * lp[128 + 64 + F.lane], s2 = lp[256 + F.lane] * lp[384 + F.lane] + lp[256 + 64 + F.lane] * lp[384 + 64 + F.lane];
    s1 = wave_sum(s1); s2 = wave_sum(s2);
    const float lam_init = 0.8f - 0.6f * expf(-0.3f * (float)l);
    const float lam = expf(s1) - expf(s2) + lam_init;
    const float* op = (const float*)(F.ws + WS_OP); bf16* cat = (bf16*)(F.ws + WS_CAT);
    const f32x4 gsub = *(const GAS f32x4*)(a.in[I_BSUBG] + (size_t)i * 256 + 4 * F.lane);
    const int gw = F.c * NWAVES + F.wave, NGW = F.G * NWAVES;
    for (int it = gw; it < T * 6; it += NGW) { const int tk = it / 6, h = it - tk * 6;
        const f32x4 o1 = *(const GAS f32x4*)(op + ((size_t)tk * 6 + h) * 512 + 4 * F.lane), o2 = *(const GAS f32x4*)(op + ((size_t)tk * 6 + h) * 512 + 256 + 4 * F.lane);
        const f32x4 o = o1 - o2 * lam; const float ss = wave_sum((o.x * o.x + o.y * o.y) + (o.z * o.z + o.w * o.w));
        const float r = (1.f - lam_init) / sqrtf(ss * (1.f / 256.f) + LN_EPS);
        v2u w; w.x = pk2(o.x * r * gsub.x, o.y * r * gsub.y); w.y = pk2(o.z * r * gsub.z, o.w * r * gsub.w);
        *(GAS v2u*)(cat + (size_t)tk * D + h * 256 + 4 * F.lane) = w; }
}

__device__ __forceinline__ void ln1_router_phase(Frame& F, const Args& a, int l) {
    const float* y = (const float*)(F.ws + WS_Y); float* x1f = (float*)(F.ws + WS_X1F); bf16* x1b = (bf16*)(F.ws + WS_X1B);
    const float* lng = a.in[I_LNG] + ((size_t)l * 2 + 0) * D; const float* lnb = a.in[I_LNB] + ((size_t)l * 2 + 0) * D;
    const float* wg1 = a.in[I_WG1] + (size_t)l * D * 4; const float* bg1 = a.in[I_BG1] + l * 4;
    const float* wg2 = a.in[I_WG2] + (size_t)l * 4 * D * 8; const float* bg2 = a.in[I_BG2] + l * 32;
    int* tok_e = (int*)(F.ws + WS_ROUTE); int* tok_rank = tok_e + 2 * T; float* tok_gate = (float*)(tok_rank + 2 * T);
    gu32* cnt = F.ctl + CW_CNT + 64 * l;
    const int gw = F.c * NWAVES + F.wave, NGW = F.G * NWAVES;
    for (int tk = gw; tk < T; tk += NGW) {
        const GAS f32x4* yr = (const GAS f32x4*)(y + (size_t)tk * D) + F.lane;
        f32x4 v[8]; float s = 0.f;
#pragma unroll
        for (int j = 0; j < 8; ++j) { v[j] = yr[64 * j]; s += (v[j].x + v[j].y) + (v[j].z + v[j].w); }
        const float mean = wave_sum(s) * (1.f / D); float s2 = 0.f;
#pragma unroll
        for (int j = 0; j < 8; ++j) { v[j] = v[j] - mean; s2 += (v[j].x * v[j].x + v[j].y * v[j].y) + (v[j].z * v[j].z + v[j].w * v[j].w); }
        const float rstd = 1.f / sqrtf(wave_sum(s2) * (1.f / D) + LN_EPS);
        f32x4 l1 = (f32x4){0.f, 0.f, 0.f, 0.f};
#pragma unroll
        for (int j = 0; j < 8; ++j) { const int d0 = 4 * F.lane + 256 * j; const f32x4 gg = *(const GAS f32x4*)(lng + d0), bb = *(const GAS f32x4*)(lnb + d0);
            v[j] = v[j] * rstd * gg + bb;
            *(GAS f32x4*)(x1f + (size_t)tk * D + d0) = v[j];
            v2u w; w.x = pk2(v[j].x, v[j].y); w.y = pk2(v[j].z, v[j].w); *(GAS v2u*)(x1b + (size_t)tk * D + d0) = w;
            const GAS f32x4* wr = (const GAS f32x4*)(wg1 + (size_t)d0 * 4);
            l1 += wr[0] * v[j].x; l1 += wr[1] * v[j].y; l1 += wr[2] * v[j].z; l1 += wr[3] * v[j].w; }
        float lg1[4] = {wave_sum(l1.x) + bg1[0], wave_sum(l1.y) + bg1[1], wave_sum(l1.z) + bg1[2], wave_sum(l1.w) + bg1[3]};
        int grp = 0; float mx = lg1[0];
#pragma unroll
        for (int g = 1; g < 4; ++g) if (lg1[g] > mx) { mx = lg1[g]; grp = g; }
        float den = 0.f;
#pragma unroll
        for (int g = 0; g < 4; ++g) den += expf(lg1[g] - mx);
        const float psel = 1.f / den;
        grp = __builtin_amdgcn_readfirstlane(grp);
        const float* w2 = wg2 + (size_t)grp * D * 8;
        f32x4 la = (f32x4){0.f, 0.f, 0.f, 0.f}, lb = la;
#pragma unroll
        for (int j = 0; j < 8; ++j) { const int d0 = 4 * F.lane + 256 * j; const GAS f32x4* wr = (const GAS f32x4*)(w2 + (size_t)d0 * 8);
            la += wr[0] * v[j].x; lb += wr[1] * v[j].x; la += wr[2] * v[j].y; lb += wr[3] * v[j].y; la += wr[4] * v[j].z; lb += wr[5] * v[j].z; la += wr[6] * v[j].w; lb += wr[7] * v[j].w; }
        float lg2[8] = {wave_sum(la.x), wave_sum(la.y), wave_sum(la.z), wave_sum(la.w), wave_sum(lb.x), wave_sum(lb.y), wave_sum(lb.z), wave_sum(lb.w)};
#pragma unroll
        for (int e = 0; e < 8; ++e) lg2[e] += bg2[grp * 8 + e];
        int i0 = 0; float v0 = lg2[0];
#pragma unroll
        for (int e = 1; e < 8; ++e) if (lg2[e] > v0) { v0 = lg2[e]; i0 = e; }
        int i1 = -1; float v1 = -INFINITY;
#pragma unroll
        for (int e = 0; e < 8; ++e) if (e != i0 && lg2[e] > v1) { v1 = lg2[e]; i1 = e; }
        const float e1 = expf(v1 - v0), g0 = psel / (1.f + e1), g1 = psel * e1 / (1.f + e1);
        if (F.lane == 0) { const int ex0 = grp * 8 + i0, ex1 = grp * 8 + i1;
            const unsigned r0 = __hip_atomic_fetch_add(cnt + ex0, 1u, RLX_AGENT), r1 = __hip_atomic_fetch_add(cnt + ex1, 1u, RLX_AGENT);
            tok_e[2 * tk] = ex0; tok_e[2 * tk + 1] = ex1; tok_rank[2 * tk] = (int)r0; tok_rank[2 * tk + 1] = (int)r1; tok_gate[2 * tk] = g0; tok_gate[2 * tk + 1] = g1; }
    }
}
__device__ __forceinline__ void moe_table(Frame& F, int l) {
    LAS int* tstart = (LAS int*)(F.lds + TAB_OFF);
    if (F.tid == 0) { int acc = 0;
        for (int e = 0; e < 32; ++e) { tstart[e] = acc; const unsigned c = __hip_atomic_load(F.ctl + CW_CNT + 64 * l + e, RLX_AGENT); acc += (int)((c + 255u) >> 8); }
        tstart[32] = acc; }
    __syncthreads();
}
__device__ __forceinline__ void gather_phase(Frame& F, int l) {
    moe_table(F, l);
    const LAS int* tstart = (const LAS int*)(F.lds + TAB_OFF);
    const bf16* x1b = (const bf16*)(F.ws + WS_X1B); bf16* xg = (bf16*)(F.ws + WS_XG);
    const int* tok_e = (const int*)(F.ws + WS_ROUTE); const int* tok_rank = tok_e + 2 * T; int* tok_slot = (int*)(F.ws + WS_ROUTE) + 6 * T;
    const int gw = F.c * NWAVES + F.wave, NGW = F.G * NWAVES;
    for (int as = gw; as < 2 * T; as += NGW) { const int tk = as >> 1; const int e = tok_e[as], rk = tok_rank[as]; const int slot = tstart[e] * 256 + rk;
        const GAS v4u* src = (const GAS v4u*)(x1b + (size_t)tk * D) + F.lane; GAS v4u* dst = (GAS v4u*)(xg + (size_t)slot * D) + F.lane;
#pragma unroll
        for (int j = 0; j < 4; ++j) dst[64 * j] = src[64 * j];
        if (F.lane == 0) tok_slot[as] = slot; }
}
__device__ __forceinline__ void ln2_phase(Frame& F, const Args& a, int l) {
    const float* x1f = (const float*)(F.ws + WS_X1F); const bf16* yb = (const bf16*)(F.ws + WS_YB);
    float* xo = (l == DEPTH - 1) ? a.out : (float*)(F.ws + WS_XF); bf16* xb = (bf16*)(F.ws + WS_XB);
    const float* lng = a.in[I_LNG] + ((size_t)l * 2 + 1) * D; const float* lnb = a.in[I_LNB] + ((size_t)l * 2 + 1) * D;
    const int* tok_slot = (const int*)(F.ws + WS_ROUTE) + 6 * T; const float* tok_gate = (const float*)(F.ws + WS_ROUTE) + 4 * T;
    const int gw = F.c * NWAVES + F.wave, NGW = F.G * NWAVES;
    for (int tk = gw; tk < T; tk += NGW) {
        const int s0 = tok_slot[2 * tk], s1 = tok_slot[2 * tk + 1]; const float g0 = tok_gate[2 * tk], g1 = tok_gate[2 * tk + 1];
        f32x4 v[8]; float s = 0.f;
#pragma unroll
        for (int j = 0; j < 8; ++j) { const int d0 = 4 * F.lane + 256 * j; const f32x4 xr = *(const GAS f32x4*)(x1f + (size_t)tk * D + d0);
            const v2u ya = *(const GAS v2u*)(yb + (size_t)s0 * D + d0), yc = *(const GAS v2u*)(yb + (size_t)s1 * D + d0);
            f32x4 f; f.x = g0 * bflo(ya.x) + g1 * bflo(yc.x); f.y = g0 * bfhi(ya.x) + g1 * bfhi(yc.x); f.z = g0 * bflo(ya.y) + g1 * bflo(yc.y); f.w = g0 * bfhi(ya.y) + g1 * bfhi(yc.y);
            v[j] = xr * DN_ALPHA + f; s += (v[j].x + v[j].y) + (v[j].z + v[j].w); }
        const float mean = wave_sum(s) * (1.f / D); float s2 = 0.f;
#pragma unroll
        for (int j = 0; j < 8; ++j) { v[j] = v[j] - mean; s2 += (v[j].x * v[j].x + v[j].y * v[j].y) + (v[j].z * v[j].z + v[j].w * v[j].w); }
        const float rstd = 1.f / sqrtf(wave_sum(s2) * (1.f / D) + LN_EPS);
#pragma unroll
        for (int j = 0; j < 8; ++j) { const int d0 = 4 * F.lane + 256 * j; const f32x4 gg = *(const GAS f32x4*)(lng + d0), bb = *(const GAS f32x4*)(lnb + d0);
            const f32x4 o = v[j] * rstd * gg + bb; *(GAS f32x4*)(xo + (size_t)tk * D + d0) = o;
            v2u w; w.x = pk2(o.x, o.y); w.y = pk2(o.z, o.w); *(GAS v2u*)(xb + (size_t)tk * D + d0) = w; }
    }
}

__global__ void __launch_bounds__(NWAVES * 64, 2) fwd_kernel(Args args) {
    extern __shared__ __attribute__((aligned(16))) unsigned char lds[];
    Frame F;
    F.lds = (LAS unsigned char*)lds; F.ldsg = (char*)lds;
    F.tid = threadIdx.x; F.lane = F.tid & 63; F.wave = __builtin_amdgcn_readfirstlane(F.tid >> 6);
    F.G = gridDim.x; F.c = blockIdx.x; F.ws = args.ws; F.ctl = (gu32*)(args.ws + WS_CTL);
    volatile LAS unsigned* MISC = (volatile LAS unsigned*)(F.lds + MISC_OFF);
    for (int u = F.tid; u < (LDS_BYTES - LDSCTL_OFF) / 4; u += NWAVES * 64) ((LAS unsigned*)(F.lds + LDSCTL_OFF))[u] = 0u;
    __syncthreads();
    const int lo = args.ph_lo, hi = args.ph_hi;
    const bool multi = (hi - lo) > 1;
    XcdBarrier bar; bar.bar = (unsigned*)(F.ctl + CW_BAR); bar.x = 0; bar.st = nullptr;
    if (multi) bar = xcd_barrier_post((unsigned*)(F.ctl + CW_BAR), MISC + 8);
#define IN(p) (lo <= (p) && (p) < hi)
#define SEAM(p) do { if ((p) + 1 < hi) xcd_barrier(bar); } while (0)
#define FRESH() do { int t_ = threadIdx.x; asm volatile("" : "+v"(t_)); F.tid = t_; F.lane = t_ & 63; F.wave = __builtin_amdgcn_readfirstlane(t_ >> 6); \
    unsigned char* w_ = args.ws; asm volatile("" : "+s"(w_)); F.ws = w_; F.ctl = (gu32*)(w_ + WS_CTL); } while (0)

    if (IN(0)) { FRESH(); prologue_phase(F, args); SEAM(0); }

    for (int l = 0; l < DEPTH; ++l) {
        const int pb = 1 + NPH_LAYER * l;
        if (IN(pb + 0)) { FRESH();
            const int N = (l < 2) ? NINA : (l == 2 ? 5120 : 2048);
            const unsigned char* Bt = F.ws + ((l < 2) ? WS_WAIN + (size_t)l * NINA * D * 2 : (l == 2 ? WS_WBIN0 : WS_WBIN1));
            pg8::Gemm g{nullptr, nullptr, T, N, D}; pg8::DualOrder S; S.init(F.ws + WS_XB, Bt, T, N, D, F.G, F.c, F.ws + WS_MEMB, F.ws + WS_WMKV, l == 0 ? 16 : 0);
            pg8::EpiBf16X E{l < 2 ? 0 : 1, (bf16*)(F.ws + WS_Z), (bf16*)(F.ws + WS_KD), (bf16*)(F.ws + WS_VD), (bf16*)(F.ws + WS_MEMKV)};
            pg8::gemm_phase<pg8::EpiBf16X, pg8::DualOrder, true, true>(F.lds + RING_OFF, g, S, E);
            SEAM(pb + 0);
        }
        if (IN(pb + 1)) { FRESH();
            if (l < 2) {
                for (int u = F.c; u < 256 + 128; u += F.G) {
                    if (u < 256) sgu_unit(F, args, l, u >> 2, u & 3);
                    else { const int r = u - 256; memattn_unit(F, l, r & 3, r >> 2, NINA, 2 * MIXW); }
                }
            } else {
                for (int u = F.c; u < 768 + 128; u += F.G) {
                    if (u < 768) { const int qb = 31 - u / 24, r = u % 24; diffattn_unit(F, args, r >> 2, qb, (r >> 1) & 1, r & 1); }
                    else { const int r = u - 768; memattn_unit(F, l, r & 3, r >> 2, 2048, MIXW); }
                }
            }
            SEAM(pb + 1);
        }
        if (IN(pb + 2)) { FRESH(); if (l >= 2) diffcombine_phase(F, args, l); SEAM(pb + 2); }
        if (IN(pb + 3)) { FRESH();
            pg8::Gemm g{nullptr, nullptr, T, D, D}; pg8::DenseOrder S; S.init(F.ws + WS_CAT, F.ws + (l < 2 ? WS_WAOUT + (size_t)l * D * D * 2 : WS_WBOUT + (size_t)(l - 2) * D * D * 2), T, D, D, F.G, F.c);
            pg8::EpiResF32 E{(l == 0) ? args.in[I_X] : (const float*)(F.ws + WS_XF), (float*)(F.ws + WS_Y), DN_ALPHA};
            pg8::gemm_phase<pg8::EpiResF32, pg8::DenseOrder, true, true>(F.lds + RING_OFF, g, S, E);
            SEAM(pb + 3);
        }
        if (IN(pb + 4)) { FRESH(); ln1_router_phase(F, args, l); SEAM(pb + 4); }
        if (IN(pb + 5)) { FRESH(); gather_phase(F, l); SEAM(pb + 5); }
        if (IN(pb + 6)) { FRESH();
            moe_table(F, l);
            pg8::Gemm g{nullptr, nullptr, SLOTS, 1024, D};
            pg8::MoeOrder S{(const PG8_LAS int*)(F.lds + TAB_OFF), 4, F.G, F.c, (const char*)(F.ws + WS_XG), (const char*)(F.ws + WS_W13) + (size_t)l * NE * 1024 * 2048 * 2, (size_t)256 * D * 2, (size_t)1024 * 2048 * 2, (size_t)256 * 2048 * 2};
            pg8::EpiMoe1 E{(bf16*)(F.ws + WS_H)};
            pg8::gemm_phase<pg8::EpiMoe1, pg8::MoeOrder, true, true>(F.lds + RING_OFF, g, S, E);
            SEAM(pb + 6);
        }
        if (IN(pb + 7)) { FRESH();
            moe_table(F, l);
            pg8::Gemm g{nullptr, nullptr, SLOTS, D, FF};
            pg8::MoeOrder S{(const PG8_LAS int*)(F.lds + TAB_OFF), 8, F.G, F.c, (const char*)(F.ws + WS_H), (const char*)(F.ws + WS_W2) + (size_t)l * NE * 2048 * 512 * 2, (size_t)256 * FF * 2, (size_t)2048 * 512 * 2, (size_t)256 * 512 * 2};
            pg8::EpiBf16X E{3, (bf16*)(F.ws + WS_YB), nullptr, nullptr, nullptr};
            pg8::gemm_phase<pg8::EpiBf16X, pg8::MoeOrder, true, true>(F.lds + RING_OFF, g, S, E);
            SEAM(pb + 7);
        }
        if (IN(pb + 8)) { FRESH(); ln2_phase(F, args, l); SEAM(pb + 8); }
    }
#undef IN
#undef SEAM
}

#ifndef MK_ONE_LAUNCH
#define MK_ONE_LAUNCH 1
#endif
extern "C" void kernel_launch(void* const* d_in, const int* in_sizes, int n_in, void* d_out, int out_size, void* d_ws, size_t ws_size, hipStream_t stream) {
    static int grid = 0;
    if (grid == 0) {
        if (n_in != 24 || in_sizes[0] != T * D || out_size != T * D || ws_size < WS_END) { fprintf(stderr, "kernel_launch: unexpected shapes (n_in %d, in0 %d, out %d, ws %zu < %zu)\n", n_in, n_in > 0 ? in_sizes[0] : -1, out_size, ws_size, (size_t)WS_END); grid = -1; return; }
        int dev = 0, cus = 0, per_cu = 0;
        if (hipGetDevice(&dev) != hipSuccess || hipDeviceGetAttribute(&cus, hipDeviceAttributeMultiprocessorCount, dev) != hipSuccess) { grid = -1; return; }
        if (hipFuncSetAttribute((const void*)fwd_kernel, hipFuncAttributeMaxDynamicSharedMemorySize, LDS_BYTES) != hipSuccess) { fprintf(stderr, "kernel_launch: hipFuncSetAttribute failed\n"); grid = -1; return; }
        if (hipOccupancyMaxActiveBlocksPerMultiprocessor(&per_cu, (const void*)fwd_kernel, NWAVES * 64, LDS_BYTES) != hipSuccess || per_cu < 1) fprintf(stderr, "kernel_launch: occupancy query reports %d\n", per_cu);
        (void)hipGetLastError();
        grid = cus;
    }
    if (grid < 0) return;
    if (hipMemsetAsync((char*)d_ws + WS_CTL, 0, CTL_ZERO_BYTES, stream) != hipSuccess) return;
    Args a{};
    for (int i = 0; i < 24; ++i) a.in[i] = (const float*)d_in[i];
    a.out = (float*)d_out; a.ws = (unsigned char*)d_ws;
#if MK_ONE_LAUNCH
    a.ph_lo = 0; a.ph_hi = NPHASES;
    hipLaunchKernelGGL(fwd_kernel, dim3(grid), dim3(NWAVES * 64), LDS_BYTES, stream, a);
#else
    for (int p = 0; p < NPHASES; ++p) {
        const int k = (p - 1) % NPH_LAYER, l = (p - 1) / NPH_LAYER;
        if (p > 0 && k == 2 && l < 2) continue;
        a.ph_lo = p; a.ph_hi = p + 1;
        hipLaunchKernelGGL(fwd_kernel, dim3(grid), dim3(NWAVES * 64), LDS_BYTES, stream, a);
    }
#endif
    const hipError_t le = hipPeekAtLastError();
    if (le != hipSuccess) fprintf(stderr, "kernel_launch: launch failed: %s\n", hipGetErrorName(le));
}
```

```cpp
#include <hip/hip_runtime.h>
#include <cstdio>
#include <cstdint>
namespace pg8 {
#define PG8_LAS __attribute__((address_space(3)))
typedef unsigned short bf16_t;
typedef short bf16x8 __attribute__((ext_vector_type(8)));
typedef float f32x4 __attribute__((ext_vector_type(4)));
typedef unsigned u32x4 __attribute__((ext_vector_type(4)));
constexpr int BM = 256, BK = 64, HALF = 128, HTB = HALF * BK * 2  , STAGE_BYTES = 8 * HTB, NXCD = 8, WGM = 8;

__host__ __device__ __forceinline__ int lds_byte(int r, int c) { const int st = (r >> 4) * 2 + (c >> 5), rr = r & 15, cc = c & 31, ob = rr * 64 + cc * 2; return st * 1024 + (ob ^ (((ob >> 9) & 1) << 5)); }
__host__ __device__ __forceinline__ void stage_rc(int b, int& R, int& C) { const int st = b / 1024, sb = b % 1024, swz = sb ^ (((sb >> 9) & 1) << 5); R = (st >> 1) * 16 + swz / 64; C = (st & 1) * 32 + (swz % 64) / 2; }
__host__ __device__ __forceinline__ int perm32(int rho) { const int n = rho >> 4, i = rho & 15; return 8 * (i >> 2) + 4 * n + (i & 3); }

typedef int pg8_v4i __attribute__((ext_vector_type(4))); typedef int pg8_v8i __attribute__((ext_vector_type(8)));
__device__ __forceinline__ pg8_v8i pg8_cat8(bf16x8 a, bf16x8 b) { return __builtin_shufflevector(__builtin_bit_cast(pg8_v4i, a), __builtin_bit_cast(pg8_v4i, b), 0, 1, 2, 3, 4, 5, 6, 7); }
struct Unit { int pm, pn, e; };
struct Gemm { const bf16_t* A; const bf16_t* Bt; int M, N, K; };

struct StaticOrder {
    static constexpr bool GATHER = false, F8 = false; static constexpr int SCALE_B = 127;
    int nM, nN, nwg, G, c;
    __host__ __device__ void init(int M, int N, int G_, int c_) { nM = M / BM; nN = N / BM; nwg = nM * nN; G = G_; c = c_; }
    __host__ __device__ bool next(int i, Unit& u) const {
        const long L = (long)i * G + c; if (L >= nwg) return false;
        int wgid = (int)L; { const int q = nwg / NXCD, r = nwg % NXCD, xcd = wgid % NXCD, off = wgid / NXCD; wgid = (xcd < r ? xcd * (q + 1) : r * (q + 1) + (xcd - r) * q) + off; }
        const int nig = WGM * nN, gid = wgid / nig, fm = gid * WGM, gsz = (nM - fm) < WGM ? (nM - fm) : WGM;
        u.pm = fm + ((wgid % nig) % gsz); u.pn = (wgid % nig) / gsz; return true;
    }
    __device__ __forceinline__ void a_ready(const Unit&) const {}
    __device__ __forceinline__ void done(const Unit&) const {}
};

__device__ __forceinline__ unsigned cvt_pk_bf16(float lo, float hi) { unsigned r; asm volatile("v_cvt_pk_bf16_f32 %0, %1, %2" : "=v"(r) : "v"(lo), "v"(hi)); return r; }
typedef float f32x2 __attribute__((ext_vector_type(2)));
__device__ __forceinline__ f32x2 gelu_pk(f32x2 v) {
    const f32x2 av = __builtin_elementwise_abs(v), d = av * 0.2316418882f + 1.0f;
    f32x2 t; t.x = __builtin_amdgcn_rcpf(d.x); t.y = __builtin_amdgcn_rcpf(d.y);
    f32x2 q = t * 0.5307027145f + (-0.7265760135f); q = q * t + 0.7107068705f; q = q * t + (-0.142248368f); q = q * t + 0.127414796f; q = q * t;
    const f32x2 s = (v * v) * (-0.72134752044f);
    f32x2 e; e.x = __builtin_amdgcn_exp2f(s.x); e.y = __builtin_amdgcn_exp2f(s.y);
    const f32x2 m = v * (q * e), r = v - m;
    f32x2 o; o.x = v.x < 0.f ? m.x : r.x; o.y = v.y < 0.f ? m.y : r.y; return o;
}

template <class Epi, class Sched, bool ALIGN_EPI = false, bool SP2 = false>
__device__ __forceinline__ void gemm_phase(PG8_LAS unsigned char* lds, const Gemm g, const Sched& S, const Epi& E) {
    int tid_ = threadIdx.x; asm volatile("" : "+v"(tid_));
    const int tid = tid_, wid = __builtin_amdgcn_readfirstlane(tid >> 6), lane = tid & 63, wr = wid >> 2, wc = wid & 3, fr = lane & 15, fq = lane >> 4;
    const int K = g.K, nt = K / BK;
    unsigned voffA[2], voffB[2];
#pragma unroll
    for (int i = 0; i < 2; ++i) { int R, C; stage_rc(tid * 16 + i * 8192, R, C); const int Rb = Epi::PERM ? ((R & ~31) + perm32(R & 31)) : R;
        voffA[i] = (unsigned)(R * K + C) * 2u; voffB[i] = (unsigned)(Rb * K + C) * 2u; }
    unsigned vAc[2][2], vAn[2][2];
    int gR[2], gC[2];
#pragma unroll
    for (int i = 0; i < 2; ++i) { stage_rc(tid * 16 + i * 8192, gR[i], gC[i]); }
    const size_t kstep = (size_t)(BK * 2);
    const size_t hstep = (size_t)HALF * K * 2;
        const unsigned ldsw = (unsigned)wid * 1024u;
    const int aoff = lds_byte(wr * 64 + fr, fq * 8), boff = lds_byte(wc * 32 + fr, fq * 8);
#define PG8_SA(b, h) (((b) * 2 + (h)) * HTB)
#define PG8_SB(b, h) ((4 + (b) * 2 + (h)) * HTB)
#define PG8_STAGE(bufoff, gbase, voff) do { _Pragma("unroll") for (int _i = 0; _i < 2; ++_i) \
        __builtin_amdgcn_global_load_lds((const unsigned*)((const char*)(gbase) + (voff)[_i]), (PG8_LAS unsigned*)(lds + (bufoff) + ldsw + _i * 8192), 16, 0, 0); } while (0)
#define PG8_STAGE_A(b, h, base, VS) do { if constexpr (Sched::GATHER) { PG8_STAGE(PG8_SA(b, h), base, VS[h]); } else { PG8_STAGE(PG8_SA(b, h), (base) + (h) * hstep, voffA); } } while (0)
#define PG8_STAGE_AN(b, h, base) do { if constexpr (Sched::GATHER) { unsigned vs_[2] = {last ? vAn[h][0] : vAc[h][0], last ? vAn[h][1] : vAc[h][1]}; PG8_STAGE(PG8_SA(b, h), base, vs_); } else { PG8_STAGE(PG8_SA(b, h), (base) + (h) * hstep, voffA); } } while (0)
#define PG8_LDA(dst, b, h) do { if constexpr (Sched::F8) { _Pragma("unroll") for (int m = 0; m < 4; ++m) { dst##8[m].lo = *(const PG8_LAS pg8_v4i*)(lds + PG8_SA(b, h) + aoff + m * 2048); dst##8[m].hi = *(const PG8_LAS pg8_v4i*)(lds + PG8_SA(b, h) + aoff + m * 2048 + 1024); } } \
        else { _Pragma("unroll") for (int m = 0; m < 4; ++m) _Pragma("unroll") for (int k = 0; k < 2; ++k) dst[m][k] = *(const PG8_LAS bf16x8*)(lds + PG8_SA(b, h) + aoff + m * 2048 + k * 1024); } } while (0)
#define PG8_LDB(dst, b, h) do { if constexpr (Sched::F8) { _Pragma("unroll") for (int n = 0; n < 2; ++n) { dst##8[n].lo = *(const PG8_LAS pg8_v4i*)(lds + PG8_SB(b, h) + boff + n * 2048); dst##8[n].hi = *(const PG8_LAS pg8_v4i*)(lds + PG8_SB(b, h) + boff + n * 2048 + 1024); } } \
        else { _Pragma("unroll") for (int n = 0; n < 2; ++n) _Pragma("unroll") for (int k = 0; k < 2; ++k) dst[n][k] = *(const PG8_LAS bf16x8*)(lds + PG8_SB(b, h) + boff + n * 2048 + k * 1024); } } while (0)
#define PG8_MMA(ai, bj, At, Bt) do { __builtin_amdgcn_s_setprio(1); if constexpr (Sched::F8) { \
        _Pragma("unroll") for (int m = 0; m < 4; ++m) _Pragma("unroll") for (int n = 0; n < 2; ++n) \
            asm volatile("v_mfma_scale_f32_16x16x128_f8f6f4 %0, %1, %2, %0, %3, %4 op_sel_hi:[0,0,0]" : "+v"(acc[ai][bj][m][n]) : "v"(Bt##8[n]), "v"(At##8[m]), "v"(sclB_), "v"(sclA_));     \
        } else { _Pragma("unroll") for (int m = 0; m < 4; ++m) _Pragma("unroll") for (int n = 0; n < 2; ++n) _Pragma("unroll") for (int k = 0; k < 2; ++k) \
        acc[ai][bj][m][n] = __builtin_amdgcn_mfma_f32_16x16x32_bf16(Bt[n][k], At[m][k], acc[ai][bj][m][n], 0, 0, 0); } __builtin_amdgcn_s_setprio(0); } while (0)
#define PG8_WAIT_V(n) asm volatile("s_waitcnt vmcnt(" #n ")" ::: "memory")
#define PG8_WAIT_L(n) asm volatile("s_waitcnt lgkmcnt(" #n ")" ::: "memory")
#define PG8_BAR __builtin_amdgcn_s_barrier()
#define PG8_SCHED __builtin_amdgcn_sched_barrier(0)
    Unit cur, nxt; int ui = 0;
    if (!S.next(0, cur)) return;
    f32x4 acc[2][2][4][2];
#pragma unroll
    for (int a = 0; a < 2; ++a)
#pragma unroll
        for (int b = 0; b < 2; ++b)
#pragma unroll
            for (int m = 0; m < 4; ++m)
#pragma unroll
                for (int n = 0; n < 2; ++n) acc[a][b][m][n] = (f32x4){0.f, 0.f, 0.f, 0.f};
    const int sclB_ = Sched::SCALE_B, sclA_ = 127;
    bf16x8 At[4][2], B0[2][2], B1[2][2]; pg8_v8i At8[4], B08[2], B18[2];
    const char* cA = S.aptr(cur); const char* cB = S.bptr(cur);
    S.a_ready(cur);
    if constexpr (Sched::GATHER) {
#pragma unroll
        for (int h = 0; h < 2; ++h)
#pragma unroll
            for (int i = 0; i < 2; ++i) { vAc[h][i] = S.rowoff(cur, h * HALF + gR[i]) + (unsigned)gC[i] * 2u; vAn[h][i] = vAc[h][i]; }
        asm volatile("s_waitcnt vmcnt(0)" ::: "memory");
    }
    if constexpr (SP2) {
        PG8_STAGE(PG8_SB(0, 0), cB, voffB); PG8_STAGE(PG8_SB(0, 1), cB + hstep, voffB); PG8_STAGE_A(0, 0, cA, vAc); PG8_STAGE_A(0, 1, cA, vAc);
        if (wr == 1) PG8_BAR;
        PG8_WAIT_V(2); PG8_BAR;
        PG8_STAGE(PG8_SB(1, 0), cB + kstep, voffB); PG8_STAGE_A(1, 0, cA + kstep, vAc); PG8_STAGE(PG8_SB(1, 1), cB + hstep + kstep, voffB);
        PG8_WAIT_V(6); PG8_BAR;
    } else {
        PG8_STAGE(PG8_SB(0, 0), cB, voffB); PG8_STAGE_A(0, 0, cA, vAc); PG8_STAGE(PG8_SB(0, 1), cB + hstep, voffB); PG8_STAGE_A(0, 1, cA, vAc);
        if (wr == 1) PG8_BAR;
        PG8_WAIT_V(4); PG8_BAR;
        PG8_STAGE(PG8_SB(1, 0), cB + kstep, voffB); PG8_STAGE_A(1, 0, cA + kstep, vAc); PG8_STAGE(PG8_SB(1, 1), cB + hstep + kstep, voffB);
        PG8_WAIT_V(6); PG8_BAR;
    }
    for (;;) {
        const bool has_next = S.next(ui + 1, nxt);
        const char* nA = has_next ? S.aptr(nxt) : cA; const char* nB = has_next ? S.bptr(nxt) : cB;
        if constexpr (Sched::GATHER) { if (has_next) {
#pragma unroll
            for (int h = 0; h < 2; ++h)
#pragma unroll
                for (int i = 0; i < 2; ++i) vAn[h][i] = S.rowoff(nxt, h * HALF + gR[i]) + (unsigned)gC[i] * 2u; } }
        for (int t = 0; t < nt; t += 2) {
            const bool last = (t == nt - 2);
            const char* a1 = cA + (size_t)(t + 1) * kstep;
            const char* a2 = last ? nA : cA + (size_t)(t + 2) * kstep; const char* b2 = last ? nB : cB + (size_t)(t + 2) * kstep;
            const char* a3 = a2 + kstep; const char* b3 = b2 + kstep;
            if (last && has_next) S.a_ready(nxt);
            if constexpr (SP2) {
            PG8_LDB(B0, 0, 0); PG8_LDB(B1, 0, 1); PG8_SCHED; PG8_LDA(At, 0, 0); PG8_STAGE_A(1, 1, a1, vAc);
            PG8_WAIT_V(8); PG8_WAIT_L(0); PG8_BAR; PG8_MMA(0, 0, At, B0); PG8_MMA(0, 1, At, B1); PG8_BAR; PG8_SCHED;
            PG8_LDA(At, 0, 1); PG8_STAGE(PG8_SB(0, 0), b2, voffB); PG8_STAGE(PG8_SB(0, 1), b2 + hstep, voffB); PG8_STAGE_AN(0, 0, a2);
            PG8_WAIT_V(8); PG8_WAIT_L(0); PG8_BAR; PG8_MMA(1, 0, At, B0); PG8_MMA(1, 1, At, B1); PG8_BAR; PG8_SCHED;
            PG8_LDB(B0, 1, 0); PG8_LDB(B1, 1, 1); PG8_SCHED; PG8_LDA(At, 1, 0); PG8_STAGE_AN(0, 1, a2);
            PG8_WAIT_V(8); PG8_WAIT_L(0); PG8_BAR; PG8_MMA(0, 0, At, B0); PG8_MMA(0, 1, At, B1); PG8_BAR; PG8_SCHED;
            PG8_LDA(At, 1, 1); PG8_STAGE(PG8_SB(1, 0), b3, voffB); PG8_STAGE(PG8_SB(1, 1), b3 + hstep, voffB); PG8_STAGE_AN(1, 0, a3);
            PG8_WAIT_V(8); PG8_WAIT_L(0); PG8_BAR; PG8_MMA(1, 0, At, B0); PG8_MMA(1, 1, At, B1); PG8_BAR; PG8_SCHED;
            } else {
            PG8_LDB(B0, 0, 0); PG8_SCHED; PG8_LDA(At, 0, 0); PG8_STAGE_A(1, 1, a1, vAc);
            PG8_WAIT_L(8); PG8_BAR; PG8_WAIT_L(0); PG8_MMA(0, 0, At, B0); PG8_BAR; PG8_SCHED;
            PG8_LDB(B1, 0, 1); PG8_STAGE(PG8_SB(0, 0), b2, voffB);
            PG8_BAR; PG8_WAIT_L(0); PG8_MMA(0, 1, At, B1); PG8_BAR;
            PG8_LDA(At, 0, 1); PG8_STAGE_AN(0, 0, a2);
            PG8_BAR; PG8_WAIT_L(0); PG8_MMA(1, 0, At, B0); PG8_BAR; PG8_SCHED;
            PG8_STAGE(PG8_SB(0, 1), b2 + hstep, voffB);
            PG8_WAIT_V(6); PG8_BAR; PG8_MMA(1, 1, At, B1); PG8_BAR;
            PG8_LDB(B0, 1, 0); PG8_SCHED; PG8_LDA(At, 1, 0); PG8_STAGE_AN(0, 1, a2);
            PG8_WAIT_L(8); PG8_BAR; PG8_WAIT_L(0); PG8_MMA(0, 0, At, B0); PG8_BAR; PG8_SCHED;
            PG8_LDB(B1, 1, 1); PG8_STAGE(PG8_SB(1, 0), b3, voffB);
            PG8_BAR; PG8_WAIT_L(0); PG8_MMA(0, 1, At, B1); PG8_BAR;
            PG8_LDA(At, 1, 1); PG8_STAGE_AN(1, 0, a3);
            PG8_BAR; PG8_WAIT_L(0); PG8_MMA(1, 0, At, B0); PG8_BAR; PG8_SCHED;
            PG8_STAGE(PG8_SB(1, 1), b3 + hstep, voffB);
            PG8_WAIT_V(6); PG8_BAR; PG8_MMA(1, 1, At, B1); PG8_BAR;
            }
        }
        if constexpr (ALIGN_EPI) { if (wr == 0) PG8_BAR; }
        if constexpr (!Epi::AFTER_DRAIN) { E(acc, cur, wr, wc, fr, fq); S.done(cur); }
        if (!has_next) break;
#pragma unroll
        for (int a = 0; a < 2; ++a)
#pragma unroll
            for (int b = 0; b < 2; ++b)
#pragma unroll
                for (int m = 0; m < 4; ++m)
#pragma unroll
                    for (int n = 0; n < 2; ++n) acc[a][b][m][n] = (f32x4){0.f, 0.f, 0.f, 0.f};
        cur = nxt; cA = nA; cB = nB; ++ui;
        if constexpr (Sched::GATHER) {
#pragma unroll
            for (int h = 0; h < 2; ++h)
#pragma unroll
                for (int i = 0; i < 2; ++i) vAc[h][i] = vAn[h][i]; }
        if constexpr (ALIGN_EPI) { if (wr == 1) PG8_BAR; }
    }
    PG8_WAIT_V(0);
    if constexpr (!ALIGN_EPI) { if (wr == 0) PG8_BAR; }
    PG8_BAR;
    if constexpr (Epi::AFTER_DRAIN) { E.fused(acc, cur, wr, wc, fr, fq, lds, wid, lane); S.done(cur); }
#undef PG8_SA
#undef PG8_SB
#undef PG8_STAGE
#undef PG8_STAGE_A
#undef PG8_STAGE_AN
#undef PG8_LDA
#undef PG8_LDB
#undef PG8_MMA
#undef PG8_WAIT_V
#undef PG8_WAIT_L
#undef PG8_BAR
#undef PG8_SCHED
}
}

constexpr int T = 8192, D = 2048, MIXW = 1536, MEMW = 512, NINA = 3584, DEPTH = 4, NE = 32, FF = 512, MEMT = 256;
constexpr int SLOTS = 24576;
constexpr float LN_EPS = 1e-5f;
constexpr float DN_ALPHA = 1.6817928305074292f;
constexpr float LOG2E = 1.4426950408889634f;
constexpr float QSCALE = 0.08838834764831845f * LOG2E;
constexpr int NWAVES = 8;

constexpr size_t MiB = 1u << 20;
constexpr size_t WS_CTL = 0, CTL_ZERO_BYTES = 1 * MiB;
constexpr size_t WS_WAIN = 2 * MiB, WS_WAOUT = 30 * MiB, WS_WBIN0 = 46 * MiB, WS_WKV = 54 * MiB, WS_WBIN1 = 66 * MiB, WS_WBOUT = 74 * MiB, WS_WMKV = 90 * MiB;
constexpr size_t WS_W13 = 106 * MiB, WS_W2 = 618 * MiB;
constexpr size_t WS_XB = 874 * MiB, WS_MEMB = 906 * MiB, WS_MEMKV = 907 * MiB, WS_Z = 910 * MiB, WS_KD = 966 * MiB, WS_VD = 990 * MiB, WS_CAT = 1014 * MiB;
constexpr size_t WS_Y = 1046 * MiB, WS_X1F = 1110 * MiB, WS_X1B = 1174 * MiB, WS_XF = 1206 * MiB, WS_XG = 1270 * MiB, WS_H = 1366 * MiB, WS_YB = 1390 * MiB, WS_OP = 1486 * MiB;
constexpr size_t WS_ROUTE = 1582 * MiB, WS_OP2 = 1583 * MiB, WS_ML = 1631 * MiB, WS_WR = 1634 * MiB, WS_TS = 1640 * MiB, WS_LIST = 1641 * MiB, WS_END = 1642 * MiB;
constexpr int CW_TMO = 0, CW_BAR = 4096, CW_CNT = 16384, CW_Q = 28672, CW_CONV = 29184, CW_DONE = 32768, CW_FIN = 40960;

constexpr int RING_OFF = 0, RING_BYTES = 131072;
constexpr int LDSCTL_OFF = 146432, MISC_OFF = LDSCTL_OFF + 320, TAB_OFF = LDSCTL_OFF + 512;
constexpr int LDS_BYTES = 147456;

#define GAS __attribute__((address_space(1)))
#define LAS __attribute__((address_space(3)))
typedef unsigned short bf16;
typedef unsigned v4u __attribute__((ext_vector_type(4)));
typedef unsigned v2u __attribute__((ext_vector_type(2)));
typedef float f32x4 __attribute__((ext_vector_type(4)));
typedef short bf16x8 __attribute__((ext_vector_type(8)));
typedef GAS unsigned gu32;
#define RLX_AGENT __ATOMIC_RELAXED, __HIP_MEMORY_SCOPE_AGENT
#define LDS_WAIT() asm volatile("s_waitcnt lgkmcnt(0)" ::: "memory")
#define VM_WAIT() asm volatile("s_waitcnt vmcnt(0)" ::: "memory")
__device__ __forceinline__ unsigned f2bf(float f) { unsigned u = __builtin_bit_cast(unsigned, f); return (u + 0x7fffu + ((u >> 16) & 1u)) >> 16; }
__device__ __forceinline__ unsigned pk2(float lo, float hi) { return f2bf(lo) | (f2bf(hi) << 16); }
__device__ __forceinline__ float bf2f(unsigned short b) { return __builtin_bit_cast(float, (unsigned)b << 16); }
__device__ __forceinline__ float bflo(unsigned w) { return __builtin_bit_cast(float, w << 16); }
__device__ __forceinline__ float bfhi(unsigned w) { return __builtin_bit_cast(float, w & 0xffff0000u); }
__device__ __forceinline__ float wave_sum(float v) {
#pragma unroll
    for (int o = 1; o < 64; o <<= 1) v += __shfl_xor(v, o);
    return v;
}

namespace pg8 {
struct DenseOrder {
    static constexpr bool GATHER = false, F8 = false; static constexpr int SCALE_B = 127;
    StaticOrder so; const char* A; const char* B; size_t astep, bstep;
    __device__ void init(const void* A_, const void* B_, int M, int N, int K, int G, int c) { so.init(M, N, G, c); A = (const char*)A_; B = (const char*)B_; astep = (size_t)256 * K * 2; bstep = astep; }
    __device__ __forceinline__ bool next(int i, Unit& u) const { u.e = 0; return so.next(i, u); }
    __device__ __forceinline__ const char* aptr(const Unit& u) const { return A + (size_t)u.pm * astep; }
    __device__ __forceinline__ const char* bptr(const Unit& u) const { return B + (size_t)u.pn * bstep; }
    __device__ __forceinline__ void a_ready(const Unit&) const {}
    __device__ __forceinline__ void done(const Unit&) const {}
};
struct DualOrder {
    static constexpr bool GATHER = false, F8 = false; static constexpr int SCALE_B = 127;
    StaticOrder so; int nwg2; const char* A; const char* B; const char* A2; const char* B2; size_t step;
    __device__ void init(const void* A_, const void* B_, int M, int N, int K, int G, int c, const void* A2_, const void* B2_, int nwg2_) { so.init(M, N, G, c); A = (const char*)A_; B = (const char*)B_; A2 = (const char*)A2_; B2 = (const char*)B2_; nwg2 = nwg2_; step = (size_t)256 * K * 2; }
    __device__ __forceinline__ bool next(int i, Unit& u) const { const int L = i * so.G + so.c; if (L < so.nwg) { u.e = 0; return so.next(i, u); } if (L - so.nwg >= nwg2) return false; u.e = 1; u.pm = 0; u.pn = L - so.nwg; return true; }
    __device__ __forceinline__ const char* aptr(const Unit& u) const { return u.e ? A2 : A + (size_t)u.pm * step; }
    __device__ __forceinline__ const char* bptr(const Unit& u) const { return (u.e ? B2 : B) + (size_t)u.pn * step; }
    __device__ __forceinline__ void a_ready(const Unit&) const {}
    __device__ __forceinline__ void done(const Unit&) const {}
};
struct MoeOrder {
    static constexpr bool GATHER = false, F8 = false; static constexpr int SCALE_B = 127;
    const PG8_LAS int* tstart; int ntn, G, c; const char* A; const char* W; size_t astep, wexp, wtile;
    __device__ __forceinline__ bool next(int i, Unit& u) const {
        const int L = i * G + c, total = tstart[32] * ntn; if (L >= total) return false;
        int wgid; { const int q = total / NXCD, r = total % NXCD, xcd = L % NXCD, off = L / NXCD; wgid = (xcd < r ? xcd * (q + 1) : r * (q + 1) + (xcd - r) * q) + off; }
        u.pm = wgid / ntn; u.pn = wgid - u.pm * ntn; int e = 0;
#pragma unroll
        for (int k = 1; k <= 31; ++k) e += (tstart[k] <= u.pm) ? 1 : 0;
        u.e = e; return true;
    }
    __device__ __forceinline__ const char* aptr(const Unit& u) const { return A + (size_t)u.pm * astep; }
    __device__ __forceinline__ const char* bptr(const Unit& u) const { return W + (size_t)u.e * wexp + (size_t)u.pn * wtile; }
    __device__ __forceinline__ void a_ready(const Unit&) const {}
    __device__ __forceinline__ void done(const Unit&) const {}
};

struct MoeOrder8 {
    static constexpr bool GATHER = false, F8 = true; static constexpr int SCALE_B = 121;
    const PG8_LAS int* tstart; int ntn, G, c; const char* A; const char* W; size_t astep, wexp, wtile;
    __device__ __forceinline__ bool next(int i, Unit& u) const {
        const int L = i * G + c, total = tstart[32] * ntn; if (L >= total) return false;
        int wgid; { const int q = total / NXCD, r = total % NXCD, xcd = L % NXCD, off = L / NXCD; wgid = (xcd < r ? xcd * (q + 1) : r * (q + 1) + (xcd - r) * q) + off; }
        u.pm = wgid / ntn; u.pn = wgid - u.pm * ntn; int e = 0;
#pragma unroll
        for (int k = 1; k <= 31; ++k) e += (tstart[k] <= u.pm) ? 1 : 0;
        u.e = e; return true;
    }
    __device__ __forceinline__ const char* aptr(const Unit& u) const { return A + (size_t)u.pm * astep; }
    __device__ __forceinline__ const char* bptr(const Unit& u) const { return W + (size_t)u.e * wexp + (size_t)u.pn * wtile; }
    __device__ __forceinline__ void a_ready(const Unit&) const {}
    __device__ __forceinline__ void done(const Unit&) const {}
};

struct MoeGatherOrder {
    static constexpr bool GATHER = true, F8 = true; static constexpr int SCALE_B = 121;
    const PG8_LAS int* tstart; const PG8_LAS int* cntl; const int* list; int ntn, G, c; const char* A; const char* W; size_t wexp, wtile; unsigned rowbytes;
    __device__ __forceinline__ bool next(int i, Unit& u) const {
        const int L = i * G + c, total = tstart[32] * ntn; if (L >= total) return false;
        int wgid; { const int q = total / NXCD, r = total % NXCD, xcd = L % NXCD, off = L / NXCD; wgid = (xcd < r ? xcd * (q + 1) : r * (q + 1) + (xcd - r) * q) + off; }
        u.pm = wgid / ntn; u.pn = wgid - u.pm * ntn; int e = 0;
#pragma unroll
        for (int k = 1; k <= 31; ++k) e += (tstart[k] <= u.pm) ? 1 : 0;
        u.e = e; return true;
    }
    __device__ __forceinline__ unsigned rowoff(const Unit& u, int r) const { const int rank = (u.pm - tstart[u.e]) * 256 + r; const int tok = list[u.e * 8192 + (rank < cntl[u.e] ? rank : 0)]; return (unsigned)tok * rowbytes; }
    __device__ __forceinline__ const char* aptr(const Unit&) const { return A; }
    __device__ __forceinline__ const char* bptr(const Unit& u) const { return W + (size_t)u.e * wexp + (size_t)u.pn * wtile; }
    __device__ __forceinline__ void a_ready(const Unit&) const {}
    __device__ __forceinline__ void done(const Unit&) const {}
};

struct EpiBf16X {
    static constexpr bool PERM = true, AFTER_DRAIN = false;
    int mode; bf16_t* p0; bf16_t* p1; bf16_t* p2; bf16_t* p3;
    const PG8_LAS int* tstart; const PG8_LAS int* cntl;
    __device__ __forceinline__ void operator()(const f32x4 (&acc)[2][2][4][2], const Unit& u, int wr, int wc, int fr, int fq) const {
        bf16_t* base; int ldc, colt; bool act = false; float sc = 1.f;
        if (u.e && mode < 2) { base = p3 + (size_t)(u.pn >> 2) * (256 * 1024); ldc = 1024; colt = (u.pn & 3) * BM; }
        else if (mode == 0) { base = p0; ldc = 3584; colt = u.pn * BM; act = u.pn < 12; if (u.pn >= 12) sc = QSCALE; }
        else if (mode == 1) { if (u.pn < 8) { base = p0; ldc = 2048; colt = u.pn * BM; sc = QSCALE; }
                              else if (u.pn < 14) { base = p1; ldc = 1536; colt = (u.pn - 8) * BM; } else { base = p2; ldc = 1536; colt = (u.pn - 14) * BM; } }
        else { base = p0; ldc = 2048; colt = u.pn * BM; }
        const int row0 = u.pm * BM + wr * 64 + fr, col0 = colt + wc * 32 + 8 * fq;
        const int rlim = (mode == 3) ? cntl[u.e] - (u.pm - tstart[u.e]) * BM : BM;
#pragma unroll
        for (int ai = 0; ai < 2; ++ai)
#pragma unroll
            for (int m = 0; m < 4; ++m) { bf16_t* rowp = base + (size_t)(row0 + ai * HALF + m * 16) * ldc + col0;
                if (wr * 64 + fr + ai * HALF + m * 16 >= rlim) continue;
#pragma unroll
                for (int bj = 0; bj < 2; ++bj) { f32x4 v0 = acc[ai][bj][m][0], v1 = acc[ai][bj][m][1];
                    if (act) { f32x2 a = gelu_pk((f32x2){v0[0], v0[1]}), b = gelu_pk((f32x2){v0[2], v0[3]}), c = gelu_pk((f32x2){v1[0], v1[1]}), d = gelu_pk((f32x2){v1[2], v1[3]});
                        v0 = (f32x4){a.x, a.y, b.x, b.y}; v1 = (f32x4){c.x, c.y, d.x, d.y}; }
                    v0 = v0 * sc; v1 = v1 * sc; u32x4 w; w.x = cvt_pk_bf16(v0[0], v0[1]); w.y = cvt_pk_bf16(v0[2], v0[3]); w.z = cvt_pk_bf16(v1[0], v1[1]); w.w = cvt_pk_bf16(v1[2], v1[3]);
                    *(u32x4*)(rowp + bj * HALF) = w; } }
    }
};
struct EpiResBf16 {
    static constexpr bool PERM = true, AFTER_DRAIN = false;
    const bf16_t* xres; bf16_t* y; float alpha;
    __device__ __forceinline__ void operator()(const f32x4 (&acc)[2][2][4][2], const Unit& u, int wr, int wc, int fr, int fq) const {
        const int row0 = u.pm * BM + wr * 64 + fr, col0 = u.pn * BM + wc * 32 + 8 * fq;
#pragma unroll
        for (int ai = 0; ai < 2; ++ai)
#pragma unroll
            for (int m = 0; m < 4; ++m) { const size_t off = (size_t)(row0 + ai * HALF + m * 16) * 2048 + col0;
#pragma unroll
                for (int bj = 0; bj < 2; ++bj) { const u32x4 xr = *(const u32x4*)(xres + off + bj * HALF); const f32x4 v0 = acc[ai][bj][m][0], v1 = acc[ai][bj][m][1]; u32x4 w;
                    w.x = cvt_pk_bf16(__builtin_bit_cast(float, xr.x << 16) * alpha + v0[0], __builtin_bit_cast(float, xr.x & 0xffff0000u) * alpha + v0[1]);
                    w.y = cvt_pk_bf16(__builtin_bit_cast(float, xr.y << 16) * alpha + v0[2], __builtin_bit_cast(float, xr.y & 0xffff0000u) * alpha + v0[3]);
                    w.z = cvt_pk_bf16(__builtin_bit_cast(float, xr.z << 16) * alpha + v1[0], __builtin_bit_cast(float, xr.z & 0xffff0000u) * alpha + v1[1]);
                    w.w = cvt_pk_bf16(__builtin_bit_cast(float, xr.w << 16) * alpha + v1[2], __builtin_bit_cast(float, xr.w & 0xffff0000u) * alpha + v1[3]);
                    *(u32x4*)(y + off + bj * HALF) = w; } }
    }
};
struct EpiMoe1 {
    static constexpr bool PERM = true, AFTER_DRAIN = false;
    bf16_t* h; const PG8_LAS int* tstart; const PG8_LAS int* cntl;
    __device__ __forceinline__ void operator()(const f32x4 (&acc)[2][2][4][2], const Unit& u, int wr, int wc, int fr, int fq) const {
        const int row0 = u.pm * BM + wr * 64 + fr, col0 = u.pn * HALF + wc * 32 + 8 * fq;
        const int rlim = cntl[u.e] - (u.pm - tstart[u.e]) * BM;
#pragma unroll
        for (int ai = 0; ai < 2; ++ai)
#pragma unroll
            for (int m = 0; m < 4; ++m) { unsigned char* rowp = (unsigned char*)h + (size_t)(row0 + ai * HALF + m * 16) * 512 + col0; float o[8];
                if (wr * 64 + fr + ai * HALF + m * 16 >= rlim) continue;
#pragma unroll
                for (int n = 0; n < 2; ++n)
#pragma unroll
                    for (int x = 0; x < 4; ++x) { const float a = acc[ai][0][m][n][x], b = acc[ai][1][m][n][x];
                        o[n * 4 + x] = a * __builtin_amdgcn_rcpf(1.0f + __builtin_amdgcn_exp2f(-a * LOG2E)) * b; }
                unsigned lo = 0u, hi = 0u; lo = __builtin_amdgcn_cvt_pk_fp8_f32(o[0], o[1], lo, false); lo = __builtin_amdgcn_cvt_pk_fp8_f32(o[2], o[3], lo, true);
                hi = __builtin_amdgcn_cvt_pk_fp8_f32(o[4], o[5], hi, false); hi = __builtin_amdgcn_cvt_pk_fp8_f32(o[6], o[7], hi, true);
                typedef unsigned u32x2e __attribute__((ext_vector_type(2))); u32x2e w; w.x = lo; w.y = hi; *(u32x2e*)rowp = w; }
    }
};
}

namespace att {
using bf16x8 = __attribute__((ext_vector_type(8))) short;
using s16x4  = __attribute__((ext_vector_type(4))) short;
using f32x16 = __attribute__((ext_vector_type(16))) float;
using u32x4  = __attribute__((ext_vector_type(4))) unsigned;
constexpr int DH = 128, QBLK = 32, KVBLK = 64;
constexpr float THR2 = 8.f * 1.4426950408889634f;
constexpr size_t SHM_V = KVBLK * DH * 2, SHM_K = KVBLK * DH * 2, SHM_ATTN = 2 * SHM_V + 2 * SHM_K + NWAVES * 64 * 4;
constexpr int TAB_N = 160;
#define KSWZ(row, colB) ((row) * 256 + ((colB) ^ (((row) & 7) << 4)))
#define SBAR() __builtin_amdgcn_sched_barrier(0)
__device__ __forceinline__ int crow(int r, int hi) { return (r & 3) + 8 * (r >> 2) + 4 * hi; }
__device__ __forceinline__ unsigned cvtpk(float lo, float hi) { unsigned r; asm volatile("v_cvt_pk_bf16_f32 %0, %1, %2" : "=v"(r) : "v"(lo), "v"(hi)); return r; }

__device__ __forceinline__ void partialSM(f32x16& p0, f32x16& p1, float& m_reg, float& mn, float& alpha) {
  float pmax = p0[0];
#pragma unroll
  for (int r = 1; r < 16; ++r) pmax = fmaxf(pmax, p0[r]);
#pragma unroll
  for (int r = 0; r < 16; ++r) pmax = fmaxf(pmax, p1[r]);
  { auto rr = __builtin_amdgcn_permlane32_swap(__float_as_uint(pmax), __float_as_uint(pmax), false, false);
    pmax = fmaxf(__uint_as_float(rr[0]), __uint_as_float(rr[1])); }
  if (__builtin_expect(__all(pmax - m_reg <= THR2), 1)) { mn = m_reg; alpha = 1.f; }
  else { mn = fmaxf(m_reg, pmax); alpha = __builtin_amdgcn_exp2f(m_reg - mn); m_reg = mn; }
#pragma unroll
  for (int r = 0; r < 16; ++r) p0[r] = p0[r] - mn;
#pragma unroll
  for (int r = 0; r < 16; ++r) p1[r] = p1[r] - mn;
#pragma unroll
  for (int r = 0; r < 16; ++r) p0[r] = __builtin_amdgcn_exp2f(p0[r]);
}
__device__ __forceinline__ void finishSM(f32x16& p0, f32x16& p1, float alpha, float& l_reg, bf16x8& pa0, bf16x8& pa1, bf16x8& pa2, bf16x8& pa3) {
#pragma unroll
  for (int r = 0; r < 16; ++r) p1[r] = __builtin_amdgcn_exp2f(p1[r]);
  float ps = 0;
#pragma unroll
  for (int r = 0; r < 16; ++r) ps += p0[r];
#pragma unroll
  for (int r = 0; r < 16; ++r) ps += p1[r];
  { auto rr = __builtin_amdgcn_permlane32_swap(__float_as_uint(ps), __float_as_uint(ps), false, false);
    ps = __uint_as_float(rr[0]) + __uint_as_float(rr[1]); }
  l_reg = l_reg * alpha + ps;
#define PK4(P, BASE, OUT) do { unsigned a0 = cvtpk(P[BASE + 0], P[BASE + 1]), a1 = cvtpk(P[BASE + 2], P[BASE + 3]);   \
    unsigned b0 = cvtpk(P[BASE + 4], P[BASE + 5]), b1 = cvtpk(P[BASE + 6], P[BASE + 7]);                              \
    auto r0 = __builtin_amdgcn_permlane32_swap(a0, b0, false, false); auto r1 = __builtin_amdgcn_permlane32_swap(a1, b1, false, false); \
    u32x4 w = {r0[0], r1[0], r0[1], r1[1]}; OUT = *reinterpret_cast<bf16x8*>(&w); } while (0)
  PK4(p0, 0, pa0); PK4(p0, 8, pa1); PK4(p1, 0, pa2); PK4(p1, 8, pa3);
#undef PK4
}
__device__ __forceinline__ void qkt(f32x16& p0, f32x16& p1, const char* Ks, const bf16x8* qr, int r32, int hi) {
  p0 = f32x16{}; p1 = f32x16{};
#pragma unroll
  for (int d0 = 0; d0 < 8; ++d0) { const int cb = (d0 * 16 + hi * 8) * 2;
    bf16x8 b0 = *reinterpret_cast<const bf16x8*>(Ks + KSWZ(r32, cb));
    bf16x8 b1 = *reinterpret_cast<const bf16x8*>(Ks + KSWZ(32 + r32, cb));
    p0 = __builtin_amdgcn_mfma_f32_32x32x16_bf16(b0, qr[d0], p0, 0, 0, 0);
    p1 = __builtin_amdgcn_mfma_f32_32x32x16_bf16(b1, qr[d0], p1, 0, 0, 0); }
}
__device__ __forceinline__ int v_st(int k, int c) { const int kk = (k & ~0xC) | ((k & 4) << 1) | ((k & 8) >> 1); return ((kk >> 3) * 4 + (c >> 5)) * 512 + ((kk & 7) * 32 + (c & 31)) * 2; }
__device__ __forceinline__ int v_rd_base(int lane) { return ((lane & 3) << 3) | (((lane >> 2) & 3) << 6) | (((lane >> 4) & 1) << 5) | (((lane >> 5) & 1) << 8); }
constexpr int v_rd_off(int d0, int ks, int half) { return d0 * 512 + ks * 4096 + half * 2048; }
template <int OFF> __device__ __forceinline__ s16x4 tr_read(int vb) {
  s16x4 r; asm volatile("ds_read_b64_tr_b16 %0, %1 offset:%2" : "=&v"(r) : "v"(vb), "i"(OFF) : "memory"); return r;
}
template <int D0> __device__ __forceinline__ void pv_one(f32x16& od, int vb, bf16x8 pa0, bf16x8 pa1, bf16x8 pa2, bf16x8 pa3) {
  const s16x4 l0 = tr_read<v_rd_off(D0, 0, 0)>(vb), h0 = tr_read<v_rd_off(D0, 0, 1)>(vb), l1 = tr_read<v_rd_off(D0, 1, 0)>(vb), h1 = tr_read<v_rd_off(D0, 1, 1)>(vb);
  const s16x4 l2 = tr_read<v_rd_off(D0, 2, 0)>(vb), h2 = tr_read<v_rd_off(D0, 2, 1)>(vb), l3 = tr_read<v_rd_off(D0, 3, 0)>(vb), h3 = tr_read<v_rd_off(D0, 3, 1)>(vb);
  asm volatile("s_waitcnt lgkmcnt(0)" ::: "memory"); SBAR();
#define PK(L, H) (bf16x8){L[0], L[1], L[2], L[3], H[0], H[1], H[2], H[3]}
  od = __builtin_amdgcn_mfma_f32_32x32x16_bf16(pa0, PK(l0, h0), od, 0, 0, 0);
  od = __builtin_amdgcn_mfma_f32_32x32x16_bf16(pa1, PK(l1, h1), od, 0, 0, 0);
  od = __builtin_amdgcn_mfma_f32_32x32x16_bf16(pa2, PK(l2, h2), od, 0, 0, 0);
  od = __builtin_amdgcn_mfma_f32_32x32x16_bf16(pa3, PK(l3, h3), od, 0, 0, 0);
#undef PK
}
__device__ __forceinline__ void pv_d0(f32x16* o, int vb, bf16x8 pa0, bf16x8 pa1, bf16x8 pa2, bf16x8 pa3) {
  pv_one<0>(o[0], vb, pa0, pa1, pa2, pa3); pv_one<1>(o[1], vb, pa0, pa1, pa2, pa3); pv_one<2>(o[2], vb, pa0, pa1, pa2, pa3); pv_one<3>(o[3], vb, pa0, pa1, pa2, pa3);
}
template <int MODE> __device__ __forceinline__ void post_scores(f32x16& p0, f32x16& p1, int t, int qrow0, int r32, int hi, const float* tab, float cfar) {
  if constexpr (MODE == 1) {
    const int cw = qrow0 >> 6;
    if (t > cw) {
#pragma unroll
      for (int r = 0; r < 16; ++r) { p0[r] = -INFINITY; p1[r] = -INFINITY; }
    } else if (qrow0 - (64 * t + 63) >= 91) {
#pragma unroll
      for (int r = 0; r < 16; ++r) { p0[r] += cfar; p1[r] += cfar; }
    } else {
      const int base = qrow0 + r32 - 64 * t + 63;
#pragma unroll
      for (int r = 0; r < 16; ++r) { const int i0 = base - crow(r, hi); const int i1 = i0 - 32;
        p0[r] += tab[i0 < TAB_N - 1 ? i0 : TAB_N - 1]; p1[r] += tab[i1 < TAB_N - 1 ? i1 : TAB_N - 1]; }
    }
  }
}

template <int MODE>
__device__ __forceinline__ void attn_body(const bf16* __restrict__ Qb, int ldq, const bf16* __restrict__ Kh, const bf16* __restrict__ Vh, int ldk,
                                          bf16* Ob, float* Of, int ldo, int NT, int q0abs, const float* tab, float cfar, char* lds) {
  int tid_ = threadIdx.x; asm volatile("" : "+v"(tid_));
  const int tid = tid_, wid = tid >> 6, lane = tid & 63, r32 = lane & 31, hi = lane >> 5;
  char* V_lds = lds; char* K_lds = lds + 2 * SHM_V;
  float* ws = (float*)(lds + 2 * SHM_V + 2 * SHM_K) + wid * 64; float* li_l = ws; float* al_l = ws + 32;
  float m_reg = -1e30f, l_reg = 0; f32x16 o[4] = {}; bf16x8 qr[8];
  const int qrow0 = q0abs + wid * QBLK;
  const bf16* Qw = Qb + (long)(wid * QBLK + r32) * ldq + hi * 8;
#pragma unroll
  for (int d0 = 0; d0 < 8; ++d0) qr[d0] = *reinterpret_cast<const bf16x8*>(Qw + d0 * 16);
  const int sr = tid >> 4, sc = (tid & 15) * 8, vst0 = v_st(sr, sc), vst1 = v_st(32 + sr, sc);
  const int vb0 = (int)(uintptr_t)V_lds + v_rd_base(lane);
  struct { bf16x8 vs0, vs1, ks0, ks1; } sr_[2];
#define SLOAD(i, k0) do { sr_[i].vs0 = *reinterpret_cast<const bf16x8*>(&Vh[(long)((k0) + sr) * ldk + sc]); sr_[i].vs1 = *reinterpret_cast<const bf16x8*>(&Vh[(long)((k0) + 32 + sr) * ldk + sc]); \
    sr_[i].ks0 = *reinterpret_cast<const bf16x8*>(&Kh[(long)((k0) + sr) * ldk + sc]); sr_[i].ks1 = *reinterpret_cast<const bf16x8*>(&Kh[(long)((k0) + 32 + sr) * ldk + sc]); } while (0)
#define SWRITE(b, i) do { *(bf16x8*)(V_lds + (b) * SHM_V + vst0) = sr_[i].vs0;          \
    *(bf16x8*)(V_lds + (b) * SHM_V + vst1) = sr_[i].vs1; const int kc = sc * 2;               \
    *(bf16x8*)(K_lds + (b) * SHM_K + KSWZ(sr, kc)) = sr_[i].ks0;                       \
    *(bf16x8*)(K_lds + (b) * SHM_K + KSWZ(32 + sr, kc)) = sr_[i].ks1; } while (0)
#define SWAIT() asm volatile("s_waitcnt vmcnt(4)" ::: "memory")
#define RESC(a) do { if (__any((a) < 1.f)) { if (hi == 0) al_l[r32] = (a); asm volatile("s_waitcnt lgkmcnt(0)" ::: "memory"); \
    _Pragma("unroll") for (int d = 0; d < 4; ++d) _Pragma("unroll") for (int r = 0; r < 16; ++r) o[d][r] *= al_l[crow(r, hi)]; } } while (0)
  f32x16 pA0, pA1, pB0, pB1; float mnA, mnB, alA, alB; bf16x8 pa0, pa1, pa2, pa3;
  constexpr int SE = 0, SO = 1;
  SLOAD(SE, 0); asm volatile("s_waitcnt vmcnt(0)" ::: "memory"); SWRITE(0, SE); __syncthreads();
  qkt(pA0, pA1, K_lds, qr, r32, hi); post_scores<MODE>(pA0, pA1, 0, qrow0, r32, hi, tab, cfar); partialSM(pA0, pA1, m_reg, mnA, alA);
  SLOAD(SO, KVBLK); if (2 < NT) SLOAD(SE, 2 * KVBLK);
  SWAIT(); SWRITE(1, SO); __syncthreads();
  for (int j = 1; j + 1 < NT; j += 2) {
    SBAR(); qkt(pB0, pB1, K_lds + SHM_K, qr, r32, hi); post_scores<MODE>(pB0, pB1, j, qrow0, r32, hi, tab, cfar);
    finishSM(pA0, pA1, alA, l_reg, pa0, pa1, pa2, pa3); SBAR();
    SLOAD(SO, (j + 2) * KVBLK); SBAR();
    pv_d0(o, vb0, pa0, pa1, pa2, pa3); partialSM(pB0, pB1, m_reg, mnB, alB);
    __syncthreads(); SWAIT(); SWRITE(0, SE);
    RESC(alB); __syncthreads();
    SBAR(); qkt(pA0, pA1, K_lds, qr, r32, hi); post_scores<MODE>(pA0, pA1, j + 1, qrow0, r32, hi, tab, cfar);
    finishSM(pB0, pB1, alB, l_reg, pa0, pa1, pa2, pa3); SBAR();
    if (j + 3 < NT) SLOAD(SE, (j + 3) * KVBLK); SBAR();
    pv_d0(o, vb0 + (int)SHM_V, pa0, pa1, pa2, pa3); partialSM(pA0, pA1, m_reg, mnA, alA);
    __syncthreads(); SWAIT(); SWRITE(1, SO);
    RESC(alA); __syncthreads();
  }
  SBAR(); qkt(pB0, pB1, K_lds + SHM_K, qr, r32, hi); post_scores<MODE>(pB0, pB1, NT - 1, qrow0, r32, hi, tab, cfar);
  finishSM(pA0, pA1, alA, l_reg, pa0, pa1, pa2, pa3); SBAR();
  pv_d0(o, vb0, pa0, pa1, pa2, pa3); partialSM(pB0, pB1, m_reg, mnB, alB);
  __syncthreads(); RESC(alB);
  finishSM(pB0, pB1, alB, l_reg, pa0, pa1, pa2, pa3); SBAR();
  pv_d0(o, vb0 + (int)SHM_V, pa0, pa1, pa2, pa3);
  if (hi == 0) li_l[r32] = l_reg; asm volatile("s_waitcnt lgkmcnt(0)" ::: "memory");
  float rli[16];
#pragma unroll
  for (int r = 0; r < 16; ++r) rli[r] = __builtin_amdgcn_rcpf(li_l[crow(r, hi)]);
  if constexpr (MODE == 0) {
    bf16* Ow = Ob + (long)(wid * QBLK) * ldo;
#pragma unroll
    for (int r = 0; r < 16; ++r) { const int orow = crow(r, hi);
#pragma unroll
      for (int d0 = 0; d0 < 4; ++d0) Ow[(long)orow * ldo + d0 * 32 + r32] = (bf16)f2bf(o[d0][r] * rli[r]); }
  } else {
    float* Ow = Of + (long)(wid * QBLK) * ldo;
#pragma unroll
    for (int r = 0; r < 16; ++r) { const int orow = crow(r, hi);
#pragma unroll
      for (int d0 = 0; d0 < 4; ++d0) Ow[(long)orow * ldo + d0 * 32 + r32] = o[d0][r] * rli[r]; }
  }
  __syncthreads();
#undef SLOAD
#undef SWRITE
#undef SWAIT
#undef RESC
}
}

#define XB_TMO      128
#define XB_XCNT(j)  (256  + 64 * (j))
#define XB_XSUB(j)  (1280 + 64 * (j))
#define XB_XGEN(j)  (2304 + 64 * (j))
#define XB_TOP      3328
#define XB_TOPGEN   3392
#define XCD_BAR_WORDS 3456
#define XB_SPIN_CAP (1u << 18)

__device__ __forceinline__ unsigned xb_ld(unsigned* p)              { return __hip_atomic_load(p, __ATOMIC_RELAXED, __HIP_MEMORY_SCOPE_AGENT); }
__device__ __forceinline__ unsigned xb_add(unsigned* p, unsigned v) { return __hip_atomic_fetch_add(p, v, __ATOMIC_RELAXED, __HIP_MEMORY_SCOPE_AGENT); }
__device__ __forceinline__ unsigned xb_xcc_id() { return (unsigned)__builtin_amdgcn_s_getreg((3 << 11) | 20) & 0xFu; }
#define XB_SPIN(cond, bar) do { unsigned _sp = 0; while (cond) { __builtin_amdgcn_s_sleep(1); \
    if ((++_sp & 255u) == 0u) { if (xb_ld(&(bar)[XB_TMO])) break; if (_sp > XB_SPIN_CAP) { atomicAdd(&(bar)[XB_TMO], 1u); break; } } } } while (0)

struct XcdBarrier {
    unsigned* bar; unsigned x;
    volatile LAS unsigned* st;
};

__device__ __forceinline__ XcdBarrier xcd_barrier_post(unsigned* bar, volatile LAS unsigned* st) {
    XcdBarrier b; b.bar = bar; b.x = xb_xcc_id(); b.st = st;
    if (threadIdx.x == 0) (void)xb_add(&bar[XB_XCNT(b.x)], 1u);
    return b;
}
__device__ __forceinline__ void xcd_barrier_complete(unsigned* bar, unsigned x, unsigned& nloc, unsigned& nx) {
    const unsigned G = gridDim.x * gridDim.y * gridDim.z;
    unsigned sum, cnt, mine, sp = 0u;
    for (;;) {
        sum = 0u; cnt = 0u; mine = 0u;
#pragma unroll
        for (unsigned j = 0; j < 16; ++j) { const unsigned c = xb_ld(&bar[XB_XCNT(j)]); sum += c; cnt += (c > 0u) ? 1u : 0u; mine = (j == x) ? c : mine; }
        if (sum == G) break;
        __builtin_amdgcn_s_sleep(1);
        if ((++sp & 255u) == 0u) { if (xb_ld(&bar[XB_TMO])) break; if (sp > XB_SPIN_CAP) { atomicAdd(&bar[XB_TMO], 1u); break; } }
    }
    nloc = mine > 0u ? mine : 1u; nx = cnt > 0u ? cnt : 1u;
}

__device__ __forceinline__ void xcd_barrier(const XcdBarrier& b) {
    asm volatile("s_waitcnt vmcnt(0)" ::: "memory");
    __syncthreads();
    if (threadIdx.x == 0) {
        unsigned* bar = b.bar;
        __builtin_amdgcn_s_waitcnt(0);
        unsigned nloc = b.st[0], nx = b.st[1];
        if (nloc == 0u) { xcd_barrier_complete(bar, b.x, nloc, nx); b.st[0] = nloc; b.st[1] = nx; }
        const unsigned old = xb_add(&bar[XB_XSUB(b.x)], 1u);
        const unsigned gen = old / nloc;
        if (old + 1u == (gen + 1u) * nloc) {
            __builtin_amdgcn_fence(__ATOMIC_RELEASE, "agent");
            asm volatile("s_waitcnt vmcnt(0)" ::: "memory");
            const unsigned og = xb_add(&bar[XB_TOP], 1u);
            const unsigned tg = og / nx;
            if (og + 1u == (tg + 1u) * nx) xb_add(&bar[XB_TOPGEN], 1u);
            else XB_SPIN(xb_ld(&bar[XB_TOPGEN]) == tg, bar);
            __builtin_amdgcn_fence(__ATOMIC_ACQUIRE, "agent");
            xb_add(&bar[XB_XGEN(b.x)], 1u);
            asm volatile("s_waitcnt vmcnt(0)" ::: "memory");
        } else {
            XB_SPIN(xb_ld(&bar[XB_XGEN(b.x)]) == gen, bar);
            __builtin_amdgcn_fence(__ATOMIC_ACQUIRE, "agent");
            asm volatile("s_waitcnt vmcnt(0)" ::: "memory");
        }
    }
    __syncthreads();
}


struct Args { const float* in[24]; float* out; unsigned char* ws; int ph_lo, ph_hi; };
enum { I_X = 0, I_MEM, I_AWIN, I_ALNG, I_ALNB, I_AWS, I_ABS, I_AWOUT, I_BWIN, I_BLAM, I_BSUBG, I_BWOUT, I_WKV, I_RELB, I_MEMWKV, I_LNG, I_LNB,
       I_WG1, I_BG1, I_WG2, I_BG2, I_W1, I_W3, I_W2 };
constexpr int NPH_LAYER = 9, NPHASES = 1 + DEPTH * NPH_LAYER;

struct Frame {
    LAS unsigned char* lds; char* ldsg;
    gu32* ctl; unsigned char* ws;
    int tid, lane, wave, G, c;
};

__device__ __forceinline__ void transpose_item(const float* W, int K, int N, bf16* WT, int drow0, LAS float* scr, int k0, int n0, int lane) {
#pragma unroll 8
    for (int i = 0; i < 32; ++i) { const int kk = 2 * i + (lane >> 5); scr[kk * 33 + (lane & 31)] = W[(size_t)(k0 + kk) * N + n0 + (lane & 31)]; }
    LDS_WAIT(); asm volatile("" ::: "memory");
    const int c = lane & 7;
#pragma unroll
    for (int j = 0; j < 4; ++j) { const int n = (lane >> 3) + 8 * j; const LAS float* s = scr + (8 * c) * 33 + n;
        v4u o; o.x = pk2(s[0 * 33], s[1 * 33]); o.y = pk2(s[2 * 33], s[3 * 33]); o.z = pk2(s[4 * 33], s[5 * 33]); o.w = pk2(s[6 * 33], s[7 * 33]);
        *(GAS v4u*)(WT + (size_t)(drow0 + n) * K + k0 + 8 * c) = o; }
    LDS_WAIT(); asm volatile("" ::: "memory");
}
__device__ __forceinline__ void transpose_item_fast(const float* W, int K, int N, bf16* WT, int drow0, LAS float* scr, int k0, int n0, int lane) {
    float t[32];
#pragma unroll
    for (int i = 0; i < 32; ++i) t[i] = W[(size_t)(k0 + 2 * i + (lane >> 5)) * N + n0 + (lane & 31)];
#pragma unroll
    for (int i = 0; i < 32; i += 8) asm volatile("" : "+v"(t[i]), "+v"(t[i + 1]), "+v"(t[i + 2]), "+v"(t[i + 3]), "+v"(t[i + 4]), "+v"(t[i + 5]), "+v"(t[i + 6]), "+v"(t[i + 7]));
#pragma unroll
    for (int i = 0; i < 32; ++i) scr[(2 * i + (lane >> 5)) * 33 + (lane & 31)] = t[i];
    LDS_WAIT(); asm volatile("" ::: "memory");
    const int c = lane & 7;
#pragma unroll
    for (int j = 0; j < 4; ++j) { const int n = (lane >> 3) + 8 * j; const LAS float* s = scr + (8 * c) * 33 + n;
        v4u o; o.x = pk2(s[0 * 33], s[1 * 33]); o.y = pk2(s[2 * 33], s[3 * 33]); o.z = pk2(s[4 * 33], s[5 * 33]); o.w = pk2(s[6 * 33], s[7 * 33]);
        *(GAS v4u*)(WT + (size_t)(drow0 + n) * K + k0 + 8 * c) = o; }
    LDS_WAIT(); asm volatile("" ::: "memory");
}
__device__ __forceinline__ void prologue_phase(Frame& F, const Args& a) {
#ifdef TOUCH
    {
        const long nthr_ = (long)F.G * 512, gt_ = (long)F.c * 512 + F.tid; unsigned acc_ = 0u;
        for (long pg = gt_; pg < (long)(WS_END / 4096); pg += nthr_) acc_ += *(const GAS unsigned*)(F.ws + pg * 4096);
        for (long pg = gt_; pg < (long)((size_t)DEPTH * NE * D * FF * 4 / 4096); pg += nthr_) { acc_ += *(const GAS unsigned*)((const char*)a.in[I_W1] + pg * 4096); acc_ += *(const GAS unsigned*)((const char*)a.in[I_W3] + pg * 4096); acc_ += *(const GAS unsigned*)((const char*)a.in[I_W2] + pg * 4096); }
        if (acc_ == 0x12345679u) F.ctl[CW_TMO] = acc_;
    }
#endif
    LAS float* scr = (LAS float*)(F.lds + RING_OFF + F.wave * 16384);
    const int gw = F.c * NWAVES + F.wave, NGW = F.G * NWAVES;
    unsigned char* ws = F.ws;
    constexpr int S0 = 3584, S1 = 2048, S5 = 4 * 1024;
    constexpr int NITEMS = S0 + S1 + S5;
    for (int it = gw; it < NITEMS; it += NGW) {
        int r = it; const float* src; bf16* dst; int K = 2048, N;
        if (r < S0) { N = 3584; src = a.in[I_AWIN]; dst = (bf16*)(ws + WS_WAIN); }
        else if ((r -= S0) < S1) { N = 2048; src = a.in[I_AWOUT]; dst = (bf16*)(ws + WS_WAOUT); }
        else { r -= S1; const int mat = r >> 10; r &= 1023; N = 1024; src = a.in[I_MEMWKV] + (size_t)mat * K * N; dst = (bf16*)(ws + WS_WMKV) + (size_t)mat * K * N; }
        const int nblk = N / 32, kb = r / nblk, nb = r - kb * nblk;
        transpose_item_fast(src, K, N, dst, 32 * nb, scr, 64 * kb, 32 * nb, F.lane);
    }
    const long nthr = (long)F.G * 512, gt = (long)F.c * 512 + F.tid;
    { float* wr = (float*)(ws + WS_WR);
      for (long i = gt; i < (long)DEPTH * 3 * 512 * 16 * 4; i += nthr) { const int j = (int)(i & 3), c = (int)((i >> 2) & 15), kg = (int)((i >> 6) & 511), r = (int)(i >> 15), nb = r % 3, l = r / 3;
          const int k = 4 * kg + j, o = 16 * nb + c; float v = 0.f;
          if (o < 4) v = a.in[I_WG1][((size_t)l * D + k) * 4 + o]; else if (o < 36) { const int g = (o - 4) >> 3, e = (o - 4) & 7; v = a.in[I_WG2][(((size_t)l * 4 + g) * D + k) * 8 + e]; }
          wr[i] = v; } }
    { const float* x = a.in[I_X]; bf16* xb = (bf16*)(ws + WS_XB);
      for (long i = gt; i < (long)T * D / 8; i += nthr) { const f32x4 v0 = *(const GAS f32x4*)(x + i * 8), v1 = *(const GAS f32x4*)(x + i * 8 + 4);
          v4u o; o.x = pk2(v0.x, v0.y); o.y = pk2(v0.z, v0.w); o.z = pk2(v1.x, v1.y); o.w = pk2(v1.z, v1.w); *(GAS v4u*)(xb + i * 8) = o; } }
    { const float* x = a.in[I_MEM]; bf16* xb = (bf16*)(ws + WS_MEMB);
      for (long i = gt; i < (long)MEMT * D / 8; i += nthr) { const f32x4 v0 = *(const GAS f32x4*)(x + i * 8), v1 = *(const GAS f32x4*)(x + i * 8 + 4);
          v4u o; o.x = pk2(v0.x, v0.y); o.y = pk2(v0.z, v0.w); o.z = pk2(v1.x, v1.y); o.w = pk2(v1.z, v1.w); *(GAS v4u*)(xb + i * 8) = o; } }
}

__device__ __forceinline__ void transpose_item_fp8(const float* W, int K, int N, unsigned char* WT, int drow0, LAS float* scr, int k0, int n0, int lane) {
    float t[32];
#pragma unroll
    for (int i = 0; i < 32; ++i) t[i] = W[(size_t)(k0 + 2 * i + (lane >> 5)) * N + n0 + (lane & 31)];
#pragma unroll
    for (int i = 0; i < 32; i += 8) asm volatile("" : "+v"(t[i]), "+v"(t[i + 1]), "+v"(t[i + 2]), "+v"(t[i + 3]), "+v"(t[i + 4]), "+v"(t[i + 5]), "+v"(t[i + 6]), "+v"(t[i + 7]));
#pragma unroll
    for (int i = 0; i < 32; ++i) scr[(2 * i + (lane >> 5)) * 33 + (lane & 31)] = t[i];
    LDS_WAIT(); asm volatile("" ::: "memory");
    const int c = lane & 7;
#pragma unroll
    for (int j = 0; j < 4; ++j) { const int n = (lane >> 3) + 8 * j; const LAS float* s = scr + (8 * c) * 33 + n;
        unsigned lo = 0u, hi = 0u;
        lo = __builtin_amdgcn_cvt_pk_fp8_f32(s[0 * 33] * 64.f, s[1 * 33] * 64.f, lo, false); lo = __builtin_amdgcn_cvt_pk_fp8_f32(s[2 * 33] * 64.f, s[3 * 33] * 64.f, lo, true);
        hi = __builtin_amdgcn_cvt_pk_fp8_f32(s[4 * 33] * 64.f, s[5 * 33] * 64.f, hi, false); hi = __builtin_amdgcn_cvt_pk_fp8_f32(s[6 * 33] * 64.f, s[7 * 33] * 64.f, hi, true);
        v2u o; o.x = lo; o.y = hi; *(GAS v2u*)(WT + (size_t)(drow0 + n) * K + k0 + 8 * c) = o; }
    LDS_WAIT(); asm volatile("" ::: "memory");
}
#ifndef QA
#define QA 14
#endif
#ifndef QM
#define QM 7
#endif
#ifndef QB
#define QB 4
#endif
constexpr int NQ = 7, MOE_ITEMS = 3 * 32 * 512;
__device__ __forceinline__ int conv_qsize(int q) { return (q & 1) ? (q == 1 ? 5632 : (q == 3 ? 7168 : 4096)) : MOE_ITEMS; }
__device__ __forceinline__ void conv_item(Frame& F, const Args& a, int q, int it) {
    LAS float* scr = (LAS float*)(F.lds + RING_OFF + F.wave * 16384);
    if (q & 1) {
        const float* src; bf16* dst; int N, r = it;
        if (q == 1) { if (r < 3584) { N = 3584; src = a.in[I_AWIN] + (size_t)2048 * 3584; dst = (bf16*)(F.ws + WS_WAIN) + (size_t)2048 * 3584; } else { r -= 3584; N = 2048; src = a.in[I_AWOUT] + (size_t)2048 * 2048; dst = (bf16*)(F.ws + WS_WAOUT) + (size_t)2048 * 2048; } }
        else if (q == 3) { if (r < 2048) { N = 2048; src = a.in[I_BWIN]; dst = (bf16*)(F.ws + WS_WBIN0); } else if ((r -= 2048) < 3072) { N = 3072; src = a.in[I_WKV]; dst = (bf16*)(F.ws + WS_WKV); } else { r -= 3072; N = 2048; src = a.in[I_BWOUT]; dst = (bf16*)(F.ws + WS_WBOUT); } }
        else { if (r < 2048) { N = 2048; src = a.in[I_BWIN] + (size_t)2048 * 2048; dst = (bf16*)(F.ws + WS_WBIN1); } else { r -= 2048; N = 2048; src = a.in[I_BWOUT] + (size_t)2048 * 2048; dst = (bf16*)(F.ws + WS_WBOUT) + (size_t)2048 * 2048; } }
        const int nblk = N / 32, kb = r / nblk, nb = r - kb * nblk;
        transpose_item_fast(src, 2048, N, dst, 32 * nb, scr, 64 * kb, 32 * nb, F.lane);
        return;
    }
    const int L = q >> 1, seg = it >> 14, r0 = it & 16383, e = r0 >> 9, r = r0 & 511, mat = L * 32 + e;
    if (seg < 2) { const int kb = r >> 4, nb = r & 15, n0 = 32 * nb;
        transpose_item_fp8(a.in[seg == 0 ? I_W1 : I_W3] + (size_t)mat * 2048 * 512, 2048, 512, (unsigned char*)(F.ws + WS_W13) + (size_t)mat * 1024 * 2048, (n0 >> 7) * 256 + (n0 & 127) + (seg == 1 ? 128 : 0), scr, 64 * kb, n0, F.lane); }
    else { const int kb = r >> 6, nb = r & 63;
        transpose_item_fp8(a.in[I_W2] + (size_t)mat * 512 * 2048, 512, 2048, (unsigned char*)(F.ws + WS_W2) + (size_t)mat * 512 * 2048, 32 * nb, scr, 64 * kb, 32 * nb, F.lane); }
}
__device__ __forceinline__ void conv_filler(Frame& F, const Args& a, int q0, int n) {
    if (q0 >= NQ || n == 0) return;
    LAS unsigned* bw = (LAS unsigned*)(F.lds + TAB_OFF + 384);
    __syncthreads();
    const bool drain = n < 0; const int per = drain ? 8 : n; int q = q0;
    for (;;) {
        if (F.tid == 0) bw[0] = __hip_atomic_fetch_add(F.ctl + CW_CONV + 64 * q, (unsigned)(8 * per), RLX_AGENT);
        __syncthreads();
        const unsigned idx = bw[0];
        __syncthreads();
        const int qs = conv_qsize(q);
        if (idx >= (unsigned)qs) { if (drain || ++q >= NQ) break; continue; }
#pragma unroll 1
        for (int i = 0; i < per; ++i) { const int it = (int)idx + F.wave * per + i; if (it < qs) conv_item(F, a, q, it); }
        if (!drain) break;
    }
}

#ifndef NCVMAX
#define NCVMAX 32
#endif
#ifndef NCVATT
#define NCVATT 16
#endif
__device__ __forceinline__ int conv_servers(int nu, int G, int fin) {
    if (fin || nu <= 0) return 0;
    const int rounds = (nu + G - 1) / G, gmin = (nu + rounds - 1) / rounds; int n = G - gmin; n = n < NCVMAX ? n : NCVMAX; return n & ~7;
}
__device__ __forceinline__ void conv_done(Frame& F, int p) { __syncthreads(); if (F.tid == 0) __hip_atomic_fetch_add(F.ctl + CW_DONE + 64 * p, 1u, RLX_AGENT); }
__device__ __forceinline__ void conv_server(Frame& F, const Args& a, int p, int q0, int ncomp) {
    int q = q0;
    for (;;) {
        if (q >= NQ) break;
        unsigned idx = 0xffffffffu;
        if (F.lane == 0) { if (__hip_atomic_load(F.ctl + CW_DONE + 64 * p, RLX_AGENT) < (unsigned)ncomp) idx = __hip_atomic_fetch_add(F.ctl + CW_CONV + 64 * q, 2u, RLX_AGENT); }
        idx = (unsigned)__builtin_amdgcn_readfirstlane((int)idx);
        if (idx == 0xffffffffu) break;
        const int qs = conv_qsize(q);
        if (idx >= (unsigned)qs) { ++q; continue; }
        conv_item(F, a, q, (int)idx); if ((int)idx + 1 < qs) conv_item(F, a, q, (int)idx + 1);
    }
}
__device__ __forceinline__ void conv_note_fin(Frame& F, int p) {
    if (blockIdx.x == 0 && F.tid == 0) { unsigned all = 1u;
        for (int q = 0; q < NQ; ++q) all &= (__hip_atomic_load(F.ctl + CW_CONV + 64 * q, RLX_AGENT) >= (unsigned)conv_qsize(q)) ? 1u : 0u;
        __hip_atomic_store(F.ctl + CW_FIN + 64 * p, all, RLX_AGENT); }
}

__device__ __forceinline__ void sgu_unit(Frame& F, const Args& a, int l, int n, int g) {
    constexpr int LDW = 136;
    LAS float* stats = (LAS float*)(F.lds); LAS bf16* Wl = (LAS bf16*)(F.lds + 1024); LAS bf16* Vt = (LAS bf16*)(F.lds + 35840);
    const bf16* z = (const bf16*)(F.ws + WS_Z); bf16* cat = (bf16*)(F.ws + WS_CAT);
    const int tok0 = n * 128;
    for (int i = 0; i < 16; ++i) { const int tk = F.wave * 16 + i; const GAS v4u* rp = (const GAS v4u*)(z + (size_t)(tok0 + tk) * NINA + MIXW) + F.lane;
        v4u w[3]; float s = 0.f;
#pragma unroll
        for (int j = 0; j < 3; ++j) { w[j] = rp[64 * j]; s += (bflo(w[j].x) + bfhi(w[j].x)) + (bflo(w[j].y) + bfhi(w[j].y)) + (bflo(w[j].z) + bfhi(w[j].z)) + (bflo(w[j].w) + bfhi(w[j].w)); }
        const float mean = wave_sum(s) * (1.f / MIXW); float q = 0.f;
#pragma unroll
        for (int j = 0; j < 3; ++j) { float d;
            d = bflo(w[j].x) - mean; q += d * d; d = bfhi(w[j].x) - mean; q += d * d; d = bflo(w[j].y) - mean; q += d * d; d = bfhi(w[j].y) - mean; q += d * d;
            d = bflo(w[j].z) - mean; q += d * d; d = bfhi(w[j].z) - mean; q += d * d; d = bflo(w[j].w) - mean; q += d * d; d = bfhi(w[j].w) - mean; q += d * d; }
        const float rstd = 1.f / sqrtf(wave_sum(q) * (1.f / MIXW) + LN_EPS);
        if (F.lane == 0) { stats[2 * tk] = mean; stats[2 * tk + 1] = rstd; } }
    { const float* wsrc = a.in[I_AWS] + ((size_t)l * 4 + g) * 128 * 128;
      for (int p = F.tid; p < 128 * 32; p += 512) { const int i = p >> 5, j4 = (p & 31) * 4; f32x4 v = *(const GAS f32x4*)(wsrc + i * 128 + j4);
          if ((j4 >> 6) > (i >> 6)) v = (f32x4){0.f, 0.f, 0.f, 0.f};
          v2u o; o.x = pk2(v.x, v.y); o.y = pk2(v.z, v.w); *(LAS v2u*)(Wl + i * LDW + j4) = o; } }
    __syncthreads();
    { const float* lg = a.in[I_ALNG] + (size_t)l * MIXW + g * 384; const float* lb = a.in[I_ALNB] + (size_t)l * MIXW + g * 384;
      for (int p = F.tid; p < 128 * 48; p += 512) { const int j = p & 127, c8 = (p >> 7) * 8;
          const v4u w = *(const GAS v4u*)(z + (size_t)(tok0 + j) * NINA + MIXW + g * 384 + c8);
          const float mean = stats[2 * j], rstd = stats[2 * j + 1];
          const f32x4 g0 = *(const GAS f32x4*)(lg + c8), g1 = *(const GAS f32x4*)(lg + c8 + 4), b0 = *(const GAS f32x4*)(lb + c8), b1 = *(const GAS f32x4*)(lb + c8 + 4);
          float v[8] = {bflo(w.x), bfhi(w.x), bflo(w.y), bfhi(w.y), bflo(w.z), bfhi(w.z), bflo(w.w), bfhi(w.w)};
          const float gg[8] = {g0.x, g0.y, g0.z, g0.w, g1.x, g1.y, g1.z, g1.w}, bb[8] = {b0.x, b0.y, b0.z, b0.w, b1.x, b1.y, b1.z, b1.w};
#pragma unroll
          for (int e = 0; e < 8; ++e) Vt[(c8 + e) * LDW + j] = (bf16)f2bf((v[e] - mean) * rstd * gg[e] + bb[e]); } }
    __syncthreads();
    const int fr = F.lane & 15, fq = F.lane >> 4;
    f32x4 acc[8][3];
#pragma unroll
    for (int mb = 0; mb < 8; ++mb)
#pragma unroll
        for (int nb = 0; nb < 3; ++nb) acc[mb][nb] = (f32x4){0.f, 0.f, 0.f, 0.f};
#pragma unroll
    for (int ks = 0; ks < 4; ++ks) { bf16x8 bfr[3];
#pragma unroll
        for (int nb = 0; nb < 3; ++nb) bfr[nb] = *(const LAS bf16x8*)(Vt + (F.wave * 48 + nb * 16 + fr) * LDW + ks * 32 + fq * 8);
#pragma unroll
        for (int mb = 0; mb < 8; ++mb) { const bf16x8 afr = *(const LAS bf16x8*)(Wl + (mb * 16 + fr) * LDW + ks * 32 + fq * 8);
#pragma unroll
            for (int nb = 0; nb < 3; ++nb) acc[mb][nb] = __builtin_amdgcn_mfma_f32_16x16x32_bf16(bfr[nb], afr, acc[mb][nb], 0, 0, 0); } }
    const float* bs = a.in[I_ABS] + ((size_t)l * 4 + g) * 128;
#pragma unroll
    for (int mb = 0; mb < 8; ++mb) { const int i = mb * 16 + fr; const float bsv = bs[i]; const size_t tk = (size_t)(tok0 + i);
#pragma unroll
        for (int nb = 0; nb < 3; ++nb) { const int c = g * 384 + F.wave * 48 + nb * 16 + 4 * fq;
            const v2u uw = *(const GAS v2u*)(z + tk * NINA + c); const f32x4 gt = acc[mb][nb] + bsv;
            v2u o; o.x = pk2(bflo(uw.x) * gt.x, bfhi(uw.x) * gt.y); o.y = pk2(bflo(uw.y) * gt.z, bfhi(uw.y) * gt.w);
            *(GAS v2u*)(cat + tk * D + c) = o; } }
    __syncthreads();
}

__device__ __forceinline__ void memattn_unit(Frame& F, int l, int hm, int qb, int ldz, int qoff) {
    const bf16* z = (const bf16*)(F.ws + WS_Z); const bf16* kv = (const bf16*)(F.ws + WS_MEMKV) + (size_t)l * 256 * 1024; bf16* cat = (bf16*)(F.ws + WS_CAT);
    att::attn_body<0>(z + (size_t)qb * 256 * ldz + qoff + hm * 128, ldz, kv + hm * 128, kv + 512 + hm * 128, 1024,
                      cat + (size_t)qb * 256 * D + MIXW + hm * 128, nullptr, D, 4, 0, nullptr, 0.f, F.ldsg);
}

__device__ __forceinline__ int t5_bucket(int rel) {
    const int a = rel < 0 ? -rel : rel; int f;
    if (a < 8) f = a; else if (a < 12) f = 8; else if (a < 16) f = 9; else if (a < 23) f = 10; else if (a < 32) f = 11; else if (a < 46) f = 12; else if (a < 64) f = 13; else if (a < 91) f = 14; else f = 15;
    return (rel > 0 ? 16 : 0) + f;
}

namespace att2 {
using att::bf16x8; using att::s16x4; using att::f32x16; using att::u32x4; using att::crow; using att::cvtpk; using att::tr_read; using att::v_rd_base;
constexpr int KT = 32, ST_K = KT * 128 * 2, ST_V = KT * 256 * 2, STAGE = 2 * ST_K + ST_V, NST = 3;
constexpr int LDS_WS = NST * STAGE, LDS_TAB = LDS_WS + 2048, LDS_UNIT = LDS_TAB + 640, LDS_END = LDS_UNIT + 16;
constexpr int NUNITS = 576;
constexpr float THR2 = 8.f * 1.4426950408889634f;
__device__ __forceinline__ int swap23(int k) { return (k & ~0xC) | ((k & 4) << 1) | ((k & 8) >> 1); }
constexpr int v_off(int d0, int ks, int half) { return d0 * 512 + ks * 8192 + half * 4096; }

struct UnitTable { unsigned short u[NUNITS]; };
constexpr UnitTable make_units() {
    UnitTable t{}; int n = 0;
    for (int c = 256; c >= 4; c -= 2) {
        { const int b = (c - 2) / 2; if ((c - 2) % 2 == 0 && b >= 32 && b <= 63) for (int part = 1; part <= 2; ++part) for (int h = 0; h < 6; ++h) t.u[n++] = (unsigned short)(h | (b << 3) | (part << 9)); }
        if (c % 4 == 0) { const int b = c / 4 - 1; if (b >= 0 && b < 32) for (int h = 0; h < 6; ++h) t.u[n++] = (unsigned short)(h | (b << 3)); }
    }
    return t;
}
__device__ const UnitTable g_units = make_units();

__device__ __forceinline__ void diff_unit(const bf16* __restrict__ Q, const bf16* __restrict__ KD, const bf16* __restrict__ VD, float* Obuf  , int orow0,
                                          float* ML  , const float* relb, int h, int b, int t_lo, int t_hi, LAS char* lds) {
  int tid_ = threadIdx.x; asm volatile("" : "+v"(tid_));
  const int tid = tid_, wid = __builtin_amdgcn_readfirstlane(tid >> 6), lane = tid & 63, r32 = lane & 31, hi = lane >> 5, m = wid >> 2, rg = wid & 3;
  LAS float* wsw = (LAS float*)(lds + LDS_WS) + wid * 64; LAS float* li_l = wsw; LAS float* al_l = wsw + 32;
  LAS float* tab = (LAS float*)(lds + LDS_TAB);
  if (tid < att::TAB_N) tab[tid] = relb[t5_bucket(63 - tid) * 6 + h] * LOG2E;
  const float cfar = relb[15 * 6 + h] * LOG2E;
  const int qrow0 = b * 128 + rg * 32;
  bf16x8 qr[8];
  { const bf16* Qw = Q + (size_t)(qrow0 + r32) * 2048 + h * 256 + m * 128 + hi * 8;
#pragma unroll
    for (int d0 = 0; d0 < 8; ++d0) qr[d0] = *reinterpret_cast<const bf16x8*>(Qw + d0 * 16); }
  int ko[2], vo[2];
#pragma unroll
  for (int i = 0; i < 2; ++i) {
    const int p = wid * 64 + lane, row = p >> 4, cp = (p & 15) ^ (row & 7); ko[i] = row * 1536 + h * 256 + i * 128 + cp * 8; }
#pragma unroll
  for (int i = 0; i < 2; ++i) {
    const int p = (wid * 2 + i) * 64 + lane, sub = p >> 5, kg = sub >> 3, cblk = sub & 7, q = p & 31, kk = kg * 8 + (q >> 2), key = swap23(kk);
    vo[i] = key * 1536 + h * 256 + cblk * 32 + (q & 3) * 8; }
  const unsigned ldsb = (unsigned)(uintptr_t)lds;
#define A2_ISSUE(t, s) do { const size_t kb_ = (size_t)(t) * KT * 1536; LAS char* sb_ = lds + (s) * STAGE; \
    __builtin_amdgcn_global_load_lds((const unsigned*)(KD + kb_ + ko[0]), (LAS unsigned*)(sb_ + wid * 1024), 16, 0, 0); \
    __builtin_amdgcn_global_load_lds((const unsigned*)(KD + kb_ + ko[1]), (LAS unsigned*)(sb_ + ST_K + wid * 1024), 16, 0, 0); \
    __builtin_amdgcn_global_load_lds((const unsigned*)(VD + kb_ + vo[0]), (LAS unsigned*)(sb_ + 2 * ST_K + (wid * 2) * 1024), 16, 0, 0); \
    __builtin_amdgcn_global_load_lds((const unsigned*)(VD + kb_ + vo[1]), (LAS unsigned*)(sb_ + 2 * ST_K + (wid * 2 + 1) * 1024), 16, 0, 0); } while (0)
  const int vis = 2 * (2 * b + (rg >> 1) + 1);
  float m_reg = -1e30f, l_reg = 0.f; f32x16 o[8];
#pragma unroll
  for (int d = 0; d < 8; ++d) o[d] = f32x16{};
  asm volatile("s_waitcnt vmcnt(0)" ::: "memory");
  A2_ISSUE(t_lo, 0); if (t_lo + 1 < t_hi) A2_ISSUE(t_lo + 1, 1);
  int s = 0;
  for (int t = t_lo; t < t_hi; ++t) {
    if (t + 1 < t_hi) asm volatile("s_waitcnt vmcnt(4) lgkmcnt(0)" ::: "memory"); else asm volatile("s_waitcnt vmcnt(0) lgkmcnt(0)" ::: "memory");
    __builtin_amdgcn_s_barrier(); asm volatile("" ::: "memory");
    if (t + 2 < t_hi) { const int s2 = (s >= 1) ? s - 1 : s + 2; A2_ISSUE(t + 2, s2); }
    if (t < vis) {
      const LAS char* Ks = lds + s * STAGE + m * ST_K;
      f32x16 p = f32x16{};
#pragma unroll
      for (int d0 = 0; d0 < 8; ++d0) { const int cb = (d0 * 16 + hi * 8) * 2;
        const bf16x8 b0 = *(const LAS bf16x8*)(Ks + KSWZ(r32, cb));
        p = __builtin_amdgcn_mfma_f32_32x32x16_bf16(b0, qr[d0], p, 0, 0, 0); }
      if (qrow0 - (KT * t + KT - 1) >= 91) {
#pragma unroll
        for (int r = 0; r < 16; ++r) p[r] += cfar;
      } else { const int base = qrow0 + r32 - KT * t + 63;
#pragma unroll
        for (int r = 0; r < 16; ++r) { const int i0 = base - crow(r, hi); p[r] += tab[i0 < att::TAB_N - 1 ? i0 : att::TAB_N - 1]; } }
      float pmax = p[0];
#pragma unroll
      for (int r = 1; r < 16; ++r) pmax = fmaxf(pmax, p[r]);
      { auto rr = __builtin_amdgcn_permlane32_swap(__float_as_uint(pmax), __float_as_uint(pmax), false, false); pmax = fmaxf(__uint_as_float(rr[0]), __uint_as_float(rr[1])); }
      float mn, alpha;
      if (__builtin_expect(__all(pmax - m_reg <= THR2), 1)) { mn = m_reg; alpha = 1.f; }
      else { mn = fmaxf(m_reg, pmax); alpha = __builtin_amdgcn_exp2f(m_reg - mn); m_reg = mn; }
      float ps = 0.f;
#pragma unroll
      for (int r = 0; r < 16; ++r) { p[r] = __builtin_amdgcn_exp2f(p[r] - mn); ps += p[r]; }
      { auto rr = __builtin_amdgcn_permlane32_swap(__float_as_uint(ps), __float_as_uint(ps), false, false); ps = __uint_as_float(rr[0]) + __uint_as_float(rr[1]); }
      l_reg = l_reg * alpha + ps;
      bf16x8 pa0, pa1;
#define A2_PK4(P, BASE, OUT) do { unsigned a0 = cvtpk(P[BASE + 0], P[BASE + 1]), a1 = cvtpk(P[BASE + 2], P[BASE + 3]);   \
    unsigned b0_ = cvtpk(P[BASE + 4], P[BASE + 5]), b1_ = cvtpk(P[BASE + 6], P[BASE + 7]);                              \
    auto r0 = __builtin_amdgcn_permlane32_swap(a0, b0_, false, false); auto r1 = __builtin_amdgcn_permlane32_swap(a1, b1_, false, false); \
    u32x4 w = {r0[0], r1[0], r0[1], r1[1]}; OUT = *reinterpret_cast<bf16x8*>(&w); } while (0)
      A2_PK4(p, 0, pa0); A2_PK4(p, 8, pa1);
      if (__any(alpha < 1.f)) { if (hi == 0) al_l[r32] = alpha; asm volatile("s_waitcnt lgkmcnt(0)" ::: "memory");
#pragma unroll
        for (int d = 0; d < 8; ++d)
#pragma unroll
          for (int r = 0; r < 16; ++r) o[d][r] *= al_l[crow(r, hi)]; }
      const int vb = (int)(ldsb + s * STAGE + 2 * ST_K) + v_rd_base(lane);
      asm volatile("s_waitcnt lgkmcnt(0)" ::: "memory"); SBAR();
#define A2_PK(L, H) (bf16x8){L[0], L[1], L[2], L[3], H[0], H[1], H[2], H[3]}
#define A2_RD(D0, l0, h0, l1, h1) do { l0 = tr_read<v_off(D0, 0, 0)>(vb); h0 = tr_read<v_off(D0, 0, 1)>(vb); l1 = tr_read<v_off(D0, 1, 0)>(vb); h1 = tr_read<v_off(D0, 1, 1)>(vb); } while (0)
#define A2_MM(D0, l0, h0, l1, h1) do { o[D0] = __builtin_amdgcn_mfma_f32_32x32x16_bf16(pa0, A2_PK(l0, h0), o[D0], 0, 0, 0); o[D0] = __builtin_amdgcn_mfma_f32_32x32x16_bf16(pa1, A2_PK(l1, h1), o[D0], 0, 0, 0); } while (0)
      s16x4 xl0, xh0, xl1, xh1, yl0, yh0, yl1, yh1;
      A2_RD(0, xl0, xh0, xl1, xh1);
      A2_RD(1, yl0, yh0, yl1, yh1); asm volatile("s_waitcnt lgkmcnt(4)" ::: "memory"); SBAR(); A2_MM(0, xl0, xh0, xl1, xh1); SBAR();
      A2_RD(2, xl0, xh0, xl1, xh1); asm volatile("s_waitcnt lgkmcnt(4)" ::: "memory"); SBAR(); A2_MM(1, yl0, yh0, yl1, yh1); SBAR();
      A2_RD(3, yl0, yh0, yl1, yh1); asm volatile("s_waitcnt lgkmcnt(4)" ::: "memory"); SBAR(); A2_MM(2, xl0, xh0, xl1, xh1); SBAR();
      A2_RD(4, xl0, xh0, xl1, xh1); asm volatile("s_waitcnt lgkmcnt(4)" ::: "memory"); SBAR(); A2_MM(3, yl0, yh0, yl1, yh1); SBAR();
      A2_RD(5, yl0, yh0, yl1, yh1); asm volatile("s_waitcnt lgkmcnt(4)" ::: "memory"); SBAR(); A2_MM(4, xl0, xh0, xl1, xh1); SBAR();
      A2_RD(6, xl0, xh0, xl1, xh1); asm volatile("s_waitcnt lgkmcnt(4)" ::: "memory"); SBAR(); A2_MM(5, yl0, yh0, yl1, yh1); SBAR();
      A2_RD(7, yl0, yh0, yl1, yh1); asm volatile("s_waitcnt lgkmcnt(4)" ::: "memory"); SBAR(); A2_MM(6, xl0, xh0, xl1, xh1); SBAR();
      asm volatile("s_waitcnt lgkmcnt(0)" ::: "memory"); SBAR(); A2_MM(7, yl0, yh0, yl1, yh1); SBAR();
    }
    s = (s == 2) ? 0 : s + 1;
  }
  if (hi == 0) li_l[r32] = l_reg; asm volatile("s_waitcnt lgkmcnt(0)" ::: "memory");
  float rli[16];
#pragma unroll
  for (int r = 0; r < 16; ++r) rli[r] = __builtin_amdgcn_rcpf(li_l[crow(r, hi)]);
  float* Ow = Obuf + (size_t)(qrow0 - orow0) * 3072 + (h * 2 + m) * 256;
#pragma unroll
  for (int r = 0; r < 16; ++r) { const int orow = crow(r, hi);
#pragma unroll
    for (int d0 = 0; d0 < 8; ++d0) Ow[(size_t)orow * 3072 + d0 * 32 + r32] = o[d0][r] * rli[r]; }
  if (hi == 0) { float* mlp = ML + (((size_t)(qrow0 - orow0 + r32) * 6 + h) * 2 + m) * 2; mlp[0] = m_reg; mlp[1] = l_reg; }
  asm volatile("s_waitcnt vmcnt(0) lgkmcnt(0)" ::: "memory");
  __builtin_amdgcn_s_barrier(); asm volatile("" ::: "memory");
#undef A2_ISSUE
#undef A2_PK4
#undef A2_PK
#undef A2_RD
#undef A2_MM
}
}

__device__ __forceinline__ void diffattn2_unit(Frame& F, const Args& a, unsigned code) {
    const int h = code & 7, b = (code >> 3) & 63, pc = code >> 9, nt = 4 * b + 4;
    const int t_lo = (pc == 2) ? nt / 2 : 0, t_hi = (pc == 1) ? nt / 2 : nt;
    float* ob = (float*)(F.ws + (pc == 2 ? WS_OP2 : WS_OP)); float* ml = (float*)(F.ws + WS_ML) + (pc == 2 ? (size_t)T * 6 * 2 * 2 : 0);
    att2::diff_unit((const bf16*)(F.ws + WS_Z), (const bf16*)(F.ws + WS_KD), (const bf16*)(F.ws + WS_VD), ob, pc == 2 ? 4096 : 0, ml, a.in[I_RELB], h, b, t_lo, t_hi, (LAS char*)F.lds);
}
__device__ __forceinline__ void diffcombine_phase(Frame& F, const Args& a, int l) {
    const int i = l - 2; const float* lp = a.in[I_BLAM] + (size_t)i * 4 * 128;
    float s1 = lp[F.lane] * lp[128 + F.lane] + lp[64 + F.lane] * lp[128 + 64 + F.lane], s2 = lp[256 + F.lane] * lp[384 + F.lane] + lp[256 + 64 + F.lane] * lp[384 + 64 + F.lane];
    s1 = wave_sum(s1); s2 = wave_sum(s2);
    const float lam_init = 0.8f - 0.6f * expf(-0.3f * (float)l);
    const float lam = expf(s1) - expf(s2) + lam_init;
    const float* op0 = (const float*)(F.ws + WS_OP); const float* op1 = (const float*)(F.ws + WS_OP2); const float* ml0 = (const float*)(F.ws + WS_ML); const float* ml1 = ml0 + (size_t)T * 6 * 2 * 2;
    bf16* cat = (bf16*)(F.ws + WS_CAT);
    const f32x4 gsub = *(const GAS f32x4*)(a.in[I_BSUBG] + (size_t)i * 256 + 4 * F.lane);
    const int gw = F.c * NWAVES + F.wave, NGW = F.G * NWAVES;
    for (int it = gw; it < T * 6; it += NGW) { const int tk = it / 6, h = it - tk * 6; f32x4 os[2];
#pragma unroll
        for (int m = 0; m < 2; ++m) { const size_t r0 = ((size_t)tk * 6 + h) * 2 + m; f32x4 oa = *(const GAS f32x4*)(op0 + r0 * 256 + 4 * F.lane);
            if (tk >= 4096) { const size_t r1 = ((size_t)(tk - 4096) * 6 + h) * 2 + m; const f32x4 ob = *(const GAS f32x4*)(op1 + r1 * 256 + 4 * F.lane);
                const float ma = ml0[r0 * 2], la = ml0[r0 * 2 + 1], mb = ml1[r1 * 2], lb = ml1[r1 * 2 + 1], M = fmaxf(ma, mb);
                const float wa = la * exp2f(ma - M), wb = lb * exp2f(mb - M), inv = 1.f / (wa + wb); oa = oa * (wa * inv) + ob * (wb * inv); }
            os[m] = oa; }
        const f32x4 o = os[0] - os[1] * lam; const float ss = wave_sum((o.x * o.x + o.y * o.y) + (o.z * o.z + o.w * o.w));
        const float r = (1.f - lam_init) / sqrtf(ss * (1.f / 256.f) + LN_EPS);
        v2u w; w.x = pk2(o.x * r * gsub.x, o.y * r * gsub.y); w.y = pk2(o.z * r * gsub.z, o.w * r * gsub.w);
        *(GAS v2u*)(cat + (size_t)tk * D + h * 256 + 4 * F.lane) = w; }
}


__device__ __forceinline__ void ln1_router_phase(Frame& F, const Args& a, int l, int probe = 0) {
    const bf16* y = (const bf16*)(F.ws + WS_Y); bf16* x1b = (bf16*)(F.ws + WS_X1B);
    const float* lng = a.in[I_LNG] + ((size_t)l * 2 + 0) * D; const float* lnb = a.in[I_LNB] + ((size_t)l * 2 + 0) * D;
    const float* wr = (const float*)(F.ws + WS_WR) + (size_t)l * 3 * 512 * 16 * 4;
    int* tok_e = (int*)(F.ws + (probe ? WS_OP : WS_ROUTE)); int* tok_rank = tok_e + 2 * T; float* tok_gate = (float*)(tok_rank + 2 * T);
    gu32* cnt = F.ctl + (probe ? 65536 : CW_CNT) + 2048 * l;
    LAS float* P = (LAS float*)(F.lds);
    typedef float f32x4v __attribute__((ext_vector_type(4)));
    for (int tb = F.c; tb < T / 32; tb += F.G) {
#pragma unroll 2
        for (int i = 0; i < 4; ++i) { const int tk = tb * 32 + F.wave * 4 + i;
            const GAS v4u* yr = (const GAS v4u*)(y + (size_t)tk * D) + F.lane;
            float v[4][8]; float s = 0.f;
#pragma unroll
            for (int j = 0; j < 4; ++j) { const v4u w = yr[64 * j]; v[j][0] = bflo(w.x); v[j][1] = bfhi(w.x); v[j][2] = bflo(w.y); v[j][3] = bfhi(w.y); v[j][4] = bflo(w.z); v[j][5] = bfhi(w.z); v[j][6] = bflo(w.w); v[j][7] = bfhi(w.w);
#pragma unroll
                for (int e = 0; e < 8; ++e) s += v[j][e]; }
            const float mean = wave_sum(s) * (1.f / D); float s2 = 0.f;
#pragma unroll
            for (int j = 0; j < 4; ++j)
#pragma unroll
                for (int e = 0; e < 8; ++e) { v[j][e] -= mean; s2 += v[j][e] * v[j][e]; }
            const float rstd = 1.f / sqrtf(wave_sum(s2) * (1.f / D) + LN_EPS);
#pragma unroll
            for (int j = 0; j < 4; ++j) { const int d0 = 8 * F.lane + 512 * j; const f32x4 g0 = *(const GAS f32x4*)(lng + d0), g1 = *(const GAS f32x4*)(lng + d0 + 4), b0 = *(const GAS f32x4*)(lnb + d0), b1 = *(const GAS f32x4*)(lnb + d0 + 4);
                const float q0 = v[j][0] * rstd * g0.x + b0.x, q1 = v[j][1] * rstd * g0.y + b0.y, q2 = v[j][2] * rstd * g0.z + b0.z, q3 = v[j][3] * rstd * g0.w + b0.w;
                const float q4 = v[j][4] * rstd * g1.x + b1.x, q5 = v[j][5] * rstd * g1.y + b1.y, q6 = v[j][6] * rstd * g1.z + b1.z, q7 = v[j][7] * rstd * g1.w + b1.w;
                v4u w; w.x = pk2(q0, q1); w.y = pk2(q2, q3); w.z = pk2(q4, q5); w.w = pk2(q6, q7);
                *(GAS v4u*)(x1b + (size_t)tk * D + d0) = w;
                unsigned lo = 0u, hi = 0u; lo = __builtin_amdgcn_cvt_pk_fp8_f32(q0, q1, lo, false); lo = __builtin_amdgcn_cvt_pk_fp8_f32(q2, q3, lo, true);
                hi = __builtin_amdgcn_cvt_pk_fp8_f32(q4, q5, hi, false); hi = __builtin_amdgcn_cvt_pk_fp8_f32(q6, q7, hi, true);
                v2u qq; qq.x = lo; qq.y = hi; *(GAS v2u*)((unsigned char*)(F.ws + WS_X1F) + (size_t)tk * D + d0) = qq; } }
        VM_WAIT(); __syncthreads();
        { const int mt = F.wave >> 2, kq = F.wave & 3, c = F.lane & 15, q = F.lane >> 4;
          const bf16* ap = x1b + (size_t)(tb * 32 + mt * 16 + c) * D + kq * 512 + 4 * q;
          const float* bp = wr + ((size_t)(kq * 128 + q) * 16 + c) * 4;
          f32x4v acc[3] = {{0.f, 0.f, 0.f, 0.f}, {0.f, 0.f, 0.f, 0.f}, {0.f, 0.f, 0.f, 0.f}};
#pragma unroll 4
          for (int ks = 0; ks < 32; ++ks) { const v2u aw = *(const GAS v2u*)(ap + 16 * ks); const f32x4 a4 = (f32x4){bflo(aw.x), bfhi(aw.x), bflo(aw.y), bfhi(aw.y)}; f32x4 b4[3];
#pragma unroll
              for (int nb = 0; nb < 3; ++nb) b4[nb] = *(const GAS f32x4*)(bp + ((size_t)nb * 512 + 4 * ks) * 64);
#pragma unroll
              for (int j = 0; j < 4; ++j)
#pragma unroll
                  for (int nb = 0; nb < 3; ++nb) acc[nb] = __builtin_amdgcn_mfma_f32_16x16x4f32(a4[j], b4[nb][j], acc[nb], 0, 0, 0); }
#pragma unroll
          for (int nb = 0; nb < 3; ++nb)
#pragma unroll
              for (int r = 0; r < 4; ++r) P[((kq * 2 + mt) * 16 + 4 * q + r) * 48 + nb * 16 + c] = acc[nb][r]; }
        __syncthreads();
        if (F.tid < 32) { const int tk = tb * 32 + F.tid, mt = F.tid >> 4, ti = F.tid & 15;
            const LAS f32x4* P4 = (const LAS f32x4*)P;
            const int rb = (mt * 16 + ti) * 12;
            const float* bg1 = a.in[I_BG1] + l * 4; const float* bg2 = a.in[I_BG2] + l * 32;
            const f32x4 s1 = (P4[rb] + P4[rb + 384]) + (P4[rb + 768] + P4[rb + 1152]);
            const float l10 = s1.x + bg1[0], l11 = s1.y + bg1[1], l12 = s1.z + bg1[2], l13 = s1.w + bg1[3];
            int grp = 0; float mx = l10;
            if (l11 > mx) { mx = l11; grp = 1; } if (l12 > mx) { mx = l12; grp = 2; } if (l13 > mx) { mx = l13; grp = 3; }
            const float psel = 1.f / (expf(l10 - mx) + expf(l11 - mx) + expf(l12 - mx) + expf(l13 - mx));
            const int ob = rb + 1 + 2 * grp;
            const f32x4 sa = (P4[ob] + P4[ob + 384]) + (P4[ob + 768] + P4[ob + 1152]), sb = (P4[ob + 1] + P4[ob + 385]) + (P4[ob + 769] + P4[ob + 1153]);
            const f32x4 ba = *(const GAS f32x4*)(bg2 + grp * 8), bb = *(const GAS f32x4*)(bg2 + grp * 8 + 4);
            const float l2[8] = {sa.x + ba.x, sa.y + ba.y, sa.z + ba.z, sa.w + ba.w, sb.x + bb.x, sb.y + bb.y, sb.z + bb.z, sb.w + bb.w};
            int i0 = 0; float v0 = l2[0];
#pragma unroll
            for (int e = 1; e < 8; ++e) if (l2[e] > v0) { v0 = l2[e]; i0 = e; }
            int i1 = -1; float v1 = -INFINITY;
#pragma unroll
            for (int e = 0; e < 8; ++e) if (e != i0 && l2[e] > v1) { v1 = l2[e]; i1 = e; }
            const float e1 = expf(v1 - v0), g0 = psel / (1.f + e1), g1 = psel * e1 / (1.f + e1);
            const int ex0 = grp * 8 + i0, ex1 = grp * 8 + i1;
            const unsigned r0 = __hip_atomic_fetch_add(cnt + 64 * ex0, 1u, RLX_AGENT), r1 = __hip_atomic_fetch_add(cnt + 64 * ex1, 1u, RLX_AGENT);
            { int* list = (int*)(F.ws + (probe ? WS_OP + 2 * MiB : WS_LIST)); list[ex0 * 8192 + (int)r0] = tk; list[ex1 * 8192 + (int)r1] = tk; }
            tok_e[2 * tk] = ex0; tok_e[2 * tk + 1] = ex1; tok_rank[2 * tk] = (int)r0; tok_rank[2 * tk + 1] = (int)r1; tok_gate[2 * tk] = g0; tok_gate[2 * tk + 1] = g1; }
        __syncthreads();
    }
}
__device__ __forceinline__ void moe_table(Frame& F, int l) {
    LAS int* tstart = (LAS int*)(F.lds + TAB_OFF);
    if (F.tid == 0) { int acc = 0;
        for (int e = 0; e < 32; ++e) { tstart[e] = acc; const unsigned c = __hip_atomic_load(F.ctl + CW_CNT + 2048 * l + 64 * e, RLX_AGENT); tstart[36 + e] = (int)c; acc += (int)((c + 255u) >> 8); }
        tstart[32] = acc; }
    __syncthreads();
}
__device__ __forceinline__ void ln2_phase(Frame& F, const Args& a, int l) {
    const bf16* x1b = (const bf16*)(F.ws + WS_X1B); const bf16* yb = (const bf16*)(F.ws + WS_YB); bf16* xb = (bf16*)(F.ws + WS_XB);
    const float* lng = a.in[I_LNG] + ((size_t)l * 2 + 1) * D; const float* lnb = a.in[I_LNB] + ((size_t)l * 2 + 1) * D;
    moe_table(F, l); const LAS int* tstart = (const LAS int*)(F.lds + TAB_OFF);
    const int* tok_e = (const int*)(F.ws + WS_ROUTE); const int* tok_rank = tok_e + 2 * T; const float* tok_gate = (const float*)(F.ws + WS_ROUTE) + 4 * T;
    const int gw = F.c * NWAVES + F.wave, NGW = F.G * NWAVES;
    for (int t4 = gw; t4 < T / 4; t4 += NGW) { const int tk0 = t4 * 4;
        int ev = 0, rv = 0; float gv = 0.f;
        if (F.lane < 8) { ev = tok_e[2 * tk0 + F.lane]; rv = tok_rank[2 * tk0 + F.lane]; gv = tok_gate[2 * tk0 + F.lane]; }
        const int slotv = (F.lane < 8) ? tstart[ev] * 256 + rv : 0;
        v4u xr[2], ya[2], yc[2]; v4u xr2[2], ya2[2], yc2[2];
#define LN2_LOAD(i, XR, YA, YC, XR2, YA2, YC2) do { const int s0_ = __builtin_amdgcn_readlane(slotv, 2 * (i)), s1_ = __builtin_amdgcn_readlane(slotv, 2 * (i) + 1); \
        _Pragma("unroll") for (int j = 0; j < 2; ++j) { const int d0 = 8 * F.lane + 512 * j; XR[j] = *(const GAS v4u*)(x1b + (size_t)(tk0 + (i)) * D + d0); YA[j] = *(const GAS v4u*)(yb + (size_t)s0_ * D + d0); YC[j] = *(const GAS v4u*)(yb + (size_t)s1_ * D + d0); } \
        _Pragma("unroll") for (int j = 0; j < 2; ++j) { const int d0 = 8 * F.lane + 512 * (j + 2); XR2[j] = *(const GAS v4u*)(x1b + (size_t)(tk0 + (i)) * D + d0); YA2[j] = *(const GAS v4u*)(yb + (size_t)s0_ * D + d0); YC2[j] = *(const GAS v4u*)(yb + (size_t)s1_ * D + d0); } } while (0)
        LN2_LOAD(0, xr, ya, yc, xr2, ya2, yc2);
#pragma unroll
        for (int i = 0; i < 4; ++i) { const int tk = tk0 + i;
            const float g0 = __builtin_bit_cast(float, __builtin_amdgcn_readlane(__builtin_bit_cast(int, gv), 2 * i)), g1 = __builtin_bit_cast(float, __builtin_amdgcn_readlane(__builtin_bit_cast(int, gv), 2 * i + 1));
            float v[4][8]; float s = 0.f;
#pragma unroll
            for (int j = 0; j < 4; ++j) { const v4u X = j < 2 ? xr[j] : xr2[j - 2], A = j < 2 ? ya[j] : ya2[j - 2], C = j < 2 ? yc[j] : yc2[j - 2];
                v[j][0] = bflo(X.x) * DN_ALPHA + (g0 * bflo(A.x) + g1 * bflo(C.x)); v[j][1] = bfhi(X.x) * DN_ALPHA + (g0 * bfhi(A.x) + g1 * bfhi(C.x));
                v[j][2] = bflo(X.y) * DN_ALPHA + (g0 * bflo(A.y) + g1 * bflo(C.y)); v[j][3] = bfhi(X.y) * DN_ALPHA + (g0 * bfhi(A.y) + g1 * bfhi(C.y));
                v[j][4] = bflo(X.z) * DN_ALPHA + (g0 * bflo(A.z) + g1 * bflo(C.z)); v[j][5] = bfhi(X.z) * DN_ALPHA + (g0 * bfhi(A.z) + g1 * bfhi(C.z));
                v[j][6] = bflo(X.w) * DN_ALPHA + (g0 * bflo(A.w) + g1 * bflo(C.w)); v[j][7] = bfhi(X.w) * DN_ALPHA + (g0 * bfhi(A.w) + g1 * bfhi(C.w));
#pragma unroll
                for (int e = 0; e < 8; ++e) s += v[j][e]; }
            if (i + 1 < 4) LN2_LOAD(i + 1, xr, ya, yc, xr2, ya2, yc2);
            const float mean = wave_sum(s) * (1.f / D); float s2 = 0.f;
#pragma unroll
            for (int j = 0; j < 4; ++j)
#pragma unroll
                for (int e = 0; e < 8; ++e) { v[j][e] -= mean; s2 += v[j][e] * v[j][e]; }
            const float rstd = 1.f / sqrtf(wave_sum(s2) * (1.f / D) + LN_EPS);
#pragma unroll
            for (int j = 0; j < 4; ++j) { const int d0 = 8 * F.lane + 512 * j; const f32x4 g0v = *(const GAS f32x4*)(lng + d0), g1v = *(const GAS f32x4*)(lng + d0 + 4), b0 = *(const GAS f32x4*)(lnb + d0), b1 = *(const GAS f32x4*)(lnb + d0 + 4);
                const f32x4 oa = (f32x4){v[j][0] * rstd * g0v.x + b0.x, v[j][1] * rstd * g0v.y + b0.y, v[j][2] * rstd * g0v.z + b0.z, v[j][3] * rstd * g0v.w + b0.w};
                const f32x4 ob = (f32x4){v[j][4] * rstd * g1v.x + b1.x, v[j][5] * rstd * g1v.y + b1.y, v[j][6] * rstd * g1v.z + b1.z, v[j][7] * rstd * g1v.w + b1.w};
                if (l == DEPTH - 1) { *(GAS f32x4*)(a.out + (size_t)tk * D + d0) = oa; *(GAS f32x4*)(a.out + (size_t)tk * D + d0 + 4) = ob; }
                else { v4u w; w.x = pk2(oa.x, oa.y); w.y = pk2(oa.z, oa.w); w.z = pk2(ob.x, ob.y); w.w = pk2(ob.z, ob.w); *(GAS v4u*)(xb + (size_t)tk * D + d0) = w; } }
        }
#undef LN2_LOAD
    }
}

__global__ void __launch_bounds__(NWAVES * 64, 2) fwd_kernel(Args args) {
    extern __shared__ __attribute__((aligned(16))) unsigned char lds[];
    Frame F;
    F.lds = (LAS unsigned char*)lds; F.ldsg = (char*)lds;
    F.tid = threadIdx.x; F.lane = F.tid & 63; F.wave = __builtin_amdgcn_readfirstlane(F.tid >> 6);
    F.G = gridDim.x; F.c = blockIdx.x; F.ws = args.ws; F.ctl = (gu32*)(args.ws + WS_CTL);
    volatile LAS unsigned* MISC = (volatile LAS unsigned*)(F.lds + MISC_OFF);
    for (int u = F.tid; u < (LDS_BYTES - LDSCTL_OFF) / 4; u += NWAVES * 64) ((LAS unsigned*)(F.lds + LDSCTL_OFF))[u] = 0u;
    __syncthreads();
    const int lo = args.ph_lo, hi = args.ph_hi; int lastp = -1;
    const bool multi = (hi - lo) > 1;
    XcdBarrier bar; bar.bar = (unsigned*)(F.ctl + CW_BAR); bar.x = 0; bar.st = nullptr;
    if (multi) bar = xcd_barrier_post((unsigned*)(F.ctl + CW_BAR), MISC + 8);
#ifndef REP_MASK
#define REP_MASK 0
#endif
#define REP(k) for (int rep_ = 0; rep_ <= ((REP_MASK >> (k)) & 1); ++rep_)
#define IN(p) (lo <= (p) && (p) < hi)
#ifdef PROBE_A
#define STAMP(i) do { if (blockIdx.x == 0 && threadIdx.x == 0) ((unsigned long long*)(args.ws + WS_TS))[(i)] = __builtin_amdgcn_s_memrealtime(); } while (0)
#else
#define STAMP(i) do { } while (0)
#endif
#define SEAM(p) do { conv_note_fin(F, (p)); lastp = (p); if ((p) + 1 < hi) xcd_barrier(bar); STAMP((p) + 1); } while (0)
#define CONVFIN() ((lastp >= 0) ? (int)__hip_atomic_load(F.ctl + CW_FIN + 64 * lastp, RLX_AGENT) : 0)
#define FRESH() do { int t_ = threadIdx.x; asm volatile("" : "+v"(t_)); F.tid = t_; F.lane = t_ & 63; F.wave = __builtin_amdgcn_readfirstlane(t_ >> 6); \
    GAS unsigned char* w_ = (GAS unsigned char*)args.ws; asm volatile("" : "+s"(w_)); F.ws = (unsigned char*)w_; F.ctl = (gu32*)(w_ + WS_CTL); } while (0)

    STAMP(0);
    if (IN(0)) { FRESH(); REP(9) prologue_phase(F, args); SEAM(0); }
#ifdef XBAR
    for (int xb_ = 0; xb_ < XBAR; ++xb_) xcd_barrier(bar);
#endif

    for (int l = 0; l < DEPTH; ++l) {
        const int pb = 1 + NPH_LAYER * l;
        if (IN(pb + 0)) { FRESH();
            const int N = (l < 2) ? NINA : (l == 2 ? 5120 : 2048);
            const unsigned char* Bt = F.ws + ((l < 2) ? WS_WAIN + (size_t)l * NINA * D * 2 : (l == 2 ? WS_WBIN0 : WS_WBIN1));
            const int nu = (T / 256) * (N / 256) + (l == 0 ? 16 : 0), ncv = conv_servers(nu, F.G, CONVFIN()), Gc = F.G - ncv;
            if (F.c < Gc) {
                pg8::Gemm g{nullptr, nullptr, T, N, D}; pg8::DualOrder S; S.init(F.ws + WS_XB, Bt, T, N, D, Gc, F.c, F.ws + WS_MEMB, F.ws + WS_WMKV, l == 0 ? 16 : 0);
                pg8::EpiBf16X E{l < 2 ? 0 : 1, (bf16*)(F.ws + WS_Z), (bf16*)(F.ws + WS_KD), (bf16*)(F.ws + WS_VD), (bf16*)(F.ws + WS_MEMKV), nullptr, nullptr};
                REP(0) pg8::gemm_phase<pg8::EpiBf16X, pg8::DualOrder, true, true>(F.lds + RING_OFF, g, S, E);
                if (ncv) conv_done(F, pb + 0);
                { const int mine = (nu - 1 - F.c) / Gc + 1, rounds = (nu + Gc - 1) / Gc; conv_filler(F, args, 2 * l, (rounds - mine) * QA); }
            } else conv_server(F, args, pb + 0, 2 * l, Gc);
            SEAM(pb + 0);
        }
        if (IN(pb + 1)) { FRESH();
            if (l < 2) {
                REP(1) for (int u = F.c; u < 256 + 128; u += F.G) {
                    if (u < 256) sgu_unit(F, args, l, u >> 2, u & 3);
                    else { const int r = u - 256; memattn_unit(F, l, r & 3, r >> 2, NINA, 2 * MIXW); }
                }
            } else {
                const int ncv = CONVFIN() ? 0 : NCVATT, Gc = F.G - ncv;
                if (F.c >= Gc) conv_server(F, args, pb + 1, 2 * l, Gc); else
                REP(2) { gu32* qh = F.ctl + CW_Q + 64 * l + 16 * rep_; LAS unsigned* uw = (LAS unsigned*)(F.lds + att2::LDS_UNIT);
                for (;;) {
                    if (F.tid == 0) *uw = __hip_atomic_fetch_add(qh, 1u, RLX_AGENT);
                    __syncthreads();
                    const unsigned idx = *uw;
                    __syncthreads();
                    if (idx >= (unsigned)(att2::NUNITS + 128)) break;
                    if (idx < (unsigned)att2::NUNITS) diffattn2_unit(F, args, att2::g_units.u[idx]);
                    else { const int r = (int)idx - att2::NUNITS; memattn_unit(F, l, r & 3, r >> 2, 2048, MIXW); }
                } }
                if (ncv && F.c < Gc) conv_done(F, pb + 1);
            }
            SEAM(pb + 1);
        }
        if (IN(pb + 2) && l >= 2) { FRESH(); REP(3) diffcombine_phase(F, args, l); SEAM(pb + 2); }
        if (IN(pb + 3)) { FRESH();
            pg8::Gemm g{nullptr, nullptr, T, D, D}; pg8::DenseOrder S; S.init(F.ws + WS_CAT, F.ws + (l < 2 ? WS_WAOUT + (size_t)l * D * D * 2 : WS_WBOUT + (size_t)(l - 2) * D * D * 2), T, D, D, F.G, F.c);
            pg8::EpiResBf16 E{(const bf16*)(F.ws + WS_XB), (bf16*)(F.ws + WS_Y), DN_ALPHA};
            REP(4) pg8::gemm_phase<pg8::EpiResBf16, pg8::DenseOrder, true, true>(F.lds + RING_OFF, g, S, E);
            SEAM(pb + 3);
        }
        if (IN(pb + 4)) { FRESH(); ln1_router_phase(F, args, l);
#ifdef REP_LN1
            ln1_router_phase(F, args, l, 1);
#endif
            conv_filler(F, args, 2 * l, -1); SEAM(pb + 4); }
        if (IN(pb + 6)) { FRESH();
            moe_table(F, l);
            const LAS int* tb = (const LAS int*)(F.lds + TAB_OFF);
            const int nu = tb[32] * 4, ncv = conv_servers(nu, F.G, CONVFIN()), Gc = F.G - ncv;
            if (F.c < Gc) {
                pg8::Gemm g{nullptr, nullptr, SLOTS, 1024, D / 2};
                pg8::MoeGatherOrder S{tb, tb + 36, (const int*)(F.ws + WS_LIST), 4, Gc, F.c, (const char*)(F.ws + WS_X1F), (const char*)(F.ws + WS_W13) + (size_t)l * NE * 1024 * 2048, (size_t)1024 * 2048, (size_t)256 * 2048, (unsigned)D};
                pg8::EpiMoe1 E{(bf16*)(F.ws + WS_H), tb, tb + 36};
                REP(6) pg8::gemm_phase<pg8::EpiMoe1, pg8::MoeGatherOrder, true, true>(F.lds + RING_OFF, g, S, E);
                if (ncv) conv_done(F, pb + 6);
                { const int mine = (F.c < nu) ? (nu - 1 - F.c) / Gc + 1 : 0, rounds = (nu + Gc - 1) / Gc; conv_filler(F, args, 2 * l + 1, (rounds - mine) * QM); }
            } else conv_server(F, args, pb + 6, 2 * l + 1, Gc);
            SEAM(pb + 6);
        }
        if (IN(pb + 7)) { FRESH();
            moe_table(F, l);
            const int nu = ((const LAS int*)(F.lds + TAB_OFF))[32] * 8, ncv = conv_servers(nu, F.G, CONVFIN()), Gc = F.G - ncv;
            if (F.c < Gc) {
                pg8::Gemm g{nullptr, nullptr, SLOTS, D, FF / 2};
                pg8::MoeOrder8 S{(const PG8_LAS int*)(F.lds + TAB_OFF), 8, Gc, F.c, (const char*)(F.ws + WS_H), (const char*)(F.ws + WS_W2) + (size_t)l * NE * 2048 * 512, (size_t)256 * FF, (size_t)2048 * 512, (size_t)256 * 512};
                pg8::EpiBf16X E{3, (bf16*)(F.ws + WS_YB), nullptr, nullptr, nullptr, (const PG8_LAS int*)(F.lds + TAB_OFF), (const PG8_LAS int*)(F.lds + TAB_OFF) + 36};
                REP(7) pg8::gemm_phase<pg8::EpiBf16X, pg8::MoeOrder8, true, true>(F.lds + RING_OFF, g, S, E);
                if (ncv) conv_done(F, pb + 7);
                { const int mine = (F.c < nu) ? (nu - 1 - F.c) / Gc + 1 : 0, rounds = (nu + Gc - 1) / Gc; conv_filler(F, args, 2 * l + 1, (rounds - mine) * QB); }
            } else conv_server(F, args, pb + 7, 2 * l + 1, Gc);
            SEAM(pb + 7);
        }
        if (IN(pb + 8)) { FRESH(); REP(8) ln2_phase(F, args, l); conv_filler(F, args, 2 * l + 1, -1); SEAM(pb + 8); }
    }
#ifdef PROBE_A
    {
        VM_WAIT(); xcd_barrier(bar);
        const unsigned long long* ts = (const unsigned long long*)(args.ws + WS_TS);
        float da = 0.f, db = 0.f;
        for (int p = 0; p < NPHASES; ++p) { const int k = (p == 0) ? 9 : (p - 1) % NPH_LAYER; const float d = (float)(ts[p + 1] - ts[p]);
            if (k == PROBE_A || PROBE_A == 10) da += d; if (k == PROBE_B || PROBE_B == 10) db += d; }
        const float kk = sqrtf(da), vv = db;
        float* o = args.out; const long n = (long)T * D;
        for (long i = (long)blockIdx.x * 512 + threadIdx.x; i < n; i += (long)gridDim.x * 512) o[i] = (i == 0) ? vv : kk;
    }
#endif
#undef IN
#undef SEAM
}

#ifndef MK_ONE_LAUNCH
#define MK_ONE_LAUNCH 1
#endif
extern "C" void kernel_launch(void* const* d_in, const int* in_sizes, int n_in, void* d_out, int out_size, void* d_ws, size_t ws_size, hipStream_t stream) {
    static int grid = 0;
    if (grid == 0) {
        if (n_in != 24 || in_sizes[0] != T * D || out_size != T * D || ws_size < WS_END) { fprintf(stderr, "kernel_launch: unexpected shapes (n_in %d, in0 %d, out %d, ws %zu < %zu)\n", n_in, n_in > 0 ? in_sizes[0] : -1, out_size, ws_size, (size_t)WS_END); grid = -1; return; }
        int dev = 0, cus = 0, per_cu = 0;
        if (hipGetDevice(&dev) != hipSuccess || hipDeviceGetAttribute(&cus, hipDeviceAttributeMultiprocessorCount, dev) != hipSuccess) { grid = -1; return; }
        if (hipFuncSetAttribute((const void*)fwd_kernel, hipFuncAttributeMaxDynamicSharedMemorySize, LDS_BYTES) != hipSuccess) { fprintf(stderr, "kernel_launch: hipFuncSetAttribute failed\n"); grid = -1; return; }
        if (hipOccupancyMaxActiveBlocksPerMultiprocessor(&per_cu, (const void*)fwd_kernel, NWAVES * 64, LDS_BYTES) != hipSuccess || per_cu < 1) fprintf(stderr, "kernel_launch: occupancy query reports %d\n", per_cu);
        (void)hipGetLastError();
        grid = cus;
    }
    if (grid < 0) return;
    if (hipMemsetAsync((char*)d_ws + WS_CTL, 0, CTL_ZERO_BYTES, stream) != hipSuccess) return;
    Args a{};
    for (int i = 0; i < 24; ++i) a.in[i] = (const float*)d_in[i];
    a.out = (float*)d_out; a.ws = (unsigned char*)d_ws;
#if MK_ONE_LAUNCH
    a.ph_lo = 0; a.ph_hi = NPHASES;
    hipLaunchKernelGGL(fwd_kernel, dim3(grid), dim3(NWAVES * 64), LDS_BYTES, stream, a);
#else
    for (int p = 0; p < NPHASES; ++p) {
        const int k = (p - 1) % NPH_LAYER, l = (p - 1) / NPH_LAYER;
        if (p > 0 && k == 2 && l < 2) continue;
        a.ph_lo = p; a.ph_hi = p + 1;
        hipLaunchKernelGGL(fwd_kernel, dim3(grid), dim3(NWAVES * 64), LDS_BYTES, stream, a);
    }
#endif
    const hipError_t le = hipPeekAtLastError();
    if (le != hipSuccess) fprintf(stderr, "kernel_launch: launch failed: %s\n", hipGetErrorName(le));
}
```

```cpp
#define NCVMAX 0
#define NCVATT 0
#define QA 28
#define QM 14
#define QB 8
#include <hip/hip_runtime.h>
#include <cstdio>
#include <cstdint>
namespace pg8 {
#define PG8_LAS __attribute__((address_space(3)))
typedef unsigned short bf16_t;
typedef short bf16x8 __attribute__((ext_vector_type(8)));
typedef float f32x4 __attribute__((ext_vector_type(4)));
typedef unsigned u32x4 __attribute__((ext_vector_type(4)));
constexpr int BM = 256, BK = 64, HALF = 128, HTB = HALF * BK * 2  , STAGE_BYTES = 8 * HTB, NXCD = 8, WGM = 8;

__host__ __device__ __forceinline__ int lds_byte(int r, int c) { const int st = (r >> 4) * 2 + (c >> 5), rr = r & 15, cc = c & 31, ob = rr * 64 + cc * 2; return st * 1024 + (ob ^ (((ob >> 9) & 1) << 5)); }
__host__ __device__ __forceinline__ void stage_rc(int b, int& R, int& C) { const int st = b / 1024, sb = b % 1024, swz = sb ^ (((sb >> 9) & 1) << 5); R = (st >> 1) * 16 + swz / 64; C = (st & 1) * 32 + (swz % 64) / 2; }
__host__ __device__ __forceinline__ int perm32(int rho) { const int n = rho >> 4, i = rho & 15; return 8 * (i >> 2) + 4 * n + (i & 3); }

typedef int pg8_v4i __attribute__((ext_vector_type(4))); typedef int pg8_v8i __attribute__((ext_vector_type(8)));
__device__ __forceinline__ pg8_v8i pg8_cat8(bf16x8 a, bf16x8 b) { return __builtin_shufflevector(__builtin_bit_cast(pg8_v4i, a), __builtin_bit_cast(pg8_v4i, b), 0, 1, 2, 3, 4, 5, 6, 7); }
struct Unit { int pm, pn, e; };
struct Gemm { const bf16_t* A; const bf16_t* Bt; int M, N, K; };

struct StaticOrder {
    static constexpr bool GATHER = false, F8 = false; static constexpr int SCALE_B = 127;
    int nM, nN, nwg, G, c;
    __host__ __device__ void init(int M, int N, int G_, int c_) { nM = M / BM; nN = N / BM; nwg = nM * nN; G = G_; c = c_; }
    __host__ __device__ bool next(int i, Unit& u) const {
        const long L = (long)i * G + c; if (L >= nwg) return false;
        int wgid = (int)L; { const int q = nwg / NXCD, r = nwg % NXCD, xcd = wgid % NXCD, off = wgid / NXCD; wgid = (xcd < r ? xcd * (q + 1) : r * (q + 1) + (xcd - r) * q) + off; }
        const int nig = WGM * nN, gid = wgid / nig, fm = gid * WGM, gsz = (nM - fm) < WGM ? (nM - fm) : WGM;
        u.pm = fm + ((wgid % nig) % gsz); u.pn = (wgid % nig) / gsz; return true;
    }
    __device__ __forceinline__ void a_ready(const Unit&) const {}
    __device__ __forceinline__ void done(const Unit&) const {}
};

__device__ __forceinline__ unsigned cvt_pk_bf16(float lo, float hi) { unsigned r; asm volatile("v_cvt_pk_bf16_f32 %0, %1, %2" : "=v"(r) : "v"(lo), "v"(hi)); return r; }
typedef float f32x2 __attribute__((ext_vector_type(2)));
__device__ __forceinline__ f32x2 gelu_pk(f32x2 v) {
    const f32x2 av = __builtin_elementwise_abs(v), d = av * 0.2316418882f + 1.0f;
    f32x2 t; t.x = __builtin_amdgcn_rcpf(d.x); t.y = __builtin_amdgcn_rcpf(d.y);
    f32x2 q = t * 0.5307027145f + (-0.7265760135f); q = q * t + 0.7107068705f; q = q * t + (-0.142248368f); q = q * t + 0.127414796f; q = q * t;
    const f32x2 s = (v * v) * (-0.72134752044f);
    f32x2 e; e.x = __builtin_amdgcn_exp2f(s.x); e.y = __builtin_amdgcn_exp2f(s.y);
    const f32x2 m = v * (q * e), r = v - m;
    f32x2 o; o.x = v.x < 0.f ? m.x : r.x; o.y = v.y < 0.f ? m.y : r.y; return o;
}

template <class Epi, class Sched, bool ALIGN_EPI = false, bool SP2 = false>
__device__ __forceinline__ void gemm_phase(PG8_LAS unsigned char* lds, const Gemm g, const Sched& S, const Epi& E) {
    int tid_ = threadIdx.x; asm volatile("" : "+v"(tid_));
    const int tid = tid_, wid = __builtin_amdgcn_readfirstlane(tid >> 6), lane = tid & 63, wr = wid >> 2, wc = wid & 3, fr = lane & 15, fq = lane >> 4;
    const int K = g.K, nt = K / BK;
    unsigned voffA[2], voffB[2];
#pragma unroll
    for (int i = 0; i < 2; ++i) { int R, C; stage_rc(tid * 16 + i * 8192, R, C); const int Rb = Epi::PERM ? ((R & ~31) + perm32(R & 31)) : R;
        voffA[i] = (unsigned)(R * K + C) * 2u; voffB[i] = (unsigned)(Rb * K + C) * 2u; }
    unsigned vAc[2][2], vAn[2][2];
    int gR[2], gC[2];
#pragma unroll
    for (int i = 0; i < 2; ++i) { stage_rc(tid * 16 + i * 8192, gR[i], gC[i]); }
    const size_t kstep = (size_t)(BK * 2);
    const size_t hstep = (size_t)HALF * K * 2;
        const unsigned ldsw = (unsigned)wid * 1024u;
    const int aoff = lds_byte(wr * 64 + fr, fq * 8), boff = lds_byte(wc * 32 + fr, fq * 8);
#define PG8_SA(b, h) (((b) * 2 + (h)) * HTB)
#define PG8_SB(b, h) ((4 + (b) * 2 + (h)) * HTB)
#define PG8_STAGE(bufoff, gbase, voff) do { _Pragma("unroll") for (int _i = 0; _i < 2; ++_i) \
        __builtin_amdgcn_global_load_lds((const unsigned*)((const char*)(gbase) + (voff)[_i]), (PG8_LAS unsigned*)(lds + (bufoff) + ldsw + _i * 8192), 16, 0, 0); } while (0)
#define PG8_STAGE_A(b, h, base, VS) do { if constexpr (Sched::GATHER) { PG8_STAGE(PG8_SA(b, h), base, VS[h]); } else { PG8_STAGE(PG8_SA(b, h), (base) + (h) * hstep, voffA); } } while (0)
#define PG8_STAGE_AN(b, h, base) do { if constexpr (Sched::GATHER) { unsigned vs_[2] = {last ? vAn[h][0] : vAc[h][0], last ? vAn[h][1] : vAc[h][1]}; PG8_STAGE(PG8_SA(b, h), base, vs_); } else { PG8_STAGE(PG8_SA(b, h), (base) + (h) * hstep, voffA); } } while (0)
#define PG8_LDA(dst, b, h) do { if constexpr (Sched::F8) { _Pragma("unroll") for (int m = 0; m < 4; ++m) { dst##8[m].lo = *(const PG8_LAS pg8_v4i*)(lds + PG8_SA(b, h) + aoff + m * 2048); dst##8[m].hi = *(const PG8_LAS pg8_v4i*)(lds + PG8_SA(b, h) + aoff + m * 2048 + 1024); } } \
        else { _Pragma("unroll") for (int m = 0; m < 4; ++m) _Pragma("unroll") for (int k = 0; k < 2; ++k) dst[m][k] = *(const PG8_LAS bf16x8*)(lds + PG8_SA(b, h) + aoff + m * 2048 + k * 1024); } } while (0)
#define PG8_LDB(dst, b, h) do { if constexpr (Sched::F8) { _Pragma("unroll") for (int n = 0; n < 2; ++n) { dst##8[n].lo = *(const PG8_LAS pg8_v4i*)(lds + PG8_SB(b, h) + boff + n * 2048); dst##8[n].hi = *(const PG8_LAS pg8_v4i*)(lds + PG8_SB(b, h) + boff + n * 2048 + 1024); } } \
        else { _Pragma("unroll") for (int n = 0; n < 2; ++n) _Pragma("unroll") for (int k = 0; k < 2; ++k) dst[n][k] = *(const PG8_LAS bf16x8*)(lds + PG8_SB(b, h) + boff + n * 2048 + k * 1024); } } while (0)
#define PG8_MMA(ai, bj, At, Bt) do { __builtin_amdgcn_s_setprio(1); if constexpr (Sched::F8) { \
        _Pragma("unroll") for (int m = 0; m < 4; ++m) _Pragma("unroll") for (int n = 0; n < 2; ++n) \
            asm volatile("v_mfma_scale_f32_16x16x128_f8f6f4 %0, %1, %2, %0, %3, %4 op_sel_hi:[0,0,0]" : "+v"(acc[ai][bj][m][n]) : "v"(Bt##8[n]), "v"(At##8[m]), "v"(sclB_), "v"(sclA_));     \
        } else { _Pragma("unroll") for (int m = 0; m < 4; ++m) _Pragma("unroll") for (int n = 0; n < 2; ++n) _Pragma("unroll") for (int k = 0; k < 2; ++k) \
        acc[ai][bj][m][n] = __builtin_amdgcn_mfma_f32_16x16x32_bf16(Bt[n][k], At[m][k], acc[ai][bj][m][n], 0, 0, 0); } __builtin_amdgcn_s_setprio(0); } while (0)
#define PG8_WAIT_V(n) asm volatile("s_waitcnt vmcnt(" #n ")" ::: "memory")
#define PG8_WAIT_L(n) asm volatile("s_waitcnt lgkmcnt(" #n ")" ::: "memory")
#define PG8_BAR __builtin_amdgcn_s_barrier()
#define PG8_SCHED __builtin_amdgcn_sched_barrier(0)
    Unit cur, nxt; int ui = 0;
    if (!S.next(0, cur)) return;
    f32x4 acc[2][2][4][2];
#pragma unroll
    for (int a = 0; a < 2; ++a)
#pragma unroll
        for (int b = 0; b < 2; ++b)
#pragma unroll
            for (int m = 0; m < 4; ++m)
#pragma unroll
                for (int n = 0; n < 2; ++n) acc[a][b][m][n] = (f32x4){0.f, 0.f, 0.f, 0.f};
    const int sclB_ = Sched::SCALE_B, sclA_ = 127;
    bf16x8 At[4][2], B0[2][2], B1[2][2]; pg8_v8i At8[4], B08[2], B18[2];
    const char* cA = S.aptr(cur); const char* cB = S.bptr(cur);
    S.a_ready(cur);
    if constexpr (Sched::GATHER) {
#pragma unroll
        for (int h = 0; h < 2; ++h)
#pragma unroll
            for (int i = 0; i < 2; ++i) { vAc[h][i] = S.rowoff(cur, h * HALF + gR[i]) + (unsigned)gC[i] * 2u; vAn[h][i] = vAc[h][i]; }
        asm volatile("s_waitcnt vmcnt(0)" ::: "memory");
    }
    if constexpr (SP2) {
        PG8_STAGE(PG8_SB(0, 0), cB, voffB); PG8_STAGE(PG8_SB(0, 1), cB + hstep, voffB); PG8_STAGE_A(0, 0, cA, vAc); PG8_STAGE_A(0, 1, cA, vAc);
        if (wr == 1) PG8_BAR;
        PG8_WAIT_V(2); PG8_BAR;
        PG8_STAGE(PG8_SB(1, 0), cB + kstep, voffB); PG8_STAGE_A(1, 0, cA + kstep, vAc); PG8_STAGE(PG8_SB(1, 1), cB + hstep + kstep, voffB);
        PG8_WAIT_V(6); PG8_BAR;
    } else {
        PG8_STAGE(PG8_SB(0, 0), cB, voffB); PG8_STAGE_A(0, 0, cA, vAc); PG8_STAGE(PG8_SB(0, 1), cB + hstep, voffB); PG8_STAGE_A(0, 1, cA, vAc);
        if (wr == 1) PG8_BAR;
        PG8_WAIT_V(4); PG8_BAR;
        PG8_STAGE(PG8_SB(1, 0), cB + kstep, voffB); PG8_STAGE_A(1, 0, cA + kstep, vAc); PG8_STAGE(PG8_SB(1, 1), cB + hstep + kstep, voffB);
        PG8_WAIT_V(6); PG8_BAR;
    }
    for (;;) {
        const bool has_next = S.next(ui + 1, nxt);
        const char* nA = has_next ? S.aptr(nxt) : cA; const char* nB = has_next ? S.bptr(nxt) : cB;
        if constexpr (Sched::GATHER) { if (has_next) {
#pragma unroll
            for (int h = 0; h < 2; ++h)
#pragma unroll
                for (int i = 0; i < 2; ++i) vAn[h][i] = S.rowoff(nxt, h * HALF + gR[i]) + (unsigned)gC[i] * 2u; } }
        for (int t = 0; t < nt; t += 2) {
            const bool last = (t == nt - 2);
            const char* a1 = cA + (size_t)(t + 1) * kstep;
            const char* a2 = last ? nA : cA + (size_t)(t + 2) * kstep; const char* b2 = last ? nB : cB + (size_t)(t + 2) * kstep;
            const char* a3 = a2 + kstep; const char* b3 = b2 + kstep;
            if (last && has_next) S.a_ready(nxt);
            if constexpr (SP2) {
            PG8_LDB(B0, 0, 0); PG8_LDB(B1, 0, 1); PG8_SCHED; PG8_LDA(At, 0, 0); PG8_STAGE_A(1, 1, a1, vAc);
            PG8_WAIT_V(8); PG8_WAIT_L(0); PG8_BAR; PG8_MMA(0, 0, At, B0); PG8_MMA(0, 1, At, B1); PG8_BAR; PG8_SCHED;
            PG8_LDA(At, 0, 1); PG8_STAGE(PG8_SB(0, 0), b2, voffB); PG8_STAGE(PG8_SB(0, 1), b2 + hstep, voffB); PG8_STAGE_AN(0, 0, a2);
            PG8_WAIT_V(8); PG8_WAIT_L(0); PG8_BAR; PG8_MMA(1, 0, At, B0); PG8_MMA(1, 1, At, B1); PG8_BAR; PG8_SCHED;
            PG8_LDB(B0, 1, 0); PG8_LDB(B1, 1, 1); PG8_SCHED; PG8_LDA(At, 1, 0); PG8_STAGE_AN(0, 1, a2);
            PG8_WAIT_V(8); PG8_WAIT_L(0); PG8_BAR; PG8_MMA(0, 0, At, B0); PG8_MMA(0, 1, At, B1); PG8_BAR; PG8_SCHED;
            PG8_LDA(At, 1, 1); PG8_STAGE(PG8_SB(1, 0), b3, voffB); PG8_STAGE(PG8_SB(1, 1), b3 + hstep, voffB); PG8_STAGE_AN(1, 0, a3);
            PG8_WAIT_V(8); PG8_WAIT_L(0); PG8_BAR; PG8_MMA(1, 0, At, B0); PG8_MMA(1, 1, At, B1); PG8_BAR; PG8_SCHED;
            } else {
            PG8_LDB(B0, 0, 0); PG8_SCHED; PG8_LDA(At, 0, 0); PG8_STAGE_A(1, 1, a1, vAc);
            PG8_WAIT_L(8); PG8_BAR; PG8_WAIT_L(0); PG8_MMA(0, 0, At, B0); PG8_BAR; PG8_SCHED;
            PG8_LDB(B1, 0, 1); PG8_STAGE(PG8_SB(0, 0), b2, voffB);
            PG8_BAR; PG8_WAIT_L(0); PG8_MMA(0, 1, At, B1); PG8_BAR;
            PG8_LDA(At, 0, 1); PG8_STAGE_AN(0, 0, a2);
            PG8_BAR; PG8_WAIT_L(0); PG8_MMA(1, 0, At, B0); PG8_BAR; PG8_SCHED;
            PG8_STAGE(PG8_SB(0, 1), b2 + hstep, voffB);
            PG8_WAIT_V(6); PG8_BAR; PG8_MMA(1, 1, At, B1); PG8_BAR;
            PG8_LDB(B0, 1, 0); PG8_SCHED; PG8_LDA(At, 1, 0); PG8_STAGE_AN(0, 1, a2);
            PG8_WAIT_L(8); PG8_BAR; PG8_WAIT_L(0); PG8_MMA(0, 0, At, B0); PG8_BAR; PG8_SCHED;
            PG8_LDB(B1, 1, 1); PG8_STAGE(PG8_SB(1, 0), b3, voffB);
            PG8_BAR; PG8_WAIT_L(0); PG8_MMA(0, 1, At, B1); PG8_BAR;
            PG8_LDA(At, 1, 1); PG8_STAGE_AN(1, 0, a3);
            PG8_BAR; PG8_WAIT_L(0); PG8_MMA(1, 0, At, B0); PG8_BAR; PG8_SCHED;
            PG8_STAGE(PG8_SB(1, 1), b3 + hstep, voffB);
            PG8_WAIT_V(6); PG8_BAR; PG8_MMA(1, 1, At, B1); PG8_BAR;
            }
        }
        if constexpr (ALIGN_EPI) { if (wr == 0) PG8_BAR; }
        if constexpr (!Epi::AFTER_DRAIN) { E(acc, cur, wr, wc, fr, fq); S.done(cur); }
        if (!has_next) break;
#pragma unroll
        for (int a = 0; a < 2; ++a)
#pragma unroll
            for (int b = 0; b < 2; ++b)
#pragma unroll
                for (int m = 0; m < 4; ++m)
#pragma unroll
                    for (int n = 0; n < 2; ++n) acc[a][b][m][n] = (f32x4){0.f, 0.f, 0.f, 0.f};
        cur = nxt; cA = nA; cB = nB; ++ui;
        if constexpr (Sched::GATHER) {
#pragma unroll
            for (int h = 0; h < 2; ++h)
#pragma unroll
                for (int i = 0; i < 2; ++i) vAc[h][i] = vAn[h][i]; }
        if constexpr (ALIGN_EPI) { if (wr == 1) PG8_BAR; }
    }
    PG8_WAIT_V(0);
    if constexpr (!ALIGN_EPI) { if (wr == 0) PG8_BAR; }
    PG8_BAR;
    if constexpr (Epi::AFTER_DRAIN) { E.fused(acc, cur, wr, wc, fr, fq, lds, wid, lane); S.done(cur); }
#undef PG8_SA
#undef PG8_SB
#undef PG8_STAGE
#undef PG8_STAGE_A
#undef PG8_STAGE_AN
#undef PG8_LDA
#undef PG8_LDB
#undef PG8_MMA
#undef PG8_WAIT_V
#undef PG8_WAIT_L
#undef PG8_BAR
#undef PG8_SCHED
}
}

constexpr int T = 8192, D = 2048, MIXW = 1536, MEMW = 512, NINA = 3584, DEPTH = 4, NE = 32, FF = 512, MEMT = 256;
constexpr int SLOTS = 24576;
constexpr float LN_EPS = 1e-5f;
constexpr float DN_ALPHA = 1.6817928305074292f;
constexpr float LOG2E = 1.4426950408889634f;
constexpr float QSCALE = 0.08838834764831845f * LOG2E;
constexpr int NWAVES = 8;

constexpr size_t MiB = 1u << 20;
constexpr size_t WS_CTL = 0, CTL_ZERO_BYTES = 1 * MiB;
constexpr size_t WS_WAIN = 2 * MiB, WS_WAOUT = 30 * MiB, WS_WBIN0 = 46 * MiB, WS_WKV = 54 * MiB, WS_WBIN1 = 66 * MiB, WS_WBOUT = 74 * MiB, WS_WMKV = 90 * MiB;
constexpr size_t WS_W13 = 106 * MiB, WS_W2 = 618 * MiB;
constexpr size_t WS_XB = 874 * MiB, WS_MEMB = 906 * MiB, WS_MEMKV = 907 * MiB, WS_Z = 910 * MiB, WS_KD = 966 * MiB, WS_VD = 990 * MiB, WS_CAT = 1014 * MiB;
constexpr size_t WS_Y = 1046 * MiB, WS_X1F = 1110 * MiB, WS_X1B = 1174 * MiB, WS_XF = 1206 * MiB, WS_XG = 1270 * MiB, WS_H = 1366 * MiB, WS_YB = 1390 * MiB, WS_OP = 1486 * MiB;
constexpr size_t WS_ROUTE = 1582 * MiB, WS_OP2 = 1583 * MiB, WS_ML = 1631 * MiB, WS_WR = 1634 * MiB, WS_TS = 1640 * MiB, WS_LIST = 1641 * MiB, WS_END = 1642 * MiB;
constexpr int CW_TMO = 0, CW_BAR = 4096, CW_CNT = 16384, CW_Q = 28672, CW_CONV = 29184, CW_DONE = 32768, CW_FIN = 40960;

constexpr int RING_OFF = 0, RING_BYTES = 131072;
constexpr int LDSCTL_OFF = 146432, MISC_OFF = LDSCTL_OFF + 320, TAB_OFF = LDSCTL_OFF + 512;
constexpr int LDS_BYTES = 147456;

#define GAS __attribute__((address_space(1)))
#define LAS __attribute__((address_space(3)))
typedef unsigned short bf16;
typedef unsigned v4u __attribute__((ext_vector_type(4)));
typedef unsigned v2u __attribute__((ext_vector_type(2)));
typedef float f32x4 __attribute__((ext_vector_type(4)));
typedef short bf16x8 __attribute__((ext_vector_type(8)));
typedef GAS unsigned gu32;
#define RLX_AGENT __ATOMIC_RELAXED, __HIP_MEMORY_SCOPE_AGENT
#define LDS_WAIT() asm volatile("s_waitcnt lgkmcnt(0)" ::: "memory")
#define VM_WAIT() asm volatile("s_waitcnt vmcnt(0)" ::: "memory")
__device__ __forceinline__ unsigned f2bf(float f) { unsigned u = __builtin_bit_cast(unsigned, f); return (u + 0x7fffu + ((u >> 16) & 1u)) >> 16; }
__device__ __forceinline__ unsigned pk2(float lo, float hi) { return f2bf(lo) | (f2bf(hi) << 16); }
__device__ __forceinline__ float bf2f(unsigned short b) { return __builtin_bit_cast(float, (unsigned)b << 16); }
__device__ __forceinline__ float bflo(unsigned w) { return __builtin_bit_cast(float, w << 16); }
__device__ __forceinline__ float bfhi(unsigned w) { return __builtin_bit_cast(float, w & 0xffff0000u); }
__device__ __forceinline__ float wave_sum(float v) {
#pragma unroll
    for (int o = 1; o < 64; o <<= 1) v += __shfl_xor(v, o);
    return v;
}

namespace pg8 {
struct DenseOrder {
    static constexpr bool GATHER = false, F8 = false; static constexpr int SCALE_B = 127;
    StaticOrder so; const char* A; const char* B; size_t astep, bstep;
    __device__ void init(const void* A_, const void* B_, int M, int N, int K, int G, int c) { so.init(M, N, G, c); A = (const char*)A_; B = (const char*)B_; astep = (size_t)256 * K * 2; bstep = astep; }
    __device__ __forceinline__ bool next(int i, Unit& u) const { u.e = 0; return so.next(i, u); }
    __device__ __forceinline__ const char* aptr(const Unit& u) const { return A + (size_t)u.pm * astep; }
    __device__ __forceinline__ const char* bptr(const Unit& u) const { return B + (size_t)u.pn * bstep; }
    __device__ __forceinline__ void a_ready(const Unit&) const {}
    __device__ __forceinline__ void done(const Unit&) const {}
};
struct DualOrder {
    static constexpr bool GATHER = false, F8 = false; static constexpr int SCALE_B = 127;
    StaticOrder so; int nwg2; const char* A; const char* B; const char* A2; const char* B2; size_t step;
    __device__ void init(const void* A_, const void* B_, int M, int N, int K, int G, int c, const void* A2_, const void* B2_, int nwg2_) { so.init(M, N, G, c); A = (const char*)A_; B = (const char*)B_; A2 = (const char*)A2_; B2 = (const char*)B2_; nwg2 = nwg2_; step = (size_t)256 * K * 2; }
    __device__ __forceinline__ bool next(int i, Unit& u) const { const int L = i * so.G + so.c; if (L < so.nwg) { u.e = 0; return so.next(i, u); } if (L - so.nwg >= nwg2) return false; u.e = 1; u.pm = 0; u.pn = L - so.nwg; return true; }
    __device__ __forceinline__ const char* aptr(const Unit& u) const { return u.e ? A2 : A + (size_t)u.pm * step; }
    __device__ __forceinline__ const char* bptr(const Unit& u) const { return (u.e ? B2 : B) + (size_t)u.pn * step; }
    __device__ __forceinline__ void a_ready(const Unit&) const {}
    __device__ __forceinline__ void done(const Unit&) const {}
};
struct MoeOrder {
    static constexpr bool GATHER = false, F8 = false; static constexpr int SCALE_B = 127;
    const PG8_LAS int* tstart; int ntn, G, c; const char* A; const char* W; size_t astep, wexp, wtile;
    __device__ __forceinline__ bool next(int i, Unit& u) const {
        const int L = i * G + c, total = tstart[32] * ntn; if (L >= total) return false;
        int wgid; { const int q = total / NXCD, r = total % NXCD, xcd = L % NXCD, off = L / NXCD; wgid = (xcd < r ? xcd * (q + 1) : r * (q + 1) + (xcd - r) * q) + off; }
        u.pm = wgid / ntn; u.pn = wgid - u.pm * ntn; int e = 0;
#pragma unroll
        for (int k = 1; k <= 31; ++k) e += (tstart[k] <= u.pm) ? 1 : 0;
        u.e = e; return true;
    }
    __device__ __forceinline__ const char* aptr(const Unit& u) const { return A + (size_t)u.pm * astep; }
    __device__ __forceinline__ const char* bptr(const Unit& u) const { return W + (size_t)u.e * wexp + (size_t)u.pn * wtile; }
    __device__ __forceinline__ void a_ready(const Unit&) const {}
    __device__ __forceinline__ void done(const Unit&) const {}
};

struct MoeOrder8 {
    static constexpr bool GATHER = false, F8 = true; static constexpr int SCALE_B = 121;
    const PG8_LAS int* tstart; int ntn, G, c; const char* A; const char* W; size_t astep, wexp, wtile;
    __device__ __forceinline__ bool next(int i, Unit& u) const {
        const int L = i * G + c, total = tstart[32] * ntn; if (L >= total) return false;
        int wgid; { const int q = total / NXCD, r = total % NXCD, xcd = L % NXCD, off = L / NXCD; wgid = (xcd < r ? xcd * (q + 1) : r * (q + 1) + (xcd - r) * q) + off; }
        u.pm = wgid / ntn; u.pn = wgid - u.pm * ntn; int e = 0;
#pragma unroll
        for (int k = 1; k <= 31; ++k) e += (tstart[k] <= u.pm) ? 1 : 0;
        u.e = e; return true;
    }
    __device__ __forceinline__ const char* aptr(const Unit& u) const { return A + (size_t)u.pm * astep; }
    __device__ __forceinline__ const char* bptr(const Unit& u) const { return W + (size_t)u.e * wexp + (size_t)u.pn * wtile; }
    __device__ __forceinline__ void a_ready(const Unit&) const {}
    __device__ __forceinline__ void done(const Unit&) const {}
};

struct MoeGatherOrder {
    static constexpr bool GATHER = true, F8 = true; static constexpr int SCALE_B = 121;
    const PG8_LAS int* tstart; const PG8_LAS int* cntl; const int* list; int ntn, G, c; const char* A; const char* W; size_t wexp, wtile; unsigned rowbytes;
    __device__ __forceinline__ bool next(int i, Unit& u) const {
        const int L = i * G + c, total = tstart[32] * ntn; if (L >= total) return false;
        int wgid; { const int q = total / NXCD, r = total % NXCD, xcd = L % NXCD, off = L / NXCD; wgid = (xcd < r ? xcd * (q + 1) : r * (q + 1) + (xcd - r) * q) + off; }
        u.pm = wgid / ntn; u.pn = wgid - u.pm * ntn; int e = 0;
#pragma unroll
        for (int k = 1; k <= 31; ++k) e += (tstart[k] <= u.pm) ? 1 : 0;
        u.e = e; return true;
    }
    __device__ __forceinline__ unsigned rowoff(const Unit& u, int r) const { const int rank = (u.pm - tstart[u.e]) * 256 + r; const int tok = list[u.e * 8192 + (rank < cntl[u.e] ? rank : 0)]; return (unsigned)tok * rowbytes; }
    __device__ __forceinline__ const char* aptr(const Unit&) const { return A; }
    __device__ __forceinline__ const char* bptr(const Unit& u) const { return W + (size_t)u.e * wexp + (size_t)u.pn * wtile; }
    __device__ __forceinline__ void a_ready(const Unit&) const {}
    __device__ __forceinline__ void done(const Unit&) const {}
};

struct EpiBf16X {
    static constexpr bool PERM = true, AFTER_DRAIN = false;
    int mode; bf16_t* p0; bf16_t* p1; bf16_t* p2; bf16_t* p3;
    const PG8_LAS int* tstart; const PG8_LAS int* cntl;
    __device__ __forceinline__ void operator()(const f32x4 (&acc)[2][2][4][2], const Unit& u, int wr, int wc, int fr, int fq) const {
        bf16_t* base; int ldc, colt; bool act = false; float sc = 1.f;
        if (u.e && mode < 2) { base = p3 + (size_t)(u.pn >> 2) * (256 * 1024); ldc = 1024; colt = (u.pn & 3) * BM; }
        else if (mode == 0) { base = p0; ldc = 3584; colt = u.pn * BM; act = u.pn < 12; if (u.pn >= 12) sc = QSCALE; }
        else if (mode == 1) { if (u.pn < 8) { base = p0; ldc = 2048; colt = u.pn * BM; sc = QSCALE; }
                              else if (u.pn < 14) { base = p1; ldc = 1536; colt = (u.pn - 8) * BM; } else { base = p2; ldc = 1536; colt = (u.pn - 14) * BM; } }
        else { base = p0; ldc = 2048; colt = u.pn * BM; }
        const int row0 = u.pm * BM + wr * 64 + fr, col0 = colt + wc * 32 + 8 * fq;
        const int rlim = (mode == 3) ? cntl[u.e] - (u.pm - tstart[u.e]) * BM : BM;
#pragma unroll
        for (int ai = 0; ai < 2; ++ai)
#pragma unroll
            for (int m = 0; m < 4; ++m) { bf16_t* rowp = base + (size_t)(row0 + ai * HALF + m * 16) * ldc + col0;
                if (wr * 64 + fr + ai * HALF + m * 16 >= rlim) continue;
#pragma unroll
                for (int bj = 0; bj < 2; ++bj) { f32x4 v0 = acc[ai][bj][m][0], v1 = acc[ai][bj][m][1];
                    if (act) { f32x2 a = gelu_pk((f32x2){v0[0], v0[1]}), b = gelu_pk((f32x2){v0[2], v0[3]}), c = gelu_pk((f32x2){v1[0], v1[1]}), d = gelu_pk((f32x2){v1[2], v1[3]});
                        v0 = (f32x4){a.x, a.y, b.x, b.y}; v1 = (f32x4){c.x, c.y, d.x, d.y}; }
                    v0 = v0 * sc; v1 = v1 * sc; u32x4 w; w.x = cvt_pk_bf16(v0[0], v0[1]); w.y = cvt_pk_bf16(v0[2], v0[3]); w.z = cvt_pk_bf16(v1[0], v1[1]); w.w = cvt_pk_bf16(v1[2], v1[3]);
                    *(u32x4*)(rowp + bj * HALF) = w; } }
    }
};
struct EpiResBf16 {
    static constexpr bool PERM = true, AFTER_DRAIN = false;
    const bf16_t* xres; bf16_t* y; float alpha;
    __device__ __forceinline__ void operator()(const f32x4 (&acc)[2][2][4][2], const Unit& u, int wr, int wc, int fr, int fq) const {
        const int row0 = u.pm * BM + wr * 64 + fr, col0 = u.pn * BM + wc * 32 + 8 * fq;
#pragma unroll
        for (int ai = 0; ai < 2; ++ai)
#pragma unroll
            for (int m = 0; m < 4; ++m) { const size_t off = (size_t)(row0 + ai * HALF + m * 16) * 2048 + col0;
#pragma unroll
                for (int bj = 0; bj < 2; ++bj) { const u32x4 xr = *(const u32x4*)(xres + off + bj * HALF); const f32x4 v0 = acc[ai][bj][m][0], v1 = acc[ai][bj][m][1]; u32x4 w;
                    w.x = cvt_pk_bf16(__builtin_bit_cast(float, xr.x << 16) * alpha + v0[0], __builtin_bit_cast(float, xr.x & 0xffff0000u) * alpha + v0[1]);
                    w.y = cvt_pk_bf16(__builtin_bit_cast(float, xr.y << 16) * alpha + v0[2], __builtin_bit_cast(float, xr.y & 0xffff0000u) * alpha + v0[3]);
                    w.z = cvt_pk_bf16(__builtin_bit_cast(float, xr.z << 16) * alpha + v1[0], __builtin_bit_cast(float, xr.z & 0xffff0000u) * alpha + v1[1]);
                    w.w = cvt_pk_bf16(__builtin_bit_cast(float, xr.w << 16) * alpha + v1[2], __builtin_bit_cast(float, xr.w & 0xffff0000u) * alpha + v1[3]);
                    *(u32x4*)(y + off + bj * HALF) = w; } }
    }
};
struct EpiMoe1 {
    static constexpr bool PERM = true, AFTER_DRAIN = false;
    bf16_t* h; const PG8_LAS int* tstart; const PG8_LAS int* cntl;
    __device__ __forceinline__ void operator()(const f32x4 (&acc)[2][2][4][2], const Unit& u, int wr, int wc, int fr, int fq) const {
        const int row0 = u.pm * BM + wr * 64 + fr, col0 = u.pn * HALF + wc * 32 + 8 * fq;
        const int rlim = cntl[u.e] - (u.pm - tstart[u.e]) * BM;
#pragma unroll
        for (int ai = 0; ai < 2; ++ai)
#pragma unroll
            for (int m = 0; m < 4; ++m) { unsigned char* rowp = (unsigned char*)h + (size_t)(row0 + ai * HALF + m * 16) * 512 + col0; float o[8];
                if (wr * 64 + fr + ai * HALF + m * 16 >= rlim) continue;
#pragma unroll
                for (int n = 0; n < 2; ++n)
#pragma unroll
                    for (int x = 0; x < 4; ++x) { const float a = acc[ai][0][m][n][x], b = acc[ai][1][m][n][x];
                        o[n * 4 + x] = a * __builtin_amdgcn_rcpf(1.0f + __builtin_amdgcn_exp2f(-a * LOG2E)) * b; }
                unsigned lo = 0u, hi = 0u; lo = __builtin_amdgcn_cvt_pk_fp8_f32(o[0], o[1], lo, false); lo = __builtin_amdgcn_cvt_pk_fp8_f32(o[2], o[3], lo, true);
                hi = __builtin_amdgcn_cvt_pk_fp8_f32(o[4], o[5], hi, false); hi = __builtin_amdgcn_cvt_pk_fp8_f32(o[6], o[7], hi, true);
                typedef unsigned u32x2e __attribute__((ext_vector_type(2))); u32x2e w; w.x = lo; w.y = hi; *(u32x2e*)rowp = w; }
    }
};
}

namespace att {
using bf16x8 = __attribute__((ext_vector_type(8))) short;
using s16x4  = __attribute__((ext_vector_type(4))) short;
using f32x16 = __attribute__((ext_vector_type(16))) float;
using u32x4  = __attribute__((ext_vector_type(4))) unsigned;
constexpr int DH = 128, QBLK = 32, KVBLK = 64;
constexpr float THR2 = 8.f * 1.4426950408889634f;
constexpr size_t SHM_V = KVBLK * DH * 2, SHM_K = KVBLK * DH * 2, SHM_ATTN = 2 * SHM_V + 2 * SHM_K + NWAVES * 64 * 4;
constexpr int TAB_N = 160;
#define KSWZ(row, colB) ((row) * 256 + ((colB) ^ (((row) & 7) << 4)))
#define SBAR() __builtin_amdgcn_sched_barrier(0)
__device__ __forceinline__ int crow(int r, int hi) { return (r & 3) + 8 * (r >> 2) + 4 * hi; }
__device__ __forceinline__ unsigned cvtpk(float lo, float hi) { unsigned r; asm volatile("v_cvt_pk_bf16_f32 %0, %1, %2" : "=v"(r) : "v"(lo), "v"(hi)); return r; }

__device__ __forceinline__ void partialSM(f32x16& p0, f32x16& p1, float& m_reg, float& mn, float& alpha) {
  float pmax = p0[0];
#pragma unroll
  for (int r = 1; r < 16; ++r) pmax = fmaxf(pmax, p0[r]);
#pragma unroll
  for (int r = 0; r < 16; ++r) pmax = fmaxf(pmax, p1[r]);
  { auto rr = __builtin_amdgcn_permlane32_swap(__float_as_uint(pmax), __float_as_uint(pmax), false, false);
    pmax = fmaxf(__uint_as_float(rr[0]), __uint_as_float(rr[1])); }
  if (__builtin_expect(__all(pmax - m_reg <= THR2), 1)) { mn = m_reg; alpha = 1.f; }
  else { mn = fmaxf(m_reg, pmax); alpha = __builtin_amdgcn_exp2f(m_reg - mn); m_reg = mn; }
#pragma unroll
  for (int r = 0; r < 16; ++r) p0[r] = p0[r] - mn;
#pragma unroll
  for (int r = 0; r < 16; ++r) p1[r] = p1[r] - mn;
#pragma unroll
  for (int r = 0; r < 16; ++r) p0[r] = __builtin_amdgcn_exp2f(p0[r]);
}
__device__ __forceinline__ void finishSM(f32x16& p0, f32x16& p1, float alpha, float& l_reg, bf16x8& pa0, bf16x8& pa1, bf16x8& pa2, bf16x8& pa3) {
#pragma unroll
  for (int r = 0; r < 16; ++r) p1[r] = __builtin_amdgcn_exp2f(p1[r]);
  float ps = 0;
#pragma unroll
  for (int r = 0; r < 16; ++r) ps += p0[r];
#pragma unroll
  for (int r = 0; r < 16; ++r) ps += p1[r];
  { auto rr = __builtin_amdgcn_permlane32_swap(__float_as_uint(ps), __float_as_uint(ps), false, false);
    ps = __uint_as_float(rr[0]) + __uint_as_float(rr[1]); }
  l_reg = l_reg * alpha + ps;
#define PK4(P, BASE, OUT) do { unsigned a0 = cvtpk(P[BASE + 0], P[BASE + 1]), a1 = cvtpk(P[BASE + 2], P[BASE + 3]);   \
    unsigned b0 = cvtpk(P[BASE + 4], P[BASE + 5]), b1 = cvtpk(P[BASE + 6], P[BASE + 7]);                              \
    auto r0 = __builtin_amdgcn_permlane32_swap(a0, b0, false, false); auto r1 = __builtin_amdgcn_permlane32_swap(a1, b1, false, false); \
    u32x4 w = {r0[0], r1[0], r0[1], r1[1]}; OUT = *reinterpret_cast<bf16x8*>(&w); } while (0)
  PK4(p0, 0, pa0); PK4(p0, 8, pa1); PK4(p1, 0, pa2); PK4(p1, 8, pa3);
#undef PK4
}
__device__ __forceinline__ void qkt(f32x16& p0, f32x16& p1, const char* Ks, const bf16x8* qr, int r32, int hi) {
  p0 = f32x16{}; p1 = f32x16{};
#pragma unroll
  for (int d0 = 0; d0 < 8; ++d0) { const int cb = (d0 * 16 + hi * 8) * 2;
    bf16x8 b0 = *reinterpret_cast<const bf16x8*>(Ks + KSWZ(r32, cb));
    bf16x8 b1 = *reinterpret_cast<const bf16x8*>(Ks + KSWZ(32 + r32, cb));
    p0 = __builtin_amdgcn_mfma_f32_32x32x16_bf16(b0, qr[d0], p0, 0, 0, 0);
    p1 = __builtin_amdgcn_mfma_f32_32x32x16_bf16(b1, qr[d0], p1, 0, 0, 0); }
}
__device__ __forceinline__ int v_st(int k, int c) { const int kk = (k & ~0xC) | ((k & 4) << 1) | ((k & 8) >> 1); return ((kk >> 3) * 4 + (c >> 5)) * 512 + ((kk & 7) * 32 + (c & 31)) * 2; }
__device__ __forceinline__ int v_rd_base(int lane) { return ((lane & 3) << 3) | (((lane >> 2) & 3) << 6) | (((lane >> 4) & 1) << 5) | (((lane >> 5) & 1) << 8); }
constexpr int v_rd_off(int d0, int ks, int half) { return d0 * 512 + ks * 4096 + half * 2048; }
template <int OFF> __device__ __forceinline__ s16x4 tr_read(int vb) {
  s16x4 r; asm volatile("ds_read_b64_tr_b16 %0, %1 offset:%2" : "=&v"(r) : "v"(vb), "i"(OFF) : "memory"); return r;
}
template <int D0> __device__ __forceinline__ void pv_one(f32x16& od, int vb, bf16x8 pa0, bf16x8 pa1, bf16x8 pa2, bf16x8 pa3) {
  const s16x4 l0 = tr_read<v_rd_off(D0, 0, 0)>(vb), h0 = tr_read<v_rd_off(D0, 0, 1)>(vb), l1 = tr_read<v_rd_off(D0, 1, 0)>(vb), h1 = tr_read<v_rd_off(D0, 1, 1)>(vb);
  const s16x4 l2 = tr_read<v_rd_off(D0, 2, 0)>(vb), h2 = tr_read<v_rd_off(D0, 2, 1)>(vb), l3 = tr_read<v_rd_off(D0, 3, 0)>(vb), h3 = tr_read<v_rd_off(D0, 3, 1)>(vb);
  asm volatile("s_waitcnt lgkmcnt(0)" ::: "memory"); SBAR();
#define PK(L, H) (bf16x8){L[0], L[1], L[2], L[3], H[0], H[1], H[2], H[3]}
  od = __builtin_amdgcn_mfma_f32_32x32x16_bf16(pa0, PK(l0, h0), od, 0, 0, 0);
  od = __builtin_amdgcn_mfma_f32_32x32x16_bf16(pa1, PK(l1, h1), od, 0, 0, 0);
  od = __builtin_amdgcn_mfma_f32_32x32x16_bf16(pa2, PK(l2, h2), od, 0, 0, 0);
  od = __builtin_amdgcn_mfma_f32_32x32x16_bf16(pa3, PK(l3, h3), od, 0, 0, 0);
#undef PK
}
__device__ __forceinline__ void pv_d0(f32x16* o, int vb, bf16x8 pa0, bf16x8 pa1, bf16x8 pa2, bf16x8 pa3) {
  pv_one<0>(o[0], vb, pa0, pa1, pa2, pa3); pv_one<1>(o[1], vb, pa0, pa1, pa2, pa3); pv_one<2>(o[2], vb, pa0, pa1, pa2, pa3); pv_one<3>(o[3], vb, pa0, pa1, pa2, pa3);
}
template <int MODE> __device__ __forceinline__ void post_scores(f32x16& p0, f32x16& p1, int t, int qrow0, int r32, int hi, const float* tab, float cfar) {
  if constexpr (MODE == 1) {
    const int cw = qrow0 >> 6;
    if (t > cw) {
#pragma unroll
      for (int r = 0; r < 16; ++r) { p0[r] = -INFINITY; p1[r] = -INFINITY; }
    } else if (qrow0 - (64 * t + 63) >= 91) {
#pragma unroll
      for (int r = 0; r < 16; ++r) { p0[r] += cfar; p1[r] += cfar; }
    } else {
      const int base = qrow0 + r32 - 64 * t + 63;
#pragma unroll
      for (int r = 0; r < 16; ++r) { const int i0 = base - crow(r, hi); const int i1 = i0 - 32;
        p0[r] += tab[i0 < TAB_N - 1 ? i0 : TAB_N - 1]; p1[r] += tab[i1 < TAB_N - 1 ? i1 : TAB_N - 1]; }
    }
  }
}

template <int MODE>
__device__ __forceinline__ void attn_body(const bf16* __restrict__ Qb, int ldq, const bf16* __restrict__ Kh, const bf16* __restrict__ Vh, int ldk,
                                          bf16* Ob, float* Of, int ldo, int NT, int q0abs, const float* tab, float cfar, char* lds) {
  int tid_ = threadIdx.x; asm volatile("" : "+v"(tid_));
  const int tid = tid_, wid = tid >> 6, lane = tid & 63, r32 = lane & 31, hi = lane >> 5;
  char* V_lds = lds; char* K_lds = lds + 2 * SHM_V;
  float* ws = (float*)(lds + 2 * SHM_V + 2 * SHM_K) + wid * 64; float* li_l = ws; float* al_l = ws + 32;
  float m_reg = -1e30f, l_reg = 0; f32x16 o[4] = {}; bf16x8 qr[8];
  const int qrow0 = q0abs + wid * QBLK;
  const bf16* Qw = Qb + (long)(wid * QBLK + r32) * ldq + hi * 8;
#pragma unroll
  for (int d0 = 0; d0 < 8; ++d0) qr[d0] = *reinterpret_cast<const bf16x8*>(Qw + d0 * 16);
  const int sr = tid >> 4, sc = (tid & 15) * 8, vst0 = v_st(sr, sc), vst1 = v_st(32 + sr, sc);
  const int vb0 = (int)(uintptr_t)V_lds + v_rd_base(lane);
  struct { bf16x8 vs0, vs1, ks0, ks1; } sr_[2];
#define SLOAD(i, k0) do { sr_[i].vs0 = *reinterpret_cast<const bf16x8*>(&Vh[(long)((k0) + sr) * ldk + sc]); sr_[i].vs1 = *reinterpret_cast<const bf16x8*>(&Vh[(long)((k0) + 32 + sr) * ldk + sc]); \
    sr_[i].ks0 = *reinterpret_cast<const bf16x8*>(&Kh[(long)((k0) + sr) * ldk + sc]); sr_[i].ks1 = *reinterpret_cast<const bf16x8*>(&Kh[(long)((k0) + 32 + sr) * ldk + sc]); } while (0)
#define SWRITE(b, i) do { *(bf16x8*)(V_lds + (b) * SHM_V + vst0) = sr_[i].vs0;          \
    *(bf16x8*)(V_lds + (b) * SHM_V + vst1) = sr_[i].vs1; const int kc = sc * 2;               \
    *(bf16x8*)(K_lds + (b) * SHM_K + KSWZ(sr, kc)) = sr_[i].ks0;                       \
    *(bf16x8*)(K_lds + (b) * SHM_K + KSWZ(32 + sr, kc)) = sr_[i].ks1; } while (0)
#define SWAIT() asm volatile("s_waitcnt vmcnt(4)" ::: "memory")
#define RESC(a) do { if (__any((a) < 1.f)) { if (hi == 0) al_l[r32] = (a); asm volatile("s_waitcnt lgkmcnt(0)" ::: "memory"); \
    _Pragma("unroll") for (int d = 0; d < 4; ++d) _Pragma("unroll") for (int r = 0; r < 16; ++r) o[d][r] *= al_l[crow(r, hi)]; } } while (0)
  f32x16 pA0, pA1, pB0, pB1; float mnA, mnB, alA, alB; bf16x8 pa0, pa1, pa2, pa3;
  constexpr int SE = 0, SO = 1;
  SLOAD(SE, 0); asm volatile("s_waitcnt vmcnt(0)" ::: "memory"); SWRITE(0, SE); __syncthreads();
  qkt(pA0, pA1, K_lds, qr, r32, hi); post_scores<MODE>(pA0, pA1, 0, qrow0, r32, hi, tab, cfar); partialSM(pA0, pA1, m_reg, mnA, alA);
  SLOAD(SO, KVBLK); if (2 < NT) SLOAD(SE, 2 * KVBLK);
  SWAIT(); SWRITE(1, SO); __syncthreads();
  for (int j = 1; j + 1 < NT; j += 2) {
    SBAR(); qkt(pB0, pB1, K_lds + SHM_K, qr, r32, hi); post_scores<MODE>(pB0, pB1, j, qrow0, r32, hi, tab, cfar);
    finishSM(pA0, pA1, alA, l_reg, pa0, pa1, pa2, pa3); SBAR();
    SLOAD(SO, (j + 2) * KVBLK); SBAR();
    pv_d0(o, vb0, pa0, pa1, pa2, pa3); partialSM(pB0, pB1, m_reg, mnB, alB);
    __syncthreads(); SWAIT(); SWRITE(0, SE);
    RESC(alB); __syncthreads();
    SBAR(); qkt(pA0, pA1, K_lds, qr, r32, hi); post_scores<MODE>(pA0, pA1, j + 1, qrow0, r32, hi, tab, cfar);
    finishSM(pB0, pB1, alB, l_reg, pa0, pa1, pa2, pa3); SBAR();
    if (j + 3 < NT) SLOAD(SE, (j + 3) * KVBLK); SBAR();
    pv_d0(o, vb0 + (int)SHM_V, pa0, pa1, pa2, pa3); partialSM(pA0, pA1, m_reg, mnA, alA);
    __syncthreads(); SWAIT(); SWRITE(1, SO);
    RESC(alA); __syncthreads();
  }
  SBAR(); qkt(pB0, pB1, K_lds + SHM_K, qr, r32, hi); post_scores<MODE>(pB0, pB1, NT - 1, qrow0, r32, hi, tab, cfar);
  finishSM(pA0, pA1, alA, l_reg, pa0, pa1, pa2, pa3); SBAR();
  pv_d0(o, vb0, pa0, pa1, pa2, pa3); partialSM(pB0, pB1, m_reg, mnB, alB);
  __syncthreads(); RESC(alB);
  finishSM(pB0, pB1, alB, l_reg, pa0, pa1, pa2, pa3); SBAR();
  pv_d0(o, vb0 + (int)SHM_V, pa0, pa1, pa2, pa3);
  if (hi == 0) li_l[r32] = l_reg; asm volatile("s_waitcnt lgkmcnt(0)" ::: "memory");
  float rli[16];
#pragma unroll
  for (int r = 0; r < 16; ++r) rli[r] = __builtin_amdgcn_rcpf(li_l[crow(r, hi)]);
  if constexpr (MODE == 0) {
    bf16* Ow = Ob + (long)(wid * QBLK) * ldo;
#pragma unroll
    for (int r = 0; r < 16; ++r) { const int orow = crow(r, hi);
#pragma unroll
      for (int d0 = 0; d0 < 4; ++d0) Ow[(long)orow * ldo + d0 * 32 + r32] = (bf16)f2bf(o[d0][r] * rli[r]); }
  } else {
    float* Ow = Of + (long)(wid * QBLK) * ldo;
#pragma unroll
    for (int r = 0; r < 16; ++r) { const int orow = crow(r, hi);
#pragma unroll
      for (int d0 = 0; d0 < 4; ++d0) Ow[(long)orow * ldo + d0 * 32 + r32] = o[d0][r] * rli[r]; }
  }
  __syncthreads();
#undef SLOAD
#undef SWRITE
#undef SWAIT
#undef RESC
}
}

#define XB_TMO      128
#define XB_XCNT(j)  (256  + 64 * (j))
#define XB_XSUB(j)  (1280 + 64 * (j))
#define XB_XGEN(j)  (2304 + 64 * (j))
#define XB_TOP      3328
#define XB_TOPGEN   3392
#define XCD_BAR_WORDS 3456
#define XB_SPIN_CAP (1u << 18)

__device__ __forceinline__ unsigned xb_ld(unsigned* p)              { return __hip_atomic_load(p, __ATOMIC_RELAXED, __HIP_MEMORY_SCOPE_AGENT); }
__device__ __forceinline__ unsigned xb_add(unsigned* p, unsigned v) { return __hip_atomic_fetch_add(p, v, __ATOMIC_RELAXED, __HIP_MEMORY_SCOPE_AGENT); }
__device__ __forceinline__ unsigned xb_xcc_id() { return (unsigned)__builtin_amdgcn_s_getreg((3 << 11) | 20) & 0xFu; }
#define XB_SPIN(cond, bar) do { unsigned _sp = 0; while (cond) { __builtin_amdgcn_s_sleep(1); \
    if ((++_sp & 255u) == 0u) { if (xb_ld(&(bar)[XB_TMO])) break; if (_sp > XB_SPIN_CAP) { atomicAdd(&(bar)[XB_TMO], 1u); break; } } } } while (0)

struct XcdBarrier {
    unsigned* bar; unsigned x;
    volatile LAS unsigned* st;
};

__device__ __forceinline__ XcdBarrier xcd_barrier_post(unsigned* bar, volatile LAS unsigned* st) {
    XcdBarrier b; b.bar = bar; b.x = xb_xcc_id(); b.st = st;
    if (threadIdx.x == 0) (void)xb_add(&bar[XB_XCNT(b.x)], 1u);
    return b;
}
__device__ __forceinline__ void xcd_barrier_complete(unsigned* bar, unsigned x, unsigned& nloc, unsigned& nx) {
    const unsigned G = gridDim.x * gridDim.y * gridDim.z;
    unsigned sum, cnt, mine, sp = 0u;
    for (;;) {
        sum = 0u; cnt = 0u; mine = 0u;
#pragma unroll
        for (unsigned j = 0; j < 16; ++j) { const unsigned c = xb_ld(&bar[XB_XCNT(j)]); sum += c; cnt += (c > 0u) ? 1u : 0u; mine = (j == x) ? c : mine; }
        if (sum == G) break;
        __builtin_amdgcn_s_sleep(1);
        if ((++sp & 255u) == 0u) { if (xb_ld(&bar[XB_TMO])) break; if (sp > XB_SPIN_CAP) { atomicAdd(&bar[XB_TMO], 1u); break; } }
    }
    nloc = mine > 0u ? mine : 1u; nx = cnt > 0u ? cnt : 1u;
}

__device__ __forceinline__ void xcd_barrier(const XcdBarrier& b) {
    asm volatile("s_waitcnt vmcnt(0)" ::: "memory");
    __syncthreads();
    if (threadIdx.x == 0) {
        unsigned* bar = b.bar;
        __builtin_amdgcn_s_waitcnt(0);
        unsigned nloc = b.st[0], nx = b.st[1];
        if (nloc == 0u) { xcd_barrier_complete(bar, b.x, nloc, nx); b.st[0] = nloc; b.st[1] = nx; }
        const unsigned old = xb_add(&bar[XB_XSUB(b.x)], 1u);
        const unsigned gen = old / nloc;
        if (old + 1u == (gen + 1u) * nloc) {
            __builtin_amdgcn_fence(__ATOMIC_RELEASE, "agent");
            asm volatile("s_waitcnt vmcnt(0)" ::: "memory");
            const unsigned og = xb_add(&bar[XB_TOP], 1u);
            const unsigned tg = og / nx;
            if (og + 1u == (tg + 1u) * nx) xb_add(&bar[XB_TOPGEN], 1u);
            else XB_SPIN(xb_ld(&bar[XB_TOPGEN]) == tg, bar);
            __builtin_amdgcn_fence(__ATOMIC_ACQUIRE, "agent");
            xb_add(&bar[XB_XGEN(b.x)], 1u);
            asm volatile("s_waitcnt vmcnt(0)" ::: "memory");
        } else {
            XB_SPIN(xb_ld(&bar[XB_XGEN(b.x)]) == gen, bar);
            __builtin_amdgcn_fence(__ATOMIC_ACQUIRE, "agent");
            asm volatile("s_waitcnt vmcnt(0)" ::: "memory");
        }
    }
    __syncthreads();
}


struct Args { const float* in[24]; float* out; unsigned char* ws; int ph_lo, ph_hi; };
enum { I_X = 0, I_MEM, I_AWIN, I_ALNG, I_ALNB, I_AWS, I_ABS, I_AWOUT, I_BWIN, I_BLAM, I_BSUBG, I_BWOUT, I_WKV, I_RELB, I_MEMWKV, I_LNG, I_LNB,
       I_WG1, I_BG1, I_WG2, I_BG2, I_W1, I_W3, I_W2 };
constexpr int NPH_LAYER = 9, NPHASES = 1 + DEPTH * NPH_LAYER;

struct Frame {
    LAS unsigned char* lds; char* ldsg;
    gu32* ctl; unsigned char* ws;
    int tid, lane, wave, G, c;
};

__device__ __forceinline__ void transpose_item(const float* W, int K, int N, bf16* WT, int drow0, LAS float* scr, int k0, int n0, int lane) {
#pragma unroll 8
    for (int i = 0; i < 32; ++i) { const int kk = 2 * i + (lane >> 5); scr[kk * 33 + (lane & 31)] = W[(size_t)(k0 + kk) * N + n0 + (lane & 31)]; }
    LDS_WAIT(); asm volatile("" ::: "memory");
    const int c = lane & 7;
#pragma unroll
    for (int j = 0; j < 4; ++j) { const int n = (lane >> 3) + 8 * j; const LAS float* s = scr + (8 * c) * 33 + n;
        v4u o; o.x = pk2(s[0 * 33], s[1 * 33]); o.y = pk2(s[2 * 33], s[3 * 33]); o.z = pk2(s[4 * 33], s[5 * 33]); o.w = pk2(s[6 * 33], s[7 * 33]);
        *(GAS v4u*)(WT + (size_t)(drow0 + n) * K + k0 + 8 * c) = o; }
    LDS_WAIT(); asm volatile("" ::: "memory");
}
__device__ __forceinline__ void transpose_item_fast(const float* W, int K, int N, bf16* WT, int drow0, LAS float* scr, int k0, int n0, int lane) {
    float t[32];
#pragma unroll
    for (int i = 0; i < 32; ++i) t[i] = W[(size_t)(k0 + 2 * i + (lane >> 5)) * N + n0 + (lane & 31)];
#pragma unroll
    for (int i = 0; i < 32; i += 8) asm volatile("" : "+v"(t[i]), "+v"(t[i + 1]), "+v"(t[i + 2]), "+v"(t[i + 3]), "+v"(t[i + 4]), "+v"(t[i + 5]), "+v"(t[i + 6]), "+v"(t[i + 7]));
#pragma unroll
    for (int i = 0; i < 32; ++i) scr[(2 * i + (lane >> 5)) * 33 + (lane & 31)] = t[i];
    LDS_WAIT(); asm volatile("" ::: "memory");
    const int c = lane & 7;
#pragma unroll
    for (int j = 0; j < 4; ++j) { const int n = (lane >> 3) + 8 * j; const LAS float* s = scr + (8 * c) * 33 + n;
        v4u o; o.x = pk2(s[0 * 33], s[1 * 33]); o.y = pk2(s[2 * 33], s[3 * 33]); o.z = pk2(s[4 * 33], s[5 * 33]); o.w = pk2(s[6 * 33], s[7 * 33]);
        *(GAS v4u*)(WT + (size_t)(drow0 + n) * K + k0 + 8 * c) = o; }
    LDS_WAIT(); asm volatile("" ::: "memory");
}
__device__ __forceinline__ void prologue_phase(Frame& F, const Args& a) {
#ifdef TOUCH
    {
        const long nthr_ = (long)F.G * 512, gt_ = (long)F.c * 512 + F.tid; unsigned acc_ = 0u;
        for (long pg = gt_; pg < (long)(WS_END / 4096); pg += nthr_) acc_ += *(const GAS unsigned*)(F.ws + pg * 4096);
        for (long pg = gt_; pg < (long)((size_t)DEPTH * NE * D * FF * 4 / 4096); pg += nthr_) { acc_ += *(const GAS unsigned*)((const char*)a.in[I_W1] + pg * 4096); acc_ += *(const GAS unsigned*)((const char*)a.in[I_W3] + pg * 4096); acc_ += *(const GAS unsigned*)((const char*)a.in[I_W2] + pg * 4096); }
        if (acc_ == 0x12345679u) F.ctl[CW_TMO] = acc_;
    }
#endif
    LAS float* scr = (LAS float*)(F.lds + RING_OFF + F.wave * 16384);
    const int gw = F.c * NWAVES + F.wave, NGW = F.G * NWAVES;
    unsigned char* ws = F.ws;
    constexpr int S0 = 3584, S1 = 2048, S5 = 4 * 1024;
    constexpr int NITEMS = S0 + S1 + S5;
    for (int it = gw; it < NITEMS; it += NGW) {
        int r = it; const float* src; bf16* dst; int K = 2048, N;
        if (r < S0) { N = 3584; src = a.in[I_AWIN]; dst = (bf16*)(ws + WS_WAIN); }
        else if ((r -= S0) < S1) { N = 2048; src = a.in[I_AWOUT]; dst = (bf16*)(ws + WS_WAOUT); }
        else { r -= S1; const int mat = r >> 10; r &= 1023; N = 1024; src = a.in[I_MEMWKV] + (size_t)mat * K * N; dst = (bf16*)(ws + WS_WMKV) + (size_t)mat * K * N; }
        const int nblk = N / 32, kb = r / nblk, nb = r - kb * nblk;
        transpose_item_fast(src, K, N, dst, 32 * nb, scr, 64 * kb, 32 * nb, F.lane);
    }
    const long nthr = (long)F.G * 512, gt = (long)F.c * 512 + F.tid;
    { float* wr = (float*)(ws + WS_WR);
      for (long i = gt; i < (long)DEPTH * 3 * 512 * 16 * 4; i += nthr) { const int j = (int)(i & 3), c = (int)((i >> 2) & 15), kg = (int)((i >> 6) & 511), r = (int)(i >> 15), nb = r % 3, l = r / 3;
          const int k = 4 * kg + j, o = 16 * nb + c; float v = 0.f;
          if (o < 4) v = a.in[I_WG1][((size_t)l * D + k) * 4 + o]; else if (o < 36) { const int g = (o - 4) >> 3, e = (o - 4) & 7; v = a.in[I_WG2][(((size_t)l * 4 + g) * D + k) * 8 + e]; }
          wr[i] = v; } }
    { const float* x = a.in[I_X]; bf16* xb = (bf16*)(ws + WS_XB);
      for (long i = gt; i < (long)T * D / 8; i += nthr) { const f32x4 v0 = *(const GAS f32x4*)(x + i * 8), v1 = *(const GAS f32x4*)(x + i * 8 + 4);
          v4u o; o.x = pk2(v0.x, v0.y); o.y = pk2(v0.z, v0.w); o.z = pk2(v1.x, v1.y); o.w = pk2(v1.z, v1.w); *(GAS v4u*)(xb + i * 8) = o; } }
    { const float* x = a.in[I_MEM]; bf16* xb = (bf16*)(ws + WS_MEMB);
      for (long i = gt; i < (long)MEMT * D / 8; i += nthr) { const f32x4 v0 = *(const GAS f32x4*)(x + i * 8), v1 = *(const GAS f32x4*)(x + i * 8 + 4);
          v4u o; o.x = pk2(v0.x, v0.y); o.y = pk2(v0.z, v0.w); o.z = pk2(v1.x, v1.y); o.w = pk2(v1.z, v1.w); *(GAS v4u*)(xb + i * 8) = o; } }
}

__device__ __forceinline__ void transpose_item_fp8(const float* W, int K, int N, unsigned char* WT, int drow0, LAS float* scr, int k0, int n0, int lane) {
    float t[32];
#pragma unroll
    for (int i = 0; i < 32; ++i) t[i] = W[(size_t)(k0 + 2 * i + (lane >> 5)) * N + n0 + (lane & 31)];
#pragma unroll
    for (int i = 0; i < 32; i += 8) asm volatile("" : "+v"(t[i]), "+v"(t[i + 1]), "+v"(t[i + 2]), "+v"(t[i + 3]), "+v"(t[i + 4]), "+v"(t[i + 5]), "+v"(t[i + 6]), "+v"(t[i + 7]));
#pragma unroll
    for (int i = 0; i < 32; ++i) scr[(2 * i + (lane >> 5)) * 33 + (lane & 31)] = t[i];
    LDS_WAIT(); asm volatile("" ::: "memory");
    const int c = lane & 7;
#pragma unroll
    for (int j = 0; j < 4; ++j) { const int n = (lane >> 3) + 8 * j; const LAS float* s = scr + (8 * c) * 33 + n;
        unsigned lo = 0u, hi = 0u;
        lo = __builtin_amdgcn_cvt_pk_fp8_f32(s[0 * 33] * 64.f, s[1 * 33] * 64.f, lo, false); lo = __builtin_amdgcn_cvt_pk_fp8_f32(s[2 * 33] * 64.f, s[3 * 33] * 64.f, lo, true);
        hi = __builtin_amdgcn_cvt_pk_fp8_f32(s[4 * 33] * 64.f, s[5 * 33] * 64.f, hi, false); hi = __builtin_amdgcn_cvt_pk_fp8_f32(s[6 * 33] * 64.f, s[7 * 33] * 64.f, hi, true);
        v2u o; o.x = lo; o.y = hi; *(GAS v2u*)(WT + (size_t)(drow0 + n) * K + k0 + 8 * c) = o; }
    LDS_WAIT(); asm volatile("" ::: "memory");
}
#ifndef CDRAIN
#define CDRAIN 8
#endif
#ifndef CSRV
#define CSRV 4
#endif
#ifndef QA
#define QA 14
#endif
#ifndef QM
#define QM 7
#endif
#ifndef QB
#define QB 4
#endif
constexpr int NQ = 7, MOE_ITEMS = 3 * 32 * 512;
__device__ __forceinline__ int conv_qsize(int q) { return (q & 1) ? (q == 1 ? 5632 : (q == 3 ? 7168 : 4096)) : MOE_ITEMS; }
__device__ __forceinline__ void conv_item(Frame& F, const Args& a, int q, int it) {
    LAS float* scr = (LAS float*)(F.lds + RING_OFF + F.wave * 16384);
    if (q & 1) {
        const float* src; bf16* dst; int N, r = it;
        if (q == 1) { if (r < 3584) { N = 3584; src = a.in[I_AWIN] + (size_t)2048 * 3584; dst = (bf16*)(F.ws + WS_WAIN) + (size_t)2048 * 3584; } else { r -= 3584; N = 2048; src = a.in[I_AWOUT] + (size_t)2048 * 2048; dst = (bf16*)(F.ws + WS_WAOUT) + (size_t)2048 * 2048; } }
        else if (q == 3) { if (r < 2048) { N = 2048; src = a.in[I_BWIN]; dst = (bf16*)(F.ws + WS_WBIN0); } else if ((r -= 2048) < 3072) { N = 3072; src = a.in[I_WKV]; dst = (bf16*)(F.ws + WS_WKV); } else { r -= 3072; N = 2048; src = a.in[I_BWOUT]; dst = (bf16*)(F.ws + WS_WBOUT); } }
        else { if (r < 2048) { N = 2048; src = a.in[I_BWIN] + (size_t)2048 * 2048; dst = (bf16*)(F.ws + WS_WBIN1); } else { r -= 2048; N = 2048; src = a.in[I_BWOUT] + (size_t)2048 * 2048; dst = (bf16*)(F.ws + WS_WBOUT) + (size_t)2048 * 2048; } }
        const int nblk = N / 32, kb = r / nblk, nb = r - kb * nblk;
        transpose_item_fast(src, 2048, N, dst, 32 * nb, scr, 64 * kb, 32 * nb, F.lane);
        return;
    }
    const int L = q >> 1, seg = it >> 14, r0 = it & 16383, e = r0 >> 9, r = r0 & 511, mat = L * 32 + e;
    if (seg < 2) { const int kb = r >> 4, nb = r & 15, n0 = 32 * nb;
        transpose_item_fp8(a.in[seg == 0 ? I_W1 : I_W3] + (size_t)mat * 2048 * 512, 2048, 512, (unsigned char*)(F.ws + WS_W13) + (size_t)mat * 1024 * 2048, (n0 >> 7) * 256 + (n0 & 127) + (seg == 1 ? 128 : 0), scr, 64 * kb, n0, F.lane); }
    else { const int kb = r >> 6, nb = r & 63;
        transpose_item_fp8(a.in[I_W2] + (size_t)mat * 512 * 2048, 512, 2048, (unsigned char*)(F.ws + WS_W2) + (size_t)mat * 512 * 2048, 32 * nb, scr, 64 * kb, 32 * nb, F.lane); }
}
#ifndef CDEPTH
#define CDEPTH 2
#endif
struct CDesc { const float* src; unsigned char* dst; int N, K, drow0, k0, n0, f8; };
__device__ __forceinline__ CDesc conv_desc(Frame& F, const Args& a, int q, int it) {
    CDesc d;
    if (q & 1) {
        const float* src; bf16* dst; int N, r = it;
        if (q == 1) { if (r < 3584) { N = 3584; src = a.in[I_AWIN] + (size_t)2048 * 3584; dst = (bf16*)(F.ws + WS_WAIN) + (size_t)2048 * 3584; } else { r -= 3584; N = 2048; src = a.in[I_AWOUT] + (size_t)2048 * 2048; dst = (bf16*)(F.ws + WS_WAOUT) + (size_t)2048 * 2048; } }
        else if (q == 3) { if (r < 2048) { N = 2048; src = a.in[I_BWIN]; dst = (bf16*)(F.ws + WS_WBIN0); } else if ((r -= 2048) < 3072) { N = 3072; src = a.in[I_WKV]; dst = (bf16*)(F.ws + WS_WKV); } else { r -= 3072; N = 2048; src = a.in[I_BWOUT]; dst = (bf16*)(F.ws + WS_WBOUT); } }
        else { if (r < 2048) { N = 2048; src = a.in[I_BWIN] + (size_t)2048 * 2048; dst = (bf16*)(F.ws + WS_WBIN1); } else { r -= 2048; N = 2048; src = a.in[I_BWOUT] + (size_t)2048 * 2048; dst = (bf16*)(F.ws + WS_WBOUT) + (size_t)2048 * 2048; } }
        const int nblk = N / 32, kb = r / nblk, nb = r - kb * nblk;
        d.src = src; d.dst = (unsigned char*)dst; d.N = N; d.K = 2048; d.drow0 = 32 * nb; d.k0 = 64 * kb; d.n0 = 32 * nb; d.f8 = 0; return d;
    }
    const int L = q >> 1, seg = it >> 14, r0 = it & 16383, e = r0 >> 9, r = r0 & 511, mat = L * 32 + e;
    if (seg < 2) { const int kb = r >> 4, nb = r & 15, n0 = 32 * nb;
        d.src = a.in[seg == 0 ? I_W1 : I_W3] + (size_t)mat * 2048 * 512; d.dst = (unsigned char*)(F.ws + WS_W13) + (size_t)mat * 1024 * 2048; d.N = 512; d.K = 2048;
        d.drow0 = (n0 >> 7) * 256 + (n0 & 127) + (seg == 1 ? 128 : 0); d.k0 = 64 * kb; d.n0 = n0; d.f8 = 1; }
    else { const int kb = r >> 6, nb = r & 63;
        d.src = a.in[I_W2] + (size_t)mat * 512 * 2048; d.dst = (unsigned char*)(F.ws + WS_W2) + (size_t)mat * 512 * 2048; d.N = 2048; d.K = 512; d.drow0 = 32 * nb; d.k0 = 64 * kb; d.n0 = 32 * nb; d.f8 = 1; }
    return d;
}
#define CV_LOAD(t_, d_) do { const float* p_ = (d_).src + (size_t)((d_).k0 + (F.lane >> 3)) * (d_).N + (d_).n0 + 4 * (F.lane & 7); const size_t st_ = (size_t)8 * (d_).N; \
    _Pragma("unroll") for (int i_ = 0; i_ < 8; ++i_) (t_)[i_] = *(const GAS f32x4*)(p_ + st_ * i_); } while (0)
__device__ __forceinline__ void conv_process(Frame& F, f32x4 (&t)[8], const CDesc& d) {
    LAS float* scr = (LAS float*)(F.lds + RING_OFF + F.wave * 16384); const int lane = F.lane;
    asm volatile("" : "+v"(t[0]), "+v"(t[1]), "+v"(t[2]), "+v"(t[3]), "+v"(t[4]), "+v"(t[5]), "+v"(t[6]), "+v"(t[7]));
    { LAS float* w = scr + (lane >> 3) * 33 + 4 * (lane & 7);
#pragma unroll
      for (int i = 0; i < 8; ++i) { w[i * 8 * 33 + 0] = t[i].x; w[i * 8 * 33 + 1] = t[i].y; w[i * 8 * 33 + 2] = t[i].z; w[i * 8 * 33 + 3] = t[i].w; } }
    LDS_WAIT(); asm volatile("" ::: "memory");
    const int c = lane & 7;
    if (d.f8) {
#pragma unroll
        for (int j = 0; j < 4; ++j) { const int n = (lane >> 3) + 8 * j; const LAS float* s = scr + (8 * c) * 33 + n;
            unsigned lo = 0u, hi = 0u;
            lo = __builtin_amdgcn_cvt_pk_fp8_f32(s[0 * 33] * 64.f, s[1 * 33] * 64.f, lo, false); lo = __builtin_amdgcn_cvt_pk_fp8_f32(s[2 * 33] * 64.f, s[3 * 33] * 64.f, lo, true);
            hi = __builtin_amdgcn_cvt_pk_fp8_f32(s[4 * 33] * 64.f, s[5 * 33] * 64.f, hi, false); hi = __builtin_amdgcn_cvt_pk_fp8_f32(s[6 * 33] * 64.f, s[7 * 33] * 64.f, hi, true);
            v2u o; o.x = lo; o.y = hi; *(GAS v2u*)(d.dst + (size_t)(d.drow0 + n) * d.K + d.k0 + 8 * c) = o; }
    } else {
#pragma unroll
        for (int j = 0; j < 4; ++j) { const int n = (lane >> 3) + 8 * j; const LAS float* s = scr + (8 * c) * 33 + n;
            v4u o; o.x = pk2(s[0 * 33], s[1 * 33]); o.y = pk2(s[2 * 33], s[3 * 33]); o.z = pk2(s[4 * 33], s[5 * 33]); o.w = pk2(s[6 * 33], s[7 * 33]);
            *(GAS v4u*)((bf16*)d.dst + (size_t)(d.drow0 + n) * d.K + d.k0 + 8 * c) = o; }
    }
    LDS_WAIT(); asm volatile("" ::: "memory");
}
__device__ __forceinline__ void conv_range(Frame& F, const Args& a, int q, int first, int cnt) {
#if CDEPTH == 1
    for (int i = 0; i < cnt; ++i) conv_item(F, a, q, first + i);
#else
    f32x4 t[CDEPTH][8]; const int last = first + cnt - 1;
#pragma unroll
    for (int s = 0; s < CDEPTH - 1; ++s) { const int it = first + s < last ? first + s : last; const CDesc d = conv_desc(F, a, q, it); CV_LOAD(t[s], d); }
#pragma unroll 1
    for (int i0 = 0; i0 < cnt; i0 += CDEPTH) {
#pragma unroll
        for (int s = 0; s < CDEPTH; ++s) {
            { const int nx = first + i0 + s + CDEPTH - 1, it = nx < last ? nx : last; const CDesc d = conv_desc(F, a, q, it); CV_LOAD(t[(s + CDEPTH - 1) % CDEPTH], d); }
            asm volatile("" ::: "memory");
            if (i0 + s < cnt) { const CDesc d = conv_desc(F, a, q, first + i0 + s); conv_process(F, t[s], d); }
        }
    }
#endif
}
__device__ __forceinline__ void conv_filler(Frame& F, const Args& a, int q0, int n) {
    if (q0 >= NQ || n == 0) return;
    LAS unsigned* bw = (LAS unsigned*)(F.lds + TAB_OFF + 384);
    __syncthreads();
    const bool drain = n < 0; const int per = drain ? CDRAIN : n; int q = q0;
    for (;;) {
        if (F.tid == 0) bw[0] = __hip_atomic_fetch_add(F.ctl + CW_CONV + 64 * q, (unsigned)(8 * per), RLX_AGENT);
        __syncthreads();
        const unsigned idx = bw[0];
        __syncthreads();
        const int qs = conv_qsize(q);
        if (idx >= (unsigned)qs) { if (drain || ++q >= NQ) break; continue; }
        { const int first = (int)idx + F.wave * per, cnt = (qs - first < per) ? qs - first : per; if (cnt > 0) conv_range(F, a, q, first, cnt); }
        if (!drain) break;
    }
}

#ifndef NCVMAX
#define NCVMAX 32
#endif
#ifndef NCVATT
#define NCVATT 16
#endif
__device__ __forceinline__ int conv_servers(int nu, int G, int fin) {
    if (fin || nu <= 0) return 0;
    const int rounds = (nu + G - 1) / G, gmin = (nu + rounds - 1) / rounds; int n = G - gmin; n = n < NCVMAX ? n : NCVMAX; return n & ~7;
}
__device__ __forceinline__ void conv_done(Frame& F, int p) { __syncthreads(); if (F.tid == 0) __hip_atomic_fetch_add(F.ctl + CW_DONE + 64 * p, 1u, RLX_AGENT); }
__device__ __forceinline__ void conv_server(Frame& F, const Args& a, int p, int q0, int ncomp) {
    int q = q0;
    for (;;) {
        if (q >= NQ) break;
        unsigned idx = 0xffffffffu;
        if (F.lane == 0) { if (__hip_atomic_load(F.ctl + CW_DONE + 64 * p, RLX_AGENT) < (unsigned)ncomp) idx = __hip_atomic_fetch_add(F.ctl + CW_CONV + 64 * q, (unsigned)CSRV, RLX_AGENT); }
        idx = (unsigned)__builtin_amdgcn_readfirstlane((int)idx);
        if (idx == 0xffffffffu) break;
        const int qs = conv_qsize(q);
        if (idx >= (unsigned)qs) { ++q; continue; }
        conv_range(F, a, q, (int)idx, (qs - (int)idx < CSRV) ? qs - (int)idx : CSRV);
    }
}
__device__ __forceinline__ void conv_note_fin(Frame& F, int p) {
    if (blockIdx.x == 0 && F.tid == 0) { unsigned all = 1u;
        for (int q = 0; q < NQ; ++q) all &= (__hip_atomic_load(F.ctl + CW_CONV + 64 * q, RLX_AGENT) >= (unsigned)conv_qsize(q)) ? 1u : 0u;
        __hip_atomic_store(F.ctl + CW_FIN + 64 * p, all, RLX_AGENT); }
}

__device__ __forceinline__ void sgu_unit(Frame& F, const Args& a, int l, int n, int g) {
    constexpr int LDW = 136;
    LAS float* stats = (LAS float*)(F.lds); LAS bf16* Wl = (LAS bf16*)(F.lds + 1024); LAS bf16* Vt = (LAS bf16*)(F.lds + 35840);
    const bf16* z = (const bf16*)(F.ws + WS_Z); bf16* cat = (bf16*)(F.ws + WS_CAT);
    const int tok0 = n * 128;
    for (int i = 0; i < 16; ++i) { const int tk = F.wave * 16 + i; const GAS v4u* rp = (const GAS v4u*)(z + (size_t)(tok0 + tk) * NINA + MIXW) + F.lane;
        v4u w[3]; float s = 0.f;
#pragma unroll
        for (int j = 0; j < 3; ++j) { w[j] = rp[64 * j]; s += (bflo(w[j].x) + bfhi(w[j].x)) + (bflo(w[j].y) + bfhi(w[j].y)) + (bflo(w[j].z) + bfhi(w[j].z)) + (bflo(w[j].w) + bfhi(w[j].w)); }
        const float mean = wave_sum(s) * (1.f / MIXW); float q = 0.f;
#pragma unroll
        for (int j = 0; j < 3; ++j) { float d;
            d = bflo(w[j].x) - mean; q += d * d; d = bfhi(w[j].x) - mean; q += d * d; d = bflo(w[j].y) - mean; q += d * d; d = bfhi(w[j].y) - mean; q += d * d;
            d = bflo(w[j].z) - mean; q += d * d; d = bfhi(w[j].z) - mean; q += d * d; d = bflo(w[j].w) - mean; q += d * d; d = bfhi(w[j].w) - mean; q += d * d; }
        const float rstd = 1.f / sqrtf(wave_sum(q) * (1.f / MIXW) + LN_EPS);
        if (F.lane == 0) { stats[2 * tk] = mean; stats[2 * tk + 1] = rstd; } }
    { const float* wsrc = a.in[I_AWS] + ((size_t)l * 4 + g) * 128 * 128;
      for (int p = F.tid; p < 128 * 32; p += 512) { const int i = p >> 5, j4 = (p & 31) * 4; f32x4 v = *(const GAS f32x4*)(wsrc + i * 128 + j4);
          if ((j4 >> 6) > (i >> 6)) v = (f32x4){0.f, 0.f, 0.f, 0.f};
          v2u o; o.x = pk2(v.x, v.y); o.y = pk2(v.z, v.w); *(LAS v2u*)(Wl + i * LDW + j4) = o; } }
    __syncthreads();
    { const float* lg = a.in[I_ALNG] + (size_t)l * MIXW + g * 384; const float* lb = a.in[I_ALNB] + (size_t)l * MIXW + g * 384;
      for (int p = F.tid; p < 128 * 48; p += 512) { const int j = p & 127, c8 = (p >> 7) * 8;
          const v4u w = *(const GAS v4u*)(z + (size_t)(tok0 + j) * NINA + MIXW + g * 384 + c8);
          const float mean = stats[2 * j], rstd = stats[2 * j + 1];
          const f32x4 g0 = *(const GAS f32x4*)(lg + c8), g1 = *(const GAS f32x4*)(lg + c8 + 4), b0 = *(const GAS f32x4*)(lb + c8), b1 = *(const GAS f32x4*)(lb + c8 + 4);
          float v[8] = {bflo(w.x), bfhi(w.x), bflo(w.y), bfhi(w.y), bflo(w.z), bfhi(w.z), bflo(w.w), bfhi(w.w)};
          const float gg[8] = {g0.x, g0.y, g0.z, g0.w, g1.x, g1.y, g1.z, g1.w}, bb[8] = {b0.x, b0.y, b0.z, b0.w, b1.x, b1.y, b1.z, b1.w};
#pragma unroll
          for (int e = 0; e < 8; ++e) Vt[(c8 + e) * LDW + j] = (bf16)f2bf((v[e] - mean) * rstd * gg[e] + bb[e]); } }
    __syncthreads();
    const int fr = F.lane & 15, fq = F.lane >> 4;
    f32x4 acc[8][3];
#pragma unroll
    for (int mb = 0; mb < 8; ++mb)
#pragma unroll
        for (int nb = 0; nb < 3; ++nb) acc[mb][nb] = (f32x4){0.f, 0.f, 0.f, 0.f};
#pragma unroll
    for (int ks = 0; ks < 4; ++ks) { bf16x8 bfr[3];
#pragma unroll
        for (int nb = 0; nb < 3; ++nb) bfr[nb] = *(const LAS bf16x8*)(Vt + (F.wave * 48 + nb * 16 + fr) * LDW + ks * 32 + fq * 8);
#pragma unroll
        for (int mb = 0; mb < 8; ++mb) { const bf16x8 afr = *(const LAS bf16x8*)(Wl + (mb * 16 + fr) * LDW + ks * 32 + fq * 8);
#pragma unroll
            for (int nb = 0; nb < 3; ++nb) acc[mb][nb] = __builtin_amdgcn_mfma_f32_16x16x32_bf16(bfr[nb], afr, acc[mb][nb], 0, 0, 0); } }
    const float* bs = a.in[I_ABS] + ((size_t)l * 4 + g) * 128;
#pragma unroll
    for (int mb = 0; mb < 8; ++mb) { const int i = mb * 16 + fr; const float bsv = bs[i]; const size_t tk = (size_t)(tok0 + i);
#pragma unroll
        for (int nb = 0; nb < 3; ++nb) { const int c = g * 384 + F.wave * 48 + nb * 16 + 4 * fq;
            const v2u uw = *(const GAS v2u*)(z + tk * NINA + c); const f32x4 gt = acc[mb][nb] + bsv;
            v2u o; o.x = pk2(bflo(uw.x) * gt.x, bfhi(uw.x) * gt.y); o.y = pk2(bflo(uw.y) * gt.z, bfhi(uw.y) * gt.w);
            *(GAS v2u*)(cat + tk * D + c) = o; } }
    __syncthreads();
}

__device__ __forceinline__ void memattn_unit(Frame& F, int l, int hm, int qb, int ldz, int qoff) {
    const bf16* z = (const bf16*)(F.ws + WS_Z); const bf16* kv = (const bf16*)(F.ws + WS_MEMKV) + (size_t)l * 256 * 1024; bf16* cat = (bf16*)(F.ws + WS_CAT);
    att::attn_body<0>(z + (size_t)qb * 256 * ldz + qoff + hm * 128, ldz, kv + hm * 128, kv + 512 + hm * 128, 1024,
                      cat + (size_t)qb * 256 * D + MIXW + hm * 128, nullptr, D, 4, 0, nullptr, 0.f, F.ldsg);
}

__device__ __forceinline__ int t5_bucket(int rel) {
    const int a = rel < 0 ? -rel : rel; int f;
    if (a < 8) f = a; else if (a < 12) f = 8; else if (a < 16) f = 9; else if (a < 23) f = 10; else if (a < 32) f = 11; else if (a < 46) f = 12; else if (a < 64) f = 13; else if (a < 91) f = 14; else f = 15;
    return (rel > 0 ? 16 : 0) + f;
}

namespace att2 {
using att::bf16x8; using att::s16x4; using att::f32x16; using att::u32x4; using att::crow; using att::cvtpk; using att::tr_read; using att::v_rd_base;
constexpr int KT = 32, ST_K = KT * 128 * 2, ST_V = KT * 256 * 2, STAGE = 2 * ST_K + ST_V, NST = 3;
constexpr int LDS_WS = NST * STAGE, LDS_TAB = LDS_WS + 2048, LDS_UNIT = LDS_TAB + 640, LDS_END = LDS_UNIT + 16;
constexpr int NUNITS = 576;
constexpr float THR2 = 8.f * 1.4426950408889634f;
__device__ __forceinline__ int swap23(int k) { return (k & ~0xC) | ((k & 4) << 1) | ((k & 8) >> 1); }
constexpr int v_off(int d0, int ks, int half) { return d0 * 512 + ks * 8192 + half * 4096; }

struct UnitTable { unsigned short u[NUNITS]; };
constexpr UnitTable make_units() {
    UnitTable t{}; int n = 0;
    for (int c = 256; c >= 4; c -= 2) {
        { const int b = (c - 2) / 2; if ((c - 2) % 2 == 0 && b >= 32 && b <= 63) for (int part = 1; part <= 2; ++part) for (int h = 0; h < 6; ++h) t.u[n++] = (unsigned short)(h | (b << 3) | (part << 9)); }
        if (c % 4 == 0) { const int b = c / 4 - 1; if (b >= 0 && b < 32) for (int h = 0; h < 6; ++h) t.u[n++] = (unsigned short)(h | (b << 3)); }
    }
    return t;
}
__device__ const UnitTable g_units = make_units();

__device__ __forceinline__ void diff_unit(const bf16* __restrict__ Q, const bf16* __restrict__ KD, const bf16* __restrict__ VD, float* Obuf  , int orow0,
                                          float* ML  , const float* relb, int h, int b, int t_lo, int t_hi, LAS char* lds) {
  int tid_ = threadIdx.x; asm volatile("" : "+v"(tid_));
  const int tid = tid_, wid = __builtin_amdgcn_readfirstlane(tid >> 6), lane = tid & 63, r32 = lane & 31, hi = lane >> 5, m = wid >> 2, rg = wid & 3;
  LAS float* wsw = (LAS float*)(lds + LDS_WS) + wid * 64; LAS float* li_l = wsw; LAS float* al_l = wsw + 32;
  LAS float* tab = (LAS float*)(lds + LDS_TAB);
  if (tid < att::TAB_N) tab[tid] = relb[t5_bucket(63 - tid) * 6 + h] * LOG2E;
  const float cfar = relb[15 * 6 + h] * LOG2E;
  const int qrow0 = b * 128 + rg * 32;
  bf16x8 qr[8];
  { const bf16* Qw = Q + (size_t)(qrow0 + r32) * 2048 + h * 256 + m * 128 + hi * 8;
#pragma unroll
    for (int d0 = 0; d0 < 8; ++d0) qr[d0] = *reinterpret_cast<const bf16x8*>(Qw + d0 * 16); }
  int ko[2], vo[2];
#pragma unroll
  for (int i = 0; i < 2; ++i) {
    const int p = wid * 64 + lane, row = p >> 4, cp = (p & 15) ^ (row & 7); ko[i] = row * 1536 + h * 256 + i * 128 + cp * 8; }
#pragma unroll
  for (int i = 0; i < 2; ++i) {
    const int p = (wid * 2 + i) * 64 + lane, sub = p >> 5, kg = sub >> 3, cblk = sub & 7, q = p & 31, kk = kg * 8 + (q >> 2), key = swap23(kk);
    vo[i] = key * 1536 + h * 256 + cblk * 32 + (q & 3) * 8; }
  const unsigned ldsb = (unsigned)(uintptr_t)lds;
#define A2_ISSUE(t, s) do { const size_t kb_ = (size_t)(t) * KT * 1536; LAS char* sb_ = lds + (s) * STAGE; \
    __builtin_amdgcn_global_load_lds((const unsigned*)(KD + kb_ + ko[0]), (LAS unsigned*)(sb_ + wid * 1024), 16, 0, 0); \
    __builtin_amdgcn_global_load_lds((const unsigned*)(KD + kb_ + ko[1]), (LAS unsigned*)(sb_ + ST_K + wid * 1024), 16, 0, 0); \
    __builtin_amdgcn_global_load_lds((const unsigned*)(VD + kb_ + vo[0]), (LAS unsigned*)(sb_ + 2 * ST_K + (wid * 2) * 1024), 16, 0, 0); \
    __builtin_amdgcn_global_load_lds((const unsigned*)(VD + kb_ + vo[1]), (LAS unsigned*)(sb_ + 2 * ST_K + (wid * 2 + 1) * 1024), 16, 0, 0); } while (0)
  const int vis = 2 * (2 * b + (rg >> 1) + 1);
  float m_reg = -1e30f, l_reg = 0.f; f32x16 o[8];
#pragma unroll
  for (int d = 0; d < 8; ++d) o[d] = f32x16{};
  asm volatile("s_waitcnt vmcnt(0)" ::: "memory");
  A2_ISSUE(t_lo, 0); if (t_lo + 1 < t_hi) A2_ISSUE(t_lo + 1, 1);
  int s = 0;
  for (int t = t_lo; t < t_hi; ++t) {
    if (t + 1 < t_hi) asm volatile("s_waitcnt vmcnt(4) lgkmcnt(0)" ::: "memory"); else asm volatile("s_waitcnt vmcnt(0) lgkmcnt(0)" ::: "memory");
    __builtin_amdgcn_s_barrier(); asm volatile("" ::: "memory");
    if (t + 2 < t_hi) { const int s2 = (s >= 1) ? s - 1 : s + 2; A2_ISSUE(t + 2, s2); }
    if (t < vis) {
      const LAS char* Ks = lds + s * STAGE + m * ST_K;
      f32x16 p = f32x16{};
#pragma unroll
      for (int d0 = 0; d0 < 8; ++d0) { const int cb = (d0 * 16 + hi * 8) * 2;
        const bf16x8 b0 = *(const LAS bf16x8*)(Ks + KSWZ(r32, cb));
        p = __builtin_amdgcn_mfma_f32_32x32x16_bf16(b0, qr[d0], p, 0, 0, 0); }
      if (qrow0 - (KT * t + KT - 1) >= 91) {
#pragma unroll
        for (int r = 0; r < 16; ++r) p[r] += cfar;
      } else { const int base = qrow0 + r32 - KT * t + 63;
#pragma unroll
        for (int r = 0; r < 16; ++r) { const int i0 = base - crow(r, hi); p[r] += tab[i0 < att::TAB_N - 1 ? i0 : att::TAB_N - 1]; } }
      float pmax = p[0];
#pragma unroll
      for (int r = 1; r < 16; ++r) pmax = fmaxf(pmax, p[r]);
      { auto rr = __builtin_amdgcn_permlane32_swap(__float_as_uint(pmax), __float_as_uint(pmax), false, false); pmax = fmaxf(__uint_as_float(rr[0]), __uint_as_float(rr[1])); }
      float mn, alpha;
      if (__builtin_expect(__all(pmax - m_reg <= THR2), 1)) { mn = m_reg; alpha = 1.f; }
      else { mn = fmaxf(m_reg, pmax); alpha = __builtin_amdgcn_exp2f(m_reg - mn); m_reg = mn; }
      float ps = 0.f;
#pragma unroll
      for (int r = 0; r < 16; ++r) { p[r] = __builtin_amdgcn_exp2f(p[r] - mn); ps += p[r]; }
      { auto rr = __builtin_amdgcn_permlane32_swap(__float_as_uint(ps), __float_as_uint(ps), false, false); ps = __uint_as_float(rr[0]) + __uint_as_float(rr[1]); }
      l_reg = l_reg * alpha + ps;
      bf16x8 pa0, pa1;
#define A2_PK4(P, BASE, OUT) do { unsigned a0 = cvtpk(P[BASE + 0], P[BASE + 1]), a1 = cvtpk(P[BASE + 2], P[BASE + 3]);   \
    unsigned b0_ = cvtpk(P[BASE + 4], P[BASE + 5]), b1_ = cvtpk(P[BASE + 6], P[BASE + 7]);                              \
    auto r0 = __builtin_amdgcn_permlane32_swap(a0, b0_, false, false); auto r1 = __builtin_amdgcn_permlane32_swap(a1, b1_, false, false); \
    u32x4 w = {r0[0], r1[0], r0[1], r1[1]}; OUT = *reinterpret_cast<bf16x8*>(&w); } while (0)
      A2_PK4(p, 0, pa0); A2_PK4(p, 8, pa1);
      if (__any(alpha < 1.f)) { if (hi == 0) al_l[r32] = alpha; asm volatile("s_waitcnt lgkmcnt(0)" ::: "memory");
#pragma unroll
        for (int d = 0; d < 8; ++d)
#pragma unroll
          for (int r = 0; r < 16; ++r) o[d][r] *= al_l[crow(r, hi)]; }
      const int vb = (int)(ldsb + s * STAGE + 2 * ST_K) + v_rd_base(lane);
      asm volatile("s_waitcnt lgkmcnt(0)" ::: "memory"); SBAR();
#define A2_PK(L, H) (bf16x8){L[0], L[1], L[2], L[3], H[0], H[1], H[2], H[3]}
#define A2_RD(D0, l0, h0, l1, h1) do { l0 = tr_read<v_off(D0, 0, 0)>(vb); h0 = tr_read<v_off(D0, 0, 1)>(vb); l1 = tr_read<v_off(D0, 1, 0)>(vb); h1 = tr_read<v_off(D0, 1, 1)>(vb); } while (0)
#define A2_MM(D0, l0, h0, l1, h1) do { o[D0] = __builtin_amdgcn_mfma_f32_32x32x16_bf16(pa0, A2_PK(l0, h0), o[D0], 0, 0, 0); o[D0] = __builtin_amdgcn_mfma_f32_32x32x16_bf16(pa1, A2_PK(l1, h1), o[D0], 0, 0, 0); } while (0)
      s16x4 xl0, xh0, xl1, xh1, yl0, yh0, yl1, yh1;
      A2_RD(0, xl0, xh0, xl1, xh1);
      A2_RD(1, yl0, yh0, yl1, yh1); asm volatile("s_waitcnt lgkmcnt(4)" ::: "memory"); SBAR(); A2_MM(0, xl0, xh0, xl1, xh1); SBAR();
      A2_RD(2, xl0, xh0, xl1, xh1); asm volatile("s_waitcnt lgkmcnt(4)" ::: "memory"); SBAR(); A2_MM(1, yl0, yh0, yl1, yh1); SBAR();
      A2_RD(3, yl0, yh0, yl1, yh1); asm volatile("s_waitcnt lgkmcnt(4)" ::: "memory"); SBAR(); A2_MM(2, xl0, xh0, xl1, xh1); SBAR();
      A2_RD(4, xl0, xh0, xl1, xh1); asm volatile("s_waitcnt lgkmcnt(4)" ::: "memory"); SBAR(); A2_MM(3, yl0, yh0, yl1, yh1); SBAR();
      A2_RD(5, yl0, yh0, yl1, yh1); asm volatile("s_waitcnt lgkmcnt(4)" ::: "memory"); SBAR(); A2_MM(4, xl0, xh0, xl1, xh1); SBAR();
      A2_RD(6, xl0, xh0, xl1, xh1); asm volatile("s_waitcnt lgkmcnt(4)" ::: "memory"); SBAR(); A2_MM(5, yl0, yh0, yl1, yh1); SBAR();
      A2_RD(7, yl0, yh0, yl1, yh1); asm volatile("s_waitcnt lgkmcnt(4)" ::: "memory"); SBAR(); A2_MM(6, xl0, xh0, xl1, xh1); SBAR();
      asm volatile("s_waitcnt lgkmcnt(0)" ::: "memory"); SBAR(); A2_MM(7, yl0, yh0, yl1, yh1); SBAR();
    }
    s = (s == 2) ? 0 : s + 1;
  }
  if (hi == 0) li_l[r32] = l_reg; asm volatile("s_waitcnt lgkmcnt(0)" ::: "memory");
  float rli[16];
#pragma unroll
  for (int r = 0; r < 16; ++r) rli[r] = __builtin_amdgcn_rcpf(li_l[crow(r, hi)]);
  float* Ow = Obuf + (size_t)(qrow0 - orow0) * 3072 + (h * 2 + m) * 256;
#pragma unroll
  for (int r = 0; r < 16; ++r) { const int orow = crow(r, hi);
#pragma unroll
    for (int d0 = 0; d0 < 8; ++d0) Ow[(size_t)orow * 3072 + d0 * 32 + r32] = o[d0][r] * rli[r]; }
  if (hi == 0) { float* mlp = ML + (((size_t)(qrow0 - orow0 + r32) * 6 + h) * 2 + m) * 2; mlp[0] = m_reg; mlp[1] = l_reg; }
  asm volatile("s_waitcnt vmcnt(0) lgkmcnt(0)" ::: "memory");
  __builtin_amdgcn_s_barrier(); asm volatile("" ::: "memory");
#undef A2_ISSUE
#undef A2_PK4
#undef A2_PK
#undef A2_RD
#undef A2_MM
}
}

__device__ __forceinline__ void diffattn2_unit(Frame& F, const Args& a, unsigned code) {
    const int h = code & 7, b = (code >> 3) & 63, pc = code >> 9, nt = 4 * b + 4;
    const int t_lo = (pc == 2) ? nt / 2 : 0, t_hi = (pc == 1) ? nt / 2 : nt;
    float* ob = (float*)(F.ws + (pc == 2 ? WS_OP2 : WS_OP)); float* ml = (float*)(F.ws + WS_ML) + (pc == 2 ? (size_t)T * 6 * 2 * 2 : 0);
    att2::diff_unit((const bf16*)(F.ws + WS_Z), (const bf16*)(F.ws + WS_KD), (const bf16*)(F.ws + WS_VD), ob, pc == 2 ? 4096 : 0, ml, a.in[I_RELB], h, b, t_lo, t_hi, (LAS char*)F.lds);
}
__device__ __forceinline__ void diffcombine_phase(Frame& F, const Args& a, int l) {
    const int i = l - 2; const float* lp = a.in[I_BLAM] + (size_t)i * 4 * 128;
    float s1 = lp[F.lane] * lp[128 + F.lane] + lp[64 + F.lane] * lp[128 + 64 + F.lane], s2 = lp[256 + F.lane] * lp[384 + F.lane] + lp[256 + 64 + F.lane] * lp[384 + 64 + F.lane];
    s1 = wave_sum(s1); s2 = wave_sum(s2);
    const float lam_init = 0.8f - 0.6f * expf(-0.3f * (float)l);
    const float lam = expf(s1) - expf(s2) + lam_init;
    const float* op0 = (const float*)(F.ws + WS_OP); const float* op1 = (const float*)(F.ws + WS_OP2); const float* ml0 = (const float*)(F.ws + WS_ML); const float* ml1 = ml0 + (size_t)T * 6 * 2 * 2;
    bf16* cat = (bf16*)(F.ws + WS_CAT);
    const f32x4 gsub = *(const GAS f32x4*)(a.in[I_BSUBG] + (size_t)i * 256 + 4 * F.lane);
    const int gw = F.c * NWAVES + F.wave, NGW = F.G * NWAVES;
    for (int it = gw; it < T * 6; it += NGW) { const int tk = it / 6, h = it - tk * 6; f32x4 os[2];
#pragma unroll
        for (int m = 0; m < 2; ++m) { const size_t r0 = ((size_t)tk * 6 + h) * 2 + m; f32x4 oa = *(const GAS f32x4*)(op0 + r0 * 256 + 4 * F.lane);
            if (tk >= 4096) { const size_t r1 = ((size_t)(tk - 4096) * 6 + h) * 2 + m; const f32x4 ob = *(const GAS f32x4*)(op1 + r1 * 256 + 4 * F.lane);
                const float ma = ml0[r0 * 2], la = ml0[r0 * 2 + 1], mb = ml1[r1 * 2], lb = ml1[r1 * 2 + 1], M = fmaxf(ma, mb);
                const float wa = la * exp2f(ma - M), wb = lb * exp2f(mb - M), inv = 1.f / (wa + wb); oa = oa * (wa * inv) + ob * (wb * inv); }
            os[m] = oa; }
        const f32x4 o = os[0] - os[1] * lam; const float ss = wave_sum((o.x * o.x + o.y * o.y) + (o.z * o.z + o.w * o.w));
        const float r = (1.f - lam_init) / sqrtf(ss * (1.f / 256.f) + LN_EPS);
        v2u w; w.x = pk2(o.x * r * gsub.x, o.y * r * gsub.y); w.y = pk2(o.z * r * gsub.z, o.w * r * gsub.w);
        *(GAS v2u*)(cat + (size_t)tk * D + h * 256 + 4 * F.lane) = w; }
}


__device__ __forceinline__ void ln1_router_phase(Frame& F, const Args& a, int l, int probe = 0) {
    const bf16* y = (const bf16*)(F.ws + WS_Y); bf16* x1b = (bf16*)(F.ws + WS_X1B);
    const float* lng = a.in[I_LNG] + ((size_t)l * 2 + 0) * D; const float* lnb = a.in[I_LNB] + ((size_t)l * 2 + 0) * D;
    const float* wr = (const float*)(F.ws + WS_WR) + (size_t)l * 3 * 512 * 16 * 4;
    int* tok_e = (int*)(F.ws + (probe ? WS_OP : WS_ROUTE)); int* tok_rank = tok_e + 2 * T; float* tok_gate = (float*)(tok_rank + 2 * T);
    gu32* cnt = F.ctl + (probe ? 65536 : CW_CNT) + 2048 * l;
    LAS float* P = (LAS float*)(F.lds);
    typedef float f32x4v __attribute__((ext_vector_type(4)));
    for (int tb = F.c; tb < T / 32; tb += F.G) {
#pragma unroll 2
        for (int i = 0; i < 4; ++i) { const int tk = tb * 32 + F.wave * 4 + i;
            const GAS v4u* yr = (const GAS v4u*)(y + (size_t)tk * D) + F.lane;
            float v[4][8]; float s = 0.f;
#pragma unroll
            for (int j = 0; j < 4; ++j) { const v4u w = yr[64 * j]; v[j][0] = bflo(w.x); v[j][1] = bfhi(w.x); v[j][2] = bflo(w.y); v[j][3] = bfhi(w.y); v[j][4] = bflo(w.z); v[j][5] = bfhi(w.z); v[j][6] = bflo(w.w); v[j][7] = bfhi(w.w);
#pragma unroll
                for (int e = 0; e < 8; ++e) s += v[j][e]; }
            const float mean = wave_sum(s) * (1.f / D); float s2 = 0.f;
#pragma unroll
            for (int j = 0; j < 4; ++j)
#pragma unroll
                for (int e = 0; e < 8; ++e) { v[j][e] -= mean; s2 += v[j][e] * v[j][e]; }
            const float rstd = 1.f / sqrtf(wave_sum(s2) * (1.f / D) + LN_EPS);
#pragma unroll
            for (int j = 0; j < 4; ++j) { const int d0 = 8 * F.lane + 512 * j; const f32x4 g0 = *(const GAS f32x4*)(lng + d0), g1 = *(const GAS f32x4*)(lng + d0 + 4), b0 = *(const GAS f32x4*)(lnb + d0), b1 = *(const GAS f32x4*)(lnb + d0 + 4);
                const float q0 = v[j][0] * rstd * g0.x + b0.x, q1 = v[j][1] * rstd * g0.y + b0.y, q2 = v[j][2] * rstd * g0.z + b0.z, q3 = v[j][3] * rstd * g0.w + b0.w;
                const float q4 = v[j][4] * rstd * g1.x + b1.x, q5 = v[j][5] * rstd * g1.y + b1.y, q6 = v[j][6] * rstd * g1.z + b1.z, q7 = v[j][7] * rstd * g1.w + b1.w;
                v4u w; w.x = pk2(q0, q1); w.y = pk2(q2, q3); w.z = pk2(q4, q5); w.w = pk2(q6, q7);
                *(GAS v4u*)(x1b + (size_t)tk * D + d0) = w;
                unsigned lo = 0u, hi = 0u; lo = __builtin_amdgcn_cvt_pk_fp8_f32(q0, q1, lo, false); lo = __builtin_amdgcn_cvt_pk_fp8_f32(q2, q3, lo, true);
                hi = __builtin_amdgcn_cvt_pk_fp8_f32(q4, q5, hi, false); hi = __builtin_amdgcn_cvt_pk_fp8_f32(q6, q7, hi, true);
                v2u qq; qq.x = lo; qq.y = hi; *(GAS v2u*)((unsigned char*)(F.ws + WS_X1F) + (size_t)tk * D + d0) = qq; } }
        VM_WAIT(); __syncthreads();
        { const int mt = F.wave >> 2, kq = F.wave & 3, c = F.lane & 15, q = F.lane >> 4;
          const bf16* ap = x1b + (size_t)(tb * 32 + mt * 16 + c) * D + kq * 512 + 4 * q;
          const float* bp = wr + ((size_t)(kq * 128 + q) * 16 + c) * 4;
          f32x4v acc[3] = {{0.f, 0.f, 0.f, 0.f}, {0.f, 0.f, 0.f, 0.f}, {0.f, 0.f, 0.f, 0.f}};
#pragma unroll 4
          for (int ks = 0; ks < 32; ++ks) { const v2u aw = *(const GAS v2u*)(ap + 16 * ks); const f32x4 a4 = (f32x4){bflo(aw.x), bfhi(aw.x), bflo(aw.y), bfhi(aw.y)}; f32x4 b4[3];
#pragma unroll
              for (int nb = 0; nb < 3; ++nb) b4[nb] = *(const GAS f32x4*)(bp + ((size_t)nb * 512 + 4 * ks) * 64);
#pragma unroll
              for (int j = 0; j < 4; ++j)
#pragma unroll
                  for (int nb = 0; nb < 3; ++nb) acc[nb] = __builtin_amdgcn_mfma_f32_16x16x4f32(a4[j], b4[nb][j], acc[nb], 0, 0, 0); }
#pragma unroll
          for (int nb = 0; nb < 3; ++nb)
#pragma unroll
              for (int r = 0; r < 4; ++r) P[((kq * 2 + mt) * 16 + 4 * q + r) * 48 + nb * 16 + c] = acc[nb][r]; }
        __syncthreads();
        if (F.tid < 32) { const int tk = tb * 32 + F.tid, mt = F.tid >> 4, ti = F.tid & 15;
            const LAS f32x4* P4 = (const LAS f32x4*)P;
            const int rb = (mt * 16 + ti) * 12;
            const float* bg1 = a.in[I_BG1] + l * 4; const float* bg2 = a.in[I_BG2] + l * 32;
            const f32x4 s1 = (P4[rb] + P4[rb + 384]) + (P4[rb + 768] + P4[rb + 1152]);
            const float l10 = s1.x + bg1[0], l11 = s1.y + bg1[1], l12 = s1.z + bg1[2], l13 = s1.w + bg1[3];
            int grp = 0; float mx = l10;
            if (l11 > mx) { mx = l11; grp = 1; } if (l12 > mx) { mx = l12; grp = 2; } if (l13 > mx) { mx = l13; grp = 3; }
            const float psel = 1.f / (expf(l10 - mx) + expf(l11 - mx) + expf(l12 - mx) + expf(l13 - mx));
            const int ob = rb + 1 + 2 * grp;
            const f32x4 sa = (P4[ob] + P4[ob + 384]) + (P4[ob + 768] + P4[ob + 1152]), sb = (P4[ob + 1] + P4[ob + 385]) + (P4[ob + 769] + P4[ob + 1153]);
            const f32x4 ba = *(const GAS f32x4*)(bg2 + grp * 8), bb = *(const GAS f32x4*)(bg2 + grp * 8 + 4);
            const float l2[8] = {sa.x + ba.x, sa.y + ba.y, sa.z + ba.z, sa.w + ba.w, sb.x + bb.x, sb.y + bb.y, sb.z + bb.z, sb.w + bb.w};
            int i0 = 0; float v0 = l2[0];
#pragma unroll
            for (int e = 1; e < 8; ++e) if (l2[e] > v0) { v0 = l2[e]; i0 = e; }
            int i1 = -1; float v1 = -INFINITY;
#pragma unroll
            for (int e = 0; e < 8; ++e) if (e != i0 && l2[e] > v1) { v1 = l2[e]; i1 = e; }
            const float e1 = expf(v1 - v0), g0 = psel / (1.f + e1), g1 = psel * e1 / (1.f + e1);
            const int ex0 = grp * 8 + i0, ex1 = grp * 8 + i1;
            const unsigned r0 = __hip_atomic_fetch_add(cnt + 64 * ex0, 1u, RLX_AGENT), r1 = __hip_atomic_fetch_add(cnt + 64 * ex1, 1u, RLX_AGENT);
            { int* list = (int*)(F.ws + (probe ? WS_OP + 2 * MiB : WS_LIST)); list[ex0 * 8192 + (int)r0] = tk; list[ex1 * 8192 + (int)r1] = tk; }
            tok_e[2 * tk] = ex0; tok_e[2 * tk + 1] = ex1; tok_rank[2 * tk] = (int)r0; tok_rank[2 * tk + 1] = (int)r1; tok_gate[2 * tk] = g0; tok_gate[2 * tk + 1] = g1; }
        __syncthreads();
    }
}
__device__ __forceinline__ void moe_table(Frame& F, int l) {
    LAS int* tstart = (LAS int*)(F.lds + TAB_OFF);
    if (F.tid == 0) { int acc = 0;
        for (int e = 0; e < 32; ++e) { tstart[e] = acc; const unsigned c = __hip_atomic_load(F.ctl + CW_CNT + 2048 * l + 64 * e, RLX_AGENT); tstart[36 + e] = (int)c; acc += (int)((c + 255u) >> 8); }
        tstart[32] = acc; }
    __syncthreads();
}
__device__ __forceinline__ void ln2_phase(Frame& F, const Args& a, int l) {
    const bf16* x1b = (const bf16*)(F.ws + WS_X1B); const bf16* yb = (const bf16*)(F.ws + WS_YB); bf16* xb = (bf16*)(F.ws + WS_XB);
    const float* lng = a.in[I_LNG] + ((size_t)l * 2 + 1) * D; const float* lnb = a.in[I_LNB] + ((size_t)l * 2 + 1) * D;
    moe_table(F, l); const LAS int* tstart = (const LAS int*)(F.lds + TAB_OFF);
    const int* tok_e = (const int*)(F.ws + WS_ROUTE); const int* tok_rank = tok_e + 2 * T; const float* tok_gate = (const float*)(F.ws + WS_ROUTE) + 4 * T;
    const int gw = F.c * NWAVES + F.wave, NGW = F.G * NWAVES;
    for (int t4 = gw; t4 < T / 4; t4 += NGW) { const int tk0 = t4 * 4;
        int ev = 0, rv = 0; float gv = 0.f;
        if (F.lane < 8) { ev = tok_e[2 * tk0 + F.lane]; rv = tok_rank[2 * tk0 + F.lane]; gv = tok_gate[2 * tk0 + F.lane]; }
        const int slotv = (F.lane < 8) ? tstart[ev] * 256 + rv : 0;
        v4u xr[2], ya[2], yc[2]; v4u xr2[2], ya2[2], yc2[2];
#define LN2_LOAD(i, XR, YA, YC, XR2, YA2, YC2) do { const int s0_ = __builtin_amdgcn_readlane(slotv, 2 * (i)), s1_ = __builtin_amdgcn_readlane(slotv, 2 * (i) + 1); \
        _Pragma("unroll") for (int j = 0; j < 2; ++j) { const int d0 = 8 * F.lane + 512 * j; XR[j] = *(const GAS v4u*)(x1b + (size_t)(tk0 + (i)) * D + d0); YA[j] = *(const GAS v4u*)(yb + (size_t)s0_ * D + d0); YC[j] = *(const GAS v4u*)(yb + (size_t)s1_ * D + d0); } \
        _Pragma("unroll") for (int j = 0; j < 2; ++j) { const int d0 = 8 * F.lane + 512 * (j + 2); XR2[j] = *(const GAS v4u*)(x1b + (size_t)(tk0 + (i)) * D + d0); YA2[j] = *(const GAS v4u*)(yb + (size_t)s0_ * D + d0); YC2[j] = *(const GAS v4u*)(yb + (size_t)s1_ * D + d0); } } while (0)
        LN2_LOAD(0, xr, ya, yc, xr2, ya2, yc2);
#pragma unroll
        for (int i = 0; i < 4; ++i) { const int tk = tk0 + i;
            const float g0 = __builtin_bit_cast(float, __builtin_amdgcn_readlane(__builtin_bit_cast(int, gv), 2 * i)), g1 = __builtin_bit_cast(float, __builtin_amdgcn_readlane(__builtin_bit_cast(int, gv), 2 * i + 1));
            float v[4][8]; float s = 0.f;
#pragma unroll
            for (int j = 0; j < 4; ++j) { const v4u X = j < 2 ? xr[j] : xr2[j - 2], A = j < 2 ? ya[j] : ya2[j - 2], C = j < 2 ? yc[j] : yc2[j - 2];
                v[j][0] = bflo(X.x) * DN_ALPHA + (g0 * bflo(A.x) + g1 * bflo(C.x)); v[j][1] = bfhi(X.x) * DN_ALPHA + (g0 * bfhi(A.x) + g1 * bfhi(C.x));
                v[j][2] = bflo(X.y) * DN_ALPHA + (g0 * bflo(A.y) + g1 * bflo(C.y)); v[j][3] = bfhi(X.y) * DN_ALPHA + (g0 * bfhi(A.y) + g1 * bfhi(C.y));
                v[j][4] = bflo(X.z) * DN_ALPHA + (g0 * bflo(A.z) + g1 * bflo(C.z)); v[j][5] = bfhi(X.z) * DN_ALPHA + (g0 * bfhi(A.z) + g1 * bfhi(C.z));
                v[j][6] = bflo(X.w) * DN_ALPHA + (g0 * bflo(A.w) + g1 * bflo(C.w)); v[j][7] = bfhi(X.w) * DN_ALPHA + (g0 * bfhi(A.w) + g1 * bfhi(C.w));
#pragma unroll
                for (int e = 0; e < 8; ++e) s += v[j][e]; }
            if (i + 1 < 4) LN2_LOAD(i + 1, xr, ya, yc, xr2, ya2, yc2);
            const float mean = wave_sum(s) * (1.f / D); float s2 = 0.f;
#pragma unroll
            for (int j = 0; j < 4; ++j)
#pragma unroll
                for (int e = 0; e < 8; ++e) { v[j][e] -= mean; s2 += v[j][e] * v[j][e]; }
            const float rstd = 1.f / sqrtf(wave_sum(s2) * (1.f / D) + LN_EPS);
#pragma unroll
            for (int j = 0; j < 4; ++j) { const int d0 = 8 * F.lane + 512 * j; const f32x4 g0v = *(const GAS f32x4*)(lng + d0), g1v = *(const GAS f32x4*)(lng + d0 + 4), b0 = *(const GAS f32x4*)(lnb + d0), b1 = *(const GAS f32x4*)(lnb + d0 + 4);
                const f32x4 oa = (f32x4){v[j][0] * rstd * g0v.x + b0.x, v[j][1] * rstd * g0v.y + b0.y, v[j][2] * rstd * g0v.z + b0.z, v[j][3] * rstd * g0v.w + b0.w};
                const f32x4 ob = (f32x4){v[j][4] * rstd * g1v.x + b1.x, v[j][5] * rstd * g1v.y + b1.y, v[j][6] * rstd * g1v.z + b1.z, v[j][7] * rstd * g1v.w + b1.w};
                if (l == DEPTH - 1) { *(GAS f32x4*)(a.out + (size_t)tk * D + d0) = oa; *(GAS f32x4*)(a.out + (size_t)tk * D + d0 + 4) = ob; }
                else { v4u w; w.x = pk2(oa.x, oa.y); w.y = pk2(oa.z, oa.w); w.z = pk2(ob.x, ob.y); w.w = pk2(ob.z, ob.w); *(GAS v4u*)(xb + (size_t)tk * D + d0) = w; } }
        }
#undef LN2_LOAD
    }
}

__global__ void __launch_bounds__(NWAVES * 64, 2) fwd_kernel(Args args) {
    extern __shared__ __attribute__((aligned(16))) unsigned char lds[];
    Frame F;
    F.lds = (LAS unsigned char*)lds; F.ldsg = (char*)lds;
    F.tid = threadIdx.x; F.lane = F.tid & 63; F.wave = __builtin_amdgcn_readfirstlane(F.tid >> 6);
    F.G = gridDim.x; F.c = blockIdx.x; F.ws = args.ws; F.ctl = (gu32*)(args.ws + WS_CTL);
    volatile LAS unsigned* MISC = (volatile LAS unsigned*)(F.lds + MISC_OFF);
    for (int u = F.tid; u < (LDS_BYTES - LDSCTL_OFF) / 4; u += NWAVES * 64) ((LAS unsigned*)(F.lds + LDSCTL_OFF))[u] = 0u;
    __syncthreads();
    const int lo = args.ph_lo, hi = args.ph_hi; int lastp = -1;
    const bool multi = (hi - lo) > 1;
    XcdBarrier bar; bar.bar = (unsigned*)(F.ctl + CW_BAR); bar.x = 0; bar.st = nullptr;
    if (multi) bar = xcd_barrier_post((unsigned*)(F.ctl + CW_BAR), MISC + 8);
#ifndef REP_MASK
#define REP_MASK 0
#endif
#define REP(k) for (int rep_ = 0; rep_ <= ((REP_MASK >> (k)) & 1); ++rep_)
#define IN(p) (lo <= (p) && (p) < hi)
#ifdef PROBE_A
#define STAMP(i) do { if (blockIdx.x == 0 && threadIdx.x == 0) ((unsigned long long*)(args.ws + WS_TS))[(i)] = __builtin_amdgcn_s_memrealtime(); } while (0)
#else
#define STAMP(i) do { } while (0)
#endif
#define SEAM(p) do { conv_note_fin(F, (p)); lastp = (p); if ((p) + 1 < hi) xcd_barrier(bar); STAMP((p) + 1); } while (0)
#define CONVFIN() ((lastp >= 0) ? (int)__hip_atomic_load(F.ctl + CW_FIN + 64 * lastp, RLX_AGENT) : 0)
#define FRESH() do { int t_ = threadIdx.x; asm volatile("" : "+v"(t_)); F.tid = t_; F.lane = t_ & 63; F.wave = __builtin_amdgcn_readfirstlane(t_ >> 6); \
    GAS unsigned char* w_ = (GAS unsigned char*)args.ws; asm volatile("" : "+s"(w_)); F.ws = (unsigned char*)w_; F.ctl = (gu32*)(w_ + WS_CTL); } while (0)

    STAMP(0);
    if (IN(0)) { FRESH(); REP(9) prologue_phase(F, args); SEAM(0); }
#ifdef XBAR
    for (int xb_ = 0; xb_ < XBAR; ++xb_) xcd_barrier(bar);
#endif

    for (int l = 0; l < DEPTH; ++l) {
        const int pb = 1 + NPH_LAYER * l;
        if (IN(pb + 0)) { FRESH();
            const int N = (l < 2) ? NINA : (l == 2 ? 5120 : 2048);
            const unsigned char* Bt = F.ws + ((l < 2) ? WS_WAIN + (size_t)l * NINA * D * 2 : (l == 2 ? WS_WBIN0 : WS_WBIN1));
            const int nu = (T / 256) * (N / 256) + (l == 0 ? 16 : 0), ncv = conv_servers(nu, F.G, CONVFIN()), Gc = F.G - ncv;
            if (F.c < Gc) {
                pg8::Gemm g{nullptr, nullptr, T, N, D}; pg8::DualOrder S; S.init(F.ws + WS_XB, Bt, T, N, D, Gc, F.c, F.ws + WS_MEMB, F.ws + WS_WMKV, l == 0 ? 16 : 0);
                pg8::EpiBf16X E{l < 2 ? 0 : 1, (bf16*)(F.ws + WS_Z), (bf16*)(F.ws + WS_KD), (bf16*)(F.ws + WS_VD), (bf16*)(F.ws + WS_MEMKV), nullptr, nullptr};
                REP(0) pg8::gemm_phase<pg8::EpiBf16X, pg8::DualOrder, true, true>(F.lds + RING_OFF, g, S, E);
                if (ncv) conv_done(F, pb + 0);
                { const int mine = (nu - 1 - F.c) / Gc + 1, rounds = (nu + Gc - 1) / Gc; conv_filler(F, args, 2 * l, (rounds - mine) * QA); }
            } else conv_server(F, args, pb + 0, 2 * l, Gc);
            SEAM(pb + 0);
        }
        if (IN(pb + 1)) { FRESH();
            if (l < 2) {
                REP(1) for (int u = F.c; u < 256 + 128; u += F.G) {
                    if (u < 256) sgu_unit(F, args, l, u >> 2, u & 3);
                    else { const int r = u - 256; memattn_unit(F, l, r & 3, r >> 2, NINA, 2 * MIXW); }
                }
            } else {
                const int ncv = CONVFIN() ? 0 : NCVATT, Gc = F.G - ncv;
                if (F.c >= Gc) conv_server(F, args, pb + 1, 2 * l, Gc); else
                REP(2) { gu32* qh = F.ctl + CW_Q + 64 * l + 16 * rep_; LAS unsigned* uw = (LAS unsigned*)(F.lds + att2::LDS_UNIT);
                for (;;) {
                    if (F.tid == 0) *uw = __hip_atomic_fetch_add(qh, 1u, RLX_AGENT);
                    __syncthreads();
                    const unsigned idx = *uw;
                    __syncthreads();
                    if (idx >= (unsigned)(att2::NUNITS + 128)) break;
                    if (idx < (unsigned)att2::NUNITS) diffattn2_unit(F, args, att2::g_units.u[idx]);
                    else { const int r = (int)idx - att2::NUNITS; memattn_unit(F, l, r & 3, r >> 2, 2048, MIXW); }
                } }
                if (ncv && F.c < Gc) conv_done(F, pb + 1);
            }
            SEAM(pb + 1);
        }
        if (IN(pb + 2) && l >= 2) { FRESH(); REP(3) diffcombine_phase(F, args, l); SEAM(pb + 2); }
        if (IN(pb + 3)) { FRESH();
            pg8::Gemm g{nullptr, nullptr, T, D, D}; pg8::DenseOrder S; S.init(F.ws + WS_CAT, F.ws + (l < 2 ? WS_WAOUT + (size_t)l * D * D * 2 : WS_WBOUT + (size_t)(l - 2) * D * D * 2), T, D, D, F.G, F.c);
            pg8::EpiResBf16 E{(const bf16*)(F.ws + WS_XB), (bf16*)(F.ws + WS_Y), DN_ALPHA};
            REP(4) pg8::gemm_phase<pg8::EpiResBf16, pg8::DenseOrder, true, true>(F.lds + RING_OFF, g, S, E);
            SEAM(pb + 3);
        }
        if (IN(pb + 4)) { FRESH(); ln1_router_phase(F, args, l);
#ifdef REP_LN1
            ln1_router_phase(F, args, l, 1);
#endif
            conv_filler(F, args, 2 * l, -1); SEAM(pb + 4); }
        if (IN(pb + 6)) { FRESH();
            moe_table(F, l);
            const LAS int* tb = (const LAS int*)(F.lds + TAB_OFF);
            const int nu = tb[32] * 4, ncv = conv_servers(nu, F.G, CONVFIN()), Gc = F.G - ncv;
            if (F.c < Gc) {
                pg8::Gemm g{nullptr, nullptr, SLOTS, 1024, D / 2};
                pg8::MoeGatherOrder S{tb, tb + 36, (const int*)(F.ws + WS_LIST), 4, Gc, F.c, (const char*)(F.ws + WS_X1F), (const char*)(F.ws + WS_W13) + (size_t)l * NE * 1024 * 2048, (size_t)1024 * 2048, (size_t)256 * 2048, (unsigned)D};
                pg8::EpiMoe1 E{(bf16*)(F.ws + WS_H), tb, tb + 36};
                REP(6) pg8::gemm_phase<pg8::EpiMoe1, pg8::MoeGatherOrder, true, true>(F.lds + RING_OFF, g, S, E);
                if (ncv) conv_done(F, pb + 6);
                { const int mine = (F.c < nu) ? (nu - 1 - F.c) / Gc + 1 : 0, rounds = (nu + Gc - 1) / Gc; conv_filler(F, args, 2 * l + 1, (rounds - mine) * QM); }
            } else conv_server(F, args, pb + 6, 2 * l + 1, Gc);
            SEAM(pb + 6);
        }
        if (IN(pb + 7)) { FRESH();
            moe_table(F, l);
            const int nu = ((const LAS int*)(F.lds + TAB_OFF))[32] * 8, ncv = conv_servers(nu, F.G, CONVFIN()), Gc = F.G - ncv;
            if (F.c < Gc) {
                pg8::Gemm g{nullptr, nullptr, SLOTS, D, FF / 2};
                pg8::MoeOrder8 S{(const PG8_LAS int*)(F.lds + TAB_OFF), 8, Gc, F.c, (const char*)(F.ws + WS_H), (const char*)(F.ws + WS_W2) + (size_t)l * NE * 2048 * 512, (size_t)256 * FF, (size_t)2048 * 512, (size_t)256 * 512};
                pg8::EpiBf16X E{3, (bf16*)(F.ws + WS_YB), nullptr, nullptr, nullptr, (const PG8_LAS int*)(F.lds + TAB_OFF), (const PG8_LAS int*)(F.lds + TAB_OFF) + 36};
                REP(7) pg8::gemm_phase<pg8::EpiBf16X, pg8::MoeOrder8, true, true>(F.lds + RING_OFF, g, S, E);
                if (ncv) conv_done(F, pb + 7);
                { const int mine = (F.c < nu) ? (nu - 1 - F.c) / Gc + 1 : 0, rounds = (nu + Gc - 1) / Gc; conv_filler(F, args, 2 * l + 1, (rounds - mine) * QB); }
            } else conv_server(F, args, pb + 7, 2 * l + 1, Gc);
            SEAM(pb + 7);
        }
        if (IN(pb + 8)) { FRESH(); REP(8) ln2_phase(F, args, l); conv_filler(F, args, 2 * l + 1, -1); SEAM(pb + 8); }
    }
#ifdef PROBE_A
    {
        VM_WAIT(); xcd_barrier(bar);
        const unsigned long long* ts = (const unsigned long long*)(args.ws + WS_TS);
        float da = 0.f, db = 0.f;
        for (int p = 0; p < NPHASES; ++p) { const int k = (p == 0) ? 9 : (p - 1) % NPH_LAYER; const float d = (float)(ts[p + 1] - ts[p]);
            if (k == PROBE_A || PROBE_A == 10) da += d; if (k == PROBE_B || PROBE_B == 10) db += d; }
        const float kk = sqrtf(da), vv = db;
        float* o = args.out; const long n = (long)T * D;
        for (long i = (long)blockIdx.x * 512 + threadIdx.x; i < n; i += (long)gridDim.x * 512) o[i] = (i == 0) ? vv : kk;
    }
#endif
#undef IN
#undef SEAM
}

#ifndef MK_ONE_LAUNCH
#define MK_ONE_LAUNCH 1
#endif
extern "C" void kernel_launch(void* const* d_in, const int* in_sizes, int n_in, void* d_out, int out_size, void* d_ws, size_t ws_size, hipStream_t stream) {
    static int grid = 0;
    if (grid == 0) {
        if (n_in != 24 || in_sizes[0] != T * D || out_size != T * D || ws_size < WS_END) { fprintf(stderr, "kernel_launch: unexpected shapes (n_in %d, in0 %d, out %d, ws %zu < %zu)\n", n_in, n_in > 0 ? in_sizes[0] : -1, out_size, ws_size, (size_t)WS_END); grid = -1; return; }
        int dev = 0, cus = 0, per_cu = 0;
        if (hipGetDevice(&dev) != hipSuccess || hipDeviceGetAttribute(&cus, hipDeviceAttributeMultiprocessorCount, dev) != hipSuccess) { grid = -1; return; }
        if (hipFuncSetAttribute((const void*)fwd_kernel, hipFuncAttributeMaxDynamicSharedMemorySize, LDS_BYTES) != hipSuccess) { fprintf(stderr, "kernel_launch: hipFuncSetAttribute failed\n"); grid = -1; return; }
        if (hipOccupancyMaxActiveBlocksPerMultiprocessor(&per_cu, (const void*)fwd_kernel, NWAVES * 64, LDS_BYTES) != hipSuccess || per_cu < 1) fprintf(stderr, "kernel_launch: occupancy query reports %d\n", per_cu);
        (void)hipGetLastError();
        grid = cus;
    }
    if (grid < 0) return;
    if (hipMemsetAsync((char*)d_ws + WS_CTL, 0, CTL_ZERO_BYTES, stream) != hipSuccess) return;
    Args a{};
    for (int i = 0; i < 24; ++i) a.in[i] = (const float*)d_in[i];
    a.out = (float*)d_out; a.ws = (unsigned char*)d_ws;
#if MK_ONE_LAUNCH
    a.ph_lo = 0; a.ph_hi = NPHASES;
    hipLaunchKernelGGL(fwd_kernel, dim3(grid), dim3(NWAVES * 64), LDS_BYTES, stream, a);
#else
    for (int p = 0; p < NPHASES; ++p) {
        const int k = (p - 1) % NPH_LAYER, l = (p - 1) / NPH_LAYER;
        if (p > 0 && k == 2 && l < 2) continue;
        a.ph_lo = p; a.ph_hi = p + 1;
        hipLaunchKernelGGL(fwd_kernel, dim3(grid), dim3(NWAVES * 64), LDS_BYTES, stream, a);
    }
#endif
    const hipError_t le = hipPeekAtLastError();
    if (le != hipSuccess) fprintf(stderr, "kernel_launch: launch failed: %s\n", hipGetErrorName(le));
}
```

```cpp
#define NCVMAX 0
#define NCVATT 32
#include <hip/hip_runtime.h>
#include <cstdio>
#include <cstdint>
namespace pg8 {
#define PG8_LAS __attribute__((address_space(3)))
typedef unsigned short bf16_t;
typedef short bf16x8 __attribute__((ext_vector_type(8)));
typedef float f32x4 __attribute__((ext_vector_type(4)));
typedef unsigned u32x4 __attribute__((ext_vector_type(4)));
constexpr int BM = 256, BK = 64, HALF = 128, HTB = HALF * BK * 2  , STAGE_BYTES = 8 * HTB, NXCD = 8, WGM = 8;

__host__ __device__ __forceinline__ int lds_byte(int r, int c) { const int st = (r >> 4) * 2 + (c >> 5), rr = r & 15, cc = c & 31, ob = rr * 64 + cc * 2; return st * 1024 + (ob ^ (((ob >> 9) & 1) << 5)); }
__host__ __device__ __forceinline__ void stage_rc(int b, int& R, int& C) { const int st = b / 1024, sb = b % 1024, swz = sb ^ (((sb >> 9) & 1) << 5); R = (st >> 1) * 16 + swz / 64; C = (st & 1) * 32 + (swz % 64) / 2; }
__host__ __device__ __forceinline__ int perm32(int rho) { const int n = rho >> 4, i = rho & 15; return 8 * (i >> 2) + 4 * n + (i & 3); }

typedef int pg8_v4i __attribute__((ext_vector_type(4))); typedef int pg8_v8i __attribute__((ext_vector_type(8)));
__device__ __forceinline__ pg8_v8i pg8_cat8(bf16x8 a, bf16x8 b) { return __builtin_shufflevector(__builtin_bit_cast(pg8_v4i, a), __builtin_bit_cast(pg8_v4i, b), 0, 1, 2, 3, 4, 5, 6, 7); }
struct Unit { int pm, pn, e; };
struct Gemm { const bf16_t* A; const bf16_t* Bt; int M, N, K; };

struct StaticOrder {
    static constexpr bool GATHER = false, F8 = false; static constexpr int SCALE_B = 127;
    int nM, nN, nwg, G, c;
    __host__ __device__ void init(int M, int N, int G_, int c_) { nM = M / BM; nN = N / BM; nwg = nM * nN; G = G_; c = c_; }
    __host__ __device__ bool next(int i, Unit& u) const {
        const long L = (long)i * G + c; if (L >= nwg) return false;
        int wgid = (int)L; { const int q = nwg / NXCD, r = nwg % NXCD, xcd = wgid % NXCD, off = wgid / NXCD; wgid = (xcd < r ? xcd * (q + 1) : r * (q + 1) + (xcd - r) * q) + off; }
        const int nig = WGM * nN, gid = wgid / nig, fm = gid * WGM, gsz = (nM - fm) < WGM ? (nM - fm) : WGM;
        u.pm = fm + ((wgid % nig) % gsz); u.pn = (wgid % nig) / gsz; return true;
    }
    __device__ __forceinline__ void a_ready(const Unit&) const {}
    __device__ __forceinline__ void done(const Unit&) const {}
};

__device__ __forceinline__ unsigned cvt_pk_bf16(float lo, float hi) { unsigned r; asm volatile("v_cvt_pk_bf16_f32 %0, %1, %2" : "=v"(r) : "v"(lo), "v"(hi)); return r; }
typedef float f32x2 __attribute__((ext_vector_type(2)));
__device__ __forceinline__ f32x2 gelu_pk(f32x2 v) {
    const f32x2 av = __builtin_elementwise_abs(v), d = av * 0.2316418882f + 1.0f;
    f32x2 t; t.x = __builtin_amdgcn_rcpf(d.x); t.y = __builtin_amdgcn_rcpf(d.y);
    f32x2 q = t * 0.5307027145f + (-0.7265760135f); q = q * t + 0.7107068705f; q = q * t + (-0.142248368f); q = q * t + 0.127414796f; q = q * t;
    const f32x2 s = (v * v) * (-0.72134752044f);
    f32x2 e; e.x = __builtin_amdgcn_exp2f(s.x); e.y = __builtin_amdgcn_exp2f(s.y);
    const f32x2 m = v * (q * e), r = v - m;
    f32x2 o; o.x = v.x < 0.f ? m.x : r.x; o.y = v.y < 0.f ? m.y : r.y; return o;
}

template <class Epi, class Sched, bool ALIGN_EPI = false, bool SP2 = false>
__device__ __forceinline__ void gemm_phase(PG8_LAS unsigned char* lds, const Gemm g, const Sched& S, const Epi& E) {
    int tid_ = threadIdx.x; asm volatile("" : "+v"(tid_));
    const int tid = tid_, wid = __builtin_amdgcn_readfirstlane(tid >> 6), lane = tid & 63, wr = wid >> 2, wc = wid & 3, fr = lane & 15, fq = lane >> 4;
    const int K = g.K, nt = K / BK;
    unsigned voffA[2], voffB[2];
#pragma unroll
    for (int i = 0; i < 2; ++i) { int R, C; stage_rc(tid * 16 + i * 8192, R, C); const int Rb = Epi::PERM ? ((R & ~31) + perm32(R & 31)) : R;
        voffA[i] = (unsigned)(R * K + C) * 2u; voffB[i] = (unsigned)(Rb * K + C) * 2u; }
    unsigned vAc[2][2], vAn[2][2];
    int gR[2], gC[2];
#pragma unroll
    for (int i = 0; i < 2; ++i) { stage_rc(tid * 16 + i * 8192, gR[i], gC[i]); }
    const size_t kstep = (size_t)(BK * 2);
    const size_t hstep = (size_t)HALF * K * 2;
        const unsigned ldsw = (unsigned)wid * 1024u;
    const int aoff = lds_byte(wr * 64 + fr, fq * 8), boff = lds_byte(wc * 32 + fr, fq * 8);
#define PG8_SA(b, h) (((b) * 2 + (h)) * HTB)
#define PG8_SB(b, h) ((4 + (b) * 2 + (h)) * HTB)
#define PG8_STAGE(bufoff, gbase, voff) do { _Pragma("unroll") for (int _i = 0; _i < 2; ++_i) \
        __builtin_amdgcn_global_load_lds((const unsigned*)((const char*)(gbase) + (voff)[_i]), (PG8_LAS unsigned*)(lds + (bufoff) + ldsw + _i * 8192), 16, 0, 0); } while (0)
#define PG8_STAGE_A(b, h, base, VS) do { if constexpr (Sched::GATHER) { PG8_STAGE(PG8_SA(b, h), base, VS[h]); } else { PG8_STAGE(PG8_SA(b, h), (base) + (h) * hstep, voffA); } } while (0)
#define PG8_STAGE_AN(b, h, base) do { if constexpr (Sched::GATHER) { unsigned vs_[2] = {last ? vAn[h][0] : vAc[h][0], last ? vAn[h][1] : vAc[h][1]}; PG8_STAGE(PG8_SA(b, h), base, vs_); } else { PG8_STAGE(PG8_SA(b, h), (base) + (h) * hstep, voffA); } } while (0)
#define PG8_LDA(dst, b, h) do { if constexpr (Sched::F8) { _Pragma("unroll") for (int m = 0; m < 4; ++m) { dst##8[m].lo = *(const PG8_LAS pg8_v4i*)(lds + PG8_SA(b, h) + aoff + m * 2048); dst##8[m].hi = *(const PG8_LAS pg8_v4i*)(lds + PG8_SA(b, h) + aoff + m * 2048 + 1024); } } \
        else { _Pragma("unroll") for (int m = 0; m < 4; ++m) _Pragma("unroll") for (int k = 0; k < 2; ++k) dst[m][k] = *(const PG8_LAS bf16x8*)(lds + PG8_SA(b, h) + aoff + m * 2048 + k * 1024); } } while (0)
#define PG8_LDB(dst, b, h) do { if constexpr (Sched::F8) { _Pragma("unroll") for (int n = 0; n < 2; ++n) { dst##8[n].lo = *(const PG8_LAS pg8_v4i*)(lds + PG8_SB(b, h) + boff + n * 2048); dst##8[n].hi = *(const PG8_LAS pg8_v4i*)(lds + PG8_SB(b, h) + boff + n * 2048 + 1024); } } \
        else { _Pragma("unroll") for (int n = 0; n < 2; ++n) _Pragma("unroll") for (int k = 0; k < 2; ++k) dst[n][k] = *(const PG8_LAS bf16x8*)(lds + PG8_SB(b, h) + boff + n * 2048 + k * 1024); } } while (0)
#define PG8_MMA(ai, bj, At, Bt) do { __builtin_amdgcn_s_setprio(1); if constexpr (Sched::F8) { \
        _Pragma("unroll") for (int m = 0; m < 4; ++m) _Pragma("unroll") for (int n = 0; n < 2; ++n) \
            asm volatile("v_mfma_scale_f32_16x16x128_f8f6f4 %0, %1, %2, %0, %3, %4 op_sel_hi:[0,0,0]" : "+v"(acc[ai][bj][m][n]) : "v"(Bt##8[n]), "v"(At##8[m]), "v"(sclB_), "v"(sclA_));     \
        } else { _Pragma("unroll") for (int m = 0; m < 4; ++m) _Pragma("unroll") for (int n = 0; n < 2; ++n) _Pragma("unroll") for (int k = 0; k < 2; ++k) \
        acc[ai][bj][m][n] = __builtin_amdgcn_mfma_f32_16x16x32_bf16(Bt[n][k], At[m][k], acc[ai][bj][m][n], 0, 0, 0); } __builtin_amdgcn_s_setprio(0); } while (0)
#define PG8_WAIT_V(n) asm volatile("s_waitcnt vmcnt(" #n ")" ::: "memory")
#define PG8_WAIT_L(n) asm volatile("s_waitcnt lgkmcnt(" #n ")" ::: "memory")
#define PG8_BAR __builtin_amdgcn_s_barrier()
#define PG8_SCHED __builtin_amdgcn_sched_barrier(0)
    Unit cur, nxt; int ui = 0;
    if (!S.next(0, cur)) return;
    f32x4 acc[2][2][4][2];
#pragma unroll
    for (int a = 0; a < 2; ++a)
#pragma unroll
        for (int b = 0; b < 2; ++b)
#pragma unroll
            for (int m = 0; m < 4; ++m)
#pragma unroll
                for (int n = 0; n < 2; ++n) acc[a][b][m][n] = (f32x4){0.f, 0.f, 0.f, 0.f};
    const int sclB_ = Sched::SCALE_B, sclA_ = 127;
    bf16x8 At[4][2], B0[2][2], B1[2][2]; pg8_v8i At8[4], B08[2], B18[2];
    const char* cA = S.aptr(cur); const char* cB = S.bptr(cur);
    S.a_ready(cur);
    if constexpr (Sched::GATHER) {
#pragma unroll
        for (int h = 0; h < 2; ++h)
#pragma unroll
            for (int i = 0; i < 2; ++i) { vAc[h][i] = S.rowoff(cur, h * HALF + gR[i]) + (unsigned)gC[i] * 2u; vAn[h][i] = vAc[h][i]; }
        asm volatile("s_waitcnt vmcnt(0)" ::: "memory");
    }
    if constexpr (SP2) {
        PG8_STAGE(PG8_SB(0, 0), cB, voffB); PG8_STAGE(PG8_SB(0, 1), cB + hstep, voffB); PG8_STAGE_A(0, 0, cA, vAc); PG8_STAGE_A(0, 1, cA, vAc);
        if (wr == 1) PG8_BAR;
        PG8_WAIT_V(2); PG8_BAR;
        PG8_STAGE(PG8_SB(1, 0), cB + kstep, voffB); PG8_STAGE_A(1, 0, cA + kstep, vAc); PG8_STAGE(PG8_SB(1, 1), cB + hstep + kstep, voffB);
        PG8_WAIT_V(6); PG8_BAR;
    } else {
        PG8_STAGE(PG8_SB(0, 0), cB, voffB); PG8_STAGE_A(0, 0, cA, vAc); PG8_STAGE(PG8_SB(0, 1), cB + hstep, voffB); PG8_STAGE_A(0, 1, cA, vAc);
        if (wr == 1) PG8_BAR;
        PG8_WAIT_V(4); PG8_BAR;
        PG8_STAGE(PG8_SB(1, 0), cB + kstep, voffB); PG8_STAGE_A(1, 0, cA + kstep, vAc); PG8_STAGE(PG8_SB(1, 1), cB + hstep + kstep, voffB);
        PG8_WAIT_V(6); PG8_BAR;
    }
    for (;;) {
        const bool has_next = S.next(ui + 1, nxt);
        const char* nA = has_next ? S.aptr(nxt) : cA; const char* nB = has_next ? S.bptr(nxt) : cB;
        if constexpr (Sched::GATHER) { if (has_next) {
#pragma unroll
            for (int h = 0; h < 2; ++h)
#pragma unroll
                for (int i = 0; i < 2; ++i) vAn[h][i] = S.rowoff(nxt, h * HALF + gR[i]) + (unsigned)gC[i] * 2u; } }
        for (int t = 0; t < nt; t += 2) {
            const bool last = (t == nt - 2);
            const char* a1 = cA + (size_t)(t + 1) * kstep;
            const char* a2 = last ? nA : cA + (size_t)(t + 2) * kstep; const char* b2 = last ? nB : cB + (size_t)(t + 2) * kstep;
            const char* a3 = a2 + kstep; const char* b3 = b2 + kstep;
            if (last && has_next) S.a_ready(nxt);
            if constexpr (SP2) {
            PG8_LDB(B0, 0, 0); PG8_LDB(B1, 0, 1); PG8_SCHED; PG8_LDA(At, 0, 0); PG8_STAGE_A(1, 1, a1, vAc);
            PG8_WAIT_V(8); PG8_WAIT_L(0); PG8_BAR; PG8_MMA(0, 0, At, B0); PG8_MMA(0, 1, At, B1); PG8_BAR; PG8_SCHED;
            PG8_LDA(At, 0, 1); PG8_STAGE(PG8_SB(0, 0), b2, voffB); PG8_STAGE(PG8_SB(0, 1), b2 + hstep, voffB); PG8_STAGE_AN(0, 0, a2);
            PG8_WAIT_V(8); PG8_WAIT_L(0); PG8_BAR; PG8_MMA(1, 0, At, B0); PG8_MMA(1, 1, At, B1); PG8_BAR; PG8_SCHED;
            PG8_LDB(B0, 1, 0); PG8_LDB(B1, 1, 1); PG8_SCHED; PG8_LDA(At, 1, 0); PG8_STAGE_AN(0, 1, a2);
            PG8_WAIT_V(8); PG8_WAIT_L(0); PG8_BAR; PG8_MMA(0, 0, At, B0); PG8_MMA(0, 1, At, B1); PG8_BAR; PG8_SCHED;
            PG8_LDA(At, 1, 1); PG8_STAGE(PG8_SB(1, 0), b3, voffB); PG8_STAGE(PG8_SB(1, 1), b3 + hstep, voffB); PG8_STAGE_AN(1, 0, a3);
            PG8_WAIT_V(8); PG8_WAIT_L(0); PG8_BAR; PG8_MMA(1, 0, At, B0); PG8_MMA(1, 1, At, B1); PG8_BAR; PG8_SCHED;
            } else {
            PG8_LDB(B0, 0, 0); PG8_SCHED; PG8_LDA(At, 0, 0); PG8_STAGE_A(1, 1, a1, vAc);
            PG8_WAIT_L(8); PG8_BAR; PG8_WAIT_L(0); PG8_MMA(0, 0, At, B0); PG8_BAR; PG8_SCHED;
            PG8_LDB(B1, 0, 1); PG8_STAGE(PG8_SB(0, 0), b2, voffB);
            PG8_BAR; PG8_WAIT_L(0); PG8_MMA(0, 1, At, B1); PG8_BAR;
            PG8_LDA(At, 0, 1); PG8_STAGE_AN(0, 0, a2);
            PG8_BAR; PG8_WAIT_L(0); PG8_MMA(1, 0, At, B0); PG8_BAR; PG8_SCHED;
            PG8_STAGE(PG8_SB(0, 1), b2 + hstep, voffB);
            PG8_WAIT_V(6); PG8_BAR; PG8_MMA(1, 1, At, B1); PG8_BAR;
            PG8_LDB(B0, 1, 0); PG8_SCHED; PG8_LDA(At, 1, 0); PG8_STAGE_AN(0, 1, a2);
            PG8_WAIT_L(8); PG8_BAR; PG8_WAIT_L(0); PG8_MMA(0, 0, At, B0); PG8_BAR; PG8_SCHED;
            PG8_LDB(B1, 1, 1); PG8_STAGE(PG8_SB(1, 0), b3, voffB);
            PG8_BAR; PG8_WAIT_L(0); PG8_MMA(0, 1, At, B1); PG8_BAR;
            PG8_LDA(At, 1, 1); PG8_STAGE_AN(1, 0, a3);
            PG8_BAR; PG8_WAIT_L(0); PG8_MMA(1, 0, At, B0); PG8_BAR; PG8_SCHED;
            PG8_STAGE(PG8_SB(1, 1), b3 + hstep, voffB);
            PG8_WAIT_V(6); PG8_BAR; PG8_MMA(1, 1, At, B1); PG8_BAR;
            }
        }
        if constexpr (ALIGN_EPI) { if (wr == 0) PG8_BAR; }
        if constexpr (!Epi::AFTER_DRAIN) { E(acc, cur, wr, wc, fr, fq); S.done(cur); }
        if (!has_next) break;
#pragma unroll
        for (int a = 0; a < 2; ++a)
#pragma unroll
            for (int b = 0; b < 2; ++b)
#pragma unroll
                for (int m = 0; m < 4; ++m)
#pragma unroll
                    for (int n = 0; n < 2; ++n) acc[a][b][m][n] = (f32x4){0.f, 0.f, 0.f, 0.f};
        cur = nxt; cA = nA; cB = nB; ++ui;
        if constexpr (Sched::GATHER) {
#pragma unroll
            for (int h = 0; h < 2; ++h)
#pragma unroll
                for (int i = 0; i < 2; ++i) vAc[h][i] = vAn[h][i]; }
        if constexpr (ALIGN_EPI) { if (wr == 1) PG8_BAR; }
    }
    PG8_WAIT_V(0);
    if constexpr (!ALIGN_EPI) { if (wr == 0) PG8_BAR; }
    PG8_BAR;
    if constexpr (Epi::AFTER_DRAIN) { E.fused(acc, cur, wr, wc, fr, fq, lds, wid, lane); S.done(cur); }
#undef PG8_SA
#undef PG8_SB
#undef PG8_STAGE
#undef PG8_STAGE_A
#undef PG8_STAGE_AN
#undef PG8_LDA
#undef PG8_LDB
#undef PG8_MMA
#undef PG8_WAIT_V
#undef PG8_WAIT_L
#undef PG8_BAR
#undef PG8_SCHED
}
}

constexpr int T = 8192, D = 2048, MIXW = 1536, MEMW = 512, NINA = 3584, DEPTH = 4, NE = 32, FF = 512, MEMT = 256;
constexpr int SLOTS = 24576;
constexpr float LN_EPS = 1e-5f;
constexpr float DN_ALPHA = 1.6817928305074292f;
constexpr float LOG2E = 1.4426950408889634f;
constexpr float QSCALE = 0.08838834764831845f * LOG2E;
constexpr int NWAVES = 8;

constexpr size_t MiB = 1u << 20;
constexpr size_t WS_CTL = 0, CTL_ZERO_BYTES = 1 * MiB;
constexpr size_t WS_WAIN = 2 * MiB, WS_WAOUT = 30 * MiB, WS_WBIN0 = 46 * MiB, WS_WKV = 54 * MiB, WS_WBIN1 = 66 * MiB, WS_WBOUT = 74 * MiB, WS_WMKV = 90 * MiB;
constexpr size_t WS_W13 = 106 * MiB, WS_W2 = 618 * MiB;
constexpr size_t WS_XB = 874 * MiB, WS_MEMB = 906 * MiB, WS_MEMKV = 907 * MiB, WS_Z = 910 * MiB, WS_KD = 966 * MiB, WS_VD = 990 * MiB, WS_CAT = 1014 * MiB;
constexpr size_t WS_Y = 1046 * MiB, WS_X1F = 1110 * MiB, WS_X1B = 1174 * MiB, WS_XF = 1206 * MiB, WS_XG = 1270 * MiB, WS_H = 1366 * MiB, WS_YB = 1390 * MiB, WS_OP = 1486 * MiB;
constexpr size_t WS_ROUTE = 1582 * MiB, WS_OP2 = 1583 * MiB, WS_ML = 1631 * MiB, WS_WR = 1634 * MiB, WS_TS = 1640 * MiB, WS_LIST = 1641 * MiB, WS_END = 1642 * MiB;
constexpr int CW_TMO = 0, CW_BAR = 4096, CW_CNT = 16384, CW_Q = 28672, CW_CONV = 29184, CW_DONE = 32768, CW_FIN = 40960;

constexpr int RING_OFF = 0, RING_BYTES = 131072;
constexpr int LDSCTL_OFF = 146432, MISC_OFF = LDSCTL_OFF + 320, TAB_OFF = LDSCTL_OFF + 512;
constexpr int LDS_BYTES = 147456;

#define GAS __attribute__((address_space(1)))
#define LAS __attribute__((address_space(3)))
typedef unsigned short bf16;
typedef unsigned v4u __attribute__((ext_vector_type(4)));
typedef unsigned v2u __attribute__((ext_vector_type(2)));
typedef float f32x4 __attribute__((ext_vector_type(4)));
typedef short bf16x8 __attribute__((ext_vector_type(8)));
typedef GAS unsigned gu32;
#define RLX_AGENT __ATOMIC_RELAXED, __HIP_MEMORY_SCOPE_AGENT
#define LDS_WAIT() asm volatile("s_waitcnt lgkmcnt(0)" ::: "memory")
#define VM_WAIT() asm volatile("s_waitcnt vmcnt(0)" ::: "memory")
__device__ __forceinline__ unsigned f2bf(float f) { unsigned u = __builtin_bit_cast(unsigned, f); return (u + 0x7fffu + ((u >> 16) & 1u)) >> 16; }
__device__ __forceinline__ unsigned pk2(float lo, float hi) { return f2bf(lo) | (f2bf(hi) << 16); }
__device__ __forceinline__ float bf2f(unsigned short b) { return __builtin_bit_cast(float, (unsigned)b << 16); }
__device__ __forceinline__ float bflo(unsigned w) { return __builtin_bit_cast(float, w << 16); }
__device__ __forceinline__ float bfhi(unsigned w) { return __builtin_bit_cast(float, w & 0xffff0000u); }
__device__ __forceinline__ float wave_sum(float v) {
#pragma unroll
    for (int o = 1; o < 64; o <<= 1) v += __shfl_xor(v, o);
    return v;
}

namespace pg8 {
struct DenseOrder {
    static constexpr bool GATHER = false, F8 = false; static constexpr int SCALE_B = 127;
    StaticOrder so; const char* A; const char* B; size_t astep, bstep;
    __device__ void init(const void* A_, const void* B_, int M, int N, int K, int G, int c) { so.init(M, N, G, c); A = (const char*)A_; B = (const char*)B_; astep = (size_t)256 * K * 2; bstep = astep; }
    __device__ __forceinline__ bool next(int i, Unit& u) const { u.e = 0; return so.next(i, u); }
    __device__ __forceinline__ const char* aptr(const Unit& u) const { return A + (size_t)u.pm * astep; }
    __device__ __forceinline__ const char* bptr(const Unit& u) const { return B + (size_t)u.pn * bstep; }
    __device__ __forceinline__ void a_ready(const Unit&) const {}
    __device__ __forceinline__ void done(const Unit&) const {}
};
struct DualOrder {
    static constexpr bool GATHER = false, F8 = false; static constexpr int SCALE_B = 127;
    StaticOrder so; int nwg2; const char* A; const char* B; const char* A2; const char* B2; size_t step;
    __device__ void init(const void* A_, const void* B_, int M, int N, int K, int G, int c, const void* A2_, const void* B2_, int nwg2_) { so.init(M, N, G, c); A = (const char*)A_; B = (const char*)B_; A2 = (const char*)A2_; B2 = (const char*)B2_; nwg2 = nwg2_; step = (size_t)256 * K * 2; }
    __device__ __forceinline__ bool next(int i, Unit& u) const { const int L = i * so.G + so.c; if (L < so.nwg) { u.e = 0; return so.next(i, u); } if (L - so.nwg >= nwg2) return false; u.e = 1; u.pm = 0; u.pn = L - so.nwg; return true; }
    __device__ __forceinline__ const char* aptr(const Unit& u) const { return u.e ? A2 : A + (size_t)u.pm * step; }
    __device__ __forceinline__ const char* bptr(const Unit& u) const { return (u.e ? B2 : B) + (size_t)u.pn * step; }
    __device__ __forceinline__ void a_ready(const Unit&) const {}
    __device__ __forceinline__ void done(const Unit&) const {}
};
struct MoeOrder {
    static constexpr bool GATHER = false, F8 = false; static constexpr int SCALE_B = 127;
    const PG8_LAS int* tstart; int ntn, G, c; const char* A; const char* W; size_t astep, wexp, wtile;
    __device__ __forceinline__ bool next(int i, Unit& u) const {
        const int L = i * G + c, total = tstart[32] * ntn; if (L >= total) return false;
        int wgid; { const int q = total / NXCD, r = total % NXCD, xcd = L % NXCD, off = L / NXCD; wgid = (xcd < r ? xcd * (q + 1) : r * (q + 1) + (xcd - r) * q) + off; }
        u.pm = wgid / ntn; u.pn = wgid - u.pm * ntn; int e = 0;
#pragma unroll
        for (int k = 1; k <= 31; ++k) e += (tstart[k] <= u.pm) ? 1 : 0;
        u.e = e; return true;
    }
    __device__ __forceinline__ const char* aptr(const Unit& u) const { return A + (size_t)u.pm * astep; }
    __device__ __forceinline__ const char* bptr(const Unit& u) const { return W + (size_t)u.e * wexp + (size_t)u.pn * wtile; }
    __device__ __forceinline__ void a_ready(const Unit&) const {}
    __device__ __forceinline__ void done(const Unit&) const {}
};

struct MoeOrder8 {
    static constexpr bool GATHER = false, F8 = true; static constexpr int SCALE_B = 121;
    const PG8_LAS int* tstart; int ntn, G, c; const char* A; const char* W; size_t astep, wexp, wtile;
    __device__ __forceinline__ bool next(int i, Unit& u) const {
        const int L = i * G + c, total = tstart[32] * ntn; if (L >= total) return false;
        int wgid; { const int q = total / NXCD, r = total % NXCD, xcd = L % NXCD, off = L / NXCD; wgid = (xcd < r ? xcd * (q + 1) : r * (q + 1) + (xcd - r) * q) + off; }
        u.pm = wgid / ntn; u.pn = wgid - u.pm * ntn; int e = 0;
#pragma unroll
        for (int k = 1; k <= 31; ++k) e += (tstart[k] <= u.pm) ? 1 : 0;
        u.e = e; return true;
    }
    __device__ __forceinline__ const char* aptr(const Unit& u) const { return A + (size_t)u.pm * astep; }
    __device__ __forceinline__ const char* bptr(const Unit& u) const { return W + (size_t)u.e * wexp + (size_t)u.pn * wtile; }
    __device__ __forceinline__ void a_ready(const Unit&) const {}
    __device__ __forceinline__ void done(const Unit&) const {}
};

struct MoeGatherOrder {
    static constexpr bool GATHER = true, F8 = true; static constexpr int SCALE_B = 121;
    const PG8_LAS int* tstart; const PG8_LAS int* cntl; const int* list; int ntn, G, c; const char* A; const char* W; size_t wexp, wtile; unsigned rowbytes;
    __device__ __forceinline__ bool next(int i, Unit& u) const {
        const int L = i * G + c, total = tstart[32] * ntn; if (L >= total) return false;
        int wgid; { const int q = total / NXCD, r = total % NXCD, xcd = L % NXCD, off = L / NXCD; wgid = (xcd < r ? xcd * (q + 1) : r * (q + 1) + (xcd - r) * q) + off; }
        u.pm = wgid / ntn; u.pn = wgid - u.pm * ntn; int e = 0;
#pragma unroll
        for (int k = 1; k <= 31; ++k) e += (tstart[k] <= u.pm) ? 1 : 0;
        u.e = e; return true;
    }
    __device__ __forceinline__ unsigned rowoff(const Unit& u, int r) const { const int rank = (u.pm - tstart[u.e]) * 256 + r; const int tok = list[u.e * 8192 + (rank < cntl[u.e] ? rank : 0)]; return (unsigned)tok * rowbytes; }
    __device__ __forceinline__ const char* aptr(const Unit&) const { return A; }
    __device__ __forceinline__ const char* bptr(const Unit& u) const { return W + (size_t)u.e * wexp + (size_t)u.pn * wtile; }
    __device__ __forceinline__ void a_ready(const Unit&) const {}
    __device__ __forceinline__ void done(const Unit&) const {}
};

struct EpiBf16X {
    static constexpr bool PERM = true, AFTER_DRAIN = false;
    int mode; bf16_t* p0; bf16_t* p1; bf16_t* p2; bf16_t* p3;
    const PG8_LAS int* tstart; const PG8_LAS int* cntl;
    __device__ __forceinline__ void operator()(const f32x4 (&acc)[2][2][4][2], const Unit& u, int wr, int wc, int fr, int fq) const {
        bf16_t* base; int ldc, colt; bool act = false; float sc = 1.f;
        if (u.e && mode < 2) { base = p3 + (size_t)(u.pn >> 2) * (256 * 1024); ldc = 1024; colt = (u.pn & 3) * BM; }
        else if (mode == 0) { base = p0; ldc = 3584; colt = u.pn * BM; act = u.pn < 12; if (u.pn >= 12) sc = QSCALE; }
        else if (mode == 1) { if (u.pn < 8) { base = p0; ldc = 2048; colt = u.pn * BM; sc = QSCALE; }
                              else if (u.pn < 14) { base = p1; ldc = 1536; colt = (u.pn - 8) * BM; } else { base = p2; ldc = 1536; colt = (u.pn - 14) * BM; } }
        else { base = p0; ldc = 2048; colt = u.pn * BM; }
        const int row0 = u.pm * BM + wr * 64 + fr, col0 = colt + wc * 32 + 8 * fq;
        const int rlim = (mode == 3) ? cntl[u.e] - (u.pm - tstart[u.e]) * BM : BM;
#pragma unroll
        for (int ai = 0; ai < 2; ++ai)
#pragma unroll
            for (int m = 0; m < 4; ++m) { bf16_t* rowp = base + (size_t)(row0 + ai * HALF + m * 16) * ldc + col0;
                if (wr * 64 + fr + ai * HALF + m * 16 >= rlim) continue;
#pragma unroll
                for (int bj = 0; bj < 2; ++bj) { f32x4 v0 = acc[ai][bj][m][0], v1 = acc[ai][bj][m][1];
                    if (act) { f32x2 a = gelu_pk((f32x2){v0[0], v0[1]}), b = gelu_pk((f32x2){v0[2], v0[3]}), c = gelu_pk((f32x2){v1[0], v1[1]}), d = gelu_pk((f32x2){v1[2], v1[3]});
                        v0 = (f32x4){a.x, a.y, b.x, b.y}; v1 = (f32x4){c.x, c.y, d.x, d.y}; }
                    v0 = v0 * sc; v1 = v1 * sc; u32x4 w; w.x = cvt_pk_bf16(v0[0], v0[1]); w.y = cvt_pk_bf16(v0[2], v0[3]); w.z = cvt_pk_bf16(v1[0], v1[1]); w.w = cvt_pk_bf16(v1[2], v1[3]);
                    *(u32x4*)(rowp + bj * HALF) = w; } }
    }
};
struct EpiResBf16 {
    static constexpr bool PERM = true, AFTER_DRAIN = false;
    const bf16_t* xres; bf16_t* y; float alpha;
    __device__ __forceinline__ void operator()(const f32x4 (&acc)[2][2][4][2], const Unit& u, int wr, int wc, int fr, int fq) const {
        const int row0 = u.pm * BM + wr * 64 + fr, col0 = u.pn * BM + wc * 32 + 8 * fq;
#pragma unroll
        for (int ai = 0; ai < 2; ++ai)
#pragma unroll
            for (int m = 0; m < 4; ++m) { const size_t off = (size_t)(row0 + ai * HALF + m * 16) * 2048 + col0;
#pragma unroll
                for (int bj = 0; bj < 2; ++bj) { const u32x4 xr = *(const u32x4*)(xres + off + bj * HALF); const f32x4 v0 = acc[ai][bj][m][0], v1 = acc[ai][bj][m][1]; u32x4 w;
                    w.x = cvt_pk_bf16(__builtin_bit_cast(float, xr.x << 16) * alpha + v0[0], __builtin_bit_cast(float, xr.x & 0xffff0000u) * alpha + v0[1]);
                    w.y = cvt_pk_bf16(__builtin_bit_cast(float, xr.y << 16) * alpha + v0[2], __builtin_bit_cast(float, xr.y & 0xffff0000u) * alpha + v0[3]);
                    w.z = cvt_pk_bf16(__builtin_bit_cast(float, xr.z << 16) * alpha + v1[0], __builtin_bit_cast(float, xr.z & 0xffff0000u) * alpha + v1[1]);
                    w.w = cvt_pk_bf16(__builtin_bit_cast(float, xr.w << 16) * alpha + v1[2], __builtin_bit_cast(float, xr.w & 0xffff0000u) * alpha + v1[3]);
                    *(u32x4*)(y + off + bj * HALF) = w; } }
    }
};
struct EpiMoe1 {
    static constexpr bool PERM = true, AFTER_DRAIN = false;
    bf16_t* h; const PG8_LAS int* tstart; const PG8_LAS int* cntl;
    __device__ __forceinline__ void operator()(const f32x4 (&acc)[2][2][4][2], const Unit& u, int wr, int wc, int fr, int fq) const {
        const int row0 = u.pm * BM + wr * 64 + fr, col0 = u.pn * HALF + wc * 32 + 8 * fq;
        const int rlim = cntl[u.e] - (u.pm - tstart[u.e]) * BM;
#pragma unroll
        for (int ai = 0; ai < 2; ++ai)
#pragma unroll
            for (int m = 0; m < 4; ++m) { unsigned char* rowp = (unsigned char*)h + (size_t)(row0 + ai * HALF + m * 16) * 512 + col0; float o[8];
                if (wr * 64 + fr + ai * HALF + m * 16 >= rlim) continue;
#pragma unroll
                for (int n = 0; n < 2; ++n)
#pragma unroll
                    for (int x = 0; x < 4; ++x) { const float a = acc[ai][0][m][n][x], b = acc[ai][1][m][n][x];
                        o[n * 4 + x] = a * __builtin_amdgcn_rcpf(1.0f + __builtin_amdgcn_exp2f(-a * LOG2E)) * b; }
                unsigned lo = 0u, hi = 0u; lo = __builtin_amdgcn_cvt_pk_fp8_f32(o[0], o[1], lo, false); lo = __builtin_amdgcn_cvt_pk_fp8_f32(o[2], o[3], lo, true);
                hi = __builtin_amdgcn_cvt_pk_fp8_f32(o[4], o[5], hi, false); hi = __builtin_amdgcn_cvt_pk_fp8_f32(o[6], o[7], hi, true);
                typedef unsigned u32x2e __attribute__((ext_vector_type(2))); u32x2e w; w.x = lo; w.y = hi; *(u32x2e*)rowp = w; }
    }
};
}

namespace att {
using bf16x8 = __attribute__((ext_vector_type(8))) short;
using s16x4  = __attribute__((ext_vector_type(4))) short;
using f32x16 = __attribute__((ext_vector_type(16))) float;
using u32x4  = __attribute__((ext_vector_type(4))) unsigned;
constexpr int DH = 128, QBLK = 32, KVBLK = 64;
constexpr float THR2 = 8.f * 1.4426950408889634f;
constexpr size_t SHM_V = KVBLK * DH * 2, SHM_K = KVBLK * DH * 2, SHM_ATTN = 2 * SHM_V + 2 * SHM_K + NWAVES * 64 * 4;
constexpr int TAB_N = 160;
#define KSWZ(row, colB) ((row) * 256 + ((colB) ^ (((row) & 7) << 4)))
#define SBAR() __builtin_amdgcn_sched_barrier(0)
__device__ __forceinline__ int crow(int r, int hi) { return (r & 3) + 8 * (r >> 2) + 4 * hi; }
__device__ __forceinline__ unsigned cvtpk(float lo, float hi) { unsigned r; asm volatile("v_cvt_pk_bf16_f32 %0, %1, %2" : "=v"(r) : "v"(lo), "v"(hi)); return r; }

__device__ __forceinline__ void partialSM(f32x16& p0, f32x16& p1, float& m_reg, float& mn, float& alpha) {
  float pmax = p0[0];
#pragma unroll
  for (int r = 1; r < 16; ++r) pmax = fmaxf(pmax, p0[r]);
#pragma unroll
  for (int r = 0; r < 16; ++r) pmax = fmaxf(pmax, p1[r]);
  { auto rr = __builtin_amdgcn_permlane32_swap(__float_as_uint(pmax), __float_as_uint(pmax), false, false);
    pmax = fmaxf(__uint_as_float(rr[0]), __uint_as_float(rr[1])); }
  if (__builtin_expect(__all(pmax - m_reg <= THR2), 1)) { mn = m_reg; alpha = 1.f; }
  else { mn = fmaxf(m_reg, pmax); alpha = __builtin_amdgcn_exp2f(m_reg - mn); m_reg = mn; }
#pragma unroll
  for (int r = 0; r < 16; ++r) p0[r] = p0[r] - mn;
#pragma unroll
  for (int r = 0; r < 16; ++r) p1[r] = p1[r] - mn;
#pragma unroll
  for (int r = 0; r < 16; ++r) p0[r] = __builtin_amdgcn_exp2f(p0[r]);
}
__device__ __forceinline__ void finishSM(f32x16& p0, f32x16& p1, float alpha, float& l_reg, bf16x8& pa0, bf16x8& pa1, bf16x8& pa2, bf16x8& pa3) {
#pragma unroll
  for (int r = 0; r < 16; ++r) p1[r] = __builtin_amdgcn_exp2f(p1[r]);
  float ps = 0;
#pragma unroll
  for (int r = 0; r < 16; ++r) ps += p0[r];
#pragma unroll
  for (int r = 0; r < 16; ++r) ps += p1[r];
  { auto rr = __builtin_amdgcn_permlane32_swap(__float_as_uint(ps), __float_as_uint(ps), false, false);
    ps = __uint_as_float(rr[0]) + __uint_as_float(rr[1]); }
  l_reg = l_reg * alpha + ps;
#define PK4(P, BASE, OUT) do { unsigned a0 = cvtpk(P[BASE + 0], P[BASE + 1]), a1 = cvtpk(P[BASE + 2], P[BASE + 3]);   \
    unsigned b0 = cvtpk(P[BASE + 4], P[BASE + 5]), b1 = cvtpk(P[BASE + 6], P[BASE + 7]);                              \
    auto r0 = __builtin_amdgcn_permlane32_swap(a0, b0, false, false); auto r1 = __builtin_amdgcn_permlane32_swap(a1, b1, false, false); \
    u32x4 w = {r0[0], r1[0], r0[1], r1[1]}; OUT = *reinterpret_cast<bf16x8*>(&w); } while (0)
  PK4(p0, 0, pa0); PK4(p0, 8, pa1); PK4(p1, 0, pa2); PK4(p1, 8, pa3);
#undef PK4
}
__device__ __forceinline__ void qkt(f32x16& p0, f32x16& p1, const char* Ks, const bf16x8* qr, int r32, int hi) {
  p0 = f32x16{}; p1 = f32x16{};
#pragma unroll
  for (int d0 = 0; d0 < 8; ++d0) { const int cb = (d0 * 16 + hi * 8) * 2;
    bf16x8 b0 = *reinterpret_cast<const bf16x8*>(Ks + KSWZ(r32, cb));
    bf16x8 b1 = *reinterpret_cast<const bf16x8*>(Ks + KSWZ(32 + r32, cb));
    p0 = __builtin_amdgcn_mfma_f32_32x32x16_bf16(b0, qr[d0], p0, 0, 0, 0);
    p1 = __builtin_amdgcn_mfma_f32_32x32x16_bf16(b1, qr[d0], p1, 0, 0, 0); }
}
__device__ __forceinline__ int v_st(int k, int c) { const int kk = (k & ~0xC) | ((k & 4) << 1) | ((k & 8) >> 1); return ((kk >> 3) * 4 + (c >> 5)) * 512 + ((kk & 7) * 32 + (c & 31)) * 2; }
__device__ __forceinline__ int v_rd_base(int lane) { return ((lane & 3) << 3) | (((lane >> 2) & 3) << 6) | (((lane >> 4) & 1) << 5) | (((lane >> 5) & 1) << 8); }
constexpr int v_rd_off(int d0, int ks, int half) { return d0 * 512 + ks * 4096 + half * 2048; }
template <int OFF> __device__ __forceinline__ s16x4 tr_read(int vb) {
  s16x4 r; asm volatile("ds_read_b64_tr_b16 %0, %1 offset:%2" : "=&v"(r) : "v"(vb), "i"(OFF) : "memory"); return r;
}
template <int D0> __device__ __forceinline__ void pv_one(f32x16& od, int vb, bf16x8 pa0, bf16x8 pa1, bf16x8 pa2, bf16x8 pa3) {
  const s16x4 l0 = tr_read<v_rd_off(D0, 0, 0)>(vb), h0 = tr_read<v_rd_off(D0, 0, 1)>(vb), l1 = tr_read<v_rd_off(D0, 1, 0)>(vb), h1 = tr_read<v_rd_off(D0, 1, 1)>(vb);
  const s16x4 l2 = tr_read<v_rd_off(D0, 2, 0)>(vb), h2 = tr_read<v_rd_off(D0, 2, 1)>(vb), l3 = tr_read<v_rd_off(D0, 3, 0)>(vb), h3 = tr_read<v_rd_off(D0, 3, 1)>(vb);
  asm volatile("s_waitcnt lgkmcnt(0)" ::: "memory"); SBAR();
#define PK(L, H) (bf16x8){L[0], L[1], L[2], L[3], H[0], H[1], H[2], H[3]}
  od = __builtin_amdgcn_mfma_f32_32x32x16_bf16(pa0, PK(l0, h0), od, 0, 0, 0);
  od = __builtin_amdgcn_mfma_f32_32x32x16_bf16(pa1, PK(l1, h1), od, 0, 0, 0);
  od = __builtin_amdgcn_mfma_f32_32x32x16_bf16(pa2, PK(l2, h2), od, 0, 0, 0);
  od = __builtin_amdgcn_mfma_f32_32x32x16_bf16(pa3, PK(l3, h3), od, 0, 0, 0);
#undef PK
}
__device__ __forceinline__ void pv_d0(f32x16* o, int vb, bf16x8 pa0, bf16x8 pa1, bf16x8 pa2, bf16x8 pa3) {
  pv_one<0>(o[0], vb, pa0, pa1, pa2, pa3); pv_one<1>(o[1], vb, pa0, pa1, pa2, pa3); pv_one<2>(o[2], vb, pa0, pa1, pa2, pa3); pv_one<3>(o[3], vb, pa0, pa1, pa2, pa3);
}
template <int MODE> __device__ __forceinline__ void post_scores(f32x16& p0, f32x16& p1, int t, int qrow0, int r32, int hi, const float* tab, float cfar) {
  if constexpr (MODE == 1) {
    const int cw = qrow0 >> 6;
    if (t > cw) {
#pragma unroll
      for (int r = 0; r < 16; ++r) { p0[r] = -INFINITY; p1[r] = -INFINITY; }
    } else if (qrow0 - (64 * t + 63) >= 91) {
#pragma unroll
      for (int r = 0; r < 16; ++r) { p0[r] += cfar; p1[r] += cfar; }
    } else {
      const int base = qrow0 + r32 - 64 * t + 63;
#pragma unroll
      for (int r = 0; r < 16; ++r) { const int i0 = base - crow(r, hi); const int i1 = i0 - 32;
        p0[r] += tab[i0 < TAB_N - 1 ? i0 : TAB_N - 1]; p1[r] += tab[i1 < TAB_N - 1 ? i1 : TAB_N - 1]; }
    }
  }
}

template <int MODE>
__device__ __forceinline__ void attn_body(const bf16* __restrict__ Qb, int ldq, const bf16* __restrict__ Kh, const bf16* __restrict__ Vh, int ldk,
                                          bf16* Ob, float* Of, int ldo, int NT, int q0abs, const float* tab, float cfar, char* lds) {
  int tid_ = threadIdx.x; asm volatile("" : "+v"(tid_));
  const int tid = tid_, wid = tid >> 6, lane = tid & 63, r32 = lane & 31, hi = lane >> 5;
  char* V_lds = lds; char* K_lds = lds + 2 * SHM_V;
  float* ws = (float*)(lds + 2 * SHM_V + 2 * SHM_K) + wid * 64; float* li_l = ws; float* al_l = ws + 32;
  float m_reg = -1e30f, l_reg = 0; f32x16 o[4] = {}; bf16x8 qr[8];
  const int qrow0 = q0abs + wid * QBLK;
  const bf16* Qw = Qb + (long)(wid * QBLK + r32) * ldq + hi * 8;
#pragma unroll
  for (int d0 = 0; d0 < 8; ++d0) qr[d0] = *reinterpret_cast<const bf16x8*>(Qw + d0 * 16);
  const int sr = tid >> 4, sc = (tid & 15) * 8, vst0 = v_st(sr, sc), vst1 = v_st(32 + sr, sc);
  const int vb0 = (int)(uintptr_t)V_lds + v_rd_base(lane);
  struct { bf16x8 vs0, vs1, ks0, ks1; } sr_[2];
#define SLOAD(i, k0) do { sr_[i].vs0 = *reinterpret_cast<const bf16x8*>(&Vh[(long)((k0) + sr) * ldk + sc]); sr_[i].vs1 = *reinterpret_cast<const bf16x8*>(&Vh[(long)((k0) + 32 + sr) * ldk + sc]); \
    sr_[i].ks0 = *reinterpret_cast<const bf16x8*>(&Kh[(long)((k0) + sr) * ldk + sc]); sr_[i].ks1 = *reinterpret_cast<const bf16x8*>(&Kh[(long)((k0) + 32 + sr) * ldk + sc]); } while (0)
#define SWRITE(b, i) do { *(bf16x8*)(V_lds + (b) * SHM_V + vst0) = sr_[i].vs0;          \
    *(bf16x8*)(V_lds + (b) * SHM_V + vst1) = sr_[i].vs1; const int kc = sc * 2;               \
    *(bf16x8*)(K_lds + (b) * SHM_K + KSWZ(sr, kc)) = sr_[i].ks0;                       \
    *(bf16x8*)(K_lds + (b) * SHM_K + KSWZ(32 + sr, kc)) = sr_[i].ks1; } while (0)
#define SWAIT() asm volatile("s_waitcnt vmcnt(4)" ::: "memory")
#define RESC(a) do { if (__any((a) < 1.f)) { if (hi == 0) al_l[r32] = (a); asm volatile("s_waitcnt lgkmcnt(0)" ::: "memory"); \
    _Pragma("unroll") for (int d = 0; d < 4; ++d) _Pragma("unroll") for (int r = 0; r < 16; ++r) o[d][r] *= al_l[crow(r, hi)]; } } while (0)
  f32x16 pA0, pA1, pB0, pB1; float mnA, mnB, alA, alB; bf16x8 pa0, pa1, pa2, pa3;
  constexpr int SE = 0, SO = 1;
  SLOAD(SE, 0); asm volatile("s_waitcnt vmcnt(0)" ::: "memory"); SWRITE(0, SE); __syncthreads();
  qkt(pA0, pA1, K_lds, qr, r32, hi); post_scores<MODE>(pA0, pA1, 0, qrow0, r32, hi, tab, cfar); partialSM(pA0, pA1, m_reg, mnA, alA);
  SLOAD(SO, KVBLK); if (2 < NT) SLOAD(SE, 2 * KVBLK);
  SWAIT(); SWRITE(1, SO); __syncthreads();
  for (int j = 1; j + 1 < NT; j += 2) {
    SBAR(); qkt(pB0, pB1, K_lds + SHM_K, qr, r32, hi); post_scores<MODE>(pB0, pB1, j, qrow0, r32, hi, tab, cfar);
    finishSM(pA0, pA1, alA, l_reg, pa0, pa1, pa2, pa3); SBAR();
    SLOAD(SO, (j + 2) * KVBLK); SBAR();
    pv_d0(o, vb0, pa0, pa1, pa2, pa3); partialSM(pB0, pB1, m_reg, mnB, alB);
    __syncthreads(); SWAIT(); SWRITE(0, SE);
    RESC(alB); __syncthreads();
    SBAR(); qkt(pA0, pA1, K_lds, qr, r32, hi); post_scores<MODE>(pA0, pA1, j + 1, qrow0, r32, hi, tab, cfar);
    finishSM(pB0, pB1, alB, l_reg, pa0, pa1, pa2, pa3); SBAR();
    if (j + 3 < NT) SLOAD(SE, (j + 3) * KVBLK); SBAR();
    pv_d0(o, vb0 + (int)SHM_V, pa0, pa1, pa2, pa3); partialSM(pA0, pA1, m_reg, mnA, alA);
    __syncthreads(); SWAIT(); SWRITE(1, SO);
    RESC(alA); __syncthreads();
  }
  SBAR(); qkt(pB0, pB1, K_lds + SHM_K, qr, r32, hi); post_scores<MODE>(pB0, pB1, NT - 1, qrow0, r32, hi, tab, cfar);
  finishSM(pA0, pA1, alA, l_reg, pa0, pa1, pa2, pa3); SBAR();
  pv_d0(o, vb0, pa0, pa1, pa2, pa3); partialSM(pB0, pB1, m_reg, mnB, alB);
  __syncthreads(); RESC(alB);
  finishSM(pB0, pB1, alB, l_reg, pa0, pa1, pa2, pa3); SBAR();
  pv_d0(o, vb0 + (int)SHM_V, pa0, pa1, pa2, pa3);
  if (hi == 0) li_l[r32] = l_reg; asm volatile("s_waitcnt lgkmcnt(0)" ::: "memory");
  float rli[16];
#pragma unroll
  for (int r = 0; r < 16; ++r) rli[r] = __builtin_amdgcn_rcpf(li_l[crow(r, hi)]);
  if constexpr (MODE == 0) {
    bf16* Ow = Ob + (long)(wid * QBLK) * ldo;
#pragma unroll
    for (int r = 0; r < 16; ++r) { const int orow = crow(r, hi);
#pragma unroll
      for (int d0 = 0; d0 < 4; ++d0) Ow[(long)orow * ldo + d0 * 32 + r32] = (bf16)f2bf(o[d0][r] * rli[r]); }
  } else {
    float* Ow = Of + (long)(wid * QBLK) * ldo;
#pragma unroll
    for (int r = 0; r < 16; ++r) { const int orow = crow(r, hi);
#pragma unroll
      for (int d0 = 0; d0 < 4; ++d0) Ow[(long)orow * ldo + d0 * 32 + r32] = o[d0][r] * rli[r]; }
  }
  __syncthreads();
#undef SLOAD
#undef SWRITE
#undef SWAIT
#undef RESC
}
}

#define XB_TMO      128
#define XB_XCNT(j)  (256  + 64 * (j))
#define XB_XSUB(j)  (1280 + 64 * (j))
#define XB_XGEN(j)  (2304 + 64 * (j))
#define XB_TOP      3328
#define XB_TOPGEN   3392
#define XCD_BAR_WORDS 3456
#define XB_SPIN_CAP (1u << 18)

__device__ __forceinline__ unsigned xb_ld(unsigned* p)              { return __hip_atomic_load(p, __ATOMIC_RELAXED, __HIP_MEMORY_SCOPE_AGENT); }
__device__ __forceinline__ unsigned xb_add(unsigned* p, unsigned v) { return __hip_atomic_fetch_add(p, v, __ATOMIC_RELAXED, __HIP_MEMORY_SCOPE_AGENT); }
__device__ __forceinline__ unsigned xb_xcc_id() { return (unsigned)__builtin_amdgcn_s_getreg((3 << 11) | 20) & 0xFu; }
#define XB_SPIN(cond, bar) do { unsigned _sp = 0; while (cond) { __builtin_amdgcn_s_sleep(1); \
    if ((++_sp & 255u) == 0u) { if (xb_ld(&(bar)[XB_TMO])) break; if (_sp > XB_SPIN_CAP) { atomicAdd(&(bar)[XB_TMO], 1u); break; } } } } while (0)

struct XcdBarrier {
    unsigned* bar; unsigned x;
    volatile LAS unsigned* st;
};

__device__ __forceinline__ XcdBarrier xcd_barrier_post(unsigned* bar, volatile LAS unsigned* st) {
    XcdBarrier b; b.bar = bar; b.x = xb_xcc_id(); b.st = st;
    if (threadIdx.x == 0) (void)xb_add(&bar[XB_XCNT(b.x)], 1u);
    return b;
}
__device__ __forceinline__ void xcd_barrier_complete(unsigned* bar, unsigned x, unsigned& nloc, unsigned& nx) {
    const unsigned G = gridDim.x * gridDim.y * gridDim.z;
    unsigned sum, cnt, mine, sp = 0u;
    for (;;) {
        sum = 0u; cnt = 0u; mine = 0u;
#pragma unroll
        for (unsigned j = 0; j < 16; ++j) { const unsigned c = xb_ld(&bar[XB_XCNT(j)]); sum += c; cnt += (c > 0u) ? 1u : 0u; mine = (j == x) ? c : mine; }
        if (sum == G) break;
        __builtin_amdgcn_s_sleep(1);
        if ((++sp & 255u) == 0u) { if (xb_ld(&bar[XB_TMO])) break; if (sp > XB_SPIN_CAP) { atomicAdd(&bar[XB_TMO], 1u); break; } }
    }
    nloc = mine > 0u ? mine : 1u; nx = cnt > 0u ? cnt : 1u;
}

__device__ __forceinline__ void xcd_barrier(const XcdBarrier& b) {
    asm volatile("s_waitcnt vmcnt(0)" ::: "memory");
    __syncthreads();
    if (threadIdx.x == 0) {
        unsigned* bar = b.bar;
        __builtin_amdgcn_s_waitcnt(0);
        unsigned nloc = b.st[0], nx = b.st[1];
        if (nloc == 0u) { xcd_barrier_complete(bar, b.x, nloc, nx); b.st[0] = nloc; b.st[1] = nx; }
        const unsigned old = xb_add(&bar[XB_XSUB(b.x)], 1u);
        const unsigned gen = old / nloc;
        if (old + 1u == (gen + 1u) * nloc) {
            __builtin_amdgcn_fence(__ATOMIC_RELEASE, "agent");
            asm volatile("s_waitcnt vmcnt(0)" ::: "memory");
            const unsigned og = xb_add(&bar[XB_TOP], 1u);
            const unsigned tg = og / nx;
            if (og + 1u == (tg + 1u) * nx) xb_add(&bar[XB_TOPGEN], 1u);
            else XB_SPIN(xb_ld(&bar[XB_TOPGEN]) == tg, bar);
            __builtin_amdgcn_fence(__ATOMIC_ACQUIRE, "agent");
            xb_add(&bar[XB_XGEN(b.x)], 1u);
            asm volatile("s_waitcnt vmcnt(0)" ::: "memory");
        } else {
            XB_SPIN(xb_ld(&bar[XB_XGEN(b.x)]) == gen, bar);
            __builtin_amdgcn_fence(__ATOMIC_ACQUIRE, "agent");
            asm volatile("s_waitcnt vmcnt(0)" ::: "memory");
        }
    }
    __syncthreads();
}


struct Args { const float* in[24]; float* out; unsigned char* ws; int ph_lo, ph_hi; };
enum { I_X = 0, I_MEM, I_AWIN, I_ALNG, I_ALNB, I_AWS, I_ABS, I_AWOUT, I_BWIN, I_BLAM, I_BSUBG, I_BWOUT, I_WKV, I_RELB, I_MEMWKV, I_LNG, I_LNB,
       I_WG1, I_BG1, I_WG2, I_BG2, I_W1, I_W3, I_W2 };
constexpr int NPH_LAYER = 9, NPHASES = 1 + DEPTH * NPH_LAYER;

struct Frame {
    LAS unsigned char* lds; char* ldsg;
    gu32* ctl; unsigned char* ws;
    int tid, lane, wave, G, c;
};

__device__ __forceinline__ void transpose_item(const float* W, int K, int N, bf16* WT, int drow0, LAS float* scr, int k0, int n0, int lane) {
#pragma unroll 8
    for (int i = 0; i < 32; ++i) { const int kk = 2 * i + (lane >> 5); scr[kk * 33 + (lane & 31)] = W[(size_t)(k0 + kk) * N + n0 + (lane & 31)]; }
    LDS_WAIT(); asm volatile("" ::: "memory");
    const int c = lane & 7;
#pragma unroll
    for (int j = 0; j < 4; ++j) { const int n = (lane >> 3) + 8 * j; const LAS float* s = scr + (8 * c) * 33 + n;
        v4u o; o.x = pk2(s[0 * 33], s[1 * 33]); o.y = pk2(s[2 * 33], s[3 * 33]); o.z = pk2(s[4 * 33], s[5 * 33]); o.w = pk2(s[6 * 33], s[7 * 33]);
        *(GAS v4u*)(WT + (size_t)(drow0 + n) * K + k0 + 8 * c) = o; }
    LDS_WAIT(); asm volatile("" ::: "memory");
}
__device__ __forceinline__ void transpose_item_fast(const float* W, int K, int N, bf16* WT, int drow0, LAS float* scr, int k0, int n0, int lane) {
    float t[32];
#pragma unroll
    for (int i = 0; i < 32; ++i) t[i] = W[(size_t)(k0 + 2 * i + (lane >> 5)) * N + n0 + (lane & 31)];
#pragma unroll
    for (int i = 0; i < 32; i += 8) asm volatile("" : "+v"(t[i]), "+v"(t[i + 1]), "+v"(t[i + 2]), "+v"(t[i + 3]), "+v"(t[i + 4]), "+v"(t[i + 5]), "+v"(t[i + 6]), "+v"(t[i + 7]));
#pragma unroll
    for (int i = 0; i < 32; ++i) scr[(2 * i + (lane >> 5)) * 33 + (lane & 31)] = t[i];
    LDS_WAIT(); asm volatile("" ::: "memory");
    const int c = lane & 7;
#pragma unroll
    for (int j = 0; j < 4; ++j) { const int n = (lane >> 3) + 8 * j; const LAS float* s = scr + (8 * c) * 33 + n;
        v4u o; o.x = pk2(s[0 * 33], s[1 * 33]); o.y = pk2(s[2 * 33], s[3 * 33]); o.z = pk2(s[4 * 33], s[5 * 33]); o.w = pk2(s[6 * 33], s[7 * 33]);
        *(GAS v4u*)(WT + (size_t)(drow0 + n) * K + k0 + 8 * c) = o; }
    LDS_WAIT(); asm volatile("" ::: "memory");
}
__device__ __forceinline__ void prologue_phase(Frame& F, const Args& a) {
#ifdef TOUCH
    {
        const long nthr_ = (long)F.G * 512, gt_ = (long)F.c * 512 + F.tid; unsigned acc_ = 0u;
        for (long pg = gt_; pg < (long)(WS_END / 4096); pg += nthr_) acc_ += *(const GAS unsigned*)(F.ws + pg * 4096);
        for (long pg = gt_; pg < (long)((size_t)DEPTH * NE * D * FF * 4 / 4096); pg += nthr_) { acc_ += *(const GAS unsigned*)((const char*)a.in[I_W1] + pg * 4096); acc_ += *(const GAS unsigned*)((const char*)a.in[I_W3] + pg * 4096); acc_ += *(const GAS unsigned*)((const char*)a.in[I_W2] + pg * 4096); }
        if (acc_ == 0x12345679u) F.ctl[CW_TMO] = acc_;
    }
#endif
    LAS float* scr = (LAS float*)(F.lds + RING_OFF + F.wave * 16384);
    const int gw = F.c * NWAVES + F.wave, NGW = F.G * NWAVES;
    unsigned char* ws = F.ws;
    constexpr int S0 = 3584, S1 = 2048, S5 = 4 * 1024;
    constexpr int NITEMS = S0 + S1 + S5;
    for (int it = gw; it < NITEMS; it += NGW) {
        int r = it; const float* src; bf16* dst; int K = 2048, N;
        if (r < S0) { N = 3584; src = a.in[I_AWIN]; dst = (bf16*)(ws + WS_WAIN); }
        else if ((r -= S0) < S1) { N = 2048; src = a.in[I_AWOUT]; dst = (bf16*)(ws + WS_WAOUT); }
        else { r -= S1; const int mat = r >> 10; r &= 1023; N = 1024; src = a.in[I_MEMWKV] + (size_t)mat * K * N; dst = (bf16*)(ws + WS_WMKV) + (size_t)mat * K * N; }
        const int nblk = N / 32, kb = r / nblk, nb = r - kb * nblk;
        transpose_item_fast(src, K, N, dst, 32 * nb, scr, 64 * kb, 32 * nb, F.lane);
    }
    const long nthr = (long)F.G * 512, gt = (long)F.c * 512 + F.tid;
    { float* wr = (float*)(ws + WS_WR);
      for (long i = gt; i < (long)DEPTH * 3 * 512 * 16 * 4; i += nthr) { const int j = (int)(i & 3), c = (int)((i >> 2) & 15), kg = (int)((i >> 6) & 511), r = (int)(i >> 15), nb = r % 3, l = r / 3;
          const int k = 4 * kg + j, o = 16 * nb + c; float v = 0.f;
          if (o < 4) v = a.in[I_WG1][((size_t)l * D + k) * 4 + o]; else if (o < 36) { const int g = (o - 4) >> 3, e = (o - 4) & 7; v = a.in[I_WG2][(((size_t)l * 4 + g) * D + k) * 8 + e]; }
          wr[i] = v; } }
    { const float* x = a.in[I_X]; bf16* xb = (bf16*)(ws + WS_XB);
      for (long i = gt; i < (long)T * D / 8; i += nthr) { const f32x4 v0 = *(const GAS f32x4*)(x + i * 8), v1 = *(const GAS f32x4*)(x + i * 8 + 4);
          v4u o; o.x = pk2(v0.x, v0.y); o.y = pk2(v0.z, v0.w); o.z = pk2(v1.x, v1.y); o.w = pk2(v1.z, v1.w); *(GAS v4u*)(xb + i * 8) = o; } }
    { const float* x = a.in[I_MEM]; bf16* xb = (bf16*)(ws + WS_MEMB);
      for (long i = gt; i < (long)MEMT * D / 8; i += nthr) { const f32x4 v0 = *(const GAS f32x4*)(x + i * 8), v1 = *(const GAS f32x4*)(x + i * 8 + 4);
          v4u o; o.x = pk2(v0.x, v0.y); o.y = pk2(v0.z, v0.w); o.z = pk2(v1.x, v1.y); o.w = pk2(v1.z, v1.w); *(GAS v4u*)(xb + i * 8) = o; } }
}

__device__ __forceinline__ void transpose_item_fp8(const float* W, int K, int N, unsigned char* WT, int drow0, LAS float* scr, int k0, int n0, int lane) {
    float t[32];
#pragma unroll
    for (int i = 0; i < 32; ++i) t[i] = W[(size_t)(k0 + 2 * i + (lane >> 5)) * N + n0 + (lane & 31)];
#pragma unroll
    for (int i = 0; i < 32; i += 8) asm volatile("" : "+v"(t[i]), "+v"(t[i + 1]), "+v"(t[i + 2]), "+v"(t[i + 3]), "+v"(t[i + 4]), "+v"(t[i + 5]), "+v"(t[i + 6]), "+v"(t[i + 7]));
#pragma unroll
    for (int i = 0; i < 32; ++i) scr[(2 * i + (lane >> 5)) * 33 + (lane & 31)] = t[i];
    LDS_WAIT(); asm volatile("" ::: "memory");
    const int c = lane & 7;
#pragma unroll
    for (int j = 0; j < 4; ++j) { const int n = (lane >> 3) + 8 * j; const LAS float* s = scr + (8 * c) * 33 + n;
        unsigned lo = 0u, hi = 0u;
        lo = __builtin_amdgcn_cvt_pk_fp8_f32(s[0 * 33] * 64.f, s[1 * 33] * 64.f, lo, false); lo = __builtin_amdgcn_cvt_pk_fp8_f32(s[2 * 33] * 64.f, s[3 * 33] * 64.f, lo, true);
        hi = __builtin_amdgcn_cvt_pk_fp8_f32(s[4 * 33] * 64.f, s[5 * 33] * 64.f, hi, false); hi = __builtin_amdgcn_cvt_pk_fp8_f32(s[6 * 33] * 64.f, s[7 * 33] * 64.f, hi, true);
        v2u o; o.x = lo; o.y = hi; *(GAS v2u*)(WT + (size_t)(drow0 + n) * K + k0 + 8 * c) = o; }
    LDS_WAIT(); asm volatile("" ::: "memory");
}
#ifndef CDRAIN
#define CDRAIN 8
#endif
#ifndef CSRV
#define CSRV 4
#endif
#ifndef QX
#define QX 6
#endif
#ifndef QA
#define QA 14
#endif
#ifndef QM
#define QM 7
#endif
#ifndef QB
#define QB 4
#endif
constexpr int NQ = 7, MOE_ITEMS = 3 * 32 * 512;
__device__ __forceinline__ int conv_qsize(int q) { return (q & 1) ? (q == 1 ? 5632 : (q == 3 ? 7168 : 4096)) : MOE_ITEMS; }
__device__ __forceinline__ void conv_item(Frame& F, const Args& a, int q, int it) {
    LAS float* scr = (LAS float*)(F.lds + RING_OFF + F.wave * 16384);
    if (q & 1) {
        const float* src; bf16* dst; int N, r = it;
        if (q == 1) { if (r < 3584) { N = 3584; src = a.in[I_AWIN] + (size_t)2048 * 3584; dst = (bf16*)(F.ws + WS_WAIN) + (size_t)2048 * 3584; } else { r -= 3584; N = 2048; src = a.in[I_AWOUT] + (size_t)2048 * 2048; dst = (bf16*)(F.ws + WS_WAOUT) + (size_t)2048 * 2048; } }
        else if (q == 3) { if (r < 2048) { N = 2048; src = a.in[I_BWIN]; dst = (bf16*)(F.ws + WS_WBIN0); } else if ((r -= 2048) < 3072) { N = 3072; src = a.in[I_WKV]; dst = (bf16*)(F.ws + WS_WKV); } else { r -= 3072; N = 2048; src = a.in[I_BWOUT]; dst = (bf16*)(F.ws + WS_WBOUT); } }
        else { if (r < 2048) { N = 2048; src = a.in[I_BWIN] + (size_t)2048 * 2048; dst = (bf16*)(F.ws + WS_WBIN1); } else { r -= 2048; N = 2048; src = a.in[I_BWOUT] + (size_t)2048 * 2048; dst = (bf16*)(F.ws + WS_WBOUT) + (size_t)2048 * 2048; } }
        const int nblk = N / 32, kb = r / nblk, nb = r - kb * nblk;
        transpose_item_fast(src, 2048, N, dst, 32 * nb, scr, 64 * kb, 32 * nb, F.lane);
        return;
    }
    const int L = q >> 1, seg = it >> 14, r0 = it & 16383, e = r0 >> 9, r = r0 & 511, mat = L * 32 + e;
    if (seg < 2) { const int kb = r >> 4, nb = r & 15, n0 = 32 * nb;
        transpose_item_fp8(a.in[seg == 0 ? I_W1 : I_W3] + (size_t)mat * 2048 * 512, 2048, 512, (unsigned char*)(F.ws + WS_W13) + (size_t)mat * 1024 * 2048, (n0 >> 7) * 256 + (n0 & 127) + (seg == 1 ? 128 : 0), scr, 64 * kb, n0, F.lane); }
    else { const int kb = r >> 6, nb = r & 63;
        transpose_item_fp8(a.in[I_W2] + (size_t)mat * 512 * 2048, 512, 2048, (unsigned char*)(F.ws + WS_W2) + (size_t)mat * 512 * 2048, 32 * nb, scr, 64 * kb, 32 * nb, F.lane); }
}
#ifndef CDEPTH
#define CDEPTH 2
#endif
struct CDesc { const float* src; unsigned char* dst; int N, K, drow0, k0, n0, f8; };
__device__ __forceinline__ CDesc conv_desc(Frame& F, const Args& a, int q, int it) {
    CDesc d;
    if (q & 1) {
        const float* src; bf16* dst; int N, r = it;
        if (q == 1) { if (r < 3584) { N = 3584; src = a.in[I_AWIN] + (size_t)2048 * 3584; dst = (bf16*)(F.ws + WS_WAIN) + (size_t)2048 * 3584; } else { r -= 3584; N = 2048; src = a.in[I_AWOUT] + (size_t)2048 * 2048; dst = (bf16*)(F.ws + WS_WAOUT) + (size_t)2048 * 2048; } }
        else if (q == 3) { if (r < 2048) { N = 2048; src = a.in[I_BWIN]; dst = (bf16*)(F.ws + WS_WBIN0); } else if ((r -= 2048) < 3072) { N = 3072; src = a.in[I_WKV]; dst = (bf16*)(F.ws + WS_WKV); } else { r -= 3072; N = 2048; src = a.in[I_BWOUT]; dst = (bf16*)(F.ws + WS_WBOUT); } }
        else { if (r < 2048) { N = 2048; src = a.in[I_BWIN] + (size_t)2048 * 2048; dst = (bf16*)(F.ws + WS_WBIN1); } else { r -= 2048; N = 2048; src = a.in[I_BWOUT] + (size_t)2048 * 2048; dst = (bf16*)(F.ws + WS_WBOUT) + (size_t)2048 * 2048; } }
        const int nblk = N / 32, kb = r / nblk, nb = r - kb * nblk;
        d.src = src; d.dst = (unsigned char*)dst; d.N = N; d.K = 2048; d.drow0 = 32 * nb; d.k0 = 64 * kb; d.n0 = 32 * nb; d.f8 = 0; return d;
    }
    const int L = q >> 1, seg = it >> 14, r0 = it & 16383, e = r0 >> 9, r = r0 & 511, mat = L * 32 + e;
    if (seg < 2) { const int kb = r >> 4, nb = r & 15, n0 = 32 * nb;
        d.src = a.in[seg == 0 ? I_W1 : I_W3] + (size_t)mat * 2048 * 512; d.dst = (unsigned char*)(F.ws + WS_W13) + (size_t)mat * 1024 * 2048; d.N = 512; d.K = 2048;
        d.drow0 = (n0 >> 7) * 256 + (n0 & 127) + (seg == 1 ? 128 : 0); d.k0 = 64 * kb; d.n0 = n0; d.f8 = 1; }
    else { const int kb = r >> 6, nb = r & 63;
        d.src = a.in[I_W2] + (size_t)mat * 512 * 2048; d.dst = (unsigned char*)(F.ws + WS_W2) + (size_t)mat * 512 * 2048; d.N = 2048; d.K = 512; d.drow0 = 32 * nb; d.k0 = 64 * kb; d.n0 = 32 * nb; d.f8 = 1; }
    return d;
}
#define CV_LOAD(t_, d_) do { const float* p_ = (d_).src + (size_t)((d_).k0 + (F.lane >> 3)) * (d_).N + (d_).n0 + 4 * (F.lane & 7); const size_t st_ = (size_t)8 * (d_).N; \
    _Pragma("unroll") for (int i_ = 0; i_ < 8; ++i_) (t_)[i_] = *(const GAS f32x4*)(p_ + st_ * i_); } while (0)
__device__ __forceinline__ void conv_process(Frame& F, f32x4 (&t)[8], const CDesc& d) {
    LAS float* scr = (LAS float*)(F.lds + RING_OFF + F.wave * 16384); const int lane = F.lane;
    asm volatile("" : "+v"(t[0]), "+v"(t[1]), "+v"(t[2]), "+v"(t[3]), "+v"(t[4]), "+v"(t[5]), "+v"(t[6]), "+v"(t[7]));
    { LAS float* w = scr + (lane >> 3) * 33 + 4 * (lane & 7);
#pragma unroll
      for (int i = 0; i < 8; ++i) { w[i * 8 * 33 + 0] = t[i].x; w[i * 8 * 33 + 1] = t[i].y; w[i * 8 * 33 + 2] = t[i].z; w[i * 8 * 33 + 3] = t[i].w; } }
    LDS_WAIT(); asm volatile("" ::: "memory");
    const int c = lane & 7;
    if (d.f8) {
#pragma unroll
        for (int j = 0; j < 4; ++j) { const int n = (lane >> 3) + 8 * j; const LAS float* s = scr + (8 * c) * 33 + n;
            unsigned lo = 0u, hi = 0u;
            lo = __builtin_amdgcn_cvt_pk_fp8_f32(s[0 * 33] * 64.f, s[1 * 33] * 64.f, lo, false); lo = __builtin_amdgcn_cvt_pk_fp8_f32(s[2 * 33] * 64.f, s[3 * 33] * 64.f, lo, true);
            hi = __builtin_amdgcn_cvt_pk_fp8_f32(s[4 * 33] * 64.f, s[5 * 33] * 64.f, hi, false); hi = __builtin_amdgcn_cvt_pk_fp8_f32(s[6 * 33] * 64.f, s[7 * 33] * 64.f, hi, true);
            v2u o; o.x = lo; o.y = hi; *(GAS v2u*)(d.dst + (size_t)(d.drow0 + n) * d.K + d.k0 + 8 * c) = o; }
    } else {
#pragma unroll
        for (int j = 0; j < 4; ++j) { const int n = (lane >> 3) + 8 * j; const LAS float* s = scr + (8 * c) * 33 + n;
            v4u o; o.x = pk2(s[0 * 33], s[1 * 33]); o.y = pk2(s[2 * 33], s[3 * 33]); o.z = pk2(s[4 * 33], s[5 * 33]); o.w = pk2(s[6 * 33], s[7 * 33]);
            *(GAS v4u*)((bf16*)d.dst + (size_t)(d.drow0 + n) * d.K + d.k0 + 8 * c) = o; }
    }
    LDS_WAIT(); asm volatile("" ::: "memory");
}
__device__ __forceinline__ void conv_range(Frame& F, const Args& a, int q, int first, int cnt) {
#if CDEPTH == 1
    for (int i = 0; i < cnt; ++i) conv_item(F, a, q, first + i);
#else
    f32x4 t[CDEPTH][8]; const int last = first + cnt - 1;
#pragma unroll
    for (int s = 0; s < CDEPTH - 1; ++s) { const int it = first + s < last ? first + s : last; const CDesc d = conv_desc(F, a, q, it); CV_LOAD(t[s], d); }
#pragma unroll 1
    for (int i0 = 0; i0 < cnt; i0 += CDEPTH) {
#pragma unroll
        for (int s = 0; s < CDEPTH; ++s) {
            { const int nx = first + i0 + s + CDEPTH - 1, it = nx < last ? nx : last; const CDesc d = conv_desc(F, a, q, it); CV_LOAD(t[(s + CDEPTH - 1) % CDEPTH], d); }
            asm volatile("" ::: "memory");
            if (i0 + s < cnt) { const CDesc d = conv_desc(F, a, q, first + i0 + s); conv_process(F, t[s], d); }
        }
    }
#endif
}
__device__ __forceinline__ void conv_filler(Frame& F, const Args& a, int q0, int n) {
    if (q0 >= NQ || n == 0) return;
    LAS unsigned* bw = (LAS unsigned*)(F.lds + TAB_OFF + 384);
    __syncthreads();
    const bool drain = n < 0; const int per = drain ? CDRAIN : n; int q = q0;
    for (;;) {
        if (F.tid == 0) bw[0] = __hip_atomic_fetch_add(F.ctl + CW_CONV + 64 * q, (unsigned)(8 * per), RLX_AGENT);
        __syncthreads();
        const unsigned idx = bw[0];
        __syncthreads();
        const int qs = conv_qsize(q);
        if (idx >= (unsigned)qs) { if (drain || ++q >= NQ) break; continue; }
        { const int first = (int)idx + F.wave * per, cnt = (qs - first < per) ? qs - first : per; if (cnt > 0) conv_range(F, a, q, first, cnt); }
        if (!drain) break;
    }
}

#ifndef NCVMAX
#define NCVMAX 32
#endif
#ifndef NCVATT
#define NCVATT 16
#endif
__device__ __forceinline__ int conv_servers(int nu, int G, int fin) {
    if (fin || nu <= 0) return 0;
    const int rounds = (nu + G - 1) / G, gmin = (nu + rounds - 1) / rounds; int n = G - gmin; n = n < NCVMAX ? n : NCVMAX; return n & ~7;
}
__device__ __forceinline__ void conv_done(Frame& F, int p) { __syncthreads(); if (F.tid == 0) __hip_atomic_fetch_add(F.ctl + CW_DONE + 64 * p, 1u, RLX_AGENT); }
__device__ __forceinline__ void conv_server(Frame& F, const Args& a, int p, int q0, int ncomp) {
    int q = q0;
    for (;;) {
        if (q >= NQ) break;
        unsigned idx = 0xffffffffu;
        if (F.lane == 0) { if (__hip_atomic_load(F.ctl + CW_DONE + 64 * p, RLX_AGENT) < (unsigned)ncomp) idx = __hip_atomic_fetch_add(F.ctl + CW_CONV + 64 * q, (unsigned)CSRV, RLX_AGENT); }
        idx = (unsigned)__builtin_amdgcn_readfirstlane((int)idx);
        if (idx == 0xffffffffu) break;
        const int qs = conv_qsize(q);
        if (idx >= (unsigned)qs) { ++q; continue; }
        conv_range(F, a, q, (int)idx, (qs - (int)idx < CSRV) ? qs - (int)idx : CSRV);
    }
}
__device__ __forceinline__ void conv_note_fin(Frame& F, int p) {
    if (blockIdx.x == 0 && F.tid == 0) { unsigned all = 1u;
        for (int q = 0; q < NQ; ++q) all &= (__hip_atomic_load(F.ctl + CW_CONV + 64 * q, RLX_AGENT) >= (unsigned)conv_qsize(q)) ? 1u : 0u;
        __hip_atomic_store(F.ctl + CW_FIN + 64 * p, all, RLX_AGENT); }
}

__device__ __forceinline__ void sgu_unit(Frame& F, const Args& a, int l, int n, int g) {
    constexpr int LDW = 136;
    LAS float* stats = (LAS float*)(F.lds); LAS bf16* Wl = (LAS bf16*)(F.lds + 1024); LAS bf16* Vt = (LAS bf16*)(F.lds + 35840);
    const bf16* z = (const bf16*)(F.ws + WS_Z); bf16* cat = (bf16*)(F.ws + WS_CAT);
    const int tok0 = n * 128;
    for (int i = 0; i < 16; ++i) { const int tk = F.wave * 16 + i; const GAS v4u* rp = (const GAS v4u*)(z + (size_t)(tok0 + tk) * NINA + MIXW) + F.lane;
        v4u w[3]; float s = 0.f;
#pragma unroll
        for (int j = 0; j < 3; ++j) { w[j] = rp[64 * j]; s += (bflo(w[j].x) + bfhi(w[j].x)) + (bflo(w[j].y) + bfhi(w[j].y)) + (bflo(w[j].z) + bfhi(w[j].z)) + (bflo(w[j].w) + bfhi(w[j].w)); }
        const float mean = wave_sum(s) * (1.f / MIXW); float q = 0.f;
#pragma unroll
        for (int j = 0; j < 3; ++j) { float d;
            d = bflo(w[j].x) - mean; q += d * d; d = bfhi(w[j].x) - mean; q += d * d; d = bflo(w[j].y) - mean; q += d * d; d = bfhi(w[j].y) - mean; q += d * d;
            d = bflo(w[j].z) - mean; q += d * d; d = bfhi(w[j].z) - mean; q += d * d; d = bflo(w[j].w) - mean; q += d * d; d = bfhi(w[j].w) - mean; q += d * d; }
        const float rstd = 1.f / sqrtf(wave_sum(q) * (1.f / MIXW) + LN_EPS);
        if (F.lane == 0) { stats[2 * tk] = mean; stats[2 * tk + 1] = rstd; } }
    { const float* wsrc = a.in[I_AWS] + ((size_t)l * 4 + g) * 128 * 128;
      for (int p = F.tid; p < 128 * 32; p += 512) { const int i = p >> 5, j4 = (p & 31) * 4; f32x4 v = *(const GAS f32x4*)(wsrc + i * 128 + j4);
          if ((j4 >> 6) > (i >> 6)) v = (f32x4){0.f, 0.f, 0.f, 0.f};
          v2u o; o.x = pk2(v.x, v.y); o.y = pk2(v.z, v.w); *(LAS v2u*)(Wl + i * LDW + j4) = o; } }
    __syncthreads();
    { const float* lg = a.in[I_ALNG] + (size_t)l * MIXW + g * 384; const float* lb = a.in[I_ALNB] + (size_t)l * MIXW + g * 384;
      for (int p = F.tid; p < 128 * 48; p += 512) { const int j = p & 127, c8 = (p >> 7) * 8;
          const v4u w = *(const GAS v4u*)(z + (size_t)(tok0 + j) * NINA + MIXW + g * 384 + c8);
          const float mean = stats[2 * j], rstd = stats[2 * j + 1];
          const f32x4 g0 = *(const GAS f32x4*)(lg + c8), g1 = *(const GAS f32x4*)(lg + c8 + 4), b0 = *(const GAS f32x4*)(lb + c8), b1 = *(const GAS f32x4*)(lb + c8 + 4);
          float v[8] = {bflo(w.x), bfhi(w.x), bflo(w.y), bfhi(w.y), bflo(w.z), bfhi(w.z), bflo(w.w), bfhi(w.w)};
          const float gg[8] = {g0.x, g0.y, g0.z, g0.w, g1.x, g1.y, g1.z, g1.w}, bb[8] = {b0.x, b0.y, b0.z, b0.w, b1.x, b1.y, b1.z, b1.w};
#pragma unroll
          for (int e = 0; e < 8; ++e) Vt[(c8 + e) * LDW + j] = (bf16)f2bf((v[e] - mean) * rstd * gg[e] + bb[e]); } }
    __syncthreads();
    const int fr = F.lane & 15, fq = F.lane >> 4;
    f32x4 acc[8][3];
#pragma unroll
    for (int mb = 0; mb < 8; ++mb)
#pragma unroll
        for (int nb = 0; nb < 3; ++nb) acc[mb][nb] = (f32x4){0.f, 0.f, 0.f, 0.f};
#pragma unroll
    for (int ks = 0; ks < 4; ++ks) { bf16x8 bfr[3];
#pragma unroll
        for (int nb = 0; nb < 3; ++nb) bfr[nb] = *(const LAS bf16x8*)(Vt + (F.wave * 48 + nb * 16 + fr) * LDW + ks * 32 + fq * 8);
#pragma unroll
        for (int mb = 0; mb < 8; ++mb) { const bf16x8 afr = *(const LAS bf16x8*)(Wl + (mb * 16 + fr) * LDW + ks * 32 + fq * 8);
#pragma unroll
            for (int nb = 0; nb < 3; ++nb) acc[mb][nb] = __builtin_amdgcn_mfma_f32_16x16x32_bf16(bfr[nb], afr, acc[mb][nb], 0, 0, 0); } }
    const float* bs = a.in[I_ABS] + ((size_t)l * 4 + g) * 128;
#pragma unroll
    for (int mb = 0; mb < 8; ++mb) { const int i = mb * 16 + fr; const float bsv = bs[i]; const size_t tk = (size_t)(tok0 + i);
#pragma unroll
        for (int nb = 0; nb < 3; ++nb) { const int c = g * 384 + F.wave * 48 + nb * 16 + 4 * fq;
            const v2u uw = *(const GAS v2u*)(z + tk * NINA + c); const f32x4 gt = acc[mb][nb] + bsv;
            v2u o; o.x = pk2(bflo(uw.x) * gt.x, bfhi(uw.x) * gt.y); o.y = pk2(bflo(uw.y) * gt.z, bfhi(uw.y) * gt.w);
            *(GAS v2u*)(cat + tk * D + c) = o; } }
    __syncthreads();
}

__device__ __forceinline__ void memattn_unit(Frame& F, int l, int hm, int qb, int ldz, int qoff) {
    const bf16* z = (const bf16*)(F.ws + WS_Z); const bf16* kv = (const bf16*)(F.ws + WS_MEMKV) + (size_t)l * 256 * 1024; bf16* cat = (bf16*)(F.ws + WS_CAT);
    att::attn_body<0>(z + (size_t)qb * 256 * ldz + qoff + hm * 128, ldz, kv + hm * 128, kv + 512 + hm * 128, 1024,
                      cat + (size_t)qb * 256 * D + MIXW + hm * 128, nullptr, D, 4, 0, nullptr, 0.f, F.ldsg);
}

__device__ __forceinline__ int t5_bucket(int rel) {
    const int a = rel < 0 ? -rel : rel; int f;
    if (a < 8) f = a; else if (a < 12) f = 8; else if (a < 16) f = 9; else if (a < 23) f = 10; else if (a < 32) f = 11; else if (a < 46) f = 12; else if (a < 64) f = 13; else if (a < 91) f = 14; else f = 15;
    return (rel > 0 ? 16 : 0) + f;
}

namespace att2 {
using att::bf16x8; using att::s16x4; using att::f32x16; using att::u32x4; using att::crow; using att::cvtpk; using att::tr_read; using att::v_rd_base;
constexpr int KT = 32, ST_K = KT * 128 * 2, ST_V = KT * 256 * 2, STAGE = 2 * ST_K + ST_V, NST = 3;
constexpr int LDS_WS = NST * STAGE, LDS_TAB = LDS_WS + 2048, LDS_UNIT = LDS_TAB + 640, LDS_END = LDS_UNIT + 16;
constexpr int NUNITS = 576;
constexpr float THR2 = 8.f * 1.4426950408889634f;
__device__ __forceinline__ int swap23(int k) { return (k & ~0xC) | ((k & 4) << 1) | ((k & 8) >> 1); }
constexpr int v_off(int d0, int ks, int half) { return d0 * 512 + ks * 8192 + half * 4096; }

struct UnitTable { unsigned short u[NUNITS]; };
constexpr UnitTable make_units() {
    UnitTable t{}; int n = 0;
    for (int c = 256; c >= 4; c -= 2) {
        { const int b = (c - 2) / 2; if ((c - 2) % 2 == 0 && b >= 32 && b <= 63) for (int part = 1; part <= 2; ++part) for (int h = 0; h < 6; ++h) t.u[n++] = (unsigned short)(h | (b << 3) | (part << 9)); }
        if (c % 4 == 0) { const int b = c / 4 - 1; if (b >= 0 && b < 32) for (int h = 0; h < 6; ++h) t.u[n++] = (unsigned short)(h | (b << 3)); }
    }
    return t;
}
__device__ const UnitTable g_units = make_units();

__device__ __forceinline__ void diff_unit(const bf16* __restrict__ Q, const bf16* __restrict__ KD, const bf16* __restrict__ VD, float* Obuf  , int orow0,
                                          float* ML  , const float* relb, int h, int b, int t_lo, int t_hi, LAS char* lds) {
  int tid_ = threadIdx.x; asm volatile("" : "+v"(tid_));
  const int tid = tid_, wid = __builtin_amdgcn_readfirstlane(tid >> 6), lane = tid & 63, r32 = lane & 31, hi = lane >> 5, m = wid >> 2, rg = wid & 3;
  LAS float* wsw = (LAS float*)(lds + LDS_WS) + wid * 64; LAS float* li_l = wsw; LAS float* al_l = wsw + 32;
  LAS float* tab = (LAS float*)(lds + LDS_TAB);
  if (tid < att::TAB_N) tab[tid] = relb[t5_bucket(63 - tid) * 6 + h] * LOG2E;
  const float cfar = relb[15 * 6 + h] * LOG2E;
  const int qrow0 = b * 128 + rg * 32;
  bf16x8 qr[8];
  { const bf16* Qw = Q + (size_t)(qrow0 + r32) * 2048 + h * 256 + m * 128 + hi * 8;
#pragma unroll
    for (int d0 = 0; d0 < 8; ++d0) qr[d0] = *reinterpret_cast<const bf16x8*>(Qw + d0 * 16); }
  int ko[2], vo[2];
#pragma unroll
  for (int i = 0; i < 2; ++i) {
    const int p = wid * 64 + lane, row = p >> 4, cp = (p & 15) ^ (row & 7); ko[i] = row * 1536 + h * 256 + i * 128 + cp * 8; }
#pragma unroll
  for (int i = 0; i < 2; ++i) {
    const int p = (wid * 2 + i) * 64 + lane, sub = p >> 5, kg = sub >> 3, cblk = sub & 7, q = p & 31, kk = kg * 8 + (q >> 2), key = swap23(kk);
    vo[i] = key * 1536 + h * 256 + cblk * 32 + (q & 3) * 8; }
  const unsigned ldsb = (unsigned)(uintptr_t)lds;
#define A2_ISSUE(t, s) do { const size_t kb_ = (size_t)(t) * KT * 1536; LAS char* sb_ = lds + (s) * STAGE; \
    __builtin_amdgcn_global_load_lds((const unsigned*)(KD + kb_ + ko[0]), (LAS unsigned*)(sb_ + wid * 1024), 16, 0, 0); \
    __builtin_amdgcn_global_load_lds((const unsigned*)(KD + kb_ + ko[1]), (LAS unsigned*)(sb_ + ST_K + wid * 1024), 16, 0, 0); \
    __builtin_amdgcn_global_load_lds((const unsigned*)(VD + kb_ + vo[0]), (LAS unsigned*)(sb_ + 2 * ST_K + (wid * 2) * 1024), 16, 0, 0); \
    __builtin_amdgcn_global_load_lds((const unsigned*)(VD + kb_ + vo[1]), (LAS unsigned*)(sb_ + 2 * ST_K + (wid * 2 + 1) * 1024), 16, 0, 0); } while (0)
  const int vis = 2 * (2 * b + (rg >> 1) + 1);
  float m_reg = -1e30f, l_reg = 0.f; f32x16 o[8];
#pragma unroll
  for (int d = 0; d < 8; ++d) o[d] = f32x16{};
  asm volatile("s_waitcnt vmcnt(0)" ::: "memory");
  A2_ISSUE(t_lo, 0); if (t_lo + 1 < t_hi) A2_ISSUE(t_lo + 1, 1);
  int s = 0;
  for (int t = t_lo; t < t_hi; ++t) {
    if (t + 1 < t_hi) asm volatile("s_waitcnt vmcnt(4) lgkmcnt(0)" ::: "memory"); else asm volatile("s_waitcnt vmcnt(0) lgkmcnt(0)" ::: "memory");
    __builtin_amdgcn_s_barrier(); asm volatile("" ::: "memory");
    if (t + 2 < t_hi) { const int s2 = (s >= 1) ? s - 1 : s + 2; A2_ISSUE(t + 2, s2); }
    if (t < vis) {
      const LAS char* Ks = lds + s * STAGE + m * ST_K;
      f32x16 p = f32x16{};
#pragma unroll
      for (int d0 = 0; d0 < 8; ++d0) { const int cb = (d0 * 16 + hi * 8) * 2;
        const bf16x8 b0 = *(const LAS bf16x8*)(Ks + KSWZ(r32, cb));
        p = __builtin_amdgcn_mfma_f32_32x32x16_bf16(b0, qr[d0], p, 0, 0, 0); }
      if (qrow0 - (KT * t + KT - 1) >= 91) {
#pragma unroll
        for (int r = 0; r < 16; ++r) p[r] += cfar;
      } else { const int base = qrow0 + r32 - KT * t + 63;
#pragma unroll
        for (int r = 0; r < 16; ++r) { const int i0 = base - crow(r, hi); p[r] += tab[i0 < att::TAB_N - 1 ? i0 : att::TAB_N - 1]; } }
      float pmax = p[0];
#pragma unroll
      for (int r = 1; r < 16; ++r) pmax = fmaxf(pmax, p[r]);
      { auto rr = __builtin_amdgcn_permlane32_swap(__float_as_uint(pmax), __float_as_uint(pmax), false, false); pmax = fmaxf(__uint_as_float(rr[0]), __uint_as_float(rr[1])); }
      float mn, alpha;
      if (__builtin_expect(__all(pmax - m_reg <= THR2), 1)) { mn = m_reg; alpha = 1.f; }
      else { mn = fmaxf(m_reg, pmax); alpha = __builtin_amdgcn_exp2f(m_reg - mn); m_reg = mn; }
      float ps = 0.f;
#pragma unroll
      for (int r = 0; r < 16; ++r) { p[r] = __builtin_amdgcn_exp2f(p[r] - mn); ps += p[r]; }
      { auto rr = __builtin_amdgcn_permlane32_swap(__float_as_uint(ps), __float_as_uint(ps), false, false); ps = __uint_as_float(rr[0]) + __uint_as_float(rr[1]); }
      l_reg = l_reg * alpha + ps;
      bf16x8 pa0, pa1;
#define A2_PK4(P, BASE, OUT) do { unsigned a0 = cvtpk(P[BASE + 0], P[BASE + 1]), a1 = cvtpk(P[BASE + 2], P[BASE + 3]);   \
    unsigned b0_ = cvtpk(P[BASE + 4], P[BASE + 5]), b1_ = cvtpk(P[BASE + 6], P[BASE + 7]);                              \
    auto r0 = __builtin_amdgcn_permlane32_swap(a0, b0_, false, false); auto r1 = __builtin_amdgcn_permlane32_swap(a1, b1_, false, false); \
    u32x4 w = {r0[0], r1[0], r0[1], r1[1]}; OUT = *reinterpret_cast<bf16x8*>(&w); } while (0)
      A2_PK4(p, 0, pa0); A2_PK4(p, 8, pa1);
      if (__any(alpha < 1.f)) { if (hi == 0) al_l[r32] = alpha; asm volatile("s_waitcnt lgkmcnt(0)" ::: "memory");
#pragma unroll
        for (int d = 0; d < 8; ++d)
#pragma unroll
          for (int r = 0; r < 16; ++r) o[d][r] *= al_l[crow(r, hi)]; }
      const int vb = (int)(ldsb + s * STAGE + 2 * ST_K) + v_rd_base(lane);
      asm volatile("s_waitcnt lgkmcnt(0)" ::: "memory"); SBAR();
#define A2_PK(L, H) (bf16x8){L[0], L[1], L[2], L[3], H[0], H[1], H[2], H[3]}
#define A2_RD(D0, l0, h0, l1, h1) do { l0 = tr_read<v_off(D0, 0, 0)>(vb); h0 = tr_read<v_off(D0, 0, 1)>(vb); l1 = tr_read<v_off(D0, 1, 0)>(vb); h1 = tr_read<v_off(D0, 1, 1)>(vb); } while (0)
#define A2_MM(D0, l0, h0, l1, h1) do { o[D0] = __builtin_amdgcn_mfma_f32_32x32x16_bf16(pa0, A2_PK(l0, h0), o[D0], 0, 0, 0); o[D0] = __builtin_amdgcn_mfma_f32_32x32x16_bf16(pa1, A2_PK(l1, h1), o[D0], 0, 0, 0); } while (0)
      s16x4 xl0, xh0, xl1, xh1, yl0, yh0, yl1, yh1;
      A2_RD(0, xl0, xh0, xl1, xh1);
      A2_RD(1, yl0, yh0, yl1, yh1); asm volatile("s_waitcnt lgkmcnt(4)" ::: "memory"); SBAR(); A2_MM(0, xl0, xh0, xl1, xh1); SBAR();
      A2_RD(2, xl0, xh0, xl1, xh1); asm volatile("s_waitcnt lgkmcnt(4)" ::: "memory"); SBAR(); A2_MM(1, yl0, yh0, yl1, yh1); SBAR();
      A2_RD(3, yl0, yh0, yl1, yh1); asm volatile("s_waitcnt lgkmcnt(4)" ::: "memory"); SBAR(); A2_MM(2, xl0, xh0, xl1, xh1); SBAR();
      A2_RD(4, xl0, xh0, xl1, xh1); asm volatile("s_waitcnt lgkmcnt(4)" ::: "memory"); SBAR(); A2_MM(3, yl0, yh0, yl1, yh1); SBAR();
      A2_RD(5, yl0, yh0, yl1, yh1); asm volatile("s_waitcnt lgkmcnt(4)" ::: "memory"); SBAR(); A2_MM(4, xl0, xh0, xl1, xh1); SBAR();
      A2_RD(6, xl0, xh0, xl1, xh1); asm volatile("s_waitcnt lgkmcnt(4)" ::: "memory"); SBAR(); A2_MM(5, yl0, yh0, yl1, yh1); SBAR();
      A2_RD(7, yl0, yh0, yl1, yh1); asm volatile("s_waitcnt lgkmcnt(4)" ::: "memory"); SBAR(); A2_MM(6, xl0, xh0, xl1, xh1); SBAR();
      asm volatile("s_waitcnt lgkmcnt(0)" ::: "memory"); SBAR(); A2_MM(7, yl0, yh0, yl1, yh1); SBAR();
    }
    s = (s == 2) ? 0 : s + 1;
  }
  if (hi == 0) li_l[r32] = l_reg; asm volatile("s_waitcnt lgkmcnt(0)" ::: "memory");
  float rli[16];
#pragma unroll
  for (int r = 0; r < 16; ++r) rli[r] = __builtin_amdgcn_rcpf(li_l[crow(r, hi)]);
  float* Ow = Obuf + (size_t)(qrow0 - orow0) * 3072 + (h * 2 + m) * 256;
#pragma unroll
  for (int r = 0; r < 16; ++r) { const int orow = crow(r, hi);
#pragma unroll
    for (int d0 = 0; d0 < 8; ++d0) Ow[(size_t)orow * 3072 + d0 * 32 + r32] = o[d0][r] * rli[r]; }
  if (hi == 0) { float* mlp = ML + (((size_t)(qrow0 - orow0 + r32) * 6 + h) * 2 + m) * 2; mlp[0] = m_reg; mlp[1] = l_reg; }
  asm volatile("s_waitcnt vmcnt(0) lgkmcnt(0)" ::: "memory");
  __builtin_amdgcn_s_barrier(); asm volatile("" ::: "memory");
#undef A2_ISSUE
#undef A2_PK4
#undef A2_PK
#undef A2_RD
#undef A2_MM
}
}

__device__ __forceinline__ void diffattn2_unit(Frame& F, const Args& a, unsigned code) {
    const int h = code & 7, b = (code >> 3) & 63, pc = code >> 9, nt = 4 * b + 4;
    const int t_lo = (pc == 2) ? nt / 2 : 0, t_hi = (pc == 1) ? nt / 2 : nt;
    float* ob = (float*)(F.ws + (pc == 2 ? WS_OP2 : WS_OP)); float* ml = (float*)(F.ws + WS_ML) + (pc == 2 ? (size_t)T * 6 * 2 * 2 : 0);
    att2::diff_unit((const bf16*)(F.ws + WS_Z), (const bf16*)(F.ws + WS_KD), (const bf16*)(F.ws + WS_VD), ob, pc == 2 ? 4096 : 0, ml, a.in[I_RELB], h, b, t_lo, t_hi, (LAS char*)F.lds);
}
__device__ __forceinline__ void diffcombine_phase(Frame& F, const Args& a, int l) {
    const int i = l - 2; const float* lp = a.in[I_BLAM] + (size_t)i * 4 * 128;
    float s1 = lp[F.lane] * lp[128 + F.lane] + lp[64 + F.lane] * lp[128 + 64 + F.lane], s2 = lp[256 + F.lane] * lp[384 + F.lane] + lp[256 + 64 + F.lane] * lp[384 + 64 + F.lane];
    s1 = wave_sum(s1); s2 = wave_sum(s2);
    const float lam_init = 0.8f - 0.6f * expf(-0.3f * (float)l);
    const float lam = expf(s1) - expf(s2) + lam_init;
    const float* op0 = (const float*)(F.ws + WS_OP); const float* op1 = (const float*)(F.ws + WS_OP2); const float* ml0 = (const float*)(F.ws + WS_ML); const float* ml1 = ml0 + (size_t)T * 6 * 2 * 2;
    bf16* cat = (bf16*)(F.ws + WS_CAT);
    const f32x4 gsub = *(const GAS f32x4*)(a.in[I_BSUBG] + (size_t)i * 256 + 4 * F.lane);
    const int gw = F.c * NWAVES + F.wave, NGW = F.G * NWAVES;
    for (int it = gw; it < T * 6; it += NGW) { const int tk = it / 6, h = it - tk * 6; f32x4 os[2];
#pragma unroll
        for (int m = 0; m < 2; ++m) { const size_t r0 = ((size_t)tk * 6 + h) * 2 + m; f32x4 oa = *(const GAS f32x4*)(op0 + r0 * 256 + 4 * F.lane);
            if (tk >= 4096) { const size_t r1 = ((size_t)(tk - 4096) * 6 + h) * 2 + m; const f32x4 ob = *(const GAS f32x4*)(op1 + r1 * 256 + 4 * F.lane);
                const float ma = ml0[r0 * 2], la = ml0[r0 * 2 + 1], mb = ml1[r1 * 2], lb = ml1[r1 * 2 + 1], M = fmaxf(ma, mb);
                const float wa = la * exp2f(ma - M), wb = lb * exp2f(mb - M), inv = 1.f / (wa + wb); oa = oa * (wa * inv) + ob * (wb * inv); }
            os[m] = oa; }
        const f32x4 o = os[0] - os[1] * lam; const float ss = wave_sum((o.x * o.x + o.y * o.y) + (o.z * o.z + o.w * o.w));
        const float r = (1.f - lam_init) / sqrtf(ss * (1.f / 256.f) + LN_EPS);
        v2u w; w.x = pk2(o.x * r * gsub.x, o.y * r * gsub.y); w.y = pk2(o.z * r * gsub.z, o.w * r * gsub.w);
        *(GAS v2u*)(cat + (size_t)tk * D + h * 256 + 4 * F.lane) = w; }
}


__device__ __forceinline__ void ln1_router_phase(Frame& F, const Args& a, int l, int probe = 0) {
    const bf16* y = (const bf16*)(F.ws + WS_Y); bf16* x1b = (bf16*)(F.ws + WS_X1B);
    const float* lng = a.in[I_LNG] + ((size_t)l * 2 + 0) * D; const float* lnb = a.in[I_LNB] + ((size_t)l * 2 + 0) * D;
    const float* wr = (const float*)(F.ws + WS_WR) + (size_t)l * 3 * 512 * 16 * 4;
    int* tok_e = (int*)(F.ws + (probe ? WS_OP : WS_ROUTE)); int* tok_rank = tok_e + 2 * T; float* tok_gate = (float*)(tok_rank + 2 * T);
    gu32* cnt = F.ctl + (probe ? 65536 : CW_CNT) + 2048 * l;
    LAS float* P = (LAS float*)(F.lds);
    typedef float f32x4v __attribute__((ext_vector_type(4)));
    for (int tb = F.c; tb < T / 32; tb += F.G) {
#pragma unroll 2
        for (int i = 0; i < 4; ++i) { const int tk = tb * 32 + F.wave * 4 + i;
            const GAS v4u* yr = (const GAS v4u*)(y + (size_t)tk * D) + F.lane;
            float v[4][8]; float s = 0.f;
#pragma unroll
            for (int j = 0; j < 4; ++j) { const v4u w = yr[64 * j]; v[j][0] = bflo(w.x); v[j][1] = bfhi(w.x); v[j][2] = bflo(w.y); v[j][3] = bfhi(w.y); v[j][4] = bflo(w.z); v[j][5] = bfhi(w.z); v[j][6] = bflo(w.w); v[j][7] = bfhi(w.w);
#pragma unroll
                for (int e = 0; e < 8; ++e) s += v[j][e]; }
            const float mean = wave_sum(s) * (1.f / D); float s2 = 0.f;
#pragma unroll
            for (int j = 0; j < 4; ++j)
#pragma unroll
                for (int e = 0; e < 8; ++e) { v[j][e] -= mean; s2 += v[j][e] * v[j][e]; }
            const float rstd = 1.f / sqrtf(wave_sum(s2) * (1.f / D) + LN_EPS);
#pragma unroll
            for (int j = 0; j < 4; ++j) { const int d0 = 8 * F.lane + 512 * j; const f32x4 g0 = *(const GAS f32x4*)(lng + d0), g1 = *(const GAS f32x4*)(lng + d0 + 4), b0 = *(const GAS f32x4*)(lnb + d0), b1 = *(const GAS f32x4*)(lnb + d0 + 4);
                const float q0 = v[j][0] * rstd * g0.x + b0.x, q1 = v[j][1] * rstd * g0.y + b0.y, q2 = v[j][2] * rstd * g0.z + b0.z, q3 = v[j][3] * rstd * g0.w + b0.w;
                const float q4 = v[j][4] * rstd * g1.x + b1.x, q5 = v[j][5] * rstd * g1.y + b1.y, q6 = v[j][6] * rstd * g1.z + b1.z, q7 = v[j][7] * rstd * g1.w + b1.w;
                v4u w; w.x = pk2(q0, q1); w.y = pk2(q2, q3); w.z = pk2(q4, q5); w.w = pk2(q6, q7);
                *(GAS v4u*)(x1b + (size_t)tk * D + d0) = w;
                unsigned lo = 0u, hi = 0u; lo = __builtin_amdgcn_cvt_pk_fp8_f32(q0, q1, lo, false); lo = __builtin_amdgcn_cvt_pk_fp8_f32(q2, q3, lo, true);
                hi = __builtin_amdgcn_cvt_pk_fp8_f32(q4, q5, hi, false); hi = __builtin_amdgcn_cvt_pk_fp8_f32(q6, q7, hi, true);
                v2u qq; qq.x = lo; qq.y = hi; *(GAS v2u*)((unsigned char*)(F.ws + WS_X1F) + (size_t)tk * D + d0) = qq; } }
        VM_WAIT(); __syncthreads();
        { const int mt = F.wave >> 2, kq = F.wave & 3, c = F.lane & 15, q = F.lane >> 4;
          const bf16* ap = x1b + (size_t)(tb * 32 + mt * 16 + c) * D + kq * 512 + 4 * q;
          const float* bp = wr + ((size_t)(kq * 128 + q) * 16 + c) * 4;
          f32x4v acc[3] = {{0.f, 0.f, 0.f, 0.f}, {0.f, 0.f, 0.f, 0.f}, {0.f, 0.f, 0.f, 0.f}};
#pragma unroll 4
          for (int ks = 0; ks < 32; ++ks) { const v2u aw = *(const GAS v2u*)(ap + 16 * ks); const f32x4 a4 = (f32x4){bflo(aw.x), bfhi(aw.x), bflo(aw.y), bfhi(aw.y)}; f32x4 b4[3];
#pragma unroll
              for (int nb = 0; nb < 3; ++nb) b4[nb] = *(const GAS f32x4*)(bp + ((size_t)nb * 512 + 4 * ks) * 64);
#pragma unroll
              for (int j = 0; j < 4; ++j)
#pragma unroll
                  for (int nb = 0; nb < 3; ++nb) acc[nb] = __builtin_amdgcn_mfma_f32_16x16x4f32(a4[j], b4[nb][j], acc[nb], 0, 0, 0); }
#pragma unroll
          for (int nb = 0; nb < 3; ++nb)
#pragma unroll
              for (int r = 0; r < 4; ++r) P[((kq * 2 + mt) * 16 + 4 * q + r) * 48 + nb * 16 + c] = acc[nb][r]; }
        __syncthreads();
        if (F.tid < 32) { const int tk = tb * 32 + F.tid, mt = F.tid >> 4, ti = F.tid & 15;
            const LAS f32x4* P4 = (const LAS f32x4*)P;
            const int rb = (mt * 16 + ti) * 12;
            const float* bg1 = a.in[I_BG1] + l * 4; const float* bg2 = a.in[I_BG2] + l * 32;
            const f32x4 s1 = (P4[rb] + P4[rb + 384]) + (P4[rb + 768] + P4[rb + 1152]);
            const float l10 = s1.x + bg1[0], l11 = s1.y + bg1[1], l12 = s1.z + bg1[2], l13 = s1.w + bg1[3];
            int grp = 0; float mx = l10;
            if (l11 > mx) { mx = l11; grp = 1; } if (l12 > mx) { mx = l12; grp = 2; } if (l13 > mx) { mx = l13; grp = 3; }
            const float psel = 1.f / (expf(l10 - mx) + expf(l11 - mx) + expf(l12 - mx) + expf(l13 - mx));
            const int ob = rb + 1 + 2 * grp;
            const f32x4 sa = (P4[ob] + P4[ob + 384]) + (P4[ob + 768] + P4[ob + 1152]), sb = (P4[ob + 1] + P4[ob + 385]) + (P4[ob + 769] + P4[ob + 1153]);
            const f32x4 ba = *(const GAS f32x4*)(bg2 + grp * 8), bb = *(const GAS f32x4*)(bg2 + grp * 8 + 4);
            const float l2[8] = {sa.x + ba.x, sa.y + ba.y, sa.z + ba.z, sa.w + ba.w, sb.x + bb.x, sb.y + bb.y, sb.z + bb.z, sb.w + bb.w};
            int i0 = 0; float v0 = l2[0];
#pragma unroll
            for (int e = 1; e < 8; ++e) if (l2[e] > v0) { v0 = l2[e]; i0 = e; }
            int i1 = -1; float v1 = -INFINITY;
#pragma unroll
            for (int e = 0; e < 8; ++e) if (e != i0 && l2[e] > v1) { v1 = l2[e]; i1 = e; }
            const float e1 = expf(v1 - v0), g0 = psel / (1.f + e1), g1 = psel * e1 / (1.f + e1);
            const int ex0 = grp * 8 + i0, ex1 = grp * 8 + i1;
            const unsigned r0 = __hip_atomic_fetch_add(cnt + 64 * ex0, 1u, RLX_AGENT), r1 = __hip_atomic_fetch_add(cnt + 64 * ex1, 1u, RLX_AGENT);
            { int* list = (int*)(F.ws + (probe ? WS_OP + 2 * MiB : WS_LIST)); list[ex0 * 8192 + (int)r0] = tk; list[ex1 * 8192 + (int)r1] = tk; }
            tok_e[2 * tk] = ex0; tok_e[2 * tk + 1] = ex1; tok_rank[2 * tk] = (int)r0; tok_rank[2 * tk + 1] = (int)r1; tok_gate[2 * tk] = g0; tok_gate[2 * tk + 1] = g1; }
        __syncthreads();
    }
}
__device__ __forceinline__ void moe_table(Frame& F, int l) {
    LAS int* tstart = (LAS int*)(F.lds + TAB_OFF);
    if (F.tid == 0) { int acc = 0;
        for (int e = 0; e < 32; ++e) { tstart[e] = acc; const unsigned c = __hip_atomic_load(F.ctl + CW_CNT + 2048 * l + 64 * e, RLX_AGENT); tstart[36 + e] = (int)c; acc += (int)((c + 255u) >> 8); }
        tstart[32] = acc; }
    __syncthreads();
}
__device__ __forceinline__ void ln2_phase(Frame& F, const Args& a, int l) {
    const bf16* x1b = (const bf16*)(F.ws + WS_X1B); const bf16* yb = (const bf16*)(F.ws + WS_YB); bf16* xb = (bf16*)(F.ws + WS_XB);
    const float* lng = a.in[I_LNG] + ((size_t)l * 2 + 1) * D; const float* lnb = a.in[I_LNB] + ((size_t)l * 2 + 1) * D;
    moe_table(F, l); const LAS int* tstart = (const LAS int*)(F.lds + TAB_OFF);
    const int* tok_e = (const int*)(F.ws + WS_ROUTE); const int* tok_rank = tok_e + 2 * T; const float* tok_gate = (const float*)(F.ws + WS_ROUTE) + 4 * T;
    const int gw = F.c * NWAVES + F.wave, NGW = F.G * NWAVES;
    for (int t4 = gw; t4 < T / 4; t4 += NGW) { const int tk0 = t4 * 4;
        int ev = 0, rv = 0; float gv = 0.f;
        if (F.lane < 8) { ev = tok_e[2 * tk0 + F.lane]; rv = tok_rank[2 * tk0 + F.lane]; gv = tok_gate[2 * tk0 + F.lane]; }
        const int slotv = (F.lane < 8) ? tstart[ev] * 256 + rv : 0;
        v4u xr[2], ya[2], yc[2]; v4u xr2[2], ya2[2], yc2[2];
#define LN2_LOAD(i, XR, YA, YC, XR2, YA2, YC2) do { const int s0_ = __builtin_amdgcn_readlane(slotv, 2 * (i)), s1_ = __builtin_amdgcn_readlane(slotv, 2 * (i) + 1); \
        _Pragma("unroll") for (int j = 0; j < 2; ++j) { const int d0 = 8 * F.lane + 512 * j; XR[j] = *(const GAS v4u*)(x1b + (size_t)(tk0 + (i)) * D + d0); YA[j] = *(const GAS v4u*)(yb + (size_t)s0_ * D + d0); YC[j] = *(const GAS v4u*)(yb + (size_t)s1_ * D + d0); } \
        _Pragma("unroll") for (int j = 0; j < 2; ++j) { const int d0 = 8 * F.lane + 512 * (j + 2); XR2[j] = *(const GAS v4u*)(x1b + (size_t)(tk0 + (i)) * D + d0); YA2[j] = *(const GAS v4u*)(yb + (size_t)s0_ * D + d0); YC2[j] = *(const GAS v4u*)(yb + (size_t)s1_ * D + d0); } } while (0)
        LN2_LOAD(0, xr, ya, yc, xr2, ya2, yc2);
#pragma unroll
        for (int i = 0; i < 4; ++i) { const int tk = tk0 + i;
            const float g0 = __builtin_bit_cast(float, __builtin_amdgcn_readlane(__builtin_bit_cast(int, gv), 2 * i)), g1 = __builtin_bit_cast(float, __builtin_amdgcn_readlane(__builtin_bit_cast(int, gv), 2 * i + 1));
            float v[4][8]; float s = 0.f;
#pragma unroll
            for (int j = 0; j < 4; ++j) { const v4u X = j < 2 ? xr[j] : xr2[j - 2], A = j < 2 ? ya[j] : ya2[j - 2], C = j < 2 ? yc[j] : yc2[j - 2];
                v[j][0] = bflo(X.x) * DN_ALPHA + (g0 * bflo(A.x) + g1 * bflo(C.x)); v[j][1] = bfhi(X.x) * DN_ALPHA + (g0 * bfhi(A.x) + g1 * bfhi(C.x));
                v[j][2] = bflo(X.y) * DN_ALPHA + (g0 * bflo(A.y) + g1 * bflo(C.y)); v[j][3] = bfhi(X.y) * DN_ALPHA + (g0 * bfhi(A.y) + g1 * bfhi(C.y));
                v[j][4] = bflo(X.z) * DN_ALPHA + (g0 * bflo(A.z) + g1 * bflo(C.z)); v[j][5] = bfhi(X.z) * DN_ALPHA + (g0 * bfhi(A.z) + g1 * bfhi(C.z));
                v[j][6] = bflo(X.w) * DN_ALPHA + (g0 * bflo(A.w) + g1 * bflo(C.w)); v[j][7] = bfhi(X.w) * DN_ALPHA + (g0 * bfhi(A.w) + g1 * bfhi(C.w));
#pragma unroll
                for (int e = 0; e < 8; ++e) s += v[j][e]; }
            if (i + 1 < 4) LN2_LOAD(i + 1, xr, ya, yc, xr2, ya2, yc2);
            const float mean = wave_sum(s) * (1.f / D); float s2 = 0.f;
#pragma unroll
            for (int j = 0; j < 4; ++j)
#pragma unroll
                for (int e = 0; e < 8; ++e) { v[j][e] -= mean; s2 += v[j][e] * v[j][e]; }
            const float rstd = 1.f / sqrtf(wave_sum(s2) * (1.f / D) + LN_EPS);
#pragma unroll
            for (int j = 0; j < 4; ++j) { const int d0 = 8 * F.lane + 512 * j; const f32x4 g0v = *(const GAS f32x4*)(lng + d0), g1v = *(const GAS f32x4*)(lng + d0 + 4), b0 = *(const GAS f32x4*)(lnb + d0), b1 = *(const GAS f32x4*)(lnb + d0 + 4);
                const f32x4 oa = (f32x4){v[j][0] * rstd * g0v.x + b0.x, v[j][1] * rstd * g0v.y + b0.y, v[j][2] * rstd * g0v.z + b0.z, v[j][3] * rstd * g0v.w + b0.w};
                const f32x4 ob = (f32x4){v[j][4] * rstd * g1v.x + b1.x, v[j][5] * rstd * g1v.y + b1.y, v[j][6] * rstd * g1v.z + b1.z, v[j][7] * rstd * g1v.w + b1.w};
                if (l == DEPTH - 1) { *(GAS f32x4*)(a.out + (size_t)tk * D + d0) = oa; *(GAS f32x4*)(a.out + (size_t)tk * D + d0 + 4) = ob; }
                else { v4u w; w.x = pk2(oa.x, oa.y); w.y = pk2(oa.z, oa.w); w.z = pk2(ob.x, ob.y); w.w = pk2(ob.z, ob.w); *(GAS v4u*)(xb + (size_t)tk * D + d0) = w; } }
        }
#undef LN2_LOAD
    }
}

__global__ void __launch_bounds__(NWAVES * 64, 2) fwd_kernel(Args args) {
    extern __shared__ __attribute__((aligned(16))) unsigned char lds[];
    Frame F;
    F.lds = (LAS unsigned char*)lds; F.ldsg = (char*)lds;
    F.tid = threadIdx.x; F.lane = F.tid & 63; F.wave = __builtin_amdgcn_readfirstlane(F.tid >> 6);
    F.G = gridDim.x; F.c = blockIdx.x; F.ws = args.ws; F.ctl = (gu32*)(args.ws + WS_CTL);
    volatile LAS unsigned* MISC = (volatile LAS unsigned*)(F.lds + MISC_OFF);
    for (int u = F.tid; u < (LDS_BYTES - LDSCTL_OFF) / 4; u += NWAVES * 64) ((LAS unsigned*)(F.lds + LDSCTL_OFF))[u] = 0u;
    __syncthreads();
    const int lo = args.ph_lo, hi = args.ph_hi; int lastp = -1;
    const bool multi = (hi - lo) > 1;
    XcdBarrier bar; bar.bar = (unsigned*)(F.ctl + CW_BAR); bar.x = 0; bar.st = nullptr;
    if (multi) bar = xcd_barrier_post((unsigned*)(F.ctl + CW_BAR), MISC + 8);
#ifndef REP_MASK
#define REP_MASK 0
#endif
#define REP(k) for (int rep_ = 0; rep_ <= ((REP_MASK >> (k)) & 1); ++rep_)
#define IN(p) (lo <= (p) && (p) < hi)
#ifdef PROBE_A
#define STAMP(i) do { if (blockIdx.x == 0 && threadIdx.x == 0) ((unsigned long long*)(args.ws + WS_TS))[(i)] = __builtin_amdgcn_s_memrealtime(); } while (0)
#else
#define STAMP(i) do { } while (0)
#endif
#define SEAM(p) do { conv_note_fin(F, (p)); lastp = (p); if ((p) + 1 < hi) xcd_barrier(bar); STAMP((p) + 1); } while (0)
#define CONVFIN() ((lastp >= 0) ? (int)__hip_atomic_load(F.ctl + CW_FIN + 64 * lastp, RLX_AGENT) : 0)
#define FRESH() do { int t_ = threadIdx.x; asm volatile("" : "+v"(t_)); F.tid = t_; F.lane = t_ & 63; F.wave = __builtin_amdgcn_readfirstlane(t_ >> 6); \
    GAS unsigned char* w_ = (GAS unsigned char*)args.ws; asm volatile("" : "+s"(w_)); F.ws = (unsigned char*)w_; F.ctl = (gu32*)(w_ + WS_CTL); } while (0)

    STAMP(0);
    if (IN(0)) { FRESH(); REP(9) prologue_phase(F, args); SEAM(0); }
#ifdef XBAR
    for (int xb_ = 0; xb_ < XBAR; ++xb_) xcd_barrier(bar);
#endif

    for (int l = 0; l < DEPTH; ++l) {
        const int pb = 1 + NPH_LAYER * l;
        if (IN(pb + 0)) { FRESH();
            const int N = (l < 2) ? NINA : (l == 2 ? 5120 : 2048);
            const unsigned char* Bt = F.ws + ((l < 2) ? WS_WAIN + (size_t)l * NINA * D * 2 : (l == 2 ? WS_WBIN0 : WS_WBIN1));
            const int nu = (T / 256) * (N / 256) + (l == 0 ? 16 : 0), ncv = conv_servers(nu, F.G, CONVFIN()), Gc = F.G - ncv;
            if (F.c < Gc) {
                pg8::Gemm g{nullptr, nullptr, T, N, D}; pg8::DualOrder S; S.init(F.ws + WS_XB, Bt, T, N, D, Gc, F.c, F.ws + WS_MEMB, F.ws + WS_WMKV, l == 0 ? 16 : 0);
                pg8::EpiBf16X E{l < 2 ? 0 : 1, (bf16*)(F.ws + WS_Z), (bf16*)(F.ws + WS_KD), (bf16*)(F.ws + WS_VD), (bf16*)(F.ws + WS_MEMKV), nullptr, nullptr};
                REP(0) pg8::gemm_phase<pg8::EpiBf16X, pg8::DualOrder, true, true>(F.lds + RING_OFF, g, S, E);
                if (ncv) conv_done(F, pb + 0);
                { const int mine = (nu - 1 - F.c) / Gc + 1, rounds = (nu + Gc - 1) / Gc; conv_filler(F, args, 2 * l, (rounds - mine) * QA); }
            } else conv_server(F, args, pb + 0, 2 * l, Gc);
            SEAM(pb + 0);
        }
        if (IN(pb + 1)) { FRESH();
            if (l < 2) {
                REP(1) for (int u = F.c; u < 256 + 128; u += F.G) {
                    if (u < 256) sgu_unit(F, args, l, u >> 2, u & 3);
                    else { const int r = u - 256; memattn_unit(F, l, r & 3, r >> 2, NINA, 2 * MIXW); }
                }
                if (F.c >= 128) conv_filler(F, args, 2 * l, QX);
            } else {
                const int ncv = CONVFIN() ? 0 : NCVATT;
                if (F.c >= F.G - ncv) { conv_server(F, args, pb + 1, 2 * l, 1); __syncthreads(); }
                REP(2) { gu32* qh = F.ctl + CW_Q + 64 * l + 16 * rep_; LAS unsigned* uw = (LAS unsigned*)(F.lds + att2::LDS_UNIT);
                for (;;) {
                    if (F.tid == 0) *uw = __hip_atomic_fetch_add(qh, 1u, RLX_AGENT);
                    __syncthreads();
                    const unsigned idx = *uw;
                    __syncthreads();
                    if (idx >= (unsigned)(att2::NUNITS + 128)) break;
                    if (idx < (unsigned)att2::NUNITS) diffattn2_unit(F, args, att2::g_units.u[idx]);
                    else { const int r = (int)idx - att2::NUNITS; memattn_unit(F, l, r & 3, r >> 2, 2048, MIXW); }
                } }
                if (ncv) conv_done(F, pb + 1);
            }
            SEAM(pb + 1);
        }
        if (IN(pb + 2) && l >= 2) { FRESH(); REP(3) diffcombine_phase(F, args, l); SEAM(pb + 2); }
        if (IN(pb + 3)) { FRESH();
            pg8::Gemm g{nullptr, nullptr, T, D, D}; pg8::DenseOrder S; S.init(F.ws + WS_CAT, F.ws + (l < 2 ? WS_WAOUT + (size_t)l * D * D * 2 : WS_WBOUT + (size_t)(l - 2) * D * D * 2), T, D, D, F.G, F.c);
            pg8::EpiResBf16 E{(const bf16*)(F.ws + WS_XB), (bf16*)(F.ws + WS_Y), DN_ALPHA};
            REP(4) pg8::gemm_phase<pg8::EpiResBf16, pg8::DenseOrder, true, true>(F.lds + RING_OFF, g, S, E);
            SEAM(pb + 3);
        }
        if (IN(pb + 4)) { FRESH(); ln1_router_phase(F, args, l);
#ifdef REP_LN1
            ln1_router_phase(F, args, l, 1);
#endif
            conv_filler(F, args, 2 * l, -1); SEAM(pb + 4); }
        if (IN(pb + 6)) { FRESH();
            moe_table(F, l);
            const LAS int* tb = (const LAS int*)(F.lds + TAB_OFF);
            const int nu = tb[32] * 4, ncv = conv_servers(nu, F.G, CONVFIN()), Gc = F.G - ncv;
            if (F.c < Gc) {
                pg8::Gemm g{nullptr, nullptr, SLOTS, 1024, D / 2};
                pg8::MoeGatherOrder S{tb, tb + 36, (const int*)(F.ws + WS_LIST), 4, Gc, F.c, (const char*)(F.ws + WS_X1F), (const char*)(F.ws + WS_W13) + (size_t)l * NE * 1024 * 2048, (size_t)1024 * 2048, (size_t)256 * 2048, (unsigned)D};
                pg8::EpiMoe1 E{(bf16*)(F.ws + WS_H), tb, tb + 36};
                REP(6) pg8::gemm_phase<pg8::EpiMoe1, pg8::MoeGatherOrder, true, true>(F.lds + RING_OFF, g, S, E);
                if (ncv) conv_done(F, pb + 6);
                { const int mine = (F.c < nu) ? (nu - 1 - F.c) / Gc + 1 : 0, rounds = (nu + Gc - 1) / Gc; conv_filler(F, args, 2 * l + 1, (rounds - mine) * QM); }
            } else conv_server(F, args, pb + 6, 2 * l + 1, Gc);
            SEAM(pb + 6);
        }
        if (IN(pb + 7)) { FRESH();
            moe_table(F, l);
            const int nu = ((const LAS int*)(F.lds + TAB_OFF))[32] * 8, ncv = conv_servers(nu, F.G, CONVFIN()), Gc = F.G - ncv;
            if (F.c < Gc) {
                pg8::Gemm g{nullptr, nullptr, SLOTS, D, FF / 2};
                pg8::MoeOrder8 S{(const PG8_LAS int*)(F.lds + TAB_OFF), 8, Gc, F.c, (const char*)(F.ws + WS_H), (const char*)(F.ws + WS_W2) + (size_t)l * NE * 2048 * 512, (size_t)256 * FF, (size_t)2048 * 512, (size_t)256 * 512};
                pg8::EpiBf16X E{3, (bf16*)(F.ws + WS_YB), nullptr, nullptr, nullptr, (const PG8_LAS int*)(F.lds + TAB_OFF), (const PG8_LAS int*)(F.lds + TAB_OFF) + 36};
                REP(7) pg8::gemm_phase<pg8::EpiBf16X, pg8::MoeOrder8, true, true>(F.lds + RING_OFF, g, S, E);
                if (ncv) conv_done(F, pb + 7);
                { const int mine = (F.c < nu) ? (nu - 1 - F.c) / Gc + 1 : 0, rounds = (nu + Gc - 1) / Gc; conv_filler(F, args, 2 * l + 1, (rounds - mine) * QB); }
            } else conv_server(F, args, pb + 7, 2 * l + 1, Gc);
            SEAM(pb + 7);
        }
        if (IN(pb + 8)) { FRESH(); REP(8) ln2_phase(F, args, l); conv_filler(F, args, 2 * l + 1, -1); SEAM(pb + 8); }
    }
#ifdef PROBE_A
    {
        VM_WAIT(); xcd_barrier(bar);
        const unsigned long long* ts = (const unsigned long long*)(args.ws + WS_TS);
        float da = 0.f, db = 0.f;
        for (int p = 0; p < NPHASES; ++p) { const int k = (p == 0) ? 9 : (p - 1) % NPH_LAYER; const float d = (float)(ts[p + 1] - ts[p]);
            if (k == PROBE_A || PROBE_A == 10) da += d; if (k == PROBE_B || PROBE_B == 10) db += d; }
        const float kk = sqrtf(da), vv = db;
        float* o = args.out; const long n = (long)T * D;
        for (long i = (long)blockIdx.x * 512 + threadIdx.x; i < n; i += (long)gridDim.x * 512) o[i] = (i == 0) ? vv : kk;
    }
#endif
#undef IN
#undef SEAM
}

#ifndef MK_ONE_LAUNCH
#define MK_ONE_LAUNCH 1
#endif
extern "C" void kernel_launch(void* const* d_in, const int* in_sizes, int n_in, void* d_out, int out_size, void* d_ws, size_t ws_size, hipStream_t stream) {
    static int grid = 0;
    if (grid == 0) {
        if (n_in != 24 || in_sizes[0] != T * D || out_size != T * D || ws_size < WS_END) { fprintf(stderr, "kernel_launch: unexpected shapes (n_in %d, in0 %d, out %d, ws %zu < %zu)\n", n_in, n_in > 0 ? in_sizes[0] : -1, out_size, ws_size, (size_t)WS_END); grid = -1; return; }
        int dev = 0, cus = 0, per_cu = 0;
        if (hipGetDevice(&dev) != hipSuccess || hipDeviceGetAttribute(&cus, hipDeviceAttributeMultiprocessorCount, dev) != hipSuccess) { grid = -1; return; }
        if (hipFuncSetAttribute((const void*)fwd_kernel, hipFuncAttributeMaxDynamicSharedMemorySize, LDS_BYTES) != hipSuccess) { fprintf(stderr, "kernel_launch: hipFuncSetAttribute failed\n"); grid = -1; return; }
        if (hipOccupancyMaxActiveBlocksPerMultiprocessor(&per_cu, (const void*)fwd_kernel, NWAVES * 64, LDS_BYTES) != hipSuccess || per_cu < 1) fprintf(stderr, "kernel_launch: occupancy query reports %d\n", per_cu);
        (void)hipGetLastError();
        grid = cus;
    }
    if (grid < 0) return;
    if (hipMemsetAsync((char*)d_ws + WS_CTL, 0, CTL_ZERO_BYTES, stream) != hipSuccess) return;
    Args a{};
    for (int i = 0; i < 24; ++i) a.in[i] = (const float*)d_in[i];
    a.out = (float*)d_out; a.ws = (unsigned char*)d_ws;
#if MK_ONE_LAUNCH
    a.ph_lo = 0; a.ph_hi = NPHASES;
    hipLaunchKernelGGL(fwd_kernel, dim3(grid), dim3(NWAVES * 64), LDS_BYTES, stream, a);
#else
    for (int p = 0; p < NPHASES; ++p) {
        const int k = (p - 1) % NPH_LAYER, l = (p - 1) / NPH_LAYER;
        if (p > 0 && k == 2 && l < 2) continue;
        a.ph_lo = p; a.ph_hi = p + 1;
        hipLaunchKernelGGL(fwd_kernel, dim3(grid), dim3(NWAVES * 64), LDS_BYTES, stream, a);
    }
#endif
    const hipError_t le = hipPeekAtLastError();
    if (le != hipSuccess) fprintf(stderr, "kernel_launch: launch failed: %s\n", hipGetErrorName(le));
}
```

```cpp
#define NCVMAX 0
#define NCVATT 96
#define CDEPTH 3
#include <hip/hip_runtime.h>
#include <cstdio>
#include <cstdint>
namespace pg8 {
#define PG8_LAS __attribute__((address_space(3)))
typedef unsigned short bf16_t;
typedef short bf16x8 __attribute__((ext_vector_type(8)));
typedef float f32x4 __attribute__((ext_vector_type(4)));
typedef unsigned u32x4 __attribute__((ext_vector_type(4)));
constexpr int BM = 256, BK = 64, HALF = 128, HTB = HALF * BK * 2  , STAGE_BYTES = 8 * HTB, NXCD = 8, WGM = 8;

__host__ __device__ __forceinline__ int lds_byte(int r, int c) { const int st = (r >> 4) * 2 + (c >> 5), rr = r & 15, cc = c & 31, ob = rr * 64 + cc * 2; return st * 1024 + (ob ^ (((ob >> 9) & 1) << 5)); }
__host__ __device__ __forceinline__ void stage_rc(int b, int& R, int& C) { const int st = b / 1024, sb = b % 1024, swz = sb ^ (((sb >> 9) & 1) << 5); R = (st >> 1) * 16 + swz / 64; C = (st & 1) * 32 + (swz % 64) / 2; }
__host__ __device__ __forceinline__ int perm32(int rho) { const int n = rho >> 4, i = rho & 15; return 8 * (i >> 2) + 4 * n + (i & 3); }

typedef int pg8_v4i __attribute__((ext_vector_type(4))); typedef int pg8_v8i __attribute__((ext_vector_type(8)));
__device__ __forceinline__ pg8_v8i pg8_cat8(bf16x8 a, bf16x8 b) { return __builtin_shufflevector(__builtin_bit_cast(pg8_v4i, a), __builtin_bit_cast(pg8_v4i, b), 0, 1, 2, 3, 4, 5, 6, 7); }
struct Unit { int pm, pn, e; };
struct Gemm { const bf16_t* A; const bf16_t* Bt; int M, N, K; };

struct StaticOrder {
    static constexpr bool GATHER = false, F8 = false; static constexpr int SCALE_B = 127;
    int nM, nN, nwg, G, c;
    __host__ __device__ void init(int M, int N, int G_, int c_) { nM = M / BM; nN = N / BM; nwg = nM * nN; G = G_; c = c_; }
    __host__ __device__ bool next(int i, Unit& u) const {
        const long L = (long)i * G + c; if (L >= nwg) return false;
        int wgid = (int)L; { const int q = nwg / NXCD, r = nwg % NXCD, xcd = wgid % NXCD, off = wgid / NXCD; wgid = (xcd < r ? xcd * (q + 1) : r * (q + 1) + (xcd - r) * q) + off; }
        const int nig = WGM * nN, gid = wgid / nig, fm = gid * WGM, gsz = (nM - fm) < WGM ? (nM - fm) : WGM;
        u.pm = fm + ((wgid % nig) % gsz); u.pn = (wgid % nig) / gsz; return true;
    }
    __device__ __forceinline__ void a_ready(const Unit&) const {}
    __device__ __forceinline__ void done(const Unit&) const {}
};

__device__ __forceinline__ unsigned cvt_pk_bf16(float lo, float hi) { unsigned r; asm volatile("v_cvt_pk_bf16_f32 %0, %1, %2" : "=v"(r) : "v"(lo), "v"(hi)); return r; }
typedef float f32x2 __attribute__((ext_vector_type(2)));
__device__ __forceinline__ f32x2 gelu_pk(f32x2 v) {
    const f32x2 av = __builtin_elementwise_abs(v), d = av * 0.2316418882f + 1.0f;
    f32x2 t; t.x = __builtin_amdgcn_rcpf(d.x); t.y = __builtin_amdgcn_rcpf(d.y);
    f32x2 q = t * 0.5307027145f + (-0.7265760135f); q = q * t + 0.7107068705f; q = q * t + (-0.142248368f); q = q * t + 0.127414796f; q = q * t;
    const f32x2 s = (v * v) * (-0.72134752044f);
    f32x2 e; e.x = __builtin_amdgcn_exp2f(s.x); e.y = __builtin_amdgcn_exp2f(s.y);
    const f32x2 m = v * (q * e), r = v - m;
    f32x2 o; o.x = v.x < 0.f ? m.x : r.x; o.y = v.y < 0.f ? m.y : r.y; return o;
}

template <class Epi, class Sched, bool ALIGN_EPI = false, bool SP2 = false>
__device__ __forceinline__ void gemm_phase(PG8_LAS unsigned char* lds, const Gemm g, const Sched& S, const Epi& E) {
    int tid_ = threadIdx.x; asm volatile("" : "+v"(tid_));
    const int tid = tid_, wid = __builtin_amdgcn_readfirstlane(tid >> 6), lane = tid & 63, wr = wid >> 2, wc = wid & 3, fr = lane & 15, fq = lane >> 4;
    const int K = g.K, nt = K / BK;
    unsigned voffA[2], voffB[2];
#pragma unroll
    for (int i = 0; i < 2; ++i) { int R, C; stage_rc(tid * 16 + i * 8192, R, C); const int Rb = Epi::PERM ? ((R & ~31) + perm32(R & 31)) : R;
        voffA[i] = (unsigned)(R * K + C) * 2u; voffB[i] = (unsigned)(Rb * K + C) * 2u; }
    unsigned vAc[2][2], vAn[2][2];
    int gR[2], gC[2];
#pragma unroll
    for (int i = 0; i < 2; ++i) { stage_rc(tid * 16 + i * 8192, gR[i], gC[i]); }
    const size_t kstep = (size_t)(BK * 2);
    const size_t hstep = (size_t)HALF * K * 2;
        const unsigned ldsw = (unsigned)wid * 1024u;
    const int aoff = lds_byte(wr * 64 + fr, fq * 8), boff = lds_byte(wc * 32 + fr, fq * 8);
#define PG8_SA(b, h) (((b) * 2 + (h)) * HTB)
#define PG8_SB(b, h) ((4 + (b) * 2 + (h)) * HTB)
#define PG8_STAGE(bufoff, gbase, voff) do { _Pragma("unroll") for (int _i = 0; _i < 2; ++_i) \
        __builtin_amdgcn_global_load_lds((const unsigned*)((const char*)(gbase) + (voff)[_i]), (PG8_LAS unsigned*)(lds + (bufoff) + ldsw + _i * 8192), 16, 0, 0); } while (0)
#define PG8_STAGE_A(b, h, base, VS) do { if constexpr (Sched::GATHER) { PG8_STAGE(PG8_SA(b, h), base, VS[h]); } else { PG8_STAGE(PG8_SA(b, h), (base) + (h) * hstep, voffA); } } while (0)
#define PG8_STAGE_AN(b, h, base) do { if constexpr (Sched::GATHER) { unsigned vs_[2] = {last ? vAn[h][0] : vAc[h][0], last ? vAn[h][1] : vAc[h][1]}; PG8_STAGE(PG8_SA(b, h), base, vs_); } else { PG8_STAGE(PG8_SA(b, h), (base) + (h) * hstep, voffA); } } while (0)
#define PG8_LDA(dst, b, h) do { if constexpr (Sched::F8) { _Pragma("unroll") for (int m = 0; m < 4; ++m) { dst##8[m].lo = *(const PG8_LAS pg8_v4i*)(lds + PG8_SA(b, h) + aoff + m * 2048); dst##8[m].hi = *(const PG8_LAS pg8_v4i*)(lds + PG8_SA(b, h) + aoff + m * 2048 + 1024); } } \
        else { _Pragma("unroll") for (int m = 0; m < 4; ++m) _Pragma("unroll") for (int k = 0; k < 2; ++k) dst[m][k] = *(const PG8_LAS bf16x8*)(lds + PG8_SA(b, h) + aoff + m * 2048 + k * 1024); } } while (0)
#define PG8_LDB(dst, b, h) do { if constexpr (Sched::F8) { _Pragma("unroll") for (int n = 0; n < 2; ++n) { dst##8[n].lo = *(const PG8_LAS pg8_v4i*)(lds + PG8_SB(b, h) + boff + n * 2048); dst##8[n].hi = *(const PG8_LAS pg8_v4i*)(lds + PG8_SB(b, h) + boff + n * 2048 + 1024); } } \
        else { _Pragma("unroll") for (int n = 0; n < 2; ++n) _Pragma("unroll") for (int k = 0; k < 2; ++k) dst[n][k] = *(const PG8_LAS bf16x8*)(lds + PG8_SB(b, h) + boff + n * 2048 + k * 1024); } } while (0)
#define PG8_MMA(ai, bj, At, Bt) do { __builtin_amdgcn_s_setprio(1); if constexpr (Sched::F8) { \
        _Pragma("unroll") for (int m = 0; m < 4; ++m) _Pragma("unroll") for (int n = 0; n < 2; ++n) \
            asm volatile("v_mfma_scale_f32_16x16x128_f8f6f4 %0, %1, %2, %0, %3, %4 op_sel_hi:[0,0,0]" : "+v"(acc[ai][bj][m][n]) : "v"(Bt##8[n]), "v"(At##8[m]), "v"(sclB_), "v"(sclA_));     \
        } else { _Pragma("unroll") for (int m = 0; m < 4; ++m) _Pragma("unroll") for (int n = 0; n < 2; ++n) _Pragma("unroll") for (int k = 0; k < 2; ++k) \
        acc[ai][bj][m][n] = __builtin_amdgcn_mfma_f32_16x16x32_bf16(Bt[n][k], At[m][k], acc[ai][bj][m][n], 0, 0, 0); } __builtin_amdgcn_s_setprio(0); } while (0)
#define PG8_WAIT_V(n) asm volatile("s_waitcnt vmcnt(" #n ")" ::: "memory")
#define PG8_WAIT_L(n) asm volatile("s_waitcnt lgkmcnt(" #n ")" ::: "memory")
#define PG8_BAR __builtin_amdgcn_s_barrier()
#define PG8_SCHED __builtin_amdgcn_sched_barrier(0)
    Unit cur, nxt; int ui = 0;
    if (!S.next(0, cur)) return;
    f32x4 acc[2][2][4][2];
#pragma unroll
    for (int a = 0; a < 2; ++a)
#pragma unroll
        for (int b = 0; b < 2; ++b)
#pragma unroll
            for (int m = 0; m < 4; ++m)
#pragma unroll
                for (int n = 0; n < 2; ++n) acc[a][b][m][n] = (f32x4){0.f, 0.f, 0.f, 0.f};
    const int sclB_ = Sched::SCALE_B, sclA_ = 127;
    bf16x8 At[4][2], B0[2][2], B1[2][2]; pg8_v8i At8[4], B08[2], B18[2];
    const char* cA = S.aptr(cur); const char* cB = S.bptr(cur);
    S.a_ready(cur);
    if constexpr (Sched::GATHER) {
#pragma unroll
        for (int h = 0; h < 2; ++h)
#pragma unroll
            for (int i = 0; i < 2; ++i) { vAc[h][i] = S.rowoff(cur, h * HALF + gR[i]) + (unsigned)gC[i] * 2u; vAn[h][i] = vAc[h][i]; }
        asm volatile("s_waitcnt vmcnt(0)" ::: "memory");
    }
    if constexpr (SP2) {
        PG8_STAGE(PG8_SB(0, 0), cB, voffB); PG8_STAGE(PG8_SB(0, 1), cB + hstep, voffB); PG8_STAGE_A(0, 0, cA, vAc); PG8_STAGE_A(0, 1, cA, vAc);
        if (wr == 1) PG8_BAR;
        PG8_WAIT_V(2); PG8_BAR;
        PG8_STAGE(PG8_SB(1, 0), cB + kstep, voffB); PG8_STAGE_A(1, 0, cA + kstep, vAc); PG8_STAGE(PG8_SB(1, 1), cB + hstep + kstep, voffB);
        PG8_WAIT_V(6); PG8_BAR;
    } else {
        PG8_STAGE(PG8_SB(0, 0), cB, voffB); PG8_STAGE_A(0, 0, cA, vAc); PG8_STAGE(PG8_SB(0, 1), cB + hstep, voffB); PG8_STAGE_A(0, 1, cA, vAc);
        if (wr == 1) PG8_BAR;
        PG8_WAIT_V(4); PG8_BAR;
        PG8_STAGE(PG8_SB(1, 0), cB + kstep, voffB); PG8_STAGE_A(1, 0, cA + kstep, vAc); PG8_STAGE(PG8_SB(1, 1), cB + hstep + kstep, voffB);
        PG8_WAIT_V(6); PG8_BAR;
    }
    for (;;) {
        const bool has_next = S.next(ui + 1, nxt);
        const char* nA = has_next ? S.aptr(nxt) : cA; const char* nB = has_next ? S.bptr(nxt) : cB;
        if constexpr (Sched::GATHER) { if (has_next) {
#pragma unroll
            for (int h = 0; h < 2; ++h)
#pragma unroll
                for (int i = 0; i < 2; ++i) vAn[h][i] = S.rowoff(nxt, h * HALF + gR[i]) + (unsigned)gC[i] * 2u; } }
        for (int t = 0; t < nt; t += 2) {
            const bool last = (t == nt - 2);
            const char* a1 = cA + (size_t)(t + 1) * kstep;
            const char* a2 = last ? nA : cA + (size_t)(t + 2) * kstep; const char* b2 = last ? nB : cB + (size_t)(t + 2) * kstep;
            const char* a3 = a2 + kstep; const char* b3 = b2 + kstep;
            if (last && has_next) S.a_ready(nxt);
            if constexpr (SP2) {
            PG8_LDB(B0, 0, 0); PG8_LDB(B1, 0, 1); PG8_SCHED; PG8_LDA(At, 0, 0); PG8_STAGE_A(1, 1, a1, vAc);
            PG8_WAIT_V(8); PG8_WAIT_L(0); PG8_BAR; PG8_MMA(0, 0, At, B0); PG8_MMA(0, 1, At, B1); PG8_BAR; PG8_SCHED;
            PG8_LDA(At, 0, 1); PG8_STAGE(PG8_SB(0, 0), b2, voffB); PG8_STAGE(PG8_SB(0, 1), b2 + hstep, voffB); PG8_STAGE_AN(0, 0, a2);
            PG8_WAIT_V(8); PG8_WAIT_L(0); PG8_BAR; PG8_MMA(1, 0, At, B0); PG8_MMA(1, 1, At, B1); PG8_BAR; PG8_SCHED;
            PG8_LDB(B0, 1, 0); PG8_LDB(B1, 1, 1); PG8_SCHED; PG8_LDA(At, 1, 0); PG8_STAGE_AN(0, 1, a2);
            PG8_WAIT_V(8); PG8_WAIT_L(0); PG8_BAR; PG8_MMA(0, 0, At, B0); PG8_MMA(0, 1, At, B1); PG8_BAR; PG8_SCHED;
            PG8_LDA(At, 1, 1); PG8_STAGE(PG8_SB(1, 0), b3, voffB); PG8_STAGE(PG8_SB(1, 1), b3 + hstep, voffB); PG8_STAGE_AN(1, 0, a3);
            PG8_WAIT_V(8); PG8_WAIT_L(0); PG8_BAR; PG8_MMA(1, 0, At, B0); PG8_MMA(1, 1, At, B1); PG8_BAR; PG8_SCHED;
            } else {
            PG8_LDB(B0, 0, 0); PG8_SCHED; PG8_LDA(At, 0, 0); PG8_STAGE_A(1, 1, a1, vAc);
            PG8_WAIT_L(8); PG8_BAR; PG8_WAIT_L(0); PG8_MMA(0, 0, At, B0); PG8_BAR; PG8_SCHED;
            PG8_LDB(B1, 0, 1); PG8_STAGE(PG8_SB(0, 0), b2, voffB);
            PG8_BAR; PG8_WAIT_L(0); PG8_MMA(0, 1, At, B1); PG8_BAR;
            PG8_LDA(At, 0, 1); PG8_STAGE_AN(0, 0, a2);
            PG8_BAR; PG8_WAIT_L(0); PG8_MMA(1, 0, At, B0); PG8_BAR; PG8_SCHED;
            PG8_STAGE(PG8_SB(0, 1), b2 + hstep, voffB);
            PG8_WAIT_V(6); PG8_BAR; PG8_MMA(1, 1, At, B1); PG8_BAR;
            PG8_LDB(B0, 1, 0); PG8_SCHED; PG8_LDA(At, 1, 0); PG8_STAGE_AN(0, 1, a2);
            PG8_WAIT_L(8); PG8_BAR; PG8_WAIT_L(0); PG8_MMA(0, 0, At, B0); PG8_BAR; PG8_SCHED;
            PG8_LDB(B1, 1, 1); PG8_STAGE(PG8_SB(1, 0), b3, voffB);
            PG8_BAR; PG8_WAIT_L(0); PG8_MMA(0, 1, At, B1); PG8_BAR;
            PG8_LDA(At, 1, 1); PG8_STAGE_AN(1, 0, a3);
            PG8_BAR; PG8_WAIT_L(0); PG8_MMA(1, 0, At, B0); PG8_BAR; PG8_SCHED;
            PG8_STAGE(PG8_SB(1, 1), b3 + hstep, voffB);
            PG8_WAIT_V(6); PG8_BAR; PG8_MMA(1, 1, At, B1); PG8_BAR;
            }
        }
        if constexpr (ALIGN_EPI) { if (wr == 0) PG8_BAR; }
        if constexpr (!Epi::AFTER_DRAIN) { E(acc, cur, wr, wc, fr, fq); S.done(cur); }
        if (!has_next) break;
#pragma unroll
        for (int a = 0; a < 2; ++a)
#pragma unroll
            for (int b = 0; b < 2; ++b)
#pragma unroll
                for (int m = 0; m < 4; ++m)
#pragma unroll
                    for (int n = 0; n < 2; ++n) acc[a][b][m][n] = (f32x4){0.f, 0.f, 0.f, 0.f};
        cur = nxt; cA = nA; cB = nB; ++ui;
        if constexpr (Sched::GATHER) {
#pragma unroll
            for (int h = 0; h < 2; ++h)
#pragma unroll
                for (int i = 0; i < 2; ++i) vAc[h][i] = vAn[h][i]; }
        if constexpr (ALIGN_EPI) { if (wr == 1) PG8_BAR; }
    }
    PG8_WAIT_V(0);
    if constexpr (!ALIGN_EPI) { if (wr == 0) PG8_BAR; }
    PG8_BAR;
    if constexpr (Epi::AFTER_DRAIN) { E.fused(acc, cur, wr, wc, fr, fq, lds, wid, lane); S.done(cur); }
#undef PG8_SA
#undef PG8_SB
#undef PG8_STAGE
#undef PG8_STAGE_A
#undef PG8_STAGE_AN
#undef PG8_LDA
#undef PG8_LDB
#undef PG8_MMA
#undef PG8_WAIT_V
#undef PG8_WAIT_L
#undef PG8_BAR
#undef PG8_SCHED
}
}

constexpr int T = 8192, D = 2048, MIXW = 1536, MEMW = 512, NINA = 3584, DEPTH = 4, NE = 32, FF = 512, MEMT = 256;
constexpr int SLOTS = 24576;
constexpr float LN_EPS = 1e-5f;
constexpr float DN_ALPHA = 1.6817928305074292f;
constexpr float LOG2E = 1.4426950408889634f;
constexpr float QSCALE = 0.08838834764831845f * LOG2E;
constexpr int NWAVES = 8;

constexpr size_t MiB = 1u << 20;
constexpr size_t WS_CTL = 0, CTL_ZERO_BYTES = 1 * MiB;
constexpr size_t WS_WAIN = 2 * MiB, WS_WAOUT = 30 * MiB, WS_WBIN0 = 46 * MiB, WS_WKV = 54 * MiB, WS_WBIN1 = 66 * MiB, WS_WBOUT = 74 * MiB, WS_WMKV = 90 * MiB;
constexpr size_t WS_W13 = 106 * MiB, WS_W2 = 618 * MiB;
constexpr size_t WS_XB = 874 * MiB, WS_MEMB = 906 * MiB, WS_MEMKV = 907 * MiB, WS_Z = 910 * MiB, WS_KD = 966 * MiB, WS_VD = 990 * MiB, WS_CAT = 1014 * MiB;
constexpr size_t WS_Y = 1046 * MiB, WS_X1F = 1110 * MiB, WS_X1B = 1174 * MiB, WS_XF = 1206 * MiB, WS_XG = 1270 * MiB, WS_H = 1366 * MiB, WS_YB = 1390 * MiB, WS_OP = 1486 * MiB;
constexpr size_t WS_ROUTE = 1582 * MiB, WS_OP2 = 1583 * MiB, WS_ML = 1631 * MiB, WS_WR = 1634 * MiB, WS_TS = 1640 * MiB, WS_LIST = 1641 * MiB, WS_END = 1642 * MiB;
constexpr int CW_TMO = 0, CW_BAR = 4096, CW_CNT = 16384, CW_Q = 28672, CW_CONV = 29184, CW_DONE = 32768, CW_FIN = 40960;

constexpr int RING_OFF = 0, RING_BYTES = 131072;
constexpr int LDSCTL_OFF = 146432, MISC_OFF = LDSCTL_OFF + 320, TAB_OFF = LDSCTL_OFF + 512;
constexpr int LDS_BYTES = 147456;

#define GAS __attribute__((address_space(1)))
#define LAS __attribute__((address_space(3)))
typedef unsigned short bf16;
typedef unsigned v4u __attribute__((ext_vector_type(4)));
typedef unsigned v2u __attribute__((ext_vector_type(2)));
typedef float f32x4 __attribute__((ext_vector_type(4)));
typedef short bf16x8 __attribute__((ext_vector_type(8)));
typedef GAS unsigned gu32;
#define RLX_AGENT __ATOMIC_RELAXED, __HIP_MEMORY_SCOPE_AGENT
#define LDS_WAIT() asm volatile("s_waitcnt lgkmcnt(0)" ::: "memory")
#define VM_WAIT() asm volatile("s_waitcnt vmcnt(0)" ::: "memory")
__device__ __forceinline__ unsigned f2bf(float f) { unsigned u = __builtin_bit_cast(unsigned, f); return (u + 0x7fffu + ((u >> 16) & 1u)) >> 16; }
__device__ __forceinline__ unsigned pk2(float lo, float hi) { return f2bf(lo) | (f2bf(hi) << 16); }
__device__ __forceinline__ float bf2f(unsigned short b) { return __builtin_bit_cast(float, (unsigned)b << 16); }
__device__ __forceinline__ float bflo(unsigned w) { return __builtin_bit_cast(float, w << 16); }
__device__ __forceinline__ float bfhi(unsigned w) { return __builtin_bit_cast(float, w & 0xffff0000u); }
__device__ __forceinline__ float wave_sum(float v) {
#pragma unroll
    for (int o = 1; o < 64; o <<= 1) v += __shfl_xor(v, o);
    return v;
}

namespace pg8 {
struct DenseOrder {
    static constexpr bool GATHER = false, F8 = false; static constexpr int SCALE_B = 127;
    StaticOrder so; const char* A; const char* B; size_t astep, bstep;
    __device__ void init(const void* A_, const void* B_, int M, int N, int K, int G, int c) { so.init(M, N, G, c); A = (const char*)A_; B = (const char*)B_; astep = (size_t)256 * K * 2; bstep = astep; }
    __device__ __forceinline__ bool next(int i, Unit& u) const { u.e = 0; return so.next(i, u); }
    __device__ __forceinline__ const char* aptr(const Unit& u) const { return A + (size_t)u.pm * astep; }
    __device__ __forceinline__ const char* bptr(const Unit& u) const { return B + (size_t)u.pn * bstep; }
    __device__ __forceinline__ void a_ready(const Unit&) const {}
    __device__ __forceinline__ void done(const Unit&) const {}
};
struct DualOrder {
    static constexpr bool GATHER = false, F8 = false; static constexpr int SCALE_B = 127;
    StaticOrder so; int nwg2; const char* A; const char* B; const char* A2; const char* B2; size_t step;
    __device__ void init(const void* A_, const void* B_, int M, int N, int K, int G, int c, const void* A2_, const void* B2_, int nwg2_) { so.init(M, N, G, c); A = (const char*)A_; B = (const char*)B_; A2 = (const char*)A2_; B2 = (const char*)B2_; nwg2 = nwg2_; step = (size_t)256 * K * 2; }
    __device__ __forceinline__ bool next(int i, Unit& u) const { const int L = i * so.G + so.c; if (L < so.nwg) { u.e = 0; return so.next(i, u); } if (L - so.nwg >= nwg2) return false; u.e = 1; u.pm = 0; u.pn = L - so.nwg; return true; }
    __device__ __forceinline__ const char* aptr(const Unit& u) const { return u.e ? A2 : A + (size_t)u.pm * step; }
    __device__ __forceinline__ const char* bptr(const Unit& u) const { return (u.e ? B2 : B) + (size_t)u.pn * step; }
    __device__ __forceinline__ void a_ready(const Unit&) const {}
    __device__ __forceinline__ void done(const Unit&) const {}
};
struct MoeOrder {
    static constexpr bool GATHER = false, F8 = false; static constexpr int SCALE_B = 127;
    const PG8_LAS int* tstart; int ntn, G, c; const char* A; const char* W; size_t astep, wexp, wtile;
    __device__ __forceinline__ bool next(int i, Unit& u) const {
        const int L = i * G + c, total = tstart[32] * ntn; if (L >= total) return false;
        int wgid; { const int q = total / NXCD, r = total % NXCD, xcd = L % NXCD, off = L / NXCD; wgid = (xcd < r ? xcd * (q + 1) : r * (q + 1) + (xcd - r) * q) + off; }
        u.pm = wgid / ntn; u.pn = wgid - u.pm * ntn; int e = 0;
#pragma unroll
        for (int k = 1; k <= 31; ++k) e += (tstart[k] <= u.pm) ? 1 : 0;
        u.e = e; return true;
    }
    __device__ __forceinline__ const char* aptr(const Unit& u) const { return A + (size_t)u.pm * astep; }
    __device__ __forceinline__ const char* bptr(const Unit& u) const { return W + (size_t)u.e * wexp + (size_t)u.pn * wtile; }
    __device__ __forceinline__ void a_ready(const Unit&) const {}
    __device__ __forceinline__ void done(const Unit&) const {}
};

struct MoeOrder8 {
    static constexpr bool GATHER = false, F8 = true; static constexpr int SCALE_B = 121;
    const PG8_LAS int* tstart; int ntn, G, c; const char* A; const char* W; size_t astep, wexp, wtile;
    __device__ __forceinline__ bool next(int i, Unit& u) const {
        const int L = i * G + c, total = tstart[32] * ntn; if (L >= total) return false;
        int wgid; { const int q = total / NXCD, r = total % NXCD, xcd = L % NXCD, off = L / NXCD; wgid = (xcd < r ? xcd * (q + 1) : r * (q + 1) + (xcd - r) * q) + off; }
        u.pm = wgid / ntn; u.pn = wgid - u.pm * ntn; int e = 0;
#pragma unroll
        for (int k = 1; k <= 31; ++k) e += (tstart[k] <= u.pm) ? 1 : 0;
        u.e = e; return true;
    }
    __device__ __forceinline__ const char* aptr(const Unit& u) const { return A + (size_t)u.pm * astep; }
    __device__ __forceinline__ const char* bptr(const Unit& u) const { return W + (size_t)u.e * wexp + (size_t)u.pn * wtile; }
    __device__ __forceinline__ void a_ready(const Unit&) const {}
    __device__ __forceinline__ void done(const Unit&) const {}
};

struct MoeGatherOrder {
    static constexpr bool GATHER = true, F8 = true; static constexpr int SCALE_B = 121;
    const PG8_LAS int* tstart; const PG8_LAS int* cntl; const int* list; int ntn, G, c; const char* A; const char* W; size_t wexp, wtile; unsigned rowbytes;
    __device__ __forceinline__ bool next(int i, Unit& u) const {
        const int L = i * G + c, total = tstart[32] * ntn; if (L >= total) return false;
        int wgid; { const int q = total / NXCD, r = total % NXCD, xcd = L % NXCD, off = L / NXCD; wgid = (xcd < r ? xcd * (q + 1) : r * (q + 1) + (xcd - r) * q) + off; }
        u.pm = wgid / ntn; u.pn = wgid - u.pm * ntn; int e = 0;
#pragma unroll
        for (int k = 1; k <= 31; ++k) e += (tstart[k] <= u.pm) ? 1 : 0;
        u.e = e; return true;
    }
    __device__ __forceinline__ unsigned rowoff(const Unit& u, int r) const { const int rank = (u.pm - tstart[u.e]) * 256 + r; const int tok = list[u.e * 8192 + (rank < cntl[u.e] ? rank : 0)]; return (unsigned)tok * rowbytes; }
    __device__ __forceinline__ const char* aptr(const Unit&) const { return A; }
    __device__ __forceinline__ const char* bptr(const Unit& u) const { return W + (size_t)u.e * wexp + (size_t)u.pn * wtile; }
    __device__ __forceinline__ void a_ready(const Unit&) const {}
    __device__ __forceinline__ void done(const Unit&) const {}
};

struct EpiBf16X {
    static constexpr bool PERM = true, AFTER_DRAIN = false;
    int mode; bf16_t* p0; bf16_t* p1; bf16_t* p2; bf16_t* p3;
    const PG8_LAS int* tstart; const PG8_LAS int* cntl;
    __device__ __forceinline__ void operator()(const f32x4 (&acc)[2][2][4][2], const Unit& u, int wr, int wc, int fr, int fq) const {
        bf16_t* base; int ldc, colt; bool act = false; float sc = 1.f;
        if (u.e && mode < 2) { base = p3 + (size_t)(u.pn >> 2) * (256 * 1024); ldc = 1024; colt = (u.pn & 3) * BM; }
        else if (mode == 0) { base = p0; ldc = 3584; colt = u.pn * BM; act = u.pn < 12; if (u.pn >= 12) sc = QSCALE; }
        else if (mode == 1) { if (u.pn < 8) { base = p0; ldc = 2048; colt = u.pn * BM; sc = QSCALE; }
                              else if (u.pn < 14) { base = p1; ldc = 1536; colt = (u.pn - 8) * BM; } else { base = p2; ldc = 1536; colt = (u.pn - 14) * BM; } }
        else { base = p0; ldc = 2048; colt = u.pn * BM; }
        const int row0 = u.pm * BM + wr * 64 + fr, col0 = colt + wc * 32 + 8 * fq;
        const int rlim = (mode == 3) ? cntl[u.e] - (u.pm - tstart[u.e]) * BM : BM;
#pragma unroll
        for (int ai = 0; ai < 2; ++ai)
#pragma unroll
            for (int m = 0; m < 4; ++m) { bf16_t* rowp = base + (size_t)(row0 + ai * HALF + m * 16) * ldc + col0;
                if (wr * 64 + fr + ai * HALF + m * 16 >= rlim) continue;
#pragma unroll
                for (int bj = 0; bj < 2; ++bj) { f32x4 v0 = acc[ai][bj][m][0], v1 = acc[ai][bj][m][1];
                    if (act) { f32x2 a = gelu_pk((f32x2){v0[0], v0[1]}), b = gelu_pk((f32x2){v0[2], v0[3]}), c = gelu_pk((f32x2){v1[0], v1[1]}), d = gelu_pk((f32x2){v1[2], v1[3]});
                        v0 = (f32x4){a.x, a.y, b.x, b.y}; v1 = (f32x4){c.x, c.y, d.x, d.y}; }
                    v0 = v0 * sc; v1 = v1 * sc; u32x4 w; w.x = cvt_pk_bf16(v0[0], v0[1]); w.y = cvt_pk_bf16(v0[2], v0[3]); w.z = cvt_pk_bf16(v1[0], v1[1]); w.w = cvt_pk_bf16(v1[2], v1[3]);
                    *(u32x4*)(rowp + bj * HALF) = w; } }
    }
};
struct EpiResBf16 {
    static constexpr bool PERM = true, AFTER_DRAIN = false;
    const bf16_t* xres; bf16_t* y; float alpha;
    __device__ __forceinline__ void operator()(const f32x4 (&acc)[2][2][4][2], const Unit& u, int wr, int wc, int fr, int fq) const {
        const int row0 = u.pm * BM + wr * 64 + fr, col0 = u.pn * BM + wc * 32 + 8 * fq;
#pragma unroll
        for (int ai = 0; ai < 2; ++ai)
#pragma unroll
            for (int m = 0; m < 4; ++m) { const size_t off = (size_t)(row0 + ai * HALF + m * 16) * 2048 + col0;
#pragma unroll
                for (int bj = 0; bj < 2; ++bj) { const u32x4 xr = *(const u32x4*)(xres + off + bj * HALF); const f32x4 v0 = acc[ai][bj][m][0], v1 = acc[ai][bj][m][1]; u32x4 w;
                    w.x = cvt_pk_bf16(__builtin_bit_cast(float, xr.x << 16) * alpha + v0[0], __builtin_bit_cast(float, xr.x & 0xffff0000u) * alpha + v0[1]);
                    w.y = cvt_pk_bf16(__builtin_bit_cast(float, xr.y << 16) * alpha + v0[2], __builtin_bit_cast(float, xr.y & 0xffff0000u) * alpha + v0[3]);
                    w.z = cvt_pk_bf16(__builtin_bit_cast(float, xr.z << 16) * alpha + v1[0], __builtin_bit_cast(float, xr.z & 0xffff0000u) * alpha + v1[1]);
                    w.w = cvt_pk_bf16(__builtin_bit_cast(float, xr.w << 16) * alpha + v1[2], __builtin_bit_cast(float, xr.w & 0xffff0000u) * alpha + v1[3]);
                    *(u32x4*)(y + off + bj * HALF) = w; } }
    }
};
struct EpiMoe1 {
    static constexpr bool PERM = true, AFTER_DRAIN = false;
    bf16_t* h; const PG8_LAS int* tstart; const PG8_LAS int* cntl;
    __device__ __forceinline__ void operator()(const f32x4 (&acc)[2][2][4][2], const Unit& u, int wr, int wc, int fr, int fq) const {
        const int row0 = u.pm * BM + wr * 64 + fr, col0 = u.pn * HALF + wc * 32 + 8 * fq;
        const int rlim = cntl[u.e] - (u.pm - tstart[u.e]) * BM;
#pragma unroll
        for (int ai = 0; ai < 2; ++ai)
#pragma unroll
            for (int m = 0; m < 4; ++m) { unsigned char* rowp = (unsigned char*)h + (size_t)(row0 + ai * HALF + m * 16) * 512 + col0; float o[8];
                if (wr * 64 + fr + ai * HALF + m * 16 >= rlim) continue;
#pragma unroll
                for (int n = 0; n < 2; ++n)
#pragma unroll
                    for (int x = 0; x < 4; ++x) { const float a = acc[ai][0][m][n][x], b = acc[ai][1][m][n][x];
                        o[n * 4 + x] = a * __builtin_amdgcn_rcpf(1.0f + __builtin_amdgcn_exp2f(-a * LOG2E)) * b; }
                unsigned lo = 0u, hi = 0u; lo = __builtin_amdgcn_cvt_pk_fp8_f32(o[0], o[1], lo, false); lo = __builtin_amdgcn_cvt_pk_fp8_f32(o[2], o[3], lo, true);
                hi = __builtin_amdgcn_cvt_pk_fp8_f32(o[4], o[5], hi, false); hi = __builtin_amdgcn_cvt_pk_fp8_f32(o[6], o[7], hi, true);
                typedef unsigned u32x2e __attribute__((ext_vector_type(2))); u32x2e w; w.x = lo; w.y = hi; *(u32x2e*)rowp = w; }
    }
};
}

namespace att {
using bf16x8 = __attribute__((ext_vector_type(8))) short;
using s16x4  = __attribute__((ext_vector_type(4))) short;
using f32x16 = __attribute__((ext_vector_type(16))) float;
using u32x4  = __attribute__((ext_vector_type(4))) unsigned;
constexpr int DH = 128, QBLK = 32, KVBLK = 64;
constexpr float THR2 = 8.f * 1.4426950408889634f;
constexpr size_t SHM_V = KVBLK * DH * 2, SHM_K = KVBLK * DH * 2, SHM_ATTN = 2 * SHM_V + 2 * SHM_K + NWAVES * 64 * 4;
constexpr int TAB_N = 160;
#define KSWZ(row, colB) ((row) * 256 + ((colB) ^ (((row) & 7) << 4)))
#define SBAR() __builtin_amdgcn_sched_barrier(0)
__device__ __forceinline__ int crow(int r, int hi) { return (r & 3) + 8 * (r >> 2) + 4 * hi; }
__device__ __forceinline__ unsigned cvtpk(float lo, float hi) { unsigned r; asm volatile("v_cvt_pk_bf16_f32 %0, %1, %2" : "=v"(r) : "v"(lo), "v"(hi)); return r; }

__device__ __forceinline__ void partialSM(f32x16& p0, f32x16& p1, float& m_reg, float& mn, float& alpha) {
  float pmax = p0[0];
#pragma unroll
  for (int r = 1; r < 16; ++r) pmax = fmaxf(pmax, p0[r]);
#pragma unroll
  for (int r = 0; r < 16; ++r) pmax = fmaxf(pmax, p1[r]);
  { auto rr = __builtin_amdgcn_permlane32_swap(__float_as_uint(pmax), __float_as_uint(pmax), false, false);
    pmax = fmaxf(__uint_as_float(rr[0]), __uint_as_float(rr[1])); }
  if (__builtin_expect(__all(pmax - m_reg <= THR2), 1)) { mn = m_reg; alpha = 1.f; }
  else { mn = fmaxf(m_reg, pmax); alpha = __builtin_amdgcn_exp2f(m_reg - mn); m_reg = mn; }
#pragma unroll
  for (int r = 0; r < 16; ++r) p0[r] = p0[r] - mn;
#pragma unroll
  for (int r = 0; r < 16; ++r) p1[r] = p1[r] - mn;
#pragma unroll
  for (int r = 0; r < 16; ++r) p0[r] = __builtin_amdgcn_exp2f(p0[r]);
}
__device__ __forceinline__ void finishSM(f32x16& p0, f32x16& p1, float alpha, float& l_reg, bf16x8& pa0, bf16x8& pa1, bf16x8& pa2, bf16x8& pa3) {
#pragma unroll
  for (int r = 0; r < 16; ++r) p1[r] = __builtin_amdgcn_exp2f(p1[r]);
  float ps = 0;
#pragma unroll
  for (int r = 0; r < 16; ++r) ps += p0[r];
#pragma unroll
  for (int r = 0; r < 16; ++r) ps += p1[r];
  { auto rr = __builtin_amdgcn_permlane32_swap(__float_as_uint(ps), __float_as_uint(ps), false, false);
    ps = __uint_as_float(rr[0]) + __uint_as_float(rr[1]); }
  l_reg = l_reg * alpha + ps;
#define PK4(P, BASE, OUT) do { unsigned a0 = cvtpk(P[BASE + 0], P[BASE + 1]), a1 = cvtpk(P[BASE + 2], P[BASE + 3]);   \
    unsigned b0 = cvtpk(P[BASE + 4], P[BASE + 5]), b1 = cvtpk(P[BASE + 6], P[BASE + 7]);                              \
    auto r0 = __builtin_amdgcn_permlane32_swap(a0, b0, false, false); auto r1 = __builtin_amdgcn_permlane32_swap(a1, b1, false, false); \
    u32x4 w = {r0[0], r1[0], r0[1], r1[1]}; OUT = *reinterpret_cast<bf16x8*>(&w); } while (0)
  PK4(p0, 0, pa0); PK4(p0, 8, pa1); PK4(p1, 0, pa2); PK4(p1, 8, pa3);
#undef PK4
}
__device__ __forceinline__ void qkt(f32x16& p0, f32x16& p1, const char* Ks, const bf16x8* qr, int r32, int hi) {
  p0 = f32x16{}; p1 = f32x16{};
#pragma unroll
  for (int d0 = 0; d0 < 8; ++d0) { const int cb = (d0 * 16 + hi * 8) * 2;
    bf16x8 b0 = *reinterpret_cast<const bf16x8*>(Ks + KSWZ(r32, cb));
    bf16x8 b1 = *reinterpret_cast<const bf16x8*>(Ks + KSWZ(32 + r32, cb));
    p0 = __builtin_amdgcn_mfma_f32_32x32x16_bf16(b0, qr[d0], p0, 0, 0, 0);
    p1 = __builtin_amdgcn_mfma_f32_32x32x16_bf16(b1, qr[d0], p1, 0, 0, 0); }
}
__device__ __forceinline__ int v_st(int k, int c) { const int kk = (k & ~0xC) | ((k & 4) << 1) | ((k & 8) >> 1); return ((kk >> 3) * 4 + (c >> 5)) * 512 + ((kk & 7) * 32 + (c & 31)) * 2; }
__device__ __forceinline__ int v_rd_base(int lane) { return ((lane & 3) << 3) | (((lane >> 2) & 3) << 6) | (((lane >> 4) & 1) << 5) | (((lane >> 5) & 1) << 8); }
constexpr int v_rd_off(int d0, int ks, int half) { return d0 * 512 + ks * 4096 + half * 2048; }
template <int OFF> __device__ __forceinline__ s16x4 tr_read(int vb) {
  s16x4 r; asm volatile("ds_read_b64_tr_b16 %0, %1 offset:%2" : "=&v"(r) : "v"(vb), "i"(OFF) : "memory"); return r;
}
template <int D0> __device__ __forceinline__ void pv_one(f32x16& od, int vb, bf16x8 pa0, bf16x8 pa1, bf16x8 pa2, bf16x8 pa3) {
  const s16x4 l0 = tr_read<v_rd_off(D0, 0, 0)>(vb), h0 = tr_read<v_rd_off(D0, 0, 1)>(vb), l1 = tr_read<v_rd_off(D0, 1, 0)>(vb), h1 = tr_read<v_rd_off(D0, 1, 1)>(vb);
  const s16x4 l2 = tr_read<v_rd_off(D0, 2, 0)>(vb), h2 = tr_read<v_rd_off(D0, 2, 1)>(vb), l3 = tr_read<v_rd_off(D0, 3, 0)>(vb), h3 = tr_read<v_rd_off(D0, 3, 1)>(vb);
  asm volatile("s_waitcnt lgkmcnt(0)" ::: "memory"); SBAR();
#define PK(L, H) (bf16x8){L[0], L[1], L[2], L[3], H[0], H[1], H[2], H[3]}
  od = __builtin_amdgcn_mfma_f32_32x32x16_bf16(pa0, PK(l0, h0), od, 0, 0, 0);
  od = __builtin_amdgcn_mfma_f32_32x32x16_bf16(pa1, PK(l1, h1), od, 0, 0, 0);
  od = __builtin_amdgcn_mfma_f32_32x32x16_bf16(pa2, PK(l2, h2), od, 0, 0, 0);
  od = __builtin_amdgcn_mfma_f32_32x32x16_bf16(pa3, PK(l3, h3), od, 0, 0, 0);
#undef PK
}
__device__ __forceinline__ void pv_d0(f32x16* o, int vb, bf16x8 pa0, bf16x8 pa1, bf16x8 pa2, bf16x8 pa3) {
  pv_one<0>(o[0], vb, pa0, pa1, pa2, pa3); pv_one<1>(o[1], vb, pa0, pa1, pa2, pa3); pv_one<2>(o[2], vb, pa0, pa1, pa2, pa3); pv_one<3>(o[3], vb, pa0, pa1, pa2, pa3);
}
template <int MODE> __device__ __forceinline__ void post_scores(f32x16& p0, f32x16& p1, int t, int qrow0, int r32, int hi, const float* tab, float cfar) {
  if constexpr (MODE == 1) {
    const int cw = qrow0 >> 6;
    if (t > cw) {
#pragma unroll
      for (int r = 0; r < 16; ++r) { p0[r] = -INFINITY; p1[r] = -INFINITY; }
    } else if (qrow0 - (64 * t + 63) >= 91) {
#pragma unroll
      for (int r = 0; r < 16; ++r) { p0[r] += cfar; p1[r] += cfar; }
    } else {
      const int base = qrow0 + r32 - 64 * t + 63;
#pragma unroll
      for (int r = 0; r < 16; ++r) { const int i0 = base - crow(r, hi); const int i1 = i0 - 32;
        p0[r] += tab[i0 < TAB_N - 1 ? i0 : TAB_N - 1]; p1[r] += tab[i1 < TAB_N - 1 ? i1 : TAB_N - 1]; }
    }
  }
}

template <int MODE>
__device__ __forceinline__ void attn_body(const bf16* __restrict__ Qb, int ldq, const bf16* __restrict__ Kh, const bf16* __restrict__ Vh, int ldk,
                                          bf16* Ob, float* Of, int ldo, int NT, int q0abs, const float* tab, float cfar, char* lds) {
  int tid_ = threadIdx.x; asm volatile("" : "+v"(tid_));
  const int tid = tid_, wid = tid >> 6, lane = tid & 63, r32 = lane & 31, hi = lane >> 5;
  char* V_lds = lds; char* K_lds = lds + 2 * SHM_V;
  float* ws = (float*)(lds + 2 * SHM_V + 2 * SHM_K) + wid * 64; float* li_l = ws; float* al_l = ws + 32;
  float m_reg = -1e30f, l_reg = 0; f32x16 o[4] = {}; bf16x8 qr[8];
  const int qrow0 = q0abs + wid * QBLK;
  const bf16* Qw = Qb + (long)(wid * QBLK + r32) * ldq + hi * 8;
#pragma unroll
  for (int d0 = 0; d0 < 8; ++d0) qr[d0] = *reinterpret_cast<const bf16x8*>(Qw + d0 * 16);
  const int sr = tid >> 4, sc = (tid & 15) * 8, vst0 = v_st(sr, sc), vst1 = v_st(32 + sr, sc);
  const int vb0 = (int)(uintptr_t)V_lds + v_rd_base(lane);
  struct { bf16x8 vs0, vs1, ks0, ks1; } sr_[2];
#define SLOAD(i, k0) do { sr_[i].vs0 = *reinterpret_cast<const bf16x8*>(&Vh[(long)((k0) + sr) * ldk + sc]); sr_[i].vs1 = *reinterpret_cast<const bf16x8*>(&Vh[(long)((k0) + 32 + sr) * ldk + sc]); \
    sr_[i].ks0 = *reinterpret_cast<const bf16x8*>(&Kh[(long)((k0) + sr) * ldk + sc]); sr_[i].ks1 = *reinterpret_cast<const bf16x8*>(&Kh[(long)((k0) + 32 + sr) * ldk + sc]); } while (0)
#define SWRITE(b, i) do { *(bf16x8*)(V_lds + (b) * SHM_V + vst0) = sr_[i].vs0;          \
    *(bf16x8*)(V_lds + (b) * SHM_V + vst1) = sr_[i].vs1; const int kc = sc * 2;               \
    *(bf16x8*)(K_lds + (b) * SHM_K + KSWZ(sr, kc)) = sr_[i].ks0;                       \
    *(bf16x8*)(K_lds + (b) * SHM_K + KSWZ(32 + sr, kc)) = sr_[i].ks1; } while (0)
#define SWAIT() asm volatile("s_waitcnt vmcnt(4)" ::: "memory")
#define RESC(a) do { if (__any((a) < 1.f)) { if (hi == 0) al_l[r32] = (a); asm volatile("s_waitcnt lgkmcnt(0)" ::: "memory"); \
    _Pragma("unroll") for (int d = 0; d < 4; ++d) _Pragma("unroll") for (int r = 0; r < 16; ++r) o[d][r] *= al_l[crow(r, hi)]; } } while (0)
  f32x16 pA0, pA1, pB0, pB1; float mnA, mnB, alA, alB; bf16x8 pa0, pa1, pa2, pa3;
  constexpr int SE = 0, SO = 1;
  SLOAD(SE, 0); asm volatile("s_waitcnt vmcnt(0)" ::: "memory"); SWRITE(0, SE); __syncthreads();
  qkt(pA0, pA1, K_lds, qr, r32, hi); post_scores<MODE>(pA0, pA1, 0, qrow0, r32, hi, tab, cfar); partialSM(pA0, pA1, m_reg, mnA, alA);
  SLOAD(SO, KVBLK); if (2 < NT) SLOAD(SE, 2 * KVBLK);
  SWAIT(); SWRITE(1, SO); __syncthreads();
  for (int j = 1; j + 1 < NT; j += 2) {
    SBAR(); qkt(pB0, pB1, K_lds + SHM_K, qr, r32, hi); post_scores<MODE>(pB0, pB1, j, qrow0, r32, hi, tab, cfar);
    finishSM(pA0, pA1, alA, l_reg, pa0, pa1, pa2, pa3); SBAR();
    SLOAD(SO, (j + 2) * KVBLK); SBAR();
    pv_d0(o, vb0, pa0, pa1, pa2, pa3); partialSM(pB0, pB1, m_reg, mnB, alB);
    __syncthreads(); SWAIT(); SWRITE(0, SE);
    RESC(alB); __syncthreads();
    SBAR(); qkt(pA0, pA1, K_lds, qr, r32, hi); post_scores<MODE>(pA0, pA1, j + 1, qrow0, r32, hi, tab, cfar);
    finishSM(pB0, pB1, alB, l_reg, pa0, pa1, pa2, pa3); SBAR();
    if (j + 3 < NT) SLOAD(SE, (j + 3) * KVBLK); SBAR();
    pv_d0(o, vb0 + (int)SHM_V, pa0, pa1, pa2, pa3); partialSM(pA0, pA1, m_reg, mnA, alA);
    __syncthreads(); SWAIT(); SWRITE(1, SO);
    RESC(alA); __syncthreads();
  }
  SBAR(); qkt(pB0, pB1, K_lds + SHM_K, qr, r32, hi); post_scores<MODE>(pB0, pB1, NT - 1, qrow0, r32, hi, tab, cfar);
  finishSM(pA0, pA1, alA, l_reg, pa0, pa1, pa2, pa3); SBAR();
  pv_d0(o, vb0, pa0, pa1, pa2, pa3); partialSM(pB0, pB1, m_reg, mnB, alB);
  __syncthreads(); RESC(alB);
  finishSM(pB0, pB1, alB, l_reg, pa0, pa1, pa2, pa3); SBAR();
  pv_d0(o, vb0 + (int)SHM_V, pa0, pa1, pa2, pa3);
  if (hi == 0) li_l[r32] = l_reg; asm volatile("s_waitcnt lgkmcnt(0)" ::: "memory");
  float rli[16];
#pragma unroll
  for (int r = 0; r < 16; ++r) rli[r] = __builtin_amdgcn_rcpf(li_l[crow(r, hi)]);
  if constexpr (MODE == 0) {
    bf16* Ow = Ob + (long)(wid * QBLK) * ldo;
#pragma unroll
    for (int r = 0; r < 16; ++r) { const int orow = crow(r, hi);
#pragma unroll
      for (int d0 = 0; d0 < 4; ++d0) Ow[(long)orow * ldo + d0 * 32 + r32] = (bf16)f2bf(o[d0][r] * rli[r]); }
  } else {
    float* Ow = Of + (long)(wid * QBLK) * ldo;
#pragma unroll
    for (int r = 0; r < 16; ++r) { const int orow = crow(r, hi);
#pragma unroll
      for (int d0 = 0; d0 < 4; ++d0) Ow[(long)orow * ldo + d0 * 32 + r32] = o[d0][r] * rli[r]; }
  }
  __syncthreads();
#undef SLOAD
#undef SWRITE
#undef SWAIT
#undef RESC
}
}

#define XB_TMO      128
#define XB_XCNT(j)  (256  + 64 * (j))
#define XB_XSUB(j)  (1280 + 64 * (j))
#define XB_XGEN(j)  (2304 + 64 * (j))
#define XB_TOP      3328
#define XB_TOPGEN   3392
#define XCD_BAR_WORDS 3456
#define XB_SPIN_CAP (1u << 18)

__device__ __forceinline__ unsigned xb_ld(unsigned* p)              { return __hip_atomic_load(p, __ATOMIC_RELAXED, __HIP_MEMORY_SCOPE_AGENT); }
__device__ __forceinline__ unsigned xb_add(unsigned* p, unsigned v) { return __hip_atomic_fetch_add(p, v, __ATOMIC_RELAXED, __HIP_MEMORY_SCOPE_AGENT); }
__device__ __forceinline__ unsigned xb_xcc_id() { return (unsigned)__builtin_amdgcn_s_getreg((3 << 11) | 20) & 0xFu; }
#define XB_SPIN(cond, bar) do { unsigned _sp = 0; while (cond) { __builtin_amdgcn_s_sleep(1); \
    if ((++_sp & 255u) == 0u) { if (xb_ld(&(bar)[XB_TMO])) break; if (_sp > XB_SPIN_CAP) { atomicAdd(&(bar)[XB_TMO], 1u); break; } } } } while (0)

struct XcdBarrier {
    unsigned* bar; unsigned x;
    volatile LAS unsigned* st;
};

__device__ __forceinline__ XcdBarrier xcd_barrier_post(unsigned* bar, volatile LAS unsigned* st) {
    XcdBarrier b; b.bar = bar; b.x = xb_xcc_id(); b.st = st;
    if (threadIdx.x == 0) (void)xb_add(&bar[XB_XCNT(b.x)], 1u);
    return b;
}
__device__ __forceinline__ void xcd_barrier_complete(unsigned* bar, unsigned x, unsigned& nloc, unsigned& nx) {
    const unsigned G = gridDim.x * gridDim.y * gridDim.z;
    unsigned sum, cnt, mine, sp = 0u;
    for (;;) {
        sum = 0u; cnt = 0u; mine = 0u;
#pragma unroll
        for (unsigned j = 0; j < 16; ++j) { const unsigned c = xb_ld(&bar[XB_XCNT(j)]); sum += c; cnt += (c > 0u) ? 1u : 0u; mine = (j == x) ? c : mine; }
        if (sum == G) break;
        __builtin_amdgcn_s_sleep(1);
        if ((++sp & 255u) == 0u) { if (xb_ld(&bar[XB_TMO])) break; if (sp > XB_SPIN_CAP) { atomicAdd(&bar[XB_TMO], 1u); break; } }
    }
    nloc = mine > 0u ? mine : 1u; nx = cnt > 0u ? cnt : 1u;
}

__device__ __forceinline__ void xcd_barrier(const XcdBarrier& b) {
    asm volatile("s_waitcnt vmcnt(0)" ::: "memory");
    __syncthreads();
    if (threadIdx.x == 0) {
        unsigned* bar = b.bar;
        __builtin_amdgcn_s_waitcnt(0);
        unsigned nloc = b.st[0], nx = b.st[1];
        if (nloc == 0u) { xcd_barrier_complete(bar, b.x, nloc, nx); b.st[0] = nloc; b.st[1] = nx; }
        const unsigned old = xb_add(&bar[XB_XSUB(b.x)], 1u);
        const unsigned gen = old / nloc;
        if (old + 1u == (gen + 1u) * nloc) {
            __builtin_amdgcn_fence(__ATOMIC_RELEASE, "agent");
            asm volatile("s_waitcnt vmcnt(0)" ::: "memory");
            const unsigned og = xb_add(&bar[XB_TOP], 1u);
            const unsigned tg = og / nx;
            if (og + 1u == (tg + 1u) * nx) xb_add(&bar[XB_TOPGEN], 1u);
            else XB_SPIN(xb_ld(&bar[XB_TOPGEN]) == tg, bar);
            __builtin_amdgcn_fence(__ATOMIC_ACQUIRE, "agent");
            xb_add(&bar[XB_XGEN(b.x)], 1u);
            asm volatile("s_waitcnt vmcnt(0)" ::: "memory");
        } else {
            XB_SPIN(xb_ld(&bar[XB_XGEN(b.x)]) == gen, bar);
            __builtin_amdgcn_fence(__ATOMIC_ACQUIRE, "agent");
            asm volatile("s_waitcnt vmcnt(0)" ::: "memory");
        }
    }
    __syncthreads();
}


struct Args { const float* in[24]; float* out; unsigned char* ws; int ph_lo, ph_hi; };
enum { I_X = 0, I_MEM, I_AWIN, I_ALNG, I_ALNB, I_AWS, I_ABS, I_AWOUT, I_BWIN, I_BLAM, I_BSUBG, I_BWOUT, I_WKV, I_RELB, I_MEMWKV, I_LNG, I_LNB,
       I_WG1, I_BG1, I_WG2, I_BG2, I_W1, I_W3, I_W2 };
constexpr int NPH_LAYER = 9, NPHASES = 1 + DEPTH * NPH_LAYER;

struct Frame {
    LAS unsigned char* lds; char* ldsg;
    gu32* ctl; unsigned char* ws;
    int tid, lane, wave, G, c;
};

__device__ __forceinline__ void transpose_item(const float* W, int K, int N, bf16* WT, int drow0, LAS float* scr, int k0, int n0, int lane) {
#pragma unroll 8
    for (int i = 0; i < 32; ++i) { const int kk = 2 * i + (lane >> 5); scr[kk * 33 + (lane & 31)] = W[(size_t)(k0 + kk) * N + n0 + (lane & 31)]; }
    LDS_WAIT(); asm volatile("" ::: "memory");
    const int c = lane & 7;
#pragma unroll
    for (int j = 0; j < 4; ++j) { const int n = (lane >> 3) + 8 * j; const LAS float* s = scr + (8 * c) * 33 + n;
        v4u o; o.x = pk2(s[0 * 33], s[1 * 33]); o.y = pk2(s[2 * 33], s[3 * 33]); o.z = pk2(s[4 * 33], s[5 * 33]); o.w = pk2(s[6 * 33], s[7 * 33]);
        *(GAS v4u*)(WT + (size_t)(drow0 + n) * K + k0 + 8 * c) = o; }
    LDS_WAIT(); asm volatile("" ::: "memory");
}
__device__ __forceinline__ void transpose_item_fast(const float* W, int K, int N, bf16* WT, int drow0, LAS float* scr, int k0, int n0, int lane) {
    float t[32];
#pragma unroll
    for (int i = 0; i < 32; ++i) t[i] = W[(size_t)(k0 + 2 * i + (lane >> 5)) * N + n0 + (lane & 31)];
#pragma unroll
    for (int i = 0; i < 32; i += 8) asm volatile("" : "+v"(t[i]), "+v"(t[i + 1]), "+v"(t[i + 2]), "+v"(t[i + 3]), "+v"(t[i + 4]), "+v"(t[i + 5]), "+v"(t[i + 6]), "+v"(t[i + 7]));
#pragma unroll
    for (int i = 0; i < 32; ++i) scr[(2 * i + (lane >> 5)) * 33 + (lane & 31)] = t[i];
    LDS_WAIT(); asm volatile("" ::: "memory");
    const int c = lane & 7;
#pragma unroll
    for (int j = 0; j < 4; ++j) { const int n = (lane >> 3) + 8 * j; const LAS float* s = scr + (8 * c) * 33 + n;
        v4u o; o.x = pk2(s[0 * 33], s[1 * 33]); o.y = pk2(s[2 * 33], s[3 * 33]); o.z = pk2(s[4 * 33], s[5 * 33]); o.w = pk2(s[6 * 33], s[7 * 33]);
        *(GAS v4u*)(WT + (size_t)(drow0 + n) * K + k0 + 8 * c) = o; }
    LDS_WAIT(); asm volatile("" ::: "memory");
}
__device__ __forceinline__ void transpose_item_fp8(const float* W, int K, int N, unsigned char* WT, int drow0, LAS float* scr, int k0, int n0, int lane) {
    float t[32];
#pragma unroll
    for (int i = 0; i < 32; ++i) t[i] = W[(size_t)(k0 + 2 * i + (lane >> 5)) * N + n0 + (lane & 31)];
#pragma unroll
    for (int i = 0; i < 32; i += 8) asm volatile("" : "+v"(t[i]), "+v"(t[i + 1]), "+v"(t[i + 2]), "+v"(t[i + 3]), "+v"(t[i + 4]), "+v"(t[i + 5]), "+v"(t[i + 6]), "+v"(t[i + 7]));
#pragma unroll
    for (int i = 0; i < 32; ++i) scr[(2 * i + (lane >> 5)) * 33 + (lane & 31)] = t[i];
    LDS_WAIT(); asm volatile("" ::: "memory");
    const int c = lane & 7;
#pragma unroll
    for (int j = 0; j < 4; ++j) { const int n = (lane >> 3) + 8 * j; const LAS float* s = scr + (8 * c) * 33 + n;
        unsigned lo = 0u, hi = 0u;
        lo = __builtin_amdgcn_cvt_pk_fp8_f32(s[0 * 33] * 64.f, s[1 * 33] * 64.f, lo, false); lo = __builtin_amdgcn_cvt_pk_fp8_f32(s[2 * 33] * 64.f, s[3 * 33] * 64.f, lo, true);
        hi = __builtin_amdgcn_cvt_pk_fp8_f32(s[4 * 33] * 64.f, s[5 * 33] * 64.f, hi, false); hi = __builtin_amdgcn_cvt_pk_fp8_f32(s[6 * 33] * 64.f, s[7 * 33] * 64.f, hi, true);
        v2u o; o.x = lo; o.y = hi; *(GAS v2u*)(WT + (size_t)(drow0 + n) * K + k0 + 8 * c) = o; }
    LDS_WAIT(); asm volatile("" ::: "memory");
}
#ifndef CDRAIN
#define CDRAIN 8
#endif
#ifndef CSRV
#define CSRV 4
#endif
#ifndef CSRVA
#define CSRVA 32
#endif
#ifndef STOPU
#define STOPU 64
#endif
#ifndef QX
#define QX 6
#endif
#ifndef QA
#define QA 14
#endif
#ifndef QM
#define QM 7
#endif
#ifndef QB
#define QB 4
#endif
constexpr int NQ = 7, MOE_ITEMS = 3 * 32 * 512;
__device__ __forceinline__ int conv_qsize(int q) { return (q & 1) ? (q == 1 ? 5632 : (q == 3 ? 7168 : 4096)) : MOE_ITEMS; }
__device__ __forceinline__ void conv_item(Frame& F, const Args& a, int q, int it) {
    LAS float* scr = (LAS float*)(F.lds + RING_OFF + F.wave * 16384);
    if (q & 1) {
        const float* src; bf16* dst; int N, r = it;
        if (q == 1) { if (r < 3584) { N = 3584; src = a.in[I_AWIN] + (size_t)2048 * 3584; dst = (bf16*)(F.ws + WS_WAIN) + (size_t)2048 * 3584; } else { r -= 3584; N = 2048; src = a.in[I_AWOUT] + (size_t)2048 * 2048; dst = (bf16*)(F.ws + WS_WAOUT) + (size_t)2048 * 2048; } }
        else if (q == 3) { if (r < 2048) { N = 2048; src = a.in[I_BWIN]; dst = (bf16*)(F.ws + WS_WBIN0); } else if ((r -= 2048) < 3072) { N = 3072; src = a.in[I_WKV]; dst = (bf16*)(F.ws + WS_WKV); } else { r -= 3072; N = 2048; src = a.in[I_BWOUT]; dst = (bf16*)(F.ws + WS_WBOUT); } }
        else { if (r < 2048) { N = 2048; src = a.in[I_BWIN] + (size_t)2048 * 2048; dst = (bf16*)(F.ws + WS_WBIN1); } else { r -= 2048; N = 2048; src = a.in[I_BWOUT] + (size_t)2048 * 2048; dst = (bf16*)(F.ws + WS_WBOUT) + (size_t)2048 * 2048; } }
        const int nblk = N / 32, kb = r / nblk, nb = r - kb * nblk;
        transpose_item_fast(src, 2048, N, dst, 32 * nb, scr, 64 * kb, 32 * nb, F.lane);
        return;
    }
    const int L = q >> 1, seg = it >> 14, r0 = it & 16383, e = r0 >> 9, r = r0 & 511, mat = L * 32 + e;
    if (seg < 2) { const int kb = r >> 4, nb = r & 15, n0 = 32 * nb;
        transpose_item_fp8(a.in[seg == 0 ? I_W1 : I_W3] + (size_t)mat * 2048 * 512, 2048, 512, (unsigned char*)(F.ws + WS_W13) + (size_t)mat * 1024 * 2048, (n0 >> 7) * 256 + (n0 & 127) + (seg == 1 ? 128 : 0), scr, 64 * kb, n0, F.lane); }
    else { const int kb = r >> 6, nb = r & 63;
        transpose_item_fp8(a.in[I_W2] + (size_t)mat * 512 * 2048, 512, 2048, (unsigned char*)(F.ws + WS_W2) + (size_t)mat * 512 * 2048, 32 * nb, scr, 64 * kb, 32 * nb, F.lane); }
}
#ifndef CDEPTH
#define CDEPTH 2
#endif
struct CDesc { const float* src; unsigned char* dst; int N, K, drow0, k0, n0, f8; };
__device__ __forceinline__ CDesc conv_desc(Frame& F, const Args& a, int q, int it) {
    CDesc d;
    if (q & 1) {
        const float* src; bf16* dst; int N, r = it;
        if (q == 1) { if (r < 3584) { N = 3584; src = a.in[I_AWIN] + (size_t)2048 * 3584; dst = (bf16*)(F.ws + WS_WAIN) + (size_t)2048 * 3584; } else { r -= 3584; N = 2048; src = a.in[I_AWOUT] + (size_t)2048 * 2048; dst = (bf16*)(F.ws + WS_WAOUT) + (size_t)2048 * 2048; } }
        else if (q == 3) { if (r < 2048) { N = 2048; src = a.in[I_BWIN]; dst = (bf16*)(F.ws + WS_WBIN0); } else if ((r -= 2048) < 3072) { N = 3072; src = a.in[I_WKV]; dst = (bf16*)(F.ws + WS_WKV); } else { r -= 3072; N = 2048; src = a.in[I_BWOUT]; dst = (bf16*)(F.ws + WS_WBOUT); } }
        else { if (r < 2048) { N = 2048; src = a.in[I_BWIN] + (size_t)2048 * 2048; dst = (bf16*)(F.ws + WS_WBIN1); } else { r -= 2048; N = 2048; src = a.in[I_BWOUT] + (size_t)2048 * 2048; dst = (bf16*)(F.ws + WS_WBOUT) + (size_t)2048 * 2048; } }
        const int nblk = N / 32, kb = r / nblk, nb = r - kb * nblk;
        d.src = src; d.dst = (unsigned char*)dst; d.N = N; d.K = 2048; d.drow0 = 32 * nb; d.k0 = 64 * kb; d.n0 = 32 * nb; d.f8 = 0; return d;
    }
    const int L = q >> 1, seg = it >> 14, r0 = it & 16383, e = r0 >> 9, r = r0 & 511, mat = L * 32 + e;
    if (seg < 2) { const int kb = r >> 4, nb = r & 15, n0 = 32 * nb;
        d.src = a.in[seg == 0 ? I_W1 : I_W3] + (size_t)mat * 2048 * 512; d.dst = (unsigned char*)(F.ws + WS_W13) + (size_t)mat * 1024 * 2048; d.N = 512; d.K = 2048;
        d.drow0 = (n0 >> 7) * 256 + (n0 & 127) + (seg == 1 ? 128 : 0); d.k0 = 64 * kb; d.n0 = n0; d.f8 = 1; }
    else { const int kb = r >> 6, nb = r & 63;
        d.src = a.in[I_W2] + (size_t)mat * 512 * 2048; d.dst = (unsigned char*)(F.ws + WS_W2) + (size_t)mat * 512 * 2048; d.N = 2048; d.K = 512; d.drow0 = 32 * nb; d.k0 = 64 * kb; d.n0 = 32 * nb; d.f8 = 1; }
    return d;
}
#ifdef CV_NT
#define CV_LD(p) __builtin_nontemporal_load(p)
#else
#define CV_LD(p) (*(p))
#endif
#define CV_LOAD(t_, d_) do { const float* p_ = (d_).src + (size_t)((d_).k0 + (F.lane >> 3)) * (d_).N + (d_).n0 + 4 * (F.lane & 7); const size_t st_ = (size_t)8 * (d_).N; \
    _Pragma("unroll") for (int i_ = 0; i_ < 8; ++i_) (t_)[i_] = CV_LD((const GAS f32x4*)(p_ + st_ * i_)); } while (0)
__device__ __forceinline__ void conv_process(Frame& F, f32x4 (&t)[8], const CDesc& d) {
    LAS float* scr = (LAS float*)(F.lds + RING_OFF + F.wave * 16384); const int lane = F.lane;
    asm volatile("" : "+v"(t[0]), "+v"(t[1]), "+v"(t[2]), "+v"(t[3]), "+v"(t[4]), "+v"(t[5]), "+v"(t[6]), "+v"(t[7]));
    { LAS float* w = scr + (lane >> 3) * 33 + 4 * (lane & 7);
#pragma unroll
      for (int i = 0; i < 8; ++i) { w[i * 8 * 33 + 0] = t[i].x; w[i * 8 * 33 + 1] = t[i].y; w[i * 8 * 33 + 2] = t[i].z; w[i * 8 * 33 + 3] = t[i].w; } }
    LDS_WAIT(); asm volatile("" ::: "memory");
    const int c = lane & 7;
    if (d.f8) {
#pragma unroll
        for (int j = 0; j < 4; ++j) { const int n = (lane >> 3) + 8 * j; const LAS float* s = scr + (8 * c) * 33 + n;
            unsigned lo = 0u, hi = 0u;
            lo = __builtin_amdgcn_cvt_pk_fp8_f32(s[0 * 33] * 64.f, s[1 * 33] * 64.f, lo, false); lo = __builtin_amdgcn_cvt_pk_fp8_f32(s[2 * 33] * 64.f, s[3 * 33] * 64.f, lo, true);
            hi = __builtin_amdgcn_cvt_pk_fp8_f32(s[4 * 33] * 64.f, s[5 * 33] * 64.f, hi, false); hi = __builtin_amdgcn_cvt_pk_fp8_f32(s[6 * 33] * 64.f, s[7 * 33] * 64.f, hi, true);
            v2u o; o.x = lo; o.y = hi; *(GAS v2u*)(d.dst + (size_t)(d.drow0 + n) * d.K + d.k0 + 8 * c) = o; }
    } else {
#pragma unroll
        for (int j = 0; j < 4; ++j) { const int n = (lane >> 3) + 8 * j; const LAS float* s = scr + (8 * c) * 33 + n;
            v4u o; o.x = pk2(s[0 * 33], s[1 * 33]); o.y = pk2(s[2 * 33], s[3 * 33]); o.z = pk2(s[4 * 33], s[5 * 33]); o.w = pk2(s[6 * 33], s[7 * 33]);
            *(GAS v4u*)((bf16*)d.dst + (size_t)(d.drow0 + n) * d.K + d.k0 + 8 * c) = o; }
    }
    LDS_WAIT(); asm volatile("" ::: "memory");
}
__device__ __forceinline__ void conv_range(Frame& F, const Args& a, int q, int first, int cnt) {
#if CDEPTH == 1
    for (int i = 0; i < cnt; ++i) conv_item(F, a, q, first + i);
#else
    f32x4 t[CDEPTH][8]; const int last = first + cnt - 1;
#pragma unroll
    for (int s = 0; s < CDEPTH - 1; ++s) { const int it = first + s < last ? first + s : last; const CDesc d = conv_desc(F, a, q, it); CV_LOAD(t[s], d); }
#pragma unroll 1
    for (int i0 = 0; i0 < cnt; i0 += CDEPTH) {
#pragma unroll
        for (int s = 0; s < CDEPTH; ++s) {
            { const int nx = first + i0 + s + CDEPTH - 1, it = nx < last ? nx : last; const CDesc d = conv_desc(F, a, q, it); CV_LOAD(t[(s + CDEPTH - 1) % CDEPTH], d); }
            asm volatile("" ::: "memory");
            if (i0 + s < cnt) { const CDesc d = conv_desc(F, a, q, first + i0 + s); conv_process(F, t[s], d); }
        }
    }
#endif
}
__device__ __forceinline__ void conv_filler(Frame& F, const Args& a, int q0, int n) {
    if (q0 >= NQ || n == 0) return;
#ifdef CONV_ALL_PRO
    return;
#endif
    LAS unsigned* bw = (LAS unsigned*)(F.lds + TAB_OFF + 384);
    __syncthreads();
    const bool drain = n < 0; const int per = drain ? CDRAIN : n; int q = q0;
    for (;;) {
        if (F.tid == 0) bw[0] = __hip_atomic_fetch_add(F.ctl + CW_CONV + 64 * q, (unsigned)(8 * per), RLX_AGENT);
        __syncthreads();
        const unsigned idx = bw[0];
        __syncthreads();
        const int qs = conv_qsize(q);
        if (idx >= (unsigned)qs) { if (drain || ++q >= NQ) break; continue; }
        { const int first = (int)idx + F.wave * per, cnt = (qs - first < per) ? qs - first : per; if (cnt > 0) conv_range(F, a, q, first, cnt); }
        if (!drain) break;
    }
}

__device__ __forceinline__ void prologue_phase(Frame& F, const Args& a) {
#ifdef TOUCH
    {
        const long nthr_ = (long)F.G * 512, gt_ = (long)F.c * 512 + F.tid; unsigned acc_ = 0u;
        for (long pg = gt_; pg < (long)(WS_END / 4096); pg += nthr_) acc_ += *(const GAS unsigned*)(F.ws + pg * 4096);
        for (long pg = gt_; pg < (long)((size_t)DEPTH * NE * D * FF * 4 / 4096); pg += nthr_) { acc_ += *(const GAS unsigned*)((const char*)a.in[I_W1] + pg * 4096); acc_ += *(const GAS unsigned*)((const char*)a.in[I_W3] + pg * 4096); acc_ += *(const GAS unsigned*)((const char*)a.in[I_W2] + pg * 4096); }
        if (acc_ == 0x12345679u) F.ctl[CW_TMO] = acc_;
    }
#endif
    LAS float* scr = (LAS float*)(F.lds + RING_OFF + F.wave * 16384);
    const int gw = F.c * NWAVES + F.wave, NGW = F.G * NWAVES;
    unsigned char* ws = F.ws;
    constexpr int S0 = 3584, S1 = 2048, S5 = 4 * 1024;
    constexpr int NITEMS = S0 + S1 + S5;
    for (int it = gw; it < NITEMS; it += NGW) {
        int r = it; const float* src; bf16* dst; int K = 2048, N;
        if (r < S0) { N = 3584; src = a.in[I_AWIN]; dst = (bf16*)(ws + WS_WAIN); }
        else if ((r -= S0) < S1) { N = 2048; src = a.in[I_AWOUT]; dst = (bf16*)(ws + WS_WAOUT); }
        else { r -= S1; const int mat = r >> 10; r &= 1023; N = 1024; src = a.in[I_MEMWKV] + (size_t)mat * K * N; dst = (bf16*)(ws + WS_WMKV) + (size_t)mat * K * N; }
        const int nblk = N / 32, kb = r / nblk, nb = r - kb * nblk;
        transpose_item_fast(src, K, N, dst, 32 * nb, scr, 64 * kb, 32 * nb, F.lane);
    }
#ifdef CONV_ALL_PRO
    for (int q = 0; q < NQ; ++q) { const int qs = conv_qsize(q); for (int it = gw * 4; it < qs; it += NGW * 4) conv_range(F, a, q, it, qs - it < 4 ? qs - it : 4); }
#endif
    const long nthr = (long)F.G * 512, gt = (long)F.c * 512 + F.tid;
    { float* wr = (float*)(ws + WS_WR);
      for (long i = gt; i < (long)DEPTH * 3 * 512 * 16 * 4; i += nthr) { const int j = (int)(i & 3), c = (int)((i >> 2) & 15), kg = (int)((i >> 6) & 511), r = (int)(i >> 15), nb = r % 3, l = r / 3;
          const int k = 4 * kg + j, o = 16 * nb + c; float v = 0.f;
          if (o < 4) v = a.in[I_WG1][((size_t)l * D + k) * 4 + o]; else if (o < 36) { const int g = (o - 4) >> 3, e = (o - 4) & 7; v = a.in[I_WG2][(((size_t)l * 4 + g) * D + k) * 8 + e]; }
          wr[i] = v; } }
    { const float* x = a.in[I_X]; bf16* xb = (bf16*)(ws + WS_XB);
      for (long i = gt; i < (long)T * D / 8; i += nthr) { const f32x4 v0 = *(const GAS f32x4*)(x + i * 8), v1 = *(const GAS f32x4*)(x + i * 8 + 4);
          v4u o; o.x = pk2(v0.x, v0.y); o.y = pk2(v0.z, v0.w); o.z = pk2(v1.x, v1.y); o.w = pk2(v1.z, v1.w); *(GAS v4u*)(xb + i * 8) = o; } }
    { const float* x = a.in[I_MEM]; bf16* xb = (bf16*)(ws + WS_MEMB);
      for (long i = gt; i < (long)MEMT * D / 8; i += nthr) { const f32x4 v0 = *(const GAS f32x4*)(x + i * 8), v1 = *(const GAS f32x4*)(x + i * 8 + 4);
          v4u o; o.x = pk2(v0.x, v0.y); o.y = pk2(v0.z, v0.w); o.z = pk2(v1.x, v1.y); o.w = pk2(v1.z, v1.w); *(GAS v4u*)(xb + i * 8) = o; } }
}

#ifndef NCVMAX
#define NCVMAX 32
#endif
#ifndef NCVATT
#define NCVATT 16
#endif
__device__ __forceinline__ int conv_servers(int nu, int G, int fin) {
    if (fin || nu <= 0) return 0;
    const int rounds = (nu + G - 1) / G, gmin = (nu + rounds - 1) / rounds; int n = G - gmin; n = n < NCVMAX ? n : NCVMAX; return n & ~7;
}
__device__ __forceinline__ void conv_done(Frame& F, int p) { __syncthreads(); if (F.tid == 0) __hip_atomic_fetch_add(F.ctl + CW_DONE + 64 * p, 1u, RLX_AGENT); }
__device__ __forceinline__ void conv_server(Frame& F, const Args& a, int p, int q0, int ncomp) {
    int q = q0;
    for (;;) {
        if (q >= NQ) break;
        unsigned idx = 0xffffffffu;
        if (F.lane == 0) { if (__hip_atomic_load(F.ctl + CW_DONE + 64 * p, RLX_AGENT) < (unsigned)ncomp) idx = __hip_atomic_fetch_add(F.ctl + CW_CONV + 64 * q, (unsigned)CSRV, RLX_AGENT); }
        idx = (unsigned)__builtin_amdgcn_readfirstlane((int)idx);
        if (idx == 0xffffffffu) break;
        const int qs = conv_qsize(q);
        if (idx >= (unsigned)qs) { ++q; continue; }
        conv_range(F, a, q, (int)idx, (qs - (int)idx < CSRV) ? qs - (int)idx : CSRV);
    }
}
__device__ __forceinline__ void conv_server_q(Frame& F, const Args& a, gu32* head, unsigned stop_at, int q0) {
    int q = q0;
    for (;;) {
        if (q >= NQ) break;
        unsigned idx = 0xffffffffu;
        if (F.lane == 0) { if (__hip_atomic_load(head, RLX_AGENT) < stop_at) idx = __hip_atomic_fetch_add(F.ctl + CW_CONV + 64 * q, (unsigned)CSRVA, RLX_AGENT); }
        idx = (unsigned)__builtin_amdgcn_readfirstlane((int)idx);
        if (idx == 0xffffffffu) break;
        const int qs = conv_qsize(q);
        if (idx >= (unsigned)qs) { ++q; continue; }
        conv_range(F, a, q, (int)idx, (qs - (int)idx < CSRVA) ? qs - (int)idx : CSRVA);
    }
}
__device__ __forceinline__ void conv_note_fin(Frame& F, int p) {
    if (blockIdx.x == 0 && F.tid == 0) { unsigned all = 1u;
        for (int q = 0; q < NQ; ++q) all &= (__hip_atomic_load(F.ctl + CW_CONV + 64 * q, RLX_AGENT) >= (unsigned)conv_qsize(q)) ? 1u : 0u;
        __hip_atomic_store(F.ctl + CW_FIN + 64 * p, all, RLX_AGENT); }
}

__device__ __forceinline__ void sgu_unit(Frame& F, const Args& a, int l, int n, int g) {
    constexpr int LDW = 136;
    LAS float* stats = (LAS float*)(F.lds); LAS bf16* Wl = (LAS bf16*)(F.lds + 1024); LAS bf16* Vt = (LAS bf16*)(F.lds + 35840);
    const bf16* z = (const bf16*)(F.ws + WS_Z); bf16* cat = (bf16*)(F.ws + WS_CAT);
    const int tok0 = n * 128;
    for (int i = 0; i < 16; ++i) { const int tk = F.wave * 16 + i; const GAS v4u* rp = (const GAS v4u*)(z + (size_t)(tok0 + tk) * NINA + MIXW) + F.lane;
        v4u w[3]; float s = 0.f;
#pragma unroll
        for (int j = 0; j < 3; ++j) { w[j] = rp[64 * j]; s += (bflo(w[j].x) + bfhi(w[j].x)) + (bflo(w[j].y) + bfhi(w[j].y)) + (bflo(w[j].z) + bfhi(w[j].z)) + (bflo(w[j].w) + bfhi(w[j].w)); }
        const float mean = wave_sum(s) * (1.f / MIXW); float q = 0.f;
#pragma unroll
        for (int j = 0; j < 3; ++j) { float d;
            d = bflo(w[j].x) - mean; q += d * d; d = bfhi(w[j].x) - mean; q += d * d; d = bflo(w[j].y) - mean; q += d * d; d = bfhi(w[j].y) - mean; q += d * d;
            d = bflo(w[j].z) - mean; q += d * d; d = bfhi(w[j].z) - mean; q += d * d; d = bflo(w[j].w) - mean; q += d * d; d = bfhi(w[j].w) - mean; q += d * d; }
        const float rstd = 1.f / sqrtf(wave_sum(q) * (1.f / MIXW) + LN_EPS);
        if (F.lane == 0) { stats[2 * tk] = mean; stats[2 * tk + 1] = rstd; } }
    { const float* wsrc = a.in[I_AWS] + ((size_t)l * 4 + g) * 128 * 128;
      for (int p = F.tid; p < 128 * 32; p += 512) { const int i = p >> 5, j4 = (p & 31) * 4; f32x4 v = *(const GAS f32x4*)(wsrc + i * 128 + j4);
          if ((j4 >> 6) > (i >> 6)) v = (f32x4){0.f, 0.f, 0.f, 0.f};
          v2u o; o.x = pk2(v.x, v.y); o.y = pk2(v.z, v.w); *(LAS v2u*)(Wl + i * LDW + j4) = o; } }
    __syncthreads();
    { const float* lg = a.in[I_ALNG] + (size_t)l * MIXW + g * 384; const float* lb = a.in[I_ALNB] + (size_t)l * MIXW + g * 384;
      for (int p = F.tid; p < 128 * 48; p += 512) { const int j = p & 127, c8 = (p >> 7) * 8;
          const v4u w = *(const GAS v4u*)(z + (size_t)(tok0 + j) * NINA + MIXW + g * 384 + c8);
          const float mean = stats[2 * j], rstd = stats[2 * j + 1];
          const f32x4 g0 = *(const GAS f32x4*)(lg + c8), g1 = *(const GAS f32x4*)(lg + c8 + 4), b0 = *(const GAS f32x4*)(lb + c8), b1 = *(const GAS f32x4*)(lb + c8 + 4);
          float v[8] = {bflo(w.x), bfhi(w.x), bflo(w.y), bfhi(w.y), bflo(w.z), bfhi(w.z), bflo(w.w), bfhi(w.w)};
          const float gg[8] = {g0.x, g0.y, g0.z, g0.w, g1.x, g1.y, g1.z, g1.w}, bb[8] = {b0.x, b0.y, b0.z, b0.w, b1.x, b1.y, b1.z, b1.w};
#pragma unroll
          for (int e = 0; e < 8; ++e) Vt[(c8 + e) * LDW + j] = (bf16)f2bf((v[e] - mean) * rstd * gg[e] + bb[e]); } }
    __syncthreads();
    const int fr = F.lane & 15, fq = F.lane >> 4;
    f32x4 acc[8][3];
#pragma unroll
    for (int mb = 0; mb < 8; ++mb)
#pragma unroll
        for (int nb = 0; nb < 3; ++nb) acc[mb][nb] = (f32x4){0.f, 0.f, 0.f, 0.f};
#pragma unroll
    for (int ks = 0; ks < 4; ++ks) { bf16x8 bfr[3];
#pragma unroll
        for (int nb = 0; nb < 3; ++nb) bfr[nb] = *(const LAS bf16x8*)(Vt + (F.wave * 48 + nb * 16 + fr) * LDW + ks * 32 + fq * 8);
#pragma unroll
        for (int mb = 0; mb < 8; ++mb) { const bf16x8 afr = *(const LAS bf16x8*)(Wl + (mb * 16 + fr) * LDW + ks * 32 + fq * 8);
#pragma unroll
            for (int nb = 0; nb < 3; ++nb) acc[mb][nb] = __builtin_amdgcn_mfma_f32_16x16x32_bf16(bfr[nb], afr, acc[mb][nb], 0, 0, 0); } }
    const float* bs = a.in[I_ABS] + ((size_t)l * 4 + g) * 128;
#pragma unroll
    for (int mb = 0; mb < 8; ++mb) { const int i = mb * 16 + fr; const float bsv = bs[i]; const size_t tk = (size_t)(tok0 + i);
#pragma unroll
        for (int nb = 0; nb < 3; ++nb) { const int c = g * 384 + F.wave * 48 + nb * 16 + 4 * fq;
            const v2u uw = *(const GAS v2u*)(z + tk * NINA + c); const f32x4 gt = acc[mb][nb] + bsv;
            v2u o; o.x = pk2(bflo(uw.x) * gt.x, bfhi(uw.x) * gt.y); o.y = pk2(bflo(uw.y) * gt.z, bfhi(uw.y) * gt.w);
            *(GAS v2u*)(cat + tk * D + c) = o; } }
    __syncthreads();
}

__device__ __forceinline__ void memattn_unit(Frame& F, int l, int hm, int qb, int ldz, int qoff) {
    const bf16* z = (const bf16*)(F.ws + WS_Z); const bf16* kv = (const bf16*)(F.ws + WS_MEMKV) + (size_t)l * 256 * 1024; bf16* cat = (bf16*)(F.ws + WS_CAT);
    att::attn_body<0>(z + (size_t)qb * 256 * ldz + qoff + hm * 128, ldz, kv + hm * 128, kv + 512 + hm * 128, 1024,
                      cat + (size_t)qb * 256 * D + MIXW + hm * 128, nullptr, D, 4, 0, nullptr, 0.f, F.ldsg);
}

__device__ __forceinline__ int t5_bucket(int rel) {
    const int a = rel < 0 ? -rel : rel; int f;
    if (a < 8) f = a; else if (a < 12) f = 8; else if (a < 16) f = 9; else if (a < 23) f = 10; else if (a < 32) f = 11; else if (a < 46) f = 12; else if (a < 64) f = 13; else if (a < 91) f = 14; else f = 15;
    return (rel > 0 ? 16 : 0) + f;
}

namespace att2 {
using att::bf16x8; using att::s16x4; using att::f32x16; using att::u32x4; using att::crow; using att::cvtpk; using att::tr_read; using att::v_rd_base;
constexpr int KT = 32, ST_K = KT * 128 * 2, ST_V = KT * 256 * 2, STAGE = 2 * ST_K + ST_V, NST = 3;
constexpr int LDS_WS = NST * STAGE, LDS_TAB = LDS_WS + 2048, LDS_UNIT = LDS_TAB + 640, LDS_END = LDS_UNIT + 16;
constexpr int NUNITS = 576;
constexpr float THR2 = 8.f * 1.4426950408889634f;
__device__ __forceinline__ int swap23(int k) { return (k & ~0xC) | ((k & 4) << 1) | ((k & 8) >> 1); }
constexpr int v_off(int d0, int ks, int half) { return d0 * 512 + ks * 8192 + half * 4096; }

struct UnitTable { unsigned short u[NUNITS]; };
constexpr UnitTable make_units() {
    UnitTable t{}; int n = 0;
    for (int c = 256; c >= 4; c -= 2) {
        { const int b = (c - 2) / 2; if ((c - 2) % 2 == 0 && b >= 32 && b <= 63) for (int part = 1; part <= 2; ++part) for (int h = 0; h < 6; ++h) t.u[n++] = (unsigned short)(h | (b << 3) | (part << 9)); }
        if (c % 4 == 0) { const int b = c / 4 - 1; if (b >= 0 && b < 32) for (int h = 0; h < 6; ++h) t.u[n++] = (unsigned short)(h | (b << 3)); }
    }
    return t;
}
__device__ const UnitTable g_units = make_units();

__device__ __forceinline__ void diff_unit(const bf16* __restrict__ Q, const bf16* __restrict__ KD, const bf16* __restrict__ VD, float* Obuf  , int orow0,
                                          float* ML  , const float* relb, int h, int b, int t_lo, int t_hi, LAS char* lds) {
  int tid_ = threadIdx.x; asm volatile("" : "+v"(tid_));
  const int tid = tid_, wid = __builtin_amdgcn_readfirstlane(tid >> 6), lane = tid & 63, r32 = lane & 31, hi = lane >> 5, m = wid >> 2, rg = wid & 3;
  LAS float* wsw = (LAS float*)(lds + LDS_WS) + wid * 64; LAS float* li_l = wsw; LAS float* al_l = wsw + 32;
  LAS float* tab = (LAS float*)(lds + LDS_TAB);
  if (tid < att::TAB_N) tab[tid] = relb[t5_bucket(63 - tid) * 6 + h] * LOG2E;
  const float cfar = relb[15 * 6 + h] * LOG2E;
  const int qrow0 = b * 128 + rg * 32;
  bf16x8 qr[8];
  { const bf16* Qw = Q + (size_t)(qrow0 + r32) * 2048 + h * 256 + m * 128 + hi * 8;
#pragma unroll
    for (int d0 = 0; d0 < 8; ++d0) qr[d0] = *reinterpret_cast<const bf16x8*>(Qw + d0 * 16); }
  int ko[2], vo[2];
#pragma unroll
  for (int i = 0; i < 2; ++i) {
    const int p = wid * 64 + lane, row = p >> 4, cp = (p & 15) ^ (row & 7); ko[i] = row * 1536 + h * 256 + i * 128 + cp * 8; }
#pragma unroll
  for (int i = 0; i < 2; ++i) {
    const int p = (wid * 2 + i) * 64 + lane, sub = p >> 5, kg = sub >> 3, cblk = sub & 7, q = p & 31, kk = kg * 8 + (q >> 2), key = swap23(kk);
    vo[i] = key * 1536 + h * 256 + cblk * 32 + (q & 3) * 8; }
  const unsigned ldsb = (unsigned)(uintptr_t)lds;
#define A2_ISSUE(t, s) do { const size_t kb_ = (size_t)(t) * KT * 1536; LAS char* sb_ = lds + (s) * STAGE; \
    __builtin_amdgcn_global_load_lds((const unsigned*)(KD + kb_ + ko[0]), (LAS unsigned*)(sb_ + wid * 1024), 16, 0, 0); \
    __builtin_amdgcn_global_load_lds((const unsigned*)(KD + kb_ + ko[1]), (LAS unsigned*)(sb_ + ST_K + wid * 1024), 16, 0, 0); \
    __builtin_amdgcn_global_load_lds((const unsigned*)(VD + kb_ + vo[0]), (LAS unsigned*)(sb_ + 2 * ST_K + (wid * 2) * 1024), 16, 0, 0); \
    __builtin_amdgcn_global_load_lds((const unsigned*)(VD + kb_ + vo[1]), (LAS unsigned*)(sb_ + 2 * ST_K + (wid * 2 + 1) * 1024), 16, 0, 0); } while (0)
  const int vis = 2 * (2 * b + (rg >> 1) + 1);
  float m_reg = -1e30f, l_reg = 0.f; f32x16 o[8];
#pragma unroll
  for (int d = 0; d < 8; ++d) o[d] = f32x16{};
  asm volatile("s_waitcnt vmcnt(0)" ::: "memory");
  A2_ISSUE(t_lo, 0); if (t_lo + 1 < t_hi) A2_ISSUE(t_lo + 1, 1);
  int s = 0;
  for (int t = t_lo; t < t_hi; ++t) {
    if (t + 1 < t_hi) asm volatile("s_waitcnt vmcnt(4) lgkmcnt(0)" ::: "memory"); else asm volatile("s_waitcnt vmcnt(0) lgkmcnt(0)" ::: "memory");
    __builtin_amdgcn_s_barrier(); asm volatile("" ::: "memory");
    if (t + 2 < t_hi) { const int s2 = (s >= 1) ? s - 1 : s + 2; A2_ISSUE(t + 2, s2); }
    if (t < vis) {
      const LAS char* Ks = lds + s * STAGE + m * ST_K;
      f32x16 p = f32x16{};
#pragma unroll
      for (int d0 = 0; d0 < 8; ++d0) { const int cb = (d0 * 16 + hi * 8) * 2;
        const bf16x8 b0 = *(const LAS bf16x8*)(Ks + KSWZ(r32, cb));
        p = __builtin_amdgcn_mfma_f32_32x32x16_bf16(b0, qr[d0], p, 0, 0, 0); }
      if (qrow0 - (KT * t + KT - 1) >= 91) {
#pragma unroll
        for (int r = 0; r < 16; ++r) p[r] += cfar;
      } else { const int base = qrow0 + r32 - KT * t + 63;
#pragma unroll
        for (int r = 0; r < 16; ++r) { const int i0 = base - crow(r, hi); p[r] += tab[i0 < att::TAB_N - 1 ? i0 : att::TAB_N - 1]; } }
      float pmax = p[0];
#pragma unroll
      for (int r = 1; r < 16; ++r) pmax = fmaxf(pmax, p[r]);
      { auto rr = __builtin_amdgcn_permlane32_swap(__float_as_uint(pmax), __float_as_uint(pmax), false, false); pmax = fmaxf(__uint_as_float(rr[0]), __uint_as_float(rr[1])); }
      float mn, alpha;
      if (__builtin_expect(__all(pmax - m_reg <= THR2), 1)) { mn = m_reg; alpha = 1.f; }
      else { mn = fmaxf(m_reg, pmax); alpha = __builtin_amdgcn_exp2f(m_reg - mn); m_reg = mn; }
      float ps = 0.f;
#pragma unroll
      for (int r = 0; r < 16; ++r) { p[r] = __builtin_amdgcn_exp2f(p[r] - mn); ps += p[r]; }
      { auto rr = __builtin_amdgcn_permlane32_swap(__float_as_uint(ps), __float_as_uint(ps), false, false); ps = __uint_as_float(rr[0]) + __uint_as_float(rr[1]); }
      l_reg = l_reg * alpha + ps;
      bf16x8 pa0, pa1;
#define A2_PK4(P, BASE, OUT) do { unsigned a0 = cvtpk(P[BASE + 0], P[BASE + 1]), a1 = cvtpk(P[BASE + 2], P[BASE + 3]);   \
    unsigned b0_ = cvtpk(P[BASE + 4], P[BASE + 5]), b1_ = cvtpk(P[BASE + 6], P[BASE + 7]);                              \
    auto r0 = __builtin_amdgcn_permlane32_swap(a0, b0_, false, false); auto r1 = __builtin_amdgcn_permlane32_swap(a1, b1_, false, false); \
    u32x4 w = {r0[0], r1[0], r0[1], r1[1]}; OUT = *reinterpret_cast<bf16x8*>(&w); } while (0)
      A2_PK4(p, 0, pa0); A2_PK4(p, 8, pa1);
      if (__any(alpha < 1.f)) { if (hi == 0) al_l[r32] = alpha; asm volatile("s_waitcnt lgkmcnt(0)" ::: "memory");
#pragma unroll
        for (int d = 0; d < 8; ++d)
#pragma unroll
          for (int r = 0; r < 16; ++r) o[d][r] *= al_l[crow(r, hi)]; }
      const int vb = (int)(ldsb + s * STAGE + 2 * ST_K) + v_rd_base(lane);
      asm volatile("s_waitcnt lgkmcnt(0)" ::: "memory"); SBAR();
#define A2_PK(L, H) (bf16x8){L[0], L[1], L[2], L[3], H[0], H[1], H[2], H[3]}
#define A2_RD(D0, l0, h0, l1, h1) do { l0 = tr_read<v_off(D0, 0, 0)>(vb); h0 = tr_read<v_off(D0, 0, 1)>(vb); l1 = tr_read<v_off(D0, 1, 0)>(vb); h1 = tr_read<v_off(D0, 1, 1)>(vb); } while (0)
#define A2_MM(D0, l0, h0, l1, h1) do { o[D0] = __builtin_amdgcn_mfma_f32_32x32x16_bf16(pa0, A2_PK(l0, h0), o[D0], 0, 0, 0); o[D0] = __builtin_amdgcn_mfma_f32_32x32x16_bf16(pa1, A2_PK(l1, h1), o[D0], 0, 0, 0); } while (0)
      s16x4 xl0, xh0, xl1, xh1, yl0, yh0, yl1, yh1;
      A2_RD(0, xl0, xh0, xl1, xh1);
      A2_RD(1, yl0, yh0, yl1, yh1); asm volatile("s_waitcnt lgkmcnt(4)" ::: "memory"); SBAR(); A2_MM(0, xl0, xh0, xl1, xh1); SBAR();
      A2_RD(2, xl0, xh0, xl1, xh1); asm volatile("s_waitcnt lgkmcnt(4)" ::: "memory"); SBAR(); A2_MM(1, yl0, yh0, yl1, yh1); SBAR();
      A2_RD(3, yl0, yh0, yl1, yh1); asm volatile("s_waitcnt lgkmcnt(4)" ::: "memory"); SBAR(); A2_MM(2, xl0, xh0, xl1, xh1); SBAR();
      A2_RD(4, xl0, xh0, xl1, xh1); asm volatile("s_waitcnt lgkmcnt(4)" ::: "memory"); SBAR(); A2_MM(3, yl0, yh0, yl1, yh1); SBAR();
      A2_RD(5, yl0, yh0, yl1, yh1); asm volatile("s_waitcnt lgkmcnt(4)" ::: "memory"); SBAR(); A2_MM(4, xl0, xh0, xl1, xh1); SBAR();
      A2_RD(6, xl0, xh0, xl1, xh1); asm volatile("s_waitcnt lgkmcnt(4)" ::: "memory"); SBAR(); A2_MM(5, yl0, yh0, yl1, yh1); SBAR();
      A2_RD(7, yl0, yh0, yl1, yh1); asm volatile("s_waitcnt lgkmcnt(4)" ::: "memory"); SBAR(); A2_MM(6, xl0, xh0, xl1, xh1); SBAR();
      asm volatile("s_waitcnt lgkmcnt(0)" ::: "memory"); SBAR(); A2_MM(7, yl0, yh0, yl1, yh1); SBAR();
    }
    s = (s == 2) ? 0 : s + 1;
  }
  if (hi == 0) li_l[r32] = l_reg; asm volatile("s_waitcnt lgkmcnt(0)" ::: "memory");
  float rli[16];
#pragma unroll
  for (int r = 0; r < 16; ++r) rli[r] = __builtin_amdgcn_rcpf(li_l[crow(r, hi)]);
  float* Ow = Obuf + (size_t)(qrow0 - orow0) * 3072 + (h * 2 + m) * 256;
#pragma unroll
  for (int r = 0; r < 16; ++r) { const int orow = crow(r, hi);
#pragma unroll
    for (int d0 = 0; d0 < 8; ++d0) Ow[(size_t)orow * 3072 + d0 * 32 + r32] = o[d0][r] * rli[r]; }
  if (hi == 0) { float* mlp = ML + (((size_t)(qrow0 - orow0 + r32) * 6 + h) * 2 + m) * 2; mlp[0] = m_reg; mlp[1] = l_reg; }
  asm volatile("s_waitcnt vmcnt(0) lgkmcnt(0)" ::: "memory");
  __builtin_amdgcn_s_barrier(); asm volatile("" ::: "memory");
#undef A2_ISSUE
#undef A2_PK4
#undef A2_PK
#undef A2_RD
#undef A2_MM
}
}

__device__ __forceinline__ void diffattn2_unit(Frame& F, const Args& a, unsigned code) {
    const int h = code & 7, b = (code >> 3) & 63, pc = code >> 9, nt = 4 * b + 4;
    const int t_lo = (pc == 2) ? nt / 2 : 0, t_hi = (pc == 1) ? nt / 2 : nt;
    float* ob = (float*)(F.ws + (pc == 2 ? WS_OP2 : WS_OP)); float* ml = (float*)(F.ws + WS_ML) + (pc == 2 ? (size_t)T * 6 * 2 * 2 : 0);
    att2::diff_unit((const bf16*)(F.ws + WS_Z), (const bf16*)(F.ws + WS_KD), (const bf16*)(F.ws + WS_VD), ob, pc == 2 ? 4096 : 0, ml, a.in[I_RELB], h, b, t_lo, t_hi, (LAS char*)F.lds);
}
__device__ __forceinline__ void diffcombine_phase(Frame& F, const Args& a, int l) {
    const int i = l - 2; const float* lp = a.in[I_BLAM] + (size_t)i * 4 * 128;
    float s1 = lp[F.lane] * lp[128 + F.lane] + lp[64 + F.lane] * lp[128 + 64 + F.lane], s2 = lp[256 + F.lane] * lp[384 + F.lane] + lp[256 + 64 + F.lane] * lp[384 + 64 + F.lane];
    s1 = wave_sum(s1); s2 = wave_sum(s2);
    const float lam_init = 0.8f - 0.6f * expf(-0.3f * (float)l);
    const float lam = expf(s1) - expf(s2) + lam_init;
    const float* op0 = (const float*)(F.ws + WS_OP); const float* op1 = (const float*)(F.ws + WS_OP2); const float* ml0 = (const float*)(F.ws + WS_ML); const float* ml1 = ml0 + (size_t)T * 6 * 2 * 2;
    bf16* cat = (bf16*)(F.ws + WS_CAT);
    const f32x4 gsub = *(const GAS f32x4*)(a.in[I_BSUBG] + (size_t)i * 256 + 4 * F.lane);
    const int gw = F.c * NWAVES + F.wave, NGW = F.G * NWAVES;
    for (int it = gw; it < T * 6; it += NGW) { const int tk = it / 6, h = it - tk * 6; f32x4 os[2];
#pragma unroll
        for (int m = 0; m < 2; ++m) { const size_t r0 = ((size_t)tk * 6 + h) * 2 + m; f32x4 oa = *(const GAS f32x4*)(op0 + r0 * 256 + 4 * F.lane);
            if (tk >= 4096) { const size_t r1 = ((size_t)(tk - 4096) * 6 + h) * 2 + m; const f32x4 ob = *(const GAS f32x4*)(op1 + r1 * 256 + 4 * F.lane);
                const float ma = ml0[r0 * 2], la = ml0[r0 * 2 + 1], mb = ml1[r1 * 2], lb = ml1[r1 * 2 + 1], M = fmaxf(ma, mb);
                const float wa = la * exp2f(ma - M), wb = lb * exp2f(mb - M), inv = 1.f / (wa + wb); oa = oa * (wa * inv) + ob * (wb * inv); }
            os[m] = oa; }
        const f32x4 o = os[0] - os[1] * lam; const float ss = wave_sum((o.x * o.x + o.y * o.y) + (o.z * o.z + o.w * o.w));
        const float r = (1.f - lam_init) / sqrtf(ss * (1.f / 256.f) + LN_EPS);
        v2u w; w.x = pk2(o.x * r * gsub.x, o.y * r * gsub.y); w.y = pk2(o.z * r * gsub.z, o.w * r * gsub.w);
        *(GAS v2u*)(cat + (size_t)tk * D + h * 256 + 4 * F.lane) = w; }
}


__device__ __forceinline__ void ln1_router_phase(Frame& F, const Args& a, int l, int probe = 0) {
    const bf16* y = (const bf16*)(F.ws + WS_Y); bf16* x1b = (bf16*)(F.ws + WS_X1B);
    const float* lng = a.in[I_LNG] + ((size_t)l * 2 + 0) * D; const float* lnb = a.in[I_LNB] + ((size_t)l * 2 + 0) * D;
    const float* wr = (const float*)(F.ws + WS_WR) + (size_t)l * 3 * 512 * 16 * 4;
    int* tok_e = (int*)(F.ws + (probe ? WS_OP : WS_ROUTE)); int* tok_rank = tok_e + 2 * T; float* tok_gate = (float*)(tok_rank + 2 * T);
    gu32* cnt = F.ctl + (probe ? 65536 : CW_CNT) + 2048 * l;
    LAS float* P = (LAS float*)(F.lds);
    typedef float f32x4v __attribute__((ext_vector_type(4)));
    for (int tb = F.c; tb < T / 32; tb += F.G) {
#pragma unroll 2
        for (int i = 0; i < 4; ++i) { const int tk = tb * 32 + F.wave * 4 + i;
            const GAS v4u* yr = (const GAS v4u*)(y + (size_t)tk * D) + F.lane;
            float v[4][8]; float s = 0.f;
#pragma unroll
            for (int j = 0; j < 4; ++j) { const v4u w = yr[64 * j]; v[j][0] = bflo(w.x); v[j][1] = bfhi(w.x); v[j][2] = bflo(w.y); v[j][3] = bfhi(w.y); v[j][4] = bflo(w.z); v[j][5] = bfhi(w.z); v[j][6] = bflo(w.w); v[j][7] = bfhi(w.w);
#pragma unroll
                for (int e = 0; e < 8; ++e) s += v[j][e]; }
            const float mean = wave_sum(s) * (1.f / D); float s2 = 0.f;
#pragma unroll
            for (int j = 0; j < 4; ++j)
#pragma unroll
                for (int e = 0; e < 8; ++e) { v[j][e] -= mean; s2 += v[j][e] * v[j][e]; }
            const float rstd = 1.f / sqrtf(wave_sum(s2) * (1.f / D) + LN_EPS);
#pragma unroll
            for (int j = 0; j < 4; ++j) { const int d0 = 8 * F.lane + 512 * j; const f32x4 g0 = *(const GAS f32x4*)(lng + d0), g1 = *(const GAS f32x4*)(lng + d0 + 4), b0 = *(const GAS f32x4*)(lnb + d0), b1 = *(const GAS f32x4*)(lnb + d0 + 4);
                const float q0 = v[j][0] * rstd * g0.x + b0.x, q1 = v[j][1] * rstd * g0.y + b0.y, q2 = v[j][2] * rstd * g0.z + b0.z, q3 = v[j][3] * rstd * g0.w + b0.w;
                const float q4 = v[j][4] * rstd * g1.x + b1.x, q5 = v[j][5] * rstd * g1.y + b1.y, q6 = v[j][6] * rstd * g1.z + b1.z, q7 = v[j][7] * rstd * g1.w + b1.w;
                v4u w; w.x = pk2(q0, q1); w.y = pk2(q2, q3); w.z = pk2(q4, q5); w.w = pk2(q6, q7);
                *(GAS v4u*)(x1b + (size_t)tk * D + d0) = w;
                unsigned lo = 0u, hi = 0u; lo = __builtin_amdgcn_cvt_pk_fp8_f32(q0, q1, lo, false); lo = __builtin_amdgcn_cvt_pk_fp8_f32(q2, q3, lo, true);
                hi = __builtin_amdgcn_cvt_pk_fp8_f32(q4, q5, hi, false); hi = __builtin_amdgcn_cvt_pk_fp8_f32(q6, q7, hi, true);
                v2u qq; qq.x = lo; qq.y = hi; *(GAS v2u*)((unsigned char*)(F.ws + WS_X1F) + (size_t)tk * D + d0) = qq; } }
        VM_WAIT(); __syncthreads();
        { const int mt = F.wave >> 2, kq = F.wave & 3, c = F.lane & 15, q = F.lane >> 4;
          const bf16* ap = x1b + (size_t)(tb * 32 + mt * 16 + c) * D + kq * 512 + 4 * q;
          const float* bp = wr + ((size_t)(kq * 128 + q) * 16 + c) * 4;
          f32x4v acc[3] = {{0.f, 0.f, 0.f, 0.f}, {0.f, 0.f, 0.f, 0.f}, {0.f, 0.f, 0.f, 0.f}};
#pragma unroll 4
          for (int ks = 0; ks < 32; ++ks) { const v2u aw = *(const GAS v2u*)(ap + 16 * ks); const f32x4 a4 = (f32x4){bflo(aw.x), bfhi(aw.x), bflo(aw.y), bfhi(aw.y)}; f32x4 b4[3];
#pragma unroll
              for (int nb = 0; nb < 3; ++nb) b4[nb] = *(const GAS f32x4*)(bp + ((size_t)nb * 512 + 4 * ks) * 64);
#pragma unroll
              for (int j = 0; j < 4; ++j)
#pragma unroll
                  for (int nb = 0; nb < 3; ++nb) acc[nb] = __builtin_amdgcn_mfma_f32_16x16x4f32(a4[j], b4[nb][j], acc[nb], 0, 0, 0); }
#pragma unroll
          for (int nb = 0; nb < 3; ++nb)
#pragma unroll
              for (int r = 0; r < 4; ++r) P[((kq * 2 + mt) * 16 + 4 * q + r) * 48 + nb * 16 + c] = acc[nb][r]; }
        __syncthreads();
        if (F.tid < 32) { const int tk = tb * 32 + F.tid, mt = F.tid >> 4, ti = F.tid & 15;
            const LAS f32x4* P4 = (const LAS f32x4*)P;
            const int rb = (mt * 16 + ti) * 12;
            const float* bg1 = a.in[I_BG1] + l * 4; const float* bg2 = a.in[I_BG2] + l * 32;
            const f32x4 s1 = (P4[rb] + P4[rb + 384]) + (P4[rb + 768] + P4[rb + 1152]);
            const float l10 = s1.x + bg1[0], l11 = s1.y + bg1[1], l12 = s1.z + bg1[2], l13 = s1.w + bg1[3];
            int grp = 0; float mx = l10;
            if (l11 > mx) { mx = l11; grp = 1; } if (l12 > mx) { mx = l12; grp = 2; } if (l13 > mx) { mx = l13; grp = 3; }
            const float psel = 1.f / (expf(l10 - mx) + expf(l11 - mx) + expf(l12 - mx) + expf(l13 - mx));
            const int ob = rb + 1 + 2 * grp;
            const f32x4 sa = (P4[ob] + P4[ob + 384]) + (P4[ob + 768] + P4[ob + 1152]), sb = (P4[ob + 1] + P4[ob + 385]) + (P4[ob + 769] + P4[ob + 1153]);
            const f32x4 ba = *(const GAS f32x4*)(bg2 + grp * 8), bb = *(const GAS f32x4*)(bg2 + grp * 8 + 4);
            const float l2[8] = {sa.x + ba.x, sa.y + ba.y, sa.z + ba.z, sa.w + ba.w, sb.x + bb.x, sb.y + bb.y, sb.z + bb.z, sb.w + bb.w};
            int i0 = 0; float v0 = l2[0];
#pragma unroll
            for (int e = 1; e < 8; ++e) if (l2[e] > v0) { v0 = l2[e]; i0 = e; }
            int i1 = -1; float v1 = -INFINITY;
#pragma unroll
            for (int e = 0; e < 8; ++e) if (e != i0 && l2[e] > v1) { v1 = l2[e]; i1 = e; }
            const float e1 = expf(v1 - v0), g0 = psel / (1.f + e1), g1 = psel * e1 / (1.f + e1);
            const int ex0 = grp * 8 + i0, ex1 = grp * 8 + i1;
            const unsigned r0 = __hip_atomic_fetch_add(cnt + 64 * ex0, 1u, RLX_AGENT), r1 = __hip_atomic_fetch_add(cnt + 64 * ex1, 1u, RLX_AGENT);
            { int* list = (int*)(F.ws + (probe ? WS_OP + 2 * MiB : WS_LIST)); list[ex0 * 8192 + (int)r0] = tk; list[ex1 * 8192 + (int)r1] = tk; }
            tok_e[2 * tk] = ex0; tok_e[2 * tk + 1] = ex1; tok_rank[2 * tk] = (int)r0; tok_rank[2 * tk + 1] = (int)r1; tok_gate[2 * tk] = g0; tok_gate[2 * tk + 1] = g1; }
        __syncthreads();
    }
}
__device__ __forceinline__ void moe_table(Frame& F, int l) {
    LAS int* tstart = (LAS int*)(F.lds + TAB_OFF);
    if (F.tid == 0) { int acc = 0;
        for (int e = 0; e < 32; ++e) { tstart[e] = acc; const unsigned c = __hip_atomic_load(F.ctl + CW_CNT + 2048 * l + 64 * e, RLX_AGENT); tstart[36 + e] = (int)c; acc += (int)((c + 255u) >> 8); }
        tstart[32] = acc; }
    __syncthreads();
}
__device__ __forceinline__ void ln2_phase(Frame& F, const Args& a, int l) {
    const bf16* x1b = (const bf16*)(F.ws + WS_X1B); const bf16* yb = (const bf16*)(F.ws + WS_YB); bf16* xb = (bf16*)(F.ws + WS_XB);
    const float* lng = a.in[I_LNG] + ((size_t)l * 2 + 1) * D; const float* lnb = a.in[I_LNB] + ((size_t)l * 2 + 1) * D;
    moe_table(F, l); const LAS int* tstart = (const LAS int*)(F.lds + TAB_OFF);
    const int* tok_e = (const int*)(F.ws + WS_ROUTE); const int* tok_rank = tok_e + 2 * T; const float* tok_gate = (const float*)(F.ws + WS_ROUTE) + 4 * T;
    const int gw = F.c * NWAVES + F.wave, NGW = F.G * NWAVES;
    for (int t4 = gw; t4 < T / 4; t4 += NGW) { const int tk0 = t4 * 4;
        int ev = 0, rv = 0; float gv = 0.f;
        if (F.lane < 8) { ev = tok_e[2 * tk0 + F.lane]; rv = tok_rank[2 * tk0 + F.lane]; gv = tok_gate[2 * tk0 + F.lane]; }
        const int slotv = (F.lane < 8) ? tstart[ev] * 256 + rv : 0;
        v4u xr[2], ya[2], yc[2]; v4u xr2[2], ya2[2], yc2[2];
#define LN2_LOAD(i, XR, YA, YC, XR2, YA2, YC2) do { const int s0_ = __builtin_amdgcn_readlane(slotv, 2 * (i)), s1_ = __builtin_amdgcn_readlane(slotv, 2 * (i) + 1); \
        _Pragma("unroll") for (int j = 0; j < 2; ++j) { const int d0 = 8 * F.lane + 512 * j; XR[j] = *(const GAS v4u*)(x1b + (size_t)(tk0 + (i)) * D + d0); YA[j] = *(const GAS v4u*)(yb + (size_t)s0_ * D + d0); YC[j] = *(const GAS v4u*)(yb + (size_t)s1_ * D + d0); } \
        _Pragma("unroll") for (int j = 0; j < 2; ++j) { const int d0 = 8 * F.lane + 512 * (j + 2); XR2[j] = *(const GAS v4u*)(x1b + (size_t)(tk0 + (i)) * D + d0); YA2[j] = *(const GAS v4u*)(yb + (size_t)s0_ * D + d0); YC2[j] = *(const GAS v4u*)(yb + (size_t)s1_ * D + d0); } } while (0)
        LN2_LOAD(0, xr, ya, yc, xr2, ya2, yc2);
#pragma unroll
        for (int i = 0; i < 4; ++i) { const int tk = tk0 + i;
            const float g0 = __builtin_bit_cast(float, __builtin_amdgcn_readlane(__builtin_bit_cast(int, gv), 2 * i)), g1 = __builtin_bit_cast(float, __builtin_amdgcn_readlane(__builtin_bit_cast(int, gv), 2 * i + 1));
            float v[4][8]; float s = 0.f;
#pragma unroll
            for (int j = 0; j < 4; ++j) { const v4u X = j < 2 ? xr[j] : xr2[j - 2], A = j < 2 ? ya[j] : ya2[j - 2], C = j < 2 ? yc[j] : yc2[j - 2];
                v[j][0] = bflo(X.x) * DN_ALPHA + (g0 * bflo(A.x) + g1 * bflo(C.x)); v[j][1] = bfhi(X.x) * DN_ALPHA + (g0 * bfhi(A.x) + g1 * bfhi(C.x));
                v[j][2] = bflo(X.y) * DN_ALPHA + (g0 * bflo(A.y) + g1 * bflo(C.y)); v[j][3] = bfhi(X.y) * DN_ALPHA + (g0 * bfhi(A.y) + g1 * bfhi(C.y));
                v[j][4] = bflo(X.z) * DN_ALPHA + (g0 * bflo(A.z) + g1 * bflo(C.z)); v[j][5] = bfhi(X.z) * DN_ALPHA + (g0 * bfhi(A.z) + g1 * bfhi(C.z));
                v[j][6] = bflo(X.w) * DN_ALPHA + (g0 * bflo(A.w) + g1 * bflo(C.w)); v[j][7] = bfhi(X.w) * DN_ALPHA + (g0 * bfhi(A.w) + g1 * bfhi(C.w));
#pragma unroll
                for (int e = 0; e < 8; ++e) s += v[j][e]; }
            if (i + 1 < 4) LN2_LOAD(i + 1, xr, ya, yc, xr2, ya2, yc2);
            const float mean = wave_sum(s) * (1.f / D); float s2 = 0.f;
#pragma unroll
            for (int j = 0; j < 4; ++j)
#pragma unroll
                for (int e = 0; e < 8; ++e) { v[j][e] -= mean; s2 += v[j][e] * v[j][e]; }
            const float rstd = 1.f / sqrtf(wave_sum(s2) * (1.f / D) + LN_EPS);
#pragma unroll
            for (int j = 0; j < 4; ++j) { const int d0 = 8 * F.lane + 512 * j; const f32x4 g0v = *(const GAS f32x4*)(lng + d0), g1v = *(const GAS f32x4*)(lng + d0 + 4), b0 = *(const GAS f32x4*)(lnb + d0), b1 = *(const GAS f32x4*)(lnb + d0 + 4);
                const f32x4 oa = (f32x4){v[j][0] * rstd * g0v.x + b0.x, v[j][1] * rstd * g0v.y + b0.y, v[j][2] * rstd * g0v.z + b0.z, v[j][3] * rstd * g0v.w + b0.w};
                const f32x4 ob = (f32x4){v[j][4] * rstd * g1v.x + b1.x, v[j][5] * rstd * g1v.y + b1.y, v[j][6] * rstd * g1v.z + b1.z, v[j][7] * rstd * g1v.w + b1.w};
                if (l == DEPTH - 1) { *(GAS f32x4*)(a.out + (size_t)tk * D + d0) = oa; *(GAS f32x4*)(a.out + (size_t)tk * D + d0 + 4) = ob; }
                else { v4u w; w.x = pk2(oa.x, oa.y); w.y = pk2(oa.z, oa.w); w.z = pk2(ob.x, ob.y); w.w = pk2(ob.z, ob.w); *(GAS v4u*)(xb + (size_t)tk * D + d0) = w; } }
        }
#undef LN2_LOAD
    }
}

__global__ void __launch_bounds__(NWAVES * 64, 2) fwd_kernel(Args args) {
    extern __shared__ __attribute__((aligned(16))) unsigned char lds[];
    Frame F;
    F.lds = (LAS unsigned char*)lds; F.ldsg = (char*)lds;
    F.tid = threadIdx.x; F.lane = F.tid & 63; F.wave = __builtin_amdgcn_readfirstlane(F.tid >> 6);
    F.G = gridDim.x; F.c = blockIdx.x; F.ws = args.ws; F.ctl = (gu32*)(args.ws + WS_CTL);
    volatile LAS unsigned* MISC = (volatile LAS unsigned*)(F.lds + MISC_OFF);
    for (int u = F.tid; u < (LDS_BYTES - LDSCTL_OFF) / 4; u += NWAVES * 64) ((LAS unsigned*)(F.lds + LDSCTL_OFF))[u] = 0u;
    __syncthreads();
    const int lo = args.ph_lo, hi = args.ph_hi; int lastp = -1;
    const bool multi = (hi - lo) > 1;
    XcdBarrier bar; bar.bar = (unsigned*)(F.ctl + CW_BAR); bar.x = 0; bar.st = nullptr;
    if (multi) bar = xcd_barrier_post((unsigned*)(F.ctl + CW_BAR), MISC + 8);
#ifndef REP_MASK
#define REP_MASK 0
#endif
#define REP(k) for (int rep_ = 0; rep_ <= ((REP_MASK >> (k)) & 1); ++rep_)
#define IN(p) (lo <= (p) && (p) < hi)
#ifdef PROBE_A
#define STAMP(i) do { if (blockIdx.x == 0 && threadIdx.x == 0) ((unsigned long long*)(args.ws + WS_TS))[(i)] = __builtin_amdgcn_s_memrealtime(); } while (0)
#else
#define STAMP(i) do { } while (0)
#endif
#define SEAM(p) do { conv_note_fin(F, (p)); lastp = (p); if ((p) + 1 < hi) xcd_barrier(bar); STAMP((p) + 1); } while (0)
#define CONVFIN() ((lastp >= 0) ? (int)__hip_atomic_load(F.ctl + CW_FIN + 64 * lastp, RLX_AGENT) : 0)
#define FRESH() do { int t_ = threadIdx.x; asm volatile("" : "+v"(t_)); F.tid = t_; F.lane = t_ & 63; F.wave = __builtin_amdgcn_readfirstlane(t_ >> 6); \
    GAS unsigned char* w_ = (GAS unsigned char*)args.ws; asm volatile("" : "+s"(w_)); F.ws = (unsigned char*)w_; F.ctl = (gu32*)(w_ + WS_CTL); } while (0)

    STAMP(0);
    if (IN(0)) { FRESH(); REP(9) prologue_phase(F, args); SEAM(0); }
#ifdef XBAR
    for (int xb_ = 0; xb_ < XBAR; ++xb_) xcd_barrier(bar);
#endif

    for (int l = 0; l < DEPTH; ++l) {
        const int pb = 1 + NPH_LAYER * l;
        if (IN(pb + 0)) { FRESH();
            const int N = (l < 2) ? NINA : (l == 2 ? 5120 : 2048);
            const unsigned char* Bt = F.ws + ((l < 2) ? WS_WAIN + (size_t)l * NINA * D * 2 : (l == 2 ? WS_WBIN0 : WS_WBIN1));
            const int nu = (T / 256) * (N / 256) + (l == 0 ? 16 : 0), ncv = conv_servers(nu, F.G, CONVFIN()), Gc = F.G - ncv;
            if (F.c < Gc) {
                pg8::Gemm g{nullptr, nullptr, T, N, D}; pg8::DualOrder S; S.init(F.ws + WS_XB, Bt, T, N, D, Gc, F.c, F.ws + WS_MEMB, F.ws + WS_WMKV, l == 0 ? 16 : 0);
                pg8::EpiBf16X E{l < 2 ? 0 : 1, (bf16*)(F.ws + WS_Z), (bf16*)(F.ws + WS_KD), (bf16*)(F.ws + WS_VD), (bf16*)(F.ws + WS_MEMKV), nullptr, nullptr};
                REP(0) pg8::gemm_phase<pg8::EpiBf16X, pg8::DualOrder, true, true>(F.lds + RING_OFF, g, S, E);
                if (ncv) conv_done(F, pb + 0);
                { const int mine = (nu - 1 - F.c) / Gc + 1, rounds = (nu + Gc - 1) / Gc; conv_filler(F, args, 2 * l, (rounds - mine) * QA); }
            } else conv_server(F, args, pb + 0, 2 * l, Gc);
            SEAM(pb + 0);
        }
        if (IN(pb + 1)) { FRESH();
            if (l < 2) {
                REP(1) for (int u = F.c; u < 256 + 128; u += F.G) {
                    if (u < 256) sgu_unit(F, args, l, u >> 2, u & 3);
                    else { const int r = u - 256; memattn_unit(F, l, r & 3, r >> 2, NINA, 2 * MIXW); }
                }
                if (F.c >= 128) conv_filler(F, args, 2 * l, QX);
            } else {
                const int ncv = CONVFIN() ? 0 : NCVATT;
                if (F.c >= F.G - ncv) { conv_server_q(F, args, F.ctl + CW_Q + 64 * l, (unsigned)(att2::NUNITS + 128 - STOPU), 2 * l); __syncthreads(); }
                REP(2) { gu32* qh = F.ctl + CW_Q + 64 * l + 16 * rep_; LAS unsigned* uw = (LAS unsigned*)(F.lds + att2::LDS_UNIT);
                for (;;) {
                    if (F.tid == 0) *uw = __hip_atomic_fetch_add(qh, 1u, RLX_AGENT);
                    __syncthreads();
                    const unsigned idx = *uw;
                    __syncthreads();
                    if (idx >= (unsigned)(att2::NUNITS + 128)) break;
                    if (idx < (unsigned)att2::NUNITS) diffattn2_unit(F, args, att2::g_units.u[idx]);
                    else { const int r = (int)idx - att2::NUNITS; memattn_unit(F, l, r & 3, r >> 2, 2048, MIXW); }
                } }
            }
            SEAM(pb + 1);
        }
        if (IN(pb + 2) && l >= 2) { FRESH(); REP(3) diffcombine_phase(F, args, l); SEAM(pb + 2); }
        if (IN(pb + 3)) { FRESH();
            pg8::Gemm g{nullptr, nullptr, T, D, D}; pg8::DenseOrder S; S.init(F.ws + WS_CAT, F.ws + (l < 2 ? WS_WAOUT + (size_t)l * D * D * 2 : WS_WBOUT + (size_t)(l - 2) * D * D * 2), T, D, D, F.G, F.c);
            pg8::EpiResBf16 E{(const bf16*)(F.ws + WS_XB), (bf16*)(F.ws + WS_Y), DN_ALPHA};
            REP(4) pg8::gemm_phase<pg8::EpiResBf16, pg8::DenseOrder, true, true>(F.lds + RING_OFF, g, S, E);
            SEAM(pb + 3);
        }
        if (IN(pb + 4)) { FRESH(); ln1_router_phase(F, args, l);
#ifdef REP_LN1
            ln1_router_phase(F, args, l, 1);
#endif
            conv_filler(F, args, 2 * l, -1); SEAM(pb + 4); }
        if (IN(pb + 6)) { FRESH();
            moe_table(F, l);
            const LAS int* tb = (const LAS int*)(F.lds + TAB_OFF);
            const int nu = tb[32] * 4, ncv = conv_servers(nu, F.G, CONVFIN()), Gc = F.G - ncv;
            if (F.c < Gc) {
                pg8::Gemm g{nullptr, nullptr, SLOTS, 1024, D / 2};
                pg8::MoeGatherOrder S{tb, tb + 36, (const int*)(F.ws + WS_LIST), 4, Gc, F.c, (const char*)(F.ws + WS_X1F), (const char*)(F.ws + WS_W13) + (size_t)l * NE * 1024 * 2048, (size_t)1024 * 2048, (size_t)256 * 2048, (unsigned)D};
                pg8::EpiMoe1 E{(bf16*)(F.ws + WS_H), tb, tb + 36};
                REP(6) pg8::gemm_phase<pg8::EpiMoe1, pg8::MoeGatherOrder, true, true>(F.lds + RING_OFF, g, S, E);
                if (ncv) conv_done(F, pb + 6);
                { const int mine = (F.c < nu) ? (nu - 1 - F.c) / Gc + 1 : 0, rounds = (nu + Gc - 1) / Gc; conv_filler(F, args, 2 * l + 1, (rounds - mine) * QM); }
            } else conv_server(F, args, pb + 6, 2 * l + 1, Gc);
            SEAM(pb + 6);
        }
        if (IN(pb + 7)) { FRESH();
            moe_table(F, l);
            const int nu = ((const LAS int*)(F.lds + TAB_OFF))[32] * 8, ncv = conv_servers(nu, F.G, CONVFIN()), Gc = F.G - ncv;
            if (F.c < Gc) {
                pg8::Gemm g{nullptr, nullptr, SLOTS, D, FF / 2};
                pg8::MoeOrder8 S{(const PG8_LAS int*)(F.lds + TAB_OFF), 8, Gc, F.c, (const char*)(F.ws + WS_H), (const char*)(F.ws + WS_W2) + (size_t)l * NE * 2048 * 512, (size_t)256 * FF, (size_t)2048 * 512, (size_t)256 * 512};
                pg8::EpiBf16X E{3, (bf16*)(F.ws + WS_YB), nullptr, nullptr, nullptr, (const PG8_LAS int*)(F.lds + TAB_OFF), (const PG8_LAS int*)(F.lds + TAB_OFF) + 36};
                REP(7) pg8::gemm_phase<pg8::EpiBf16X, pg8::MoeOrder8, true, true>(F.lds + RING_OFF, g, S, E);
                if (ncv) conv_done(F, pb + 7);
                { const int mine = (F.c < nu) ? (nu - 1 - F.c) / Gc + 1 : 0, rounds = (nu + Gc - 1) / Gc; conv_filler(F, args, 2 * l + 1, (rounds - mine) * QB); }
            } else conv_server(F, args, pb + 7, 2 * l + 1, Gc);
            SEAM(pb + 7);
        }
        if (IN(pb + 8)) { FRESH(); REP(8) ln2_phase(F, args, l); conv_filler(F, args, 2 * l + 1, -1); SEAM(pb + 8); }
    }
#ifdef PROBE_A
    {
        VM_WAIT(); xcd_barrier(bar);
        const unsigned long long* ts = (const unsigned long long*)(args.ws + WS_TS);
        float da = 0.f, db = 0.f;
        for (int p = 0; p < NPHASES; ++p) { const int k = (p == 0) ? 9 : (p - 1) % NPH_LAYER; const float d = (float)(ts[p + 1] - ts[p]);
            if (k == PROBE_A || PROBE_A == 10) da += d; if (k == PROBE_B || PROBE_B == 10) db += d; }
        const float kk = sqrtf(da), vv = db;
        float* o = args.out; const long n = (long)T * D;
        for (long i = (long)blockIdx.x * 512 + threadIdx.x; i < n; i += (long)gridDim.x * 512) o[i] = (i == 0) ? vv : kk;
    }
#endif
#undef IN
#undef SEAM
}

#ifndef MK_ONE_LAUNCH
#define MK_ONE_LAUNCH 1
#endif
extern "C" void kernel_launch(void* const* d_in, const int* in_sizes, int n_in, void* d_out, int out_size, void* d_ws, size_t ws_size, hipStream_t stream) {
    static int grid = 0;
    if (grid == 0) {
        if (n_in != 24 || in_sizes[0] != T * D || out_size != T * D || ws_size < WS_END) { fprintf(stderr, "kernel_launch: unexpected shapes (n_in %d, in0 %d, out %d, ws %zu < %zu)\n", n_in, n_in > 0 ? in_sizes[0] : -1, out_size, ws_size, (size_t)WS_END); grid = -1; return; }
        int dev = 0, cus = 0, per_cu = 0;
        if (hipGetDevice(&dev) != hipSuccess || hipDeviceGetAttribute(&cus, hipDeviceAttributeMultiprocessorCount, dev) != hipSuccess) { grid = -1; return; }
        if (hipFuncSetAttribute((const void*)fwd_kernel, hipFuncAttributeMaxDynamicSharedMemorySize, LDS_BYTES) != hipSuccess) { fprintf(stderr, "kernel_launch: hipFuncSetAttribute failed\n"); grid = -1; return; }
        if (hipOccupancyMaxActiveBlocksPerMultiprocessor(&per_cu, (const void*)fwd_kernel, NWAVES * 64, LDS_BYTES) != hipSuccess || per_cu < 1) fprintf(stderr, "kernel_launch: occupancy query reports %d\n", per_cu);
        (void)hipGetLastError();
        grid = cus;
    }
    if (grid < 0) return;
    if (hipMemsetAsync((char*)d_ws + WS_CTL, 0, CTL_ZERO_BYTES, stream) != hipSuccess) return;
    Args a{};
    for (int i = 0; i < 24; ++i) a.in[i] = (const float*)d_in[i];
    a.out = (float*)d_out; a.ws = (unsigned char*)d_ws;
#if MK_ONE_LAUNCH
    a.ph_lo = 0; a.ph_hi = NPHASES;
    hipLaunchKernelGGL(fwd_kernel, dim3(grid), dim3(NWAVES * 64), LDS_BYTES, stream, a);
#else
    for (int p = 0; p < NPHASES; ++p) {
        const int k = (p - 1) % NPH_LAYER, l = (p - 1) / NPH_LAYER;
        if (p > 0 && k == 2 && l < 2) continue;
        a.ph_lo = p; a.ph_hi = p + 1;
        hipLaunchKernelGGL(fwd_kernel, dim3(grid), dim3(NWAVES * 64), LDS_BYTES, stream, a);
    }
#endif
    const hipError_t le = hipPeekAtLastError();
    if (le != hipSuccess) fprintf(stderr, "kernel_launch: launch failed: %s\n", hipGetErrorName(le));
}
```

```cpp
#define F8MASK 12
#include <hip/hip_runtime.h>
#include <cstdio>
#include <cstdint>
namespace pg8 {
#define PG8_LAS __attribute__((address_space(3)))
typedef unsigned short bf16_t;
typedef short bf16x8 __attribute__((ext_vector_type(8)));
typedef float f32x4 __attribute__((ext_vector_type(4)));
typedef unsigned u32x4 __attribute__((ext_vector_type(4)));
constexpr int BM = 256, BK = 64, HALF = 128, HTB = HALF * BK * 2  , STAGE_BYTES = 8 * HTB, NXCD = 8, WGM = 8;

__host__ __device__ __forceinline__ int lds_byte(int r, int c) { const int st = (r >> 4) * 2 + (c >> 5), rr = r & 15, cc = c & 31, ob = rr * 64 + cc * 2; return st * 1024 + (ob ^ (((ob >> 9) & 1) << 5)); }
__host__ __device__ __forceinline__ void stage_rc(int b, int& R, int& C) { const int st = b / 1024, sb = b % 1024, swz = sb ^ (((sb >> 9) & 1) << 5); R = (st >> 1) * 16 + swz / 64; C = (st & 1) * 32 + (swz % 64) / 2; }
__host__ __device__ __forceinline__ int perm32(int rho) { const int n = rho >> 4, i = rho & 15; return 8 * (i >> 2) + 4 * n + (i & 3); }

typedef int pg8_v4i __attribute__((ext_vector_type(4))); typedef int pg8_v8i __attribute__((ext_vector_type(8)));
__device__ __forceinline__ pg8_v8i pg8_cat8(bf16x8 a, bf16x8 b) { return __builtin_shufflevector(__builtin_bit_cast(pg8_v4i, a), __builtin_bit_cast(pg8_v4i, b), 0, 1, 2, 3, 4, 5, 6, 7); }
struct Unit { int pm, pn, e; };
struct Gemm { const bf16_t* A; const bf16_t* Bt; int M, N, K; };

struct StaticOrder {
    static constexpr bool GATHER = false, F8 = false; static constexpr int SCALE_B = 127;
    int nM, nN, nwg, G, c;
    __host__ __device__ void init(int M, int N, int G_, int c_) { nM = M / BM; nN = N / BM; nwg = nM * nN; G = G_; c = c_; }
    __host__ __device__ bool next(int i, Unit& u) const {
        const long L = (long)i * G + c; if (L >= nwg) return false;
        int wgid = (int)L; { const int q = nwg / NXCD, r = nwg % NXCD, xcd = wgid % NXCD, off = wgid / NXCD; wgid = (xcd < r ? xcd * (q + 1) : r * (q + 1) + (xcd - r) * q) + off; }
        const int nig = WGM * nN, gid = wgid / nig, fm = gid * WGM, gsz = (nM - fm) < WGM ? (nM - fm) : WGM;
        u.pm = fm + ((wgid % nig) % gsz); u.pn = (wgid % nig) / gsz; return true;
    }
    __device__ __forceinline__ void a_ready(const Unit&) const {}
    __device__ __forceinline__ void done(const Unit&) const {}
};

__device__ __forceinline__ unsigned cvt_pk_bf16(float lo, float hi) { unsigned r; asm volatile("v_cvt_pk_bf16_f32 %0, %1, %2" : "=v"(r) : "v"(lo), "v"(hi)); return r; }
typedef float f32x2 __attribute__((ext_vector_type(2)));
__device__ __forceinline__ f32x2 gelu_pk(f32x2 v) {
    const f32x2 av = __builtin_elementwise_abs(v), d = av * 0.2316418882f + 1.0f;
    f32x2 t; t.x = __builtin_amdgcn_rcpf(d.x); t.y = __builtin_amdgcn_rcpf(d.y);
    f32x2 q = t * 0.5307027145f + (-0.7265760135f); q = q * t + 0.7107068705f; q = q * t + (-0.142248368f); q = q * t + 0.127414796f; q = q * t;
    const f32x2 s = (v * v) * (-0.72134752044f);
    f32x2 e; e.x = __builtin_amdgcn_exp2f(s.x); e.y = __builtin_amdgcn_exp2f(s.y);
    const f32x2 m = v * (q * e), r = v - m;
    f32x2 o; o.x = v.x < 0.f ? m.x : r.x; o.y = v.y < 0.f ? m.y : r.y; return o;
}

template <class Epi, class Sched, bool ALIGN_EPI = false, bool SP2 = false>
__device__ __forceinline__ void gemm_phase(PG8_LAS unsigned char* lds, const Gemm g, const Sched& S, const Epi& E) {
    int tid_ = threadIdx.x; asm volatile("" : "+v"(tid_));
    const int tid = tid_, wid = __builtin_amdgcn_readfirstlane(tid >> 6), lane = tid & 63, wr = wid >> 2, wc = wid & 3, fr = lane & 15, fq = lane >> 4;
    const int K = g.K, nt = K / BK;
    unsigned voffA[2], voffB[2];
#pragma unroll
    for (int i = 0; i < 2; ++i) { int R, C; stage_rc(tid * 16 + i * 8192, R, C); const int Rb = Epi::PERM ? ((R & ~31) + perm32(R & 31)) : R;
        voffA[i] = (unsigned)(R * K + C) * 2u; voffB[i] = (unsigned)(Rb * K + C) * 2u; }
    unsigned vAc[2][2], vAn[2][2];
    int gR[2], gC[2];
#pragma unroll
    for (int i = 0; i < 2; ++i) { stage_rc(tid * 16 + i * 8192, gR[i], gC[i]); }
    const size_t kstep = (size_t)(BK * 2);
    const size_t hstep = (size_t)HALF * K * 2;
        const unsigned ldsw = (unsigned)wid * 1024u;
    const int aoff = lds_byte(wr * 64 + fr, fq * 8), boff = lds_byte(wc * 32 + fr, fq * 8);
#define PG8_SA(b, h) (((b) * 2 + (h)) * HTB)
#define PG8_SB(b, h) ((4 + (b) * 2 + (h)) * HTB)
#define PG8_STAGE(bufoff, gbase, voff) do { _Pragma("unroll") for (int _i = 0; _i < 2; ++_i) \
        __builtin_amdgcn_global_load_lds((const unsigned*)((const char*)(gbase) + (voff)[_i]), (PG8_LAS unsigned*)(lds + (bufoff) + ldsw + _i * 8192), 16, 0, 0); } while (0)
#define PG8_STAGE_A(b, h, base, VS) do { if constexpr (Sched::GATHER) { PG8_STAGE(PG8_SA(b, h), base, VS[h]); } else { PG8_STAGE(PG8_SA(b, h), (base) + (h) * hstep, voffA); } } while (0)
#define PG8_STAGE_AN(b, h, base) do { if constexpr (Sched::GATHER) { unsigned vs_[2] = {last ? vAn[h][0] : vAc[h][0], last ? vAn[h][1] : vAc[h][1]}; PG8_STAGE(PG8_SA(b, h), base, vs_); } else { PG8_STAGE(PG8_SA(b, h), (base) + (h) * hstep, voffA); } } while (0)
#define PG8_LDA(dst, b, h) do { if constexpr (Sched::F8) { _Pragma("unroll") for (int m = 0; m < 4; ++m) { dst##8[m].lo = *(const PG8_LAS pg8_v4i*)(lds + PG8_SA(b, h) + aoff + m * 2048); dst##8[m].hi = *(const PG8_LAS pg8_v4i*)(lds + PG8_SA(b, h) + aoff + m * 2048 + 1024); } } \
        else { _Pragma("unroll") for (int m = 0; m < 4; ++m) _Pragma("unroll") for (int k = 0; k < 2; ++k) dst[m][k] = *(const PG8_LAS bf16x8*)(lds + PG8_SA(b, h) + aoff + m * 2048 + k * 1024); } } while (0)
#define PG8_LDB(dst, b, h) do { if constexpr (Sched::F8) { _Pragma("unroll") for (int n = 0; n < 2; ++n) { dst##8[n].lo = *(const PG8_LAS pg8_v4i*)(lds + PG8_SB(b, h) + boff + n * 2048); dst##8[n].hi = *(const PG8_LAS pg8_v4i*)(lds + PG8_SB(b, h) + boff + n * 2048 + 1024); } } \
        else { _Pragma("unroll") for (int n = 0; n < 2; ++n) _Pragma("unroll") for (int k = 0; k < 2; ++k) dst[n][k] = *(const PG8_LAS bf16x8*)(lds + PG8_SB(b, h) + boff + n * 2048 + k * 1024); } } while (0)
#define PG8_MMA(ai, bj, At, Bt) do { __builtin_amdgcn_s_setprio(1); if constexpr (Sched::F8) { \
        _Pragma("unroll") for (int m = 0; m < 4; ++m) _Pragma("unroll") for (int n = 0; n < 2; ++n) \
            asm volatile("v_mfma_scale_f32_16x16x128_f8f6f4 %0, %1, %2, %0, %3, %4 op_sel_hi:[0,0,0]" : "+v"(acc[ai][bj][m][n]) : "v"(Bt##8[n]), "v"(At##8[m]), "v"(sclB_), "v"(sclA_));     \
        } else { _Pragma("unroll") for (int m = 0; m < 4; ++m) _Pragma("unroll") for (int n = 0; n < 2; ++n) _Pragma("unroll") for (int k = 0; k < 2; ++k) \
        acc[ai][bj][m][n] = __builtin_amdgcn_mfma_f32_16x16x32_bf16(Bt[n][k], At[m][k], acc[ai][bj][m][n], 0, 0, 0); } __builtin_amdgcn_s_setprio(0); } while (0)
#define PG8_WAIT_V(n) asm volatile("s_waitcnt vmcnt(" #n ")" ::: "memory")
#define PG8_WAIT_L(n) asm volatile("s_waitcnt lgkmcnt(" #n ")" ::: "memory")
#define PG8_BAR __builtin_amdgcn_s_barrier()
#define PG8_SCHED __builtin_amdgcn_sched_barrier(0)
    Unit cur, nxt; int ui = 0;
    if (!S.next(0, cur)) return;
    f32x4 acc[2][2][4][2];
#pragma unroll
    for (int a = 0; a < 2; ++a)
#pragma unroll
        for (int b = 0; b < 2; ++b)
#pragma unroll
            for (int m = 0; m < 4; ++m)
#pragma unroll
                for (int n = 0; n < 2; ++n) acc[a][b][m][n] = (f32x4){0.f, 0.f, 0.f, 0.f};
    const int sclB_ = Sched::SCALE_B, sclA_ = 127;
    bf16x8 At[4][2], B0[2][2], B1[2][2]; pg8_v8i At8[4], B08[2], B18[2];
    const char* cA = S.aptr(cur); const char* cB = S.bptr(cur);
    S.a_ready(cur);
    if constexpr (Sched::GATHER) {
#pragma unroll
        for (int h = 0; h < 2; ++h)
#pragma unroll
            for (int i = 0; i < 2; ++i) { vAc[h][i] = S.rowoff(cur, h * HALF + gR[i]) + (unsigned)gC[i] * 2u; vAn[h][i] = vAc[h][i]; }
        asm volatile("s_waitcnt vmcnt(0)" ::: "memory");
    }
    if constexpr (SP2) {
        PG8_STAGE(PG8_SB(0, 0), cB, voffB); PG8_STAGE(PG8_SB(0, 1), cB + hstep, voffB); PG8_STAGE_A(0, 0, cA, vAc); PG8_STAGE_A(0, 1, cA, vAc);
        if (wr == 1) PG8_BAR;
        PG8_WAIT_V(2); PG8_BAR;
        PG8_STAGE(PG8_SB(1, 0), cB + kstep, voffB); PG8_STAGE_A(1, 0, cA + kstep, vAc); PG8_STAGE(PG8_SB(1, 1), cB + hstep + kstep, voffB);
        PG8_WAIT_V(6); PG8_BAR;
    } else {
        PG8_STAGE(PG8_SB(0, 0), cB, voffB); PG8_STAGE_A(0, 0, cA, vAc); PG8_STAGE(PG8_SB(0, 1), cB + hstep, voffB); PG8_STAGE_A(0, 1, cA, vAc);
        if (wr == 1) PG8_BAR;
        PG8_WAIT_V(4); PG8_BAR;
        PG8_STAGE(PG8_SB(1, 0), cB + kstep, voffB); PG8_STAGE_A(1, 0, cA + kstep, vAc); PG8_STAGE(PG8_SB(1, 1), cB + hstep + kstep, voffB);
        PG8_WAIT_V(6); PG8_BAR;
    }
    for (;;) {
        const bool has_next = S.next(ui + 1, nxt);
        const char* nA = has_next ? S.aptr(nxt) : cA; const char* nB = has_next ? S.bptr(nxt) : cB;
        if constexpr (Sched::GATHER) { if (has_next) {
#pragma unroll
            for (int h = 0; h < 2; ++h)
#pragma unroll
                for (int i = 0; i < 2; ++i) vAn[h][i] = S.rowoff(nxt, h * HALF + gR[i]) + (unsigned)gC[i] * 2u; } }
        for (int t = 0; t < nt; t += 2) {
            const bool last = (t == nt - 2);
            const char* a1 = cA + (size_t)(t + 1) * kstep;
            const char* a2 = last ? nA : cA + (size_t)(t + 2) * kstep; const char* b2 = last ? nB : cB + (size_t)(t + 2) * kstep;
            const char* a3 = a2 + kstep; const char* b3 = b2 + kstep;
            if (last && has_next) S.a_ready(nxt);
            if constexpr (SP2) {
            PG8_LDB(B0, 0, 0); PG8_LDB(B1, 0, 1); PG8_SCHED; PG8_LDA(At, 0, 0); PG8_STAGE_A(1, 1, a1, vAc);
            PG8_WAIT_V(8); PG8_WAIT_L(0); PG8_BAR; PG8_MMA(0, 0, At, B0); PG8_MMA(0, 1, At, B1); PG8_BAR; PG8_SCHED;
            PG8_LDA(At, 0, 1); PG8_STAGE(PG8_SB(0, 0), b2, voffB); PG8_STAGE(PG8_SB(0, 1), b2 + hstep, voffB); PG8_STAGE_AN(0, 0, a2);
            PG8_WAIT_V(8); PG8_WAIT_L(0); PG8_BAR; PG8_MMA(1, 0, At, B0); PG8_MMA(1, 1, At, B1); PG8_BAR; PG8_SCHED;
            PG8_LDB(B0, 1, 0); PG8_LDB(B1, 1, 1); PG8_SCHED; PG8_LDA(At, 1, 0); PG8_STAGE_AN(0, 1, a2);
            PG8_WAIT_V(8); PG8_WAIT_L(0); PG8_BAR; PG8_MMA(0, 0, At, B0); PG8_MMA(0, 1, At, B1); PG8_BAR; PG8_SCHED;
            PG8_LDA(At, 1, 1); PG8_STAGE(PG8_SB(1, 0), b3, voffB); PG8_STAGE(PG8_SB(1, 1), b3 + hstep, voffB); PG8_STAGE_AN(1, 0, a3);
            PG8_WAIT_V(8); PG8_WAIT_L(0); PG8_BAR; PG8_MMA(1, 0, At, B0); PG8_MMA(1, 1, At, B1); PG8_BAR; PG8_SCHED;
            } else {
            PG8_LDB(B0, 0, 0); PG8_SCHED; PG8_LDA(At, 0, 0); PG8_STAGE_A(1, 1, a1, vAc);
            PG8_WAIT_L(8); PG8_BAR; PG8_WAIT_L(0); PG8_MMA(0, 0, At, B0); PG8_BAR; PG8_SCHED;
            PG8_LDB(B1, 0, 1); PG8_STAGE(PG8_SB(0, 0), b2, voffB);
            PG8_BAR; PG8_WAIT_L(0); PG8_MMA(0, 1, At, B1); PG8_BAR;
            PG8_LDA(At, 0, 1); PG8_STAGE_AN(0, 0, a2);
            PG8_BAR; PG8_WAIT_L(0); PG8_MMA(1, 0, At, B0); PG8_BAR; PG8_SCHED;
            PG8_STAGE(PG8_SB(0, 1), b2 + hstep, voffB);
            PG8_WAIT_V(6); PG8_BAR; PG8_MMA(1, 1, At, B1); PG8_BAR;
            PG8_LDB(B0, 1, 0); PG8_SCHED; PG8_LDA(At, 1, 0); PG8_STAGE_AN(0, 1, a2);
            PG8_WAIT_L(8); PG8_BAR; PG8_WAIT_L(0); PG8_MMA(0, 0, At, B0); PG8_BAR; PG8_SCHED;
            PG8_LDB(B1, 1, 1); PG8_STAGE(PG8_SB(1, 0), b3, voffB);
            PG8_BAR; PG8_WAIT_L(0); PG8_MMA(0, 1, At, B1); PG8_BAR;
            PG8_LDA(At, 1, 1); PG8_STAGE_AN(1, 0, a3);
            PG8_BAR; PG8_WAIT_L(0); PG8_MMA(1, 0, At, B0); PG8_BAR; PG8_SCHED;
            PG8_STAGE(PG8_SB(1, 1), b3 + hstep, voffB);
            PG8_WAIT_V(6); PG8_BAR; PG8_MMA(1, 1, At, B1); PG8_BAR;
            }
        }
        if constexpr (ALIGN_EPI) { if (wr == 0) PG8_BAR; }
        if constexpr (!Epi::AFTER_DRAIN) { E(acc, cur, wr, wc, fr, fq); S.done(cur); }
        if (!has_next) break;
#pragma unroll
        for (int a = 0; a < 2; ++a)
#pragma unroll
            for (int b = 0; b < 2; ++b)
#pragma unroll
                for (int m = 0; m < 4; ++m)
#pragma unroll
                    for (int n = 0; n < 2; ++n) acc[a][b][m][n] = (f32x4){0.f, 0.f, 0.f, 0.f};
        cur = nxt; cA = nA; cB = nB; ++ui;
        if constexpr (Sched::GATHER) {
#pragma unroll
            for (int h = 0; h < 2; ++h)
#pragma unroll
                for (int i = 0; i < 2; ++i) vAc[h][i] = vAn[h][i]; }
        if constexpr (ALIGN_EPI) { if (wr == 1) PG8_BAR; }
    }
    PG8_WAIT_V(0);
    if constexpr (!ALIGN_EPI) { if (wr == 0) PG8_BAR; }
    PG8_BAR;
    if constexpr (Epi::AFTER_DRAIN) { E.fused(acc, cur, wr, wc, fr, fq, lds, wid, lane); S.done(cur); }
#undef PG8_SA
#undef PG8_SB
#undef PG8_STAGE
#undef PG8_STAGE_A
#undef PG8_STAGE_AN
#undef PG8_LDA
#undef PG8_LDB
#undef PG8_MMA
#undef PG8_WAIT_V
#undef PG8_WAIT_L
#undef PG8_BAR
#undef PG8_SCHED
}
}

constexpr int T = 8192, D = 2048, MIXW = 1536, MEMW = 512, NINA = 3584, DEPTH = 4, NE = 32, FF = 512, MEMT = 256;
constexpr int SLOTS = 24576;
constexpr float LN_EPS = 1e-5f;
constexpr float DN_ALPHA = 1.6817928305074292f;
constexpr float LOG2E = 1.4426950408889634f;
constexpr float QSCALE = 0.08838834764831845f * LOG2E;
constexpr int NWAVES = 8;

constexpr size_t MiB = 1u << 20;
constexpr size_t WS_CTL = 0, CTL_ZERO_BYTES = 1 * MiB;
constexpr size_t WS_WAIN = 2 * MiB, WS_WAOUT = 30 * MiB, WS_WBIN0 = 46 * MiB, WS_WKV = 54 * MiB, WS_WBIN1 = 66 * MiB, WS_WBOUT = 74 * MiB, WS_WMKV = 90 * MiB;
constexpr size_t WS_W13 = 106 * MiB, WS_W2 = 618 * MiB;
constexpr size_t WS_XB = 874 * MiB, WS_MEMB = 906 * MiB, WS_MEMKV = 907 * MiB, WS_Z = 910 * MiB, WS_KD = 966 * MiB, WS_VD = 990 * MiB, WS_CAT = 1014 * MiB;
constexpr size_t WS_XQ = 1206 * MiB, WS_MEMQ = 1238 * MiB;
constexpr size_t WS_Y = 1046 * MiB, WS_X1F = 1110 * MiB, WS_X1B = 1174 * MiB, WS_XF = 1206 * MiB, WS_XG = 1270 * MiB, WS_H = 1366 * MiB, WS_YB = 1390 * MiB, WS_OP = 1486 * MiB;
constexpr size_t WS_ROUTE = 1582 * MiB, WS_OP2 = 1583 * MiB, WS_ML = 1631 * MiB, WS_WR = 1634 * MiB, WS_TS = 1640 * MiB, WS_LIST = 1641 * MiB, WS_END = 1642 * MiB;
constexpr int CW_TMO = 0, CW_BAR = 4096, CW_CNT = 16384, CW_Q = 28672, CW_CONV = 29184, CW_DONE = 32768, CW_FIN = 40960;

constexpr int RING_OFF = 0, RING_BYTES = 131072;
constexpr int LDSCTL_OFF = 146432, MISC_OFF = LDSCTL_OFF + 320, TAB_OFF = LDSCTL_OFF + 512;
constexpr int LDS_BYTES = 147456;

#define GAS __attribute__((address_space(1)))
#define LAS __attribute__((address_space(3)))
typedef unsigned short bf16;
typedef unsigned v4u __attribute__((ext_vector_type(4)));
typedef unsigned v2u __attribute__((ext_vector_type(2)));
typedef float f32x4 __attribute__((ext_vector_type(4)));
typedef short bf16x8 __attribute__((ext_vector_type(8)));
typedef GAS unsigned gu32;
#define RLX_AGENT __ATOMIC_RELAXED, __HIP_MEMORY_SCOPE_AGENT
#define LDS_WAIT() asm volatile("s_waitcnt lgkmcnt(0)" ::: "memory")
#define VM_WAIT() asm volatile("s_waitcnt vmcnt(0)" ::: "memory")
__device__ __forceinline__ unsigned f2bf(float f) { unsigned u = __builtin_bit_cast(unsigned, f); return (u + 0x7fffu + ((u >> 16) & 1u)) >> 16; }
__device__ __forceinline__ unsigned pk2(float lo, float hi) { return f2bf(lo) | (f2bf(hi) << 16); }
__device__ __forceinline__ float bf2f(unsigned short b) { return __builtin_bit_cast(float, (unsigned)b << 16); }
__device__ __forceinline__ float bflo(unsigned w) { return __builtin_bit_cast(float, w << 16); }
__device__ __forceinline__ float bfhi(unsigned w) { return __builtin_bit_cast(float, w & 0xffff0000u); }
__device__ __forceinline__ float wave_sum(float v) {
#pragma unroll
    for (int o = 1; o < 64; o <<= 1) v += __shfl_xor(v, o);
    return v;
}

namespace pg8 {
struct DenseOrder {
    static constexpr bool GATHER = false, F8 = false; static constexpr int SCALE_B = 127;
    StaticOrder so; const char* A; const char* B; size_t astep, bstep;
    __device__ void init(const void* A_, const void* B_, int M, int N, int K, int G, int c) { so.init(M, N, G, c); A = (const char*)A_; B = (const char*)B_; astep = (size_t)256 * K * 2; bstep = astep; }
    __device__ __forceinline__ bool next(int i, Unit& u) const { u.e = 0; return so.next(i, u); }
    __device__ __forceinline__ const char* aptr(const Unit& u) const { return A + (size_t)u.pm * astep; }
    __device__ __forceinline__ const char* bptr(const Unit& u) const { return B + (size_t)u.pn * bstep; }
    __device__ __forceinline__ void a_ready(const Unit&) const {}
    __device__ __forceinline__ void done(const Unit&) const {}
};
struct DualOrder {
    static constexpr bool GATHER = false, F8 = false; static constexpr int SCALE_B = 127;
    StaticOrder so; int nwg2; const char* A; const char* B; const char* A2; const char* B2; size_t step;
    __device__ void init(const void* A_, const void* B_, int M, int N, int K, int G, int c, const void* A2_, const void* B2_, int nwg2_) { so.init(M, N, G, c); A = (const char*)A_; B = (const char*)B_; A2 = (const char*)A2_; B2 = (const char*)B2_; nwg2 = nwg2_; step = (size_t)256 * K * 2; }
    __device__ __forceinline__ bool next(int i, Unit& u) const { const int L = i * so.G + so.c; if (L < so.nwg) { u.e = 0; return so.next(i, u); } if (L - so.nwg >= nwg2) return false; u.e = 1; u.pm = 0; u.pn = L - so.nwg; return true; }
    __device__ __forceinline__ const char* aptr(const Unit& u) const { return u.e ? A2 : A + (size_t)u.pm * step; }
    __device__ __forceinline__ const char* bptr(const Unit& u) const { return (u.e ? B2 : B) + (size_t)u.pn * step; }
    __device__ __forceinline__ void a_ready(const Unit&) const {}
    __device__ __forceinline__ void done(const Unit&) const {}
};
struct DualOrder8 {
    static constexpr bool GATHER = false, F8 = true; static constexpr int SCALE_B = 121;
    StaticOrder so; int nwg2; const char* A; const char* B; const char* A2; const char* B2; size_t step;
    __device__ void init(const void* A_, const void* B_, int M, int N, int K, int G, int c, const void* A2_, const void* B2_, int nwg2_) { so.init(M, N, G, c); A = (const char*)A_; B = (const char*)B_; A2 = (const char*)A2_; B2 = (const char*)B2_; nwg2 = nwg2_; step = (size_t)256 * K * 2; }
    __device__ __forceinline__ bool next(int i, Unit& u) const { const int L = i * so.G + so.c; if (L < so.nwg) { u.e = 0; return so.next(i, u); } if (L - so.nwg >= nwg2) return false; u.e = 1; u.pm = 0; u.pn = L - so.nwg; return true; }
    __device__ __forceinline__ const char* aptr(const Unit& u) const { return u.e ? A2 : A + (size_t)u.pm * step; }
    __device__ __forceinline__ const char* bptr(const Unit& u) const { return (u.e ? B2 : B) + (size_t)u.pn * step; }
    __device__ __forceinline__ void a_ready(const Unit&) const {}
    __device__ __forceinline__ void done(const Unit&) const {}
};
struct MoeOrder {
    static constexpr bool GATHER = false, F8 = false; static constexpr int SCALE_B = 127;
    const PG8_LAS int* tstart; int ntn, G, c; const char* A; const char* W; size_t astep, wexp, wtile;
    __device__ __forceinline__ bool next(int i, Unit& u) const {
        const int L = i * G + c, total = tstart[32] * ntn; if (L >= total) return false;
        int wgid; { const int q = total / NXCD, r = total % NXCD, xcd = L % NXCD, off = L / NXCD; wgid = (xcd < r ? xcd * (q + 1) : r * (q + 1) + (xcd - r) * q) + off; }
        u.pm = wgid / ntn; u.pn = wgid - u.pm * ntn; int e = 0;
#pragma unroll
        for (int k = 1; k <= 31; ++k) e += (tstart[k] <= u.pm) ? 1 : 0;
        u.e = e; return true;
    }
    __device__ __forceinline__ const char* aptr(const Unit& u) const { return A + (size_t)u.pm * astep; }
    __device__ __forceinline__ const char* bptr(const Unit& u) const { return W + (size_t)u.e * wexp + (size_t)u.pn * wtile; }
    __device__ __forceinline__ void a_ready(const Unit&) const {}
    __device__ __forceinline__ void done(const Unit&) const {}
};

struct MoeOrder8 {
    static constexpr bool GATHER = false, F8 = true; static constexpr int SCALE_B = 121;
    const PG8_LAS int* tstart; int ntn, G, c; const char* A; const char* W; size_t astep, wexp, wtile;
    __device__ __forceinline__ bool next(int i, Unit& u) const {
        const int L = i * G + c, total = tstart[32] * ntn; if (L >= total) return false;
        int wgid; { const int q = total / NXCD, r = total % NXCD, xcd = L % NXCD, off = L / NXCD; wgid = (xcd < r ? xcd * (q + 1) : r * (q + 1) + (xcd - r) * q) + off; }
        u.pm = wgid / ntn; u.pn = wgid - u.pm * ntn; int e = 0;
#pragma unroll
        for (int k = 1; k <= 31; ++k) e += (tstart[k] <= u.pm) ? 1 : 0;
        u.e = e; return true;
    }
    __device__ __forceinline__ const char* aptr(const Unit& u) const { return A + (size_t)u.pm * astep; }
    __device__ __forceinline__ const char* bptr(const Unit& u) const { return W + (size_t)u.e * wexp + (size_t)u.pn * wtile; }
    __device__ __forceinline__ void a_ready(const Unit&) const {}
    __device__ __forceinline__ void done(const Unit&) const {}
};

struct MoeGatherOrder {
    static constexpr bool GATHER = true, F8 = true; static constexpr int SCALE_B = 121;
    const PG8_LAS int* tstart; const PG8_LAS int* cntl; const int* list; int ntn, G, c; const char* A; const char* W; size_t wexp, wtile; unsigned rowbytes;
    __device__ __forceinline__ bool next(int i, Unit& u) const {
        const int L = i * G + c, total = tstart[32] * ntn; if (L >= total) return false;
        int wgid; { const int q = total / NXCD, r = total % NXCD, xcd = L % NXCD, off = L / NXCD; wgid = (xcd < r ? xcd * (q + 1) : r * (q + 1) + (xcd - r) * q) + off; }
        u.pm = wgid / ntn; u.pn = wgid - u.pm * ntn; int e = 0;
#pragma unroll
        for (int k = 1; k <= 31; ++k) e += (tstart[k] <= u.pm) ? 1 : 0;
        u.e = e; return true;
    }
    __device__ __forceinline__ unsigned rowoff(const Unit& u, int r) const { const int rank = (u.pm - tstart[u.e]) * 256 + r; const int tok = list[u.e * 8192 + (rank < cntl[u.e] ? rank : 0)]; return (unsigned)tok * rowbytes; }
    __device__ __forceinline__ const char* aptr(const Unit&) const { return A; }
    __device__ __forceinline__ const char* bptr(const Unit& u) const { return W + (size_t)u.e * wexp + (size_t)u.pn * wtile; }
    __device__ __forceinline__ void a_ready(const Unit&) const {}
    __device__ __forceinline__ void done(const Unit&) const {}
};

struct EpiBf16X {
    static constexpr bool PERM = true, AFTER_DRAIN = false;
    int mode; bf16_t* p0; bf16_t* p1; bf16_t* p2; bf16_t* p3;
    const PG8_LAS int* tstart; const PG8_LAS int* cntl;
    __device__ __forceinline__ void operator()(const f32x4 (&acc)[2][2][4][2], const Unit& u, int wr, int wc, int fr, int fq) const {
        bf16_t* base; int ldc, colt; bool act = false; float sc = 1.f;
        if (u.e && mode < 2) { base = p3 + (size_t)(u.pn >> 2) * (256 * 1024); ldc = 1024; colt = (u.pn & 3) * BM; }
        else if (mode == 0) { base = p0; ldc = 3584; colt = u.pn * BM; act = u.pn < 12; if (u.pn >= 12) sc = QSCALE; }
        else if (mode == 1) { if (u.pn < 8) { base = p0; ldc = 2048; colt = u.pn * BM; sc = QSCALE; }
                              else if (u.pn < 14) { base = p1; ldc = 1536; colt = (u.pn - 8) * BM; } else { base = p2; ldc = 1536; colt = (u.pn - 14) * BM; } }
        else { base = p0; ldc = 2048; colt = u.pn * BM; }
        const int row0 = u.pm * BM + wr * 64 + fr, col0 = colt + wc * 32 + 8 * fq;
        const int rlim = (mode == 3) ? cntl[u.e] - (u.pm - tstart[u.e]) * BM : BM;
#pragma unroll
        for (int ai = 0; ai < 2; ++ai)
#pragma unroll
            for (int m = 0; m < 4; ++m) { bf16_t* rowp = base + (size_t)(row0 + ai * HALF + m * 16) * ldc + col0;
                if (wr * 64 + fr + ai * HALF + m * 16 >= rlim) continue;
#pragma unroll
                for (int bj = 0; bj < 2; ++bj) { f32x4 v0 = acc[ai][bj][m][0], v1 = acc[ai][bj][m][1];
                    if (act) { f32x2 a = gelu_pk((f32x2){v0[0], v0[1]}), b = gelu_pk((f32x2){v0[2], v0[3]}), c = gelu_pk((f32x2){v1[0], v1[1]}), d = gelu_pk((f32x2){v1[2], v1[3]});
                        v0 = (f32x4){a.x, a.y, b.x, b.y}; v1 = (f32x4){c.x, c.y, d.x, d.y}; }
                    v0 = v0 * sc; v1 = v1 * sc; u32x4 w; w.x = cvt_pk_bf16(v0[0], v0[1]); w.y = cvt_pk_bf16(v0[2], v0[3]); w.z = cvt_pk_bf16(v1[0], v1[1]); w.w = cvt_pk_bf16(v1[2], v1[3]);
                    *(u32x4*)(rowp + bj * HALF) = w; } }
    }
};
struct EpiResBf16 {
    static constexpr bool PERM = true, AFTER_DRAIN = false;
    const bf16_t* xres; bf16_t* y; float alpha;
    __device__ __forceinline__ void operator()(const f32x4 (&acc)[2][2][4][2], const Unit& u, int wr, int wc, int fr, int fq) const {
        const int row0 = u.pm * BM + wr * 64 + fr, col0 = u.pn * BM + wc * 32 + 8 * fq;
#pragma unroll
        for (int ai = 0; ai < 2; ++ai)
#pragma unroll
            for (int m = 0; m < 4; ++m) { const size_t off = (size_t)(row0 + ai * HALF + m * 16) * 2048 + col0;
#pragma unroll
                for (int bj = 0; bj < 2; ++bj) { const u32x4 xr = *(const u32x4*)(xres + off + bj * HALF); const f32x4 v0 = acc[ai][bj][m][0], v1 = acc[ai][bj][m][1]; u32x4 w;
                    w.x = cvt_pk_bf16(__builtin_bit_cast(float, xr.x << 16) * alpha + v0[0], __builtin_bit_cast(float, xr.x & 0xffff0000u) * alpha + v0[1]);
                    w.y = cvt_pk_bf16(__builtin_bit_cast(float, xr.y << 16) * alpha + v0[2], __builtin_bit_cast(float, xr.y & 0xffff0000u) * alpha + v0[3]);
                    w.z = cvt_pk_bf16(__builtin_bit_cast(float, xr.z << 16) * alpha + v1[0], __builtin_bit_cast(float, xr.z & 0xffff0000u) * alpha + v1[1]);
                    w.w = cvt_pk_bf16(__builtin_bit_cast(float, xr.w << 16) * alpha + v1[2], __builtin_bit_cast(float, xr.w & 0xffff0000u) * alpha + v1[3]);
                    *(u32x4*)(y + off + bj * HALF) = w; } }
    }
};
struct EpiMoe1 {
    static constexpr bool PERM = true, AFTER_DRAIN = false;
    bf16_t* h; const PG8_LAS int* tstart; const PG8_LAS int* cntl;
    __device__ __forceinline__ void operator()(const f32x4 (&acc)[2][2][4][2], const Unit& u, int wr, int wc, int fr, int fq) const {
        const int row0 = u.pm * BM + wr * 64 + fr, col0 = u.pn * HALF + wc * 32 + 8 * fq;
        const int rlim = cntl[u.e] - (u.pm - tstart[u.e]) * BM;
#pragma unroll
        for (int ai = 0; ai < 2; ++ai)
#pragma unroll
            for (int m = 0; m < 4; ++m) { unsigned char* rowp = (unsigned char*)h + (size_t)(row0 + ai * HALF + m * 16) * 512 + col0; float o[8];
                if (wr * 64 + fr + ai * HALF + m * 16 >= rlim) continue;
#pragma unroll
                for (int n = 0; n < 2; ++n)
#pragma unroll
                    for (int x = 0; x < 4; ++x) { const float a = acc[ai][0][m][n][x], b = acc[ai][1][m][n][x];
                        o[n * 4 + x] = a * __builtin_amdgcn_rcpf(1.0f + __builtin_amdgcn_exp2f(-a * LOG2E)) * b; }
                unsigned lo = 0u, hi = 0u; lo = __builtin_amdgcn_cvt_pk_fp8_f32(o[0], o[1], lo, false); lo = __builtin_amdgcn_cvt_pk_fp8_f32(o[2], o[3], lo, true);
                hi = __builtin_amdgcn_cvt_pk_fp8_f32(o[4], o[5], hi, false); hi = __builtin_amdgcn_cvt_pk_fp8_f32(o[6], o[7], hi, true);
                typedef unsigned u32x2e __attribute__((ext_vector_type(2))); u32x2e w; w.x = lo; w.y = hi; *(u32x2e*)rowp = w; }
    }
};
}

namespace att {
using bf16x8 = __attribute__((ext_vector_type(8))) short;
using s16x4  = __attribute__((ext_vector_type(4))) short;
using f32x16 = __attribute__((ext_vector_type(16))) float;
using u32x4  = __attribute__((ext_vector_type(4))) unsigned;
constexpr int DH = 128, QBLK = 32, KVBLK = 64;
constexpr float THR2 = 8.f * 1.4426950408889634f;
constexpr size_t SHM_V = KVBLK * DH * 2, SHM_K = KVBLK * DH * 2, SHM_ATTN = 2 * SHM_V + 2 * SHM_K + NWAVES * 64 * 4;
constexpr int TAB_N = 160;
#define KSWZ(row, colB) ((row) * 256 + ((colB) ^ (((row) & 7) << 4)))
#define SBAR() __builtin_amdgcn_sched_barrier(0)
__device__ __forceinline__ int crow(int r, int hi) { return (r & 3) + 8 * (r >> 2) + 4 * hi; }
__device__ __forceinline__ unsigned cvtpk(float lo, float hi) { unsigned r; asm volatile("v_cvt_pk_bf16_f32 %0, %1, %2" : "=v"(r) : "v"(lo), "v"(hi)); return r; }

__device__ __forceinline__ void partialSM(f32x16& p0, f32x16& p1, float& m_reg, float& mn, float& alpha) {
  float pmax = p0[0];
#pragma unroll
  for (int r = 1; r < 16; ++r) pmax = fmaxf(pmax, p0[r]);
#pragma unroll
  for (int r = 0; r < 16; ++r) pmax = fmaxf(pmax, p1[r]);
  { auto rr = __builtin_amdgcn_permlane32_swap(__float_as_uint(pmax), __float_as_uint(pmax), false, false);
    pmax = fmaxf(__uint_as_float(rr[0]), __uint_as_float(rr[1])); }
  if (__builtin_expect(__all(pmax - m_reg <= THR2), 1)) { mn = m_reg; alpha = 1.f; }
  else { mn = fmaxf(m_reg, pmax); alpha = __builtin_amdgcn_exp2f(m_reg - mn); m_reg = mn; }
#pragma unroll
  for (int r = 0; r < 16; ++r) p0[r] = p0[r] - mn;
#pragma unroll
  for (int r = 0; r < 16; ++r) p1[r] = p1[r] - mn;
#pragma unroll
  for (int r = 0; r < 16; ++r) p0[r] = __builtin_amdgcn_exp2f(p0[r]);
}
__device__ __forceinline__ void finishSM(f32x16& p0, f32x16& p1, float alpha, float& l_reg, bf16x8& pa0, bf16x8& pa1, bf16x8& pa2, bf16x8& pa3) {
#pragma unroll
  for (int r = 0; r < 16; ++r) p1[r] = __builtin_amdgcn_exp2f(p1[r]);
  float ps = 0;
#pragma unroll
  for (int r = 0; r < 16; ++r) ps += p0[r];
#pragma unroll
  for (int r = 0; r < 16; ++r) ps += p1[r];
  { auto rr = __builtin_amdgcn_permlane32_swap(__float_as_uint(ps), __float_as_uint(ps), false, false);
    ps = __uint_as_float(rr[0]) + __uint_as_float(rr[1]); }
  l_reg = l_reg * alpha + ps;
#define PK4(P, BASE, OUT) do { unsigned a0 = cvtpk(P[BASE + 0], P[BASE + 1]), a1 = cvtpk(P[BASE + 2], P[BASE + 3]);   \
    unsigned b0 = cvtpk(P[BASE + 4], P[BASE + 5]), b1 = cvtpk(P[BASE + 6], P[BASE + 7]);                              \
    auto r0 = __builtin_amdgcn_permlane32_swap(a0, b0, false, false); auto r1 = __builtin_amdgcn_permlane32_swap(a1, b1, false, false); \
    u32x4 w = {r0[0], r1[0], r0[1], r1[1]}; OUT = *reinterpret_cast<bf16x8*>(&w); } while (0)
  PK4(p0, 0, pa0); PK4(p0, 8, pa1); PK4(p1, 0, pa2); PK4(p1, 8, pa3);
#undef PK4
}
__device__ __forceinline__ void qkt(f32x16& p0, f32x16& p1, const char* Ks, const bf16x8* qr, int r32, int hi) {
  p0 = f32x16{}; p1 = f32x16{};
#pragma unroll
  for (int d0 = 0; d0 < 8; ++d0) { const int cb = (d0 * 16 + hi * 8) * 2;
    bf16x8 b0 = *reinterpret_cast<const bf16x8*>(Ks + KSWZ(r32, cb));
    bf16x8 b1 = *reinterpret_cast<const bf16x8*>(Ks + KSWZ(32 + r32, cb));
    p0 = __builtin_amdgcn_mfma_f32_32x32x16_bf16(b0, qr[d0], p0, 0, 0, 0);
    p1 = __builtin_amdgcn_mfma_f32_32x32x16_bf16(b1, qr[d0], p1, 0, 0, 0); }
}
__device__ __forceinline__ int v_st(int k, int c) { const int kk = (k & ~0xC) | ((k & 4) << 1) | ((k & 8) >> 1); return ((kk >> 3) * 4 + (c >> 5)) * 512 + ((kk & 7) * 32 + (c & 31)) * 2; }
__device__ __forceinline__ int v_rd_base(int lane) { return ((lane & 3) << 3) | (((lane >> 2) & 3) << 6) | (((lane >> 4) & 1) << 5) | (((lane >> 5) & 1) << 8); }
constexpr int v_rd_off(int d0, int ks, int half) { return d0 * 512 + ks * 4096 + half * 2048; }
template <int OFF> __device__ __forceinline__ s16x4 tr_read(int vb) {
  s16x4 r; asm volatile("ds_read_b64_tr_b16 %0, %1 offset:%2" : "=&v"(r) : "v"(vb), "i"(OFF) : "memory"); return r;
}
template <int D0> __device__ __forceinline__ void pv_one(f32x16& od, int vb, bf16x8 pa0, bf16x8 pa1, bf16x8 pa2, bf16x8 pa3) {
  const s16x4 l0 = tr_read<v_rd_off(D0, 0, 0)>(vb), h0 = tr_read<v_rd_off(D0, 0, 1)>(vb), l1 = tr_read<v_rd_off(D0, 1, 0)>(vb), h1 = tr_read<v_rd_off(D0, 1, 1)>(vb);
  const s16x4 l2 = tr_read<v_rd_off(D0, 2, 0)>(vb), h2 = tr_read<v_rd_off(D0, 2, 1)>(vb), l3 = tr_read<v_rd_off(D0, 3, 0)>(vb), h3 = tr_read<v_rd_off(D0, 3, 1)>(vb);
  asm volatile("s_waitcnt lgkmcnt(0)" ::: "memory"); SBAR();
#define PK(L, H) (bf16x8){L[0], L[1], L[2], L[3], H[0], H[1], H[2], H[3]}
  od = __builtin_amdgcn_mfma_f32_32x32x16_bf16(pa0, PK(l0, h0), od, 0, 0, 0);
  od = __builtin_amdgcn_mfma_f32_32x32x16_bf16(pa1, PK(l1, h1), od, 0, 0, 0);
  od = __builtin_amdgcn_mfma_f32_32x32x16_bf16(pa2, PK(l2, h2), od, 0, 0, 0);
  od = __builtin_amdgcn_mfma_f32_32x32x16_bf16(pa3, PK(l3, h3), od, 0, 0, 0);
#undef PK
}
__device__ __forceinline__ void pv_d0(f32x16* o, int vb, bf16x8 pa0, bf16x8 pa1, bf16x8 pa2, bf16x8 pa3) {
  pv_one<0>(o[0], vb, pa0, pa1, pa2, pa3); pv_one<1>(o[1], vb, pa0, pa1, pa2, pa3); pv_one<2>(o[2], vb, pa0, pa1, pa2, pa3); pv_one<3>(o[3], vb, pa0, pa1, pa2, pa3);
}
template <int MODE> __device__ __forceinline__ void post_scores(f32x16& p0, f32x16& p1, int t, int qrow0, int r32, int hi, const float* tab, float cfar) {
  if constexpr (MODE == 1) {
    const int cw = qrow0 >> 6;
    if (t > cw) {
#pragma unroll
      for (int r = 0; r < 16; ++r) { p0[r] = -INFINITY; p1[r] = -INFINITY; }
    } else if (qrow0 - (64 * t + 63) >= 91) {
#pragma unroll
      for (int r = 0; r < 16; ++r) { p0[r] += cfar; p1[r] += cfar; }
    } else {
      const int base = qrow0 + r32 - 64 * t + 63;
#pragma unroll
      for (int r = 0; r < 16; ++r) { const int i0 = base - crow(r, hi); const int i1 = i0 - 32;
        p0[r] += tab[i0 < TAB_N - 1 ? i0 : TAB_N - 1]; p1[r] += tab[i1 < TAB_N - 1 ? i1 : TAB_N - 1]; }
    }
  }
}

template <int MODE>
__device__ __forceinline__ void attn_body(const bf16* __restrict__ Qb, int ldq, const bf16* __restrict__ Kh, const bf16* __restrict__ Vh, int ldk,
                                          bf16* Ob, float* Of, int ldo, int NT, int q0abs, const float* tab, float cfar, char* lds) {
  int tid_ = threadIdx.x; asm volatile("" : "+v"(tid_));
  const int tid = tid_, wid = tid >> 6, lane = tid & 63, r32 = lane & 31, hi = lane >> 5;
  char* V_lds = lds; char* K_lds = lds + 2 * SHM_V;
  float* ws = (float*)(lds + 2 * SHM_V + 2 * SHM_K) + wid * 64; float* li_l = ws; float* al_l = ws + 32;
  float m_reg = -1e30f, l_reg = 0; f32x16 o[4] = {}; bf16x8 qr[8];
  const int qrow0 = q0abs + wid * QBLK;
  const bf16* Qw = Qb + (long)(wid * QBLK + r32) * ldq + hi * 8;
#pragma unroll
  for (int d0 = 0; d0 < 8; ++d0) qr[d0] = *reinterpret_cast<const bf16x8*>(Qw + d0 * 16);
  const int sr = tid >> 4, sc = (tid & 15) * 8, vst0 = v_st(sr, sc), vst1 = v_st(32 + sr, sc);
  const int vb0 = (int)(uintptr_t)V_lds + v_rd_base(lane);
  struct { bf16x8 vs0, vs1, ks0, ks1; } sr_[2];
#define SLOAD(i, k0) do { sr_[i].vs0 = *reinterpret_cast<const bf16x8*>(&Vh[(long)((k0) + sr) * ldk + sc]); sr_[i].vs1 = *reinterpret_cast<const bf16x8*>(&Vh[(long)((k0) + 32 + sr) * ldk + sc]); \
    sr_[i].ks0 = *reinterpret_cast<const bf16x8*>(&Kh[(long)((k0) + sr) * ldk + sc]); sr_[i].ks1 = *reinterpret_cast<const bf16x8*>(&Kh[(long)((k0) + 32 + sr) * ldk + sc]); } while (0)
#define SWRITE(b, i) do { *(bf16x8*)(V_lds + (b) * SHM_V + vst0) = sr_[i].vs0;          \
    *(bf16x8*)(V_lds + (b) * SHM_V + vst1) = sr_[i].vs1; const int kc = sc * 2;               \
    *(bf16x8*)(K_lds + (b) * SHM_K + KSWZ(sr, kc)) = sr_[i].ks0;                       \
    *(bf16x8*)(K_lds + (b) * SHM_K + KSWZ(32 + sr, kc)) = sr_[i].ks1; } while (0)
#define SWAIT() asm volatile("s_waitcnt vmcnt(4)" ::: "memory")
#define RESC(a) do { if (__any((a) < 1.f)) { if (hi == 0) al_l[r32] = (a); asm volatile("s_waitcnt lgkmcnt(0)" ::: "memory"); \
    _Pragma("unroll") for (int d = 0; d < 4; ++d) _Pragma("unroll") for (int r = 0; r < 16; ++r) o[d][r] *= al_l[crow(r, hi)]; } } while (0)
  f32x16 pA0, pA1, pB0, pB1; float mnA, mnB, alA, alB; bf16x8 pa0, pa1, pa2, pa3;
  constexpr int SE = 0, SO = 1;
  SLOAD(SE, 0); asm volatile("s_waitcnt vmcnt(0)" ::: "memory"); SWRITE(0, SE); __syncthreads();
  qkt(pA0, pA1, K_lds, qr, r32, hi); post_scores<MODE>(pA0, pA1, 0, qrow0, r32, hi, tab, cfar); partialSM(pA0, pA1, m_reg, mnA, alA);
  SLOAD(SO, KVBLK); if (2 < NT) SLOAD(SE, 2 * KVBLK);
  SWAIT(); SWRITE(1, SO); __syncthreads();
  for (int j = 1; j + 1 < NT; j += 2) {
    SBAR(); qkt(pB0, pB1, K_lds + SHM_K, qr, r32, hi); post_scores<MODE>(pB0, pB1, j, qrow0, r32, hi, tab, cfar);
    finishSM(pA0, pA1, alA, l_reg, pa0, pa1, pa2, pa3); SBAR();
    SLOAD(SO, (j + 2) * KVBLK); SBAR();
    pv_d0(o, vb0, pa0, pa1, pa2, pa3); partialSM(pB0, pB1, m_reg, mnB, alB);
    __syncthreads(); SWAIT(); SWRITE(0, SE);
    RESC(alB); __syncthreads();
    SBAR(); qkt(pA0, pA1, K_lds, qr, r32, hi); post_scores<MODE>(pA0, pA1, j + 1, qrow0, r32, hi, tab, cfar);
    finishSM(pB0, pB1, alB, l_reg, pa0, pa1, pa2, pa3); SBAR();
    if (j + 3 < NT) SLOAD(SE, (j + 3) * KVBLK); SBAR();
    pv_d0(o, vb0 + (int)SHM_V, pa0, pa1, pa2, pa3); partialSM(pA0, pA1, m_reg, mnA, alA);
    __syncthreads(); SWAIT(); SWRITE(1, SO);
    RESC(alA); __syncthreads();
  }
  SBAR(); qkt(pB0, pB1, K_lds + SHM_K, qr, r32, hi); post_scores<MODE>(pB0, pB1, NT - 1, qrow0, r32, hi, tab, cfar);
  finishSM(pA0, pA1, alA, l_reg, pa0, pa1, pa2, pa3); SBAR();
  pv_d0(o, vb0, pa0, pa1, pa2, pa3); partialSM(pB0, pB1, m_reg, mnB, alB);
  __syncthreads(); RESC(alB);
  finishSM(pB0, pB1, alB, l_reg, pa0, pa1, pa2, pa3); SBAR();
  pv_d0(o, vb0 + (int)SHM_V, pa0, pa1, pa2, pa3);
  if (hi == 0) li_l[r32] = l_reg; asm volatile("s_waitcnt lgkmcnt(0)" ::: "memory");
  float rli[16];
#pragma unroll
  for (int r = 0; r < 16; ++r) rli[r] = __builtin_amdgcn_rcpf(li_l[crow(r, hi)]);
  if constexpr (MODE == 0) {
    bf16* Ow = Ob + (long)(wid * QBLK) * ldo;
#pragma unroll
    for (int r = 0; r < 16; ++r) { const int orow = crow(r, hi);
#pragma unroll
      for (int d0 = 0; d0 < 4; ++d0) Ow[(long)orow * ldo + d0 * 32 + r32] = (bf16)f2bf(o[d0][r] * rli[r]); }
  } else {
    float* Ow = Of + (long)(wid * QBLK) * ldo;
#pragma unroll
    for (int r = 0; r < 16; ++r) { const int orow = crow(r, hi);
#pragma unroll
      for (int d0 = 0; d0 < 4; ++d0) Ow[(long)orow * ldo + d0 * 32 + r32] = o[d0][r] * rli[r]; }
  }
  __syncthreads();
#undef SLOAD
#undef SWRITE
#undef SWAIT
#undef RESC
}
}

#define XB_TMO      128
#define XB_XCNT(j)  (256  + 64 * (j))
#define XB_XSUB(j)  (1280 + 64 * (j))
#define XB_XGEN(j)  (2304 + 64 * (j))
#define XB_TOP      3328
#define XB_TOPGEN   3392
#define XCD_BAR_WORDS 3456
#define XB_SPIN_CAP (1u << 18)

__device__ __forceinline__ unsigned xb_ld(unsigned* p)              { return __hip_atomic_load(p, __ATOMIC_RELAXED, __HIP_MEMORY_SCOPE_AGENT); }
__device__ __forceinline__ unsigned xb_add(unsigned* p, unsigned v) { return __hip_atomic_fetch_add(p, v, __ATOMIC_RELAXED, __HIP_MEMORY_SCOPE_AGENT); }
__device__ __forceinline__ unsigned xb_xcc_id() { return (unsigned)__builtin_amdgcn_s_getreg((3 << 11) | 20) & 0xFu; }
#define XB_SPIN(cond, bar) do { unsigned _sp = 0; while (cond) { __builtin_amdgcn_s_sleep(1); \
    if ((++_sp & 255u) == 0u) { if (xb_ld(&(bar)[XB_TMO])) break; if (_sp > XB_SPIN_CAP) { atomicAdd(&(bar)[XB_TMO], 1u); break; } } } } while (0)

struct XcdBarrier {
    unsigned* bar; unsigned x;
    volatile LAS unsigned* st;
};

__device__ __forceinline__ XcdBarrier xcd_barrier_post(unsigned* bar, volatile LAS unsigned* st) {
    XcdBarrier b; b.bar = bar; b.x = xb_xcc_id(); b.st = st;
    if (threadIdx.x == 0) (void)xb_add(&bar[XB_XCNT(b.x)], 1u);
    return b;
}
__device__ __forceinline__ void xcd_barrier_complete(unsigned* bar, unsigned x, unsigned& nloc, unsigned& nx) {
    const unsigned G = gridDim.x * gridDim.y * gridDim.z;
    unsigned sum, cnt, mine, sp = 0u;
    for (;;) {
        sum = 0u; cnt = 0u; mine = 0u;
#pragma unroll
        for (unsigned j = 0; j < 16; ++j) { const unsigned c = xb_ld(&bar[XB_XCNT(j)]); sum += c; cnt += (c > 0u) ? 1u : 0u; mine = (j == x) ? c : mine; }
        if (sum == G) break;
        __builtin_amdgcn_s_sleep(1);
        if ((++sp & 255u) == 0u) { if (xb_ld(&bar[XB_TMO])) break; if (sp > XB_SPIN_CAP) { atomicAdd(&bar[XB_TMO], 1u); break; } }
    }
    nloc = mine > 0u ? mine : 1u; nx = cnt > 0u ? cnt : 1u;
}

__device__ __forceinline__ void xcd_barrier(const XcdBarrier& b) {
    asm volatile("s_waitcnt vmcnt(0)" ::: "memory");
    __syncthreads();
    if (threadIdx.x == 0) {
        unsigned* bar = b.bar;
        __builtin_amdgcn_s_waitcnt(0);
        unsigned nloc = b.st[0], nx = b.st[1];
        if (nloc == 0u) { xcd_barrier_complete(bar, b.x, nloc, nx); b.st[0] = nloc; b.st[1] = nx; }
        const unsigned old = xb_add(&bar[XB_XSUB(b.x)], 1u);
        const unsigned gen = old / nloc;
        if (old + 1u == (gen + 1u) * nloc) {
            __builtin_amdgcn_fence(__ATOMIC_RELEASE, "agent");
            asm volatile("s_waitcnt vmcnt(0)" ::: "memory");
            const unsigned og = xb_add(&bar[XB_TOP], 1u);
            const unsigned tg = og / nx;
            if (og + 1u == (tg + 1u) * nx) xb_add(&bar[XB_TOPGEN], 1u);
            else XB_SPIN(xb_ld(&bar[XB_TOPGEN]) == tg, bar);
            __builtin_amdgcn_fence(__ATOMIC_ACQUIRE, "agent");
            xb_add(&bar[XB_XGEN(b.x)], 1u);
            asm volatile("s_waitcnt vmcnt(0)" ::: "memory");
        } else {
            XB_SPIN(xb_ld(&bar[XB_XGEN(b.x)]) == gen, bar);
            __builtin_amdgcn_fence(__ATOMIC_ACQUIRE, "agent");
            asm volatile("s_waitcnt vmcnt(0)" ::: "memory");
        }
    }
    __syncthreads();
}


struct Args { const float* in[24]; float* out; unsigned char* ws; int ph_lo, ph_hi; };
enum { I_X = 0, I_MEM, I_AWIN, I_ALNG, I_ALNB, I_AWS, I_ABS, I_AWOUT, I_BWIN, I_BLAM, I_BSUBG, I_BWOUT, I_WKV, I_RELB, I_MEMWKV, I_LNG, I_LNB,
       I_WG1, I_BG1, I_WG2, I_BG2, I_W1, I_W3, I_W2 };
constexpr int NPH_LAYER = 9, NPHASES = 1 + DEPTH * NPH_LAYER;

struct Frame {
    LAS unsigned char* lds; char* ldsg;
    gu32* ctl; unsigned char* ws;
    int tid, lane, wave, G, c;
};

__device__ __forceinline__ void transpose_item(const float* W, int K, int N, bf16* WT, int drow0, LAS float* scr, int k0, int n0, int lane) {
#pragma unroll 8
    for (int i = 0; i < 32; ++i) { const int kk = 2 * i + (lane >> 5); scr[kk * 33 + (lane & 31)] = W[(size_t)(k0 + kk) * N + n0 + (lane & 31)]; }
    LDS_WAIT(); asm volatile("" ::: "memory");
    const int c = lane & 7;
#pragma unroll
    for (int j = 0; j < 4; ++j) { const int n = (lane >> 3) + 8 * j; const LAS float* s = scr + (8 * c) * 33 + n;
        v4u o; o.x = pk2(s[0 * 33], s[1 * 33]); o.y = pk2(s[2 * 33], s[3 * 33]); o.z = pk2(s[4 * 33], s[5 * 33]); o.w = pk2(s[6 * 33], s[7 * 33]);
        *(GAS v4u*)(WT + (size_t)(drow0 + n) * K + k0 + 8 * c) = o; }
    LDS_WAIT(); asm volatile("" ::: "memory");
}
__device__ __forceinline__ void transpose_item_fast(const float* W, int K, int N, bf16* WT, int drow0, LAS float* scr, int k0, int n0, int lane) {
    float t[32];
#pragma unroll
    for (int i = 0; i < 32; ++i) t[i] = W[(size_t)(k0 + 2 * i + (lane >> 5)) * N + n0 + (lane & 31)];
#pragma unroll
    for (int i = 0; i < 32; i += 8) asm volatile("" : "+v"(t[i]), "+v"(t[i + 1]), "+v"(t[i + 2]), "+v"(t[i + 3]), "+v"(t[i + 4]), "+v"(t[i + 5]), "+v"(t[i + 6]), "+v"(t[i + 7]));
#pragma unroll
    for (int i = 0; i < 32; ++i) scr[(2 * i + (lane >> 5)) * 33 + (lane & 31)] = t[i];
    LDS_WAIT(); asm volatile("" ::: "memory");
    const int c = lane & 7;
#pragma unroll
    for (int j = 0; j < 4; ++j) { const int n = (lane >> 3) + 8 * j; const LAS float* s = scr + (8 * c) * 33 + n;
        v4u o; o.x = pk2(s[0 * 33], s[1 * 33]); o.y = pk2(s[2 * 33], s[3 * 33]); o.z = pk2(s[4 * 33], s[5 * 33]); o.w = pk2(s[6 * 33], s[7 * 33]);
        *(GAS v4u*)(WT + (size_t)(drow0 + n) * K + k0 + 8 * c) = o; }
    LDS_WAIT(); asm volatile("" ::: "memory");
}
__device__ __forceinline__ void transpose_item_fp8(const float* W, int K, int N, unsigned char* WT, int drow0, LAS float* scr, int k0, int n0, int lane) {
    float t[32];
#pragma unroll
    for (int i = 0; i < 32; ++i) t[i] = W[(size_t)(k0 + 2 * i + (lane >> 5)) * N + n0 + (lane & 31)];
#pragma unroll
    for (int i = 0; i < 32; i += 8) asm volatile("" : "+v"(t[i]), "+v"(t[i + 1]), "+v"(t[i + 2]), "+v"(t[i + 3]), "+v"(t[i + 4]), "+v"(t[i + 5]), "+v"(t[i + 6]), "+v"(t[i + 7]));
#pragma unroll
    for (int i = 0; i < 32; ++i) scr[(2 * i + (lane >> 5)) * 33 + (lane & 31)] = t[i];
    LDS_WAIT(); asm volatile("" ::: "memory");
    const int c = lane & 7;
#pragma unroll
    for (int j = 0; j < 4; ++j) { const int n = (lane >> 3) + 8 * j; const LAS float* s = scr + (8 * c) * 33 + n;
        unsigned lo = 0u, hi = 0u;
        lo = __builtin_amdgcn_cvt_pk_fp8_f32(s[0 * 33] * 64.f, s[1 * 33] * 64.f, lo, false); lo = __builtin_amdgcn_cvt_pk_fp8_f32(s[2 * 33] * 64.f, s[3 * 33] * 64.f, lo, true);
        hi = __builtin_amdgcn_cvt_pk_fp8_f32(s[4 * 33] * 64.f, s[5 * 33] * 64.f, hi, false); hi = __builtin_amdgcn_cvt_pk_fp8_f32(s[6 * 33] * 64.f, s[7 * 33] * 64.f, hi, true);
        v2u o; o.x = lo; o.y = hi; *(GAS v2u*)(WT + (size_t)(drow0 + n) * K + k0 + 8 * c) = o; }
    LDS_WAIT(); asm volatile("" ::: "memory");
}
#ifndef CDRAIN
#define CDRAIN 8
#endif
#ifndef CSRV
#define CSRV 4
#endif
#ifndef CSRVA
#define CSRVA 32
#endif
#ifndef STOPU
#define STOPU 64
#endif
#ifndef QX
#define QX 6
#endif
#ifndef QA
#define QA 14
#endif
#ifndef QM
#define QM 7
#endif
#ifndef QB
#define QB 4
#endif
constexpr int NQ = 7, MOE_ITEMS = 3 * 32 * 512;
__device__ __forceinline__ int conv_qsize(int q) { return (q & 1) ? (q == 1 ? 5632 : (q == 3 ? 7168 : 4096)) : MOE_ITEMS; }
__device__ __forceinline__ void conv_item(Frame& F, const Args& a, int q, int it) {
    LAS float* scr = (LAS float*)(F.lds + RING_OFF + F.wave * 16384);
    if (q & 1) {
        const float* src; bf16* dst; int N, r = it;
        if (q == 1) { if (r < 3584) { N = 3584; src = a.in[I_AWIN] + (size_t)2048 * 3584; dst = (bf16*)(F.ws + WS_WAIN) + (size_t)2048 * 3584; } else { r -= 3584; N = 2048; src = a.in[I_AWOUT] + (size_t)2048 * 2048; dst = (bf16*)(F.ws + WS_WAOUT) + (size_t)2048 * 2048; } }
        else if (q == 3) { if (r < 2048) { N = 2048; src = a.in[I_BWIN]; dst = (bf16*)(F.ws + WS_WBIN0); } else if ((r -= 2048) < 3072) { N = 3072; src = a.in[I_WKV]; dst = (bf16*)(F.ws + WS_WKV); } else { r -= 3072; N = 2048; src = a.in[I_BWOUT]; dst = (bf16*)(F.ws + WS_WBOUT); } }
        else { if (r < 2048) { N = 2048; src = a.in[I_BWIN] + (size_t)2048 * 2048; dst = (bf16*)(F.ws + WS_WBIN1); } else { r -= 2048; N = 2048; src = a.in[I_BWOUT] + (size_t)2048 * 2048; dst = (bf16*)(F.ws + WS_WBOUT) + (size_t)2048 * 2048; } }
        const int nblk = N / 32, kb = r / nblk, nb = r - kb * nblk;
        transpose_item_fast(src, 2048, N, dst, 32 * nb, scr, 64 * kb, 32 * nb, F.lane);
        return;
    }
    const int L = q >> 1, seg = it >> 14, r0 = it & 16383, e = r0 >> 9, r = r0 & 511, mat = L * 32 + e;
    if (seg < 2) { const int kb = r >> 4, nb = r & 15, n0 = 32 * nb;
        transpose_item_fp8(a.in[seg == 0 ? I_W1 : I_W3] + (size_t)mat * 2048 * 512, 2048, 512, (unsigned char*)(F.ws + WS_W13) + (size_t)mat * 1024 * 2048, (n0 >> 7) * 256 + (n0 & 127) + (seg == 1 ? 128 : 0), scr, 64 * kb, n0, F.lane); }
    else { const int kb = r >> 6, nb = r & 63;
        transpose_item_fp8(a.in[I_W2] + (size_t)mat * 512 * 2048, 512, 2048, (unsigned char*)(F.ws + WS_W2) + (size_t)mat * 512 * 2048, 32 * nb, scr, 64 * kb, 32 * nb, F.lane); }
}
#ifndef F8MASK
#define F8MASK 4
#endif
#define F8L(l) (((F8MASK) >> (l)) & 1)
#ifndef CDEPTH
#define CDEPTH 3
#endif
struct CDesc { const float* src; unsigned char* dst; int N, K, drow0, k0, n0, f8; };
__device__ __forceinline__ CDesc conv_desc(Frame& F, const Args& a, int q, int it) {
    CDesc d;
    if (q & 1) {
        const float* src; unsigned char* dst; int N, r = it, f8 = F8L((q + 1) >> 1);
        if (q == 1) { if (r < 3584) { N = 3584; src = a.in[I_AWIN] + (size_t)2048 * 3584; dst = F.ws + WS_WAIN + (size_t)2048 * 3584 * 2; } else { r -= 3584; N = 2048; f8 = 0; src = a.in[I_AWOUT] + (size_t)2048 * 2048; dst = F.ws + WS_WAOUT + (size_t)2048 * 2048 * 2; } }
        else if (q == 3) { if (r < 2048) { N = 2048; src = a.in[I_BWIN]; dst = F.ws + WS_WBIN0; } else if ((r -= 2048) < 3072) { N = 3072; src = a.in[I_WKV]; dst = F.ws + WS_WBIN0 + (size_t)2048 * 2048 * (F8L(2) ? 1 : 2); } else { r -= 3072; N = 2048; f8 = 0; src = a.in[I_BWOUT]; dst = F.ws + WS_WBOUT; } }
        else { if (r < 2048) { N = 2048; src = a.in[I_BWIN] + (size_t)2048 * 2048; dst = F.ws + WS_WBIN1; } else { r -= 2048; N = 2048; f8 = 0; src = a.in[I_BWOUT] + (size_t)2048 * 2048; dst = F.ws + WS_WBOUT + (size_t)2048 * 2048 * 2; } }
        const int nblk = N / 32, kb = r / nblk, nb = r - kb * nblk;
        d.src = src; d.dst = dst; d.N = N; d.K = 2048; d.drow0 = 32 * nb; d.k0 = 64 * kb; d.n0 = 32 * nb; d.f8 = f8; return d;
    }
    const int L = q >> 1, seg = it >> 14, r0 = it & 16383, e = r0 >> 9, r = r0 & 511, mat = L * 32 + e;
    if (seg < 2) { const int kb = r >> 4, nb = r & 15, n0 = 32 * nb;
        d.src = a.in[seg == 0 ? I_W1 : I_W3] + (size_t)mat * 2048 * 512; d.dst = (unsigned char*)(F.ws + WS_W13) + (size_t)mat * 1024 * 2048; d.N = 512; d.K = 2048;
        d.drow0 = (n0 >> 7) * 256 + (n0 & 127) + (seg == 1 ? 128 : 0); d.k0 = 64 * kb; d.n0 = n0; d.f8 = 1; }
    else { const int kb = r >> 6, nb = r & 63;
        d.src = a.in[I_W2] + (size_t)mat * 512 * 2048; d.dst = (unsigned char*)(F.ws + WS_W2) + (size_t)mat * 512 * 2048; d.N = 2048; d.K = 512; d.drow0 = 32 * nb; d.k0 = 64 * kb; d.n0 = 32 * nb; d.f8 = 1; }
    return d;
}
#define CV_LOAD(t_, d_) do { const float* p_ = (d_).src + (size_t)((d_).k0 + (F.lane >> 3)) * (d_).N + (d_).n0 + 4 * (F.lane & 7); const size_t st_ = (size_t)8 * (d_).N; \
    _Pragma("unroll") for (int i_ = 0; i_ < 8; ++i_) (t_)[i_] = *(const GAS f32x4*)(p_ + st_ * i_); } while (0)
__device__ __forceinline__ void conv_process(Frame& F, f32x4 (&t)[8], const CDesc& d) {
    LAS float* scr = (LAS float*)(F.lds + RING_OFF + F.wave * 16384); const int lane = F.lane;
    asm volatile("" : "+v"(t[0]), "+v"(t[1]), "+v"(t[2]), "+v"(t[3]), "+v"(t[4]), "+v"(t[5]), "+v"(t[6]), "+v"(t[7]));
    { LAS float* w = scr + (lane >> 3) * 33 + 4 * (lane & 7);
#pragma unroll
      for (int i = 0; i < 8; ++i) { w[i * 8 * 33 + 0] = t[i].x; w[i * 8 * 33 + 1] = t[i].y; w[i * 8 * 33 + 2] = t[i].z; w[i * 8 * 33 + 3] = t[i].w; } }
    LDS_WAIT(); asm volatile("" ::: "memory");
    const int c = lane & 7;
    if (d.f8) {
#pragma unroll
        for (int j = 0; j < 4; ++j) { const int n = (lane >> 3) + 8 * j; const LAS float* s = scr + (8 * c) * 33 + n;
            unsigned lo = 0u, hi = 0u;
            lo = __builtin_amdgcn_cvt_pk_fp8_f32(s[0 * 33] * 64.f, s[1 * 33] * 64.f, lo, false); lo = __builtin_amdgcn_cvt_pk_fp8_f32(s[2 * 33] * 64.f, s[3 * 33] * 64.f, lo, true);
            hi = __builtin_amdgcn_cvt_pk_fp8_f32(s[4 * 33] * 64.f, s[5 * 33] * 64.f, hi, false); hi = __builtin_amdgcn_cvt_pk_fp8_f32(s[6 * 33] * 64.f, s[7 * 33] * 64.f, hi, true);
            v2u o; o.x = lo; o.y = hi; *(GAS v2u*)(d.dst + (size_t)(d.drow0 + n) * d.K + d.k0 + 8 * c) = o; }
    } else {
#pragma unroll
        for (int j = 0; j < 4; ++j) { const int n = (lane >> 3) + 8 * j; const LAS float* s = scr + (8 * c) * 33 + n;
            v4u o; o.x = pk2(s[0 * 33], s[1 * 33]); o.y = pk2(s[2 * 33], s[3 * 33]); o.z = pk2(s[4 * 33], s[5 * 33]); o.w = pk2(s[6 * 33], s[7 * 33]);
            *(GAS v4u*)((bf16*)d.dst + (size_t)(d.drow0 + n) * d.K + d.k0 + 8 * c) = o; }
    }
    LDS_WAIT(); asm volatile("" ::: "memory");
}
__device__ __forceinline__ void conv_range(Frame& F, const Args& a, int q, int first, int cnt) {
#if CDEPTH == 1
    for (int i = 0; i < cnt; ++i) conv_item(F, a, q, first + i);
#else
    f32x4 t[CDEPTH][8]; const int last = first + cnt - 1;
#pragma unroll
    for (int s = 0; s < CDEPTH - 1; ++s) { const int it = first + s < last ? first + s : last; const CDesc d = conv_desc(F, a, q, it); CV_LOAD(t[s], d); }
#pragma unroll 1
    for (int i0 = 0; i0 < cnt; i0 += CDEPTH) {
#pragma unroll
        for (int s = 0; s < CDEPTH; ++s) {
            { const int nx = first + i0 + s + CDEPTH - 1, it = nx < last ? nx : last; const CDesc d = conv_desc(F, a, q, it); CV_LOAD(t[(s + CDEPTH - 1) % CDEPTH], d); }
            asm volatile("" ::: "memory");
            if (i0 + s < cnt) { const CDesc d = conv_desc(F, a, q, first + i0 + s); conv_process(F, t[s], d); }
        }
    }
#endif
}
__device__ __forceinline__ void conv_filler(Frame& F, const Args& a, int q0, int n) {
    if (q0 >= NQ || n == 0) return;
#ifdef CONV_ALL_PRO
    return;
#endif
    LAS unsigned* bw = (LAS unsigned*)(F.lds + TAB_OFF + 384);
    __syncthreads();
    const bool drain = n < 0; const int per = drain ? CDRAIN : n; int q = q0;
    for (;;) {
        if (F.tid == 0) bw[0] = __hip_atomic_fetch_add(F.ctl + CW_CONV + 64 * q, (unsigned)(8 * per), RLX_AGENT);
        __syncthreads();
        const unsigned idx = bw[0];
        __syncthreads();
        const int qs = conv_qsize(q);
        if (idx >= (unsigned)qs) { if (drain || ++q >= NQ) break; continue; }
        { const int first = (int)idx + F.wave * per, cnt = (qs - first < per) ? qs - first : per; if (cnt > 0) conv_range(F, a, q, first, cnt); }
        if (!drain) break;
    }
}

__device__ __forceinline__ void prologue_phase(Frame& F, const Args& a) {
#ifdef TOUCH
    {
        const long nthr_ = (long)F.G * 512, gt_ = (long)F.c * 512 + F.tid; unsigned acc_ = 0u;
        for (long pg = gt_; pg < (long)(WS_END / 4096); pg += nthr_) acc_ += *(const GAS unsigned*)(F.ws + pg * 4096);
        for (long pg = gt_; pg < (long)((size_t)DEPTH * NE * D * FF * 4 / 4096); pg += nthr_) { acc_ += *(const GAS unsigned*)((const char*)a.in[I_W1] + pg * 4096); acc_ += *(const GAS unsigned*)((const char*)a.in[I_W3] + pg * 4096); acc_ += *(const GAS unsigned*)((const char*)a.in[I_W2] + pg * 4096); }
        if (acc_ == 0x12345679u) F.ctl[CW_TMO] = acc_;
    }
#endif
    LAS float* scr = (LAS float*)(F.lds + RING_OFF + F.wave * 16384);
    const int gw = F.c * NWAVES + F.wave, NGW = F.G * NWAVES;
    unsigned char* ws = F.ws;
    constexpr int S0 = 3584, S1 = 2048, S5 = 4 * 1024;
    constexpr int NITEMS = S0 + S1 + S5;
    for (int it = gw; it < NITEMS; it += NGW) {
        int r = it; const float* src; unsigned char* dst; int K = 2048, N; bool f8 = F8L(0);
        if (r < S0) { N = 3584; src = a.in[I_AWIN]; dst = ws + WS_WAIN; }
        else if ((r -= S0) < S1) { N = 2048; f8 = false; src = a.in[I_AWOUT]; dst = ws + WS_WAOUT; }
        else { r -= S1; const int mat = r >> 10; r &= 1023; N = 1024; src = a.in[I_MEMWKV] + (size_t)mat * K * N; dst = ws + WS_WMKV + (size_t)mat * K * N * (F8L(0) ? 1 : 2); }
        const int nblk = N / 32, kb = r / nblk, nb = r - kb * nblk;
        if (f8) transpose_item_fp8(src, K, N, dst, 32 * nb, scr, 64 * kb, 32 * nb, F.lane);
        else transpose_item_fast(src, K, N, (bf16*)dst, 32 * nb, scr, 64 * kb, 32 * nb, F.lane);
    }
#ifdef CONV_ALL_PRO
    for (int q = 0; q < NQ; ++q) { const int qs = conv_qsize(q); for (int it = gw * 4; it < qs; it += NGW * 4) conv_range(F, a, q, it, qs - it < 4 ? qs - it : 4); }
#endif
    const long nthr = (long)F.G * 512, gt = (long)F.c * 512 + F.tid;
    { float* wr = (float*)(ws + WS_WR);
      for (long i = gt; i < (long)DEPTH * 3 * 512 * 16 * 4; i += nthr) { const int j = (int)(i & 3), c = (int)((i >> 2) & 15), kg = (int)((i >> 6) & 511), r = (int)(i >> 15), nb = r % 3, l = r / 3;
          const int k = 4 * kg + j, o = 16 * nb + c; float v = 0.f;
          if (o < 4) v = a.in[I_WG1][((size_t)l * D + k) * 4 + o]; else if (o < 36) { const int g = (o - 4) >> 3, e = (o - 4) & 7; v = a.in[I_WG2][(((size_t)l * 4 + g) * D + k) * 8 + e]; }
          wr[i] = v; } }
    { const float* x = a.in[I_X]; bf16* xb = (bf16*)(ws + WS_XB);
      for (long i = gt; i < (long)T * D / 8; i += nthr) { const f32x4 v0 = *(const GAS f32x4*)(x + i * 8), v1 = *(const GAS f32x4*)(x + i * 8 + 4);
          v4u o; o.x = pk2(v0.x, v0.y); o.y = pk2(v0.z, v0.w); o.z = pk2(v1.x, v1.y); o.w = pk2(v1.z, v1.w); *(GAS v4u*)(xb + i * 8) = o;
          unsigned lo = 0u, hi = 0u; lo = __builtin_amdgcn_cvt_pk_fp8_f32(v0.x, v0.y, lo, false); lo = __builtin_amdgcn_cvt_pk_fp8_f32(v0.z, v0.w, lo, true); hi = __builtin_amdgcn_cvt_pk_fp8_f32(v1.x, v1.y, hi, false); hi = __builtin_amdgcn_cvt_pk_fp8_f32(v1.z, v1.w, hi, true);
          v2u qq; qq.x = lo; qq.y = hi; *(GAS v2u*)(ws + WS_XQ + i * 8) = qq; } }
    { const float* x = a.in[I_MEM]; bf16* xb = (bf16*)(ws + WS_MEMB);
      for (long i = gt; i < (long)MEMT * D / 8; i += nthr) { const f32x4 v0 = *(const GAS f32x4*)(x + i * 8), v1 = *(const GAS f32x4*)(x + i * 8 + 4);
          v4u o; o.x = pk2(v0.x, v0.y); o.y = pk2(v0.z, v0.w); o.z = pk2(v1.x, v1.y); o.w = pk2(v1.z, v1.w); *(GAS v4u*)(xb + i * 8) = o;
          unsigned lo = 0u, hi = 0u; lo = __builtin_amdgcn_cvt_pk_fp8_f32(v0.x, v0.y, lo, false); lo = __builtin_amdgcn_cvt_pk_fp8_f32(v0.z, v0.w, lo, true); hi = __builtin_amdgcn_cvt_pk_fp8_f32(v1.x, v1.y, hi, false); hi = __builtin_amdgcn_cvt_pk_fp8_f32(v1.z, v1.w, hi, true);
          v2u qq; qq.x = lo; qq.y = hi; *(GAS v2u*)(ws + WS_MEMQ + i * 8) = qq; } }
}

#ifndef NCVMAX
#define NCVMAX 0
#endif
#ifndef NCVATT
#define NCVATT 96
#endif
__device__ __forceinline__ int conv_servers(int nu, int G, int fin) {
    if (fin || nu <= 0) return 0;
    const int rounds = (nu + G - 1) / G, gmin = (nu + rounds - 1) / rounds; int n = G - gmin; n = n < NCVMAX ? n : NCVMAX; return n & ~7;
}
__device__ __forceinline__ void conv_done(Frame& F, int p) { __syncthreads(); if (F.tid == 0) __hip_atomic_fetch_add(F.ctl + CW_DONE + 64 * p, 1u, RLX_AGENT); }
__device__ __forceinline__ void conv_server(Frame& F, const Args& a, int p, int q0, int ncomp) {
    int q = q0;
    for (;;) {
        if (q >= NQ) break;
        unsigned idx = 0xffffffffu;
        if (F.lane == 0) { if (__hip_atomic_load(F.ctl + CW_DONE + 64 * p, RLX_AGENT) < (unsigned)ncomp) idx = __hip_atomic_fetch_add(F.ctl + CW_CONV + 64 * q, (unsigned)CSRV, RLX_AGENT); }
        idx = (unsigned)__builtin_amdgcn_readfirstlane((int)idx);
        if (idx == 0xffffffffu) break;
        const int qs = conv_qsize(q);
        if (idx >= (unsigned)qs) { ++q; continue; }
        conv_range(F, a, q, (int)idx, (qs - (int)idx < CSRV) ? qs - (int)idx : CSRV);
    }
}
__device__ __forceinline__ void conv_server_q(Frame& F, const Args& a, gu32* head, unsigned stop_at, int q0) {
    int q = q0;
    for (;;) {
        if (q >= NQ) break;
        unsigned idx = 0xffffffffu;
        if (F.lane == 0) { if (__hip_atomic_load(head, RLX_AGENT) < stop_at) idx = __hip_atomic_fetch_add(F.ctl + CW_CONV + 64 * q, (unsigned)CSRVA, RLX_AGENT); }
        idx = (unsigned)__builtin_amdgcn_readfirstlane((int)idx);
        if (idx == 0xffffffffu) break;
        const int qs = conv_qsize(q);
        if (idx >= (unsigned)qs) { ++q; continue; }
        conv_range(F, a, q, (int)idx, (qs - (int)idx < CSRVA) ? qs - (int)idx : CSRVA);
    }
}
__device__ __forceinline__ void conv_note_fin(Frame& F, int p) {
    if (blockIdx.x == 0 && F.tid == 0) { unsigned all = 1u;
        for (int q = 0; q < NQ; ++q) all &= (__hip_atomic_load(F.ctl + CW_CONV + 64 * q, RLX_AGENT) >= (unsigned)conv_qsize(q)) ? 1u : 0u;
        __hip_atomic_store(F.ctl + CW_FIN + 64 * p, all, RLX_AGENT); }
}

__device__ __forceinline__ void sgu_unit(Frame& F, const Args& a, int l, int n, int g) {
    constexpr int LDW = 136;
    LAS float* stats = (LAS float*)(F.lds); LAS bf16* Wl = (LAS bf16*)(F.lds + 1024); LAS bf16* Vt = (LAS bf16*)(F.lds + 35840);
    const bf16* z = (const bf16*)(F.ws + WS_Z); bf16* cat = (bf16*)(F.ws + WS_CAT);
    const int tok0 = n * 128;
    for (int i = 0; i < 16; ++i) { const int tk = F.wave * 16 + i; const GAS v4u* rp = (const GAS v4u*)(z + (size_t)(tok0 + tk) * NINA + MIXW) + F.lane;
        v4u w[3]; float s = 0.f;
#pragma unroll
        for (int j = 0; j < 3; ++j) { w[j] = rp[64 * j]; s += (bflo(w[j].x) + bfhi(w[j].x)) + (bflo(w[j].y) + bfhi(w[j].y)) + (bflo(w[j].z) + bfhi(w[j].z)) + (bflo(w[j].w) + bfhi(w[j].w)); }
        const float mean = wave_sum(s) * (1.f / MIXW); float q = 0.f;
#pragma unroll
        for (int j = 0; j < 3; ++j) { float d;
            d = bflo(w[j].x) - mean; q += d * d; d = bfhi(w[j].x) - mean; q += d * d; d = bflo(w[j].y) - mean; q += d * d; d = bfhi(w[j].y) - mean; q += d * d;
            d = bflo(w[j].z) - mean; q += d * d; d = bfhi(w[j].z) - mean; q += d * d; d = bflo(w[j].w) - mean; q += d * d; d = bfhi(w[j].w) - mean; q += d * d; }
        const float rstd = 1.f / sqrtf(wave_sum(q) * (1.f / MIXW) + LN_EPS);
        if (F.lane == 0) { stats[2 * tk] = mean; stats[2 * tk + 1] = rstd; } }
    { const float* wsrc = a.in[I_AWS] + ((size_t)l * 4 + g) * 128 * 128;
      for (int p = F.tid; p < 128 * 32; p += 512) { const int i = p >> 5, j4 = (p & 31) * 4; f32x4 v = *(const GAS f32x4*)(wsrc + i * 128 + j4);
          if ((j4 >> 6) > (i >> 6)) v = (f32x4){0.f, 0.f, 0.f, 0.f};
          v2u o; o.x = pk2(v.x, v.y); o.y = pk2(v.z, v.w); *(LAS v2u*)(Wl + i * LDW + j4) = o; } }
    __syncthreads();
    { const float* lg = a.in[I_ALNG] + (size_t)l * MIXW + g * 384; const float* lb = a.in[I_ALNB] + (size_t)l * MIXW + g * 384;
      for (int p = F.tid; p < 128 * 48; p += 512) { const int j = p & 127, c8 = (p >> 7) * 8;
          const v4u w = *(const GAS v4u*)(z + (size_t)(tok0 + j) * NINA + MIXW + g * 384 + c8);
          const float mean = stats[2 * j], rstd = stats[2 * j + 1];
          const f32x4 g0 = *(const GAS f32x4*)(lg + c8), g1 = *(const GAS f32x4*)(lg + c8 + 4), b0 = *(const GAS f32x4*)(lb + c8), b1 = *(const GAS f32x4*)(lb + c8 + 4);
          float v[8] = {bflo(w.x), bfhi(w.x), bflo(w.y), bfhi(w.y), bflo(w.z), bfhi(w.z), bflo(w.w), bfhi(w.w)};
          const float gg[8] = {g0.x, g0.y, g0.z, g0.w, g1.x, g1.y, g1.z, g1.w}, bb[8] = {b0.x, b0.y, b0.z, b0.w, b1.x, b1.y, b1.z, b1.w};
#pragma unroll
          for (int e = 0; e < 8; ++e) Vt[(c8 + e) * LDW + j] = (bf16)f2bf((v[e] - mean) * rstd * gg[e] + bb[e]); } }
    __syncthreads();
    const int fr = F.lane & 15, fq = F.lane >> 4;
    f32x4 acc[8][3];
#pragma unroll
    for (int mb = 0; mb < 8; ++mb)
#pragma unroll
        for (int nb = 0; nb < 3; ++nb) acc[mb][nb] = (f32x4){0.f, 0.f, 0.f, 0.f};
#pragma unroll
    for (int ks = 0; ks < 4; ++ks) { bf16x8 bfr[3];
#pragma unroll
        for (int nb = 0; nb < 3; ++nb) bfr[nb] = *(const LAS bf16x8*)(Vt + (F.wave * 48 + nb * 16 + fr) * LDW + ks * 32 + fq * 8);
#pragma unroll
        for (int mb = 0; mb < 8; ++mb) { const bf16x8 afr = *(const LAS bf16x8*)(Wl + (mb * 16 + fr) * LDW + ks * 32 + fq * 8);
#pragma unroll
            for (int nb = 0; nb < 3; ++nb) acc[mb][nb] = __builtin_amdgcn_mfma_f32_16x16x32_bf16(bfr[nb], afr, acc[mb][nb], 0, 0, 0); } }
    const float* bs = a.in[I_ABS] + ((size_t)l * 4 + g) * 128;
#pragma unroll
    for (int mb = 0; mb < 8; ++mb) { const int i = mb * 16 + fr; const float bsv = bs[i]; const size_t tk = (size_t)(tok0 + i);
#pragma unroll
        for (int nb = 0; nb < 3; ++nb) { const int c = g * 384 + F.wave * 48 + nb * 16 + 4 * fq;
            const v2u uw = *(const GAS v2u*)(z + tk * NINA + c); const f32x4 gt = acc[mb][nb] + bsv;
            v2u o; o.x = pk2(bflo(uw.x) * gt.x, bfhi(uw.x) * gt.y); o.y = pk2(bflo(uw.y) * gt.z, bfhi(uw.y) * gt.w);
            *(GAS v2u*)(cat + tk * D + c) = o; } }
    __syncthreads();
}

__device__ __forceinline__ void memattn_unit(Frame& F, int l, int hm, int qb, int ldz, int qoff) {
    const bf16* z = (const bf16*)(F.ws + WS_Z); const bf16* kv = (const bf16*)(F.ws + WS_MEMKV) + (size_t)l * 256 * 1024; bf16* cat = (bf16*)(F.ws + WS_CAT);
    att::attn_body<0>(z + (size_t)qb * 256 * ldz + qoff + hm * 128, ldz, kv + hm * 128, kv + 512 + hm * 128, 1024,
                      cat + (size_t)qb * 256 * D + MIXW + hm * 128, nullptr, D, 4, 0, nullptr, 0.f, F.ldsg);
}

__device__ __forceinline__ int t5_bucket(int rel) {
    const int a = rel < 0 ? -rel : rel; int f;
    if (a < 8) f = a; else if (a < 12) f = 8; else if (a < 16) f = 9; else if (a < 23) f = 10; else if (a < 32) f = 11; else if (a < 46) f = 12; else if (a < 64) f = 13; else if (a < 91) f = 14; else f = 15;
    return (rel > 0 ? 16 : 0) + f;
}

namespace att2 {
using att::bf16x8; using att::s16x4; using att::f32x16; using att::u32x4; using att::crow; using att::cvtpk; using att::tr_read; using att::v_rd_base;
constexpr int KT = 32, ST_K = KT * 128 * 2, ST_V = KT * 256 * 2, STAGE = 2 * ST_K + ST_V, NST = 3;
constexpr int LDS_WS = NST * STAGE, LDS_TAB = LDS_WS + 2048, LDS_UNIT = LDS_TAB + 640, LDS_END = LDS_UNIT + 16;
constexpr int NUNITS = 576;
constexpr float THR2 = 8.f * 1.4426950408889634f;
__device__ __forceinline__ int swap23(int k) { return (k & ~0xC) | ((k & 4) << 1) | ((k & 8) >> 1); }
constexpr int v_off(int d0, int ks, int half) { return d0 * 512 + ks * 8192 + half * 4096; }

struct UnitTable { unsigned short u[NUNITS]; };
constexpr UnitTable make_units() {
    UnitTable t{}; int n = 0;
    for (int c = 256; c >= 4; c -= 2) {
        { const int b = (c - 2) / 2; if ((c - 2) % 2 == 0 && b >= 32 && b <= 63) for (int part = 1; part <= 2; ++part) for (int h = 0; h < 6; ++h) t.u[n++] = (unsigned short)(h | (b << 3) | (part << 9)); }
        if (c % 4 == 0) { const int b = c / 4 - 1; if (b >= 0 && b < 32) for (int h = 0; h < 6; ++h) t.u[n++] = (unsigned short)(h | (b << 3)); }
    }
    return t;
}
__device__ const UnitTable g_units = make_units();

__device__ __forceinline__ void diff_unit(const bf16* __restrict__ Q, const bf16* __restrict__ KD, const bf16* __restrict__ VD, float* Obuf  , int orow0,
                                          float* ML  , const float* relb, int h, int b, int t_lo, int t_hi, LAS char* lds) {
  int tid_ = threadIdx.x; asm volatile("" : "+v"(tid_));
  const int tid = tid_, wid = __builtin_amdgcn_readfirstlane(tid >> 6), lane = tid & 63, r32 = lane & 31, hi = lane >> 5, m = wid >> 2, rg = wid & 3;
  LAS float* wsw = (LAS float*)(lds + LDS_WS) + wid * 64; LAS float* li_l = wsw; LAS float* al_l = wsw + 32;
  LAS float* tab = (LAS float*)(lds + LDS_TAB);
  if (tid < att::TAB_N) tab[tid] = relb[t5_bucket(63 - tid) * 6 + h] * LOG2E;
  const float cfar = relb[15 * 6 + h] * LOG2E;
  const int qrow0 = b * 128 + rg * 32;
  bf16x8 qr[8];
  { const bf16* Qw = Q + (size_t)(qrow0 + r32) * 2048 + h * 256 + m * 128 + hi * 8;
#pragma unroll
    for (int d0 = 0; d0 < 8; ++d0) qr[d0] = *reinterpret_cast<const bf16x8*>(Qw + d0 * 16); }
  int ko[2], vo[2];
#pragma unroll
  for (int i = 0; i < 2; ++i) {
    const int p = wid * 64 + lane, row = p >> 4, cp = (p & 15) ^ (row & 7); ko[i] = row * 1536 + h * 256 + i * 128 + cp * 8; }
#pragma unroll
  for (int i = 0; i < 2; ++i) {
    const int p = (wid * 2 + i) * 64 + lane, sub = p >> 5, kg = sub >> 3, cblk = sub & 7, q = p & 31, kk = kg * 8 + (q >> 2), key = swap23(kk);
    vo[i] = key * 1536 + h * 256 + cblk * 32 + (q & 3) * 8; }
  const unsigned ldsb = (unsigned)(uintptr_t)lds;
#define A2_ISSUE(t, s) do { const size_t kb_ = (size_t)(t) * KT * 1536; LAS char* sb_ = lds + (s) * STAGE; \
    __builtin_amdgcn_global_load_lds((const unsigned*)(KD + kb_ + ko[0]), (LAS unsigned*)(sb_ + wid * 1024), 16, 0, 0); \
    __builtin_amdgcn_global_load_lds((const unsigned*)(KD + kb_ + ko[1]), (LAS unsigned*)(sb_ + ST_K + wid * 1024), 16, 0, 0); \
    __builtin_amdgcn_global_load_lds((const unsigned*)(VD + kb_ + vo[0]), (LAS unsigned*)(sb_ + 2 * ST_K + (wid * 2) * 1024), 16, 0, 0); \
    __builtin_amdgcn_global_load_lds((const unsigned*)(VD + kb_ + vo[1]), (LAS unsigned*)(sb_ + 2 * ST_K + (wid * 2 + 1) * 1024), 16, 0, 0); } while (0)
  const int vis = 2 * (2 * b + (rg >> 1) + 1);
  float m_reg = -1e30f, l_reg = 0.f; f32x16 o[8];
#pragma unroll
  for (int d = 0; d < 8; ++d) o[d] = f32x16{};
  asm volatile("s_waitcnt vmcnt(0)" ::: "memory");
  A2_ISSUE(t_lo, 0); if (t_lo + 1 < t_hi) A2_ISSUE(t_lo + 1, 1);
  int s = 0;
  for (int t = t_lo; t < t_hi; ++t) {
    if (t + 1 < t_hi) asm volatile("s_waitcnt vmcnt(4) lgkmcnt(0)" ::: "memory"); else asm volatile("s_waitcnt vmcnt(0) lgkmcnt(0)" ::: "memory");
    __builtin_amdgcn_s_barrier(); asm volatile("" ::: "memory");
    if (t + 2 < t_hi) { const int s2 = (s >= 1) ? s - 1 : s + 2; A2_ISSUE(t + 2, s2); }
    if (t < vis) {
      const LAS char* Ks = lds + s * STAGE + m * ST_K;
      f32x16 p = f32x16{};
#pragma unroll
      for (int d0 = 0; d0 < 8; ++d0) { const int cb = (d0 * 16 + hi * 8) * 2;
        const bf16x8 b0 = *(const LAS bf16x8*)(Ks + KSWZ(r32, cb));
        p = __builtin_amdgcn_mfma_f32_32x32x16_bf16(b0, qr[d0], p, 0, 0, 0); }
      if (qrow0 - (KT * t + KT - 1) >= 91) {
#pragma unroll
        for (int r = 0; r < 16; ++r) p[r] += cfar;
      } else { const int base = qrow0 + r32 - KT * t + 63;
#pragma unroll
        for (int r = 0; r < 16; ++r) { const int i0 = base - crow(r, hi); p[r] += tab[i0 < att::TAB_N - 1 ? i0 : att::TAB_N - 1]; } }
      float pmax = p[0];
#pragma unroll
      for (int r = 1; r < 16; ++r) pmax = fmaxf(pmax, p[r]);
      { auto rr = __builtin_amdgcn_permlane32_swap(__float_as_uint(pmax), __float_as_uint(pmax), false, false); pmax = fmaxf(__uint_as_float(rr[0]), __uint_as_float(rr[1])); }
      float mn, alpha;
      if (__builtin_expect(__all(pmax - m_reg <= THR2), 1)) { mn = m_reg; alpha = 1.f; }
      else { mn = fmaxf(m_reg, pmax); alpha = __builtin_amdgcn_exp2f(m_reg - mn); m_reg = mn; }
      float ps = 0.f;
#pragma unroll
      for (int r = 0; r < 16; ++r) { p[r] = __builtin_amdgcn_exp2f(p[r] - mn); ps += p[r]; }
      { auto rr = __builtin_amdgcn_permlane32_swap(__float_as_uint(ps), __float_as_uint(ps), false, false); ps = __uint_as_float(rr[0]) + __uint_as_float(rr[1]); }
      l_reg = l_reg * alpha + ps;
      bf16x8 pa0, pa1;
#define A2_PK4(P, BASE, OUT) do { unsigned a0 = cvtpk(P[BASE + 0], P[BASE + 1]), a1 = cvtpk(P[BASE + 2], P[BASE + 3]);   \
    unsigned b0_ = cvtpk(P[BASE + 4], P[BASE + 5]), b1_ = cvtpk(P[BASE + 6], P[BASE + 7]);                              \
    auto r0 = __builtin_amdgcn_permlane32_swap(a0, b0_, false, false); auto r1 = __builtin_amdgcn_permlane32_swap(a1, b1_, false, false); \
    u32x4 w = {r0[0], r1[0], r0[1], r1[1]}; OUT = *reinterpret_cast<bf16x8*>(&w); } while (0)
      A2_PK4(p, 0, pa0); A2_PK4(p, 8, pa1);
      if (__any(alpha < 1.f)) { if (hi == 0) al_l[r32] = alpha; asm volatile("s_waitcnt lgkmcnt(0)" ::: "memory");
#pragma unroll
        for (int d = 0; d < 8; ++d)
#pragma unroll
          for (int r = 0; r < 16; ++r) o[d][r] *= al_l[crow(r, hi)]; }
      const int vb = (int)(ldsb + s * STAGE + 2 * ST_K) + v_rd_base(lane);
      asm volatile("s_waitcnt lgkmcnt(0)" ::: "memory"); SBAR();
#define A2_PK(L, H) (bf16x8){L[0], L[1], L[2], L[3], H[0], H[1], H[2], H[3]}
#define A2_RD(D0, l0, h0, l1, h1) do { l0 = tr_read<v_off(D0, 0, 0)>(vb); h0 = tr_read<v_off(D0, 0, 1)>(vb); l1 = tr_read<v_off(D0, 1, 0)>(vb); h1 = tr_read<v_off(D0, 1, 1)>(vb); } while (0)
#define A2_MM(D0, l0, h0, l1, h1) do { o[D0] = __builtin_amdgcn_mfma_f32_32x32x16_bf16(pa0, A2_PK(l0, h0), o[D0], 0, 0, 0); o[D0] = __builtin_amdgcn_mfma_f32_32x32x16_bf16(pa1, A2_PK(l1, h1), o[D0], 0, 0, 0); } while (0)
      s16x4 xl0, xh0, xl1, xh1, yl0, yh0, yl1, yh1;
      A2_RD(0, xl0, xh0, xl1, xh1);
      A2_RD(1, yl0, yh0, yl1, yh1); asm volatile("s_waitcnt lgkmcnt(4)" ::: "memory"); SBAR(); A2_MM(0, xl0, xh0, xl1, xh1); SBAR();
      A2_RD(2, xl0, xh0, xl1, xh1); asm volatile("s_waitcnt lgkmcnt(4)" ::: "memory"); SBAR(); A2_MM(1, yl0, yh0, yl1, yh1); SBAR();
      A2_RD(3, yl0, yh0, yl1, yh1); asm volatile("s_waitcnt lgkmcnt(4)" ::: "memory"); SBAR(); A2_MM(2, xl0, xh0, xl1, xh1); SBAR();
      A2_RD(4, xl0, xh0, xl1, xh1); asm volatile("s_waitcnt lgkmcnt(4)" ::: "memory"); SBAR(); A2_MM(3, yl0, yh0, yl1, yh1); SBAR();
      A2_RD(5, yl0, yh0, yl1, yh1); asm volatile("s_waitcnt lgkmcnt(4)" ::: "memory"); SBAR(); A2_MM(4, xl0, xh0, xl1, xh1); SBAR();
      A2_RD(6, xl0, xh0, xl1, xh1); asm volatile("s_waitcnt lgkmcnt(4)" ::: "memory"); SBAR(); A2_MM(5, yl0, yh0, yl1, yh1); SBAR();
      A2_RD(7, yl0, yh0, yl1, yh1); asm volatile("s_waitcnt lgkmcnt(4)" ::: "memory"); SBAR(); A2_MM(6, xl0, xh0, xl1, xh1); SBAR();
      asm volatile("s_waitcnt lgkmcnt(0)" ::: "memory"); SBAR(); A2_MM(7, yl0, yh0, yl1, yh1); SBAR();
    }
    s = (s == 2) ? 0 : s + 1;
  }
  if (hi == 0) li_l[r32] = l_reg; asm volatile("s_waitcnt lgkmcnt(0)" ::: "memory");
  float rli[16];
#pragma unroll
  for (int r = 0; r < 16; ++r) rli[r] = __builtin_amdgcn_rcpf(li_l[crow(r, hi)]);
  float* Ow = Obuf + (size_t)(qrow0 - orow0) * 3072 + (h * 2 + m) * 256;
#pragma unroll
  for (int r = 0; r < 16; ++r) { const int orow = crow(r, hi);
#pragma unroll
    for (int d0 = 0; d0 < 8; ++d0) Ow[(size_t)orow * 3072 + d0 * 32 + r32] = o[d0][r] * rli[r]; }
  if (hi == 0) { float* mlp = ML + (((size_t)(qrow0 - orow0 + r32) * 6 + h) * 2 + m) * 2; mlp[0] = m_reg; mlp[1] = l_reg; }
  asm volatile("s_waitcnt vmcnt(0) lgkmcnt(0)" ::: "memory");
  __builtin_amdgcn_s_barrier(); asm volatile("" ::: "memory");
#undef A2_ISSUE
#undef A2_PK4
#undef A2_PK
#undef A2_RD
#undef A2_MM
}
}

__device__ __forceinline__ void diffattn2_unit(Frame& F, const Args& a, unsigned code) {
    const int h = code & 7, b = (code >> 3) & 63, pc = code >> 9, nt = 4 * b + 4;
    const int t_lo = (pc == 2) ? nt / 2 : 0, t_hi = (pc == 1) ? nt / 2 : nt;
    float* ob = (float*)(F.ws + (pc == 2 ? WS_OP2 : WS_OP)); float* ml = (float*)(F.ws + WS_ML) + (pc == 2 ? (size_t)T * 6 * 2 * 2 : 0);
    att2::diff_unit((const bf16*)(F.ws + WS_Z), (const bf16*)(F.ws + WS_KD), (const bf16*)(F.ws + WS_VD), ob, pc == 2 ? 4096 : 0, ml, a.in[I_RELB], h, b, t_lo, t_hi, (LAS char*)F.lds);
}
__device__ __forceinline__ void diffcombine_phase(Frame& F, const Args& a, int l) {
    const int i = l - 2; const float* lp = a.in[I_BLAM] + (size_t)i * 4 * 128;
    float s1 = lp[F.lane] * lp[128 + F.lane] + lp[64 + F.lane] * lp[128 + 64 + F.lane], s2 = lp[256 + F.lane] * lp[384 + F.lane] + lp[256 + 64 + F.lane] * lp[384 + 64 + F.lane];
    s1 = wave_sum(s1); s2 = wave_sum(s2);
    const float lam_init = 0.8f - 0.6f * expf(-0.3f * (float)l);
    const float lam = expf(s1) - expf(s2) + lam_init;
    const float* op0 = (const float*)(F.ws + WS_OP); const float* op1 = (const float*)(F.ws + WS_OP2); const float* ml0 = (const float*)(F.ws + WS_ML); const float* ml1 = ml0 + (size_t)T * 6 * 2 * 2;
    bf16* cat = (bf16*)(F.ws + WS_CAT);
    const f32x4 gsub = *(const GAS f32x4*)(a.in[I_BSUBG] + (size_t)i * 256 + 4 * F.lane);
    const int gw = F.c * NWAVES + F.wave, NGW = F.G * NWAVES;
    for (int it = gw; it < T * 6; it += NGW) { const int tk = it / 6, h = it - tk * 6; f32x4 os[2];
#pragma unroll
        for (int m = 0; m < 2; ++m) { const size_t r0 = ((size_t)tk * 6 + h) * 2 + m; f32x4 oa = *(const GAS f32x4*)(op0 + r0 * 256 + 4 * F.lane);
            if (tk >= 4096) { const size_t r1 = ((size_t)(tk - 4096) * 6 + h) * 2 + m; const f32x4 ob = *(const GAS f32x4*)(op1 + r1 * 256 + 4 * F.lane);
                const float ma = ml0[r0 * 2], la = ml0[r0 * 2 + 1], mb = ml1[r1 * 2], lb = ml1[r1 * 2 + 1], M = fmaxf(ma, mb);
                const float wa = la * exp2f(ma - M), wb = lb * exp2f(mb - M), inv = 1.f / (wa + wb); oa = oa * (wa * inv) + ob * (wb * inv); }
            os[m] = oa; }
        const f32x4 o = os[0] - os[1] * lam; const float ss = wave_sum((o.x * o.x + o.y * o.y) + (o.z * o.z + o.w * o.w));
        const float r = (1.f - lam_init) / sqrtf(ss * (1.f / 256.f) + LN_EPS);
        v2u w; w.x = pk2(o.x * r * gsub.x, o.y * r * gsub.y); w.y = pk2(o.z * r * gsub.z, o.w * r * gsub.w);
        *(GAS v2u*)(cat + (size_t)tk * D + h * 256 + 4 * F.lane) = w; }
}


__device__ __forceinline__ void ln1_router_phase(Frame& F, const Args& a, int l, int probe = 0) {
    const bf16* y = (const bf16*)(F.ws + WS_Y); bf16* x1b = (bf16*)(F.ws + WS_X1B);
    const float* lng = a.in[I_LNG] + ((size_t)l * 2 + 0) * D; const float* lnb = a.in[I_LNB] + ((size_t)l * 2 + 0) * D;
    const float* wr = (const float*)(F.ws + WS_WR) + (size_t)l * 3 * 512 * 16 * 4;
    int* tok_e = (int*)(F.ws + (probe ? WS_OP : WS_ROUTE)); int* tok_rank = tok_e + 2 * T; float* tok_gate = (float*)(tok_rank + 2 * T);
    gu32* cnt = F.ctl + (probe ? 65536 : CW_CNT) + 2048 * l;
    LAS float* P = (LAS float*)(F.lds);
    typedef float f32x4v __attribute__((ext_vector_type(4)));
    for (int tb = F.c; tb < T / 32; tb += F.G) {
#pragma unroll 2
        for (int i = 0; i < 4; ++i) { const int tk = tb * 32 + F.wave * 4 + i;
            const GAS v4u* yr = (const GAS v4u*)(y + (size_t)tk * D) + F.lane;
            float v[4][8]; float s = 0.f;
#pragma unroll
            for (int j = 0; j < 4; ++j) { const v4u w = yr[64 * j]; v[j][0] = bflo(w.x); v[j][1] = bfhi(w.x); v[j][2] = bflo(w.y); v[j][3] = bfhi(w.y); v[j][4] = bflo(w.z); v[j][5] = bfhi(w.z); v[j][6] = bflo(w.w); v[j][7] = bfhi(w.w);
#pragma unroll
                for (int e = 0; e < 8; ++e) s += v[j][e]; }
            const float mean = wave_sum(s) * (1.f / D); float s2 = 0.f;
#pragma unroll
            for (int j = 0; j < 4; ++j)
#pragma unroll
                for (int e = 0; e < 8; ++e) { v[j][e] -= mean; s2 += v[j][e] * v[j][e]; }
            const float rstd = 1.f / sqrtf(wave_sum(s2) * (1.f / D) + LN_EPS);
#pragma unroll
            for (int j = 0; j < 4; ++j) { const int d0 = 8 * F.lane + 512 * j; const f32x4 g0 = *(const GAS f32x4*)(lng + d0), g1 = *(const GAS f32x4*)(lng + d0 + 4), b0 = *(const GAS f32x4*)(lnb + d0), b1 = *(const GAS f32x4*)(lnb + d0 + 4);
                const float q0 = v[j][0] * rstd * g0.x + b0.x, q1 = v[j][1] * rstd * g0.y + b0.y, q2 = v[j][2] * rstd * g0.z + b0.z, q3 = v[j][3] * rstd * g0.w + b0.w;
                const float q4 = v[j][4] * rstd * g1.x + b1.x, q5 = v[j][5] * rstd * g1.y + b1.y, q6 = v[j][6] * rstd * g1.z + b1.z, q7 = v[j][7] * rstd * g1.w + b1.w;
                v4u w; w.x = pk2(q0, q1); w.y = pk2(q2, q3); w.z = pk2(q4, q5); w.w = pk2(q6, q7);
                *(GAS v4u*)(x1b + (size_t)tk * D + d0) = w;
                unsigned lo = 0u, hi = 0u; lo = __builtin_amdgcn_cvt_pk_fp8_f32(q0, q1, lo, false); lo = __builtin_amdgcn_cvt_pk_fp8_f32(q2, q3, lo, true);
                hi = __builtin_amdgcn_cvt_pk_fp8_f32(q4, q5, hi, false); hi = __builtin_amdgcn_cvt_pk_fp8_f32(q6, q7, hi, true);
                v2u qq; qq.x = lo; qq.y = hi; *(GAS v2u*)((unsigned char*)(F.ws + WS_X1F) + (size_t)tk * D + d0) = qq; } }
        VM_WAIT(); __syncthreads();
        { const int mt = F.wave >> 2, kq = F.wave & 3, c = F.lane & 15, q = F.lane >> 4;
          const bf16* ap = x1b + (size_t)(tb * 32 + mt * 16 + c) * D + kq * 512 + 4 * q;
          const float* bp = wr + ((size_t)(kq * 128 + q) * 16 + c) * 4;
          f32x4v acc[3] = {{0.f, 0.f, 0.f, 0.f}, {0.f, 0.f, 0.f, 0.f}, {0.f, 0.f, 0.f, 0.f}};
#pragma unroll 4
          for (int ks = 0; ks < 32; ++ks) { const v2u aw = *(const GAS v2u*)(ap + 16 * ks); const f32x4 a4 = (f32x4){bflo(aw.x), bfhi(aw.x), bflo(aw.y), bfhi(aw.y)}; f32x4 b4[3];
#pragma unroll
              for (int nb = 0; nb < 3; ++nb) b4[nb] = *(const GAS f32x4*)(bp + ((size_t)nb * 512 + 4 * ks) * 64);
#pragma unroll
              for (int j = 0; j < 4; ++j)
#pragma unroll
                  for (int nb = 0; nb < 3; ++nb) acc[nb] = __builtin_amdgcn_mfma_f32_16x16x4f32(a4[j], b4[nb][j], acc[nb], 0, 0, 0); }
#pragma unroll
          for (int nb = 0; nb < 3; ++nb)
#pragma unroll
              for (int r = 0; r < 4; ++r) P[((kq * 2 + mt) * 16 + 4 * q + r) * 48 + nb * 16 + c] = acc[nb][r]; }
        __syncthreads();
        if (F.tid < 32) { const int tk = tb * 32 + F.tid, mt = F.tid >> 4, ti = F.tid & 15;
            const LAS f32x4* P4 = (const LAS f32x4*)P;
            const int rb = (mt * 16 + ti) * 12;
            const float* bg1 = a.in[I_BG1] + l * 4; const float* bg2 = a.in[I_BG2] + l * 32;
            const f32x4 s1 = (P4[rb] + P4[rb + 384]) + (P4[rb + 768] + P4[rb + 1152]);
            const float l10 = s1.x + bg1[0], l11 = s1.y + bg1[1], l12 = s1.z + bg1[2], l13 = s1.w + bg1[3];
            int grp = 0; float mx = l10;
            if (l11 > mx) { mx = l11; grp = 1; } if (l12 > mx) { mx = l12; grp = 2; } if (l13 > mx) { mx = l13; grp = 3; }
            const float psel = 1.f / (expf(l10 - mx) + expf(l11 - mx) + expf(l12 - mx) + expf(l13 - mx));
            const int ob = rb + 1 + 2 * grp;
            const f32x4 sa = (P4[ob] + P4[ob + 384]) + (P4[ob + 768] + P4[ob + 1152]), sb = (P4[ob + 1] + P4[ob + 385]) + (P4[ob + 769] + P4[ob + 1153]);
            const f32x4 ba = *(const GAS f32x4*)(bg2 + grp * 8), bb = *(const GAS f32x4*)(bg2 + grp * 8 + 4);
            const float l2[8] = {sa.x + ba.x, sa.y + ba.y, sa.z + ba.z, sa.w + ba.w, sb.x + bb.x, sb.y + bb.y, sb.z + bb.z, sb.w + bb.w};
            int i0 = 0; float v0 = l2[0];
#pragma unroll
            for (int e = 1; e < 8; ++e) if (l2[e] > v0) { v0 = l2[e]; i0 = e; }
            int i1 = -1; float v1 = -INFINITY;
#pragma unroll
            for (int e = 0; e < 8; ++e) if (e != i0 && l2[e] > v1) { v1 = l2[e]; i1 = e; }
            const float e1 = expf(v1 - v0), g0 = psel / (1.f + e1), g1 = psel * e1 / (1.f + e1);
            const int ex0 = grp * 8 + i0, ex1 = grp * 8 + i1;
            const unsigned r0 = __hip_atomic_fetch_add(cnt + 64 * ex0, 1u, RLX_AGENT), r1 = __hip_atomic_fetch_add(cnt + 64 * ex1, 1u, RLX_AGENT);
            { int* list = (int*)(F.ws + (probe ? WS_OP + 2 * MiB : WS_LIST)); list[ex0 * 8192 + (int)r0] = tk; list[ex1 * 8192 + (int)r1] = tk; }
            tok_e[2 * tk] = ex0; tok_e[2 * tk + 1] = ex1; tok_rank[2 * tk] = (int)r0; tok_rank[2 * tk + 1] = (int)r1; tok_gate[2 * tk] = g0; tok_gate[2 * tk + 1] = g1; }
        __syncthreads();
    }
}
__device__ __forceinline__ void moe_table(Frame& F, int l) {
    LAS int* tstart = (LAS int*)(F.lds + TAB_OFF);
    if (F.tid == 0) { int acc = 0;
        for (int e = 0; e < 32; ++e) { tstart[e] = acc; const unsigned c = __hip_atomic_load(F.ctl + CW_CNT + 2048 * l + 64 * e, RLX_AGENT); tstart[36 + e] = (int)c; acc += (int)((c + 255u) >> 8); }
        tstart[32] = acc; }
    __syncthreads();
}
__device__ __forceinline__ void ln2_phase(Frame& F, const Args& a, int l) {
    const bf16* x1b = (const bf16*)(F.ws + WS_X1B); const bf16* yb = (const bf16*)(F.ws + WS_YB); bf16* xb = (bf16*)(F.ws + WS_XB);
    const float* lng = a.in[I_LNG] + ((size_t)l * 2 + 1) * D; const float* lnb = a.in[I_LNB] + ((size_t)l * 2 + 1) * D;
    moe_table(F, l); const LAS int* tstart = (const LAS int*)(F.lds + TAB_OFF);
    const int* tok_e = (const int*)(F.ws + WS_ROUTE); const int* tok_rank = tok_e + 2 * T; const float* tok_gate = (const float*)(F.ws + WS_ROUTE) + 4 * T;
    const int gw = F.c * NWAVES + F.wave, NGW = F.G * NWAVES;
    for (int t4 = gw; t4 < T / 4; t4 += NGW) { const int tk0 = t4 * 4;
        int ev = 0, rv = 0; float gv = 0.f;
        if (F.lane < 8) { ev = tok_e[2 * tk0 + F.lane]; rv = tok_rank[2 * tk0 + F.lane]; gv = tok_gate[2 * tk0 + F.lane]; }
        const int slotv = (F.lane < 8) ? tstart[ev] * 256 + rv : 0;
        v4u xr[2], ya[2], yc[2]; v4u xr2[2], ya2[2], yc2[2];
#define LN2_LOAD(i, XR, YA, YC, XR2, YA2, YC2) do { const int s0_ = __builtin_amdgcn_readlane(slotv, 2 * (i)), s1_ = __builtin_amdgcn_readlane(slotv, 2 * (i) + 1); \
        _Pragma("unroll") for (int j = 0; j < 2; ++j) { const int d0 = 8 * F.lane + 512 * j; XR[j] = *(const GAS v4u*)(x1b + (size_t)(tk0 + (i)) * D + d0); YA[j] = *(const GAS v4u*)(yb + (size_t)s0_ * D + d0); YC[j] = *(const GAS v4u*)(yb + (size_t)s1_ * D + d0); } \
        _Pragma("unroll") for (int j = 0; j < 2; ++j) { const int d0 = 8 * F.lane + 512 * (j + 2); XR2[j] = *(const GAS v4u*)(x1b + (size_t)(tk0 + (i)) * D + d0); YA2[j] = *(const GAS v4u*)(yb + (size_t)s0_ * D + d0); YC2[j] = *(const GAS v4u*)(yb + (size_t)s1_ * D + d0); } } while (0)
        LN2_LOAD(0, xr, ya, yc, xr2, ya2, yc2);
#pragma unroll
        for (int i = 0; i < 4; ++i) { const int tk = tk0 + i;
            const float g0 = __builtin_bit_cast(float, __builtin_amdgcn_readlane(__builtin_bit_cast(int, gv), 2 * i)), g1 = __builtin_bit_cast(float, __builtin_amdgcn_readlane(__builtin_bit_cast(int, gv), 2 * i + 1));
            float v[4][8]; float s = 0.f;
#pragma unroll
            for (int j = 0; j < 4; ++j) { const v4u X = j < 2 ? xr[j] : xr2[j - 2], A = j < 2 ? ya[j] : ya2[j - 2], C = j < 2 ? yc[j] : yc2[j - 2];
                v[j][0] = bflo(X.x) * DN_ALPHA + (g0 * bflo(A.x) + g1 * bflo(C.x)); v[j][1] = bfhi(X.x) * DN_ALPHA + (g0 * bfhi(A.x) + g1 * bfhi(C.x));
                v[j][2] = bflo(X.y) * DN_ALPHA + (g0 * bflo(A.y) + g1 * bflo(C.y)); v[j][3] = bfhi(X.y) * DN_ALPHA + (g0 * bfhi(A.y) + g1 * bfhi(C.y));
                v[j][4] = bflo(X.z) * DN_ALPHA + (g0 * bflo(A.z) + g1 * bflo(C.z)); v[j][5] = bfhi(X.z) * DN_ALPHA + (g0 * bfhi(A.z) + g1 * bfhi(C.z));
                v[j][6] = bflo(X.w) * DN_ALPHA + (g0 * bflo(A.w) + g1 * bflo(C.w)); v[j][7] = bfhi(X.w) * DN_ALPHA + (g0 * bfhi(A.w) + g1 * bfhi(C.w));
#pragma unroll
                for (int e = 0; e < 8; ++e) s += v[j][e]; }
            if (i + 1 < 4) LN2_LOAD(i + 1, xr, ya, yc, xr2, ya2, yc2);
            const float mean = wave_sum(s) * (1.f / D); float s2 = 0.f;
#pragma unroll
            for (int j = 0; j < 4; ++j)
#pragma unroll
                for (int e = 0; e < 8; ++e) { v[j][e] -= mean; s2 += v[j][e] * v[j][e]; }
            const float rstd = 1.f / sqrtf(wave_sum(s2) * (1.f / D) + LN_EPS);
#pragma unroll
            for (int j = 0; j < 4; ++j) { const int d0 = 8 * F.lane + 512 * j; const f32x4 g0v = *(const GAS f32x4*)(lng + d0), g1v = *(const GAS f32x4*)(lng + d0 + 4), b0 = *(const GAS f32x4*)(lnb + d0), b1 = *(const GAS f32x4*)(lnb + d0 + 4);
                const f32x4 oa = (f32x4){v[j][0] * rstd * g0v.x + b0.x, v[j][1] * rstd * g0v.y + b0.y, v[j][2] * rstd * g0v.z + b0.z, v[j][3] * rstd * g0v.w + b0.w};
                const f32x4 ob = (f32x4){v[j][4] * rstd * g1v.x + b1.x, v[j][5] * rstd * g1v.y + b1.y, v[j][6] * rstd * g1v.z + b1.z, v[j][7] * rstd * g1v.w + b1.w};
                if (l == DEPTH - 1) { *(GAS f32x4*)(a.out + (size_t)tk * D + d0) = oa; *(GAS f32x4*)(a.out + (size_t)tk * D + d0 + 4) = ob; }
                else { v4u w; w.x = pk2(oa.x, oa.y); w.y = pk2(oa.z, oa.w); w.z = pk2(ob.x, ob.y); w.w = pk2(ob.z, ob.w); *(GAS v4u*)(xb + (size_t)tk * D + d0) = w;
                    unsigned lo = 0u, hi = 0u; lo = __builtin_amdgcn_cvt_pk_fp8_f32(oa.x, oa.y, lo, false); lo = __builtin_amdgcn_cvt_pk_fp8_f32(oa.z, oa.w, lo, true); hi = __builtin_amdgcn_cvt_pk_fp8_f32(ob.x, ob.y, hi, false); hi = __builtin_amdgcn_cvt_pk_fp8_f32(ob.z, ob.w, hi, true);
                    v2u qq; qq.x = lo; qq.y = hi; *(GAS v2u*)(F.ws + WS_XQ + (size_t)tk * D + d0) = qq; } }
        }
#undef LN2_LOAD
    }
}

__global__ void __launch_bounds__(NWAVES * 64, 2) fwd_kernel(Args args) {
    extern __shared__ __attribute__((aligned(16))) unsigned char lds[];
    Frame F;
    F.lds = (LAS unsigned char*)lds; F.ldsg = (char*)lds;
    F.tid = threadIdx.x; F.lane = F.tid & 63; F.wave = __builtin_amdgcn_readfirstlane(F.tid >> 6);
    F.G = gridDim.x; F.c = blockIdx.x; F.ws = args.ws; F.ctl = (gu32*)(args.ws + WS_CTL);
    volatile LAS unsigned* MISC = (volatile LAS unsigned*)(F.lds + MISC_OFF);
    for (int u = F.tid; u < (LDS_BYTES - LDSCTL_OFF) / 4; u += NWAVES * 64) ((LAS unsigned*)(F.lds + LDSCTL_OFF))[u] = 0u;
    __syncthreads();
    const int lo = args.ph_lo, hi = args.ph_hi; int lastp = -1;
    const bool multi = (hi - lo) > 1;
    XcdBarrier bar; bar.bar = (unsigned*)(F.ctl + CW_BAR); bar.x = 0; bar.st = nullptr;
    if (multi) bar = xcd_barrier_post((unsigned*)(F.ctl + CW_BAR), MISC + 8);
#ifndef REP_MASK
#define REP_MASK 0
#endif
#define REP(k) for (int rep_ = 0; rep_ <= ((REP_MASK >> (k)) & 1); ++rep_)
#define IN(p) (lo <= (p) && (p) < hi)
#ifdef PROBE_A
#define STAMP(i) do { if (blockIdx.x == 0 && threadIdx.x == 0) ((unsigned long long*)(args.ws + WS_TS))[(i)] = __builtin_amdgcn_s_memrealtime(); } while (0)
#else
#define STAMP(i) do { } while (0)
#endif
#define SEAM(p) do { conv_note_fin(F, (p)); lastp = (p); if ((p) + 1 < hi) xcd_barrier(bar); STAMP((p) + 1); } while (0)
#define CONVFIN() ((lastp >= 0) ? (int)__hip_atomic_load(F.ctl + CW_FIN + 64 * lastp, RLX_AGENT) : 0)
#define FRESH() do { int t_ = threadIdx.x; asm volatile("" : "+v"(t_)); F.tid = t_; F.lane = t_ & 63; F.wave = __builtin_amdgcn_readfirstlane(t_ >> 6); \
    GAS unsigned char* w_ = (GAS unsigned char*)args.ws; asm volatile("" : "+s"(w_)); F.ws = (unsigned char*)w_; F.ctl = (gu32*)(w_ + WS_CTL); } while (0)

    STAMP(0);
    if (IN(0)) { FRESH(); REP(9) prologue_phase(F, args); SEAM(0); }
#ifdef XBAR
    for (int xb_ = 0; xb_ < XBAR; ++xb_) xcd_barrier(bar);
#endif

    for (int l = 0; l < DEPTH; ++l) {
        const int pb = 1 + NPH_LAYER * l;
        if (IN(pb + 0)) { FRESH();
            const int N = (l < 2) ? NINA : (l == 2 ? 5120 : 2048);
            const unsigned char* Bt = F.ws + ((l < 2) ? WS_WAIN + (size_t)l * NINA * D * 2 : (l == 2 ? WS_WBIN0 : WS_WBIN1));
            const int nu = (T / 256) * (N / 256) + (l == 0 ? 16 : 0), ncv = conv_servers(nu, F.G, CONVFIN()), Gc = F.G - ncv; const bool f8 = F8L(l);
            if (F.c < Gc) {
                pg8::EpiBf16X E{l < 2 ? 0 : 1, (bf16*)(F.ws + WS_Z), (bf16*)(F.ws + WS_KD), (bf16*)(F.ws + WS_VD), (bf16*)(F.ws + WS_MEMKV), nullptr, nullptr};
                if (f8) { pg8::Gemm g{nullptr, nullptr, T, N, D / 2}; pg8::DualOrder8 S; S.init(F.ws + WS_XQ, Bt, T, N, D / 2, Gc, F.c, F.ws + WS_MEMQ, F.ws + WS_WMKV, l == 0 ? 16 : 0);
                    REP(0) pg8::gemm_phase<pg8::EpiBf16X, pg8::DualOrder8, true, true>(F.lds + RING_OFF, g, S, E); }
                else { pg8::Gemm g{nullptr, nullptr, T, N, D}; pg8::DualOrder S; S.init(F.ws + WS_XB, Bt, T, N, D, Gc, F.c, F.ws + WS_MEMB, F.ws + WS_WMKV, l == 0 ? 16 : 0);
                    REP(0) pg8::gemm_phase<pg8::EpiBf16X, pg8::DualOrder, true, true>(F.lds + RING_OFF, g, S, E); }
                if (ncv) conv_done(F, pb + 0);
                { const int mine = (nu - 1 - F.c) / Gc + 1, rounds = (nu + Gc - 1) / Gc; conv_filler(F, args, 2 * l, (rounds - mine) * (f8 ? (QA + 1) / 2 : QA)); }
            } else conv_server(F, args, pb + 0, 2 * l, Gc);
            SEAM(pb + 0);
        }
        if (IN(pb + 1)) { FRESH();
            if (l < 2) {
                REP(1) for (int u = F.c; u < 256 + 128; u += F.G) {
                    if (u < 256) sgu_unit(F, args, l, u >> 2, u & 3);
                    else { const int r = u - 256; memattn_unit(F, l, r & 3, r >> 2, NINA, 2 * MIXW); }
                }
                if (F.c >= 128) conv_filler(F, args, 2 * l, QX);
            } else {
                const int ncv = CONVFIN() ? 0 : NCVATT;
                if (F.c >= F.G - ncv) { conv_server_q(F, args, F.ctl + CW_Q + 64 * l, (unsigned)(att2::NUNITS + 128 - STOPU), 2 * l); __syncthreads(); }
                REP(2) { gu32* qh = F.ctl + CW_Q + 64 * l + 16 * rep_; LAS unsigned* uw = (LAS unsigned*)(F.lds + att2::LDS_UNIT);
                for (;;) {
                    if (F.tid == 0) *uw = __hip_atomic_fetch_add(qh, 1u, RLX_AGENT);
                    __syncthreads();
                    const unsigned idx = *uw;
                    __syncthreads();
                    if (idx >= (unsigned)(att2::NUNITS + 128)) break;
                    if (idx < (unsigned)att2::NUNITS) diffattn2_unit(F, args, att2::g_units.u[idx]);
                    else { const int r = (int)idx - att2::NUNITS; memattn_unit(F, l, r & 3, r >> 2, 2048, MIXW); }
                } }
            }
            SEAM(pb + 1);
        }
        if (IN(pb + 2) && l >= 2) { FRESH(); REP(3) diffcombine_phase(F, args, l); SEAM(pb + 2); }
        if (IN(pb + 3)) { FRESH();
            pg8::Gemm g{nullptr, nullptr, T, D, D}; pg8::DenseOrder S; S.init(F.ws + WS_CAT, F.ws + (l < 2 ? WS_WAOUT + (size_t)l * D * D * 2 : WS_WBOUT + (size_t)(l - 2) * D * D * 2), T, D, D, F.G, F.c);
            pg8::EpiResBf16 E{(const bf16*)(F.ws + WS_XB), (bf16*)(F.ws + WS_Y), DN_ALPHA};
            REP(4) pg8::gemm_phase<pg8::EpiResBf16, pg8::DenseOrder, true, true>(F.lds + RING_OFF, g, S, E);
            SEAM(pb + 3);
        }
        if (IN(pb + 4)) { FRESH(); ln1_router_phase(F, args, l);
#ifdef REP_LN1
            ln1_router_phase(F, args, l, 1);
#endif
            conv_filler(F, args, 2 * l, -1); SEAM(pb + 4); }
        if (IN(pb + 6)) { FRESH();
            moe_table(F, l);
            const LAS int* tb = (const LAS int*)(F.lds + TAB_OFF);
            const int nu = tb[32] * 4, ncv = conv_servers(nu, F.G, CONVFIN()), Gc = F.G - ncv;
            if (F.c < Gc) {
                pg8::Gemm g{nullptr, nullptr, SLOTS, 1024, D / 2};
                pg8::MoeGatherOrder S{tb, tb + 36, (const int*)(F.ws + WS_LIST), 4, Gc, F.c, (const char*)(F.ws + WS_X1F), (const char*)(F.ws + WS_W13) + (size_t)l * NE * 1024 * 2048, (size_t)1024 * 2048, (size_t)256 * 2048, (unsigned)D};
                pg8::EpiMoe1 E{(bf16*)(F.ws + WS_H), tb, tb + 36};
                REP(6) pg8::gemm_phase<pg8::EpiMoe1, pg8::MoeGatherOrder, true, true>(F.lds + RING_OFF, g, S, E);
                if (ncv) conv_done(F, pb + 6);
                { const int mine = (F.c < nu) ? (nu - 1 - F.c) / Gc + 1 : 0, rounds = (nu + Gc - 1) / Gc; conv_filler(F, args, 2 * l + 1, (rounds - mine) * QM); }
            } else conv_server(F, args, pb + 6, 2 * l + 1, Gc);
            SEAM(pb + 6);
        }
        if (IN(pb + 7)) { FRESH();
            moe_table(F, l);
            const int nu = ((const LAS int*)(F.lds + TAB_OFF))[32] * 8, ncv = conv_servers(nu, F.G, CONVFIN()), Gc = F.G - ncv;
            if (F.c < Gc) {
                pg8::Gemm g{nullptr, nullptr, SLOTS, D, FF / 2};
                pg8::MoeOrder8 S{(const PG8_LAS int*)(F.lds + TAB_OFF), 8, Gc, F.c, (const char*)(F.ws + WS_H), (const char*)(F.ws + WS_W2) + (size_t)l * NE * 2048 * 512, (size_t)256 * FF, (size_t)2048 * 512, (size_t)256 * 512};
                pg8::EpiBf16X E{3, (bf16*)(F.ws + WS_YB), nullptr, nullptr, nullptr, (const PG8_LAS int*)(F.lds + TAB_OFF), (const PG8_LAS int*)(F.lds + TAB_OFF) + 36};
                REP(7) pg8::gemm_phase<pg8::EpiBf16X, pg8::MoeOrder8, true, true>(F.lds + RING_OFF, g, S, E);
                if (ncv) conv_done(F, pb + 7);
                { const int mine = (F.c < nu) ? (nu - 1 - F.c) / Gc + 1 : 0, rounds = (nu + Gc - 1) / Gc; conv_filler(F, args, 2 * l + 1, (rounds - mine) * QB); }
            } else conv_server(F, args, pb + 7, 2 * l + 1, Gc);
            SEAM(pb + 7);
        }
        if (IN(pb + 8)) { FRESH(); REP(8) ln2_phase(F, args, l); conv_filler(F, args, 2 * l + 1, -1); SEAM(pb + 8); }
    }
#ifdef PROBE_A
    {
        VM_WAIT(); xcd_barrier(bar);
        const unsigned long long* ts = (const unsigned long long*)(args.ws + WS_TS);
        float da = 0.f, db = 0.f;
        for (int p = 0; p < NPHASES; ++p) { const int k = (p == 0) ? 9 : (p - 1) % NPH_LAYER; const float d = (float)(ts[p + 1] - ts[p]);
            if (k == PROBE_A || PROBE_A == 10) da += d; if (k == PROBE_B || PROBE_B == 10) db += d; }
        const float kk = sqrtf(da), vv = db;
        float* o = args.out; const long n = (long)T * D;
        for (long i = (long)blockIdx.x * 512 + threadIdx.x; i < n; i += (long)gridDim.x * 512) o[i] = (i == 0) ? vv : kk;
    }
#endif
#undef IN
#undef SEAM
}

#ifndef MK_ONE_LAUNCH
#define MK_ONE_LAUNCH 1
#endif
extern "C" void kernel_launch(void* const* d_in, const int* in_sizes, int n_in, void* d_out, int out_size, void* d_ws, size_t ws_size, hipStream_t stream) {
    static int grid = 0;
    if (grid == 0) {
        if (n_in != 24 || in_sizes[0] != T * D || out_size != T * D || ws_size < WS_END) { fprintf(stderr, "kernel_launch: unexpected shapes (n_in %d, in0 %d, out %d, ws %zu < %zu)\n", n_in, n_in > 0 ? in_sizes[0] : -1, out_size, ws_size, (size_t)WS_END); grid = -1; return; }
        int dev = 0, cus = 0, per_cu = 0;
        if (hipGetDevice(&dev) != hipSuccess || hipDeviceGetAttribute(&cus, hipDeviceAttributeMultiprocessorCount, dev) != hipSuccess) { grid = -1; return; }
        if (hipFuncSetAttribute((const void*)fwd_kernel, hipFuncAttributeMaxDynamicSharedMemorySize, LDS_BYTES) != hipSuccess) { fprintf(stderr, "kernel_launch: hipFuncSetAttribute failed\n"); grid = -1; return; }
        if (hipOccupancyMaxActiveBlocksPerMultiprocessor(&per_cu, (const void*)fwd_kernel, NWAVES * 64, LDS_BYTES) != hipSuccess || per_cu < 1) fprintf(stderr, "kernel_launch: occupancy query reports %d\n", per_cu);
        (void)hipGetLastError();
        grid = cus;
    }
    if (grid < 0) return;
    if (hipMemsetAsync((char*)d_ws + WS_CTL, 0, CTL_ZERO_BYTES, stream) != hipSuccess) return;
    Args a{};
    for (int i = 0; i < 24; ++i) a.in[i] = (const float*)d_in[i];
    a.out = (float*)d_out; a.ws = (unsigned char*)d_ws;
#if MK_ONE_LAUNCH
    a.ph_lo = 0; a.ph_hi = NPHASES;
    hipLaunchKernelGGL(fwd_kernel, dim3(grid), dim3(NWAVES * 64), LDS_BYTES, stream, a);
#else
    for (int p = 0; p < NPHASES; ++p) {
        const int k = (p - 1) % NPH_LAYER, l = (p - 1) / NPH_LAYER;
        if (p > 0 && k == 2 && l < 2) continue;
        a.ph_lo = p; a.ph_hi = p + 1;
        hipLaunchKernelGGL(fwd_kernel, dim3(grid), dim3(NWAVES * 64), LDS_BYTES, stream, a);
    }
#endif
    const hipError_t le = hipPeekAtLastError();
    if (le != hipSuccess) fprintf(stderr, "kernel_launch: launch failed: %s\n", hipGetErrorName(le));
}
```

```cpp
#define F8MASK 12
#define F8OMASK 12
#include <hip/hip_runtime.h>
#include <cstdio>
#include <cstdint>
namespace pg8 {
#define PG8_LAS __attribute__((address_space(3)))
typedef unsigned short bf16_t;
typedef short bf16x8 __attribute__((ext_vector_type(8)));
typedef float f32x4 __attribute__((ext_vector_type(4)));
typedef unsigned u32x4 __attribute__((ext_vector_type(4)));
constexpr int BM = 256, BK = 64, HALF = 128, HTB = HALF * BK * 2  , STAGE_BYTES = 8 * HTB, NXCD = 8, WGM = 8;

__host__ __device__ __forceinline__ int lds_byte(int r, int c) { const int st = (r >> 4) * 2 + (c >> 5), rr = r & 15, cc = c & 31, ob = rr * 64 + cc * 2; return st * 1024 + (ob ^ (((ob >> 9) & 1) << 5)); }
__host__ __device__ __forceinline__ void stage_rc(int b, int& R, int& C) { const int st = b / 1024, sb = b % 1024, swz = sb ^ (((sb >> 9) & 1) << 5); R = (st >> 1) * 16 + swz / 64; C = (st & 1) * 32 + (swz % 64) / 2; }
__host__ __device__ __forceinline__ int perm32(int rho) { const int n = rho >> 4, i = rho & 15; return 8 * (i >> 2) + 4 * n + (i & 3); }

typedef int pg8_v4i __attribute__((ext_vector_type(4))); typedef int pg8_v8i __attribute__((ext_vector_type(8)));
__device__ __forceinline__ pg8_v8i pg8_cat8(bf16x8 a, bf16x8 b) { return __builtin_shufflevector(__builtin_bit_cast(pg8_v4i, a), __builtin_bit_cast(pg8_v4i, b), 0, 1, 2, 3, 4, 5, 6, 7); }
struct Unit { int pm, pn, e; };
struct Gemm { const bf16_t* A; const bf16_t* Bt; int M, N, K; };

struct StaticOrder {
    static constexpr bool GATHER = false, F8 = false; static constexpr int SCALE_B = 127;
    int nM, nN, nwg, G, c;
    __host__ __device__ void init(int M, int N, int G_, int c_) { nM = M / BM; nN = N / BM; nwg = nM * nN; G = G_; c = c_; }
    __host__ __device__ bool next(int i, Unit& u) const {
        const long L = (long)i * G + c; if (L >= nwg) return false;
        int wgid = (int)L; { const int q = nwg / NXCD, r = nwg % NXCD, xcd = wgid % NXCD, off = wgid / NXCD; wgid = (xcd < r ? xcd * (q + 1) : r * (q + 1) + (xcd - r) * q) + off; }
        const int nig = WGM * nN, gid = wgid / nig, fm = gid * WGM, gsz = (nM - fm) < WGM ? (nM - fm) : WGM;
        u.pm = fm + ((wgid % nig) % gsz); u.pn = (wgid % nig) / gsz; return true;
    }
    __device__ __forceinline__ void a_ready(const Unit&) const {}
    __device__ __forceinline__ void done(const Unit&) const {}
};

__device__ __forceinline__ unsigned cvt_pk_bf16(float lo, float hi) { unsigned r; asm volatile("v_cvt_pk_bf16_f32 %0, %1, %2" : "=v"(r) : "v"(lo), "v"(hi)); return r; }
typedef float f32x2 __attribute__((ext_vector_type(2)));
__device__ __forceinline__ f32x2 gelu_pk(f32x2 v) {
    const f32x2 av = __builtin_elementwise_abs(v), d = av * 0.2316418882f + 1.0f;
    f32x2 t; t.x = __builtin_amdgcn_rcpf(d.x); t.y = __builtin_amdgcn_rcpf(d.y);
    f32x2 q = t * 0.5307027145f + (-0.7265760135f); q = q * t + 0.7107068705f; q = q * t + (-0.142248368f); q = q * t + 0.127414796f; q = q * t;
    const f32x2 s = (v * v) * (-0.72134752044f);
    f32x2 e; e.x = __builtin_amdgcn_exp2f(s.x); e.y = __builtin_amdgcn_exp2f(s.y);
    const f32x2 m = v * (q * e), r = v - m;
    f32x2 o; o.x = v.x < 0.f ? m.x : r.x; o.y = v.y < 0.f ? m.y : r.y; return o;
}

template <class Epi, class Sched, bool ALIGN_EPI = false, bool SP2 = false>
__device__ __forceinline__ void gemm_phase(PG8_LAS unsigned char* lds, const Gemm g, const Sched& S, const Epi& E) {
    int tid_ = threadIdx.x; asm volatile("" : "+v"(tid_));
    const int tid = tid_, wid = __builtin_amdgcn_readfirstlane(tid >> 6), lane = tid & 63, wr = wid >> 2, wc = wid & 3, fr = lane & 15, fq = lane >> 4;
    const int K = g.K, nt = K / BK;
    unsigned voffA[2], voffB[2];
#pragma unroll
    for (int i = 0; i < 2; ++i) { int R, C; stage_rc(tid * 16 + i * 8192, R, C); const int Rb = Epi::PERM ? ((R & ~31) + perm32(R & 31)) : R;
        voffA[i] = (unsigned)(R * K + C) * 2u; voffB[i] = (unsigned)(Rb * K + C) * 2u; }
    unsigned vAc[2][2], vAn[2][2];
    int gR[2], gC[2];
#pragma unroll
    for (int i = 0; i < 2; ++i) { stage_rc(tid * 16 + i * 8192, gR[i], gC[i]); }
    const size_t kstep = (size_t)(BK * 2);
    const size_t hstep = (size_t)HALF * K * 2;
        const unsigned ldsw = (unsigned)wid * 1024u;
    const int aoff = lds_byte(wr * 64 + fr, fq * 8), boff = lds_byte(wc * 32 + fr, fq * 8);
#define PG8_SA(b, h) (((b) * 2 + (h)) * HTB)
#define PG8_SB(b, h) ((4 + (b) * 2 + (h)) * HTB)
#define PG8_STAGE(bufoff, gbase, voff) do { _Pragma("unroll") for (int _i = 0; _i < 2; ++_i) \
        __builtin_amdgcn_global_load_lds((const unsigned*)((const char*)(gbase) + (voff)[_i]), (PG8_LAS unsigned*)(lds + (bufoff) + ldsw + _i * 8192), 16, 0, 0); } while (0)
#define PG8_STAGE_A(b, h, base, VS) do { if constexpr (Sched::GATHER) { PG8_STAGE(PG8_SA(b, h), base, VS[h]); } else { PG8_STAGE(PG8_SA(b, h), (base) + (h) * hstep, voffA); } } while (0)
#define PG8_STAGE_AN(b, h, base) do { if constexpr (Sched::GATHER) { unsigned vs_[2] = {last ? vAn[h][0] : vAc[h][0], last ? vAn[h][1] : vAc[h][1]}; PG8_STAGE(PG8_SA(b, h), base, vs_); } else { PG8_STAGE(PG8_SA(b, h), (base) + (h) * hstep, voffA); } } while (0)
#define PG8_LDA(dst, b, h) do { if constexpr (Sched::F8) { _Pragma("unroll") for (int m = 0; m < 4; ++m) { dst##8[m].lo = *(const PG8_LAS pg8_v4i*)(lds + PG8_SA(b, h) + aoff + m * 2048); dst##8[m].hi = *(const PG8_LAS pg8_v4i*)(lds + PG8_SA(b, h) + aoff + m * 2048 + 1024); } } \
        else { _Pragma("unroll") for (int m = 0; m < 4; ++m) _Pragma("unroll") for (int k = 0; k < 2; ++k) dst[m][k] = *(const PG8_LAS bf16x8*)(lds + PG8_SA(b, h) + aoff + m * 2048 + k * 1024); } } while (0)
#define PG8_LDB(dst, b, h) do { if constexpr (Sched::F8) { _Pragma("unroll") for (int n = 0; n < 2; ++n) { dst##8[n].lo = *(const PG8_LAS pg8_v4i*)(lds + PG8_SB(b, h) + boff + n * 2048); dst##8[n].hi = *(const PG8_LAS pg8_v4i*)(lds + PG8_SB(b, h) + boff + n * 2048 + 1024); } } \
        else { _Pragma("unroll") for (int n = 0; n < 2; ++n) _Pragma("unroll") for (int k = 0; k < 2; ++k) dst[n][k] = *(const PG8_LAS bf16x8*)(lds + PG8_SB(b, h) + boff + n * 2048 + k * 1024); } } while (0)
#define PG8_MMA(ai, bj, At, Bt) do { __builtin_amdgcn_s_setprio(1); if constexpr (Sched::F8) { \
        _Pragma("unroll") for (int m = 0; m < 4; ++m) _Pragma("unroll") for (int n = 0; n < 2; ++n) \
            asm volatile("v_mfma_scale_f32_16x16x128_f8f6f4 %0, %1, %2, %0, %3, %4 op_sel_hi:[0,0,0]" : "+v"(acc[ai][bj][m][n]) : "v"(Bt##8[n]), "v"(At##8[m]), "v"(sclB_), "v"(sclA_));     \
        } else { _Pragma("unroll") for (int m = 0; m < 4; ++m) _Pragma("unroll") for (int n = 0; n < 2; ++n) _Pragma("unroll") for (int k = 0; k < 2; ++k) \
        acc[ai][bj][m][n] = __builtin_amdgcn_mfma_f32_16x16x32_bf16(Bt[n][k], At[m][k], acc[ai][bj][m][n], 0, 0, 0); } __builtin_amdgcn_s_setprio(0); } while (0)
#define PG8_WAIT_V(n) asm volatile("s_waitcnt vmcnt(" #n ")" ::: "memory")
#define PG8_WAIT_L(n) asm volatile("s_waitcnt lgkmcnt(" #n ")" ::: "memory")
#define PG8_BAR __builtin_amdgcn_s_barrier()
#define PG8_SCHED __builtin_amdgcn_sched_barrier(0)
    Unit cur, nxt; int ui = 0;
    if (!S.next(0, cur)) return;
    f32x4 acc[2][2][4][2];
#pragma unroll
    for (int a = 0; a < 2; ++a)
#pragma unroll
        for (int b = 0; b < 2; ++b)
#pragma unroll
            for (int m = 0; m < 4; ++m)
#pragma unroll
                for (int n = 0; n < 2; ++n) acc[a][b][m][n] = (f32x4){0.f, 0.f, 0.f, 0.f};
    const int sclB_ = Sched::SCALE_B, sclA_ = 127;
    bf16x8 At[4][2], B0[2][2], B1[2][2]; pg8_v8i At8[4], B08[2], B18[2];
    const char* cA = S.aptr(cur); const char* cB = S.bptr(cur);
    S.a_ready(cur);
    if constexpr (Sched::GATHER) {
#pragma unroll
        for (int h = 0; h < 2; ++h)
#pragma unroll
            for (int i = 0; i < 2; ++i) { vAc[h][i] = S.rowoff(cur, h * HALF + gR[i]) + (unsigned)gC[i] * 2u; vAn[h][i] = vAc[h][i]; }
        asm volatile("s_waitcnt vmcnt(0)" ::: "memory");
    }
    if constexpr (SP2) {
        PG8_STAGE(PG8_SB(0, 0), cB, voffB); PG8_STAGE(PG8_SB(0, 1), cB + hstep, voffB); PG8_STAGE_A(0, 0, cA, vAc); PG8_STAGE_A(0, 1, cA, vAc);
        if (wr == 1) PG8_BAR;
        PG8_WAIT_V(2); PG8_BAR;
        PG8_STAGE(PG8_SB(1, 0), cB + kstep, voffB); PG8_STAGE_A(1, 0, cA + kstep, vAc); PG8_STAGE(PG8_SB(1, 1), cB + hstep + kstep, voffB);
        PG8_WAIT_V(6); PG8_BAR;
    } else {
        PG8_STAGE(PG8_SB(0, 0), cB, voffB); PG8_STAGE_A(0, 0, cA, vAc); PG8_STAGE(PG8_SB(0, 1), cB + hstep, voffB); PG8_STAGE_A(0, 1, cA, vAc);
        if (wr == 1) PG8_BAR;
        PG8_WAIT_V(4); PG8_BAR;
        PG8_STAGE(PG8_SB(1, 0), cB + kstep, voffB); PG8_STAGE_A(1, 0, cA + kstep, vAc); PG8_STAGE(PG8_SB(1, 1), cB + hstep + kstep, voffB);
        PG8_WAIT_V(6); PG8_BAR;
    }
    for (;;) {
        const bool has_next = S.next(ui + 1, nxt);
        const char* nA = has_next ? S.aptr(nxt) : cA; const char* nB = has_next ? S.bptr(nxt) : cB;
        if constexpr (Sched::GATHER) { if (has_next) {
#pragma unroll
            for (int h = 0; h < 2; ++h)
#pragma unroll
                for (int i = 0; i < 2; ++i) vAn[h][i] = S.rowoff(nxt, h * HALF + gR[i]) + (unsigned)gC[i] * 2u; } }
        for (int t = 0; t < nt; t += 2) {
            const bool last = (t == nt - 2);
            const char* a1 = cA + (size_t)(t + 1) * kstep;
            const char* a2 = last ? nA : cA + (size_t)(t + 2) * kstep; const char* b2 = last ? nB : cB + (size_t)(t + 2) * kstep;
            const char* a3 = a2 + kstep; const char* b3 = b2 + kstep;
            if (last && has_next) S.a_ready(nxt);
            if constexpr (SP2) {
            PG8_LDB(B0, 0, 0); PG8_LDB(B1, 0, 1); PG8_SCHED; PG8_LDA(At, 0, 0); PG8_STAGE_A(1, 1, a1, vAc);
            PG8_WAIT_V(8); PG8_WAIT_L(0); PG8_BAR; PG8_MMA(0, 0, At, B0); PG8_MMA(0, 1, At, B1); PG8_BAR; PG8_SCHED;
            PG8_LDA(At, 0, 1); PG8_STAGE(PG8_SB(0, 0), b2, voffB); PG8_STAGE(PG8_SB(0, 1), b2 + hstep, voffB); PG8_STAGE_AN(0, 0, a2);
            PG8_WAIT_V(8); PG8_WAIT_L(0); PG8_BAR; PG8_MMA(1, 0, At, B0); PG8_MMA(1, 1, At, B1); PG8_BAR; PG8_SCHED;
            PG8_LDB(B0, 1, 0); PG8_LDB(B1, 1, 1); PG8_SCHED; PG8_LDA(At, 1, 0); PG8_STAGE_AN(0, 1, a2);
            PG8_WAIT_V(8); PG8_WAIT_L(0); PG8_BAR; PG8_MMA(0, 0, At, B0); PG8_MMA(0, 1, At, B1); PG8_BAR; PG8_SCHED;
            PG8_LDA(At, 1, 1); PG8_STAGE(PG8_SB(1, 0), b3, voffB); PG8_STAGE(PG8_SB(1, 1), b3 + hstep, voffB); PG8_STAGE_AN(1, 0, a3);
            PG8_WAIT_V(8); PG8_WAIT_L(0); PG8_BAR; PG8_MMA(1, 0, At, B0); PG8_MMA(1, 1, At, B1); PG8_BAR; PG8_SCHED;
            } else {
            PG8_LDB(B0, 0, 0); PG8_SCHED; PG8_LDA(At, 0, 0); PG8_STAGE_A(1, 1, a1, vAc);
            PG8_WAIT_L(8); PG8_BAR; PG8_WAIT_L(0); PG8_MMA(0, 0, At, B0); PG8_BAR; PG8_SCHED;
            PG8_LDB(B1, 0, 1); PG8_STAGE(PG8_SB(0, 0), b2, voffB);
            PG8_BAR; PG8_WAIT_L(0); PG8_MMA(0, 1, At, B1); PG8_BAR;
            PG8_LDA(At, 0, 1); PG8_STAGE_AN(0, 0, a2);
            PG8_BAR; PG8_WAIT_L(0); PG8_MMA(1, 0, At, B0); PG8_BAR; PG8_SCHED;
            PG8_STAGE(PG8_SB(0, 1), b2 + hstep, voffB);
            PG8_WAIT_V(6); PG8_BAR; PG8_MMA(1, 1, At, B1); PG8_BAR;
            PG8_LDB(B0, 1, 0); PG8_SCHED; PG8_LDA(At, 1, 0); PG8_STAGE_AN(0, 1, a2);
            PG8_WAIT_L(8); PG8_BAR; PG8_WAIT_L(0); PG8_MMA(0, 0, At, B0); PG8_BAR; PG8_SCHED;
            PG8_LDB(B1, 1, 1); PG8_STAGE(PG8_SB(1, 0), b3, voffB);
            PG8_BAR; PG8_WAIT_L(0); PG8_MMA(0, 1, At, B1); PG8_BAR;
            PG8_LDA(At, 1, 1); PG8_STAGE_AN(1, 0, a3);
            PG8_BAR; PG8_WAIT_L(0); PG8_MMA(1, 0, At, B0); PG8_BAR; PG8_SCHED;
            PG8_STAGE(PG8_SB(1, 1), b3 + hstep, voffB);
            PG8_WAIT_V(6); PG8_BAR; PG8_MMA(1, 1, At, B1); PG8_BAR;
            }
        }
        if constexpr (ALIGN_EPI) { if (wr == 0) PG8_BAR; }
        if constexpr (!Epi::AFTER_DRAIN) { E(acc, cur, wr, wc, fr, fq); S.done(cur); }
        if (!has_next) break;
#pragma unroll
        for (int a = 0; a < 2; ++a)
#pragma unroll
            for (int b = 0; b < 2; ++b)
#pragma unroll
                for (int m = 0; m < 4; ++m)
#pragma unroll
                    for (int n = 0; n < 2; ++n) acc[a][b][m][n] = (f32x4){0.f, 0.f, 0.f, 0.f};
        cur = nxt; cA = nA; cB = nB; ++ui;
        if constexpr (Sched::GATHER) {
#pragma unroll
            for (int h = 0; h < 2; ++h)
#pragma unroll
                for (int i = 0; i < 2; ++i) vAc[h][i] = vAn[h][i]; }
        if constexpr (ALIGN_EPI) { if (wr == 1) PG8_BAR; }
    }
    PG8_WAIT_V(0);
    if constexpr (!ALIGN_EPI) { if (wr == 0) PG8_BAR; }
    PG8_BAR;
    if constexpr (Epi::AFTER_DRAIN) { E.fused(acc, cur, wr, wc, fr, fq, lds, wid, lane); S.done(cur); }
#undef PG8_SA
#undef PG8_SB
#undef PG8_STAGE
#undef PG8_STAGE_A
#undef PG8_STAGE_AN
#undef PG8_LDA
#undef PG8_LDB
#undef PG8_MMA
#undef PG8_WAIT_V
#undef PG8_WAIT_L
#undef PG8_BAR
#undef PG8_SCHED
}
}

constexpr int T = 8192, D = 2048, MIXW = 1536, MEMW = 512, NINA = 3584, DEPTH = 4, NE = 32, FF = 512, MEMT = 256;
constexpr int SLOTS = 24576;
constexpr float LN_EPS = 1e-5f;
constexpr float DN_ALPHA = 1.6817928305074292f;
constexpr float LOG2E = 1.4426950408889634f;
constexpr float QSCALE = 0.08838834764831845f * LOG2E;
constexpr int NWAVES = 8;

constexpr size_t MiB = 1u << 20;
constexpr size_t WS_CTL = 0, CTL_ZERO_BYTES = 1 * MiB;
constexpr size_t WS_WAIN = 2 * MiB, WS_WAOUT = 30 * MiB, WS_WBIN0 = 46 * MiB, WS_WKV = 54 * MiB, WS_WBIN1 = 66 * MiB, WS_WBOUT = 74 * MiB, WS_WMKV = 90 * MiB;
constexpr size_t WS_W13 = 106 * MiB, WS_W2 = 618 * MiB;
constexpr size_t WS_XB = 874 * MiB, WS_MEMB = 906 * MiB, WS_MEMKV = 907 * MiB, WS_Z = 910 * MiB, WS_KD = 966 * MiB, WS_VD = 990 * MiB, WS_CAT = 1014 * MiB;
constexpr size_t WS_XQ = 1206 * MiB, WS_MEMQ = 1238 * MiB, WS_CATQ = 1246 * MiB;
constexpr size_t WS_Y = 1046 * MiB, WS_X1F = 1110 * MiB, WS_X1B = 1174 * MiB, WS_XF = 1206 * MiB, WS_XG = 1270 * MiB, WS_H = 1366 * MiB, WS_YB = 1390 * MiB, WS_OP = 1486 * MiB;
constexpr size_t WS_ROUTE = 1582 * MiB, WS_OP2 = 1583 * MiB, WS_ML = 1631 * MiB, WS_WR = 1634 * MiB, WS_TS = 1640 * MiB, WS_LIST = 1641 * MiB, WS_END = 1642 * MiB;
constexpr int CW_TMO = 0, CW_BAR = 4096, CW_CNT = 16384, CW_Q = 28672, CW_CONV = 29184, CW_DONE = 32768, CW_FIN = 40960;

constexpr int RING_OFF = 0, RING_BYTES = 131072;
constexpr int LDSCTL_OFF = 146432, MISC_OFF = LDSCTL_OFF + 320, TAB_OFF = LDSCTL_OFF + 512;
constexpr int LDS_BYTES = 147456;

#define GAS __attribute__((address_space(1)))
#define LAS __attribute__((address_space(3)))
typedef unsigned short bf16;
typedef unsigned v4u __attribute__((ext_vector_type(4)));
typedef unsigned v2u __attribute__((ext_vector_type(2)));
typedef float f32x4 __attribute__((ext_vector_type(4)));
typedef short bf16x8 __attribute__((ext_vector_type(8)));
typedef GAS unsigned gu32;
#define RLX_AGENT __ATOMIC_RELAXED, __HIP_MEMORY_SCOPE_AGENT
#define LDS_WAIT() asm volatile("s_waitcnt lgkmcnt(0)" ::: "memory")
#define VM_WAIT() asm volatile("s_waitcnt vmcnt(0)" ::: "memory")
__device__ __forceinline__ unsigned f2bf(float f) { unsigned u = __builtin_bit_cast(unsigned, f); return (u + 0x7fffu + ((u >> 16) & 1u)) >> 16; }
__device__ __forceinline__ unsigned pk2(float lo, float hi) { return f2bf(lo) | (f2bf(hi) << 16); }
__device__ __forceinline__ float bf2f(unsigned short b) { return __builtin_bit_cast(float, (unsigned)b << 16); }
__device__ __forceinline__ float bflo(unsigned w) { return __builtin_bit_cast(float, w << 16); }
__device__ __forceinline__ float bfhi(unsigned w) { return __builtin_bit_cast(float, w & 0xffff0000u); }
__device__ __forceinline__ float wave_sum(float v) {
#pragma unroll
    for (int o = 1; o < 64; o <<= 1) v += __shfl_xor(v, o);
    return v;
}

namespace pg8 {
struct DenseOrder {
    static constexpr bool GATHER = false, F8 = false; static constexpr int SCALE_B = 127;
    StaticOrder so; const char* A; const char* B; size_t astep, bstep;
    __device__ void init(const void* A_, const void* B_, int M, int N, int K, int G, int c) { so.init(M, N, G, c); A = (const char*)A_; B = (const char*)B_; astep = (size_t)256 * K * 2; bstep = astep; }
    __device__ __forceinline__ bool next(int i, Unit& u) const { u.e = 0; return so.next(i, u); }
    __device__ __forceinline__ const char* aptr(const Unit& u) const { return A + (size_t)u.pm * astep; }
    __device__ __forceinline__ const char* bptr(const Unit& u) const { return B + (size_t)u.pn * bstep; }
    __device__ __forceinline__ void a_ready(const Unit&) const {}
    __device__ __forceinline__ void done(const Unit&) const {}
};
struct DenseOrder8 {
    static constexpr bool GATHER = false, F8 = true; static constexpr int SCALE_B = 121;
    StaticOrder so; const char* A; const char* B; size_t astep, bstep;
    __device__ void init(const void* A_, const void* B_, int M, int N, int K, int G, int c) { so.init(M, N, G, c); A = (const char*)A_; B = (const char*)B_; astep = (size_t)256 * K * 2; bstep = astep; }
    __device__ __forceinline__ bool next(int i, Unit& u) const { u.e = 0; return so.next(i, u); }
    __device__ __forceinline__ const char* aptr(const Unit& u) const { return A + (size_t)u.pm * astep; }
    __device__ __forceinline__ const char* bptr(const Unit& u) const { return B + (size_t)u.pn * bstep; }
    __device__ __forceinline__ void a_ready(const Unit&) const {}
    __device__ __forceinline__ void done(const Unit&) const {}
};
struct DualOrder {
    static constexpr bool GATHER = false, F8 = false; static constexpr int SCALE_B = 127;
    StaticOrder so; int nwg2; const char* A; const char* B; const char* A2; const char* B2; size_t step;
    __device__ void init(const void* A_, const void* B_, int M, int N, int K, int G, int c, const void* A2_, const void* B2_, int nwg2_) { so.init(M, N, G, c); A = (const char*)A_; B = (const char*)B_; A2 = (const char*)A2_; B2 = (const char*)B2_; nwg2 = nwg2_; step = (size_t)256 * K * 2; }
    __device__ __forceinline__ bool next(int i, Unit& u) const { const int L = i * so.G + so.c; if (L < so.nwg) { u.e = 0; return so.next(i, u); } if (L - so.nwg >= nwg2) return false; u.e = 1; u.pm = 0; u.pn = L - so.nwg; return true; }
    __device__ __forceinline__ const char* aptr(const Unit& u) const { return u.e ? A2 : A + (size_t)u.pm * step; }
    __device__ __forceinline__ const char* bptr(const Unit& u) const { return (u.e ? B2 : B) + (size_t)u.pn * step; }
    __device__ __forceinline__ void a_ready(const Unit&) const {}
    __device__ __forceinline__ void done(const Unit&) const {}
};
struct DualOrder8 {
    static constexpr bool GATHER = false, F8 = true; static constexpr int SCALE_B = 121;
    StaticOrder so; int nwg2; const char* A; const char* B; const char* A2; const char* B2; size_t step;
    __device__ void init(const void* A_, const void* B_, int M, int N, int K, int G, int c, const void* A2_, const void* B2_, int nwg2_) { so.init(M, N, G, c); A = (const char*)A_; B = (const char*)B_; A2 = (const char*)A2_; B2 = (const char*)B2_; nwg2 = nwg2_; step = (size_t)256 * K * 2; }
    __device__ __forceinline__ bool next(int i, Unit& u) const { const int L = i * so.G + so.c; if (L < so.nwg) { u.e = 0; return so.next(i, u); } if (L - so.nwg >= nwg2) return false; u.e = 1; u.pm = 0; u.pn = L - so.nwg; return true; }
    __device__ __forceinline__ const char* aptr(const Unit& u) const { return u.e ? A2 : A + (size_t)u.pm * step; }
    __device__ __forceinline__ const char* bptr(const Unit& u) const { return (u.e ? B2 : B) + (size_t)u.pn * step; }
    __device__ __forceinline__ void a_ready(const Unit&) const {}
    __device__ __forceinline__ void done(const Unit&) const {}
};
struct MoeOrder {
    static constexpr bool GATHER = false, F8 = false; static constexpr int SCALE_B = 127;
    const PG8_LAS int* tstart; int ntn, G, c; const char* A; const char* W; size_t astep, wexp, wtile;
    __device__ __forceinline__ bool next(int i, Unit& u) const {
        const int L = i * G + c, total = tstart[32] * ntn; if (L >= total) return false;
        int wgid; { const int q = total / NXCD, r = total % NXCD, xcd = L % NXCD, off = L / NXCD; wgid = (xcd < r ? xcd * (q + 1) : r * (q + 1) + (xcd - r) * q) + off; }
        u.pm = wgid / ntn; u.pn = wgid - u.pm * ntn; int e = 0;
#pragma unroll
        for (int k = 1; k <= 31; ++k) e += (tstart[k] <= u.pm) ? 1 : 0;
        u.e = e; return true;
    }
    __device__ __forceinline__ const char* aptr(const Unit& u) const { return A + (size_t)u.pm * astep; }
    __device__ __forceinline__ const char* bptr(const Unit& u) const { return W + (size_t)u.e * wexp + (size_t)u.pn * wtile; }
    __device__ __forceinline__ void a_ready(const Unit&) const {}
    __device__ __forceinline__ void done(const Unit&) const {}
};

struct MoeOrder8 {
    static constexpr bool GATHER = false, F8 = true; static constexpr int SCALE_B = 121;
    const PG8_LAS int* tstart; int ntn, G, c; const char* A; const char* W; size_t astep, wexp, wtile;
    __device__ __forceinline__ bool next(int i, Unit& u) const {
        const int L = i * G + c, total = tstart[32] * ntn; if (L >= total) return false;
        int wgid; { const int q = total / NXCD, r = total % NXCD, xcd = L % NXCD, off = L / NXCD; wgid = (xcd < r ? xcd * (q + 1) : r * (q + 1) + (xcd - r) * q) + off; }
        u.pm = wgid / ntn; u.pn = wgid - u.pm * ntn; int e = 0;
#pragma unroll
        for (int k = 1; k <= 31; ++k) e += (tstart[k] <= u.pm) ? 1 : 0;
        u.e = e; return true;
    }
    __device__ __forceinline__ const char* aptr(const Unit& u) const { return A + (size_t)u.pm * astep; }
    __device__ __forceinline__ const char* bptr(const Unit& u) const { return W + (size_t)u.e * wexp + (size_t)u.pn * wtile; }
    __device__ __forceinline__ void a_ready(const Unit&) const {}
    __device__ __forceinline__ void done(const Unit&) const {}
};

struct MoeGatherOrder {
    static constexpr bool GATHER = true, F8 = true; static constexpr int SCALE_B = 121;
    const PG8_LAS int* tstart; const PG8_LAS int* cntl; const int* list; int ntn, G, c; const char* A; const char* W; size_t wexp, wtile; unsigned rowbytes;
    __device__ __forceinline__ bool next(int i, Unit& u) const {
        const int L = i * G + c, total = tstart[32] * ntn; if (L >= total) return false;
        int wgid; { const int q = total / NXCD, r = total % NXCD, xcd = L % NXCD, off = L / NXCD; wgid = (xcd < r ? xcd * (q + 1) : r * (q + 1) + (xcd - r) * q) + off; }
        u.pm = wgid / ntn; u.pn = wgid - u.pm * ntn; int e = 0;
#pragma unroll
        for (int k = 1; k <= 31; ++k) e += (tstart[k] <= u.pm) ? 1 : 0;
        u.e = e; return true;
    }
    __device__ __forceinline__ unsigned rowoff(const Unit& u, int r) const { const int rank = (u.pm - tstart[u.e]) * 256 + r; const int tok = list[u.e * 8192 + (rank < cntl[u.e] ? rank : 0)]; return (unsigned)tok * rowbytes; }
    __device__ __forceinline__ const char* aptr(const Unit&) const { return A; }
    __device__ __forceinline__ const char* bptr(const Unit& u) const { return W + (size_t)u.e * wexp + (size_t)u.pn * wtile; }
    __device__ __forceinline__ void a_ready(const Unit&) const {}
    __device__ __forceinline__ void done(const Unit&) const {}
};

struct EpiBf16X {
    static constexpr bool PERM = true, AFTER_DRAIN = false;
    int mode; bf16_t* p0; bf16_t* p1; bf16_t* p2; bf16_t* p3;
    const PG8_LAS int* tstart; const PG8_LAS int* cntl;
    __device__ __forceinline__ void operator()(const f32x4 (&acc)[2][2][4][2], const Unit& u, int wr, int wc, int fr, int fq) const {
        bf16_t* base; int ldc, colt; bool act = false; float sc = 1.f;
        if (u.e && mode < 2) { base = p3 + (size_t)(u.pn >> 2) * (256 * 1024); ldc = 1024; colt = (u.pn & 3) * BM; }
        else if (mode == 0) { base = p0; ldc = 3584; colt = u.pn * BM; act = u.pn < 12; if (u.pn >= 12) sc = QSCALE; }
        else if (mode == 1) { if (u.pn < 8) { base = p0; ldc = 2048; colt = u.pn * BM; sc = QSCALE; }
                              else if (u.pn < 14) { base = p1; ldc = 1536; colt = (u.pn - 8) * BM; } else { base = p2; ldc = 1536; colt = (u.pn - 14) * BM; } }
        else { base = p0; ldc = 2048; colt = u.pn * BM; }
        const int row0 = u.pm * BM + wr * 64 + fr, col0 = colt + wc * 32 + 8 * fq;
        const int rlim = (mode == 3) ? cntl[u.e] - (u.pm - tstart[u.e]) * BM : BM;
#pragma unroll
        for (int ai = 0; ai < 2; ++ai)
#pragma unroll
            for (int m = 0; m < 4; ++m) { bf16_t* rowp = base + (size_t)(row0 + ai * HALF + m * 16) * ldc + col0;
                if (wr * 64 + fr + ai * HALF + m * 16 >= rlim) continue;
#pragma unroll
                for (int bj = 0; bj < 2; ++bj) { f32x4 v0 = acc[ai][bj][m][0], v1 = acc[ai][bj][m][1];
                    if (act) { f32x2 a = gelu_pk((f32x2){v0[0], v0[1]}), b = gelu_pk((f32x2){v0[2], v0[3]}), c = gelu_pk((f32x2){v1[0], v1[1]}), d = gelu_pk((f32x2){v1[2], v1[3]});
                        v0 = (f32x4){a.x, a.y, b.x, b.y}; v1 = (f32x4){c.x, c.y, d.x, d.y}; }
                    v0 = v0 * sc; v1 = v1 * sc; u32x4 w; w.x = cvt_pk_bf16(v0[0], v0[1]); w.y = cvt_pk_bf16(v0[2], v0[3]); w.z = cvt_pk_bf16(v1[0], v1[1]); w.w = cvt_pk_bf16(v1[2], v1[3]);
                    *(u32x4*)(rowp + bj * HALF) = w; } }
    }
};
struct EpiResBf16 {
    static constexpr bool PERM = true, AFTER_DRAIN = false;
    const bf16_t* xres; bf16_t* y; float alpha;
    __device__ __forceinline__ void operator()(const f32x4 (&acc)[2][2][4][2], const Unit& u, int wr, int wc, int fr, int fq) const {
        const int row0 = u.pm * BM + wr * 64 + fr, col0 = u.pn * BM + wc * 32 + 8 * fq;
#pragma unroll
        for (int ai = 0; ai < 2; ++ai)
#pragma unroll
            for (int m = 0; m < 4; ++m) { const size_t off = (size_t)(row0 + ai * HALF + m * 16) * 2048 + col0;
#pragma unroll
                for (int bj = 0; bj < 2; ++bj) { const u32x4 xr = *(const u32x4*)(xres + off + bj * HALF); const f32x4 v0 = acc[ai][bj][m][0], v1 = acc[ai][bj][m][1]; u32x4 w;
                    w.x = cvt_pk_bf16(__builtin_bit_cast(float, xr.x << 16) * alpha + v0[0], __builtin_bit_cast(float, xr.x & 0xffff0000u) * alpha + v0[1]);
                    w.y = cvt_pk_bf16(__builtin_bit_cast(float, xr.y << 16) * alpha + v0[2], __builtin_bit_cast(float, xr.y & 0xffff0000u) * alpha + v0[3]);
                    w.z = cvt_pk_bf16(__builtin_bit_cast(float, xr.z << 16) * alpha + v1[0], __builtin_bit_cast(float, xr.z & 0xffff0000u) * alpha + v1[1]);
                    w.w = cvt_pk_bf16(__builtin_bit_cast(float, xr.w << 16) * alpha + v1[2], __builtin_bit_cast(float, xr.w & 0xffff0000u) * alpha + v1[3]);
                    *(u32x4*)(y + off + bj * HALF) = w; } }
    }
};
struct EpiMoe1 {
    static constexpr bool PERM = true, AFTER_DRAIN = false;
    bf16_t* h; const PG8_LAS int* tstart; const PG8_LAS int* cntl;
    __device__ __forceinline__ void operator()(const f32x4 (&acc)[2][2][4][2], const Unit& u, int wr, int wc, int fr, int fq) const {
        const int row0 = u.pm * BM + wr * 64 + fr, col0 = u.pn * HALF + wc * 32 + 8 * fq;
        const int rlim = cntl[u.e] - (u.pm - tstart[u.e]) * BM;
#pragma unroll
        for (int ai = 0; ai < 2; ++ai)
#pragma unroll
            for (int m = 0; m < 4; ++m) { unsigned char* rowp = (unsigned char*)h + (size_t)(row0 + ai * HALF + m * 16) * 512 + col0; float o[8];
                if (wr * 64 + fr + ai * HALF + m * 16 >= rlim) continue;
#pragma unroll
                for (int n = 0; n < 2; ++n)
#pragma unroll
                    for (int x = 0; x < 4; ++x) { const float a = acc[ai][0][m][n][x], b = acc[ai][1][m][n][x];
                        o[n * 4 + x] = a * __builtin_amdgcn_rcpf(1.0f + __builtin_amdgcn_exp2f(-a * LOG2E)) * b; }
                unsigned lo = 0u, hi = 0u; lo = __builtin_amdgcn_cvt_pk_fp8_f32(o[0], o[1], lo, false); lo = __builtin_amdgcn_cvt_pk_fp8_f32(o[2], o[3], lo, true);
                hi = __builtin_amdgcn_cvt_pk_fp8_f32(o[4], o[5], hi, false); hi = __builtin_amdgcn_cvt_pk_fp8_f32(o[6], o[7], hi, true);
                typedef unsigned u32x2e __attribute__((ext_vector_type(2))); u32x2e w; w.x = lo; w.y = hi; *(u32x2e*)rowp = w; }
    }
};
}

namespace att {
using bf16x8 = __attribute__((ext_vector_type(8))) short;
using s16x4  = __attribute__((ext_vector_type(4))) short;
using f32x16 = __attribute__((ext_vector_type(16))) float;
using u32x4  = __attribute__((ext_vector_type(4))) unsigned;
constexpr int DH = 128, QBLK = 32, KVBLK = 64;
constexpr float THR2 = 8.f * 1.4426950408889634f;
constexpr size_t SHM_V = KVBLK * DH * 2, SHM_K = KVBLK * DH * 2, SHM_ATTN = 2 * SHM_V + 2 * SHM_K + NWAVES * 64 * 4;
constexpr int TAB_N = 160;
#define KSWZ(row, colB) ((row) * 256 + ((colB) ^ (((row) & 7) << 4)))
#define SBAR() __builtin_amdgcn_sched_barrier(0)
__device__ __forceinline__ int crow(int r, int hi) { return (r & 3) + 8 * (r >> 2) + 4 * hi; }
__device__ __forceinline__ unsigned cvtpk(float lo, float hi) { unsigned r; asm volatile("v_cvt_pk_bf16_f32 %0, %1, %2" : "=v"(r) : "v"(lo), "v"(hi)); return r; }

__device__ __forceinline__ void partialSM(f32x16& p0, f32x16& p1, float& m_reg, float& mn, float& alpha) {
  float pmax = p0[0];
#pragma unroll
  for (int r = 1; r < 16; ++r) pmax = fmaxf(pmax, p0[r]);
#pragma unroll
  for (int r = 0; r < 16; ++r) pmax = fmaxf(pmax, p1[r]);
  { auto rr = __builtin_amdgcn_permlane32_swap(__float_as_uint(pmax), __float_as_uint(pmax), false, false);
    pmax = fmaxf(__uint_as_float(rr[0]), __uint_as_float(rr[1])); }
  if (__builtin_expect(__all(pmax - m_reg <= THR2), 1)) { mn = m_reg; alpha = 1.f; }
  else { mn = fmaxf(m_reg, pmax); alpha = __builtin_amdgcn_exp2f(m_reg - mn); m_reg = mn; }
#pragma unroll
  for (int r = 0; r < 16; ++r) p0[r] = p0[r] - mn;
#pragma unroll
  for (int r = 0; r < 16; ++r) p1[r] = p1[r] - mn;
#pragma unroll
  for (int r = 0; r < 16; ++r) p0[r] = __builtin_amdgcn_exp2f(p0[r]);
}
__device__ __forceinline__ void finishSM(f32x16& p0, f32x16& p1, float alpha, float& l_reg, bf16x8& pa0, bf16x8& pa1, bf16x8& pa2, bf16x8& pa3) {
#pragma unroll
  for (int r = 0; r < 16; ++r) p1[r] = __builtin_amdgcn_exp2f(p1[r]);
  float ps = 0;
#pragma unroll
  for (int r = 0; r < 16; ++r) ps += p0[r];
#pragma unroll
  for (int r = 0; r < 16; ++r) ps += p1[r];
  { auto rr = __builtin_amdgcn_permlane32_swap(__float_as_uint(ps), __float_as_uint(ps), false, false);
    ps = __uint_as_float(rr[0]) + __uint_as_float(rr[1]); }
  l_reg = l_reg * alpha + ps;
#define PK4(P, BASE, OUT) do { unsigned a0 = cvtpk(P[BASE + 0], P[BASE + 1]), a1 = cvtpk(P[BASE + 2], P[BASE + 3]);   \
    unsigned b0 = cvtpk(P[BASE + 4], P[BASE + 5]), b1 = cvtpk(P[BASE + 6], P[BASE + 7]);                              \
    auto r0 = __builtin_amdgcn_permlane32_swap(a0, b0, false, false); auto r1 = __builtin_amdgcn_permlane32_swap(a1, b1, false, false); \
    u32x4 w = {r0[0], r1[0], r0[1], r1[1]}; OUT = *reinterpret_cast<bf16x8*>(&w); } while (0)
  PK4(p0, 0, pa0); PK4(p0, 8, pa1); PK4(p1, 0, pa2); PK4(p1, 8, pa3);
#undef PK4
}
__device__ __forceinline__ void qkt(f32x16& p0, f32x16& p1, const char* Ks, const bf16x8* qr, int r32, int hi) {
  p0 = f32x16{}; p1 = f32x16{};
#pragma unroll
  for (int d0 = 0; d0 < 8; ++d0) { const int cb = (d0 * 16 + hi * 8) * 2;
    bf16x8 b0 = *reinterpret_cast<const bf16x8*>(Ks + KSWZ(r32, cb));
    bf16x8 b1 = *reinterpret_cast<const bf16x8*>(Ks + KSWZ(32 + r32, cb));
    p0 = __builtin_amdgcn_mfma_f32_32x32x16_bf16(b0, qr[d0], p0, 0, 0, 0);
    p1 = __builtin_amdgcn_mfma_f32_32x32x16_bf16(b1, qr[d0], p1, 0, 0, 0); }
}
__device__ __forceinline__ int v_st(int k, int c) { const int kk = (k & ~0xC) | ((k & 4) << 1) | ((k & 8) >> 1); return ((kk >> 3) * 4 + (c >> 5)) * 512 + ((kk & 7) * 32 + (c & 31)) * 2; }
__device__ __forceinline__ int v_rd_base(int lane) { return ((lane & 3) << 3) | (((lane >> 2) & 3) << 6) | (((lane >> 4) & 1) << 5) | (((lane >> 5) & 1) << 8); }
constexpr int v_rd_off(int d0, int ks, int half) { return d0 * 512 + ks * 4096 + half * 2048; }
template <int OFF> __device__ __forceinline__ s16x4 tr_read(int vb) {
  s16x4 r; asm volatile("ds_read_b64_tr_b16 %0, %1 offset:%2" : "=&v"(r) : "v"(vb), "i"(OFF) : "memory"); return r;
}
template <int D0> __device__ __forceinline__ void pv_one(f32x16& od, int vb, bf16x8 pa0, bf16x8 pa1, bf16x8 pa2, bf16x8 pa3) {
  const s16x4 l0 = tr_read<v_rd_off(D0, 0, 0)>(vb), h0 = tr_read<v_rd_off(D0, 0, 1)>(vb), l1 = tr_read<v_rd_off(D0, 1, 0)>(vb), h1 = tr_read<v_rd_off(D0, 1, 1)>(vb);
  const s16x4 l2 = tr_read<v_rd_off(D0, 2, 0)>(vb), h2 = tr_read<v_rd_off(D0, 2, 1)>(vb), l3 = tr_read<v_rd_off(D0, 3, 0)>(vb), h3 = tr_read<v_rd_off(D0, 3, 1)>(vb);
  asm volatile("s_waitcnt lgkmcnt(0)" ::: "memory"); SBAR();
#define PK(L, H) (bf16x8){L[0], L[1], L[2], L[3], H[0], H[1], H[2], H[3]}
  od = __builtin_amdgcn_mfma_f32_32x32x16_bf16(pa0, PK(l0, h0), od, 0, 0, 0);
  od = __builtin_amdgcn_mfma_f32_32x32x16_bf16(pa1, PK(l1, h1), od, 0, 0, 0);
  od = __builtin_amdgcn_mfma_f32_32x32x16_bf16(pa2, PK(l2, h2), od, 0, 0, 0);
  od = __builtin_amdgcn_mfma_f32_32x32x16_bf16(pa3, PK(l3, h3), od, 0, 0, 0);
#undef PK
}
__device__ __forceinline__ void pv_d0(f32x16* o, int vb, bf16x8 pa0, bf16x8 pa1, bf16x8 pa2, bf16x8 pa3) {
  pv_one<0>(o[0], vb, pa0, pa1, pa2, pa3); pv_one<1>(o[1], vb, pa0, pa1, pa2, pa3); pv_one<2>(o[2], vb, pa0, pa1, pa2, pa3); pv_one<3>(o[3], vb, pa0, pa1, pa2, pa3);
}
template <int MODE> __device__ __forceinline__ void post_scores(f32x16& p0, f32x16& p1, int t, int qrow0, int r32, int hi, const float* tab, float cfar) {
  if constexpr (MODE == 1) {
    const int cw = qrow0 >> 6;
    if (t > cw) {
#pragma unroll
      for (int r = 0; r < 16; ++r) { p0[r] = -INFINITY; p1[r] = -INFINITY; }
    } else if (qrow0 - (64 * t + 63) >= 91) {
#pragma unroll
      for (int r = 0; r < 16; ++r) { p0[r] += cfar; p1[r] += cfar; }
    } else {
      const int base = qrow0 + r32 - 64 * t + 63;
#pragma unroll
      for (int r = 0; r < 16; ++r) { const int i0 = base - crow(r, hi); const int i1 = i0 - 32;
        p0[r] += tab[i0 < TAB_N - 1 ? i0 : TAB_N - 1]; p1[r] += tab[i1 < TAB_N - 1 ? i1 : TAB_N - 1]; }
    }
  }
}

template <int MODE>
__device__ __forceinline__ void attn_body(const bf16* __restrict__ Qb, int ldq, const bf16* __restrict__ Kh, const bf16* __restrict__ Vh, int ldk,
                                          bf16* Ob, float* Of, int ldo, int NT, int q0abs, const float* tab, float cfar, char* lds) {
  int tid_ = threadIdx.x; asm volatile("" : "+v"(tid_));
  const int tid = tid_, wid = tid >> 6, lane = tid & 63, r32 = lane & 31, hi = lane >> 5;
  char* V_lds = lds; char* K_lds = lds + 2 * SHM_V;
  float* ws = (float*)(lds + 2 * SHM_V + 2 * SHM_K) + wid * 64; float* li_l = ws; float* al_l = ws + 32;
  float m_reg = -1e30f, l_reg = 0; f32x16 o[4] = {}; bf16x8 qr[8];
  const int qrow0 = q0abs + wid * QBLK;
  const bf16* Qw = Qb + (long)(wid * QBLK + r32) * ldq + hi * 8;
#pragma unroll
  for (int d0 = 0; d0 < 8; ++d0) qr[d0] = *reinterpret_cast<const bf16x8*>(Qw + d0 * 16);
  const int sr = tid >> 4, sc = (tid & 15) * 8, vst0 = v_st(sr, sc), vst1 = v_st(32 + sr, sc);
  const int vb0 = (int)(uintptr_t)V_lds + v_rd_base(lane);
  struct { bf16x8 vs0, vs1, ks0, ks1; } sr_[2];
#define SLOAD(i, k0) do { sr_[i].vs0 = *reinterpret_cast<const bf16x8*>(&Vh[(long)((k0) + sr) * ldk + sc]); sr_[i].vs1 = *reinterpret_cast<const bf16x8*>(&Vh[(long)((k0) + 32 + sr) * ldk + sc]); \
    sr_[i].ks0 = *reinterpret_cast<const bf16x8*>(&Kh[(long)((k0) + sr) * ldk + sc]); sr_[i].ks1 = *reinterpret_cast<const bf16x8*>(&Kh[(long)((k0) + 32 + sr) * ldk + sc]); } while (0)
#define SWRITE(b, i) do { *(bf16x8*)(V_lds + (b) * SHM_V + vst0) = sr_[i].vs0;          \
    *(bf16x8*)(V_lds + (b) * SHM_V + vst1) = sr_[i].vs1; const int kc = sc * 2;               \
    *(bf16x8*)(K_lds + (b) * SHM_K + KSWZ(sr, kc)) = sr_[i].ks0;                       \
    *(bf16x8*)(K_lds + (b) * SHM_K + KSWZ(32 + sr, kc)) = sr_[i].ks1; } while (0)
#define SWAIT() asm volatile("s_waitcnt vmcnt(4)" ::: "memory")
#define RESC(a) do { if (__any((a) < 1.f)) { if (hi == 0) al_l[r32] = (a); asm volatile("s_waitcnt lgkmcnt(0)" ::: "memory"); \
    _Pragma("unroll") for (int d = 0; d < 4; ++d) _Pragma("unroll") for (int r = 0; r < 16; ++r) o[d][r] *= al_l[crow(r, hi)]; } } while (0)
  f32x16 pA0, pA1, pB0, pB1; float mnA, mnB, alA, alB; bf16x8 pa0, pa1, pa2, pa3;
  constexpr int SE = 0, SO = 1;
  SLOAD(SE, 0); asm volatile("s_waitcnt vmcnt(0)" ::: "memory"); SWRITE(0, SE); __syncthreads();
  qkt(pA0, pA1, K_lds, qr, r32, hi); post_scores<MODE>(pA0, pA1, 0, qrow0, r32, hi, tab, cfar); partialSM(pA0, pA1, m_reg, mnA, alA);
  SLOAD(SO, KVBLK); if (2 < NT) SLOAD(SE, 2 * KVBLK);
  SWAIT(); SWRITE(1, SO); __syncthreads();
  for (int j = 1; j + 1 < NT; j += 2) {
    SBAR(); qkt(pB0, pB1, K_lds + SHM_K, qr, r32, hi); post_scores<MODE>(pB0, pB1, j, qrow0, r32, hi, tab, cfar);
    finishSM(pA0, pA1, alA, l_reg, pa0, pa1, pa2, pa3); SBAR();
    SLOAD(SO, (j + 2) * KVBLK); SBAR();
    pv_d0(o, vb0, pa0, pa1, pa2, pa3); partialSM(pB0, pB1, m_reg, mnB, alB);
    __syncthreads(); SWAIT(); SWRITE(0, SE);
    RESC(alB); __syncthreads();
    SBAR(); qkt(pA0, pA1, K_lds, qr, r32, hi); post_scores<MODE>(pA0, pA1, j + 1, qrow0, r32, hi, tab, cfar);
    finishSM(pB0, pB1, alB, l_reg, pa0, pa1, pa2, pa3); SBAR();
    if (j + 3 < NT) SLOAD(SE, (j + 3) * KVBLK); SBAR();
    pv_d0(o, vb0 + (int)SHM_V, pa0, pa1, pa2, pa3); partialSM(pA0, pA1, m_reg, mnA, alA);
    __syncthreads(); SWAIT(); SWRITE(1, SO);
    RESC(alA); __syncthreads();
  }
  SBAR(); qkt(pB0, pB1, K_lds + SHM_K, qr, r32, hi); post_scores<MODE>(pB0, pB1, NT - 1, qrow0, r32, hi, tab, cfar);
  finishSM(pA0, pA1, alA, l_reg, pa0, pa1, pa2, pa3); SBAR();
  pv_d0(o, vb0, pa0, pa1, pa2, pa3); partialSM(pB0, pB1, m_reg, mnB, alB);
  __syncthreads(); RESC(alB);
  finishSM(pB0, pB1, alB, l_reg, pa0, pa1, pa2, pa3); SBAR();
  pv_d0(o, vb0 + (int)SHM_V, pa0, pa1, pa2, pa3);
  if (hi == 0) li_l[r32] = l_reg; asm volatile("s_waitcnt lgkmcnt(0)" ::: "memory");
  float rli[16];
#pragma unroll
  for (int r = 0; r < 16; ++r) rli[r] = __builtin_amdgcn_rcpf(li_l[crow(r, hi)]);
  if constexpr (MODE == 0) {
    bf16* Ow = Ob + (long)(wid * QBLK) * ldo;
#pragma unroll
    for (int r = 0; r < 16; ++r) { const int orow = crow(r, hi);
#pragma unroll
      for (int d0 = 0; d0 < 4; ++d0) Ow[(long)orow * ldo + d0 * 32 + r32] = (bf16)f2bf(o[d0][r] * rli[r]); }
  } else {
    float* Ow = Of + (long)(wid * QBLK) * ldo;
#pragma unroll
    for (int r = 0; r < 16; ++r) { const int orow = crow(r, hi);
#pragma unroll
      for (int d0 = 0; d0 < 4; ++d0) Ow[(long)orow * ldo + d0 * 32 + r32] = o[d0][r] * rli[r]; }
  }
  __syncthreads();
#undef SLOAD
#undef SWRITE
#undef SWAIT
#undef RESC
}
}

#define XB_TMO      128
#define XB_XCNT(j)  (256  + 64 * (j))
#define XB_XSUB(j)  (1280 + 64 * (j))
#define XB_XGEN(j)  (2304 + 64 * (j))
#define XB_TOP      3328
#define XB_TOPGEN   3392
#define XCD_BAR_WORDS 3456
#define XB_SPIN_CAP (1u << 18)

__device__ __forceinline__ unsigned xb_ld(unsigned* p)              { return __hip_atomic_load(p, __ATOMIC_RELAXED, __HIP_MEMORY_SCOPE_AGENT); }
__device__ __forceinline__ unsigned xb_add(unsigned* p, unsigned v) { return __hip_atomic_fetch_add(p, v, __ATOMIC_RELAXED, __HIP_MEMORY_SCOPE_AGENT); }
__device__ __forceinline__ unsigned xb_xcc_id() { return (unsigned)__builtin_amdgcn_s_getreg((3 << 11) | 20) & 0xFu; }
#define XB_SPIN(cond, bar) do { unsigned _sp = 0; while (cond) { __builtin_amdgcn_s_sleep(1); \
    if ((++_sp & 255u) == 0u) { if (xb_ld(&(bar)[XB_TMO])) break; if (_sp > XB_SPIN_CAP) { atomicAdd(&(bar)[XB_TMO], 1u); break; } } } } while (0)

struct XcdBarrier {
    unsigned* bar; unsigned x;
    volatile LAS unsigned* st;
};

__device__ __forceinline__ XcdBarrier xcd_barrier_post(unsigned* bar, volatile LAS unsigned* st) {
    XcdBarrier b; b.bar = bar; b.x = xb_xcc_id(); b.st = st;
    if (threadIdx.x == 0) (void)xb_add(&bar[XB_XCNT(b.x)], 1u);
    return b;
}
__device__ __forceinline__ void xcd_barrier_complete(unsigned* bar, unsigned x, unsigned& nloc, unsigned& nx) {
    const unsigned G = gridDim.x * gridDim.y * gridDim.z;
    unsigned sum, cnt, mine, sp = 0u;
    for (;;) {
        sum = 0u; cnt = 0u; mine = 0u;
#pragma unroll
        for (unsigned j = 0; j < 16; ++j) { const unsigned c = xb_ld(&bar[XB_XCNT(j)]); sum += c; cnt += (c > 0u) ? 1u : 0u; mine = (j == x) ? c : mine; }
        if (sum == G) break;
        __builtin_amdgcn_s_sleep(1);
        if ((++sp & 255u) == 0u) { if (xb_ld(&bar[XB_TMO])) break; if (sp > XB_SPIN_CAP) { atomicAdd(&bar[XB_TMO], 1u); break; } }
    }
    nloc = mine > 0u ? mine : 1u; nx = cnt > 0u ? cnt : 1u;
}

__device__ __forceinline__ void xcd_barrier(const XcdBarrier& b) {
    asm volatile("s_waitcnt vmcnt(0)" ::: "memory");
    __syncthreads();
    if (threadIdx.x == 0) {
        unsigned* bar = b.bar;
        __builtin_amdgcn_s_waitcnt(0);
        unsigned nloc = b.st[0], nx = b.st[1];
        if (nloc == 0u) { xcd_barrier_complete(bar, b.x, nloc, nx); b.st[0] = nloc; b.st[1] = nx; }
        const unsigned old = xb_add(&bar[XB_XSUB(b.x)], 1u);
        const unsigned gen = old / nloc;
        if (old + 1u == (gen + 1u) * nloc) {
            __builtin_amdgcn_fence(__ATOMIC_RELEASE, "agent");
            asm volatile("s_waitcnt vmcnt(0)" ::: "memory");
            const unsigned og = xb_add(&bar[XB_TOP], 1u);
            const unsigned tg = og / nx;
            if (og + 1u == (tg + 1u) * nx) xb_add(&bar[XB_TOPGEN], 1u);
            else XB_SPIN(xb_ld(&bar[XB_TOPGEN]) == tg, bar);
            __builtin_amdgcn_fence(__ATOMIC_ACQUIRE, "agent");
            xb_add(&bar[XB_XGEN(b.x)], 1u);
            asm volatile("s_waitcnt vmcnt(0)" ::: "memory");
        } else {
            XB_SPIN(xb_ld(&bar[XB_XGEN(b.x)]) == gen, bar);
            __builtin_amdgcn_fence(__ATOMIC_ACQUIRE, "agent");
            asm volatile("s_waitcnt vmcnt(0)" ::: "memory");
        }
    }
    __syncthreads();
}


struct Args { const float* in[24]; float* out; unsigned char* ws; int ph_lo, ph_hi; };
enum { I_X = 0, I_MEM, I_AWIN, I_ALNG, I_ALNB, I_AWS, I_ABS, I_AWOUT, I_BWIN, I_BLAM, I_BSUBG, I_BWOUT, I_WKV, I_RELB, I_MEMWKV, I_LNG, I_LNB,
       I_WG1, I_BG1, I_WG2, I_BG2, I_W1, I_W3, I_W2 };
constexpr int NPH_LAYER = 9, NPHASES = 1 + DEPTH * NPH_LAYER;

struct Frame {
    LAS unsigned char* lds; char* ldsg;
    gu32* ctl; unsigned char* ws;
    int tid, lane, wave, G, c;
};

__device__ __forceinline__ void transpose_item(const float* W, int K, int N, bf16* WT, int drow0, LAS float* scr, int k0, int n0, int lane) {
#pragma unroll 8
    for (int i = 0; i < 32; ++i) { const int kk = 2 * i + (lane >> 5); scr[kk * 33 + (lane & 31)] = W[(size_t)(k0 + kk) * N + n0 + (lane & 31)]; }
    LDS_WAIT(); asm volatile("" ::: "memory");
    const int c = lane & 7;
#pragma unroll
    for (int j = 0; j < 4; ++j) { const int n = (lane >> 3) + 8 * j; const LAS float* s = scr + (8 * c) * 33 + n;
        v4u o; o.x = pk2(s[0 * 33], s[1 * 33]); o.y = pk2(s[2 * 33], s[3 * 33]); o.z = pk2(s[4 * 33], s[5 * 33]); o.w = pk2(s[6 * 33], s[7 * 33]);
        *(GAS v4u*)(WT + (size_t)(drow0 + n) * K + k0 + 8 * c) = o; }
    LDS_WAIT(); asm volatile("" ::: "memory");
}
__device__ __forceinline__ void transpose_item_fast(const float* W, int K, int N, bf16* WT, int drow0, LAS float* scr, int k0, int n0, int lane) {
    float t[32];
#pragma unroll
    for (int i = 0; i < 32; ++i) t[i] = W[(size_t)(k0 + 2 * i + (lane >> 5)) * N + n0 + (lane & 31)];
#pragma unroll
    for (int i = 0; i < 32; i += 8) asm volatile("" : "+v"(t[i]), "+v"(t[i + 1]), "+v"(t[i + 2]), "+v"(t[i + 3]), "+v"(t[i + 4]), "+v"(t[i + 5]), "+v"(t[i + 6]), "+v"(t[i + 7]));
#pragma unroll
    for (int i = 0; i < 32; ++i) scr[(2 * i + (lane >> 5)) * 33 + (lane & 31)] = t[i];
    LDS_WAIT(); asm volatile("" ::: "memory");
    const int c = lane & 7;
#pragma unroll
    for (int j = 0; j < 4; ++j) { const int n = (lane >> 3) + 8 * j; const LAS float* s = scr + (8 * c) * 33 + n;
        v4u o; o.x = pk2(s[0 * 33], s[1 * 33]); o.y = pk2(s[2 * 33], s[3 * 33]); o.z = pk2(s[4 * 33], s[5 * 33]); o.w = pk2(s[6 * 33], s[7 * 33]);
        *(GAS v4u*)(WT + (size_t)(drow0 + n) * K + k0 + 8 * c) = o; }
    LDS_WAIT(); asm volatile("" ::: "memory");
}
__device__ __forceinline__ void transpose_item_fp8(const float* W, int K, int N, unsigned char* WT, int drow0, LAS float* scr, int k0, int n0, int lane) {
    float t[32];
#pragma unroll
    for (int i = 0; i < 32; ++i) t[i] = W[(size_t)(k0 + 2 * i + (lane >> 5)) * N + n0 + (lane & 31)];
#pragma unroll
    for (int i = 0; i < 32; i += 8) asm volatile("" : "+v"(t[i]), "+v"(t[i + 1]), "+v"(t[i + 2]), "+v"(t[i + 3]), "+v"(t[i + 4]), "+v"(t[i + 5]), "+v"(t[i + 6]), "+v"(t[i + 7]));
#pragma unroll
    for (int i = 0; i < 32; ++i) scr[(2 * i + (lane >> 5)) * 33 + (lane & 31)] = t[i];
    LDS_WAIT(); asm volatile("" ::: "memory");
    const int c = lane & 7;
#pragma unroll
    for (int j = 0; j < 4; ++j) { const int n = (lane >> 3) + 8 * j; const LAS float* s = scr + (8 * c) * 33 + n;
        unsigned lo = 0u, hi = 0u;
        lo = __builtin_amdgcn_cvt_pk_fp8_f32(s[0 * 33] * 64.f, s[1 * 33] * 64.f, lo, false); lo = __builtin_amdgcn_cvt_pk_fp8_f32(s[2 * 33] * 64.f, s[3 * 33] * 64.f, lo, true);
        hi = __builtin_amdgcn_cvt_pk_fp8_f32(s[4 * 33] * 64.f, s[5 * 33] * 64.f, hi, false); hi = __builtin_amdgcn_cvt_pk_fp8_f32(s[6 * 33] * 64.f, s[7 * 33] * 64.f, hi, true);
        v2u o; o.x = lo; o.y = hi; *(GAS v2u*)(WT + (size_t)(drow0 + n) * K + k0 + 8 * c) = o; }
    LDS_WAIT(); asm volatile("" ::: "memory");
}
#ifndef CDRAIN
#define CDRAIN 8
#endif
#ifndef CSRV
#define CSRV 4
#endif
#ifndef CSRVA
#define CSRVA 32
#endif
#ifndef STOPU
#define STOPU 64
#endif
#ifndef QX
#define QX 6
#endif
#ifndef QA
#define QA 14
#endif
#ifndef QM
#define QM 7
#endif
#ifndef QB
#define QB 4
#endif
constexpr int NQ = 7, MOE_ITEMS = 3 * 32 * 512;
__device__ __forceinline__ int conv_qsize(int q) { return (q & 1) ? (q == 1 ? 5632 : (q == 3 ? 7168 : 4096)) : MOE_ITEMS; }
__device__ __forceinline__ void conv_item(Frame& F, const Args& a, int q, int it) {
    LAS float* scr = (LAS float*)(F.lds + RING_OFF + F.wave * 16384);
    if (q & 1) {
        const float* src; bf16* dst; int N, r = it;
        if (q == 1) { if (r < 3584) { N = 3584; src = a.in[I_AWIN] + (size_t)2048 * 3584; dst = (bf16*)(F.ws + WS_WAIN) + (size_t)2048 * 3584; } else { r -= 3584; N = 2048; src = a.in[I_AWOUT] + (size_t)2048 * 2048; dst = (bf16*)(F.ws + WS_WAOUT) + (size_t)2048 * 2048; } }
        else if (q == 3) { if (r < 2048) { N = 2048; src = a.in[I_BWIN]; dst = (bf16*)(F.ws + WS_WBIN0); } else if ((r -= 2048) < 3072) { N = 3072; src = a.in[I_WKV]; dst = (bf16*)(F.ws + WS_WKV); } else { r -= 3072; N = 2048; src = a.in[I_BWOUT]; dst = (bf16*)(F.ws + WS_WBOUT); } }
        else { if (r < 2048) { N = 2048; src = a.in[I_BWIN] + (size_t)2048 * 2048; dst = (bf16*)(F.ws + WS_WBIN1); } else { r -= 2048; N = 2048; src = a.in[I_BWOUT] + (size_t)2048 * 2048; dst = (bf16*)(F.ws + WS_WBOUT) + (size_t)2048 * 2048; } }
        const int nblk = N / 32, kb = r / nblk, nb = r - kb * nblk;
        transpose_item_fast(src, 2048, N, dst, 32 * nb, scr, 64 * kb, 32 * nb, F.lane);
        return;
    }
    const int L = q >> 1, seg = it >> 14, r0 = it & 16383, e = r0 >> 9, r = r0 & 511, mat = L * 32 + e;
    if (seg < 2) { const int kb = r >> 4, nb = r & 15, n0 = 32 * nb;
        transpose_item_fp8(a.in[seg == 0 ? I_W1 : I_W3] + (size_t)mat * 2048 * 512, 2048, 512, (unsigned char*)(F.ws + WS_W13) + (size_t)mat * 1024 * 2048, (n0 >> 7) * 256 + (n0 & 127) + (seg == 1 ? 128 : 0), scr, 64 * kb, n0, F.lane); }
    else { const int kb = r >> 6, nb = r & 63;
        transpose_item_fp8(a.in[I_W2] + (size_t)mat * 512 * 2048, 512, 2048, (unsigned char*)(F.ws + WS_W2) + (size_t)mat * 512 * 2048, 32 * nb, scr, 64 * kb, 32 * nb, F.lane); }
}
#ifndef F8MASK
#define F8MASK 4
#endif
#define F8L(l) (((F8MASK) >> (l)) & 1)
#ifndef F8OMASK
#define F8OMASK 12
#endif
#define F8OL(l) (((F8OMASK) >> (l)) & 1)
#ifndef CDEPTH
#define CDEPTH 3
#endif
struct CDesc { const float* src; unsigned char* dst; int N, K, drow0, k0, n0, f8; };
__device__ __forceinline__ CDesc conv_desc(Frame& F, const Args& a, int q, int it) {
    CDesc d;
    if (q & 1) {
        const float* src; unsigned char* dst; int N, r = it, f8 = F8L((q + 1) >> 1);
        if (q == 1) { if (r < 3584) { N = 3584; src = a.in[I_AWIN] + (size_t)2048 * 3584; dst = F.ws + WS_WAIN + (size_t)2048 * 3584 * 2; } else { r -= 3584; N = 2048; f8 = 0; src = a.in[I_AWOUT] + (size_t)2048 * 2048; dst = F.ws + WS_WAOUT + (size_t)2048 * 2048 * 2; } }
        else if (q == 3) { if (r < 2048) { N = 2048; src = a.in[I_BWIN]; dst = F.ws + WS_WBIN0; } else if ((r -= 2048) < 3072) { N = 3072; src = a.in[I_WKV]; dst = F.ws + WS_WBIN0 + (size_t)2048 * 2048 * (F8L(2) ? 1 : 2); } else { r -= 3072; N = 2048; f8 = F8OL(2); src = a.in[I_BWOUT]; dst = F.ws + WS_WBOUT; } }
        else { if (r < 2048) { N = 2048; src = a.in[I_BWIN] + (size_t)2048 * 2048; dst = F.ws + WS_WBIN1; } else { r -= 2048; N = 2048; f8 = F8OL(3); src = a.in[I_BWOUT] + (size_t)2048 * 2048; dst = F.ws + WS_WBOUT + (size_t)2048 * 2048 * 2; } }
        const int nblk = N / 32, kb = r / nblk, nb = r - kb * nblk;
        d.src = src; d.dst = dst; d.N = N; d.K = 2048; d.drow0 = 32 * nb; d.k0 = 64 * kb; d.n0 = 32 * nb; d.f8 = f8; return d;
    }
    const int L = q >> 1, seg = it >> 14, r0 = it & 16383, e = r0 >> 9, r = r0 & 511, mat = L * 32 + e;
    if (seg < 2) { const int kb = r >> 4, nb = r & 15, n0 = 32 * nb;
        d.src = a.in[seg == 0 ? I_W1 : I_W3] + (size_t)mat * 2048 * 512; d.dst = (unsigned char*)(F.ws + WS_W13) + (size_t)mat * 1024 * 2048; d.N = 512; d.K = 2048;
        d.drow0 = (n0 >> 7) * 256 + (n0 & 127) + (seg == 1 ? 128 : 0); d.k0 = 64 * kb; d.n0 = n0; d.f8 = 1; }
    else { const int kb = r >> 6, nb = r & 63;
        d.src = a.in[I_W2] + (size_t)mat * 512 * 2048; d.dst = (unsigned char*)(F.ws + WS_W2) + (size_t)mat * 512 * 2048; d.N = 2048; d.K = 512; d.drow0 = 32 * nb; d.k0 = 64 * kb; d.n0 = 32 * nb; d.f8 = 1; }
    return d;
}
#define CV_LOAD(t_, d_) do { const float* p_ = (d_).src + (size_t)((d_).k0 + (F.lane >> 3)) * (d_).N + (d_).n0 + 4 * (F.lane & 7); const size_t st_ = (size_t)8 * (d_).N; \
    _Pragma("unroll") for (int i_ = 0; i_ < 8; ++i_) (t_)[i_] = *(const GAS f32x4*)(p_ + st_ * i_); } while (0)
__device__ __forceinline__ void conv_process(Frame& F, f32x4 (&t)[8], const CDesc& d) {
    LAS float* scr = (LAS float*)(F.lds + RING_OFF + F.wave * 16384); const int lane = F.lane;
    asm volatile("" : "+v"(t[0]), "+v"(t[1]), "+v"(t[2]), "+v"(t[3]), "+v"(t[4]), "+v"(t[5]), "+v"(t[6]), "+v"(t[7]));
    { LAS float* w = scr + (lane >> 3) * 33 + 4 * (lane & 7);
#pragma unroll
      for (int i = 0; i < 8; ++i) { w[i * 8 * 33 + 0] = t[i].x; w[i * 8 * 33 + 1] = t[i].y; w[i * 8 * 33 + 2] = t[i].z; w[i * 8 * 33 + 3] = t[i].w; } }
    LDS_WAIT(); asm volatile("" ::: "memory");
    const int c = lane & 7;
    if (d.f8) {
#pragma unroll
        for (int j = 0; j < 4; ++j) { const int n = (lane >> 3) + 8 * j; const LAS float* s = scr + (8 * c) * 33 + n;
            unsigned lo = 0u, hi = 0u;
            lo = __builtin_amdgcn_cvt_pk_fp8_f32(s[0 * 33] * 64.f, s[1 * 33] * 64.f, lo, false); lo = __builtin_amdgcn_cvt_pk_fp8_f32(s[2 * 33] * 64.f, s[3 * 33] * 64.f, lo, true);
            hi = __builtin_amdgcn_cvt_pk_fp8_f32(s[4 * 33] * 64.f, s[5 * 33] * 64.f, hi, false); hi = __builtin_amdgcn_cvt_pk_fp8_f32(s[6 * 33] * 64.f, s[7 * 33] * 64.f, hi, true);
            v2u o; o.x = lo; o.y = hi; *(GAS v2u*)(d.dst + (size_t)(d.drow0 + n) * d.K + d.k0 + 8 * c) = o; }
    } else {
#pragma unroll
        for (int j = 0; j < 4; ++j) { const int n = (lane >> 3) + 8 * j; const LAS float* s = scr + (8 * c) * 33 + n;
            v4u o; o.x = pk2(s[0 * 33], s[1 * 33]); o.y = pk2(s[2 * 33], s[3 * 33]); o.z = pk2(s[4 * 33], s[5 * 33]); o.w = pk2(s[6 * 33], s[7 * 33]);
            *(GAS v4u*)((bf16*)d.dst + (size_t)(d.drow0 + n) * d.K + d.k0 + 8 * c) = o; }
    }
    LDS_WAIT(); asm volatile("" ::: "memory");
}
__device__ __forceinline__ void conv_range(Frame& F, const Args& a, int q, int first, int cnt) {
#if CDEPTH == 1
    for (int i = 0; i < cnt; ++i) conv_item(F, a, q, first + i);
#else
    f32x4 t[CDEPTH][8]; const int last = first + cnt - 1;
#pragma unroll
    for (int s = 0; s < CDEPTH - 1; ++s) { const int it = first + s < last ? first + s : last; const CDesc d = conv_desc(F, a, q, it); CV_LOAD(t[s], d); }
#pragma unroll 1
    for (int i0 = 0; i0 < cnt; i0 += CDEPTH) {
#pragma unroll
        for (int s = 0; s < CDEPTH; ++s) {
            { const int nx = first + i0 + s + CDEPTH - 1, it = nx < last ? nx : last; const CDesc d = conv_desc(F, a, q, it); CV_LOAD(t[(s + CDEPTH - 1) % CDEPTH], d); }
            asm volatile("" ::: "memory");
            if (i0 + s < cnt) { const CDesc d = conv_desc(F, a, q, first + i0 + s); conv_process(F, t[s], d); }
        }
    }
#endif
}
__device__ __forceinline__ void conv_filler(Frame& F, const Args& a, int q0, int n) {
    if (q0 >= NQ || n == 0) return;
#ifdef CONV_ALL_PRO
    return;
#endif
    LAS unsigned* bw = (LAS unsigned*)(F.lds + TAB_OFF + 384);
    __syncthreads();
    const bool drain = n < 0; const int per = drain ? CDRAIN : n; int q = q0;
    for (;;) {
        if (F.tid == 0) bw[0] = __hip_atomic_fetch_add(F.ctl + CW_CONV + 64 * q, (unsigned)(8 * per), RLX_AGENT);
        __syncthreads();
        const unsigned idx = bw[0];
        __syncthreads();
        const int qs = conv_qsize(q);
        if (idx >= (unsigned)qs) { if (drain || ++q >= NQ) break; continue; }
        { const int first = (int)idx + F.wave * per, cnt = (qs - first < per) ? qs - first : per; if (cnt > 0) conv_range(F, a, q, first, cnt); }
        if (!drain) break;
    }
}

__device__ __forceinline__ void prologue_phase(Frame& F, const Args& a) {
#ifdef TOUCH
    {
        const long nthr_ = (long)F.G * 512, gt_ = (long)F.c * 512 + F.tid; unsigned acc_ = 0u;
        for (long pg = gt_; pg < (long)(WS_END / 4096); pg += nthr_) acc_ += *(const GAS unsigned*)(F.ws + pg * 4096);
        for (long pg = gt_; pg < (long)((size_t)DEPTH * NE * D * FF * 4 / 4096); pg += nthr_) { acc_ += *(const GAS unsigned*)((const char*)a.in[I_W1] + pg * 4096); acc_ += *(const GAS unsigned*)((const char*)a.in[I_W3] + pg * 4096); acc_ += *(const GAS unsigned*)((const char*)a.in[I_W2] + pg * 4096); }
        if (acc_ == 0x12345679u) F.ctl[CW_TMO] = acc_;
    }
#endif
    LAS float* scr = (LAS float*)(F.lds + RING_OFF + F.wave * 16384);
    const int gw = F.c * NWAVES + F.wave, NGW = F.G * NWAVES;
    unsigned char* ws = F.ws;
    constexpr int S0 = 3584, S1 = 2048, S5 = 4 * 1024;
    constexpr int NITEMS = S0 + S1 + S5;
    for (int it = gw; it < NITEMS; it += NGW) {
        int r = it; const float* src; unsigned char* dst; int K = 2048, N; bool f8 = F8L(0);
        if (r < S0) { N = 3584; src = a.in[I_AWIN]; dst = ws + WS_WAIN; }
        else if ((r -= S0) < S1) { N = 2048; f8 = false; src = a.in[I_AWOUT]; dst = ws + WS_WAOUT; }
        else { r -= S1; const int mat = r >> 10; r &= 1023; N = 1024; src = a.in[I_MEMWKV] + (size_t)mat * K * N; dst = ws + WS_WMKV + (size_t)mat * K * N * (F8L(0) ? 1 : 2); }
        const int nblk = N / 32, kb = r / nblk, nb = r - kb * nblk;
        if (f8) transpose_item_fp8(src, K, N, dst, 32 * nb, scr, 64 * kb, 32 * nb, F.lane);
        else transpose_item_fast(src, K, N, (bf16*)dst, 32 * nb, scr, 64 * kb, 32 * nb, F.lane);
    }
#ifdef CONV_ALL_PRO
    for (int q = 0; q < NQ; ++q) { const int qs = conv_qsize(q); for (int it = gw * 4; it < qs; it += NGW * 4) conv_range(F, a, q, it, qs - it < 4 ? qs - it : 4); }
#endif
    const long nthr = (long)F.G * 512, gt = (long)F.c * 512 + F.tid;
    { float* wr = (float*)(ws + WS_WR);
      for (long i = gt; i < (long)DEPTH * 3 * 512 * 16 * 4; i += nthr) { const int j = (int)(i & 3), c = (int)((i >> 2) & 15), kg = (int)((i >> 6) & 511), r = (int)(i >> 15), nb = r % 3, l = r / 3;
          const int k = 4 * kg + j, o = 16 * nb + c; float v = 0.f;
          if (o < 4) v = a.in[I_WG1][((size_t)l * D + k) * 4 + o]; else if (o < 36) { const int g = (o - 4) >> 3, e = (o - 4) & 7; v = a.in[I_WG2][(((size_t)l * 4 + g) * D + k) * 8 + e]; }
          wr[i] = v; } }
    { const float* x = a.in[I_X]; bf16* xb = (bf16*)(ws + WS_XB);
      for (long i = gt; i < (long)T * D / 8; i += nthr) { const f32x4 v0 = *(const GAS f32x4*)(x + i * 8), v1 = *(const GAS f32x4*)(x + i * 8 + 4);
          v4u o; o.x = pk2(v0.x, v0.y); o.y = pk2(v0.z, v0.w); o.z = pk2(v1.x, v1.y); o.w = pk2(v1.z, v1.w); *(GAS v4u*)(xb + i * 8) = o;
          unsigned lo = 0u, hi = 0u; lo = __builtin_amdgcn_cvt_pk_fp8_f32(v0.x, v0.y, lo, false); lo = __builtin_amdgcn_cvt_pk_fp8_f32(v0.z, v0.w, lo, true); hi = __builtin_amdgcn_cvt_pk_fp8_f32(v1.x, v1.y, hi, false); hi = __builtin_amdgcn_cvt_pk_fp8_f32(v1.z, v1.w, hi, true);
          v2u qq; qq.x = lo; qq.y = hi; *(GAS v2u*)(ws + WS_XQ + i * 8) = qq; } }
    { const float* x = a.in[I_MEM]; bf16* xb = (bf16*)(ws + WS_MEMB);
      for (long i = gt; i < (long)MEMT * D / 8; i += nthr) { const f32x4 v0 = *(const GAS f32x4*)(x + i * 8), v1 = *(const GAS f32x4*)(x + i * 8 + 4);
          v4u o; o.x = pk2(v0.x, v0.y); o.y = pk2(v0.z, v0.w); o.z = pk2(v1.x, v1.y); o.w = pk2(v1.z, v1.w); *(GAS v4u*)(xb + i * 8) = o;
          unsigned lo = 0u, hi = 0u; lo = __builtin_amdgcn_cvt_pk_fp8_f32(v0.x, v0.y, lo, false); lo = __builtin_amdgcn_cvt_pk_fp8_f32(v0.z, v0.w, lo, true); hi = __builtin_amdgcn_cvt_pk_fp8_f32(v1.x, v1.y, hi, false); hi = __builtin_amdgcn_cvt_pk_fp8_f32(v1.z, v1.w, hi, true);
          v2u qq; qq.x = lo; qq.y = hi; *(GAS v2u*)(ws + WS_MEMQ + i * 8) = qq; } }
}

#ifndef NCVMAX
#define NCVMAX 0
#endif
#ifndef NCVATT
#define NCVATT 96
#endif
__device__ __forceinline__ int conv_servers(int nu, int G, int fin) {
    if (fin || nu <= 0) return 0;
    const int rounds = (nu + G - 1) / G, gmin = (nu + rounds - 1) / rounds; int n = G - gmin; n = n < NCVMAX ? n : NCVMAX; return n & ~7;
}
__device__ __forceinline__ void conv_done(Frame& F, int p) { __syncthreads(); if (F.tid == 0) __hip_atomic_fetch_add(F.ctl + CW_DONE + 64 * p, 1u, RLX_AGENT); }
__device__ __forceinline__ void conv_server(Frame& F, const Args& a, int p, int q0, int ncomp) {
    int q = q0;
    for (;;) {
        if (q >= NQ) break;
        unsigned idx = 0xffffffffu;
        if (F.lane == 0) { if (__hip_atomic_load(F.ctl + CW_DONE + 64 * p, RLX_AGENT) < (unsigned)ncomp) idx = __hip_atomic_fetch_add(F.ctl + CW_CONV + 64 * q, (unsigned)CSRV, RLX_AGENT); }
        idx = (unsigned)__builtin_amdgcn_readfirstlane((int)idx);
        if (idx == 0xffffffffu) break;
        const int qs = conv_qsize(q);
        if (idx >= (unsigned)qs) { ++q; continue; }
        conv_range(F, a, q, (int)idx, (qs - (int)idx < CSRV) ? qs - (int)idx : CSRV);
    }
}
__device__ __forceinline__ void conv_server_q(Frame& F, const Args& a, gu32* head, unsigned stop_at, int q0) {
    int q = q0;
    for (;;) {
        if (q >= NQ) break;
        unsigned idx = 0xffffffffu;
        if (F.lane == 0) { if (__hip_atomic_load(head, RLX_AGENT) < stop_at) idx = __hip_atomic_fetch_add(F.ctl + CW_CONV + 64 * q, (unsigned)CSRVA, RLX_AGENT); }
        idx = (unsigned)__builtin_amdgcn_readfirstlane((int)idx);
        if (idx == 0xffffffffu) break;
        const int qs = conv_qsize(q);
        if (idx >= (unsigned)qs) { ++q; continue; }
        conv_range(F, a, q, (int)idx, (qs - (int)idx < CSRVA) ? qs - (int)idx : CSRVA);
    }
}
__device__ __forceinline__ void conv_note_fin(Frame& F, int p) {
    if (blockIdx.x == 0 && F.tid == 0) { unsigned all = 1u;
        for (int q = 0; q < NQ; ++q) all &= (__hip_atomic_load(F.ctl + CW_CONV + 64 * q, RLX_AGENT) >= (unsigned)conv_qsize(q)) ? 1u : 0u;
        __hip_atomic_store(F.ctl + CW_FIN + 64 * p, all, RLX_AGENT); }
}

__device__ __forceinline__ void sgu_unit(Frame& F, const Args& a, int l, int n, int g) {
    constexpr int LDW = 136;
    LAS float* stats = (LAS float*)(F.lds); LAS bf16* Wl = (LAS bf16*)(F.lds + 1024); LAS bf16* Vt = (LAS bf16*)(F.lds + 35840);
    const bf16* z = (const bf16*)(F.ws + WS_Z); bf16* cat = (bf16*)(F.ws + WS_CAT);
    const int tok0 = n * 128;
    for (int i = 0; i < 16; ++i) { const int tk = F.wave * 16 + i; const GAS v4u* rp = (const GAS v4u*)(z + (size_t)(tok0 + tk) * NINA + MIXW) + F.lane;
        v4u w[3]; float s = 0.f;
#pragma unroll
        for (int j = 0; j < 3; ++j) { w[j] = rp[64 * j]; s += (bflo(w[j].x) + bfhi(w[j].x)) + (bflo(w[j].y) + bfhi(w[j].y)) + (bflo(w[j].z) + bfhi(w[j].z)) + (bflo(w[j].w) + bfhi(w[j].w)); }
        const float mean = wave_sum(s) * (1.f / MIXW); float q = 0.f;
#pragma unroll
        for (int j = 0; j < 3; ++j) { float d;
            d = bflo(w[j].x) - mean; q += d * d; d = bfhi(w[j].x) - mean; q += d * d; d = bflo(w[j].y) - mean; q += d * d; d = bfhi(w[j].y) - mean; q += d * d;
            d = bflo(w[j].z) - mean; q += d * d; d = bfhi(w[j].z) - mean; q += d * d; d = bflo(w[j].w) - mean; q += d * d; d = bfhi(w[j].w) - mean; q += d * d; }
        const float rstd = 1.f / sqrtf(wave_sum(q) * (1.f / MIXW) + LN_EPS);
        if (F.lane == 0) { stats[2 * tk] = mean; stats[2 * tk + 1] = rstd; } }
    { const float* wsrc = a.in[I_AWS] + ((size_t)l * 4 + g) * 128 * 128;
      for (int p = F.tid; p < 128 * 32; p += 512) { const int i = p >> 5, j4 = (p & 31) * 4; f32x4 v = *(const GAS f32x4*)(wsrc + i * 128 + j4);
          if ((j4 >> 6) > (i >> 6)) v = (f32x4){0.f, 0.f, 0.f, 0.f};
          v2u o; o.x = pk2(v.x, v.y); o.y = pk2(v.z, v.w); *(LAS v2u*)(Wl + i * LDW + j4) = o; } }
    __syncthreads();
    { const float* lg = a.in[I_ALNG] + (size_t)l * MIXW + g * 384; const float* lb = a.in[I_ALNB] + (size_t)l * MIXW + g * 384;
      for (int p = F.tid; p < 128 * 48; p += 512) { const int j = p & 127, c8 = (p >> 7) * 8;
          const v4u w = *(const GAS v4u*)(z + (size_t)(tok0 + j) * NINA + MIXW + g * 384 + c8);
          const float mean = stats[2 * j], rstd = stats[2 * j + 1];
          const f32x4 g0 = *(const GAS f32x4*)(lg + c8), g1 = *(const GAS f32x4*)(lg + c8 + 4), b0 = *(const GAS f32x4*)(lb + c8), b1 = *(const GAS f32x4*)(lb + c8 + 4);
          float v[8] = {bflo(w.x), bfhi(w.x), bflo(w.y), bfhi(w.y), bflo(w.z), bfhi(w.z), bflo(w.w), bfhi(w.w)};
          const float gg[8] = {g0.x, g0.y, g0.z, g0.w, g1.x, g1.y, g1.z, g1.w}, bb[8] = {b0.x, b0.y, b0.z, b0.w, b1.x, b1.y, b1.z, b1.w};
#pragma unroll
          for (int e = 0; e < 8; ++e) Vt[(c8 + e) * LDW + j] = (bf16)f2bf((v[e] - mean) * rstd * gg[e] + bb[e]); } }
    __syncthreads();
    const int fr = F.lane & 15, fq = F.lane >> 4;
    f32x4 acc[8][3];
#pragma unroll
    for (int mb = 0; mb < 8; ++mb)
#pragma unroll
        for (int nb = 0; nb < 3; ++nb) acc[mb][nb] = (f32x4){0.f, 0.f, 0.f, 0.f};
#pragma unroll
    for (int ks = 0; ks < 4; ++ks) { bf16x8 bfr[3];
#pragma unroll
        for (int nb = 0; nb < 3; ++nb) bfr[nb] = *(const LAS bf16x8*)(Vt + (F.wave * 48 + nb * 16 + fr) * LDW + ks * 32 + fq * 8);
#pragma unroll
        for (int mb = 0; mb < 8; ++mb) { const bf16x8 afr = *(const LAS bf16x8*)(Wl + (mb * 16 + fr) * LDW + ks * 32 + fq * 8);
#pragma unroll
            for (int nb = 0; nb < 3; ++nb) acc[mb][nb] = __builtin_amdgcn_mfma_f32_16x16x32_bf16(bfr[nb], afr, acc[mb][nb], 0, 0, 0); } }
    const float* bs = a.in[I_ABS] + ((size_t)l * 4 + g) * 128;
#pragma unroll
    for (int mb = 0; mb < 8; ++mb) { const int i = mb * 16 + fr; const float bsv = bs[i]; const size_t tk = (size_t)(tok0 + i);
#pragma unroll
        for (int nb = 0; nb < 3; ++nb) { const int c = g * 384 + F.wave * 48 + nb * 16 + 4 * fq;
            const v2u uw = *(const GAS v2u*)(z + tk * NINA + c); const f32x4 gt = acc[mb][nb] + bsv;
            v2u o; o.x = pk2(bflo(uw.x) * gt.x, bfhi(uw.x) * gt.y); o.y = pk2(bflo(uw.y) * gt.z, bfhi(uw.y) * gt.w);
            *(GAS v2u*)(cat + tk * D + c) = o; } }
    __syncthreads();
}

__device__ __forceinline__ void memattn_unit(Frame& F, int l, int hm, int qb, int ldz, int qoff) {
    const bf16* z = (const bf16*)(F.ws + WS_Z); const bf16* kv = (const bf16*)(F.ws + WS_MEMKV) + (size_t)l * 256 * 1024; bf16* cat = (bf16*)(F.ws + WS_CAT);
    att::attn_body<0>(z + (size_t)qb * 256 * ldz + qoff + hm * 128, ldz, kv + hm * 128, kv + 512 + hm * 128, 1024,
                      cat + (size_t)qb * 256 * D + MIXW + hm * 128, nullptr, D, 4, 0, nullptr, 0.f, F.ldsg);
}

__device__ __forceinline__ int t5_bucket(int rel) {
    const int a = rel < 0 ? -rel : rel; int f;
    if (a < 8) f = a; else if (a < 12) f = 8; else if (a < 16) f = 9; else if (a < 23) f = 10; else if (a < 32) f = 11; else if (a < 46) f = 12; else if (a < 64) f = 13; else if (a < 91) f = 14; else f = 15;
    return (rel > 0 ? 16 : 0) + f;
}

namespace att2 {
using att::bf16x8; using att::s16x4; using att::f32x16; using att::u32x4; using att::crow; using att::cvtpk; using att::tr_read; using att::v_rd_base;
constexpr int KT = 32, ST_K = KT * 128 * 2, ST_V = KT * 256 * 2, STAGE = 2 * ST_K + ST_V, NST = 3;
constexpr int LDS_WS = NST * STAGE, LDS_TAB = LDS_WS + 2048, LDS_UNIT = LDS_TAB + 640, LDS_END = LDS_UNIT + 16;
constexpr int NUNITS = 576;
constexpr float THR2 = 8.f * 1.4426950408889634f;
__device__ __forceinline__ int swap23(int k) { return (k & ~0xC) | ((k & 4) << 1) | ((k & 8) >> 1); }
constexpr int v_off(int d0, int ks, int half) { return d0 * 512 + ks * 8192 + half * 4096; }

struct UnitTable { unsigned short u[NUNITS]; };
constexpr UnitTable make_units() {
    UnitTable t{}; int n = 0;
    for (int c = 256; c >= 4; c -= 2) {
        { const int b = (c - 2) / 2; if ((c - 2) % 2 == 0 && b >= 32 && b <= 63) for (int part = 1; part <= 2; ++part) for (int h = 0; h < 6; ++h) t.u[n++] = (unsigned short)(h | (b << 3) | (part << 9)); }
        if (c % 4 == 0) { const int b = c / 4 - 1; if (b >= 0 && b < 32) for (int h = 0; h < 6; ++h) t.u[n++] = (unsigned short)(h | (b << 3)); }
    }
    return t;
}
__device__ const UnitTable g_units = make_units();

__device__ __forceinline__ void diff_unit(const bf16* __restrict__ Q, const bf16* __restrict__ KD, const bf16* __restrict__ VD, float* Obuf  , int orow0,
                                          float* ML  , const float* relb, int h, int b, int t_lo, int t_hi, LAS char* lds) {
  int tid_ = threadIdx.x; asm volatile("" : "+v"(tid_));
  const int tid = tid_, wid = __builtin_amdgcn_readfirstlane(tid >> 6), lane = tid & 63, r32 = lane & 31, hi = lane >> 5, m = wid >> 2, rg = wid & 3;
  LAS float* wsw = (LAS float*)(lds + LDS_WS) + wid * 64; LAS float* li_l = wsw; LAS float* al_l = wsw + 32;
  LAS float* tab = (LAS float*)(lds + LDS_TAB);
  if (tid < att::TAB_N) tab[tid] = relb[t5_bucket(63 - tid) * 6 + h] * LOG2E;
  const float cfar = relb[15 * 6 + h] * LOG2E;
  const int qrow0 = b * 128 + rg * 32;
  bf16x8 qr[8];
  { const bf16* Qw = Q + (size_t)(qrow0 + r32) * 2048 + h * 256 + m * 128 + hi * 8;
#pragma unroll
    for (int d0 = 0; d0 < 8; ++d0) qr[d0] = *reinterpret_cast<const bf16x8*>(Qw + d0 * 16); }
  int ko[2], vo[2];
#pragma unroll
  for (int i = 0; i < 2; ++i) {
    const int p = wid * 64 + lane, row = p >> 4, cp = (p & 15) ^ (row & 7); ko[i] = row * 1536 + h * 256 + i * 128 + cp * 8; }
#pragma unroll
  for (int i = 0; i < 2; ++i) {
    const int p = (wid * 2 + i) * 64 + lane, sub = p >> 5, kg = sub >> 3, cblk = sub & 7, q = p & 31, kk = kg * 8 + (q >> 2), key = swap23(kk);
    vo[i] = key * 1536 + h * 256 + cblk * 32 + (q & 3) * 8; }
  const unsigned ldsb = (unsigned)(uintptr_t)lds;
#define A2_ISSUE(t, s) do { const size_t kb_ = (size_t)(t) * KT * 1536; LAS char* sb_ = lds + (s) * STAGE; \
    __builtin_amdgcn_global_load_lds((const unsigned*)(KD + kb_ + ko[0]), (LAS unsigned*)(sb_ + wid * 1024), 16, 0, 0); \
    __builtin_amdgcn_global_load_lds((const unsigned*)(KD + kb_ + ko[1]), (LAS unsigned*)(sb_ + ST_K + wid * 1024), 16, 0, 0); \
    __builtin_amdgcn_global_load_lds((const unsigned*)(VD + kb_ + vo[0]), (LAS unsigned*)(sb_ + 2 * ST_K + (wid * 2) * 1024), 16, 0, 0); \
    __builtin_amdgcn_global_load_lds((const unsigned*)(VD + kb_ + vo[1]), (LAS unsigned*)(sb_ + 2 * ST_K + (wid * 2 + 1) * 1024), 16, 0, 0); } while (0)
  const int vis = 2 * (2 * b + (rg >> 1) + 1);
  float m_reg = -1e30f, l_reg = 0.f; f32x16 o[8];
#pragma unroll
  for (int d = 0; d < 8; ++d) o[d] = f32x16{};
  asm volatile("s_waitcnt vmcnt(0)" ::: "memory");
  A2_ISSUE(t_lo, 0); if (t_lo + 1 < t_hi) A2_ISSUE(t_lo + 1, 1);
  int s = 0;
  for (int t = t_lo; t < t_hi; ++t) {
    if (t + 1 < t_hi) asm volatile("s_waitcnt vmcnt(4) lgkmcnt(0)" ::: "memory"); else asm volatile("s_waitcnt vmcnt(0) lgkmcnt(0)" ::: "memory");
    __builtin_amdgcn_s_barrier(); asm volatile("" ::: "memory");
    if (t + 2 < t_hi) { const int s2 = (s >= 1) ? s - 1 : s + 2; A2_ISSUE(t + 2, s2); }
    if (t < vis) {
      const LAS char* Ks = lds + s * STAGE + m * ST_K;
      f32x16 p = f32x16{};
#pragma unroll
      for (int d0 = 0; d0 < 8; ++d0) { const int cb = (d0 * 16 + hi * 8) * 2;
        const bf16x8 b0 = *(const LAS bf16x8*)(Ks + KSWZ(r32, cb));
        p = __builtin_amdgcn_mfma_f32_32x32x16_bf16(b0, qr[d0], p, 0, 0, 0); }
      if (qrow0 - (KT * t + KT - 1) >= 91) {
#pragma unroll
        for (int r = 0; r < 16; ++r) p[r] += cfar;
      } else { const int base = qrow0 + r32 - KT * t + 63;
#pragma unroll
        for (int r = 0; r < 16; ++r) { const int i0 = base - crow(r, hi); p[r] += tab[i0 < att::TAB_N - 1 ? i0 : att::TAB_N - 1]; } }
      float pmax = p[0];
#pragma unroll
      for (int r = 1; r < 16; ++r) pmax = fmaxf(pmax, p[r]);
      { auto rr = __builtin_amdgcn_permlane32_swap(__float_as_uint(pmax), __float_as_uint(pmax), false, false); pmax = fmaxf(__uint_as_float(rr[0]), __uint_as_float(rr[1])); }
      float mn, alpha;
      if (__builtin_expect(__all(pmax - m_reg <= THR2), 1)) { mn = m_reg; alpha = 1.f; }
      else { mn = fmaxf(m_reg, pmax); alpha = __builtin_amdgcn_exp2f(m_reg - mn); m_reg = mn; }
      float ps = 0.f;
#pragma unroll
      for (int r = 0; r < 16; ++r) { p[r] = __builtin_amdgcn_exp2f(p[r] - mn); ps += p[r]; }
      { auto rr = __builtin_amdgcn_permlane32_swap(__float_as_uint(ps), __float_as_uint(ps), false, false); ps = __uint_as_float(rr[0]) + __uint_as_float(rr[1]); }
      l_reg = l_reg * alpha + ps;
      bf16x8 pa0, pa1;
#define A2_PK4(P, BASE, OUT) do { unsigned a0 = cvtpk(P[BASE + 0], P[BASE + 1]), a1 = cvtpk(P[BASE + 2], P[BASE + 3]);   \
    unsigned b0_ = cvtpk(P[BASE + 4], P[BASE + 5]), b1_ = cvtpk(P[BASE + 6], P[BASE + 7]);                              \
    auto r0 = __builtin_amdgcn_permlane32_swap(a0, b0_, false, false); auto r1 = __builtin_amdgcn_permlane32_swap(a1, b1_, false, false); \
    u32x4 w = {r0[0], r1[0], r0[1], r1[1]}; OUT = *reinterpret_cast<bf16x8*>(&w); } while (0)
      A2_PK4(p, 0, pa0); A2_PK4(p, 8, pa1);
      if (__any(alpha < 1.f)) { if (hi == 0) al_l[r32] = alpha; asm volatile("s_waitcnt lgkmcnt(0)" ::: "memory");
#pragma unroll
        for (int d = 0; d < 8; ++d)
#pragma unroll
          for (int r = 0; r < 16; ++r) o[d][r] *= al_l[crow(r, hi)]; }
      const int vb = (int)(ldsb + s * STAGE + 2 * ST_K) + v_rd_base(lane);
      asm volatile("s_waitcnt lgkmcnt(0)" ::: "memory"); SBAR();
#define A2_PK(L, H) (bf16x8){L[0], L[1], L[2], L[3], H[0], H[1], H[2], H[3]}
#define A2_RD(D0, l0, h0, l1, h1) do { l0 = tr_read<v_off(D0, 0, 0)>(vb); h0 = tr_read<v_off(D0, 0, 1)>(vb); l1 = tr_read<v_off(D0, 1, 0)>(vb); h1 = tr_read<v_off(D0, 1, 1)>(vb); } while (0)
#define A2_MM(D0, l0, h0, l1, h1) do { o[D0] = __builtin_amdgcn_mfma_f32_32x32x16_bf16(pa0, A2_PK(l0, h0), o[D0], 0, 0, 0); o[D0] = __builtin_amdgcn_mfma_f32_32x32x16_bf16(pa1, A2_PK(l1, h1), o[D0], 0, 0, 0); } while (0)
      s16x4 xl0, xh0, xl1, xh1, yl0, yh0, yl1, yh1;
      A2_RD(0, xl0, xh0, xl1, xh1);
      A2_RD(1, yl0, yh0, yl1, yh1); asm volatile("s_waitcnt lgkmcnt(4)" ::: "memory"); SBAR(); A2_MM(0, xl0, xh0, xl1, xh1); SBAR();
      A2_RD(2, xl0, xh0, xl1, xh1); asm volatile("s_waitcnt lgkmcnt(4)" ::: "memory"); SBAR(); A2_MM(1, yl0, yh0, yl1, yh1); SBAR();
      A2_RD(3, yl0, yh0, yl1, yh1); asm volatile("s_waitcnt lgkmcnt(4)" ::: "memory"); SBAR(); A2_MM(2, xl0, xh0, xl1, xh1); SBAR();
      A2_RD(4, xl0, xh0, xl1, xh1); asm volatile("s_waitcnt lgkmcnt(4)" ::: "memory"); SBAR(); A2_MM(3, yl0, yh0, yl1, yh1); SBAR();
      A2_RD(5, yl0, yh0, yl1, yh1); asm volatile("s_waitcnt lgkmcnt(4)" ::: "memory"); SBAR(); A2_MM(4, xl0, xh0, xl1, xh1); SBAR();
      A2_RD(6, xl0, xh0, xl1, xh1); asm volatile("s_waitcnt lgkmcnt(4)" ::: "memory"); SBAR(); A2_MM(5, yl0, yh0, yl1, yh1); SBAR();
      A2_RD(7, yl0, yh0, yl1, yh1); asm volatile("s_waitcnt lgkmcnt(4)" ::: "memory"); SBAR(); A2_MM(6, xl0, xh0, xl1, xh1); SBAR();
      asm volatile("s_waitcnt lgkmcnt(0)" ::: "memory"); SBAR(); A2_MM(7, yl0, yh0, yl1, yh1); SBAR();
    }
    s = (s == 2) ? 0 : s + 1;
  }
  if (hi == 0) li_l[r32] = l_reg; asm volatile("s_waitcnt lgkmcnt(0)" ::: "memory");
  float rli[16];
#pragma unroll
  for (int r = 0; r < 16; ++r) rli[r] = __builtin_amdgcn_rcpf(li_l[crow(r, hi)]);
  float* Ow = Obuf + (size_t)(qrow0 - orow0) * 3072 + (h * 2 + m) * 256;
#pragma unroll
  for (int r = 0; r < 16; ++r) { const int orow = crow(r, hi);
#pragma unroll
    for (int d0 = 0; d0 < 8; ++d0) Ow[(size_t)orow * 3072 + d0 * 32 + r32] = o[d0][r] * rli[r]; }
  if (hi == 0) { float* mlp = ML + (((size_t)(qrow0 - orow0 + r32) * 6 + h) * 2 + m) * 2; mlp[0] = m_reg; mlp[1] = l_reg; }
  asm volatile("s_waitcnt vmcnt(0) lgkmcnt(0)" ::: "memory");
  __builtin_amdgcn_s_barrier(); asm volatile("" ::: "memory");
#undef A2_ISSUE
#undef A2_PK4
#undef A2_PK
#undef A2_RD
#undef A2_MM
}
}

__device__ __forceinline__ void diffattn2_unit(Frame& F, const Args& a, unsigned code) {
    const int h = code & 7, b = (code >> 3) & 63, pc = code >> 9, nt = 4 * b + 4;
    const int t_lo = (pc == 2) ? nt / 2 : 0, t_hi = (pc == 1) ? nt / 2 : nt;
    float* ob = (float*)(F.ws + (pc == 2 ? WS_OP2 : WS_OP)); float* ml = (float*)(F.ws + WS_ML) + (pc == 2 ? (size_t)T * 6 * 2 * 2 : 0);
    att2::diff_unit((const bf16*)(F.ws + WS_Z), (const bf16*)(F.ws + WS_KD), (const bf16*)(F.ws + WS_VD), ob, pc == 2 ? 4096 : 0, ml, a.in[I_RELB], h, b, t_lo, t_hi, (LAS char*)F.lds);
}
__device__ __forceinline__ void diffcombine_phase(Frame& F, const Args& a, int l) {
    const int i = l - 2; const float* lp = a.in[I_BLAM] + (size_t)i * 4 * 128;
    float s1 = lp[F.lane] * lp[128 + F.lane] + lp[64 + F.lane] * lp[128 + 64 + F.lane], s2 = lp[256 + F.lane] * lp[384 + F.lane] + lp[256 + 64 + F.lane] * lp[384 + 64 + F.lane];
    s1 = wave_sum(s1); s2 = wave_sum(s2);
    const float lam_init = 0.8f - 0.6f * expf(-0.3f * (float)l);
    const float lam = expf(s1) - expf(s2) + lam_init;
    const float* op0 = (const float*)(F.ws + WS_OP); const float* op1 = (const float*)(F.ws + WS_OP2); const float* ml0 = (const float*)(F.ws + WS_ML); const float* ml1 = ml0 + (size_t)T * 6 * 2 * 2;
    bf16* cat = (bf16*)(F.ws + WS_CAT);
    const f32x4 gsub = *(const GAS f32x4*)(a.in[I_BSUBG] + (size_t)i * 256 + 4 * F.lane);
    const int gw = F.c * NWAVES + F.wave, NGW = F.G * NWAVES;
    for (int it = gw; it < T * 6; it += NGW) { const int tk = it / 6, h = it - tk * 6; f32x4 os[2];
#pragma unroll
        for (int m = 0; m < 2; ++m) { const size_t r0 = ((size_t)tk * 6 + h) * 2 + m; f32x4 oa = *(const GAS f32x4*)(op0 + r0 * 256 + 4 * F.lane);
            if (tk >= 4096) { const size_t r1 = ((size_t)(tk - 4096) * 6 + h) * 2 + m; const f32x4 ob = *(const GAS f32x4*)(op1 + r1 * 256 + 4 * F.lane);
                const float ma = ml0[r0 * 2], la = ml0[r0 * 2 + 1], mb = ml1[r1 * 2], lb = ml1[r1 * 2 + 1], M = fmaxf(ma, mb);
                const float wa = la * exp2f(ma - M), wb = lb * exp2f(mb - M), inv = 1.f / (wa + wb); oa = oa * (wa * inv) + ob * (wb * inv); }
            os[m] = oa; }
        const f32x4 o = os[0] - os[1] * lam; const float ss = wave_sum((o.x * o.x + o.y * o.y) + (o.z * o.z + o.w * o.w));
        const float r = (1.f - lam_init) / sqrtf(ss * (1.f / 256.f) + LN_EPS);
        v2u w; w.x = pk2(o.x * r * gsub.x, o.y * r * gsub.y); w.y = pk2(o.z * r * gsub.z, o.w * r * gsub.w);
        *(GAS v2u*)(cat + (size_t)tk * D + h * 256 + 4 * F.lane) = w;
        { unsigned q8 = 0u; q8 = __builtin_amdgcn_cvt_pk_fp8_f32(o.x * r * gsub.x, o.y * r * gsub.y, q8, false); q8 = __builtin_amdgcn_cvt_pk_fp8_f32(o.z * r * gsub.z, o.w * r * gsub.w, q8, true);
          *(GAS unsigned*)(F.ws + WS_CATQ + (size_t)tk * D + h * 256 + 4 * F.lane) = q8; } }
    { const long nthr = (long)F.G * 512, gt = (long)F.c * 512 + F.tid;
      for (long i2 = gt; i2 < (long)T * 64; i2 += nthr) { const long tk = i2 >> 6; const int c8 = (int)(i2 & 63) * 8; const v4u w = *(const GAS v4u*)(cat + tk * D + MIXW + c8);
          unsigned lo = 0u, hi = 0u; lo = __builtin_amdgcn_cvt_pk_fp8_f32(bflo(w.x), bfhi(w.x), lo, false); lo = __builtin_amdgcn_cvt_pk_fp8_f32(bflo(w.y), bfhi(w.y), lo, true);
          hi = __builtin_amdgcn_cvt_pk_fp8_f32(bflo(w.z), bfhi(w.z), hi, false); hi = __builtin_amdgcn_cvt_pk_fp8_f32(bflo(w.w), bfhi(w.w), hi, true);
          v2u qq; qq.x = lo; qq.y = hi; *(GAS v2u*)(F.ws + WS_CATQ + tk * D + MIXW + c8) = qq; } }
}


__device__ __forceinline__ void ln1_router_phase(Frame& F, const Args& a, int l, int probe = 0) {
    const bf16* y = (const bf16*)(F.ws + WS_Y); bf16* x1b = (bf16*)(F.ws + WS_X1B);
    const float* lng = a.in[I_LNG] + ((size_t)l * 2 + 0) * D; const float* lnb = a.in[I_LNB] + ((size_t)l * 2 + 0) * D;
    const float* wr = (const float*)(F.ws + WS_WR) + (size_t)l * 3 * 512 * 16 * 4;
    int* tok_e = (int*)(F.ws + (probe ? WS_OP : WS_ROUTE)); int* tok_rank = tok_e + 2 * T; float* tok_gate = (float*)(tok_rank + 2 * T);
    gu32* cnt = F.ctl + (probe ? 65536 : CW_CNT) + 2048 * l;
    LAS float* P = (LAS float*)(F.lds);
    typedef float f32x4v __attribute__((ext_vector_type(4)));
    for (int tb = F.c; tb < T / 32; tb += F.G) {
#pragma unroll 2
        for (int i = 0; i < 4; ++i) { const int tk = tb * 32 + F.wave * 4 + i;
            const GAS v4u* yr = (const GAS v4u*)(y + (size_t)tk * D) + F.lane;
            float v[4][8]; float s = 0.f;
#pragma unroll
            for (int j = 0; j < 4; ++j) { const v4u w = yr[64 * j]; v[j][0] = bflo(w.x); v[j][1] = bfhi(w.x); v[j][2] = bflo(w.y); v[j][3] = bfhi(w.y); v[j][4] = bflo(w.z); v[j][5] = bfhi(w.z); v[j][6] = bflo(w.w); v[j][7] = bfhi(w.w);
#pragma unroll
                for (int e = 0; e < 8; ++e) s += v[j][e]; }
            const float mean = wave_sum(s) * (1.f / D); float s2 = 0.f;
#pragma unroll
            for (int j = 0; j < 4; ++j)
#pragma unroll
                for (int e = 0; e < 8; ++e) { v[j][e] -= mean; s2 += v[j][e] * v[j][e]; }
            const float rstd = 1.f / sqrtf(wave_sum(s2) * (1.f / D) + LN_EPS);
#pragma unroll
            for (int j = 0; j < 4; ++j) { const int d0 = 8 * F.lane + 512 * j; const f32x4 g0 = *(const GAS f32x4*)(lng + d0), g1 = *(const GAS f32x4*)(lng + d0 + 4), b0 = *(const GAS f32x4*)(lnb + d0), b1 = *(const GAS f32x4*)(lnb + d0 + 4);
                const float q0 = v[j][0] * rstd * g0.x + b0.x, q1 = v[j][1] * rstd * g0.y + b0.y, q2 = v[j][2] * rstd * g0.z + b0.z, q3 = v[j][3] * rstd * g0.w + b0.w;
                const float q4 = v[j][4] * rstd * g1.x + b1.x, q5 = v[j][5] * rstd * g1.y + b1.y, q6 = v[j][6] * rstd * g1.z + b1.z, q7 = v[j][7] * rstd * g1.w + b1.w;
                v4u w; w.x = pk2(q0, q1); w.y = pk2(q2, q3); w.z = pk2(q4, q5); w.w = pk2(q6, q7);
                *(GAS v4u*)(x1b + (size_t)tk * D + d0) = w;
                unsigned lo = 0u, hi = 0u; lo = __builtin_amdgcn_cvt_pk_fp8_f32(q0, q1, lo, false); lo = __builtin_amdgcn_cvt_pk_fp8_f32(q2, q3, lo, true);
                hi = __builtin_amdgcn_cvt_pk_fp8_f32(q4, q5, hi, false); hi = __builtin_amdgcn_cvt_pk_fp8_f32(q6, q7, hi, true);
                v2u qq; qq.x = lo; qq.y = hi; *(GAS v2u*)((unsigned char*)(F.ws + WS_X1F) + (size_t)tk * D + d0) = qq; } }
        VM_WAIT(); __syncthreads();
        { const int mt = F.wave >> 2, kq = F.wave & 3, c = F.lane & 15, q = F.lane >> 4;
          const bf16* ap = x1b + (size_t)(tb * 32 + mt * 16 + c) * D + kq * 512 + 4 * q;
          const float* bp = wr + ((size_t)(kq * 128 + q) * 16 + c) * 4;
          f32x4v acc[3] = {{0.f, 0.f, 0.f, 0.f}, {0.f, 0.f, 0.f, 0.f}, {0.f, 0.f, 0.f, 0.f}};
#pragma unroll 4
          for (int ks = 0; ks < 32; ++ks) { const v2u aw = *(const GAS v2u*)(ap + 16 * ks); const f32x4 a4 = (f32x4){bflo(aw.x), bfhi(aw.x), bflo(aw.y), bfhi(aw.y)}; f32x4 b4[3];
#pragma unroll
              for (int nb = 0; nb < 3; ++nb) b4[nb] = *(const GAS f32x4*)(bp + ((size_t)nb * 512 + 4 * ks) * 64);
#pragma unroll
              for (int j = 0; j < 4; ++j)
#pragma unroll
                  for (int nb = 0; nb < 3; ++nb) acc[nb] = __builtin_amdgcn_mfma_f32_16x16x4f32(a4[j], b4[nb][j], acc[nb], 0, 0, 0); }
#pragma unroll
          for (int nb = 0; nb < 3; ++nb)
#pragma unroll
              for (int r = 0; r < 4; ++r) P[((kq * 2 + mt) * 16 + 4 * q + r) * 48 + nb * 16 + c] = acc[nb][r]; }
        __syncthreads();
        if (F.tid < 32) { const int tk = tb * 32 + F.tid, mt = F.tid >> 4, ti = F.tid & 15;
            const LAS f32x4* P4 = (const LAS f32x4*)P;
            const int rb = (mt * 16 + ti) * 12;
            const float* bg1 = a.in[I_BG1] + l * 4; const float* bg2 = a.in[I_BG2] + l * 32;
            const f32x4 s1 = (P4[rb] + P4[rb + 384]) + (P4[rb + 768] + P4[rb + 1152]);
            const float l10 = s1.x + bg1[0], l11 = s1.y + bg1[1], l12 = s1.z + bg1[2], l13 = s1.w + bg1[3];
            int grp = 0; float mx = l10;
            if (l11 > mx) { mx = l11; grp = 1; } if (l12 > mx) { mx = l12; grp = 2; } if (l13 > mx) { mx = l13; grp = 3; }
            const float psel = 1.f / (expf(l10 - mx) + expf(l11 - mx) + expf(l12 - mx) + expf(l13 - mx));
            const int ob = rb + 1 + 2 * grp;
            const f32x4 sa = (P4[ob] + P4[ob + 384]) + (P4[ob + 768] + P4[ob + 1152]), sb = (P4[ob + 1] + P4[ob + 385]) + (P4[ob + 769] + P4[ob + 1153]);
            const f32x4 ba = *(const GAS f32x4*)(bg2 + grp * 8), bb = *(const GAS f32x4*)(bg2 + grp * 8 + 4);
            const float l2[8] = {sa.x + ba.x, sa.y + ba.y, sa.z + ba.z, sa.w + ba.w, sb.x + bb.x, sb.y + bb.y, sb.z + bb.z, sb.w + bb.w};
            int i0 = 0; float v0 = l2[0];
#pragma unroll
            for (int e = 1; e < 8; ++e) if (l2[e] > v0) { v0 = l2[e]; i0 = e; }
            int i1 = -1; float v1 = -INFINITY;
#pragma unroll
            for (int e = 0; e < 8; ++e) if (e != i0 && l2[e] > v1) { v1 = l2[e]; i1 = e; }
            const float e1 = expf(v1 - v0), g0 = psel / (1.f + e1), g1 = psel * e1 / (1.f + e1);
            const int ex0 = grp * 8 + i0, ex1 = grp * 8 + i1;
            const unsigned r0 = __hip_atomic_fetch_add(cnt + 64 * ex0, 1u, RLX_AGENT), r1 = __hip_atomic_fetch_add(cnt + 64 * ex1, 1u, RLX_AGENT);
            { int* list = (int*)(F.ws + (probe ? WS_OP + 2 * MiB : WS_LIST)); list[ex0 * 8192 + (int)r0] = tk; list[ex1 * 8192 + (int)r1] = tk; }
            tok_e[2 * tk] = ex0; tok_e[2 * tk + 1] = ex1; tok_rank[2 * tk] = (int)r0; tok_rank[2 * tk + 1] = (int)r1; tok_gate[2 * tk] = g0; tok_gate[2 * tk + 1] = g1; }
        __syncthreads();
    }
}
__device__ __forceinline__ void moe_table(Frame& F, int l) {
    LAS int* tstart = (LAS int*)(F.lds + TAB_OFF);
    if (F.tid == 0) { int acc = 0;
        for (int e = 0; e < 32; ++e) { tstart[e] = acc; const unsigned c = __hip_atomic_load(F.ctl + CW_CNT + 2048 * l + 64 * e, RLX_AGENT); tstart[36 + e] = (int)c; acc += (int)((c + 255u) >> 8); }
        tstart[32] = acc; }
    __syncthreads();
}
__device__ __forceinline__ void ln2_phase(Frame& F, const Args& a, int l) {
    const bf16* x1b = (const bf16*)(F.ws + WS_X1B); const bf16* yb = (const bf16*)(F.ws + WS_YB); bf16* xb = (bf16*)(F.ws + WS_XB);
    const float* lng = a.in[I_LNG] + ((size_t)l * 2 + 1) * D; const float* lnb = a.in[I_LNB] + ((size_t)l * 2 + 1) * D;
    moe_table(F, l); const LAS int* tstart = (const LAS int*)(F.lds + TAB_OFF);
    const int* tok_e = (const int*)(F.ws + WS_ROUTE); const int* tok_rank = tok_e + 2 * T; const float* tok_gate = (const float*)(F.ws + WS_ROUTE) + 4 * T;
    const int gw = F.c * NWAVES + F.wave, NGW = F.G * NWAVES;
    for (int t4 = gw; t4 < T / 4; t4 += NGW) { const int tk0 = t4 * 4;
        int ev = 0, rv = 0; float gv = 0.f;
        if (F.lane < 8) { ev = tok_e[2 * tk0 + F.lane]; rv = tok_rank[2 * tk0 + F.lane]; gv = tok_gate[2 * tk0 + F.lane]; }
        const int slotv = (F.lane < 8) ? tstart[ev] * 256 + rv : 0;
        v4u xr[2], ya[2], yc[2]; v4u xr2[2], ya2[2], yc2[2];
#define LN2_LOAD(i, XR, YA, YC, XR2, YA2, YC2) do { const int s0_ = __builtin_amdgcn_readlane(slotv, 2 * (i)), s1_ = __builtin_amdgcn_readlane(slotv, 2 * (i) + 1); \
        _Pragma("unroll") for (int j = 0; j < 2; ++j) { const int d0 = 8 * F.lane + 512 * j; XR[j] = *(const GAS v4u*)(x1b + (size_t)(tk0 + (i)) * D + d0); YA[j] = *(const GAS v4u*)(yb + (size_t)s0_ * D + d0); YC[j] = *(const GAS v4u*)(yb + (size_t)s1_ * D + d0); } \
        _Pragma("unroll") for (int j = 0; j < 2; ++j) { const int d0 = 8 * F.lane + 512 * (j + 2); XR2[j] = *(const GAS v4u*)(x1b + (size_t)(tk0 + (i)) * D + d0); YA2[j] = *(const GAS v4u*)(yb + (size_t)s0_ * D + d0); YC2[j] = *(const GAS v4u*)(yb + (size_t)s1_ * D + d0); } } while (0)
        LN2_LOAD(0, xr, ya, yc, xr2, ya2, yc2);
#pragma unroll
        for (int i = 0; i < 4; ++i) { const int tk = tk0 + i;
            const float g0 = __builtin_bit_cast(float, __builtin_amdgcn_readlane(__builtin_bit_cast(int, gv), 2 * i)), g1 = __builtin_bit_cast(float, __builtin_amdgcn_readlane(__builtin_bit_cast(int, gv), 2 * i + 1));
            float v[4][8]; float s = 0.f;
#pragma unroll
            for (int j = 0; j < 4; ++j) { const v4u X = j < 2 ? xr[j] : xr2[j - 2], A = j < 2 ? ya[j] : ya2[j - 2], C = j < 2 ? yc[j] : yc2[j - 2];
                v[j][0] = bflo(X.x) * DN_ALPHA + (g0 * bflo(A.x) + g1 * bflo(C.x)); v[j][1] = bfhi(X.x) * DN_ALPHA + (g0 * bfhi(A.x) + g1 * bfhi(C.x));
                v[j][2] = bflo(X.y) * DN_ALPHA + (g0 * bflo(A.y) + g1 * bflo(C.y)); v[j][3] = bfhi(X.y) * DN_ALPHA + (g0 * bfhi(A.y) + g1 * bfhi(C.y));
                v[j][4] = bflo(X.z) * DN_ALPHA + (g0 * bflo(A.z) + g1 * bflo(C.z)); v[j][5] = bfhi(X.z) * DN_ALPHA + (g0 * bfhi(A.z) + g1 * bfhi(C.z));
                v[j][6] = bflo(X.w) * DN_ALPHA + (g0 * bflo(A.w) + g1 * bflo(C.w)); v[j][7] = bfhi(X.w) * DN_ALPHA + (g0 * bfhi(A.w) + g1 * bfhi(C.w));
#pragma unroll
                for (int e = 0; e < 8; ++e) s += v[j][e]; }
            if (i + 1 < 4) LN2_LOAD(i + 1, xr, ya, yc, xr2, ya2, yc2);
            const float mean = wave_sum(s) * (1.f / D); float s2 = 0.f;
#pragma unroll
            for (int j = 0; j < 4; ++j)
#pragma unroll
                for (int e = 0; e < 8; ++e) { v[j][e] -= mean; s2 += v[j][e] * v[j][e]; }
            const float rstd = 1.f / sqrtf(wave_sum(s2) * (1.f / D) + LN_EPS);
#pragma unroll
            for (int j = 0; j < 4; ++j) { const int d0 = 8 * F.lane + 512 * j; const f32x4 g0v = *(const GAS f32x4*)(lng + d0), g1v = *(const GAS f32x4*)(lng + d0 + 4), b0 = *(const GAS f32x4*)(lnb + d0), b1 = *(const GAS f32x4*)(lnb + d0 + 4);
                const f32x4 oa = (f32x4){v[j][0] * rstd * g0v.x + b0.x, v[j][1] * rstd * g0v.y + b0.y, v[j][2] * rstd * g0v.z + b0.z, v[j][3] * rstd * g0v.w + b0.w};
                const f32x4 ob = (f32x4){v[j][4] * rstd * g1v.x + b1.x, v[j][5] * rstd * g1v.y + b1.y, v[j][6] * rstd * g1v.z + b1.z, v[j][7] * rstd * g1v.w + b1.w};
                if (l == DEPTH - 1) { *(GAS f32x4*)(a.out + (size_t)tk * D + d0) = oa; *(GAS f32x4*)(a.out + (size_t)tk * D + d0 + 4) = ob; }
                else { v4u w; w.x = pk2(oa.x, oa.y); w.y = pk2(oa.z, oa.w); w.z = pk2(ob.x, ob.y); w.w = pk2(ob.z, ob.w); *(GAS v4u*)(xb + (size_t)tk * D + d0) = w;
                    unsigned lo = 0u, hi = 0u; lo = __builtin_amdgcn_cvt_pk_fp8_f32(oa.x, oa.y, lo, false); lo = __builtin_amdgcn_cvt_pk_fp8_f32(oa.z, oa.w, lo, true); hi = __builtin_amdgcn_cvt_pk_fp8_f32(ob.x, ob.y, hi, false); hi = __builtin_amdgcn_cvt_pk_fp8_f32(ob.z, ob.w, hi, true);
                    v2u qq; qq.x = lo; qq.y = hi; *(GAS v2u*)(F.ws + WS_XQ + (size_t)tk * D + d0) = qq; } }
        }
#undef LN2_LOAD
    }
}

__global__ void __launch_bounds__(NWAVES * 64, 2) fwd_kernel(Args args) {
    extern __shared__ __attribute__((aligned(16))) unsigned char lds[];
    Frame F;
    F.lds = (LAS unsigned char*)lds; F.ldsg = (char*)lds;
    F.tid = threadIdx.x; F.lane = F.tid & 63; F.wave = __builtin_amdgcn_readfirstlane(F.tid >> 6);
    F.G = gridDim.x; F.c = blockIdx.x; F.ws = args.ws; F.ctl = (gu32*)(args.ws + WS_CTL);
    volatile LAS unsigned* MISC = (volatile LAS unsigned*)(F.lds + MISC_OFF);
    for (int u = F.tid; u < (LDS_BYTES - LDSCTL_OFF) / 4; u += NWAVES * 64) ((LAS unsigned*)(F.lds + LDSCTL_OFF))[u] = 0u;
    __syncthreads();
    const int lo = args.ph_lo, hi = args.ph_hi; int lastp = -1;
    const bool multi = (hi - lo) > 1;
    XcdBarrier bar; bar.bar = (unsigned*)(F.ctl + CW_BAR); bar.x = 0; bar.st = nullptr;
    if (multi) bar = xcd_barrier_post((unsigned*)(F.ctl + CW_BAR), MISC + 8);
#ifndef REP_MASK
#define REP_MASK 0
#endif
#define REP(k) for (int rep_ = 0; rep_ <= ((REP_MASK >> (k)) & 1); ++rep_)
#define IN(p) (lo <= (p) && (p) < hi)
#ifdef PROBE_A
#define STAMP(i) do { if (blockIdx.x == 0 && threadIdx.x == 0) ((unsigned long long*)(args.ws + WS_TS))[(i)] = __builtin_amdgcn_s_memrealtime(); } while (0)
#else
#define STAMP(i) do { } while (0)
#endif
#define SEAM(p) do { conv_note_fin(F, (p)); lastp = (p); if ((p) + 1 < hi) xcd_barrier(bar); STAMP((p) + 1); } while (0)
#define CONVFIN() ((lastp >= 0) ? (int)__hip_atomic_load(F.ctl + CW_FIN + 64 * lastp, RLX_AGENT) : 0)
#define FRESH() do { int t_ = threadIdx.x; asm volatile("" : "+v"(t_)); F.tid = t_; F.lane = t_ & 63; F.wave = __builtin_amdgcn_readfirstlane(t_ >> 6); \
    GAS unsigned char* w_ = (GAS unsigned char*)args.ws; asm volatile("" : "+s"(w_)); F.ws = (unsigned char*)w_; F.ctl = (gu32*)(w_ + WS_CTL); } while (0)

    STAMP(0);
    if (IN(0)) { FRESH(); REP(9) prologue_phase(F, args); SEAM(0); }
#ifdef XBAR
    for (int xb_ = 0; xb_ < XBAR; ++xb_) xcd_barrier(bar);
#endif

    for (int l = 0; l < DEPTH; ++l) {
        const int pb = 1 + NPH_LAYER * l;
        if (IN(pb + 0)) { FRESH();
            const int N = (l < 2) ? NINA : (l == 2 ? 5120 : 2048);
            const unsigned char* Bt = F.ws + ((l < 2) ? WS_WAIN + (size_t)l * NINA * D * 2 : (l == 2 ? WS_WBIN0 : WS_WBIN1));
            const int nu = (T / 256) * (N / 256) + (l == 0 ? 16 : 0), ncv = conv_servers(nu, F.G, CONVFIN()), Gc = F.G - ncv; const bool f8 = F8L(l);
            if (F.c < Gc) {
                pg8::EpiBf16X E{l < 2 ? 0 : 1, (bf16*)(F.ws + WS_Z), (bf16*)(F.ws + WS_KD), (bf16*)(F.ws + WS_VD), (bf16*)(F.ws + WS_MEMKV), nullptr, nullptr};
                if (f8) { pg8::Gemm g{nullptr, nullptr, T, N, D / 2}; pg8::DualOrder8 S; S.init(F.ws + WS_XQ, Bt, T, N, D / 2, Gc, F.c, F.ws + WS_MEMQ, F.ws + WS_WMKV, l == 0 ? 16 : 0);
                    REP(0) pg8::gemm_phase<pg8::EpiBf16X, pg8::DualOrder8, true, true>(F.lds + RING_OFF, g, S, E); }
                else { pg8::Gemm g{nullptr, nullptr, T, N, D}; pg8::DualOrder S; S.init(F.ws + WS_XB, Bt, T, N, D, Gc, F.c, F.ws + WS_MEMB, F.ws + WS_WMKV, l == 0 ? 16 : 0);
                    REP(0) pg8::gemm_phase<pg8::EpiBf16X, pg8::DualOrder, true, true>(F.lds + RING_OFF, g, S, E); }
                if (ncv) conv_done(F, pb + 0);
                { const int mine = (nu - 1 - F.c) / Gc + 1, rounds = (nu + Gc - 1) / Gc; conv_filler(F, args, 2 * l, (rounds - mine) * (f8 ? (QA + 1) / 2 : QA)); }
            } else conv_server(F, args, pb + 0, 2 * l, Gc);
            SEAM(pb + 0);
        }
        if (IN(pb + 1)) { FRESH();
            if (l < 2) {
                REP(1) for (int u = F.c; u < 256 + 128; u += F.G) {
                    if (u < 256) sgu_unit(F, args, l, u >> 2, u & 3);
                    else { const int r = u - 256; memattn_unit(F, l, r & 3, r >> 2, NINA, 2 * MIXW); }
                }
                if (F.c >= 128) conv_filler(F, args, 2 * l, QX);
            } else {
                const int ncv = CONVFIN() ? 0 : NCVATT;
                if (F.c >= F.G - ncv) { conv_server_q(F, args, F.ctl + CW_Q + 64 * l, (unsigned)(att2::NUNITS + 128 - STOPU), 2 * l); __syncthreads(); }
                REP(2) { gu32* qh = F.ctl + CW_Q + 64 * l + 16 * rep_; LAS unsigned* uw = (LAS unsigned*)(F.lds + att2::LDS_UNIT);
                for (;;) {
                    if (F.tid == 0) *uw = __hip_atomic_fetch_add(qh, 1u, RLX_AGENT);
                    __syncthreads();
                    const unsigned idx = *uw;
                    __syncthreads();
                    if (idx >= (unsigned)(att2::NUNITS + 128)) break;
                    if (idx < (unsigned)att2::NUNITS) diffattn2_unit(F, args, att2::g_units.u[idx]);
                    else { const int r = (int)idx - att2::NUNITS; memattn_unit(F, l, r & 3, r >> 2, 2048, MIXW); }
                } }
            }
            SEAM(pb + 1);
        }
        if (IN(pb + 2) && l >= 2) { FRESH(); REP(3) diffcombine_phase(F, args, l); SEAM(pb + 2); }
        if (IN(pb + 3)) { FRESH();
            pg8::EpiResBf16 E{(const bf16*)(F.ws + WS_XB), (bf16*)(F.ws + WS_Y), DN_ALPHA};
            const unsigned char* Wo = F.ws + (l < 2 ? WS_WAOUT + (size_t)l * D * D * 2 : WS_WBOUT + (size_t)(l - 2) * D * D * 2);
            if (F8OL(l)) { pg8::Gemm g{nullptr, nullptr, T, D, D / 2}; pg8::DenseOrder8 S; S.init(F.ws + WS_CATQ, Wo, T, D, D / 2, F.G, F.c);
                REP(4) pg8::gemm_phase<pg8::EpiResBf16, pg8::DenseOrder8, true, true>(F.lds + RING_OFF, g, S, E); }
            else { pg8::Gemm g{nullptr, nullptr, T, D, D}; pg8::DenseOrder S; S.init(F.ws + WS_CAT, Wo, T, D, D, F.G, F.c);
                REP(4) pg8::gemm_phase<pg8::EpiResBf16, pg8::DenseOrder, true, true>(F.lds + RING_OFF, g, S, E); }
            SEAM(pb + 3);
        }
        if (IN(pb + 4)) { FRESH(); ln1_router_phase(F, args, l);
#ifdef REP_LN1
            ln1_router_phase(F, args, l, 1);
#endif
            conv_filler(F, args, 2 * l, -1); SEAM(pb + 4); }
        if (IN(pb + 6)) { FRESH();
            moe_table(F, l);
            const LAS int* tb = (const LAS int*)(F.lds + TAB_OFF);
            const int nu = tb[32] * 4, ncv = conv_servers(nu, F.G, CONVFIN()), Gc = F.G - ncv;
            if (F.c < Gc) {
                pg8::Gemm g{nullptr, nullptr, SLOTS, 1024, D / 2};
                pg8::MoeGatherOrder S{tb, tb + 36, (const int*)(F.ws + WS_LIST), 4, Gc, F.c, (const char*)(F.ws + WS_X1F), (const char*)(F.ws + WS_W13) + (size_t)l * NE * 1024 * 2048, (size_t)1024 * 2048, (size_t)256 * 2048, (unsigned)D};
                pg8::EpiMoe1 E{(bf16*)(F.ws + WS_H), tb, tb + 36};
                REP(6) pg8::gemm_phase<pg8::EpiMoe1, pg8::MoeGatherOrder, true, true>(F.lds + RING_OFF, g, S, E);
                if (ncv) conv_done(F, pb + 6);
                { const int mine = (F.c < nu) ? (nu - 1 - F.c) / Gc + 1 : 0, rounds = (nu + Gc - 1) / Gc; conv_filler(F, args, 2 * l + 1, (rounds - mine) * QM); }
            } else conv_server(F, args, pb + 6, 2 * l + 1, Gc);
            SEAM(pb + 6);
        }
        if (IN(pb + 7)) { FRESH();
            moe_table(F, l);
            const int nu = ((const LAS int*)(F.lds + TAB_OFF))[32] * 8, ncv = conv_servers(nu, F.G, CONVFIN()), Gc = F.G - ncv;
            if (F.c < Gc) {
                pg8::Gemm g{nullptr, nullptr, SLOTS, D, FF / 2};
                pg8::MoeOrder8 S{(const PG8_LAS int*)(F.lds + TAB_OFF), 8, Gc, F.c, (const char*)(F.ws + WS_H), (const char*)(F.ws + WS_W2) + (size_t)l * NE * 2048 * 512, (size_t)256 * FF, (size_t)2048 * 512, (size_t)256 * 512};
                pg8::EpiBf16X E{3, (bf16*)(F.ws + WS_YB), nullptr, nullptr, nullptr, (const PG8_LAS int*)(F.lds + TAB_OFF), (const PG8_LAS int*)(F.lds + TAB_OFF) + 36};
                REP(7) pg8::gemm_phase<pg8::EpiBf16X, pg8::MoeOrder8, true, true>(F.lds + RING_OFF, g, S, E);
                if (ncv) conv_done(F, pb + 7);
                { const int mine = (F.c < nu) ? (nu - 1 - F.c) / Gc + 1 : 0, rounds = (nu + Gc - 1) / Gc; conv_filler(F, args, 2 * l + 1, (rounds - mine) * QB); }
            } else conv_server(F, args, pb + 7, 2 * l + 1, Gc);
            SEAM(pb + 7);
        }
        if (IN(pb + 8)) { FRESH(); REP(8) ln2_phase(F, args, l); conv_filler(F, args, 2 * l + 1, -1); SEAM(pb + 8); }
    }
#ifdef PROBE_A
    {
        VM_WAIT(); xcd_barrier(bar);
        const unsigned long long* ts = (const unsigned long long*)(args.ws + WS_TS);
        float da = 0.f, db = 0.f;
        for (int p = 0; p < NPHASES; ++p) { const int k = (p == 0) ? 9 : (p - 1) % NPH_LAYER; const float d = (float)(ts[p + 1] - ts[p]);
            if (k == PROBE_A || PROBE_A == 10) da += d; if (k == PROBE_B || PROBE_B == 10) db += d; }
        const float kk = sqrtf(da), vv = db;
        float* o = args.out; const long n = (long)T * D;
        for (long i = (long)blockIdx.x * 512 + threadIdx.x; i < n; i += (long)gridDim.x * 512) o[i] = (i == 0) ? vv : kk;
    }
#endif
#undef IN
#undef SEAM
}

#ifndef MK_ONE_LAUNCH
#define MK_ONE_LAUNCH 1
#endif
extern "C" void kernel_launch(void* const* d_in, const int* in_sizes, int n_in, void* d_out, int out_size, void* d_ws, size_t ws_size, hipStream_t stream) {
    static int grid = 0;
    if (grid == 0) {
        if (n_in != 24 || in_sizes[0] != T * D || out_size != T * D || ws_size < WS_END) { fprintf(stderr, "kernel_launch: unexpected shapes (n_in %d, in0 %d, out %d, ws %zu < %zu)\n", n_in, n_in > 0 ? in_sizes[0] : -1, out_size, ws_size, (size_t)WS_END); grid = -1; return; }
        int dev = 0, cus = 0, per_cu = 0;
        if (hipGetDevice(&dev) != hipSuccess || hipDeviceGetAttribute(&cus, hipDeviceAttributeMultiprocessorCount, dev) != hipSuccess) { grid = -1; return; }
        if (hipFuncSetAttribute((const void*)fwd_kernel, hipFuncAttributeMaxDynamicSharedMemorySize, LDS_BYTES) != hipSuccess) { fprintf(stderr, "kernel_launch: hipFuncSetAttribute failed\n"); grid = -1; return; }
        if (hipOccupancyMaxActiveBlocksPerMultiprocessor(&per_cu, (const void*)fwd_kernel, NWAVES * 64, LDS_BYTES) != hipSuccess || per_cu < 1) fprintf(stderr, "kernel_launch: occupancy query reports %d\n", per_cu);
        (void)hipGetLastError();
        grid = cus;
    }
    if (grid < 0) return;
    if (hipMemsetAsync((char*)d_ws + WS_CTL, 0, CTL_ZERO_BYTES, stream) != hipSuccess) return;
    Args a{};
    for (int i = 0; i < 24; ++i) a.in[i] = (const float*)d_in[i];
    a.out = (float*)d_out; a.ws = (unsigned char*)d_ws;
#if MK_ONE_LAUNCH
    a.ph_lo = 0; a.ph_hi = NPHASES;
    hipLaunchKernelGGL(fwd_kernel, dim3(grid), dim3(NWAVES * 64), LDS_BYTES, stream, a);
#else
    for (int p = 0; p < NPHASES; ++p) {
        const int k = (p - 1) % NPH_LAYER, l = (p - 1) / NPH_LAYER;
        if (p > 0 && k == 2 && l < 2) continue;
        a.ph_lo = p; a.ph_hi = p + 1;
        hipLaunchKernelGGL(fwd_kernel, dim3(grid), dim3(NWAVES * 64), LDS_BYTES, stream, a);
    }
#endif
    const hipError_t le = hipPeekAtLastError();
    if (le != hipSuccess) fprintf(stderr, "kernel_launch: launch failed: %s\n", hipGetErrorName(le));
}
```

```cpp
#define F8MASK 12
#define F8OMASK 12
#include <hip/hip_runtime.h>
#include <cstdio>
#include <cstdint>
namespace pg8 {
#define PG8_LAS __attribute__((address_space(3)))
typedef unsigned short bf16_t;
typedef short bf16x8 __attribute__((ext_vector_type(8)));
typedef float f32x4 __attribute__((ext_vector_type(4)));
typedef unsigned u32x4 __attribute__((ext_vector_type(4)));
constexpr int BM = 256, BK = 64, HALF = 128, HTB = HALF * BK * 2  , STAGE_BYTES = 8 * HTB, NXCD = 8, WGM = 8;

__host__ __device__ __forceinline__ int lds_byte(int r, int c) { const int st = (r >> 4) * 2 + (c >> 5), rr = r & 15, cc = c & 31, ob = rr * 64 + cc * 2; return st * 1024 + (ob ^ (((ob >> 9) & 1) << 5)); }
__host__ __device__ __forceinline__ void stage_rc(int b, int& R, int& C) { const int st = b / 1024, sb = b % 1024, swz = sb ^ (((sb >> 9) & 1) << 5); R = (st >> 1) * 16 + swz / 64; C = (st & 1) * 32 + (swz % 64) / 2; }
__host__ __device__ __forceinline__ int perm32(int rho) { const int n = rho >> 4, i = rho & 15; return 8 * (i >> 2) + 4 * n + (i & 3); }

typedef int pg8_v4i __attribute__((ext_vector_type(4))); typedef int pg8_v8i __attribute__((ext_vector_type(8)));
__device__ __forceinline__ pg8_v8i pg8_cat8(bf16x8 a, bf16x8 b) { return __builtin_shufflevector(__builtin_bit_cast(pg8_v4i, a), __builtin_bit_cast(pg8_v4i, b), 0, 1, 2, 3, 4, 5, 6, 7); }
struct Unit { int pm, pn, e; };
struct Gemm { const bf16_t* A; const bf16_t* Bt; int M, N, K; };

struct StaticOrder {
    static constexpr bool GATHER = false, F8 = false; static constexpr int SCALE_B = 127;
    int nM, nN, nwg, G, c;
    __host__ __device__ void init(int M, int N, int G_, int c_) { nM = M / BM; nN = N / BM; nwg = nM * nN; G = G_; c = c_; }
    __host__ __device__ bool next(int i, Unit& u) const {
        const long L = (long)i * G + c; if (L >= nwg) return false;
        int wgid = (int)L; { const int q = nwg / NXCD, r = nwg % NXCD, xcd = wgid % NXCD, off = wgid / NXCD; wgid = (xcd < r ? xcd * (q + 1) : r * (q + 1) + (xcd - r) * q) + off; }
        const int nig = WGM * nN, gid = wgid / nig, fm = gid * WGM, gsz = (nM - fm) < WGM ? (nM - fm) : WGM;
        u.pm = fm + ((wgid % nig) % gsz); u.pn = (wgid % nig) / gsz; return true;
    }
    __device__ __forceinline__ void a_ready(const Unit&) const {}
    __device__ __forceinline__ void done(const Unit&) const {}
};

__device__ __forceinline__ unsigned cvt_pk_bf16(float lo, float hi) { unsigned r; asm volatile("v_cvt_pk_bf16_f32 %0, %1, %2" : "=v"(r) : "v"(lo), "v"(hi)); return r; }
typedef float f32x2 __attribute__((ext_vector_type(2)));
__device__ __forceinline__ f32x2 gelu_pk(f32x2 v) {
    const f32x2 av = __builtin_elementwise_abs(v), d = av * 0.2316418882f + 1.0f;
    f32x2 t; t.x = __builtin_amdgcn_rcpf(d.x); t.y = __builtin_amdgcn_rcpf(d.y);
    f32x2 q = t * 0.5307027145f + (-0.7265760135f); q = q * t + 0.7107068705f; q = q * t + (-0.142248368f); q = q * t + 0.127414796f; q = q * t;
    const f32x2 s = (v * v) * (-0.72134752044f);
    f32x2 e; e.x = __builtin_amdgcn_exp2f(s.x); e.y = __builtin_amdgcn_exp2f(s.y);
    const f32x2 m = v * (q * e), r = v - m;
    f32x2 o; o.x = v.x < 0.f ? m.x : r.x; o.y = v.y < 0.f ? m.y : r.y; return o;
}

template <class Epi, class Sched, bool ALIGN_EPI = false, bool SP2 = false>
__device__ __forceinline__ void gemm_phase(PG8_LAS unsigned char* lds, const Gemm g, const Sched& S, const Epi& E) {
    int tid_ = threadIdx.x; asm volatile("" : "+v"(tid_));
    const int tid = tid_, wid = __builtin_amdgcn_readfirstlane(tid >> 6), lane = tid & 63, wr = wid >> 2, wc = wid & 3, fr = lane & 15, fq = lane >> 4;
    const int K = g.K, nt = K / BK;
    unsigned voffA[2], voffB[2];
#pragma unroll
    for (int i = 0; i < 2; ++i) { int R, C; stage_rc(tid * 16 + i * 8192, R, C); const int Rb = Epi::PERM ? ((R & ~31) + perm32(R & 31)) : R;
        voffA[i] = (unsigned)(R * K + C) * 2u; voffB[i] = (unsigned)(Rb * K + C) * 2u; }
    unsigned vAc[2][2], vAn[2][2];
    int gR[2], gC[2];
#pragma unroll
    for (int i = 0; i < 2; ++i) { stage_rc(tid * 16 + i * 8192, gR[i], gC[i]); }
    const size_t kstep = (size_t)(BK * 2);
    const size_t hstep = (size_t)HALF * K * 2;
        const unsigned ldsw = (unsigned)wid * 1024u;
    const int aoff = lds_byte(wr * 64 + fr, fq * 8), boff = lds_byte(wc * 32 + fr, fq * 8);
#define PG8_SA(b, h) (((b) * 2 + (h)) * HTB)
#define PG8_SB(b, h) ((4 + (b) * 2 + (h)) * HTB)
#define PG8_STAGE(bufoff, gbase, voff) do { _Pragma("unroll") for (int _i = 0; _i < 2; ++_i) \
        __builtin_amdgcn_global_load_lds((const unsigned*)((const char*)(gbase) + (voff)[_i]), (PG8_LAS unsigned*)(lds + (bufoff) + ldsw + _i * 8192), 16, 0, 0); } while (0)
#define PG8_STAGE_A(b, h, base, VS) do { if constexpr (Sched::GATHER) { PG8_STAGE(PG8_SA(b, h), base, VS[h]); } else { PG8_STAGE(PG8_SA(b, h), (base) + (h) * hstep, voffA); } } while (0)
#define PG8_STAGE_AN(b, h, base) do { if constexpr (Sched::GATHER) { unsigned vs_[2] = {last ? vAn[h][0] : vAc[h][0], last ? vAn[h][1] : vAc[h][1]}; PG8_STAGE(PG8_SA(b, h), base, vs_); } else { PG8_STAGE(PG8_SA(b, h), (base) + (h) * hstep, voffA); } } while (0)
#define PG8_LDA(dst, b, h) do { if constexpr (Sched::F8) { _Pragma("unroll") for (int m = 0; m < 4; ++m) { dst##8[m].lo = *(const PG8_LAS pg8_v4i*)(lds + PG8_SA(b, h) + aoff + m * 2048); dst##8[m].hi = *(const PG8_LAS pg8_v4i*)(lds + PG8_SA(b, h) + aoff + m * 2048 + 1024); } } \
        else { _Pragma("unroll") for (int m = 0; m < 4; ++m) _Pragma("unroll") for (int k = 0; k < 2; ++k) dst[m][k] = *(const PG8_LAS bf16x8*)(lds + PG8_SA(b, h) + aoff + m * 2048 + k * 1024); } } while (0)
#define PG8_LDB(dst, b, h) do { if constexpr (Sched::F8) { _Pragma("unroll") for (int n = 0; n < 2; ++n) { dst##8[n].lo = *(const PG8_LAS pg8_v4i*)(lds + PG8_SB(b, h) + boff + n * 2048); dst##8[n].hi = *(const PG8_LAS pg8_v4i*)(lds + PG8_SB(b, h) + boff + n * 2048 + 1024); } } \
        else { _Pragma("unroll") for (int n = 0; n < 2; ++n) _Pragma("unroll") for (int k = 0; k < 2; ++k) dst[n][k] = *(const PG8_LAS bf16x8*)(lds + PG8_SB(b, h) + boff + n * 2048 + k * 1024); } } while (0)
#define PG8_MMA(ai, bj, At, Bt) do { __builtin_amdgcn_s_setprio(1); if constexpr (Sched::F8) { \
        _Pragma("unroll") for (int m = 0; m < 4; ++m) _Pragma("unroll") for (int n = 0; n < 2; ++n) \
            asm volatile("v_mfma_scale_f32_16x16x128_f8f6f4 %0, %1, %2, %0, %3, %4 op_sel_hi:[0,0,0]" : "+v"(acc[ai][bj][m][n]) : "v"(Bt##8[n]), "v"(At##8[m]), "v"(sclB_), "v"(sclA_));     \
        } else { _Pragma("unroll") for (int m = 0; m < 4; ++m) _Pragma("unroll") for (int n = 0; n < 2; ++n) _Pragma("unroll") for (int k = 0; k < 2; ++k) \
        acc[ai][bj][m][n] = __builtin_amdgcn_mfma_f32_16x16x32_bf16(Bt[n][k], At[m][k], acc[ai][bj][m][n], 0, 0, 0); } __builtin_amdgcn_s_setprio(0); } while (0)
#define PG8_WAIT_V(n) asm volatile("s_waitcnt vmcnt(" #n ")" ::: "memory")
#define PG8_WAIT_L(n) asm volatile("s_waitcnt lgkmcnt(" #n ")" ::: "memory")
#define PG8_BAR __builtin_amdgcn_s_barrier()
#define PG8_SCHED __builtin_amdgcn_sched_barrier(0)
    Unit cur, nxt; int ui = 0;
    if (!S.next(0, cur)) return;
    f32x4 acc[2][2][4][2];
#pragma unroll
    for (int a = 0; a < 2; ++a)
#pragma unroll
        for (int b = 0; b < 2; ++b)
#pragma unroll
            for (int m = 0; m < 4; ++m)
#pragma unroll
                for (int n = 0; n < 2; ++n) acc[a][b][m][n] = (f32x4){0.f, 0.f, 0.f, 0.f};
    const int sclB_ = Sched::SCALE_B, sclA_ = 127;
    bf16x8 At[4][2], B0[2][2], B1[2][2]; pg8_v8i At8[4], B08[2], B18[2];
    const char* cA = S.aptr(cur); const char* cB = S.bptr(cur);
    S.a_ready(cur);
    if constexpr (Sched::GATHER) {
#pragma unroll
        for (int h = 0; h < 2; ++h)
#pragma unroll
            for (int i = 0; i < 2; ++i) { vAc[h][i] = S.rowoff(cur, h * HALF + gR[i]) + (unsigned)gC[i] * 2u; vAn[h][i] = vAc[h][i]; }
        asm volatile("s_waitcnt vmcnt(0)" ::: "memory");
    }
    if constexpr (SP2) {
        PG8_STAGE(PG8_SB(0, 0), cB, voffB); PG8_STAGE(PG8_SB(0, 1), cB + hstep, voffB); PG8_STAGE_A(0, 0, cA, vAc); PG8_STAGE_A(0, 1, cA, vAc);
        if (wr == 1) PG8_BAR;
        PG8_WAIT_V(2); PG8_BAR;
        PG8_STAGE(PG8_SB(1, 0), cB + kstep, voffB); PG8_STAGE_A(1, 0, cA + kstep, vAc); PG8_STAGE(PG8_SB(1, 1), cB + hstep + kstep, voffB);
        PG8_WAIT_V(6); PG8_BAR;
    } else {
        PG8_STAGE(PG8_SB(0, 0), cB, voffB); PG8_STAGE_A(0, 0, cA, vAc); PG8_STAGE(PG8_SB(0, 1), cB + hstep, voffB); PG8_STAGE_A(0, 1, cA, vAc);
        if (wr == 1) PG8_BAR;
        PG8_WAIT_V(4); PG8_BAR;
        PG8_STAGE(PG8_SB(1, 0), cB + kstep, voffB); PG8_STAGE_A(1, 0, cA + kstep, vAc); PG8_STAGE(PG8_SB(1, 1), cB + hstep + kstep, voffB);
        PG8_WAIT_V(6); PG8_BAR;
    }
    for (;;) {
        const bool has_next = S.next(ui + 1, nxt);
        const char* nA = has_next ? S.aptr(nxt) : cA; const char* nB = has_next ? S.bptr(nxt) : cB;
        if constexpr (Sched::GATHER) { if (has_next) {
#pragma unroll
            for (int h = 0; h < 2; ++h)
#pragma unroll
                for (int i = 0; i < 2; ++i) vAn[h][i] = S.rowoff(nxt, h * HALF + gR[i]) + (unsigned)gC[i] * 2u; } }
        for (int t = 0; t < nt; t += 2) {
            const bool last = (t == nt - 2);
            const char* a1 = cA + (size_t)(t + 1) * kstep;
            const char* a2 = last ? nA : cA + (size_t)(t + 2) * kstep; const char* b2 = last ? nB : cB + (size_t)(t + 2) * kstep;
            const char* a3 = a2 + kstep; const char* b3 = b2 + kstep;
            if (last && has_next) S.a_ready(nxt);
            if constexpr (SP2) {
            PG8_LDB(B0, 0, 0); PG8_LDB(B1, 0, 1); PG8_SCHED; PG8_LDA(At, 0, 0); PG8_STAGE_A(1, 1, a1, vAc);
            PG8_WAIT_V(8); PG8_WAIT_L(0); PG8_BAR; PG8_MMA(0, 0, At, B0); PG8_MMA(0, 1, At, B1); PG8_BAR; PG8_SCHED;
            PG8_LDA(At, 0, 1); PG8_STAGE(PG8_SB(0, 0), b2, voffB); PG8_STAGE(PG8_SB(0, 1), b2 + hstep, voffB); PG8_STAGE_AN(0, 0, a2);
            PG8_WAIT_V(8); PG8_WAIT_L(0); PG8_BAR; PG8_MMA(1, 0, At, B0); PG8_MMA(1, 1, At, B1); PG8_BAR; PG8_SCHED;
            PG8_LDB(B0, 1, 0); PG8_LDB(B1, 1, 1); PG8_SCHED; PG8_LDA(At, 1, 0); PG8_STAGE_AN(0, 1, a2);
            PG8_WAIT_V(8); PG8_WAIT_L(0); PG8_BAR; PG8_MMA(0, 0, At, B0); PG8_MMA(0, 1, At, B1); PG8_BAR; PG8_SCHED;
            PG8_LDA(At, 1, 1); PG8_STAGE(PG8_SB(1, 0), b3, voffB); PG8_STAGE(PG8_SB(1, 1), b3 + hstep, voffB); PG8_STAGE_AN(1, 0, a3);
            PG8_WAIT_V(8); PG8_WAIT_L(0); PG8_BAR; PG8_MMA(1, 0, At, B0); PG8_MMA(1, 1, At, B1); PG8_BAR; PG8_SCHED;
            } else {
            PG8_LDB(B0, 0, 0); PG8_SCHED; PG8_LDA(At, 0, 0); PG8_STAGE_A(1, 1, a1, vAc);
            PG8_WAIT_L(8); PG8_BAR; PG8_WAIT_L(0); PG8_MMA(0, 0, At, B0); PG8_BAR; PG8_SCHED;
            PG8_LDB(B1, 0, 1); PG8_STAGE(PG8_SB(0, 0), b2, voffB);
            PG8_BAR; PG8_WAIT_L(0); PG8_MMA(0, 1, At, B1); PG8_BAR;
            PG8_LDA(At, 0, 1); PG8_STAGE_AN(0, 0, a2);
            PG8_BAR; PG8_WAIT_L(0); PG8_MMA(1, 0, At, B0); PG8_BAR; PG8_SCHED;
            PG8_STAGE(PG8_SB(0, 1), b2 + hstep, voffB);
            PG8_WAIT_V(6); PG8_BAR; PG8_MMA(1, 1, At, B1); PG8_BAR;
            PG8_LDB(B0, 1, 0); PG8_SCHED; PG8_LDA(At, 1, 0); PG8_STAGE_AN(0, 1, a2);
            PG8_WAIT_L(8); PG8_BAR; PG8_WAIT_L(0); PG8_MMA(0, 0, At, B0); PG8_BAR; PG8_SCHED;
            PG8_LDB(B1, 1, 1); PG8_STAGE(PG8_SB(1, 0), b3, voffB);
            PG8_BAR; PG8_WAIT_L(0); PG8_MMA(0, 1, At, B1); PG8_BAR;
            PG8_LDA(At, 1, 1); PG8_STAGE_AN(1, 0, a3);
            PG8_BAR; PG8_WAIT_L(0); PG8_MMA(1, 0, At, B0); PG8_BAR; PG8_SCHED;
            PG8_STAGE(PG8_SB(1, 1), b3 + hstep, voffB);
            PG8_WAIT_V(6); PG8_BAR; PG8_MMA(1, 1, At, B1); PG8_BAR;
            }
        }
        if constexpr (ALIGN_EPI) { if (wr == 0) PG8_BAR; }
        if constexpr (!Epi::AFTER_DRAIN) { E(acc, cur, wr, wc, fr, fq); S.done(cur); }
        if (!has_next) break;
#pragma unroll
        for (int a = 0; a < 2; ++a)
#pragma unroll
            for (int b = 0; b < 2; ++b)
#pragma unroll
                for (int m = 0; m < 4; ++m)
#pragma unroll
                    for (int n = 0; n < 2; ++n) acc[a][b][m][n] = (f32x4){0.f, 0.f, 0.f, 0.f};
        cur = nxt; cA = nA; cB = nB; ++ui;
        if constexpr (Sched::GATHER) {
#pragma unroll
            for (int h = 0; h < 2; ++h)
#pragma unroll
                for (int i = 0; i < 2; ++i) vAc[h][i] = vAn[h][i]; }
        if constexpr (ALIGN_EPI) { if (wr == 1) PG8_BAR; }
    }
    PG8_WAIT_V(0);
    if constexpr (!ALIGN_EPI) { if (wr == 0) PG8_BAR; }
    PG8_BAR;
    if constexpr (Epi::AFTER_DRAIN) { E.fused(acc, cur, wr, wc, fr, fq, lds, wid, lane); S.done(cur); }
#undef PG8_SA
#undef PG8_SB
#undef PG8_STAGE
#undef PG8_STAGE_A
#undef PG8_STAGE_AN
#undef PG8_LDA
#undef PG8_LDB
#undef PG8_MMA
#undef PG8_WAIT_V
#undef PG8_WAIT_L
#undef PG8_BAR
#undef PG8_SCHED
}
}

constexpr int T = 8192, D = 2048, MIXW = 1536, MEMW = 512, NINA = 3584, DEPTH = 4, NE = 32, FF = 512, MEMT = 256;
constexpr int SLOTS = 24576;
constexpr float LN_EPS = 1e-5f;
constexpr float DN_ALPHA = 1.6817928305074292f;
constexpr float LOG2E = 1.4426950408889634f;
constexpr float QSCALE = 0.08838834764831845f * LOG2E;
constexpr int NWAVES = 8;

constexpr size_t MiB = 1u << 20;
constexpr size_t WS_CTL = 0, CTL_ZERO_BYTES = 1 * MiB;
constexpr size_t WS_WAIN = 2 * MiB, WS_WAOUT = 30 * MiB, WS_WBIN0 = 46 * MiB, WS_WKV = 54 * MiB, WS_WBIN1 = 66 * MiB, WS_WBOUT = 74 * MiB, WS_WMKV = 90 * MiB;
constexpr size_t WS_W13 = 106 * MiB, WS_W2 = 618 * MiB;
constexpr size_t WS_XB = 874 * MiB, WS_MEMB = 906 * MiB, WS_MEMKV = 907 * MiB, WS_Z = 910 * MiB, WS_KD = 966 * MiB, WS_VD = 990 * MiB, WS_CAT = 1014 * MiB;
constexpr size_t WS_XQ = 1206 * MiB, WS_ZQ = 1222 * MiB, WS_MEMQ = 1238 * MiB, WS_CATQ = 1246 * MiB;
constexpr size_t WS_Y = 1046 * MiB, WS_X1F = 1110 * MiB, WS_X1B = 1174 * MiB, WS_XF = 1206 * MiB, WS_XG = 1270 * MiB, WS_H = 1366 * MiB, WS_YB = 1390 * MiB, WS_OP = 1486 * MiB;
constexpr size_t WS_ROUTE = 1582 * MiB, WS_OP2 = 1583 * MiB, WS_ML = 1631 * MiB, WS_WR = 1634 * MiB, WS_TS = 1640 * MiB, WS_LIST = 1641 * MiB, WS_END = 1642 * MiB;
constexpr int CW_TMO = 0, CW_BAR = 4096, CW_CNT = 16384, CW_Q = 28672, CW_CONV = 29184, CW_DONE = 32768, CW_FIN = 40960;

constexpr int RING_OFF = 0, RING_BYTES = 131072;
constexpr int LDSCTL_OFF = 146432, MISC_OFF = LDSCTL_OFF + 320, TAB_OFF = LDSCTL_OFF + 512;
constexpr int LDS_BYTES = 147456;

#define GAS __attribute__((address_space(1)))
#define LAS __attribute__((address_space(3)))
typedef unsigned short bf16;
typedef unsigned v4u __attribute__((ext_vector_type(4)));
typedef unsigned v2u __attribute__((ext_vector_type(2)));
typedef float f32x4 __attribute__((ext_vector_type(4)));
typedef short bf16x8 __attribute__((ext_vector_type(8)));
typedef GAS unsigned gu32;
#define RLX_AGENT __ATOMIC_RELAXED, __HIP_MEMORY_SCOPE_AGENT
#define LDS_WAIT() asm volatile("s_waitcnt lgkmcnt(0)" ::: "memory")
#define VM_WAIT() asm volatile("s_waitcnt vmcnt(0)" ::: "memory")
__device__ __forceinline__ unsigned f2bf(float f) { unsigned u = __builtin_bit_cast(unsigned, f); return (u + 0x7fffu + ((u >> 16) & 1u)) >> 16; }
__device__ __forceinline__ unsigned pk2(float lo, float hi) { return f2bf(lo) | (f2bf(hi) << 16); }
__device__ __forceinline__ float bf2f(unsigned short b) { return __builtin_bit_cast(float, (unsigned)b << 16); }
__device__ __forceinline__ float bflo(unsigned w) { return __builtin_bit_cast(float, w << 16); }
__device__ __forceinline__ float bfhi(unsigned w) { return __builtin_bit_cast(float, w & 0xffff0000u); }
__device__ __forceinline__ float wave_sum(float v) {
#pragma unroll
    for (int o = 1; o < 64; o <<= 1) v += __shfl_xor(v, o);
    return v;
}

namespace pg8 {
struct DenseOrder {
    static constexpr bool GATHER = false, F8 = false; static constexpr int SCALE_B = 127;
    StaticOrder so; const char* A; const char* B; size_t astep, bstep;
    __device__ void init(const void* A_, const void* B_, int M, int N, int K, int G, int c) { so.init(M, N, G, c); A = (const char*)A_; B = (const char*)B_; astep = (size_t)256 * K * 2; bstep = astep; }
    __device__ __forceinline__ bool next(int i, Unit& u) const { u.e = 0; return so.next(i, u); }
    __device__ __forceinline__ const char* aptr(const Unit& u) const { return A + (size_t)u.pm * astep; }
    __device__ __forceinline__ const char* bptr(const Unit& u) const { return B + (size_t)u.pn * bstep; }
    __device__ __forceinline__ void a_ready(const Unit&) const {}
    __device__ __forceinline__ void done(const Unit&) const {}
};
struct DenseOrder8 {
    static constexpr bool GATHER = false, F8 = true; static constexpr int SCALE_B = 121;
    StaticOrder so; const char* A; const char* B; size_t astep, bstep;
    __device__ void init(const void* A_, const void* B_, int M, int N, int K, int G, int c) { so.init(M, N, G, c); A = (const char*)A_; B = (const char*)B_; astep = (size_t)256 * K * 2; bstep = astep; }
    __device__ __forceinline__ bool next(int i, Unit& u) const { u.e = 0; return so.next(i, u); }
    __device__ __forceinline__ const char* aptr(const Unit& u) const { return A + (size_t)u.pm * astep; }
    __device__ __forceinline__ const char* bptr(const Unit& u) const { return B + (size_t)u.pn * bstep; }
    __device__ __forceinline__ void a_ready(const Unit&) const {}
    __device__ __forceinline__ void done(const Unit&) const {}
};
struct DualOrder {
    static constexpr bool GATHER = false, F8 = false; static constexpr int SCALE_B = 127;
    StaticOrder so; int nwg2; const char* A; const char* B; const char* A2; const char* B2; size_t step;
    __device__ void init(const void* A_, const void* B_, int M, int N, int K, int G, int c, const void* A2_, const void* B2_, int nwg2_) { so.init(M, N, G, c); A = (const char*)A_; B = (const char*)B_; A2 = (const char*)A2_; B2 = (const char*)B2_; nwg2 = nwg2_; step = (size_t)256 * K * 2; }
    __device__ __forceinline__ bool next(int i, Unit& u) const { const int L = i * so.G + so.c; if (L < so.nwg) { u.e = 0; return so.next(i, u); } if (L - so.nwg >= nwg2) return false; u.e = 1; u.pm = 0; u.pn = L - so.nwg; return true; }
    __device__ __forceinline__ const char* aptr(const Unit& u) const { return u.e ? A2 : A + (size_t)u.pm * step; }
    __device__ __forceinline__ const char* bptr(const Unit& u) const { return (u.e ? B2 : B) + (size_t)u.pn * step; }
    __device__ __forceinline__ void a_ready(const Unit&) const {}
    __device__ __forceinline__ void done(const Unit&) const {}
};
struct DualOrder8 {
    static constexpr bool GATHER = false, F8 = true; static constexpr int SCALE_B = 121;
    StaticOrder so; int nwg2; const char* A; const char* B; const char* A2; const char* B2; size_t step;
    __device__ void init(const void* A_, const void* B_, int M, int N, int K, int G, int c, const void* A2_, const void* B2_, int nwg2_) { so.init(M, N, G, c); A = (const char*)A_; B = (const char*)B_; A2 = (const char*)A2_; B2 = (const char*)B2_; nwg2 = nwg2_; step = (size_t)256 * K * 2; }
    __device__ __forceinline__ bool next(int i, Unit& u) const { const int L = i * so.G + so.c; if (L < so.nwg) { u.e = 0; return so.next(i, u); } if (L - so.nwg >= nwg2) return false; u.e = 1; u.pm = 0; u.pn = L - so.nwg; return true; }
    __device__ __forceinline__ const char* aptr(const Unit& u) const { return u.e ? A2 : A + (size_t)u.pm * step; }
    __device__ __forceinline__ const char* bptr(const Unit& u) const { return (u.e ? B2 : B) + (size_t)u.pn * step; }
    __device__ __forceinline__ void a_ready(const Unit&) const {}
    __device__ __forceinline__ void done(const Unit&) const {}
};
struct MoeOrder {
    static constexpr bool GATHER = false, F8 = false; static constexpr int SCALE_B = 127;
    const PG8_LAS int* tstart; int ntn, G, c; const char* A; const char* W; size_t astep, wexp, wtile;
    __device__ __forceinline__ bool next(int i, Unit& u) const {
        const int L = i * G + c, total = tstart[32] * ntn; if (L >= total) return false;
        int wgid; { const int q = total / NXCD, r = total % NXCD, xcd = L % NXCD, off = L / NXCD; wgid = (xcd < r ? xcd * (q + 1) : r * (q + 1) + (xcd - r) * q) + off; }
        u.pm = wgid / ntn; u.pn = wgid - u.pm * ntn; int e = 0;
#pragma unroll
        for (int k = 1; k <= 31; ++k) e += (tstart[k] <= u.pm) ? 1 : 0;
        u.e = e; return true;
    }
    __device__ __forceinline__ const char* aptr(const Unit& u) const { return A + (size_t)u.pm * astep; }
    __device__ __forceinline__ const char* bptr(const Unit& u) const { return W + (size_t)u.e * wexp + (size_t)u.pn * wtile; }
    __device__ __forceinline__ void a_ready(const Unit&) const {}
    __device__ __forceinline__ void done(const Unit&) const {}
};

struct MoeOrder8 {
    static constexpr bool GATHER = false, F8 = true; static constexpr int SCALE_B = 121;
    const PG8_LAS int* tstart; int ntn, G, c; const char* A; const char* W; size_t astep, wexp, wtile;
    __device__ __forceinline__ bool next(int i, Unit& u) const {
        const int L = i * G + c, total = tstart[32] * ntn; if (L >= total) return false;
        int wgid; { const int q = total / NXCD, r = total % NXCD, xcd = L % NXCD, off = L / NXCD; wgid = (xcd < r ? xcd * (q + 1) : r * (q + 1) + (xcd - r) * q) + off; }
        u.pm = wgid / ntn; u.pn = wgid - u.pm * ntn; int e = 0;
#pragma unroll
        for (int k = 1; k <= 31; ++k) e += (tstart[k] <= u.pm) ? 1 : 0;
        u.e = e; return true;
    }
    __device__ __forceinline__ const char* aptr(const Unit& u) const { return A + (size_t)u.pm * astep; }
    __device__ __forceinline__ const char* bptr(const Unit& u) const { return W + (size_t)u.e * wexp + (size_t)u.pn * wtile; }
    __device__ __forceinline__ void a_ready(const Unit&) const {}
    __device__ __forceinline__ void done(const Unit&) const {}
};

struct MoeGatherOrder {
    static constexpr bool GATHER = true, F8 = true; static constexpr int SCALE_B = 121;
    const PG8_LAS int* tstart; const PG8_LAS int* cntl; const int* list; int ntn, G, c; const char* A; const char* W; size_t wexp, wtile; unsigned rowbytes;
    __device__ __forceinline__ bool next(int i, Unit& u) const {
        const int L = i * G + c, total = tstart[32] * ntn; if (L >= total) return false;
        int wgid; { const int q = total / NXCD, r = total % NXCD, xcd = L % NXCD, off = L / NXCD; wgid = (xcd < r ? xcd * (q + 1) : r * (q + 1) + (xcd - r) * q) + off; }
        u.pm = wgid / ntn; u.pn = wgid - u.pm * ntn; int e = 0;
#pragma unroll
        for (int k = 1; k <= 31; ++k) e += (tstart[k] <= u.pm) ? 1 : 0;
        u.e = e; return true;
    }
    __device__ __forceinline__ unsigned rowoff(const Unit& u, int r) const { const int rank = (u.pm - tstart[u.e]) * 256 + r; const int tok = list[u.e * 8192 + (rank < cntl[u.e] ? rank : 0)]; return (unsigned)tok * rowbytes; }
    __device__ __forceinline__ const char* aptr(const Unit&) const { return A; }
    __device__ __forceinline__ const char* bptr(const Unit& u) const { return W + (size_t)u.e * wexp + (size_t)u.pn * wtile; }
    __device__ __forceinline__ void a_ready(const Unit&) const {}
    __device__ __forceinline__ void done(const Unit&) const {}
};

typedef unsigned u32x2 __attribute__((ext_vector_type(2)));
struct EpiBf16X {
    static constexpr bool PERM = true, AFTER_DRAIN = false;
    int mode; bf16_t* p0; bf16_t* p1; bf16_t* p2; bf16_t* p3;
    const PG8_LAS int* tstart; const PG8_LAS int* cntl;
    __device__ __forceinline__ void operator()(const f32x4 (&acc)[2][2][4][2], const Unit& u, int wr, int wc, int fr, int fq) const {
#ifndef ATT_BF16
        if (mode == 1 && !u.e) {
            int tok0 = u.pm * BM + wr * 64 + fr, cc0 = wc * 32 + 8 * fq; asm volatile("" : "+v"(tok0), "+v"(cc0));
            if (u.pn >= 14) { const int colv = (u.pn - 14) * BM + cc0; unsigned char* vb = (unsigned char*)p2 + ((size_t)((colv >> 8) * 128 + (tok0 >> 6)) * 256 + (colv & 255)) * 64 + (tok0 & 63);
#pragma unroll
                for (int ai = 0; ai < 2; ++ai)
#pragma unroll
                    for (int m = 0; m < 4; ++m)
#pragma unroll
                        for (int bj = 0; bj < 2; ++bj) { const f32x4 v0 = acc[ai][bj][m][0], v1 = acc[ai][bj][m][1]; unsigned a_ = 0u, b_ = 0u;
                            a_ = __builtin_amdgcn_cvt_pk_fp8_f32(v0[0], v0[1], a_, false); a_ = __builtin_amdgcn_cvt_pk_fp8_f32(v0[2], v0[3], a_, true); b_ = __builtin_amdgcn_cvt_pk_fp8_f32(v1[0], v1[1], b_, false); b_ = __builtin_amdgcn_cvt_pk_fp8_f32(v1[2], v1[3], b_, true);
                            unsigned char* vp = vb + (size_t)(ai * 2) * 16384 + m * 16 + (size_t)bj * HALF * 64;
                            vp[0] = (unsigned char)a_; vp[64] = (unsigned char)(a_ >> 8); vp[128] = (unsigned char)(a_ >> 16); vp[192] = (unsigned char)(a_ >> 24);
                            vp[256] = (unsigned char)b_; vp[320] = (unsigned char)(b_ >> 8); vp[384] = (unsigned char)(b_ >> 16); vp[448] = (unsigned char)(b_ >> 24); }
                return; }
            if (u.pn >= 8) { unsigned char* kb = (unsigned char*)p1 + (size_t)tok0 * 1536 + (u.pn - 8) * BM + cc0;
#pragma unroll
                for (int ai = 0; ai < 2; ++ai)
#pragma unroll
                    for (int m = 0; m < 4; ++m)
#pragma unroll
                        for (int bj = 0; bj < 2; ++bj) { const f32x4 v0 = acc[ai][bj][m][0], v1 = acc[ai][bj][m][1]; unsigned a_ = 0u, b_ = 0u;
                            a_ = __builtin_amdgcn_cvt_pk_fp8_f32(v0[0], v0[1], a_, false); a_ = __builtin_amdgcn_cvt_pk_fp8_f32(v0[2], v0[3], a_, true); b_ = __builtin_amdgcn_cvt_pk_fp8_f32(v1[0], v1[1], b_, false); b_ = __builtin_amdgcn_cvt_pk_fp8_f32(v1[2], v1[3], b_, true);
                            u32x2 kk; kk.x = a_; kk.y = b_; *(u32x2*)(kb + (size_t)(ai * HALF + m * 16) * 1536 + bj * HALF) = kk; }
                return; }
            { unsigned char* qb = (unsigned char*)p0 + (WS_ZQ - WS_Z) + (size_t)tok0 * 2048 + u.pn * BM + cc0; bf16_t* zb = p0 + (size_t)tok0 * 2048 + u.pn * BM + cc0;
#pragma unroll
                for (int ai = 0; ai < 2; ++ai)
#pragma unroll
                    for (int m = 0; m < 4; ++m)
#pragma unroll
                        for (int bj = 0; bj < 2; ++bj) { const f32x4 v0 = acc[ai][bj][m][0] * QSCALE, v1 = acc[ai][bj][m][1] * QSCALE; unsigned a_ = 0u, b_ = 0u;
                            a_ = __builtin_amdgcn_cvt_pk_fp8_f32(v0[0], v0[1], a_, false); a_ = __builtin_amdgcn_cvt_pk_fp8_f32(v0[2], v0[3], a_, true); b_ = __builtin_amdgcn_cvt_pk_fp8_f32(v1[0], v1[1], b_, false); b_ = __builtin_amdgcn_cvt_pk_fp8_f32(v1[2], v1[3], b_, true);
                            const size_t o_ = (size_t)(ai * HALF + m * 16) * 2048 + bj * HALF;
                            u32x2 qq; qq.x = a_; qq.y = b_; *(u32x2*)(qb + o_) = qq;
                            u32x4 w; w.x = cvt_pk_bf16(v0[0], v0[1]); w.y = cvt_pk_bf16(v0[2], v0[3]); w.z = cvt_pk_bf16(v1[0], v1[1]); w.w = cvt_pk_bf16(v1[2], v1[3]); *(u32x4*)(zb + o_) = w; }
                return; }
        }
#endif
        bf16_t* base; int ldc, colt; bool act = false; float sc = 1.f;
        if (u.e && mode < 2) { base = p3 + (size_t)(u.pn >> 2) * (256 * 1024); ldc = 1024; colt = (u.pn & 3) * BM; }
        else if (mode == 0) { base = p0; ldc = 3584; colt = u.pn * BM; act = u.pn < 12; if (u.pn >= 12) sc = QSCALE; }
        else if (mode == 1) { if (u.pn < 8) { base = p0; ldc = 2048; colt = u.pn * BM; sc = QSCALE; }
                              else if (u.pn < 14) { base = p1; ldc = 1536; colt = (u.pn - 8) * BM; } else { base = p2; ldc = 1536; colt = (u.pn - 14) * BM; } }
        else { base = p0; ldc = 2048; colt = u.pn * BM; }
        const int row0 = u.pm * BM + wr * 64 + fr, col0 = colt + wc * 32 + 8 * fq;
        const int rlim = (mode == 3) ? cntl[u.e] - (u.pm - tstart[u.e]) * BM : BM;
#pragma unroll
        for (int ai = 0; ai < 2; ++ai)
#pragma unroll
            for (int m = 0; m < 4; ++m) { bf16_t* rowp = base + (size_t)(row0 + ai * HALF + m * 16) * ldc + col0;
                if (wr * 64 + fr + ai * HALF + m * 16 >= rlim) continue;
#pragma unroll
                for (int bj = 0; bj < 2; ++bj) { f32x4 v0 = acc[ai][bj][m][0], v1 = acc[ai][bj][m][1];
                    if (act) { f32x2 a = gelu_pk((f32x2){v0[0], v0[1]}), b = gelu_pk((f32x2){v0[2], v0[3]}), c = gelu_pk((f32x2){v1[0], v1[1]}), d = gelu_pk((f32x2){v1[2], v1[3]});
                        v0 = (f32x4){a.x, a.y, b.x, b.y}; v1 = (f32x4){c.x, c.y, d.x, d.y}; }
                    v0 = v0 * sc; v1 = v1 * sc; u32x4 w; w.x = cvt_pk_bf16(v0[0], v0[1]); w.y = cvt_pk_bf16(v0[2], v0[3]); w.z = cvt_pk_bf16(v1[0], v1[1]); w.w = cvt_pk_bf16(v1[2], v1[3]);
                    *(u32x4*)(rowp + bj * HALF) = w; } }
    }
};
struct EpiResBf16 {
    static constexpr bool PERM = true, AFTER_DRAIN = false;
    const bf16_t* xres; bf16_t* y; float alpha;
    __device__ __forceinline__ void operator()(const f32x4 (&acc)[2][2][4][2], const Unit& u, int wr, int wc, int fr, int fq) const {
        const int row0 = u.pm * BM + wr * 64 + fr, col0 = u.pn * BM + wc * 32 + 8 * fq;
#pragma unroll
        for (int ai = 0; ai < 2; ++ai)
#pragma unroll
            for (int m = 0; m < 4; ++m) { const size_t off = (size_t)(row0 + ai * HALF + m * 16) * 2048 + col0;
#pragma unroll
                for (int bj = 0; bj < 2; ++bj) { const u32x4 xr = *(const u32x4*)(xres + off + bj * HALF); const f32x4 v0 = acc[ai][bj][m][0], v1 = acc[ai][bj][m][1]; u32x4 w;
                    w.x = cvt_pk_bf16(__builtin_bit_cast(float, xr.x << 16) * alpha + v0[0], __builtin_bit_cast(float, xr.x & 0xffff0000u) * alpha + v0[1]);
                    w.y = cvt_pk_bf16(__builtin_bit_cast(float, xr.y << 16) * alpha + v0[2], __builtin_bit_cast(float, xr.y & 0xffff0000u) * alpha + v0[3]);
                    w.z = cvt_pk_bf16(__builtin_bit_cast(float, xr.z << 16) * alpha + v1[0], __builtin_bit_cast(float, xr.z & 0xffff0000u) * alpha + v1[1]);
                    w.w = cvt_pk_bf16(__builtin_bit_cast(float, xr.w << 16) * alpha + v1[2], __builtin_bit_cast(float, xr.w & 0xffff0000u) * alpha + v1[3]);
                    *(u32x4*)(y + off + bj * HALF) = w; } }
    }
};
struct EpiMoe1 {
    static constexpr bool PERM = true, AFTER_DRAIN = false;
    bf16_t* h; const PG8_LAS int* tstart; const PG8_LAS int* cntl;
    __device__ __forceinline__ void operator()(const f32x4 (&acc)[2][2][4][2], const Unit& u, int wr, int wc, int fr, int fq) const {
        const int row0 = u.pm * BM + wr * 64 + fr, col0 = u.pn * HALF + wc * 32 + 8 * fq;
        const int rlim = cntl[u.e] - (u.pm - tstart[u.e]) * BM;
#pragma unroll
        for (int ai = 0; ai < 2; ++ai)
#pragma unroll
            for (int m = 0; m < 4; ++m) { unsigned char* rowp = (unsigned char*)h + (size_t)(row0 + ai * HALF + m * 16) * 512 + col0; float o[8];
                if (wr * 64 + fr + ai * HALF + m * 16 >= rlim) continue;
#pragma unroll
                for (int n = 0; n < 2; ++n)
#pragma unroll
                    for (int x = 0; x < 4; ++x) { const float a = acc[ai][0][m][n][x], b = acc[ai][1][m][n][x];
                        o[n * 4 + x] = a * __builtin_amdgcn_rcpf(1.0f + __builtin_amdgcn_exp2f(-a * LOG2E)) * b; }
                unsigned lo = 0u, hi = 0u; lo = __builtin_amdgcn_cvt_pk_fp8_f32(o[0], o[1], lo, false); lo = __builtin_amdgcn_cvt_pk_fp8_f32(o[2], o[3], lo, true);
                hi = __builtin_amdgcn_cvt_pk_fp8_f32(o[4], o[5], hi, false); hi = __builtin_amdgcn_cvt_pk_fp8_f32(o[6], o[7], hi, true);
                typedef unsigned u32x2e __attribute__((ext_vector_type(2))); u32x2e w; w.x = lo; w.y = hi; *(u32x2e*)rowp = w; }
    }
};
}

namespace att {
using bf16x8 = __attribute__((ext_vector_type(8))) short;
using s16x4  = __attribute__((ext_vector_type(4))) short;
using f32x16 = __attribute__((ext_vector_type(16))) float;
using u32x4  = __attribute__((ext_vector_type(4))) unsigned;
constexpr int DH = 128, QBLK = 32, KVBLK = 64;
constexpr float THR2 = 8.f * 1.4426950408889634f;
constexpr size_t SHM_V = KVBLK * DH * 2, SHM_K = KVBLK * DH * 2, SHM_ATTN = 2 * SHM_V + 2 * SHM_K + NWAVES * 64 * 4;
constexpr int TAB_N = 160;
#define KSWZ(row, colB) ((row) * 256 + ((colB) ^ (((row) & 7) << 4)))
#define SBAR() __builtin_amdgcn_sched_barrier(0)
__device__ __forceinline__ int crow(int r, int hi) { return (r & 3) + 8 * (r >> 2) + 4 * hi; }
__device__ __forceinline__ unsigned cvtpk(float lo, float hi) { unsigned r; asm volatile("v_cvt_pk_bf16_f32 %0, %1, %2" : "=v"(r) : "v"(lo), "v"(hi)); return r; }

__device__ __forceinline__ void partialSM(f32x16& p0, f32x16& p1, float& m_reg, float& mn, float& alpha) {
  float pmax = p0[0];
#pragma unroll
  for (int r = 1; r < 16; ++r) pmax = fmaxf(pmax, p0[r]);
#pragma unroll
  for (int r = 0; r < 16; ++r) pmax = fmaxf(pmax, p1[r]);
  { auto rr = __builtin_amdgcn_permlane32_swap(__float_as_uint(pmax), __float_as_uint(pmax), false, false);
    pmax = fmaxf(__uint_as_float(rr[0]), __uint_as_float(rr[1])); }
  if (__builtin_expect(__all(pmax - m_reg <= THR2), 1)) { mn = m_reg; alpha = 1.f; }
  else { mn = fmaxf(m_reg, pmax); alpha = __builtin_amdgcn_exp2f(m_reg - mn); m_reg = mn; }
#pragma unroll
  for (int r = 0; r < 16; ++r) p0[r] = p0[r] - mn;
#pragma unroll
  for (int r = 0; r < 16; ++r) p1[r] = p1[r] - mn;
#pragma unroll
  for (int r = 0; r < 16; ++r) p0[r] = __builtin_amdgcn_exp2f(p0[r]);
}
__device__ __forceinline__ void finishSM(f32x16& p0, f32x16& p1, float alpha, float& l_reg, bf16x8& pa0, bf16x8& pa1, bf16x8& pa2, bf16x8& pa3) {
#pragma unroll
  for (int r = 0; r < 16; ++r) p1[r] = __builtin_amdgcn_exp2f(p1[r]);
  float ps = 0;
#pragma unroll
  for (int r = 0; r < 16; ++r) ps += p0[r];
#pragma unroll
  for (int r = 0; r < 16; ++r) ps += p1[r];
  { auto rr = __builtin_amdgcn_permlane32_swap(__float_as_uint(ps), __float_as_uint(ps), false, false);
    ps = __uint_as_float(rr[0]) + __uint_as_float(rr[1]); }
  l_reg = l_reg * alpha + ps;
#define PK4(P, BASE, OUT) do { unsigned a0 = cvtpk(P[BASE + 0], P[BASE + 1]), a1 = cvtpk(P[BASE + 2], P[BASE + 3]);   \
    unsigned b0 = cvtpk(P[BASE + 4], P[BASE + 5]), b1 = cvtpk(P[BASE + 6], P[BASE + 7]);                              \
    auto r0 = __builtin_amdgcn_permlane32_swap(a0, b0, false, false); auto r1 = __builtin_amdgcn_permlane32_swap(a1, b1, false, false); \
    u32x4 w = {r0[0], r1[0], r0[1], r1[1]}; OUT = *reinterpret_cast<bf16x8*>(&w); } while (0)
  PK4(p0, 0, pa0); PK4(p0, 8, pa1); PK4(p1, 0, pa2); PK4(p1, 8, pa3);
#undef PK4
}
__device__ __forceinline__ void qkt(f32x16& p0, f32x16& p1, const char* Ks, const bf16x8* qr, int r32, int hi) {
  p0 = f32x16{}; p1 = f32x16{};
#pragma unroll
  for (int d0 = 0; d0 < 8; ++d0) { const int cb = (d0 * 16 + hi * 8) * 2;
    bf16x8 b0 = *reinterpret_cast<const bf16x8*>(Ks + KSWZ(r32, cb));
    bf16x8 b1 = *reinterpret_cast<const bf16x8*>(Ks + KSWZ(32 + r32, cb));
    p0 = __builtin_amdgcn_mfma_f32_32x32x16_bf16(b0, qr[d0], p0, 0, 0, 0);
    p1 = __builtin_amdgcn_mfma_f32_32x32x16_bf16(b1, qr[d0], p1, 0, 0, 0); }
}
__device__ __forceinline__ int v_st(int k, int c) { const int kk = (k & ~0xC) | ((k & 4) << 1) | ((k & 8) >> 1); return ((kk >> 3) * 4 + (c >> 5)) * 512 + ((kk & 7) * 32 + (c & 31)) * 2; }
__device__ __forceinline__ int v_rd_base(int lane) { return ((lane & 3) << 3) | (((lane >> 2) & 3) << 6) | (((lane >> 4) & 1) << 5) | (((lane >> 5) & 1) << 8); }
constexpr int v_rd_off(int d0, int ks, int half) { return d0 * 512 + ks * 4096 + half * 2048; }
template <int OFF> __device__ __forceinline__ s16x4 tr_read(int vb) {
  s16x4 r; asm volatile("ds_read_b64_tr_b16 %0, %1 offset:%2" : "=&v"(r) : "v"(vb), "i"(OFF) : "memory"); return r;
}
template <int D0> __device__ __forceinline__ void pv_one(f32x16& od, int vb, bf16x8 pa0, bf16x8 pa1, bf16x8 pa2, bf16x8 pa3) {
  const s16x4 l0 = tr_read<v_rd_off(D0, 0, 0)>(vb), h0 = tr_read<v_rd_off(D0, 0, 1)>(vb), l1 = tr_read<v_rd_off(D0, 1, 0)>(vb), h1 = tr_read<v_rd_off(D0, 1, 1)>(vb);
  const s16x4 l2 = tr_read<v_rd_off(D0, 2, 0)>(vb), h2 = tr_read<v_rd_off(D0, 2, 1)>(vb), l3 = tr_read<v_rd_off(D0, 3, 0)>(vb), h3 = tr_read<v_rd_off(D0, 3, 1)>(vb);
  asm volatile("s_waitcnt lgkmcnt(0)" ::: "memory"); SBAR();
#define PK(L, H) (bf16x8){L[0], L[1], L[2], L[3], H[0], H[1], H[2], H[3]}
  od = __builtin_amdgcn_mfma_f32_32x32x16_bf16(pa0, PK(l0, h0), od, 0, 0, 0);
  od = __builtin_amdgcn_mfma_f32_32x32x16_bf16(pa1, PK(l1, h1), od, 0, 0, 0);
  od = __builtin_amdgcn_mfma_f32_32x32x16_bf16(pa2, PK(l2, h2), od, 0, 0, 0);
  od = __builtin_amdgcn_mfma_f32_32x32x16_bf16(pa3, PK(l3, h3), od, 0, 0, 0);
#undef PK
}
__device__ __forceinline__ void pv_d0(f32x16* o, int vb, bf16x8 pa0, bf16x8 pa1, bf16x8 pa2, bf16x8 pa3) {
  pv_one<0>(o[0], vb, pa0, pa1, pa2, pa3); pv_one<1>(o[1], vb, pa0, pa1, pa2, pa3); pv_one<2>(o[2], vb, pa0, pa1, pa2, pa3); pv_one<3>(o[3], vb, pa0, pa1, pa2, pa3);
}
template <int MODE> __device__ __forceinline__ void post_scores(f32x16& p0, f32x16& p1, int t, int qrow0, int r32, int hi, const float* tab, float cfar) {
  if constexpr (MODE == 1) {
    const int cw = qrow0 >> 6;
    if (t > cw) {
#pragma unroll
      for (int r = 0; r < 16; ++r) { p0[r] = -INFINITY; p1[r] = -INFINITY; }
    } else if (qrow0 - (64 * t + 63) >= 91) {
#pragma unroll
      for (int r = 0; r < 16; ++r) { p0[r] += cfar; p1[r] += cfar; }
    } else {
      const int base = qrow0 + r32 - 64 * t + 63;
#pragma unroll
      for (int r = 0; r < 16; ++r) { const int i0 = base - crow(r, hi); const int i1 = i0 - 32;
        p0[r] += tab[i0 < TAB_N - 1 ? i0 : TAB_N - 1]; p1[r] += tab[i1 < TAB_N - 1 ? i1 : TAB_N - 1]; }
    }
  }
}

template <int MODE>
__device__ __forceinline__ void attn_body(const bf16* __restrict__ Qb, int ldq, const bf16* __restrict__ Kh, const bf16* __restrict__ Vh, int ldk,
                                          bf16* Ob, float* Of, int ldo, int NT, int q0abs, const float* tab, float cfar, char* lds) {
  int tid_ = threadIdx.x; asm volatile("" : "+v"(tid_));
  const int tid = tid_, wid = tid >> 6, lane = tid & 63, r32 = lane & 31, hi = lane >> 5;
  char* V_lds = lds; char* K_lds = lds + 2 * SHM_V;
  float* ws = (float*)(lds + 2 * SHM_V + 2 * SHM_K) + wid * 64; float* li_l = ws; float* al_l = ws + 32;
  float m_reg = -1e30f, l_reg = 0; f32x16 o[4] = {}; bf16x8 qr[8];
  const int qrow0 = q0abs + wid * QBLK;
  const bf16* Qw = Qb + (long)(wid * QBLK + r32) * ldq + hi * 8;
#pragma unroll
  for (int d0 = 0; d0 < 8; ++d0) qr[d0] = *reinterpret_cast<const bf16x8*>(Qw + d0 * 16);
  const int sr = tid >> 4, sc = (tid & 15) * 8, vst0 = v_st(sr, sc), vst1 = v_st(32 + sr, sc);
  const int vb0 = (int)(uintptr_t)V_lds + v_rd_base(lane);
  struct { bf16x8 vs0, vs1, ks0, ks1; } sr_[2];
#define SLOAD(i, k0) do { sr_[i].vs0 = *reinterpret_cast<const bf16x8*>(&Vh[(long)((k0) + sr) * ldk + sc]); sr_[i].vs1 = *reinterpret_cast<const bf16x8*>(&Vh[(long)((k0) + 32 + sr) * ldk + sc]); \
    sr_[i].ks0 = *reinterpret_cast<const bf16x8*>(&Kh[(long)((k0) + sr) * ldk + sc]); sr_[i].ks1 = *reinterpret_cast<const bf16x8*>(&Kh[(long)((k0) + 32 + sr) * ldk + sc]); } while (0)
#define SWRITE(b, i) do { *(bf16x8*)(V_lds + (b) * SHM_V + vst0) = sr_[i].vs0;          \
    *(bf16x8*)(V_lds + (b) * SHM_V + vst1) = sr_[i].vs1; const int kc = sc * 2;               \
    *(bf16x8*)(K_lds + (b) * SHM_K + KSWZ(sr, kc)) = sr_[i].ks0;                       \
    *(bf16x8*)(K_lds + (b) * SHM_K + KSWZ(32 + sr, kc)) = sr_[i].ks1; } while (0)
#define SWAIT() asm volatile("s_waitcnt vmcnt(4)" ::: "memory")
#define RESC(a) do { if (__any((a) < 1.f)) { if (hi == 0) al_l[r32] = (a); asm volatile("s_waitcnt lgkmcnt(0)" ::: "memory"); \
    _Pragma("unroll") for (int d = 0; d < 4; ++d) _Pragma("unroll") for (int r = 0; r < 16; ++r) o[d][r] *= al_l[crow(r, hi)]; } } while (0)
  f32x16 pA0, pA1, pB0, pB1; float mnA, mnB, alA, alB; bf16x8 pa0, pa1, pa2, pa3;
  constexpr int SE = 0, SO = 1;
  SLOAD(SE, 0); asm volatile("s_waitcnt vmcnt(0)" ::: "memory"); SWRITE(0, SE); __syncthreads();
  qkt(pA0, pA1, K_lds, qr, r32, hi); post_scores<MODE>(pA0, pA1, 0, qrow0, r32, hi, tab, cfar); partialSM(pA0, pA1, m_reg, mnA, alA);
  SLOAD(SO, KVBLK); if (2 < NT) SLOAD(SE, 2 * KVBLK);
  SWAIT(); SWRITE(1, SO); __syncthreads();
  for (int j = 1; j + 1 < NT; j += 2) {
    SBAR(); qkt(pB0, pB1, K_lds + SHM_K, qr, r32, hi); post_scores<MODE>(pB0, pB1, j, qrow0, r32, hi, tab, cfar);
    finishSM(pA0, pA1, alA, l_reg, pa0, pa1, pa2, pa3); SBAR();
    SLOAD(SO, (j + 2) * KVBLK); SBAR();
    pv_d0(o, vb0, pa0, pa1, pa2, pa3); partialSM(pB0, pB1, m_reg, mnB, alB);
    __syncthreads(); SWAIT(); SWRITE(0, SE);
    RESC(alB); __syncthreads();
    SBAR(); qkt(pA0, pA1, K_lds, qr, r32, hi); post_scores<MODE>(pA0, pA1, j + 1, qrow0, r32, hi, tab, cfar);
    finishSM(pB0, pB1, alB, l_reg, pa0, pa1, pa2, pa3); SBAR();
    if (j + 3 < NT) SLOAD(SE, (j + 3) * KVBLK); SBAR();
    pv_d0(o, vb0 + (int)SHM_V, pa0, pa1, pa2, pa3); partialSM(pA0, pA1, m_reg, mnA, alA);
    __syncthreads(); SWAIT(); SWRITE(1, SO);
    RESC(alA); __syncthreads();
  }
  SBAR(); qkt(pB0, pB1, K_lds + SHM_K, qr, r32, hi); post_scores<MODE>(pB0, pB1, NT - 1, qrow0, r32, hi, tab, cfar);
  finishSM(pA0, pA1, alA, l_reg, pa0, pa1, pa2, pa3); SBAR();
  pv_d0(o, vb0, pa0, pa1, pa2, pa3); partialSM(pB0, pB1, m_reg, mnB, alB);
  __syncthreads(); RESC(alB);
  finishSM(pB0, pB1, alB, l_reg, pa0, pa1, pa2, pa3); SBAR();
  pv_d0(o, vb0 + (int)SHM_V, pa0, pa1, pa2, pa3);
  if (hi == 0) li_l[r32] = l_reg; asm volatile("s_waitcnt lgkmcnt(0)" ::: "memory");
  float rli[16];
#pragma unroll
  for (int r = 0; r < 16; ++r) rli[r] = __builtin_amdgcn_rcpf(li_l[crow(r, hi)]);
  if constexpr (MODE == 0) {
    bf16* Ow = Ob + (long)(wid * QBLK) * ldo;
#pragma unroll
    for (int r = 0; r < 16; ++r) { const int orow = crow(r, hi);
#pragma unroll
      for (int d0 = 0; d0 < 4; ++d0) Ow[(long)orow * ldo + d0 * 32 + r32] = (bf16)f2bf(o[d0][r] * rli[r]); }
  } else {
    float* Ow = Of + (long)(wid * QBLK) * ldo;
#pragma unroll
    for (int r = 0; r < 16; ++r) { const int orow = crow(r, hi);
#pragma unroll
      for (int d0 = 0; d0 < 4; ++d0) Ow[(long)orow * ldo + d0 * 32 + r32] = o[d0][r] * rli[r]; }
  }
  __syncthreads();
#undef SLOAD
#undef SWRITE
#undef SWAIT
#undef RESC
}
}

#define XB_TMO      128
#define XB_XCNT(j)  (256  + 64 * (j))
#define XB_XSUB(j)  (1280 + 64 * (j))
#define XB_XGEN(j)  (2304 + 64 * (j))
#define XB_TOP      3328
#define XB_TOPGEN   3392
#define XCD_BAR_WORDS 3456
#define XB_SPIN_CAP (1u << 18)

__device__ __forceinline__ unsigned xb_ld(unsigned* p)              { return __hip_atomic_load(p, __ATOMIC_RELAXED, __HIP_MEMORY_SCOPE_AGENT); }
__device__ __forceinline__ unsigned xb_add(unsigned* p, unsigned v) { return __hip_atomic_fetch_add(p, v, __ATOMIC_RELAXED, __HIP_MEMORY_SCOPE_AGENT); }
__device__ __forceinline__ unsigned xb_xcc_id() { return (unsigned)__builtin_amdgcn_s_getreg((3 << 11) | 20) & 0xFu; }
#define XB_SPIN(cond, bar) do { unsigned _sp = 0; while (cond) { __builtin_amdgcn_s_sleep(1); \
    if ((++_sp & 255u) == 0u) { if (xb_ld(&(bar)[XB_TMO])) break; if (_sp > XB_SPIN_CAP) { atomicAdd(&(bar)[XB_TMO], 1u); break; } } } } while (0)

struct XcdBarrier {
    unsigned* bar; unsigned x;
    volatile LAS unsigned* st;
};

__device__ __forceinline__ XcdBarrier xcd_barrier_post(unsigned* bar, volatile LAS unsigned* st) {
    XcdBarrier b; b.bar = bar; b.x = xb_xcc_id(); b.st = st;
    if (threadIdx.x == 0) (void)xb_add(&bar[XB_XCNT(b.x)], 1u);
    return b;
}
__device__ __forceinline__ void xcd_barrier_complete(unsigned* bar, unsigned x, unsigned& nloc, unsigned& nx) {
    const unsigned G = gridDim.x * gridDim.y * gridDim.z;
    unsigned sum, cnt, mine, sp = 0u;
    for (;;) {
        sum = 0u; cnt = 0u; mine = 0u;
#pragma unroll
        for (unsigned j = 0; j < 16; ++j) { const unsigned c = xb_ld(&bar[XB_XCNT(j)]); sum += c; cnt += (c > 0u) ? 1u : 0u; mine = (j == x) ? c : mine; }
        if (sum == G) break;
        __builtin_amdgcn_s_sleep(1);
        if ((++sp & 255u) == 0u) { if (xb_ld(&bar[XB_TMO])) break; if (sp > XB_SPIN_CAP) { atomicAdd(&bar[XB_TMO], 1u); break; } }
    }
    nloc = mine > 0u ? mine : 1u; nx = cnt > 0u ? cnt : 1u;
}

__device__ __forceinline__ void xcd_barrier(const XcdBarrier& b) {
    asm volatile("s_waitcnt vmcnt(0)" ::: "memory");
    __syncthreads();
    if (threadIdx.x == 0) {
        unsigned* bar = b.bar;
        __builtin_amdgcn_s_waitcnt(0);
        unsigned nloc = b.st[0], nx = b.st[1];
        if (nloc == 0u) { xcd_barrier_complete(bar, b.x, nloc, nx); b.st[0] = nloc; b.st[1] = nx; }
        const unsigned old = xb_add(&bar[XB_XSUB(b.x)], 1u);
        const unsigned gen = old / nloc;
        if (old + 1u == (gen + 1u) * nloc) {
            __builtin_amdgcn_fence(__ATOMIC_RELEASE, "agent");
            asm volatile("s_waitcnt vmcnt(0)" ::: "memory");
            const unsigned og = xb_add(&bar[XB_TOP], 1u);
            const unsigned tg = og / nx;
            if (og + 1u == (tg + 1u) * nx) xb_add(&bar[XB_TOPGEN], 1u);
            else XB_SPIN(xb_ld(&bar[XB_TOPGEN]) == tg, bar);
            __builtin_amdgcn_fence(__ATOMIC_ACQUIRE, "agent");
            xb_add(&bar[XB_XGEN(b.x)], 1u);
            asm volatile("s_waitcnt vmcnt(0)" ::: "memory");
        } else {
            XB_SPIN(xb_ld(&bar[XB_XGEN(b.x)]) == gen, bar);
            __builtin_amdgcn_fence(__ATOMIC_ACQUIRE, "agent");
            asm volatile("s_waitcnt vmcnt(0)" ::: "memory");
        }
    }
    __syncthreads();
}


struct Args { const float* in[24]; float* out; unsigned char* ws; int ph_lo, ph_hi; };
enum { I_X = 0, I_MEM, I_AWIN, I_ALNG, I_ALNB, I_AWS, I_ABS, I_AWOUT, I_BWIN, I_BLAM, I_BSUBG, I_BWOUT, I_WKV, I_RELB, I_MEMWKV, I_LNG, I_LNB,
       I_WG1, I_BG1, I_WG2, I_BG2, I_W1, I_W3, I_W2 };
constexpr int NPH_LAYER = 9, NPHASES = 1 + DEPTH * NPH_LAYER;

struct Frame {
    LAS unsigned char* lds; char* ldsg;
    gu32* ctl; unsigned char* ws;
    int tid, lane, wave, G, c;
};

__device__ __forceinline__ void transpose_item(const float* W, int K, int N, bf16* WT, int drow0, LAS float* scr, int k0, int n0, int lane) {
#pragma unroll 8
    for (int i = 0; i < 32; ++i) { const int kk = 2 * i + (lane >> 5); scr[kk * 33 + (lane & 31)] = W[(size_t)(k0 + kk) * N + n0 + (lane & 31)]; }
    LDS_WAIT(); asm volatile("" ::: "memory");
    const int c = lane & 7;
#pragma unroll
    for (int j = 0; j < 4; ++j) { const int n = (lane >> 3) + 8 * j; const LAS float* s = scr + (8 * c) * 33 + n;
        v4u o; o.x = pk2(s[0 * 33], s[1 * 33]); o.y = pk2(s[2 * 33], s[3 * 33]); o.z = pk2(s[4 * 33], s[5 * 33]); o.w = pk2(s[6 * 33], s[7 * 33]);
        *(GAS v4u*)(WT + (size_t)(drow0 + n) * K + k0 + 8 * c) = o; }
    LDS_WAIT(); asm volatile("" ::: "memory");
}
__device__ __forceinline__ void transpose_item_fast(const float* W, int K, int N, bf16* WT, int drow0, LAS float* scr, int k0, int n0, int lane) {
    float t[32];
#pragma unroll
    for (int i = 0; i < 32; ++i) t[i] = W[(size_t)(k0 + 2 * i + (lane >> 5)) * N + n0 + (lane & 31)];
#pragma unroll
    for (int i = 0; i < 32; i += 8) asm volatile("" : "+v"(t[i]), "+v"(t[i + 1]), "+v"(t[i + 2]), "+v"(t[i + 3]), "+v"(t[i + 4]), "+v"(t[i + 5]), "+v"(t[i + 6]), "+v"(t[i + 7]));
#pragma unroll
    for (int i = 0; i < 32; ++i) scr[(2 * i + (lane >> 5)) * 33 + (lane & 31)] = t[i];
    LDS_WAIT(); asm volatile("" ::: "memory");
    const int c = lane & 7;
#pragma unroll
    for (int j = 0; j < 4; ++j) { const int n = (lane >> 3) + 8 * j; const LAS float* s = scr + (8 * c) * 33 + n;
        v4u o; o.x = pk2(s[0 * 33], s[1 * 33]); o.y = pk2(s[2 * 33], s[3 * 33]); o.z = pk2(s[4 * 33], s[5 * 33]); o.w = pk2(s[6 * 33], s[7 * 33]);
        *(GAS v4u*)(WT + (size_t)(drow0 + n) * K + k0 + 8 * c) = o; }
    LDS_WAIT(); asm volatile("" ::: "memory");
}
__device__ __forceinline__ void transpose_item_fp8(const float* W, int K, int N, unsigned char* WT, int drow0, LAS float* scr, int k0, int n0, int lane) {
    float t[32];
#pragma unroll
    for (int i = 0; i < 32; ++i) t[i] = W[(size_t)(k0 + 2 * i + (lane >> 5)) * N + n0 + (lane & 31)];
#pragma unroll
    for (int i = 0; i < 32; i += 8) asm volatile("" : "+v"(t[i]), "+v"(t[i + 1]), "+v"(t[i + 2]), "+v"(t[i + 3]), "+v"(t[i + 4]), "+v"(t[i + 5]), "+v"(t[i + 6]), "+v"(t[i + 7]));
#pragma unroll
    for (int i = 0; i < 32; ++i) scr[(2 * i + (lane >> 5)) * 33 + (lane & 31)] = t[i];
    LDS_WAIT(); asm volatile("" ::: "memory");
    const int c = lane & 7;
#pragma unroll
    for (int j = 0; j < 4; ++j) { const int n = (lane >> 3) + 8 * j; const LAS float* s = scr + (8 * c) * 33 + n;
        unsigned lo = 0u, hi = 0u;
        lo = __builtin_amdgcn_cvt_pk_fp8_f32(s[0 * 33] * 64.f, s[1 * 33] * 64.f, lo, false); lo = __builtin_amdgcn_cvt_pk_fp8_f32(s[2 * 33] * 64.f, s[3 * 33] * 64.f, lo, true);
        hi = __builtin_amdgcn_cvt_pk_fp8_f32(s[4 * 33] * 64.f, s[5 * 33] * 64.f, hi, false); hi = __builtin_amdgcn_cvt_pk_fp8_f32(s[6 * 33] * 64.f, s[7 * 33] * 64.f, hi, true);
        v2u o; o.x = lo; o.y = hi; *(GAS v2u*)(WT + (size_t)(drow0 + n) * K + k0 + 8 * c) = o; }
    LDS_WAIT(); asm volatile("" ::: "memory");
}
#ifndef CDRAIN
#define CDRAIN 8
#endif
#ifndef CSRV
#define CSRV 4
#endif
#ifndef CSRVA
#define CSRVA 32
#endif
#ifndef STOPU
#define STOPU 64
#endif
#ifndef QX
#define QX 6
#endif
#ifndef QA
#define QA 14
#endif
#ifndef QM
#define QM 7
#endif
#ifndef QB
#define QB 4
#endif
constexpr int NQ = 7, MOE_ITEMS = 3 * 32 * 512;
__device__ __forceinline__ int conv_qsize(int q) { return (q & 1) ? (q == 1 ? 5632 : (q == 3 ? 7168 : 4096)) : MOE_ITEMS; }
__device__ __forceinline__ void conv_item(Frame& F, const Args& a, int q, int it) {
    LAS float* scr = (LAS float*)(F.lds + RING_OFF + F.wave * 16384);
    if (q & 1) {
        const float* src; bf16* dst; int N, r = it;
        if (q == 1) { if (r < 3584) { N = 3584; src = a.in[I_AWIN] + (size_t)2048 * 3584; dst = (bf16*)(F.ws + WS_WAIN) + (size_t)2048 * 3584; } else { r -= 3584; N = 2048; src = a.in[I_AWOUT] + (size_t)2048 * 2048; dst = (bf16*)(F.ws + WS_WAOUT) + (size_t)2048 * 2048; } }
        else if (q == 3) { if (r < 2048) { N = 2048; src = a.in[I_BWIN]; dst = (bf16*)(F.ws + WS_WBIN0); } else if ((r -= 2048) < 3072) { N = 3072; src = a.in[I_WKV]; dst = (bf16*)(F.ws + WS_WKV); } else { r -= 3072; N = 2048; src = a.in[I_BWOUT]; dst = (bf16*)(F.ws + WS_WBOUT); } }
        else { if (r < 2048) { N = 2048; src = a.in[I_BWIN] + (size_t)2048 * 2048; dst = (bf16*)(F.ws + WS_WBIN1); } else { r -= 2048; N = 2048; src = a.in[I_BWOUT] + (size_t)2048 * 2048; dst = (bf16*)(F.ws + WS_WBOUT) + (size_t)2048 * 2048; } }
        const int nblk = N / 32, kb = r / nblk, nb = r - kb * nblk;
        transpose_item_fast(src, 2048, N, dst, 32 * nb, scr, 64 * kb, 32 * nb, F.lane);
        return;
    }
    const int L = q >> 1, seg = it >> 14, r0 = it & 16383, e = r0 >> 9, r = r0 & 511, mat = L * 32 + e;
    if (seg < 2) { const int kb = r >> 4, nb = r & 15, n0 = 32 * nb;
        transpose_item_fp8(a.in[seg == 0 ? I_W1 : I_W3] + (size_t)mat * 2048 * 512, 2048, 512, (unsigned char*)(F.ws + WS_W13) + (size_t)mat * 1024 * 2048, (n0 >> 7) * 256 + (n0 & 127) + (seg == 1 ? 128 : 0), scr, 64 * kb, n0, F.lane); }
    else { const int kb = r >> 6, nb = r & 63;
        transpose_item_fp8(a.in[I_W2] + (size_t)mat * 512 * 2048, 512, 2048, (unsigned char*)(F.ws + WS_W2) + (size_t)mat * 512 * 2048, 32 * nb, scr, 64 * kb, 32 * nb, F.lane); }
}
#ifndef F8MASK
#define F8MASK 4
#endif
#define F8L(l) (((F8MASK) >> (l)) & 1)
#ifndef F8OMASK
#define F8OMASK 12
#endif
#define F8OL(l) (((F8OMASK) >> (l)) & 1)
#ifndef CDEPTH
#define CDEPTH 3
#endif
struct CDesc { const float* src; unsigned char* dst; int N, K, drow0, k0, n0, f8; };
__device__ __forceinline__ CDesc conv_desc(Frame& F, const Args& a, int q, int it) {
    CDesc d;
    if (q & 1) {
        const float* src; unsigned char* dst; int N, r = it, f8 = F8L((q + 1) >> 1);
        if (q == 1) { if (r < 3584) { N = 3584; src = a.in[I_AWIN] + (size_t)2048 * 3584; dst = F.ws + WS_WAIN + (size_t)2048 * 3584 * 2; } else { r -= 3584; N = 2048; f8 = 0; src = a.in[I_AWOUT] + (size_t)2048 * 2048; dst = F.ws + WS_WAOUT + (size_t)2048 * 2048 * 2; } }
        else if (q == 3) { if (r < 2048) { N = 2048; src = a.in[I_BWIN]; dst = F.ws + WS_WBIN0; } else if ((r -= 2048) < 3072) { N = 3072; src = a.in[I_WKV]; dst = F.ws + WS_WBIN0 + (size_t)2048 * 2048 * (F8L(2) ? 1 : 2); } else { r -= 3072; N = 2048; f8 = F8OL(2); src = a.in[I_BWOUT]; dst = F.ws + WS_WBOUT; } }
        else { if (r < 2048) { N = 2048; src = a.in[I_BWIN] + (size_t)2048 * 2048; dst = F.ws + WS_WBIN1; } else { r -= 2048; N = 2048; f8 = F8OL(3); src = a.in[I_BWOUT] + (size_t)2048 * 2048; dst = F.ws + WS_WBOUT + (size_t)2048 * 2048 * 2; } }
        const int nblk = N / 32, kb = r / nblk, nb = r - kb * nblk;
        d.src = src; d.dst = dst; d.N = N; d.K = 2048; d.drow0 = 32 * nb; d.k0 = 64 * kb; d.n0 = 32 * nb; d.f8 = f8; return d;
    }
    const int L = q >> 1, seg = it >> 14, r0 = it & 16383, e = r0 >> 9, r = r0 & 511, mat = L * 32 + e;
    if (seg < 2) { const int kb = r >> 4, nb = r & 15, n0 = 32 * nb;
        d.src = a.in[seg == 0 ? I_W1 : I_W3] + (size_t)mat * 2048 * 512; d.dst = (unsigned char*)(F.ws + WS_W13) + (size_t)mat * 1024 * 2048; d.N = 512; d.K = 2048;
        d.drow0 = (n0 >> 7) * 256 + (n0 & 127) + (seg == 1 ? 128 : 0); d.k0 = 64 * kb; d.n0 = n0; d.f8 = 1; }
    else { const int kb = r >> 6, nb = r & 63;
        d.src = a.in[I_W2] + (size_t)mat * 512 * 2048; d.dst = (unsigned char*)(F.ws + WS_W2) + (size_t)mat * 512 * 2048; d.N = 2048; d.K = 512; d.drow0 = 32 * nb; d.k0 = 64 * kb; d.n0 = 32 * nb; d.f8 = 1; }
    return d;
}
#define CV_LOAD(t_, d_) do { const float* p_ = (d_).src + (size_t)((d_).k0 + (F.lane >> 3)) * (d_).N + (d_).n0 + 4 * (F.lane & 7); const size_t st_ = (size_t)8 * (d_).N; \
    _Pragma("unroll") for (int i_ = 0; i_ < 8; ++i_) (t_)[i_] = *(const GAS f32x4*)(p_ + st_ * i_); } while (0)
__device__ __forceinline__ void conv_process(Frame& F, f32x4 (&t)[8], const CDesc& d) {
    LAS float* scr = (LAS float*)(F.lds + RING_OFF + F.wave * 16384); const int lane = F.lane;
    asm volatile("" : "+v"(t[0]), "+v"(t[1]), "+v"(t[2]), "+v"(t[3]), "+v"(t[4]), "+v"(t[5]), "+v"(t[6]), "+v"(t[7]));
    { LAS float* w = scr + (lane >> 3) * 33 + 4 * (lane & 7);
#pragma unroll
      for (int i = 0; i < 8; ++i) { w[i * 8 * 33 + 0] = t[i].x; w[i * 8 * 33 + 1] = t[i].y; w[i * 8 * 33 + 2] = t[i].z; w[i * 8 * 33 + 3] = t[i].w; } }
    LDS_WAIT(); asm volatile("" ::: "memory");
    const int c = lane & 7;
    if (d.f8) {
#pragma unroll
        for (int j = 0; j < 4; ++j) { const int n = (lane >> 3) + 8 * j; const LAS float* s = scr + (8 * c) * 33 + n;
            unsigned lo = 0u, hi = 0u;
            lo = __builtin_amdgcn_cvt_pk_fp8_f32(s[0 * 33] * 64.f, s[1 * 33] * 64.f, lo, false); lo = __builtin_amdgcn_cvt_pk_fp8_f32(s[2 * 33] * 64.f, s[3 * 33] * 64.f, lo, true);
            hi = __builtin_amdgcn_cvt_pk_fp8_f32(s[4 * 33] * 64.f, s[5 * 33] * 64.f, hi, false); hi = __builtin_amdgcn_cvt_pk_fp8_f32(s[6 * 33] * 64.f, s[7 * 33] * 64.f, hi, true);
            v2u o; o.x = lo; o.y = hi; *(GAS v2u*)(d.dst + (size_t)(d.drow0 + n) * d.K + d.k0 + 8 * c) = o; }
    } else {
#pragma unroll
        for (int j = 0; j < 4; ++j) { const int n = (lane >> 3) + 8 * j; const LAS float* s = scr + (8 * c) * 33 + n;
            v4u o; o.x = pk2(s[0 * 33], s[1 * 33]); o.y = pk2(s[2 * 33], s[3 * 33]); o.z = pk2(s[4 * 33], s[5 * 33]); o.w = pk2(s[6 * 33], s[7 * 33]);
            *(GAS v4u*)((bf16*)d.dst + (size_t)(d.drow0 + n) * d.K + d.k0 + 8 * c) = o; }
    }
    LDS_WAIT(); asm volatile("" ::: "memory");
}
__device__ __forceinline__ void conv_range(Frame& F, const Args& a, int q, int first, int cnt) {
#if CDEPTH == 1
    for (int i = 0; i < cnt; ++i) conv_item(F, a, q, first + i);
#else
    f32x4 t[CDEPTH][8]; const int last = first + cnt - 1;
#pragma unroll
    for (int s = 0; s < CDEPTH - 1; ++s) { const int it = first + s < last ? first + s : last; const CDesc d = conv_desc(F, a, q, it); CV_LOAD(t[s], d); }
#pragma unroll 1
    for (int i0 = 0; i0 < cnt; i0 += CDEPTH) {
#pragma unroll
        for (int s = 0; s < CDEPTH; ++s) {
            { const int nx = first + i0 + s + CDEPTH - 1, it = nx < last ? nx : last; const CDesc d = conv_desc(F, a, q, it); CV_LOAD(t[(s + CDEPTH - 1) % CDEPTH], d); }
            asm volatile("" ::: "memory");
            if (i0 + s < cnt) { const CDesc d = conv_desc(F, a, q, first + i0 + s); conv_process(F, t[s], d); }
        }
    }
#endif
}
__device__ __forceinline__ void conv_filler(Frame& F, const Args& a, int q0, int n) {
    if (q0 >= NQ || n == 0) return;
#ifdef CONV_ALL_PRO
    return;
#endif
    LAS unsigned* bw = (LAS unsigned*)(F.lds + TAB_OFF + 384);
    __syncthreads();
    const bool drain = n < 0; const int per = drain ? CDRAIN : n; int q = q0;
    for (;;) {
        if (F.tid == 0) bw[0] = __hip_atomic_fetch_add(F.ctl + CW_CONV + 64 * q, (unsigned)(8 * per), RLX_AGENT);
        __syncthreads();
        const unsigned idx = bw[0];
        __syncthreads();
        const int qs = conv_qsize(q);
        if (idx >= (unsigned)qs) { if (drain || ++q >= NQ) break; continue; }
        { const int first = (int)idx + F.wave * per, cnt = (qs - first < per) ? qs - first : per; if (cnt > 0) conv_range(F, a, q, first, cnt); }
        if (!drain) break;
    }
}

__device__ __forceinline__ void prologue_phase(Frame& F, const Args& a) {
#ifdef TOUCH
    {
        const long nthr_ = (long)F.G * 512, gt_ = (long)F.c * 512 + F.tid; unsigned acc_ = 0u;
        for (long pg = gt_; pg < (long)(WS_END / 4096); pg += nthr_) acc_ += *(const GAS unsigned*)(F.ws + pg * 4096);
        for (long pg = gt_; pg < (long)((size_t)DEPTH * NE * D * FF * 4 / 4096); pg += nthr_) { acc_ += *(const GAS unsigned*)((const char*)a.in[I_W1] + pg * 4096); acc_ += *(const GAS unsigned*)((const char*)a.in[I_W3] + pg * 4096); acc_ += *(const GAS unsigned*)((const char*)a.in[I_W2] + pg * 4096); }
        if (acc_ == 0x12345679u) F.ctl[CW_TMO] = acc_;
    }
#endif
    LAS float* scr = (LAS float*)(F.lds + RING_OFF + F.wave * 16384);
    const int gw = F.c * NWAVES + F.wave, NGW = F.G * NWAVES;
    unsigned char* ws = F.ws;
    constexpr int S0 = 3584, S1 = 2048, S5 = 4 * 1024;
    constexpr int NITEMS = S0 + S1 + S5;
    for (int it = gw; it < NITEMS; it += NGW) {
        int r = it; const float* src; unsigned char* dst; int K = 2048, N; bool f8 = F8L(0);
        if (r < S0) { N = 3584; src = a.in[I_AWIN]; dst = ws + WS_WAIN; }
        else if ((r -= S0) < S1) { N = 2048; f8 = false; src = a.in[I_AWOUT]; dst = ws + WS_WAOUT; }
        else { r -= S1; const int mat = r >> 10; r &= 1023; N = 1024; src = a.in[I_MEMWKV] + (size_t)mat * K * N; dst = ws + WS_WMKV + (size_t)mat * K * N * (F8L(0) ? 1 : 2); }
        const int nblk = N / 32, kb = r / nblk, nb = r - kb * nblk;
        if (f8) transpose_item_fp8(src, K, N, dst, 32 * nb, scr, 64 * kb, 32 * nb, F.lane);
        else transpose_item_fast(src, K, N, (bf16*)dst, 32 * nb, scr, 64 * kb, 32 * nb, F.lane);
    }
#ifdef CONV_ALL_PRO
    for (int q = 0; q < NQ; ++q) { const int qs = conv_qsize(q); for (int it = gw * 4; it < qs; it += NGW * 4) conv_range(F, a, q, it, qs - it < 4 ? qs - it : 4); }
#endif
    const long nthr = (long)F.G * 512, gt = (long)F.c * 512 + F.tid;
    { float* wr = (float*)(ws + WS_WR);
      for (long i = gt; i < (long)DEPTH * 3 * 512 * 16 * 4; i += nthr) { const int j = (int)(i & 3), c = (int)((i >> 2) & 15), kg = (int)((i >> 6) & 511), r = (int)(i >> 15), nb = r % 3, l = r / 3;
          const int k = 4 * kg + j, o = 16 * nb + c; float v = 0.f;
          if (o < 4) v = a.in[I_WG1][((size_t)l * D + k) * 4 + o]; else if (o < 36) { const int g = (o - 4) >> 3, e = (o - 4) & 7; v = a.in[I_WG2][(((size_t)l * 4 + g) * D + k) * 8 + e]; }
          wr[i] = v; } }
    { const float* x = a.in[I_X]; bf16* xb = (bf16*)(ws + WS_XB);
      for (long i = gt; i < (long)T * D / 8; i += nthr) { const f32x4 v0 = *(const GAS f32x4*)(x + i * 8), v1 = *(const GAS f32x4*)(x + i * 8 + 4);
          v4u o; o.x = pk2(v0.x, v0.y); o.y = pk2(v0.z, v0.w); o.z = pk2(v1.x, v1.y); o.w = pk2(v1.z, v1.w); *(GAS v4u*)(xb + i * 8) = o;
          unsigned lo = 0u, hi = 0u; lo = __builtin_amdgcn_cvt_pk_fp8_f32(v0.x, v0.y, lo, false); lo = __builtin_amdgcn_cvt_pk_fp8_f32(v0.z, v0.w, lo, true); hi = __builtin_amdgcn_cvt_pk_fp8_f32(v1.x, v1.y, hi, false); hi = __builtin_amdgcn_cvt_pk_fp8_f32(v1.z, v1.w, hi, true);
          v2u qq; qq.x = lo; qq.y = hi; *(GAS v2u*)(ws + WS_XQ + i * 8) = qq; } }
    { const float* x = a.in[I_MEM]; bf16* xb = (bf16*)(ws + WS_MEMB);
      for (long i = gt; i < (long)MEMT * D / 8; i += nthr) { const f32x4 v0 = *(const GAS f32x4*)(x + i * 8), v1 = *(const GAS f32x4*)(x + i * 8 + 4);
          v4u o; o.x = pk2(v0.x, v0.y); o.y = pk2(v0.z, v0.w); o.z = pk2(v1.x, v1.y); o.w = pk2(v1.z, v1.w); *(GAS v4u*)(xb + i * 8) = o;
          unsigned lo = 0u, hi = 0u; lo = __builtin_amdgcn_cvt_pk_fp8_f32(v0.x, v0.y, lo, false); lo = __builtin_amdgcn_cvt_pk_fp8_f32(v0.z, v0.w, lo, true); hi = __builtin_amdgcn_cvt_pk_fp8_f32(v1.x, v1.y, hi, false); hi = __builtin_amdgcn_cvt_pk_fp8_f32(v1.z, v1.w, hi, true);
          v2u qq; qq.x = lo; qq.y = hi; *(GAS v2u*)(ws + WS_MEMQ + i * 8) = qq; } }
}

#ifndef NCVMAX
#define NCVMAX 0
#endif
#ifndef NCVATT
#define NCVATT 96
#endif
__device__ __forceinline__ int conv_servers(int nu, int G, int fin) {
    if (fin || nu <= 0) return 0;
    const int rounds = (nu + G - 1) / G, gmin = (nu + rounds - 1) / rounds; int n = G - gmin; n = n < NCVMAX ? n : NCVMAX; return n & ~7;
}
__device__ __forceinline__ void conv_done(Frame& F, int p) { __syncthreads(); if (F.tid == 0) __hip_atomic_fetch_add(F.ctl + CW_DONE + 64 * p, 1u, RLX_AGENT); }
__device__ __forceinline__ void conv_server(Frame& F, const Args& a, int p, int q0, int ncomp) {
    int q = q0;
    for (;;) {
        if (q >= NQ) break;
        unsigned idx = 0xffffffffu;
        if (F.lane == 0) { if (__hip_atomic_load(F.ctl + CW_DONE + 64 * p, RLX_AGENT) < (unsigned)ncomp) idx = __hip_atomic_fetch_add(F.ctl + CW_CONV + 64 * q, (unsigned)CSRV, RLX_AGENT); }
        idx = (unsigned)__builtin_amdgcn_readfirstlane((int)idx);
        if (idx == 0xffffffffu) break;
        const int qs = conv_qsize(q);
        if (idx >= (unsigned)qs) { ++q; continue; }
        conv_range(F, a, q, (int)idx, (qs - (int)idx < CSRV) ? qs - (int)idx : CSRV);
    }
}
__device__ __forceinline__ void conv_server_q(Frame& F, const Args& a, gu32* head, unsigned stop_at, int q0) {
    int q = q0;
    for (;;) {
        if (q >= NQ) break;
        unsigned idx = 0xffffffffu;
        if (F.lane == 0) { if (__hip_atomic_load(head, RLX_AGENT) < stop_at) idx = __hip_atomic_fetch_add(F.ctl + CW_CONV + 64 * q, (unsigned)CSRVA, RLX_AGENT); }
        idx = (unsigned)__builtin_amdgcn_readfirstlane((int)idx);
        if (idx == 0xffffffffu) break;
        const int qs = conv_qsize(q);
        if (idx >= (unsigned)qs) { ++q; continue; }
        conv_range(F, a, q, (int)idx, (qs - (int)idx < CSRVA) ? qs - (int)idx : CSRVA);
    }
}
__device__ __forceinline__ void conv_note_fin(Frame& F, int p) {
    if (blockIdx.x == 0 && F.tid == 0) { unsigned all = 1u;
        for (int q = 0; q < NQ; ++q) all &= (__hip_atomic_load(F.ctl + CW_CONV + 64 * q, RLX_AGENT) >= (unsigned)conv_qsize(q)) ? 1u : 0u;
        __hip_atomic_store(F.ctl + CW_FIN + 64 * p, all, RLX_AGENT); }
}

__device__ __forceinline__ void sgu_unit(Frame& F, const Args& a, int l, int n, int g) {
    constexpr int LDW = 136;
    LAS float* stats = (LAS float*)(F.lds); LAS bf16* Wl = (LAS bf16*)(F.lds + 1024); LAS bf16* Vt = (LAS bf16*)(F.lds + 35840);
    const bf16* z = (const bf16*)(F.ws + WS_Z); bf16* cat = (bf16*)(F.ws + WS_CAT);
    const int tok0 = n * 128;
    for (int i = 0; i < 16; ++i) { const int tk = F.wave * 16 + i; const GAS v4u* rp = (const GAS v4u*)(z + (size_t)(tok0 + tk) * NINA + MIXW) + F.lane;
        v4u w[3]; float s = 0.f;
#pragma unroll
        for (int j = 0; j < 3; ++j) { w[j] = rp[64 * j]; s += (bflo(w[j].x) + bfhi(w[j].x)) + (bflo(w[j].y) + bfhi(w[j].y)) + (bflo(w[j].z) + bfhi(w[j].z)) + (bflo(w[j].w) + bfhi(w[j].w)); }
        const float mean = wave_sum(s) * (1.f / MIXW); float q = 0.f;
#pragma unroll
        for (int j = 0; j < 3; ++j) { float d;
            d = bflo(w[j].x) - mean; q += d * d; d = bfhi(w[j].x) - mean; q += d * d; d = bflo(w[j].y) - mean; q += d * d; d = bfhi(w[j].y) - mean; q += d * d;
            d = bflo(w[j].z) - mean; q += d * d; d = bfhi(w[j].z) - mean; q += d * d; d = bflo(w[j].w) - mean; q += d * d; d = bfhi(w[j].w) - mean; q += d * d; }
        const float rstd = 1.f / sqrtf(wave_sum(q) * (1.f / MIXW) + LN_EPS);
        if (F.lane == 0) { stats[2 * tk] = mean; stats[2 * tk + 1] = rstd; } }
    { const float* wsrc = a.in[I_AWS] + ((size_t)l * 4 + g) * 128 * 128;
      for (int p = F.tid; p < 128 * 32; p += 512) { const int i = p >> 5, j4 = (p & 31) * 4; f32x4 v = *(const GAS f32x4*)(wsrc + i * 128 + j4);
          if ((j4 >> 6) > (i >> 6)) v = (f32x4){0.f, 0.f, 0.f, 0.f};
          v2u o; o.x = pk2(v.x, v.y); o.y = pk2(v.z, v.w); *(LAS v2u*)(Wl + i * LDW + j4) = o; } }
    __syncthreads();
    { const float* lg = a.in[I_ALNG] + (size_t)l * MIXW + g * 384; const float* lb = a.in[I_ALNB] + (size_t)l * MIXW + g * 384;
      for (int p = F.tid; p < 128 * 48; p += 512) { const int j = p & 127, c8 = (p >> 7) * 8;
          const v4u w = *(const GAS v4u*)(z + (size_t)(tok0 + j) * NINA + MIXW + g * 384 + c8);
          const float mean = stats[2 * j], rstd = stats[2 * j + 1];
          const f32x4 g0 = *(const GAS f32x4*)(lg + c8), g1 = *(const GAS f32x4*)(lg + c8 + 4), b0 = *(const GAS f32x4*)(lb + c8), b1 = *(const GAS f32x4*)(lb + c8 + 4);
          float v[8] = {bflo(w.x), bfhi(w.x), bflo(w.y), bfhi(w.y), bflo(w.z), bfhi(w.z), bflo(w.w), bfhi(w.w)};
          const float gg[8] = {g0.x, g0.y, g0.z, g0.w, g1.x, g1.y, g1.z, g1.w}, bb[8] = {b0.x, b0.y, b0.z, b0.w, b1.x, b1.y, b1.z, b1.w};
#pragma unroll
          for (int e = 0; e < 8; ++e) Vt[(c8 + e) * LDW + j] = (bf16)f2bf((v[e] - mean) * rstd * gg[e] + bb[e]); } }
    __syncthreads();
    const int fr = F.lane & 15, fq = F.lane >> 4;
    f32x4 acc[8][3];
#pragma unroll
    for (int mb = 0; mb < 8; ++mb)
#pragma unroll
        for (int nb = 0; nb < 3; ++nb) acc[mb][nb] = (f32x4){0.f, 0.f, 0.f, 0.f};
#pragma unroll
    for (int ks = 0; ks < 4; ++ks) { bf16x8 bfr[3];
#pragma unroll
        for (int nb = 0; nb < 3; ++nb) bfr[nb] = *(const LAS bf16x8*)(Vt + (F.wave * 48 + nb * 16 + fr) * LDW + ks * 32 + fq * 8);
#pragma unroll
        for (int mb = 0; mb < 8; ++mb) { const bf16x8 afr = *(const LAS bf16x8*)(Wl + (mb * 16 + fr) * LDW + ks * 32 + fq * 8);
#pragma unroll
            for (int nb = 0; nb < 3; ++nb) acc[mb][nb] = __builtin_amdgcn_mfma_f32_16x16x32_bf16(bfr[nb], afr, acc[mb][nb], 0, 0, 0); } }
    const float* bs = a.in[I_ABS] + ((size_t)l * 4 + g) * 128;
#pragma unroll
    for (int mb = 0; mb < 8; ++mb) { const int i = mb * 16 + fr; const float bsv = bs[i]; const size_t tk = (size_t)(tok0 + i);
#pragma unroll
        for (int nb = 0; nb < 3; ++nb) { const int c = g * 384 + F.wave * 48 + nb * 16 + 4 * fq;
            const v2u uw = *(const GAS v2u*)(z + tk * NINA + c); const f32x4 gt = acc[mb][nb] + bsv;
            v2u o; o.x = pk2(bflo(uw.x) * gt.x, bfhi(uw.x) * gt.y); o.y = pk2(bflo(uw.y) * gt.z, bfhi(uw.y) * gt.w);
            *(GAS v2u*)(cat + tk * D + c) = o; } }
    __syncthreads();
}

__device__ __forceinline__ void memattn_unit(Frame& F, int l, int hm, int qb, int ldz, int qoff) {
    const bf16* z = (const bf16*)(F.ws + WS_Z); const bf16* kv = (const bf16*)(F.ws + WS_MEMKV) + (size_t)l * 256 * 1024; bf16* cat = (bf16*)(F.ws + WS_CAT);
    att::attn_body<0>(z + (size_t)qb * 256 * ldz + qoff + hm * 128, ldz, kv + hm * 128, kv + 512 + hm * 128, 1024,
                      cat + (size_t)qb * 256 * D + MIXW + hm * 128, nullptr, D, 4, 0, nullptr, 0.f, F.ldsg);
}

__device__ __forceinline__ int t5_bucket(int rel) {
    const int a = rel < 0 ? -rel : rel; int f;
    if (a < 8) f = a; else if (a < 12) f = 8; else if (a < 16) f = 9; else if (a < 23) f = 10; else if (a < 32) f = 11; else if (a < 46) f = 12; else if (a < 64) f = 13; else if (a < 91) f = 14; else f = 15;
    return (rel > 0 ? 16 : 0) + f;
}

namespace att2 {
using att::bf16x8; using att::s16x4; using att::f32x16; using att::u32x4; using att::crow; using att::cvtpk; using att::tr_read; using att::v_rd_base;
constexpr int KT = 32, ST_K = KT * 128 * 2, ST_V = KT * 256 * 2, STAGE = 2 * ST_K + ST_V, NST = 3;
constexpr int LDS_WS = NST * STAGE, LDS_TAB = LDS_WS + 2048, LDS_UNIT = LDS_TAB + 640, LDS_END = LDS_UNIT + 16;
constexpr int NUNITS = 576;
constexpr float THR2 = 8.f * 1.4426950408889634f;
__device__ __forceinline__ int swap23(int k) { return (k & ~0xC) | ((k & 4) << 1) | ((k & 8) >> 1); }
constexpr int v_off(int d0, int ks, int half) { return d0 * 512 + ks * 8192 + half * 4096; }

struct UnitTable { unsigned short u[NUNITS]; };
constexpr UnitTable make_units() {
    UnitTable t{}; int n = 0;
    for (int c = 256; c >= 4; c -= 2) {
        { const int b = (c - 2) / 2; if ((c - 2) % 2 == 0 && b >= 32 && b <= 63) for (int part = 1; part <= 2; ++part) for (int h = 0; h < 6; ++h) t.u[n++] = (unsigned short)(h | (b << 3) | (part << 9)); }
        if (c % 4 == 0) { const int b = c / 4 - 1; if (b >= 0 && b < 32) for (int h = 0; h < 6; ++h) t.u[n++] = (unsigned short)(h | (b << 3)); }
    }
    return t;
}
__device__ const UnitTable g_units = make_units();

__device__ __forceinline__ void diff_unit(const bf16* __restrict__ Q, const bf16* __restrict__ KD, const bf16* __restrict__ VD, float* Obuf  , int orow0,
                                          float* ML  , const float* relb, int h, int b, int t_lo, int t_hi, LAS char* lds) {
  int tid_ = threadIdx.x; asm volatile("" : "+v"(tid_));
  const int tid = tid_, wid = __builtin_amdgcn_readfirstlane(tid >> 6), lane = tid & 63, r32 = lane & 31, hi = lane >> 5, m = wid >> 2, rg = wid & 3;
  LAS float* wsw = (LAS float*)(lds + LDS_WS) + wid * 64; LAS float* li_l = wsw; LAS float* al_l = wsw + 32;
  LAS float* tab = (LAS float*)(lds + LDS_TAB);
  if (tid < att::TAB_N) tab[tid] = relb[t5_bucket(63 - tid) * 6 + h] * LOG2E;
  const float cfar = relb[15 * 6 + h] * LOG2E;
  const int qrow0 = b * 128 + rg * 32;
  bf16x8 qr[8];
  { const bf16* Qw = Q + (size_t)(qrow0 + r32) * 2048 + h * 256 + m * 128 + hi * 8;
#pragma unroll
    for (int d0 = 0; d0 < 8; ++d0) qr[d0] = *reinterpret_cast<const bf16x8*>(Qw + d0 * 16); }
  int ko[2], vo[2];
#pragma unroll
  for (int i = 0; i < 2; ++i) {
    const int p = wid * 64 + lane, row = p >> 4, cp = (p & 15) ^ (row & 7); ko[i] = row * 1536 + h * 256 + i * 128 + cp * 8; }
#pragma unroll
  for (int i = 0; i < 2; ++i) {
    const int p = (wid * 2 + i) * 64 + lane, sub = p >> 5, kg = sub >> 3, cblk = sub & 7, q = p & 31, kk = kg * 8 + (q >> 2), key = swap23(kk);
    vo[i] = key * 1536 + h * 256 + cblk * 32 + (q & 3) * 8; }
  const unsigned ldsb = (unsigned)(uintptr_t)lds;
#define A2_ISSUE(t, s) do { const size_t kb_ = (size_t)(t) * KT * 1536; LAS char* sb_ = lds + (s) * STAGE; \
    __builtin_amdgcn_global_load_lds((const unsigned*)(KD + kb_ + ko[0]), (LAS unsigned*)(sb_ + wid * 1024), 16, 0, 0); \
    __builtin_amdgcn_global_load_lds((const unsigned*)(KD + kb_ + ko[1]), (LAS unsigned*)(sb_ + ST_K + wid * 1024), 16, 0, 0); \
    __builtin_amdgcn_global_load_lds((const unsigned*)(VD + kb_ + vo[0]), (LAS unsigned*)(sb_ + 2 * ST_K + (wid * 2) * 1024), 16, 0, 0); \
    __builtin_amdgcn_global_load_lds((const unsigned*)(VD + kb_ + vo[1]), (LAS unsigned*)(sb_ + 2 * ST_K + (wid * 2 + 1) * 1024), 16, 0, 0); } while (0)
  const int vis = 2 * (2 * b + (rg >> 1) + 1);
  float m_reg = -1e30f, l_reg = 0.f; f32x16 o[8];
#pragma unroll
  for (int d = 0; d < 8; ++d) o[d] = f32x16{};
  asm volatile("s_waitcnt vmcnt(0)" ::: "memory");
  A2_ISSUE(t_lo, 0); if (t_lo + 1 < t_hi) A2_ISSUE(t_lo + 1, 1);
  int s = 0;
  for (int t = t_lo; t < t_hi; ++t) {
    if (t + 1 < t_hi) asm volatile("s_waitcnt vmcnt(4) lgkmcnt(0)" ::: "memory"); else asm volatile("s_waitcnt vmcnt(0) lgkmcnt(0)" ::: "memory");
    __builtin_amdgcn_s_barrier(); asm volatile("" ::: "memory");
    if (t + 2 < t_hi) { const int s2 = (s >= 1) ? s - 1 : s + 2; A2_ISSUE(t + 2, s2); }
    if (t < vis) {
      const LAS char* Ks = lds + s * STAGE + m * ST_K;
      f32x16 p = f32x16{};
#pragma unroll
      for (int d0 = 0; d0 < 8; ++d0) { const int cb = (d0 * 16 + hi * 8) * 2;
        const bf16x8 b0 = *(const LAS bf16x8*)(Ks + KSWZ(r32, cb));
        p = __builtin_amdgcn_mfma_f32_32x32x16_bf16(b0, qr[d0], p, 0, 0, 0); }
      if (qrow0 - (KT * t + KT - 1) >= 91) {
#pragma unroll
        for (int r = 0; r < 16; ++r) p[r] += cfar;
      } else { const int base = qrow0 + r32 - KT * t + 63;
#pragma unroll
        for (int r = 0; r < 16; ++r) { const int i0 = base - crow(r, hi); p[r] += tab[i0 < att::TAB_N - 1 ? i0 : att::TAB_N - 1]; } }
      float pmax = p[0];
#pragma unroll
      for (int r = 1; r < 16; ++r) pmax = fmaxf(pmax, p[r]);
      { auto rr = __builtin_amdgcn_permlane32_swap(__float_as_uint(pmax), __float_as_uint(pmax), false, false); pmax = fmaxf(__uint_as_float(rr[0]), __uint_as_float(rr[1])); }
      float mn, alpha;
      if (__builtin_expect(__all(pmax - m_reg <= THR2), 1)) { mn = m_reg; alpha = 1.f; }
      else { mn = fmaxf(m_reg, pmax); alpha = __builtin_amdgcn_exp2f(m_reg - mn); m_reg = mn; }
      float ps = 0.f;
#pragma unroll
      for (int r = 0; r < 16; ++r) { p[r] = __builtin_amdgcn_exp2f(p[r] - mn); ps += p[r]; }
      { auto rr = __builtin_amdgcn_permlane32_swap(__float_as_uint(ps), __float_as_uint(ps), false, false); ps = __uint_as_float(rr[0]) + __uint_as_float(rr[1]); }
      l_reg = l_reg * alpha + ps;
      bf16x8 pa0, pa1;
#define A2_PK4(P, BASE, OUT) do { unsigned a0 = cvtpk(P[BASE + 0], P[BASE + 1]), a1 = cvtpk(P[BASE + 2], P[BASE + 3]);   \
    unsigned b0_ = cvtpk(P[BASE + 4], P[BASE + 5]), b1_ = cvtpk(P[BASE + 6], P[BASE + 7]);                              \
    auto r0 = __builtin_amdgcn_permlane32_swap(a0, b0_, false, false); auto r1 = __builtin_amdgcn_permlane32_swap(a1, b1_, false, false); \
    u32x4 w = {r0[0], r1[0], r0[1], r1[1]}; OUT = *reinterpret_cast<bf16x8*>(&w); } while (0)
      A2_PK4(p, 0, pa0); A2_PK4(p, 8, pa1);
      if (__any(alpha < 1.f)) { if (hi == 0) al_l[r32] = alpha; asm volatile("s_waitcnt lgkmcnt(0)" ::: "memory");
#pragma unroll
        for (int d = 0; d < 8; ++d)
#pragma unroll
          for (int r = 0; r < 16; ++r) o[d][r] *= al_l[crow(r, hi)]; }
      const int vb = (int)(ldsb + s * STAGE + 2 * ST_K) + v_rd_base(lane);
      asm volatile("s_waitcnt lgkmcnt(0)" ::: "memory"); SBAR();
#define A2_PK(L, H) (bf16x8){L[0], L[1], L[2], L[3], H[0], H[1], H[2], H[3]}
#define A2_RD(D0, l0, h0, l1, h1) do { l0 = tr_read<v_off(D0, 0, 0)>(vb); h0 = tr_read<v_off(D0, 0, 1)>(vb); l1 = tr_read<v_off(D0, 1, 0)>(vb); h1 = tr_read<v_off(D0, 1, 1)>(vb); } while (0)
#define A2_MM(D0, l0, h0, l1, h1) do { o[D0] = __builtin_amdgcn_mfma_f32_32x32x16_bf16(pa0, A2_PK(l0, h0), o[D0], 0, 0, 0); o[D0] = __builtin_amdgcn_mfma_f32_32x32x16_bf16(pa1, A2_PK(l1, h1), o[D0], 0, 0, 0); } while (0)
      s16x4 xl0, xh0, xl1, xh1, yl0, yh0, yl1, yh1;
      A2_RD(0, xl0, xh0, xl1, xh1);
      A2_RD(1, yl0, yh0, yl1, yh1); asm volatile("s_waitcnt lgkmcnt(4)" ::: "memory"); SBAR(); A2_MM(0, xl0, xh0, xl1, xh1); SBAR();
      A2_RD(2, xl0, xh0, xl1, xh1); asm volatile("s_waitcnt lgkmcnt(4)" ::: "memory"); SBAR(); A2_MM(1, yl0, yh0, yl1, yh1); SBAR();
      A2_RD(3, yl0, yh0, yl1, yh1); asm volatile("s_waitcnt lgkmcnt(4)" ::: "memory"); SBAR(); A2_MM(2, xl0, xh0, xl1, xh1); SBAR();
      A2_RD(4, xl0, xh0, xl1, xh1); asm volatile("s_waitcnt lgkmcnt(4)" ::: "memory"); SBAR(); A2_MM(3, yl0, yh0, yl1, yh1); SBAR();
      A2_RD(5, yl0, yh0, yl1, yh1); asm volatile("s_waitcnt lgkmcnt(4)" ::: "memory"); SBAR(); A2_MM(4, xl0, xh0, xl1, xh1); SBAR();
      A2_RD(6, xl0, xh0, xl1, xh1); asm volatile("s_waitcnt lgkmcnt(4)" ::: "memory"); SBAR(); A2_MM(5, yl0, yh0, yl1, yh1); SBAR();
      A2_RD(7, yl0, yh0, yl1, yh1); asm volatile("s_waitcnt lgkmcnt(4)" ::: "memory"); SBAR(); A2_MM(6, xl0, xh0, xl1, xh1); SBAR();
      asm volatile("s_waitcnt lgkmcnt(0)" ::: "memory"); SBAR(); A2_MM(7, yl0, yh0, yl1, yh1); SBAR();
    }
    s = (s == 2) ? 0 : s + 1;
  }
  if (hi == 0) li_l[r32] = l_reg; asm volatile("s_waitcnt lgkmcnt(0)" ::: "memory");
  float rli[16];
#pragma unroll
  for (int r = 0; r < 16; ++r) rli[r] = __builtin_amdgcn_rcpf(li_l[crow(r, hi)]);
  float* Ow = Obuf + (size_t)(qrow0 - orow0) * 3072 + (h * 2 + m) * 256;
#pragma unroll
  for (int r = 0; r < 16; ++r) { const int orow = crow(r, hi);
#pragma unroll
    for (int d0 = 0; d0 < 8; ++d0) Ow[(size_t)orow * 3072 + d0 * 32 + r32] = o[d0][r] * rli[r]; }
  if (hi == 0) { float* mlp = ML + (((size_t)(qrow0 - orow0 + r32) * 6 + h) * 2 + m) * 2; mlp[0] = m_reg; mlp[1] = l_reg; }
  asm volatile("s_waitcnt vmcnt(0) lgkmcnt(0)" ::: "memory");
  __builtin_amdgcn_s_barrier(); asm volatile("" ::: "memory");
#undef A2_ISSUE
#undef A2_PK4
#undef A2_PK
#undef A2_RD
#undef A2_MM
}
}

namespace att3 {
using att::f32x16; using att::crow;
typedef int v8i __attribute__((ext_vector_type(8))); typedef int v4i __attribute__((ext_vector_type(4)));
constexpr int KT = 64, ST_K = KT * 128, ST_V = 256 * 64, STAGE = 2 * ST_K + ST_V, NST = 3;
static_assert(NST * STAGE == att2::LDS_WS, "same ring size as att2");
constexpr float THR2 = 2.f;
__device__ __forceinline__ v8i cat8(v4i a, v4i b) { return __builtin_shufflevector(a, b, 0, 1, 2, 3, 4, 5, 6, 7); }
__device__ __forceinline__ void diff_unit(const unsigned char* __restrict__ Q8, const unsigned char* __restrict__ K8, const unsigned char* __restrict__ VT, float* Obuf, int orow0,
                                          float* ML, const float* relb, int h, int b, int t_lo, int t_hi, LAS char* lds) {
  int tid_ = threadIdx.x; asm volatile("" : "+v"(tid_));
  const int tid = tid_, wid = __builtin_amdgcn_readfirstlane(tid >> 6), lane = tid & 63, r32 = lane & 31, hi = lane >> 5, m = wid >> 2, rg = wid & 3;
  LAS float* wsw = (LAS float*)(lds + att2::LDS_WS) + wid * 64; LAS float* li_l = wsw; LAS float* al_l = wsw + 32;
  LAS float* tab = (LAS float*)(lds + att2::LDS_TAB);
  if (tid < att::TAB_N) tab[tid] = relb[t5_bucket(63 - tid) * 6 + h] * LOG2E;
  const float cfar = relb[15 * 6 + h] * LOG2E;
  const int qrow0 = b * 128 + rg * 32;
  v8i q8[2];
  { const unsigned char* Qw = Q8 + (size_t)(qrow0 + r32) * 2048 + h * 256 + m * 128 + hi * 32;
#pragma unroll
    for (int c = 0; c < 2; ++c) q8[c] = cat8(*(const GAS v4i*)(Qw + 64 * c), *(const GAS v4i*)(Qw + 64 * c + 16)); }
  int ko, vo[2];
  { const int p = wid * 64 + lane, row = p >> 3, cp = (p & 7) ^ (row & 7); ko = row * 1536 + h * 256 + cp * 16; }
#pragma unroll
  for (int i = 0; i < 2; ++i) { const int p = (wid * 2 + i) * 64 + lane, d = p >> 2, cp = (p & 3) ^ ((d >> 1) & 3); vo[i] = d * 64 + cp * 16; }
  const unsigned char* VTh = VT + (size_t)h * 128 * 16384;
#define A3_ISSUE(t, s) do { const size_t kb_ = (size_t)(t) * KT * 1536; LAS char* sb_ = lds + (s) * STAGE; \
    __builtin_amdgcn_global_load_lds((const unsigned*)(K8 + kb_ + ko), (LAS unsigned*)(sb_ + wid * 1024), 16, 0, 0); \
    __builtin_amdgcn_global_load_lds((const unsigned*)(K8 + kb_ + ko + 128), (LAS unsigned*)(sb_ + ST_K + wid * 1024), 16, 0, 0); \
    __builtin_amdgcn_global_load_lds((const unsigned*)(VTh + (size_t)(t) * 16384 + vo[0]), (LAS unsigned*)(sb_ + 2 * ST_K + (wid * 2) * 1024), 16, 0, 0); \
    __builtin_amdgcn_global_load_lds((const unsigned*)(VTh + (size_t)(t) * 16384 + vo[1]), (LAS unsigned*)(sb_ + 2 * ST_K + (wid * 2 + 1) * 1024), 16, 0, 0); } while (0)
  const int vis = 2 * b + (rg >> 1) + 1;
  float m_reg = -1e30f, l_reg = 0.f; f32x16 o[8];
#pragma unroll
  for (int d = 0; d < 8; ++d) o[d] = f32x16{};
  const int kx = (r32 & 7), koff0 = r32 * 128 + (((2 * hi) ^ kx) << 4), koff1 = r32 * 128 + (((2 * hi + 1) ^ kx) << 4);
  const int vx = (r32 >> 1) & 3, voff0 = r32 * 64 + (((2 * hi) ^ vx) << 4), voff1 = r32 * 64 + (((2 * hi + 1) ^ vx) << 4);
  int sclP = 121, scl1 = 127; asm volatile("" : "+v"(sclP), "+v"(scl1));
  asm volatile("s_waitcnt vmcnt(0)" ::: "memory");
  A3_ISSUE(t_lo, 0); if (t_lo + 1 < t_hi) A3_ISSUE(t_lo + 1, 1);
  int s = 0;
  for (int t = t_lo; t < t_hi; ++t) {
    if (t + 1 < t_hi) asm volatile("s_waitcnt vmcnt(4) lgkmcnt(0)" ::: "memory"); else asm volatile("s_waitcnt vmcnt(0) lgkmcnt(0)" ::: "memory");
    __builtin_amdgcn_s_barrier(); asm volatile("" ::: "memory");
    if (t + 2 < t_hi) { const int s2 = (s >= 1) ? s - 1 : s + 2; A3_ISSUE(t + 2, s2); }
    if (t < vis) {
      const LAS char* Ks = lds + s * STAGE + m * ST_K;
      f32x16 p0 = f32x16{}, p1 = f32x16{};
#pragma unroll
      for (int c = 0; c < 2; ++c) {
        const int x0 = koff0 ^ (c << 6), x1 = koff1 ^ (c << 6);
        const v8i k0 = cat8(*(const LAS v4i*)(Ks + x0), *(const LAS v4i*)(Ks + x1));
        const v8i k1 = cat8(*(const LAS v4i*)(Ks + 4096 + x0), *(const LAS v4i*)(Ks + 4096 + x1));
        asm volatile("v_mfma_scale_f32_32x32x64_f8f6f4 %0, %1, %2, %0, %3, %3 op_sel_hi:[0,0,0]" : "+v"(p0) : "v"(k0), "v"(q8[c]), "v"(scl1));
        asm volatile("v_mfma_scale_f32_32x32x64_f8f6f4 %0, %1, %2, %0, %3, %3 op_sel_hi:[0,0,0]" : "+v"(p1) : "v"(k1), "v"(q8[c]), "v"(scl1)); }
      asm volatile("s_nop 15\n s_nop 7" : "+v"(p0), "+v"(p1));
      if (qrow0 - (KT * t + KT - 1) >= 91) {
#pragma unroll
        for (int r = 0; r < 16; ++r) { p0[r] += cfar; p1[r] += cfar; }
      } else { const int base = qrow0 + r32 - KT * t + 63;
#pragma unroll
        for (int r = 0; r < 16; ++r) { const int i0 = base - crow(r, hi), i1 = i0 - 32; p0[r] += tab[i0 < att::TAB_N - 1 ? i0 : att::TAB_N - 1]; p1[r] += tab[i1 < att::TAB_N - 1 ? i1 : att::TAB_N - 1]; } }
      float pmax = fmaxf(p0[0], p1[0]);
#pragma unroll
      for (int r = 1; r < 16; ++r) pmax = fmaxf(pmax, fmaxf(p0[r], p1[r]));
      { auto rr = __builtin_amdgcn_permlane32_swap(__float_as_uint(pmax), __float_as_uint(pmax), false, false); pmax = fmaxf(__uint_as_float(rr[0]), __uint_as_float(rr[1])); }
      float mn, alpha;
      if (__builtin_expect(__all(pmax - m_reg <= THR2), 1)) { mn = m_reg; alpha = 1.f; }
      else { mn = fmaxf(m_reg, pmax); alpha = __builtin_amdgcn_exp2f(m_reg - mn); m_reg = mn; }
      const float mn6 = mn - 6.f; float ps = 0.f;
#pragma unroll
      for (int r = 0; r < 16; ++r) { p0[r] = __builtin_amdgcn_exp2f(p0[r] - mn6); p1[r] = __builtin_amdgcn_exp2f(p1[r] - mn6); ps += p0[r] + p1[r]; }
      { auto rr = __builtin_amdgcn_permlane32_swap(__float_as_uint(ps), __float_as_uint(ps), false, false); ps = __uint_as_float(rr[0]) + __uint_as_float(rr[1]); }
      l_reg = l_reg * alpha + ps;
      v8i pa;
#pragma unroll
      for (int g = 0; g < 4; ++g) { unsigned x = 0u, y = 0u;
        x = __builtin_amdgcn_cvt_pk_fp8_f32(p0[4 * g], p0[4 * g + 1], x, false); x = __builtin_amdgcn_cvt_pk_fp8_f32(p0[4 * g + 2], p0[4 * g + 3], x, true);
        y = __builtin_amdgcn_cvt_pk_fp8_f32(p1[4 * g], p1[4 * g + 1], y, false); y = __builtin_amdgcn_cvt_pk_fp8_f32(p1[4 * g + 2], p1[4 * g + 3], y, true);
        auto rr = __builtin_amdgcn_permlane32_swap(x, y, false, false); pa[2 * g] = (int)rr[0]; pa[2 * g + 1] = (int)rr[1]; }
      if (__any(alpha < 1.f)) { if (hi == 0) al_l[r32] = alpha; asm volatile("s_waitcnt lgkmcnt(0)" ::: "memory");
#pragma unroll
        for (int d = 0; d < 8; ++d)
#pragma unroll
          for (int r = 0; r < 16; ++r) o[d][r] *= al_l[crow(r, hi)]; }
      const LAS char* Vs = lds + s * STAGE + 2 * ST_K;
#define A3_RD(D0, V) do { V = cat8(*(const LAS v4i*)(Vs + (D0) * 2048 + voff0), *(const LAS v4i*)(Vs + (D0) * 2048 + voff1)); } while (0)
#define A3_MM(D0, V) asm volatile("v_mfma_scale_f32_32x32x64_f8f6f4 %0, %1, %2, %0, %3, %4 op_sel_hi:[0,0,0]" : "+v"(o[D0]) : "v"(pa), "v"(V), "v"(sclP), "v"(scl1))
      v8i va, vb;
      A3_RD(0, va);
      A3_RD(1, vb); A3_MM(0, va);
      A3_RD(2, va); A3_MM(1, vb);
      A3_RD(3, vb); A3_MM(2, va);
      A3_RD(4, va); A3_MM(3, vb);
      A3_RD(5, vb); A3_MM(4, va);
      A3_RD(6, va); A3_MM(5, vb);
      A3_RD(7, vb); A3_MM(6, va);
      A3_MM(7, vb);
    }
    s = (s == 2) ? 0 : s + 1;
  }
  asm volatile("s_nop 15\n s_nop 15" ::: "memory");
  if (hi == 0) li_l[r32] = l_reg; asm volatile("s_waitcnt lgkmcnt(0)" ::: "memory");
  float rli[16];
#pragma unroll
  for (int r = 0; r < 16; ++r) rli[r] = 64.f * __builtin_amdgcn_rcpf(li_l[crow(r, hi)]);
  float* Ow = Obuf + (size_t)(qrow0 - orow0) * 3072 + (h * 2 + m) * 256;
#pragma unroll
  for (int r = 0; r < 16; ++r) { const int orow = crow(r, hi);
#pragma unroll
    for (int d0 = 0; d0 < 8; ++d0) Ow[(size_t)orow * 3072 + d0 * 32 + r32] = o[d0][r] * rli[r]; }
  if (hi == 0) { float* mlp = ML + (((size_t)(qrow0 - orow0 + r32) * 6 + h) * 2 + m) * 2; mlp[0] = m_reg; mlp[1] = l_reg * (1.f / 64.f); }
  asm volatile("s_waitcnt vmcnt(0) lgkmcnt(0)" ::: "memory");
  __builtin_amdgcn_s_barrier(); asm volatile("" ::: "memory");
#undef A3_ISSUE
#undef A3_RD
#undef A3_MM
}
}

__device__ __forceinline__ void diffattn2_unit(Frame& F, const Args& a, unsigned code) {
    const int h = code & 7, b = (code >> 3) & 63, pc = code >> 9;
    float* ob = (float*)(F.ws + (pc == 2 ? WS_OP2 : WS_OP)); float* ml = (float*)(F.ws + WS_ML) + (pc == 2 ? (size_t)T * 6 * 2 * 2 : 0);
#ifdef ATT_BF16
    const int nt = 4 * b + 4, t_lo = (pc == 2) ? nt / 2 : 0, t_hi = (pc == 1) ? nt / 2 : nt;
    att2::diff_unit((const bf16*)(F.ws + WS_Z), (const bf16*)(F.ws + WS_KD), (const bf16*)(F.ws + WS_VD), ob, pc == 2 ? 4096 : 0, ml, a.in[I_RELB], h, b, t_lo, t_hi, (LAS char*)F.lds);
#else
    const int nt = 2 * b + 2, t_lo = (pc == 2) ? nt / 2 : 0, t_hi = (pc == 1) ? nt / 2 : nt;
    att3::diff_unit(F.ws + WS_ZQ, F.ws + WS_KD, F.ws + WS_VD, ob, pc == 2 ? 4096 : 0, ml, a.in[I_RELB], h, b, t_lo, t_hi, (LAS char*)F.lds);
#endif
}
__device__ __forceinline__ void diffcombine_phase(Frame& F, const Args& a, int l) {
    const int i = l - 2; const float* lp = a.in[I_BLAM] + (size_t)i * 4 * 128;
    float s1 = lp[F.lane] * lp[128 + F.lane] + lp[64 + F.lane] * lp[128 + 64 + F.lane], s2 = lp[256 + F.lane] * lp[384 + F.lane] + lp[256 + 64 + F.lane] * lp[384 + 64 + F.lane];
    s1 = wave_sum(s1); s2 = wave_sum(s2);
    const float lam_init = 0.8f - 0.6f * expf(-0.3f * (float)l);
    const float lam = expf(s1) - expf(s2) + lam_init;
    const float* op0 = (const float*)(F.ws + WS_OP); const float* op1 = (const float*)(F.ws + WS_OP2); const float* ml0 = (const float*)(F.ws + WS_ML); const float* ml1 = ml0 + (size_t)T * 6 * 2 * 2;
    bf16* cat = (bf16*)(F.ws + WS_CAT);
    const f32x4 gsub = *(const GAS f32x4*)(a.in[I_BSUBG] + (size_t)i * 256 + 4 * F.lane);
    const int gw = F.c * NWAVES + F.wave, NGW = F.G * NWAVES;
    for (int it = gw; it < T * 6; it += NGW) { const int tk = it / 6, h = it - tk * 6; f32x4 os[2];
#pragma unroll
        for (int m = 0; m < 2; ++m) { const size_t r0 = ((size_t)tk * 6 + h) * 2 + m; f32x4 oa = *(const GAS f32x4*)(op0 + r0 * 256 + 4 * F.lane);
            if (tk >= 4096) { const size_t r1 = ((size_t)(tk - 4096) * 6 + h) * 2 + m; const f32x4 ob = *(const GAS f32x4*)(op1 + r1 * 256 + 4 * F.lane);
                const float ma = ml0[r0 * 2], la = ml0[r0 * 2 + 1], mb = ml1[r1 * 2], lb = ml1[r1 * 2 + 1], M = fmaxf(ma, mb);
                const float wa = la * exp2f(ma - M), wb = lb * exp2f(mb - M), inv = 1.f / (wa + wb); oa = oa * (wa * inv) + ob * (wb * inv); }
            os[m] = oa; }
        const f32x4 o = os[0] - os[1] * lam; const float ss = wave_sum((o.x * o.x + o.y * o.y) + (o.z * o.z + o.w * o.w));
        const float r = (1.f - lam_init) / sqrtf(ss * (1.f / 256.f) + LN_EPS);
        v2u w; w.x = pk2(o.x * r * gsub.x, o.y * r * gsub.y); w.y = pk2(o.z * r * gsub.z, o.w * r * gsub.w);
        *(GAS v2u*)(cat + (size_t)tk * D + h * 256 + 4 * F.lane) = w;
        { unsigned q8 = 0u; q8 = __builtin_amdgcn_cvt_pk_fp8_f32(o.x * r * gsub.x, o.y * r * gsub.y, q8, false); q8 = __builtin_amdgcn_cvt_pk_fp8_f32(o.z * r * gsub.z, o.w * r * gsub.w, q8, true);
          *(GAS unsigned*)(F.ws + WS_CATQ + (size_t)tk * D + h * 256 + 4 * F.lane) = q8; } }
    { const long nthr = (long)F.G * 512, gt = (long)F.c * 512 + F.tid;
      for (long i2 = gt; i2 < (long)T * 64; i2 += nthr) { const long tk = i2 >> 6; const int c8 = (int)(i2 & 63) * 8; const v4u w = *(const GAS v4u*)(cat + tk * D + MIXW + c8);
          unsigned lo = 0u, hi = 0u; lo = __builtin_amdgcn_cvt_pk_fp8_f32(bflo(w.x), bfhi(w.x), lo, false); lo = __builtin_amdgcn_cvt_pk_fp8_f32(bflo(w.y), bfhi(w.y), lo, true);
          hi = __builtin_amdgcn_cvt_pk_fp8_f32(bflo(w.z), bfhi(w.z), hi, false); hi = __builtin_amdgcn_cvt_pk_fp8_f32(bflo(w.w), bfhi(w.w), hi, true);
          v2u qq; qq.x = lo; qq.y = hi; *(GAS v2u*)(F.ws + WS_CATQ + tk * D + MIXW + c8) = qq; } }
}


__device__ __forceinline__ void ln1_router_phase(Frame& F, const Args& a, int l, int probe = 0) {
    const bf16* y = (const bf16*)(F.ws + WS_Y); bf16* x1b = (bf16*)(F.ws + WS_X1B);
    const float* lng = a.in[I_LNG] + ((size_t)l * 2 + 0) * D; const float* lnb = a.in[I_LNB] + ((size_t)l * 2 + 0) * D;
    const float* wr = (const float*)(F.ws + WS_WR) + (size_t)l * 3 * 512 * 16 * 4;
    int* tok_e = (int*)(F.ws + (probe ? WS_OP : WS_ROUTE)); int* tok_rank = tok_e + 2 * T; float* tok_gate = (float*)(tok_rank + 2 * T);
    gu32* cnt = F.ctl + (probe ? 65536 : CW_CNT) + 2048 * l;
    LAS float* P = (LAS float*)(F.lds);
    typedef float f32x4v __attribute__((ext_vector_type(4)));
    for (int tb = F.c; tb < T / 32; tb += F.G) {
#pragma unroll 2
        for (int i = 0; i < 4; ++i) { const int tk = tb * 32 + F.wave * 4 + i;
            const GAS v4u* yr = (const GAS v4u*)(y + (size_t)tk * D) + F.lane;
            float v[4][8]; float s = 0.f;
#pragma unroll
            for (int j = 0; j < 4; ++j) { const v4u w = yr[64 * j]; v[j][0] = bflo(w.x); v[j][1] = bfhi(w.x); v[j][2] = bflo(w.y); v[j][3] = bfhi(w.y); v[j][4] = bflo(w.z); v[j][5] = bfhi(w.z); v[j][6] = bflo(w.w); v[j][7] = bfhi(w.w);
#pragma unroll
                for (int e = 0; e < 8; ++e) s += v[j][e]; }
            const float mean = wave_sum(s) * (1.f / D); float s2 = 0.f;
#pragma unroll
            for (int j = 0; j < 4; ++j)
#pragma unroll
                for (int e = 0; e < 8; ++e) { v[j][e] -= mean; s2 += v[j][e] * v[j][e]; }
            const float rstd = 1.f / sqrtf(wave_sum(s2) * (1.f / D) + LN_EPS);
#pragma unroll
            for (int j = 0; j < 4; ++j) { const int d0 = 8 * F.lane + 512 * j; const f32x4 g0 = *(const GAS f32x4*)(lng + d0), g1 = *(const GAS f32x4*)(lng + d0 + 4), b0 = *(const GAS f32x4*)(lnb + d0), b1 = *(const GAS f32x4*)(lnb + d0 + 4);
                const float q0 = v[j][0] * rstd * g0.x + b0.x, q1 = v[j][1] * rstd * g0.y + b0.y, q2 = v[j][2] * rstd * g0.z + b0.z, q3 = v[j][3] * rstd * g0.w + b0.w;
                const float q4 = v[j][4] * rstd * g1.x + b1.x, q5 = v[j][5] * rstd * g1.y + b1.y, q6 = v[j][6] * rstd * g1.z + b1.z, q7 = v[j][7] * rstd * g1.w + b1.w;
                v4u w; w.x = pk2(q0, q1); w.y = pk2(q2, q3); w.z = pk2(q4, q5); w.w = pk2(q6, q7);
                *(GAS v4u*)(x1b + (size_t)tk * D + d0) = w;
                unsigned lo = 0u, hi = 0u; lo = __builtin_amdgcn_cvt_pk_fp8_f32(q0, q1, lo, false); lo = __builtin_amdgcn_cvt_pk_fp8_f32(q2, q3, lo, true);
                hi = __builtin_amdgcn_cvt_pk_fp8_f32(q4, q5, hi, false); hi = __builtin_amdgcn_cvt_pk_fp8_f32(q6, q7, hi, true);
                v2u qq; qq.x = lo; qq.y = hi; *(GAS v2u*)((unsigned char*)(F.ws + WS_X1F) + (size_t)tk * D + d0) = qq; } }
        VM_WAIT(); __syncthreads();
        { const int mt = F.wave >> 2, kq = F.wave & 3, c = F.lane & 15, q = F.lane >> 4;
          const bf16* ap = x1b + (size_t)(tb * 32 + mt * 16 + c) * D + kq * 512 + 4 * q;
          const float* bp = wr + ((size_t)(kq * 128 + q) * 16 + c) * 4;
          f32x4v acc[3] = {{0.f, 0.f, 0.f, 0.f}, {0.f, 0.f, 0.f, 0.f}, {0.f, 0.f, 0.f, 0.f}};
#pragma unroll 4
          for (int ks = 0; ks < 32; ++ks) { const v2u aw = *(const GAS v2u*)(ap + 16 * ks); const f32x4 a4 = (f32x4){bflo(aw.x), bfhi(aw.x), bflo(aw.y), bfhi(aw.y)}; f32x4 b4[3];
#pragma unroll
              for (int nb = 0; nb < 3; ++nb) b4[nb] = *(const GAS f32x4*)(bp + ((size_t)nb * 512 + 4 * ks) * 64);
#pragma unroll
              for (int j = 0; j < 4; ++j)
#pragma unroll
                  for (int nb = 0; nb < 3; ++nb) acc[nb] = __builtin_amdgcn_mfma_f32_16x16x4f32(a4[j], b4[nb][j], acc[nb], 0, 0, 0); }
#pragma unroll
          for (int nb = 0; nb < 3; ++nb)
#pragma unroll
              for (int r = 0; r < 4; ++r) P[((kq * 2 + mt) * 16 + 4 * q + r) * 48 + nb * 16 + c] = acc[nb][r]; }
        __syncthreads();
        if (F.tid < 32) { const int tk = tb * 32 + F.tid, mt = F.tid >> 4, ti = F.tid & 15;
            const LAS f32x4* P4 = (const LAS f32x4*)P;
            const int rb = (mt * 16 + ti) * 12;
            const float* bg1 = a.in[I_BG1] + l * 4; const float* bg2 = a.in[I_BG2] + l * 32;
            const f32x4 s1 = (P4[rb] + P4[rb + 384]) + (P4[rb + 768] + P4[rb + 1152]);
            const float l10 = s1.x + bg1[0], l11 = s1.y + bg1[1], l12 = s1.z + bg1[2], l13 = s1.w + bg1[3];
            int grp = 0; float mx = l10;
            if (l11 > mx) { mx = l11; grp = 1; } if (l12 > mx) { mx = l12; grp = 2; } if (l13 > mx) { mx = l13; grp = 3; }
            const float psel = 1.f / (expf(l10 - mx) + expf(l11 - mx) + expf(l12 - mx) + expf(l13 - mx));
            const int ob = rb + 1 + 2 * grp;
            const f32x4 sa = (P4[ob] + P4[ob + 384]) + (P4[ob + 768] + P4[ob + 1152]), sb = (P4[ob + 1] + P4[ob + 385]) + (P4[ob + 769] + P4[ob + 1153]);
            const f32x4 ba = *(const GAS f32x4*)(bg2 + grp * 8), bb = *(const GAS f32x4*)(bg2 + grp * 8 + 4);
            const float l2[8] = {sa.x + ba.x, sa.y + ba.y, sa.z + ba.z, sa.w + ba.w, sb.x + bb.x, sb.y + bb.y, sb.z + bb.z, sb.w + bb.w};
            int i0 = 0; float v0 = l2[0];
#pragma unroll
            for (int e = 1; e < 8; ++e) if (l2[e] > v0) { v0 = l2[e]; i0 = e; }
            int i1 = -1; float v1 = -INFINITY;
#pragma unroll
            for (int e = 0; e < 8; ++e) if (e != i0 && l2[e] > v1) { v1 = l2[e]; i1 = e; }
            const float e1 = expf(v1 - v0), g0 = psel / (1.f + e1), g1 = psel * e1 / (1.f + e1);
            const int ex0 = grp * 8 + i0, ex1 = grp * 8 + i1;
            const unsigned r0 = __hip_atomic_fetch_add(cnt + 64 * ex0, 1u, RLX_AGENT), r1 = __hip_atomic_fetch_add(cnt + 64 * ex1, 1u, RLX_AGENT);
            { int* list = (int*)(F.ws + (probe ? WS_OP + 2 * MiB : WS_LIST)); list[ex0 * 8192 + (int)r0] = tk; list[ex1 * 8192 + (int)r1] = tk; }
            tok_e[2 * tk] = ex0; tok_e[2 * tk + 1] = ex1; tok_rank[2 * tk] = (int)r0; tok_rank[2 * tk + 1] = (int)r1; tok_gate[2 * tk] = g0; tok_gate[2 * tk + 1] = g1; }
        __syncthreads();
    }
}
__device__ __forceinline__ void moe_table(Frame& F, int l) {
    LAS int* tstart = (LAS int*)(F.lds + TAB_OFF);
    if (F.tid == 0) { int acc = 0;
        for (int e = 0; e < 32; ++e) { tstart[e] = acc; const unsigned c = __hip_atomic_load(F.ctl + CW_CNT + 2048 * l + 64 * e, RLX_AGENT); tstart[36 + e] = (int)c; acc += (int)((c + 255u) >> 8); }
        tstart[32] = acc; }
    __syncthreads();
}
__device__ __forceinline__ void ln2_phase(Frame& F, const Args& a, int l) {
    const bf16* x1b = (const bf16*)(F.ws + WS_X1B); const bf16* yb = (const bf16*)(F.ws + WS_YB); bf16* xb = (bf16*)(F.ws + WS_XB);
    const float* lng = a.in[I_LNG] + ((size_t)l * 2 + 1) * D; const float* lnb = a.in[I_LNB] + ((size_t)l * 2 + 1) * D;
    moe_table(F, l); const LAS int* tstart = (const LAS int*)(F.lds + TAB_OFF);
    const int* tok_e = (const int*)(F.ws + WS_ROUTE); const int* tok_rank = tok_e + 2 * T; const float* tok_gate = (const float*)(F.ws + WS_ROUTE) + 4 * T;
    const int gw = F.c * NWAVES + F.wave, NGW = F.G * NWAVES;
    for (int t4 = gw; t4 < T / 4; t4 += NGW) { const int tk0 = t4 * 4;
        int ev = 0, rv = 0; float gv = 0.f;
        if (F.lane < 8) { ev = tok_e[2 * tk0 + F.lane]; rv = tok_rank[2 * tk0 + F.lane]; gv = tok_gate[2 * tk0 + F.lane]; }
        const int slotv = (F.lane < 8) ? tstart[ev] * 256 + rv : 0;
        v4u xr[2], ya[2], yc[2]; v4u xr2[2], ya2[2], yc2[2];
#define LN2_LOAD(i, XR, YA, YC, XR2, YA2, YC2) do { const int s0_ = __builtin_amdgcn_readlane(slotv, 2 * (i)), s1_ = __builtin_amdgcn_readlane(slotv, 2 * (i) + 1); \
        _Pragma("unroll") for (int j = 0; j < 2; ++j) { const int d0 = 8 * F.lane + 512 * j; XR[j] = *(const GAS v4u*)(x1b + (size_t)(tk0 + (i)) * D + d0); YA[j] = *(const GAS v4u*)(yb + (size_t)s0_ * D + d0); YC[j] = *(const GAS v4u*)(yb + (size_t)s1_ * D + d0); } \
        _Pragma("unroll") for (int j = 0; j < 2; ++j) { const int d0 = 8 * F.lane + 512 * (j + 2); XR2[j] = *(const GAS v4u*)(x1b + (size_t)(tk0 + (i)) * D + d0); YA2[j] = *(const GAS v4u*)(yb + (size_t)s0_ * D + d0); YC2[j] = *(const GAS v4u*)(yb + (size_t)s1_ * D + d0); } } while (0)
        LN2_LOAD(0, xr, ya, yc, xr2, ya2, yc2);
#pragma unroll
        for (int i = 0; i < 4; ++i) { const int tk = tk0 + i;
            const float g0 = __builtin_bit_cast(float, __builtin_amdgcn_readlane(__builtin_bit_cast(int, gv), 2 * i)), g1 = __builtin_bit_cast(float, __builtin_amdgcn_readlane(__builtin_bit_cast(int, gv), 2 * i + 1));
            float v[4][8]; float s = 0.f;
#pragma unroll
            for (int j = 0; j < 4; ++j) { const v4u X = j < 2 ? xr[j] : xr2[j - 2], A = j < 2 ? ya[j] : ya2[j - 2], C = j < 2 ? yc[j] : yc2[j - 2];
                v[j][0] = bflo(X.x) * DN_ALPHA + (g0 * bflo(A.x) + g1 * bflo(C.x)); v[j][1] = bfhi(X.x) * DN_ALPHA + (g0 * bfhi(A.x) + g1 * bfhi(C.x));
                v[j][2] = bflo(X.y) * DN_ALPHA + (g0 * bflo(A.y) + g1 * bflo(C.y)); v[j][3] = bfhi(X.y) * DN_ALPHA + (g0 * bfhi(A.y) + g1 * bfhi(C.y));
                v[j][4] = bflo(X.z) * DN_ALPHA + (g0 * bflo(A.z) + g1 * bflo(C.z)); v[j][5] = bfhi(X.z) * DN_ALPHA + (g0 * bfhi(A.z) + g1 * bfhi(C.z));
                v[j][6] = bflo(X.w) * DN_ALPHA + (g0 * bflo(A.w) + g1 * bflo(C.w)); v[j][7] = bfhi(X.w) * DN_ALPHA + (g0 * bfhi(A.w) + g1 * bfhi(C.w));
#pragma unroll
                for (int e = 0; e < 8; ++e) s += v[j][e]; }
            if (i + 1 < 4) LN2_LOAD(i + 1, xr, ya, yc, xr2, ya2, yc2);
            const float mean = wave_sum(s) * (1.f / D); float s2 = 0.f;
#pragma unroll
            for (int j = 0; j < 4; ++j)
#pragma unroll
                for (int e = 0; e < 8; ++e) { v[j][e] -= mean; s2 += v[j][e] * v[j][e]; }
            const float rstd = 1.f / sqrtf(wave_sum(s2) * (1.f / D) + LN_EPS);
#pragma unroll
            for (int j = 0; j < 4; ++j) { const int d0 = 8 * F.lane + 512 * j; const f32x4 g0v = *(const GAS f32x4*)(lng + d0), g1v = *(const GAS f32x4*)(lng + d0 + 4), b0 = *(const GAS f32x4*)(lnb + d0), b1 = *(const GAS f32x4*)(lnb + d0 + 4);
                const f32x4 oa = (f32x4){v[j][0] * rstd * g0v.x + b0.x, v[j][1] * rstd * g0v.y + b0.y, v[j][2] * rstd * g0v.z + b0.z, v[j][3] * rstd * g0v.w + b0.w};
                const f32x4 ob = (f32x4){v[j][4] * rstd * g1v.x + b1.x, v[j][5] * rstd * g1v.y + b1.y, v[j][6] * rstd * g1v.z + b1.z, v[j][7] * rstd * g1v.w + b1.w};
                if (l == DEPTH - 1) { *(GAS f32x4*)(a.out + (size_t)tk * D + d0) = oa; *(GAS f32x4*)(a.out + (size_t)tk * D + d0 + 4) = ob; }
                else { v4u w; w.x = pk2(oa.x, oa.y); w.y = pk2(oa.z, oa.w); w.z = pk2(ob.x, ob.y); w.w = pk2(ob.z, ob.w); *(GAS v4u*)(xb + (size_t)tk * D + d0) = w;
                    unsigned lo = 0u, hi = 0u; lo = __builtin_amdgcn_cvt_pk_fp8_f32(oa.x, oa.y, lo, false); lo = __builtin_amdgcn_cvt_pk_fp8_f32(oa.z, oa.w, lo, true); hi = __builtin_amdgcn_cvt_pk_fp8_f32(ob.x, ob.y, hi, false); hi = __builtin_amdgcn_cvt_pk_fp8_f32(ob.z, ob.w, hi, true);
                    v2u qq; qq.x = lo; qq.y = hi; *(GAS v2u*)(F.ws + WS_XQ + (size_t)tk * D + d0) = qq; } }
        }
#undef LN2_LOAD
    }
}

__global__ void __launch_bounds__(NWAVES * 64, 2) fwd_kernel(Args args) {
    extern __shared__ __attribute__((aligned(16))) unsigned char lds[];
    Frame F;
    F.lds = (LAS unsigned char*)lds; F.ldsg = (char*)lds;
    F.tid = threadIdx.x; F.lane = F.tid & 63; F.wave = __builtin_amdgcn_readfirstlane(F.tid >> 6);
    F.G = gridDim.x; F.c = blockIdx.x; F.ws = args.ws; F.ctl = (gu32*)(args.ws + WS_CTL);
    volatile LAS unsigned* MISC = (volatile LAS unsigned*)(F.lds + MISC_OFF);
    for (int u = F.tid; u < (LDS_BYTES - LDSCTL_OFF) / 4; u += NWAVES * 64) ((LAS unsigned*)(F.lds + LDSCTL_OFF))[u] = 0u;
    __syncthreads();
    const int lo = args.ph_lo, hi = args.ph_hi; int lastp = -1;
    const bool multi = (hi - lo) > 1;
    XcdBarrier bar; bar.bar = (unsigned*)(F.ctl + CW_BAR); bar.x = 0; bar.st = nullptr;
    if (multi) bar = xcd_barrier_post((unsigned*)(F.ctl + CW_BAR), MISC + 8);
#ifndef REP_MASK
#define REP_MASK 0
#endif
#define REP(k) for (int rep_ = 0; rep_ <= ((REP_MASK >> (k)) & 1); ++rep_)
#define IN(p) (lo <= (p) && (p) < hi)
#ifdef PROBE_A
#define STAMP(i) do { if (blockIdx.x == 0 && threadIdx.x == 0) ((unsigned long long*)(args.ws + WS_TS))[(i)] = __builtin_amdgcn_s_memrealtime(); } while (0)
#else
#define STAMP(i) do { } while (0)
#endif
#define SEAM(p) do { conv_note_fin(F, (p)); lastp = (p); if ((p) + 1 < hi) xcd_barrier(bar); STAMP((p) + 1); } while (0)
#define CONVFIN() ((lastp >= 0) ? (int)__hip_atomic_load(F.ctl + CW_FIN + 64 * lastp, RLX_AGENT) : 0)
#define FRESH() do { int t_ = threadIdx.x; asm volatile("" : "+v"(t_)); F.tid = t_; F.lane = t_ & 63; F.wave = __builtin_amdgcn_readfirstlane(t_ >> 6); \
    GAS unsigned char* w_ = (GAS unsigned char*)args.ws; asm volatile("" : "+s"(w_)); F.ws = (unsigned char*)w_; F.ctl = (gu32*)(w_ + WS_CTL); } while (0)

    STAMP(0);
    if (IN(0)) { FRESH(); REP(9) prologue_phase(F, args); SEAM(0); }
#ifdef XBAR
    for (int xb_ = 0; xb_ < XBAR; ++xb_) xcd_barrier(bar);
#endif

    for (int l = 0; l < DEPTH; ++l) {
        const int pb = 1 + NPH_LAYER * l;
        if (IN(pb + 0)) { FRESH();
            const int N = (l < 2) ? NINA : (l == 2 ? 5120 : 2048);
            const unsigned char* Bt = F.ws + ((l < 2) ? WS_WAIN + (size_t)l * NINA * D * 2 : (l == 2 ? WS_WBIN0 : WS_WBIN1));
            const int nu = (T / 256) * (N / 256) + (l == 0 ? 16 : 0), ncv = conv_servers(nu, F.G, CONVFIN()), Gc = F.G - ncv; const bool f8 = F8L(l);
            if (F.c < Gc) {
                pg8::EpiBf16X E{l < 2 ? 0 : 1, (bf16*)(F.ws + WS_Z), (bf16*)(F.ws + WS_KD), (bf16*)(F.ws + WS_VD), (bf16*)(F.ws + WS_MEMKV), nullptr, nullptr};
                if (f8) { pg8::Gemm g{nullptr, nullptr, T, N, D / 2}; pg8::DualOrder8 S; S.init(F.ws + WS_XQ, Bt, T, N, D / 2, Gc, F.c, F.ws + WS_MEMQ, F.ws + WS_WMKV, l == 0 ? 16 : 0);
                    REP(0) pg8::gemm_phase<pg8::EpiBf16X, pg8::DualOrder8, true, true>(F.lds + RING_OFF, g, S, E); }
                else { pg8::Gemm g{nullptr, nullptr, T, N, D}; pg8::DualOrder S; S.init(F.ws + WS_XB, Bt, T, N, D, Gc, F.c, F.ws + WS_MEMB, F.ws + WS_WMKV, l == 0 ? 16 : 0);
                    REP(0) pg8::gemm_phase<pg8::EpiBf16X, pg8::DualOrder, true, true>(F.lds + RING_OFF, g, S, E); }
                if (ncv) conv_done(F, pb + 0);
                { const int mine = (nu - 1 - F.c) / Gc + 1, rounds = (nu + Gc - 1) / Gc; conv_filler(F, args, 2 * l, (rounds - mine) * (f8 ? (QA + 1) / 2 : QA)); }
            } else conv_server(F, args, pb + 0, 2 * l, Gc);
            SEAM(pb + 0);
        }
        if (IN(pb + 1)) { FRESH();
            if (l < 2) {
                REP(1) for (int u = F.c; u < 256 + 128; u += F.G) {
                    if (u < 256) sgu_unit(F, args, l, u >> 2, u & 3);
                    else { const int r = u - 256; memattn_unit(F, l, r & 3, r >> 2, NINA, 2 * MIXW); }
                }
                if (F.c >= 128) conv_filler(F, args, 2 * l, QX);
            } else {
                const int ncv = CONVFIN() ? 0 : NCVATT;
                if (F.c >= F.G - ncv) { conv_server_q(F, args, F.ctl + CW_Q + 64 * l, (unsigned)(att2::NUNITS + 128 - STOPU), 2 * l); __syncthreads(); }
                REP(2) { gu32* qh = F.ctl + CW_Q + 64 * l + 16 * rep_; LAS unsigned* uw = (LAS unsigned*)(F.lds + att2::LDS_UNIT);
                for (;;) {
                    if (F.tid == 0) *uw = __hip_atomic_fetch_add(qh, 1u, RLX_AGENT);
                    __syncthreads();
                    const unsigned idx = *uw;
                    __syncthreads();
                    if (idx >= (unsigned)(att2::NUNITS + 128)) break;
                    if (idx < (unsigned)att2::NUNITS) diffattn2_unit(F, args, att2::g_units.u[idx]);
                    else { const int r = (int)idx - att2::NUNITS; memattn_unit(F, l, r & 3, r >> 2, 2048, MIXW); }
                } }
            }
            SEAM(pb + 1);
        }
        if (IN(pb + 2) && l >= 2) { FRESH(); REP(3) diffcombine_phase(F, args, l); SEAM(pb + 2); }
        if (IN(pb + 3)) { FRESH();
            pg8::EpiResBf16 E{(const bf16*)(F.ws + WS_XB), (bf16*)(F.ws + WS_Y), DN_ALPHA};
            const unsigned char* Wo = F.ws + (l < 2 ? WS_WAOUT + (size_t)l * D * D * 2 : WS_WBOUT + (size_t)(l - 2) * D * D * 2);
            if (F8OL(l)) { pg8::Gemm g{nullptr, nullptr, T, D, D / 2}; pg8::DenseOrder8 S; S.init(F.ws + WS_CATQ, Wo, T, D, D / 2, F.G, F.c);
                REP(4) pg8::gemm_phase<pg8::EpiResBf16, pg8::DenseOrder8, true, true>(F.lds + RING_OFF, g, S, E); }
            else { pg8::Gemm g{nullptr, nullptr, T, D, D}; pg8::DenseOrder S; S.init(F.ws + WS_CAT, Wo, T, D, D, F.G, F.c);
                REP(4) pg8::gemm_phase<pg8::EpiResBf16, pg8::DenseOrder, true, true>(F.lds + RING_OFF, g, S, E); }
            SEAM(pb + 3);
        }
        if (IN(pb + 4)) { FRESH(); ln1_router_phase(F, args, l);
#ifdef REP_LN1
            ln1_router_phase(F, args, l, 1);
#endif
            conv_filler(F, args, 2 * l, -1); SEAM(pb + 4); }
        if (IN(pb + 6)) { FRESH();
            moe_table(F, l);
            const LAS int* tb = (const LAS int*)(F.lds + TAB_OFF);
            const int nu = tb[32] * 4, ncv = conv_servers(nu, F.G, CONVFIN()), Gc = F.G - ncv;
            if (F.c < Gc) {
                pg8::Gemm g{nullptr, nullptr, SLOTS, 1024, D / 2};
                pg8::MoeGatherOrder S{tb, tb + 36, (const int*)(F.ws + WS_LIST), 4, Gc, F.c, (const char*)(F.ws + WS_X1F), (const char*)(F.ws + WS_W13) + (size_t)l * NE * 1024 * 2048, (size_t)1024 * 2048, (size_t)256 * 2048, (unsigned)D};
                pg8::EpiMoe1 E{(bf16*)(F.ws + WS_H), tb, tb + 36};
                REP(6) pg8::gemm_phase<pg8::EpiMoe1, pg8::MoeGatherOrder, true, true>(F.lds + RING_OFF, g, S, E);
                if (ncv) conv_done(F, pb + 6);
                { const int mine = (F.c < nu) ? (nu - 1 - F.c) / Gc + 1 : 0, rounds = (nu + Gc - 1) / Gc; conv_filler(F, args, 2 * l + 1, (rounds - mine) * QM); }
            } else conv_server(F, args, pb + 6, 2 * l + 1, Gc);
            SEAM(pb + 6);
        }
        if (IN(pb + 7)) { FRESH();
            moe_table(F, l);
            const int nu = ((const LAS int*)(F.lds + TAB_OFF))[32] * 8, ncv = conv_servers(nu, F.G, CONVFIN()), Gc = F.G - ncv;
            if (F.c < Gc) {
                pg8::Gemm g{nullptr, nullptr, SLOTS, D, FF / 2};
                pg8::MoeOrder8 S{(const PG8_LAS int*)(F.lds + TAB_OFF), 8, Gc, F.c, (const char*)(F.ws + WS_H), (const char*)(F.ws + WS_W2) + (size_t)l * NE * 2048 * 512, (size_t)256 * FF, (size_t)2048 * 512, (size_t)256 * 512};
                pg8::EpiBf16X E{3, (bf16*)(F.ws + WS_YB), nullptr, nullptr, nullptr, (const PG8_LAS int*)(F.lds + TAB_OFF), (const PG8_LAS int*)(F.lds + TAB_OFF) + 36};
                REP(7) pg8::gemm_phase<pg8::EpiBf16X, pg8::MoeOrder8, true, true>(F.lds + RING_OFF, g, S, E);
                if (ncv) conv_done(F, pb + 7);
                { const int mine = (F.c < nu) ? (nu - 1 - F.c) / Gc + 1 : 0, rounds = (nu + Gc - 1) / Gc; conv_filler(F, args, 2 * l + 1, (rounds - mine) * QB); }
            } else conv_server(F, args, pb + 7, 2 * l + 1, Gc);
            SEAM(pb + 7);
        }
        if (IN(pb + 8)) { FRESH(); REP(8) ln2_phase(F, args, l); conv_filler(F, args, 2 * l + 1, -1); SEAM(pb + 8); }
    }
#ifdef PROBE_A
    {
        VM_WAIT(); xcd_barrier(bar);
        const unsigned long long* ts = (const unsigned long long*)(args.ws + WS_TS);
        float da = 0.f, db = 0.f;
        for (int p = 0; p < NPHASES; ++p) { const int k = (p == 0) ? 9 : (p - 1) % NPH_LAYER; const float d = (float)(ts[p + 1] - ts[p]);
            if (k == PROBE_A || PROBE_A == 10) da += d; if (k == PROBE_B || PROBE_B == 10) db += d; }
        const float kk = sqrtf(da), vv = db;
        float* o = args.out; const long n = (long)T * D;
        for (long i = (long)blockIdx.x * 512 + threadIdx.x; i < n; i += (long)gridDim.x * 512) o[i] = (i == 0) ? vv : kk;
    }
#endif
#undef IN
#undef SEAM
}

#ifndef MK_ONE_LAUNCH
#define MK_ONE_LAUNCH 1
#endif
extern "C" void kernel_launch(void* const* d_in, const int* in_sizes, int n_in, void* d_out, int out_size, void* d_ws, size_t ws_size, hipStream_t stream) {
    static int grid = 0;
    if (grid == 0) {
        if (n_in != 24 || in_sizes[0] != T * D || out_size != T * D || ws_size < WS_END) { fprintf(stderr, "kernel_launch: unexpected shapes (n_in %d, in0 %d, out %d, ws %zu < %zu)\n", n_in, n_in > 0 ? in_sizes[0] : -1, out_size, ws_size, (size_t)WS_END); grid = -1; return; }
        int dev = 0, cus = 0, per_cu = 0;
        if (hipGetDevice(&dev) != hipSuccess || hipDeviceGetAttribute(&cus, hipDeviceAttributeMultiprocessorCount, dev) != hipSuccess) { grid = -1; return; }
        if (hipFuncSetAttribute((const void*)fwd_kernel, hipFuncAttributeMaxDynamicSharedMemorySize, LDS_BYTES) != hipSuccess) { fprintf(stderr, "kernel_launch: hipFuncSetAttribute failed\n"); grid = -1; return; }
        if (hipOccupancyMaxActiveBlocksPerMultiprocessor(&per_cu, (const void*)fwd_kernel, NWAVES * 64, LDS_BYTES) != hipSuccess || per_cu < 1) fprintf(stderr, "kernel_launch: occupancy query reports %d\n", per_cu);
        (void)hipGetLastError();
        grid = cus;
    }
    if (grid < 0) return;
    if (hipMemsetAsync((char*)d_ws + WS_CTL, 0, CTL_ZERO_BYTES, stream) != hipSuccess) return;
    Args a{};
    for (int i = 0; i < 24; ++i) a.in[i] = (const float*)d_in[i];
    a.out = (float*)d_out; a.ws = (unsigned char*)d_ws;
#if MK_ONE_LAUNCH
    a.ph_lo = 0; a.ph_hi = NPHASES;
    hipLaunchKernelGGL(fwd_kernel, dim3(grid), dim3(NWAVES * 64), LDS_BYTES, stream, a);
#else
    for (int p = 0; p < NPHASES; ++p) {
        const int k = (p - 1) % NPH_LAYER, l = (p - 1) / NPH_LAYER;
        if (p > 0 && k == 2 && l < 2) continue;
        a.ph_lo = p; a.ph_hi = p + 1;
        hipLaunchKernelGGL(fwd_kernel, dim3(grid), dim3(NWAVES * 64), LDS_BYTES, stream, a);
    }
#endif
    const hipError_t le = hipPeekAtLastError();
    if (le != hipSuccess) fprintf(stderr, "kernel_launch: launch failed: %s\n", hipGetErrorName(le));
}
```

```cpp
#define F8MASK 12
#define F8OMASK 12
#include <hip/hip_runtime.h>
#include <cstdio>
#include <cstdint>
namespace pg8 {
#define PG8_LAS __attribute__((address_space(3)))
typedef unsigned short bf16_t;
typedef short bf16x8 __attribute__((ext_vector_type(8)));
typedef float f32x4 __attribute__((ext_vector_type(4)));
typedef unsigned u32x4 __attribute__((ext_vector_type(4)));
constexpr int BM = 256, BK = 64, HALF = 128, HTB = HALF * BK * 2  , STAGE_BYTES = 8 * HTB, NXCD = 8, WGM = 8;

__host__ __device__ __forceinline__ int lds_byte(int r, int c) { const int st = (r >> 4) * 2 + (c >> 5), rr = r & 15, cc = c & 31, ob = rr * 64 + cc * 2; return st * 1024 + (ob ^ (((ob >> 9) & 1) << 5)); }
__host__ __device__ __forceinline__ void stage_rc(int b, int& R, int& C) { const int st = b / 1024, sb = b % 1024, swz = sb ^ (((sb >> 9) & 1) << 5); R = (st >> 1) * 16 + swz / 64; C = (st & 1) * 32 + (swz % 64) / 2; }
__host__ __device__ __forceinline__ int perm32(int rho) { const int n = rho >> 4, i = rho & 15; return 8 * (i >> 2) + 4 * n + (i & 3); }

typedef int pg8_v4i __attribute__((ext_vector_type(4))); typedef int pg8_v8i __attribute__((ext_vector_type(8)));
__device__ __forceinline__ pg8_v8i pg8_cat8(bf16x8 a, bf16x8 b) { return __builtin_shufflevector(__builtin_bit_cast(pg8_v4i, a), __builtin_bit_cast(pg8_v4i, b), 0, 1, 2, 3, 4, 5, 6, 7); }
struct Unit { int pm, pn, e; };
struct Gemm { const bf16_t* A; const bf16_t* Bt; int M, N, K; };

struct StaticOrder {
    static constexpr bool GATHER = false, F8 = false; static constexpr int SCALE_B = 127;
    int nM, nN, nwg, G, c;
    __host__ __device__ void init(int M, int N, int G_, int c_) { nM = M / BM; nN = N / BM; nwg = nM * nN; G = G_; c = c_; }
    __host__ __device__ bool next(int i, Unit& u) const {
        const long L = (long)i * G + c; if (L >= nwg) return false;
        int wgid = (int)L; { const int q = nwg / NXCD, r = nwg % NXCD, xcd = wgid % NXCD, off = wgid / NXCD; wgid = (xcd < r ? xcd * (q + 1) : r * (q + 1) + (xcd - r) * q) + off; }
        const int nig = WGM * nN, gid = wgid / nig, fm = gid * WGM, gsz = (nM - fm) < WGM ? (nM - fm) : WGM;
        u.pm = fm + ((wgid % nig) % gsz); u.pn = (wgid % nig) / gsz; return true;
    }
    __device__ __forceinline__ void a_ready(const Unit&) const {}
    __device__ __forceinline__ void done(const Unit&) const {}
};

__device__ __forceinline__ unsigned cvt_pk_bf16(float lo, float hi) { unsigned r; asm volatile("v_cvt_pk_bf16_f32 %0, %1, %2" : "=v"(r) : "v"(lo), "v"(hi)); return r; }
typedef float f32x2 __attribute__((ext_vector_type(2)));
__device__ __forceinline__ f32x2 gelu_pk(f32x2 v) {
    const f32x2 av = __builtin_elementwise_abs(v), d = av * 0.2316418882f + 1.0f;
    f32x2 t; t.x = __builtin_amdgcn_rcpf(d.x); t.y = __builtin_amdgcn_rcpf(d.y);
    f32x2 q = t * 0.5307027145f + (-0.7265760135f); q = q * t + 0.7107068705f; q = q * t + (-0.142248368f); q = q * t + 0.127414796f; q = q * t;
    const f32x2 s = (v * v) * (-0.72134752044f);
    f32x2 e; e.x = __builtin_amdgcn_exp2f(s.x); e.y = __builtin_amdgcn_exp2f(s.y);
    const f32x2 m = v * (q * e), r = v - m;
    f32x2 o; o.x = v.x < 0.f ? m.x : r.x; o.y = v.y < 0.f ? m.y : r.y; return o;
}

template <class Epi, class Sched, bool ALIGN_EPI = false, bool SP2 = false>
__device__ __forceinline__ void gemm_phase(PG8_LAS unsigned char* lds, const Gemm g, const Sched& S, const Epi& E) {
    int tid_ = threadIdx.x; asm volatile("" : "+v"(tid_));
    const int tid = tid_, wid = __builtin_amdgcn_readfirstlane(tid >> 6), lane = tid & 63, wr = wid >> 2, wc = wid & 3, fr = lane & 15, fq = lane >> 4;
    const int K = g.K, nt = K / BK;
    unsigned voffA[2], voffB[2];
#pragma unroll
    for (int i = 0; i < 2; ++i) { int R, C; stage_rc(tid * 16 + i * 8192, R, C); const int Rb = Epi::PERM ? ((R & ~31) + perm32(R & 31)) : R;
        voffA[i] = (unsigned)(R * K + C) * 2u; voffB[i] = (unsigned)(Rb * K + C) * 2u; }
    unsigned vAc[2][2], vAn[2][2];
    int gR[2], gC[2];
#pragma unroll
    for (int i = 0; i < 2; ++i) { stage_rc(tid * 16 + i * 8192, gR[i], gC[i]); }
    const size_t kstep = (size_t)(BK * 2);
    const size_t hstep = (size_t)HALF * K * 2;
        const unsigned ldsw = (unsigned)wid * 1024u;
    const int aoff = lds_byte(wr * 64 + fr, fq * 8), boff = lds_byte(wc * 32 + fr, fq * 8);
#define PG8_SA(b, h) (((b) * 2 + (h)) * HTB)
#define PG8_SB(b, h) ((4 + (b) * 2 + (h)) * HTB)
#define PG8_STAGE(bufoff, gbase, voff) do { _Pragma("unroll") for (int _i = 0; _i < 2; ++_i) \
        __builtin_amdgcn_global_load_lds((const unsigned*)((const char*)(gbase) + (voff)[_i]), (PG8_LAS unsigned*)(lds + (bufoff) + ldsw + _i * 8192), 16, 0, 0); } while (0)
#define PG8_STAGE_A(b, h, base, VS) do { if constexpr (Sched::GATHER) { PG8_STAGE(PG8_SA(b, h), base, VS[h]); } else { PG8_STAGE(PG8_SA(b, h), (base) + (h) * hstep, voffA); } } while (0)
#define PG8_STAGE_AN(b, h, base) do { if constexpr (Sched::GATHER) { unsigned vs_[2] = {last ? vAn[h][0] : vAc[h][0], last ? vAn[h][1] : vAc[h][1]}; PG8_STAGE(PG8_SA(b, h), base, vs_); } else { PG8_STAGE(PG8_SA(b, h), (base) + (h) * hstep, voffA); } } while (0)
#define PG8_LDA(dst, b, h) do { if constexpr (Sched::F8) { _Pragma("unroll") for (int m = 0; m < 4; ++m) { dst##8[m].lo = *(const PG8_LAS pg8_v4i*)(lds + PG8_SA(b, h) + aoff + m * 2048); dst##8[m].hi = *(const PG8_LAS pg8_v4i*)(lds + PG8_SA(b, h) + aoff + m * 2048 + 1024); } } \
        else { _Pragma("unroll") for (int m = 0; m < 4; ++m) _Pragma("unroll") for (int k = 0; k < 2; ++k) dst[m][k] = *(const PG8_LAS bf16x8*)(lds + PG8_SA(b, h) + aoff + m * 2048 + k * 1024); } } while (0)
#define PG8_LDB(dst, b, h) do { if constexpr (Sched::F8) { _Pragma("unroll") for (int n = 0; n < 2; ++n) { dst##8[n].lo = *(const PG8_LAS pg8_v4i*)(lds + PG8_SB(b, h) + boff + n * 2048); dst##8[n].hi = *(const PG8_LAS pg8_v4i*)(lds + PG8_SB(b, h) + boff + n * 2048 + 1024); } } \
        else { _Pragma("unroll") for (int n = 0; n < 2; ++n) _Pragma("unroll") for (int k = 0; k < 2; ++k) dst[n][k] = *(const PG8_LAS bf16x8*)(lds + PG8_SB(b, h) + boff + n * 2048 + k * 1024); } } while (0)
#define PG8_MMA(ai, bj, At, Bt) do { __builtin_amdgcn_s_setprio(1); if constexpr (Sched::F8) { \
        _Pragma("unroll") for (int m = 0; m < 4; ++m) _Pragma("unroll") for (int n = 0; n < 2; ++n) \
            asm volatile("v_mfma_scale_f32_16x16x128_f8f6f4 %0, %1, %2, %0, %3, %4 op_sel_hi:[0,0,0]" : "+v"(acc[ai][bj][m][n]) : "v"(Bt##8[n]), "v"(At##8[m]), "v"(sclB_), "v"(sclA_));     \
        } else { _Pragma("unroll") for (int m = 0; m < 4; ++m) _Pragma("unroll") for (int n = 0; n < 2; ++n) _Pragma("unroll") for (int k = 0; k < 2; ++k) \
        acc[ai][bj][m][n] = __builtin_amdgcn_mfma_f32_16x16x32_bf16(Bt[n][k], At[m][k], acc[ai][bj][m][n], 0, 0, 0); } __builtin_amdgcn_s_setprio(0); } while (0)
#define PG8_WAIT_V(n) asm volatile("s_waitcnt vmcnt(" #n ")" ::: "memory")
#define PG8_WAIT_L(n) asm volatile("s_waitcnt lgkmcnt(" #n ")" ::: "memory")
#define PG8_BAR __builtin_amdgcn_s_barrier()
#define PG8_SCHED __builtin_amdgcn_sched_barrier(0)
    Unit cur, nxt; int ui = 0;
    if (!S.next(0, cur)) return;
    f32x4 acc[2][2][4][2];
#pragma unroll
    for (int a = 0; a < 2; ++a)
#pragma unroll
        for (int b = 0; b < 2; ++b)
#pragma unroll
            for (int m = 0; m < 4; ++m)
#pragma unroll
                for (int n = 0; n < 2; ++n) acc[a][b][m][n] = (f32x4){0.f, 0.f, 0.f, 0.f};
    const int sclB_ = Sched::SCALE_B, sclA_ = 127;
    bf16x8 At[4][2], B0[2][2], B1[2][2]; pg8_v8i At8[4], B08[2], B18[2];
    const char* cA = S.aptr(cur); const char* cB = S.bptr(cur);
    S.a_ready(cur);
    if constexpr (Sched::GATHER) {
#pragma unroll
        for (int h = 0; h < 2; ++h)
#pragma unroll
            for (int i = 0; i < 2; ++i) { vAc[h][i] = S.rowoff(cur, h * HALF + gR[i]) + (unsigned)gC[i] * 2u; vAn[h][i] = vAc[h][i]; }
        asm volatile("s_waitcnt vmcnt(0)" ::: "memory");
    }
    if constexpr (SP2) {
        PG8_STAGE(PG8_SB(0, 0), cB, voffB); PG8_STAGE(PG8_SB(0, 1), cB + hstep, voffB); PG8_STAGE_A(0, 0, cA, vAc); PG8_STAGE_A(0, 1, cA, vAc);
        if (wr == 1) PG8_BAR;
        PG8_WAIT_V(2); PG8_BAR;
        PG8_STAGE(PG8_SB(1, 0), cB + kstep, voffB); PG8_STAGE_A(1, 0, cA + kstep, vAc); PG8_STAGE(PG8_SB(1, 1), cB + hstep + kstep, voffB);
        PG8_WAIT_V(6); PG8_BAR;
    } else {
        PG8_STAGE(PG8_SB(0, 0), cB, voffB); PG8_STAGE_A(0, 0, cA, vAc); PG8_STAGE(PG8_SB(0, 1), cB + hstep, voffB); PG8_STAGE_A(0, 1, cA, vAc);
        if (wr == 1) PG8_BAR;
        PG8_WAIT_V(4); PG8_BAR;
        PG8_STAGE(PG8_SB(1, 0), cB + kstep, voffB); PG8_STAGE_A(1, 0, cA + kstep, vAc); PG8_STAGE(PG8_SB(1, 1), cB + hstep + kstep, voffB);
        PG8_WAIT_V(6); PG8_BAR;
    }
    for (;;) {
        const bool has_next = S.next(ui + 1, nxt);
        const char* nA = has_next ? S.aptr(nxt) : cA; const char* nB = has_next ? S.bptr(nxt) : cB;
        if constexpr (Sched::GATHER) { if (has_next) {
#pragma unroll
            for (int h = 0; h < 2; ++h)
#pragma unroll
                for (int i = 0; i < 2; ++i) vAn[h][i] = S.rowoff(nxt, h * HALF + gR[i]) + (unsigned)gC[i] * 2u; } }
        for (int t = 0; t < nt; t += 2) {
            const bool last = (t == nt - 2);
            const char* a1 = cA + (size_t)(t + 1) * kstep;
            const char* a2 = last ? nA : cA + (size_t)(t + 2) * kstep; const char* b2 = last ? nB : cB + (size_t)(t + 2) * kstep;
            const char* a3 = a2 + kstep; const char* b3 = b2 + kstep;
            if (last && has_next) S.a_ready(nxt);
            if constexpr (SP2) {
            PG8_LDB(B0, 0, 0); PG8_LDB(B1, 0, 1); PG8_SCHED; PG8_LDA(At, 0, 0); PG8_STAGE_A(1, 1, a1, vAc);
            PG8_WAIT_V(8); PG8_WAIT_L(0); PG8_BAR; PG8_MMA(0, 0, At, B0); PG8_MMA(0, 1, At, B1); PG8_BAR; PG8_SCHED;
            PG8_LDA(At, 0, 1); PG8_STAGE(PG8_SB(0, 0), b2, voffB); PG8_STAGE(PG8_SB(0, 1), b2 + hstep, voffB); PG8_STAGE_AN(0, 0, a2);
            PG8_WAIT_V(8); PG8_WAIT_L(0); PG8_BAR; PG8_MMA(1, 0, At, B0); PG8_MMA(1, 1, At, B1); PG8_BAR; PG8_SCHED;
            PG8_LDB(B0, 1, 0); PG8_LDB(B1, 1, 1); PG8_SCHED; PG8_LDA(At, 1, 0); PG8_STAGE_AN(0, 1, a2);
            PG8_WAIT_V(8); PG8_WAIT_L(0); PG8_BAR; PG8_MMA(0, 0, At, B0); PG8_MMA(0, 1, At, B1); PG8_BAR; PG8_SCHED;
            PG8_LDA(At, 1, 1); PG8_STAGE(PG8_SB(1, 0), b3, voffB); PG8_STAGE(PG8_SB(1, 1), b3 + hstep, voffB); PG8_STAGE_AN(1, 0, a3);
            PG8_WAIT_V(8); PG8_WAIT_L(0); PG8_BAR; PG8_MMA(1, 0, At, B0); PG8_MMA(1, 1, At, B1); PG8_BAR; PG8_SCHED;
            } else {
            PG8_LDB(B0, 0, 0); PG8_SCHED; PG8_LDA(At, 0, 0); PG8_STAGE_A(1, 1, a1, vAc);
            PG8_WAIT_L(8); PG8_BAR; PG8_WAIT_L(0); PG8_MMA(0, 0, At, B0); PG8_BAR; PG8_SCHED;
            PG8_LDB(B1, 0, 1); PG8_STAGE(PG8_SB(0, 0), b2, voffB);
            PG8_BAR; PG8_WAIT_L(0); PG8_MMA(0, 1, At, B1); PG8_BAR;
            PG8_LDA(At, 0, 1); PG8_STAGE_AN(0, 0, a2);
            PG8_BAR; PG8_WAIT_L(0); PG8_MMA(1, 0, At, B0); PG8_BAR; PG8_SCHED;
            PG8_STAGE(PG8_SB(0, 1), b2 + hstep, voffB);
            PG8_WAIT_V(6); PG8_BAR; PG8_MMA(1, 1, At, B1); PG8_BAR;
            PG8_LDB(B0, 1, 0); PG8_SCHED; PG8_LDA(At, 1, 0); PG8_STAGE_AN(0, 1, a2);
            PG8_WAIT_L(8); PG8_BAR; PG8_WAIT_L(0); PG8_MMA(0, 0, At, B0); PG8_BAR; PG8_SCHED;
            PG8_LDB(B1, 1, 1); PG8_STAGE(PG8_SB(1, 0), b3, voffB);
            PG8_BAR; PG8_WAIT_L(0); PG8_MMA(0, 1, At, B1); PG8_BAR;
            PG8_LDA(At, 1, 1); PG8_STAGE_AN(1, 0, a3);
            PG8_BAR; PG8_WAIT_L(0); PG8_MMA(1, 0, At, B0); PG8_BAR; PG8_SCHED;
            PG8_STAGE(PG8_SB(1, 1), b3 + hstep, voffB);
            PG8_WAIT_V(6); PG8_BAR; PG8_MMA(1, 1, At, B1); PG8_BAR;
            }
        }
        if constexpr (ALIGN_EPI) { if (wr == 0) PG8_BAR; }
        if constexpr (!Epi::AFTER_DRAIN) { E(acc, cur, wr, wc, fr, fq); S.done(cur); }
        if (!has_next) break;
#pragma unroll
        for (int a = 0; a < 2; ++a)
#pragma unroll
            for (int b = 0; b < 2; ++b)
#pragma unroll
                for (int m = 0; m < 4; ++m)
#pragma unroll
                    for (int n = 0; n < 2; ++n) acc[a][b][m][n] = (f32x4){0.f, 0.f, 0.f, 0.f};
        cur = nxt; cA = nA; cB = nB; ++ui;
        if constexpr (Sched::GATHER) {
#pragma unroll
            for (int h = 0; h < 2; ++h)
#pragma unroll
                for (int i = 0; i < 2; ++i) vAc[h][i] = vAn[h][i]; }
        if constexpr (ALIGN_EPI) { if (wr == 1) PG8_BAR; }
    }
    PG8_WAIT_V(0);
    if constexpr (!ALIGN_EPI) { if (wr == 0) PG8_BAR; }
    PG8_BAR;
    if constexpr (Epi::AFTER_DRAIN) { E.fused(acc, cur, wr, wc, fr, fq, lds, wid, lane); S.done(cur); }
#undef PG8_SA
#undef PG8_SB
#undef PG8_STAGE
#undef PG8_STAGE_A
#undef PG8_STAGE_AN
#undef PG8_LDA
#undef PG8_LDB
#undef PG8_MMA
#undef PG8_WAIT_V
#undef PG8_WAIT_L
#undef PG8_BAR
#undef PG8_SCHED
}
}

constexpr int T = 8192, D = 2048, MIXW = 1536, MEMW = 512, NINA = 3584, DEPTH = 4, NE = 32, FF = 512, MEMT = 256;
constexpr int SLOTS = 24576;
constexpr float LN_EPS = 1e-5f;
constexpr float DN_ALPHA = 1.6817928305074292f;
constexpr float LOG2E = 1.4426950408889634f;
constexpr float QSCALE = 0.08838834764831845f * LOG2E;
constexpr int NWAVES = 8;

constexpr size_t MiB = 1u << 20;
constexpr size_t WS_CTL = 0, CTL_ZERO_BYTES = 1 * MiB;
constexpr size_t WS_WAIN = 2 * MiB, WS_WAOUT = 30 * MiB, WS_WBIN0 = 46 * MiB, WS_WKV = 54 * MiB, WS_WBIN1 = 66 * MiB, WS_WBOUT = 74 * MiB, WS_WMKV = 90 * MiB;
constexpr size_t WS_W13 = 106 * MiB, WS_W2 = 618 * MiB;
constexpr size_t WS_XB = 874 * MiB, WS_MEMB = 906 * MiB, WS_MEMKV = 907 * MiB, WS_Z = 910 * MiB, WS_KD = 966 * MiB, WS_VD = 990 * MiB, WS_CAT = 1014 * MiB;
constexpr size_t WS_XQ = 1206 * MiB, WS_ZQ = 1222 * MiB, WS_MEMQ = 1238 * MiB, WS_CATQ = 1246 * MiB;
constexpr size_t WS_Y = 1046 * MiB, WS_X1F = 1110 * MiB, WS_X1B = 1174 * MiB, WS_XF = 1206 * MiB, WS_XG = 1270 * MiB, WS_H = 1366 * MiB, WS_YB = 1390 * MiB, WS_OP = 1486 * MiB;
constexpr size_t WS_ROUTE = 1582 * MiB, WS_OP2 = 1583 * MiB, WS_ML = 1631 * MiB, WS_WR = 1634 * MiB, WS_TS = 1640 * MiB, WS_LIST = 1641 * MiB, WS_END = 1642 * MiB;
constexpr int CW_TMO = 0, CW_BAR = 4096, CW_CNT = 16384, CW_Q = 28672, CW_CONV = 29184, CW_DONE = 32768, CW_FIN = 40960;

constexpr int RING_OFF = 0, RING_BYTES = 131072;
constexpr int LDSCTL_OFF = 146432, MISC_OFF = LDSCTL_OFF + 320, TAB_OFF = LDSCTL_OFF + 512;
constexpr int LDS_BYTES = 147456;

#define GAS __attribute__((address_space(1)))
#define LAS __attribute__((address_space(3)))
typedef unsigned short bf16;
typedef unsigned v4u __attribute__((ext_vector_type(4)));
typedef unsigned v2u __attribute__((ext_vector_type(2)));
typedef float f32x4 __attribute__((ext_vector_type(4)));
typedef short bf16x8 __attribute__((ext_vector_type(8)));
typedef GAS unsigned gu32;
#define RLX_AGENT __ATOMIC_RELAXED, __HIP_MEMORY_SCOPE_AGENT
#define LDS_WAIT() asm volatile("s_waitcnt lgkmcnt(0)" ::: "memory")
#define VM_WAIT() asm volatile("s_waitcnt vmcnt(0)" ::: "memory")
__device__ __forceinline__ unsigned f2bf(float f) { unsigned u = __builtin_bit_cast(unsigned, f); return (u + 0x7fffu + ((u >> 16) & 1u)) >> 16; }
__device__ __forceinline__ unsigned pk2(float lo, float hi) { return f2bf(lo) | (f2bf(hi) << 16); }
__device__ __forceinline__ float bf2f(unsigned short b) { return __builtin_bit_cast(float, (unsigned)b << 16); }
__device__ __forceinline__ float bflo(unsigned w) { return __builtin_bit_cast(float, w << 16); }
__device__ __forceinline__ float bfhi(unsigned w) { return __builtin_bit_cast(float, w & 0xffff0000u); }
__device__ __forceinline__ float wave_sum(float v) {
#pragma unroll
    for (int o = 1; o < 64; o <<= 1) v += __shfl_xor(v, o);
    return v;
}

namespace pg8 {
struct DenseOrder {
    static constexpr bool GATHER = false, F8 = false; static constexpr int SCALE_B = 127;
    StaticOrder so; const char* A; const char* B; size_t astep, bstep;
    __device__ void init(const void* A_, const void* B_, int M, int N, int K, int G, int c) { so.init(M, N, G, c); A = (const char*)A_; B = (const char*)B_; astep = (size_t)256 * K * 2; bstep = astep; }
    __device__ __forceinline__ bool next(int i, Unit& u) const { u.e = 0; return so.next(i, u); }
    __device__ __forceinline__ const char* aptr(const Unit& u) const { return A + (size_t)u.pm * astep; }
    __device__ __forceinline__ const char* bptr(const Unit& u) const { return B + (size_t)u.pn * bstep; }
    __device__ __forceinline__ void a_ready(const Unit&) const {}
    __device__ __forceinline__ void done(const Unit&) const {}
};
struct DenseOrder8 {
    static constexpr bool GATHER = false, F8 = true; static constexpr int SCALE_B = 121;
    StaticOrder so; const char* A; const char* B; size_t astep, bstep;
    __device__ void init(const void* A_, const void* B_, int M, int N, int K, int G, int c) { so.init(M, N, G, c); A = (const char*)A_; B = (const char*)B_; astep = (size_t)256 * K * 2; bstep = astep; }
    __device__ __forceinline__ bool next(int i, Unit& u) const { u.e = 0; return so.next(i, u); }
    __device__ __forceinline__ const char* aptr(const Unit& u) const { return A + (size_t)u.pm * astep; }
    __device__ __forceinline__ const char* bptr(const Unit& u) const { return B + (size_t)u.pn * bstep; }
    __device__ __forceinline__ void a_ready(const Unit&) const {}
    __device__ __forceinline__ void done(const Unit&) const {}
};
struct DualOrder {
    static constexpr bool GATHER = false, F8 = false; static constexpr int SCALE_B = 127;
    StaticOrder so; int nwg2; const char* A; const char* B; const char* A2; const char* B2; size_t step;
    __device__ void init(const void* A_, const void* B_, int M, int N, int K, int G, int c, const void* A2_, const void* B2_, int nwg2_) { so.init(M, N, G, c); A = (const char*)A_; B = (const char*)B_; A2 = (const char*)A2_; B2 = (const char*)B2_; nwg2 = nwg2_; step = (size_t)256 * K * 2; }
    __device__ __forceinline__ bool next(int i, Unit& u) const { const int L = i * so.G + so.c; if (L < so.nwg) { u.e = 0; return so.next(i, u); } if (L - so.nwg >= nwg2) return false; u.e = 1; u.pm = 0; u.pn = L - so.nwg; return true; }
    __device__ __forceinline__ const char* aptr(const Unit& u) const { return u.e ? A2 : A + (size_t)u.pm * step; }
    __device__ __forceinline__ const char* bptr(const Unit& u) const { return (u.e ? B2 : B) + (size_t)u.pn * step; }
    __device__ __forceinline__ void a_ready(const Unit&) const {}
    __device__ __forceinline__ void done(const Unit&) const {}
};
struct DualOrder8 {
    static constexpr bool GATHER = false, F8 = true; static constexpr int SCALE_B = 121;
    StaticOrder so; int nwg2; const char* A; const char* B; const char* A2; const char* B2; size_t step;
    __device__ void init(const void* A_, const void* B_, int M, int N, int K, int G, int c, const void* A2_, const void* B2_, int nwg2_) { so.init(M, N, G, c); A = (const char*)A_; B = (const char*)B_; A2 = (const char*)A2_; B2 = (const char*)B2_; nwg2 = nwg2_; step = (size_t)256 * K * 2; }
    __device__ __forceinline__ bool next(int i, Unit& u) const { const int L = i * so.G + so.c; if (L < so.nwg) { u.e = 0; return so.next(i, u); } if (L - so.nwg >= nwg2) return false; u.e = 1; u.pm = 0; u.pn = L - so.nwg; return true; }
    __device__ __forceinline__ const char* aptr(const Unit& u) const { return u.e ? A2 : A + (size_t)u.pm * step; }
    __device__ __forceinline__ const char* bptr(const Unit& u) const { return (u.e ? B2 : B) + (size_t)u.pn * step; }
    __device__ __forceinline__ void a_ready(const Unit&) const {}
    __device__ __forceinline__ void done(const Unit&) const {}
};
struct MoeOrder {
    static constexpr bool GATHER = false, F8 = false; static constexpr int SCALE_B = 127;
    const PG8_LAS int* tstart; int ntn, G, c; const char* A; const char* W; size_t astep, wexp, wtile;
    __device__ __forceinline__ bool next(int i, Unit& u) const {
        const int L = i * G + c, total = tstart[32] * ntn; if (L >= total) return false;
        int wgid; { const int q = total / NXCD, r = total % NXCD, xcd = L % NXCD, off = L / NXCD; wgid = (xcd < r ? xcd * (q + 1) : r * (q + 1) + (xcd - r) * q) + off; }
        u.pm = wgid / ntn; u.pn = wgid - u.pm * ntn; int e = 0;
#pragma unroll
        for (int k = 1; k <= 31; ++k) e += (tstart[k] <= u.pm) ? 1 : 0;
        u.e = e; return true;
    }
    __device__ __forceinline__ const char* aptr(const Unit& u) const { return A + (size_t)u.pm * astep; }
    __device__ __forceinline__ const char* bptr(const Unit& u) const { return W + (size_t)u.e * wexp + (size_t)u.pn * wtile; }
    __device__ __forceinline__ void a_ready(const Unit&) const {}
    __device__ __forceinline__ void done(const Unit&) const {}
};

struct MoeOrder8 {
    static constexpr bool GATHER = false, F8 = true; static constexpr int SCALE_B = 121;
    const PG8_LAS int* tstart; int ntn, G, c; const char* A; const char* W; size_t astep, wexp, wtile;
    __device__ __forceinline__ bool next(int i, Unit& u) const {
        const int L = i * G + c, total = tstart[32] * ntn; if (L >= total) return false;
        int wgid; { const int q = total / NXCD, r = total % NXCD, xcd = L % NXCD, off = L / NXCD; wgid = (xcd < r ? xcd * (q + 1) : r * (q + 1) + (xcd - r) * q) + off; }
        u.pm = wgid / ntn; u.pn = wgid - u.pm * ntn; int e = 0;
#pragma unroll
        for (int k = 1; k <= 31; ++k) e += (tstart[k] <= u.pm) ? 1 : 0;
        u.e = e; return true;
    }
    __device__ __forceinline__ const char* aptr(const Unit& u) const { return A + (size_t)u.pm * astep; }
    __device__ __forceinline__ const char* bptr(const Unit& u) const { return W + (size_t)u.e * wexp + (size_t)u.pn * wtile; }
    __device__ __forceinline__ void a_ready(const Unit&) const {}
    __device__ __forceinline__ void done(const Unit&) const {}
};

struct MoeGatherOrder {
    static constexpr bool GATHER = true, F8 = true; static constexpr int SCALE_B = 121;
    const PG8_LAS int* tstart; const PG8_LAS int* cntl; const int* list; int ntn, G, c; const char* A; const char* W; size_t wexp, wtile; unsigned rowbytes;
    __device__ __forceinline__ bool next(int i, Unit& u) const {
        const int L = i * G + c, total = tstart[32] * ntn; if (L >= total) return false;
        int wgid; { const int q = total / NXCD, r = total % NXCD, xcd = L % NXCD, off = L / NXCD; wgid = (xcd < r ? xcd * (q + 1) : r * (q + 1) + (xcd - r) * q) + off; }
        u.pm = wgid / ntn; u.pn = wgid - u.pm * ntn; int e = 0;
#pragma unroll
        for (int k = 1; k <= 31; ++k) e += (tstart[k] <= u.pm) ? 1 : 0;
        u.e = e; return true;
    }
    __device__ __forceinline__ unsigned rowoff(const Unit& u, int r) const { const int rank = (u.pm - tstart[u.e]) * 256 + r; const int tok = list[u.e * 8192 + (rank < cntl[u.e] ? rank : 0)]; return (unsigned)tok * rowbytes; }
    __device__ __forceinline__ const char* aptr(const Unit&) const { return A; }
    __device__ __forceinline__ const char* bptr(const Unit& u) const { return W + (size_t)u.e * wexp + (size_t)u.pn * wtile; }
    __device__ __forceinline__ void a_ready(const Unit&) const {}
    __device__ __forceinline__ void done(const Unit&) const {}
};

typedef unsigned u32x2 __attribute__((ext_vector_type(2)));
struct EpiBf16X {
    static constexpr bool PERM = true, AFTER_DRAIN = false;
    int mode; bf16_t* p0; bf16_t* p1; bf16_t* p2; bf16_t* p3;
    const PG8_LAS int* tstart; const PG8_LAS int* cntl;
    __device__ __forceinline__ void operator()(const f32x4 (&acc)[2][2][4][2], const Unit& u, int wr, int wc, int fr, int fq) const {
#ifndef ATT_BF16
        if (mode == 1 && !u.e) {
            int tok0 = u.pm * BM + wr * 64 + fr, cc0 = wc * 32 + 8 * fq; asm volatile("" : "+v"(tok0), "+v"(cc0));
            if (u.pn >= 14) { const int colv = (u.pn - 14) * BM + cc0; unsigned char* vb = (unsigned char*)p2 + ((size_t)((colv >> 8) * 128 + (tok0 >> 6)) * 256 + (colv & 255)) * 64 + (tok0 & 63);
#pragma unroll
                for (int ai = 0; ai < 2; ++ai)
#pragma unroll
                    for (int m = 0; m < 4; ++m)
#pragma unroll
                        for (int bj = 0; bj < 2; ++bj) { const f32x4 v0 = acc[ai][bj][m][0], v1 = acc[ai][bj][m][1]; unsigned a_ = 0u, b_ = 0u;
                            a_ = __builtin_amdgcn_cvt_pk_fp8_f32(v0[0], v0[1], a_, false); a_ = __builtin_amdgcn_cvt_pk_fp8_f32(v0[2], v0[3], a_, true); b_ = __builtin_amdgcn_cvt_pk_fp8_f32(v1[0], v1[1], b_, false); b_ = __builtin_amdgcn_cvt_pk_fp8_f32(v1[2], v1[3], b_, true);
                            unsigned char* vp = vb + (size_t)(ai * 2) * 16384 + m * 16 + (size_t)bj * HALF * 64;
                            vp[0] = (unsigned char)a_; vp[64] = (unsigned char)(a_ >> 8); vp[128] = (unsigned char)(a_ >> 16); vp[192] = (unsigned char)(a_ >> 24);
                            vp[256] = (unsigned char)b_; vp[320] = (unsigned char)(b_ >> 8); vp[384] = (unsigned char)(b_ >> 16); vp[448] = (unsigned char)(b_ >> 24); }
                return; }
            if (u.pn >= 8) { unsigned char* kb = (unsigned char*)p1 + (size_t)tok0 * 1536 + (u.pn - 8) * BM + cc0;
#pragma unroll
                for (int ai = 0; ai < 2; ++ai)
#pragma unroll
                    for (int m = 0; m < 4; ++m)
#pragma unroll
                        for (int bj = 0; bj < 2; ++bj) { const f32x4 v0 = acc[ai][bj][m][0], v1 = acc[ai][bj][m][1]; unsigned a_ = 0u, b_ = 0u;
                            a_ = __builtin_amdgcn_cvt_pk_fp8_f32(v0[0], v0[1], a_, false); a_ = __builtin_amdgcn_cvt_pk_fp8_f32(v0[2], v0[3], a_, true); b_ = __builtin_amdgcn_cvt_pk_fp8_f32(v1[0], v1[1], b_, false); b_ = __builtin_amdgcn_cvt_pk_fp8_f32(v1[2], v1[3], b_, true);
                            u32x2 kk; kk.x = a_; kk.y = b_; *(u32x2*)(kb + (size_t)(ai * HALF + m * 16) * 1536 + bj * HALF) = kk; }
                return; }
            { unsigned char* qb = (unsigned char*)p0 + (WS_ZQ - WS_Z) + (size_t)tok0 * 2048 + u.pn * BM + cc0; bf16_t* zb = p0 + (size_t)tok0 * 2048 + u.pn * BM + cc0;
#pragma unroll
                for (int ai = 0; ai < 2; ++ai)
#pragma unroll
                    for (int m = 0; m < 4; ++m)
#pragma unroll
                        for (int bj = 0; bj < 2; ++bj) { const f32x4 v0 = acc[ai][bj][m][0] * QSCALE, v1 = acc[ai][bj][m][1] * QSCALE; unsigned a_ = 0u, b_ = 0u;
                            a_ = __builtin_amdgcn_cvt_pk_fp8_f32(v0[0], v0[1], a_, false); a_ = __builtin_amdgcn_cvt_pk_fp8_f32(v0[2], v0[3], a_, true); b_ = __builtin_amdgcn_cvt_pk_fp8_f32(v1[0], v1[1], b_, false); b_ = __builtin_amdgcn_cvt_pk_fp8_f32(v1[2], v1[3], b_, true);
                            const size_t o_ = (size_t)(ai * HALF + m * 16) * 2048 + bj * HALF;
                            u32x2 qq; qq.x = a_; qq.y = b_; *(u32x2*)(qb + o_) = qq;
                            u32x4 w; w.x = cvt_pk_bf16(v0[0], v0[1]); w.y = cvt_pk_bf16(v0[2], v0[3]); w.z = cvt_pk_bf16(v1[0], v1[1]); w.w = cvt_pk_bf16(v1[2], v1[3]); *(u32x4*)(zb + o_) = w; }
                return; }
        }
#endif
        bf16_t* base; int ldc, colt; bool act = false; float sc = 1.f;
        if (u.e && mode < 2) { base = p3 + (size_t)(u.pn >> 2) * (256 * 1024); ldc = 1024; colt = (u.pn & 3) * BM; }
        else if (mode == 0) { base = p0; ldc = 3584; colt = u.pn * BM; act = u.pn < 12; if (u.pn >= 12) sc = QSCALE; }
        else if (mode == 1) { if (u.pn < 8) { base = p0; ldc = 2048; colt = u.pn * BM; sc = QSCALE; }
                              else if (u.pn < 14) { base = p1; ldc = 1536; colt = (u.pn - 8) * BM; } else { base = p2; ldc = 1536; colt = (u.pn - 14) * BM; } }
        else { base = p0; ldc = 2048; colt = u.pn * BM; }
        const int row0 = u.pm * BM + wr * 64 + fr, col0 = colt + wc * 32 + 8 * fq;
        const int rlim = (mode == 3) ? cntl[u.e] - (u.pm - tstart[u.e]) * BM : BM;
#pragma unroll
        for (int ai = 0; ai < 2; ++ai)
#pragma unroll
            for (int m = 0; m < 4; ++m) { bf16_t* rowp = base + (size_t)(row0 + ai * HALF + m * 16) * ldc + col0;
                if (wr * 64 + fr + ai * HALF + m * 16 >= rlim) continue;
#pragma unroll
                for (int bj = 0; bj < 2; ++bj) { f32x4 v0 = acc[ai][bj][m][0], v1 = acc[ai][bj][m][1];
                    if (act) { f32x2 a = gelu_pk((f32x2){v0[0], v0[1]}), b = gelu_pk((f32x2){v0[2], v0[3]}), c = gelu_pk((f32x2){v1[0], v1[1]}), d = gelu_pk((f32x2){v1[2], v1[3]});
                        v0 = (f32x4){a.x, a.y, b.x, b.y}; v1 = (f32x4){c.x, c.y, d.x, d.y}; }
                    v0 = v0 * sc; v1 = v1 * sc; u32x4 w; w.x = cvt_pk_bf16(v0[0], v0[1]); w.y = cvt_pk_bf16(v0[2], v0[3]); w.z = cvt_pk_bf16(v1[0], v1[1]); w.w = cvt_pk_bf16(v1[2], v1[3]);
                    *(u32x4*)(rowp + bj * HALF) = w; } }
    }
};
struct EpiResBf16 {
    static constexpr bool PERM = true, AFTER_DRAIN = false;
    const bf16_t* xres; bf16_t* y; float alpha;
    __device__ __forceinline__ void operator()(const f32x4 (&acc)[2][2][4][2], const Unit& u, int wr, int wc, int fr, int fq) const {
        const int row0 = u.pm * BM + wr * 64 + fr, col0 = u.pn * BM + wc * 32 + 8 * fq;
#pragma unroll
        for (int ai = 0; ai < 2; ++ai)
#pragma unroll
            for (int m = 0; m < 4; ++m) { const size_t off = (size_t)(row0 + ai * HALF + m * 16) * 2048 + col0;
#pragma unroll
                for (int bj = 0; bj < 2; ++bj) { const u32x4 xr = *(const u32x4*)(xres + off + bj * HALF); const f32x4 v0 = acc[ai][bj][m][0], v1 = acc[ai][bj][m][1]; u32x4 w;
                    w.x = cvt_pk_bf16(__builtin_bit_cast(float, xr.x << 16) * alpha + v0[0], __builtin_bit_cast(float, xr.x & 0xffff0000u) * alpha + v0[1]);
                    w.y = cvt_pk_bf16(__builtin_bit_cast(float, xr.y << 16) * alpha + v0[2], __builtin_bit_cast(float, xr.y & 0xffff0000u) * alpha + v0[3]);
                    w.z = cvt_pk_bf16(__builtin_bit_cast(float, xr.z << 16) * alpha + v1[0], __builtin_bit_cast(float, xr.z & 0xffff0000u) * alpha + v1[1]);
                    w.w = cvt_pk_bf16(__builtin_bit_cast(float, xr.w << 16) * alpha + v1[2], __builtin_bit_cast(float, xr.w & 0xffff0000u) * alpha + v1[3]);
                    *(u32x4*)(y + off + bj * HALF) = w; } }
    }
};
struct EpiMoe1 {
    static constexpr bool PERM = true, AFTER_DRAIN = false;
    bf16_t* h; const PG8_LAS int* tstart; const PG8_LAS int* cntl;
    __device__ __forceinline__ void operator()(const f32x4 (&acc)[2][2][4][2], const Unit& u, int wr, int wc, int fr, int fq) const {
        const int row0 = u.pm * BM + wr * 64 + fr, col0 = u.pn * HALF + wc * 32 + 8 * fq;
        const int rlim = cntl[u.e] - (u.pm - tstart[u.e]) * BM;
#pragma unroll
        for (int ai = 0; ai < 2; ++ai)
#pragma unroll
            for (int m = 0; m < 4; ++m) { unsigned char* rowp = (unsigned char*)h + (size_t)(row0 + ai * HALF + m * 16) * 512 + col0; float o[8];
                if (wr * 64 + fr + ai * HALF + m * 16 >= rlim) continue;
#pragma unroll
                for (int n = 0; n < 2; ++n)
#pragma unroll
                    for (int x = 0; x < 4; ++x) { const float a = acc[ai][0][m][n][x], b = acc[ai][1][m][n][x];
                        o[n * 4 + x] = a * __builtin_amdgcn_rcpf(1.0f + __builtin_amdgcn_exp2f(-a * LOG2E)) * b; }
                unsigned lo = 0u, hi = 0u; lo = __builtin_amdgcn_cvt_pk_fp8_f32(o[0], o[1], lo, false); lo = __builtin_amdgcn_cvt_pk_fp8_f32(o[2], o[3], lo, true);
                hi = __builtin_amdgcn_cvt_pk_fp8_f32(o[4], o[5], hi, false); hi = __builtin_amdgcn_cvt_pk_fp8_f32(o[6], o[7], hi, true);
                typedef unsigned u32x2e __attribute__((ext_vector_type(2))); u32x2e w; w.x = lo; w.y = hi; *(u32x2e*)rowp = w; }
    }
};
}

namespace att {
using bf16x8 = __attribute__((ext_vector_type(8))) short;
using s16x4  = __attribute__((ext_vector_type(4))) short;
using f32x16 = __attribute__((ext_vector_type(16))) float;
using u32x4  = __attribute__((ext_vector_type(4))) unsigned;
constexpr int DH = 128, QBLK = 32, KVBLK = 64;
constexpr float THR2 = 8.f * 1.4426950408889634f;
constexpr size_t SHM_V = KVBLK * DH * 2, SHM_K = KVBLK * DH * 2, SHM_ATTN = 2 * SHM_V + 2 * SHM_K + NWAVES * 64 * 4;
constexpr int TAB_N = 160;
#define KSWZ(row, colB) ((row) * 256 + ((colB) ^ (((row) & 7) << 4)))
#define SBAR() __builtin_amdgcn_sched_barrier(0)
__device__ __forceinline__ int crow(int r, int hi) { return (r & 3) + 8 * (r >> 2) + 4 * hi; }
__device__ __forceinline__ unsigned cvtpk(float lo, float hi) { unsigned r; asm volatile("v_cvt_pk_bf16_f32 %0, %1, %2" : "=v"(r) : "v"(lo), "v"(hi)); return r; }

__device__ __forceinline__ void partialSM(f32x16& p0, f32x16& p1, float& m_reg, float& mn, float& alpha) {
  float pmax = p0[0];
#pragma unroll
  for (int r = 1; r < 16; ++r) pmax = fmaxf(pmax, p0[r]);
#pragma unroll
  for (int r = 0; r < 16; ++r) pmax = fmaxf(pmax, p1[r]);
  { auto rr = __builtin_amdgcn_permlane32_swap(__float_as_uint(pmax), __float_as_uint(pmax), false, false);
    pmax = fmaxf(__uint_as_float(rr[0]), __uint_as_float(rr[1])); }
  if (__builtin_expect(__all(pmax - m_reg <= THR2), 1)) { mn = m_reg; alpha = 1.f; }
  else { mn = fmaxf(m_reg, pmax); alpha = __builtin_amdgcn_exp2f(m_reg - mn); m_reg = mn; }
#pragma unroll
  for (int r = 0; r < 16; ++r) p0[r] = p0[r] - mn;
#pragma unroll
  for (int r = 0; r < 16; ++r) p1[r] = p1[r] - mn;
#pragma unroll
  for (int r = 0; r < 16; ++r) p0[r] = __builtin_amdgcn_exp2f(p0[r]);
}
__device__ __forceinline__ void finishSM(f32x16& p0, f32x16& p1, float alpha, float& l_reg, bf16x8& pa0, bf16x8& pa1, bf16x8& pa2, bf16x8& pa3) {
#pragma unroll
  for (int r = 0; r < 16; ++r) p1[r] = __builtin_amdgcn_exp2f(p1[r]);
  float ps = 0;
#pragma unroll
  for (int r = 0; r < 16; ++r) ps += p0[r];
#pragma unroll
  for (int r = 0; r < 16; ++r) ps += p1[r];
  { auto rr = __builtin_amdgcn_permlane32_swap(__float_as_uint(ps), __float_as_uint(ps), false, false);
    ps = __uint_as_float(rr[0]) + __uint_as_float(rr[1]); }
  l_reg = l_reg * alpha + ps;
#define PK4(P, BASE, OUT) do { unsigned a0 = cvtpk(P[BASE + 0], P[BASE + 1]), a1 = cvtpk(P[BASE + 2], P[BASE + 3]);   \
    unsigned b0 = cvtpk(P[BASE + 4], P[BASE + 5]), b1 = cvtpk(P[BASE + 6], P[BASE + 7]);                              \
    auto r0 = __builtin_amdgcn_permlane32_swap(a0, b0, false, false); auto r1 = __builtin_amdgcn_permlane32_swap(a1, b1, false, false); \
    u32x4 w = {r0[0], r1[0], r0[1], r1[1]}; OUT = *reinterpret_cast<bf16x8*>(&w); } while (0)
  PK4(p0, 0, pa0); PK4(p0, 8, pa1); PK4(p1, 0, pa2); PK4(p1, 8, pa3);
#undef PK4
}
__device__ __forceinline__ void qkt(f32x16& p0, f32x16& p1, const char* Ks, const bf16x8* qr, int r32, int hi) {
  p0 = f32x16{}; p1 = f32x16{};
#pragma unroll
  for (int d0 = 0; d0 < 8; ++d0) { const int cb = (d0 * 16 + hi * 8) * 2;
    bf16x8 b0 = *reinterpret_cast<const bf16x8*>(Ks + KSWZ(r32, cb));
    bf16x8 b1 = *reinterpret_cast<const bf16x8*>(Ks + KSWZ(32 + r32, cb));
    p0 = __builtin_amdgcn_mfma_f32_32x32x16_bf16(b0, qr[d0], p0, 0, 0, 0);
    p1 = __builtin_amdgcn_mfma_f32_32x32x16_bf16(b1, qr[d0], p1, 0, 0, 0); }
}
__device__ __forceinline__ int v_st(int k, int c) { const int kk = (k & ~0xC) | ((k & 4) << 1) | ((k & 8) >> 1); return ((kk >> 3) * 4 + (c >> 5)) * 512 + ((kk & 7) * 32 + (c & 31)) * 2; }
__device__ __forceinline__ int v_rd_base(int lane) { return ((lane & 3) << 3) | (((lane >> 2) & 3) << 6) | (((lane >> 4) & 1) << 5) | (((lane >> 5) & 1) << 8); }
constexpr int v_rd_off(int d0, int ks, int half) { return d0 * 512 + ks * 4096 + half * 2048; }
template <int OFF> __device__ __forceinline__ s16x4 tr_read(int vb) {
  s16x4 r; asm volatile("ds_read_b64_tr_b16 %0, %1 offset:%2" : "=&v"(r) : "v"(vb), "i"(OFF) : "memory"); return r;
}
template <int D0> __device__ __forceinline__ void pv_one(f32x16& od, int vb, bf16x8 pa0, bf16x8 pa1, bf16x8 pa2, bf16x8 pa3) {
  const s16x4 l0 = tr_read<v_rd_off(D0, 0, 0)>(vb), h0 = tr_read<v_rd_off(D0, 0, 1)>(vb), l1 = tr_read<v_rd_off(D0, 1, 0)>(vb), h1 = tr_read<v_rd_off(D0, 1, 1)>(vb);
  const s16x4 l2 = tr_read<v_rd_off(D0, 2, 0)>(vb), h2 = tr_read<v_rd_off(D0, 2, 1)>(vb), l3 = tr_read<v_rd_off(D0, 3, 0)>(vb), h3 = tr_read<v_rd_off(D0, 3, 1)>(vb);
  asm volatile("s_waitcnt lgkmcnt(0)" ::: "memory"); SBAR();
#define PK(L, H) (bf16x8){L[0], L[1], L[2], L[3], H[0], H[1], H[2], H[3]}
  od = __builtin_amdgcn_mfma_f32_32x32x16_bf16(pa0, PK(l0, h0), od, 0, 0, 0);
  od = __builtin_amdgcn_mfma_f32_32x32x16_bf16(pa1, PK(l1, h1), od, 0, 0, 0);
  od = __builtin_amdgcn_mfma_f32_32x32x16_bf16(pa2, PK(l2, h2), od, 0, 0, 0);
  od = __builtin_amdgcn_mfma_f32_32x32x16_bf16(pa3, PK(l3, h3), od, 0, 0, 0);
#undef PK
}
__device__ __forceinline__ void pv_d0(f32x16* o, int vb, bf16x8 pa0, bf16x8 pa1, bf16x8 pa2, bf16x8 pa3) {
  pv_one<0>(o[0], vb, pa0, pa1, pa2, pa3); pv_one<1>(o[1], vb, pa0, pa1, pa2, pa3); pv_one<2>(o[2], vb, pa0, pa1, pa2, pa3); pv_one<3>(o[3], vb, pa0, pa1, pa2, pa3);
}
template <int MODE> __device__ __forceinline__ void post_scores(f32x16& p0, f32x16& p1, int t, int qrow0, int r32, int hi, const float* tab, float cfar) {
  if constexpr (MODE == 1) {
    const int cw = qrow0 >> 6;
    if (t > cw) {
#pragma unroll
      for (int r = 0; r < 16; ++r) { p0[r] = -INFINITY; p1[r] = -INFINITY; }
    } else if (qrow0 - (64 * t + 63) >= 91) {
#pragma unroll
      for (int r = 0; r < 16; ++r) { p0[r] += cfar; p1[r] += cfar; }
    } else {
      const int base = qrow0 + r32 - 64 * t + 63;
#pragma unroll
      for (int r = 0; r < 16; ++r) { const int i0 = base - crow(r, hi); const int i1 = i0 - 32;
        p0[r] += tab[i0 < TAB_N - 1 ? i0 : TAB_N - 1]; p1[r] += tab[i1 < TAB_N - 1 ? i1 : TAB_N - 1]; }
    }
  }
}

template <int MODE>
__device__ __forceinline__ void attn_body(const bf16* __restrict__ Qb, int ldq, const bf16* __restrict__ Kh, const bf16* __restrict__ Vh, int ldk,
                                          bf16* Ob, float* Of, int ldo, int NT, int q0abs, const float* tab, float cfar, char* lds) {
  int tid_ = threadIdx.x; asm volatile("" : "+v"(tid_));
  const int tid = tid_, wid = tid >> 6, lane = tid & 63, r32 = lane & 31, hi = lane >> 5;
  char* V_lds = lds; char* K_lds = lds + 2 * SHM_V;
  float* ws = (float*)(lds + 2 * SHM_V + 2 * SHM_K) + wid * 64; float* li_l = ws; float* al_l = ws + 32;
  float m_reg = -1e30f, l_reg = 0; f32x16 o[4] = {}; bf16x8 qr[8];
  const int qrow0 = q0abs + wid * QBLK;
  const bf16* Qw = Qb + (long)(wid * QBLK + r32) * ldq + hi * 8;
#pragma unroll
  for (int d0 = 0; d0 < 8; ++d0) qr[d0] = *reinterpret_cast<const bf16x8*>(Qw + d0 * 16);
  const int sr = tid >> 4, sc = (tid & 15) * 8, vst0 = v_st(sr, sc), vst1 = v_st(32 + sr, sc);
  const int vb0 = (int)(uintptr_t)V_lds + v_rd_base(lane);
  struct { bf16x8 vs0, vs1, ks0, ks1; } sr_[2];
#define SLOAD(i, k0) do { sr_[i].vs0 = *reinterpret_cast<const bf16x8*>(&Vh[(long)((k0) + sr) * ldk + sc]); sr_[i].vs1 = *reinterpret_cast<const bf16x8*>(&Vh[(long)((k0) + 32 + sr) * ldk + sc]); \
    sr_[i].ks0 = *reinterpret_cast<const bf16x8*>(&Kh[(long)((k0) + sr) * ldk + sc]); sr_[i].ks1 = *reinterpret_cast<const bf16x8*>(&Kh[(long)((k0) + 32 + sr) * ldk + sc]); } while (0)
#define SWRITE(b, i) do { *(bf16x8*)(V_lds + (b) * SHM_V + vst0) = sr_[i].vs0;          \
    *(bf16x8*)(V_lds + (b) * SHM_V + vst1) = sr_[i].vs1; const int kc = sc * 2;               \
    *(bf16x8*)(K_lds + (b) * SHM_K + KSWZ(sr, kc)) = sr_[i].ks0;                       \
    *(bf16x8*)(K_lds + (b) * SHM_K + KSWZ(32 + sr, kc)) = sr_[i].ks1; } while (0)
#define SWAIT() asm volatile("s_waitcnt vmcnt(4)" ::: "memory")
#define RESC(a) do { if (__any((a) < 1.f)) { if (hi == 0) al_l[r32] = (a); asm volatile("s_waitcnt lgkmcnt(0)" ::: "memory"); \
    _Pragma("unroll") for (int d = 0; d < 4; ++d) _Pragma("unroll") for (int r = 0; r < 16; ++r) o[d][r] *= al_l[crow(r, hi)]; } } while (0)
  f32x16 pA0, pA1, pB0, pB1; float mnA, mnB, alA, alB; bf16x8 pa0, pa1, pa2, pa3;
  constexpr int SE = 0, SO = 1;
  SLOAD(SE, 0); asm volatile("s_waitcnt vmcnt(0)" ::: "memory"); SWRITE(0, SE); __syncthreads();
  qkt(pA0, pA1, K_lds, qr, r32, hi); post_scores<MODE>(pA0, pA1, 0, qrow0, r32, hi, tab, cfar); partialSM(pA0, pA1, m_reg, mnA, alA);
  SLOAD(SO, KVBLK); if (2 < NT) SLOAD(SE, 2 * KVBLK);
  SWAIT(); SWRITE(1, SO); __syncthreads();
  for (int j = 1; j + 1 < NT; j += 2) {
    SBAR(); qkt(pB0, pB1, K_lds + SHM_K, qr, r32, hi); post_scores<MODE>(pB0, pB1, j, qrow0, r32, hi, tab, cfar);
    finishSM(pA0, pA1, alA, l_reg, pa0, pa1, pa2, pa3); SBAR();
    SLOAD(SO, (j + 2) * KVBLK); SBAR();
    pv_d0(o, vb0, pa0, pa1, pa2, pa3); partialSM(pB0, pB1, m_reg, mnB, alB);
    __syncthreads(); SWAIT(); SWRITE(0, SE);
    RESC(alB); __syncthreads();
    SBAR(); qkt(pA0, pA1, K_lds, qr, r32, hi); post_scores<MODE>(pA0, pA1, j + 1, qrow0, r32, hi, tab, cfar);
    finishSM(pB0, pB1, alB, l_reg, pa0, pa1, pa2, pa3); SBAR();
    if (j + 3 < NT) SLOAD(SE, (j + 3) * KVBLK); SBAR();
    pv_d0(o, vb0 + (int)SHM_V, pa0, pa1, pa2, pa3); partialSM(pA0, pA1, m_reg, mnA, alA);
    __syncthreads(); SWAIT(); SWRITE(1, SO);
    RESC(alA); __syncthreads();
  }
  SBAR(); qkt(pB0, pB1, K_lds + SHM_K, qr, r32, hi); post_scores<MODE>(pB0, pB1, NT - 1, qrow0, r32, hi, tab, cfar);
  finishSM(pA0, pA1, alA, l_reg, pa0, pa1, pa2, pa3); SBAR();
  pv_d0(o, vb0, pa0, pa1, pa2, pa3); partialSM(pB0, pB1, m_reg, mnB, alB);
  __syncthreads(); RESC(alB);
  finishSM(pB0, pB1, alB, l_reg, pa0, pa1, pa2, pa3); SBAR();
  pv_d0(o, vb0 + (int)SHM_V, pa0, pa1, pa2, pa3);
  if (hi == 0) li_l[r32] = l_reg; asm volatile("s_waitcnt lgkmcnt(0)" ::: "memory");
  float rli[16];
#pragma unroll
  for (int r = 0; r < 16; ++r) rli[r] = __builtin_amdgcn_rcpf(li_l[crow(r, hi)]);
  if constexpr (MODE == 0) {
    bf16* Ow = Ob + (long)(wid * QBLK) * ldo;
#pragma unroll
    for (int r = 0; r < 16; ++r) { const int orow = crow(r, hi);
#pragma unroll
      for (int d0 = 0; d0 < 4; ++d0) Ow[(long)orow * ldo + d0 * 32 + r32] = (bf16)f2bf(o[d0][r] * rli[r]); }
  } else {
    float* Ow = Of + (long)(wid * QBLK) * ldo;
#pragma unroll
    for (int r = 0; r < 16; ++r) { const int orow = crow(r, hi);
#pragma unroll
      for (int d0 = 0; d0 < 4; ++d0) Ow[(long)orow * ldo + d0 * 32 + r32] = o[d0][r] * rli[r]; }
  }
  __syncthreads();
#undef SLOAD
#undef SWRITE
#undef SWAIT
#undef RESC
}
}

#define XB_TMO      128
#define XB_XCNT(j)  (256  + 64 * (j))
#define XB_XSUB(j)  (1280 + 64 * (j))
#define XB_XGEN(j)  (2304 + 64 * (j))
#define XB_TOP      3328
#define XB_TOPGEN   3392
#define XCD_BAR_WORDS 3456
#define XB_SPIN_CAP (1u << 18)

__device__ __forceinline__ unsigned xb_ld(unsigned* p)              { return __hip_atomic_load(p, __ATOMIC_RELAXED, __HIP_MEMORY_SCOPE_AGENT); }
__device__ __forceinline__ unsigned xb_add(unsigned* p, unsigned v) { return __hip_atomic_fetch_add(p, v, __ATOMIC_RELAXED, __HIP_MEMORY_SCOPE_AGENT); }
__device__ __forceinline__ unsigned xb_xcc_id() { return (unsigned)__builtin_amdgcn_s_getreg((3 << 11) | 20) & 0xFu; }
#define XB_SPIN(cond, bar) do { unsigned _sp = 0; while (cond) { __builtin_amdgcn_s_sleep(1); \
    if ((++_sp & 255u) == 0u) { if (xb_ld(&(bar)[XB_TMO])) break; if (_sp > XB_SPIN_CAP) { atomicAdd(&(bar)[XB_TMO], 1u); break; } } } } while (0)

struct XcdBarrier {
    unsigned* bar; unsigned x;
    volatile LAS unsigned* st;
};

__device__ __forceinline__ XcdBarrier xcd_barrier_post(unsigned* bar, volatile LAS unsigned* st) {
    XcdBarrier b; b.bar = bar; b.x = xb_xcc_id(); b.st = st;
    if (threadIdx.x == 0) (void)xb_add(&bar[XB_XCNT(b.x)], 1u);
    return b;
}
__device__ __forceinline__ void xcd_barrier_complete(unsigned* bar, unsigned x, unsigned& nloc, unsigned& nx) {
    const unsigned G = gridDim.x * gridDim.y * gridDim.z;
    unsigned sum, cnt, mine, sp = 0u;
    for (;;) {
        sum = 0u; cnt = 0u; mine = 0u;
#pragma unroll
        for (unsigned j = 0; j < 16; ++j) { const unsigned c = xb_ld(&bar[XB_XCNT(j)]); sum += c; cnt += (c > 0u) ? 1u : 0u; mine = (j == x) ? c : mine; }
        if (sum == G) break;
        __builtin_amdgcn_s_sleep(1);
        if ((++sp & 255u) == 0u) { if (xb_ld(&bar[XB_TMO])) break; if (sp > XB_SPIN_CAP) { atomicAdd(&bar[XB_TMO], 1u); break; } }
    }
    nloc = mine > 0u ? mine : 1u; nx = cnt > 0u ? cnt : 1u;
}

__device__ __forceinline__ void xcd_barrier(const XcdBarrier& b) {
    asm volatile("s_waitcnt vmcnt(0)" ::: "memory");
    __syncthreads();
    if (threadIdx.x == 0) {
        unsigned* bar = b.bar;
        __builtin_amdgcn_s_waitcnt(0);
        unsigned nloc = b.st[0], nx = b.st[1];
        if (nloc == 0u) { xcd_barrier_complete(bar, b.x, nloc, nx); b.st[0] = nloc; b.st[1] = nx; }
        const unsigned old = xb_add(&bar[XB_XSUB(b.x)], 1u);
        const unsigned gen = old / nloc;
        if (old + 1u == (gen + 1u) * nloc) {
            __builtin_amdgcn_fence(__ATOMIC_RELEASE, "agent");
            asm volatile("s_waitcnt vmcnt(0)" ::: "memory");
            const unsigned og = xb_add(&bar[XB_TOP], 1u);
            const unsigned tg = og / nx;
            if (og + 1u == (tg + 1u) * nx) xb_add(&bar[XB_TOPGEN], 1u);
            else XB_SPIN(xb_ld(&bar[XB_TOPGEN]) == tg, bar);
            __builtin_amdgcn_fence(__ATOMIC_ACQUIRE, "agent");
            xb_add(&bar[XB_XGEN(b.x)], 1u);
            asm volatile("s_waitcnt vmcnt(0)" ::: "memory");
        } else {
            XB_SPIN(xb_ld(&bar[XB_XGEN(b.x)]) == gen, bar);
            __builtin_amdgcn_fence(__ATOMIC_ACQUIRE, "agent");
            asm volatile("s_waitcnt vmcnt(0)" ::: "memory");
        }
    }
    __syncthreads();
}


struct Args { const float* in[24]; float* out; unsigned char* ws; int ph_lo, ph_hi; };
enum { I_X = 0, I_MEM, I_AWIN, I_ALNG, I_ALNB, I_AWS, I_ABS, I_AWOUT, I_BWIN, I_BLAM, I_BSUBG, I_BWOUT, I_WKV, I_RELB, I_MEMWKV, I_LNG, I_LNB,
       I_WG1, I_BG1, I_WG2, I_BG2, I_W1, I_W3, I_W2 };
constexpr int NPH_LAYER = 9, NPHASES = 1 + DEPTH * NPH_LAYER;

struct Frame {
    LAS unsigned char* lds; char* ldsg;
    gu32* ctl; unsigned char* ws;
    int tid, lane, wave, G, c;
};

__device__ __forceinline__ void transpose_item(const float* W, int K, int N, bf16* WT, int drow0, LAS float* scr, int k0, int n0, int lane) {
#pragma unroll 8
    for (int i = 0; i < 32; ++i) { const int kk = 2 * i + (lane >> 5); scr[kk * 33 + (lane & 31)] = W[(size_t)(k0 + kk) * N + n0 + (lane & 31)]; }
    LDS_WAIT(); asm volatile("" ::: "memory");
    const int c = lane & 7;
#pragma unroll
    for (int j = 0; j < 4; ++j) { const int n = (lane >> 3) + 8 * j; const LAS float* s = scr + (8 * c) * 33 + n;
        v4u o; o.x = pk2(s[0 * 33], s[1 * 33]); o.y = pk2(s[2 * 33], s[3 * 33]); o.z = pk2(s[4 * 33], s[5 * 33]); o.w = pk2(s[6 * 33], s[7 * 33]);
        *(GAS v4u*)(WT + (size_t)(drow0 + n) * K + k0 + 8 * c) = o; }
    LDS_WAIT(); asm volatile("" ::: "memory");
}
__device__ __forceinline__ void transpose_item_fast(const float* W, int K, int N, bf16* WT, int drow0, LAS float* scr, int k0, int n0, int lane) {
    float t[32];
#pragma unroll
    for (int i = 0; i < 32; ++i) t[i] = W[(size_t)(k0 + 2 * i + (lane >> 5)) * N + n0 + (lane & 31)];
#pragma unroll
    for (int i = 0; i < 32; i += 8) asm volatile("" : "+v"(t[i]), "+v"(t[i + 1]), "+v"(t[i + 2]), "+v"(t[i + 3]), "+v"(t[i + 4]), "+v"(t[i + 5]), "+v"(t[i + 6]), "+v"(t[i + 7]));
#pragma unroll
    for (int i = 0; i < 32; ++i) scr[(2 * i + (lane >> 5)) * 33 + (lane & 31)] = t[i];
    LDS_WAIT(); asm volatile("" ::: "memory");
    const int c = lane & 7;
#pragma unroll
    for (int j = 0; j < 4; ++j) { const int n = (lane >> 3) + 8 * j; const LAS float* s = scr + (8 * c) * 33 + n;
        v4u o; o.x = pk2(s[0 * 33], s[1 * 33]); o.y = pk2(s[2 * 33], s[3 * 33]); o.z = pk2(s[4 * 33], s[5 * 33]); o.w = pk2(s[6 * 33], s[7 * 33]);
        *(GAS v4u*)(WT + (size_t)(drow0 + n) * K + k0 + 8 * c) = o; }
    LDS_WAIT(); asm volatile("" ::: "memory");
}
__device__ __forceinline__ void transpose_item_fp8(const float* W, int K, int N, unsigned char* WT, int drow0, LAS float* scr, int k0, int n0, int lane) {
    float t[32];
#pragma unroll
    for (int i = 0; i < 32; ++i) t[i] = W[(size_t)(k0 + 2 * i + (lane >> 5)) * N + n0 + (lane & 31)];
#pragma unroll
    for (int i = 0; i < 32; i += 8) asm volatile("" : "+v"(t[i]), "+v"(t[i + 1]), "+v"(t[i + 2]), "+v"(t[i + 3]), "+v"(t[i + 4]), "+v"(t[i + 5]), "+v"(t[i + 6]), "+v"(t[i + 7]));
#pragma unroll
    for (int i = 0; i < 32; ++i) scr[(2 * i + (lane >> 5)) * 33 + (lane & 31)] = t[i];
    LDS_WAIT(); asm volatile("" ::: "memory");
    const int c = lane & 7;
#pragma unroll
    for (int j = 0; j < 4; ++j) { const int n = (lane >> 3) + 8 * j; const LAS float* s = scr + (8 * c) * 33 + n;
        unsigned lo = 0u, hi = 0u;
        lo = __builtin_amdgcn_cvt_pk_fp8_f32(s[0 * 33] * 64.f, s[1 * 33] * 64.f, lo, false); lo = __builtin_amdgcn_cvt_pk_fp8_f32(s[2 * 33] * 64.f, s[3 * 33] * 64.f, lo, true);
        hi = __builtin_amdgcn_cvt_pk_fp8_f32(s[4 * 33] * 64.f, s[5 * 33] * 64.f, hi, false); hi = __builtin_amdgcn_cvt_pk_fp8_f32(s[6 * 33] * 64.f, s[7 * 33] * 64.f, hi, true);
        v2u o; o.x = lo; o.y = hi; *(GAS v2u*)(WT + (size_t)(drow0 + n) * K + k0 + 8 * c) = o; }
    LDS_WAIT(); asm volatile("" ::: "memory");
}
#ifndef CDRAIN
#define CDRAIN 8
#endif
#ifndef CSRV
#define CSRV 4
#endif
#ifndef CSRVA
#define CSRVA 32
#endif
#ifndef STOPU
#define STOPU 64
#endif
#ifndef QX
#define QX 6
#endif
#ifndef QA
#define QA 14
#endif
#ifndef QM
#define QM 7
#endif
#ifndef QB
#define QB 4
#endif
constexpr int NQ = 7, MOE_ITEMS = 3 * 32 * 512;
__device__ __forceinline__ int conv_qsize(int q) { return (q & 1) ? (q == 1 ? 5632 : (q == 3 ? 7168 : 4096)) : MOE_ITEMS; }
__device__ __forceinline__ void conv_item(Frame& F, const Args& a, int q, int it) {
    LAS float* scr = (LAS float*)(F.lds + RING_OFF + F.wave * 16384);
    if (q & 1) {
        const float* src; bf16* dst; int N, r = it;
        if (q == 1) { if (r < 3584) { N = 3584; src = a.in[I_AWIN] + (size_t)2048 * 3584; dst = (bf16*)(F.ws + WS_WAIN) + (size_t)2048 * 3584; } else { r -= 3584; N = 2048; src = a.in[I_AWOUT] + (size_t)2048 * 2048; dst = (bf16*)(F.ws + WS_WAOUT) + (size_t)2048 * 2048; } }
        else if (q == 3) { if (r < 2048) { N = 2048; src = a.in[I_BWIN]; dst = (bf16*)(F.ws + WS_WBIN0); } else if ((r -= 2048) < 3072) { N = 3072; src = a.in[I_WKV]; dst = (bf16*)(F.ws + WS_WKV); } else { r -= 3072; N = 2048; src = a.in[I_BWOUT]; dst = (bf16*)(F.ws + WS_WBOUT); } }
        else { if (r < 2048) { N = 2048; src = a.in[I_BWIN] + (size_t)2048 * 2048; dst = (bf16*)(F.ws + WS_WBIN1); } else { r -= 2048; N = 2048; src = a.in[I_BWOUT] + (size_t)2048 * 2048; dst = (bf16*)(F.ws + WS_WBOUT) + (size_t)2048 * 2048; } }
        const int nblk = N / 32, kb = r / nblk, nb = r - kb * nblk;
        transpose_item_fast(src, 2048, N, dst, 32 * nb, scr, 64 * kb, 32 * nb, F.lane);
        return;
    }
    const int L = q >> 1, seg = it >> 14, r0 = it & 16383, e = r0 >> 9, r = r0 & 511, mat = L * 32 + e;
    if (seg < 2) { const int kb = r >> 4, nb = r & 15, n0 = 32 * nb;
        transpose_item_fp8(a.in[seg == 0 ? I_W1 : I_W3] + (size_t)mat * 2048 * 512, 2048, 512, (unsigned char*)(F.ws + WS_W13) + (size_t)mat * 1024 * 2048, (n0 >> 7) * 256 + (n0 & 127) + (seg == 1 ? 128 : 0), scr, 64 * kb, n0, F.lane); }
    else { const int kb = r >> 6, nb = r & 63;
        transpose_item_fp8(a.in[I_W2] + (size_t)mat * 512 * 2048, 512, 2048, (unsigned char*)(F.ws + WS_W2) + (size_t)mat * 512 * 2048, 32 * nb, scr, 64 * kb, 32 * nb, F.lane); }
}
#ifndef F8MASK
#define F8MASK 4
#endif
#define F8L(l) (((F8MASK) >> (l)) & 1)
#ifndef F8OMASK
#define F8OMASK 12
#endif
#define F8OL(l) (((F8OMASK) >> (l)) & 1)
#ifndef CDEPTH
#define CDEPTH 3
#endif
struct CDesc { const float* src; unsigned char* dst; int N, K, drow0, k0, n0, f8; };
__device__ __forceinline__ CDesc conv_desc(Frame& F, const Args& a, int q, int it) {
    CDesc d;
    if (q & 1) {
        const float* src; unsigned char* dst; int N, r = it, f8 = F8L((q + 1) >> 1);
        if (q == 1) { if (r < 3584) { N = 3584; src = a.in[I_AWIN] + (size_t)2048 * 3584; dst = F.ws + WS_WAIN + (size_t)2048 * 3584 * 2; } else { r -= 3584; N = 2048; f8 = 0; src = a.in[I_AWOUT] + (size_t)2048 * 2048; dst = F.ws + WS_WAOUT + (size_t)2048 * 2048 * 2; } }
        else if (q == 3) { if (r < 2048) { N = 2048; src = a.in[I_BWIN]; dst = F.ws + WS_WBIN0; } else if ((r -= 2048) < 3072) { N = 3072; src = a.in[I_WKV]; dst = F.ws + WS_WBIN0 + (size_t)2048 * 2048 * (F8L(2) ? 1 : 2); } else { r -= 3072; N = 2048; f8 = F8OL(2); src = a.in[I_BWOUT]; dst = F.ws + WS_WBOUT; } }
        else { if (r < 2048) { N = 2048; src = a.in[I_BWIN] + (size_t)2048 * 2048; dst = F.ws + WS_WBIN1; } else { r -= 2048; N = 2048; f8 = F8OL(3); src = a.in[I_BWOUT] + (size_t)2048 * 2048; dst = F.ws + WS_WBOUT + (size_t)2048 * 2048 * 2; } }
        const int nblk = N / 32, kb = r / nblk, nb = r - kb * nblk;
        d.src = src; d.dst = dst; d.N = N; d.K = 2048; d.drow0 = 32 * nb; d.k0 = 64 * kb; d.n0 = 32 * nb; d.f8 = f8; return d;
    }
    const int L = q >> 1, seg = it >> 14, r0 = it & 16383, e = r0 >> 9, r = r0 & 511, mat = L * 32 + e;
    if (seg < 2) { const int kb = r >> 4, nb = r & 15, n0 = 32 * nb;
        d.src = a.in[seg == 0 ? I_W1 : I_W3] + (size_t)mat * 2048 * 512; d.dst = (unsigned char*)(F.ws + WS_W13) + (size_t)mat * 1024 * 2048; d.N = 512; d.K = 2048;
        d.drow0 = (n0 >> 7) * 256 + (n0 & 127) + (seg == 1 ? 128 : 0); d.k0 = 64 * kb; d.n0 = n0; d.f8 = 1; }
    else { const int kb = r >> 6, nb = r & 63;
        d.src = a.in[I_W2] + (size_t)mat * 512 * 2048; d.dst = (unsigned char*)(F.ws + WS_W2) + (size_t)mat * 512 * 2048; d.N = 2048; d.K = 512; d.drow0 = 32 * nb; d.k0 = 64 * kb; d.n0 = 32 * nb; d.f8 = 1; }
    return d;
}
#define CV_LOAD(t_, d_) do { const float* p_ = (d_).src + (size_t)((d_).k0 + (F.lane >> 3)) * (d_).N + (d_).n0 + 4 * (F.lane & 7); const size_t st_ = (size_t)8 * (d_).N; \
    _Pragma("unroll") for (int i_ = 0; i_ < 8; ++i_) (t_)[i_] = *(const GAS f32x4*)(p_ + st_ * i_); } while (0)
__device__ __forceinline__ void conv_process(Frame& F, f32x4 (&t)[8], const CDesc& d) {
    LAS float* scr = (LAS float*)(F.lds + RING_OFF + F.wave * 16384); const int lane = F.lane;
    asm volatile("" : "+v"(t[0]), "+v"(t[1]), "+v"(t[2]), "+v"(t[3]), "+v"(t[4]), "+v"(t[5]), "+v"(t[6]), "+v"(t[7]));
    { LAS float* w = scr + (lane >> 3) * 33 + 4 * (lane & 7);
#pragma unroll
      for (int i = 0; i < 8; ++i) { w[i * 8 * 33 + 0] = t[i].x; w[i * 8 * 33 + 1] = t[i].y; w[i * 8 * 33 + 2] = t[i].z; w[i * 8 * 33 + 3] = t[i].w; } }
    LDS_WAIT(); asm volatile("" ::: "memory");
    const int c = lane & 7;
    if (d.f8) {
#pragma unroll
        for (int j = 0; j < 4; ++j) { const int n = (lane >> 3) + 8 * j; const LAS float* s = scr + (8 * c) * 33 + n;
            unsigned lo = 0u, hi = 0u;
            lo = __builtin_amdgcn_cvt_pk_fp8_f32(s[0 * 33] * 64.f, s[1 * 33] * 64.f, lo, false); lo = __builtin_amdgcn_cvt_pk_fp8_f32(s[2 * 33] * 64.f, s[3 * 33] * 64.f, lo, true);
            hi = __builtin_amdgcn_cvt_pk_fp8_f32(s[4 * 33] * 64.f, s[5 * 33] * 64.f, hi, false); hi = __builtin_amdgcn_cvt_pk_fp8_f32(s[6 * 33] * 64.f, s[7 * 33] * 64.f, hi, true);
            v2u o; o.x = lo; o.y = hi; *(GAS v2u*)(d.dst + (size_t)(d.drow0 + n) * d.K + d.k0 + 8 * c) = o; }
    } else {
#pragma unroll
        for (int j = 0; j < 4; ++j) { const int n = (lane >> 3) + 8 * j; const LAS float* s = scr + (8 * c) * 33 + n;
            v4u o; o.x = pk2(s[0 * 33], s[1 * 33]); o.y = pk2(s[2 * 33], s[3 * 33]); o.z = pk2(s[4 * 33], s[5 * 33]); o.w = pk2(s[6 * 33], s[7 * 33]);
            *(GAS v4u*)((bf16*)d.dst + (size_t)(d.drow0 + n) * d.K + d.k0 + 8 * c) = o; }
    }
    LDS_WAIT(); asm volatile("" ::: "memory");
}
__device__ __forceinline__ void conv_range(Frame& F, const Args& a, int q, int first, int cnt) {
#if CDEPTH == 1
    for (int i = 0; i < cnt; ++i) conv_item(F, a, q, first + i);
#else
    f32x4 t[CDEPTH][8]; const int last = first + cnt - 1;
#pragma unroll
    for (int s = 0; s < CDEPTH - 1; ++s) { const int it = first + s < last ? first + s : last; const CDesc d = conv_desc(F, a, q, it); CV_LOAD(t[s], d); }
#pragma unroll 1
    for (int i0 = 0; i0 < cnt; i0 += CDEPTH) {
#pragma unroll
        for (int s = 0; s < CDEPTH; ++s) {
            { const int nx = first + i0 + s + CDEPTH - 1, it = nx < last ? nx : last; const CDesc d = conv_desc(F, a, q, it); CV_LOAD(t[(s + CDEPTH - 1) % CDEPTH], d); }
            asm volatile("" ::: "memory");
            if (i0 + s < cnt) { const CDesc d = conv_desc(F, a, q, first + i0 + s); conv_process(F, t[s], d); }
        }
    }
#endif
}
__device__ __forceinline__ void conv_filler(Frame& F, const Args& a, int q0, int n) {
    if (q0 >= NQ || n == 0) return;
#ifdef CONV_ALL_PRO
    return;
#endif
    LAS unsigned* bw = (LAS unsigned*)(F.lds + TAB_OFF + 384);
    __syncthreads();
    const bool drain = n < 0; const int per = drain ? CDRAIN : n; int q = q0;
    for (;;) {
        if (F.tid == 0) bw[0] = __hip_atomic_fetch_add(F.ctl + CW_CONV + 64 * q, (unsigned)(8 * per), RLX_AGENT);
        __syncthreads();
        const unsigned idx = bw[0];
        __syncthreads();
        const int qs = conv_qsize(q);
        if (idx >= (unsigned)qs) { if (drain || ++q >= NQ) break; continue; }
        { const int first = (int)idx + F.wave * per, cnt = (qs - first < per) ? qs - first : per; if (cnt > 0) conv_range(F, a, q, first, cnt); }
        if (!drain) break;
    }
}

__device__ __forceinline__ void prologue_phase(Frame& F, const Args& a) {
#ifdef TOUCH
    {
        const long nthr_ = (long)F.G * 512, gt_ = (long)F.c * 512 + F.tid; unsigned acc_ = 0u;
        for (long pg = gt_; pg < (long)(WS_END / 4096); pg += nthr_) acc_ += *(const GAS unsigned*)(F.ws + pg * 4096);
        for (long pg = gt_; pg < (long)((size_t)DEPTH * NE * D * FF * 4 / 4096); pg += nthr_) { acc_ += *(const GAS unsigned*)((const char*)a.in[I_W1] + pg * 4096); acc_ += *(const GAS unsigned*)((const char*)a.in[I_W3] + pg * 4096); acc_ += *(const GAS unsigned*)((const char*)a.in[I_W2] + pg * 4096); }
        if (acc_ == 0x12345679u) F.ctl[CW_TMO] = acc_;
    }
#endif
    LAS float* scr = (LAS float*)(F.lds + RING_OFF + F.wave * 16384);
    const int gw = F.c * NWAVES + F.wave, NGW = F.G * NWAVES;
    unsigned char* ws = F.ws;
    constexpr int S0 = 3584, S1 = 2048, S5 = 4 * 1024;
    constexpr int NITEMS = S0 + S1 + S5;
    for (int it = gw; it < NITEMS; it += NGW) {
        int r = it; const float* src; unsigned char* dst; int K = 2048, N; bool f8 = F8L(0);
        if (r < S0) { N = 3584; src = a.in[I_AWIN]; dst = ws + WS_WAIN; }
        else if ((r -= S0) < S1) { N = 2048; f8 = false; src = a.in[I_AWOUT]; dst = ws + WS_WAOUT; }
        else { r -= S1; const int mat = r >> 10; r &= 1023; N = 1024; src = a.in[I_MEMWKV] + (size_t)mat * K * N; dst = ws + WS_WMKV + (size_t)mat * K * N * (F8L(0) ? 1 : 2); }
        const int nblk = N / 32, kb = r / nblk, nb = r - kb * nblk;
        if (f8) transpose_item_fp8(src, K, N, dst, 32 * nb, scr, 64 * kb, 32 * nb, F.lane);
        else transpose_item_fast(src, K, N, (bf16*)dst, 32 * nb, scr, 64 * kb, 32 * nb, F.lane);
    }
#ifdef CONV_ALL_PRO
    for (int q = 0; q < NQ; ++q) { const int qs = conv_qsize(q); for (int it = gw * 4; it < qs; it += NGW * 4) conv_range(F, a, q, it, qs - it < 4 ? qs - it : 4); }
#endif
    const long nthr = (long)F.G * 512, gt = (long)F.c * 512 + F.tid;
    { float* wr = (float*)(ws + WS_WR);
      for (long i = gt; i < (long)DEPTH * 3 * 512 * 16 * 4; i += nthr) { const int j = (int)(i & 3), c = (int)((i >> 2) & 15), kg = (int)((i >> 6) & 511), r = (int)(i >> 15), nb = r % 3, l = r / 3;
          const int k = 4 * kg + j, o = 16 * nb + c; float v = 0.f;
          if (o < 4) v = a.in[I_WG1][((size_t)l * D + k) * 4 + o]; else if (o < 36) { const int g = (o - 4) >> 3, e = (o - 4) & 7; v = a.in[I_WG2][(((size_t)l * 4 + g) * D + k) * 8 + e]; }
          wr[i] = v; } }
    { const float* x = a.in[I_X]; bf16* xb = (bf16*)(ws + WS_XB);
      for (long i = gt; i < (long)T * D / 8; i += nthr) { const f32x4 v0 = *(const GAS f32x4*)(x + i * 8), v1 = *(const GAS f32x4*)(x + i * 8 + 4);
          v4u o; o.x = pk2(v0.x, v0.y); o.y = pk2(v0.z, v0.w); o.z = pk2(v1.x, v1.y); o.w = pk2(v1.z, v1.w); *(GAS v4u*)(xb + i * 8) = o;
          unsigned lo = 0u, hi = 0u; lo = __builtin_amdgcn_cvt_pk_fp8_f32(v0.x, v0.y, lo, false); lo = __builtin_amdgcn_cvt_pk_fp8_f32(v0.z, v0.w, lo, true); hi = __builtin_amdgcn_cvt_pk_fp8_f32(v1.x, v1.y, hi, false); hi = __builtin_amdgcn_cvt_pk_fp8_f32(v1.z, v1.w, hi, true);
          v2u qq; qq.x = lo; qq.y = hi; *(GAS v2u*)(ws + WS_XQ + i * 8) = qq; } }
    { const float* x = a.in[I_MEM]; bf16* xb = (bf16*)(ws + WS_MEMB);
      for (long i = gt; i < (long)MEMT * D / 8; i += nthr) { const f32x4 v0 = *(const GAS f32x4*)(x + i * 8), v1 = *(const GAS f32x4*)(x + i * 8 + 4);
          v4u o; o.x = pk2(v0.x, v0.y); o.y = pk2(v0.z, v0.w); o.z = pk2(v1.x, v1.y); o.w = pk2(v1.z, v1.w); *(GAS v4u*)(xb + i * 8) = o;
          unsigned lo = 0u, hi = 0u; lo = __builtin_amdgcn_cvt_pk_fp8_f32(v0.x, v0.y, lo, false); lo = __builtin_amdgcn_cvt_pk_fp8_f32(v0.z, v0.w, lo, true); hi = __builtin_amdgcn_cvt_pk_fp8_f32(v1.x, v1.y, hi, false); hi = __builtin_amdgcn_cvt_pk_fp8_f32(v1.z, v1.w, hi, true);
          v2u qq; qq.x = lo; qq.y = hi; *(GAS v2u*)(ws + WS_MEMQ + i * 8) = qq; } }
}

#ifndef NCVMAX
#define NCVMAX 0
#endif
#ifndef NCVATT
#define NCVATT 96
#endif
__device__ __forceinline__ int conv_servers(int nu, int G, int fin) {
    if (fin || nu <= 0) return 0;
    const int rounds = (nu + G - 1) / G, gmin = (nu + rounds - 1) / rounds; int n = G - gmin; n = n < NCVMAX ? n : NCVMAX; return n & ~7;
}
__device__ __forceinline__ void conv_done(Frame& F, int p) { __syncthreads(); if (F.tid == 0) __hip_atomic_fetch_add(F.ctl + CW_DONE + 64 * p, 1u, RLX_AGENT); }
__device__ __forceinline__ void conv_server(Frame& F, const Args& a, int p, int q0, int ncomp) {
    int q = q0;
    for (;;) {
        if (q >= NQ) break;
        unsigned idx = 0xffffffffu;
        if (F.lane == 0) { if (__hip_atomic_load(F.ctl + CW_DONE + 64 * p, RLX_AGENT) < (unsigned)ncomp) idx = __hip_atomic_fetch_add(F.ctl + CW_CONV + 64 * q, (unsigned)CSRV, RLX_AGENT); }
        idx = (unsigned)__builtin_amdgcn_readfirstlane((int)idx);
        if (idx == 0xffffffffu) break;
        const int qs = conv_qsize(q);
        if (idx >= (unsigned)qs) { ++q; continue; }
        conv_range(F, a, q, (int)idx, (qs - (int)idx < CSRV) ? qs - (int)idx : CSRV);
    }
}
__device__ __forceinline__ void conv_server_q(Frame& F, const Args& a, gu32* head, unsigned stop_at, int q0) {
    int q = q0;
    for (;;) {
        if (q >= NQ) break;
        unsigned idx = 0xffffffffu;
        if (F.lane == 0) { if (__hip_atomic_load(head, RLX_AGENT) < stop_at) idx = __hip_atomic_fetch_add(F.ctl + CW_CONV + 64 * q, (unsigned)CSRVA, RLX_AGENT); }
        idx = (unsigned)__builtin_amdgcn_readfirstlane((int)idx);
        if (idx == 0xffffffffu) break;
        const int qs = conv_qsize(q);
        if (idx >= (unsigned)qs) { ++q; continue; }
        conv_range(F, a, q, (int)idx, (qs - (int)idx < CSRVA) ? qs - (int)idx : CSRVA);
    }
}
__device__ __forceinline__ void conv_note_fin(Frame& F, int p) {
    if (blockIdx.x == 0 && F.tid == 0) { unsigned all = 1u;
        for (int q = 0; q < NQ; ++q) all &= (__hip_atomic_load(F.ctl + CW_CONV + 64 * q, RLX_AGENT) >= (unsigned)conv_qsize(q)) ? 1u : 0u;
        __hip_atomic_store(F.ctl + CW_FIN + 64 * p, all, RLX_AGENT); }
}

__device__ __forceinline__ void sgu_unit(Frame& F, const Args& a, int l, int n, int g) {
    constexpr int LDW = 136;
    LAS float* stats = (LAS float*)(F.lds); LAS bf16* Wl = (LAS bf16*)(F.lds + 1024); LAS bf16* Vt = (LAS bf16*)(F.lds + 35840);
    const bf16* z = (const bf16*)(F.ws + WS_Z); bf16* cat = (bf16*)(F.ws + WS_CAT);
    const int tok0 = n * 128;
    for (int i = 0; i < 16; ++i) { const int tk = F.wave * 16 + i; const GAS v4u* rp = (const GAS v4u*)(z + (size_t)(tok0 + tk) * NINA + MIXW) + F.lane;
        v4u w[3]; float s = 0.f;
#pragma unroll
        for (int j = 0; j < 3; ++j) { w[j] = rp[64 * j]; s += (bflo(w[j].x) + bfhi(w[j].x)) + (bflo(w[j].y) + bfhi(w[j].y)) + (bflo(w[j].z) + bfhi(w[j].z)) + (bflo(w[j].w) + bfhi(w[j].w)); }
        const float mean = wave_sum(s) * (1.f / MIXW); float q = 0.f;
#pragma unroll
        for (int j = 0; j < 3; ++j) { float d;
            d = bflo(w[j].x) - mean; q += d * d; d = bfhi(w[j].x) - mean; q += d * d; d = bflo(w[j].y) - mean; q += d * d; d = bfhi(w[j].y) - mean; q += d * d;
            d = bflo(w[j].z) - mean; q += d * d; d = bfhi(w[j].z) - mean; q += d * d; d = bflo(w[j].w) - mean; q += d * d; d = bfhi(w[j].w) - mean; q += d * d; }
        const float rstd = 1.f / sqrtf(wave_sum(q) * (1.f / MIXW) + LN_EPS);
        if (F.lane == 0) { stats[2 * tk] = mean; stats[2 * tk + 1] = rstd; } }
    { const float* wsrc = a.in[I_AWS] + ((size_t)l * 4 + g) * 128 * 128;
      for (int p = F.tid; p < 128 * 32; p += 512) { const int i = p >> 5, j4 = (p & 31) * 4; f32x4 v = *(const GAS f32x4*)(wsrc + i * 128 + j4);
          if ((j4 >> 6) > (i >> 6)) v = (f32x4){0.f, 0.f, 0.f, 0.f};
          v2u o; o.x = pk2(v.x, v.y); o.y = pk2(v.z, v.w); *(LAS v2u*)(Wl + i * LDW + j4) = o; } }
    __syncthreads();
    { const float* lg = a.in[I_ALNG] + (size_t)l * MIXW + g * 384; const float* lb = a.in[I_ALNB] + (size_t)l * MIXW + g * 384;
      for (int p = F.tid; p < 128 * 48; p += 512) { const int j = p & 127, c8 = (p >> 7) * 8;
          const v4u w = *(const GAS v4u*)(z + (size_t)(tok0 + j) * NINA + MIXW + g * 384 + c8);
          const float mean = stats[2 * j], rstd = stats[2 * j + 1];
          const f32x4 g0 = *(const GAS f32x4*)(lg + c8), g1 = *(const GAS f32x4*)(lg + c8 + 4), b0 = *(const GAS f32x4*)(lb + c8), b1 = *(const GAS f32x4*)(lb + c8 + 4);
          float v[8] = {bflo(w.x), bfhi(w.x), bflo(w.y), bfhi(w.y), bflo(w.z), bfhi(w.z), bflo(w.w), bfhi(w.w)};
          const float gg[8] = {g0.x, g0.y, g0.z, g0.w, g1.x, g1.y, g1.z, g1.w}, bb[8] = {b0.x, b0.y, b0.z, b0.w, b1.x, b1.y, b1.z, b1.w};
#pragma unroll
          for (int e = 0; e < 8; ++e) Vt[(c8 + e) * LDW + j] = (bf16)f2bf((v[e] - mean) * rstd * gg[e] + bb[e]); } }
    __syncthreads();
    const int fr = F.lane & 15, fq = F.lane >> 4;
    f32x4 acc[8][3];
#pragma unroll
    for (int mb = 0; mb < 8; ++mb)
#pragma unroll
        for (int nb = 0; nb < 3; ++nb) acc[mb][nb] = (f32x4){0.f, 0.f, 0.f, 0.f};
#pragma unroll
    for (int ks = 0; ks < 4; ++ks) { bf16x8 bfr[3];
#pragma unroll
        for (int nb = 0; nb < 3; ++nb) bfr[nb] = *(const LAS bf16x8*)(Vt + (F.wave * 48 + nb * 16 + fr) * LDW + ks * 32 + fq * 8);
#pragma unroll
        for (int mb = 0; mb < 8; ++mb) { const bf16x8 afr = *(const LAS bf16x8*)(Wl + (mb * 16 + fr) * LDW + ks * 32 + fq * 8);
#pragma unroll
            for (int nb = 0; nb < 3; ++nb) acc[mb][nb] = __builtin_amdgcn_mfma_f32_16x16x32_bf16(bfr[nb], afr, acc[mb][nb], 0, 0, 0); } }
    const float* bs = a.in[I_ABS] + ((size_t)l * 4 + g) * 128;
#pragma unroll
    for (int mb = 0; mb < 8; ++mb) { const int i = mb * 16 + fr; const float bsv = bs[i]; const size_t tk = (size_t)(tok0 + i);
#pragma unroll
        for (int nb = 0; nb < 3; ++nb) { const int c = g * 384 + F.wave * 48 + nb * 16 + 4 * fq;
            const v2u uw = *(const GAS v2u*)(z + tk * NINA + c); const f32x4 gt = acc[mb][nb] + bsv;
            v2u o; o.x = pk2(bflo(uw.x) * gt.x, bfhi(uw.x) * gt.y); o.y = pk2(bflo(uw.y) * gt.z, bfhi(uw.y) * gt.w);
            *(GAS v2u*)(cat + tk * D + c) = o; } }
    __syncthreads();
}

__device__ __forceinline__ void memattn_unit(Frame& F, int l, int hm, int qb, int ldz, int qoff) {
    const bf16* z = (const bf16*)(F.ws + WS_Z); const bf16* kv = (const bf16*)(F.ws + WS_MEMKV) + (size_t)l * 256 * 1024; bf16* cat = (bf16*)(F.ws + WS_CAT);
    att::attn_body<0>(z + (size_t)qb * 256 * ldz + qoff + hm * 128, ldz, kv + hm * 128, kv + 512 + hm * 128, 1024,
                      cat + (size_t)qb * 256 * D + MIXW + hm * 128, nullptr, D, 4, 0, nullptr, 0.f, F.ldsg);
}

__device__ __forceinline__ int t5_bucket(int rel) {
    const int a = rel < 0 ? -rel : rel; int f;
    if (a < 8) f = a; else if (a < 12) f = 8; else if (a < 16) f = 9; else if (a < 23) f = 10; else if (a < 32) f = 11; else if (a < 46) f = 12; else if (a < 64) f = 13; else if (a < 91) f = 14; else f = 15;
    return (rel > 0 ? 16 : 0) + f;
}

namespace att2 {
using att::bf16x8; using att::s16x4; using att::f32x16; using att::u32x4; using att::crow; using att::cvtpk; using att::tr_read; using att::v_rd_base;
constexpr int KT = 32, ST_K = KT * 128 * 2, ST_V = KT * 256 * 2, STAGE = 2 * ST_K + ST_V, NST = 3;
constexpr int LDS_WS = NST * STAGE, LDS_TAB = LDS_WS + 2048, LDS_UNIT = LDS_TAB + 640, LDS_END = LDS_UNIT + 16;
constexpr int NUNITS = 576;
constexpr float THR2 = 8.f * 1.4426950408889634f;
__device__ __forceinline__ int swap23(int k) { return (k & ~0xC) | ((k & 4) << 1) | ((k & 8) >> 1); }
constexpr int v_off(int d0, int ks, int half) { return d0 * 512 + ks * 8192 + half * 4096; }

struct UnitTable { unsigned short u[NUNITS]; };
constexpr UnitTable make_units() {
    UnitTable t{}; int n = 0;
    for (int c = 256; c >= 4; c -= 2) {
        { const int b = (c - 2) / 2; if ((c - 2) % 2 == 0 && b >= 32 && b <= 63) for (int part = 1; part <= 2; ++part) for (int h = 0; h < 6; ++h) t.u[n++] = (unsigned short)(h | (b << 3) | (part << 9)); }
        if (c % 4 == 0) { const int b = c / 4 - 1; if (b >= 0 && b < 32) for (int h = 0; h < 6; ++h) t.u[n++] = (unsigned short)(h | (b << 3)); }
    }
    return t;
}
__device__ const UnitTable g_units = make_units();

__device__ __forceinline__ void diff_unit(const bf16* __restrict__ Q, const bf16* __restrict__ KD, const bf16* __restrict__ VD, float* Obuf  , int orow0,
                                          float* ML  , const float* relb, int h, int b, int t_lo, int t_hi, LAS char* lds) {
  int tid_ = threadIdx.x; asm volatile("" : "+v"(tid_));
  const int tid = tid_, wid = __builtin_amdgcn_readfirstlane(tid >> 6), lane = tid & 63, r32 = lane & 31, hi = lane >> 5, m = wid >> 2, rg = wid & 3;
  LAS float* wsw = (LAS float*)(lds + LDS_WS) + wid * 64; LAS float* li_l = wsw; LAS float* al_l = wsw + 32;
  LAS float* tab = (LAS float*)(lds + LDS_TAB);
  if (tid < att::TAB_N) tab[tid] = relb[t5_bucket(63 - tid) * 6 + h] * LOG2E;
  const float cfar = relb[15 * 6 + h] * LOG2E;
  const int qrow0 = b * 128 + rg * 32;
  bf16x8 qr[8];
  { const bf16* Qw = Q + (size_t)(qrow0 + r32) * 2048 + h * 256 + m * 128 + hi * 8;
#pragma unroll
    for (int d0 = 0; d0 < 8; ++d0) qr[d0] = *reinterpret_cast<const bf16x8*>(Qw + d0 * 16); }
  int ko[2], vo[2];
#pragma unroll
  for (int i = 0; i < 2; ++i) {
    const int p = wid * 64 + lane, row = p >> 4, cp = (p & 15) ^ (row & 7); ko[i] = row * 1536 + h * 256 + i * 128 + cp * 8; }
#pragma unroll
  for (int i = 0; i < 2; ++i) {
    const int p = (wid * 2 + i) * 64 + lane, sub = p >> 5, kg = sub >> 3, cblk = sub & 7, q = p & 31, kk = kg * 8 + (q >> 2), key = swap23(kk);
    vo[i] = key * 1536 + h * 256 + cblk * 32 + (q & 3) * 8; }
  const unsigned ldsb = (unsigned)(uintptr_t)lds;
#define A2_ISSUE(t, s) do { const size_t kb_ = (size_t)(t) * KT * 1536; LAS char* sb_ = lds + (s) * STAGE; \
    __builtin_amdgcn_global_load_lds((const unsigned*)(KD + kb_ + ko[0]), (LAS unsigned*)(sb_ + wid * 1024), 16, 0, 0); \
    __builtin_amdgcn_global_load_lds((const unsigned*)(KD + kb_ + ko[1]), (LAS unsigned*)(sb_ + ST_K + wid * 1024), 16, 0, 0); \
    __builtin_amdgcn_global_load_lds((const unsigned*)(VD + kb_ + vo[0]), (LAS unsigned*)(sb_ + 2 * ST_K + (wid * 2) * 1024), 16, 0, 0); \
    __builtin_amdgcn_global_load_lds((const unsigned*)(VD + kb_ + vo[1]), (LAS unsigned*)(sb_ + 2 * ST_K + (wid * 2 + 1) * 1024), 16, 0, 0); } while (0)
  const int vis = 2 * (2 * b + (rg >> 1) + 1);
  float m_reg = -1e30f, l_reg = 0.f; f32x16 o[8];
#pragma unroll
  for (int d = 0; d < 8; ++d) o[d] = f32x16{};
  asm volatile("s_waitcnt vmcnt(0)" ::: "memory");
  A2_ISSUE(t_lo, 0); if (t_lo + 1 < t_hi) A2_ISSUE(t_lo + 1, 1);
  int s = 0;
  for (int t = t_lo; t < t_hi; ++t) {
    if (t + 1 < t_hi) asm volatile("s_waitcnt vmcnt(4) lgkmcnt(0)" ::: "memory"); else asm volatile("s_waitcnt vmcnt(0) lgkmcnt(0)" ::: "memory");
    __builtin_amdgcn_s_barrier(); asm volatile("" ::: "memory");
    if (t + 2 < t_hi) { const int s2 = (s >= 1) ? s - 1 : s + 2; A2_ISSUE(t + 2, s2); }
    if (t < vis) {
      const LAS char* Ks = lds + s * STAGE + m * ST_K;
      f32x16 p = f32x16{};
#pragma unroll
      for (int d0 = 0; d0 < 8; ++d0) { const int cb = (d0 * 16 + hi * 8) * 2;
        const bf16x8 b0 = *(const LAS bf16x8*)(Ks + KSWZ(r32, cb));
        p = __builtin_amdgcn_mfma_f32_32x32x16_bf16(b0, qr[d0], p, 0, 0, 0); }
      if (qrow0 - (KT * t + KT - 1) >= 91) {
#pragma unroll
        for (int r = 0; r < 16; ++r) p[r] += cfar;
      } else { const int base = qrow0 + r32 - KT * t + 63;
#pragma unroll
        for (int r = 0; r < 16; ++r) { const int i0 = base - crow(r, hi); p[r] += tab[i0 < att::TAB_N - 1 ? i0 : att::TAB_N - 1]; } }
      float pmax = p[0];
#pragma unroll
      for (int r = 1; r < 16; ++r) pmax = fmaxf(pmax, p[r]);
      { auto rr = __builtin_amdgcn_permlane32_swap(__float_as_uint(pmax), __float_as_uint(pmax), false, false); pmax = fmaxf(__uint_as_float(rr[0]), __uint_as_float(rr[1])); }
      float mn, alpha;
      if (__builtin_expect(__all(pmax - m_reg <= THR2), 1)) { mn = m_reg; alpha = 1.f; }
      else { mn = fmaxf(m_reg, pmax); alpha = __builtin_amdgcn_exp2f(m_reg - mn); m_reg = mn; }
      float ps = 0.f;
#pragma unroll
      for (int r = 0; r < 16; ++r) { p[r] = __builtin_amdgcn_exp2f(p[r] - mn); ps += p[r]; }
      { auto rr = __builtin_amdgcn_permlane32_swap(__float_as_uint(ps), __float_as_uint(ps), false, false); ps = __uint_as_float(rr[0]) + __uint_as_float(rr[1]); }
      l_reg = l_reg * alpha + ps;
      bf16x8 pa0, pa1;
#define A2_PK4(P, BASE, OUT) do { unsigned a0 = cvtpk(P[BASE + 0], P[BASE + 1]), a1 = cvtpk(P[BASE + 2], P[BASE + 3]);   \
    unsigned b0_ = cvtpk(P[BASE + 4], P[BASE + 5]), b1_ = cvtpk(P[BASE + 6], P[BASE + 7]);                              \
    auto r0 = __builtin_amdgcn_permlane32_swap(a0, b0_, false, false); auto r1 = __builtin_amdgcn_permlane32_swap(a1, b1_, false, false); \
    u32x4 w = {r0[0], r1[0], r0[1], r1[1]}; OUT = *reinterpret_cast<bf16x8*>(&w); } while (0)
      A2_PK4(p, 0, pa0); A2_PK4(p, 8, pa1);
      if (__any(alpha < 1.f)) { if (hi == 0) al_l[r32] = alpha; asm volatile("s_waitcnt lgkmcnt(0)" ::: "memory");
#pragma unroll
        for (int d = 0; d < 8; ++d)
#pragma unroll
          for (int r = 0; r < 16; ++r) o[d][r] *= al_l[crow(r, hi)]; }
      const int vb = (int)(ldsb + s * STAGE + 2 * ST_K) + v_rd_base(lane);
      asm volatile("s_waitcnt lgkmcnt(0)" ::: "memory"); SBAR();
#define A2_PK(L, H) (bf16x8){L[0], L[1], L[2], L[3], H[0], H[1], H[2], H[3]}
#define A2_RD(D0, l0, h0, l1, h1) do { l0 = tr_read<v_off(D0, 0, 0)>(vb); h0 = tr_read<v_off(D0, 0, 1)>(vb); l1 = tr_read<v_off(D0, 1, 0)>(vb); h1 = tr_read<v_off(D0, 1, 1)>(vb); } while (0)
#define A2_MM(D0, l0, h0, l1, h1) do { o[D0] = __builtin_amdgcn_mfma_f32_32x32x16_bf16(pa0, A2_PK(l0, h0), o[D0], 0, 0, 0); o[D0] = __builtin_amdgcn_mfma_f32_32x32x16_bf16(pa1, A2_PK(l1, h1), o[D0], 0, 0, 0); } while (0)
      s16x4 xl0, xh0, xl1, xh1, yl0, yh0, yl1, yh1;
      A2_RD(0, xl0, xh0, xl1, xh1);
      A2_RD(1, yl0, yh0, yl1, yh1); asm volatile("s_waitcnt lgkmcnt(4)" ::: "memory"); SBAR(); A2_MM(0, xl0, xh0, xl1, xh1); SBAR();
      A2_RD(2, xl0, xh0, xl1, xh1); asm volatile("s_waitcnt lgkmcnt(4)" ::: "memory"); SBAR(); A2_MM(1, yl0, yh0, yl1, yh1); SBAR();
      A2_RD(3, yl0, yh0, yl1, yh1); asm volatile("s_waitcnt lgkmcnt(4)" ::: "memory"); SBAR(); A2_MM(2, xl0, xh0, xl1, xh1); SBAR();
      A2_RD(4, xl0, xh0, xl1, xh1); asm volatile("s_waitcnt lgkmcnt(4)" ::: "memory"); SBAR(); A2_MM(3, yl0, yh0, yl1, yh1); SBAR();
      A2_RD(5, yl0, yh0, yl1, yh1); asm volatile("s_waitcnt lgkmcnt(4)" ::: "memory"); SBAR(); A2_MM(4, xl0, xh0, xl1, xh1); SBAR();
      A2_RD(6, xl0, xh0, xl1, xh1); asm volatile("s_waitcnt lgkmcnt(4)" ::: "memory"); SBAR(); A2_MM(5, yl0, yh0, yl1, yh1); SBAR();
      A2_RD(7, yl0, yh0, yl1, yh1); asm volatile("s_waitcnt lgkmcnt(4)" ::: "memory"); SBAR(); A2_MM(6, xl0, xh0, xl1, xh1); SBAR();
      asm volatile("s_waitcnt lgkmcnt(0)" ::: "memory"); SBAR(); A2_MM(7, yl0, yh0, yl1, yh1); SBAR();
    }
    s = (s == 2) ? 0 : s + 1;
  }
  if (hi == 0) li_l[r32] = l_reg; asm volatile("s_waitcnt lgkmcnt(0)" ::: "memory");
  float rli[16];
#pragma unroll
  for (int r = 0; r < 16; ++r) rli[r] = __builtin_amdgcn_rcpf(li_l[crow(r, hi)]);
  float* Ow = Obuf + (size_t)(qrow0 - orow0) * 3072 + (h * 2 + m) * 256;
#pragma unroll
  for (int r = 0; r < 16; ++r) { const int orow = crow(r, hi);
#pragma unroll
    for (int d0 = 0; d0 < 8; ++d0) Ow[(size_t)orow * 3072 + d0 * 32 + r32] = o[d0][r] * rli[r]; }
  if (hi == 0) { float* mlp = ML + (((size_t)(qrow0 - orow0 + r32) * 6 + h) * 2 + m) * 2; mlp[0] = m_reg; mlp[1] = l_reg; }
  asm volatile("s_waitcnt vmcnt(0) lgkmcnt(0)" ::: "memory");
  __builtin_amdgcn_s_barrier(); asm volatile("" ::: "memory");
#undef A2_ISSUE
#undef A2_PK4
#undef A2_PK
#undef A2_RD
#undef A2_MM
}
}

namespace att3 {
using att::f32x16; using att::crow;
typedef int v8i __attribute__((ext_vector_type(8))); typedef int v4i __attribute__((ext_vector_type(4)));
constexpr int KT = 64, ST_K = KT * 128, ST_V = 256 * 64, STAGE = 2 * ST_K + ST_V, NST = 3;
static_assert(NST * STAGE == att2::LDS_WS, "same ring size as att2");
constexpr float THR2 = 2.f;
__device__ __forceinline__ v8i cat8(v4i a, v4i b) { return __builtin_shufflevector(a, b, 0, 1, 2, 3, 4, 5, 6, 7); }
__device__ __forceinline__ void diff_unit(const unsigned char* __restrict__ Q8, const unsigned char* __restrict__ K8, const unsigned char* __restrict__ VT, float* Obuf, int orow0,
                                          float* ML, const float* relb, int h, int b, int t_lo, int t_hi, LAS char* lds) {
  int tid_ = threadIdx.x; asm volatile("" : "+v"(tid_));
  const int tid = tid_, wid = __builtin_amdgcn_readfirstlane(tid >> 6), lane = tid & 63, r32 = lane & 31, hi = lane >> 5, m = wid >> 2, rg = wid & 3;
  LAS float* wsw = (LAS float*)(lds + att2::LDS_WS) + wid * 64; LAS float* li_l = wsw; LAS float* al_l = wsw + 32;
  LAS float* tab = (LAS float*)(lds + att2::LDS_TAB);
  if (tid < att::TAB_N) tab[tid] = relb[t5_bucket(63 - tid) * 6 + h] * LOG2E;
  const float cfar = relb[15 * 6 + h] * LOG2E;
  const int qrow0 = b * 128 + rg * 32;
  v8i q8[2];
  { const unsigned char* Qw = Q8 + (size_t)(qrow0 + r32) * 2048 + h * 256 + m * 128 + hi * 32;
#pragma unroll
    for (int c = 0; c < 2; ++c) q8[c] = cat8(*(const GAS v4i*)(Qw + 64 * c), *(const GAS v4i*)(Qw + 64 * c + 16)); }
  int ko, vo[2];
  { const int p = wid * 64 + lane, row = p >> 3, cp = (p & 7) ^ (row & 7); ko = row * 1536 + h * 256 + cp * 16; }
#pragma unroll
  for (int i = 0; i < 2; ++i) { const int p = (wid * 2 + i) * 64 + lane, d = p >> 2, cp = (p & 3) ^ ((d >> 1) & 3); vo[i] = d * 64 + cp * 16; }
  const unsigned char* VTh = VT + (size_t)h * 128 * 16384;
#define A3_ISSUE(t, s) do { const size_t kb_ = (size_t)(t) * KT * 1536; LAS char* sb_ = lds + (s) * STAGE; \
    __builtin_amdgcn_global_load_lds((const unsigned*)(K8 + kb_ + ko), (LAS unsigned*)(sb_ + wid * 1024), 16, 0, 0); \
    __builtin_amdgcn_global_load_lds((const unsigned*)(K8 + kb_ + ko + 128), (LAS unsigned*)(sb_ + ST_K + wid * 1024), 16, 0, 0); \
    __builtin_amdgcn_global_load_lds((const unsigned*)(VTh + (size_t)(t) * 16384 + vo[0]), (LAS unsigned*)(sb_ + 2 * ST_K + (wid * 2) * 1024), 16, 0, 0); \
    __builtin_amdgcn_global_load_lds((const unsigned*)(VTh + (size_t)(t) * 16384 + vo[1]), (LAS unsigned*)(sb_ + 2 * ST_K + (wid * 2 + 1) * 1024), 16, 0, 0); } while (0)
  const int vis = 2 * b + (rg >> 1) + 1;
  float m_reg = -1e30f, l_reg = 0.f; f32x16 o[8];
#pragma unroll
  for (int d = 0; d < 8; ++d) o[d] = f32x16{};
  const int kx = (r32 & 7), koff0 = r32 * 128 + (((2 * hi) ^ kx) << 4), koff1 = r32 * 128 + (((2 * hi + 1) ^ kx) << 4);
  const int vx = (r32 >> 1) & 3, voff0 = r32 * 64 + (((2 * hi) ^ vx) << 4), voff1 = r32 * 64 + (((2 * hi + 1) ^ vx) << 4);
  int sclP = 121, scl1 = 127; asm volatile("" : "+v"(sclP), "+v"(scl1));
  asm volatile("s_waitcnt vmcnt(0)" ::: "memory");
  A3_ISSUE(t_lo, 0); if (t_lo + 1 < t_hi) A3_ISSUE(t_lo + 1, 1);
  int s = 0;
  for (int t = t_lo; t < t_hi; ++t) {
    if (t + 1 < t_hi) asm volatile("s_waitcnt vmcnt(4) lgkmcnt(0)" ::: "memory"); else asm volatile("s_waitcnt vmcnt(0) lgkmcnt(0)" ::: "memory");
    __builtin_amdgcn_s_barrier(); asm volatile("" ::: "memory");
    if (t + 2 < t_hi) { const int s2 = (s >= 1) ? s - 1 : s + 2; A3_ISSUE(t + 2, s2); }
    if (t < vis) {
      const LAS char* Ks = lds + s * STAGE + m * ST_K;
      f32x16 p0 = f32x16{}, p1 = f32x16{};
#pragma unroll
      for (int c = 0; c < 2; ++c) {
        const int x0 = koff0 ^ (c << 6), x1 = koff1 ^ (c << 6);
        const v8i k0 = cat8(*(const LAS v4i*)(Ks + x0), *(const LAS v4i*)(Ks + x1));
        const v8i k1 = cat8(*(const LAS v4i*)(Ks + 4096 + x0), *(const LAS v4i*)(Ks + 4096 + x1));
        asm volatile("v_mfma_scale_f32_32x32x64_f8f6f4 %0, %1, %2, %0, %3, %3 op_sel_hi:[0,0,0]" : "+v"(p0) : "v"(k0), "v"(q8[c]), "v"(scl1));
        asm volatile("v_mfma_scale_f32_32x32x64_f8f6f4 %0, %1, %2, %0, %3, %3 op_sel_hi:[0,0,0]" : "+v"(p1) : "v"(k1), "v"(q8[c]), "v"(scl1)); }
      asm volatile("s_nop 15\n s_nop 7" : "+v"(p0), "+v"(p1));
      const bool far = qrow0 - (KT * t + KT - 1) >= 91;
      if (!far) { const int base = qrow0 + r32 - KT * t + 63;
#pragma unroll
        for (int r = 0; r < 16; ++r) { const int i0 = base - crow(r, hi), i1 = i0 - 32; p0[r] += tab[i0 < att::TAB_N - 1 ? i0 : att::TAB_N - 1]; p1[r] += tab[i1 < att::TAB_N - 1 ? i1 : att::TAB_N - 1]; } }
      const float cb = far ? cfar : 0.f;
      float pmax;
      asm("v_max3_f32 %0, %1, %2, %3" : "=v"(pmax) : "v"(p0[0]), "v"(p1[0]), "v"(p0[1]));
      asm("v_max3_f32 %0, %1, %2, %3" : "=v"(pmax) : "v"(pmax), "v"(p1[1]), "v"(p0[2]));
#pragma unroll
      for (int r = 2; r < 15; ++r) asm("v_max3_f32 %0, %1, %2, %3" : "=v"(pmax) : "v"(pmax), "v"(p1[r]), "v"(p0[r + 1]));
      asm("v_max_f32 %0, %1, %2" : "=v"(pmax) : "v"(pmax), "v"(p1[15]));
      pmax += cb;
      { auto rr = __builtin_amdgcn_permlane32_swap(__float_as_uint(pmax), __float_as_uint(pmax), false, false); asm("v_max_f32 %0, %1, %2" : "=v"(pmax) : "v"(__uint_as_float(rr[0])), "v"(__uint_as_float(rr[1]))); }
      float mn, alpha;
      if (__builtin_expect(__all(pmax - m_reg <= THR2), 1)) { mn = m_reg; alpha = 1.f; }
      else { mn = fmaxf(m_reg, pmax); alpha = __builtin_amdgcn_exp2f(m_reg - mn); m_reg = mn; }
      typedef float f32x2v __attribute__((ext_vector_type(2)));
      const float off = cb - (mn - 6.f); const f32x2v off2 = {off, off}; f32x2v ps2 = {0.f, 0.f};
#pragma unroll
      for (int r = 0; r < 16; r += 2) {
        f32x2v a = (f32x2v){p0[r], p0[r + 1]} + off2, c2 = (f32x2v){p1[r], p1[r + 1]} + off2;
        p0[r] = __builtin_amdgcn_exp2f(a.x); p0[r + 1] = __builtin_amdgcn_exp2f(a.y); p1[r] = __builtin_amdgcn_exp2f(c2.x); p1[r + 1] = __builtin_amdgcn_exp2f(c2.y);
        ps2 += (f32x2v){p0[r], p0[r + 1]}; ps2 += (f32x2v){p1[r], p1[r + 1]}; }
      float ps = ps2.x + ps2.y;
      { auto rr = __builtin_amdgcn_permlane32_swap(__float_as_uint(ps), __float_as_uint(ps), false, false); ps = __uint_as_float(rr[0]) + __uint_as_float(rr[1]); }
      l_reg = l_reg * alpha + ps;
      v8i pa;
#pragma unroll
      for (int g = 0; g < 4; ++g) { unsigned x = 0u, y = 0u;
        x = __builtin_amdgcn_cvt_pk_fp8_f32(p0[4 * g], p0[4 * g + 1], x, false); x = __builtin_amdgcn_cvt_pk_fp8_f32(p0[4 * g + 2], p0[4 * g + 3], x, true);
        y = __builtin_amdgcn_cvt_pk_fp8_f32(p1[4 * g], p1[4 * g + 1], y, false); y = __builtin_amdgcn_cvt_pk_fp8_f32(p1[4 * g + 2], p1[4 * g + 3], y, true);
        auto rr = __builtin_amdgcn_permlane32_swap(x, y, false, false); pa[2 * g] = (int)rr[0]; pa[2 * g + 1] = (int)rr[1]; }
      if (__any(alpha < 1.f)) { if (hi == 0) al_l[r32] = alpha; asm volatile("s_waitcnt lgkmcnt(0)" ::: "memory");
#pragma unroll
        for (int d = 0; d < 8; ++d)
#pragma unroll
          for (int r = 0; r < 16; ++r) o[d][r] *= al_l[crow(r, hi)]; }
      const LAS char* Vs = lds + s * STAGE + 2 * ST_K;
#define A3_RD(D0, V) do { V = cat8(*(const LAS v4i*)(Vs + (D0) * 2048 + voff0), *(const LAS v4i*)(Vs + (D0) * 2048 + voff1)); } while (0)
#define A3_MM(D0, V) asm volatile("v_mfma_scale_f32_32x32x64_f8f6f4 %0, %1, %2, %0, %3, %4 op_sel_hi:[0,0,0]" : "+v"(o[D0]) : "v"(pa), "v"(V), "v"(sclP), "v"(scl1))
      v8i va, vb;
      A3_RD(0, va);
      A3_RD(1, vb); A3_MM(0, va);
      A3_RD(2, va); A3_MM(1, vb);
      A3_RD(3, vb); A3_MM(2, va);
      A3_RD(4, va); A3_MM(3, vb);
      A3_RD(5, vb); A3_MM(4, va);
      A3_RD(6, va); A3_MM(5, vb);
      A3_RD(7, vb); A3_MM(6, va);
      A3_MM(7, vb);
    }
    s = (s == 2) ? 0 : s + 1;
  }
  asm volatile("s_nop 15\n s_nop 15" ::: "memory");
  if (hi == 0) li_l[r32] = l_reg; asm volatile("s_waitcnt lgkmcnt(0)" ::: "memory");
  float rli[16];
#pragma unroll
  for (int r = 0; r < 16; ++r) rli[r] = 64.f * __builtin_amdgcn_rcpf(li_l[crow(r, hi)]);
  float* Ow = Obuf + (size_t)(qrow0 - orow0) * 3072 + (h * 2 + m) * 256;
#pragma unroll
  for (int r = 0; r < 16; ++r) { const int orow = crow(r, hi);
#pragma unroll
    for (int d0 = 0; d0 < 8; ++d0) Ow[(size_t)orow * 3072 + d0 * 32 + r32] = o[d0][r] * rli[r]; }
  if (hi == 0) { float* mlp = ML + (((size_t)(qrow0 - orow0 + r32) * 6 + h) * 2 + m) * 2; mlp[0] = m_reg; mlp[1] = l_reg * (1.f / 64.f); }
  asm volatile("s_waitcnt vmcnt(0) lgkmcnt(0)" ::: "memory");
  __builtin_amdgcn_s_barrier(); asm volatile("" ::: "memory");
#undef A3_ISSUE
#undef A3_RD
#undef A3_MM
}
}

__device__ __forceinline__ void diffattn2_unit(Frame& F, const Args& a, unsigned code) {
    const int h = code & 7, b = (code >> 3) & 63, pc = code >> 9;
    float* ob = (float*)(F.ws + (pc == 2 ? WS_OP2 : WS_OP)); float* ml = (float*)(F.ws + WS_ML) + (pc == 2 ? (size_t)T * 6 * 2 * 2 : 0);
#ifdef ATT_BF16
    const int nt = 4 * b + 4, t_lo = (pc == 2) ? nt / 2 : 0, t_hi = (pc == 1) ? nt / 2 : nt;
    att2::diff_unit((const bf16*)(F.ws + WS_Z), (const bf16*)(F.ws + WS_KD), (const bf16*)(F.ws + WS_VD), ob, pc == 2 ? 4096 : 0, ml, a.in[I_RELB], h, b, t_lo, t_hi, (LAS char*)F.lds);
#else
    const int nt = 2 * b + 2, t_lo = (pc == 2) ? nt / 2 : 0, t_hi = (pc == 1) ? nt / 2 : nt;
    att3::diff_unit(F.ws + WS_ZQ, F.ws + WS_KD, F.ws + WS_VD, ob, pc == 2 ? 4096 : 0, ml, a.in[I_RELB], h, b, t_lo, t_hi, (LAS char*)F.lds);
#endif
}
__device__ __forceinline__ void diffcombine_phase(Frame& F, const Args& a, int l) {
    const int i = l - 2; const float* lp = a.in[I_BLAM] + (size_t)i * 4 * 128;
    float s1 = lp[F.lane] * lp[128 + F.lane] + lp[64 + F.lane] * lp[128 + 64 + F.lane], s2 = lp[256 + F.lane] * lp[384 + F.lane] + lp[256 + 64 + F.lane] * lp[384 + 64 + F.lane];
    s1 = wave_sum(s1); s2 = wave_sum(s2);
    const float lam_init = 0.8f - 0.6f * expf(-0.3f * (float)l);
    const float lam = expf(s1) - expf(s2) + lam_init;
    const float* op0 = (const float*)(F.ws + WS_OP); const float* op1 = (const float*)(F.ws + WS_OP2); const float* ml0 = (const float*)(F.ws + WS_ML); const float* ml1 = ml0 + (size_t)T * 6 * 2 * 2;
    bf16* cat = (bf16*)(F.ws + WS_CAT);
    const f32x4 gsub = *(const GAS f32x4*)(a.in[I_BSUBG] + (size_t)i * 256 + 4 * F.lane);
    const int gw = F.c * NWAVES + F.wave, NGW = F.G * NWAVES;
    for (int it = gw; it < T * 6; it += NGW) { const int tk = it / 6, h = it - tk * 6; f32x4 os[2];
#pragma unroll
        for (int m = 0; m < 2; ++m) { const size_t r0 = ((size_t)tk * 6 + h) * 2 + m; f32x4 oa = *(const GAS f32x4*)(op0 + r0 * 256 + 4 * F.lane);
            if (tk >= 4096) { const size_t r1 = ((size_t)(tk - 4096) * 6 + h) * 2 + m; const f32x4 ob = *(const GAS f32x4*)(op1 + r1 * 256 + 4 * F.lane);
                const float ma = ml0[r0 * 2], la = ml0[r0 * 2 + 1], mb = ml1[r1 * 2], lb = ml1[r1 * 2 + 1], M = fmaxf(ma, mb);
                const float wa = la * exp2f(ma - M), wb = lb * exp2f(mb - M), inv = 1.f / (wa + wb); oa = oa * (wa * inv) + ob * (wb * inv); }
            os[m] = oa; }
        const f32x4 o = os[0] - os[1] * lam; const float ss = wave_sum((o.x * o.x + o.y * o.y) + (o.z * o.z + o.w * o.w));
        const float r = (1.f - lam_init) / sqrtf(ss * (1.f / 256.f) + LN_EPS);
        v2u w; w.x = pk2(o.x * r * gsub.x, o.y * r * gsub.y); w.y = pk2(o.z * r * gsub.z, o.w * r * gsub.w);
        *(GAS v2u*)(cat + (size_t)tk * D + h * 256 + 4 * F.lane) = w;
        { unsigned q8 = 0u; q8 = __builtin_amdgcn_cvt_pk_fp8_f32(o.x * r * gsub.x, o.y * r * gsub.y, q8, false); q8 = __builtin_amdgcn_cvt_pk_fp8_f32(o.z * r * gsub.z, o.w * r * gsub.w, q8, true);
          *(GAS unsigned*)(F.ws + WS_CATQ + (size_t)tk * D + h * 256 + 4 * F.lane) = q8; } }
    { const long nthr = (long)F.G * 512, gt = (long)F.c * 512 + F.tid;
      for (long i2 = gt; i2 < (long)T * 64; i2 += nthr) { const long tk = i2 >> 6; const int c8 = (int)(i2 & 63) * 8; const v4u w = *(const GAS v4u*)(cat + tk * D + MIXW + c8);
          unsigned lo = 0u, hi = 0u; lo = __builtin_amdgcn_cvt_pk_fp8_f32(bflo(w.x), bfhi(w.x), lo, false); lo = __builtin_amdgcn_cvt_pk_fp8_f32(bflo(w.y), bfhi(w.y), lo, true);
          hi = __builtin_amdgcn_cvt_pk_fp8_f32(bflo(w.z), bfhi(w.z), hi, false); hi = __builtin_amdgcn_cvt_pk_fp8_f32(bflo(w.w), bfhi(w.w), hi, true);
          v2u qq; qq.x = lo; qq.y = hi; *(GAS v2u*)(F.ws + WS_CATQ + tk * D + MIXW + c8) = qq; } }
}


__device__ __forceinline__ void ln1_router_phase(Frame& F, const Args& a, int l, int probe = 0) {
    const bf16* y = (const bf16*)(F.ws + WS_Y); bf16* x1b = (bf16*)(F.ws + WS_X1B);
    const float* lng = a.in[I_LNG] + ((size_t)l * 2 + 0) * D; const float* lnb = a.in[I_LNB] + ((size_t)l * 2 + 0) * D;
    const float* wr = (const float*)(F.ws + WS_WR) + (size_t)l * 3 * 512 * 16 * 4;
    int* tok_e = (int*)(F.ws + (probe ? WS_OP : WS_ROUTE)); int* tok_rank = tok_e + 2 * T; float* tok_gate = (float*)(tok_rank + 2 * T);
    gu32* cnt = F.ctl + (probe ? 65536 : CW_CNT) + 2048 * l;
    LAS float* P = (LAS float*)(F.lds);
    typedef float f32x4v __attribute__((ext_vector_type(4)));
    for (int tb = F.c; tb < T / 32; tb += F.G) {
#pragma unroll 2
        for (int i = 0; i < 4; ++i) { const int tk = tb * 32 + F.wave * 4 + i;
            const GAS v4u* yr = (const GAS v4u*)(y + (size_t)tk * D) + F.lane;
            float v[4][8]; float s = 0.f;
#pragma unroll
            for (int j = 0; j < 4; ++j) { const v4u w = yr[64 * j]; v[j][0] = bflo(w.x); v[j][1] = bfhi(w.x); v[j][2] = bflo(w.y); v[j][3] = bfhi(w.y); v[j][4] = bflo(w.z); v[j][5] = bfhi(w.z); v[j][6] = bflo(w.w); v[j][7] = bfhi(w.w);
#pragma unroll
                for (int e = 0; e < 8; ++e) s += v[j][e]; }
            const float mean = wave_sum(s) * (1.f / D); float s2 = 0.f;
#pragma unroll
            for (int j = 0; j < 4; ++j)
#pragma unroll
                for (int e = 0; e < 8; ++e) { v[j][e] -= mean; s2 += v[j][e] * v[j][e]; }
            const float rstd = 1.f / sqrtf(wave_sum(s2) * (1.f / D) + LN_EPS);
#pragma unroll
            for (int j = 0; j < 4; ++j) { const int d0 = 8 * F.lane + 512 * j; const f32x4 g0 = *(const GAS f32x4*)(lng + d0), g1 = *(const GAS f32x4*)(lng + d0 + 4), b0 = *(const GAS f32x4*)(lnb + d0), b1 = *(const GAS f32x4*)(lnb + d0 + 4);
                const float q0 = v[j][0] * rstd * g0.x + b0.x, q1 = v[j][1] * rstd * g0.y + b0.y, q2 = v[j][2] * rstd * g0.z + b0.z, q3 = v[j][3] * rstd * g0.w + b0.w;
                const float q4 = v[j][4] * rstd * g1.x + b1.x, q5 = v[j][5] * rstd * g1.y + b1.y, q6 = v[j][6] * rstd * g1.z + b1.z, q7 = v[j][7] * rstd * g1.w + b1.w;
                v4u w; w.x = pk2(q0, q1); w.y = pk2(q2, q3); w.z = pk2(q4, q5); w.w = pk2(q6, q7);
                *(GAS v4u*)(x1b + (size_t)tk * D + d0) = w;
                unsigned lo = 0u, hi = 0u; lo = __builtin_amdgcn_cvt_pk_fp8_f32(q0, q1, lo, false); lo = __builtin_amdgcn_cvt_pk_fp8_f32(q2, q3, lo, true);
                hi = __builtin_amdgcn_cvt_pk_fp8_f32(q4, q5, hi, false); hi = __builtin_amdgcn_cvt_pk_fp8_f32(q6, q7, hi, true);
                v2u qq; qq.x = lo; qq.y = hi; *(GAS v2u*)((unsigned char*)(F.ws + WS_X1F) + (size_t)tk * D + d0) = qq; } }
        VM_WAIT(); __syncthreads();
        { const int mt = F.wave >> 2, kq = F.wave & 3, c = F.lane & 15, q = F.lane >> 4;
          const bf16* ap = x1b + (size_t)(tb * 32 + mt * 16 + c) * D + kq * 512 + 4 * q;
          const float* bp = wr + ((size_t)(kq * 128 + q) * 16 + c) * 4;
          f32x4v acc[3] = {{0.f, 0.f, 0.f, 0.f}, {0.f, 0.f, 0.f, 0.f}, {0.f, 0.f, 0.f, 0.f}};
#pragma unroll 4
          for (int ks = 0; ks < 32; ++ks) { const v2u aw = *(const GAS v2u*)(ap + 16 * ks); const f32x4 a4 = (f32x4){bflo(aw.x), bfhi(aw.x), bflo(aw.y), bfhi(aw.y)}; f32x4 b4[3];
#pragma unroll
              for (int nb = 0; nb < 3; ++nb) b4[nb] = *(const GAS f32x4*)(bp + ((size_t)nb * 512 + 4 * ks) * 64);
#pragma unroll
              for (int j = 0; j < 4; ++j)
#pragma unroll
                  for (int nb = 0; nb < 3; ++nb) acc[nb] = __builtin_amdgcn_mfma_f32_16x16x4f32(a4[j], b4[nb][j], acc[nb], 0, 0, 0); }
#pragma unroll
          for (int nb = 0; nb < 3; ++nb)
#pragma unroll
              for (int r = 0; r < 4; ++r) P[((kq * 2 + mt) * 16 + 4 * q + r) * 48 + nb * 16 + c] = acc[nb][r]; }
        __syncthreads();
        if (F.tid < 32) { const int tk = tb * 32 + F.tid, mt = F.tid >> 4, ti = F.tid & 15;
            const LAS f32x4* P4 = (const LAS f32x4*)P;
            const int rb = (mt * 16 + ti) * 12;
            const float* bg1 = a.in[I_BG1] + l * 4; const float* bg2 = a.in[I_BG2] + l * 32;
            const f32x4 s1 = (P4[rb] + P4[rb + 384]) + (P4[rb + 768] + P4[rb + 1152]);
            const float l10 = s1.x + bg1[0], l11 = s1.y + bg1[1], l12 = s1.z + bg1[2], l13 = s1.w + bg1[3];
            int grp = 0; float mx = l10;
            if (l11 > mx) { mx = l11; grp = 1; } if (l12 > mx) { mx = l12; grp = 2; } if (l13 > mx) { mx = l13; grp = 3; }
            const float psel = 1.f / (expf(l10 - mx) + expf(l11 - mx) + expf(l12 - mx) + expf(l13 - mx));
            const int ob = rb + 1 + 2 * grp;
            const f32x4 sa = (P4[ob] + P4[ob + 384]) + (P4[ob + 768] + P4[ob + 1152]), sb = (P4[ob + 1] + P4[ob + 385]) + (P4[ob + 769] + P4[ob + 1153]);
            const f32x4 ba = *(const GAS f32x4*)(bg2 + grp * 8), bb = *(const GAS f32x4*)(bg2 + grp * 8 + 4);
            const float l2[8] = {sa.x + ba.x, sa.y + ba.y, sa.z + ba.z, sa.w + ba.w, sb.x + bb.x, sb.y + bb.y, sb.z + bb.z, sb.w + bb.w};
            int i0 = 0; float v0 = l2[0];
#pragma unroll
            for (int e = 1; e < 8; ++e) if (l2[e] > v0) { v0 = l2[e]; i0 = e; }
            int i1 = -1; float v1 = -INFINITY;
#pragma unroll
            for (int e = 0; e < 8; ++e) if (e != i0 && l2[e] > v1) { v1 = l2[e]; i1 = e; }
            const float e1 = expf(v1 - v0), g0 = psel / (1.f + e1), g1 = psel * e1 / (1.f + e1);
            const int ex0 = grp * 8 + i0, ex1 = grp * 8 + i1;
            const unsigned r0 = __hip_atomic_fetch_add(cnt + 64 * ex0, 1u, RLX_AGENT), r1 = __hip_atomic_fetch_add(cnt + 64 * ex1, 1u, RLX_AGENT);
            { int* list = (int*)(F.ws + (probe ? WS_OP + 2 * MiB : WS_LIST)); list[ex0 * 8192 + (int)r0] = tk; list[ex1 * 8192 + (int)r1] = tk; }
            tok_e[2 * tk] = ex0; tok_e[2 * tk + 1] = ex1; tok_rank[2 * tk] = (int)r0; tok_rank[2 * tk + 1] = (int)r1; tok_gate[2 * tk] = g0; tok_gate[2 * tk + 1] = g1; }
        __syncthreads();
    }
}
__device__ __forceinline__ void moe_table(Frame& F, int l) {
    LAS int* tstart = (LAS int*)(F.lds + TAB_OFF);
    if (F.tid == 0) { int acc = 0;
        for (int e = 0; e < 32; ++e) { tstart[e] = acc; const unsigned c = __hip_atomic_load(F.ctl + CW_CNT + 2048 * l + 64 * e, RLX_AGENT); tstart[36 + e] = (int)c; acc += (int)((c + 255u) >> 8); }
        tstart[32] = acc; }
    __syncthreads();
}
__device__ __forceinline__ void ln2_phase(Frame& F, const Args& a, int l) {
    const bf16* x1b = (const bf16*)(F.ws + WS_X1B); const bf16* yb = (const bf16*)(F.ws + WS_YB); bf16* xb = (bf16*)(F.ws + WS_XB);
    const float* lng = a.in[I_LNG] + ((size_t)l * 2 + 1) * D; const float* lnb = a.in[I_LNB] + ((size_t)l * 2 + 1) * D;
    moe_table(F, l); const LAS int* tstart = (const LAS int*)(F.lds + TAB_OFF);
    const int* tok_e = (const int*)(F.ws + WS_ROUTE); const int* tok_rank = tok_e + 2 * T; const float* tok_gate = (const float*)(F.ws + WS_ROUTE) + 4 * T;
    const int gw = F.c * NWAVES + F.wave, NGW = F.G * NWAVES;
    for (int t4 = gw; t4 < T / 4; t4 += NGW) { const int tk0 = t4 * 4;
        int ev = 0, rv = 0; float gv = 0.f;
        if (F.lane < 8) { ev = tok_e[2 * tk0 + F.lane]; rv = tok_rank[2 * tk0 + F.lane]; gv = tok_gate[2 * tk0 + F.lane]; }
        const int slotv = (F.lane < 8) ? tstart[ev] * 256 + rv : 0;
        v4u xr[2], ya[2], yc[2]; v4u xr2[2], ya2[2], yc2[2];
#define LN2_LOAD(i, XR, YA, YC, XR2, YA2, YC2) do { const int s0_ = __builtin_amdgcn_readlane(slotv, 2 * (i)), s1_ = __builtin_amdgcn_readlane(slotv, 2 * (i) + 1); \
        _Pragma("unroll") for (int j = 0; j < 2; ++j) { const int d0 = 8 * F.lane + 512 * j; XR[j] = *(const GAS v4u*)(x1b + (size_t)(tk0 + (i)) * D + d0); YA[j] = *(const GAS v4u*)(yb + (size_t)s0_ * D + d0); YC[j] = *(const GAS v4u*)(yb + (size_t)s1_ * D + d0); } \
        _Pragma("unroll") for (int j = 0; j < 2; ++j) { const int d0 = 8 * F.lane + 512 * (j + 2); XR2[j] = *(const GAS v4u*)(x1b + (size_t)(tk0 + (i)) * D + d0); YA2[j] = *(const GAS v4u*)(yb + (size_t)s0_ * D + d0); YC2[j] = *(const GAS v4u*)(yb + (size_t)s1_ * D + d0); } } while (0)
        LN2_LOAD(0, xr, ya, yc, xr2, ya2, yc2);
#pragma unroll
        for (int i = 0; i < 4; ++i) { const int tk = tk0 + i;
            const float g0 = __builtin_bit_cast(float, __builtin_amdgcn_readlane(__builtin_bit_cast(int, gv), 2 * i)), g1 = __builtin_bit_cast(float, __builtin_amdgcn_readlane(__builtin_bit_cast(int, gv), 2 * i + 1));
            float v[4][8]; float s = 0.f;
#pragma unroll
            for (int j = 0; j < 4; ++j) { const v4u X = j < 2 ? xr[j] : xr2[j - 2], A = j < 2 ? ya[j] : ya2[j - 2], C = j < 2 ? yc[j] : yc2[j - 2];
                v[j][0] = bflo(X.x) * DN_ALPHA + (g0 * bflo(A.x) + g1 * bflo(C.x)); v[j][1] = bfhi(X.x) * DN_ALPHA + (g0 * bfhi(A.x) + g1 * bfhi(C.x));
                v[j][2] = bflo(X.y) * DN_ALPHA + (g0 * bflo(A.y) + g1 * bflo(C.y)); v[j][3] = bfhi(X.y) * DN_ALPHA + (g0 * bfhi(A.y) + g1 * bfhi(C.y));
                v[j][4] = bflo(X.z) * DN_ALPHA + (g0 * bflo(A.z) + g1 * bflo(C.z)); v[j][5] = bfhi(X.z) * DN_ALPHA + (g0 * bfhi(A.z) + g1 * bfhi(C.z));
                v[j][6] = bflo(X.w) * DN_ALPHA + (g0 * bflo(A.w) + g1 * bflo(C.w)); v[j][7] = bfhi(X.w) * DN_ALPHA + (g0 * bfhi(A.w) + g1 * bfhi(C.w));
#pragma unroll
                for (int e = 0; e < 8; ++e) s += v[j][e]; }
            if (i + 1 < 4) LN2_LOAD(i + 1, xr, ya, yc, xr2, ya2, yc2);
            const float mean = wave_sum(s) * (1.f / D); float s2 = 0.f;
#pragma unroll
            for (int j = 0; j < 4; ++j)
#pragma unroll
                for (int e = 0; e < 8; ++e) { v[j][e] -= mean; s2 += v[j][e] * v[j][e]; }
            const float rstd = 1.f / sqrtf(wave_sum(s2) * (1.f / D) + LN_EPS);
#pragma unroll
            for (int j = 0; j < 4; ++j) { const int d0 = 8 * F.lane + 512 * j; const f32x4 g0v = *(const GAS f32x4*)(lng + d0), g1v = *(const GAS f32x4*)(lng + d0 + 4), b0 = *(const GAS f32x4*)(lnb + d0), b1 = *(const GAS f32x4*)(lnb + d0 + 4);
                const f32x4 oa = (f32x4){v[j][0] * rstd * g0v.x + b0.x, v[j][1] * rstd * g0v.y + b0.y, v[j][2] * rstd * g0v.z + b0.z, v[j][3] * rstd * g0v.w + b0.w};
                const f32x4 ob = (f32x4){v[j][4] * rstd * g1v.x + b1.x, v[j][5] * rstd * g1v.y + b1.y, v[j][6] * rstd * g1v.z + b1.z, v[j][7] * rstd * g1v.w + b1.w};
                if (l == DEPTH - 1) { *(GAS f32x4*)(a.out + (size_t)tk * D + d0) = oa; *(GAS f32x4*)(a.out + (size_t)tk * D + d0 + 4) = ob; }
                else { v4u w; w.x = pk2(oa.x, oa.y); w.y = pk2(oa.z, oa.w); w.z = pk2(ob.x, ob.y); w.w = pk2(ob.z, ob.w); *(GAS v4u*)(xb + (size_t)tk * D + d0) = w;
                    unsigned lo = 0u, hi = 0u; lo = __builtin_amdgcn_cvt_pk_fp8_f32(oa.x, oa.y, lo, false); lo = __builtin_amdgcn_cvt_pk_fp8_f32(oa.z, oa.w, lo, true); hi = __builtin_amdgcn_cvt_pk_fp8_f32(ob.x, ob.y, hi, false); hi = __builtin_amdgcn_cvt_pk_fp8_f32(ob.z, ob.w, hi, true);
                    v2u qq; qq.x = lo; qq.y = hi; *(GAS v2u*)(F.ws + WS_XQ + (size_t)tk * D + d0) = qq; } }
        }
#undef LN2_LOAD
    }
}

__global__ void __launch_bounds__(NWAVES * 64, 2) fwd_kernel(Args args) {
    extern __shared__ __attribute__((aligned(16))) unsigned char lds[];
    Frame F;
    F.lds = (LAS unsigned char*)lds; F.ldsg = (char*)lds;
    F.tid = threadIdx.x; F.lane = F.tid & 63; F.wave = __builtin_amdgcn_readfirstlane(F.tid >> 6);
    F.G = gridDim.x; F.c = blockIdx.x; F.ws = args.ws; F.ctl = (gu32*)(args.ws + WS_CTL);
    volatile LAS unsigned* MISC = (volatile LAS unsigned*)(F.lds + MISC_OFF);
    for (int u = F.tid; u < (LDS_BYTES - LDSCTL_OFF) / 4; u += NWAVES * 64) ((LAS unsigned*)(F.lds + LDSCTL_OFF))[u] = 0u;
    __syncthreads();
    const int lo = args.ph_lo, hi = args.ph_hi; int lastp = -1;
    const bool multi = (hi - lo) > 1;
    XcdBarrier bar; bar.bar = (unsigned*)(F.ctl + CW_BAR); bar.x = 0; bar.st = nullptr;
    if (multi) bar = xcd_barrier_post((unsigned*)(F.ctl + CW_BAR), MISC + 8);
#ifndef REP_MASK
#define REP_MASK 0
#endif
#define REP(k) for (int rep_ = 0; rep_ <= ((REP_MASK >> (k)) & 1); ++rep_)
#define IN(p) (lo <= (p) && (p) < hi)
#ifdef PROBE_A
#define STAMP(i) do { if (blockIdx.x == 0 && threadIdx.x == 0) ((unsigned long long*)(args.ws + WS_TS))[(i)] = __builtin_amdgcn_s_memrealtime(); } while (0)
#else
#define STAMP(i) do { } while (0)
#endif
#define SEAM(p) do { conv_note_fin(F, (p)); lastp = (p); if ((p) + 1 < hi) xcd_barrier(bar); STAMP((p) + 1); } while (0)
#define CONVFIN() ((lastp >= 0) ? (int)__hip_atomic_load(F.ctl + CW_FIN + 64 * lastp, RLX_AGENT) : 0)
#define FRESH() do { int t_ = threadIdx.x; asm volatile("" : "+v"(t_)); F.tid = t_; F.lane = t_ & 63; F.wave = __builtin_amdgcn_readfirstlane(t_ >> 6); \
    GAS unsigned char* w_ = (GAS unsigned char*)args.ws; asm volatile("" : "+s"(w_)); F.ws = (unsigned char*)w_; F.ctl = (gu32*)(w_ + WS_CTL); } while (0)

    STAMP(0);
    if (IN(0)) { FRESH(); REP(9) prologue_phase(F, args); SEAM(0); }
#ifdef XBAR
    for (int xb_ = 0; xb_ < XBAR; ++xb_) xcd_barrier(bar);
#endif

    for (int l = 0; l < DEPTH; ++l) {
        const int pb = 1 + NPH_LAYER * l;
        if (IN(pb + 0)) { FRESH();
            const int N = (l < 2) ? NINA : (l == 2 ? 5120 : 2048);
            const unsigned char* Bt = F.ws + ((l < 2) ? WS_WAIN + (size_t)l * NINA * D * 2 : (l == 2 ? WS_WBIN0 : WS_WBIN1));
            const int nu = (T / 256) * (N / 256) + (l == 0 ? 16 : 0), ncv = conv_servers(nu, F.G, CONVFIN()), Gc = F.G - ncv; const bool f8 = F8L(l);
            if (F.c < Gc) {
                pg8::EpiBf16X E{l < 2 ? 0 : 1, (bf16*)(F.ws + WS_Z), (bf16*)(F.ws + WS_KD), (bf16*)(F.ws + WS_VD), (bf16*)(F.ws + WS_MEMKV), nullptr, nullptr};
                if (f8) { pg8::Gemm g{nullptr, nullptr, T, N, D / 2}; pg8::DualOrder8 S; S.init(F.ws + WS_XQ, Bt, T, N, D / 2, Gc, F.c, F.ws + WS_MEMQ, F.ws + WS_WMKV, l == 0 ? 16 : 0);
                    REP(0) pg8::gemm_phase<pg8::EpiBf16X, pg8::DualOrder8, true, true>(F.lds + RING_OFF, g, S, E); }
                else { pg8::Gemm g{nullptr, nullptr, T, N, D}; pg8::DualOrder S; S.init(F.ws + WS_XB, Bt, T, N, D, Gc, F.c, F.ws + WS_MEMB, F.ws + WS_WMKV, l == 0 ? 16 : 0);
                    REP(0) pg8::gemm_phase<pg8::EpiBf16X, pg8::DualOrder, true, true>(F.lds + RING_OFF, g, S, E); }
                if (ncv) conv_done(F, pb + 0);
                { const int mine = (nu - 1 - F.c) / Gc + 1, rounds = (nu + Gc - 1) / Gc; conv_filler(F, args, 2 * l, (rounds - mine) * (f8 ? (QA + 1) / 2 : QA)); }
            } else conv_server(F, args, pb + 0, 2 * l, Gc);
            SEAM(pb + 0);
        }
        if (IN(pb + 1)) { FRESH();
            if (l < 2) {
                REP(1) for (int u = F.c; u < 256 + 128; u += F.G) {
                    if (u < 256) sgu_unit(F, args, l, u >> 2, u & 3);
                    else { const int r = u - 256; memattn_unit(F, l, r & 3, r >> 2, NINA, 2 * MIXW); }
                }
                if (F.c >= 128) conv_filler(F, args, 2 * l, QX);
            } else {
                const int ncv = CONVFIN() ? 0 : NCVATT;
                if (F.c >= F.G - ncv) { conv_server_q(F, args, F.ctl + CW_Q + 64 * l, (unsigned)(att2::NUNITS + 128 - STOPU), 2 * l); __syncthreads(); }
                REP(2) { gu32* qh = F.ctl + CW_Q + 64 * l + 16 * rep_; LAS unsigned* uw = (LAS unsigned*)(F.lds + att2::LDS_UNIT);
                for (;;) {
                    if (F.tid == 0) *uw = __hip_atomic_fetch_add(qh, 1u, RLX_AGENT);
                    __syncthreads();
                    const unsigned idx = *uw;
                    __syncthreads();
                    if (idx >= (unsigned)(att2::NUNITS + 128)) break;
                    if (idx < (unsigned)att2::NUNITS) diffattn2_unit(F, args, att2::g_units.u[idx]);
                    else { const int r = (int)idx - att2::NUNITS; memattn_unit(F, l, r & 3, r >> 2, 2048, MIXW); }
                } }
            }
            SEAM(pb + 1);
        }
        if (IN(pb + 2) && l >= 2) { FRESH(); REP(3) diffcombine_phase(F, args, l); SEAM(pb + 2); }
        if (IN(pb + 3)) { FRESH();
            pg8::EpiResBf16 E{(const bf16*)(F.ws + WS_XB), (bf16*)(F.ws + WS_Y), DN_ALPHA};
            const unsigned char* Wo = F.ws + (l < 2 ? WS_WAOUT + (size_t)l * D * D * 2 : WS_WBOUT + (size_t)(l - 2) * D * D * 2);
            if (F8OL(l)) { pg8::Gemm g{nullptr, nullptr, T, D, D / 2}; pg8::DenseOrder8 S; S.init(F.ws + WS_CATQ, Wo, T, D, D / 2, F.G, F.c);
                REP(4) pg8::gemm_phase<pg8::EpiResBf16, pg8::DenseOrder8, true, true>(F.lds + RING_OFF, g, S, E); }
            else { pg8::Gemm g{nullptr, nullptr, T, D, D}; pg8::DenseOrder S; S.init(F.ws + WS_CAT, Wo, T, D, D, F.G, F.c);
                REP(4) pg8::gemm_phase<pg8::EpiResBf16, pg8::DenseOrder, true, true>(F.lds + RING_OFF, g, S, E); }
            SEAM(pb + 3);
        }
        if (IN(pb + 4)) { FRESH(); ln1_router_phase(F, args, l);
#ifdef REP_LN1
            ln1_router_phase(F, args, l, 1);
#endif
            conv_filler(F, args, 2 * l, -1); SEAM(pb + 4); }
        if (IN(pb + 6)) { FRESH();
            moe_table(F, l);
            const LAS int* tb = (const LAS int*)(F.lds + TAB_OFF);
            const int nu = tb[32] * 4, ncv = conv_servers(nu, F.G, CONVFIN()), Gc = F.G - ncv;
            if (F.c < Gc) {
                pg8::Gemm g{nullptr, nullptr, SLOTS, 1024, D / 2};
                pg8::MoeGatherOrder S{tb, tb + 36, (const int*)(F.ws + WS_LIST), 4, Gc, F.c, (const char*)(F.ws + WS_X1F), (const char*)(F.ws + WS_W13) + (size_t)l * NE * 1024 * 2048, (size_t)1024 * 2048, (size_t)256 * 2048, (unsigned)D};
                pg8::EpiMoe1 E{(bf16*)(F.ws + WS_H), tb, tb + 36};
                REP(6) pg8::gemm_phase<pg8::EpiMoe1, pg8::MoeGatherOrder, true, true>(F.lds + RING_OFF, g, S, E);
                if (ncv) conv_done(F, pb + 6);
                { const int mine = (F.c < nu) ? (nu - 1 - F.c) / Gc + 1 : 0, rounds = (nu + Gc - 1) / Gc; conv_filler(F, args, 2 * l + 1, (rounds - mine) * QM); }
            } else conv_server(F, args, pb + 6, 2 * l + 1, Gc);
            SEAM(pb + 6);
        }
        if (IN(pb + 7)) { FRESH();
            moe_table(F, l);
            const int nu = ((const LAS int*)(F.lds + TAB_OFF))[32] * 8, ncv = conv_servers(nu, F.G, CONVFIN()), Gc = F.G - ncv;
            if (F.c < Gc) {
                pg8::Gemm g{nullptr, nullptr, SLOTS, D, FF / 2};
                pg8::MoeOrder8 S{(const PG8_LAS int*)(F.lds + TAB_OFF), 8, Gc, F.c, (const char*)(F.ws + WS_H), (const char*)(F.ws + WS_W2) + (size_t)l * NE * 2048 * 512, (size_t)256 * FF, (size_t)2048 * 512, (size_t)256 * 512};
                pg8::EpiBf16X E{3, (bf16*)(F.ws + WS_YB), nullptr, nullptr, nullptr, (const PG8_LAS int*)(F.lds + TAB_OFF), (const PG8_LAS int*)(F.lds + TAB_OFF) + 36};
                REP(7) pg8::gemm_phase<pg8::EpiBf16X, pg8::MoeOrder8, true, true>(F.lds + RING_OFF, g, S, E);
                if (ncv) conv_done(F, pb + 7);
                { const int mine = (F.c < nu) ? (nu - 1 - F.c) / Gc + 1 : 0, rounds = (nu + Gc - 1) / Gc; conv_filler(F, args, 2 * l + 1, (rounds - mine) * QB); }
            } else conv_server(F, args, pb + 7, 2 * l + 1, Gc);
            SEAM(pb + 7);
        }
        if (IN(pb + 8)) { FRESH(); REP(8) ln2_phase(F, args, l); conv_filler(F, args, 2 * l + 1, -1); SEAM(pb + 8); }
    }
#ifdef PROBE_A
    {
        VM_WAIT(); xcd_barrier(bar);
        const unsigned long long* ts = (const unsigned long long*)(args.ws + WS_TS);
        float da = 0.f, db = 0.f;
        for (int p = 0; p < NPHASES; ++p) { const int k = (p == 0) ? 9 : (p - 1) % NPH_LAYER; const float d = (float)(ts[p + 1] - ts[p]);
            if (k == PROBE_A || PROBE_A == 10) da += d; if (k == PROBE_B || PROBE_B == 10) db += d; }
        const float kk = sqrtf(da), vv = db;
        float* o = args.out; const long n = (long)T * D;
        for (long i = (long)blockIdx.x * 512 + threadIdx.x; i < n; i += (long)gridDim.x * 512) o[i] = (i == 0) ? vv : kk;
    }
#endif
#undef IN
#undef SEAM
}

#ifndef MK_ONE_LAUNCH
#define MK_ONE_LAUNCH 1
#endif
extern "C" void kernel_launch(void* const* d_in, const int* in_sizes, int n_in, void* d_out, int out_size, void* d_ws, size_t ws_size, hipStream_t stream) {
    static int grid = 0;
    if (grid == 0) {
        if (n_in != 24 || in_sizes[0] != T * D || out_size != T * D || ws_size < WS_END) { fprintf(stderr, "kernel_launch: unexpected shapes (n_in %d, in0 %d, out %d, ws %zu < %zu)\n", n_in, n_in > 0 ? in_sizes[0] : -1, out_size, ws_size, (size_t)WS_END); grid = -1; return; }
        int dev = 0, cus = 0, per_cu = 0;
        if (hipGetDevice(&dev) != hipSuccess || hipDeviceGetAttribute(&cus, hipDeviceAttributeMultiprocessorCount, dev) != hipSuccess) { grid = -1; return; }
        if (hipFuncSetAttribute((const void*)fwd_kernel, hipFuncAttributeMaxDynamicSharedMemorySize, LDS_BYTES) != hipSuccess) { fprintf(stderr, "kernel_launch: hipFuncSetAttribute failed\n"); grid = -1; return; }
        if (hipOccupancyMaxActiveBlocksPerMultiprocessor(&per_cu, (const void*)fwd_kernel, NWAVES * 64, LDS_BYTES) != hipSuccess || per_cu < 1) fprintf(stderr, "kernel_launch: occupancy query reports %d\n", per_cu);
        (void)hipGetLastError();
        grid = cus;
    }
    if (grid < 0) return;
    if (hipMemsetAsync((char*)d_ws + WS_CTL, 0, CTL_ZERO_BYTES, stream) != hipSuccess) return;
    Args a{};
    for (int i = 0; i < 24; ++i) a.in[i] = (const float*)d_in[i];
    a.out = (float*)d_out; a.ws = (unsigned char*)d_ws;
#if MK_ONE_LAUNCH
    a.ph_lo = 0; a.ph_hi = NPHASES;
    hipLaunchKernelGGL(fwd_kernel, dim3(grid), dim3(NWAVES * 64), LDS_BYTES, stream, a);
#else
    for (int p = 0; p < NPHASES; ++p) {
        const int k = (p - 1) % NPH_LAYER, l = (p - 1) / NPH_LAYER;
        if (p > 0 && k == 2 && l < 2) continue;
        a.ph_lo = p; a.ph_hi = p + 1;
        hipLaunchKernelGGL(fwd_kernel, dim3(grid), dim3(NWAVES * 64), LDS_BYTES, stream, a);
    }
#endif
    const hipError_t le = hipPeekAtLastError();
    if (le != hipSuccess) fprintf(stderr, "kernel_launch: launch failed: %s\n", hipGetErrorName(le));
}
```

```cpp
#define F8MASK 12
#define F8OMASK 12
#include <hip/hip_runtime.h>
#include <cstdio>
#include <cstdint>
namespace pg8 {
#define PG8_LAS __attribute__((address_space(3)))
typedef unsigned short bf16_t;
typedef short bf16x8 __attribute__((ext_vector_type(8)));
typedef float f32x4 __attribute__((ext_vector_type(4)));
typedef unsigned u32x4 __attribute__((ext_vector_type(4)));
constexpr int BM = 256, BK = 64, HALF = 128, HTB = HALF * BK * 2  , STAGE_BYTES = 8 * HTB, NXCD = 8, WGM = 8;

__host__ __device__ __forceinline__ int lds_byte(int r, int c) { const int st = (r >> 4) * 2 + (c >> 5), rr = r & 15, cc = c & 31, ob = rr * 64 + cc * 2; return st * 1024 + (ob ^ (((ob >> 9) & 1) << 5)); }
__host__ __device__ __forceinline__ void stage_rc(int b, int& R, int& C) { const int st = b / 1024, sb = b % 1024, swz = sb ^ (((sb >> 9) & 1) << 5); R = (st >> 1) * 16 + swz / 64; C = (st & 1) * 32 + (swz % 64) / 2; }
__host__ __device__ __forceinline__ int perm32(int rho) { const int n = rho >> 4, i = rho & 15; return 8 * (i >> 2) + 4 * n + (i & 3); }

typedef int pg8_v4i __attribute__((ext_vector_type(4))); typedef int pg8_v8i __attribute__((ext_vector_type(8)));
__device__ __forceinline__ pg8_v8i pg8_cat8(bf16x8 a, bf16x8 b) { return __builtin_shufflevector(__builtin_bit_cast(pg8_v4i, a), __builtin_bit_cast(pg8_v4i, b), 0, 1, 2, 3, 4, 5, 6, 7); }
struct Unit { int pm, pn, e; };
struct Gemm { const bf16_t* A; const bf16_t* Bt; int M, N, K; };

struct StaticOrder {
    static constexpr bool GATHER = false, F8 = false; static constexpr int SCALE_B = 127;
    int nM, nN, nwg, G, c;
    __host__ __device__ void init(int M, int N, int G_, int c_) { nM = M / BM; nN = N / BM; nwg = nM * nN; G = G_; c = c_; }
    __host__ __device__ bool next(int i, Unit& u) const {
        const long L = (long)i * G + c; if (L >= nwg) return false;
        int wgid = (int)L; { const int q = nwg / NXCD, r = nwg % NXCD, xcd = wgid % NXCD, off = wgid / NXCD; wgid = (xcd < r ? xcd * (q + 1) : r * (q + 1) + (xcd - r) * q) + off; }
        const int nig = WGM * nN, gid = wgid / nig, fm = gid * WGM, gsz = (nM - fm) < WGM ? (nM - fm) : WGM;
        u.pm = fm + ((wgid % nig) % gsz); u.pn = (wgid % nig) / gsz; return true;
    }
    __device__ __forceinline__ void a_ready(const Unit&) const {}
    __device__ __forceinline__ void done(const Unit&) const {}
};

__device__ __forceinline__ unsigned cvt_pk_bf16(float lo, float hi) { unsigned r; asm volatile("v_cvt_pk_bf16_f32 %0, %1, %2" : "=v"(r) : "v"(lo), "v"(hi)); return r; }
typedef float f32x2 __attribute__((ext_vector_type(2)));
__device__ __forceinline__ f32x2 gelu_pk(f32x2 v) {
    const f32x2 av = __builtin_elementwise_abs(v), d = av * 0.2316418882f + 1.0f;
    f32x2 t; t.x = __builtin_amdgcn_rcpf(d.x); t.y = __builtin_amdgcn_rcpf(d.y);
    f32x2 q = t * 0.5307027145f + (-0.7265760135f); q = q * t + 0.7107068705f; q = q * t + (-0.142248368f); q = q * t + 0.127414796f; q = q * t;
    const f32x2 s = (v * v) * (-0.72134752044f);
    f32x2 e; e.x = __builtin_amdgcn_exp2f(s.x); e.y = __builtin_amdgcn_exp2f(s.y);
    const f32x2 m = v * (q * e), r = v - m;
    f32x2 o; o.x = v.x < 0.f ? m.x : r.x; o.y = v.y < 0.f ? m.y : r.y; return o;
}

template <class Epi, class Sched, bool ALIGN_EPI = false, bool SP2 = false>
__device__ __forceinline__ void gemm_phase(PG8_LAS unsigned char* lds, const Gemm g, const Sched& S, const Epi& E) {
    int tid_ = threadIdx.x; asm volatile("" : "+v"(tid_));
    const int tid = tid_, wid = __builtin_amdgcn_readfirstlane(tid >> 6), lane = tid & 63, wr = wid >> 2, wc = wid & 3, fr = lane & 15, fq = lane >> 4;
    const int K = g.K, nt = K / BK;
    unsigned voffA[2], voffB[2];
#pragma unroll
    for (int i = 0; i < 2; ++i) { int R, C; stage_rc(tid * 16 + i * 8192, R, C); const int Rb = Epi::PERM ? ((R & ~31) + perm32(R & 31)) : R;
        voffA[i] = (unsigned)(R * K + C) * 2u; voffB[i] = (unsigned)(Rb * K + C) * 2u; }
    unsigned vAc[2][2], vAn[2][2];
    int gR[2], gC[2];
#pragma unroll
    for (int i = 0; i < 2; ++i) { stage_rc(tid * 16 + i * 8192, gR[i], gC[i]); }
    const size_t kstep = (size_t)(BK * 2);
    const size_t hstep = (size_t)HALF * K * 2;
        const unsigned ldsw = (unsigned)wid * 1024u;
    const int aoff = lds_byte(wr * 64 + fr, fq * 8), boff = lds_byte(wc * 32 + fr, fq * 8);
#define PG8_SA(b, h) (((b) * 2 + (h)) * HTB)
#define PG8_SB(b, h) ((4 + (b) * 2 + (h)) * HTB)
#define PG8_STAGE(bufoff, gbase, voff) do { _Pragma("unroll") for (int _i = 0; _i < 2; ++_i) \
        __builtin_amdgcn_global_load_lds((const unsigned*)((const char*)(gbase) + (voff)[_i]), (PG8_LAS unsigned*)(lds + (bufoff) + ldsw + _i * 8192), 16, 0, 0); } while (0)
#define PG8_STAGE_A(b, h, base, VS) do { if constexpr (Sched::GATHER) { PG8_STAGE(PG8_SA(b, h), base, VS[h]); } else { PG8_STAGE(PG8_SA(b, h), (base) + (h) * hstep, voffA); } } while (0)
#define PG8_STAGE_AN(b, h, base) do { if constexpr (Sched::GATHER) { unsigned vs_[2] = {last ? vAn[h][0] : vAc[h][0], last ? vAn[h][1] : vAc[h][1]}; PG8_STAGE(PG8_SA(b, h), base, vs_); } else { PG8_STAGE(PG8_SA(b, h), (base) + (h) * hstep, voffA); } } while (0)
#define PG8_LDA(dst, b, h) do { if constexpr (Sched::F8) { _Pragma("unroll") for (int m = 0; m < 4; ++m) { dst##8[m].lo = *(const PG8_LAS pg8_v4i*)(lds + PG8_SA(b, h) + aoff + m * 2048); dst##8[m].hi = *(const PG8_LAS pg8_v4i*)(lds + PG8_SA(b, h) + aoff + m * 2048 + 1024); } } \
        else { _Pragma("unroll") for (int m = 0; m < 4; ++m) _Pragma("unroll") for (int k = 0; k < 2; ++k) dst[m][k] = *(const PG8_LAS bf16x8*)(lds + PG8_SA(b, h) + aoff + m * 2048 + k * 1024); } } while (0)
#define PG8_LDB(dst, b, h) do { if constexpr (Sched::F8) { _Pragma("unroll") for (int n = 0; n < 2; ++n) { dst##8[n].lo = *(const PG8_LAS pg8_v4i*)(lds + PG8_SB(b, h) + boff + n * 2048); dst##8[n].hi = *(const PG8_LAS pg8_v4i*)(lds + PG8_SB(b, h) + boff + n * 2048 + 1024); } } \
        else { _Pragma("unroll") for (int n = 0; n < 2; ++n) _Pragma("unroll") for (int k = 0; k < 2; ++k) dst[n][k] = *(const PG8_LAS bf16x8*)(lds + PG8_SB(b, h) + boff + n * 2048 + k * 1024); } } while (0)
#define PG8_MMA(ai, bj, At, Bt) do { __builtin_amdgcn_s_setprio(1); if constexpr (Sched::F8) { \
        _Pragma("unroll") for (int m = 0; m < 4; ++m) _Pragma("unroll") for (int n = 0; n < 2; ++n) \
            asm volatile("v_mfma_scale_f32_16x16x128_f8f6f4 %0, %1, %2, %0, %3, %4 op_sel_hi:[0,0,0]" : "+v"(acc[ai][bj][m][n]) : "v"(Bt##8[n]), "v"(At##8[m]), "v"(sclB_), "v"(sclA_));     \
        } else { _Pragma("unroll") for (int m = 0; m < 4; ++m) _Pragma("unroll") for (int n = 0; n < 2; ++n) _Pragma("unroll") for (int k = 0; k < 2; ++k) \
        acc[ai][bj][m][n] = __builtin_amdgcn_mfma_f32_16x16x32_bf16(Bt[n][k], At[m][k], acc[ai][bj][m][n], 0, 0, 0); } __builtin_amdgcn_s_setprio(0); } while (0)
#define PG8_WAIT_V(n) asm volatile("s_waitcnt vmcnt(" #n ")" ::: "memory")
#define PG8_WAIT_L(n) asm volatile("s_waitcnt lgkmcnt(" #n ")" ::: "memory")
#define PG8_BAR __builtin_amdgcn_s_barrier()
#define PG8_SCHED __builtin_amdgcn_sched_barrier(0)
    Unit cur, nxt; int ui = 0;
    if (!S.next(0, cur)) return;
    f32x4 acc[2][2][4][2];
#pragma unroll
    for (int a = 0; a < 2; ++a)
#pragma unroll
        for (int b = 0; b < 2; ++b)
#pragma unroll
            for (int m = 0; m < 4; ++m)
#pragma unroll
                for (int n = 0; n < 2; ++n) acc[a][b][m][n] = (f32x4){0.f, 0.f, 0.f, 0.f};
    const int sclB_ = Sched::SCALE_B, sclA_ = 127;
    bf16x8 At[4][2], B0[2][2], B1[2][2]; pg8_v8i At8[4], B08[2], B18[2];
    const char* cA = S.aptr(cur); const char* cB = S.bptr(cur);
    S.a_ready(cur);
    if constexpr (Sched::GATHER) {
#pragma unroll
        for (int h = 0; h < 2; ++h)
#pragma unroll
            for (int i = 0; i < 2; ++i) { vAc[h][i] = S.rowoff(cur, h * HALF + gR[i]) + (unsigned)gC[i] * 2u; vAn[h][i] = vAc[h][i]; }
        asm volatile("s_waitcnt vmcnt(0)" ::: "memory");
    }
    if constexpr (SP2) {
        PG8_STAGE(PG8_SB(0, 0), cB, voffB); PG8_STAGE(PG8_SB(0, 1), cB + hstep, voffB); PG8_STAGE_A(0, 0, cA, vAc); PG8_STAGE_A(0, 1, cA, vAc);
        if (wr == 1) PG8_BAR;
        PG8_WAIT_V(2); PG8_BAR;
        PG8_STAGE(PG8_SB(1, 0), cB + kstep, voffB); PG8_STAGE_A(1, 0, cA + kstep, vAc); PG8_STAGE(PG8_SB(1, 1), cB + hstep + kstep, voffB);
        PG8_WAIT_V(6); PG8_BAR;
    } else {
        PG8_STAGE(PG8_SB(0, 0), cB, voffB); PG8_STAGE_A(0, 0, cA, vAc); PG8_STAGE(PG8_SB(0, 1), cB + hstep, voffB); PG8_STAGE_A(0, 1, cA, vAc);
        if (wr == 1) PG8_BAR;
        PG8_WAIT_V(4); PG8_BAR;
        PG8_STAGE(PG8_SB(1, 0), cB + kstep, voffB); PG8_STAGE_A(1, 0, cA + kstep, vAc); PG8_STAGE(PG8_SB(1, 1), cB + hstep + kstep, voffB);
        PG8_WAIT_V(6); PG8_BAR;
    }
    for (;;) {
        const bool has_next = S.next(ui + 1, nxt);
        const char* nA = has_next ? S.aptr(nxt) : cA; const char* nB = has_next ? S.bptr(nxt) : cB;
        if constexpr (Sched::GATHER) { if (has_next) {
#pragma unroll
            for (int h = 0; h < 2; ++h)
#pragma unroll
                for (int i = 0; i < 2; ++i) vAn[h][i] = S.rowoff(nxt, h * HALF + gR[i]) + (unsigned)gC[i] * 2u; } }
        for (int t = 0; t < nt; t += 2) {
            const bool last = (t == nt - 2);
            const char* a1 = cA + (size_t)(t + 1) * kstep;
            const char* a2 = last ? nA : cA + (size_t)(t + 2) * kstep; const char* b2 = last ? nB : cB + (size_t)(t + 2) * kstep;
            const char* a3 = a2 + kstep; const char* b3 = b2 + kstep;
            if (last && has_next) S.a_ready(nxt);
            if constexpr (SP2) {
            PG8_LDB(B0, 0, 0); PG8_LDB(B1, 0, 1); PG8_SCHED; PG8_LDA(At, 0, 0); PG8_STAGE_A(1, 1, a1, vAc);
            PG8_WAIT_V(8); PG8_WAIT_L(0); PG8_BAR; PG8_MMA(0, 0, At, B0); PG8_MMA(0, 1, At, B1); PG8_BAR; PG8_SCHED;
            PG8_LDA(At, 0, 1); PG8_STAGE(PG8_SB(0, 0), b2, voffB); PG8_STAGE(PG8_SB(0, 1), b2 + hstep, voffB); PG8_STAGE_AN(0, 0, a2);
            PG8_WAIT_V(8); PG8_WAIT_L(0); PG8_BAR; PG8_MMA(1, 0, At, B0); PG8_MMA(1, 1, At, B1); PG8_BAR; PG8_SCHED;
            PG8_LDB(B0, 1, 0); PG8_LDB(B1, 1, 1); PG8_SCHED; PG8_LDA(At, 1, 0); PG8_STAGE_AN(0, 1, a2);
            PG8_WAIT_V(8); PG8_WAIT_L(0); PG8_BAR; PG8_MMA(0, 0, At, B0); PG8_MMA(0, 1, At, B1); PG8_BAR; PG8_SCHED;
            PG8_LDA(At, 1, 1); PG8_STAGE(PG8_SB(1, 0), b3, voffB); PG8_STAGE(PG8_SB(1, 1), b3 + hstep, voffB); PG8_STAGE_AN(1, 0, a3);
            PG8_WAIT_V(8); PG8_WAIT_L(0); PG8_BAR; PG8_MMA(1, 0, At, B0); PG8_MMA(1, 1, At, B1); PG8_BAR; PG8_SCHED;
            } else {
            PG8_LDB(B0, 0, 0); PG8_SCHED; PG8_LDA(At, 0, 0); PG8_STAGE_A(1, 1, a1, vAc);
            PG8_WAIT_L(8); PG8_BAR; PG8_WAIT_L(0); PG8_MMA(0, 0, At, B0); PG8_BAR; PG8_SCHED;
            PG8_LDB(B1, 0, 1); PG8_STAGE(PG8_SB(0, 0), b2, voffB);
            PG8_BAR; PG8_WAIT_L(0); PG8_MMA(0, 1, At, B1); PG8_BAR;
            PG8_LDA(At, 0, 1); PG8_STAGE_AN(0, 0, a2);
            PG8_BAR; PG8_WAIT_L(0); PG8_MMA(1, 0, At, B0); PG8_BAR; PG8_SCHED;
            PG8_STAGE(PG8_SB(0, 1), b2 + hstep, voffB);
            PG8_WAIT_V(6); PG8_BAR; PG8_MMA(1, 1, At, B1); PG8_BAR;
            PG8_LDB(B0, 1, 0); PG8_SCHED; PG8_LDA(At, 1, 0); PG8_STAGE_AN(0, 1, a2);
            PG8_WAIT_L(8); PG8_BAR; PG8_WAIT_L(0); PG8_MMA(0, 0, At, B0); PG8_BAR; PG8_SCHED;
            PG8_LDB(B1, 1, 1); PG8_STAGE(PG8_SB(1, 0), b3, voffB);
            PG8_BAR; PG8_WAIT_L(0); PG8_MMA(0, 1, At, B1); PG8_BAR;
            PG8_LDA(At, 1, 1); PG8_STAGE_AN(1, 0, a3);
            PG8_BAR; PG8_WAIT_L(0); PG8_MMA(1, 0, At, B0); PG8_BAR; PG8_SCHED;
            PG8_STAGE(PG8_SB(1, 1), b3 + hstep, voffB);
            PG8_WAIT_V(6); PG8_BAR; PG8_MMA(1, 1, At, B1); PG8_BAR;
            }
        }
        if constexpr (ALIGN_EPI) { if (wr == 0) PG8_BAR; }
        if constexpr (!Epi::AFTER_DRAIN) { E(acc, cur, wr, wc, fr, fq); S.done(cur); }
        if (!has_next) break;
#pragma unroll
        for (int a = 0; a < 2; ++a)
#pragma unroll
            for (int b = 0; b < 2; ++b)
#pragma unroll
                for (int m = 0; m < 4; ++m)
#pragma unroll
                    for (int n = 0; n < 2; ++n) acc[a][b][m][n] = (f32x4){0.f, 0.f, 0.f, 0.f};
        cur = nxt; cA = nA; cB = nB; ++ui;
        if constexpr (Sched::GATHER) {
#pragma unroll
            for (int h = 0; h < 2; ++h)
#pragma unroll
                for (int i = 0; i < 2; ++i) vAc[h][i] = vAn[h][i]; }
        if constexpr (ALIGN_EPI) { if (wr == 1) PG8_BAR; }
    }
    PG8_WAIT_V(0);
    if constexpr (!ALIGN_EPI) { if (wr == 0) PG8_BAR; }
    PG8_BAR;
    if constexpr (Epi::AFTER_DRAIN) { E.fused(acc, cur, wr, wc, fr, fq, lds, wid, lane); S.done(cur); }
#undef PG8_SA
#undef PG8_SB
#undef PG8_STAGE
#undef PG8_STAGE_A
#undef PG8_STAGE_AN
#undef PG8_LDA
#undef PG8_LDB
#undef PG8_MMA
#undef PG8_WAIT_V
#undef PG8_WAIT_L
#undef PG8_BAR
#undef PG8_SCHED
}
}

constexpr int T = 8192, D = 2048, MIXW = 1536, MEMW = 512, NINA = 3584, DEPTH = 4, NE = 32, FF = 512, MEMT = 256;
constexpr int SLOTS = 24576;
constexpr float LN_EPS = 1e-5f;
constexpr float DN_ALPHA = 1.6817928305074292f;
constexpr float LOG2E = 1.4426950408889634f;
constexpr float QSCALE = 0.08838834764831845f * LOG2E;
constexpr int NWAVES = 8;

constexpr size_t MiB = 1u << 20;
constexpr size_t WS_CTL = 0, CTL_ZERO_BYTES = 1 * MiB;
constexpr size_t WS_WAIN = 2 * MiB, WS_WAOUT = 30 * MiB, WS_WBIN0 = 46 * MiB, WS_WKV = 54 * MiB, WS_WBIN1 = 66 * MiB, WS_WBOUT = 74 * MiB, WS_WMKV = 90 * MiB;
constexpr size_t WS_W13 = 106 * MiB, WS_W2 = 618 * MiB;
constexpr size_t WS_XB = 874 * MiB, WS_MEMB = 906 * MiB, WS_MEMKV = 907 * MiB, WS_Z = 910 * MiB, WS_KD = 966 * MiB, WS_VD = 990 * MiB, WS_CAT = 1014 * MiB;
constexpr size_t WS_XQ = 1206 * MiB, WS_ZQ = 1222 * MiB, WS_MEMQ = 1238 * MiB, WS_CATQ = 1246 * MiB;
constexpr size_t WS_Y = 1046 * MiB, WS_X1F = 1110 * MiB, WS_X1B = 1174 * MiB, WS_XF = 1206 * MiB, WS_XG = 1270 * MiB, WS_H = 1366 * MiB, WS_YB = 1390 * MiB, WS_OP = 1486 * MiB;
constexpr size_t WS_ROUTE = 1582 * MiB, WS_OP2 = 1583 * MiB, WS_ML = 1631 * MiB, WS_WR = 1634 * MiB, WS_TS = 1640 * MiB, WS_LIST = 1641 * MiB, WS_END = 1642 * MiB;
constexpr int CW_TMO = 0, CW_BAR = 4096, CW_CNT = 16384, CW_Q = 28672, CW_CONV = 29184, CW_DONE = 32768, CW_FIN = 40960;

constexpr int RING_OFF = 0, RING_BYTES = 131072;
constexpr int LDSCTL_OFF = 146432, MISC_OFF = LDSCTL_OFF + 320, TAB_OFF = LDSCTL_OFF + 512;
constexpr int LDS_BYTES = 147456;

#define GAS __attribute__((address_space(1)))
#define LAS __attribute__((address_space(3)))
typedef unsigned short bf16;
typedef unsigned v4u __attribute__((ext_vector_type(4)));
typedef unsigned v2u __attribute__((ext_vector_type(2)));
typedef float f32x4 __attribute__((ext_vector_type(4)));
typedef short bf16x8 __attribute__((ext_vector_type(8)));
typedef GAS unsigned gu32;
#define RLX_AGENT __ATOMIC_RELAXED, __HIP_MEMORY_SCOPE_AGENT
#define LDS_WAIT() asm volatile("s_waitcnt lgkmcnt(0)" ::: "memory")
#define VM_WAIT() asm volatile("s_waitcnt vmcnt(0)" ::: "memory")
__device__ __forceinline__ unsigned f2bf(float f) { unsigned u = __builtin_bit_cast(unsigned, f); return (u + 0x7fffu + ((u >> 16) & 1u)) >> 16; }
__device__ __forceinline__ unsigned pk2(float lo, float hi) { return f2bf(lo) | (f2bf(hi) << 16); }
__device__ __forceinline__ float bf2f(unsigned short b) { return __builtin_bit_cast(float, (unsigned)b << 16); }
__device__ __forceinline__ float bflo(unsigned w) { return __builtin_bit_cast(float, w << 16); }
__device__ __forceinline__ float bfhi(unsigned w) { return __builtin_bit_cast(float, w & 0xffff0000u); }
__device__ __forceinline__ float wave_sum(float v) {
#pragma unroll
    for (int o = 1; o < 64; o <<= 1) v += __shfl_xor(v, o);
    return v;
}

namespace pg8 {
struct DenseOrder {
    static constexpr bool GATHER = false, F8 = false; static constexpr int SCALE_B = 127;
    StaticOrder so; const char* A; const char* B; size_t astep, bstep;
    __device__ void init(const void* A_, const void* B_, int M, int N, int K, int G, int c) { so.init(M, N, G, c); A = (const char*)A_; B = (const char*)B_; astep = (size_t)256 * K * 2; bstep = astep; }
    __device__ __forceinline__ bool next(int i, Unit& u) const { u.e = 0; return so.next(i, u); }
    __device__ __forceinline__ const char* aptr(const Unit& u) const { return A + (size_t)u.pm * astep; }
    __device__ __forceinline__ const char* bptr(const Unit& u) const { return B + (size_t)u.pn * bstep; }
    __device__ __forceinline__ void a_ready(const Unit&) const {}
    __device__ __forceinline__ void done(const Unit&) const {}
};
struct DenseOrder8 {
    static constexpr bool GATHER = false, F8 = true; static constexpr int SCALE_B = 121;
    StaticOrder so; const char* A; const char* B; size_t astep, bstep;
    __device__ void init(const void* A_, const void* B_, int M, int N, int K, int G, int c) { so.init(M, N, G, c); A = (const char*)A_; B = (const char*)B_; astep = (size_t)256 * K * 2; bstep = astep; }
    __device__ __forceinline__ bool next(int i, Unit& u) const { u.e = 0; return so.next(i, u); }
    __device__ __forceinline__ const char* aptr(const Unit& u) const { return A + (size_t)u.pm * astep; }
    __device__ __forceinline__ const char* bptr(const Unit& u) const { return B + (size_t)u.pn * bstep; }
    __device__ __forceinline__ void a_ready(const Unit&) const {}
    __device__ __forceinline__ void done(const Unit&) const {}
};
struct DualOrder {
    static constexpr bool GATHER = false, F8 = false; static constexpr int SCALE_B = 127;
    StaticOrder so; int nwg2; const char* A; const char* B; const char* A2; const char* B2; size_t step;
    __device__ void init(const void* A_, const void* B_, int M, int N, int K, int G, int c, const void* A2_, const void* B2_, int nwg2_) { so.init(M, N, G, c); A = (const char*)A_; B = (const char*)B_; A2 = (const char*)A2_; B2 = (const char*)B2_; nwg2 = nwg2_; step = (size_t)256 * K * 2; }
    __device__ __forceinline__ bool next(int i, Unit& u) const { const int L = i * so.G + so.c; if (L < so.nwg) { u.e = 0; return so.next(i, u); } if (L - so.nwg >= nwg2) return false; u.e = 1; u.pm = 0; u.pn = L - so.nwg; return true; }
    __device__ __forceinline__ const char* aptr(const Unit& u) const { return u.e ? A2 : A + (size_t)u.pm * step; }
    __device__ __forceinline__ const char* bptr(const Unit& u) const { return (u.e ? B2 : B) + (size_t)u.pn * step; }
    __device__ __forceinline__ void a_ready(const Unit&) const {}
    __device__ __forceinline__ void done(const Unit&) const {}
};
struct DualOrder8 {
    static constexpr bool GATHER = false, F8 = true; static constexpr int SCALE_B = 121;
    StaticOrder so; int nwg2; const char* A; const char* B; const char* A2; const char* B2; size_t step;
    __device__ void init(const void* A_, const void* B_, int M, int N, int K, int G, int c, const void* A2_, const void* B2_, int nwg2_) { so.init(M, N, G, c); A = (const char*)A_; B = (const char*)B_; A2 = (const char*)A2_; B2 = (const char*)B2_; nwg2 = nwg2_; step = (size_t)256 * K * 2; }
    __device__ __forceinline__ bool next(int i, Unit& u) const { const int L = i * so.G + so.c; if (L < so.nwg) { u.e = 0; return so.next(i, u); } if (L - so.nwg >= nwg2) return false; u.e = 1; u.pm = 0; u.pn = L - so.nwg; return true; }
    __device__ __forceinline__ const char* aptr(const Unit& u) const { return u.e ? A2 : A + (size_t)u.pm * step; }
    __device__ __forceinline__ const char* bptr(const Unit& u) const { return (u.e ? B2 : B) + (size_t)u.pn * step; }
    __device__ __forceinline__ void a_ready(const Unit&) const {}
    __device__ __forceinline__ void done(const Unit&) const {}
};
struct MoeOrder {
    static constexpr bool GATHER = false, F8 = false; static constexpr int SCALE_B = 127;
    const PG8_LAS int* tstart; int ntn, G, c; const char* A; const char* W; size_t astep, wexp, wtile;
    __device__ __forceinline__ bool next(int i, Unit& u) const {
        const int L = i * G + c, total = tstart[32] * ntn; if (L >= total) return false;
        int wgid; { const int q = total / NXCD, r = total % NXCD, xcd = L % NXCD, off = L / NXCD; wgid = (xcd < r ? xcd * (q + 1) : r * (q + 1) + (xcd - r) * q) + off; }
        u.pm = wgid / ntn; u.pn = wgid - u.pm * ntn; int e = 0;
#pragma unroll
        for (int k = 1; k <= 31; ++k) e += (tstart[k] <= u.pm) ? 1 : 0;
        u.e = e; return true;
    }
    __device__ __forceinline__ const char* aptr(const Unit& u) const { return A + (size_t)u.pm * astep; }
    __device__ __forceinline__ const char* bptr(const Unit& u) const { return W + (size_t)u.e * wexp + (size_t)u.pn * wtile; }
    __device__ __forceinline__ void a_ready(const Unit&) const {}
    __device__ __forceinline__ void done(const Unit&) const {}
};

struct MoeOrder8 {
    static constexpr bool GATHER = false, F8 = true; static constexpr int SCALE_B = 121;
    const PG8_LAS int* tstart; int ntn, G, c; const char* A; const char* W; size_t astep, wexp, wtile;
    __device__ __forceinline__ bool next(int i, Unit& u) const {
        const int L = i * G + c, total = tstart[32] * ntn; if (L >= total) return false;
        int wgid; { const int q = total / NXCD, r = total % NXCD, xcd = L % NXCD, off = L / NXCD; wgid = (xcd < r ? xcd * (q + 1) : r * (q + 1) + (xcd - r) * q) + off; }
        u.pm = wgid / ntn; u.pn = wgid - u.pm * ntn; int e = 0;
#pragma unroll
        for (int k = 1; k <= 31; ++k) e += (tstart[k] <= u.pm) ? 1 : 0;
        u.e = e; return true;
    }
    __device__ __forceinline__ const char* aptr(const Unit& u) const { return A + (size_t)u.pm * astep; }
    __device__ __forceinline__ const char* bptr(const Unit& u) const { return W + (size_t)u.e * wexp + (size_t)u.pn * wtile; }
    __device__ __forceinline__ void a_ready(const Unit&) const {}
    __device__ __forceinline__ void done(const Unit&) const {}
};

struct MoeGatherOrder {
    static constexpr bool GATHER = true, F8 = true; static constexpr int SCALE_B = 121;
    const PG8_LAS int* tstart; const PG8_LAS int* cntl; const int* list; int ntn, G, c; const char* A; const char* W; size_t wexp, wtile; unsigned rowbytes;
    __device__ __forceinline__ bool next(int i, Unit& u) const {
        const int L = i * G + c, total = tstart[32] * ntn; if (L >= total) return false;
        int wgid; { const int q = total / NXCD, r = total % NXCD, xcd = L % NXCD, off = L / NXCD; wgid = (xcd < r ? xcd * (q + 1) : r * (q + 1) + (xcd - r) * q) + off; }
        u.pm = wgid / ntn; u.pn = wgid - u.pm * ntn; int e = 0;
#pragma unroll
        for (int k = 1; k <= 31; ++k) e += (tstart[k] <= u.pm) ? 1 : 0;
        u.e = e; return true;
    }
    __device__ __forceinline__ unsigned rowoff(const Unit& u, int r) const { const int rank = (u.pm - tstart[u.e]) * 256 + r; const int tok = list[u.e * 8192 + (rank < cntl[u.e] ? rank : 0)]; return (unsigned)tok * rowbytes; }
    __device__ __forceinline__ const char* aptr(const Unit&) const { return A; }
    __device__ __forceinline__ const char* bptr(const Unit& u) const { return W + (size_t)u.e * wexp + (size_t)u.pn * wtile; }
    __device__ __forceinline__ void a_ready(const Unit&) const {}
    __device__ __forceinline__ void done(const Unit&) const {}
};

typedef unsigned u32x2 __attribute__((ext_vector_type(2)));
struct EpiBf16X {
    static constexpr bool PERM = true, AFTER_DRAIN = false;
    int mode; bf16_t* p0; bf16_t* p1; bf16_t* p2; bf16_t* p3;
    const PG8_LAS int* tstart; const PG8_LAS int* cntl;
    __device__ __forceinline__ void operator()(const f32x4 (&acc)[2][2][4][2], const Unit& u, int wr, int wc, int fr, int fq) const {
#ifndef ATT_BF16
        if (mode == 1 && !u.e) {
            int tok0 = u.pm * BM + wr * 64 + fr, cc0 = wc * 32 + 8 * fq; asm volatile("" : "+v"(tok0), "+v"(cc0));
            if (u.pn >= 14) { const int colv = (u.pn - 14) * BM + cc0; unsigned char* vb = (unsigned char*)p2 + ((size_t)((colv >> 8) * 128 + (tok0 >> 6)) * 256 + (colv & 255)) * 64 + (tok0 & 63);
#pragma unroll
                for (int ai = 0; ai < 2; ++ai)
#pragma unroll
                    for (int m = 0; m < 4; ++m)
#pragma unroll
                        for (int bj = 0; bj < 2; ++bj) { const f32x4 v0 = acc[ai][bj][m][0], v1 = acc[ai][bj][m][1]; unsigned a_ = 0u, b_ = 0u;
                            a_ = __builtin_amdgcn_cvt_pk_fp8_f32(v0[0], v0[1], a_, false); a_ = __builtin_amdgcn_cvt_pk_fp8_f32(v0[2], v0[3], a_, true); b_ = __builtin_amdgcn_cvt_pk_fp8_f32(v1[0], v1[1], b_, false); b_ = __builtin_amdgcn_cvt_pk_fp8_f32(v1[2], v1[3], b_, true);
                            unsigned char* vp = vb + (size_t)(ai * 2) * 16384 + m * 16 + (size_t)bj * HALF * 64;
                            vp[0] = (unsigned char)a_; vp[64] = (unsigned char)(a_ >> 8); vp[128] = (unsigned char)(a_ >> 16); vp[192] = (unsigned char)(a_ >> 24);
                            vp[256] = (unsigned char)b_; vp[320] = (unsigned char)(b_ >> 8); vp[384] = (unsigned char)(b_ >> 16); vp[448] = (unsigned char)(b_ >> 24); }
                return; }
            if (u.pn >= 8) { unsigned char* kb = (unsigned char*)p1 + (size_t)tok0 * 1536 + (u.pn - 8) * BM + cc0;
#pragma unroll
                for (int ai = 0; ai < 2; ++ai)
#pragma unroll
                    for (int m = 0; m < 4; ++m)
#pragma unroll
                        for (int bj = 0; bj < 2; ++bj) { const f32x4 v0 = acc[ai][bj][m][0], v1 = acc[ai][bj][m][1]; unsigned a_ = 0u, b_ = 0u;
                            a_ = __builtin_amdgcn_cvt_pk_fp8_f32(v0[0], v0[1], a_, false); a_ = __builtin_amdgcn_cvt_pk_fp8_f32(v0[2], v0[3], a_, true); b_ = __builtin_amdgcn_cvt_pk_fp8_f32(v1[0], v1[1], b_, false); b_ = __builtin_amdgcn_cvt_pk_fp8_f32(v1[2], v1[3], b_, true);
                            u32x2 kk; kk.x = a_; kk.y = b_; *(u32x2*)(kb + (size_t)(ai * HALF + m * 16) * 1536 + bj * HALF) = kk; }
                return; }
            { unsigned char* qb = (unsigned char*)p0 + (WS_ZQ - WS_Z) + (size_t)tok0 * 2048 + u.pn * BM + cc0; bf16_t* zb = p0 + (size_t)tok0 * 2048 + u.pn * BM + cc0;
#pragma unroll
                for (int ai = 0; ai < 2; ++ai)
#pragma unroll
                    for (int m = 0; m < 4; ++m)
#pragma unroll
                        for (int bj = 0; bj < 2; ++bj) { const f32x4 v0 = acc[ai][bj][m][0] * QSCALE, v1 = acc[ai][bj][m][1] * QSCALE; unsigned a_ = 0u, b_ = 0u;
                            a_ = __builtin_amdgcn_cvt_pk_fp8_f32(v0[0], v0[1], a_, false); a_ = __builtin_amdgcn_cvt_pk_fp8_f32(v0[2], v0[3], a_, true); b_ = __builtin_amdgcn_cvt_pk_fp8_f32(v1[0], v1[1], b_, false); b_ = __builtin_amdgcn_cvt_pk_fp8_f32(v1[2], v1[3], b_, true);
                            const size_t o_ = (size_t)(ai * HALF + m * 16) * 2048 + bj * HALF;
                            u32x2 qq; qq.x = a_; qq.y = b_; *(u32x2*)(qb + o_) = qq;
                            u32x4 w; w.x = cvt_pk_bf16(v0[0], v0[1]); w.y = cvt_pk_bf16(v0[2], v0[3]); w.z = cvt_pk_bf16(v1[0], v1[1]); w.w = cvt_pk_bf16(v1[2], v1[3]); *(u32x4*)(zb + o_) = w; }
                return; }
        }
#endif
        bf16_t* base; int ldc, colt; bool act = false; float sc = 1.f;
        if (u.e && mode < 2) { base = p3 + (size_t)(u.pn >> 2) * (256 * 1024); ldc = 1024; colt = (u.pn & 3) * BM; }
        else if (mode == 0) { base = p0; ldc = 3584; colt = u.pn * BM; act = u.pn < 12; if (u.pn >= 12) sc = QSCALE; }
        else if (mode == 1) { if (u.pn < 8) { base = p0; ldc = 2048; colt = u.pn * BM; sc = QSCALE; }
                              else if (u.pn < 14) { base = p1; ldc = 1536; colt = (u.pn - 8) * BM; } else { base = p2; ldc = 1536; colt = (u.pn - 14) * BM; } }
        else { base = p0; ldc = 2048; colt = u.pn * BM; }
        const int row0 = u.pm * BM + wr * 64 + fr, col0 = colt + wc * 32 + 8 * fq;
        const int rlim = (mode == 3) ? cntl[u.e] - (u.pm - tstart[u.e]) * BM : BM;
#pragma unroll
        for (int ai = 0; ai < 2; ++ai)
#pragma unroll
            for (int m = 0; m < 4; ++m) { bf16_t* rowp = base + (size_t)(row0 + ai * HALF + m * 16) * ldc + col0;
                if (wr * 64 + fr + ai * HALF + m * 16 >= rlim) continue;
#pragma unroll
                for (int bj = 0; bj < 2; ++bj) { f32x4 v0 = acc[ai][bj][m][0], v1 = acc[ai][bj][m][1];
                    if (act) { f32x2 a = gelu_pk((f32x2){v0[0], v0[1]}), b = gelu_pk((f32x2){v0[2], v0[3]}), c = gelu_pk((f32x2){v1[0], v1[1]}), d = gelu_pk((f32x2){v1[2], v1[3]});
                        v0 = (f32x4){a.x, a.y, b.x, b.y}; v1 = (f32x4){c.x, c.y, d.x, d.y}; }
                    v0 = v0 * sc; v1 = v1 * sc; u32x4 w; w.x = cvt_pk_bf16(v0[0], v0[1]); w.y = cvt_pk_bf16(v0[2], v0[3]); w.z = cvt_pk_bf16(v1[0], v1[1]); w.w = cvt_pk_bf16(v1[2], v1[3]);
                    *(u32x4*)(rowp + bj * HALF) = w; } }
    }
};
struct EpiResBf16 {
    static constexpr bool PERM = true, AFTER_DRAIN = false;
    const bf16_t* xres; bf16_t* y; float alpha;
    __device__ __forceinline__ void operator()(const f32x4 (&acc)[2][2][4][2], const Unit& u, int wr, int wc, int fr, int fq) const {
        const int row0 = u.pm * BM + wr * 64 + fr, col0 = u.pn * BM + wc * 32 + 8 * fq;
#pragma unroll
        for (int ai = 0; ai < 2; ++ai)
#pragma unroll
            for (int m = 0; m < 4; ++m) { const size_t off = (size_t)(row0 + ai * HALF + m * 16) * 2048 + col0;
#pragma unroll
                for (int bj = 0; bj < 2; ++bj) { const u32x4 xr = *(const u32x4*)(xres + off + bj * HALF); const f32x4 v0 = acc[ai][bj][m][0], v1 = acc[ai][bj][m][1]; u32x4 w;
                    w.x = cvt_pk_bf16(__builtin_bit_cast(float, xr.x << 16) * alpha + v0[0], __builtin_bit_cast(float, xr.x & 0xffff0000u) * alpha + v0[1]);
                    w.y = cvt_pk_bf16(__builtin_bit_cast(float, xr.y << 16) * alpha + v0[2], __builtin_bit_cast(float, xr.y & 0xffff0000u) * alpha + v0[3]);
                    w.z = cvt_pk_bf16(__builtin_bit_cast(float, xr.z << 16) * alpha + v1[0], __builtin_bit_cast(float, xr.z & 0xffff0000u) * alpha + v1[1]);
                    w.w = cvt_pk_bf16(__builtin_bit_cast(float, xr.w << 16) * alpha + v1[2], __builtin_bit_cast(float, xr.w & 0xffff0000u) * alpha + v1[3]);
                    *(u32x4*)(y + off + bj * HALF) = w; } }
    }
};
struct EpiMoe1 {
    static constexpr bool PERM = true, AFTER_DRAIN = false;
    bf16_t* h; const PG8_LAS int* tstart; const PG8_LAS int* cntl;
    __device__ __forceinline__ void operator()(const f32x4 (&acc)[2][2][4][2], const Unit& u, int wr, int wc, int fr, int fq) const {
        const int row0 = u.pm * BM + wr * 64 + fr, col0 = u.pn * HALF + wc * 32 + 8 * fq;
        const int rlim = cntl[u.e] - (u.pm - tstart[u.e]) * BM;
#pragma unroll
        for (int ai = 0; ai < 2; ++ai)
#pragma unroll
            for (int m = 0; m < 4; ++m) { unsigned char* rowp = (unsigned char*)h + (size_t)(row0 + ai * HALF + m * 16) * 512 + col0; float o[8];
                if (wr * 64 + fr + ai * HALF + m * 16 >= rlim) continue;
#pragma unroll
                for (int n = 0; n < 2; ++n)
#pragma unroll
                    for (int x = 0; x < 4; ++x) { const float a = acc[ai][0][m][n][x], b = acc[ai][1][m][n][x];
                        o[n * 4 + x] = a * __builtin_amdgcn_rcpf(1.0f + __builtin_amdgcn_exp2f(-a * LOG2E)) * b; }
                unsigned lo = 0u, hi = 0u; lo = __builtin_amdgcn_cvt_pk_fp8_f32(o[0], o[1], lo, false); lo = __builtin_amdgcn_cvt_pk_fp8_f32(o[2], o[3], lo, true);
                hi = __builtin_amdgcn_cvt_pk_fp8_f32(o[4], o[5], hi, false); hi = __builtin_amdgcn_cvt_pk_fp8_f32(o[6], o[7], hi, true);
                typedef unsigned u32x2e __attribute__((ext_vector_type(2))); u32x2e w; w.x = lo; w.y = hi; *(u32x2e*)rowp = w; }
    }
};
}

namespace att {
using bf16x8 = __attribute__((ext_vector_type(8))) short;
using s16x4  = __attribute__((ext_vector_type(4))) short;
using f32x16 = __attribute__((ext_vector_type(16))) float;
using u32x4  = __attribute__((ext_vector_type(4))) unsigned;
constexpr int DH = 128, QBLK = 32, KVBLK = 64;
constexpr float THR2 = 8.f * 1.4426950408889634f;
constexpr size_t SHM_V = KVBLK * DH * 2, SHM_K = KVBLK * DH * 2, SHM_ATTN = 2 * SHM_V + 2 * SHM_K + NWAVES * 64 * 4;
constexpr int TAB_N = 160;
#define KSWZ(row, colB) ((row) * 256 + ((colB) ^ (((row) & 7) << 4)))
#define SBAR() __builtin_amdgcn_sched_barrier(0)
__device__ __forceinline__ int crow(int r, int hi) { return (r & 3) + 8 * (r >> 2) + 4 * hi; }
__device__ __forceinline__ unsigned cvtpk(float lo, float hi) { unsigned r; asm volatile("v_cvt_pk_bf16_f32 %0, %1, %2" : "=v"(r) : "v"(lo), "v"(hi)); return r; }

__device__ __forceinline__ void partialSM(f32x16& p0, f32x16& p1, float& m_reg, float& mn, float& alpha) {
  float pmax = p0[0];
#pragma unroll
  for (int r = 1; r < 16; ++r) pmax = fmaxf(pmax, p0[r]);
#pragma unroll
  for (int r = 0; r < 16; ++r) pmax = fmaxf(pmax, p1[r]);
  { auto rr = __builtin_amdgcn_permlane32_swap(__float_as_uint(pmax), __float_as_uint(pmax), false, false);
    pmax = fmaxf(__uint_as_float(rr[0]), __uint_as_float(rr[1])); }
  if (__builtin_expect(__all(pmax - m_reg <= THR2), 1)) { mn = m_reg; alpha = 1.f; }
  else { mn = fmaxf(m_reg, pmax); alpha = __builtin_amdgcn_exp2f(m_reg - mn); m_reg = mn; }
#pragma unroll
  for (int r = 0; r < 16; ++r) p0[r] = p0[r] - mn;
#pragma unroll
  for (int r = 0; r < 16; ++r) p1[r] = p1[r] - mn;
#pragma unroll
  for (int r = 0; r < 16; ++r) p0[r] = __builtin_amdgcn_exp2f(p0[r]);
}
__device__ __forceinline__ void finishSM(f32x16& p0, f32x16& p1, float alpha, float& l_reg, bf16x8& pa0, bf16x8& pa1, bf16x8& pa2, bf16x8& pa3) {
#pragma unroll
  for (int r = 0; r < 16; ++r) p1[r] = __builtin_amdgcn_exp2f(p1[r]);
  float ps = 0;
#pragma unroll
  for (int r = 0; r < 16; ++r) ps += p0[r];
#pragma unroll
  for (int r = 0; r < 16; ++r) ps += p1[r];
  { auto rr = __builtin_amdgcn_permlane32_swap(__float_as_uint(ps), __float_as_uint(ps), false, false);
    ps = __uint_as_float(rr[0]) + __uint_as_float(rr[1]); }
  l_reg = l_reg * alpha + ps;
#define PK4(P, BASE, OUT) do { unsigned a0 = cvtpk(P[BASE + 0], P[BASE + 1]), a1 = cvtpk(P[BASE + 2], P[BASE + 3]);   \
    unsigned b0 = cvtpk(P[BASE + 4], P[BASE + 5]), b1 = cvtpk(P[BASE + 6], P[BASE + 7]);                              \
    auto r0 = __builtin_amdgcn_permlane32_swap(a0, b0, false, false); auto r1 = __builtin_amdgcn_permlane32_swap(a1, b1, false, false); \
    u32x4 w = {r0[0], r1[0], r0[1], r1[1]}; OUT = *reinterpret_cast<bf16x8*>(&w); } while (0)
  PK4(p0, 0, pa0); PK4(p0, 8, pa1); PK4(p1, 0, pa2); PK4(p1, 8, pa3);
#undef PK4
}
__device__ __forceinline__ void qkt(f32x16& p0, f32x16& p1, const char* Ks, const bf16x8* qr, int r32, int hi) {
  p0 = f32x16{}; p1 = f32x16{};
#pragma unroll
  for (int d0 = 0; d0 < 8; ++d0) { const int cb = (d0 * 16 + hi * 8) * 2;
    bf16x8 b0 = *reinterpret_cast<const bf16x8*>(Ks + KSWZ(r32, cb));
    bf16x8 b1 = *reinterpret_cast<const bf16x8*>(Ks + KSWZ(32 + r32, cb));
    p0 = __builtin_amdgcn_mfma_f32_32x32x16_bf16(b0, qr[d0], p0, 0, 0, 0);
    p1 = __builtin_amdgcn_mfma_f32_32x32x16_bf16(b1, qr[d0], p1, 0, 0, 0); }
}
__device__ __forceinline__ int v_st(int k, int c) { const int kk = (k & ~0xC) | ((k & 4) << 1) | ((k & 8) >> 1); return ((kk >> 3) * 4 + (c >> 5)) * 512 + ((kk & 7) * 32 + (c & 31)) * 2; }
__device__ __forceinline__ int v_rd_base(int lane) { return ((lane & 3) << 3) | (((lane >> 2) & 3) << 6) | (((lane >> 4) & 1) << 5) | (((lane >> 5) & 1) << 8); }
constexpr int v_rd_off(int d0, int ks, int half) { return d0 * 512 + ks * 4096 + half * 2048; }
template <int OFF> __device__ __forceinline__ s16x4 tr_read(int vb) {
  s16x4 r; asm volatile("ds_read_b64_tr_b16 %0, %1 offset:%2" : "=&v"(r) : "v"(vb), "i"(OFF) : "memory"); return r;
}
template <int D0> __device__ __forceinline__ void pv_one(f32x16& od, int vb, bf16x8 pa0, bf16x8 pa1, bf16x8 pa2, bf16x8 pa3) {
  const s16x4 l0 = tr_read<v_rd_off(D0, 0, 0)>(vb), h0 = tr_read<v_rd_off(D0, 0, 1)>(vb), l1 = tr_read<v_rd_off(D0, 1, 0)>(vb), h1 = tr_read<v_rd_off(D0, 1, 1)>(vb);
  const s16x4 l2 = tr_read<v_rd_off(D0, 2, 0)>(vb), h2 = tr_read<v_rd_off(D0, 2, 1)>(vb), l3 = tr_read<v_rd_off(D0, 3, 0)>(vb), h3 = tr_read<v_rd_off(D0, 3, 1)>(vb);
  asm volatile("s_waitcnt lgkmcnt(0)" ::: "memory"); SBAR();
#define PK(L, H) (bf16x8){L[0], L[1], L[2], L[3], H[0], H[1], H[2], H[3]}
  od = __builtin_amdgcn_mfma_f32_32x32x16_bf16(pa0, PK(l0, h0), od, 0, 0, 0);
  od = __builtin_amdgcn_mfma_f32_32x32x16_bf16(pa1, PK(l1, h1), od, 0, 0, 0);
  od = __builtin_amdgcn_mfma_f32_32x32x16_bf16(pa2, PK(l2, h2), od, 0, 0, 0);
  od = __builtin_amdgcn_mfma_f32_32x32x16_bf16(pa3, PK(l3, h3), od, 0, 0, 0);
#undef PK
}
__device__ __forceinline__ void pv_d0(f32x16* o, int vb, bf16x8 pa0, bf16x8 pa1, bf16x8 pa2, bf16x8 pa3) {
  pv_one<0>(o[0], vb, pa0, pa1, pa2, pa3); pv_one<1>(o[1], vb, pa0, pa1, pa2, pa3); pv_one<2>(o[2], vb, pa0, pa1, pa2, pa3); pv_one<3>(o[3], vb, pa0, pa1, pa2, pa3);
}
template <int MODE> __device__ __forceinline__ void post_scores(f32x16& p0, f32x16& p1, int t, int qrow0, int r32, int hi, const float* tab, float cfar) {
  if constexpr (MODE == 1) {
    const int cw = qrow0 >> 6;
    if (t > cw) {
#pragma unroll
      for (int r = 0; r < 16; ++r) { p0[r] = -INFINITY; p1[r] = -INFINITY; }
    } else if (qrow0 - (64 * t + 63) >= 91) {
#pragma unroll
      for (int r = 0; r < 16; ++r) { p0[r] += cfar; p1[r] += cfar; }
    } else {
      const int base = qrow0 + r32 - 64 * t + 63;
#pragma unroll
      for (int r = 0; r < 16; ++r) { const int i0 = base - crow(r, hi); const int i1 = i0 - 32;
        p0[r] += tab[i0 < TAB_N - 1 ? i0 : TAB_N - 1]; p1[r] += tab[i1 < TAB_N - 1 ? i1 : TAB_N - 1]; }
    }
  }
}

template <int MODE>
__device__ __forceinline__ void attn_body(const bf16* __restrict__ Qb, int ldq, const bf16* __restrict__ Kh, const bf16* __restrict__ Vh, int ldk,
                                          bf16* Ob, float* Of, int ldo, int NT, int q0abs, const float* tab, float cfar, char* lds) {
  int tid_ = threadIdx.x; asm volatile("" : "+v"(tid_));
  const int tid = tid_, wid = tid >> 6, lane = tid & 63, r32 = lane & 31, hi = lane >> 5;
  char* V_lds = lds; char* K_lds = lds + 2 * SHM_V;
  float* ws = (float*)(lds + 2 * SHM_V + 2 * SHM_K) + wid * 64; float* li_l = ws; float* al_l = ws + 32;
  float m_reg = -1e30f, l_reg = 0; f32x16 o[4] = {}; bf16x8 qr[8];
  const int qrow0 = q0abs + wid * QBLK;
  const bf16* Qw = Qb + (long)(wid * QBLK + r32) * ldq + hi * 8;
#pragma unroll
  for (int d0 = 0; d0 < 8; ++d0) qr[d0] = *reinterpret_cast<const bf16x8*>(Qw + d0 * 16);
  const int sr = tid >> 4, sc = (tid & 15) * 8, vst0 = v_st(sr, sc), vst1 = v_st(32 + sr, sc);
  const int vb0 = (int)(uintptr_t)V_lds + v_rd_base(lane);
  struct { bf16x8 vs0, vs1, ks0, ks1; } sr_[2];
#define SLOAD(i, k0) do { sr_[i].vs0 = *reinterpret_cast<const bf16x8*>(&Vh[(long)((k0) + sr) * ldk + sc]); sr_[i].vs1 = *reinterpret_cast<const bf16x8*>(&Vh[(long)((k0) + 32 + sr) * ldk + sc]); \
    sr_[i].ks0 = *reinterpret_cast<const bf16x8*>(&Kh[(long)((k0) + sr) * ldk + sc]); sr_[i].ks1 = *reinterpret_cast<const bf16x8*>(&Kh[(long)((k0) + 32 + sr) * ldk + sc]); } while (0)
#define SWRITE(b, i) do { *(bf16x8*)(V_lds + (b) * SHM_V + vst0) = sr_[i].vs0;          \
    *(bf16x8*)(V_lds + (b) * SHM_V + vst1) = sr_[i].vs1; const int kc = sc * 2;               \
    *(bf16x8*)(K_lds + (b) * SHM_K + KSWZ(sr, kc)) = sr_[i].ks0;                       \
    *(bf16x8*)(K_lds + (b) * SHM_K + KSWZ(32 + sr, kc)) = sr_[i].ks1; } while (0)
#define SWAIT() asm volatile("s_waitcnt vmcnt(4)" ::: "memory")
#define RESC(a) do { if (__any((a) < 1.f)) { if (hi == 0) al_l[r32] = (a); asm volatile("s_waitcnt lgkmcnt(0)" ::: "memory"); \
    _Pragma("unroll") for (int d = 0; d < 4; ++d) _Pragma("unroll") for (int r = 0; r < 16; ++r) o[d][r] *= al_l[crow(r, hi)]; } } while (0)
  f32x16 pA0, pA1, pB0, pB1; float mnA, mnB, alA, alB; bf16x8 pa0, pa1, pa2, pa3;
  constexpr int SE = 0, SO = 1;
  SLOAD(SE, 0); asm volatile("s_waitcnt vmcnt(0)" ::: "memory"); SWRITE(0, SE); __syncthreads();
  qkt(pA0, pA1, K_lds, qr, r32, hi); post_scores<MODE>(pA0, pA1, 0, qrow0, r32, hi, tab, cfar); partialSM(pA0, pA1, m_reg, mnA, alA);
  SLOAD(SO, KVBLK); if (2 < NT) SLOAD(SE, 2 * KVBLK);
  SWAIT(); SWRITE(1, SO); __syncthreads();
  for (int j = 1; j + 1 < NT; j += 2) {
    SBAR(); qkt(pB0, pB1, K_lds + SHM_K, qr, r32, hi); post_scores<MODE>(pB0, pB1, j, qrow0, r32, hi, tab, cfar);
    finishSM(pA0, pA1, alA, l_reg, pa0, pa1, pa2, pa3); SBAR();
    SLOAD(SO, (j + 2) * KVBLK); SBAR();
    pv_d0(o, vb0, pa0, pa1, pa2, pa3); partialSM(pB0, pB1, m_reg, mnB, alB);
    __syncthreads(); SWAIT(); SWRITE(0, SE);
    RESC(alB); __syncthreads();
    SBAR(); qkt(pA0, pA1, K_lds, qr, r32, hi); post_scores<MODE>(pA0, pA1, j + 1, qrow0, r32, hi, tab, cfar);
    finishSM(pB0, pB1, alB, l_reg, pa0, pa1, pa2, pa3); SBAR();
    if (j + 3 < NT) SLOAD(SE, (j + 3) * KVBLK); SBAR();
    pv_d0(o, vb0 + (int)SHM_V, pa0, pa1, pa2, pa3); partialSM(pA0, pA1, m_reg, mnA, alA);
    __syncthreads(); SWAIT(); SWRITE(1, SO);
    RESC(alA); __syncthreads();
  }
  SBAR(); qkt(pB0, pB1, K_lds + SHM_K, qr, r32, hi); post_scores<MODE>(pB0, pB1, NT - 1, qrow0, r32, hi, tab, cfar);
  finishSM(pA0, pA1, alA, l_reg, pa0, pa1, pa2, pa3); SBAR();
  pv_d0(o, vb0, pa0, pa1, pa2, pa3); partialSM(pB0, pB1, m_reg, mnB, alB);
  __syncthreads(); RESC(alB);
  finishSM(pB0, pB1, alB, l_reg, pa0, pa1, pa2, pa3); SBAR();
  pv_d0(o, vb0 + (int)SHM_V, pa0, pa1, pa2, pa3);
  if (hi == 0) li_l[r32] = l_reg; asm volatile("s_waitcnt lgkmcnt(0)" ::: "memory");
  float rli[16];
#pragma unroll
  for (int r = 0; r < 16; ++r) rli[r] = __builtin_amdgcn_rcpf(li_l[crow(r, hi)]);
  if constexpr (MODE == 0) {
    bf16* Ow = Ob + (long)(wid * QBLK) * ldo;
#pragma unroll
    for (int r = 0; r < 16; ++r) { const int orow = crow(r, hi);
#pragma unroll
      for (int d0 = 0; d0 < 4; ++d0) Ow[(long)orow * ldo + d0 * 32 + r32] = (bf16)f2bf(o[d0][r] * rli[r]); }
  } else {
    float* Ow = Of + (long)(wid * QBLK) * ldo;
#pragma unroll
    for (int r = 0; r < 16; ++r) { const int orow = crow(r, hi);
#pragma unroll
      for (int d0 = 0; d0 < 4; ++d0) Ow[(long)orow * ldo + d0 * 32 + r32] = o[d0][r] * rli[r]; }
  }
  __syncthreads();
#undef SLOAD
#undef SWRITE
#undef SWAIT
#undef RESC
}
}

#define XB_TMO      128
#define XB_XCNT(j)  (256  + 64 * (j))
#define XB_XSUB(j)  (1280 + 64 * (j))
#define XB_XGEN(j)  (2304 + 64 * (j))
#define XB_TOP      3328
#define XB_TOPGEN   3392
#define XCD_BAR_WORDS 3456
#define XB_SPIN_CAP (1u << 18)

__device__ __forceinline__ unsigned xb_ld(unsigned* p)              { return __hip_atomic_load(p, __ATOMIC_RELAXED, __HIP_MEMORY_SCOPE_AGENT); }
__device__ __forceinline__ unsigned xb_add(unsigned* p, unsigned v) { return __hip_atomic_fetch_add(p, v, __ATOMIC_RELAXED, __HIP_MEMORY_SCOPE_AGENT); }
__device__ __forceinline__ unsigned xb_xcc_id() { return (unsigned)__builtin_amdgcn_s_getreg((3 << 11) | 20) & 0xFu; }
#define XB_SPIN(cond, bar) do { unsigned _sp = 0; while (cond) { __builtin_amdgcn_s_sleep(1); \
    if ((++_sp & 255u) == 0u) { if (xb_ld(&(bar)[XB_TMO])) break; if (_sp > XB_SPIN_CAP) { atomicAdd(&(bar)[XB_TMO], 1u); break; } } } } while (0)

struct XcdBarrier {
    unsigned* bar; unsigned x;
    volatile LAS unsigned* st;
};

__device__ __forceinline__ XcdBarrier xcd_barrier_post(unsigned* bar, volatile LAS unsigned* st) {
    XcdBarrier b; b.bar = bar; b.x = xb_xcc_id(); b.st = st;
    if (threadIdx.x == 0) (void)xb_add(&bar[XB_XCNT(b.x)], 1u);
    return b;
}
__device__ __forceinline__ void xcd_barrier_complete(unsigned* bar, unsigned x, unsigned& nloc, unsigned& nx) {
    const unsigned G = gridDim.x * gridDim.y * gridDim.z;
    unsigned sum, cnt, mine, sp = 0u;
    for (;;) {
        sum = 0u; cnt = 0u; mine = 0u;
#pragma unroll
        for (unsigned j = 0; j < 16; ++j) { const unsigned c = xb_ld(&bar[XB_XCNT(j)]); sum += c; cnt += (c > 0u) ? 1u : 0u; mine = (j == x) ? c : mine; }
        if (sum == G) break;
        __builtin_amdgcn_s_sleep(1);
        if ((++sp & 255u) == 0u) { if (xb_ld(&bar[XB_TMO])) break; if (sp > XB_SPIN_CAP) { atomicAdd(&bar[XB_TMO], 1u); break; } }
    }
    nloc = mine > 0u ? mine : 1u; nx = cnt > 0u ? cnt : 1u;
}

__device__ __forceinline__ void xcd_barrier(const XcdBarrier& b) {
    asm volatile("s_waitcnt vmcnt(0)" ::: "memory");
    __syncthreads();
    if (threadIdx.x == 0) {
        unsigned* bar = b.bar;
        __builtin_amdgcn_s_waitcnt(0);
        unsigned nloc = b.st[0], nx = b.st[1];
        if (nloc == 0u) { xcd_barrier_complete(bar, b.x, nloc, nx); b.st[0] = nloc; b.st[1] = nx; }
        const unsigned old = xb_add(&bar[XB_XSUB(b.x)], 1u);
        const unsigned gen = old / nloc;
        if (old + 1u == (gen + 1u) * nloc) {
            __builtin_amdgcn_fence(__ATOMIC_RELEASE, "agent");
            asm volatile("s_waitcnt vmcnt(0)" ::: "memory");
            const unsigned og = xb_add(&bar[XB_TOP], 1u);
            const unsigned tg = og / nx;
            if (og + 1u == (tg + 1u) * nx) xb_add(&bar[XB_TOPGEN], 1u);
            else XB_SPIN(xb_ld(&bar[XB_TOPGEN]) == tg, bar);
            __builtin_amdgcn_fence(__ATOMIC_ACQUIRE, "agent");
            xb_add(&bar[XB_XGEN(b.x)], 1u);
            asm volatile("s_waitcnt vmcnt(0)" ::: "memory");
        } else {
            XB_SPIN(xb_ld(&bar[XB_XGEN(b.x)]) == gen, bar);
            __builtin_amdgcn_fence(__ATOMIC_ACQUIRE, "agent");
            asm volatile("s_waitcnt vmcnt(0)" ::: "memory");
        }
    }
    __syncthreads();
}


struct Args { const float* in[24]; float* out; unsigned char* ws; int ph_lo, ph_hi; };
enum { I_X = 0, I_MEM, I_AWIN, I_ALNG, I_ALNB, I_AWS, I_ABS, I_AWOUT, I_BWIN, I_BLAM, I_BSUBG, I_BWOUT, I_WKV, I_RELB, I_MEMWKV, I_LNG, I_LNB,
       I_WG1, I_BG1, I_WG2, I_BG2, I_W1, I_W3, I_W2 };
constexpr int NPH_LAYER = 9, NPHASES = 1 + DEPTH * NPH_LAYER;

struct Frame {
    LAS unsigned char* lds; char* ldsg;
    gu32* ctl; unsigned char* ws;
    int tid, lane, wave, G, c;
};

__device__ __forceinline__ void transpose_item(const float* W, int K, int N, bf16* WT, int drow0, LAS float* scr, int k0, int n0, int lane) {
#pragma unroll 8
    for (int i = 0; i < 32; ++i) { const int kk = 2 * i + (lane >> 5); scr[kk * 33 + (lane & 31)] = W[(size_t)(k0 + kk) * N + n0 + (lane & 31)]; }
    LDS_WAIT(); asm volatile("" ::: "memory");
    const int c = lane & 7;
#pragma unroll
    for (int j = 0; j < 4; ++j) { const int n = (lane >> 3) + 8 * j; const LAS float* s = scr + (8 * c) * 33 + n;
        v4u o; o.x = pk2(s[0 * 33], s[1 * 33]); o.y = pk2(s[2 * 33], s[3 * 33]); o.z = pk2(s[4 * 33], s[5 * 33]); o.w = pk2(s[6 * 33], s[7 * 33]);
        *(GAS v4u*)(WT + (size_t)(drow0 + n) * K + k0 + 8 * c) = o; }
    LDS_WAIT(); asm volatile("" ::: "memory");
}
__device__ __forceinline__ void transpose_item_fast(const float* W, int K, int N, bf16* WT, int drow0, LAS float* scr, int k0, int n0, int lane) {
    float t[32];
#pragma unroll
    for (int i = 0; i < 32; ++i) t[i] = W[(size_t)(k0 + 2 * i + (lane >> 5)) * N + n0 + (lane & 31)];
#pragma unroll
    for (int i = 0; i < 32; i += 8) asm volatile("" : "+v"(t[i]), "+v"(t[i + 1]), "+v"(t[i + 2]), "+v"(t[i + 3]), "+v"(t[i + 4]), "+v"(t[i + 5]), "+v"(t[i + 6]), "+v"(t[i + 7]));
#pragma unroll
    for (int i = 0; i < 32; ++i) scr[(2 * i + (lane >> 5)) * 33 + (lane & 31)] = t[i];
    LDS_WAIT(); asm volatile("" ::: "memory");
    const int c = lane & 7;
#pragma unroll
    for (int j = 0; j < 4; ++j) { const int n = (lane >> 3) + 8 * j; const LAS float* s = scr + (8 * c) * 33 + n;
        v4u o; o.x = pk2(s[0 * 33], s[1 * 33]); o.y = pk2(s[2 * 33], s[3 * 33]); o.z = pk2(s[4 * 33], s[5 * 33]); o.w = pk2(s[6 * 33], s[7 * 33]);
        *(GAS v4u*)(WT + (size_t)(drow0 + n) * K + k0 + 8 * c) = o; }
    LDS_WAIT(); asm volatile("" ::: "memory");
}
__device__ __forceinline__ void transpose_item_fp8(const float* W, int K, int N, unsigned char* WT, int drow0, LAS float* scr, int k0, int n0, int lane) {
    float t[32];
#pragma unroll
    for (int i = 0; i < 32; ++i) t[i] = W[(size_t)(k0 + 2 * i + (lane >> 5)) * N + n0 + (lane & 31)];
#pragma unroll
    for (int i = 0; i < 32; i += 8) asm volatile("" : "+v"(t[i]), "+v"(t[i + 1]), "+v"(t[i + 2]), "+v"(t[i + 3]), "+v"(t[i + 4]), "+v"(t[i + 5]), "+v"(t[i + 6]), "+v"(t[i + 7]));
#pragma unroll
    for (int i = 0; i < 32; ++i) scr[(2 * i + (lane >> 5)) * 33 + (lane & 31)] = t[i];
    LDS_WAIT(); asm volatile("" ::: "memory");
    const int c = lane & 7;
#pragma unroll
    for (int j = 0; j < 4; ++j) { const int n = (lane >> 3) + 8 * j; const LAS float* s = scr + (8 * c) * 33 + n;
        unsigned lo = 0u, hi = 0u;
        lo = __builtin_amdgcn_cvt_pk_fp8_f32(s[0 * 33] * 64.f, s[1 * 33] * 64.f, lo, false); lo = __builtin_amdgcn_cvt_pk_fp8_f32(s[2 * 33] * 64.f, s[3 * 33] * 64.f, lo, true);
        hi = __builtin_amdgcn_cvt_pk_fp8_f32(s[4 * 33] * 64.f, s[5 * 33] * 64.f, hi, false); hi = __builtin_amdgcn_cvt_pk_fp8_f32(s[6 * 33] * 64.f, s[7 * 33] * 64.f, hi, true);
        v2u o; o.x = lo; o.y = hi; *(GAS v2u*)(WT + (size_t)(drow0 + n) * K + k0 + 8 * c) = o; }
    LDS_WAIT(); asm volatile("" ::: "memory");
}
#ifndef CDRAIN
#define CDRAIN 8
#endif
#ifndef CSRV
#define CSRV 4
#endif
#ifndef CSRVA
#define CSRVA 32
#endif
#ifndef STOPU
#define STOPU 64
#endif
#ifndef QX
#define QX 6
#endif
#ifndef QA
#define QA 14
#endif
#ifndef QM
#define QM 7
#endif
#ifndef QB
#define QB 4
#endif
constexpr int NQ = 7, MOE_ITEMS = 3 * 32 * 512;
__device__ __forceinline__ int conv_qsize(int q) { return (q & 1) ? (q == 1 ? 5632 : (q == 3 ? 7168 : 4096)) : MOE_ITEMS; }
__device__ __forceinline__ void conv_item(Frame& F, const Args& a, int q, int it) {
    LAS float* scr = (LAS float*)(F.lds + RING_OFF + F.wave * 16384);
    if (q & 1) {
        const float* src; bf16* dst; int N, r = it;
        if (q == 1) { if (r < 3584) { N = 3584; src = a.in[I_AWIN] + (size_t)2048 * 3584; dst = (bf16*)(F.ws + WS_WAIN) + (size_t)2048 * 3584; } else { r -= 3584; N = 2048; src = a.in[I_AWOUT] + (size_t)2048 * 2048; dst = (bf16*)(F.ws + WS_WAOUT) + (size_t)2048 * 2048; } }
        else if (q == 3) { if (r < 2048) { N = 2048; src = a.in[I_BWIN]; dst = (bf16*)(F.ws + WS_WBIN0); } else if ((r -= 2048) < 3072) { N = 3072; src = a.in[I_WKV]; dst = (bf16*)(F.ws + WS_WKV); } else { r -= 3072; N = 2048; src = a.in[I_BWOUT]; dst = (bf16*)(F.ws + WS_WBOUT); } }
        else { if (r < 2048) { N = 2048; src = a.in[I_BWIN] + (size_t)2048 * 2048; dst = (bf16*)(F.ws + WS_WBIN1); } else { r -= 2048; N = 2048; src = a.in[I_BWOUT] + (size_t)2048 * 2048; dst = (bf16*)(F.ws + WS_WBOUT) + (size_t)2048 * 2048; } }
        const int nblk = N / 32, kb = r / nblk, nb = r - kb * nblk;
        transpose_item_fast(src, 2048, N, dst, 32 * nb, scr, 64 * kb, 32 * nb, F.lane);
        return;
    }
    const int L = q >> 1, seg = it >> 14, r0 = it & 16383, e = r0 >> 9, r = r0 & 511, mat = L * 32 + e;
    if (seg < 2) { const int kb = r >> 4, nb = r & 15, n0 = 32 * nb;
        transpose_item_fp8(a.in[seg == 0 ? I_W1 : I_W3] + (size_t)mat * 2048 * 512, 2048, 512, (unsigned char*)(F.ws + WS_W13) + (size_t)mat * 1024 * 2048, (n0 >> 7) * 256 + (n0 & 127) + (seg == 1 ? 128 : 0), scr, 64 * kb, n0, F.lane); }
    else { const int kb = r >> 6, nb = r & 63;
        transpose_item_fp8(a.in[I_W2] + (size_t)mat * 512 * 2048, 512, 2048, (unsigned char*)(F.ws + WS_W2) + (size_t)mat * 512 * 2048, 32 * nb, scr, 64 * kb, 32 * nb, F.lane); }
}
#ifndef F8MASK
#define F8MASK 4
#endif
#define F8L(l) (((F8MASK) >> (l)) & 1)
#ifndef F8OMASK
#define F8OMASK 12
#endif
#define F8OL(l) (((F8OMASK) >> (l)) & 1)
#ifndef CDEPTH
#define CDEPTH 3
#endif
struct CDesc { const float* src; unsigned char* dst; int N, K, drow0, k0, n0, f8; };
__device__ __forceinline__ CDesc conv_desc(Frame& F, const Args& a, int q, int it) {
    CDesc d;
    if (q & 1) {
        const float* src; unsigned char* dst; int N, r = it, f8 = F8L((q + 1) >> 1);
        if (q == 1) { if (r < 3584) { N = 3584; src = a.in[I_AWIN] + (size_t)2048 * 3584; dst = F.ws + WS_WAIN + (size_t)2048 * 3584 * 2; } else { r -= 3584; N = 2048; f8 = 0; src = a.in[I_AWOUT] + (size_t)2048 * 2048; dst = F.ws + WS_WAOUT + (size_t)2048 * 2048 * 2; } }
        else if (q == 3) { if (r < 2048) { N = 2048; src = a.in[I_BWIN]; dst = F.ws + WS_WBIN0; } else if ((r -= 2048) < 3072) { N = 3072; src = a.in[I_WKV]; dst = F.ws + WS_WBIN0 + (size_t)2048 * 2048 * (F8L(2) ? 1 : 2); } else { r -= 3072; N = 2048; f8 = F8OL(2); src = a.in[I_BWOUT]; dst = F.ws + WS_WBOUT; } }
        else { if (r < 2048) { N = 2048; src = a.in[I_BWIN] + (size_t)2048 * 2048; dst = F.ws + WS_WBIN1; } else { r -= 2048; N = 2048; f8 = F8OL(3); src = a.in[I_BWOUT] + (size_t)2048 * 2048; dst = F.ws + WS_WBOUT + (size_t)2048 * 2048 * 2; } }
        const int nblk = N / 32, kb = r / nblk, nb = r - kb * nblk;
        d.src = src; d.dst = dst; d.N = N; d.K = 2048; d.drow0 = 32 * nb; d.k0 = 64 * kb; d.n0 = 32 * nb; d.f8 = f8; return d;
    }
    const int L = q >> 1, seg = it >> 14, r0 = it & 16383, e = r0 >> 9, r = r0 & 511, mat = L * 32 + e;
    if (seg < 2) { const int kb = r >> 4, nb = r & 15, n0 = 32 * nb;
        d.src = a.in[seg == 0 ? I_W1 : I_W3] + (size_t)mat * 2048 * 512; d.dst = (unsigned char*)(F.ws + WS_W13) + (size_t)mat * 1024 * 2048; d.N = 512; d.K = 2048;
        d.drow0 = (n0 >> 7) * 256 + (n0 & 127) + (seg == 1 ? 128 : 0); d.k0 = 64 * kb; d.n0 = n0; d.f8 = 1; }
    else { const int kb = r >> 6, nb = r & 63;
        d.src = a.in[I_W2] + (size_t)mat * 512 * 2048; d.dst = (unsigned char*)(F.ws + WS_W2) + (size_t)mat * 512 * 2048; d.N = 2048; d.K = 512; d.drow0 = 32 * nb; d.k0 = 64 * kb; d.n0 = 32 * nb; d.f8 = 1; }
    return d;
}
#define CV_LOAD(t_, d_) do { const float* p_ = (d_).src + (size_t)((d_).k0 + (F.lane >> 3)) * (d_).N + (d_).n0 + 4 * (F.lane & 7); const size_t st_ = (size_t)8 * (d_).N; \
    _Pragma("unroll") for (int i_ = 0; i_ < 8; ++i_) (t_)[i_] = *(const GAS f32x4*)(p_ + st_ * i_); } while (0)
__device__ __forceinline__ void conv_process(Frame& F, f32x4 (&t)[8], const CDesc& d) {
    LAS float* scr = (LAS float*)(F.lds + RING_OFF + F.wave * 16384); const int lane = F.lane;
    asm volatile("" : "+v"(t[0]), "+v"(t[1]), "+v"(t[2]), "+v"(t[3]), "+v"(t[4]), "+v"(t[5]), "+v"(t[6]), "+v"(t[7]));
    { LAS float* w = scr + (lane >> 3) * 33 + 4 * (lane & 7);
#pragma unroll
      for (int i = 0; i < 8; ++i) { w[i * 8 * 33 + 0] = t[i].x; w[i * 8 * 33 + 1] = t[i].y; w[i * 8 * 33 + 2] = t[i].z; w[i * 8 * 33 + 3] = t[i].w; } }
    LDS_WAIT(); asm volatile("" ::: "memory");
    const int c = lane & 7;
    if (d.f8) {
#pragma unroll
        for (int j = 0; j < 4; ++j) { const int n = (lane >> 3) + 8 * j; const LAS float* s = scr + (8 * c) * 33 + n;
            unsigned lo = 0u, hi = 0u;
            lo = __builtin_amdgcn_cvt_pk_fp8_f32(s[0 * 33] * 64.f, s[1 * 33] * 64.f, lo, false); lo = __builtin_amdgcn_cvt_pk_fp8_f32(s[2 * 33] * 64.f, s[3 * 33] * 64.f, lo, true);
            hi = __builtin_amdgcn_cvt_pk_fp8_f32(s[4 * 33] * 64.f, s[5 * 33] * 64.f, hi, false); hi = __builtin_amdgcn_cvt_pk_fp8_f32(s[6 * 33] * 64.f, s[7 * 33] * 64.f, hi, true);
            v2u o; o.x = lo; o.y = hi; *(GAS v2u*)(d.dst + (size_t)(d.drow0 + n) * d.K + d.k0 + 8 * c) = o; }
    } else {
#pragma unroll
        for (int j = 0; j < 4; ++j) { const int n = (lane >> 3) + 8 * j; const LAS float* s = scr + (8 * c) * 33 + n;
            v4u o; o.x = pk2(s[0 * 33], s[1 * 33]); o.y = pk2(s[2 * 33], s[3 * 33]); o.z = pk2(s[4 * 33], s[5 * 33]); o.w = pk2(s[6 * 33], s[7 * 33]);
            *(GAS v4u*)((bf16*)d.dst + (size_t)(d.drow0 + n) * d.K + d.k0 + 8 * c) = o; }
    }
    LDS_WAIT(); asm volatile("" ::: "memory");
}
__device__ __forceinline__ void conv_range(Frame& F, const Args& a, int q, int first, int cnt) {
#if CDEPTH == 1
    for (int i = 0; i < cnt; ++i) conv_item(F, a, q, first + i);
#else
    f32x4 t[CDEPTH][8]; const int last = first + cnt - 1;
#pragma unroll
    for (int s = 0; s < CDEPTH - 1; ++s) { const int it = first + s < last ? first + s : last; const CDesc d = conv_desc(F, a, q, it); CV_LOAD(t[s], d); }
#pragma unroll 1
    for (int i0 = 0; i0 < cnt; i0 += CDEPTH) {
#pragma unroll
        for (int s = 0; s < CDEPTH; ++s) {
            { const int nx = first + i0 + s + CDEPTH - 1, it = nx < last ? nx : last; const CDesc d = conv_desc(F, a, q, it); CV_LOAD(t[(s + CDEPTH - 1) % CDEPTH], d); }
            asm volatile("" ::: "memory");
            if (i0 + s < cnt) { const CDesc d = conv_desc(F, a, q, first + i0 + s); conv_process(F, t[s], d); }
        }
    }
#endif
}
__device__ __forceinline__ void conv_filler(Frame& F, const Args& a, int q0, int n) {
    if (q0 >= NQ || n == 0) return;
#ifdef CONV_ALL_PRO
    return;
#endif
    LAS unsigned* bw = (LAS unsigned*)(F.lds + TAB_OFF + 384);
    __syncthreads();
    const bool drain = n < 0; const int per = drain ? CDRAIN : n; int q = q0;
    for (;;) {
        if (F.tid == 0) bw[0] = __hip_atomic_fetch_add(F.ctl + CW_CONV + 64 * q, (unsigned)(8 * per), RLX_AGENT);
        __syncthreads();
        const unsigned idx = bw[0];
        __syncthreads();
        const int qs = conv_qsize(q);
        if (idx >= (unsigned)qs) { if (drain || ++q >= NQ) break; continue; }
        { const int first = (int)idx + F.wave * per, cnt = (qs - first < per) ? qs - first : per; if (cnt > 0) conv_range(F, a, q, first, cnt); }
        if (!drain) break;
    }
}

__device__ __forceinline__ void prologue_phase(Frame& F, const Args& a) {
#ifdef TOUCH
    {
        const long nthr_ = (long)F.G * 512, gt_ = (long)F.c * 512 + F.tid; unsigned acc_ = 0u;
        for (long pg = gt_; pg < (long)(WS_END / 4096); pg += nthr_) acc_ += *(const GAS unsigned*)(F.ws + pg * 4096);
        for (long pg = gt_; pg < (long)((size_t)DEPTH * NE * D * FF * 4 / 4096); pg += nthr_) { acc_ += *(const GAS unsigned*)((const char*)a.in[I_W1] + pg * 4096); acc_ += *(const GAS unsigned*)((const char*)a.in[I_W3] + pg * 4096); acc_ += *(const GAS unsigned*)((const char*)a.in[I_W2] + pg * 4096); }
        if (acc_ == 0x12345679u) F.ctl[CW_TMO] = acc_;
    }
#endif
    LAS float* scr = (LAS float*)(F.lds + RING_OFF + F.wave * 16384);
    const int gw = F.c * NWAVES + F.wave, NGW = F.G * NWAVES;
    unsigned char* ws = F.ws;
    constexpr int S0 = 3584, S1 = 2048, S5 = 4 * 1024;
    constexpr int NITEMS = S0 + S1 + S5;
    for (int it = gw; it < NITEMS; it += NGW) {
        int r = it; const float* src; unsigned char* dst; int K = 2048, N; bool f8 = F8L(0);
        if (r < S0) { N = 3584; src = a.in[I_AWIN]; dst = ws + WS_WAIN; }
        else if ((r -= S0) < S1) { N = 2048; f8 = false; src = a.in[I_AWOUT]; dst = ws + WS_WAOUT; }
        else { r -= S1; const int mat = r >> 10; r &= 1023; N = 1024; src = a.in[I_MEMWKV] + (size_t)mat * K * N; dst = ws + WS_WMKV + (size_t)mat * K * N * (F8L(0) ? 1 : 2); }
        const int nblk = N / 32, kb = r / nblk, nb = r - kb * nblk;
        if (f8) transpose_item_fp8(src, K, N, dst, 32 * nb, scr, 64 * kb, 32 * nb, F.lane);
        else transpose_item_fast(src, K, N, (bf16*)dst, 32 * nb, scr, 64 * kb, 32 * nb, F.lane);
    }
#ifdef CONV_ALL_PRO
    for (int q = 0; q < NQ; ++q) { const int qs = conv_qsize(q); for (int it = gw * 4; it < qs; it += NGW * 4) conv_range(F, a, q, it, qs - it < 4 ? qs - it : 4); }
#endif
    const long nthr = (long)F.G * 512, gt = (long)F.c * 512 + F.tid;
    { float* wr = (float*)(ws + WS_WR);
      for (long i = gt; i < (long)DEPTH * 3 * 512 * 16 * 4; i += nthr) { const int j = (int)(i & 3), c = (int)((i >> 2) & 15), kg = (int)((i >> 6) & 511), r = (int)(i >> 15), nb = r % 3, l = r / 3;
          const int k = 4 * kg + j, o = 16 * nb + c; float v = 0.f;
          if (o < 4) v = a.in[I_WG1][((size_t)l * D + k) * 4 + o]; else if (o < 36) { const int g = (o - 4) >> 3, e = (o - 4) & 7; v = a.in[I_WG2][(((size_t)l * 4 + g) * D + k) * 8 + e]; }
          wr[i] = v; } }
    { const float* x = a.in[I_X]; bf16* xb = (bf16*)(ws + WS_XB);
      for (long i = gt; i < (long)T * D / 8; i += nthr) { const f32x4 v0 = *(const GAS f32x4*)(x + i * 8), v1 = *(const GAS f32x4*)(x + i * 8 + 4);
          v4u o; o.x = pk2(v0.x, v0.y); o.y = pk2(v0.z, v0.w); o.z = pk2(v1.x, v1.y); o.w = pk2(v1.z, v1.w); *(GAS v4u*)(xb + i * 8) = o;
          unsigned lo = 0u, hi = 0u; lo = __builtin_amdgcn_cvt_pk_fp8_f32(v0.x, v0.y, lo, false); lo = __builtin_amdgcn_cvt_pk_fp8_f32(v0.z, v0.w, lo, true); hi = __builtin_amdgcn_cvt_pk_fp8_f32(v1.x, v1.y, hi, false); hi = __builtin_amdgcn_cvt_pk_fp8_f32(v1.z, v1.w, hi, true);
          v2u qq; qq.x = lo; qq.y = hi; *(GAS v2u*)(ws + WS_XQ + i * 8) = qq; } }
    { const float* x = a.in[I_MEM]; bf16* xb = (bf16*)(ws + WS_MEMB);
      for (long i = gt; i < (long)MEMT * D / 8; i += nthr) { const f32x4 v0 = *(const GAS f32x4*)(x + i * 8), v1 = *(const GAS f32x4*)(x + i * 8 + 4);
          v4u o; o.x = pk2(v0.x, v0.y); o.y = pk2(v0.z, v0.w); o.z = pk2(v1.x, v1.y); o.w = pk2(v1.z, v1.w); *(GAS v4u*)(xb + i * 8) = o;
          unsigned lo = 0u, hi = 0u; lo = __builtin_amdgcn_cvt_pk_fp8_f32(v0.x, v0.y, lo, false); lo = __builtin_amdgcn_cvt_pk_fp8_f32(v0.z, v0.w, lo, true); hi = __builtin_amdgcn_cvt_pk_fp8_f32(v1.x, v1.y, hi, false); hi = __builtin_amdgcn_cvt_pk_fp8_f32(v1.z, v1.w, hi, true);
          v2u qq; qq.x = lo; qq.y = hi; *(GAS v2u*)(ws + WS_MEMQ + i * 8) = qq; } }
}

#ifndef NCVMAX
#define NCVMAX 0
#endif
#ifndef NCVATT
#define NCVATT 96
#endif
__device__ __forceinline__ int conv_servers(int nu, int G, int fin) {
    if (fin || nu <= 0) return 0;
    const int rounds = (nu + G - 1) / G, gmin = (nu + rounds - 1) / rounds; int n = G - gmin; n = n < NCVMAX ? n : NCVMAX; return n & ~7;
}
__device__ __forceinline__ void conv_done(Frame& F, int p) { __syncthreads(); if (F.tid == 0) __hip_atomic_fetch_add(F.ctl + CW_DONE + 64 * p, 1u, RLX_AGENT); }
__device__ __forceinline__ void conv_server(Frame& F, const Args& a, int p, int q0, int ncomp) {
    int q = q0;
    for (;;) {
        if (q >= NQ) break;
        unsigned idx = 0xffffffffu;
        if (F.lane == 0) { if (__hip_atomic_load(F.ctl + CW_DONE + 64 * p, RLX_AGENT) < (unsigned)ncomp) idx = __hip_atomic_fetch_add(F.ctl + CW_CONV + 64 * q, (unsigned)CSRV, RLX_AGENT); }
        idx = (unsigned)__builtin_amdgcn_readfirstlane((int)idx);
        if (idx == 0xffffffffu) break;
        const int qs = conv_qsize(q);
        if (idx >= (unsigned)qs) { ++q; continue; }
        conv_range(F, a, q, (int)idx, (qs - (int)idx < CSRV) ? qs - (int)idx : CSRV);
    }
}
__device__ __forceinline__ void conv_server_q(Frame& F, const Args& a, gu32* head, unsigned stop_at, int q0) {
    int q = q0;
    for (;;) {
        if (q >= NQ) break;
        unsigned idx = 0xffffffffu;
        if (F.lane == 0) { if (__hip_atomic_load(head, RLX_AGENT) < stop_at) idx = __hip_atomic_fetch_add(F.ctl + CW_CONV + 64 * q, (unsigned)CSRVA, RLX_AGENT); }
        idx = (unsigned)__builtin_amdgcn_readfirstlane((int)idx);
        if (idx == 0xffffffffu) break;
        const int qs = conv_qsize(q);
        if (idx >= (unsigned)qs) { ++q; continue; }
        conv_range(F, a, q, (int)idx, (qs - (int)idx < CSRVA) ? qs - (int)idx : CSRVA);
    }
}
__device__ __forceinline__ void conv_note_fin(Frame& F, int p) {
    if (blockIdx.x == 0 && F.tid == 0) { unsigned all = 1u;
        for (int q = 0; q < NQ; ++q) all &= (__hip_atomic_load(F.ctl + CW_CONV + 64 * q, RLX_AGENT) >= (unsigned)conv_qsize(q)) ? 1u : 0u;
        __hip_atomic_store(F.ctl + CW_FIN + 64 * p, all, RLX_AGENT); }
}

__device__ __forceinline__ void sgu_unit(Frame& F, const Args& a, int l, int n, int g) {
    constexpr int LDW = 136;
    LAS float* stats = (LAS float*)(F.lds); LAS bf16* Wl = (LAS bf16*)(F.lds + 1024); LAS bf16* Vt = (LAS bf16*)(F.lds + 35840);
    const bf16* z = (const bf16*)(F.ws + WS_Z); bf16* cat = (bf16*)(F.ws + WS_CAT);
    const int tok0 = n * 128;
    for (int i = 0; i < 16; ++i) { const int tk = F.wave * 16 + i; const GAS v4u* rp = (const GAS v4u*)(z + (size_t)(tok0 + tk) * NINA + MIXW) + F.lane;
        v4u w[3]; float s = 0.f;
#pragma unroll
        for (int j = 0; j < 3; ++j) { w[j] = rp[64 * j]; s += (bflo(w[j].x) + bfhi(w[j].x)) + (bflo(w[j].y) + bfhi(w[j].y)) + (bflo(w[j].z) + bfhi(w[j].z)) + (bflo(w[j].w) + bfhi(w[j].w)); }
        const float mean = wave_sum(s) * (1.f / MIXW); float q = 0.f;
#pragma unroll
        for (int j = 0; j < 3; ++j) { float d;
            d = bflo(w[j].x) - mean; q += d * d; d = bfhi(w[j].x) - mean; q += d * d; d = bflo(w[j].y) - mean; q += d * d; d = bfhi(w[j].y) - mean; q += d * d;
            d = bflo(w[j].z) - mean; q += d * d; d = bfhi(w[j].z) - mean; q += d * d; d = bflo(w[j].w) - mean; q += d * d; d = bfhi(w[j].w) - mean; q += d * d; }
        const float rstd = 1.f / sqrtf(wave_sum(q) * (1.f / MIXW) + LN_EPS);
        if (F.lane == 0) { stats[2 * tk] = mean; stats[2 * tk + 1] = rstd; } }
    { const float* wsrc = a.in[I_AWS] + ((size_t)l * 4 + g) * 128 * 128;
      for (int p = F.tid; p < 128 * 32; p += 512) { const int i = p >> 5, j4 = (p & 31) * 4; f32x4 v = *(const GAS f32x4*)(wsrc + i * 128 + j4);
          if ((j4 >> 6) > (i >> 6)) v = (f32x4){0.f, 0.f, 0.f, 0.f};
          v2u o; o.x = pk2(v.x, v.y); o.y = pk2(v.z, v.w); *(LAS v2u*)(Wl + i * LDW + j4) = o; } }
    __syncthreads();
    { const float* lg = a.in[I_ALNG] + (size_t)l * MIXW + g * 384; const float* lb = a.in[I_ALNB] + (size_t)l * MIXW + g * 384;
      for (int p = F.tid; p < 128 * 48; p += 512) { const int j = p & 127, c8 = (p >> 7) * 8;
          const v4u w = *(const GAS v4u*)(z + (size_t)(tok0 + j) * NINA + MIXW + g * 384 + c8);
          const float mean = stats[2 * j], rstd = stats[2 * j + 1];
          const f32x4 g0 = *(const GAS f32x4*)(lg + c8), g1 = *(const GAS f32x4*)(lg + c8 + 4), b0 = *(const GAS f32x4*)(lb + c8), b1 = *(const GAS f32x4*)(lb + c8 + 4);
          float v[8] = {bflo(w.x), bfhi(w.x), bflo(w.y), bfhi(w.y), bflo(w.z), bfhi(w.z), bflo(w.w), bfhi(w.w)};
          const float gg[8] = {g0.x, g0.y, g0.z, g0.w, g1.x, g1.y, g1.z, g1.w}, bb[8] = {b0.x, b0.y, b0.z, b0.w, b1.x, b1.y, b1.z, b1.w};
#pragma unroll
          for (int e = 0; e < 8; ++e) Vt[(c8 + e) * LDW + j] = (bf16)f2bf((v[e] - mean) * rstd * gg[e] + bb[e]); } }
    __syncthreads();
    const int fr = F.lane & 15, fq = F.lane >> 4;
    f32x4 acc[8][3];
#pragma unroll
    for (int mb = 0; mb < 8; ++mb)
#pragma unroll
        for (int nb = 0; nb < 3; ++nb) acc[mb][nb] = (f32x4){0.f, 0.f, 0.f, 0.f};
#pragma unroll
    for (int ks = 0; ks < 4; ++ks) { bf16x8 bfr[3];
#pragma unroll
        for (int nb = 0; nb < 3; ++nb) bfr[nb] = *(const LAS bf16x8*)(Vt + (F.wave * 48 + nb * 16 + fr) * LDW + ks * 32 + fq * 8);
#pragma unroll
        for (int mb = 0; mb < 8; ++mb) { const bf16x8 afr = *(const LAS bf16x8*)(Wl + (mb * 16 + fr) * LDW + ks * 32 + fq * 8);
#pragma unroll
            for (int nb = 0; nb < 3; ++nb) acc[mb][nb] = __builtin_amdgcn_mfma_f32_16x16x32_bf16(bfr[nb], afr, acc[mb][nb], 0, 0, 0); } }
    const float* bs = a.in[I_ABS] + ((size_t)l * 4 + g) * 128;
#pragma unroll
    for (int mb = 0; mb < 8; ++mb) { const int i = mb * 16 + fr; const float bsv = bs[i]; const size_t tk = (size_t)(tok0 + i);
#pragma unroll
        for (int nb = 0; nb < 3; ++nb) { const int c = g * 384 + F.wave * 48 + nb * 16 + 4 * fq;
            const v2u uw = *(const GAS v2u*)(z + tk * NINA + c); const f32x4 gt = acc[mb][nb] + bsv;
            v2u o; o.x = pk2(bflo(uw.x) * gt.x, bfhi(uw.x) * gt.y); o.y = pk2(bflo(uw.y) * gt.z, bfhi(uw.y) * gt.w);
            *(GAS v2u*)(cat + tk * D + c) = o; } }
    __syncthreads();
}

__device__ __forceinline__ void memattn_unit(Frame& F, int l, int hm, int qb, int ldz, int qoff) {
    const bf16* z = (const bf16*)(F.ws + WS_Z); const bf16* kv = (const bf16*)(F.ws + WS_MEMKV) + (size_t)l * 256 * 1024; bf16* cat = (bf16*)(F.ws + WS_CAT);
    att::attn_body<0>(z + (size_t)qb * 256 * ldz + qoff + hm * 128, ldz, kv + hm * 128, kv + 512 + hm * 128, 1024,
                      cat + (size_t)qb * 256 * D + MIXW + hm * 128, nullptr, D, 4, 0, nullptr, 0.f, F.ldsg);
}

__device__ __forceinline__ int t5_bucket(int rel) {
    const int a = rel < 0 ? -rel : rel; int f;
    if (a < 8) f = a; else if (a < 12) f = 8; else if (a < 16) f = 9; else if (a < 23) f = 10; else if (a < 32) f = 11; else if (a < 46) f = 12; else if (a < 64) f = 13; else if (a < 91) f = 14; else f = 15;
    return (rel > 0 ? 16 : 0) + f;
}

namespace att2 {
using att::bf16x8; using att::s16x4; using att::f32x16; using att::u32x4; using att::crow; using att::cvtpk; using att::tr_read; using att::v_rd_base;
constexpr int KT = 32, ST_K = KT * 128 * 2, ST_V = KT * 256 * 2, STAGE = 2 * ST_K + ST_V, NST = 3;
constexpr int LDS_WS = NST * STAGE, LDS_TAB = LDS_WS + 2048, LDS_UNIT = LDS_TAB + 640, LDS_END = LDS_UNIT + 16;
constexpr int NUNITS = 576;
constexpr float THR2 = 8.f * 1.4426950408889634f;
__device__ __forceinline__ int swap23(int k) { return (k & ~0xC) | ((k & 4) << 1) | ((k & 8) >> 1); }
constexpr int v_off(int d0, int ks, int half) { return d0 * 512 + ks * 8192 + half * 4096; }

struct UnitTable { unsigned short u[NUNITS]; };
constexpr UnitTable make_units() {
    UnitTable t{}; int n = 0;
    for (int c = 256; c >= 4; c -= 2) {
        { const int b = (c - 2) / 2; if ((c - 2) % 2 == 0 && b >= 32 && b <= 63) for (int part = 1; part <= 2; ++part) for (int h = 0; h < 6; ++h) t.u[n++] = (unsigned short)(h | (b << 3) | (part << 9)); }
        if (c % 4 == 0) { const int b = c / 4 - 1; if (b >= 0 && b < 32) for (int h = 0; h < 6; ++h) t.u[n++] = (unsigned short)(h | (b << 3)); }
    }
    return t;
}
__device__ const UnitTable g_units = make_units();

__device__ __forceinline__ void diff_unit(const bf16* __restrict__ Q, const bf16* __restrict__ KD, const bf16* __restrict__ VD, float* Obuf  , int orow0,
                                          float* ML  , const float* relb, int h, int b, int t_lo, int t_hi, LAS char* lds) {
  int tid_ = threadIdx.x; asm volatile("" : "+v"(tid_));
  const int tid = tid_, wid = __builtin_amdgcn_readfirstlane(tid >> 6), lane = tid & 63, r32 = lane & 31, hi = lane >> 5, m = wid >> 2, rg = wid & 3;
  LAS float* wsw = (LAS float*)(lds + LDS_WS) + wid * 64; LAS float* li_l = wsw; LAS float* al_l = wsw + 32;
  LAS float* tab = (LAS float*)(lds + LDS_TAB);
  if (tid < att::TAB_N) tab[tid] = relb[t5_bucket(63 - tid) * 6 + h] * LOG2E;
  const float cfar = relb[15 * 6 + h] * LOG2E;
  const int qrow0 = b * 128 + rg * 32;
  bf16x8 qr[8];
  { const bf16* Qw = Q + (size_t)(qrow0 + r32) * 2048 + h * 256 + m * 128 + hi * 8;
#pragma unroll
    for (int d0 = 0; d0 < 8; ++d0) qr[d0] = *reinterpret_cast<const bf16x8*>(Qw + d0 * 16); }
  int ko[2], vo[2];
#pragma unroll
  for (int i = 0; i < 2; ++i) {
    const int p = wid * 64 + lane, row = p >> 4, cp = (p & 15) ^ (row & 7); ko[i] = row * 1536 + h * 256 + i * 128 + cp * 8; }
#pragma unroll
  for (int i = 0; i < 2; ++i) {
    const int p = (wid * 2 + i) * 64 + lane, sub = p >> 5, kg = sub >> 3, cblk = sub & 7, q = p & 31, kk = kg * 8 + (q >> 2), key = swap23(kk);
    vo[i] = key * 1536 + h * 256 + cblk * 32 + (q & 3) * 8; }
  const unsigned ldsb = (unsigned)(uintptr_t)lds;
#define A2_ISSUE(t, s) do { const size_t kb_ = (size_t)(t) * KT * 1536; LAS char* sb_ = lds + (s) * STAGE; \
    __builtin_amdgcn_global_load_lds((const unsigned*)(KD + kb_ + ko[0]), (LAS unsigned*)(sb_ + wid * 1024), 16, 0, 0); \
    __builtin_amdgcn_global_load_lds((const unsigned*)(KD + kb_ + ko[1]), (LAS unsigned*)(sb_ + ST_K + wid * 1024), 16, 0, 0); \
    __builtin_amdgcn_global_load_lds((const unsigned*)(VD + kb_ + vo[0]), (LAS unsigned*)(sb_ + 2 * ST_K + (wid * 2) * 1024), 16, 0, 0); \
    __builtin_amdgcn_global_load_lds((const unsigned*)(VD + kb_ + vo[1]), (LAS unsigned*)(sb_ + 2 * ST_K + (wid * 2 + 1) * 1024), 16, 0, 0); } while (0)
  const int vis = 2 * (2 * b + (rg >> 1) + 1);
  float m_reg = -1e30f, l_reg = 0.f; f32x16 o[8];
#pragma unroll
  for (int d = 0; d < 8; ++d) o[d] = f32x16{};
  asm volatile("s_waitcnt vmcnt(0)" ::: "memory");
  A2_ISSUE(t_lo, 0); if (t_lo + 1 < t_hi) A2_ISSUE(t_lo + 1, 1);
  int s = 0;
  for (int t = t_lo; t < t_hi; ++t) {
    if (t + 1 < t_hi) asm volatile("s_waitcnt vmcnt(4) lgkmcnt(0)" ::: "memory"); else asm volatile("s_waitcnt vmcnt(0) lgkmcnt(0)" ::: "memory");
    __builtin_amdgcn_s_barrier(); asm volatile("" ::: "memory");
    if (t + 2 < t_hi) { const int s2 = (s >= 1) ? s - 1 : s + 2; A2_ISSUE(t + 2, s2); }
    if (t < vis) {
      const LAS char* Ks = lds + s * STAGE + m * ST_K;
      f32x16 p = f32x16{};
#pragma unroll
      for (int d0 = 0; d0 < 8; ++d0) { const int cb = (d0 * 16 + hi * 8) * 2;
        const bf16x8 b0 = *(const LAS bf16x8*)(Ks + KSWZ(r32, cb));
        p = __builtin_amdgcn_mfma_f32_32x32x16_bf16(b0, qr[d0], p, 0, 0, 0); }
      if (qrow0 - (KT * t + KT - 1) >= 91) {
#pragma unroll
        for (int r = 0; r < 16; ++r) p[r] += cfar;
      } else { const int base = qrow0 + r32 - KT * t + 63;
#pragma unroll
        for (int r = 0; r < 16; ++r) { const int i0 = base - crow(r, hi); p[r] += tab[i0 < att::TAB_N - 1 ? i0 : att::TAB_N - 1]; } }
      float pmax = p[0];
#pragma unroll
      for (int r = 1; r < 16; ++r) pmax = fmaxf(pmax, p[r]);
      { auto rr = __builtin_amdgcn_permlane32_swap(__float_as_uint(pmax), __float_as_uint(pmax), false, false); pmax = fmaxf(__uint_as_float(rr[0]), __uint_as_float(rr[1])); }
      float mn, alpha;
      if (__builtin_expect(__all(pmax - m_reg <= THR2), 1)) { mn = m_reg; alpha = 1.f; }
      else { mn = fmaxf(m_reg, pmax); alpha = __builtin_amdgcn_exp2f(m_reg - mn); m_reg = mn; }
      float ps = 0.f;
#pragma unroll
      for (int r = 0; r < 16; ++r) { p[r] = __builtin_amdgcn_exp2f(p[r] - mn); ps += p[r]; }
      { auto rr = __builtin_amdgcn_permlane32_swap(__float_as_uint(ps), __float_as_uint(ps), false, false); ps = __uint_as_float(rr[0]) + __uint_as_float(rr[1]); }
      l_reg = l_reg * alpha + ps;
      bf16x8 pa0, pa1;
#define A2_PK4(P, BASE, OUT) do { unsigned a0 = cvtpk(P[BASE + 0], P[BASE + 1]), a1 = cvtpk(P[BASE + 2], P[BASE + 3]);   \
    unsigned b0_ = cvtpk(P[BASE + 4], P[BASE + 5]), b1_ = cvtpk(P[BASE + 6], P[BASE + 7]);                              \
    auto r0 = __builtin_amdgcn_permlane32_swap(a0, b0_, false, false); auto r1 = __builtin_amdgcn_permlane32_swap(a1, b1_, false, false); \
    u32x4 w = {r0[0], r1[0], r0[1], r1[1]}; OUT = *reinterpret_cast<bf16x8*>(&w); } while (0)
      A2_PK4(p, 0, pa0); A2_PK4(p, 8, pa1);
      if (__any(alpha < 1.f)) { if (hi == 0) al_l[r32] = alpha; asm volatile("s_waitcnt lgkmcnt(0)" ::: "memory");
#pragma unroll
        for (int d = 0; d < 8; ++d)
#pragma unroll
          for (int r = 0; r < 16; ++r) o[d][r] *= al_l[crow(r, hi)]; }
      const int vb = (int)(ldsb + s * STAGE + 2 * ST_K) + v_rd_base(lane);
      asm volatile("s_waitcnt lgkmcnt(0)" ::: "memory"); SBAR();
#define A2_PK(L, H) (bf16x8){L[0], L[1], L[2], L[3], H[0], H[1], H[2], H[3]}
#define A2_RD(D0, l0, h0, l1, h1) do { l0 = tr_read<v_off(D0, 0, 0)>(vb); h0 = tr_read<v_off(D0, 0, 1)>(vb); l1 = tr_read<v_off(D0, 1, 0)>(vb); h1 = tr_read<v_off(D0, 1, 1)>(vb); } while (0)
#define A2_MM(D0, l0, h0, l1, h1) do { o[D0] = __builtin_amdgcn_mfma_f32_32x32x16_bf16(pa0, A2_PK(l0, h0), o[D0], 0, 0, 0); o[D0] = __builtin_amdgcn_mfma_f32_32x32x16_bf16(pa1, A2_PK(l1, h1), o[D0], 0, 0, 0); } while (0)
      s16x4 xl0, xh0, xl1, xh1, yl0, yh0, yl1, yh1;
      A2_RD(0, xl0, xh0, xl1, xh1);
      A2_RD(1, yl0, yh0, yl1, yh1); asm volatile("s_waitcnt lgkmcnt(4)" ::: "memory"); SBAR(); A2_MM(0, xl0, xh0, xl1, xh1); SBAR();
      A2_RD(2, xl0, xh0, xl1, xh1); asm volatile("s_waitcnt lgkmcnt(4)" ::: "memory"); SBAR(); A2_MM(1, yl0, yh0, yl1, yh1); SBAR();
      A2_RD(3, yl0, yh0, yl1, yh1); asm volatile("s_waitcnt lgkmcnt(4)" ::: "memory"); SBAR(); A2_MM(2, xl0, xh0, xl1, xh1); SBAR();
      A2_RD(4, xl0, xh0, xl1, xh1); asm volatile("s_waitcnt lgkmcnt(4)" ::: "memory"); SBAR(); A2_MM(3, yl0, yh0, yl1, yh1); SBAR();
      A2_RD(5, yl0, yh0, yl1, yh1); asm volatile("s_waitcnt lgkmcnt(4)" ::: "memory"); SBAR(); A2_MM(4, xl0, xh0, xl1, xh1); SBAR();
      A2_RD(6, xl0, xh0, xl1, xh1); asm volatile("s_waitcnt lgkmcnt(4)" ::: "memory"); SBAR(); A2_MM(5, yl0, yh0, yl1, yh1); SBAR();
      A2_RD(7, yl0, yh0, yl1, yh1); asm volatile("s_waitcnt lgkmcnt(4)" ::: "memory"); SBAR(); A2_MM(6, xl0, xh0, xl1, xh1); SBAR();
      asm volatile("s_waitcnt lgkmcnt(0)" ::: "memory"); SBAR(); A2_MM(7, yl0, yh0, yl1, yh1); SBAR();
    }
    s = (s == 2) ? 0 : s + 1;
  }
  if (hi == 0) li_l[r32] = l_reg; asm volatile("s_waitcnt lgkmcnt(0)" ::: "memory");
  float rli[16];
#pragma unroll
  for (int r = 0; r < 16; ++r) rli[r] = __builtin_amdgcn_rcpf(li_l[crow(r, hi)]);
  float* Ow = Obuf + (size_t)(qrow0 - orow0) * 3072 + (h * 2 + m) * 256;
#pragma unroll
  for (int r = 0; r < 16; ++r) { const int orow = crow(r, hi);
#pragma unroll
    for (int d0 = 0; d0 < 8; ++d0) Ow[(size_t)orow * 3072 + d0 * 32 + r32] = o[d0][r] * rli[r]; }
  if (hi == 0) { float* mlp = ML + (((size_t)(qrow0 - orow0 + r32) * 6 + h) * 2 + m) * 2; mlp[0] = m_reg; mlp[1] = l_reg; }
  asm volatile("s_waitcnt vmcnt(0) lgkmcnt(0)" ::: "memory");
  __builtin_amdgcn_s_barrier(); asm volatile("" ::: "memory");
#undef A2_ISSUE
#undef A2_PK4
#undef A2_PK
#undef A2_RD
#undef A2_MM
}
}

namespace att3 {
using att::f32x16; using att::crow;
typedef int v8i __attribute__((ext_vector_type(8))); typedef int v4i __attribute__((ext_vector_type(4)));
constexpr int KT = 64, ST_K = KT * 128, ST_V = 256 * 64, STAGE = 2 * ST_K + ST_V, NST = 3;
static_assert(NST * STAGE == att2::LDS_WS, "same ring size as att2");
constexpr float THR2 = 2.f;
__device__ __forceinline__ v8i cat8(v4i a, v4i b) { return __builtin_shufflevector(a, b, 0, 1, 2, 3, 4, 5, 6, 7); }
__device__ __forceinline__ void diff_unit(const unsigned char* __restrict__ Q8, const unsigned char* __restrict__ K8, const unsigned char* __restrict__ VT, float* Obuf, int orow0,
                                          float* ML, const float* relb, int h, int b, int t_lo, int t_hi, LAS char* lds) {
  int tid_ = threadIdx.x; asm volatile("" : "+v"(tid_));
  const int tid = tid_, wid = __builtin_amdgcn_readfirstlane(tid >> 6), lane = tid & 63, r32 = lane & 31, hi = lane >> 5, m = wid >> 2, rg = wid & 3;
  LAS float* wsw = (LAS float*)(lds + att2::LDS_WS) + wid * 64; LAS float* li_l = wsw; LAS float* al_l = wsw + 32;
  LAS float* tab = (LAS float*)(lds + att2::LDS_TAB);
  if (tid < att::TAB_N) tab[tid] = relb[t5_bucket(63 - tid) * 6 + h] * LOG2E;
  const float cfar = relb[15 * 6 + h] * LOG2E;
  const int qrow0 = b * 128 + rg * 32;
  v8i q8[2];
  { const unsigned char* Qw = Q8 + (size_t)(qrow0 + r32) * 2048 + h * 256 + m * 128 + hi * 32;
#pragma unroll
    for (int c = 0; c < 2; ++c) q8[c] = cat8(*(const GAS v4i*)(Qw + 64 * c), *(const GAS v4i*)(Qw + 64 * c + 16)); }
  int ko, vo[2];
  { const int p = wid * 64 + lane, row = p >> 3, cp = (p & 7) ^ (row & 7); ko = row * 1536 + h * 256 + cp * 16; }
#pragma unroll
  for (int i = 0; i < 2; ++i) { const int p = (wid * 2 + i) * 64 + lane, d = p >> 2, cp = (p & 3) ^ ((d >> 1) & 3); vo[i] = d * 64 + cp * 16; }
  const unsigned char* VTh = VT + (size_t)h * 128 * 16384;
#define A3_ISSUE(t, s) do { const size_t kb_ = (size_t)(t) * KT * 1536; LAS char* sb_ = lds + (s) * STAGE; \
    __builtin_amdgcn_global_load_lds((const unsigned*)(K8 + kb_ + ko), (LAS unsigned*)(sb_ + wid * 1024), 16, 0, 0); \
    __builtin_amdgcn_global_load_lds((const unsigned*)(K8 + kb_ + ko + 128), (LAS unsigned*)(sb_ + ST_K + wid * 1024), 16, 0, 0); \
    __builtin_amdgcn_global_load_lds((const unsigned*)(VTh + (size_t)(t) * 16384 + vo[0]), (LAS unsigned*)(sb_ + 2 * ST_K + (wid * 2) * 1024), 16, 0, 0); \
    __builtin_amdgcn_global_load_lds((const unsigned*)(VTh + (size_t)(t) * 16384 + vo[1]), (LAS unsigned*)(sb_ + 2 * ST_K + (wid * 2 + 1) * 1024), 16, 0, 0); } while (0)
  const int vis = 2 * b + (rg >> 1) + 1;
  float m_reg = -1e30f, l_reg = 0.f; f32x16 o[8];
#pragma unroll
  for (int d = 0; d < 8; ++d) o[d] = f32x16{};
  const int kx = (r32 & 7), koff0 = r32 * 128 + (((2 * hi) ^ kx) << 4), koff1 = r32 * 128 + (((2 * hi + 1) ^ kx) << 4);
  const int vx = (r32 >> 1) & 3, voff0 = r32 * 64 + (((2 * hi) ^ vx) << 4), voff1 = r32 * 64 + (((2 * hi + 1) ^ vx) << 4);
  int sclP = 121, scl1 = 127; asm volatile("" : "+v"(sclP), "+v"(scl1));
  asm volatile("s_waitcnt vmcnt(0)" ::: "memory");
  A3_ISSUE(t_lo, 0); if (t_lo + 1 < t_hi) A3_ISSUE(t_lo + 1, 1);
  int s = 0;
  for (int t = t_lo; t < t_hi; ++t) {
    if (t + 1 < t_hi) asm volatile("s_waitcnt vmcnt(4) lgkmcnt(0)" ::: "memory"); else asm volatile("s_waitcnt vmcnt(0) lgkmcnt(0)" ::: "memory");
    __builtin_amdgcn_s_barrier(); asm volatile("" ::: "memory");
    if (t + 2 < t_hi) { const int s2 = (s >= 1) ? s - 1 : s + 2; A3_ISSUE(t + 2, s2); }
    if (t < vis) {
      const LAS char* Ks = lds + s * STAGE + m * ST_K;
      f32x16 p0 = f32x16{}, p1 = f32x16{};
#pragma unroll
      for (int c = 0; c < 2; ++c) {
        const int x0 = koff0 ^ (c << 6), x1 = koff1 ^ (c << 6);
        const v8i k0 = cat8(*(const LAS v4i*)(Ks + x0), *(const LAS v4i*)(Ks + x1));
        const v8i k1 = cat8(*(const LAS v4i*)(Ks + 4096 + x0), *(const LAS v4i*)(Ks + 4096 + x1));
        asm volatile("v_mfma_scale_f32_32x32x64_f8f6f4 %0, %1, %2, %0, %3, %3 op_sel_hi:[0,0,0]" : "+v"(p0) : "v"(k0), "v"(q8[c]), "v"(scl1));
        asm volatile("v_mfma_scale_f32_32x32x64_f8f6f4 %0, %1, %2, %0, %3, %3 op_sel_hi:[0,0,0]" : "+v"(p1) : "v"(k1), "v"(q8[c]), "v"(scl1)); }
      asm volatile("s_nop 15\n s_nop 7" : "+v"(p0), "+v"(p1));
      const bool far = qrow0 - (KT * t + KT - 1) >= 91;
      if (!far) { const int base = qrow0 + r32 - KT * t + 63;
#pragma unroll
        for (int r = 0; r < 16; ++r) { const int i0 = base - crow(r, hi), i1 = i0 - 32; p0[r] += tab[i0 < att::TAB_N - 1 ? i0 : att::TAB_N - 1]; p1[r] += tab[i1 < att::TAB_N - 1 ? i1 : att::TAB_N - 1]; } }
      const float cb = far ? cfar : 0.f;
      float pmax;
      asm("v_max3_f32 %0, %1, %2, %3" : "=v"(pmax) : "v"(p0[0]), "v"(p1[0]), "v"(p0[1]));
      asm("v_max3_f32 %0, %1, %2, %3" : "=v"(pmax) : "v"(pmax), "v"(p1[1]), "v"(p0[2]));
#pragma unroll
      for (int r = 2; r < 15; ++r) asm("v_max3_f32 %0, %1, %2, %3" : "=v"(pmax) : "v"(pmax), "v"(p1[r]), "v"(p0[r + 1]));
      asm("v_max_f32 %0, %1, %2" : "=v"(pmax) : "v"(pmax), "v"(p1[15]));
      pmax += cb;
      { auto rr = __builtin_amdgcn_permlane32_swap(__float_as_uint(pmax), __float_as_uint(pmax), false, false); asm("v_max_f32 %0, %1, %2" : "=v"(pmax) : "v"(__uint_as_float(rr[0])), "v"(__uint_as_float(rr[1]))); }
      float mn, alpha;
      if (__builtin_expect(__all(pmax - m_reg <= THR2), 1)) { mn = m_reg; alpha = 1.f; }
      else { mn = fmaxf(m_reg, pmax); alpha = __builtin_amdgcn_exp2f(m_reg - mn); m_reg = mn; }
      typedef float f32x2v __attribute__((ext_vector_type(2)));
      const float off = cb - (mn - 6.f); const f32x2v off2 = {off, off}; f32x2v ps2 = {0.f, 0.f};
#pragma unroll
      for (int r = 0; r < 16; r += 2) {
        f32x2v a = (f32x2v){p0[r], p0[r + 1]} + off2, c2 = (f32x2v){p1[r], p1[r + 1]} + off2;
        p0[r] = __builtin_amdgcn_exp2f(a.x); p0[r + 1] = __builtin_amdgcn_exp2f(a.y); p1[r] = __builtin_amdgcn_exp2f(c2.x); p1[r + 1] = __builtin_amdgcn_exp2f(c2.y);
        ps2 += (f32x2v){p0[r], p0[r + 1]}; ps2 += (f32x2v){p1[r], p1[r + 1]}; }
      float ps = ps2.x + ps2.y;
      { auto rr = __builtin_amdgcn_permlane32_swap(__float_as_uint(ps), __float_as_uint(ps), false, false); ps = __uint_as_float(rr[0]) + __uint_as_float(rr[1]); }
      l_reg = l_reg * alpha + ps;
      v8i pa;
#pragma unroll
      for (int g = 0; g < 4; ++g) { unsigned x = 0u, y = 0u;
        x = __builtin_amdgcn_cvt_pk_fp8_f32(p0[4 * g], p0[4 * g + 1], x, false); x = __builtin_amdgcn_cvt_pk_fp8_f32(p0[4 * g + 2], p0[4 * g + 3], x, true);
        y = __builtin_amdgcn_cvt_pk_fp8_f32(p1[4 * g], p1[4 * g + 1], y, false); y = __builtin_amdgcn_cvt_pk_fp8_f32(p1[4 * g + 2], p1[4 * g + 3], y, true);
        auto rr = __builtin_amdgcn_permlane32_swap(x, y, false, false); pa[2 * g] = (int)rr[0]; pa[2 * g + 1] = (int)rr[1]; }
      if (__any(alpha < 1.f)) { if (hi == 0) al_l[r32] = alpha; asm volatile("s_waitcnt lgkmcnt(0)" ::: "memory");
#pragma unroll
        for (int d = 0; d < 8; ++d)
#pragma unroll
          for (int r = 0; r < 16; ++r) o[d][r] *= al_l[crow(r, hi)]; }
      const LAS char* Vs = lds + s * STAGE + 2 * ST_K;
#define A3_RD(D0, V) do { V = cat8(*(const LAS v4i*)(Vs + (D0) * 2048 + voff0), *(const LAS v4i*)(Vs + (D0) * 2048 + voff1)); } while (0)
#define A3_MM(D0, V) asm volatile("v_mfma_scale_f32_32x32x64_f8f6f4 %0, %1, %2, %0, %3, %4 op_sel_hi:[0,0,0]" : "+v"(o[D0]) : "v"(pa), "v"(V), "v"(sclP), "v"(scl1))
      v8i va, vb;
      A3_RD(0, va);
      A3_RD(1, vb); A3_MM(0, va);
      A3_RD(2, va); A3_MM(1, vb);
      A3_RD(3, vb); A3_MM(2, va);
      A3_RD(4, va); A3_MM(3, vb);
      A3_RD(5, vb); A3_MM(4, va);
      A3_RD(6, va); A3_MM(5, vb);
      A3_RD(7, vb); A3_MM(6, va);
      A3_MM(7, vb);
    }
    s = (s == 2) ? 0 : s + 1;
  }
  asm volatile("s_nop 15\n s_nop 15" ::: "memory");
  if (hi == 0) li_l[r32] = l_reg; asm volatile("s_waitcnt lgkmcnt(0)" ::: "memory");
  float rli[16];
#pragma unroll
  for (int r = 0; r < 16; ++r) rli[r] = 64.f * __builtin_amdgcn_rcpf(li_l[crow(r, hi)]);
  float* Ow = Obuf + (size_t)(qrow0 - orow0) * 3072 + (h * 2 + m) * 256;
#pragma unroll
  for (int r = 0; r < 16; ++r) { const int orow = crow(r, hi);
#pragma unroll
    for (int d0 = 0; d0 < 8; ++d0) Ow[(size_t)orow * 3072 + d0 * 32 + r32] = o[d0][r] * rli[r]; }
  if (hi == 0) { float* mlp = ML + (((size_t)(qrow0 - orow0 + r32) * 6 + h) * 2 + m) * 2; mlp[0] = m_reg; mlp[1] = l_reg * (1.f / 64.f); }
  asm volatile("s_waitcnt vmcnt(0) lgkmcnt(0)" ::: "memory");
  __builtin_amdgcn_s_barrier(); asm volatile("" ::: "memory");
#undef A3_ISSUE
#undef A3_RD
#undef A3_MM
}
}

__device__ __forceinline__ void diffattn2_unit(Frame& F, const Args& a, unsigned code) {
    const int h = code & 7, b = (code >> 3) & 63, pc = code >> 9;
    float* ob = (float*)(F.ws + (pc == 2 ? WS_OP2 : WS_OP)); float* ml = (float*)(F.ws + WS_ML) + (pc == 2 ? (size_t)T * 6 * 2 * 2 : 0);
#ifdef ATT_BF16
    const int nt = 4 * b + 4, t_lo = (pc == 2) ? nt / 2 : 0, t_hi = (pc == 1) ? nt / 2 : nt;
    att2::diff_unit((const bf16*)(F.ws + WS_Z), (const bf16*)(F.ws + WS_KD), (const bf16*)(F.ws + WS_VD), ob, pc == 2 ? 4096 : 0, ml, a.in[I_RELB], h, b, t_lo, t_hi, (LAS char*)F.lds);
#else
    const int nt = 2 * b + 2, t_lo = (pc == 2) ? nt / 2 : 0, t_hi = (pc == 1) ? nt / 2 : nt;
    att3::diff_unit(F.ws + WS_ZQ, F.ws + WS_KD, F.ws + WS_VD, ob, pc == 2 ? 4096 : 0, ml, a.in[I_RELB], h, b, t_lo, t_hi, (LAS char*)F.lds);
#endif
}
__device__ __forceinline__ void diffcombine_phase(Frame& F, const Args& a, int l) {
    const int i = l - 2; const float* lp = a.in[I_BLAM] + (size_t)i * 4 * 128;
    float s1 = lp[F.lane] * lp[128 + F.lane] + lp[64 + F.lane] * lp[128 + 64 + F.lane], s2 = lp[256 + F.lane] * lp[384 + F.lane] + lp[256 + 64 + F.lane] * lp[384 + 64 + F.lane];
    s1 = wave_sum(s1); s2 = wave_sum(s2);
    const float lam_init = 0.8f - 0.6f * expf(-0.3f * (float)l);
    const float lam = expf(s1) - expf(s2) + lam_init;
    const float* op0 = (const float*)(F.ws + WS_OP); const float* op1 = (const float*)(F.ws + WS_OP2); const float* ml0 = (const float*)(F.ws + WS_ML); const float* ml1 = ml0 + (size_t)T * 6 * 2 * 2;
    bf16* cat = (bf16*)(F.ws + WS_CAT);
    const f32x4 gsub = *(const GAS f32x4*)(a.in[I_BSUBG] + (size_t)i * 256 + 4 * F.lane);
    const int gw = F.c * NWAVES + F.wave, NGW = F.G * NWAVES;
    for (int it = gw; it < T * 6; it += NGW) { const int tk = it / 6, h = it - tk * 6; f32x4 os[2];
#pragma unroll
        for (int m = 0; m < 2; ++m) { const size_t r0 = ((size_t)tk * 6 + h) * 2 + m; f32x4 oa = *(const GAS f32x4*)(op0 + r0 * 256 + 4 * F.lane);
            if (tk >= 4096) { const size_t r1 = ((size_t)(tk - 4096) * 6 + h) * 2 + m; const f32x4 ob = *(const GAS f32x4*)(op1 + r1 * 256 + 4 * F.lane);
                const float ma = ml0[r0 * 2], la = ml0[r0 * 2 + 1], mb = ml1[r1 * 2], lb = ml1[r1 * 2 + 1], M = fmaxf(ma, mb);
                const float wa = la * exp2f(ma - M), wb = lb * exp2f(mb - M), inv = 1.f / (wa + wb); oa = oa * (wa * inv) + ob * (wb * inv); }
            os[m] = oa; }
        const f32x4 o = os[0] - os[1] * lam; const float ss = wave_sum((o.x * o.x + o.y * o.y) + (o.z * o.z + o.w * o.w));
        const float r = (1.f - lam_init) / sqrtf(ss * (1.f / 256.f) + LN_EPS);
        v2u w; w.x = pk2(o.x * r * gsub.x, o.y * r * gsub.y); w.y = pk2(o.z * r * gsub.z, o.w * r * gsub.w);
        *(GAS v2u*)(cat + (size_t)tk * D + h * 256 + 4 * F.lane) = w;
        { unsigned q8 = 0u; q8 = __builtin_amdgcn_cvt_pk_fp8_f32(o.x * r * gsub.x, o.y * r * gsub.y, q8, false); q8 = __builtin_amdgcn_cvt_pk_fp8_f32(o.z * r * gsub.z, o.w * r * gsub.w, q8, true);
          *(GAS unsigned*)(F.ws + WS_CATQ + (size_t)tk * D + h * 256 + 4 * F.lane) = q8; } }
    { const long nthr = (long)F.G * 512, gt = (long)F.c * 512 + F.tid;
      for (long i2 = gt; i2 < (long)T * 64; i2 += nthr) { const long tk = i2 >> 6; const int c8 = (int)(i2 & 63) * 8; const v4u w = *(const GAS v4u*)(cat + tk * D + MIXW + c8);
          unsigned lo = 0u, hi = 0u; lo = __builtin_amdgcn_cvt_pk_fp8_f32(bflo(w.x), bfhi(w.x), lo, false); lo = __builtin_amdgcn_cvt_pk_fp8_f32(bflo(w.y), bfhi(w.y), lo, true);
          hi = __builtin_amdgcn_cvt_pk_fp8_f32(bflo(w.z), bfhi(w.z), hi, false); hi = __builtin_amdgcn_cvt_pk_fp8_f32(bflo(w.w), bfhi(w.w), hi, true);
          v2u qq; qq.x = lo; qq.y = hi; *(GAS v2u*)(F.ws + WS_CATQ + tk * D + MIXW + c8) = qq; } }
}


__device__ __forceinline__ void ln1_router_phase(Frame& F, const Args& a, int l, int probe = 0) {
    const bf16* y = (const bf16*)(F.ws + WS_Y); bf16* x1b = (bf16*)(F.ws + WS_X1B);
    const float* lng = a.in[I_LNG] + ((size_t)l * 2 + 0) * D; const float* lnb = a.in[I_LNB] + ((size_t)l * 2 + 0) * D;
    const float* wr = (const float*)(F.ws + WS_WR) + (size_t)l * 3 * 512 * 16 * 4;
    int* tok_e = (int*)(F.ws + (probe ? WS_OP : WS_ROUTE)); int* tok_rank = tok_e + 2 * T; float* tok_gate = (float*)(tok_rank + 2 * T);
    gu32* cnt = F.ctl + (probe ? 65536 : CW_CNT) + 2048 * l;
    LAS float* P = (LAS float*)(F.lds);
    typedef float f32x4v __attribute__((ext_vector_type(4)));
    for (int tb = F.c; tb < T / 32; tb += F.G) {
#pragma unroll 2
        for (int i = 0; i < 4; ++i) { const int tk = tb * 32 + F.wave * 4 + i;
            const GAS v4u* yr = (const GAS v4u*)(y + (size_t)tk * D) + F.lane;
            float v[4][8]; float s = 0.f;
#pragma unroll
            for (int j = 0; j < 4; ++j) { const v4u w = yr[64 * j]; v[j][0] = bflo(w.x); v[j][1] = bfhi(w.x); v[j][2] = bflo(w.y); v[j][3] = bfhi(w.y); v[j][4] = bflo(w.z); v[j][5] = bfhi(w.z); v[j][6] = bflo(w.w); v[j][7] = bfhi(w.w);
#pragma unroll
                for (int e = 0; e < 8; ++e) s += v[j][e]; }
            const float mean = wave_sum(s) * (1.f / D); float s2 = 0.f;
#pragma unroll
            for (int j = 0; j < 4; ++j)
#pragma unroll
                for (int e = 0; e < 8; ++e) { v[j][e] -= mean; s2 += v[j][e] * v[j][e]; }
            const float rstd = 1.f / sqrtf(wave_sum(s2) * (1.f / D) + LN_EPS);
#pragma unroll
            for (int j = 0; j < 4; ++j) { const int d0 = 8 * F.lane + 512 * j; const f32x4 g0 = *(const GAS f32x4*)(lng + d0), g1 = *(const GAS f32x4*)(lng + d0 + 4), b0 = *(const GAS f32x4*)(lnb + d0), b1 = *(const GAS f32x4*)(lnb + d0 + 4);
                const float q0 = v[j][0] * rstd * g0.x + b0.x, q1 = v[j][1] * rstd * g0.y + b0.y, q2 = v[j][2] * rstd * g0.z + b0.z, q3 = v[j][3] * rstd * g0.w + b0.w;
                const float q4 = v[j][4] * rstd * g1.x + b1.x, q5 = v[j][5] * rstd * g1.y + b1.y, q6 = v[j][6] * rstd * g1.z + b1.z, q7 = v[j][7] * rstd * g1.w + b1.w;
                v4u w; w.x = pk2(q0, q1); w.y = pk2(q2, q3); w.z = pk2(q4, q5); w.w = pk2(q6, q7);
                *(GAS v4u*)(x1b + (size_t)tk * D + d0) = w;
                unsigned lo = 0u, hi = 0u; lo = __builtin_amdgcn_cvt_pk_fp8_f32(q0, q1, lo, false); lo = __builtin_amdgcn_cvt_pk_fp8_f32(q2, q3, lo, true);
                hi = __builtin_amdgcn_cvt_pk_fp8_f32(q4, q5, hi, false); hi = __builtin_amdgcn_cvt_pk_fp8_f32(q6, q7, hi, true);
                v2u qq; qq.x = lo; qq.y = hi; *(GAS v2u*)((unsigned char*)(F.ws + WS_X1F) + (size_t)tk * D + d0) = qq; } }
        VM_WAIT(); __syncthreads();
        { const int mt = F.wave >> 2, kq = F.wave & 3, c = F.lane & 15, q = F.lane >> 4;
          const bf16* ap = x1b + (size_t)(tb * 32 + mt * 16 + c) * D + kq * 512 + 4 * q;
          const float* bp = wr + ((size_t)(kq * 128 + q) * 16 + c) * 4;
          f32x4v acc[3] = {{0.f, 0.f, 0.f, 0.f}, {0.f, 0.f, 0.f, 0.f}, {0.f, 0.f, 0.f, 0.f}};
#pragma unroll 8
          for (int ks = 0; ks < 32; ++ks) { const v2u aw = *(const GAS v2u*)(ap + 16 * ks); const f32x4 a4 = (f32x4){bflo(aw.x), bfhi(aw.x), bflo(aw.y), bfhi(aw.y)}; f32x4 b4[3];
#pragma unroll
              for (int nb = 0; nb < 3; ++nb) b4[nb] = *(const GAS f32x4*)(bp + ((size_t)nb * 512 + 4 * ks) * 64);
#pragma unroll
              for (int j = 0; j < 4; ++j)
#pragma unroll
                  for (int nb = 0; nb < 3; ++nb) acc[nb] = __builtin_amdgcn_mfma_f32_16x16x4f32(a4[j], b4[nb][j], acc[nb], 0, 0, 0); }
#pragma unroll
          for (int nb = 0; nb < 3; ++nb)
#pragma unroll
              for (int r = 0; r < 4; ++r) P[((kq * 2 + mt) * 16 + 4 * q + r) * 48 + nb * 16 + c] = acc[nb][r]; }
        __syncthreads();
        if (F.tid < 64) { const int tsel = F.tid & 31, tk = tb * 32 + tsel, mt = tsel >> 4, ti = tsel & 15;
            const LAS f32x4* P4 = (const LAS f32x4*)P;
            const int rb = (mt * 16 + ti) * 12;
            const float* bg1 = a.in[I_BG1] + l * 4; const float* bg2 = a.in[I_BG2] + l * 32;
            const f32x4 s1 = (P4[rb] + P4[rb + 384]) + (P4[rb + 768] + P4[rb + 1152]);
            const float l10 = s1.x + bg1[0], l11 = s1.y + bg1[1], l12 = s1.z + bg1[2], l13 = s1.w + bg1[3];
            int grp = 0; float mx = l10;
            if (l11 > mx) { mx = l11; grp = 1; } if (l12 > mx) { mx = l12; grp = 2; } if (l13 > mx) { mx = l13; grp = 3; }
            const float psel = 1.f / (expf(l10 - mx) + expf(l11 - mx) + expf(l12 - mx) + expf(l13 - mx));
            const int ob = rb + 1 + 2 * grp;
            const f32x4 sa = (P4[ob] + P4[ob + 384]) + (P4[ob + 768] + P4[ob + 1152]), sb = (P4[ob + 1] + P4[ob + 385]) + (P4[ob + 769] + P4[ob + 1153]);
            const f32x4 ba = *(const GAS f32x4*)(bg2 + grp * 8), bb = *(const GAS f32x4*)(bg2 + grp * 8 + 4);
            const float l2[8] = {sa.x + ba.x, sa.y + ba.y, sa.z + ba.z, sa.w + ba.w, sb.x + bb.x, sb.y + bb.y, sb.z + bb.z, sb.w + bb.w};
            int i0 = 0; float v0 = l2[0];
#pragma unroll
            for (int e = 1; e < 8; ++e) if (l2[e] > v0) { v0 = l2[e]; i0 = e; }
            int i1 = -1; float v1 = -INFINITY;
#pragma unroll
            for (int e = 0; e < 8; ++e) if (e != i0 && l2[e] > v1) { v1 = l2[e]; i1 = e; }
            const float e1 = expf(v1 - v0), g0 = psel / (1.f + e1), g1 = psel * e1 / (1.f + e1);
            const int ex0 = grp * 8 + i0, ex1 = grp * 8 + i1;
            const int which = F.lane >> 5, ex = which ? ex1 : ex0; const float gg = which ? g1 : g0;
            int leader = F.lane, idx = 0, gcount = 1;
            { unsigned long long rem = ~0ull;
              while (rem) { const int l0 = __builtin_ctzll(rem); const int le = __builtin_amdgcn_readlane(ex, l0); const unsigned long long mm = __ballot(ex == le);
                  if (ex == le) { leader = l0; idx = __builtin_popcountll(mm & ((1ull << F.lane) - 1ull)); gcount = __builtin_popcountll(mm); }
                  rem &= ~mm; } }
            unsigned base = 0u; if (F.lane == leader) base = __hip_atomic_fetch_add(cnt + 64 * ex, (unsigned)gcount, RLX_AGENT);
            base = (unsigned)__shfl((int)base, leader);
            const int rk = (int)base + idx;
            { int* list = (int*)(F.ws + (probe ? WS_OP + 2 * MiB : WS_LIST)); list[ex * 8192 + rk] = tk; }
            tok_e[2 * tk + which] = ex; tok_rank[2 * tk + which] = rk; tok_gate[2 * tk + which] = gg; }
        __syncthreads();
    }
}
__device__ __forceinline__ void moe_table(Frame& F, int l) {
    LAS int* tstart = (LAS int*)(F.lds + TAB_OFF);
    if (F.tid == 0) { int acc = 0;
        for (int e = 0; e < 32; ++e) { tstart[e] = acc; const unsigned c = __hip_atomic_load(F.ctl + CW_CNT + 2048 * l + 64 * e, RLX_AGENT); tstart[36 + e] = (int)c; acc += (int)((c + 255u) >> 8); }
        tstart[32] = acc; }
    __syncthreads();
}
__device__ __forceinline__ void ln2_phase(Frame& F, const Args& a, int l) {
    const bf16* x1b = (const bf16*)(F.ws + WS_X1B); const bf16* yb = (const bf16*)(F.ws + WS_YB); bf16* xb = (bf16*)(F.ws + WS_XB);
    const float* lng = a.in[I_LNG] + ((size_t)l * 2 + 1) * D; const float* lnb = a.in[I_LNB] + ((size_t)l * 2 + 1) * D;
    moe_table(F, l); const LAS int* tstart = (const LAS int*)(F.lds + TAB_OFF);
    const int* tok_e = (const int*)(F.ws + WS_ROUTE); const int* tok_rank = tok_e + 2 * T; const float* tok_gate = (const float*)(F.ws + WS_ROUTE) + 4 * T;
    const int gw = F.c * NWAVES + F.wave, NGW = F.G * NWAVES;
    for (int t4 = gw; t4 < T / 4; t4 += NGW) { const int tk0 = t4 * 4;
        int ev = 0, rv = 0; float gv = 0.f;
        if (F.lane < 8) { ev = tok_e[2 * tk0 + F.lane]; rv = tok_rank[2 * tk0 + F.lane]; gv = tok_gate[2 * tk0 + F.lane]; }
        const int slotv = (F.lane < 8) ? tstart[ev] * 256 + rv : 0;
        v4u xr[2], ya[2], yc[2]; v4u xr2[2], ya2[2], yc2[2];
#define LN2_LOAD(i, XR, YA, YC, XR2, YA2, YC2) do { const int s0_ = __builtin_amdgcn_readlane(slotv, 2 * (i)), s1_ = __builtin_amdgcn_readlane(slotv, 2 * (i) + 1); \
        _Pragma("unroll") for (int j = 0; j < 2; ++j) { const int d0 = 8 * F.lane + 512 * j; XR[j] = *(const GAS v4u*)(x1b + (size_t)(tk0 + (i)) * D + d0); YA[j] = *(const GAS v4u*)(yb + (size_t)s0_ * D + d0); YC[j] = *(const GAS v4u*)(yb + (size_t)s1_ * D + d0); } \
        _Pragma("unroll") for (int j = 0; j < 2; ++j) { const int d0 = 8 * F.lane + 512 * (j + 2); XR2[j] = *(const GAS v4u*)(x1b + (size_t)(tk0 + (i)) * D + d0); YA2[j] = *(const GAS v4u*)(yb + (size_t)s0_ * D + d0); YC2[j] = *(const GAS v4u*)(yb + (size_t)s1_ * D + d0); } } while (0)
        LN2_LOAD(0, xr, ya, yc, xr2, ya2, yc2);
#pragma unroll
        for (int i = 0; i < 4; ++i) { const int tk = tk0 + i;
            const float g0 = __builtin_bit_cast(float, __builtin_amdgcn_readlane(__builtin_bit_cast(int, gv), 2 * i)), g1 = __builtin_bit_cast(float, __builtin_amdgcn_readlane(__builtin_bit_cast(int, gv), 2 * i + 1));
            float v[4][8]; float s = 0.f;
#pragma unroll
            for (int j = 0; j < 4; ++j) { const v4u X = j < 2 ? xr[j] : xr2[j - 2], A = j < 2 ? ya[j] : ya2[j - 2], C = j < 2 ? yc[j] : yc2[j - 2];
                v[j][0] = bflo(X.x) * DN_ALPHA + (g0 * bflo(A.x) + g1 * bflo(C.x)); v[j][1] = bfhi(X.x) * DN_ALPHA + (g0 * bfhi(A.x) + g1 * bfhi(C.x));
                v[j][2] = bflo(X.y) * DN_ALPHA + (g0 * bflo(A.y) + g1 * bflo(C.y)); v[j][3] = bfhi(X.y) * DN_ALPHA + (g0 * bfhi(A.y) + g1 * bfhi(C.y));
                v[j][4] = bflo(X.z) * DN_ALPHA + (g0 * bflo(A.z) + g1 * bflo(C.z)); v[j][5] = bfhi(X.z) * DN_ALPHA + (g0 * bfhi(A.z) + g1 * bfhi(C.z));
                v[j][6] = bflo(X.w) * DN_ALPHA + (g0 * bflo(A.w) + g1 * bflo(C.w)); v[j][7] = bfhi(X.w) * DN_ALPHA + (g0 * bfhi(A.w) + g1 * bfhi(C.w));
#pragma unroll
                for (int e = 0; e < 8; ++e) s += v[j][e]; }
            if (i + 1 < 4) LN2_LOAD(i + 1, xr, ya, yc, xr2, ya2, yc2);
            const float mean = wave_sum(s) * (1.f / D); float s2 = 0.f;
#pragma unroll
            for (int j = 0; j < 4; ++j)
#pragma unroll
                for (int e = 0; e < 8; ++e) { v[j][e] -= mean; s2 += v[j][e] * v[j][e]; }
            const float rstd = 1.f / sqrtf(wave_sum(s2) * (1.f / D) + LN_EPS);
#pragma unroll
            for (int j = 0; j < 4; ++j) { const int d0 = 8 * F.lane + 512 * j; const f32x4 g0v = *(const GAS f32x4*)(lng + d0), g1v = *(const GAS f32x4*)(lng + d0 + 4), b0 = *(const GAS f32x4*)(lnb + d0), b1 = *(const GAS f32x4*)(lnb + d0 + 4);
                const f32x4 oa = (f32x4){v[j][0] * rstd * g0v.x + b0.x, v[j][1] * rstd * g0v.y + b0.y, v[j][2] * rstd * g0v.z + b0.z, v[j][3] * rstd * g0v.w + b0.w};
                const f32x4 ob = (f32x4){v[j][4] * rstd * g1v.x + b1.x, v[j][5] * rstd * g1v.y + b1.y, v[j][6] * rstd * g1v.z + b1.z, v[j][7] * rstd * g1v.w + b1.w};
                if (l == DEPTH - 1) { *(GAS f32x4*)(a.out + (size_t)tk * D + d0) = oa; *(GAS f32x4*)(a.out + (size_t)tk * D + d0 + 4) = ob; }
                else { v4u w; w.x = pk2(oa.x, oa.y); w.y = pk2(oa.z, oa.w); w.z = pk2(ob.x, ob.y); w.w = pk2(ob.z, ob.w); *(GAS v4u*)(xb + (size_t)tk * D + d0) = w;
                    unsigned lo = 0u, hi = 0u; lo = __builtin_amdgcn_cvt_pk_fp8_f32(oa.x, oa.y, lo, false); lo = __builtin_amdgcn_cvt_pk_fp8_f32(oa.z, oa.w, lo, true); hi = __builtin_amdgcn_cvt_pk_fp8_f32(ob.x, ob.y, hi, false); hi = __builtin_amdgcn_cvt_pk_fp8_f32(ob.z, ob.w, hi, true);
                    v2u qq; qq.x = lo; qq.y = hi; *(GAS v2u*)(F.ws + WS_XQ + (size_t)tk * D + d0) = qq; } }
        }
#undef LN2_LOAD
    }
}

__global__ void __launch_bounds__(NWAVES * 64, 2) fwd_kernel(Args args) {
    extern __shared__ __attribute__((aligned(16))) unsigned char lds[];
    Frame F;
    F.lds = (LAS unsigned char*)lds; F.ldsg = (char*)lds;
    F.tid = threadIdx.x; F.lane = F.tid & 63; F.wave = __builtin_amdgcn_readfirstlane(F.tid >> 6);
    F.G = gridDim.x; F.c = blockIdx.x; F.ws = args.ws; F.ctl = (gu32*)(args.ws + WS_CTL);
    volatile LAS unsigned* MISC = (volatile LAS unsigned*)(F.lds + MISC_OFF);
    for (int u = F.tid; u < (LDS_BYTES - LDSCTL_OFF) / 4; u += NWAVES * 64) ((LAS unsigned*)(F.lds + LDSCTL_OFF))[u] = 0u;
    __syncthreads();
    const int lo = args.ph_lo, hi = args.ph_hi; int lastp = -1;
    const bool multi = (hi - lo) > 1;
    XcdBarrier bar; bar.bar = (unsigned*)(F.ctl + CW_BAR); bar.x = 0; bar.st = nullptr;
    if (multi) bar = xcd_barrier_post((unsigned*)(F.ctl + CW_BAR), MISC + 8);
#ifndef REP_MASK
#define REP_MASK 0
#endif
#define REP(k) for (int rep_ = 0; rep_ <= ((REP_MASK >> (k)) & 1); ++rep_)
#define IN(p) (lo <= (p) && (p) < hi)
#ifdef PROBE_A
#define STAMP(i) do { if (blockIdx.x == 0 && threadIdx.x == 0) ((unsigned long long*)(args.ws + WS_TS))[(i)] = __builtin_amdgcn_s_memrealtime(); } while (0)
#else
#define STAMP(i) do { } while (0)
#endif
#define SEAM(p) do { conv_note_fin(F, (p)); lastp = (p); if ((p) + 1 < hi) xcd_barrier(bar); STAMP((p) + 1); } while (0)
#define CONVFIN() ((lastp >= 0) ? (int)__hip_atomic_load(F.ctl + CW_FIN + 64 * lastp, RLX_AGENT) : 0)
#define FRESH() do { int t_ = threadIdx.x; asm volatile("" : "+v"(t_)); F.tid = t_; F.lane = t_ & 63; F.wave = __builtin_amdgcn_readfirstlane(t_ >> 6); \
    GAS unsigned char* w_ = (GAS unsigned char*)args.ws; asm volatile("" : "+s"(w_)); F.ws = (unsigned char*)w_; F.ctl = (gu32*)(w_ + WS_CTL); } while (0)

    STAMP(0);
    if (IN(0)) { FRESH(); REP(9) prologue_phase(F, args); SEAM(0); }
#ifdef XBAR
    for (int xb_ = 0; xb_ < XBAR; ++xb_) xcd_barrier(bar);
#endif

    for (int l = 0; l < DEPTH; ++l) {
        const int pb = 1 + NPH_LAYER * l;
        if (IN(pb + 0)) { FRESH();
            const int N = (l < 2) ? NINA : (l == 2 ? 5120 : 2048);
            const unsigned char* Bt = F.ws + ((l < 2) ? WS_WAIN + (size_t)l * NINA * D * 2 : (l == 2 ? WS_WBIN0 : WS_WBIN1));
            const int nu = (T / 256) * (N / 256) + (l == 0 ? 16 : 0), ncv = conv_servers(nu, F.G, CONVFIN()), Gc = F.G - ncv; const bool f8 = F8L(l);
            if (F.c < Gc) {
                pg8::EpiBf16X E{l < 2 ? 0 : 1, (bf16*)(F.ws + WS_Z), (bf16*)(F.ws + WS_KD), (bf16*)(F.ws + WS_VD), (bf16*)(F.ws + WS_MEMKV), nullptr, nullptr};
                if (f8) { pg8::Gemm g{nullptr, nullptr, T, N, D / 2}; pg8::DualOrder8 S; S.init(F.ws + WS_XQ, Bt, T, N, D / 2, Gc, F.c, F.ws + WS_MEMQ, F.ws + WS_WMKV, l == 0 ? 16 : 0);
                    REP(0) pg8::gemm_phase<pg8::EpiBf16X, pg8::DualOrder8, true, true>(F.lds + RING_OFF, g, S, E); }
                else { pg8::Gemm g{nullptr, nullptr, T, N, D}; pg8::DualOrder S; S.init(F.ws + WS_XB, Bt, T, N, D, Gc, F.c, F.ws + WS_MEMB, F.ws + WS_WMKV, l == 0 ? 16 : 0);
                    REP(0) pg8::gemm_phase<pg8::EpiBf16X, pg8::DualOrder, true, true>(F.lds + RING_OFF, g, S, E); }
                if (ncv) conv_done(F, pb + 0);
                { const int mine = (nu - 1 - F.c) / Gc + 1, rounds = (nu + Gc - 1) / Gc; conv_filler(F, args, 2 * l, (rounds - mine) * (f8 ? (QA + 1) / 2 : QA)); }
            } else conv_server(F, args, pb + 0, 2 * l, Gc);
            SEAM(pb + 0);
        }
        if (IN(pb + 1)) { FRESH();
            if (l < 2) {
                REP(1) for (int u = F.c; u < 256 + 128; u += F.G) {
                    if (u < 256) sgu_unit(F, args, l, u >> 2, u & 3);
                    else { const int r = u - 256; memattn_unit(F, l, r & 3, r >> 2, NINA, 2 * MIXW); }
                }
                if (F.c >= 128) conv_filler(F, args, 2 * l, QX);
            } else {
                const int ncv = CONVFIN() ? 0 : NCVATT;
                if (F.c >= F.G - ncv) { conv_server_q(F, args, F.ctl + CW_Q + 64 * l, (unsigned)(att2::NUNITS + 128 - STOPU), 2 * l); __syncthreads(); }
                REP(2) { gu32* qh = F.ctl + CW_Q + 64 * l + 16 * rep_; LAS unsigned* uw = (LAS unsigned*)(F.lds + att2::LDS_UNIT);
                for (;;) {
                    if (F.tid == 0) *uw = __hip_atomic_fetch_add(qh, 1u, RLX_AGENT);
                    __syncthreads();
                    const unsigned idx = *uw;
                    __syncthreads();
                    if (idx >= (unsigned)(att2::NUNITS + 128)) break;
                    if (idx < (unsigned)att2::NUNITS) diffattn2_unit(F, args, att2::g_units.u[idx]);
                    else { const int r = (int)idx - att2::NUNITS; memattn_unit(F, l, r & 3, r >> 2, 2048, MIXW); }
                } }
            }
            SEAM(pb + 1);
        }
        if (IN(pb + 2) && l >= 2) { FRESH(); REP(3) diffcombine_phase(F, args, l); SEAM(pb + 2); }
        if (IN(pb + 3)) { FRESH();
            pg8::EpiResBf16 E{(const bf16*)(F.ws + WS_XB), (bf16*)(F.ws + WS_Y), DN_ALPHA};
            const unsigned char* Wo = F.ws + (l < 2 ? WS_WAOUT + (size_t)l * D * D * 2 : WS_WBOUT + (size_t)(l - 2) * D * D * 2);
            if (F8OL(l)) { pg8::Gemm g{nullptr, nullptr, T, D, D / 2}; pg8::DenseOrder8 S; S.init(F.ws + WS_CATQ, Wo, T, D, D / 2, F.G, F.c);
                REP(4) pg8::gemm_phase<pg8::EpiResBf16, pg8::DenseOrder8, true, true>(F.lds + RING_OFF, g, S, E); }
            else { pg8::Gemm g{nullptr, nullptr, T, D, D}; pg8::DenseOrder S; S.init(F.ws + WS_CAT, Wo, T, D, D, F.G, F.c);
                REP(4) pg8::gemm_phase<pg8::EpiResBf16, pg8::DenseOrder, true, true>(F.lds + RING_OFF, g, S, E); }
            SEAM(pb + 3);
        }
        if (IN(pb + 4)) { FRESH(); ln1_router_phase(F, args, l);
#ifdef REP_LN1
            ln1_router_phase(F, args, l, 1);
#endif
            conv_filler(F, args, 2 * l, -1); SEAM(pb + 4); }
        if (IN(pb + 6)) { FRESH();
            moe_table(F, l);
            const LAS int* tb = (const LAS int*)(F.lds + TAB_OFF);
            const int nu = tb[32] * 4, ncv = conv_servers(nu, F.G, CONVFIN()), Gc = F.G - ncv;
            if (F.c < Gc) {
                pg8::Gemm g{nullptr, nullptr, SLOTS, 1024, D / 2};
                pg8::MoeGatherOrder S{tb, tb + 36, (const int*)(F.ws + WS_LIST), 4, Gc, F.c, (const char*)(F.ws + WS_X1F), (const char*)(F.ws + WS_W13) + (size_t)l * NE * 1024 * 2048, (size_t)1024 * 2048, (size_t)256 * 2048, (unsigned)D};
                pg8::EpiMoe1 E{(bf16*)(F.ws + WS_H), tb, tb + 36};
                REP(6) pg8::gemm_phase<pg8::EpiMoe1, pg8::MoeGatherOrder, true, true>(F.lds + RING_OFF, g, S, E);
                if (ncv) conv_done(F, pb + 6);
                { const int mine = (F.c < nu) ? (nu - 1 - F.c) / Gc + 1 : 0, rounds = (nu + Gc - 1) / Gc; conv_filler(F, args, 2 * l + 1, (rounds - mine) * QM); }
            } else conv_server(F, args, pb + 6, 2 * l + 1, Gc);
            SEAM(pb + 6);
        }
        if (IN(pb + 7)) { FRESH();
            moe_table(F, l);
            const int nu = ((const LAS int*)(F.lds + TAB_OFF))[32] * 8, ncv = conv_servers(nu, F.G, CONVFIN()), Gc = F.G - ncv;
            if (F.c < Gc) {
                pg8::Gemm g{nullptr, nullptr, SLOTS, D, FF / 2};
                pg8::MoeOrder8 S{(const PG8_LAS int*)(F.lds + TAB_OFF), 8, Gc, F.c, (const char*)(F.ws + WS_H), (const char*)(F.ws + WS_W2) + (size_t)l * NE * 2048 * 512, (size_t)256 * FF, (size_t)2048 * 512, (size_t)256 * 512};
                pg8::EpiBf16X E{3, (bf16*)(F.ws + WS_YB), nullptr, nullptr, nullptr, (const PG8_LAS int*)(F.lds + TAB_OFF), (const PG8_LAS int*)(F.lds + TAB_OFF) + 36};
                REP(7) pg8::gemm_phase<pg8::EpiBf16X, pg8::MoeOrder8, true, true>(F.lds + RING_OFF, g, S, E);
                if (ncv) conv_done(F, pb + 7);
                { const int mine = (F.c < nu) ? (nu - 1 - F.c) / Gc + 1 : 0, rounds = (nu + Gc - 1) / Gc; conv_filler(F, args, 2 * l + 1, (rounds - mine) * QB); }
            } else conv_server(F, args, pb + 7, 2 * l + 1, Gc);
            SEAM(pb + 7);
        }
        if (IN(pb + 8)) { FRESH(); REP(8) ln2_phase(F, args, l); conv_filler(F, args, 2 * l + 1, -1); SEAM(pb + 8); }
    }
#ifdef PROBE_A
    {
        VM_WAIT(); xcd_barrier(bar);
        const unsigned long long* ts = (const unsigned long long*)(args.ws + WS_TS);
        float da = 0.f, db = 0.f;
        for (int p = 0; p < NPHASES; ++p) { const int k = (p == 0) ? 9 : (p - 1) % NPH_LAYER; const float d = (float)(ts[p + 1] - ts[p]);
            if (k == PROBE_A || PROBE_A == 10) da += d; if (k == PROBE_B || PROBE_B == 10) db += d; }
        const float kk = sqrtf(da), vv = db;
        float* o = args.out; const long n = (long)T * D;
        for (long i = (long)blockIdx.x * 512 + threadIdx.x; i < n; i += (long)gridDim.x * 512) o[i] = (i == 0) ? vv : kk;
    }
#endif
#undef IN
#undef SEAM
}

#ifndef MK_ONE_LAUNCH
#define MK_ONE_LAUNCH 1
#endif
extern "C" void kernel_launch(void* const* d_in, const int* in_sizes, int n_in, void* d_out, int out_size, void* d_ws, size_t ws_size, hipStream_t stream) {
    static int grid = 0;
    if (grid == 0) {
        if (n_in != 24 || in_sizes[0] != T * D || out_size != T * D || ws_size < WS_END) { fprintf(stderr, "kernel_launch: unexpected shapes (n_in %d, in0 %d, out %d, ws %zu < %zu)\n", n_in, n_in > 0 ? in_sizes[0] : -1, out_size, ws_size, (size_t)WS_END); grid = -1; return; }
        int dev = 0, cus = 0, per_cu = 0;
        if (hipGetDevice(&dev) != hipSuccess || hipDeviceGetAttribute(&cus, hipDeviceAttributeMultiprocessorCount, dev) != hipSuccess) { grid = -1; return; }
        if (hipFuncSetAttribute((const void*)fwd_kernel, hipFuncAttributeMaxDynamicSharedMemorySize, LDS_BYTES) != hipSuccess) { fprintf(stderr, "kernel_launch: hipFuncSetAttribute failed\n"); grid = -1; return; }
        if (hipOccupancyMaxActiveBlocksPerMultiprocessor(&per_cu, (const void*)fwd_kernel, NWAVES * 64, LDS_BYTES) != hipSuccess || per_cu < 1) fprintf(stderr, "kernel_launch: occupancy query reports %d\n", per_cu);
        (void)hipGetLastError();
        grid = cus;
    }
    if (grid < 0) return;
    if (hipMemsetAsync((char*)d_ws + WS_CTL, 0, CTL_ZERO_BYTES, stream) != hipSuccess) return;
    Args a{};
    for (int i = 0; i < 24; ++i) a.in[i] = (const float*)d_in[i];
    a.out = (float*)d_out; a.ws = (unsigned char*)d_ws;
#if MK_ONE_LAUNCH
    a.ph_lo = 0; a.ph_hi = NPHASES;
    hipLaunchKernelGGL(fwd_kernel, dim3(grid), dim3(NWAVES * 64), LDS_BYTES, stream, a);
#else
    for (int p = 0; p < NPHASES; ++p) {
        const int k = (p - 1) % NPH_LAYER, l = (p - 1) / NPH_LAYER;
        if (p > 0 && k == 2 && l < 2) continue;
        a.ph_lo = p; a.ph_hi = p + 1;
        hipLaunchKernelGGL(fwd_kernel, dim3(grid), dim3(NWAVES * 64), LDS_BYTES, stream, a);
    }
#endif
    const hipError_t le = hipPeekAtLastError();
    if (le != hipSuccess) fprintf(stderr, "kernel_launch: launch failed: %s\n", hipGetErrorName(le));
}
```

```cpp
#define F8MASK 12
#define F8OMASK 12
#include <hip/hip_runtime.h>
#include <cstdio>
#include <cstdint>
namespace pg8 {
#define PG8_LAS __attribute__((address_space(3)))
typedef unsigned short bf16_t;
typedef short bf16x8 __attribute__((ext_vector_type(8)));
typedef float f32x4 __attribute__((ext_vector_type(4)));
typedef unsigned u32x4 __attribute__((ext_vector_type(4)));
constexpr int BM = 256, BK = 64, HALF = 128, HTB = HALF * BK * 2  , STAGE_BYTES = 8 * HTB, NXCD = 8, WGM = 8;

__host__ __device__ __forceinline__ int lds_byte(int r, int c) { const int st = (r >> 4) * 2 + (c >> 5), rr = r & 15, cc = c & 31, ob = rr * 64 + cc * 2; return st * 1024 + (ob ^ (((ob >> 9) & 1) << 5)); }
__host__ __device__ __forceinline__ void stage_rc(int b, int& R, int& C) { const int st = b / 1024, sb = b % 1024, swz = sb ^ (((sb >> 9) & 1) << 5); R = (st >> 1) * 16 + swz / 64; C = (st & 1) * 32 + (swz % 64) / 2; }
__host__ __device__ __forceinline__ int perm32(int rho) { const int n = rho >> 4, i = rho & 15; return 8 * (i >> 2) + 4 * n + (i & 3); }

typedef int pg8_v4i __attribute__((ext_vector_type(4))); typedef int pg8_v8i __attribute__((ext_vector_type(8)));
__device__ __forceinline__ pg8_v8i pg8_cat8(bf16x8 a, bf16x8 b) { return __builtin_shufflevector(__builtin_bit_cast(pg8_v4i, a), __builtin_bit_cast(pg8_v4i, b), 0, 1, 2, 3, 4, 5, 6, 7); }
struct Unit { int pm, pn, e; };
struct Gemm { const bf16_t* A; const bf16_t* Bt; int M, N, K; };

struct StaticOrder {
    static constexpr bool GATHER = false, F8 = false; static constexpr int SCALE_B = 127;
    int nM, nN, nwg, G, c;
    __host__ __device__ void init(int M, int N, int G_, int c_) { nM = M / BM; nN = N / BM; nwg = nM * nN; G = G_; c = c_; }
    __host__ __device__ bool next(int i, Unit& u) const {
        const long L = (long)i * G + c; if (L >= nwg) return false;
        int wgid = (int)L; { const int q = nwg / NXCD, r = nwg % NXCD, xcd = wgid % NXCD, off = wgid / NXCD; wgid = (xcd < r ? xcd * (q + 1) : r * (q + 1) + (xcd - r) * q) + off; }
        const int nig = WGM * nN, gid = wgid / nig, fm = gid * WGM, gsz = (nM - fm) < WGM ? (nM - fm) : WGM;
        u.pm = fm + ((wgid % nig) % gsz); u.pn = (wgid % nig) / gsz; return true;
    }
    __device__ __forceinline__ void a_ready(const Unit&) const {}
    __device__ __forceinline__ void done(const Unit&) const {}
};

__device__ __forceinline__ unsigned cvt_pk_bf16(float lo, float hi) { unsigned r; asm volatile("v_cvt_pk_bf16_f32 %0, %1, %2" : "=v"(r) : "v"(lo), "v"(hi)); return r; }
typedef float f32x2 __attribute__((ext_vector_type(2)));
__device__ __forceinline__ f32x2 gelu_pk(f32x2 v) {
    const f32x2 av = __builtin_elementwise_abs(v), d = av * 0.2316418882f + 1.0f;
    f32x2 t; t.x = __builtin_amdgcn_rcpf(d.x); t.y = __builtin_amdgcn_rcpf(d.y);
    f32x2 q = t * 0.5307027145f + (-0.7265760135f); q = q * t + 0.7107068705f; q = q * t + (-0.142248368f); q = q * t + 0.127414796f; q = q * t;
    const f32x2 s = (v * v) * (-0.72134752044f);
    f32x2 e; e.x = __builtin_amdgcn_exp2f(s.x); e.y = __builtin_amdgcn_exp2f(s.y);
    const f32x2 m = v * (q * e), r = v - m;
    f32x2 o; o.x = v.x < 0.f ? m.x : r.x; o.y = v.y < 0.f ? m.y : r.y; return o;
}

template <class Epi, class Sched, bool ALIGN_EPI = false, bool SP2 = false>
__device__ __forceinline__ void gemm_phase(PG8_LAS unsigned char* lds, const Gemm g, const Sched& S, const Epi& E) {
    int tid_ = threadIdx.x; asm volatile("" : "+v"(tid_));
    const int tid = tid_, wid = __builtin_amdgcn_readfirstlane(tid >> 6), lane = tid & 63, wr = wid >> 2, wc = wid & 3, fr = lane & 15, fq = lane >> 4;
    const int K = g.K, nt = K / BK;
    unsigned voffA[2], voffB[2];
#pragma unroll
    for (int i = 0; i < 2; ++i) { int R, C; stage_rc(tid * 16 + i * 8192, R, C); const int Rb = Epi::PERM ? ((R & ~31) + perm32(R & 31)) : R;
        voffA[i] = (unsigned)(R * K + C) * 2u; voffB[i] = (unsigned)(Rb * K + C) * 2u; }
    unsigned vAc[2][2], vAn[2][2];
    int gR[2], gC[2];
#pragma unroll
    for (int i = 0; i < 2; ++i) { stage_rc(tid * 16 + i * 8192, gR[i], gC[i]); }
    const size_t kstep = (size_t)(BK * 2);
    const size_t hstep = (size_t)HALF * K * 2;
        const unsigned ldsw = (unsigned)wid * 1024u;
    const int aoff = lds_byte(wr * 64 + fr, fq * 8), boff = lds_byte(wc * 32 + fr, fq * 8);
#define PG8_SA(b, h) (((b) * 2 + (h)) * HTB)
#define PG8_SB(b, h) ((4 + (b) * 2 + (h)) * HTB)
#define PG8_STAGE(bufoff, gbase, voff) do { _Pragma("unroll") for (int _i = 0; _i < 2; ++_i) \
        __builtin_amdgcn_global_load_lds((const unsigned*)((const char*)(gbase) + (voff)[_i]), (PG8_LAS unsigned*)(lds + (bufoff) + ldsw + _i * 8192), 16, 0, 0); } while (0)
#define PG8_STAGE_A(b, h, base, VS) do { if constexpr (Sched::GATHER) { PG8_STAGE(PG8_SA(b, h), base, VS[h]); } else { PG8_STAGE(PG8_SA(b, h), (base) + (h) * hstep, voffA); } } while (0)
#define PG8_STAGE_AN(b, h, base) do { if constexpr (Sched::GATHER) { unsigned vs_[2] = {last ? vAn[h][0] : vAc[h][0], last ? vAn[h][1] : vAc[h][1]}; PG8_STAGE(PG8_SA(b, h), base, vs_); } else { PG8_STAGE(PG8_SA(b, h), (base) + (h) * hstep, voffA); } } while (0)
#define PG8_LDA(dst, b, h) do { if constexpr (Sched::F8) { _Pragma("unroll") for (int m = 0; m < 4; ++m) { dst##8[m].lo = *(const PG8_LAS pg8_v4i*)(lds + PG8_SA(b, h) + aoff + m * 2048); dst##8[m].hi = *(const PG8_LAS pg8_v4i*)(lds + PG8_SA(b, h) + aoff + m * 2048 + 1024); } } \
        else { _Pragma("unroll") for (int m = 0; m < 4; ++m) _Pragma("unroll") for (int k = 0; k < 2; ++k) dst[m][k] = *(const PG8_LAS bf16x8*)(lds + PG8_SA(b, h) + aoff + m * 2048 + k * 1024); } } while (0)
#define PG8_LDB(dst, b, h) do { if constexpr (Sched::F8) { _Pragma("unroll") for (int n = 0; n < 2; ++n) { dst##8[n].lo = *(const PG8_LAS pg8_v4i*)(lds + PG8_SB(b, h) + boff + n * 2048); dst##8[n].hi = *(const PG8_LAS pg8_v4i*)(lds + PG8_SB(b, h) + boff + n * 2048 + 1024); } } \
        else { _Pragma("unroll") for (int n = 0; n < 2; ++n) _Pragma("unroll") for (int k = 0; k < 2; ++k) dst[n][k] = *(const PG8_LAS bf16x8*)(lds + PG8_SB(b, h) + boff + n * 2048 + k * 1024); } } while (0)
#define PG8_MMA(ai, bj, At, Bt) do { __builtin_amdgcn_s_setprio(1); if constexpr (Sched::F8) { \
        _Pragma("unroll") for (int m = 0; m < 4; ++m) _Pragma("unroll") for (int n = 0; n < 2; ++n) \
            asm volatile("v_mfma_scale_f32_16x16x128_f8f6f4 %0, %1, %2, %0, %3, %4 op_sel_hi:[0,0,0]" : "+v"(acc[ai][bj][m][n]) : "v"(Bt##8[n]), "v"(At##8[m]), "v"(sclB_), "v"(sclA_));     \
        } else { _Pragma("unroll") for (int m = 0; m < 4; ++m) _Pragma("unroll") for (int n = 0; n < 2; ++n) _Pragma("unroll") for (int k = 0; k < 2; ++k) \
        acc[ai][bj][m][n] = __builtin_amdgcn_mfma_f32_16x16x32_bf16(Bt[n][k], At[m][k], acc[ai][bj][m][n], 0, 0, 0); } __builtin_amdgcn_s_setprio(0); } while (0)
#define PG8_WAIT_V(n) asm volatile("s_waitcnt vmcnt(" #n ")" ::: "memory")
#define PG8_WAIT_L(n) asm volatile("s_waitcnt lgkmcnt(" #n ")" ::: "memory")
#define PG8_BAR __builtin_amdgcn_s_barrier()
#define PG8_SCHED __builtin_amdgcn_sched_barrier(0)
    Unit cur, nxt; int ui = 0;
    if (!S.next(0, cur)) return;
    f32x4 acc[2][2][4][2];
#pragma unroll
    for (int a = 0; a < 2; ++a)
#pragma unroll
        for (int b = 0; b < 2; ++b)
#pragma unroll
            for (int m = 0; m < 4; ++m)
#pragma unroll
                for (int n = 0; n < 2; ++n) acc[a][b][m][n] = (f32x4){0.f, 0.f, 0.f, 0.f};
    const int sclB_ = Sched::SCALE_B, sclA_ = 127;
    bf16x8 At[4][2], B0[2][2], B1[2][2]; pg8_v8i At8[4], B08[2], B18[2];
    const char* cA = S.aptr(cur); const char* cB = S.bptr(cur);
    S.a_ready(cur);
    if constexpr (Sched::GATHER) {
#pragma unroll
        for (int h = 0; h < 2; ++h)
#pragma unroll
            for (int i = 0; i < 2; ++i) { vAc[h][i] = S.rowoff(cur, h * HALF + gR[i]) + (unsigned)gC[i] * 2u; vAn[h][i] = vAc[h][i]; }
        asm volatile("s_waitcnt vmcnt(0)" ::: "memory");
    }
    if constexpr (SP2) {
        PG8_STAGE(PG8_SB(0, 0), cB, voffB); PG8_STAGE(PG8_SB(0, 1), cB + hstep, voffB); PG8_STAGE_A(0, 0, cA, vAc); PG8_STAGE_A(0, 1, cA, vAc);
        if (wr == 1) PG8_BAR;
        PG8_WAIT_V(2); PG8_BAR;
        PG8_STAGE(PG8_SB(1, 0), cB + kstep, voffB); PG8_STAGE_A(1, 0, cA + kstep, vAc); PG8_STAGE(PG8_SB(1, 1), cB + hstep + kstep, voffB);
        PG8_WAIT_V(6); PG8_BAR;
    } else {
        PG8_STAGE(PG8_SB(0, 0), cB, voffB); PG8_STAGE_A(0, 0, cA, vAc); PG8_STAGE(PG8_SB(0, 1), cB + hstep, voffB); PG8_STAGE_A(0, 1, cA, vAc);
        if (wr == 1) PG8_BAR;
        PG8_WAIT_V(4); PG8_BAR;
        PG8_STAGE(PG8_SB(1, 0), cB + kstep, voffB); PG8_STAGE_A(1, 0, cA + kstep, vAc); PG8_STAGE(PG8_SB(1, 1), cB + hstep + kstep, voffB);
        PG8_WAIT_V(6); PG8_BAR;
    }
    for (;;) {
        const bool has_next = S.next(ui + 1, nxt);
        const char* nA = has_next ? S.aptr(nxt) : cA; const char* nB = has_next ? S.bptr(nxt) : cB;
        if constexpr (Sched::GATHER) { if (has_next) {
#pragma unroll
            for (int h = 0; h < 2; ++h)
#pragma unroll
                for (int i = 0; i < 2; ++i) vAn[h][i] = S.rowoff(nxt, h * HALF + gR[i]) + (unsigned)gC[i] * 2u; } }
        for (int t = 0; t < nt; t += 2) {
            const bool last = (t == nt - 2);
            const char* a1 = cA + (size_t)(t + 1) * kstep;
            const char* a2 = last ? nA : cA + (size_t)(t + 2) * kstep; const char* b2 = last ? nB : cB + (size_t)(t + 2) * kstep;
            const char* a3 = a2 + kstep; const char* b3 = b2 + kstep;
            if (last && has_next) S.a_ready(nxt);
            if constexpr (SP2) {
            PG8_LDB(B0, 0, 0); PG8_LDB(B1, 0, 1); PG8_SCHED; PG8_LDA(At, 0, 0); PG8_STAGE_A(1, 1, a1, vAc);
            PG8_WAIT_V(8); PG8_WAIT_L(0); PG8_BAR; PG8_MMA(0, 0, At, B0); PG8_MMA(0, 1, At, B1); PG8_BAR; PG8_SCHED;
            PG8_LDA(At, 0, 1); PG8_STAGE(PG8_SB(0, 0), b2, voffB); PG8_STAGE(PG8_SB(0, 1), b2 + hstep, voffB); PG8_STAGE_AN(0, 0, a2);
            PG8_WAIT_V(8); PG8_WAIT_L(0); PG8_BAR; PG8_MMA(1, 0, At, B0); PG8_MMA(1, 1, At, B1); PG8_BAR; PG8_SCHED;
            PG8_LDB(B0, 1, 0); PG8_LDB(B1, 1, 1); PG8_SCHED; PG8_LDA(At, 1, 0); PG8_STAGE_AN(0, 1, a2);
            PG8_WAIT_V(8); PG8_WAIT_L(0); PG8_BAR; PG8_MMA(0, 0, At, B0); PG8_MMA(0, 1, At, B1); PG8_BAR; PG8_SCHED;
            PG8_LDA(At, 1, 1); PG8_STAGE(PG8_SB(1, 0), b3, voffB); PG8_STAGE(PG8_SB(1, 1), b3 + hstep, voffB); PG8_STAGE_AN(1, 0, a3);
            PG8_WAIT_V(8); PG8_WAIT_L(0); PG8_BAR; PG8_MMA(1, 0, At, B0); PG8_MMA(1, 1, At, B1); PG8_BAR; PG8_SCHED;
            } else {
            PG8_LDB(B0, 0, 0); PG8_SCHED; PG8_LDA(At, 0, 0); PG8_STAGE_A(1, 1, a1, vAc);
            PG8_WAIT_L(8); PG8_BAR; PG8_WAIT_L(0); PG8_MMA(0, 0, At, B0); PG8_BAR; PG8_SCHED;
            PG8_LDB(B1, 0, 1); PG8_STAGE(PG8_SB(0, 0), b2, voffB);
            PG8_BAR; PG8_WAIT_L(0); PG8_MMA(0, 1, At, B1); PG8_BAR;
            PG8_LDA(At, 0, 1); PG8_STAGE_AN(0, 0, a2);
            PG8_BAR; PG8_WAIT_L(0); PG8_MMA(1, 0, At, B0); PG8_BAR; PG8_SCHED;
            PG8_STAGE(PG8_SB(0, 1), b2 + hstep, voffB);
            PG8_WAIT_V(6); PG8_BAR; PG8_MMA(1, 1, At, B1); PG8_BAR;
            PG8_LDB(B0, 1, 0); PG8_SCHED; PG8_LDA(At, 1, 0); PG8_STAGE_AN(0, 1, a2);
            PG8_WAIT_L(8); PG8_BAR; PG8_WAIT_L(0); PG8_MMA(0, 0, At, B0); PG8_BAR; PG8_SCHED;
            PG8_LDB(B1, 1, 1); PG8_STAGE(PG8_SB(1, 0), b3, voffB);
            PG8_BAR; PG8_WAIT_L(0); PG8_MMA(0, 1, At, B1); PG8_BAR;
            PG8_LDA(At, 1, 1); PG8_STAGE_AN(1, 0, a3);
            PG8_BAR; PG8_WAIT_L(0); PG8_MMA(1, 0, At, B0); PG8_BAR; PG8_SCHED;
            PG8_STAGE(PG8_SB(1, 1), b3 + hstep, voffB);
            PG8_WAIT_V(6); PG8_BAR; PG8_MMA(1, 1, At, B1); PG8_BAR;
            }
        }
        if constexpr (ALIGN_EPI) { if (wr == 0) PG8_BAR; }
        if constexpr (!Epi::AFTER_DRAIN) { E(acc, cur, wr, wc, fr, fq); S.done(cur); }
        if (!has_next) break;
#pragma unroll
        for (int a = 0; a < 2; ++a)
#pragma unroll
            for (int b = 0; b < 2; ++b)
#pragma unroll
                for (int m = 0; m < 4; ++m)
#pragma unroll
                    for (int n = 0; n < 2; ++n) acc[a][b][m][n] = (f32x4){0.f, 0.f, 0.f, 0.f};
        cur = nxt; cA = nA; cB = nB; ++ui;
        if constexpr (Sched::GATHER) {
#pragma unroll
            for (int h = 0; h < 2; ++h)
#pragma unroll
                for (int i = 0; i < 2; ++i) vAc[h][i] = vAn[h][i]; }
        if constexpr (ALIGN_EPI) { if (wr == 1) PG8_BAR; }
    }
    PG8_WAIT_V(0);
    if constexpr (!ALIGN_EPI) { if (wr == 0) PG8_BAR; }
    PG8_BAR;
    if constexpr (Epi::AFTER_DRAIN) { E.fused(acc, cur, wr, wc, fr, fq, lds, wid, lane); S.done(cur); }
#undef PG8_SA
#undef PG8_SB
#undef PG8_STAGE
#undef PG8_STAGE_A
#undef PG8_STAGE_AN
#undef PG8_LDA
#undef PG8_LDB
#undef PG8_MMA
#undef PG8_WAIT_V
#undef PG8_WAIT_L
#undef PG8_BAR
#undef PG8_SCHED
}
}

constexpr int T = 8192, D = 2048, MIXW = 1536, MEMW = 512, NINA = 3584, DEPTH = 4, NE = 32, FF = 512, MEMT = 256;
constexpr int SLOTS = 24576;
constexpr float LN_EPS = 1e-5f;
constexpr float DN_ALPHA = 1.6817928305074292f;
constexpr float LOG2E = 1.4426950408889634f;
constexpr float QSCALE = 0.08838834764831845f * LOG2E;
constexpr int NWAVES = 8;

constexpr size_t MiB = 1u << 20;
constexpr size_t WS_CTL = 0, CTL_ZERO_BYTES = 1 * MiB;
constexpr size_t WS_WAIN = 2 * MiB, WS_WAOUT = 30 * MiB, WS_WBIN0 = 46 * MiB, WS_WKV = 54 * MiB, WS_WBIN1 = 66 * MiB, WS_WBOUT = 74 * MiB, WS_WMKV = 90 * MiB;
constexpr size_t WS_W13 = 106 * MiB, WS_W2 = 618 * MiB;
constexpr size_t WS_XB = 874 * MiB, WS_MEMB = 906 * MiB, WS_MEMKV = 907 * MiB, WS_Z = 910 * MiB, WS_KD = 966 * MiB, WS_VD = 990 * MiB, WS_CAT = 1014 * MiB;
constexpr size_t WS_XQ = 1206 * MiB, WS_ZQ = 1222 * MiB, WS_MEMQ = 1238 * MiB, WS_CATQ = 1246 * MiB;
constexpr size_t WS_Y = 1046 * MiB, WS_X1F = 1110 * MiB, WS_X1B = 1174 * MiB, WS_XF = 1206 * MiB, WS_XG = 1270 * MiB, WS_H = 1366 * MiB, WS_YB = 1390 * MiB, WS_OP = 1486 * MiB;
constexpr size_t WS_ROUTE = 1582 * MiB, WS_OP2 = 1583 * MiB, WS_ML = 1631 * MiB, WS_WR = 1634 * MiB, WS_TS = 1640 * MiB, WS_LIST = 1641 * MiB, WS_END = 1642 * MiB;
constexpr int CW_TMO = 0, CW_BAR = 4096, CW_CNT = 16384, CW_Q = 28672, CW_CONV = 29184, CW_DONE = 32768, CW_FIN = 40960;

constexpr int RING_OFF = 0, RING_BYTES = 131072;
constexpr int LDSCTL_OFF = 146432, MISC_OFF = LDSCTL_OFF + 320, TAB_OFF = LDSCTL_OFF + 512;
constexpr int LDS_BYTES = 147456;

#define GAS __attribute__((address_space(1)))
#define LAS __attribute__((address_space(3)))
typedef unsigned short bf16;
typedef unsigned v4u __attribute__((ext_vector_type(4)));
typedef unsigned v2u __attribute__((ext_vector_type(2)));
typedef float f32x4 __attribute__((ext_vector_type(4)));
typedef short bf16x8 __attribute__((ext_vector_type(8)));
typedef GAS unsigned gu32;
#define RLX_AGENT __ATOMIC_RELAXED, __HIP_MEMORY_SCOPE_AGENT
#define LDS_WAIT() asm volatile("s_waitcnt lgkmcnt(0)" ::: "memory")
#define VM_WAIT() asm volatile("s_waitcnt vmcnt(0)" ::: "memory")
__device__ __forceinline__ unsigned f2bf(float f) { unsigned u = __builtin_bit_cast(unsigned, f); return (u + 0x7fffu + ((u >> 16) & 1u)) >> 16; }
__device__ __forceinline__ unsigned pk2(float lo, float hi) { return f2bf(lo) | (f2bf(hi) << 16); }
__device__ __forceinline__ float bf2f(unsigned short b) { return __builtin_bit_cast(float, (unsigned)b << 16); }
__device__ __forceinline__ float bflo(unsigned w) { return __builtin_bit_cast(float, w << 16); }
__device__ __forceinline__ float bfhi(unsigned w) { return __builtin_bit_cast(float, w & 0xffff0000u); }
__device__ __forceinline__ float wave_sum(float v) {
#pragma unroll
    for (int o = 1; o < 64; o <<= 1) v += __shfl_xor(v, o);
    return v;
}

namespace pg8 {
struct DenseOrder {
    static constexpr bool GATHER = false, F8 = false; static constexpr int SCALE_B = 127;
    StaticOrder so; const char* A; const char* B; size_t astep, bstep;
    __device__ void init(const void* A_, const void* B_, int M, int N, int K, int G, int c) { so.init(M, N, G, c); A = (const char*)A_; B = (const char*)B_; astep = (size_t)256 * K * 2; bstep = astep; }
    __device__ __forceinline__ bool next(int i, Unit& u) const { u.e = 0; return so.next(i, u); }
    __device__ __forceinline__ const char* aptr(const Unit& u) const { return A + (size_t)u.pm * astep; }
    __device__ __forceinline__ const char* bptr(const Unit& u) const { return B + (size_t)u.pn * bstep; }
    __device__ __forceinline__ void a_ready(const Unit&) const {}
    __device__ __forceinline__ void done(const Unit&) const {}
};
struct DenseOrder8 {
    static constexpr bool GATHER = false, F8 = true; static constexpr int SCALE_B = 121;
    StaticOrder so; const char* A; const char* B; size_t astep, bstep;
    __device__ void init(const void* A_, const void* B_, int M, int N, int K, int G, int c) { so.init(M, N, G, c); A = (const char*)A_; B = (const char*)B_; astep = (size_t)256 * K * 2; bstep = astep; }
    __device__ __forceinline__ bool next(int i, Unit& u) const { u.e = 0; return so.next(i, u); }
    __device__ __forceinline__ const char* aptr(const Unit& u) const { return A + (size_t)u.pm * astep; }
    __device__ __forceinline__ const char* bptr(const Unit& u) const { return B + (size_t)u.pn * bstep; }
    __device__ __forceinline__ void a_ready(const Unit&) const {}
    __device__ __forceinline__ void done(const Unit&) const {}
};
struct DualOrder {
    static constexpr bool GATHER = false, F8 = false; static constexpr int SCALE_B = 127;
    StaticOrder so; int nwg2; const char* A; const char* B; const char* A2; const char* B2; size_t step;
    __device__ void init(const void* A_, const void* B_, int M, int N, int K, int G, int c, const void* A2_, const void* B2_, int nwg2_) { so.init(M, N, G, c); A = (const char*)A_; B = (const char*)B_; A2 = (const char*)A2_; B2 = (const char*)B2_; nwg2 = nwg2_; step = (size_t)256 * K * 2; }
    __device__ __forceinline__ bool next(int i, Unit& u) const { const int L = i * so.G + so.c; if (L < so.nwg) { u.e = 0; return so.next(i, u); } if (L - so.nwg >= nwg2) return false; u.e = 1; u.pm = 0; u.pn = L - so.nwg; return true; }
    __device__ __forceinline__ const char* aptr(const Unit& u) const { return u.e ? A2 : A + (size_t)u.pm * step; }
    __device__ __forceinline__ const char* bptr(const Unit& u) const { return (u.e ? B2 : B) + (size_t)u.pn * step; }
    __device__ __forceinline__ void a_ready(const Unit&) const {}
    __device__ __forceinline__ void done(const Unit&) const {}
};
struct DualOrder8 {
    static constexpr bool GATHER = false, F8 = true; static constexpr int SCALE_B = 121;
    StaticOrder so; int nwg2; const char* A; const char* B; const char* A2; const char* B2; size_t step;
    __device__ void init(const void* A_, const void* B_, int M, int N, int K, int G, int c, const void* A2_, const void* B2_, int nwg2_) { so.init(M, N, G, c); A = (const char*)A_; B = (const char*)B_; A2 = (const char*)A2_; B2 = (const char*)B2_; nwg2 = nwg2_; step = (size_t)256 * K * 2; }
    __device__ __forceinline__ bool next(int i, Unit& u) const { const int L = i * so.G + so.c; if (L < so.nwg) { u.e = 0; return so.next(i, u); } if (L - so.nwg >= nwg2) return false; u.e = 1; u.pm = 0; u.pn = L - so.nwg; return true; }
    __device__ __forceinline__ const char* aptr(const Unit& u) const { return u.e ? A2 : A + (size_t)u.pm * step; }
    __device__ __forceinline__ const char* bptr(const Unit& u) const { return (u.e ? B2 : B) + (size_t)u.pn * step; }
    __device__ __forceinline__ void a_ready(const Unit&) const {}
    __device__ __forceinline__ void done(const Unit&) const {}
};
struct MoeOrder {
    static constexpr bool GATHER = false, F8 = false; static constexpr int SCALE_B = 127;
    const PG8_LAS int* tstart; int ntn, G, c; const char* A; const char* W; size_t astep, wexp, wtile;
    __device__ __forceinline__ bool next(int i, Unit& u) const {
        const int L = i * G + c, total = tstart[32] * ntn; if (L >= total) return false;
        int wgid; { const int q = total / NXCD, r = total % NXCD, xcd = L % NXCD, off = L / NXCD; wgid = (xcd < r ? xcd * (q + 1) : r * (q + 1) + (xcd - r) * q) + off; }
        u.pm = wgid / ntn; u.pn = wgid - u.pm * ntn; int e = 0;
#pragma unroll
        for (int k = 1; k <= 31; ++k) e += (tstart[k] <= u.pm) ? 1 : 0;
        u.e = e; return true;
    }
    __device__ __forceinline__ const char* aptr(const Unit& u) const { return A + (size_t)u.pm * astep; }
    __device__ __forceinline__ const char* bptr(const Unit& u) const { return W + (size_t)u.e * wexp + (size_t)u.pn * wtile; }
    __device__ __forceinline__ void a_ready(const Unit&) const {}
    __device__ __forceinline__ void done(const Unit&) const {}
};

struct MoeOrder8 {
    static constexpr bool GATHER = false, F8 = true; static constexpr int SCALE_B = 121;
    const PG8_LAS int* tstart; int ntn, G, c; const char* A; const char* W; size_t astep, wexp, wtile;
    __device__ __forceinline__ bool next(int i, Unit& u) const {
        const int L = i * G + c, total = tstart[32] * ntn; if (L >= total) return false;
        int wgid; { const int q = total / NXCD, r = total % NXCD, xcd = L % NXCD, off = L / NXCD; wgid = (xcd < r ? xcd * (q + 1) : r * (q + 1) + (xcd - r) * q) + off; }
        u.pm = wgid / ntn; u.pn = wgid - u.pm * ntn; int e = 0;
#pragma unroll
        for (int k = 1; k <= 31; ++k) e += (tstart[k] <= u.pm) ? 1 : 0;
        u.e = e; return true;
    }
    __device__ __forceinline__ const char* aptr(const Unit& u) const { return A + (size_t)u.pm * astep; }
    __device__ __forceinline__ const char* bptr(const Unit& u) const { return W + (size_t)u.e * wexp + (size_t)u.pn * wtile; }
    __device__ __forceinline__ void a_ready(const Unit&) const {}
    __device__ __forceinline__ void done(const Unit&) const {}
};

struct MoeGatherOrder {
    static constexpr bool GATHER = true, F8 = true; static constexpr int SCALE_B = 121;
    const PG8_LAS int* tstart; const PG8_LAS int* cntl; const int* list; int ntn, G, c; const char* A; const char* W; size_t wexp, wtile; unsigned rowbytes;
    __device__ __forceinline__ bool next(int i, Unit& u) const {
        const int L = i * G + c, total = tstart[32] * ntn; if (L >= total) return false;
        int wgid; { const int q = total / NXCD, r = total % NXCD, xcd = L % NXCD, off = L / NXCD; wgid = (xcd < r ? xcd * (q + 1) : r * (q + 1) + (xcd - r) * q) + off; }
        u.pm = wgid / ntn; u.pn = wgid - u.pm * ntn; int e = 0;
#pragma unroll
        for (int k = 1; k <= 31; ++k) e += (tstart[k] <= u.pm) ? 1 : 0;
        u.e = e; return true;
    }
    __device__ __forceinline__ unsigned rowoff(const Unit& u, int r) const { const int rank = (u.pm - tstart[u.e]) * 256 + r; const int tok = list[u.e * 8192 + (rank < cntl[u.e] ? rank : 0)]; return (unsigned)tok * rowbytes; }
    __device__ __forceinline__ const char* aptr(const Unit&) const { return A; }
    __device__ __forceinline__ const char* bptr(const Unit& u) const { return W + (size_t)u.e * wexp + (size_t)u.pn * wtile; }
    __device__ __forceinline__ void a_ready(const Unit&) const {}
    __device__ __forceinline__ void done(const Unit&) const {}
};

typedef unsigned u32x2 __attribute__((ext_vector_type(2)));
struct EpiBf16X {
    static constexpr bool PERM = true, AFTER_DRAIN = false;
    int mode; bf16_t* p0; bf16_t* p1; bf16_t* p2; bf16_t* p3;
    const PG8_LAS int* tstart; const PG8_LAS int* cntl;
    __device__ __forceinline__ void operator()(const f32x4 (&acc)[2][2][4][2], const Unit& u, int wr, int wc, int fr, int fq) const {
#ifndef ATT_BF16
        if (mode == 1 && !u.e) {
            int tok0 = u.pm * BM + wr * 64 + fr, cc0 = wc * 32 + 8 * fq; asm volatile("" : "+v"(tok0), "+v"(cc0));
            if (u.pn >= 14) { const int colv = (u.pn - 14) * BM + cc0; unsigned char* vb = (unsigned char*)p2 + ((size_t)((colv >> 8) * 128 + (tok0 >> 6)) * 256 + (colv & 255)) * 64 + (tok0 & 63);
#pragma unroll
                for (int ai = 0; ai < 2; ++ai)
#pragma unroll
                    for (int m = 0; m < 4; ++m)
#pragma unroll
                        for (int bj = 0; bj < 2; ++bj) { const f32x4 v0 = acc[ai][bj][m][0], v1 = acc[ai][bj][m][1]; unsigned a_ = 0u, b_ = 0u;
                            a_ = __builtin_amdgcn_cvt_pk_fp8_f32(v0[0], v0[1], a_, false); a_ = __builtin_amdgcn_cvt_pk_fp8_f32(v0[2], v0[3], a_, true); b_ = __builtin_amdgcn_cvt_pk_fp8_f32(v1[0], v1[1], b_, false); b_ = __builtin_amdgcn_cvt_pk_fp8_f32(v1[2], v1[3], b_, true);
                            unsigned char* vp = vb + (size_t)(ai * 2) * 16384 + m * 16 + (size_t)bj * HALF * 64;
                            vp[0] = (unsigned char)a_; vp[64] = (unsigned char)(a_ >> 8); vp[128] = (unsigned char)(a_ >> 16); vp[192] = (unsigned char)(a_ >> 24);
                            vp[256] = (unsigned char)b_; vp[320] = (unsigned char)(b_ >> 8); vp[384] = (unsigned char)(b_ >> 16); vp[448] = (unsigned char)(b_ >> 24); }
                return; }
            if (u.pn >= 8) { unsigned char* kb = (unsigned char*)p1 + (size_t)tok0 * 1536 + (u.pn - 8) * BM + cc0;
#pragma unroll
                for (int ai = 0; ai < 2; ++ai)
#pragma unroll
                    for (int m = 0; m < 4; ++m)
#pragma unroll
                        for (int bj = 0; bj < 2; ++bj) { const f32x4 v0 = acc[ai][bj][m][0], v1 = acc[ai][bj][m][1]; unsigned a_ = 0u, b_ = 0u;
                            a_ = __builtin_amdgcn_cvt_pk_fp8_f32(v0[0], v0[1], a_, false); a_ = __builtin_amdgcn_cvt_pk_fp8_f32(v0[2], v0[3], a_, true); b_ = __builtin_amdgcn_cvt_pk_fp8_f32(v1[0], v1[1], b_, false); b_ = __builtin_amdgcn_cvt_pk_fp8_f32(v1[2], v1[3], b_, true);
                            u32x2 kk; kk.x = a_; kk.y = b_; *(u32x2*)(kb + (size_t)(ai * HALF + m * 16) * 1536 + bj * HALF) = kk; }
                return; }
            { unsigned char* qb = (unsigned char*)p0 + (WS_ZQ - WS_Z) + (size_t)tok0 * 2048 + u.pn * BM + cc0; bf16_t* zb = p0 + (size_t)tok0 * 2048 + u.pn * BM + cc0;
#pragma unroll
                for (int ai = 0; ai < 2; ++ai)
#pragma unroll
                    for (int m = 0; m < 4; ++m)
#pragma unroll
                        for (int bj = 0; bj < 2; ++bj) { const f32x4 v0 = acc[ai][bj][m][0] * QSCALE, v1 = acc[ai][bj][m][1] * QSCALE; unsigned a_ = 0u, b_ = 0u;
                            a_ = __builtin_amdgcn_cvt_pk_fp8_f32(v0[0], v0[1], a_, false); a_ = __builtin_amdgcn_cvt_pk_fp8_f32(v0[2], v0[3], a_, true); b_ = __builtin_amdgcn_cvt_pk_fp8_f32(v1[0], v1[1], b_, false); b_ = __builtin_amdgcn_cvt_pk_fp8_f32(v1[2], v1[3], b_, true);
                            const size_t o_ = (size_t)(ai * HALF + m * 16) * 2048 + bj * HALF;
                            u32x2 qq; qq.x = a_; qq.y = b_; *(u32x2*)(qb + o_) = qq;
                            u32x4 w; w.x = cvt_pk_bf16(v0[0], v0[1]); w.y = cvt_pk_bf16(v0[2], v0[3]); w.z = cvt_pk_bf16(v1[0], v1[1]); w.w = cvt_pk_bf16(v1[2], v1[3]); *(u32x4*)(zb + o_) = w; }
                return; }
        }
#endif
        bf16_t* base; int ldc, colt; bool act = false; float sc = 1.f;
        if (u.e && mode < 2) { base = p3 + (size_t)(u.pn >> 2) * (256 * 1024); ldc = 1024; colt = (u.pn & 3) * BM; }
        else if (mode == 0) { base = p0; ldc = 3584; colt = u.pn * BM; act = u.pn < 12; if (u.pn >= 12) sc = QSCALE; }
        else if (mode == 1) { if (u.pn < 8) { base = p0; ldc = 2048; colt = u.pn * BM; sc = QSCALE; }
                              else if (u.pn < 14) { base = p1; ldc = 1536; colt = (u.pn - 8) * BM; } else { base = p2; ldc = 1536; colt = (u.pn - 14) * BM; } }
        else { base = p0; ldc = 2048; colt = u.pn * BM; }
        const int row0 = u.pm * BM + wr * 64 + fr, col0 = colt + wc * 32 + 8 * fq;
        const int rlim = (mode == 3) ? cntl[u.e] - (u.pm - tstart[u.e]) * BM : BM;
#pragma unroll
        for (int ai = 0; ai < 2; ++ai)
#pragma unroll
            for (int m = 0; m < 4; ++m) { bf16_t* rowp = base + (size_t)(row0 + ai * HALF + m * 16) * ldc + col0;
                if (wr * 64 + fr + ai * HALF + m * 16 >= rlim) continue;
#pragma unroll
                for (int bj = 0; bj < 2; ++bj) { f32x4 v0 = acc[ai][bj][m][0], v1 = acc[ai][bj][m][1];
                    if (act) { f32x2 a = gelu_pk((f32x2){v0[0], v0[1]}), b = gelu_pk((f32x2){v0[2], v0[3]}), c = gelu_pk((f32x2){v1[0], v1[1]}), d = gelu_pk((f32x2){v1[2], v1[3]});
                        v0 = (f32x4){a.x, a.y, b.x, b.y}; v1 = (f32x4){c.x, c.y, d.x, d.y}; }
                    v0 = v0 * sc; v1 = v1 * sc; u32x4 w; w.x = cvt_pk_bf16(v0[0], v0[1]); w.y = cvt_pk_bf16(v0[2], v0[3]); w.z = cvt_pk_bf16(v1[0], v1[1]); w.w = cvt_pk_bf16(v1[2], v1[3]);
                    *(u32x4*)(rowp + bj * HALF) = w; } }
    }
};
struct EpiResBf16 {
    static constexpr bool PERM = true, AFTER_DRAIN = false;
    const bf16_t* xres; bf16_t* y; float alpha;
    __device__ __forceinline__ void operator()(const f32x4 (&acc)[2][2][4][2], const Unit& u, int wr, int wc, int fr, int fq) const {
        const int row0 = u.pm * BM + wr * 64 + fr, col0 = u.pn * BM + wc * 32 + 8 * fq;
#pragma unroll
        for (int ai = 0; ai < 2; ++ai)
#pragma unroll
            for (int m = 0; m < 4; ++m) { const size_t off = (size_t)(row0 + ai * HALF + m * 16) * 2048 + col0;
#pragma unroll
                for (int bj = 0; bj < 2; ++bj) { const u32x4 xr = *(const u32x4*)(xres + off + bj * HALF); const f32x4 v0 = acc[ai][bj][m][0], v1 = acc[ai][bj][m][1]; u32x4 w;
                    w.x = cvt_pk_bf16(__builtin_bit_cast(float, xr.x << 16) * alpha + v0[0], __builtin_bit_cast(float, xr.x & 0xffff0000u) * alpha + v0[1]);
                    w.y = cvt_pk_bf16(__builtin_bit_cast(float, xr.y << 16) * alpha + v0[2], __builtin_bit_cast(float, xr.y & 0xffff0000u) * alpha + v0[3]);
                    w.z = cvt_pk_bf16(__builtin_bit_cast(float, xr.z << 16) * alpha + v1[0], __builtin_bit_cast(float, xr.z & 0xffff0000u) * alpha + v1[1]);
                    w.w = cvt_pk_bf16(__builtin_bit_cast(float, xr.w << 16) * alpha + v1[2], __builtin_bit_cast(float, xr.w & 0xffff0000u) * alpha + v1[3]);
                    *(u32x4*)(y + off + bj * HALF) = w; } }
    }
};
struct EpiMoe1 {
    static constexpr bool PERM = true, AFTER_DRAIN = false;
    bf16_t* h; const PG8_LAS int* tstart; const PG8_LAS int* cntl;
    __device__ __forceinline__ void operator()(const f32x4 (&acc)[2][2][4][2], const Unit& u, int wr, int wc, int fr, int fq) const {
        const int row0 = u.pm * BM + wr * 64 + fr, col0 = u.pn * HALF + wc * 32 + 8 * fq;
        const int rlim = cntl[u.e] - (u.pm - tstart[u.e]) * BM;
#pragma unroll
        for (int ai = 0; ai < 2; ++ai)
#pragma unroll
            for (int m = 0; m < 4; ++m) { unsigned char* rowp = (unsigned char*)h + (size_t)(row0 + ai * HALF + m * 16) * 512 + col0; float o[8];
                if (wr * 64 + fr + ai * HALF + m * 16 >= rlim) continue;
#pragma unroll
                for (int n = 0; n < 2; ++n)
#pragma unroll
                    for (int x = 0; x < 4; ++x) { const float a = acc[ai][0][m][n][x], b = acc[ai][1][m][n][x];
                        o[n * 4 + x] = a * __builtin_amdgcn_rcpf(1.0f + __builtin_amdgcn_exp2f(-a * LOG2E)) * b; }
                unsigned lo = 0u, hi = 0u; lo = __builtin_amdgcn_cvt_pk_fp8_f32(o[0], o[1], lo, false); lo = __builtin_amdgcn_cvt_pk_fp8_f32(o[2], o[3], lo, true);
                hi = __builtin_amdgcn_cvt_pk_fp8_f32(o[4], o[5], hi, false); hi = __builtin_amdgcn_cvt_pk_fp8_f32(o[6], o[7], hi, true);
                typedef unsigned u32x2e __attribute__((ext_vector_type(2))); u32x2e w; w.x = lo; w.y = hi; *(u32x2e*)rowp = w; }
    }
};
}

namespace att {
using bf16x8 = __attribute__((ext_vector_type(8))) short;
using s16x4  = __attribute__((ext_vector_type(4))) short;
using f32x16 = __attribute__((ext_vector_type(16))) float;
using u32x4  = __attribute__((ext_vector_type(4))) unsigned;
constexpr int DH = 128, QBLK = 32, KVBLK = 64;
constexpr float THR2 = 8.f * 1.4426950408889634f;
constexpr size_t SHM_V = KVBLK * DH * 2, SHM_K = KVBLK * DH * 2, SHM_ATTN = 2 * SHM_V + 2 * SHM_K + NWAVES * 64 * 4;
constexpr int TAB_N = 160;
#define KSWZ(row, colB) ((row) * 256 + ((colB) ^ (((row) & 7) << 4)))
#define SBAR() __builtin_amdgcn_sched_barrier(0)
__device__ __forceinline__ int crow(int r, int hi) { return (r & 3) + 8 * (r >> 2) + 4 * hi; }
__device__ __forceinline__ unsigned cvtpk(float lo, float hi) { unsigned r; asm volatile("v_cvt_pk_bf16_f32 %0, %1, %2" : "=v"(r) : "v"(lo), "v"(hi)); return r; }

__device__ __forceinline__ void partialSM(f32x16& p0, f32x16& p1, float& m_reg, float& mn, float& alpha) {
  float pmax = p0[0];
#pragma unroll
  for (int r = 1; r < 16; ++r) pmax = fmaxf(pmax, p0[r]);
#pragma unroll
  for (int r = 0; r < 16; ++r) pmax = fmaxf(pmax, p1[r]);
  { auto rr = __builtin_amdgcn_permlane32_swap(__float_as_uint(pmax), __float_as_uint(pmax), false, false);
    pmax = fmaxf(__uint_as_float(rr[0]), __uint_as_float(rr[1])); }
  if (__builtin_expect(__all(pmax - m_reg <= THR2), 1)) { mn = m_reg; alpha = 1.f; }
  else { mn = fmaxf(m_reg, pmax); alpha = __builtin_amdgcn_exp2f(m_reg - mn); m_reg = mn; }
#pragma unroll
  for (int r = 0; r < 16; ++r) p0[r] = p0[r] - mn;
#pragma unroll
  for (int r = 0; r < 16; ++r) p1[r] = p1[r] - mn;
#pragma unroll
  for (int r = 0; r < 16; ++r) p0[r] = __builtin_amdgcn_exp2f(p0[r]);
}
__device__ __forceinline__ void finishSM(f32x16& p0, f32x16& p1, float alpha, float& l_reg, bf16x8& pa0, bf16x8& pa1, bf16x8& pa2, bf16x8& pa3) {
#pragma unroll
  for (int r = 0; r < 16; ++r) p1[r] = __builtin_amdgcn_exp2f(p1[r]);
  float ps = 0;
#pragma unroll
  for (int r = 0; r < 16; ++r) ps += p0[r];
#pragma unroll
  for (int r = 0; r < 16; ++r) ps += p1[r];
  { auto rr = __builtin_amdgcn_permlane32_swap(__float_as_uint(ps), __float_as_uint(ps), false, false);
    ps = __uint_as_float(rr[0]) + __uint_as_float(rr[1]); }
  l_reg = l_reg * alpha + ps;
#define PK4(P, BASE, OUT) do { unsigned a0 = cvtpk(P[BASE + 0], P[BASE + 1]), a1 = cvtpk(P[BASE + 2], P[BASE + 3]);   \
    unsigned b0 = cvtpk(P[BASE + 4], P[BASE + 5]), b1 = cvtpk(P[BASE + 6], P[BASE + 7]);                              \
    auto r0 = __builtin_amdgcn_permlane32_swap(a0, b0, false, false); auto r1 = __builtin_amdgcn_permlane32_swap(a1, b1, false, false); \
    u32x4 w = {r0[0], r1[0], r0[1], r1[1]}; OUT = *reinterpret_cast<bf16x8*>(&w); } while (0)
  PK4(p0, 0, pa0); PK4(p0, 8, pa1); PK4(p1, 0, pa2); PK4(p1, 8, pa3);
#undef PK4
}
__device__ __forceinline__ void qkt(f32x16& p0, f32x16& p1, const char* Ks, const bf16x8* qr, int r32, int hi) {
  p0 = f32x16{}; p1 = f32x16{};
#pragma unroll
  for (int d0 = 0; d0 < 8; ++d0) { const int cb = (d0 * 16 + hi * 8) * 2;
    bf16x8 b0 = *reinterpret_cast<const bf16x8*>(Ks + KSWZ(r32, cb));
    bf16x8 b1 = *reinterpret_cast<const bf16x8*>(Ks + KSWZ(32 + r32, cb));
    p0 = __builtin_amdgcn_mfma_f32_32x32x16_bf16(b0, qr[d0], p0, 0, 0, 0);
    p1 = __builtin_amdgcn_mfma_f32_32x32x16_bf16(b1, qr[d0], p1, 0, 0, 0); }
}
__device__ __forceinline__ int v_st(int k, int c) { const int kk = (k & ~0xC) | ((k & 4) << 1) | ((k & 8) >> 1); return ((kk >> 3) * 4 + (c >> 5)) * 512 + ((kk & 7) * 32 + (c & 31)) * 2; }
__device__ __forceinline__ int v_rd_base(int lane) { return ((lane & 3) << 3) | (((lane >> 2) & 3) << 6) | (((lane >> 4) & 1) << 5) | (((lane >> 5) & 1) << 8); }
constexpr int v_rd_off(int d0, int ks, int half) { return d0 * 512 + ks * 4096 + half * 2048; }
template <int OFF> __device__ __forceinline__ s16x4 tr_read(int vb) {
  s16x4 r; asm volatile("ds_read_b64_tr_b16 %0, %1 offset:%2" : "=&v"(r) : "v"(vb), "i"(OFF) : "memory"); return r;
}
template <int D0> __device__ __forceinline__ void pv_one(f32x16& od, int vb, bf16x8 pa0, bf16x8 pa1, bf16x8 pa2, bf16x8 pa3) {
  const s16x4 l0 = tr_read<v_rd_off(D0, 0, 0)>(vb), h0 = tr_read<v_rd_off(D0, 0, 1)>(vb), l1 = tr_read<v_rd_off(D0, 1, 0)>(vb), h1 = tr_read<v_rd_off(D0, 1, 1)>(vb);
  const s16x4 l2 = tr_read<v_rd_off(D0, 2, 0)>(vb), h2 = tr_read<v_rd_off(D0, 2, 1)>(vb), l3 = tr_read<v_rd_off(D0, 3, 0)>(vb), h3 = tr_read<v_rd_off(D0, 3, 1)>(vb);
  asm volatile("s_waitcnt lgkmcnt(0)" ::: "memory"); SBAR();
#define PK(L, H) (bf16x8){L[0], L[1], L[2], L[3], H[0], H[1], H[2], H[3]}
  od = __builtin_amdgcn_mfma_f32_32x32x16_bf16(pa0, PK(l0, h0), od, 0, 0, 0);
  od = __builtin_amdgcn_mfma_f32_32x32x16_bf16(pa1, PK(l1, h1), od, 0, 0, 0);
  od = __builtin_amdgcn_mfma_f32_32x32x16_bf16(pa2, PK(l2, h2), od, 0, 0, 0);
  od = __builtin_amdgcn_mfma_f32_32x32x16_bf16(pa3, PK(l3, h3), od, 0, 0, 0);
#undef PK
}
__device__ __forceinline__ void pv_d0(f32x16* o, int vb, bf16x8 pa0, bf16x8 pa1, bf16x8 pa2, bf16x8 pa3) {
  pv_one<0>(o[0], vb, pa0, pa1, pa2, pa3); pv_one<1>(o[1], vb, pa0, pa1, pa2, pa3); pv_one<2>(o[2], vb, pa0, pa1, pa2, pa3); pv_one<3>(o[3], vb, pa0, pa1, pa2, pa3);
}
template <int MODE> __device__ __forceinline__ void post_scores(f32x16& p0, f32x16& p1, int t, int qrow0, int r32, int hi, const float* tab, float cfar) {
  if constexpr (MODE == 1) {
    const int cw = qrow0 >> 6;
    if (t > cw) {
#pragma unroll
      for (int r = 0; r < 16; ++r) { p0[r] = -INFINITY; p1[r] = -INFINITY; }
    } else if (qrow0 - (64 * t + 63) >= 91) {
#pragma unroll
      for (int r = 0; r < 16; ++r) { p0[r] += cfar; p1[r] += cfar; }
    } else {
      const int base = qrow0 + r32 - 64 * t + 63;
#pragma unroll
      for (int r = 0; r < 16; ++r) { const int i0 = base - crow(r, hi); const int i1 = i0 - 32;
        p0[r] += tab[i0 < TAB_N - 1 ? i0 : TAB_N - 1]; p1[r] += tab[i1 < TAB_N - 1 ? i1 : TAB_N - 1]; }
    }
  }
}

template <int MODE>
__device__ __forceinline__ void attn_body(const bf16* __restrict__ Qb, int ldq, const bf16* __restrict__ Kh, const bf16* __restrict__ Vh, int ldk,
                                          bf16* Ob, float* Of, int ldo, int NT, int q0abs, const float* tab, float cfar, char* lds) {
  int tid_ = threadIdx.x; asm volatile("" : "+v"(tid_));
  const int tid = tid_, wid = tid >> 6, lane = tid & 63, r32 = lane & 31, hi = lane >> 5;
  char* V_lds = lds; char* K_lds = lds + 2 * SHM_V;
  float* ws = (float*)(lds + 2 * SHM_V + 2 * SHM_K) + wid * 64; float* li_l = ws; float* al_l = ws + 32;
  float m_reg = -1e30f, l_reg = 0; f32x16 o[4] = {}; bf16x8 qr[8];
  const int qrow0 = q0abs + wid * QBLK;
  const bf16* Qw = Qb + (long)(wid * QBLK + r32) * ldq + hi * 8;
#pragma unroll
  for (int d0 = 0; d0 < 8; ++d0) qr[d0] = *reinterpret_cast<const bf16x8*>(Qw + d0 * 16);
  const int sr = tid >> 4, sc = (tid & 15) * 8, vst0 = v_st(sr, sc), vst1 = v_st(32 + sr, sc);
  const int vb0 = (int)(uintptr_t)V_lds + v_rd_base(lane);
  struct { bf16x8 vs0, vs1, ks0, ks1; } sr_[2];
#define SLOAD(i, k0) do { sr_[i].vs0 = *reinterpret_cast<const bf16x8*>(&Vh[(long)((k0) + sr) * ldk + sc]); sr_[i].vs1 = *reinterpret_cast<const bf16x8*>(&Vh[(long)((k0) + 32 + sr) * ldk + sc]); \
    sr_[i].ks0 = *reinterpret_cast<const bf16x8*>(&Kh[(long)((k0) + sr) * ldk + sc]); sr_[i].ks1 = *reinterpret_cast<const bf16x8*>(&Kh[(long)((k0) + 32 + sr) * ldk + sc]); } while (0)
#define SWRITE(b, i) do { *(bf16x8*)(V_lds + (b) * SHM_V + vst0) = sr_[i].vs0;          \
    *(bf16x8*)(V_lds + (b) * SHM_V + vst1) = sr_[i].vs1; const int kc = sc * 2;               \
    *(bf16x8*)(K_lds + (b) * SHM_K + KSWZ(sr, kc)) = sr_[i].ks0;                       \
    *(bf16x8*)(K_lds + (b) * SHM_K + KSWZ(32 + sr, kc)) = sr_[i].ks1; } while (0)
#define SWAIT() asm volatile("s_waitcnt vmcnt(4)" ::: "memory")
#define RESC(a) do { if (__any((a) < 1.f)) { if (hi == 0) al_l[r32] = (a); asm volatile("s_waitcnt lgkmcnt(0)" ::: "memory"); \
    _Pragma("unroll") for (int d = 0; d < 4; ++d) _Pragma("unroll") for (int r = 0; r < 16; ++r) o[d][r] *= al_l[crow(r, hi)]; } } while (0)
  f32x16 pA0, pA1, pB0, pB1; float mnA, mnB, alA, alB; bf16x8 pa0, pa1, pa2, pa3;
  constexpr int SE = 0, SO = 1;
  SLOAD(SE, 0); asm volatile("s_waitcnt vmcnt(0)" ::: "memory"); SWRITE(0, SE); __syncthreads();
  qkt(pA0, pA1, K_lds, qr, r32, hi); post_scores<MODE>(pA0, pA1, 0, qrow0, r32, hi, tab, cfar); partialSM(pA0, pA1, m_reg, mnA, alA);
  SLOAD(SO, KVBLK); if (2 < NT) SLOAD(SE, 2 * KVBLK);
  SWAIT(); SWRITE(1, SO); __syncthreads();
  for (int j = 1; j + 1 < NT; j += 2) {
    SBAR(); qkt(pB0, pB1, K_lds + SHM_K, qr, r32, hi); post_scores<MODE>(pB0, pB1, j, qrow0, r32, hi, tab, cfar);
    finishSM(pA0, pA1, alA, l_reg, pa0, pa1, pa2, pa3); SBAR();
    SLOAD(SO, (j + 2) * KVBLK); SBAR();
    pv_d0(o, vb0, pa0, pa1, pa2, pa3); partialSM(pB0, pB1, m_reg, mnB, alB);
    __syncthreads(); SWAIT(); SWRITE(0, SE);
    RESC(alB); __syncthreads();
    SBAR(); qkt(pA0, pA1, K_lds, qr, r32, hi); post_scores<MODE>(pA0, pA1, j + 1, qrow0, r32, hi, tab, cfar);
    finishSM(pB0, pB1, alB, l_reg, pa0, pa1, pa2, pa3); SBAR();
    if (j + 3 < NT) SLOAD(SE, (j + 3) * KVBLK); SBAR();
    pv_d0(o, vb0 + (int)SHM_V, pa0, pa1, pa2, pa3); partialSM(pA0, pA1, m_reg, mnA, alA);
    __syncthreads(); SWAIT(); SWRITE(1, SO);
    RESC(alA); __syncthreads();
  }
  SBAR(); qkt(pB0, pB1, K_lds + SHM_K, qr, r32, hi); post_scores<MODE>(pB0, pB1, NT - 1, qrow0, r32, hi, tab, cfar);
  finishSM(pA0, pA1, alA, l_reg, pa0, pa1, pa2, pa3); SBAR();
  pv_d0(o, vb0, pa0, pa1, pa2, pa3); partialSM(pB0, pB1, m_reg, mnB, alB);
  __syncthreads(); RESC(alB);
  finishSM(pB0, pB1, alB, l_reg, pa0, pa1, pa2, pa3); SBAR();
  pv_d0(o, vb0 + (int)SHM_V, pa0, pa1, pa2, pa3);
  if (hi == 0) li_l[r32] = l_reg; asm volatile("s_waitcnt lgkmcnt(0)" ::: "memory");
  float rli[16];
#pragma unroll
  for (int r = 0; r < 16; ++r) rli[r] = __builtin_amdgcn_rcpf(li_l[crow(r, hi)]);
  if constexpr (MODE == 0) {
    bf16* Ow = Ob + (long)(wid * QBLK) * ldo;
#pragma unroll
    for (int r = 0; r < 16; ++r) { const int orow = crow(r, hi);
#pragma unroll
      for (int d0 = 0; d0 < 4; ++d0) Ow[(long)orow * ldo + d0 * 32 + r32] = (bf16)f2bf(o[d0][r] * rli[r]); }
  } else {
    float* Ow = Of + (long)(wid * QBLK) * ldo;
#pragma unroll
    for (int r = 0; r < 16; ++r) { const int orow = crow(r, hi);
#pragma unroll
      for (int d0 = 0; d0 < 4; ++d0) Ow[(long)orow * ldo + d0 * 32 + r32] = o[d0][r] * rli[r]; }
  }
  __syncthreads();
#undef SLOAD
#undef SWRITE
#undef SWAIT
#undef RESC
}
}

#define XB_TMO      128
#define XB_XCNT(j)  (256  + 64 * (j))
#define XB_XSUB(j)  (1280 + 64 * (j))
#define XB_XGEN(j)  (2304 + 64 * (j))
#define XB_TOP      3328
#define XB_TOPGEN   3392
#define XCD_BAR_WORDS 3456
#define XB_SPIN_CAP (1u << 18)

__device__ __forceinline__ unsigned xb_ld(unsigned* p)              { return __hip_atomic_load(p, __ATOMIC_RELAXED, __HIP_MEMORY_SCOPE_AGENT); }
__device__ __forceinline__ unsigned xb_add(unsigned* p, unsigned v) { return __hip_atomic_fetch_add(p, v, __ATOMIC_RELAXED, __HIP_MEMORY_SCOPE_AGENT); }
__device__ __forceinline__ unsigned xb_xcc_id() { return (unsigned)__builtin_amdgcn_s_getreg((3 << 11) | 20) & 0xFu; }
#define XB_SPIN(cond, bar) do { unsigned _sp = 0; while (cond) { __builtin_amdgcn_s_sleep(1); \
    if ((++_sp & 255u) == 0u) { if (xb_ld(&(bar)[XB_TMO])) break; if (_sp > XB_SPIN_CAP) { atomicAdd(&(bar)[XB_TMO], 1u); break; } } } } while (0)

struct XcdBarrier {
    unsigned* bar; unsigned x;
    volatile LAS unsigned* st;
};

__device__ __forceinline__ XcdBarrier xcd_barrier_post(unsigned* bar, volatile LAS unsigned* st) {
    XcdBarrier b; b.bar = bar; b.x = xb_xcc_id(); b.st = st;
    if (threadIdx.x == 0) (void)xb_add(&bar[XB_XCNT(b.x)], 1u);
    return b;
}
__device__ __forceinline__ void xcd_barrier_complete(unsigned* bar, unsigned x, unsigned& nloc, unsigned& nx) {
    const unsigned G = gridDim.x * gridDim.y * gridDim.z;
    unsigned sum, cnt, mine, sp = 0u;
    for (;;) {
        sum = 0u; cnt = 0u; mine = 0u;
#pragma unroll
        for (unsigned j = 0; j < 16; ++j) { const unsigned c = xb_ld(&bar[XB_XCNT(j)]); sum += c; cnt += (c > 0u) ? 1u : 0u; mine = (j == x) ? c : mine; }
        if (sum == G) break;
        __builtin_amdgcn_s_sleep(1);
        if ((++sp & 255u) == 0u) { if (xb_ld(&bar[XB_TMO])) break; if (sp > XB_SPIN_CAP) { atomicAdd(&bar[XB_TMO], 1u); break; } }
    }
    nloc = mine > 0u ? mine : 1u; nx = cnt > 0u ? cnt : 1u;
}

__device__ __forceinline__ void xcd_barrier(const XcdBarrier& b) {
    asm volatile("s_waitcnt vmcnt(0)" ::: "memory");
    __syncthreads();
    if (threadIdx.x == 0) {
        unsigned* bar = b.bar;
        __builtin_amdgcn_s_waitcnt(0);
        unsigned nloc = b.st[0], nx = b.st[1];
        if (nloc == 0u) { xcd_barrier_complete(bar, b.x, nloc, nx); b.st[0] = nloc; b.st[1] = nx; }
        const unsigned old = xb_add(&bar[XB_XSUB(b.x)], 1u);
        const unsigned gen = old / nloc;
        if (old + 1u == (gen + 1u) * nloc) {
            __builtin_amdgcn_fence(__ATOMIC_RELEASE, "agent");
            asm volatile("s_waitcnt vmcnt(0)" ::: "memory");
            const unsigned og = xb_add(&bar[XB_TOP], 1u);
            const unsigned tg = og / nx;
            if (og + 1u == (tg + 1u) * nx) xb_add(&bar[XB_TOPGEN], 1u);
            else XB_SPIN(xb_ld(&bar[XB_TOPGEN]) == tg, bar);
            __builtin_amdgcn_fence(__ATOMIC_ACQUIRE, "agent");
            xb_add(&bar[XB_XGEN(b.x)], 1u);
            asm volatile("s_waitcnt vmcnt(0)" ::: "memory");
        } else {
            XB_SPIN(xb_ld(&bar[XB_XGEN(b.x)]) == gen, bar);
            __builtin_amdgcn_fence(__ATOMIC_ACQUIRE, "agent");
            asm volatile("s_waitcnt vmcnt(0)" ::: "memory");
        }
    }
    __syncthreads();
}


struct Args { const float* in[24]; float* out; unsigned char* ws; int ph_lo, ph_hi; };
enum { I_X = 0, I_MEM, I_AWIN, I_ALNG, I_ALNB, I_AWS, I_ABS, I_AWOUT, I_BWIN, I_BLAM, I_BSUBG, I_BWOUT, I_WKV, I_RELB, I_MEMWKV, I_LNG, I_LNB,
       I_WG1, I_BG1, I_WG2, I_BG2, I_W1, I_W3, I_W2 };
constexpr int NPH_LAYER = 9, NPHASES = 1 + DEPTH * NPH_LAYER;

struct Frame {
    LAS unsigned char* lds; char* ldsg;
    gu32* ctl; unsigned char* ws;
    int tid, lane, wave, G, c;
};

__device__ __forceinline__ void transpose_item(const float* W, int K, int N, bf16* WT, int drow0, LAS float* scr, int k0, int n0, int lane) {
#pragma unroll 8
    for (int i = 0; i < 32; ++i) { const int kk = 2 * i + (lane >> 5); scr[kk * 33 + (lane & 31)] = W[(size_t)(k0 + kk) * N + n0 + (lane & 31)]; }
    LDS_WAIT(); asm volatile("" ::: "memory");
    const int c = lane & 7;
#pragma unroll
    for (int j = 0; j < 4; ++j) { const int n = (lane >> 3) + 8 * j; const LAS float* s = scr + (8 * c) * 33 + n;
        v4u o; o.x = pk2(s[0 * 33], s[1 * 33]); o.y = pk2(s[2 * 33], s[3 * 33]); o.z = pk2(s[4 * 33], s[5 * 33]); o.w = pk2(s[6 * 33], s[7 * 33]);
        *(GAS v4u*)(WT + (size_t)(drow0 + n) * K + k0 + 8 * c) = o; }
    LDS_WAIT(); asm volatile("" ::: "memory");
}
__device__ __forceinline__ void transpose_item_fast(const float* W, int K, int N, bf16* WT, int drow0, LAS float* scr, int k0, int n0, int lane) {
    float t[32];
#pragma unroll
    for (int i = 0; i < 32; ++i) t[i] = W[(size_t)(k0 + 2 * i + (lane >> 5)) * N + n0 + (lane & 31)];
#pragma unroll
    for (int i = 0; i < 32; i += 8) asm volatile("" : "+v"(t[i]), "+v"(t[i + 1]), "+v"(t[i + 2]), "+v"(t[i + 3]), "+v"(t[i + 4]), "+v"(t[i + 5]), "+v"(t[i + 6]), "+v"(t[i + 7]));
#pragma unroll
    for (int i = 0; i < 32; ++i) scr[(2 * i + (lane >> 5)) * 33 + (lane & 31)] = t[i];
    LDS_WAIT(); asm volatile("" ::: "memory");
    const int c = lane & 7;
#pragma unroll
    for (int j = 0; j < 4; ++j) { const int n = (lane >> 3) + 8 * j; const LAS float* s = scr + (8 * c) * 33 + n;
        v4u o; o.x = pk2(s[0 * 33], s[1 * 33]); o.y = pk2(s[2 * 33], s[3 * 33]); o.z = pk2(s[4 * 33], s[5 * 33]); o.w = pk2(s[6 * 33], s[7 * 33]);
        *(GAS v4u*)(WT + (size_t)(drow0 + n) * K + k0 + 8 * c) = o; }
    LDS_WAIT(); asm volatile("" ::: "memory");
}
__device__ __forceinline__ void transpose_item_fp8(const float* W, int K, int N, unsigned char* WT, int drow0, LAS float* scr, int k0, int n0, int lane) {
    float t[32];
#pragma unroll
    for (int i = 0; i < 32; ++i) t[i] = W[(size_t)(k0 + 2 * i + (lane >> 5)) * N + n0 + (lane & 31)];
#pragma unroll
    for (int i = 0; i < 32; i += 8) asm volatile("" : "+v"(t[i]), "+v"(t[i + 1]), "+v"(t[i + 2]), "+v"(t[i + 3]), "+v"(t[i + 4]), "+v"(t[i + 5]), "+v"(t[i + 6]), "+v"(t[i + 7]));
#pragma unroll
    for (int i = 0; i < 32; ++i) scr[(2 * i + (lane >> 5)) * 33 + (lane & 31)] = t[i];
    LDS_WAIT(); asm volatile("" ::: "memory");
    const int c = lane & 7;
#pragma unroll
    for (int j = 0; j < 4; ++j) { const int n = (lane >> 3) + 8 * j; const LAS float* s = scr + (8 * c) * 33 + n;
        unsigned lo = 0u, hi = 0u;
        lo = __builtin_amdgcn_cvt_pk_fp8_f32(s[0 * 33] * 64.f, s[1 * 33] * 64.f, lo, false); lo = __builtin_amdgcn_cvt_pk_fp8_f32(s[2 * 33] * 64.f, s[3 * 33] * 64.f, lo, true);
        hi = __builtin_amdgcn_cvt_pk_fp8_f32(s[4 * 33] * 64.f, s[5 * 33] * 64.f, hi, false); hi = __builtin_amdgcn_cvt_pk_fp8_f32(s[6 * 33] * 64.f, s[7 * 33] * 64.f, hi, true);
        v2u o; o.x = lo; o.y = hi; *(GAS v2u*)(WT + (size_t)(drow0 + n) * K + k0 + 8 * c) = o; }
    LDS_WAIT(); asm volatile("" ::: "memory");
}
#ifndef CDRAIN
#define CDRAIN 8
#endif
#ifndef CSRV
#define CSRV 4
#endif
#ifndef CSRVA
#define CSRVA 32
#endif
#ifndef STOPU
#define STOPU 64
#endif
#ifndef QX
#define QX 6
#endif
#ifndef QA
#define QA 14
#endif
#ifndef QM
#define QM 7
#endif
#ifndef QB
#define QB 4
#endif
constexpr int NQ = 7, MOE_ITEMS = 3 * 32 * 512;
__device__ __forceinline__ int conv_qsize(int q) { return (q & 1) ? (q == 1 ? 5632 : (q == 3 ? 7168 : 4096)) : MOE_ITEMS; }
__device__ __forceinline__ void conv_item(Frame& F, const Args& a, int q, int it) {
    LAS float* scr = (LAS float*)(F.lds + RING_OFF + F.wave * 16384);
    if (q & 1) {
        const float* src; bf16* dst; int N, r = it;
        if (q == 1) { if (r < 3584) { N = 3584; src = a.in[I_AWIN] + (size_t)2048 * 3584; dst = (bf16*)(F.ws + WS_WAIN) + (size_t)2048 * 3584; } else { r -= 3584; N = 2048; src = a.in[I_AWOUT] + (size_t)2048 * 2048; dst = (bf16*)(F.ws + WS_WAOUT) + (size_t)2048 * 2048; } }
        else if (q == 3) { if (r < 2048) { N = 2048; src = a.in[I_BWIN]; dst = (bf16*)(F.ws + WS_WBIN0); } else if ((r -= 2048) < 3072) { N = 3072; src = a.in[I_WKV]; dst = (bf16*)(F.ws + WS_WKV); } else { r -= 3072; N = 2048; src = a.in[I_BWOUT]; dst = (bf16*)(F.ws + WS_WBOUT); } }
        else { if (r < 2048) { N = 2048; src = a.in[I_BWIN] + (size_t)2048 * 2048; dst = (bf16*)(F.ws + WS_WBIN1); } else { r -= 2048; N = 2048; src = a.in[I_BWOUT] + (size_t)2048 * 2048; dst = (bf16*)(F.ws + WS_WBOUT) + (size_t)2048 * 2048; } }
        const int nblk = N / 32, kb = r / nblk, nb = r - kb * nblk;
        transpose_item_fast(src, 2048, N, dst, 32 * nb, scr, 64 * kb, 32 * nb, F.lane);
        return;
    }
    const int L = q >> 1, seg = it >> 14, r0 = it & 16383, e = r0 >> 9, r = r0 & 511, mat = L * 32 + e;
    if (seg < 2) { const int kb = r >> 4, nb = r & 15, n0 = 32 * nb;
        transpose_item_fp8(a.in[seg == 0 ? I_W1 : I_W3] + (size_t)mat * 2048 * 512, 2048, 512, (unsigned char*)(F.ws + WS_W13) + (size_t)mat * 1024 * 2048, (n0 >> 7) * 256 + (n0 & 127) + (seg == 1 ? 128 : 0), scr, 64 * kb, n0, F.lane); }
    else { const int kb = r >> 6, nb = r & 63;
        transpose_item_fp8(a.in[I_W2] + (size_t)mat * 512 * 2048, 512, 2048, (unsigned char*)(F.ws + WS_W2) + (size_t)mat * 512 * 2048, 32 * nb, scr, 64 * kb, 32 * nb, F.lane); }
}
#ifndef F8MASK
#define F8MASK 4
#endif
#define F8L(l) (((F8MASK) >> (l)) & 1)
#ifndef F8OMASK
#define F8OMASK 12
#endif
#define F8OL(l) (((F8OMASK) >> (l)) & 1)
#ifndef CDEPTH
#define CDEPTH 3
#endif
struct CDesc { const float* src; unsigned char* dst; int N, K, drow0, k0, n0, f8; };
__device__ __forceinline__ CDesc conv_desc(Frame& F, const Args& a, int q, int it) {
    CDesc d;
    if (q & 1) {
        const float* src; unsigned char* dst; int N, r = it, f8 = F8L((q + 1) >> 1);
        if (q == 1) { if (r < 3584) { N = 3584; src = a.in[I_AWIN] + (size_t)2048 * 3584; dst = F.ws + WS_WAIN + (size_t)2048 * 3584 * 2; } else { r -= 3584; N = 2048; f8 = 0; src = a.in[I_AWOUT] + (size_t)2048 * 2048; dst = F.ws + WS_WAOUT + (size_t)2048 * 2048 * 2; } }
        else if (q == 3) { if (r < 2048) { N = 2048; src = a.in[I_BWIN]; dst = F.ws + WS_WBIN0; } else if ((r -= 2048) < 3072) { N = 3072; src = a.in[I_WKV]; dst = F.ws + WS_WBIN0 + (size_t)2048 * 2048 * (F8L(2) ? 1 : 2); } else { r -= 3072; N = 2048; f8 = F8OL(2); src = a.in[I_BWOUT]; dst = F.ws + WS_WBOUT; } }
        else { if (r < 2048) { N = 2048; src = a.in[I_BWIN] + (size_t)2048 * 2048; dst = F.ws + WS_WBIN1; } else { r -= 2048; N = 2048; f8 = F8OL(3); src = a.in[I_BWOUT] + (size_t)2048 * 2048; dst = F.ws + WS_WBOUT + (size_t)2048 * 2048 * 2; } }
        const int nblk = N / 32, kb = r / nblk, nb = r - kb * nblk;
        d.src = src; d.dst = dst; d.N = N; d.K = 2048; d.drow0 = 32 * nb; d.k0 = 64 * kb; d.n0 = 32 * nb; d.f8 = f8; return d;
    }
    const int L = q >> 1, seg = it >> 14, r0 = it & 16383, e = r0 >> 9, r = r0 & 511, mat = L * 32 + e;
    if (seg < 2) { const int kb = r >> 4, nb = r & 15, n0 = 32 * nb;
        d.src = a.in[seg == 0 ? I_W1 : I_W3] + (size_t)mat * 2048 * 512; d.dst = (unsigned char*)(F.ws + WS_W13) + (size_t)mat * 1024 * 2048; d.N = 512; d.K = 2048;
        d.drow0 = (n0 >> 7) * 256 + (n0 & 127) + (seg == 1 ? 128 : 0); d.k0 = 64 * kb; d.n0 = n0; d.f8 = 1; }
    else { const int kb = r >> 6, nb = r & 63;
        d.src = a.in[I_W2] + (size_t)mat * 512 * 2048; d.dst = (unsigned char*)(F.ws + WS_W2) + (size_t)mat * 512 * 2048; d.N = 2048; d.K = 512; d.drow0 = 32 * nb; d.k0 = 64 * kb; d.n0 = 32 * nb; d.f8 = 1; }
    return d;
}
#define CV_LOAD(t_, d_) do { const float* p_ = (d_).src + (size_t)((d_).k0 + (F.lane >> 3)) * (d_).N + (d_).n0 + 4 * (F.lane & 7); const size_t st_ = (size_t)8 * (d_).N; \
    _Pragma("unroll") for (int i_ = 0; i_ < 8; ++i_) (t_)[i_] = *(const GAS f32x4*)(p_ + st_ * i_); } while (0)
__device__ __forceinline__ void conv_process(Frame& F, f32x4 (&t)[8], const CDesc& d) {
    LAS float* scr = (LAS float*)(F.lds + RING_OFF + F.wave * 16384); const int lane = F.lane;
    asm volatile("" : "+v"(t[0]), "+v"(t[1]), "+v"(t[2]), "+v"(t[3]), "+v"(t[4]), "+v"(t[5]), "+v"(t[6]), "+v"(t[7]));
    { LAS float* w = scr + (lane >> 3) * 33 + 4 * (lane & 7);
#pragma unroll
      for (int i = 0; i < 8; ++i) { w[i * 8 * 33 + 0] = t[i].x; w[i * 8 * 33 + 1] = t[i].y; w[i * 8 * 33 + 2] = t[i].z; w[i * 8 * 33 + 3] = t[i].w; } }
    LDS_WAIT(); asm volatile("" ::: "memory");
    const int c = lane & 7;
    if (d.f8) {
#pragma unroll
        for (int j = 0; j < 4; ++j) { const int n = (lane >> 3) + 8 * j; const LAS float* s = scr + (8 * c) * 33 + n;
            unsigned lo = 0u, hi = 0u;
            lo = __builtin_amdgcn_cvt_pk_fp8_f32(s[0 * 33] * 64.f, s[1 * 33] * 64.f, lo, false); lo = __builtin_amdgcn_cvt_pk_fp8_f32(s[2 * 33] * 64.f, s[3 * 33] * 64.f, lo, true);
            hi = __builtin_amdgcn_cvt_pk_fp8_f32(s[4 * 33] * 64.f, s[5 * 33] * 64.f, hi, false); hi = __builtin_amdgcn_cvt_pk_fp8_f32(s[6 * 33] * 64.f, s[7 * 33] * 64.f, hi, true);
            v2u o; o.x = lo; o.y = hi; *(GAS v2u*)(d.dst + (size_t)(d.drow0 + n) * d.K + d.k0 + 8 * c) = o; }
    } else {
#pragma unroll
        for (int j = 0; j < 4; ++j) { const int n = (lane >> 3) + 8 * j; const LAS float* s = scr + (8 * c) * 33 + n;
            v4u o; o.x = pk2(s[0 * 33], s[1 * 33]); o.y = pk2(s[2 * 33], s[3 * 33]); o.z = pk2(s[4 * 33], s[5 * 33]); o.w = pk2(s[6 * 33], s[7 * 33]);
            *(GAS v4u*)((bf16*)d.dst + (size_t)(d.drow0 + n) * d.K + d.k0 + 8 * c) = o; }
    }
    LDS_WAIT(); asm volatile("" ::: "memory");
}
__device__ __forceinline__ void conv_range(Frame& F, const Args& a, int q, int first, int cnt) {
#if CDEPTH == 1
    for (int i = 0; i < cnt; ++i) conv_item(F, a, q, first + i);
#else
    f32x4 t[CDEPTH][8]; const int last = first + cnt - 1;
#pragma unroll
    for (int s = 0; s < CDEPTH - 1; ++s) { const int it = first + s < last ? first + s : last; const CDesc d = conv_desc(F, a, q, it); CV_LOAD(t[s], d); }
#pragma unroll 1
    for (int i0 = 0; i0 < cnt; i0 += CDEPTH) {
#pragma unroll
        for (int s = 0; s < CDEPTH; ++s) {
            { const int nx = first + i0 + s + CDEPTH - 1, it = nx < last ? nx : last; const CDesc d = conv_desc(F, a, q, it); CV_LOAD(t[(s + CDEPTH - 1) % CDEPTH], d); }
            asm volatile("" ::: "memory");
            if (i0 + s < cnt) { const CDesc d = conv_desc(F, a, q, first + i0 + s); conv_process(F, t[s], d); }
        }
    }
#endif
}
__device__ __forceinline__ void conv_filler(Frame& F, const Args& a, int q0, int n) {
    if (q0 >= NQ || n == 0) return;
#ifdef CONV_ALL_PRO
    return;
#endif
    LAS unsigned* bw = (LAS unsigned*)(F.lds + TAB_OFF + 384);
    __syncthreads();
    const bool drain = n < 0; const int per = drain ? CDRAIN : n; int q = q0;
    for (;;) {
        if (F.tid == 0) bw[0] = __hip_atomic_fetch_add(F.ctl + CW_CONV + 64 * q, (unsigned)(8 * per), RLX_AGENT);
        __syncthreads();
        const unsigned idx = bw[0];
        __syncthreads();
        const int qs = conv_qsize(q);
        if (idx >= (unsigned)qs) { if (drain || ++q >= NQ) break; continue; }
        { const int first = (int)idx + F.wave * per, cnt = (qs - first < per) ? qs - first : per; if (cnt > 0) conv_range(F, a, q, first, cnt); }
        if (!drain) break;
    }
}

__device__ __forceinline__ void prologue_phase(Frame& F, const Args& a) {
#ifdef TOUCH
    {
        const long nthr_ = (long)F.G * 512, gt_ = (long)F.c * 512 + F.tid; unsigned acc_ = 0u;
        for (long pg = gt_; pg < (long)(WS_END / 4096); pg += nthr_) acc_ += *(const GAS unsigned*)(F.ws + pg * 4096);
        for (long pg = gt_; pg < (long)((size_t)DEPTH * NE * D * FF * 4 / 4096); pg += nthr_) { acc_ += *(const GAS unsigned*)((const char*)a.in[I_W1] + pg * 4096); acc_ += *(const GAS unsigned*)((const char*)a.in[I_W3] + pg * 4096); acc_ += *(const GAS unsigned*)((const char*)a.in[I_W2] + pg * 4096); }
        if (acc_ == 0x12345679u) F.ctl[CW_TMO] = acc_;
    }
#endif
    LAS float* scr = (LAS float*)(F.lds + RING_OFF + F.wave * 16384);
    const int gw = F.c * NWAVES + F.wave, NGW = F.G * NWAVES;
    unsigned char* ws = F.ws;
    constexpr int S0 = 3584, S1 = 2048, S5 = 4 * 1024;
    constexpr int NITEMS = S0 + S1 + S5;
    for (int it = gw; it < NITEMS; it += NGW) {
        int r = it; const float* src; unsigned char* dst; int K = 2048, N; bool f8 = F8L(0);
        if (r < S0) { N = 3584; src = a.in[I_AWIN]; dst = ws + WS_WAIN; }
        else if ((r -= S0) < S1) { N = 2048; f8 = false; src = a.in[I_AWOUT]; dst = ws + WS_WAOUT; }
        else { r -= S1; const int mat = r >> 10; r &= 1023; N = 1024; src = a.in[I_MEMWKV] + (size_t)mat * K * N; dst = ws + WS_WMKV + (size_t)mat * K * N * (F8L(0) ? 1 : 2); }
        const int nblk = N / 32, kb = r / nblk, nb = r - kb * nblk;
        if (f8) transpose_item_fp8(src, K, N, dst, 32 * nb, scr, 64 * kb, 32 * nb, F.lane);
        else transpose_item_fast(src, K, N, (bf16*)dst, 32 * nb, scr, 64 * kb, 32 * nb, F.lane);
    }
#ifdef CONV_ALL_PRO
    for (int q = 0; q < NQ; ++q) { const int qs = conv_qsize(q); for (int it = gw * 4; it < qs; it += NGW * 4) conv_range(F, a, q, it, qs - it < 4 ? qs - it : 4); }
#endif
    const long nthr = (long)F.G * 512, gt = (long)F.c * 512 + F.tid;
    { float* wr = (float*)(ws + WS_WR);
      for (long i = gt; i < (long)DEPTH * 3 * 512 * 16 * 4; i += nthr) { const int j = (int)(i & 3), c = (int)((i >> 2) & 15), kg = (int)((i >> 6) & 511), r = (int)(i >> 15), nb = r % 3, l = r / 3;
          const int k = 4 * kg + j, o = 16 * nb + c; float v = 0.f;
          if (o < 4) v = a.in[I_WG1][((size_t)l * D + k) * 4 + o]; else if (o < 36) { const int g = (o - 4) >> 3, e = (o - 4) & 7; v = a.in[I_WG2][(((size_t)l * 4 + g) * D + k) * 8 + e]; }
          wr[i] = v; } }
    { const float* x = a.in[I_X]; bf16* xb = (bf16*)(ws + WS_XB);
      for (long i = gt; i < (long)T * D / 8; i += nthr) { const f32x4 v0 = *(const GAS f32x4*)(x + i * 8), v1 = *(const GAS f32x4*)(x + i * 8 + 4);
          v4u o; o.x = pk2(v0.x, v0.y); o.y = pk2(v0.z, v0.w); o.z = pk2(v1.x, v1.y); o.w = pk2(v1.z, v1.w); *(GAS v4u*)(xb + i * 8) = o;
          unsigned lo = 0u, hi = 0u; lo = __builtin_amdgcn_cvt_pk_fp8_f32(v0.x, v0.y, lo, false); lo = __builtin_amdgcn_cvt_pk_fp8_f32(v0.z, v0.w, lo, true); hi = __builtin_amdgcn_cvt_pk_fp8_f32(v1.x, v1.y, hi, false); hi = __builtin_amdgcn_cvt_pk_fp8_f32(v1.z, v1.w, hi, true);
          v2u qq; qq.x = lo; qq.y = hi; *(GAS v2u*)(ws + WS_XQ + i * 8) = qq; } }
    { const float* x = a.in[I_MEM]; bf16* xb = (bf16*)(ws + WS_MEMB);
      for (long i = gt; i < (long)MEMT * D / 8; i += nthr) { const f32x4 v0 = *(const GAS f32x4*)(x + i * 8), v1 = *(const GAS f32x4*)(x + i * 8 + 4);
          v4u o; o.x = pk2(v0.x, v0.y); o.y = pk2(v0.z, v0.w); o.z = pk2(v1.x, v1.y); o.w = pk2(v1.z, v1.w); *(GAS v4u*)(xb + i * 8) = o;
          unsigned lo = 0u, hi = 0u; lo = __builtin_amdgcn_cvt_pk_fp8_f32(v0.x, v0.y, lo, false); lo = __builtin_amdgcn_cvt_pk_fp8_f32(v0.z, v0.w, lo, true); hi = __builtin_amdgcn_cvt_pk_fp8_f32(v1.x, v1.y, hi, false); hi = __builtin_amdgcn_cvt_pk_fp8_f32(v1.z, v1.w, hi, true);
          v2u qq; qq.x = lo; qq.y = hi; *(GAS v2u*)(ws + WS_MEMQ + i * 8) = qq; } }
}

#ifndef NCVMAX
#define NCVMAX 0
#endif
#ifndef NCVATT
#define NCVATT 96
#endif
__device__ __forceinline__ int conv_servers(int nu, int G, int fin) {
    if (fin || nu <= 0) return 0;
    const int rounds = (nu + G - 1) / G, gmin = (nu + rounds - 1) / rounds; int n = G - gmin; n = n < NCVMAX ? n : NCVMAX; return n & ~7;
}
__device__ __forceinline__ void conv_done(Frame& F, int p) { __syncthreads(); if (F.tid == 0) __hip_atomic_fetch_add(F.ctl + CW_DONE + 64 * p, 1u, RLX_AGENT); }
__device__ __forceinline__ void conv_server(Frame& F, const Args& a, int p, int q0, int ncomp) {
    int q = q0;
    for (;;) {
        if (q >= NQ) break;
        unsigned idx = 0xffffffffu;
        if (F.lane == 0) { if (__hip_atomic_load(F.ctl + CW_DONE + 64 * p, RLX_AGENT) < (unsigned)ncomp) idx = __hip_atomic_fetch_add(F.ctl + CW_CONV + 64 * q, (unsigned)CSRV, RLX_AGENT); }
        idx = (unsigned)__builtin_amdgcn_readfirstlane((int)idx);
        if (idx == 0xffffffffu) break;
        const int qs = conv_qsize(q);
        if (idx >= (unsigned)qs) { ++q; continue; }
        conv_range(F, a, q, (int)idx, (qs - (int)idx < CSRV) ? qs - (int)idx : CSRV);
    }
}
__device__ __forceinline__ void conv_server_q(Frame& F, const Args& a, gu32* head, unsigned stop_at, int q0) {
    int q = q0;
    for (;;) {
        if (q >= NQ) break;
        unsigned idx = 0xffffffffu;
        if (F.lane == 0) { if (__hip_atomic_load(head, RLX_AGENT) < stop_at) idx = __hip_atomic_fetch_add(F.ctl + CW_CONV + 64 * q, (unsigned)CSRVA, RLX_AGENT); }
        idx = (unsigned)__builtin_amdgcn_readfirstlane((int)idx);
        if (idx == 0xffffffffu) break;
        const int qs = conv_qsize(q);
        if (idx >= (unsigned)qs) { ++q; continue; }
        conv_range(F, a, q, (int)idx, (qs - (int)idx < CSRVA) ? qs - (int)idx : CSRVA);
    }
}
__device__ __forceinline__ void conv_note_fin(Frame& F, int p) {
    if (blockIdx.x == 0 && F.tid == 0) { unsigned all = 1u;
        for (int q = 0; q < NQ; ++q) all &= (__hip_atomic_load(F.ctl + CW_CONV + 64 * q, RLX_AGENT) >= (unsigned)conv_qsize(q)) ? 1u : 0u;
        __hip_atomic_store(F.ctl + CW_FIN + 64 * p, all, RLX_AGENT); }
}

__device__ __forceinline__ void sgu_unit(Frame& F, const Args& a, int l, int n, int g) {
    constexpr int LDW = 136;
    LAS float* stats = (LAS float*)(F.lds); LAS bf16* Wl = (LAS bf16*)(F.lds + 1024); LAS bf16* Vt = (LAS bf16*)(F.lds + 35840);
    const bf16* z = (const bf16*)(F.ws + WS_Z); bf16* cat = (bf16*)(F.ws + WS_CAT);
    const int tok0 = n * 128;
    for (int i = 0; i < 16; ++i) { const int tk = F.wave * 16 + i; const GAS v4u* rp = (const GAS v4u*)(z + (size_t)(tok0 + tk) * NINA + MIXW) + F.lane;
        v4u w[3]; float s = 0.f;
#pragma unroll
        for (int j = 0; j < 3; ++j) { w[j] = rp[64 * j]; s += (bflo(w[j].x) + bfhi(w[j].x)) + (bflo(w[j].y) + bfhi(w[j].y)) + (bflo(w[j].z) + bfhi(w[j].z)) + (bflo(w[j].w) + bfhi(w[j].w)); }
        const float mean = wave_sum(s) * (1.f / MIXW); float q = 0.f;
#pragma unroll
        for (int j = 0; j < 3; ++j) { float d;
            d = bflo(w[j].x) - mean; q += d * d; d = bfhi(w[j].x) - mean; q += d * d; d = bflo(w[j].y) - mean; q += d * d; d = bfhi(w[j].y) - mean; q += d * d;
            d = bflo(w[j].z) - mean; q += d * d; d = bfhi(w[j].z) - mean; q += d * d; d = bflo(w[j].w) - mean; q += d * d; d = bfhi(w[j].w) - mean; q += d * d; }
        const float rstd = 1.f / sqrtf(wave_sum(q) * (1.f / MIXW) + LN_EPS);
        if (F.lane == 0) { stats[2 * tk] = mean; stats[2 * tk + 1] = rstd; } }
    { const float* wsrc = a.in[I_AWS] + ((size_t)l * 4 + g) * 128 * 128;
      for (int p = F.tid; p < 128 * 32; p += 512) { const int i = p >> 5, j4 = (p & 31) * 4; f32x4 v = *(const GAS f32x4*)(wsrc + i * 128 + j4);
          if ((j4 >> 6) > (i >> 6)) v = (f32x4){0.f, 0.f, 0.f, 0.f};
          v2u o; o.x = pk2(v.x, v.y); o.y = pk2(v.z, v.w); *(LAS v2u*)(Wl + i * LDW + j4) = o; } }
    __syncthreads();
    { const float* lg = a.in[I_ALNG] + (size_t)l * MIXW + g * 384; const float* lb = a.in[I_ALNB] + (size_t)l * MIXW + g * 384;
      for (int p = F.tid; p < 128 * 48; p += 512) { const int j = p & 127, c8 = (p >> 7) * 8;
          const v4u w = *(const GAS v4u*)(z + (size_t)(tok0 + j) * NINA + MIXW + g * 384 + c8);
          const float mean = stats[2 * j], rstd = stats[2 * j + 1];
          const f32x4 g0 = *(const GAS f32x4*)(lg + c8), g1 = *(const GAS f32x4*)(lg + c8 + 4), b0 = *(const GAS f32x4*)(lb + c8), b1 = *(const GAS f32x4*)(lb + c8 + 4);
          float v[8] = {bflo(w.x), bfhi(w.x), bflo(w.y), bfhi(w.y), bflo(w.z), bfhi(w.z), bflo(w.w), bfhi(w.w)};
          const float gg[8] = {g0.x, g0.y, g0.z, g0.w, g1.x, g1.y, g1.z, g1.w}, bb[8] = {b0.x, b0.y, b0.z, b0.w, b1.x, b1.y, b1.z, b1.w};
#pragma unroll
          for (int e = 0; e < 8; ++e) Vt[(c8 + e) * LDW + j] = (bf16)f2bf((v[e] - mean) * rstd * gg[e] + bb[e]); } }
    __syncthreads();
    const int fr = F.lane & 15, fq = F.lane >> 4;
    f32x4 acc[8][3];
#pragma unroll
    for (int mb = 0; mb < 8; ++mb)
#pragma unroll
        for (int nb = 0; nb < 3; ++nb) acc[mb][nb] = (f32x4){0.f, 0.f, 0.f, 0.f};
#pragma unroll
    for (int ks = 0; ks < 4; ++ks) { bf16x8 bfr[3];
#pragma unroll
        for (int nb = 0; nb < 3; ++nb) bfr[nb] = *(const LAS bf16x8*)(Vt + (F.wave * 48 + nb * 16 + fr) * LDW + ks * 32 + fq * 8);
#pragma unroll
        for (int mb = 0; mb < 8; ++mb) { const bf16x8 afr = *(const LAS bf16x8*)(Wl + (mb * 16 + fr) * LDW + ks * 32 + fq * 8);
#pragma unroll
            for (int nb = 0; nb < 3; ++nb) acc[mb][nb] = __builtin_amdgcn_mfma_f32_16x16x32_bf16(bfr[nb], afr, acc[mb][nb], 0, 0, 0); } }
    const float* bs = a.in[I_ABS] + ((size_t)l * 4 + g) * 128;
#pragma unroll
    for (int mb = 0; mb < 8; ++mb) { const int i = mb * 16 + fr; const float bsv = bs[i]; const size_t tk = (size_t)(tok0 + i);
#pragma unroll
        for (int nb = 0; nb < 3; ++nb) { const int c = g * 384 + F.wave * 48 + nb * 16 + 4 * fq;
            const v2u uw = *(const GAS v2u*)(z + tk * NINA + c); const f32x4 gt = acc[mb][nb] + bsv;
            v2u o; o.x = pk2(bflo(uw.x) * gt.x, bfhi(uw.x) * gt.y); o.y = pk2(bflo(uw.y) * gt.z, bfhi(uw.y) * gt.w);
            *(GAS v2u*)(cat + tk * D + c) = o; } }
    __syncthreads();
}

__device__ __forceinline__ void memattn_unit(Frame& F, int l, int hm, int qb, int ldz, int qoff) {
    const bf16* z = (const bf16*)(F.ws + WS_Z); const bf16* kv = (const bf16*)(F.ws + WS_MEMKV) + (size_t)l * 256 * 1024; bf16* cat = (bf16*)(F.ws + WS_CAT);
    att::attn_body<0>(z + (size_t)qb * 256 * ldz + qoff + hm * 128, ldz, kv + hm * 128, kv + 512 + hm * 128, 1024,
                      cat + (size_t)qb * 256 * D + MIXW + hm * 128, nullptr, D, 4, 0, nullptr, 0.f, F.ldsg);
}

__device__ __forceinline__ int t5_bucket(int rel) {
    const int a = rel < 0 ? -rel : rel; int f;
    if (a < 8) f = a; else if (a < 12) f = 8; else if (a < 16) f = 9; else if (a < 23) f = 10; else if (a < 32) f = 11; else if (a < 46) f = 12; else if (a < 64) f = 13; else if (a < 91) f = 14; else f = 15;
    return (rel > 0 ? 16 : 0) + f;
}

namespace att2 {
using att::bf16x8; using att::s16x4; using att::f32x16; using att::u32x4; using att::crow; using att::cvtpk; using att::tr_read; using att::v_rd_base;
constexpr int KT = 32, ST_K = KT * 128 * 2, ST_V = KT * 256 * 2, STAGE = 2 * ST_K + ST_V, NST = 3;
constexpr int LDS_WS = NST * STAGE, LDS_TAB = LDS_WS + 2048, LDS_UNIT = LDS_TAB + 640, LDS_END = LDS_UNIT + 16;
constexpr int NUNITS = 576;
constexpr float THR2 = 8.f * 1.4426950408889634f;
__device__ __forceinline__ int swap23(int k) { return (k & ~0xC) | ((k & 4) << 1) | ((k & 8) >> 1); }
constexpr int v_off(int d0, int ks, int half) { return d0 * 512 + ks * 8192 + half * 4096; }

struct UnitTable { unsigned short u[NUNITS]; };
constexpr UnitTable make_units() {
    UnitTable t{}; int n = 0;
    for (int c = 256; c >= 4; c -= 2) {
        { const int b = (c - 2) / 2; if ((c - 2) % 2 == 0 && b >= 32 && b <= 63) for (int part = 1; part <= 2; ++part) for (int h = 0; h < 6; ++h) t.u[n++] = (unsigned short)(h | (b << 3) | (part << 9)); }
        if (c % 4 == 0) { const int b = c / 4 - 1; if (b >= 0 && b < 32) for (int h = 0; h < 6; ++h) t.u[n++] = (unsigned short)(h | (b << 3)); }
    }
    return t;
}
__device__ const UnitTable g_units = make_units();

__device__ __forceinline__ void diff_unit(const bf16* __restrict__ Q, const bf16* __restrict__ KD, const bf16* __restrict__ VD, float* Obuf  , int orow0,
                                          float* ML  , const float* relb, int h, int b, int t_lo, int t_hi, LAS char* lds) {
  int tid_ = threadIdx.x; asm volatile("" : "+v"(tid_));
  const int tid = tid_, wid = __builtin_amdgcn_readfirstlane(tid >> 6), lane = tid & 63, r32 = lane & 31, hi = lane >> 5, m = wid >> 2, rg = wid & 3;
  LAS float* wsw = (LAS float*)(lds + LDS_WS) + wid * 64; LAS float* li_l = wsw; LAS float* al_l = wsw + 32;
  LAS float* tab = (LAS float*)(lds + LDS_TAB);
  if (tid < att::TAB_N) tab[tid] = relb[t5_bucket(63 - tid) * 6 + h] * LOG2E;
  const float cfar = relb[15 * 6 + h] * LOG2E;
  const int qrow0 = b * 128 + rg * 32;
  bf16x8 qr[8];
  { const bf16* Qw = Q + (size_t)(qrow0 + r32) * 2048 + h * 256 + m * 128 + hi * 8;
#pragma unroll
    for (int d0 = 0; d0 < 8; ++d0) qr[d0] = *reinterpret_cast<const bf16x8*>(Qw + d0 * 16); }
  int ko[2], vo[2];
#pragma unroll
  for (int i = 0; i < 2; ++i) {
    const int p = wid * 64 + lane, row = p >> 4, cp = (p & 15) ^ (row & 7); ko[i] = row * 1536 + h * 256 + i * 128 + cp * 8; }
#pragma unroll
  for (int i = 0; i < 2; ++i) {
    const int p = (wid * 2 + i) * 64 + lane, sub = p >> 5, kg = sub >> 3, cblk = sub & 7, q = p & 31, kk = kg * 8 + (q >> 2), key = swap23(kk);
    vo[i] = key * 1536 + h * 256 + cblk * 32 + (q & 3) * 8; }
  const unsigned ldsb = (unsigned)(uintptr_t)lds;
#define A2_ISSUE(t, s) do { const size_t kb_ = (size_t)(t) * KT * 1536; LAS char* sb_ = lds + (s) * STAGE; \
    __builtin_amdgcn_global_load_lds((const unsigned*)(KD + kb_ + ko[0]), (LAS unsigned*)(sb_ + wid * 1024), 16, 0, 0); \
    __builtin_amdgcn_global_load_lds((const unsigned*)(KD + kb_ + ko[1]), (LAS unsigned*)(sb_ + ST_K + wid * 1024), 16, 0, 0); \
    __builtin_amdgcn_global_load_lds((const unsigned*)(VD + kb_ + vo[0]), (LAS unsigned*)(sb_ + 2 * ST_K + (wid * 2) * 1024), 16, 0, 0); \
    __builtin_amdgcn_global_load_lds((const unsigned*)(VD + kb_ + vo[1]), (LAS unsigned*)(sb_ + 2 * ST_K + (wid * 2 + 1) * 1024), 16, 0, 0); } while (0)
  const int vis = 2 * (2 * b + (rg >> 1) + 1);
  float m_reg = -1e30f, l_reg = 0.f; f32x16 o[8];
#pragma unroll
  for (int d = 0; d < 8; ++d) o[d] = f32x16{};
  asm volatile("s_waitcnt vmcnt(0)" ::: "memory");
  A2_ISSUE(t_lo, 0); if (t_lo + 1 < t_hi) A2_ISSUE(t_lo + 1, 1);
  int s = 0;
  for (int t = t_lo; t < t_hi; ++t) {
    if (t + 1 < t_hi) asm volatile("s_waitcnt vmcnt(4) lgkmcnt(0)" ::: "memory"); else asm volatile("s_waitcnt vmcnt(0) lgkmcnt(0)" ::: "memory");
    __builtin_amdgcn_s_barrier(); asm volatile("" ::: "memory");
    if (t + 2 < t_hi) { const int s2 = (s >= 1) ? s - 1 : s + 2; A2_ISSUE(t + 2, s2); }
    if (t < vis) {
      const LAS char* Ks = lds + s * STAGE + m * ST_K;
      f32x16 p = f32x16{};
#pragma unroll
      for (int d0 = 0; d0 < 8; ++d0) { const int cb = (d0 * 16 + hi * 8) * 2;
        const bf16x8 b0 = *(const LAS bf16x8*)(Ks + KSWZ(r32, cb));
        p = __builtin_amdgcn_mfma_f32_32x32x16_bf16(b0, qr[d0], p, 0, 0, 0); }
      if (qrow0 - (KT * t + KT - 1) >= 91) {
#pragma unroll
        for (int r = 0; r < 16; ++r) p[r] += cfar;
      } else { const int base = qrow0 + r32 - KT * t + 63;
#pragma unroll
        for (int r = 0; r < 16; ++r) { const int i0 = base - crow(r, hi); p[r] += tab[i0 < att::TAB_N - 1 ? i0 : att::TAB_N - 1]; } }
      float pmax = p[0];
#pragma unroll
      for (int r = 1; r < 16; ++r) pmax = fmaxf(pmax, p[r]);
      { auto rr = __builtin_amdgcn_permlane32_swap(__float_as_uint(pmax), __float_as_uint(pmax), false, false); pmax = fmaxf(__uint_as_float(rr[0]), __uint_as_float(rr[1])); }
      float mn, alpha;
      if (__builtin_expect(__all(pmax - m_reg <= THR2), 1)) { mn = m_reg; alpha = 1.f; }
      else { mn = fmaxf(m_reg, pmax); alpha = __builtin_amdgcn_exp2f(m_reg - mn); m_reg = mn; }
      float ps = 0.f;
#pragma unroll
      for (int r = 0; r < 16; ++r) { p[r] = __builtin_amdgcn_exp2f(p[r] - mn); ps += p[r]; }
      { auto rr = __builtin_amdgcn_permlane32_swap(__float_as_uint(ps), __float_as_uint(ps), false, false); ps = __uint_as_float(rr[0]) + __uint_as_float(rr[1]); }
      l_reg = l_reg * alpha + ps;
      bf16x8 pa0, pa1;
#define A2_PK4(P, BASE, OUT) do { unsigned a0 = cvtpk(P[BASE + 0], P[BASE + 1]), a1 = cvtpk(P[BASE + 2], P[BASE + 3]);   \
    unsigned b0_ = cvtpk(P[BASE + 4], P[BASE + 5]), b1_ = cvtpk(P[BASE + 6], P[BASE + 7]);                              \
    auto r0 = __builtin_amdgcn_permlane32_swap(a0, b0_, false, false); auto r1 = __builtin_amdgcn_permlane32_swap(a1, b1_, false, false); \
    u32x4 w = {r0[0], r1[0], r0[1], r1[1]}; OUT = *reinterpret_cast<bf16x8*>(&w); } while (0)
      A2_PK4(p, 0, pa0); A2_PK4(p, 8, pa1);
      if (__any(alpha < 1.f)) { if (hi == 0) al_l[r32] = alpha; asm volatile("s_waitcnt lgkmcnt(0)" ::: "memory");
#pragma unroll
        for (int d = 0; d < 8; ++d)
#pragma unroll
          for (int r = 0; r < 16; ++r) o[d][r] *= al_l[crow(r, hi)]; }
      const int vb = (int)(ldsb + s * STAGE + 2 * ST_K) + v_rd_base(lane);
      asm volatile("s_waitcnt lgkmcnt(0)" ::: "memory"); SBAR();
#define A2_PK(L, H) (bf16x8){L[0], L[1], L[2], L[3], H[0], H[1], H[2], H[3]}
#define A2_RD(D0, l0, h0, l1, h1) do { l0 = tr_read<v_off(D0, 0, 0)>(vb); h0 = tr_read<v_off(D0, 0, 1)>(vb); l1 = tr_read<v_off(D0, 1, 0)>(vb); h1 = tr_read<v_off(D0, 1, 1)>(vb); } while (0)
#define A2_MM(D0, l0, h0, l1, h1) do { o[D0] = __builtin_amdgcn_mfma_f32_32x32x16_bf16(pa0, A2_PK(l0, h0), o[D0], 0, 0, 0); o[D0] = __builtin_amdgcn_mfma_f32_32x32x16_bf16(pa1, A2_PK(l1, h1), o[D0], 0, 0, 0); } while (0)
      s16x4 xl0, xh0, xl1, xh1, yl0, yh0, yl1, yh1;
      A2_RD(0, xl0, xh0, xl1, xh1);
      A2_RD(1, yl0, yh0, yl1, yh1); asm volatile("s_waitcnt lgkmcnt(4)" ::: "memory"); SBAR(); A2_MM(0, xl0, xh0, xl1, xh1); SBAR();
      A2_RD(2, xl0, xh0, xl1, xh1); asm volatile("s_waitcnt lgkmcnt(4)" ::: "memory"); SBAR(); A2_MM(1, yl0, yh0, yl1, yh1); SBAR();
      A2_RD(3, yl0, yh0, yl1, yh1); asm volatile("s_waitcnt lgkmcnt(4)" ::: "memory"); SBAR(); A2_MM(2, xl0, xh0, xl1, xh1); SBAR();
      A2_RD(4, xl0, xh0, xl1, xh1); asm volatile("s_waitcnt lgkmcnt(4)" ::: "memory"); SBAR(); A2_MM(3, yl0, yh0, yl1, yh1); SBAR();
      A2_RD(5, yl0, yh0, yl1, yh1); asm volatile("s_waitcnt lgkmcnt(4)" ::: "memory"); SBAR(); A2_MM(4, xl0, xh0, xl1, xh1); SBAR();
      A2_RD(6, xl0, xh0, xl1, xh1); asm volatile("s_waitcnt lgkmcnt(4)" ::: "memory"); SBAR(); A2_MM(5, yl0, yh0, yl1, yh1); SBAR();
      A2_RD(7, yl0, yh0, yl1, yh1); asm volatile("s_waitcnt lgkmcnt(4)" ::: "memory"); SBAR(); A2_MM(6, xl0, xh0, xl1, xh1); SBAR();
      asm volatile("s_waitcnt lgkmcnt(0)" ::: "memory"); SBAR(); A2_MM(7, yl0, yh0, yl1, yh1); SBAR();
    }
    s = (s == 2) ? 0 : s + 1;
  }
  if (hi == 0) li_l[r32] = l_reg; asm volatile("s_waitcnt lgkmcnt(0)" ::: "memory");
  float rli[16];
#pragma unroll
  for (int r = 0; r < 16; ++r) rli[r] = __builtin_amdgcn_rcpf(li_l[crow(r, hi)]);
  float* Ow = Obuf + (size_t)(qrow0 - orow0) * 3072 + (h * 2 + m) * 256;
#pragma unroll
  for (int r = 0; r < 16; ++r) { const int orow = crow(r, hi);
#pragma unroll
    for (int d0 = 0; d0 < 8; ++d0) Ow[(size_t)orow * 3072 + d0 * 32 + r32] = o[d0][r] * rli[r]; }
  if (hi == 0) { float* mlp = ML + (((size_t)(qrow0 - orow0 + r32) * 6 + h) * 2 + m) * 2; mlp[0] = m_reg; mlp[1] = l_reg; }
  asm volatile("s_waitcnt vmcnt(0) lgkmcnt(0)" ::: "memory");
  __builtin_amdgcn_s_barrier(); asm volatile("" ::: "memory");
#undef A2_ISSUE
#undef A2_PK4
#undef A2_PK
#undef A2_RD
#undef A2_MM
}
}

namespace att3 {
using att::f32x16; using att::crow;
typedef int v8i __attribute__((ext_vector_type(8))); typedef int v4i __attribute__((ext_vector_type(4)));
constexpr int KT = 64, ST_K = KT * 128, ST_V = 256 * 64, STAGE = 2 * ST_K + ST_V, NST = 3;
static_assert(NST * STAGE == att2::LDS_WS, "same ring size as att2");
constexpr float THR2 = 2.f;
__device__ __forceinline__ v8i cat8(v4i a, v4i b) { return __builtin_shufflevector(a, b, 0, 1, 2, 3, 4, 5, 6, 7); }
__device__ __forceinline__ void diff_unit(const unsigned char* __restrict__ Q8, const unsigned char* __restrict__ K8, const unsigned char* __restrict__ VT, float* Obuf, int orow0,
                                          float* ML, const float* relb, int h, int b, int t_lo, int t_hi, LAS char* lds) {
  int tid_ = threadIdx.x; asm volatile("" : "+v"(tid_));
  const int tid = tid_, wid = __builtin_amdgcn_readfirstlane(tid >> 6), lane = tid & 63, r32 = lane & 31, hi = lane >> 5, m = wid >> 2, rg = wid & 3;
  LAS float* wsw = (LAS float*)(lds + att2::LDS_WS) + wid * 64; LAS float* li_l = wsw; LAS float* al_l = wsw + 32;
  LAS float* tab = (LAS float*)(lds + att2::LDS_TAB);
  if (tid < att::TAB_N) tab[tid] = relb[t5_bucket(63 - tid) * 6 + h] * LOG2E;
  const float cfar = relb[15 * 6 + h] * LOG2E;
  const int qrow0 = b * 128 + rg * 32;
  v8i q8[2];
  { const unsigned char* Qw = Q8 + (size_t)(qrow0 + r32) * 2048 + h * 256 + m * 128 + hi * 32;
#pragma unroll
    for (int c = 0; c < 2; ++c) q8[c] = cat8(*(const GAS v4i*)(Qw + 64 * c), *(const GAS v4i*)(Qw + 64 * c + 16)); }
  int ko, vo[2];
  { const int p = wid * 64 + lane, row = p >> 3, cp = (p & 7) ^ (row & 7); ko = row * 1536 + h * 256 + cp * 16; }
#pragma unroll
  for (int i = 0; i < 2; ++i) { const int p = (wid * 2 + i) * 64 + lane, d = p >> 2, cp = (p & 3) ^ ((d >> 1) & 3); vo[i] = d * 64 + cp * 16; }
  const unsigned char* VTh = VT + (size_t)h * 128 * 16384;
#define A3_ISSUE(t, s) do { const size_t kb_ = (size_t)(t) * KT * 1536; LAS char* sb_ = lds + (s) * STAGE; \
    __builtin_amdgcn_global_load_lds((const unsigned*)(K8 + kb_ + ko), (LAS unsigned*)(sb_ + wid * 1024), 16, 0, 0); \
    __builtin_amdgcn_global_load_lds((const unsigned*)(K8 + kb_ + ko + 128), (LAS unsigned*)(sb_ + ST_K + wid * 1024), 16, 0, 0); \
    __builtin_amdgcn_global_load_lds((const unsigned*)(VTh + (size_t)(t) * 16384 + vo[0]), (LAS unsigned*)(sb_ + 2 * ST_K + (wid * 2) * 1024), 16, 0, 0); \
    __builtin_amdgcn_global_load_lds((const unsigned*)(VTh + (size_t)(t) * 16384 + vo[1]), (LAS unsigned*)(sb_ + 2 * ST_K + (wid * 2 + 1) * 1024), 16, 0, 0); } while (0)
  const int vis = 2 * b + (rg >> 1) + 1;
  float m_reg = -1e30f, l_reg = 0.f; f32x16 o[8];
#pragma unroll
  for (int d = 0; d < 8; ++d) o[d] = f32x16{};
  const int kx = (r32 & 7), koff0 = r32 * 128 + (((2 * hi) ^ kx) << 4), koff1 = r32 * 128 + (((2 * hi + 1) ^ kx) << 4);
  const int vx = (r32 >> 1) & 3, voff0 = r32 * 64 + (((2 * hi) ^ vx) << 4), voff1 = r32 * 64 + (((2 * hi + 1) ^ vx) << 4);
  int sclP = 121, scl1 = 127; asm volatile("" : "+v"(sclP), "+v"(scl1));
  asm volatile("s_waitcnt vmcnt(0)" ::: "memory");
  A3_ISSUE(t_lo, 0); if (t_lo + 1 < t_hi) A3_ISSUE(t_lo + 1, 1);
  int s = 0;
  for (int t = t_lo; t < t_hi; ++t) {
    if (t + 1 < t_hi) asm volatile("s_waitcnt vmcnt(4) lgkmcnt(0)" ::: "memory"); else asm volatile("s_waitcnt vmcnt(0) lgkmcnt(0)" ::: "memory");
    __builtin_amdgcn_s_barrier(); asm volatile("" ::: "memory");
    if (t + 2 < t_hi) { const int s2 = (s >= 1) ? s - 1 : s + 2; A3_ISSUE(t + 2, s2); }
    if (t < vis) {
      const LAS char* Ks = lds + s * STAGE + m * ST_K;
      f32x16 p0 = f32x16{}, p1 = f32x16{};
#pragma unroll
      for (int c = 0; c < 2; ++c) {
        const int x0 = koff0 ^ (c << 6), x1 = koff1 ^ (c << 6);
        const v8i k0 = cat8(*(const LAS v4i*)(Ks + x0), *(const LAS v4i*)(Ks + x1));
        const v8i k1 = cat8(*(const LAS v4i*)(Ks + 4096 + x0), *(const LAS v4i*)(Ks + 4096 + x1));
        asm volatile("v_mfma_scale_f32_32x32x64_f8f6f4 %0, %1, %2, %0, %3, %3 op_sel_hi:[0,0,0]" : "+v"(p0) : "v"(k0), "v"(q8[c]), "v"(scl1));
        asm volatile("v_mfma_scale_f32_32x32x64_f8f6f4 %0, %1, %2, %0, %3, %3 op_sel_hi:[0,0,0]" : "+v"(p1) : "v"(k1), "v"(q8[c]), "v"(scl1)); }
      asm volatile("s_nop 15\n s_nop 7" : "+v"(p0), "+v"(p1));
      const bool far = qrow0 - (KT * t + KT - 1) >= 91;
      if (!far) { const int base = qrow0 + r32 - KT * t + 63;
#pragma unroll
        for (int r = 0; r < 16; ++r) { const int i0 = base - crow(r, hi), i1 = i0 - 32; p0[r] += tab[i0 < att::TAB_N - 1 ? i0 : att::TAB_N - 1]; p1[r] += tab[i1 < att::TAB_N - 1 ? i1 : att::TAB_N - 1]; } }
      const float cb = far ? cfar : 0.f;
      float pmax;
      asm("v_max3_f32 %0, %1, %2, %3" : "=v"(pmax) : "v"(p0[0]), "v"(p1[0]), "v"(p0[1]));
      asm("v_max3_f32 %0, %1, %2, %3" : "=v"(pmax) : "v"(pmax), "v"(p1[1]), "v"(p0[2]));
#pragma unroll
      for (int r = 2; r < 15; ++r) asm("v_max3_f32 %0, %1, %2, %3" : "=v"(pmax) : "v"(pmax), "v"(p1[r]), "v"(p0[r + 1]));
      asm("v_max_f32 %0, %1, %2" : "=v"(pmax) : "v"(pmax), "v"(p1[15]));
      pmax += cb;
      { auto rr = __builtin_amdgcn_permlane32_swap(__float_as_uint(pmax), __float_as_uint(pmax), false, false); asm("v_max_f32 %0, %1, %2" : "=v"(pmax) : "v"(__uint_as_float(rr[0])), "v"(__uint_as_float(rr[1]))); }
      float mn, alpha;
      if (__builtin_expect(__all(pmax - m_reg <= THR2), 1)) { mn = m_reg; alpha = 1.f; }
      else { mn = fmaxf(m_reg, pmax); alpha = __builtin_amdgcn_exp2f(m_reg - mn); m_reg = mn; }
      typedef float f32x2v __attribute__((ext_vector_type(2)));
      const float off = cb - (mn - 6.f); const f32x2v off2 = {off, off}; f32x2v ps2 = {0.f, 0.f};
#pragma unroll
      for (int r = 0; r < 16; r += 2) {
        f32x2v a = (f32x2v){p0[r], p0[r + 1]} + off2, c2 = (f32x2v){p1[r], p1[r + 1]} + off2;
        p0[r] = __builtin_amdgcn_exp2f(a.x); p0[r + 1] = __builtin_amdgcn_exp2f(a.y); p1[r] = __builtin_amdgcn_exp2f(c2.x); p1[r + 1] = __builtin_amdgcn_exp2f(c2.y);
        ps2 += (f32x2v){p0[r], p0[r + 1]}; ps2 += (f32x2v){p1[r], p1[r + 1]}; }
      float ps = ps2.x + ps2.y;
      { auto rr = __builtin_amdgcn_permlane32_swap(__float_as_uint(ps), __float_as_uint(ps), false, false); ps = __uint_as_float(rr[0]) + __uint_as_float(rr[1]); }
      l_reg = l_reg * alpha + ps;
      v8i pa;
#pragma unroll
      for (int g = 0; g < 4; ++g) { unsigned x = 0u, y = 0u;
        x = __builtin_amdgcn_cvt_pk_fp8_f32(p0[4 * g], p0[4 * g + 1], x, false); x = __builtin_amdgcn_cvt_pk_fp8_f32(p0[4 * g + 2], p0[4 * g + 3], x, true);
        y = __builtin_amdgcn_cvt_pk_fp8_f32(p1[4 * g], p1[4 * g + 1], y, false); y = __builtin_amdgcn_cvt_pk_fp8_f32(p1[4 * g + 2], p1[4 * g + 3], y, true);
        auto rr = __builtin_amdgcn_permlane32_swap(x, y, false, false); pa[2 * g] = (int)rr[0]; pa[2 * g + 1] = (int)rr[1]; }
      if (__any(alpha < 1.f)) { if (hi == 0) al_l[r32] = alpha; asm volatile("s_waitcnt lgkmcnt(0)" ::: "memory");
#pragma unroll
        for (int d = 0; d < 8; ++d)
#pragma unroll
          for (int r = 0; r < 16; ++r) o[d][r] *= al_l[crow(r, hi)]; }
      const LAS char* Vs = lds + s * STAGE + 2 * ST_K;
#define A3_RD(D0, V) do { V = cat8(*(const LAS v4i*)(Vs + (D0) * 2048 + voff0), *(const LAS v4i*)(Vs + (D0) * 2048 + voff1)); } while (0)
#define A3_MM(D0, V) asm volatile("v_mfma_scale_f32_32x32x64_f8f6f4 %0, %1, %2, %0, %3, %4 op_sel_hi:[0,0,0]" : "+v"(o[D0]) : "v"(pa), "v"(V), "v"(sclP), "v"(scl1))
      v8i va, vb;
      A3_RD(0, va);
      A3_RD(1, vb); A3_MM(0, va);
      A3_RD(2, va); A3_MM(1, vb);
      A3_RD(3, vb); A3_MM(2, va);
      A3_RD(4, va); A3_MM(3, vb);
      A3_RD(5, vb); A3_MM(4, va);
      A3_RD(6, va); A3_MM(5, vb);
      A3_RD(7, vb); A3_MM(6, va);
      A3_MM(7, vb);
    }
    s = (s == 2) ? 0 : s + 1;
  }
  asm volatile("s_nop 15\n s_nop 15" ::: "memory");
  if (hi == 0) li_l[r32] = l_reg; asm volatile("s_waitcnt lgkmcnt(0)" ::: "memory");
  float rli[16];
#pragma unroll
  for (int r = 0; r < 16; ++r) rli[r] = 64.f * __builtin_amdgcn_rcpf(li_l[crow(r, hi)]);
  float* Ow = Obuf + (size_t)(qrow0 - orow0) * 3072 + (h * 2 + m) * 256;
#pragma unroll
  for (int r = 0; r < 16; ++r) { const int orow = crow(r, hi);
#pragma unroll
    for (int d0 = 0; d0 < 8; ++d0) Ow[(size_t)orow * 3072 + d0 * 32 + r32] = o[d0][r] * rli[r]; }
  if (hi == 0) { float* mlp = ML + (((size_t)(qrow0 - orow0 + r32) * 6 + h) * 2 + m) * 2; mlp[0] = m_reg; mlp[1] = l_reg * (1.f / 64.f); }
  asm volatile("s_waitcnt vmcnt(0) lgkmcnt(0)" ::: "memory");
  __builtin_amdgcn_s_barrier(); asm volatile("" ::: "memory");
#undef A3_ISSUE
#undef A3_RD
#undef A3_MM
}
}

__device__ __forceinline__ void diffattn2_unit(Frame& F, const Args& a, unsigned code) {
    const int h = code & 7, b = (code >> 3) & 63, pc = code >> 9;
    float* ob = (float*)(F.ws + (pc == 2 ? WS_OP2 : WS_OP)); float* ml = (float*)(F.ws + WS_ML) + (pc == 2 ? (size_t)T * 6 * 2 * 2 : 0);
#ifdef ATT_BF16
    const int nt = 4 * b + 4, t_lo = (pc == 2) ? nt / 2 : 0, t_hi = (pc == 1) ? nt / 2 : nt;
    att2::diff_unit((const bf16*)(F.ws + WS_Z), (const bf16*)(F.ws + WS_KD), (const bf16*)(F.ws + WS_VD), ob, pc == 2 ? 4096 : 0, ml, a.in[I_RELB], h, b, t_lo, t_hi, (LAS char*)F.lds);
#else
    const int nt = 2 * b + 2, t_lo = (pc == 2) ? nt / 2 : 0, t_hi = (pc == 1) ? nt / 2 : nt;
    att3::diff_unit(F.ws + WS_ZQ, F.ws + WS_KD, F.ws + WS_VD, ob, pc == 2 ? 4096 : 0, ml, a.in[I_RELB], h, b, t_lo, t_hi, (LAS char*)F.lds);
#endif
}
__device__ __forceinline__ void diffcombine_phase(Frame& F, const Args& a, int l) {
    const int i = l - 2; const float* lp = a.in[I_BLAM] + (size_t)i * 4 * 128;
    float s1 = lp[F.lane] * lp[128 + F.lane] + lp[64 + F.lane] * lp[128 + 64 + F.lane], s2 = lp[256 + F.lane] * lp[384 + F.lane] + lp[256 + 64 + F.lane] * lp[384 + 64 + F.lane];
    s1 = wave_sum(s1); s2 = wave_sum(s2);
    const float lam_init = 0.8f - 0.6f * expf(-0.3f * (float)l);
    const float lam = expf(s1) - expf(s2) + lam_init;
    const float* op0 = (const float*)(F.ws + WS_OP); const float* op1 = (const float*)(F.ws + WS_OP2); const float* ml0 = (const float*)(F.ws + WS_ML); const float* ml1 = ml0 + (size_t)T * 6 * 2 * 2;
    bf16* cat = (bf16*)(F.ws + WS_CAT);
    const f32x4 gsub = *(const GAS f32x4*)(a.in[I_BSUBG] + (size_t)i * 256 + 4 * F.lane);
    const int gw = F.c * NWAVES + F.wave, NGW = F.G * NWAVES;
    for (int it = gw; it < T * 6; it += NGW) { const int tk = it / 6, h = it - tk * 6; f32x4 os[2];
#pragma unroll
        for (int m = 0; m < 2; ++m) { const size_t r0 = ((size_t)tk * 6 + h) * 2 + m; f32x4 oa = *(const GAS f32x4*)(op0 + r0 * 256 + 4 * F.lane);
            if (tk >= 4096) { const size_t r1 = ((size_t)(tk - 4096) * 6 + h) * 2 + m; const f32x4 ob = *(const GAS f32x4*)(op1 + r1 * 256 + 4 * F.lane);
                const float ma = ml0[r0 * 2], la = ml0[r0 * 2 + 1], mb = ml1[r1 * 2], lb = ml1[r1 * 2 + 1], M = fmaxf(ma, mb);
                const float wa = la * exp2f(ma - M), wb = lb * exp2f(mb - M), inv = 1.f / (wa + wb); oa = oa * (wa * inv) + ob * (wb * inv); }
            os[m] = oa; }
        const f32x4 o = os[0] - os[1] * lam; const float ss = wave_sum((o.x * o.x + o.y * o.y) + (o.z * o.z + o.w * o.w));
        const float r = (1.f - lam_init) / sqrtf(ss * (1.f / 256.f) + LN_EPS);
        v2u w; w.x = pk2(o.x * r * gsub.x, o.y * r * gsub.y); w.y = pk2(o.z * r * gsub.z, o.w * r * gsub.w);
        *(GAS v2u*)(cat + (size_t)tk * D + h * 256 + 4 * F.lane) = w;
        { unsigned q8 = 0u; q8 = __builtin_amdgcn_cvt_pk_fp8_f32(o.x * r * gsub.x, o.y * r * gsub.y, q8, false); q8 = __builtin_amdgcn_cvt_pk_fp8_f32(o.z * r * gsub.z, o.w * r * gsub.w, q8, true);
          *(GAS unsigned*)(F.ws + WS_CATQ + (size_t)tk * D + h * 256 + 4 * F.lane) = q8; } }
    { const long nthr = (long)F.G * 512, gt = (long)F.c * 512 + F.tid;
      for (long i2 = gt; i2 < (long)T * 64; i2 += nthr) { const long tk = i2 >> 6; const int c8 = (int)(i2 & 63) * 8; const v4u w = *(const GAS v4u*)(cat + tk * D + MIXW + c8);
          unsigned lo = 0u, hi = 0u; lo = __builtin_amdgcn_cvt_pk_fp8_f32(bflo(w.x), bfhi(w.x), lo, false); lo = __builtin_amdgcn_cvt_pk_fp8_f32(bflo(w.y), bfhi(w.y), lo, true);
          hi = __builtin_amdgcn_cvt_pk_fp8_f32(bflo(w.z), bfhi(w.z), hi, false); hi = __builtin_amdgcn_cvt_pk_fp8_f32(bflo(w.w), bfhi(w.w), hi, true);
          v2u qq; qq.x = lo; qq.y = hi; *(GAS v2u*)(F.ws + WS_CATQ + tk * D + MIXW + c8) = qq; } }
}


__device__ __forceinline__ void ln1_router_phase(Frame& F, const Args& a, int l, int probe = 0) {
    const bf16* y = (const bf16*)(F.ws + WS_Y); bf16* x1b = (bf16*)(F.ws + WS_X1B);
    const float* lng = a.in[I_LNG] + ((size_t)l * 2 + 0) * D; const float* lnb = a.in[I_LNB] + ((size_t)l * 2 + 0) * D;
    const float* wr = (const float*)(F.ws + WS_WR) + (size_t)l * 3 * 512 * 16 * 4;
    int* tok_e = (int*)(F.ws + (probe ? WS_OP : WS_ROUTE)); int* tok_rank = tok_e + 2 * T; float* tok_gate = (float*)(tok_rank + 2 * T);
    gu32* cnt = F.ctl + (probe ? 65536 : CW_CNT) + 2048 * l;
    LAS float* P = (LAS float*)(F.lds);
    constexpr int X1ROW = 2 * D + 16;
    typedef float f32x4v __attribute__((ext_vector_type(4)));
    for (int tb = F.c; tb < T / 32; tb += F.G) {
#pragma unroll 2
        for (int i = 0; i < 4; ++i) { const int tk = tb * 32 + F.wave * 4 + i;
            const GAS v4u* yr = (const GAS v4u*)(y + (size_t)tk * D) + F.lane;
            float v[4][8]; float s = 0.f;
#pragma unroll
            for (int j = 0; j < 4; ++j) { const v4u w = yr[64 * j]; v[j][0] = bflo(w.x); v[j][1] = bfhi(w.x); v[j][2] = bflo(w.y); v[j][3] = bfhi(w.y); v[j][4] = bflo(w.z); v[j][5] = bfhi(w.z); v[j][6] = bflo(w.w); v[j][7] = bfhi(w.w);
#pragma unroll
                for (int e = 0; e < 8; ++e) s += v[j][e]; }
            const float mean = wave_sum(s) * (1.f / D); float s2 = 0.f;
#pragma unroll
            for (int j = 0; j < 4; ++j)
#pragma unroll
                for (int e = 0; e < 8; ++e) { v[j][e] -= mean; s2 += v[j][e] * v[j][e]; }
            const float rstd = 1.f / sqrtf(wave_sum(s2) * (1.f / D) + LN_EPS);
#pragma unroll
            for (int j = 0; j < 4; ++j) { const int d0 = 8 * F.lane + 512 * j; const f32x4 g0 = *(const GAS f32x4*)(lng + d0), g1 = *(const GAS f32x4*)(lng + d0 + 4), b0 = *(const GAS f32x4*)(lnb + d0), b1 = *(const GAS f32x4*)(lnb + d0 + 4);
                const float q0 = v[j][0] * rstd * g0.x + b0.x, q1 = v[j][1] * rstd * g0.y + b0.y, q2 = v[j][2] * rstd * g0.z + b0.z, q3 = v[j][3] * rstd * g0.w + b0.w;
                const float q4 = v[j][4] * rstd * g1.x + b1.x, q5 = v[j][5] * rstd * g1.y + b1.y, q6 = v[j][6] * rstd * g1.z + b1.z, q7 = v[j][7] * rstd * g1.w + b1.w;
                v4u w; w.x = pk2(q0, q1); w.y = pk2(q2, q3); w.z = pk2(q4, q5); w.w = pk2(q6, q7);
                *(GAS v4u*)(x1b + (size_t)tk * D + d0) = w;
                *(LAS v4u*)(F.lds + RING_OFF + (F.wave * 4 + i) * X1ROW + d0 * 2) = w;
                unsigned lo = 0u, hi = 0u; lo = __builtin_amdgcn_cvt_pk_fp8_f32(q0, q1, lo, false); lo = __builtin_amdgcn_cvt_pk_fp8_f32(q2, q3, lo, true);
                hi = __builtin_amdgcn_cvt_pk_fp8_f32(q4, q5, hi, false); hi = __builtin_amdgcn_cvt_pk_fp8_f32(q6, q7, hi, true);
                v2u qq; qq.x = lo; qq.y = hi; *(GAS v2u*)((unsigned char*)(F.ws + WS_X1F) + (size_t)tk * D + d0) = qq; } }
        __syncthreads();
        { const int mt = F.wave >> 2, kq = F.wave & 3, c = F.lane & 15, q = F.lane >> 4;
          const LAS unsigned char* ap = F.lds + RING_OFF + (mt * 16 + c) * X1ROW + (kq * 512 + 4 * q) * 2;
          const float* bp = wr + ((size_t)(kq * 128 + q) * 16 + c) * 4;
          f32x4v acc[3] = {{0.f, 0.f, 0.f, 0.f}, {0.f, 0.f, 0.f, 0.f}, {0.f, 0.f, 0.f, 0.f}};
#pragma unroll 8
          for (int ks = 0; ks < 32; ++ks) { const v2u aw = *(const LAS v2u*)(ap + 32 * ks); const f32x4 a4 = (f32x4){bflo(aw.x), bfhi(aw.x), bflo(aw.y), bfhi(aw.y)}; f32x4 b4[3];
#pragma unroll
              for (int nb = 0; nb < 3; ++nb) b4[nb] = *(const GAS f32x4*)(bp + ((size_t)nb * 512 + 4 * ks) * 64);
#pragma unroll
              for (int j = 0; j < 4; ++j)
#pragma unroll
                  for (int nb = 0; nb < 3; ++nb) acc[nb] = __builtin_amdgcn_mfma_f32_16x16x4f32(a4[j], b4[nb][j], acc[nb], 0, 0, 0); }
          __syncthreads();
#pragma unroll
          for (int nb = 0; nb < 3; ++nb)
#pragma unroll
              for (int r = 0; r < 4; ++r) P[((kq * 2 + mt) * 16 + 4 * q + r) * 48 + nb * 16 + c] = acc[nb][r]; }
        __syncthreads();
        if (F.tid < 64) { const int tsel = F.tid & 31, tk = tb * 32 + tsel, mt = tsel >> 4, ti = tsel & 15;
            const LAS f32x4* P4 = (const LAS f32x4*)P;
            const int rb = (mt * 16 + ti) * 12;
            const float* bg1 = a.in[I_BG1] + l * 4; const float* bg2 = a.in[I_BG2] + l * 32;
            const f32x4 s1 = (P4[rb] + P4[rb + 384]) + (P4[rb + 768] + P4[rb + 1152]);
            const float l10 = s1.x + bg1[0], l11 = s1.y + bg1[1], l12 = s1.z + bg1[2], l13 = s1.w + bg1[3];
            int grp = 0; float mx = l10;
            if (l11 > mx) { mx = l11; grp = 1; } if (l12 > mx) { mx = l12; grp = 2; } if (l13 > mx) { mx = l13; grp = 3; }
            const float psel = 1.f / (expf(l10 - mx) + expf(l11 - mx) + expf(l12 - mx) + expf(l13 - mx));
            const int ob = rb + 1 + 2 * grp;
            const f32x4 sa = (P4[ob] + P4[ob + 384]) + (P4[ob + 768] + P4[ob + 1152]), sb = (P4[ob + 1] + P4[ob + 385]) + (P4[ob + 769] + P4[ob + 1153]);
            const f32x4 ba = *(const GAS f32x4*)(bg2 + grp * 8), bb = *(const GAS f32x4*)(bg2 + grp * 8 + 4);
            const float l2[8] = {sa.x + ba.x, sa.y + ba.y, sa.z + ba.z, sa.w + ba.w, sb.x + bb.x, sb.y + bb.y, sb.z + bb.z, sb.w + bb.w};
            int i0 = 0; float v0 = l2[0];
#pragma unroll
            for (int e = 1; e < 8; ++e) if (l2[e] > v0) { v0 = l2[e]; i0 = e; }
            int i1 = -1; float v1 = -INFINITY;
#pragma unroll
            for (int e = 0; e < 8; ++e) if (e != i0 && l2[e] > v1) { v1 = l2[e]; i1 = e; }
            const float e1 = expf(v1 - v0), g0 = psel / (1.f + e1), g1 = psel * e1 / (1.f + e1);
            const int ex0 = grp * 8 + i0, ex1 = grp * 8 + i1;
            const int which = F.lane >> 5, ex = which ? ex1 : ex0; const float gg = which ? g1 : g0;
            int leader = F.lane, idx = 0, gcount = 1;
            { unsigned long long rem = ~0ull;
              while (rem) { const int l0 = __builtin_ctzll(rem); const int le = __builtin_amdgcn_readlane(ex, l0); const unsigned long long mm = __ballot(ex == le);
                  if (ex == le) { leader = l0; idx = __builtin_popcountll(mm & ((1ull << F.lane) - 1ull)); gcount = __builtin_popcountll(mm); }
                  rem &= ~mm; } }
            unsigned base = 0u; if (F.lane == leader) base = __hip_atomic_fetch_add(cnt + 64 * ex, (unsigned)gcount, RLX_AGENT);
            base = (unsigned)__shfl((int)base, leader);
            const int rk = (int)base + idx;
            { int* list = (int*)(F.ws + (probe ? WS_OP + 2 * MiB : WS_LIST)); list[ex * 8192 + rk] = tk; }
            tok_e[2 * tk + which] = ex; tok_rank[2 * tk + which] = rk; tok_gate[2 * tk + which] = gg; }
        __syncthreads();
    }
}
__device__ __forceinline__ void moe_table(Frame& F, int l) {
    LAS int* tstart = (LAS int*)(F.lds + TAB_OFF);
    if (F.tid == 0) { int acc = 0;
        for (int e = 0; e < 32; ++e) { tstart[e] = acc; const unsigned c = __hip_atomic_load(F.ctl + CW_CNT + 2048 * l + 64 * e, RLX_AGENT); tstart[36 + e] = (int)c; acc += (int)((c + 255u) >> 8); }
        tstart[32] = acc; }
    __syncthreads();
}
__device__ __forceinline__ void ln2_phase(Frame& F, const Args& a, int l) {
    const bf16* x1b = (const bf16*)(F.ws + WS_X1B); const bf16* yb = (const bf16*)(F.ws + WS_YB); bf16* xb = (bf16*)(F.ws + WS_XB);
    const float* lng = a.in[I_LNG] + ((size_t)l * 2 + 1) * D; const float* lnb = a.in[I_LNB] + ((size_t)l * 2 + 1) * D;
    moe_table(F, l); const LAS int* tstart = (const LAS int*)(F.lds + TAB_OFF);
    const int* tok_e = (const int*)(F.ws + WS_ROUTE); const int* tok_rank = tok_e + 2 * T; const float* tok_gate = (const float*)(F.ws + WS_ROUTE) + 4 * T;
    const int gw = F.c * NWAVES + F.wave, NGW = F.G * NWAVES;
    for (int t4 = gw; t4 < T / 4; t4 += NGW) { const int tk0 = t4 * 4;
        int ev = 0, rv = 0; float gv = 0.f;
        if (F.lane < 8) { ev = tok_e[2 * tk0 + F.lane]; rv = tok_rank[2 * tk0 + F.lane]; gv = tok_gate[2 * tk0 + F.lane]; }
        const int slotv = (F.lane < 8) ? tstart[ev] * 256 + rv : 0;
        v4u xr[2], ya[2], yc[2]; v4u xr2[2], ya2[2], yc2[2];
#define LN2_LOAD(i, XR, YA, YC, XR2, YA2, YC2) do { const int s0_ = __builtin_amdgcn_readlane(slotv, 2 * (i)), s1_ = __builtin_amdgcn_readlane(slotv, 2 * (i) + 1); \
        _Pragma("unroll") for (int j = 0; j < 2; ++j) { const int d0 = 8 * F.lane + 512 * j; XR[j] = *(const GAS v4u*)(x1b + (size_t)(tk0 + (i)) * D + d0); YA[j] = *(const GAS v4u*)(yb + (size_t)s0_ * D + d0); YC[j] = *(const GAS v4u*)(yb + (size_t)s1_ * D + d0); } \
        _Pragma("unroll") for (int j = 0; j < 2; ++j) { const int d0 = 8 * F.lane + 512 * (j + 2); XR2[j] = *(const GAS v4u*)(x1b + (size_t)(tk0 + (i)) * D + d0); YA2[j] = *(const GAS v4u*)(yb + (size_t)s0_ * D + d0); YC2[j] = *(const GAS v4u*)(yb + (size_t)s1_ * D + d0); } } while (0)
        LN2_LOAD(0, xr, ya, yc, xr2, ya2, yc2);
#pragma unroll
        for (int i = 0; i < 4; ++i) { const int tk = tk0 + i;
            const float g0 = __builtin_bit_cast(float, __builtin_amdgcn_readlane(__builtin_bit_cast(int, gv), 2 * i)), g1 = __builtin_bit_cast(float, __builtin_amdgcn_readlane(__builtin_bit_cast(int, gv), 2 * i + 1));
            float v[4][8]; float s = 0.f;
#pragma unroll
            for (int j = 0; j < 4; ++j) { const v4u X = j < 2 ? xr[j] : xr2[j - 2], A = j < 2 ? ya[j] : ya2[j - 2], C = j < 2 ? yc[j] : yc2[j - 2];
                v[j][0] = bflo(X.x) * DN_ALPHA + (g0 * bflo(A.x) + g1 * bflo(C.x)); v[j][1] = bfhi(X.x) * DN_ALPHA + (g0 * bfhi(A.x) + g1 * bfhi(C.x));
                v[j][2] = bflo(X.y) * DN_ALPHA + (g0 * bflo(A.y) + g1 * bflo(C.y)); v[j][3] = bfhi(X.y) * DN_ALPHA + (g0 * bfhi(A.y) + g1 * bfhi(C.y));
                v[j][4] = bflo(X.z) * DN_ALPHA + (g0 * bflo(A.z) + g1 * bflo(C.z)); v[j][5] = bfhi(X.z) * DN_ALPHA + (g0 * bfhi(A.z) + g1 * bfhi(C.z));
                v[j][6] = bflo(X.w) * DN_ALPHA + (g0 * bflo(A.w) + g1 * bflo(C.w)); v[j][7] = bfhi(X.w) * DN_ALPHA + (g0 * bfhi(A.w) + g1 * bfhi(C.w));
#pragma unroll
                for (int e = 0; e < 8; ++e) s += v[j][e]; }
            if (i + 1 < 4) LN2_LOAD(i + 1, xr, ya, yc, xr2, ya2, yc2);
            const float mean = wave_sum(s) * (1.f / D); float s2 = 0.f;
#pragma unroll
            for (int j = 0; j < 4; ++j)
#pragma unroll
                for (int e = 0; e < 8; ++e) { v[j][e] -= mean; s2 += v[j][e] * v[j][e]; }
            const float rstd = 1.f / sqrtf(wave_sum(s2) * (1.f / D) + LN_EPS);
#pragma unroll
            for (int j = 0; j < 4; ++j) { const int d0 = 8 * F.lane + 512 * j; const f32x4 g0v = *(const GAS f32x4*)(lng + d0), g1v = *(const GAS f32x4*)(lng + d0 + 4), b0 = *(const GAS f32x4*)(lnb + d0), b1 = *(const GAS f32x4*)(lnb + d0 + 4);
                const f32x4 oa = (f32x4){v[j][0] * rstd * g0v.x + b0.x, v[j][1] * rstd * g0v.y + b0.y, v[j][2] * rstd * g0v.z + b0.z, v[j][3] * rstd * g0v.w + b0.w};
                const f32x4 ob = (f32x4){v[j][4] * rstd * g1v.x + b1.x, v[j][5] * rstd * g1v.y + b1.y, v[j][6] * rstd * g1v.z + b1.z, v[j][7] * rstd * g1v.w + b1.w};
                if (l == DEPTH - 1) { *(GAS f32x4*)(a.out + (size_t)tk * D + d0) = oa; *(GAS f32x4*)(a.out + (size_t)tk * D + d0 + 4) = ob; }
                else { v4u w; w.x = pk2(oa.x, oa.y); w.y = pk2(oa.z, oa.w); w.z = pk2(ob.x, ob.y); w.w = pk2(ob.z, ob.w); *(GAS v4u*)(xb + (size_t)tk * D + d0) = w;
                    unsigned lo = 0u, hi = 0u; lo = __builtin_amdgcn_cvt_pk_fp8_f32(oa.x, oa.y, lo, false); lo = __builtin_amdgcn_cvt_pk_fp8_f32(oa.z, oa.w, lo, true); hi = __builtin_amdgcn_cvt_pk_fp8_f32(ob.x, ob.y, hi, false); hi = __builtin_amdgcn_cvt_pk_fp8_f32(ob.z, ob.w, hi, true);
                    v2u qq; qq.x = lo; qq.y = hi; *(GAS v2u*)(F.ws + WS_XQ + (size_t)tk * D + d0) = qq; } }
        }
#undef LN2_LOAD
    }
}

__global__ void __launch_bounds__(NWAVES * 64, 2) fwd_kernel(Args args) {
    extern __shared__ __attribute__((aligned(16))) unsigned char lds[];
    Frame F;
    F.lds = (LAS unsigned char*)lds; F.ldsg = (char*)lds;
    F.tid = threadIdx.x; F.lane = F.tid & 63; F.wave = __builtin_amdgcn_readfirstlane(F.tid >> 6);
    F.G = gridDim.x; F.c = blockIdx.x; F.ws = args.ws; F.ctl = (gu32*)(args.ws + WS_CTL);
    volatile LAS unsigned* MISC = (volatile LAS unsigned*)(F.lds + MISC_OFF);
    for (int u = F.tid; u < (LDS_BYTES - LDSCTL_OFF) / 4; u += NWAVES * 64) ((LAS unsigned*)(F.lds + LDSCTL_OFF))[u] = 0u;
    __syncthreads();
    const int lo = args.ph_lo, hi = args.ph_hi; int lastp = -1;
    const bool multi = (hi - lo) > 1;
    XcdBarrier bar; bar.bar = (unsigned*)(F.ctl + CW_BAR); bar.x = 0; bar.st = nullptr;
    if (multi) bar = xcd_barrier_post((unsigned*)(F.ctl + CW_BAR), MISC + 8);
#ifndef REP_MASK
#define REP_MASK 0
#endif
#define REP(k) for (int rep_ = 0; rep_ <= ((REP_MASK >> (k)) & 1); ++rep_)
#define IN(p) (lo <= (p) && (p) < hi)
#ifdef PROBE_A
#define STAMP(i) do { if (blockIdx.x == 0 && threadIdx.x == 0) ((unsigned long long*)(args.ws + WS_TS))[(i)] = __builtin_amdgcn_s_memrealtime(); } while (0)
#else
#define STAMP(i) do { } while (0)
#endif
#define SEAM(p) do { conv_note_fin(F, (p)); lastp = (p); if ((p) + 1 < hi) xcd_barrier(bar); STAMP((p) + 1); } while (0)
#define CONVFIN() ((lastp >= 0) ? (int)__hip_atomic_load(F.ctl + CW_FIN + 64 * lastp, RLX_AGENT) : 0)
#define FRESH() do { int t_ = threadIdx.x; asm volatile("" : "+v"(t_)); F.tid = t_; F.lane = t_ & 63; F.wave = __builtin_amdgcn_readfirstlane(t_ >> 6); \
    GAS unsigned char* w_ = (GAS unsigned char*)args.ws; asm volatile("" : "+s"(w_)); F.ws = (unsigned char*)w_; F.ctl = (gu32*)(w_ + WS_CTL); } while (0)

    STAMP(0);
    if (IN(0)) { FRESH(); REP(9) prologue_phase(F, args); SEAM(0); }
#ifdef XBAR
    for (int xb_ = 0; xb_ < XBAR; ++xb_) xcd_barrier(bar);
#endif

    for (int l = 0; l < DEPTH; ++l) {
        const int pb = 1 + NPH_LAYER * l;
        if (IN(pb + 0)) { FRESH();
            const int N = (l < 2) ? NINA : (l == 2 ? 5120 : 2048);
            const unsigned char* Bt = F.ws + ((l < 2) ? WS_WAIN + (size_t)l * NINA * D * 2 : (l == 2 ? WS_WBIN0 : WS_WBIN1));
            const int nu = (T / 256) * (N / 256) + (l == 0 ? 16 : 0), ncv = conv_servers(nu, F.G, CONVFIN()), Gc = F.G - ncv; const bool f8 = F8L(l);
            if (F.c < Gc) {
                pg8::EpiBf16X E{l < 2 ? 0 : 1, (bf16*)(F.ws + WS_Z), (bf16*)(F.ws + WS_KD), (bf16*)(F.ws + WS_VD), (bf16*)(F.ws + WS_MEMKV), nullptr, nullptr};
                if (f8) { pg8::Gemm g{nullptr, nullptr, T, N, D / 2}; pg8::DualOrder8 S; S.init(F.ws + WS_XQ, Bt, T, N, D / 2, Gc, F.c, F.ws + WS_MEMQ, F.ws + WS_WMKV, l == 0 ? 16 : 0);
                    REP(0) pg8::gemm_phase<pg8::EpiBf16X, pg8::DualOrder8, true, true>(F.lds + RING_OFF, g, S, E); }
                else { pg8::Gemm g{nullptr, nullptr, T, N, D}; pg8::DualOrder S; S.init(F.ws + WS_XB, Bt, T, N, D, Gc, F.c, F.ws + WS_MEMB, F.ws + WS_WMKV, l == 0 ? 16 : 0);
                    REP(0) pg8::gemm_phase<pg8::EpiBf16X, pg8::DualOrder, true, true>(F.lds + RING_OFF, g, S, E); }
                if (ncv) conv_done(F, pb + 0);
                { const int mine = (nu - 1 - F.c) / Gc + 1, rounds = (nu + Gc - 1) / Gc; conv_filler(F, args, 2 * l, (rounds - mine) * (f8 ? (QA + 1) / 2 : QA)); }
            } else conv_server(F, args, pb + 0, 2 * l, Gc);
            SEAM(pb + 0);
        }
        if (IN(pb + 1)) { FRESH();
            if (l < 2) {
                REP(1) for (int u = F.c; u < 256 + 128; u += F.G) {
                    if (u < 256) sgu_unit(F, args, l, u >> 2, u & 3);
                    else { const int r = u - 256; memattn_unit(F, l, r & 3, r >> 2, NINA, 2 * MIXW); }
                }
                if (F.c >= 128) conv_filler(F, args, 2 * l, QX);
            } else {
                const int ncv = CONVFIN() ? 0 : NCVATT;
                if (F.c >= F.G - ncv) { conv_server_q(F, args, F.ctl + CW_Q + 64 * l, (unsigned)(att2::NUNITS + 128 - STOPU), 2 * l); __syncthreads(); }
                REP(2) { gu32* qh = F.ctl + CW_Q + 64 * l + 16 * rep_; LAS unsigned* uw = (LAS unsigned*)(F.lds + att2::LDS_UNIT);
                for (;;) {
                    if (F.tid == 0) *uw = __hip_atomic_fetch_add(qh, 1u, RLX_AGENT);
                    __syncthreads();
                    const unsigned idx = *uw;
                    __syncthreads();
                    if (idx >= (unsigned)(att2::NUNITS + 128)) break;
                    if (idx < (unsigned)att2::NUNITS) diffattn2_unit(F, args, att2::g_units.u[idx]);
                    else { const int r = (int)idx - att2::NUNITS; memattn_unit(F, l, r & 3, r >> 2, 2048, MIXW); }
                } }
            }
            SEAM(pb + 1);
        }
        if (IN(pb + 2) && l >= 2) { FRESH(); REP(3) diffcombine_phase(F, args, l); SEAM(pb + 2); }
        if (IN(pb + 3)) { FRESH();
            pg8::EpiResBf16 E{(const bf16*)(F.ws + WS_XB), (bf16*)(F.ws + WS_Y), DN_ALPHA};
            const unsigned char* Wo = F.ws + (l < 2 ? WS_WAOUT + (size_t)l * D * D * 2 : WS_WBOUT + (size_t)(l - 2) * D * D * 2);
            if (F8OL(l)) { pg8::Gemm g{nullptr, nullptr, T, D, D / 2}; pg8::DenseOrder8 S; S.init(F.ws + WS_CATQ, Wo, T, D, D / 2, F.G, F.c);
                REP(4) pg8::gemm_phase<pg8::EpiResBf16, pg8::DenseOrder8, true, true>(F.lds + RING_OFF, g, S, E); }
            else { pg8::Gemm g{nullptr, nullptr, T, D, D}; pg8::DenseOrder S; S.init(F.ws + WS_CAT, Wo, T, D, D, F.G, F.c);
                REP(4) pg8::gemm_phase<pg8::EpiResBf16, pg8::DenseOrder, true, true>(F.lds + RING_OFF, g, S, E); }
            SEAM(pb + 3);
        }
        if (IN(pb + 4)) { FRESH(); ln1_router_phase(F, args, l);
#ifdef REP_LN1
            ln1_router_phase(F, args, l, 1);
#endif
            conv_filler(F, args, 2 * l, -1); SEAM(pb + 4); }
        if (IN(pb + 6)) { FRESH();
            moe_table(F, l);
            const LAS int* tb = (const LAS int*)(F.lds + TAB_OFF);
            const int nu = tb[32] * 4, ncv = conv_servers(nu, F.G, CONVFIN()), Gc = F.G - ncv;
            if (F.c < Gc) {
                pg8::Gemm g{nullptr, nullptr, SLOTS, 1024, D / 2};
                pg8::MoeGatherOrder S{tb, tb + 36, (const int*)(F.ws + WS_LIST), 4, Gc, F.c, (const char*)(F.ws + WS_X1F), (const char*)(F.ws + WS_W13) + (size_t)l * NE * 1024 * 2048, (size_t)1024 * 2048, (size_t)256 * 2048, (unsigned)D};
                pg8::EpiMoe1 E{(bf16*)(F.ws + WS_H), tb, tb + 36};
                REP(6) pg8::gemm_phase<pg8::EpiMoe1, pg8::MoeGatherOrder, true, true>(F.lds + RING_OFF, g, S, E);
                if (ncv) conv_done(F, pb + 6);
                { const int mine = (F.c < nu) ? (nu - 1 - F.c) / Gc + 1 : 0, rounds = (nu + Gc - 1) / Gc; conv_filler(F, args, 2 * l + 1, (rounds - mine) * QM); }
            } else conv_server(F, args, pb + 6, 2 * l + 1, Gc);
            SEAM(pb + 6);
        }
        if (IN(pb + 7)) { FRESH();
            moe_table(F, l);
            const int nu = ((const LAS int*)(F.lds + TAB_OFF))[32] * 8, ncv = conv_servers(nu, F.G, CONVFIN()), Gc = F.G - ncv;
            if (F.c < Gc) {
                pg8::Gemm g{nullptr, nullptr, SLOTS, D, FF / 2};
                pg8::MoeOrder8 S{(const PG8_LAS int*)(F.lds + TAB_OFF), 8, Gc, F.c, (const char*)(F.ws + WS_H), (const char*)(F.ws + WS_W2) + (size_t)l * NE * 2048 * 512, (size_t)256 * FF, (size_t)2048 * 512, (size_t)256 * 512};
                pg8::EpiBf16X E{3, (bf16*)(F.ws + WS_YB), nullptr, nullptr, nullptr, (const PG8_LAS int*)(F.lds + TAB_OFF), (const PG8_LAS int*)(F.lds + TAB_OFF) + 36};
                REP(7) pg8::gemm_phase<pg8::EpiBf16X, pg8::MoeOrder8, true, true>(F.lds + RING_OFF, g, S, E);
                if (ncv) conv_done(F, pb + 7);
                { const int mine = (F.c < nu) ? (nu - 1 - F.c) / Gc + 1 : 0, rounds = (nu + Gc - 1) / Gc; conv_filler(F, args, 2 * l + 1, (rounds - mine) * QB); }
            } else conv_server(F, args, pb + 7, 2 * l + 1, Gc);
            SEAM(pb + 7);
        }
        if (IN(pb + 8)) { FRESH(); REP(8) ln2_phase(F, args, l); conv_filler(F, args, 2 * l + 1, -1); SEAM(pb + 8); }
    }
#ifdef PROBE_A
    {
        VM_WAIT(); xcd_barrier(bar);
        const unsigned long long* ts = (const unsigned long long*)(args.ws + WS_TS);
        float da = 0.f, db = 0.f;
        for (int p = 0; p < NPHASES; ++p) { const int k = (p == 0) ? 9 : (p - 1) % NPH_LAYER; const float d = (float)(ts[p + 1] - ts[p]);
            if (k == PROBE_A || PROBE_A == 10) da += d; if (k == PROBE_B || PROBE_B == 10) db += d; }
        const float kk = sqrtf(da), vv = db;
        float* o = args.out; const long n = (long)T * D;
        for (long i = (long)blockIdx.x * 512 + threadIdx.x; i < n; i += (long)gridDim.x * 512) o[i] = (i == 0) ? vv : kk;
    }
#endif
#undef IN
#undef SEAM
}

#ifndef MK_ONE_LAUNCH
#define MK_ONE_LAUNCH 1
#endif
extern "C" void kernel_launch(void* const* d_in, const int* in_sizes, int n_in, void* d_out, int out_size, void* d_ws, size_t ws_size, hipStream_t stream) {
    static int grid = 0;
    if (grid == 0) {
        if (n_in != 24 || in_sizes[0] != T * D || out_size != T * D || ws_size < WS_END) { fprintf(stderr, "kernel_launch: unexpected shapes (n_in %d, in0 %d, out %d, ws %zu < %zu)\n", n_in, n_in > 0 ? in_sizes[0] : -1, out_size, ws_size, (size_t)WS_END); grid = -1; return; }
        int dev = 0, cus = 0, per_cu = 0;
        if (hipGetDevice(&dev) != hipSuccess || hipDeviceGetAttribute(&cus, hipDeviceAttributeMultiprocessorCount, dev) != hipSuccess) { grid = -1; return; }
        if (hipFuncSetAttribute((const void*)fwd_kernel, hipFuncAttributeMaxDynamicSharedMemorySize, LDS_BYTES) != hipSuccess) { fprintf(stderr, "kernel_launch: hipFuncSetAttribute failed\n"); grid = -1; return; }
        if (hipOccupancyMaxActiveBlocksPerMultiprocessor(&per_cu, (const void*)fwd_kernel, NWAVES * 64, LDS_BYTES) != hipSuccess || per_cu < 1) fprintf(stderr, "kernel_launch: occupancy query reports %d\n", per_cu);
        (void)hipGetLastError();
        grid = cus;
    }
    if (grid < 0) return;
    if (hipMemsetAsync((char*)d_ws + WS_CTL, 0, CTL_ZERO_BYTES, stream) != hipSuccess) return;
    Args a{};
    for (int i = 0; i < 24; ++i) a.in[i] = (const float*)d_in[i];
    a.out = (float*)d_out; a.ws = (unsigned char*)d_ws;
#if MK_ONE_LAUNCH
    a.ph_lo = 0; a.ph_hi = NPHASES;
    hipLaunchKernelGGL(fwd_kernel, dim3(grid), dim3(NWAVES * 64), LDS_BYTES, stream, a);
#else
    for (int p = 0; p < NPHASES; ++p) {
        const int k = (p - 1) % NPH_LAYER, l = (p - 1) / NPH_LAYER;
        if (p > 0 && k == 2 && l < 2) continue;
        a.ph_lo = p; a.ph_hi = p + 1;
        hipLaunchKernelGGL(fwd_kernel, dim3(grid), dim3(NWAVES * 64), LDS_BYTES, stream, a);
    }
#endif
    const hipError_t le = hipPeekAtLastError();
    if (le != hipSuccess) fprintf(stderr, "kernel_launch: launch failed: %s\n", hipGetErrorName(le));
}
```

```cpp
#define F8MASK 12
#define F8OMASK 12
#include <hip/hip_runtime.h>
#include <cstdio>
#include <cstdint>
namespace pg8 {
#define PG8_LAS __attribute__((address_space(3)))
typedef unsigned short bf16_t;
typedef short bf16x8 __attribute__((ext_vector_type(8)));
typedef float f32x4 __attribute__((ext_vector_type(4)));
typedef unsigned u32x4 __attribute__((ext_vector_type(4)));
constexpr int BM = 256, BK = 64, HALF = 128, HTB = HALF * BK * 2  , STAGE_BYTES = 8 * HTB, NXCD = 8, WGM = 8;

__host__ __device__ __forceinline__ int lds_byte(int r, int c) { const int st = (r >> 4) * 2 + (c >> 5), rr = r & 15, cc = c & 31, ob = rr * 64 + cc * 2; return st * 1024 + (ob ^ (((ob >> 9) & 1) << 5)); }
__host__ __device__ __forceinline__ void stage_rc(int b, int& R, int& C) { const int st = b / 1024, sb = b % 1024, swz = sb ^ (((sb >> 9) & 1) << 5); R = (st >> 1) * 16 + swz / 64; C = (st & 1) * 32 + (swz % 64) / 2; }
__host__ __device__ __forceinline__ int perm32(int rho) { const int n = rho >> 4, i = rho & 15; return 8 * (i >> 2) + 4 * n + (i & 3); }

typedef int pg8_v4i __attribute__((ext_vector_type(4))); typedef int pg8_v8i __attribute__((ext_vector_type(8)));
__device__ __forceinline__ pg8_v8i pg8_cat8(bf16x8 a, bf16x8 b) { return __builtin_shufflevector(__builtin_bit_cast(pg8_v4i, a), __builtin_bit_cast(pg8_v4i, b), 0, 1, 2, 3, 4, 5, 6, 7); }
struct Unit { int pm, pn, e; };
struct Gemm { const bf16_t* A; const bf16_t* Bt; int M, N, K; };

struct StaticOrder {
    static constexpr bool GATHER = false, F8 = false; static constexpr int SCALE_B = 127;
    int nM, nN, nwg, G, c;
    __host__ __device__ void init(int M, int N, int G_, int c_) { nM = M / BM; nN = N / BM; nwg = nM * nN; G = G_; c = c_; }
    __host__ __device__ bool next(int i, Unit& u) const {
        const long L = (long)i * G + c; if (L >= nwg) return false;
        int wgid = (int)L; { const int q = nwg / NXCD, r = nwg % NXCD, xcd = wgid % NXCD, off = wgid / NXCD; wgid = (xcd < r ? xcd * (q + 1) : r * (q + 1) + (xcd - r) * q) + off; }
        const int nig = WGM * nN, gid = wgid / nig, fm = gid * WGM, gsz = (nM - fm) < WGM ? (nM - fm) : WGM;
        u.pm = fm + ((wgid % nig) % gsz); u.pn = (wgid % nig) / gsz; return true;
    }
    __device__ __forceinline__ void a_ready(const Unit&) const {}
    __device__ __forceinline__ void done(const Unit&) const {}
};

__device__ __forceinline__ unsigned cvt_pk_bf16(float lo, float hi) { unsigned r; asm volatile("v_cvt_pk_bf16_f32 %0, %1, %2" : "=v"(r) : "v"(lo), "v"(hi)); return r; }
typedef float f32x2 __attribute__((ext_vector_type(2)));
__device__ __forceinline__ f32x2 gelu_pk(f32x2 v) {
    const f32x2 av = __builtin_elementwise_abs(v), d = av * 0.2316418882f + 1.0f;
    f32x2 t; t.x = __builtin_amdgcn_rcpf(d.x); t.y = __builtin_amdgcn_rcpf(d.y);
    f32x2 q = t * 0.5307027145f + (-0.7265760135f); q = q * t + 0.7107068705f; q = q * t + (-0.142248368f); q = q * t + 0.127414796f; q = q * t;
    const f32x2 s = (v * v) * (-0.72134752044f);
    f32x2 e; e.x = __builtin_amdgcn_exp2f(s.x); e.y = __builtin_amdgcn_exp2f(s.y);
    const f32x2 m = v * (q * e), r = v - m;
    f32x2 o; o.x = v.x < 0.f ? m.x : r.x; o.y = v.y < 0.f ? m.y : r.y; return o;
}

template <class Epi, class Sched, bool ALIGN_EPI = false, bool SP2 = false>
__device__ __forceinline__ void gemm_phase(PG8_LAS unsigned char* lds, const Gemm g, const Sched& S, const Epi& E) {
    int tid_ = threadIdx.x; asm volatile("" : "+v"(tid_));
    const int tid = tid_, wid = __builtin_amdgcn_readfirstlane(tid >> 6), lane = tid & 63, wr = wid >> 2, wc = wid & 3, fr = lane & 15, fq = lane >> 4;
    const int K = g.K, nt = K / BK;
    unsigned voffA[2], voffB[2];
#pragma unroll
    for (int i = 0; i < 2; ++i) { int R, C; stage_rc(tid * 16 + i * 8192, R, C); const int Rb = Epi::PERM ? ((R & ~31) + perm32(R & 31)) : R;
        voffA[i] = (unsigned)(R * K + C) * 2u; voffB[i] = (unsigned)(Rb * K + C) * 2u; }
    unsigned vAc[2][2], vAn[2][2];
    int gR[2], gC[2];
#pragma unroll
    for (int i = 0; i < 2; ++i) { stage_rc(tid * 16 + i * 8192, gR[i], gC[i]); }
    const size_t kstep = (size_t)(BK * 2);
    const size_t hstep = (size_t)HALF * K * 2;
        const unsigned ldsw = (unsigned)wid * 1024u;
    const int aoff = lds_byte(wr * 64 + fr, fq * 8), boff = lds_byte(wc * 32 + fr, fq * 8);
#define PG8_SA(b, h) (((b) * 2 + (h)) * HTB)
#define PG8_SB(b, h) ((4 + (b) * 2 + (h)) * HTB)
#define PG8_STAGE(bufoff, gbase, voff) do { _Pragma("unroll") for (int _i = 0; _i < 2; ++_i) \
        __builtin_amdgcn_global_load_lds((const unsigned*)((const char*)(gbase) + (voff)[_i]), (PG8_LAS unsigned*)(lds + (bufoff) + ldsw + _i * 8192), 16, 0, 0); } while (0)
#define PG8_STAGE_A(b, h, base, VS) do { if constexpr (Sched::GATHER) { PG8_STAGE(PG8_SA(b, h), base, VS[h]); } else { PG8_STAGE(PG8_SA(b, h), (base) + (h) * hstep, voffA); } } while (0)
#define PG8_STAGE_AN(b, h, base) do { if constexpr (Sched::GATHER) { unsigned vs_[2] = {last ? vAn[h][0] : vAc[h][0], last ? vAn[h][1] : vAc[h][1]}; PG8_STAGE(PG8_SA(b, h), base, vs_); } else { PG8_STAGE(PG8_SA(b, h), (base) + (h) * hstep, voffA); } } while (0)
#define PG8_LDA(dst, b, h) do { if constexpr (Sched::F8) { _Pragma("unroll") for (int m = 0; m < 4; ++m) { dst##8[m].lo = *(const PG8_LAS pg8_v4i*)(lds + PG8_SA(b, h) + aoff + m * 2048); dst##8[m].hi = *(const PG8_LAS pg8_v4i*)(lds + PG8_SA(b, h) + aoff + m * 2048 + 1024); } } \
        else { _Pragma("unroll") for (int m = 0; m < 4; ++m) _Pragma("unroll") for (int k = 0; k < 2; ++k) dst[m][k] = *(const PG8_LAS bf16x8*)(lds + PG8_SA(b, h) + aoff + m * 2048 + k * 1024); } } while (0)
#define PG8_LDB(dst, b, h) do { if constexpr (Sched::F8) { _Pragma("unroll") for (int n = 0; n < 2; ++n) { dst##8[n].lo = *(const PG8_LAS pg8_v4i*)(lds + PG8_SB(b, h) + boff + n * 2048); dst##8[n].hi = *(const PG8_LAS pg8_v4i*)(lds + PG8_SB(b, h) + boff + n * 2048 + 1024); } } \
        else { _Pragma("unroll") for (int n = 0; n < 2; ++n) _Pragma("unroll") for (int k = 0; k < 2; ++k) dst[n][k] = *(const PG8_LAS bf16x8*)(lds + PG8_SB(b, h) + boff + n * 2048 + k * 1024); } } while (0)
#define PG8_MMA(ai, bj, At, Bt) do { __builtin_amdgcn_s_setprio(1); if constexpr (Sched::F8) { \
        _Pragma("unroll") for (int m = 0; m < 4; ++m) _Pragma("unroll") for (int n = 0; n < 2; ++n) \
            asm volatile("v_mfma_scale_f32_16x16x128_f8f6f4 %0, %1, %2, %0, %3, %4 op_sel_hi:[0,0,0]" : "+v"(acc[ai][bj][m][n]) : "v"(Bt##8[n]), "v"(At##8[m]), "v"(sclB_), "v"(sclA_));     \
        } else { _Pragma("unroll") for (int m = 0; m < 4; ++m) _Pragma("unroll") for (int n = 0; n < 2; ++n) _Pragma("unroll") for (int k = 0; k < 2; ++k) \
        acc[ai][bj][m][n] = __builtin_amdgcn_mfma_f32_16x16x32_bf16(Bt[n][k], At[m][k], acc[ai][bj][m][n], 0, 0, 0); } __builtin_amdgcn_s_setprio(0); } while (0)
#define PG8_WAIT_V(n) asm volatile("s_waitcnt vmcnt(" #n ")" ::: "memory")
#define PG8_WAIT_L(n) asm volatile("s_waitcnt lgkmcnt(" #n ")" ::: "memory")
#define PG8_BAR __builtin_amdgcn_s_barrier()
#define PG8_SCHED __builtin_amdgcn_sched_barrier(0)
    Unit cur, nxt; int ui = 0;
    if (!S.next(0, cur)) return;
    f32x4 acc[2][2][4][2];
#pragma unroll
    for (int a = 0; a < 2; ++a)
#pragma unroll
        for (int b = 0; b < 2; ++b)
#pragma unroll
            for (int m = 0; m < 4; ++m)
#pragma unroll
                for (int n = 0; n < 2; ++n) acc[a][b][m][n] = (f32x4){0.f, 0.f, 0.f, 0.f};
    const int sclB_ = Sched::SCALE_B, sclA_ = 127;
    bf16x8 At[4][2], B0[2][2], B1[2][2]; pg8_v8i At8[4], B08[2], B18[2];
    const char* cA = S.aptr(cur); const char* cB = S.bptr(cur);
    S.a_ready(cur);
    if constexpr (Sched::GATHER) {
#pragma unroll
        for (int h = 0; h < 2; ++h)
#pragma unroll
            for (int i = 0; i < 2; ++i) { vAc[h][i] = S.rowoff(cur, h * HALF + gR[i]) + (unsigned)gC[i] * 2u; vAn[h][i] = vAc[h][i]; }
        asm volatile("s_waitcnt vmcnt(0)" ::: "memory");
    }
    if constexpr (SP2) {
        PG8_STAGE(PG8_SB(0, 0), cB, voffB); PG8_STAGE(PG8_SB(0, 1), cB + hstep, voffB); PG8_STAGE_A(0, 0, cA, vAc); PG8_STAGE_A(0, 1, cA, vAc);
        if (wr == 1) PG8_BAR;
        PG8_WAIT_V(2); PG8_BAR;
        PG8_STAGE(PG8_SB(1, 0), cB + kstep, voffB); PG8_STAGE_A(1, 0, cA + kstep, vAc); PG8_STAGE(PG8_SB(1, 1), cB + hstep + kstep, voffB);
        PG8_WAIT_V(6); PG8_BAR;
    } else {
        PG8_STAGE(PG8_SB(0, 0), cB, voffB); PG8_STAGE_A(0, 0, cA, vAc); PG8_STAGE(PG8_SB(0, 1), cB + hstep, voffB); PG8_STAGE_A(0, 1, cA, vAc);
        if (wr == 1) PG8_BAR;
        PG8_WAIT_V(4); PG8_BAR;
        PG8_STAGE(PG8_SB(1, 0), cB + kstep, voffB); PG8_STAGE_A(1, 0, cA + kstep, vAc); PG8_STAGE(PG8_SB(1, 1), cB + hstep + kstep, voffB);
        PG8_WAIT_V(6); PG8_BAR;
    }
    for (;;) {
        const bool has_next = S.next(ui + 1, nxt);
        const char* nA = has_next ? S.aptr(nxt) : cA; const char* nB = has_next ? S.bptr(nxt) : cB;
        if constexpr (Sched::GATHER) { if (has_next) {
#pragma unroll
            for (int h = 0; h < 2; ++h)
#pragma unroll
                for (int i = 0; i < 2; ++i) vAn[h][i] = S.rowoff(nxt, h * HALF + gR[i]) + (unsigned)gC[i] * 2u; } }
        for (int t = 0; t < nt; t += 2) {
            const bool last = (t == nt - 2);
            const char* a1 = cA + (size_t)(t + 1) * kstep;
            const char* a2 = last ? nA : cA + (size_t)(t + 2) * kstep; const char* b2 = last ? nB : cB + (size_t)(t + 2) * kstep;
            const char* a3 = a2 + kstep; const char* b3 = b2 + kstep;
            if (last && has_next) S.a_ready(nxt);
            if constexpr (SP2) {
            PG8_LDB(B0, 0, 0); PG8_LDB(B1, 0, 1); PG8_SCHED; PG8_LDA(At, 0, 0); PG8_STAGE_A(1, 1, a1, vAc);
            PG8_WAIT_V(8); PG8_WAIT_L(0); PG8_BAR; PG8_MMA(0, 0, At, B0); PG8_MMA(0, 1, At, B1); PG8_BAR; PG8_SCHED;
            PG8_LDA(At, 0, 1); PG8_STAGE(PG8_SB(0, 0), b2, voffB); PG8_STAGE(PG8_SB(0, 1), b2 + hstep, voffB); PG8_STAGE_AN(0, 0, a2);
            PG8_WAIT_V(8); PG8_WAIT_L(0); PG8_BAR; PG8_MMA(1, 0, At, B0); PG8_MMA(1, 1, At, B1); PG8_BAR; PG8_SCHED;
            PG8_LDB(B0, 1, 0); PG8_LDB(B1, 1, 1); PG8_SCHED; PG8_LDA(At, 1, 0); PG8_STAGE_AN(0, 1, a2);
            PG8_WAIT_V(8); PG8_WAIT_L(0); PG8_BAR; PG8_MMA(0, 0, At, B0); PG8_MMA(0, 1, At, B1); PG8_BAR; PG8_SCHED;
            PG8_LDA(At, 1, 1); PG8_STAGE(PG8_SB(1, 0), b3, voffB); PG8_STAGE(PG8_SB(1, 1), b3 + hstep, voffB); PG8_STAGE_AN(1, 0, a3);
            PG8_WAIT_V(8); PG8_WAIT_L(0); PG8_BAR; PG8_MMA(1, 0, At, B0); PG8_MMA(1, 1, At, B1); PG8_BAR; PG8_SCHED;
            } else {
            PG8_LDB(B0, 0, 0); PG8_SCHED; PG8_LDA(At, 0, 0); PG8_STAGE_A(1, 1, a1, vAc);
            PG8_WAIT_L(8); PG8_BAR; PG8_WAIT_L(0); PG8_MMA(0, 0, At, B0); PG8_BAR; PG8_SCHED;
            PG8_LDB(B1, 0, 1); PG8_STAGE(PG8_SB(0, 0), b2, voffB);
            PG8_BAR; PG8_WAIT_L(0); PG8_MMA(0, 1, At, B1); PG8_BAR;
            PG8_LDA(At, 0, 1); PG8_STAGE_AN(0, 0, a2);
            PG8_BAR; PG8_WAIT_L(0); PG8_MMA(1, 0, At, B0); PG8_BAR; PG8_SCHED;
            PG8_STAGE(PG8_SB(0, 1), b2 + hstep, voffB);
            PG8_WAIT_V(6); PG8_BAR; PG8_MMA(1, 1, At, B1); PG8_BAR;
            PG8_LDB(B0, 1, 0); PG8_SCHED; PG8_LDA(At, 1, 0); PG8_STAGE_AN(0, 1, a2);
            PG8_WAIT_L(8); PG8_BAR; PG8_WAIT_L(0); PG8_MMA(0, 0, At, B0); PG8_BAR; PG8_SCHED;
            PG8_LDB(B1, 1, 1); PG8_STAGE(PG8_SB(1, 0), b3, voffB);
            PG8_BAR; PG8_WAIT_L(0); PG8_MMA(0, 1, At, B1); PG8_BAR;
            PG8_LDA(At, 1, 1); PG8_STAGE_AN(1, 0, a3);
            PG8_BAR; PG8_WAIT_L(0); PG8_MMA(1, 0, At, B0); PG8_BAR; PG8_SCHED;
            PG8_STAGE(PG8_SB(1, 1), b3 + hstep, voffB);
            PG8_WAIT_V(6); PG8_BAR; PG8_MMA(1, 1, At, B1); PG8_BAR;
            }
        }
        if constexpr (ALIGN_EPI) { if (wr == 0) PG8_BAR; }
        if constexpr (!Epi::AFTER_DRAIN) { E(acc, cur, wr, wc, fr, fq); S.done(cur); }
        if (!has_next) break;
#pragma unroll
        for (int a = 0; a < 2; ++a)
#pragma unroll
            for (int b = 0; b < 2; ++b)
#pragma unroll
                for (int m = 0; m < 4; ++m)
#pragma unroll
                    for (int n = 0; n < 2; ++n) acc[a][b][m][n] = (f32x4){0.f, 0.f, 0.f, 0.f};
        cur = nxt; cA = nA; cB = nB; ++ui;
        if constexpr (Sched::GATHER) {
#pragma unroll
            for (int h = 0; h < 2; ++h)
#pragma unroll
                for (int i = 0; i < 2; ++i) vAc[h][i] = vAn[h][i]; }
        if constexpr (ALIGN_EPI) { if (wr == 1) PG8_BAR; }
    }
    PG8_WAIT_V(0);
    if constexpr (!ALIGN_EPI) { if (wr == 0) PG8_BAR; }
    PG8_BAR;
    if constexpr (Epi::AFTER_DRAIN) { E.fused(acc, cur, wr, wc, fr, fq, lds, wid, lane); S.done(cur); }
#undef PG8_SA
#undef PG8_SB
#undef PG8_STAGE
#undef PG8_STAGE_A
#undef PG8_STAGE_AN
#undef PG8_LDA
#undef PG8_LDB
#undef PG8_MMA
#undef PG8_WAIT_V
#undef PG8_WAIT_L
#undef PG8_BAR
#undef PG8_SCHED
}
}

constexpr int T = 8192, D = 2048, MIXW = 1536, MEMW = 512, NINA = 3584, DEPTH = 4, NE = 32, FF = 512, MEMT = 256;
constexpr int SLOTS = 24576;
constexpr float LN_EPS = 1e-5f;
constexpr float DN_ALPHA = 1.6817928305074292f;
constexpr float LOG2E = 1.4426950408889634f;
constexpr float QSCALE = 0.08838834764831845f * LOG2E;
constexpr int NWAVES = 8;

constexpr size_t MiB = 1u << 20;
constexpr size_t WS_CTL = 0, CTL_ZERO_BYTES = 1 * MiB;
constexpr size_t WS_WAIN = 2 * MiB, WS_WAOUT = 30 * MiB, WS_WBIN0 = 46 * MiB, WS_WKV = 54 * MiB, WS_WBIN1 = 66 * MiB, WS_WBOUT = 74 * MiB, WS_WMKV = 90 * MiB;
constexpr size_t WS_W13 = 106 * MiB, WS_W2 = 618 * MiB;
constexpr size_t WS_XB = 874 * MiB, WS_MEMB = 906 * MiB, WS_MEMKV = 907 * MiB, WS_Z = 910 * MiB, WS_KD = 966 * MiB, WS_VD = 990 * MiB, WS_CAT = 1014 * MiB;
constexpr size_t WS_XQ = 1206 * MiB, WS_ZQ = 1222 * MiB, WS_MEMQ = 1238 * MiB, WS_CATQ = 1246 * MiB;
constexpr size_t WS_Y = 1046 * MiB, WS_X1F = 1110 * MiB, WS_X1B = 1174 * MiB, WS_XF = 1206 * MiB, WS_XG = 1270 * MiB, WS_H = 1366 * MiB, WS_YB = 1390 * MiB, WS_OP = 1486 * MiB;
constexpr size_t WS_ROUTE = 1582 * MiB, WS_OP2 = 1583 * MiB, WS_ML = 1631 * MiB, WS_WR = 1634 * MiB, WS_TS = 1640 * MiB, WS_LIST = 1641 * MiB, WS_END = 1642 * MiB;
constexpr int CW_TMO = 0, CW_BAR = 4096, CW_CNT = 16384, CW_Q = 28672, CW_CONV = 29184, CW_DONE = 32768, CW_FIN = 40960;

constexpr int RING_OFF = 0, RING_BYTES = 131072;
constexpr int LDSCTL_OFF = 146432, MISC_OFF = LDSCTL_OFF + 320, TAB_OFF = LDSCTL_OFF + 512;
constexpr int LDS_BYTES = 147456;

#define GAS __attribute__((address_space(1)))
#define LAS __attribute__((address_space(3)))
typedef unsigned short bf16;
typedef unsigned v4u __attribute__((ext_vector_type(4)));
typedef unsigned v2u __attribute__((ext_vector_type(2)));
typedef float f32x4 __attribute__((ext_vector_type(4)));
typedef short bf16x8 __attribute__((ext_vector_type(8)));
typedef GAS unsigned gu32;
#define RLX_AGENT __ATOMIC_RELAXED, __HIP_MEMORY_SCOPE_AGENT
#define LDS_WAIT() asm volatile("s_waitcnt lgkmcnt(0)" ::: "memory")
#define VM_WAIT() asm volatile("s_waitcnt vmcnt(0)" ::: "memory")
__device__ __forceinline__ unsigned f2bf(float f) { unsigned u = __builtin_bit_cast(unsigned, f); return (u + 0x7fffu + ((u >> 16) & 1u)) >> 16; }
__device__ __forceinline__ unsigned pk2(float lo, float hi) { return f2bf(lo) | (f2bf(hi) << 16); }
__device__ __forceinline__ float bf2f(unsigned short b) { return __builtin_bit_cast(float, (unsigned)b << 16); }
__device__ __forceinline__ float bflo(unsigned w) { return __builtin_bit_cast(float, w << 16); }
__device__ __forceinline__ float bfhi(unsigned w) { return __builtin_bit_cast(float, w & 0xffff0000u); }
__device__ __forceinline__ float wave_sum(float v) {
#pragma unroll
    for (int o = 1; o < 64; o <<= 1) v += __shfl_xor(v, o);
    return v;
}

namespace pg8 {
struct DenseOrder {
    static constexpr bool GATHER = false, F8 = false; static constexpr int SCALE_B = 127;
    StaticOrder so; const char* A; const char* B; size_t astep, bstep;
    __device__ void init(const void* A_, const void* B_, int M, int N, int K, int G, int c) { so.init(M, N, G, c); A = (const char*)A_; B = (const char*)B_; astep = (size_t)256 * K * 2; bstep = astep; }
    __device__ __forceinline__ bool next(int i, Unit& u) const { u.e = 0; return so.next(i, u); }
    __device__ __forceinline__ const char* aptr(const Unit& u) const { return A + (size_t)u.pm * astep; }
    __device__ __forceinline__ const char* bptr(const Unit& u) const { return B + (size_t)u.pn * bstep; }
    __device__ __forceinline__ void a_ready(const Unit&) const {}
    __device__ __forceinline__ void done(const Unit&) const {}
};
struct DenseOrder8 {
    static constexpr bool GATHER = false, F8 = true; static constexpr int SCALE_B = 121;
    StaticOrder so; const char* A; const char* B; size_t astep, bstep;
    __device__ void init(const void* A_, const void* B_, int M, int N, int K, int G, int c) { so.init(M, N, G, c); A = (const char*)A_; B = (const char*)B_; astep = (size_t)256 * K * 2; bstep = astep; }
    __device__ __forceinline__ bool next(int i, Unit& u) const { u.e = 0; return so.next(i, u); }
    __device__ __forceinline__ const char* aptr(const Unit& u) const { return A + (size_t)u.pm * astep; }
    __device__ __forceinline__ const char* bptr(const Unit& u) const { return B + (size_t)u.pn * bstep; }
    __device__ __forceinline__ void a_ready(const Unit&) const {}
    __device__ __forceinline__ void done(const Unit&) const {}
};
struct DualOrder {
    static constexpr bool GATHER = false, F8 = false; static constexpr int SCALE_B = 127;
    StaticOrder so; int nwg2; const char* A; const char* B; const char* A2; const char* B2; size_t step;
    __device__ void init(const void* A_, const void* B_, int M, int N, int K, int G, int c, const void* A2_, const void* B2_, int nwg2_) { so.init(M, N, G, c); A = (const char*)A_; B = (const char*)B_; A2 = (const char*)A2_; B2 = (const char*)B2_; nwg2 = nwg2_; step = (size_t)256 * K * 2; }
    __device__ __forceinline__ bool next(int i, Unit& u) const { const int L = i * so.G + so.c; if (L < so.nwg) { u.e = 0; return so.next(i, u); } if (L - so.nwg >= nwg2) return false; u.e = 1; u.pm = 0; u.pn = L - so.nwg; return true; }
    __device__ __forceinline__ const char* aptr(const Unit& u) const { return u.e ? A2 : A + (size_t)u.pm * step; }
    __device__ __forceinline__ const char* bptr(const Unit& u) const { return (u.e ? B2 : B) + (size_t)u.pn * step; }
    __device__ __forceinline__ void a_ready(const Unit&) const {}
    __device__ __forceinline__ void done(const Unit&) const {}
};
struct DualOrder8 {
    static constexpr bool GATHER = false, F8 = true; static constexpr int SCALE_B = 121;
    StaticOrder so; int nwg2; const char* A; const char* B; const char* A2; const char* B2; size_t step;
    __device__ void init(const void* A_, const void* B_, int M, int N, int K, int G, int c, const void* A2_, const void* B2_, int nwg2_) { so.init(M, N, G, c); A = (const char*)A_; B = (const char*)B_; A2 = (const char*)A2_; B2 = (const char*)B2_; nwg2 = nwg2_; step = (size_t)256 * K * 2; }
    __device__ __forceinline__ bool next(int i, Unit& u) const { const int L = i * so.G + so.c; if (L < so.nwg) { u.e = 0; return so.next(i, u); } if (L - so.nwg >= nwg2) return false; u.e = 1; u.pm = 0; u.pn = L - so.nwg; return true; }
    __device__ __forceinline__ const char* aptr(const Unit& u) const { return u.e ? A2 : A + (size_t)u.pm * step; }
    __device__ __forceinline__ const char* bptr(const Unit& u) const { return (u.e ? B2 : B) + (size_t)u.pn * step; }
    __device__ __forceinline__ void a_ready(const Unit&) const {}
    __device__ __forceinline__ void done(const Unit&) const {}
};
struct MoeOrder {
    static constexpr bool GATHER = false, F8 = false; static constexpr int SCALE_B = 127;
    const PG8_LAS int* tstart; int ntn, G, c; const char* A; const char* W; size_t astep, wexp, wtile;
    __device__ __forceinline__ bool next(int i, Unit& u) const {
        const int L = i * G + c, total = tstart[32] * ntn; if (L >= total) return false;
        int wgid; { const int q = total / NXCD, r = total % NXCD, xcd = L % NXCD, off = L / NXCD; wgid = (xcd < r ? xcd * (q + 1) : r * (q + 1) + (xcd - r) * q) + off; }
        u.pm = wgid / ntn; u.pn = wgid - u.pm * ntn; int e = 0;
#pragma unroll
        for (int k = 1; k <= 31; ++k) e += (tstart[k] <= u.pm) ? 1 : 0;
        u.e = e; return true;
    }
    __device__ __forceinline__ const char* aptr(const Unit& u) const { return A + (size_t)u.pm * astep; }
    __device__ __forceinline__ const char* bptr(const Unit& u) const { return W + (size_t)u.e * wexp + (size_t)u.pn * wtile; }
    __device__ __forceinline__ void a_ready(const Unit&) const {}
    __device__ __forceinline__ void done(const Unit&) const {}
};

struct MoeOrder8 {
    static constexpr bool GATHER = false, F8 = true; static constexpr int SCALE_B = 121;
    const PG8_LAS int* tstart; int ntn, G, c; const char* A; const char* W; size_t astep, wexp, wtile;
    __device__ __forceinline__ bool next(int i, Unit& u) const {
        const int L = i * G + c, total = tstart[32] * ntn; if (L >= total) return false;
        int wgid; { const int q = total / NXCD, r = total % NXCD, xcd = L % NXCD, off = L / NXCD; wgid = (xcd < r ? xcd * (q + 1) : r * (q + 1) + (xcd - r) * q) + off; }
        u.pm = wgid / ntn; u.pn = wgid - u.pm * ntn; int e = 0;
#pragma unroll
        for (int k = 1; k <= 31; ++k) e += (tstart[k] <= u.pm) ? 1 : 0;
        u.e = e; return true;
    }
    __device__ __forceinline__ const char* aptr(const Unit& u) const { return A + (size_t)u.pm * astep; }
    __device__ __forceinline__ const char* bptr(const Unit& u) const { return W + (size_t)u.e * wexp + (size_t)u.pn * wtile; }
    __device__ __forceinline__ void a_ready(const Unit&) const {}
    __device__ __forceinline__ void done(const Unit&) const {}
};

struct MoeGatherOrder {
    static constexpr bool GATHER = true, F8 = true; static constexpr int SCALE_B = 121;
    const PG8_LAS int* tstart; const PG8_LAS int* cntl; const int* list; int ntn, G, c; const char* A; const char* W; size_t wexp, wtile; unsigned rowbytes;
    __device__ __forceinline__ bool next(int i, Unit& u) const {
        const int L = i * G + c, total = tstart[32] * ntn; if (L >= total) return false;
        int wgid; { const int q = total / NXCD, r = total % NXCD, xcd = L % NXCD, off = L / NXCD; wgid = (xcd < r ? xcd * (q + 1) : r * (q + 1) + (xcd - r) * q) + off; }
        u.pm = wgid / ntn; u.pn = wgid - u.pm * ntn; int e = 0;
#pragma unroll
        for (int k = 1; k <= 31; ++k) e += (tstart[k] <= u.pm) ? 1 : 0;
        u.e = e; return true;
    }
    __device__ __forceinline__ unsigned rowoff(const Unit& u, int r) const { const int rank = (u.pm - tstart[u.e]) * 256 + r; const int tok = list[u.e * 8192 + (rank < cntl[u.e] ? rank : 0)]; return (unsigned)tok * rowbytes; }
    __device__ __forceinline__ const char* aptr(const Unit&) const { return A; }
    __device__ __forceinline__ const char* bptr(const Unit& u) const { return W + (size_t)u.e * wexp + (size_t)u.pn * wtile; }
    __device__ __forceinline__ void a_ready(const Unit&) const {}
    __device__ __forceinline__ void done(const Unit&) const {}
};

typedef unsigned u32x2 __attribute__((ext_vector_type(2)));
struct EpiBf16X {
    static constexpr bool PERM = true, AFTER_DRAIN = false;
    int mode; bf16_t* p0; bf16_t* p1; bf16_t* p2; bf16_t* p3;
    const PG8_LAS int* tstart; const PG8_LAS int* cntl;
    __device__ __forceinline__ void operator()(const f32x4 (&acc)[2][2][4][2], const Unit& u, int wr, int wc, int fr, int fq) const {
#ifndef ATT_BF16
        if (mode == 1 && !u.e) {
            int tok0 = u.pm * BM + wr * 64 + fr, cc0 = wc * 32 + 8 * fq; asm volatile("" : "+v"(tok0), "+v"(cc0));
            if (u.pn >= 14) { const int colv = (u.pn - 14) * BM + cc0; unsigned char* vb = (unsigned char*)p2 + ((size_t)((colv >> 8) * 128 + (tok0 >> 6)) * 256 + (colv & 255)) * 64 + (tok0 & 63);
#pragma unroll
                for (int ai = 0; ai < 2; ++ai)
#pragma unroll
                    for (int m = 0; m < 4; ++m)
#pragma unroll
                        for (int bj = 0; bj < 2; ++bj) { const f32x4 v0 = acc[ai][bj][m][0], v1 = acc[ai][bj][m][1]; unsigned a_ = 0u, b_ = 0u;
                            a_ = __builtin_amdgcn_cvt_pk_fp8_f32(v0[0], v0[1], a_, false); a_ = __builtin_amdgcn_cvt_pk_fp8_f32(v0[2], v0[3], a_, true); b_ = __builtin_amdgcn_cvt_pk_fp8_f32(v1[0], v1[1], b_, false); b_ = __builtin_amdgcn_cvt_pk_fp8_f32(v1[2], v1[3], b_, true);
                            unsigned char* vp = vb + (size_t)(ai * 2) * 16384 + m * 16 + (size_t)bj * HALF * 64;
                            vp[0] = (unsigned char)a_; vp[64] = (unsigned char)(a_ >> 8); vp[128] = (unsigned char)(a_ >> 16); vp[192] = (unsigned char)(a_ >> 24);
                            vp[256] = (unsigned char)b_; vp[320] = (unsigned char)(b_ >> 8); vp[384] = (unsigned char)(b_ >> 16); vp[448] = (unsigned char)(b_ >> 24); }
                return; }
            if (u.pn >= 8) { unsigned char* kb = (unsigned char*)p1 + (size_t)tok0 * 1536 + (u.pn - 8) * BM + cc0;
#pragma unroll
                for (int ai = 0; ai < 2; ++ai)
#pragma unroll
                    for (int m = 0; m < 4; ++m)
#pragma unroll
                        for (int bj = 0; bj < 2; ++bj) { const f32x4 v0 = acc[ai][bj][m][0], v1 = acc[ai][bj][m][1]; unsigned a_ = 0u, b_ = 0u;
                            a_ = __builtin_amdgcn_cvt_pk_fp8_f32(v0[0], v0[1], a_, false); a_ = __builtin_amdgcn_cvt_pk_fp8_f32(v0[2], v0[3], a_, true); b_ = __builtin_amdgcn_cvt_pk_fp8_f32(v1[0], v1[1], b_, false); b_ = __builtin_amdgcn_cvt_pk_fp8_f32(v1[2], v1[3], b_, true);
                            u32x2 kk; kk.x = a_; kk.y = b_; *(u32x2*)(kb + (size_t)(ai * HALF + m * 16) * 1536 + bj * HALF) = kk; }
                return; }
            { unsigned char* qb = (unsigned char*)p0 + (WS_ZQ - WS_Z) + (size_t)tok0 * 2048 + u.pn * BM + cc0; bf16_t* zb = p0 + (size_t)tok0 * 2048 + u.pn * BM + cc0;
#pragma unroll
                for (int ai = 0; ai < 2; ++ai)
#pragma unroll
                    for (int m = 0; m < 4; ++m)
#pragma unroll
                        for (int bj = 0; bj < 2; ++bj) { const f32x4 v0 = acc[ai][bj][m][0] * QSCALE, v1 = acc[ai][bj][m][1] * QSCALE; unsigned a_ = 0u, b_ = 0u;
                            a_ = __builtin_amdgcn_cvt_pk_fp8_f32(v0[0], v0[1], a_, false); a_ = __builtin_amdgcn_cvt_pk_fp8_f32(v0[2], v0[3], a_, true); b_ = __builtin_amdgcn_cvt_pk_fp8_f32(v1[0], v1[1], b_, false); b_ = __builtin_amdgcn_cvt_pk_fp8_f32(v1[2], v1[3], b_, true);
                            const size_t o_ = (size_t)(ai * HALF + m * 16) * 2048 + bj * HALF;
                            u32x2 qq; qq.x = a_; qq.y = b_; *(u32x2*)(qb + o_) = qq;
                            u32x4 w; w.x = cvt_pk_bf16(v0[0], v0[1]); w.y = cvt_pk_bf16(v0[2], v0[3]); w.z = cvt_pk_bf16(v1[0], v1[1]); w.w = cvt_pk_bf16(v1[2], v1[3]); *(u32x4*)(zb + o_) = w; }
                return; }
        }
#endif
        if (mode == 3) {
            int r0_ = wr * 64 + fr, c0_ = u.pn * BM + wc * 32 + 8 * fq; asm volatile("" : "+v"(r0_), "+v"(c0_));
            const int rlim = cntl[u.e] - (u.pm - tstart[u.e]) * BM;
            unsigned char* yb_ = (unsigned char*)p0 + (size_t)(u.pm * BM + r0_) * 2048 + c0_;
#pragma unroll
            for (int ai = 0; ai < 2; ++ai)
#pragma unroll
                for (int m = 0; m < 4; ++m) { if (r0_ + ai * HALF + m * 16 >= rlim) continue;
#pragma unroll
                    for (int bj = 0; bj < 2; ++bj) { const f32x4 v0 = acc[ai][bj][m][0] * 16.f, v1 = acc[ai][bj][m][1] * 16.f; unsigned a_ = 0u, b_ = 0u;
                        a_ = __builtin_amdgcn_cvt_pk_fp8_f32(v0[0], v0[1], a_, false); a_ = __builtin_amdgcn_cvt_pk_fp8_f32(v0[2], v0[3], a_, true); b_ = __builtin_amdgcn_cvt_pk_fp8_f32(v1[0], v1[1], b_, false); b_ = __builtin_amdgcn_cvt_pk_fp8_f32(v1[2], v1[3], b_, true);
                        u32x2 q_; q_.x = a_; q_.y = b_; *(u32x2*)(yb_ + (size_t)(ai * HALF + m * 16) * 2048 + bj * HALF) = q_; } }
            return; }
        bf16_t* base; int ldc, colt; bool act = false; float sc = 1.f;
        if (u.e && mode < 2) { base = p3 + (size_t)(u.pn >> 2) * (256 * 1024); ldc = 1024; colt = (u.pn & 3) * BM; }
        else if (mode == 0) { base = p0; ldc = 3584; colt = u.pn * BM; act = u.pn < 12; if (u.pn >= 12) sc = QSCALE; }
        else if (mode == 1) { if (u.pn < 8) { base = p0; ldc = 2048; colt = u.pn * BM; sc = QSCALE; }
                              else if (u.pn < 14) { base = p1; ldc = 1536; colt = (u.pn - 8) * BM; } else { base = p2; ldc = 1536; colt = (u.pn - 14) * BM; } }
        else { base = p0; ldc = 2048; colt = u.pn * BM; }
        const int row0 = u.pm * BM + wr * 64 + fr, col0 = colt + wc * 32 + 8 * fq;
        const int rlim = (mode == 3) ? cntl[u.e] - (u.pm - tstart[u.e]) * BM : BM;
#pragma unroll
        for (int ai = 0; ai < 2; ++ai)
#pragma unroll
            for (int m = 0; m < 4; ++m) { bf16_t* rowp = base + (size_t)(row0 + ai * HALF + m * 16) * ldc + col0;
                if (wr * 64 + fr + ai * HALF + m * 16 >= rlim) continue;
#pragma unroll
                for (int bj = 0; bj < 2; ++bj) { f32x4 v0 = acc[ai][bj][m][0], v1 = acc[ai][bj][m][1];
                    if (act) { f32x2 a = gelu_pk((f32x2){v0[0], v0[1]}), b = gelu_pk((f32x2){v0[2], v0[3]}), c = gelu_pk((f32x2){v1[0], v1[1]}), d = gelu_pk((f32x2){v1[2], v1[3]});
                        v0 = (f32x4){a.x, a.y, b.x, b.y}; v1 = (f32x4){c.x, c.y, d.x, d.y}; }
                    v0 = v0 * sc; v1 = v1 * sc; u32x4 w; w.x = cvt_pk_bf16(v0[0], v0[1]); w.y = cvt_pk_bf16(v0[2], v0[3]); w.z = cvt_pk_bf16(v1[0], v1[1]); w.w = cvt_pk_bf16(v1[2], v1[3]);
                    *(u32x4*)(rowp + bj * HALF) = w; } }
    }
};
struct EpiResBf16 {
    static constexpr bool PERM = true, AFTER_DRAIN = false;
    const bf16_t* xres; bf16_t* y; float alpha;
    __device__ __forceinline__ void operator()(const f32x4 (&acc)[2][2][4][2], const Unit& u, int wr, int wc, int fr, int fq) const {
        const int row0 = u.pm * BM + wr * 64 + fr, col0 = u.pn * BM + wc * 32 + 8 * fq;
#pragma unroll
        for (int ai = 0; ai < 2; ++ai)
#pragma unroll
            for (int m = 0; m < 4; ++m) { const size_t off = (size_t)(row0 + ai * HALF + m * 16) * 2048 + col0;
#pragma unroll
                for (int bj = 0; bj < 2; ++bj) { const u32x4 xr = *(const u32x4*)(xres + off + bj * HALF); const f32x4 v0 = acc[ai][bj][m][0], v1 = acc[ai][bj][m][1]; u32x4 w;
                    w.x = cvt_pk_bf16(__builtin_bit_cast(float, xr.x << 16) * alpha + v0[0], __builtin_bit_cast(float, xr.x & 0xffff0000u) * alpha + v0[1]);
                    w.y = cvt_pk_bf16(__builtin_bit_cast(float, xr.y << 16) * alpha + v0[2], __builtin_bit_cast(float, xr.y & 0xffff0000u) * alpha + v0[3]);
                    w.z = cvt_pk_bf16(__builtin_bit_cast(float, xr.z << 16) * alpha + v1[0], __builtin_bit_cast(float, xr.z & 0xffff0000u) * alpha + v1[1]);
                    w.w = cvt_pk_bf16(__builtin_bit_cast(float, xr.w << 16) * alpha + v1[2], __builtin_bit_cast(float, xr.w & 0xffff0000u) * alpha + v1[3]);
                    *(u32x4*)(y + off + bj * HALF) = w; } }
    }
};
struct EpiMoe1 {
    static constexpr bool PERM = true, AFTER_DRAIN = false;
    bf16_t* h; const PG8_LAS int* tstart; const PG8_LAS int* cntl;
    __device__ __forceinline__ void operator()(const f32x4 (&acc)[2][2][4][2], const Unit& u, int wr, int wc, int fr, int fq) const {
        const int row0 = u.pm * BM + wr * 64 + fr, col0 = u.pn * HALF + wc * 32 + 8 * fq;
        const int rlim = cntl[u.e] - (u.pm - tstart[u.e]) * BM;
#pragma unroll
        for (int ai = 0; ai < 2; ++ai)
#pragma unroll
            for (int m = 0; m < 4; ++m) { unsigned char* rowp = (unsigned char*)h + (size_t)(row0 + ai * HALF + m * 16) * 512 + col0; float o[8];
                if (wr * 64 + fr + ai * HALF + m * 16 >= rlim) continue;
#pragma unroll
                for (int n = 0; n < 2; ++n)
#pragma unroll
                    for (int x = 0; x < 4; ++x) { const float a = acc[ai][0][m][n][x], b = acc[ai][1][m][n][x];
                        o[n * 4 + x] = a * __builtin_amdgcn_rcpf(1.0f + __builtin_amdgcn_exp2f(-a * LOG2E)) * b; }
                unsigned lo = 0u, hi = 0u; lo = __builtin_amdgcn_cvt_pk_fp8_f32(o[0], o[1], lo, false); lo = __builtin_amdgcn_cvt_pk_fp8_f32(o[2], o[3], lo, true);
                hi = __builtin_amdgcn_cvt_pk_fp8_f32(o[4], o[5], hi, false); hi = __builtin_amdgcn_cvt_pk_fp8_f32(o[6], o[7], hi, true);
                typedef unsigned u32x2e __attribute__((ext_vector_type(2))); u32x2e w; w.x = lo; w.y = hi; *(u32x2e*)rowp = w; }
    }
};
}

namespace att {
using bf16x8 = __attribute__((ext_vector_type(8))) short;
using s16x4  = __attribute__((ext_vector_type(4))) short;
using f32x16 = __attribute__((ext_vector_type(16))) float;
using u32x4  = __attribute__((ext_vector_type(4))) unsigned;
constexpr int DH = 128, QBLK = 32, KVBLK = 64;
constexpr float THR2 = 8.f * 1.4426950408889634f;
constexpr size_t SHM_V = KVBLK * DH * 2, SHM_K = KVBLK * DH * 2, SHM_ATTN = 2 * SHM_V + 2 * SHM_K + NWAVES * 64 * 4;
constexpr int TAB_N = 160;
#define KSWZ(row, colB) ((row) * 256 + ((colB) ^ (((row) & 7) << 4)))
#define SBAR() __builtin_amdgcn_sched_barrier(0)
__device__ __forceinline__ int crow(int r, int hi) { return (r & 3) + 8 * (r >> 2) + 4 * hi; }
__device__ __forceinline__ unsigned cvtpk(float lo, float hi) { unsigned r; asm volatile("v_cvt_pk_bf16_f32 %0, %1, %2" : "=v"(r) : "v"(lo), "v"(hi)); return r; }

__device__ __forceinline__ void partialSM(f32x16& p0, f32x16& p1, float& m_reg, float& mn, float& alpha) {
  float pmax = p0[0];
#pragma unroll
  for (int r = 1; r < 16; ++r) pmax = fmaxf(pmax, p0[r]);
#pragma unroll
  for (int r = 0; r < 16; ++r) pmax = fmaxf(pmax, p1[r]);
  { auto rr = __builtin_amdgcn_permlane32_swap(__float_as_uint(pmax), __float_as_uint(pmax), false, false);
    pmax = fmaxf(__uint_as_float(rr[0]), __uint_as_float(rr[1])); }
  if (__builtin_expect(__all(pmax - m_reg <= THR2), 1)) { mn = m_reg; alpha = 1.f; }
  else { mn = fmaxf(m_reg, pmax); alpha = __builtin_amdgcn_exp2f(m_reg - mn); m_reg = mn; }
#pragma unroll
  for (int r = 0; r < 16; ++r) p0[r] = p0[r] - mn;
#pragma unroll
  for (int r = 0; r < 16; ++r) p1[r] = p1[r] - mn;
#pragma unroll
  for (int r = 0; r < 16; ++r) p0[r] = __builtin_amdgcn_exp2f(p0[r]);
}
__device__ __forceinline__ void finishSM(f32x16& p0, f32x16& p1, float alpha, float& l_reg, bf16x8& pa0, bf16x8& pa1, bf16x8& pa2, bf16x8& pa3) {
#pragma unroll
  for (int r = 0; r < 16; ++r) p1[r] = __builtin_amdgcn_exp2f(p1[r]);
  float ps = 0;
#pragma unroll
  for (int r = 0; r < 16; ++r) ps += p0[r];
#pragma unroll
  for (int r = 0; r < 16; ++r) ps += p1[r];
  { auto rr = __builtin_amdgcn_permlane32_swap(__float_as_uint(ps), __float_as_uint(ps), false, false);
    ps = __uint_as_float(rr[0]) + __uint_as_float(rr[1]); }
  l_reg = l_reg * alpha + ps;
#define PK4(P, BASE, OUT) do { unsigned a0 = cvtpk(P[BASE + 0], P[BASE + 1]), a1 = cvtpk(P[BASE + 2], P[BASE + 3]);   \
    unsigned b0 = cvtpk(P[BASE + 4], P[BASE + 5]), b1 = cvtpk(P[BASE + 6], P[BASE + 7]);                              \
    auto r0 = __builtin_amdgcn_permlane32_swap(a0, b0, false, false); auto r1 = __builtin_amdgcn_permlane32_swap(a1, b1, false, false); \
    u32x4 w = {r0[0], r1[0], r0[1], r1[1]}; OUT = *reinterpret_cast<bf16x8*>(&w); } while (0)
  PK4(p0, 0, pa0); PK4(p0, 8, pa1); PK4(p1, 0, pa2); PK4(p1, 8, pa3);
#undef PK4
}
__device__ __forceinline__ void qkt(f32x16& p0, f32x16& p1, const char* Ks, const bf16x8* qr, int r32, int hi) {
  p0 = f32x16{}; p1 = f32x16{};
#pragma unroll
  for (int d0 = 0; d0 < 8; ++d0) { const int cb = (d0 * 16 + hi * 8) * 2;
    bf16x8 b0 = *reinterpret_cast<const bf16x8*>(Ks + KSWZ(r32, cb));
    bf16x8 b1 = *reinterpret_cast<const bf16x8*>(Ks + KSWZ(32 + r32, cb));
    p0 = __builtin_amdgcn_mfma_f32_32x32x16_bf16(b0, qr[d0], p0, 0, 0, 0);
    p1 = __builtin_amdgcn_mfma_f32_32x32x16_bf16(b1, qr[d0], p1, 0, 0, 0); }
}
__device__ __forceinline__ int v_st(int k, int c) { const int kk = (k & ~0xC) | ((k & 4) << 1) | ((k & 8) >> 1); return ((kk >> 3) * 4 + (c >> 5)) * 512 + ((kk & 7) * 32 + (c & 31)) * 2; }
__device__ __forceinline__ int v_rd_base(int lane) { return ((lane & 3) << 3) | (((lane >> 2) & 3) << 6) | (((lane >> 4) & 1) << 5) | (((lane >> 5) & 1) << 8); }
constexpr int v_rd_off(int d0, int ks, int half) { return d0 * 512 + ks * 4096 + half * 2048; }
template <int OFF> __device__ __forceinline__ s16x4 tr_read(int vb) {
  s16x4 r; asm volatile("ds_read_b64_tr_b16 %0, %1 offset:%2" : "=&v"(r) : "v"(vb), "i"(OFF) : "memory"); return r;
}
template <int D0> __device__ __forceinline__ void pv_one(f32x16& od, int vb, bf16x8 pa0, bf16x8 pa1, bf16x8 pa2, bf16x8 pa3) {
  const s16x4 l0 = tr_read<v_rd_off(D0, 0, 0)>(vb), h0 = tr_read<v_rd_off(D0, 0, 1)>(vb), l1 = tr_read<v_rd_off(D0, 1, 0)>(vb), h1 = tr_read<v_rd_off(D0, 1, 1)>(vb);
  const s16x4 l2 = tr_read<v_rd_off(D0, 2, 0)>(vb), h2 = tr_read<v_rd_off(D0, 2, 1)>(vb), l3 = tr_read<v_rd_off(D0, 3, 0)>(vb), h3 = tr_read<v_rd_off(D0, 3, 1)>(vb);
  asm volatile("s_waitcnt lgkmcnt(0)" ::: "memory"); SBAR();
#define PK(L, H) (bf16x8){L[0], L[1], L[2], L[3], H[0], H[1], H[2], H[3]}
  od = __builtin_amdgcn_mfma_f32_32x32x16_bf16(pa0, PK(l0, h0), od, 0, 0, 0);
  od = __builtin_amdgcn_mfma_f32_32x32x16_bf16(pa1, PK(l1, h1), od, 0, 0, 0);
  od = __builtin_amdgcn_mfma_f32_32x32x16_bf16(pa2, PK(l2, h2), od, 0, 0, 0);
  od = __builtin_amdgcn_mfma_f32_32x32x16_bf16(pa3, PK(l3, h3), od, 0, 0, 0);
#undef PK
}
__device__ __forceinline__ void pv_d0(f32x16* o, int vb, bf16x8 pa0, bf16x8 pa1, bf16x8 pa2, bf16x8 pa3) {
  pv_one<0>(o[0], vb, pa0, pa1, pa2, pa3); pv_one<1>(o[1], vb, pa0, pa1, pa2, pa3); pv_one<2>(o[2], vb, pa0, pa1, pa2, pa3); pv_one<3>(o[3], vb, pa0, pa1, pa2, pa3);
}
template <int MODE> __device__ __forceinline__ void post_scores(f32x16& p0, f32x16& p1, int t, int qrow0, int r32, int hi, const float* tab, float cfar) {
  if constexpr (MODE == 1) {
    const int cw = qrow0 >> 6;
    if (t > cw) {
#pragma unroll
      for (int r = 0; r < 16; ++r) { p0[r] = -INFINITY; p1[r] = -INFINITY; }
    } else if (qrow0 - (64 * t + 63) >= 91) {
#pragma unroll
      for (int r = 0; r < 16; ++r) { p0[r] += cfar; p1[r] += cfar; }
    } else {
      const int base = qrow0 + r32 - 64 * t + 63;
#pragma unroll
      for (int r = 0; r < 16; ++r) { const int i0 = base - crow(r, hi); const int i1 = i0 - 32;
        p0[r] += tab[i0 < TAB_N - 1 ? i0 : TAB_N - 1]; p1[r] += tab[i1 < TAB_N - 1 ? i1 : TAB_N - 1]; }
    }
  }
}

template <int MODE>
__device__ __forceinline__ void attn_body(const bf16* __restrict__ Qb, int ldq, const bf16* __restrict__ Kh, const bf16* __restrict__ Vh, int ldk,
                                          bf16* Ob, float* Of, int ldo, int NT, int q0abs, const float* tab, float cfar, char* lds) {
  int tid_ = threadIdx.x; asm volatile("" : "+v"(tid_));
  const int tid = tid_, wid = tid >> 6, lane = tid & 63, r32 = lane & 31, hi = lane >> 5;
  char* V_lds = lds; char* K_lds = lds + 2 * SHM_V;
  float* ws = (float*)(lds + 2 * SHM_V + 2 * SHM_K) + wid * 64; float* li_l = ws; float* al_l = ws + 32;
  float m_reg = -1e30f, l_reg = 0; f32x16 o[4] = {}; bf16x8 qr[8];
  const int qrow0 = q0abs + wid * QBLK;
  const bf16* Qw = Qb + (long)(wid * QBLK + r32) * ldq + hi * 8;
#pragma unroll
  for (int d0 = 0; d0 < 8; ++d0) qr[d0] = *reinterpret_cast<const bf16x8*>(Qw + d0 * 16);
  const int sr = tid >> 4, sc = (tid & 15) * 8, vst0 = v_st(sr, sc), vst1 = v_st(32 + sr, sc);
  const int vb0 = (int)(uintptr_t)V_lds + v_rd_base(lane);
  struct { bf16x8 vs0, vs1, ks0, ks1; } sr_[2];
#define SLOAD(i, k0) do { sr_[i].vs0 = *reinterpret_cast<const bf16x8*>(&Vh[(long)((k0) + sr) * ldk + sc]); sr_[i].vs1 = *reinterpret_cast<const bf16x8*>(&Vh[(long)((k0) + 32 + sr) * ldk + sc]); \
    sr_[i].ks0 = *reinterpret_cast<const bf16x8*>(&Kh[(long)((k0) + sr) * ldk + sc]); sr_[i].ks1 = *reinterpret_cast<const bf16x8*>(&Kh[(long)((k0) + 32 + sr) * ldk + sc]); } while (0)
#define SWRITE(b, i) do { *(bf16x8*)(V_lds + (b) * SHM_V + vst0) = sr_[i].vs0;          \
    *(bf16x8*)(V_lds + (b) * SHM_V + vst1) = sr_[i].vs1; const int kc = sc * 2;               \
    *(bf16x8*)(K_lds + (b) * SHM_K + KSWZ(sr, kc)) = sr_[i].ks0;                       \
    *(bf16x8*)(K_lds + (b) * SHM_K + KSWZ(32 + sr, kc)) = sr_[i].ks1; } while (0)
#define SWAIT() asm volatile("s_waitcnt vmcnt(4)" ::: "memory")
#define RESC(a) do { if (__any((a) < 1.f)) { if (hi == 0) al_l[r32] = (a); asm volatile("s_waitcnt lgkmcnt(0)" ::: "memory"); \
    _Pragma("unroll") for (int d = 0; d < 4; ++d) _Pragma("unroll") for (int r = 0; r < 16; ++r) o[d][r] *= al_l[crow(r, hi)]; } } while (0)
  f32x16 pA0, pA1, pB0, pB1; float mnA, mnB, alA, alB; bf16x8 pa0, pa1, pa2, pa3;
  constexpr int SE = 0, SO = 1;
  SLOAD(SE, 0); asm volatile("s_waitcnt vmcnt(0)" ::: "memory"); SWRITE(0, SE); __syncthreads();
  qkt(pA0, pA1, K_lds, qr, r32, hi); post_scores<MODE>(pA0, pA1, 0, qrow0, r32, hi, tab, cfar); partialSM(pA0, pA1, m_reg, mnA, alA);
  SLOAD(SO, KVBLK); if (2 < NT) SLOAD(SE, 2 * KVBLK);
  SWAIT(); SWRITE(1, SO); __syncthreads();
  for (int j = 1; j + 1 < NT; j += 2) {
    SBAR(); qkt(pB0, pB1, K_lds + SHM_K, qr, r32, hi); post_scores<MODE>(pB0, pB1, j, qrow0, r32, hi, tab, cfar);
    finishSM(pA0, pA1, alA, l_reg, pa0, pa1, pa2, pa3); SBAR();
    SLOAD(SO, (j + 2) * KVBLK); SBAR();
    pv_d0(o, vb0, pa0, pa1, pa2, pa3); partialSM(pB0, pB1, m_reg, mnB, alB);
    __syncthreads(); SWAIT(); SWRITE(0, SE);
    RESC(alB); __syncthreads();
    SBAR(); qkt(pA0, pA1, K_lds, qr, r32, hi); post_scores<MODE>(pA0, pA1, j + 1, qrow0, r32, hi, tab, cfar);
    finishSM(pB0, pB1, alB, l_reg, pa0, pa1, pa2, pa3); SBAR();
    if (j + 3 < NT) SLOAD(SE, (j + 3) * KVBLK); SBAR();
    pv_d0(o, vb0 + (int)SHM_V, pa0, pa1, pa2, pa3); partialSM(pA0, pA1, m_reg, mnA, alA);
    __syncthreads(); SWAIT(); SWRITE(1, SO);
    RESC(alA); __syncthreads();
  }
  SBAR(); qkt(pB0, pB1, K_lds + SHM_K, qr, r32, hi); post_scores<MODE>(pB0, pB1, NT - 1, qrow0, r32, hi, tab, cfar);
  finishSM(pA0, pA1, alA, l_reg, pa0, pa1, pa2, pa3); SBAR();
  pv_d0(o, vb0, pa0, pa1, pa2, pa3); partialSM(pB0, pB1, m_reg, mnB, alB);
  __syncthreads(); RESC(alB);
  finishSM(pB0, pB1, alB, l_reg, pa0, pa1, pa2, pa3); SBAR();
  pv_d0(o, vb0 + (int)SHM_V, pa0, pa1, pa2, pa3);
  if (hi == 0) li_l[r32] = l_reg; asm volatile("s_waitcnt lgkmcnt(0)" ::: "memory");
  float rli[16];
#pragma unroll
  for (int r = 0; r < 16; ++r) rli[r] = __builtin_amdgcn_rcpf(li_l[crow(r, hi)]);
  if constexpr (MODE == 0) {
    bf16* Ow = Ob + (long)(wid * QBLK) * ldo;
#pragma unroll
    for (int r = 0; r < 16; ++r) { const int orow = crow(r, hi);
#pragma unroll
      for (int d0 = 0; d0 < 4; ++d0) Ow[(long)orow * ldo + d0 * 32 + r32] = (bf16)f2bf(o[d0][r] * rli[r]); }
  } else {
    float* Ow = Of + (long)(wid * QBLK) * ldo;
#pragma unroll
    for (int r = 0; r < 16; ++r) { const int orow = crow(r, hi);
#pragma unroll
      for (int d0 = 0; d0 < 4; ++d0) Ow[(long)orow * ldo + d0 * 32 + r32] = o[d0][r] * rli[r]; }
  }
  __syncthreads();
#undef SLOAD
#undef SWRITE
#undef SWAIT
#undef RESC
}
}

#define XB_TMO      128
#define XB_XCNT(j)  (256  + 64 * (j))
#define XB_XSUB(j)  (1280 + 64 * (j))
#define XB_XGEN(j)  (2304 + 64 * (j))
#define XB_TOP      3328
#define XB_TOPGEN   3392
#define XCD_BAR_WORDS 3456
#define XB_SPIN_CAP (1u << 18)

__device__ __forceinline__ unsigned xb_ld(unsigned* p)              { return __hip_atomic_load(p, __ATOMIC_RELAXED, __HIP_MEMORY_SCOPE_AGENT); }
__device__ __forceinline__ unsigned xb_add(unsigned* p, unsigned v) { return __hip_atomic_fetch_add(p, v, __ATOMIC_RELAXED, __HIP_MEMORY_SCOPE_AGENT); }
__device__ __forceinline__ unsigned xb_xcc_id() { return (unsigned)__builtin_amdgcn_s_getreg((3 << 11) | 20) & 0xFu; }
#define XB_SPIN(cond, bar) do { unsigned _sp = 0; while (cond) { __builtin_amdgcn_s_sleep(1); \
    if ((++_sp & 255u) == 0u) { if (xb_ld(&(bar)[XB_TMO])) break; if (_sp > XB_SPIN_CAP) { atomicAdd(&(bar)[XB_TMO], 1u); break; } } } } while (0)

struct XcdBarrier {
    unsigned* bar; unsigned x;
    volatile LAS unsigned* st;
};

__device__ __forceinline__ XcdBarrier xcd_barrier_post(unsigned* bar, volatile LAS unsigned* st) {
    XcdBarrier b; b.bar = bar; b.x = xb_xcc_id(); b.st = st;
    if (threadIdx.x == 0) (void)xb_add(&bar[XB_XCNT(b.x)], 1u);
    return b;
}
__device__ __forceinline__ void xcd_barrier_complete(unsigned* bar, unsigned x, unsigned& nloc, unsigned& nx) {
    const unsigned G = gridDim.x * gridDim.y * gridDim.z;
    unsigned sum, cnt, mine, sp = 0u;
    for (;;) {
        sum = 0u; cnt = 0u; mine = 0u;
#pragma unroll
        for (unsigned j = 0; j < 16; ++j) { const unsigned c = xb_ld(&bar[XB_XCNT(j)]); sum += c; cnt += (c > 0u) ? 1u : 0u; mine = (j == x) ? c : mine; }
        if (sum == G) break;
        __builtin_amdgcn_s_sleep(1);
        if ((++sp & 255u) == 0u) { if (xb_ld(&bar[XB_TMO])) break; if (sp > XB_SPIN_CAP) { atomicAdd(&bar[XB_TMO], 1u); break; } }
    }
    nloc = mine > 0u ? mine : 1u; nx = cnt > 0u ? cnt : 1u;
}

__device__ __forceinline__ void xcd_barrier(const XcdBarrier& b) {
    asm volatile("s_waitcnt vmcnt(0)" ::: "memory");
    __syncthreads();
    if (threadIdx.x == 0) {
        unsigned* bar = b.bar;
        __builtin_amdgcn_s_waitcnt(0);
        unsigned nloc = b.st[0], nx = b.st[1];
        if (nloc == 0u) { xcd_barrier_complete(bar, b.x, nloc, nx); b.st[0] = nloc; b.st[1] = nx; }
        const unsigned old = xb_add(&bar[XB_XSUB(b.x)], 1u);
        const unsigned gen = old / nloc;
        if (old + 1u == (gen + 1u) * nloc) {
            __builtin_amdgcn_fence(__ATOMIC_RELEASE, "agent");
            asm volatile("s_waitcnt vmcnt(0)" ::: "memory");
            const unsigned og = xb_add(&bar[XB_TOP], 1u);
            const unsigned tg = og / nx;
            if (og + 1u == (tg + 1u) * nx) xb_add(&bar[XB_TOPGEN], 1u);
            else XB_SPIN(xb_ld(&bar[XB_TOPGEN]) == tg, bar);
            __builtin_amdgcn_fence(__ATOMIC_ACQUIRE, "agent");
            xb_add(&bar[XB_XGEN(b.x)], 1u);
            asm volatile("s_waitcnt vmcnt(0)" ::: "memory");
        } else {
            XB_SPIN(xb_ld(&bar[XB_XGEN(b.x)]) == gen, bar);
            __builtin_amdgcn_fence(__ATOMIC_ACQUIRE, "agent");
            asm volatile("s_waitcnt vmcnt(0)" ::: "memory");
        }
    }
    __syncthreads();
}


struct Args { const float* in[24]; float* out; unsigned char* ws; int ph_lo, ph_hi; };
enum { I_X = 0, I_MEM, I_AWIN, I_ALNG, I_ALNB, I_AWS, I_ABS, I_AWOUT, I_BWIN, I_BLAM, I_BSUBG, I_BWOUT, I_WKV, I_RELB, I_MEMWKV, I_LNG, I_LNB,
       I_WG1, I_BG1, I_WG2, I_BG2, I_W1, I_W3, I_W2 };
constexpr int NPH_LAYER = 9, NPHASES = 1 + DEPTH * NPH_LAYER;

struct Frame {
    LAS unsigned char* lds; char* ldsg;
    gu32* ctl; unsigned char* ws;
    int tid, lane, wave, G, c;
};

__device__ __forceinline__ void transpose_item(const float* W, int K, int N, bf16* WT, int drow0, LAS float* scr, int k0, int n0, int lane) {
#pragma unroll 8
    for (int i = 0; i < 32; ++i) { const int kk = 2 * i + (lane >> 5); scr[kk * 33 + (lane & 31)] = W[(size_t)(k0 + kk) * N + n0 + (lane & 31)]; }
    LDS_WAIT(); asm volatile("" ::: "memory");
    const int c = lane & 7;
#pragma unroll
    for (int j = 0; j < 4; ++j) { const int n = (lane >> 3) + 8 * j; const LAS float* s = scr + (8 * c) * 33 + n;
        v4u o; o.x = pk2(s[0 * 33], s[1 * 33]); o.y = pk2(s[2 * 33], s[3 * 33]); o.z = pk2(s[4 * 33], s[5 * 33]); o.w = pk2(s[6 * 33], s[7 * 33]);
        *(GAS v4u*)(WT + (size_t)(drow0 + n) * K + k0 + 8 * c) = o; }
    LDS_WAIT(); asm volatile("" ::: "memory");
}
__device__ __forceinline__ void transpose_item_fast(const float* W, int K, int N, bf16* WT, int drow0, LAS float* scr, int k0, int n0, int lane) {
    float t[32];
#pragma unroll
    for (int i = 0; i < 32; ++i) t[i] = W[(size_t)(k0 + 2 * i + (lane >> 5)) * N + n0 + (lane & 31)];
#pragma unroll
    for (int i = 0; i < 32; i += 8) asm volatile("" : "+v"(t[i]), "+v"(t[i + 1]), "+v"(t[i + 2]), "+v"(t[i + 3]), "+v"(t[i + 4]), "+v"(t[i + 5]), "+v"(t[i + 6]), "+v"(t[i + 7]));
#pragma unroll
    for (int i = 0; i < 32; ++i) scr[(2 * i + (lane >> 5)) * 33 + (lane & 31)] = t[i];
    LDS_WAIT(); asm volatile("" ::: "memory");
    const int c = lane & 7;
#pragma unroll
    for (int j = 0; j < 4; ++j) { const int n = (lane >> 3) + 8 * j; const LAS float* s = scr + (8 * c) * 33 + n;
        v4u o; o.x = pk2(s[0 * 33], s[1 * 33]); o.y = pk2(s[2 * 33], s[3 * 33]); o.z = pk2(s[4 * 33], s[5 * 33]); o.w = pk2(s[6 * 33], s[7 * 33]);
        *(GAS v4u*)(WT + (size_t)(drow0 + n) * K + k0 + 8 * c) = o; }
    LDS_WAIT(); asm volatile("" ::: "memory");
}
__device__ __forceinline__ void transpose_item_fp8(const float* W, int K, int N, unsigned char* WT, int drow0, LAS float* scr, int k0, int n0, int lane) {
    float t[32];
#pragma unroll
    for (int i = 0; i < 32; ++i) t[i] = W[(size_t)(k0 + 2 * i + (lane >> 5)) * N + n0 + (lane & 31)];
#pragma unroll
    for (int i = 0; i < 32; i += 8) asm volatile("" : "+v"(t[i]), "+v"(t[i + 1]), "+v"(t[i + 2]), "+v"(t[i + 3]), "+v"(t[i + 4]), "+v"(t[i + 5]), "+v"(t[i + 6]), "+v"(t[i + 7]));
#pragma unroll
    for (int i = 0; i < 32; ++i) scr[(2 * i + (lane >> 5)) * 33 + (lane & 31)] = t[i];
    LDS_WAIT(); asm volatile("" ::: "memory");
    const int c = lane & 7;
#pragma unroll
    for (int j = 0; j < 4; ++j) { const int n = (lane >> 3) + 8 * j; const LAS float* s = scr + (8 * c) * 33 + n;
        unsigned lo = 0u, hi = 0u;
        lo = __builtin_amdgcn_cvt_pk_fp8_f32(s[0 * 33] * 64.f, s[1 * 33] * 64.f, lo, false); lo = __builtin_amdgcn_cvt_pk_fp8_f32(s[2 * 33] * 64.f, s[3 * 33] * 64.f, lo, true);
        hi = __builtin_amdgcn_cvt_pk_fp8_f32(s[4 * 33] * 64.f, s[5 * 33] * 64.f, hi, false); hi = __builtin_amdgcn_cvt_pk_fp8_f32(s[6 * 33] * 64.f, s[7 * 33] * 64.f, hi, true);
        v2u o; o.x = lo; o.y = hi; *(GAS v2u*)(WT + (size_t)(drow0 + n) * K + k0 + 8 * c) = o; }
    LDS_WAIT(); asm volatile("" ::: "memory");
}
#ifndef CDRAIN
#define CDRAIN 8
#endif
#ifndef CSRV
#define CSRV 4
#endif
#ifndef CSRVA
#define CSRVA 32
#endif
#ifndef STOPU
#define STOPU 64
#endif
#ifndef QX
#define QX 6
#endif
#ifndef QA
#define QA 14
#endif
#ifndef QM
#define QM 7
#endif
#ifndef QB
#define QB 4
#endif
constexpr int NQ = 7, MOE_ITEMS = 3 * 32 * 512;
__device__ __forceinline__ int conv_qsize(int q) { return (q & 1) ? (q == 1 ? 5632 : (q == 3 ? 7168 : 4096)) : MOE_ITEMS; }
__device__ __forceinline__ void conv_item(Frame& F, const Args& a, int q, int it) {
    LAS float* scr = (LAS float*)(F.lds + RING_OFF + F.wave * 16384);
    if (q & 1) {
        const float* src; bf16* dst; int N, r = it;
        if (q == 1) { if (r < 3584) { N = 3584; src = a.in[I_AWIN] + (size_t)2048 * 3584; dst = (bf16*)(F.ws + WS_WAIN) + (size_t)2048 * 3584; } else { r -= 3584; N = 2048; src = a.in[I_AWOUT] + (size_t)2048 * 2048; dst = (bf16*)(F.ws + WS_WAOUT) + (size_t)2048 * 2048; } }
        else if (q == 3) { if (r < 2048) { N = 2048; src = a.in[I_BWIN]; dst = (bf16*)(F.ws + WS_WBIN0); } else if ((r -= 2048) < 3072) { N = 3072; src = a.in[I_WKV]; dst = (bf16*)(F.ws + WS_WKV); } else { r -= 3072; N = 2048; src = a.in[I_BWOUT]; dst = (bf16*)(F.ws + WS_WBOUT); } }
        else { if (r < 2048) { N = 2048; src = a.in[I_BWIN] + (size_t)2048 * 2048; dst = (bf16*)(F.ws + WS_WBIN1); } else { r -= 2048; N = 2048; src = a.in[I_BWOUT] + (size_t)2048 * 2048; dst = (bf16*)(F.ws + WS_WBOUT) + (size_t)2048 * 2048; } }
        const int nblk = N / 32, kb = r / nblk, nb = r - kb * nblk;
        transpose_item_fast(src, 2048, N, dst, 32 * nb, scr, 64 * kb, 32 * nb, F.lane);
        return;
    }
    const int L = q >> 1, seg = it >> 14, r0 = it & 16383, e = r0 >> 9, r = r0 & 511, mat = L * 32 + e;
    if (seg < 2) { const int kb = r >> 4, nb = r & 15, n0 = 32 * nb;
        transpose_item_fp8(a.in[seg == 0 ? I_W1 : I_W3] + (size_t)mat * 2048 * 512, 2048, 512, (unsigned char*)(F.ws + WS_W13) + (size_t)mat * 1024 * 2048, (n0 >> 7) * 256 + (n0 & 127) + (seg == 1 ? 128 : 0), scr, 64 * kb, n0, F.lane); }
    else { const int kb = r >> 6, nb = r & 63;
        transpose_item_fp8(a.in[I_W2] + (size_t)mat * 512 * 2048, 512, 2048, (unsigned char*)(F.ws + WS_W2) + (size_t)mat * 512 * 2048, 32 * nb, scr, 64 * kb, 32 * nb, F.lane); }
}
#ifndef F8MASK
#define F8MASK 4
#endif
#define F8L(l) (((F8MASK) >> (l)) & 1)
#ifndef F8OMASK
#define F8OMASK 12
#endif
#define F8OL(l) (((F8OMASK) >> (l)) & 1)
#ifndef CDEPTH
#define CDEPTH 3
#endif
struct CDesc { const float* src; unsigned char* dst; int N, K, drow0, k0, n0, f8; };
__device__ __forceinline__ CDesc conv_desc(Frame& F, const Args& a, int q, int it) {
    CDesc d;
    if (q & 1) {
        const float* src; unsigned char* dst; int N, r = it, f8 = F8L((q + 1) >> 1);
        if (q == 1) { if (r < 3584) { N = 3584; src = a.in[I_AWIN] + (size_t)2048 * 3584; dst = F.ws + WS_WAIN + (size_t)2048 * 3584 * 2; } else { r -= 3584; N = 2048; f8 = 0; src = a.in[I_AWOUT] + (size_t)2048 * 2048; dst = F.ws + WS_WAOUT + (size_t)2048 * 2048 * 2; } }
        else if (q == 3) { if (r < 2048) { N = 2048; src = a.in[I_BWIN]; dst = F.ws + WS_WBIN0; } else if ((r -= 2048) < 3072) { N = 3072; src = a.in[I_WKV]; dst = F.ws + WS_WBIN0 + (size_t)2048 * 2048 * (F8L(2) ? 1 : 2); } else { r -= 3072; N = 2048; f8 = F8OL(2); src = a.in[I_BWOUT]; dst = F.ws + WS_WBOUT; } }
        else { if (r < 2048) { N = 2048; src = a.in[I_BWIN] + (size_t)2048 * 2048; dst = F.ws + WS_WBIN1; } else { r -= 2048; N = 2048; f8 = F8OL(3); src = a.in[I_BWOUT] + (size_t)2048 * 2048; dst = F.ws + WS_WBOUT + (size_t)2048 * 2048 * 2; } }
        const int nblk = N / 32, kb = r / nblk, nb = r - kb * nblk;
        d.src = src; d.dst = dst; d.N = N; d.K = 2048; d.drow0 = 32 * nb; d.k0 = 64 * kb; d.n0 = 32 * nb; d.f8 = f8; return d;
    }
    const int L = q >> 1, seg = it >> 14, r0 = it & 16383, e = r0 >> 9, r = r0 & 511, mat = L * 32 + e;
    if (seg < 2) { const int kb = r >> 4, nb = r & 15, n0 = 32 * nb;
        d.src = a.in[seg == 0 ? I_W1 : I_W3] + (size_t)mat * 2048 * 512; d.dst = (unsigned char*)(F.ws + WS_W13) + (size_t)mat * 1024 * 2048; d.N = 512; d.K = 2048;
        d.drow0 = (n0 >> 7) * 256 + (n0 & 127) + (seg == 1 ? 128 : 0); d.k0 = 64 * kb; d.n0 = n0; d.f8 = 1; }
    else { const int kb = r >> 6, nb = r & 63;
        d.src = a.in[I_W2] + (size_t)mat * 512 * 2048; d.dst = (unsigned char*)(F.ws + WS_W2) + (size_t)mat * 512 * 2048; d.N = 2048; d.K = 512; d.drow0 = 32 * nb; d.k0 = 64 * kb; d.n0 = 32 * nb; d.f8 = 1; }
    return d;
}
#define CV_LOAD(t_, d_) do { const float* p_ = (d_).src + (size_t)((d_).k0 + (F.lane >> 3)) * (d_).N + (d_).n0 + 4 * (F.lane & 7); const size_t st_ = (size_t)8 * (d_).N; \
    _Pragma("unroll") for (int i_ = 0; i_ < 8; ++i_) (t_)[i_] = *(const GAS f32x4*)(p_ + st_ * i_); } while (0)
__device__ __forceinline__ void conv_process(Frame& F, f32x4 (&t)[8], const CDesc& d) {
    LAS float* scr = (LAS float*)(F.lds + RING_OFF + F.wave * 16384); const int lane = F.lane;
    asm volatile("" : "+v"(t[0]), "+v"(t[1]), "+v"(t[2]), "+v"(t[3]), "+v"(t[4]), "+v"(t[5]), "+v"(t[6]), "+v"(t[7]));
    { LAS float* w = scr + (lane >> 3) * 33 + 4 * (lane & 7);
#pragma unroll
      for (int i = 0; i < 8; ++i) { w[i * 8 * 33 + 0] = t[i].x; w[i * 8 * 33 + 1] = t[i].y; w[i * 8 * 33 + 2] = t[i].z; w[i * 8 * 33 + 3] = t[i].w; } }
    LDS_WAIT(); asm volatile("" ::: "memory");
    const int c = lane & 7;
    if (d.f8) {
#pragma unroll
        for (int j = 0; j < 4; ++j) { const int n = (lane >> 3) + 8 * j; const LAS float* s = scr + (8 * c) * 33 + n;
            unsigned lo = 0u, hi = 0u;
            lo = __builtin_amdgcn_cvt_pk_fp8_f32(s[0 * 33] * 64.f, s[1 * 33] * 64.f, lo, false); lo = __builtin_amdgcn_cvt_pk_fp8_f32(s[2 * 33] * 64.f, s[3 * 33] * 64.f, lo, true);
            hi = __builtin_amdgcn_cvt_pk_fp8_f32(s[4 * 33] * 64.f, s[5 * 33] * 64.f, hi, false); hi = __builtin_amdgcn_cvt_pk_fp8_f32(s[6 * 33] * 64.f, s[7 * 33] * 64.f, hi, true);
            v2u o; o.x = lo; o.y = hi; *(GAS v2u*)(d.dst + (size_t)(d.drow0 + n) * d.K + d.k0 + 8 * c) = o; }
    } else {
#pragma unroll
        for (int j = 0; j < 4; ++j) { const int n = (lane >> 3) + 8 * j; const LAS float* s = scr + (8 * c) * 33 + n;
            v4u o; o.x = pk2(s[0 * 33], s[1 * 33]); o.y = pk2(s[2 * 33], s[3 * 33]); o.z = pk2(s[4 * 33], s[5 * 33]); o.w = pk2(s[6 * 33], s[7 * 33]);
            *(GAS v4u*)((bf16*)d.dst + (size_t)(d.drow0 + n) * d.K + d.k0 + 8 * c) = o; }
    }
    LDS_WAIT(); asm volatile("" ::: "memory");
}
__device__ __forceinline__ void conv_range(Frame& F, const Args& a, int q, int first, int cnt) {
#if CDEPTH == 1
    for (int i = 0; i < cnt; ++i) conv_item(F, a, q, first + i);
#else
    f32x4 t[CDEPTH][8]; const int last = first + cnt - 1;
#pragma unroll
    for (int s = 0; s < CDEPTH - 1; ++s) { const int it = first + s < last ? first + s : last; const CDesc d = conv_desc(F, a, q, it); CV_LOAD(t[s], d); }
#pragma unroll 1
    for (int i0 = 0; i0 < cnt; i0 += CDEPTH) {
#pragma unroll
        for (int s = 0; s < CDEPTH; ++s) {
            { const int nx = first + i0 + s + CDEPTH - 1, it = nx < last ? nx : last; const CDesc d = conv_desc(F, a, q, it); CV_LOAD(t[(s + CDEPTH - 1) % CDEPTH], d); }
            asm volatile("" ::: "memory");
            if (i0 + s < cnt) { const CDesc d = conv_desc(F, a, q, first + i0 + s); conv_process(F, t[s], d); }
        }
    }
#endif
}
__device__ __forceinline__ void conv_filler(Frame& F, const Args& a, int q0, int n) {
    if (q0 >= NQ || n == 0) return;
#ifdef CONV_ALL_PRO
    return;
#endif
    LAS unsigned* bw = (LAS unsigned*)(F.lds + TAB_OFF + 384);
    __syncthreads();
    const bool drain = n < 0; const int per = drain ? CDRAIN : n; int q = q0;
    for (;;) {
        if (F.tid == 0) bw[0] = __hip_atomic_fetch_add(F.ctl + CW_CONV + 64 * q, (unsigned)(8 * per), RLX_AGENT);
        __syncthreads();
        const unsigned idx = bw[0];
        __syncthreads();
        const int qs = conv_qsize(q);
        if (idx >= (unsigned)qs) { if (drain || ++q >= NQ) break; continue; }
        { const int first = (int)idx + F.wave * per, cnt = (qs - first < per) ? qs - first : per; if (cnt > 0) conv_range(F, a, q, first, cnt); }
        if (!drain) break;
    }
}

__device__ __forceinline__ void prologue_phase(Frame& F, const Args& a) {
#ifdef TOUCH
    {
        const long nthr_ = (long)F.G * 512, gt_ = (long)F.c * 512 + F.tid; unsigned acc_ = 0u;
        for (long pg = gt_; pg < (long)(WS_END / 4096); pg += nthr_) acc_ += *(const GAS unsigned*)(F.ws + pg * 4096);
        for (long pg = gt_; pg < (long)((size_t)DEPTH * NE * D * FF * 4 / 4096); pg += nthr_) { acc_ += *(const GAS unsigned*)((const char*)a.in[I_W1] + pg * 4096); acc_ += *(const GAS unsigned*)((const char*)a.in[I_W3] + pg * 4096); acc_ += *(const GAS unsigned*)((const char*)a.in[I_W2] + pg * 4096); }
        if (acc_ == 0x12345679u) F.ctl[CW_TMO] = acc_;
    }
#endif
    LAS float* scr = (LAS float*)(F.lds + RING_OFF + F.wave * 16384);
    const int gw = F.c * NWAVES + F.wave, NGW = F.G * NWAVES;
    unsigned char* ws = F.ws;
    constexpr int S0 = 3584, S1 = 2048, S5 = 4 * 1024;
    constexpr int NITEMS = S0 + S1 + S5;
    for (int it = gw; it < NITEMS; it += NGW) {
        int r = it; const float* src; unsigned char* dst; int K = 2048, N; bool f8 = F8L(0);
        if (r < S0) { N = 3584; src = a.in[I_AWIN]; dst = ws + WS_WAIN; }
        else if ((r -= S0) < S1) { N = 2048; f8 = false; src = a.in[I_AWOUT]; dst = ws + WS_WAOUT; }
        else { r -= S1; const int mat = r >> 10; r &= 1023; N = 1024; src = a.in[I_MEMWKV] + (size_t)mat * K * N; dst = ws + WS_WMKV + (size_t)mat * K * N * (F8L(0) ? 1 : 2); }
        const int nblk = N / 32, kb = r / nblk, nb = r - kb * nblk;
        if (f8) transpose_item_fp8(src, K, N, dst, 32 * nb, scr, 64 * kb, 32 * nb, F.lane);
        else transpose_item_fast(src, K, N, (bf16*)dst, 32 * nb, scr, 64 * kb, 32 * nb, F.lane);
    }
#ifdef CONV_ALL_PRO
    for (int q = 0; q < NQ; ++q) { const int qs = conv_qsize(q); for (int it = gw * 4; it < qs; it += NGW * 4) conv_range(F, a, q, it, qs - it < 4 ? qs - it : 4); }
#endif
    const long nthr = (long)F.G * 512, gt = (long)F.c * 512 + F.tid;
    { float* wr = (float*)(ws + WS_WR);
      for (long i = gt; i < (long)DEPTH * 3 * 512 * 16 * 4; i += nthr) { const int j = (int)(i & 3), c = (int)((i >> 2) & 15), kg = (int)((i >> 6) & 511), r = (int)(i >> 15), nb = r % 3, l = r / 3;
          const int k = 4 * kg + j, o = 16 * nb + c; float v = 0.f;
          if (o < 4) v = a.in[I_WG1][((size_t)l * D + k) * 4 + o]; else if (o < 36) { const int g = (o - 4) >> 3, e = (o - 4) & 7; v = a.in[I_WG2][(((size_t)l * 4 + g) * D + k) * 8 + e]; }
          wr[i] = v; } }
    { const float* x = a.in[I_X]; bf16* xb = (bf16*)(ws + WS_XB);
      for (long i = gt; i < (long)T * D / 8; i += nthr) { const f32x4 v0 = *(const GAS f32x4*)(x + i * 8), v1 = *(const GAS f32x4*)(x + i * 8 + 4);
          v4u o; o.x = pk2(v0.x, v0.y); o.y = pk2(v0.z, v0.w); o.z = pk2(v1.x, v1.y); o.w = pk2(v1.z, v1.w); *(GAS v4u*)(xb + i * 8) = o;
          unsigned lo = 0u, hi = 0u; lo = __builtin_amdgcn_cvt_pk_fp8_f32(v0.x, v0.y, lo, false); lo = __builtin_amdgcn_cvt_pk_fp8_f32(v0.z, v0.w, lo, true); hi = __builtin_amdgcn_cvt_pk_fp8_f32(v1.x, v1.y, hi, false); hi = __builtin_amdgcn_cvt_pk_fp8_f32(v1.z, v1.w, hi, true);
          v2u qq; qq.x = lo; qq.y = hi; *(GAS v2u*)(ws + WS_XQ + i * 8) = qq; } }
    { const float* x = a.in[I_MEM]; bf16* xb = (bf16*)(ws + WS_MEMB);
      for (long i = gt; i < (long)MEMT * D / 8; i += nthr) { const f32x4 v0 = *(const GAS f32x4*)(x + i * 8), v1 = *(const GAS f32x4*)(x + i * 8 + 4);
          v4u o; o.x = pk2(v0.x, v0.y); o.y = pk2(v0.z, v0.w); o.z = pk2(v1.x, v1.y); o.w = pk2(v1.z, v1.w); *(GAS v4u*)(xb + i * 8) = o;
          unsigned lo = 0u, hi = 0u; lo = __builtin_amdgcn_cvt_pk_fp8_f32(v0.x, v0.y, lo, false); lo = __builtin_amdgcn_cvt_pk_fp8_f32(v0.z, v0.w, lo, true); hi = __builtin_amdgcn_cvt_pk_fp8_f32(v1.x, v1.y, hi, false); hi = __builtin_amdgcn_cvt_pk_fp8_f32(v1.z, v1.w, hi, true);
          v2u qq; qq.x = lo; qq.y = hi; *(GAS v2u*)(ws + WS_MEMQ + i * 8) = qq; } }
}

#ifndef NCVMAX
#define NCVMAX 0
#endif
#ifndef NCVATT
#define NCVATT 96
#endif
__device__ __forceinline__ int conv_servers(int nu, int G, int fin) {
    if (fin || nu <= 0) return 0;
    const int rounds = (nu + G - 1) / G, gmin = (nu + rounds - 1) / rounds; int n = G - gmin; n = n < NCVMAX ? n : NCVMAX; return n & ~7;
}
__device__ __forceinline__ void conv_done(Frame& F, int p) { __syncthreads(); if (F.tid == 0) __hip_atomic_fetch_add(F.ctl + CW_DONE + 64 * p, 1u, RLX_AGENT); }
__device__ __forceinline__ void conv_server(Frame& F, const Args& a, int p, int q0, int ncomp) {
    int q = q0;
    for (;;) {
        if (q >= NQ) break;
        unsigned idx = 0xffffffffu;
        if (F.lane == 0) { if (__hip_atomic_load(F.ctl + CW_DONE + 64 * p, RLX_AGENT) < (unsigned)ncomp) idx = __hip_atomic_fetch_add(F.ctl + CW_CONV + 64 * q, (unsigned)CSRV, RLX_AGENT); }
        idx = (unsigned)__builtin_amdgcn_readfirstlane((int)idx);
        if (idx == 0xffffffffu) break;
        const int qs = conv_qsize(q);
        if (idx >= (unsigned)qs) { ++q; continue; }
        conv_range(F, a, q, (int)idx, (qs - (int)idx < CSRV) ? qs - (int)idx : CSRV);
    }
}
__device__ __forceinline__ void conv_server_q(Frame& F, const Args& a, gu32* head, unsigned stop_at, int q0) {
    int q = q0;
    for (;;) {
        if (q >= NQ) break;
        unsigned idx = 0xffffffffu;
        if (F.lane == 0) { if (__hip_atomic_load(head, RLX_AGENT) < stop_at) idx = __hip_atomic_fetch_add(F.ctl + CW_CONV + 64 * q, (unsigned)CSRVA, RLX_AGENT); }
        idx = (unsigned)__builtin_amdgcn_readfirstlane((int)idx);
        if (idx == 0xffffffffu) break;
        const int qs = conv_qsize(q);
        if (idx >= (unsigned)qs) { ++q; continue; }
        conv_range(F, a, q, (int)idx, (qs - (int)idx < CSRVA) ? qs - (int)idx : CSRVA);
    }
}
__device__ __forceinline__ void conv_note_fin(Frame& F, int p) {
    if (blockIdx.x == 0 && F.tid == 0) { unsigned all = 1u;
        for (int q = 0; q < NQ; ++q) all &= (__hip_atomic_load(F.ctl + CW_CONV + 64 * q, RLX_AGENT) >= (unsigned)conv_qsize(q)) ? 1u : 0u;
        __hip_atomic_store(F.ctl + CW_FIN + 64 * p, all, RLX_AGENT); }
}

__device__ __forceinline__ void sgu_unit(Frame& F, const Args& a, int l, int n, int g) {
    constexpr int LDW = 136;
    LAS float* stats = (LAS float*)(F.lds); LAS bf16* Wl = (LAS bf16*)(F.lds + 1024); LAS bf16* Vt = (LAS bf16*)(F.lds + 35840);
    const bf16* z = (const bf16*)(F.ws + WS_Z); bf16* cat = (bf16*)(F.ws + WS_CAT);
    const int tok0 = n * 128;
    for (int i = 0; i < 16; ++i) { const int tk = F.wave * 16 + i; const GAS v4u* rp = (const GAS v4u*)(z + (size_t)(tok0 + tk) * NINA + MIXW) + F.lane;
        v4u w[3]; float s = 0.f;
#pragma unroll
        for (int j = 0; j < 3; ++j) { w[j] = rp[64 * j]; s += (bflo(w[j].x) + bfhi(w[j].x)) + (bflo(w[j].y) + bfhi(w[j].y)) + (bflo(w[j].z) + bfhi(w[j].z)) + (bflo(w[j].w) + bfhi(w[j].w)); }
        const float mean = wave_sum(s) * (1.f / MIXW); float q = 0.f;
#pragma unroll
        for (int j = 0; j < 3; ++j) { float d;
            d = bflo(w[j].x) - mean; q += d * d; d = bfhi(w[j].x) - mean; q += d * d; d = bflo(w[j].y) - mean; q += d * d; d = bfhi(w[j].y) - mean; q += d * d;
            d = bflo(w[j].z) - mean; q += d * d; d = bfhi(w[j].z) - mean; q += d * d; d = bflo(w[j].w) - mean; q += d * d; d = bfhi(w[j].w) - mean; q += d * d; }
        const float rstd = 1.f / sqrtf(wave_sum(q) * (1.f / MIXW) + LN_EPS);
        if (F.lane == 0) { stats[2 * tk] = mean; stats[2 * tk + 1] = rstd; } }
    { const float* wsrc = a.in[I_AWS] + ((size_t)l * 4 + g) * 128 * 128;
      for (int p = F.tid; p < 128 * 32; p += 512) { const int i = p >> 5, j4 = (p & 31) * 4; f32x4 v = *(const GAS f32x4*)(wsrc + i * 128 + j4);
          if ((j4 >> 6) > (i >> 6)) v = (f32x4){0.f, 0.f, 0.f, 0.f};
          v2u o; o.x = pk2(v.x, v.y); o.y = pk2(v.z, v.w); *(LAS v2u*)(Wl + i * LDW + j4) = o; } }
    __syncthreads();
    { const float* lg = a.in[I_ALNG] + (size_t)l * MIXW + g * 384; const float* lb = a.in[I_ALNB] + (size_t)l * MIXW + g * 384;
      for (int p = F.tid; p < 128 * 48; p += 512) { const int j = p & 127, c8 = (p >> 7) * 8;
          const v4u w = *(const GAS v4u*)(z + (size_t)(tok0 + j) * NINA + MIXW + g * 384 + c8);
          const float mean = stats[2 * j], rstd = stats[2 * j + 1];
          const f32x4 g0 = *(const GAS f32x4*)(lg + c8), g1 = *(const GAS f32x4*)(lg + c8 + 4), b0 = *(const GAS f32x4*)(lb + c8), b1 = *(const GAS f32x4*)(lb + c8 + 4);
          float v[8] = {bflo(w.x), bfhi(w.x), bflo(w.y), bfhi(w.y), bflo(w.z), bfhi(w.z), bflo(w.w), bfhi(w.w)};
          const float gg[8] = {g0.x, g0.y, g0.z, g0.w, g1.x, g1.y, g1.z, g1.w}, bb[8] = {b0.x, b0.y, b0.z, b0.w, b1.x, b1.y, b1.z, b1.w};
#pragma unroll
          for (int e = 0; e < 8; ++e) Vt[(c8 + e) * LDW + j] = (bf16)f2bf((v[e] - mean) * rstd * gg[e] + bb[e]); } }
    __syncthreads();
    const int fr = F.lane & 15, fq = F.lane >> 4;
    f32x4 acc[8][3];
#pragma unroll
    for (int mb = 0; mb < 8; ++mb)
#pragma unroll
        for (int nb = 0; nb < 3; ++nb) acc[mb][nb] = (f32x4){0.f, 0.f, 0.f, 0.f};
#pragma unroll
    for (int ks = 0; ks < 4; ++ks) { bf16x8 bfr[3];
#pragma unroll
        for (int nb = 0; nb < 3; ++nb) bfr[nb] = *(const LAS bf16x8*)(Vt + (F.wave * 48 + nb * 16 + fr) * LDW + ks * 32 + fq * 8);
#pragma unroll
        for (int mb = 0; mb < 8; ++mb) { const bf16x8 afr = *(const LAS bf16x8*)(Wl + (mb * 16 + fr) * LDW + ks * 32 + fq * 8);
#pragma unroll
            for (int nb = 0; nb < 3; ++nb) acc[mb][nb] = __builtin_amdgcn_mfma_f32_16x16x32_bf16(bfr[nb], afr, acc[mb][nb], 0, 0, 0); } }
    const float* bs = a.in[I_ABS] + ((size_t)l * 4 + g) * 128;
#pragma unroll
    for (int mb = 0; mb < 8; ++mb) { const int i = mb * 16 + fr; const float bsv = bs[i]; const size_t tk = (size_t)(tok0 + i);
#pragma unroll
        for (int nb = 0; nb < 3; ++nb) { const int c = g * 384 + F.wave * 48 + nb * 16 + 4 * fq;
            const v2u uw = *(const GAS v2u*)(z + tk * NINA + c); const f32x4 gt = acc[mb][nb] + bsv;
            v2u o; o.x = pk2(bflo(uw.x) * gt.x, bfhi(uw.x) * gt.y); o.y = pk2(bflo(uw.y) * gt.z, bfhi(uw.y) * gt.w);
            *(GAS v2u*)(cat + tk * D + c) = o; } }
    __syncthreads();
}

__device__ __forceinline__ void memattn_unit(Frame& F, int l, int hm, int qb, int ldz, int qoff) {
    const bf16* z = (const bf16*)(F.ws + WS_Z); const bf16* kv = (const bf16*)(F.ws + WS_MEMKV) + (size_t)l * 256 * 1024; bf16* cat = (bf16*)(F.ws + WS_CAT);
    att::attn_body<0>(z + (size_t)qb * 256 * ldz + qoff + hm * 128, ldz, kv + hm * 128, kv + 512 + hm * 128, 1024,
                      cat + (size_t)qb * 256 * D + MIXW + hm * 128, nullptr, D, 4, 0, nullptr, 0.f, F.ldsg);
}

__device__ __forceinline__ int t5_bucket(int rel) {
    const int a = rel < 0 ? -rel : rel; int f;
    if (a < 8) f = a; else if (a < 12) f = 8; else if (a < 16) f = 9; else if (a < 23) f = 10; else if (a < 32) f = 11; else if (a < 46) f = 12; else if (a < 64) f = 13; else if (a < 91) f = 14; else f = 15;
    return (rel > 0 ? 16 : 0) + f;
}

namespace att2 {
using att::bf16x8; using att::s16x4; using att::f32x16; using att::u32x4; using att::crow; using att::cvtpk; using att::tr_read; using att::v_rd_base;
constexpr int KT = 32, ST_K = KT * 128 * 2, ST_V = KT * 256 * 2, STAGE = 2 * ST_K + ST_V, NST = 3;
constexpr int LDS_WS = NST * STAGE, LDS_TAB = LDS_WS + 2048, LDS_UNIT = LDS_TAB + 640, LDS_END = LDS_UNIT + 16;
constexpr int NUNITS = 576;
constexpr float THR2 = 8.f * 1.4426950408889634f;
__device__ __forceinline__ int swap23(int k) { return (k & ~0xC) | ((k & 4) << 1) | ((k & 8) >> 1); }
constexpr int v_off(int d0, int ks, int half) { return d0 * 512 + ks * 8192 + half * 4096; }

struct UnitTable { unsigned short u[NUNITS]; };
constexpr UnitTable make_units() {
    UnitTable t{}; int n = 0;
    for (int c = 256; c >= 4; c -= 2) {
        { const int b = (c - 2) / 2; if ((c - 2) % 2 == 0 && b >= 32 && b <= 63) for (int part = 1; part <= 2; ++part) for (int h = 0; h < 6; ++h) t.u[n++] = (unsigned short)(h | (b << 3) | (part << 9)); }
        if (c % 4 == 0) { const int b = c / 4 - 1; if (b >= 0 && b < 32) for (int h = 0; h < 6; ++h) t.u[n++] = (unsigned short)(h | (b << 3)); }
    }
    return t;
}
__device__ const UnitTable g_units = make_units();

__device__ __forceinline__ void diff_unit(const bf16* __restrict__ Q, const bf16* __restrict__ KD, const bf16* __restrict__ VD, float* Obuf  , int orow0,
                                          float* ML  , const float* relb, int h, int b, int t_lo, int t_hi, LAS char* lds) {
  int tid_ = threadIdx.x; asm volatile("" : "+v"(tid_));
  const int tid = tid_, wid = __builtin_amdgcn_readfirstlane(tid >> 6), lane = tid & 63, r32 = lane & 31, hi = lane >> 5, m = wid >> 2, rg = wid & 3;
  LAS float* wsw = (LAS float*)(lds + LDS_WS) + wid * 64; LAS float* li_l = wsw; LAS float* al_l = wsw + 32;
  LAS float* tab = (LAS float*)(lds + LDS_TAB);
  if (tid < att::TAB_N) tab[tid] = relb[t5_bucket(63 - tid) * 6 + h] * LOG2E;
  const float cfar = relb[15 * 6 + h] * LOG2E;
  const int qrow0 = b * 128 + rg * 32;
  bf16x8 qr[8];
  { const bf16* Qw = Q + (size_t)(qrow0 + r32) * 2048 + h * 256 + m * 128 + hi * 8;
#pragma unroll
    for (int d0 = 0; d0 < 8; ++d0) qr[d0] = *reinterpret_cast<const bf16x8*>(Qw + d0 * 16); }
  int ko[2], vo[2];
#pragma unroll
  for (int i = 0; i < 2; ++i) {
    const int p = wid * 64 + lane, row = p >> 4, cp = (p & 15) ^ (row & 7); ko[i] = row * 1536 + h * 256 + i * 128 + cp * 8; }
#pragma unroll
  for (int i = 0; i < 2; ++i) {
    const int p = (wid * 2 + i) * 64 + lane, sub = p >> 5, kg = sub >> 3, cblk = sub & 7, q = p & 31, kk = kg * 8 + (q >> 2), key = swap23(kk);
    vo[i] = key * 1536 + h * 256 + cblk * 32 + (q & 3) * 8; }
  const unsigned ldsb = (unsigned)(uintptr_t)lds;
#define A2_ISSUE(t, s) do { const size_t kb_ = (size_t)(t) * KT * 1536; LAS char* sb_ = lds + (s) * STAGE; \
    __builtin_amdgcn_global_load_lds((const unsigned*)(KD + kb_ + ko[0]), (LAS unsigned*)(sb_ + wid * 1024), 16, 0, 0); \
    __builtin_amdgcn_global_load_lds((const unsigned*)(KD + kb_ + ko[1]), (LAS unsigned*)(sb_ + ST_K + wid * 1024), 16, 0, 0); \
    __builtin_amdgcn_global_load_lds((const unsigned*)(VD + kb_ + vo[0]), (LAS unsigned*)(sb_ + 2 * ST_K + (wid * 2) * 1024), 16, 0, 0); \
    __builtin_amdgcn_global_load_lds((const unsigned*)(VD + kb_ + vo[1]), (LAS unsigned*)(sb_ + 2 * ST_K + (wid * 2 + 1) * 1024), 16, 0, 0); } while (0)
  const int vis = 2 * (2 * b + (rg >> 1) + 1);
  float m_reg = -1e30f, l_reg = 0.f; f32x16 o[8];
#pragma unroll
  for (int d = 0; d < 8; ++d) o[d] = f32x16{};
  asm volatile("s_waitcnt vmcnt(0)" ::: "memory");
  A2_ISSUE(t_lo, 0); if (t_lo + 1 < t_hi) A2_ISSUE(t_lo + 1, 1);
  int s = 0;
  for (int t = t_lo; t < t_hi; ++t) {
    if (t + 1 < t_hi) asm volatile("s_waitcnt vmcnt(4) lgkmcnt(0)" ::: "memory"); else asm volatile("s_waitcnt vmcnt(0) lgkmcnt(0)" ::: "memory");
    __builtin_amdgcn_s_barrier(); asm volatile("" ::: "memory");
    if (t + 2 < t_hi) { const int s2 = (s >= 1) ? s - 1 : s + 2; A2_ISSUE(t + 2, s2); }
    if (t < vis) {
      const LAS char* Ks = lds + s * STAGE + m * ST_K;
      f32x16 p = f32x16{};
#pragma unroll
      for (int d0 = 0; d0 < 8; ++d0) { const int cb = (d0 * 16 + hi * 8) * 2;
        const bf16x8 b0 = *(const LAS bf16x8*)(Ks + KSWZ(r32, cb));
        p = __builtin_amdgcn_mfma_f32_32x32x16_bf16(b0, qr[d0], p, 0, 0, 0); }
      if (qrow0 - (KT * t + KT - 1) >= 91) {
#pragma unroll
        for (int r = 0; r < 16; ++r) p[r] += cfar;
      } else { const int base = qrow0 + r32 - KT * t + 63;
#pragma unroll
        for (int r = 0; r < 16; ++r) { const int i0 = base - crow(r, hi); p[r] += tab[i0 < att::TAB_N - 1 ? i0 : att::TAB_N - 1]; } }
      float pmax = p[0];
#pragma unroll
      for (int r = 1; r < 16; ++r) pmax = fmaxf(pmax, p[r]);
      { auto rr = __builtin_amdgcn_permlane32_swap(__float_as_uint(pmax), __float_as_uint(pmax), false, false); pmax = fmaxf(__uint_as_float(rr[0]), __uint_as_float(rr[1])); }
      float mn, alpha;
      if (__builtin_expect(__all(pmax - m_reg <= THR2), 1)) { mn = m_reg; alpha = 1.f; }
      else { mn = fmaxf(m_reg, pmax); alpha = __builtin_amdgcn_exp2f(m_reg - mn); m_reg = mn; }
      float ps = 0.f;
#pragma unroll
      for (int r = 0; r < 16; ++r) { p[r] = __builtin_amdgcn_exp2f(p[r] - mn); ps += p[r]; }
      { auto rr = __builtin_amdgcn_permlane32_swap(__float_as_uint(ps), __float_as_uint(ps), false, false); ps = __uint_as_float(rr[0]) + __uint_as_float(rr[1]); }
      l_reg = l_reg * alpha + ps;
      bf16x8 pa0, pa1;
#define A2_PK4(P, BASE, OUT) do { unsigned a0 = cvtpk(P[BASE + 0], P[BASE + 1]), a1 = cvtpk(P[BASE + 2], P[BASE + 3]);   \
    unsigned b0_ = cvtpk(P[BASE + 4], P[BASE + 5]), b1_ = cvtpk(P[BASE + 6], P[BASE + 7]);                              \
    auto r0 = __builtin_amdgcn_permlane32_swap(a0, b0_, false, false); auto r1 = __builtin_amdgcn_permlane32_swap(a1, b1_, false, false); \
    u32x4 w = {r0[0], r1[0], r0[1], r1[1]}; OUT = *reinterpret_cast<bf16x8*>(&w); } while (0)
      A2_PK4(p, 0, pa0); A2_PK4(p, 8, pa1);
      if (__any(alpha < 1.f)) { if (hi == 0) al_l[r32] = alpha; asm volatile("s_waitcnt lgkmcnt(0)" ::: "memory");
#pragma unroll
        for (int d = 0; d < 8; ++d)
#pragma unroll
          for (int r = 0; r < 16; ++r) o[d][r] *= al_l[crow(r, hi)]; }
      const int vb = (int)(ldsb + s * STAGE + 2 * ST_K) + v_rd_base(lane);
      asm volatile("s_waitcnt lgkmcnt(0)" ::: "memory"); SBAR();
#define A2_PK(L, H) (bf16x8){L[0], L[1], L[2], L[3], H[0], H[1], H[2], H[3]}
#define A2_RD(D0, l0, h0, l1, h1) do { l0 = tr_read<v_off(D0, 0, 0)>(vb); h0 = tr_read<v_off(D0, 0, 1)>(vb); l1 = tr_read<v_off(D0, 1, 0)>(vb); h1 = tr_read<v_off(D0, 1, 1)>(vb); } while (0)
#define A2_MM(D0, l0, h0, l1, h1) do { o[D0] = __builtin_amdgcn_mfma_f32_32x32x16_bf16(pa0, A2_PK(l0, h0), o[D0], 0, 0, 0); o[D0] = __builtin_amdgcn_mfma_f32_32x32x16_bf16(pa1, A2_PK(l1, h1), o[D0], 0, 0, 0); } while (0)
      s16x4 xl0, xh0, xl1, xh1, yl0, yh0, yl1, yh1;
      A2_RD(0, xl0, xh0, xl1, xh1);
      A2_RD(1, yl0, yh0, yl1, yh1); asm volatile("s_waitcnt lgkmcnt(4)" ::: "memory"); SBAR(); A2_MM(0, xl0, xh0, xl1, xh1); SBAR();
      A2_RD(2, xl0, xh0, xl1, xh1); asm volatile("s_waitcnt lgkmcnt(4)" ::: "memory"); SBAR(); A2_MM(1, yl0, yh0, yl1, yh1); SBAR();
      A2_RD(3, yl0, yh0, yl1, yh1); asm volatile("s_waitcnt lgkmcnt(4)" ::: "memory"); SBAR(); A2_MM(2, xl0, xh0, xl1, xh1); SBAR();
      A2_RD(4, xl0, xh0, xl1, xh1); asm volatile("s_waitcnt lgkmcnt(4)" ::: "memory"); SBAR(); A2_MM(3, yl0, yh0, yl1, yh1); SBAR();
      A2_RD(5, yl0, yh0, yl1, yh1); asm volatile("s_waitcnt lgkmcnt(4)" ::: "memory"); SBAR(); A2_MM(4, xl0, xh0, xl1, xh1); SBAR();
      A2_RD(6, xl0, xh0, xl1, xh1); asm volatile("s_waitcnt lgkmcnt(4)" ::: "memory"); SBAR(); A2_MM(5, yl0, yh0, yl1, yh1); SBAR();
      A2_RD(7, yl0, yh0, yl1, yh1); asm volatile("s_waitcnt lgkmcnt(4)" ::: "memory"); SBAR(); A2_MM(6, xl0, xh0, xl1, xh1); SBAR();
      asm volatile("s_waitcnt lgkmcnt(0)" ::: "memory"); SBAR(); A2_MM(7, yl0, yh0, yl1, yh1); SBAR();
    }
    s = (s == 2) ? 0 : s + 1;
  }
  if (hi == 0) li_l[r32] = l_reg; asm volatile("s_waitcnt lgkmcnt(0)" ::: "memory");
  float rli[16];
#pragma unroll
  for (int r = 0; r < 16; ++r) rli[r] = __builtin_amdgcn_rcpf(li_l[crow(r, hi)]);
  float* Ow = Obuf + (size_t)(qrow0 - orow0) * 3072 + (h * 2 + m) * 256;
#pragma unroll
  for (int r = 0; r < 16; ++r) { const int orow = crow(r, hi);
#pragma unroll
    for (int d0 = 0; d0 < 8; ++d0) Ow[(size_t)orow * 3072 + d0 * 32 + r32] = o[d0][r] * rli[r]; }
  if (hi == 0) { float* mlp = ML + (((size_t)(qrow0 - orow0 + r32) * 6 + h) * 2 + m) * 2; mlp[0] = m_reg; mlp[1] = l_reg; }
  asm volatile("s_waitcnt vmcnt(0) lgkmcnt(0)" ::: "memory");
  __builtin_amdgcn_s_barrier(); asm volatile("" ::: "memory");
#undef A2_ISSUE
#undef A2_PK4
#undef A2_PK
#undef A2_RD
#undef A2_MM
}
}

namespace att3 {
using att::f32x16; using att::crow;
typedef int v8i __attribute__((ext_vector_type(8))); typedef int v4i __attribute__((ext_vector_type(4)));
constexpr int KT = 64, ST_K = KT * 128, ST_V = 256 * 64, STAGE = 2 * ST_K + ST_V, NST = 3;
static_assert(NST * STAGE == att2::LDS_WS, "same ring size as att2");
constexpr float THR2 = 2.f;
__device__ __forceinline__ v8i cat8(v4i a, v4i b) { return __builtin_shufflevector(a, b, 0, 1, 2, 3, 4, 5, 6, 7); }
__device__ __forceinline__ void diff_unit(const unsigned char* __restrict__ Q8, const unsigned char* __restrict__ K8, const unsigned char* __restrict__ VT, float* Obuf, int orow0,
                                          float* ML, const float* relb, int h, int b, int t_lo, int t_hi, LAS char* lds) {
  int tid_ = threadIdx.x; asm volatile("" : "+v"(tid_));
  const int tid = tid_, wid = __builtin_amdgcn_readfirstlane(tid >> 6), lane = tid & 63, r32 = lane & 31, hi = lane >> 5, m = wid >> 2, rg = wid & 3;
  LAS float* wsw = (LAS float*)(lds + att2::LDS_WS) + wid * 64; LAS float* li_l = wsw; LAS float* al_l = wsw + 32;
  LAS float* tab = (LAS float*)(lds + att2::LDS_TAB);
  if (tid < att::TAB_N) tab[tid] = relb[t5_bucket(63 - tid) * 6 + h] * LOG2E;
  const float cfar = relb[15 * 6 + h] * LOG2E;
  const int qrow0 = b * 128 + rg * 32;
  v8i q8[2];
  { const unsigned char* Qw = Q8 + (size_t)(qrow0 + r32) * 2048 + h * 256 + m * 128 + hi * 32;
#pragma unroll
    for (int c = 0; c < 2; ++c) q8[c] = cat8(*(const GAS v4i*)(Qw + 64 * c), *(const GAS v4i*)(Qw + 64 * c + 16)); }
  int ko, vo[2];
  { const int p = wid * 64 + lane, row = p >> 3, cp = (p & 7) ^ (row & 7); ko = row * 1536 + h * 256 + cp * 16; }
#pragma unroll
  for (int i = 0; i < 2; ++i) { const int p = (wid * 2 + i) * 64 + lane, d = p >> 2, cp = (p & 3) ^ ((d >> 1) & 3); vo[i] = d * 64 + cp * 16; }
  const unsigned char* VTh = VT + (size_t)h * 128 * 16384;
#define A3_ISSUE(t, s) do { const size_t kb_ = (size_t)(t) * KT * 1536; LAS char* sb_ = lds + (s) * STAGE; \
    __builtin_amdgcn_global_load_lds((const unsigned*)(K8 + kb_ + ko), (LAS unsigned*)(sb_ + wid * 1024), 16, 0, 0); \
    __builtin_amdgcn_global_load_lds((const unsigned*)(K8 + kb_ + ko + 128), (LAS unsigned*)(sb_ + ST_K + wid * 1024), 16, 0, 0); \
    __builtin_amdgcn_global_load_lds((const unsigned*)(VTh + (size_t)(t) * 16384 + vo[0]), (LAS unsigned*)(sb_ + 2 * ST_K + (wid * 2) * 1024), 16, 0, 0); \
    __builtin_amdgcn_global_load_lds((const unsigned*)(VTh + (size_t)(t) * 16384 + vo[1]), (LAS unsigned*)(sb_ + 2 * ST_K + (wid * 2 + 1) * 1024), 16, 0, 0); } while (0)
  const int vis = 2 * b + (rg >> 1) + 1;
  float m_reg = -1e30f, l_reg = 0.f; f32x16 o[8];
#pragma unroll
  for (int d = 0; d < 8; ++d) o[d] = f32x16{};
  const int kx = (r32 & 7), koff0 = r32 * 128 + (((2 * hi) ^ kx) << 4), koff1 = r32 * 128 + (((2 * hi + 1) ^ kx) << 4);
  const int vx = (r32 >> 1) & 3, voff0 = r32 * 64 + (((2 * hi) ^ vx) << 4), voff1 = r32 * 64 + (((2 * hi + 1) ^ vx) << 4);
  int sclP = 121, scl1 = 127; asm volatile("" : "+v"(sclP), "+v"(scl1));
  asm volatile("s_waitcnt vmcnt(0)" ::: "memory");
  A3_ISSUE(t_lo, 0); if (t_lo + 1 < t_hi) A3_ISSUE(t_lo + 1, 1);
  int s = 0;
  for (int t = t_lo; t < t_hi; ++t) {
    if (t + 1 < t_hi) asm volatile("s_waitcnt vmcnt(4) lgkmcnt(0)" ::: "memory"); else asm volatile("s_waitcnt vmcnt(0) lgkmcnt(0)" ::: "memory");
    __builtin_amdgcn_s_barrier(); asm volatile("" ::: "memory");
    if (t + 2 < t_hi) { const int s2 = (s >= 1) ? s - 1 : s + 2; A3_ISSUE(t + 2, s2); }
    if (t < vis) {
      const LAS char* Ks = lds + s * STAGE + m * ST_K;
      f32x16 p0 = f32x16{}, p1 = f32x16{};
#pragma unroll
      for (int c = 0; c < 2; ++c) {
        const int x0 = koff0 ^ (c << 6), x1 = koff1 ^ (c << 6);
        const v8i k0 = cat8(*(const LAS v4i*)(Ks + x0), *(const LAS v4i*)(Ks + x1));
        const v8i k1 = cat8(*(const LAS v4i*)(Ks + 4096 + x0), *(const LAS v4i*)(Ks + 4096 + x1));
        asm volatile("v_mfma_scale_f32_32x32x64_f8f6f4 %0, %1, %2, %0, %3, %3 op_sel_hi:[0,0,0]" : "+v"(p0) : "v"(k0), "v"(q8[c]), "v"(scl1));
        asm volatile("v_mfma_scale_f32_32x32x64_f8f6f4 %0, %1, %2, %0, %3, %3 op_sel_hi:[0,0,0]" : "+v"(p1) : "v"(k1), "v"(q8[c]), "v"(scl1)); }
      asm volatile("s_nop 15\n s_nop 7" : "+v"(p0), "+v"(p1));
      const bool far = qrow0 - (KT * t + KT - 1) >= 91;
      if (!far) { const int base = qrow0 + r32 - KT * t + 63;
#pragma unroll
        for (int r = 0; r < 16; ++r) { const int i0 = base - crow(r, hi), i1 = i0 - 32; p0[r] += tab[i0 < att::TAB_N - 1 ? i0 : att::TAB_N - 1]; p1[r] += tab[i1 < att::TAB_N - 1 ? i1 : att::TAB_N - 1]; } }
      const float cb = far ? cfar : 0.f;
      float pmax;
      asm("v_max3_f32 %0, %1, %2, %3" : "=v"(pmax) : "v"(p0[0]), "v"(p1[0]), "v"(p0[1]));
      asm("v_max3_f32 %0, %1, %2, %3" : "=v"(pmax) : "v"(pmax), "v"(p1[1]), "v"(p0[2]));
#pragma unroll
      for (int r = 2; r < 15; ++r) asm("v_max3_f32 %0, %1, %2, %3" : "=v"(pmax) : "v"(pmax), "v"(p1[r]), "v"(p0[r + 1]));
      asm("v_max_f32 %0, %1, %2" : "=v"(pmax) : "v"(pmax), "v"(p1[15]));
      pmax += cb;
      { auto rr = __builtin_amdgcn_permlane32_swap(__float_as_uint(pmax), __float_as_uint(pmax), false, false); asm("v_max_f32 %0, %1, %2" : "=v"(pmax) : "v"(__uint_as_float(rr[0])), "v"(__uint_as_float(rr[1]))); }
      float mn, alpha;
      if (__builtin_expect(__all(pmax - m_reg <= THR2), 1)) { mn = m_reg; alpha = 1.f; }
      else { mn = fmaxf(m_reg, pmax); alpha = __builtin_amdgcn_exp2f(m_reg - mn); m_reg = mn; }
      typedef float f32x2v __attribute__((ext_vector_type(2)));
      const float off = cb - (mn - 6.f); const f32x2v off2 = {off, off}; f32x2v ps2 = {0.f, 0.f};
#pragma unroll
      for (int r = 0; r < 16; r += 2) {
        f32x2v a = (f32x2v){p0[r], p0[r + 1]} + off2, c2 = (f32x2v){p1[r], p1[r + 1]} + off2;
        p0[r] = __builtin_amdgcn_exp2f(a.x); p0[r + 1] = __builtin_amdgcn_exp2f(a.y); p1[r] = __builtin_amdgcn_exp2f(c2.x); p1[r + 1] = __builtin_amdgcn_exp2f(c2.y);
        ps2 += (f32x2v){p0[r], p0[r + 1]}; ps2 += (f32x2v){p1[r], p1[r + 1]}; }
      float ps = ps2.x + ps2.y;
      { auto rr = __builtin_amdgcn_permlane32_swap(__float_as_uint(ps), __float_as_uint(ps), false, false); ps = __uint_as_float(rr[0]) + __uint_as_float(rr[1]); }
      l_reg = l_reg * alpha + ps;
      v8i pa;
#pragma unroll
      for (int g = 0; g < 4; ++g) { unsigned x = 0u, y = 0u;
        x = __builtin_amdgcn_cvt_pk_fp8_f32(p0[4 * g], p0[4 * g + 1], x, false); x = __builtin_amdgcn_cvt_pk_fp8_f32(p0[4 * g + 2], p0[4 * g + 3], x, true);
        y = __builtin_amdgcn_cvt_pk_fp8_f32(p1[4 * g], p1[4 * g + 1], y, false); y = __builtin_amdgcn_cvt_pk_fp8_f32(p1[4 * g + 2], p1[4 * g + 3], y, true);
        auto rr = __builtin_amdgcn_permlane32_swap(x, y, false, false); pa[2 * g] = (int)rr[0]; pa[2 * g + 1] = (int)rr[1]; }
      if (__any(alpha < 1.f)) { if (hi == 0) al_l[r32] = alpha; asm volatile("s_waitcnt lgkmcnt(0)" ::: "memory");
#pragma unroll
        for (int d = 0; d < 8; ++d)
#pragma unroll
          for (int r = 0; r < 16; ++r) o[d][r] *= al_l[crow(r, hi)]; }
      const LAS char* Vs = lds + s * STAGE + 2 * ST_K;
#define A3_RD(D0, V) do { V = cat8(*(const LAS v4i*)(Vs + (D0) * 2048 + voff0), *(const LAS v4i*)(Vs + (D0) * 2048 + voff1)); } while (0)
#define A3_MM(D0, V) asm volatile("v_mfma_scale_f32_32x32x64_f8f6f4 %0, %1, %2, %0, %3, %4 op_sel_hi:[0,0,0]" : "+v"(o[D0]) : "v"(pa), "v"(V), "v"(sclP), "v"(scl1))
      v8i va, vb;
      A3_RD(0, va);
      A3_RD(1, vb); A3_MM(0, va);
      A3_RD(2, va); A3_MM(1, vb);
      A3_RD(3, vb); A3_MM(2, va);
      A3_RD(4, va); A3_MM(3, vb);
      A3_RD(5, vb); A3_MM(4, va);
      A3_RD(6, va); A3_MM(5, vb);
      A3_RD(7, vb); A3_MM(6, va);
      A3_MM(7, vb);
    }
    s = (s == 2) ? 0 : s + 1;
  }
  asm volatile("s_nop 15\n s_nop 15" ::: "memory");
  if (hi == 0) li_l[r32] = l_reg; asm volatile("s_waitcnt lgkmcnt(0)" ::: "memory");
  float rli[16];
#pragma unroll
  for (int r = 0; r < 16; ++r) rli[r] = 64.f * __builtin_amdgcn_rcpf(li_l[crow(r, hi)]);
  float* Ow = Obuf + (size_t)(qrow0 - orow0) * 3072 + (h * 2 + m) * 256;
#pragma unroll
  for (int r = 0; r < 16; ++r) { const int orow = crow(r, hi);
#pragma unroll
    for (int d0 = 0; d0 < 8; ++d0) Ow[(size_t)orow * 3072 + d0 * 32 + r32] = o[d0][r] * rli[r]; }
  if (hi == 0) { float* mlp = ML + (((size_t)(qrow0 - orow0 + r32) * 6 + h) * 2 + m) * 2; mlp[0] = m_reg; mlp[1] = l_reg * (1.f / 64.f); }
  asm volatile("s_waitcnt vmcnt(0) lgkmcnt(0)" ::: "memory");
  __builtin_amdgcn_s_barrier(); asm volatile("" ::: "memory");
#undef A3_ISSUE
#undef A3_RD
#undef A3_MM
}
}

__device__ __forceinline__ void diffattn2_unit(Frame& F, const Args& a, unsigned code) {
    const int h = code & 7, b = (code >> 3) & 63, pc = code >> 9;
    float* ob = (float*)(F.ws + (pc == 2 ? WS_OP2 : WS_OP)); float* ml = (float*)(F.ws + WS_ML) + (pc == 2 ? (size_t)T * 6 * 2 * 2 : 0);
#ifdef ATT_BF16
    const int nt = 4 * b + 4, t_lo = (pc == 2) ? nt / 2 : 0, t_hi = (pc == 1) ? nt / 2 : nt;
    att2::diff_unit((const bf16*)(F.ws + WS_Z), (const bf16*)(F.ws + WS_KD), (const bf16*)(F.ws + WS_VD), ob, pc == 2 ? 4096 : 0, ml, a.in[I_RELB], h, b, t_lo, t_hi, (LAS char*)F.lds);
#else
    const int nt = 2 * b + 2, t_lo = (pc == 2) ? nt / 2 : 0, t_hi = (pc == 1) ? nt / 2 : nt;
    att3::diff_unit(F.ws + WS_ZQ, F.ws + WS_KD, F.ws + WS_VD, ob, pc == 2 ? 4096 : 0, ml, a.in[I_RELB], h, b, t_lo, t_hi, (LAS char*)F.lds);
#endif
}
__device__ __forceinline__ void diffcombine_phase(Frame& F, const Args& a, int l) {
    const int i = l - 2; const float* lp = a.in[I_BLAM] + (size_t)i * 4 * 128;
    float s1 = lp[F.lane] * lp[128 + F.lane] + lp[64 + F.lane] * lp[128 + 64 + F.lane], s2 = lp[256 + F.lane] * lp[384 + F.lane] + lp[256 + 64 + F.lane] * lp[384 + 64 + F.lane];
    s1 = wave_sum(s1); s2 = wave_sum(s2);
    const float lam_init = 0.8f - 0.6f * expf(-0.3f * (float)l);
    const float lam = expf(s1) - expf(s2) + lam_init;
    const float* op0 = (const float*)(F.ws + WS_OP); const float* op1 = (const float*)(F.ws + WS_OP2); const float* ml0 = (const float*)(F.ws + WS_ML); const float* ml1 = ml0 + (size_t)T * 6 * 2 * 2;
    bf16* cat = (bf16*)(F.ws + WS_CAT);
    const f32x4 gsub = *(const GAS f32x4*)(a.in[I_BSUBG] + (size_t)i * 256 + 4 * F.lane);
    const int gw = F.c * NWAVES + F.wave, NGW = F.G * NWAVES;
    for (int it = gw; it < T * 6; it += NGW) { const int tk = it / 6, h = it - tk * 6; f32x4 os[2];
#pragma unroll
        for (int m = 0; m < 2; ++m) { const size_t r0 = ((size_t)tk * 6 + h) * 2 + m; f32x4 oa = *(const GAS f32x4*)(op0 + r0 * 256 + 4 * F.lane);
            if (tk >= 4096) { const size_t r1 = ((size_t)(tk - 4096) * 6 + h) * 2 + m; const f32x4 ob = *(const GAS f32x4*)(op1 + r1 * 256 + 4 * F.lane);
                const float ma = ml0[r0 * 2], la = ml0[r0 * 2 + 1], mb = ml1[r1 * 2], lb = ml1[r1 * 2 + 1], M = fmaxf(ma, mb);
                const float wa = la * exp2f(ma - M), wb = lb * exp2f(mb - M), inv = 1.f / (wa + wb); oa = oa * (wa * inv) + ob * (wb * inv); }
            os[m] = oa; }
        const f32x4 o = os[0] - os[1] * lam; const float ss = wave_sum((o.x * o.x + o.y * o.y) + (o.z * o.z + o.w * o.w));
        const float r = (1.f - lam_init) / sqrtf(ss * (1.f / 256.f) + LN_EPS);
        v2u w; w.x = pk2(o.x * r * gsub.x, o.y * r * gsub.y); w.y = pk2(o.z * r * gsub.z, o.w * r * gsub.w);
        *(GAS v2u*)(cat + (size_t)tk * D + h * 256 + 4 * F.lane) = w;
        { unsigned q8 = 0u; q8 = __builtin_amdgcn_cvt_pk_fp8_f32(o.x * r * gsub.x, o.y * r * gsub.y, q8, false); q8 = __builtin_amdgcn_cvt_pk_fp8_f32(o.z * r * gsub.z, o.w * r * gsub.w, q8, true);
          *(GAS unsigned*)(F.ws + WS_CATQ + (size_t)tk * D + h * 256 + 4 * F.lane) = q8; } }
    { const long nthr = (long)F.G * 512, gt = (long)F.c * 512 + F.tid;
      for (long i2 = gt; i2 < (long)T * 64; i2 += nthr) { const long tk = i2 >> 6; const int c8 = (int)(i2 & 63) * 8; const v4u w = *(const GAS v4u*)(cat + tk * D + MIXW + c8);
          unsigned lo = 0u, hi = 0u; lo = __builtin_amdgcn_cvt_pk_fp8_f32(bflo(w.x), bfhi(w.x), lo, false); lo = __builtin_amdgcn_cvt_pk_fp8_f32(bflo(w.y), bfhi(w.y), lo, true);
          hi = __builtin_amdgcn_cvt_pk_fp8_f32(bflo(w.z), bfhi(w.z), hi, false); hi = __builtin_amdgcn_cvt_pk_fp8_f32(bflo(w.w), bfhi(w.w), hi, true);
          v2u qq; qq.x = lo; qq.y = hi; *(GAS v2u*)(F.ws + WS_CATQ + tk * D + MIXW + c8) = qq; } }
}


__device__ __forceinline__ void ln1_router_phase(Frame& F, const Args& a, int l, int probe = 0) {
    const bf16* y = (const bf16*)(F.ws + WS_Y); bf16* x1b = (bf16*)(F.ws + WS_X1B);
    const float* lng = a.in[I_LNG] + ((size_t)l * 2 + 0) * D; const float* lnb = a.in[I_LNB] + ((size_t)l * 2 + 0) * D;
    const float* wr = (const float*)(F.ws + WS_WR) + (size_t)l * 3 * 512 * 16 * 4;
    int* tok_e = (int*)(F.ws + (probe ? WS_OP : WS_ROUTE)); int* tok_rank = tok_e + 2 * T; float* tok_gate = (float*)(tok_rank + 2 * T);
    gu32* cnt = F.ctl + (probe ? 65536 : CW_CNT) + 2048 * l;
    LAS float* P = (LAS float*)(F.lds);
    constexpr int X1ROW = 2 * D + 16;
    typedef float f32x4v __attribute__((ext_vector_type(4)));
    for (int tb = F.c; tb < T / 32; tb += F.G) {
#pragma unroll 2
        for (int i = 0; i < 4; ++i) { const int tk = tb * 32 + F.wave * 4 + i;
            const GAS v4u* yr = (const GAS v4u*)(y + (size_t)tk * D) + F.lane;
            float v[4][8]; float s = 0.f;
#pragma unroll
            for (int j = 0; j < 4; ++j) { const v4u w = yr[64 * j]; v[j][0] = bflo(w.x); v[j][1] = bfhi(w.x); v[j][2] = bflo(w.y); v[j][3] = bfhi(w.y); v[j][4] = bflo(w.z); v[j][5] = bfhi(w.z); v[j][6] = bflo(w.w); v[j][7] = bfhi(w.w);
#pragma unroll
                for (int e = 0; e < 8; ++e) s += v[j][e]; }
            const float mean = wave_sum(s) * (1.f / D); float s2 = 0.f;
#pragma unroll
            for (int j = 0; j < 4; ++j)
#pragma unroll
                for (int e = 0; e < 8; ++e) { v[j][e] -= mean; s2 += v[j][e] * v[j][e]; }
            const float rstd = 1.f / sqrtf(wave_sum(s2) * (1.f / D) + LN_EPS);
#pragma unroll
            for (int j = 0; j < 4; ++j) { const int d0 = 8 * F.lane + 512 * j; const f32x4 g0 = *(const GAS f32x4*)(lng + d0), g1 = *(const GAS f32x4*)(lng + d0 + 4), b0 = *(const GAS f32x4*)(lnb + d0), b1 = *(const GAS f32x4*)(lnb + d0 + 4);
                const float q0 = v[j][0] * rstd * g0.x + b0.x, q1 = v[j][1] * rstd * g0.y + b0.y, q2 = v[j][2] * rstd * g0.z + b0.z, q3 = v[j][3] * rstd * g0.w + b0.w;
                const float q4 = v[j][4] * rstd * g1.x + b1.x, q5 = v[j][5] * rstd * g1.y + b1.y, q6 = v[j][6] * rstd * g1.z + b1.z, q7 = v[j][7] * rstd * g1.w + b1.w;
                v4u w; w.x = pk2(q0, q1); w.y = pk2(q2, q3); w.z = pk2(q4, q5); w.w = pk2(q6, q7);
                *(GAS v4u*)(x1b + (size_t)tk * D + d0) = w;
                *(LAS v4u*)(F.lds + RING_OFF + (F.wave * 4 + i) * X1ROW + d0 * 2) = w;
                unsigned lo = 0u, hi = 0u; lo = __builtin_amdgcn_cvt_pk_fp8_f32(q0, q1, lo, false); lo = __builtin_amdgcn_cvt_pk_fp8_f32(q2, q3, lo, true);
                hi = __builtin_amdgcn_cvt_pk_fp8_f32(q4, q5, hi, false); hi = __builtin_amdgcn_cvt_pk_fp8_f32(q6, q7, hi, true);
                v2u qq; qq.x = lo; qq.y = hi; *(GAS v2u*)((unsigned char*)(F.ws + WS_X1F) + (size_t)tk * D + d0) = qq; } }
        __syncthreads();
        { const int mt = F.wave >> 2, kq = F.wave & 3, c = F.lane & 15, q = F.lane >> 4;
          const LAS unsigned char* ap = F.lds + RING_OFF + (mt * 16 + c) * X1ROW + (kq * 512 + 4 * q) * 2;
          const float* bp = wr + ((size_t)(kq * 128 + q) * 16 + c) * 4;
          f32x4v acc[3] = {{0.f, 0.f, 0.f, 0.f}, {0.f, 0.f, 0.f, 0.f}, {0.f, 0.f, 0.f, 0.f}};
#pragma unroll 8
          for (int ks = 0; ks < 32; ++ks) { const v2u aw = *(const LAS v2u*)(ap + 32 * ks); const f32x4 a4 = (f32x4){bflo(aw.x), bfhi(aw.x), bflo(aw.y), bfhi(aw.y)}; f32x4 b4[3];
#pragma unroll
              for (int nb = 0; nb < 3; ++nb) b4[nb] = *(const GAS f32x4*)(bp + ((size_t)nb * 512 + 4 * ks) * 64);
#pragma unroll
              for (int j = 0; j < 4; ++j)
#pragma unroll
                  for (int nb = 0; nb < 3; ++nb) acc[nb] = __builtin_amdgcn_mfma_f32_16x16x4f32(a4[j], b4[nb][j], acc[nb], 0, 0, 0); }
          __syncthreads();
#pragma unroll
          for (int nb = 0; nb < 3; ++nb)
#pragma unroll
              for (int r = 0; r < 4; ++r) P[((kq * 2 + mt) * 16 + 4 * q + r) * 48 + nb * 16 + c] = acc[nb][r]; }
        __syncthreads();
        if (F.tid < 64) { const int tsel = F.tid & 31, tk = tb * 32 + tsel, mt = tsel >> 4, ti = tsel & 15;
            const LAS f32x4* P4 = (const LAS f32x4*)P;
            const int rb = (mt * 16 + ti) * 12;
            const float* bg1 = a.in[I_BG1] + l * 4; const float* bg2 = a.in[I_BG2] + l * 32;
            const f32x4 s1 = (P4[rb] + P4[rb + 384]) + (P4[rb + 768] + P4[rb + 1152]);
            const float l10 = s1.x + bg1[0], l11 = s1.y + bg1[1], l12 = s1.z + bg1[2], l13 = s1.w + bg1[3];
            int grp = 0; float mx = l10;
            if (l11 > mx) { mx = l11; grp = 1; } if (l12 > mx) { mx = l12; grp = 2; } if (l13 > mx) { mx = l13; grp = 3; }
            const float psel = 1.f / (expf(l10 - mx) + expf(l11 - mx) + expf(l12 - mx) + expf(l13 - mx));
            const int ob = rb + 1 + 2 * grp;
            const f32x4 sa = (P4[ob] + P4[ob + 384]) + (P4[ob + 768] + P4[ob + 1152]), sb = (P4[ob + 1] + P4[ob + 385]) + (P4[ob + 769] + P4[ob + 1153]);
            const f32x4 ba = *(const GAS f32x4*)(bg2 + grp * 8), bb = *(const GAS f32x4*)(bg2 + grp * 8 + 4);
            const float l2[8] = {sa.x + ba.x, sa.y + ba.y, sa.z + ba.z, sa.w + ba.w, sb.x + bb.x, sb.y + bb.y, sb.z + bb.z, sb.w + bb.w};
            int i0 = 0; float v0 = l2[0];
#pragma unroll
            for (int e = 1; e < 8; ++e) if (l2[e] > v0) { v0 = l2[e]; i0 = e; }
            int i1 = -1; float v1 = -INFINITY;
#pragma unroll
            for (int e = 0; e < 8; ++e) if (e != i0 && l2[e] > v1) { v1 = l2[e]; i1 = e; }
            const float e1 = expf(v1 - v0), g0 = psel / (1.f + e1), g1 = psel * e1 / (1.f + e1);
            const int ex0 = grp * 8 + i0, ex1 = grp * 8 + i1;
            const int which = F.lane >> 5, ex = which ? ex1 : ex0; const float gg = which ? g1 : g0;
            int leader = F.lane, idx = 0, gcount = 1;
            { unsigned long long rem = ~0ull;
              while (rem) { const int l0 = __builtin_ctzll(rem); const int le = __builtin_amdgcn_readlane(ex, l0); const unsigned long long mm = __ballot(ex == le);
                  if (ex == le) { leader = l0; idx = __builtin_popcountll(mm & ((1ull << F.lane) - 1ull)); gcount = __builtin_popcountll(mm); }
                  rem &= ~mm; } }
            unsigned base = 0u; if (F.lane == leader) base = __hip_atomic_fetch_add(cnt + 64 * ex, (unsigned)gcount, RLX_AGENT);
            base = (unsigned)__shfl((int)base, leader);
            const int rk = (int)base + idx;
            { int* list = (int*)(F.ws + (probe ? WS_OP + 2 * MiB : WS_LIST)); list[ex * 8192 + rk] = tk; }
            tok_e[2 * tk + which] = ex; tok_rank[2 * tk + which] = rk; tok_gate[2 * tk + which] = gg; }
        __syncthreads();
    }
}
__device__ __forceinline__ void moe_table(Frame& F, int l) {
    LAS int* tstart = (LAS int*)(F.lds + TAB_OFF);
    if (F.tid == 0) { int acc = 0;
        for (int e = 0; e < 32; ++e) { tstart[e] = acc; const unsigned c = __hip_atomic_load(F.ctl + CW_CNT + 2048 * l + 64 * e, RLX_AGENT); tstart[36 + e] = (int)c; acc += (int)((c + 255u) >> 8); }
        tstart[32] = acc; }
    __syncthreads();
}
__device__ __forceinline__ void ln2_phase(Frame& F, const Args& a, int l) {
    const bf16* x1b = (const bf16*)(F.ws + WS_X1B); const unsigned char* yb8 = F.ws + WS_YB; bf16* xb = (bf16*)(F.ws + WS_XB);
    const float* lng = a.in[I_LNG] + ((size_t)l * 2 + 1) * D; const float* lnb = a.in[I_LNB] + ((size_t)l * 2 + 1) * D;
    moe_table(F, l); const LAS int* tstart = (const LAS int*)(F.lds + TAB_OFF);
    const int* tok_e = (const int*)(F.ws + WS_ROUTE); const int* tok_rank = tok_e + 2 * T; const float* tok_gate = (const float*)(F.ws + WS_ROUTE) + 4 * T;
    const int gw = F.c * NWAVES + F.wave, NGW = F.G * NWAVES;
    for (int t4 = gw; t4 < T / 4; t4 += NGW) { const int tk0 = t4 * 4;
        int ev = 0, rv = 0; float gv = 0.f;
        if (F.lane < 8) { ev = tok_e[2 * tk0 + F.lane]; rv = tok_rank[2 * tk0 + F.lane]; gv = tok_gate[2 * tk0 + F.lane]; }
        const int slotv = (F.lane < 8) ? tstart[ev] * 256 + rv : 0;
        v4u xr[2], xr2[2]; v2u ya[2], yc[2], ya2[2], yc2[2];
#define LN2_LOAD(i, XR, YA, YC, XR2, YA2, YC2) do { const int s0_ = __builtin_amdgcn_readlane(slotv, 2 * (i)), s1_ = __builtin_amdgcn_readlane(slotv, 2 * (i) + 1); \
        _Pragma("unroll") for (int j = 0; j < 2; ++j) { const int d0 = 8 * F.lane + 512 * j; XR[j] = *(const GAS v4u*)(x1b + (size_t)(tk0 + (i)) * D + d0); YA[j] = *(const GAS v2u*)(yb8 + (size_t)s0_ * D + d0); YC[j] = *(const GAS v2u*)(yb8 + (size_t)s1_ * D + d0); } \
        _Pragma("unroll") for (int j = 0; j < 2; ++j) { const int d0 = 8 * F.lane + 512 * (j + 2); XR2[j] = *(const GAS v4u*)(x1b + (size_t)(tk0 + (i)) * D + d0); YA2[j] = *(const GAS v2u*)(yb8 + (size_t)s0_ * D + d0); YC2[j] = *(const GAS v2u*)(yb8 + (size_t)s1_ * D + d0); } } while (0)
        LN2_LOAD(0, xr, ya, yc, xr2, ya2, yc2);
#pragma unroll
        for (int i = 0; i < 4; ++i) { const int tk = tk0 + i;
            const float g0 = (1.f / 16.f) * __builtin_bit_cast(float, __builtin_amdgcn_readlane(__builtin_bit_cast(int, gv), 2 * i)), g1 = (1.f / 16.f) * __builtin_bit_cast(float, __builtin_amdgcn_readlane(__builtin_bit_cast(int, gv), 2 * i + 1));
            float v[4][8]; float s = 0.f;
#pragma unroll
            for (int j = 0; j < 4; ++j) { const v4u X = j < 2 ? xr[j] : xr2[j - 2]; const v2u A = j < 2 ? ya[j] : ya2[j - 2], C = j < 2 ? yc[j] : yc2[j - 2];
#define Y8(W, B) __builtin_amdgcn_cvt_f32_fp8((int)(W), (B))
                v[j][0] = bflo(X.x) * DN_ALPHA + (g0 * Y8(A.x, 0) + g1 * Y8(C.x, 0)); v[j][1] = bfhi(X.x) * DN_ALPHA + (g0 * Y8(A.x, 1) + g1 * Y8(C.x, 1));
                v[j][2] = bflo(X.y) * DN_ALPHA + (g0 * Y8(A.x, 2) + g1 * Y8(C.x, 2)); v[j][3] = bfhi(X.y) * DN_ALPHA + (g0 * Y8(A.x, 3) + g1 * Y8(C.x, 3));
                v[j][4] = bflo(X.z) * DN_ALPHA + (g0 * Y8(A.y, 0) + g1 * Y8(C.y, 0)); v[j][5] = bfhi(X.z) * DN_ALPHA + (g0 * Y8(A.y, 1) + g1 * Y8(C.y, 1));
                v[j][6] = bflo(X.w) * DN_ALPHA + (g0 * Y8(A.y, 2) + g1 * Y8(C.y, 2)); v[j][7] = bfhi(X.w) * DN_ALPHA + (g0 * Y8(A.y, 3) + g1 * Y8(C.y, 3));
#undef Y8
#pragma unroll
                for (int e = 0; e < 8; ++e) s += v[j][e]; }
            if (i + 1 < 4) LN2_LOAD(i + 1, xr, ya, yc, xr2, ya2, yc2);
            const float mean = wave_sum(s) * (1.f / D); float s2 = 0.f;
#pragma unroll
            for (int j = 0; j < 4; ++j)
#pragma unroll
                for (int e = 0; e < 8; ++e) { v[j][e] -= mean; s2 += v[j][e] * v[j][e]; }
            const float rstd = 1.f / sqrtf(wave_sum(s2) * (1.f / D) + LN_EPS);
#pragma unroll
            for (int j = 0; j < 4; ++j) { const int d0 = 8 * F.lane + 512 * j; const f32x4 g0v = *(const GAS f32x4*)(lng + d0), g1v = *(const GAS f32x4*)(lng + d0 + 4), b0 = *(const GAS f32x4*)(lnb + d0), b1 = *(const GAS f32x4*)(lnb + d0 + 4);
                const f32x4 oa = (f32x4){v[j][0] * rstd * g0v.x + b0.x, v[j][1] * rstd * g0v.y + b0.y, v[j][2] * rstd * g0v.z + b0.z, v[j][3] * rstd * g0v.w + b0.w};
                const f32x4 ob = (f32x4){v[j][4] * rstd * g1v.x + b1.x, v[j][5] * rstd * g1v.y + b1.y, v[j][6] * rstd * g1v.z + b1.z, v[j][7] * rstd * g1v.w + b1.w};
                if (l == DEPTH - 1) { *(GAS f32x4*)(a.out + (size_t)tk * D + d0) = oa; *(GAS f32x4*)(a.out + (size_t)tk * D + d0 + 4) = ob; }
                else { v4u w; w.x = pk2(oa.x, oa.y); w.y = pk2(oa.z, oa.w); w.z = pk2(ob.x, ob.y); w.w = pk2(ob.z, ob.w); *(GAS v4u*)(xb + (size_t)tk * D + d0) = w;
                    unsigned lo = 0u, hi = 0u; lo = __builtin_amdgcn_cvt_pk_fp8_f32(oa.x, oa.y, lo, false); lo = __builtin_amdgcn_cvt_pk_fp8_f32(oa.z, oa.w, lo, true); hi = __builtin_amdgcn_cvt_pk_fp8_f32(ob.x, ob.y, hi, false); hi = __builtin_amdgcn_cvt_pk_fp8_f32(ob.z, ob.w, hi, true);
                    v2u qq; qq.x = lo; qq.y = hi; *(GAS v2u*)(F.ws + WS_XQ + (size_t)tk * D + d0) = qq; } }
        }
#undef LN2_LOAD
    }
}

__global__ void __launch_bounds__(NWAVES * 64, 2) fwd_kernel(Args args) {
    extern __shared__ __attribute__((aligned(16))) unsigned char lds[];
    Frame F;
    F.lds = (LAS unsigned char*)lds; F.ldsg = (char*)lds;
    F.tid = threadIdx.x; F.lane = F.tid & 63; F.wave = __builtin_amdgcn_readfirstlane(F.tid >> 6);
    F.G = gridDim.x; F.c = blockIdx.x; F.ws = args.ws; F.ctl = (gu32*)(args.ws + WS_CTL);
    volatile LAS unsigned* MISC = (volatile LAS unsigned*)(F.lds + MISC_OFF);
    for (int u = F.tid; u < (LDS_BYTES - LDSCTL_OFF) / 4; u += NWAVES * 64) ((LAS unsigned*)(F.lds + LDSCTL_OFF))[u] = 0u;
    __syncthreads();
    const int lo = args.ph_lo, hi = args.ph_hi; int lastp = -1;
    const bool multi = (hi - lo) > 1;
    XcdBarrier bar; bar.bar = (unsigned*)(F.ctl + CW_BAR); bar.x = 0; bar.st = nullptr;
    if (multi) bar = xcd_barrier_post((unsigned*)(F.ctl + CW_BAR), MISC + 8);
#ifndef REP_MASK
#define REP_MASK 0
#endif
#define REP(k) for (int rep_ = 0; rep_ <= ((REP_MASK >> (k)) & 1); ++rep_)
#define IN(p) (lo <= (p) && (p) < hi)
#ifdef PROBE_A
#define STAMP(i) do { if (blockIdx.x == 0 && threadIdx.x == 0) ((unsigned long long*)(args.ws + WS_TS))[(i)] = __builtin_amdgcn_s_memrealtime(); } while (0)
#else
#define STAMP(i) do { } while (0)
#endif
#define SEAM(p) do { conv_note_fin(F, (p)); lastp = (p); if ((p) + 1 < hi) xcd_barrier(bar); STAMP((p) + 1); } while (0)
#define CONVFIN() ((lastp >= 0) ? (int)__hip_atomic_load(F.ctl + CW_FIN + 64 * lastp, RLX_AGENT) : 0)
#define FRESH() do { int t_ = threadIdx.x; asm volatile("" : "+v"(t_)); F.tid = t_; F.lane = t_ & 63; F.wave = __builtin_amdgcn_readfirstlane(t_ >> 6); \
    GAS unsigned char* w_ = (GAS unsigned char*)args.ws; asm volatile("" : "+s"(w_)); F.ws = (unsigned char*)w_; F.ctl = (gu32*)(w_ + WS_CTL); } while (0)

    STAMP(0);
    if (IN(0)) { FRESH(); REP(9) prologue_phase(F, args); SEAM(0); }
#ifdef XBAR
    for (int xb_ = 0; xb_ < XBAR; ++xb_) xcd_barrier(bar);
#endif

#pragma unroll 1
    for (int l_ = 0; l_ < DEPTH; ++l_) {
        const int pb = 1 + NPH_LAYER * l_;
#pragma unroll 1
        for (int k_ = 0; k_ < NPH_LAYER; ++k_) {
            const int p = pb + k_;
            if (!IN(p) || k_ == 5 || (k_ == 2 && l_ < 2)) continue;
            int l = l_, k = k_; asm volatile("" : "+s"(l), "+s"(k));
            FRESH();
            int cq = NQ, cn = 0;
            switch (k) {
            case 0: {
                const int N = (l < 2) ? NINA : (l == 2 ? 5120 : 2048);
                const unsigned char* Bt = F.ws + ((l < 2) ? WS_WAIN + (size_t)l * NINA * D * 2 : (l == 2 ? WS_WBIN0 : WS_WBIN1));
                const int nu = (T / 256) * (N / 256) + (l == 0 ? 16 : 0); const bool f8 = F8L(l);
                pg8::EpiBf16X E{l < 2 ? 0 : 1, (bf16*)(F.ws + WS_Z), (bf16*)(F.ws + WS_KD), (bf16*)(F.ws + WS_VD), (bf16*)(F.ws + WS_MEMKV), nullptr, nullptr};
                if (f8) { pg8::Gemm g{nullptr, nullptr, T, N, D / 2}; pg8::DualOrder8 S; S.init(F.ws + WS_XQ, Bt, T, N, D / 2, F.G, F.c, F.ws + WS_MEMQ, F.ws + WS_WMKV, l == 0 ? 16 : 0);
                    REP(0) pg8::gemm_phase<pg8::EpiBf16X, pg8::DualOrder8, true, true>(F.lds + RING_OFF, g, S, E); }
                else { pg8::Gemm g{nullptr, nullptr, T, N, D}; pg8::DualOrder S; S.init(F.ws + WS_XB, Bt, T, N, D, F.G, F.c, F.ws + WS_MEMB, F.ws + WS_WMKV, l == 0 ? 16 : 0);
                    REP(0) pg8::gemm_phase<pg8::EpiBf16X, pg8::DualOrder, true, true>(F.lds + RING_OFF, g, S, E); }
                { const int mine = (nu - 1 - F.c) / F.G + 1, rounds = (nu + F.G - 1) / F.G; cq = 2 * l; cn = (rounds - mine) * (f8 ? (QA + 1) / 2 : QA); }
            } break;
            case 1: {
                if (l < 2) {
                    REP(1) for (int u = F.c; u < 256 + 128; u += F.G) {
                        if (u < 256) sgu_unit(F, args, l, u >> 2, u & 3);
                        else { const int r = u - 256; memattn_unit(F, l, r & 3, r >> 2, NINA, 2 * MIXW); }
                    }
                    if (F.c >= 128) { cq = 2 * l; cn = QX; }
                } else {
                    const int ncv = CONVFIN() ? 0 : NCVATT;
                    if (F.c >= F.G - ncv) { conv_server_q(F, args, F.ctl + CW_Q + 64 * l, (unsigned)(att2::NUNITS + 128 - STOPU), 2 * l); __syncthreads(); }
                    REP(2) { gu32* qh = F.ctl + CW_Q + 64 * l + 16 * rep_; LAS unsigned* uw = (LAS unsigned*)(F.lds + att2::LDS_UNIT);
                    for (;;) {
                        if (F.tid == 0) *uw = __hip_atomic_fetch_add(qh, 1u, RLX_AGENT);
                        __syncthreads();
                        const unsigned idx = *uw;
                        __syncthreads();
                        if (idx >= (unsigned)(att2::NUNITS + 128)) break;
                        if (idx < (unsigned)att2::NUNITS) diffattn2_unit(F, args, att2::g_units.u[idx]);
                        else { const int r = (int)idx - att2::NUNITS; memattn_unit(F, l, r & 3, r >> 2, 2048, MIXW); }
                    } }
                }
            } break;
            case 2: { REP(3) diffcombine_phase(F, args, l); } break;
            case 3: {
                pg8::EpiResBf16 E{(const bf16*)(F.ws + WS_XB), (bf16*)(F.ws + WS_Y), DN_ALPHA};
                const unsigned char* Wo = F.ws + (l < 2 ? WS_WAOUT + (size_t)l * D * D * 2 : WS_WBOUT + (size_t)(l - 2) * D * D * 2);
                if (F8OL(l)) { pg8::Gemm g{nullptr, nullptr, T, D, D / 2}; pg8::DenseOrder8 S; S.init(F.ws + WS_CATQ, Wo, T, D, D / 2, F.G, F.c);
                    REP(4) pg8::gemm_phase<pg8::EpiResBf16, pg8::DenseOrder8, true, true>(F.lds + RING_OFF, g, S, E); }
                else { pg8::Gemm g{nullptr, nullptr, T, D, D}; pg8::DenseOrder S; S.init(F.ws + WS_CAT, Wo, T, D, D, F.G, F.c);
                    REP(4) pg8::gemm_phase<pg8::EpiResBf16, pg8::DenseOrder, true, true>(F.lds + RING_OFF, g, S, E); }
            } break;
            case 4: {
                ln1_router_phase(F, args, l);
#ifdef REP_LN1
                ln1_router_phase(F, args, l, 1);
#endif
                cq = 2 * l; cn = -1;
            } break;
            case 6: {
                moe_table(F, l);
                const LAS int* tb = (const LAS int*)(F.lds + TAB_OFF);
                pg8::Gemm g{nullptr, nullptr, SLOTS, 1024, D / 2};
                pg8::MoeGatherOrder S{tb, tb + 36, (const int*)(F.ws + WS_LIST), 4, F.G, F.c, (const char*)(F.ws + WS_X1F), (const char*)(F.ws + WS_W13) + (size_t)l * NE * 1024 * 2048, (size_t)1024 * 2048, (size_t)256 * 2048, (unsigned)D};
                pg8::EpiMoe1 E{(bf16*)(F.ws + WS_H), tb, tb + 36};
                REP(6) pg8::gemm_phase<pg8::EpiMoe1, pg8::MoeGatherOrder, true, true>(F.lds + RING_OFF, g, S, E);
                { const int nu = __builtin_amdgcn_readfirstlane(((const LAS int*)(F.lds + TAB_OFF))[32]) * 4, mine = (F.c < nu) ? (nu - 1 - F.c) / F.G + 1 : 0, rounds = (nu + F.G - 1) / F.G; cq = 2 * l + 1; cn = (rounds - mine) * QM; }
            } break;
            case 7: {
                moe_table(F, l);
                pg8::Gemm g{nullptr, nullptr, SLOTS, D, FF / 2};
                pg8::MoeOrder8 S{(const PG8_LAS int*)(F.lds + TAB_OFF), 8, F.G, F.c, (const char*)(F.ws + WS_H), (const char*)(F.ws + WS_W2) + (size_t)l * NE * 2048 * 512, (size_t)256 * FF, (size_t)2048 * 512, (size_t)256 * 512};
                pg8::EpiBf16X E{3, (bf16*)(F.ws + WS_YB), nullptr, nullptr, nullptr, (const PG8_LAS int*)(F.lds + TAB_OFF), (const PG8_LAS int*)(F.lds + TAB_OFF) + 36};
                REP(7) pg8::gemm_phase<pg8::EpiBf16X, pg8::MoeOrder8, true, true>(F.lds + RING_OFF, g, S, E);
                { const int nu = __builtin_amdgcn_readfirstlane(((const LAS int*)(F.lds + TAB_OFF))[32]) * 8, mine = (F.c < nu) ? (nu - 1 - F.c) / F.G + 1 : 0, rounds = (nu + F.G - 1) / F.G; cq = 2 * l + 1; cn = (rounds - mine) * QB; }
            } break;
            default: {
                REP(8) ln2_phase(F, args, l);
                cq = 2 * l + 1; cn = -1;
            } break;
            }
            FRESH();
            conv_filler(F, args, cq, cn);
            SEAM(p);
        }
    }
#ifdef PROBE_A
    {
        VM_WAIT(); xcd_barrier(bar);
        const unsigned long long* ts = (const unsigned long long*)(args.ws + WS_TS);
        float da = 0.f, db = 0.f;
        for (int p = 0; p < NPHASES; ++p) { const int k = (p == 0) ? 9 : (p - 1) % NPH_LAYER; const float d = (float)(ts[p + 1] - ts[p]);
            if (k == PROBE_A || PROBE_A == 10) da += d; if (k == PROBE_B || PROBE_B == 10) db += d; }
        const float kk = sqrtf(da), vv = db;
        float* o = args.out; const long n = (long)T * D;
        for (long i = (long)blockIdx.x * 512 + threadIdx.x; i < n; i += (long)gridDim.x * 512) o[i] = (i == 0) ? vv : kk;
    }
#endif
#undef IN
#undef SEAM
}

#ifndef MK_ONE_LAUNCH
#define MK_ONE_LAUNCH 1
#endif
extern "C" void kernel_launch(void* const* d_in, const int* in_sizes, int n_in, void* d_out, int out_size, void* d_ws, size_t ws_size, hipStream_t stream) {
    static int grid = 0;
    if (grid == 0) {
        if (n_in != 24 || in_sizes[0] != T * D || out_size != T * D || ws_size < WS_END) { fprintf(stderr, "kernel_launch: unexpected shapes (n_in %d, in0 %d, out %d, ws %zu < %zu)\n", n_in, n_in > 0 ? in_sizes[0] : -1, out_size, ws_size, (size_t)WS_END); grid = -1; return; }
        int dev = 0, cus = 0, per_cu = 0;
        if (hipGetDevice(&dev) != hipSuccess || hipDeviceGetAttribute(&cus, hipDeviceAttributeMultiprocessorCount, dev) != hipSuccess) { grid = -1; return; }
        if (hipFuncSetAttribute((const void*)fwd_kernel, hipFuncAttributeMaxDynamicSharedMemorySize, LDS_BYTES) != hipSuccess) { fprintf(stderr, "kernel_launch: hipFuncSetAttribute failed\n"); grid = -1; return; }
        if (hipOccupancyMaxActiveBlocksPerMultiprocessor(&per_cu, (const void*)fwd_kernel, NWAVES * 64, LDS_BYTES) != hipSuccess || per_cu < 1) fprintf(stderr, "kernel_launch: occupancy query reports %d\n", per_cu);
        (void)hipGetLastError();
        grid = cus;
    }
    if (grid < 0) return;
    if (hipMemsetAsync((char*)d_ws + WS_CTL, 0, CTL_ZERO_BYTES, stream) != hipSuccess) return;
    Args a{};
    for (int i = 0; i < 24; ++i) a.in[i] = (const float*)d_in[i];
    a.out = (float*)d_out; a.ws = (unsigned char*)d_ws;
#if MK_ONE_LAUNCH
    a.ph_lo = 0; a.ph_hi = NPHASES;
    hipLaunchKernelGGL(fwd_kernel, dim3(grid), dim3(NWAVES * 64), LDS_BYTES, stream, a);
#else
    for (int p = 0; p < NPHASES; ++p) {
        const int k = (p - 1) % NPH_LAYER, l = (p - 1) / NPH_LAYER;
        if (p > 0 && k == 2 && l < 2) continue;
        a.ph_lo = p; a.ph_hi = p + 1;
        hipLaunchKernelGGL(fwd_kernel, dim3(grid), dim3(NWAVES * 64), LDS_BYTES, stream, a);
    }
#endif
    const hipError_t le = hipPeekAtLastError();
    if (le != hipSuccess) fprintf(stderr, "kernel_launch: launch failed: %s\n", hipGetErrorName(le));
}
```

```cpp
#define F8MASK 12
#define F8OMASK 12
#include <hip/hip_runtime.h>
#include <cstdio>
#include <cstdint>
namespace pg8 {
#define PG8_LAS __attribute__((address_space(3)))
typedef unsigned short bf16_t;
typedef short bf16x8 __attribute__((ext_vector_type(8)));
typedef float f32x4 __attribute__((ext_vector_type(4)));
typedef unsigned u32x4 __attribute__((ext_vector_type(4)));
constexpr int BM = 256, BK = 64, HALF = 128, HTB = HALF * BK * 2  , STAGE_BYTES = 8 * HTB, NXCD = 8, WGM = 8;

__host__ __device__ __forceinline__ int lds_byte(int r, int c) { const int st = (r >> 4) * 2 + (c >> 5), rr = r & 15, cc = c & 31, ob = rr * 64 + cc * 2; return st * 1024 + (ob ^ (((ob >> 9) & 1) << 5)); }
__host__ __device__ __forceinline__ void stage_rc(int b, int& R, int& C) { const int st = b / 1024, sb = b % 1024, swz = sb ^ (((sb >> 9) & 1) << 5); R = (st >> 1) * 16 + swz / 64; C = (st & 1) * 32 + (swz % 64) / 2; }
__host__ __device__ __forceinline__ int perm32(int rho) { const int n = rho >> 4, i = rho & 15; return 8 * (i >> 2) + 4 * n + (i & 3); }

typedef int pg8_v4i __attribute__((ext_vector_type(4))); typedef int pg8_v8i __attribute__((ext_vector_type(8)));
__device__ __forceinline__ pg8_v8i pg8_cat8(bf16x8 a, bf16x8 b) { return __builtin_shufflevector(__builtin_bit_cast(pg8_v4i, a), __builtin_bit_cast(pg8_v4i, b), 0, 1, 2, 3, 4, 5, 6, 7); }
struct Unit { int pm, pn, e; };
struct Gemm { const bf16_t* A; const bf16_t* Bt; int M, N, K; };

struct StaticOrder {
    static constexpr bool GATHER = false, F8 = false; static constexpr int SCALE_B = 127;
    int nM, nN, nwg, G, c;
    __host__ __device__ void init(int M, int N, int G_, int c_) { nM = M / BM; nN = N / BM; nwg = nM * nN; G = G_; c = c_; }
    __host__ __device__ bool next(int i, Unit& u) const {
        const long L = (long)i * G + c; if (L >= nwg) return false;
        int wgid = (int)L; { const int q = nwg / NXCD, r = nwg % NXCD, xcd = wgid % NXCD, off = wgid / NXCD; wgid = (xcd < r ? xcd * (q + 1) : r * (q + 1) + (xcd - r) * q) + off; }
        const int nig = WGM * nN, gid = wgid / nig, fm = gid * WGM, gsz = (nM - fm) < WGM ? (nM - fm) : WGM;
        u.pm = fm + ((wgid % nig) % gsz); u.pn = (wgid % nig) / gsz; return true;
    }
    __device__ __forceinline__ void a_ready(const Unit&) const {}
    __device__ __forceinline__ void done(const Unit&) const {}
};

__device__ __forceinline__ unsigned cvt_pk_bf16(float lo, float hi) { unsigned r; asm volatile("v_cvt_pk_bf16_f32 %0, %1, %2" : "=v"(r) : "v"(lo), "v"(hi)); return r; }
typedef float f32x2 __attribute__((ext_vector_type(2)));
__device__ __forceinline__ f32x2 gelu_pk(f32x2 v) {
    const f32x2 av = __builtin_elementwise_abs(v), d = av * 0.2316418882f + 1.0f;
    f32x2 t; t.x = __builtin_amdgcn_rcpf(d.x); t.y = __builtin_amdgcn_rcpf(d.y);
    f32x2 q = t * 0.5307027145f + (-0.7265760135f); q = q * t + 0.7107068705f; q = q * t + (-0.142248368f); q = q * t + 0.127414796f; q = q * t;
    const f32x2 s = (v * v) * (-0.72134752044f);
    f32x2 e; e.x = __builtin_amdgcn_exp2f(s.x); e.y = __builtin_amdgcn_exp2f(s.y);
    const f32x2 m = v * (q * e), r = v - m;
    f32x2 o; o.x = v.x < 0.f ? m.x : r.x; o.y = v.y < 0.f ? m.y : r.y; return o;
}

template <class Epi, class Sched, bool ALIGN_EPI = false, bool SP2 = false>
__device__ __forceinline__ void gemm_phase(PG8_LAS unsigned char* lds, const Gemm g, const Sched& S, const Epi& E) {
    int tid_ = threadIdx.x; asm volatile("" : "+v"(tid_));
    const int tid = tid_, wid = __builtin_amdgcn_readfirstlane(tid >> 6), lane = tid & 63, wr = wid >> 2, wc = wid & 3, fr = lane & 15, fq = lane >> 4;
    const int K = g.K, nt = K / BK;
    unsigned voffA[2], voffB[2];
#pragma unroll
    for (int i = 0; i < 2; ++i) { int R, C; stage_rc(tid * 16 + i * 8192, R, C); const int Rb = Epi::PERM ? ((R & ~31) + perm32(R & 31)) : R;
        voffA[i] = (unsigned)(R * K + C) * 2u; voffB[i] = (unsigned)(Rb * K + C) * 2u; }
    unsigned vAc[2][2], vAn[2][2];
    int gR[2], gC[2];
#pragma unroll
    for (int i = 0; i < 2; ++i) { stage_rc(tid * 16 + i * 8192, gR[i], gC[i]); }
    const size_t kstep = (size_t)(BK * 2);
    const size_t hstep = (size_t)HALF * K * 2;
        const unsigned ldsw = (unsigned)wid * 1024u;
    const int aoff = lds_byte(wr * 64 + fr, fq * 8), boff = lds_byte(wc * 32 + fr, fq * 8);
#define PG8_SA(b, h) (((b) * 2 + (h)) * HTB)
#define PG8_SB(b, h) ((4 + (b) * 2 + (h)) * HTB)
#define PG8_STAGE(bufoff, gbase, voff) do { _Pragma("unroll") for (int _i = 0; _i < 2; ++_i) \
        __builtin_amdgcn_global_load_lds((const unsigned*)((const char*)(gbase) + (voff)[_i]), (PG8_LAS unsigned*)(lds + (bufoff) + ldsw + _i * 8192), 16, 0, 0); } while (0)
#define PG8_STAGE_A(b, h, base, VS) do { if constexpr (Sched::GATHER) { PG8_STAGE(PG8_SA(b, h), base, VS[h]); } else { PG8_STAGE(PG8_SA(b, h), (base) + (h) * hstep, voffA); } } while (0)
#define PG8_STAGE_AN(b, h, base) do { if constexpr (Sched::GATHER) { unsigned vs_[2] = {last ? vAn[h][0] : vAc[h][0], last ? vAn[h][1] : vAc[h][1]}; PG8_STAGE(PG8_SA(b, h), base, vs_); } else { PG8_STAGE(PG8_SA(b, h), (base) + (h) * hstep, voffA); } } while (0)
#define PG8_LDA(dst, b, h) do { if constexpr (Sched::F8) { _Pragma("unroll") for (int m = 0; m < 4; ++m) { dst##8[m].lo = *(const PG8_LAS pg8_v4i*)(lds + PG8_SA(b, h) + aoff + m * 2048); dst##8[m].hi = *(const PG8_LAS pg8_v4i*)(lds + PG8_SA(b, h) + aoff + m * 2048 + 1024); } } \
        else { _Pragma("unroll") for (int m = 0; m < 4; ++m) _Pragma("unroll") for (int k = 0; k < 2; ++k) dst[m][k] = *(const PG8_LAS bf16x8*)(lds + PG8_SA(b, h) + aoff + m * 2048 + k * 1024); } } while (0)
#define PG8_LDB(dst, b, h) do { if constexpr (Sched::F8) { _Pragma("unroll") for (int n = 0; n < 2; ++n) { dst##8[n].lo = *(const PG8_LAS pg8_v4i*)(lds + PG8_SB(b, h) + boff + n * 2048); dst##8[n].hi = *(const PG8_LAS pg8_v4i*)(lds + PG8_SB(b, h) + boff + n * 2048 + 1024); } } \
        else { _Pragma("unroll") for (int n = 0; n < 2; ++n) _Pragma("unroll") for (int k = 0; k < 2; ++k) dst[n][k] = *(const PG8_LAS bf16x8*)(lds + PG8_SB(b, h) + boff + n * 2048 + k * 1024); } } while (0)
#define PG8_MMA(ai, bj, At, Bt) do { __builtin_amdgcn_s_setprio(1); if constexpr (Sched::F8) { \
        _Pragma("unroll") for (int m = 0; m < 4; ++m) _Pragma("unroll") for (int n = 0; n < 2; ++n) \
            asm volatile("v_mfma_scale_f32_16x16x128_f8f6f4 %0, %1, %2, %0, %3, %4 op_sel_hi:[0,0,0]" : "+v"(acc[ai][bj][m][n]) : "v"(Bt##8[n]), "v"(At##8[m]), "v"(sclB_), "v"(sclA_));     \
        } else { _Pragma("unroll") for (int m = 0; m < 4; ++m) _Pragma("unroll") for (int n = 0; n < 2; ++n) _Pragma("unroll") for (int k = 0; k < 2; ++k) \
        acc[ai][bj][m][n] = __builtin_amdgcn_mfma_f32_16x16x32_bf16(Bt[n][k], At[m][k], acc[ai][bj][m][n], 0, 0, 0); } __builtin_amdgcn_s_setprio(0); } while (0)
#define PG8_WAIT_V(n) asm volatile("s_waitcnt vmcnt(" #n ")" ::: "memory")
#define PG8_WAIT_L(n) asm volatile("s_waitcnt lgkmcnt(" #n ")" ::: "memory")
#define PG8_BAR __builtin_amdgcn_s_barrier()
#define PG8_SCHED __builtin_amdgcn_sched_barrier(0)
    Unit cur, nxt; int ui = 0;
    if (!S.next(0, cur)) return;
    f32x4 acc[2][2][4][2];
#pragma unroll
    for (int a = 0; a < 2; ++a)
#pragma unroll
        for (int b = 0; b < 2; ++b)
#pragma unroll
            for (int m = 0; m < 4; ++m)
#pragma unroll
                for (int n = 0; n < 2; ++n) acc[a][b][m][n] = (f32x4){0.f, 0.f, 0.f, 0.f};
    const int sclB_ = Sched::SCALE_B, sclA_ = 127;
    bf16x8 At[4][2], B0[2][2], B1[2][2]; pg8_v8i At8[4], B08[2], B18[2];
    const char* cA = S.aptr(cur); const char* cB = S.bptr(cur);
    S.a_ready(cur);
    if constexpr (Sched::GATHER) {
#pragma unroll
        for (int h = 0; h < 2; ++h)
#pragma unroll
            for (int i = 0; i < 2; ++i) { vAc[h][i] = S.rowoff(cur, h * HALF + gR[i]) + (unsigned)gC[i] * 2u; vAn[h][i] = vAc[h][i]; }
        asm volatile("s_waitcnt vmcnt(0)" ::: "memory");
    }
    if constexpr (SP2) {
        PG8_STAGE(PG8_SB(0, 0), cB, voffB); PG8_STAGE(PG8_SB(0, 1), cB + hstep, voffB); PG8_STAGE_A(0, 0, cA, vAc); PG8_STAGE_A(0, 1, cA, vAc);
        if (wr == 1) PG8_BAR;
        PG8_WAIT_V(2); PG8_BAR;
        PG8_STAGE(PG8_SB(1, 0), cB + kstep, voffB); PG8_STAGE_A(1, 0, cA + kstep, vAc); PG8_STAGE(PG8_SB(1, 1), cB + hstep + kstep, voffB);
        PG8_WAIT_V(6); PG8_BAR;
    } else {
        PG8_STAGE(PG8_SB(0, 0), cB, voffB); PG8_STAGE_A(0, 0, cA, vAc); PG8_STAGE(PG8_SB(0, 1), cB + hstep, voffB); PG8_STAGE_A(0, 1, cA, vAc);
        if (wr == 1) PG8_BAR;
        PG8_WAIT_V(4); PG8_BAR;
        PG8_STAGE(PG8_SB(1, 0), cB + kstep, voffB); PG8_STAGE_A(1, 0, cA + kstep, vAc); PG8_STAGE(PG8_SB(1, 1), cB + hstep + kstep, voffB);
        PG8_WAIT_V(6); PG8_BAR;
    }
    for (;;) {
        const bool has_next = S.next(ui + 1, nxt);
        const char* nA = has_next ? S.aptr(nxt) : cA; const char* nB = has_next ? S.bptr(nxt) : cB;
        if constexpr (Sched::GATHER) { if (has_next) {
#pragma unroll
            for (int h = 0; h < 2; ++h)
#pragma unroll
                for (int i = 0; i < 2; ++i) vAn[h][i] = S.rowoff(nxt, h * HALF + gR[i]) + (unsigned)gC[i] * 2u; } }
        for (int t = 0; t < nt; t += 2) {
            const bool last = (t == nt - 2);
            const char* a1 = cA + (size_t)(t + 1) * kstep;
            const char* a2 = last ? nA : cA + (size_t)(t + 2) * kstep; const char* b2 = last ? nB : cB + (size_t)(t + 2) * kstep;
            const char* a3 = a2 + kstep; const char* b3 = b2 + kstep;
            if (last && has_next) S.a_ready(nxt);
            if constexpr (SP2) {
            PG8_LDB(B0, 0, 0); PG8_LDB(B1, 0, 1); PG8_SCHED; PG8_LDA(At, 0, 0); PG8_STAGE_A(1, 1, a1, vAc);
            PG8_WAIT_V(8); PG8_WAIT_L(0); PG8_BAR; PG8_MMA(0, 0, At, B0); PG8_MMA(0, 1, At, B1); PG8_BAR; PG8_SCHED;
            PG8_LDA(At, 0, 1); PG8_STAGE(PG8_SB(0, 0), b2, voffB); PG8_STAGE(PG8_SB(0, 1), b2 + hstep, voffB); PG8_STAGE_AN(0, 0, a2);
            PG8_WAIT_V(8); PG8_WAIT_L(0); PG8_BAR; PG8_MMA(1, 0, At, B0); PG8_MMA(1, 1, At, B1); PG8_BAR; PG8_SCHED;
            PG8_LDB(B0, 1, 0); PG8_LDB(B1, 1, 1); PG8_SCHED; PG8_LDA(At, 1, 0); PG8_STAGE_AN(0, 1, a2);
            PG8_WAIT_V(8); PG8_WAIT_L(0); PG8_BAR; PG8_MMA(0, 0, At, B0); PG8_MMA(0, 1, At, B1); PG8_BAR; PG8_SCHED;
            PG8_LDA(At, 1, 1); PG8_STAGE(PG8_SB(1, 0), b3, voffB); PG8_STAGE(PG8_SB(1, 1), b3 + hstep, voffB); PG8_STAGE_AN(1, 0, a3);
            PG8_WAIT_V(8); PG8_WAIT_L(0); PG8_BAR; PG8_MMA(1, 0, At, B0); PG8_MMA(1, 1, At, B1); PG8_BAR; PG8_SCHED;
            } else {
            PG8_LDB(B0, 0, 0); PG8_SCHED; PG8_LDA(At, 0, 0); PG8_STAGE_A(1, 1, a1, vAc);
            PG8_WAIT_L(8); PG8_BAR; PG8_WAIT_L(0); PG8_MMA(0, 0, At, B0); PG8_BAR; PG8_SCHED;
            PG8_LDB(B1, 0, 1); PG8_STAGE(PG8_SB(0, 0), b2, voffB);
            PG8_BAR; PG8_WAIT_L(0); PG8_MMA(0, 1, At, B1); PG8_BAR;
            PG8_LDA(At, 0, 1); PG8_STAGE_AN(0, 0, a2);
            PG8_BAR; PG8_WAIT_L(0); PG8_MMA(1, 0, At, B0); PG8_BAR; PG8_SCHED;
            PG8_STAGE(PG8_SB(0, 1), b2 + hstep, voffB);
            PG8_WAIT_V(6); PG8_BAR; PG8_MMA(1, 1, At, B1); PG8_BAR;
            PG8_LDB(B0, 1, 0); PG8_SCHED; PG8_LDA(At, 1, 0); PG8_STAGE_AN(0, 1, a2);
            PG8_WAIT_L(8); PG8_BAR; PG8_WAIT_L(0); PG8_MMA(0, 0, At, B0); PG8_BAR; PG8_SCHED;
            PG8_LDB(B1, 1, 1); PG8_STAGE(PG8_SB(1, 0), b3, voffB);
            PG8_BAR; PG8_WAIT_L(0); PG8_MMA(0, 1, At, B1); PG8_BAR;
            PG8_LDA(At, 1, 1); PG8_STAGE_AN(1, 0, a3);
            PG8_BAR; PG8_WAIT_L(0); PG8_MMA(1, 0, At, B0); PG8_BAR; PG8_SCHED;
            PG8_STAGE(PG8_SB(1, 1), b3 + hstep, voffB);
            PG8_WAIT_V(6); PG8_BAR; PG8_MMA(1, 1, At, B1); PG8_BAR;
            }
        }
        if constexpr (ALIGN_EPI) { if (wr == 0) PG8_BAR; }
        if constexpr (!Epi::AFTER_DRAIN) { E(acc, cur, wr, wc, fr, fq); S.done(cur); }
        if (!has_next) break;
#pragma unroll
        for (int a = 0; a < 2; ++a)
#pragma unroll
            for (int b = 0; b < 2; ++b)
#pragma unroll
                for (int m = 0; m < 4; ++m)
#pragma unroll
                    for (int n = 0; n < 2; ++n) acc[a][b][m][n] = (f32x4){0.f, 0.f, 0.f, 0.f};
        cur = nxt; cA = nA; cB = nB; ++ui;
        if constexpr (Sched::GATHER) {
#pragma unroll
            for (int h = 0; h < 2; ++h)
#pragma unroll
                for (int i = 0; i < 2; ++i) vAc[h][i] = vAn[h][i]; }
        if constexpr (ALIGN_EPI) { if (wr == 1) PG8_BAR; }
    }
    PG8_WAIT_V(0);
    if constexpr (!ALIGN_EPI) { if (wr == 0) PG8_BAR; }
    PG8_BAR;
    if constexpr (Epi::AFTER_DRAIN) { E.fused(acc, cur, wr, wc, fr, fq, lds, wid, lane); S.done(cur); }
#undef PG8_SA
#undef PG8_SB
#undef PG8_STAGE
#undef PG8_STAGE_A
#undef PG8_STAGE_AN
#undef PG8_LDA
#undef PG8_LDB
#undef PG8_MMA
#undef PG8_WAIT_V
#undef PG8_WAIT_L
#undef PG8_BAR
#undef PG8_SCHED
}
}

constexpr int T = 8192, D = 2048, MIXW = 1536, MEMW = 512, NINA = 3584, DEPTH = 4, NE = 32, FF = 512, MEMT = 256;
constexpr int SLOTS = 24576;
constexpr float LN_EPS = 1e-5f;
constexpr float DN_ALPHA = 1.6817928305074292f;
constexpr float LOG2E = 1.4426950408889634f;
constexpr float QSCALE = 0.08838834764831845f * LOG2E;
constexpr int NWAVES = 8;

constexpr size_t MiB = 1u << 20;
constexpr size_t WS_CTL = 0, CTL_ZERO_BYTES = 1 * MiB;
constexpr size_t WS_WAIN = 2 * MiB, WS_WAOUT = 30 * MiB, WS_WBIN0 = 46 * MiB, WS_WKV = 54 * MiB, WS_WBIN1 = 66 * MiB, WS_WBOUT = 74 * MiB, WS_WMKV = 90 * MiB;
constexpr size_t WS_W13 = 106 * MiB, WS_W2 = 618 * MiB;
constexpr size_t WS_XB = 874 * MiB, WS_MEMB = 906 * MiB, WS_MEMKV = 907 * MiB, WS_Z = 910 * MiB, WS_KD = 966 * MiB, WS_VD = 990 * MiB, WS_CAT = 1014 * MiB;
constexpr size_t WS_XQ = 1206 * MiB, WS_ZQ = 1222 * MiB, WS_MEMQ = 1238 * MiB, WS_CATQ = 1246 * MiB;
constexpr size_t WS_Y = 1046 * MiB, WS_X1F = 1110 * MiB, WS_X1B = 1174 * MiB, WS_XF = 1206 * MiB, WS_XG = 1270 * MiB, WS_H = 1366 * MiB, WS_YB = 1390 * MiB, WS_OP = 1486 * MiB;
constexpr size_t WS_ROUTE = 1582 * MiB, WS_OP2 = 1583 * MiB, WS_ML = 1631 * MiB, WS_WR = 1634 * MiB, WS_TS = 1640 * MiB, WS_LIST = 1641 * MiB, WS_END = 1642 * MiB;
constexpr int CW_TMO = 0, CW_BAR = 4096, CW_CNT = 16384, CW_Q = 28672, CW_CONV = 29184, CW_DONE = 32768, CW_FIN = 40960;

constexpr int RING_OFF = 0, RING_BYTES = 131072;
constexpr int LDSCTL_OFF = 146432, MISC_OFF = LDSCTL_OFF + 320, TAB_OFF = LDSCTL_OFF + 512;
constexpr int LDS_BYTES = 147456;

#define GAS __attribute__((address_space(1)))
#define LAS __attribute__((address_space(3)))
typedef unsigned short bf16;
typedef unsigned v4u __attribute__((ext_vector_type(4)));
typedef unsigned v2u __attribute__((ext_vector_type(2)));
typedef float f32x4 __attribute__((ext_vector_type(4)));
typedef short bf16x8 __attribute__((ext_vector_type(8)));
typedef GAS unsigned gu32;
#define RLX_AGENT __ATOMIC_RELAXED, __HIP_MEMORY_SCOPE_AGENT
#define LDS_WAIT() asm volatile("s_waitcnt lgkmcnt(0)" ::: "memory")
#define VM_WAIT() asm volatile("s_waitcnt vmcnt(0)" ::: "memory")
__device__ __forceinline__ unsigned f2bf(float f) { unsigned u = __builtin_bit_cast(unsigned, f); return (u + 0x7fffu + ((u >> 16) & 1u)) >> 16; }
__device__ __forceinline__ unsigned pk2(float lo, float hi) { return f2bf(lo) | (f2bf(hi) << 16); }
__device__ __forceinline__ float bf2f(unsigned short b) { return __builtin_bit_cast(float, (unsigned)b << 16); }
__device__ __forceinline__ float bflo(unsigned w) { return __builtin_bit_cast(float, w << 16); }
__device__ __forceinline__ float bfhi(unsigned w) { return __builtin_bit_cast(float, w & 0xffff0000u); }
__device__ __forceinline__ float wave_sum(float v) {
#pragma unroll
    for (int o = 1; o < 64; o <<= 1) v += __shfl_xor(v, o);
    return v;
}

namespace pg8 {
struct DenseOrder {
    static constexpr bool GATHER = false, F8 = false; static constexpr int SCALE_B = 127;
    StaticOrder so; const char* A; const char* B; size_t astep, bstep;
    __device__ void init(const void* A_, const void* B_, int M, int N, int K, int G, int c) { so.init(M, N, G, c); A = (const char*)A_; B = (const char*)B_; astep = (size_t)256 * K * 2; bstep = astep; }
    __device__ __forceinline__ bool next(int i, Unit& u) const { u.e = 0; return so.next(i, u); }
    __device__ __forceinline__ const char* aptr(const Unit& u) const { return A + (size_t)u.pm * astep; }
    __device__ __forceinline__ const char* bptr(const Unit& u) const { return B + (size_t)u.pn * bstep; }
    __device__ __forceinline__ void a_ready(const Unit&) const {}
    __device__ __forceinline__ void done(const Unit&) const {}
};
struct DenseOrder8 {
    static constexpr bool GATHER = false, F8 = true; static constexpr int SCALE_B = 121;
    StaticOrder so; const char* A; const char* B; size_t astep, bstep;
    __device__ void init(const void* A_, const void* B_, int M, int N, int K, int G, int c) { so.init(M, N, G, c); A = (const char*)A_; B = (const char*)B_; astep = (size_t)256 * K * 2; bstep = astep; }
    __device__ __forceinline__ bool next(int i, Unit& u) const { u.e = 0; return so.next(i, u); }
    __device__ __forceinline__ const char* aptr(const Unit& u) const { return A + (size_t)u.pm * astep; }
    __device__ __forceinline__ const char* bptr(const Unit& u) const { return B + (size_t)u.pn * bstep; }
    __device__ __forceinline__ void a_ready(const Unit&) const {}
    __device__ __forceinline__ void done(const Unit&) const {}
};
struct DualOrder {
    static constexpr bool GATHER = false, F8 = false; static constexpr int SCALE_B = 127;
    StaticOrder so; int nwg2; const char* A; const char* B; const char* A2; const char* B2; size_t step;
    __device__ void init(const void* A_, const void* B_, int M, int N, int K, int G, int c, const void* A2_, const void* B2_, int nwg2_) { so.init(M, N, G, c); A = (const char*)A_; B = (const char*)B_; A2 = (const char*)A2_; B2 = (const char*)B2_; nwg2 = nwg2_; step = (size_t)256 * K * 2; }
    __device__ __forceinline__ bool next(int i, Unit& u) const { const int L = i * so.G + so.c; if (L < so.nwg) { u.e = 0; return so.next(i, u); } if (L - so.nwg >= nwg2) return false; u.e = 1; u.pm = 0; u.pn = L - so.nwg; return true; }
    __device__ __forceinline__ const char* aptr(const Unit& u) const { return u.e ? A2 : A + (size_t)u.pm * step; }
    __device__ __forceinline__ const char* bptr(const Unit& u) const { return (u.e ? B2 : B) + (size_t)u.pn * step; }
    __device__ __forceinline__ void a_ready(const Unit&) const {}
    __device__ __forceinline__ void done(const Unit&) const {}
};
struct DualOrder8 {
    static constexpr bool GATHER = false, F8 = true; static constexpr int SCALE_B = 121;
    StaticOrder so; int nwg2; const char* A; const char* B; const char* A2; const char* B2; size_t step;
    __device__ void init(const void* A_, const void* B_, int M, int N, int K, int G, int c, const void* A2_, const void* B2_, int nwg2_) { so.init(M, N, G, c); A = (const char*)A_; B = (const char*)B_; A2 = (const char*)A2_; B2 = (const char*)B2_; nwg2 = nwg2_; step = (size_t)256 * K * 2; }
    __device__ __forceinline__ bool next(int i, Unit& u) const { const int L = i * so.G + so.c; if (L < so.nwg) { u.e = 0; return so.next(i, u); } if (L - so.nwg >= nwg2) return false; u.e = 1; u.pm = 0; u.pn = L - so.nwg; return true; }
    __device__ __forceinline__ const char* aptr(const Unit& u) const { return u.e ? A2 : A + (size_t)u.pm * step; }
    __device__ __forceinline__ const char* bptr(const Unit& u) const { return (u.e ? B2 : B) + (size_t)u.pn * step; }
    __device__ __forceinline__ void a_ready(const Unit&) const {}
    __device__ __forceinline__ void done(const Unit&) const {}
};
struct MoeOrder {
    static constexpr bool GATHER = false, F8 = false; static constexpr int SCALE_B = 127;
    const PG8_LAS int* tstart; int ntn, G, c; const char* A; const char* W; size_t astep, wexp, wtile;
    __device__ __forceinline__ bool next(int i, Unit& u) const {
        const int L = i * G + c, total = tstart[32] * ntn; if (L >= total) return false;
        int wgid; { const int q = total / NXCD, r = total % NXCD, xcd = L % NXCD, off = L / NXCD; wgid = (xcd < r ? xcd * (q + 1) : r * (q + 1) + (xcd - r) * q) + off; }
        u.pm = wgid / ntn; u.pn = wgid - u.pm * ntn; int e = 0;
#pragma unroll
        for (int k = 1; k <= 31; ++k) e += (tstart[k] <= u.pm) ? 1 : 0;
        u.e = e; return true;
    }
    __device__ __forceinline__ const char* aptr(const Unit& u) const { return A + (size_t)u.pm * astep; }
    __device__ __forceinline__ const char* bptr(const Unit& u) const { return W + (size_t)u.e * wexp + (size_t)u.pn * wtile; }
    __device__ __forceinline__ void a_ready(const Unit&) const {}
    __device__ __forceinline__ void done(const Unit&) const {}
};

struct MoeOrder8 {
    static constexpr bool GATHER = false, F8 = true; static constexpr int SCALE_B = 121;
    const PG8_LAS int* tstart; int ntn, G, c; const char* A; const char* W; size_t astep, wexp, wtile;
    __device__ __forceinline__ bool next(int i, Unit& u) const {
        const int L = i * G + c, total = tstart[32] * ntn; if (L >= total) return false;
        int wgid; { const int q = total / NXCD, r = total % NXCD, xcd = L % NXCD, off = L / NXCD; wgid = (xcd < r ? xcd * (q + 1) : r * (q + 1) + (xcd - r) * q) + off; }
        u.pm = wgid / ntn; u.pn = wgid - u.pm * ntn; int e = 0;
#pragma unroll
        for (int k = 1; k <= 31; ++k) e += (tstart[k] <= u.pm) ? 1 : 0;
        u.e = e; return true;
    }
    __device__ __forceinline__ const char* aptr(const Unit& u) const { return A + (size_t)u.pm * astep; }
    __device__ __forceinline__ const char* bptr(const Unit& u) const { return W + (size_t)u.e * wexp + (size_t)u.pn * wtile; }
    __device__ __forceinline__ void a_ready(const Unit&) const {}
    __device__ __forceinline__ void done(const Unit&) const {}
};

struct MoeGatherOrder {
    static constexpr bool GATHER = true, F8 = true; static constexpr int SCALE_B = 121;
    const PG8_LAS int* tstart; const PG8_LAS int* cntl; const int* list; int ntn, G, c; const char* A; const char* W; size_t wexp, wtile; unsigned rowbytes;
    __device__ __forceinline__ bool next(int i, Unit& u) const {
        const int L = i * G + c, total = tstart[32] * ntn; if (L >= total) return false;
        int wgid; { const int q = total / NXCD, r = total % NXCD, xcd = L % NXCD, off = L / NXCD; wgid = (xcd < r ? xcd * (q + 1) : r * (q + 1) + (xcd - r) * q) + off; }
        u.pm = wgid / ntn; u.pn = wgid - u.pm * ntn; int e = 0;
#pragma unroll
        for (int k = 1; k <= 31; ++k) e += (tstart[k] <= u.pm) ? 1 : 0;
        u.e = e; return true;
    }
    __device__ __forceinline__ unsigned rowoff(const Unit& u, int r) const { const int rank = (u.pm - tstart[u.e]) * 256 + r; const int tok = list[u.e * 8192 + (rank < cntl[u.e] ? rank : 0)]; return (unsigned)tok * rowbytes; }
    __device__ __forceinline__ const char* aptr(const Unit&) const { return A; }
    __device__ __forceinline__ const char* bptr(const Unit& u) const { return W + (size_t)u.e * wexp + (size_t)u.pn * wtile; }
    __device__ __forceinline__ void a_ready(const Unit&) const {}
    __device__ __forceinline__ void done(const Unit&) const {}
};

typedef unsigned u32x2 __attribute__((ext_vector_type(2)));
struct EpiBf16X {
    static constexpr bool PERM = true, AFTER_DRAIN = false;
    int mode; bf16_t* p0; bf16_t* p1; bf16_t* p2; bf16_t* p3;
    const PG8_LAS int* tstart; const PG8_LAS int* cntl;
    __device__ __forceinline__ void operator()(const f32x4 (&acc)[2][2][4][2], const Unit& u, int wr, int wc, int fr, int fq) const {
#ifndef ATT_BF16
        if (mode == 1 && !u.e) {
            int tok0 = u.pm * BM + wr * 64 + fr, cc0 = wc * 32 + 8 * fq; asm volatile("" : "+v"(tok0), "+v"(cc0));
            if (u.pn >= 14) { const int colv = (u.pn - 14) * BM + cc0; unsigned char* vb = (unsigned char*)p2 + ((size_t)((colv >> 8) * 128 + (tok0 >> 6)) * 256 + (colv & 255)) * 64 + (tok0 & 63);
#pragma unroll
                for (int ai = 0; ai < 2; ++ai)
#pragma unroll
                    for (int m = 0; m < 4; ++m)
#pragma unroll
                        for (int bj = 0; bj < 2; ++bj) { const f32x4 v0 = acc[ai][bj][m][0], v1 = acc[ai][bj][m][1]; unsigned a_ = 0u, b_ = 0u;
                            a_ = __builtin_amdgcn_cvt_pk_fp8_f32(v0[0], v0[1], a_, false); a_ = __builtin_amdgcn_cvt_pk_fp8_f32(v0[2], v0[3], a_, true); b_ = __builtin_amdgcn_cvt_pk_fp8_f32(v1[0], v1[1], b_, false); b_ = __builtin_amdgcn_cvt_pk_fp8_f32(v1[2], v1[3], b_, true);
                            unsigned char* vp = vb + (size_t)(ai * 2) * 16384 + m * 16 + (size_t)bj * HALF * 64;
                            vp[0] = (unsigned char)a_; vp[64] = (unsigned char)(a_ >> 8); vp[128] = (unsigned char)(a_ >> 16); vp[192] = (unsigned char)(a_ >> 24);
                            vp[256] = (unsigned char)b_; vp[320] = (unsigned char)(b_ >> 8); vp[384] = (unsigned char)(b_ >> 16); vp[448] = (unsigned char)(b_ >> 24); }
                return; }
            if (u.pn >= 8) { unsigned char* kb = (unsigned char*)p1 + (size_t)tok0 * 1536 + (u.pn - 8) * BM + cc0;
#pragma unroll
                for (int ai = 0; ai < 2; ++ai)
#pragma unroll
                    for (int m = 0; m < 4; ++m)
#pragma unroll
                        for (int bj = 0; bj < 2; ++bj) { const f32x4 v0 = acc[ai][bj][m][0], v1 = acc[ai][bj][m][1]; unsigned a_ = 0u, b_ = 0u;
                            a_ = __builtin_amdgcn_cvt_pk_fp8_f32(v0[0], v0[1], a_, false); a_ = __builtin_amdgcn_cvt_pk_fp8_f32(v0[2], v0[3], a_, true); b_ = __builtin_amdgcn_cvt_pk_fp8_f32(v1[0], v1[1], b_, false); b_ = __builtin_amdgcn_cvt_pk_fp8_f32(v1[2], v1[3], b_, true);
                            u32x2 kk; kk.x = a_; kk.y = b_; *(u32x2*)(kb + (size_t)(ai * HALF + m * 16) * 1536 + bj * HALF) = kk; }
                return; }
            { unsigned char* qb = (unsigned char*)p0 + (WS_ZQ - WS_Z) + (size_t)tok0 * 2048 + u.pn * BM + cc0; bf16_t* zb = p0 + (size_t)tok0 * 2048 + u.pn * BM + cc0;
#pragma unroll
                for (int ai = 0; ai < 2; ++ai)
#pragma unroll
                    for (int m = 0; m < 4; ++m)
#pragma unroll
                        for (int bj = 0; bj < 2; ++bj) { const f32x4 v0 = acc[ai][bj][m][0] * QSCALE, v1 = acc[ai][bj][m][1] * QSCALE; unsigned a_ = 0u, b_ = 0u;
                            a_ = __builtin_amdgcn_cvt_pk_fp8_f32(v0[0], v0[1], a_, false); a_ = __builtin_amdgcn_cvt_pk_fp8_f32(v0[2], v0[3], a_, true); b_ = __builtin_amdgcn_cvt_pk_fp8_f32(v1[0], v1[1], b_, false); b_ = __builtin_amdgcn_cvt_pk_fp8_f32(v1[2], v1[3], b_, true);
                            const size_t o_ = (size_t)(ai * HALF + m * 16) * 2048 + bj * HALF;
                            u32x2 qq; qq.x = a_; qq.y = b_; *(u32x2*)(qb + o_) = qq;
                            if (u.pn >= 6) { u32x4 w; w.x = cvt_pk_bf16(v0[0], v0[1]); w.y = cvt_pk_bf16(v0[2], v0[3]); w.z = cvt_pk_bf16(v1[0], v1[1]); w.w = cvt_pk_bf16(v1[2], v1[3]); *(u32x4*)(zb + o_) = w; } }
                return; }
        }
#endif
        if (mode == 3) {
            int r0_ = wr * 64 + fr, c0_ = u.pn * BM + wc * 32 + 8 * fq; asm volatile("" : "+v"(r0_), "+v"(c0_));
            const int rlim = cntl[u.e] - (u.pm - tstart[u.e]) * BM;
            unsigned char* yb_ = (unsigned char*)p0 + (size_t)(u.pm * BM + r0_) * 2048 + c0_;
#pragma unroll
            for (int ai = 0; ai < 2; ++ai)
#pragma unroll
                for (int m = 0; m < 4; ++m) { if (r0_ + ai * HALF + m * 16 >= rlim) continue;
#pragma unroll
                    for (int bj = 0; bj < 2; ++bj) { const f32x4 v0 = acc[ai][bj][m][0] * 16.f, v1 = acc[ai][bj][m][1] * 16.f; unsigned a_ = 0u, b_ = 0u;
                        a_ = __builtin_amdgcn_cvt_pk_fp8_f32(v0[0], v0[1], a_, false); a_ = __builtin_amdgcn_cvt_pk_fp8_f32(v0[2], v0[3], a_, true); b_ = __builtin_amdgcn_cvt_pk_fp8_f32(v1[0], v1[1], b_, false); b_ = __builtin_amdgcn_cvt_pk_fp8_f32(v1[2], v1[3], b_, true);
                        u32x2 q_; q_.x = a_; q_.y = b_; *(u32x2*)(yb_ + (size_t)(ai * HALF + m * 16) * 2048 + bj * HALF) = q_; } }
            return; }
        bf16_t* base; int ldc, colt; bool act = false; float sc = 1.f;
        if (u.e && mode < 2) { base = p3 + (size_t)(u.pn >> 2) * (256 * 1024); ldc = 1024; colt = (u.pn & 3) * BM; }
        else if (mode == 0) { base = p0; ldc = 3584; colt = u.pn * BM; act = u.pn < 12; if (u.pn >= 12) sc = QSCALE; }
        else if (mode == 1) { if (u.pn < 8) { base = p0; ldc = 2048; colt = u.pn * BM; sc = QSCALE; }
                              else if (u.pn < 14) { base = p1; ldc = 1536; colt = (u.pn - 8) * BM; } else { base = p2; ldc = 1536; colt = (u.pn - 14) * BM; } }
        else { base = p0; ldc = 2048; colt = u.pn * BM; }
        const int row0 = u.pm * BM + wr * 64 + fr, col0 = colt + wc * 32 + 8 * fq;
        const int rlim = (mode == 3) ? cntl[u.e] - (u.pm - tstart[u.e]) * BM : BM;
#pragma unroll
        for (int ai = 0; ai < 2; ++ai)
#pragma unroll
            for (int m = 0; m < 4; ++m) { bf16_t* rowp = base + (size_t)(row0 + ai * HALF + m * 16) * ldc + col0;
                if (wr * 64 + fr + ai * HALF + m * 16 >= rlim) continue;
#pragma unroll
                for (int bj = 0; bj < 2; ++bj) { f32x4 v0 = acc[ai][bj][m][0], v1 = acc[ai][bj][m][1];
                    if (act) { f32x2 a = gelu_pk((f32x2){v0[0], v0[1]}), b = gelu_pk((f32x2){v0[2], v0[3]}), c = gelu_pk((f32x2){v1[0], v1[1]}), d = gelu_pk((f32x2){v1[2], v1[3]});
                        v0 = (f32x4){a.x, a.y, b.x, b.y}; v1 = (f32x4){c.x, c.y, d.x, d.y}; }
                    v0 = v0 * sc; v1 = v1 * sc; u32x4 w; w.x = cvt_pk_bf16(v0[0], v0[1]); w.y = cvt_pk_bf16(v0[2], v0[3]); w.z = cvt_pk_bf16(v1[0], v1[1]); w.w = cvt_pk_bf16(v1[2], v1[3]);
                    *(u32x4*)(rowp + bj * HALF) = w; } }
    }
};
struct EpiResBf16 {
    static constexpr bool PERM = true, AFTER_DRAIN = false;
    const bf16_t* xres; bf16_t* y; float alpha;
    __device__ __forceinline__ void operator()(const f32x4 (&acc)[2][2][4][2], const Unit& u, int wr, int wc, int fr, int fq) const {
        const int row0 = u.pm * BM + wr * 64 + fr, col0 = u.pn * BM + wc * 32 + 8 * fq;
#pragma unroll
        for (int ai = 0; ai < 2; ++ai)
#pragma unroll
            for (int m = 0; m < 4; ++m) { const size_t off = (size_t)(row0 + ai * HALF + m * 16) * 2048 + col0;
#pragma unroll
                for (int bj = 0; bj < 2; ++bj) { const u32x4 xr = *(const u32x4*)(xres + off + bj * HALF); const f32x4 v0 = acc[ai][bj][m][0], v1 = acc[ai][bj][m][1]; u32x4 w;
                    w.x = cvt_pk_bf16(__builtin_bit_cast(float, xr.x << 16) * alpha + v0[0], __builtin_bit_cast(float, xr.x & 0xffff0000u) * alpha + v0[1]);
                    w.y = cvt_pk_bf16(__builtin_bit_cast(float, xr.y << 16) * alpha + v0[2], __builtin_bit_cast(float, xr.y & 0xffff0000u) * alpha + v0[3]);
                    w.z = cvt_pk_bf16(__builtin_bit_cast(float, xr.z << 16) * alpha + v1[0], __builtin_bit_cast(float, xr.z & 0xffff0000u) * alpha + v1[1]);
                    w.w = cvt_pk_bf16(__builtin_bit_cast(float, xr.w << 16) * alpha + v1[2], __builtin_bit_cast(float, xr.w & 0xffff0000u) * alpha + v1[3]);
                    *(u32x4*)(y + off + bj * HALF) = w; } }
    }
};
struct EpiMoe1 {
    static constexpr bool PERM = true, AFTER_DRAIN = false;
    bf16_t* h; const PG8_LAS int* tstart; const PG8_LAS int* cntl;
    __device__ __forceinline__ void operator()(const f32x4 (&acc)[2][2][4][2], const Unit& u, int wr, int wc, int fr, int fq) const {
        const int row0 = u.pm * BM + wr * 64 + fr, col0 = u.pn * HALF + wc * 32 + 8 * fq;
        const int rlim = cntl[u.e] - (u.pm - tstart[u.e]) * BM;
#pragma unroll
        for (int ai = 0; ai < 2; ++ai)
#pragma unroll
            for (int m = 0; m < 4; ++m) { unsigned char* rowp = (unsigned char*)h + (size_t)(row0 + ai * HALF + m * 16) * 512 + col0; float o[8];
                if (wr * 64 + fr + ai * HALF + m * 16 >= rlim) continue;
#pragma unroll
                for (int n = 0; n < 2; ++n)
#pragma unroll
                    for (int x = 0; x < 4; ++x) { const float a = acc[ai][0][m][n][x], b = acc[ai][1][m][n][x];
                        o[n * 4 + x] = a * __builtin_amdgcn_rcpf(1.0f + __builtin_amdgcn_exp2f(-a * LOG2E)) * b; }
                unsigned lo = 0u, hi = 0u; lo = __builtin_amdgcn_cvt_pk_fp8_f32(o[0], o[1], lo, false); lo = __builtin_amdgcn_cvt_pk_fp8_f32(o[2], o[3], lo, true);
                hi = __builtin_amdgcn_cvt_pk_fp8_f32(o[4], o[5], hi, false); hi = __builtin_amdgcn_cvt_pk_fp8_f32(o[6], o[7], hi, true);
                typedef unsigned u32x2e __attribute__((ext_vector_type(2))); u32x2e w; w.x = lo; w.y = hi; *(u32x2e*)rowp = w; }
    }
};
}

namespace att {
using bf16x8 = __attribute__((ext_vector_type(8))) short;
using s16x4  = __attribute__((ext_vector_type(4))) short;
using f32x16 = __attribute__((ext_vector_type(16))) float;
using u32x4  = __attribute__((ext_vector_type(4))) unsigned;
constexpr int DH = 128, QBLK = 32, KVBLK = 64;
constexpr float THR2 = 8.f * 1.4426950408889634f;
constexpr size_t SHM_V = KVBLK * DH * 2, SHM_K = KVBLK * DH * 2, SHM_ATTN = 2 * SHM_V + 2 * SHM_K + NWAVES * 64 * 4;
constexpr int TAB_N = 160;
#define KSWZ(row, colB) ((row) * 256 + ((colB) ^ (((row) & 7) << 4)))
#define SBAR() __builtin_amdgcn_sched_barrier(0)
__device__ __forceinline__ int crow(int r, int hi) { return (r & 3) + 8 * (r >> 2) + 4 * hi; }
__device__ __forceinline__ unsigned cvtpk(float lo, float hi) { unsigned r; asm volatile("v_cvt_pk_bf16_f32 %0, %1, %2" : "=v"(r) : "v"(lo), "v"(hi)); return r; }

__device__ __forceinline__ void partialSM(f32x16& p0, f32x16& p1, float& m_reg, float& mn, float& alpha) {
  float pmax = p0[0];
#pragma unroll
  for (int r = 1; r < 16; ++r) pmax = fmaxf(pmax, p0[r]);
#pragma unroll
  for (int r = 0; r < 16; ++r) pmax = fmaxf(pmax, p1[r]);
  { auto rr = __builtin_amdgcn_permlane32_swap(__float_as_uint(pmax), __float_as_uint(pmax), false, false);
    pmax = fmaxf(__uint_as_float(rr[0]), __uint_as_float(rr[1])); }
  if (__builtin_expect(__all(pmax - m_reg <= THR2), 1)) { mn = m_reg; alpha = 1.f; }
  else { mn = fmaxf(m_reg, pmax); alpha = __builtin_amdgcn_exp2f(m_reg - mn); m_reg = mn; }
#pragma unroll
  for (int r = 0; r < 16; ++r) p0[r] = p0[r] - mn;
#pragma unroll
  for (int r = 0; r < 16; ++r) p1[r] = p1[r] - mn;
#pragma unroll
  for (int r = 0; r < 16; ++r) p0[r] = __builtin_amdgcn_exp2f(p0[r]);
}
__device__ __forceinline__ void finishSM(f32x16& p0, f32x16& p1, float alpha, float& l_reg, bf16x8& pa0, bf16x8& pa1, bf16x8& pa2, bf16x8& pa3) {
#pragma unroll
  for (int r = 0; r < 16; ++r) p1[r] = __builtin_amdgcn_exp2f(p1[r]);
  float ps = 0;
#pragma unroll
  for (int r = 0; r < 16; ++r) ps += p0[r];
#pragma unroll
  for (int r = 0; r < 16; ++r) ps += p1[r];
  { auto rr = __builtin_amdgcn_permlane32_swap(__float_as_uint(ps), __float_as_uint(ps), false, false);
    ps = __uint_as_float(rr[0]) + __uint_as_float(rr[1]); }
  l_reg = l_reg * alpha + ps;
#define PK4(P, BASE, OUT) do { unsigned a0 = cvtpk(P[BASE + 0], P[BASE + 1]), a1 = cvtpk(P[BASE + 2], P[BASE + 3]);   \
    unsigned b0 = cvtpk(P[BASE + 4], P[BASE + 5]), b1 = cvtpk(P[BASE + 6], P[BASE + 7]);                              \
    auto r0 = __builtin_amdgcn_permlane32_swap(a0, b0, false, false); auto r1 = __builtin_amdgcn_permlane32_swap(a1, b1, false, false); \
    u32x4 w = {r0[0], r1[0], r0[1], r1[1]}; OUT = *reinterpret_cast<bf16x8*>(&w); } while (0)
  PK4(p0, 0, pa0); PK4(p0, 8, pa1); PK4(p1, 0, pa2); PK4(p1, 8, pa3);
#undef PK4
}
__device__ __forceinline__ void qkt(f32x16& p0, f32x16& p1, const char* Ks, const bf16x8* qr, int r32, int hi) {
  p0 = f32x16{}; p1 = f32x16{};
#pragma unroll
  for (int d0 = 0; d0 < 8; ++d0) { const int cb = (d0 * 16 + hi * 8) * 2;
    bf16x8 b0 = *reinterpret_cast<const bf16x8*>(Ks + KSWZ(r32, cb));
    bf16x8 b1 = *reinterpret_cast<const bf16x8*>(Ks + KSWZ(32 + r32, cb));
    p0 = __builtin_amdgcn_mfma_f32_32x32x16_bf16(b0, qr[d0], p0, 0, 0, 0);
    p1 = __builtin_amdgcn_mfma_f32_32x32x16_bf16(b1, qr[d0], p1, 0, 0, 0); }
}
__device__ __forceinline__ int v_st(int k, int c) { const int kk = (k & ~0xC) | ((k & 4) << 1) | ((k & 8) >> 1); return ((kk >> 3) * 4 + (c >> 5)) * 512 + ((kk & 7) * 32 + (c & 31)) * 2; }
__device__ __forceinline__ int v_rd_base(int lane) { return ((lane & 3) << 3) | (((lane >> 2) & 3) << 6) | (((lane >> 4) & 1) << 5) | (((lane >> 5) & 1) << 8); }
constexpr int v_rd_off(int d0, int ks, int half) { return d0 * 512 + ks * 4096 + half * 2048; }
template <int OFF> __device__ __forceinline__ s16x4 tr_read(int vb) {
  s16x4 r; asm volatile("ds_read_b64_tr_b16 %0, %1 offset:%2" : "=&v"(r) : "v"(vb), "i"(OFF) : "memory"); return r;
}
template <int D0> __device__ __forceinline__ void pv_one(f32x16& od, int vb, bf16x8 pa0, bf16x8 pa1, bf16x8 pa2, bf16x8 pa3) {
  const s16x4 l0 = tr_read<v_rd_off(D0, 0, 0)>(vb), h0 = tr_read<v_rd_off(D0, 0, 1)>(vb), l1 = tr_read<v_rd_off(D0, 1, 0)>(vb), h1 = tr_read<v_rd_off(D0, 1, 1)>(vb);
  const s16x4 l2 = tr_read<v_rd_off(D0, 2, 0)>(vb), h2 = tr_read<v_rd_off(D0, 2, 1)>(vb), l3 = tr_read<v_rd_off(D0, 3, 0)>(vb), h3 = tr_read<v_rd_off(D0, 3, 1)>(vb);
  asm volatile("s_waitcnt lgkmcnt(0)" ::: "memory"); SBAR();
#define PK(L, H) (bf16x8){L[0], L[1], L[2], L[3], H[0], H[1], H[2], H[3]}
  od = __builtin_amdgcn_mfma_f32_32x32x16_bf16(pa0, PK(l0, h0), od, 0, 0, 0);
  od = __builtin_amdgcn_mfma_f32_32x32x16_bf16(pa1, PK(l1, h1), od, 0, 0, 0);
  od = __builtin_amdgcn_mfma_f32_32x32x16_bf16(pa2, PK(l2, h2), od, 0, 0, 0);
  od = __builtin_amdgcn_mfma_f32_32x32x16_bf16(pa3, PK(l3, h3), od, 0, 0, 0);
#undef PK
}
__device__ __forceinline__ void pv_d0(f32x16* o, int vb, bf16x8 pa0, bf16x8 pa1, bf16x8 pa2, bf16x8 pa3) {
  pv_one<0>(o[0], vb, pa0, pa1, pa2, pa3); pv_one<1>(o[1], vb, pa0, pa1, pa2, pa3); pv_one<2>(o[2], vb, pa0, pa1, pa2, pa3); pv_one<3>(o[3], vb, pa0, pa1, pa2, pa3);
}
template <int MODE> __device__ __forceinline__ void post_scores(f32x16& p0, f32x16& p1, int t, int qrow0, int r32, int hi, const float* tab, float cfar) {
  if constexpr (MODE == 1) {
    const int cw = qrow0 >> 6;
    if (t > cw) {
#pragma unroll
      for (int r = 0; r < 16; ++r) { p0[r] = -INFINITY; p1[r] = -INFINITY; }
    } else if (qrow0 - (64 * t + 63) >= 91) {
#pragma unroll
      for (int r = 0; r < 16; ++r) { p0[r] += cfar; p1[r] += cfar; }
    } else {
      const int base = qrow0 + r32 - 64 * t + 63;
#pragma unroll
      for (int r = 0; r < 16; ++r) { const int i0 = base - crow(r, hi); const int i1 = i0 - 32;
        p0[r] += tab[i0 < TAB_N - 1 ? i0 : TAB_N - 1]; p1[r] += tab[i1 < TAB_N - 1 ? i1 : TAB_N - 1]; }
    }
  }
}

template <int MODE>
__device__ __forceinline__ void attn_body(const bf16* __restrict__ Qb, int ldq, const bf16* __restrict__ Kh, const bf16* __restrict__ Vh, int ldk,
                                          bf16* Ob, float* Of, int ldo, int NT, int q0abs, const float* tab, float cfar, char* lds) {
  int tid_ = threadIdx.x; asm volatile("" : "+v"(tid_));
  const int tid = tid_, wid = tid >> 6, lane = tid & 63, r32 = lane & 31, hi = lane >> 5;
  char* V_lds = lds; char* K_lds = lds + 2 * SHM_V;
  float* ws = (float*)(lds + 2 * SHM_V + 2 * SHM_K) + wid * 64; float* li_l = ws; float* al_l = ws + 32;
  float m_reg = -1e30f, l_reg = 0; f32x16 o[4] = {}; bf16x8 qr[8];
  const int qrow0 = q0abs + wid * QBLK;
  const bf16* Qw = Qb + (long)(wid * QBLK + r32) * ldq + hi * 8;
#pragma unroll
  for (int d0 = 0; d0 < 8; ++d0) qr[d0] = *reinterpret_cast<const bf16x8*>(Qw + d0 * 16);
  const int sr = tid >> 4, sc = (tid & 15) * 8, vst0 = v_st(sr, sc), vst1 = v_st(32 + sr, sc);
  const int vb0 = (int)(uintptr_t)V_lds + v_rd_base(lane);
  struct { bf16x8 vs0, vs1, ks0, ks1; } sr_[2];
#define SLOAD(i, k0) do { sr_[i].vs0 = *reinterpret_cast<const bf16x8*>(&Vh[(long)((k0) + sr) * ldk + sc]); sr_[i].vs1 = *reinterpret_cast<const bf16x8*>(&Vh[(long)((k0) + 32 + sr) * ldk + sc]); \
    sr_[i].ks0 = *reinterpret_cast<const bf16x8*>(&Kh[(long)((k0) + sr) * ldk + sc]); sr_[i].ks1 = *reinterpret_cast<const bf16x8*>(&Kh[(long)((k0) + 32 + sr) * ldk + sc]); } while (0)
#define SWRITE(b, i) do { *(bf16x8*)(V_lds + (b) * SHM_V + vst0) = sr_[i].vs0;          \
    *(bf16x8*)(V_lds + (b) * SHM_V + vst1) = sr_[i].vs1; const int kc = sc * 2;               \
    *(bf16x8*)(K_lds + (b) * SHM_K + KSWZ(sr, kc)) = sr_[i].ks0;                       \
    *(bf16x8*)(K_lds + (b) * SHM_K + KSWZ(32 + sr, kc)) = sr_[i].ks1; } while (0)
#define SWAIT() asm volatile("s_waitcnt vmcnt(4)" ::: "memory")
#define RESC(a) do { if (__any((a) < 1.f)) { if (hi == 0) al_l[r32] = (a); asm volatile("s_waitcnt lgkmcnt(0)" ::: "memory"); \
    _Pragma("unroll") for (int d = 0; d < 4; ++d) _Pragma("unroll") for (int r = 0; r < 16; ++r) o[d][r] *= al_l[crow(r, hi)]; } } while (0)
  f32x16 pA0, pA1, pB0, pB1; float mnA, mnB, alA, alB; bf16x8 pa0, pa1, pa2, pa3;
  constexpr int SE = 0, SO = 1;
  SLOAD(SE, 0); asm volatile("s_waitcnt vmcnt(0)" ::: "memory"); SWRITE(0, SE); __syncthreads();
  qkt(pA0, pA1, K_lds, qr, r32, hi); post_scores<MODE>(pA0, pA1, 0, qrow0, r32, hi, tab, cfar); partialSM(pA0, pA1, m_reg, mnA, alA);
  SLOAD(SO, KVBLK); if (2 < NT) SLOAD(SE, 2 * KVBLK);
  SWAIT(); SWRITE(1, SO); __syncthreads();
  for (int j = 1; j + 1 < NT; j += 2) {
    SBAR(); qkt(pB0, pB1, K_lds + SHM_K, qr, r32, hi); post_scores<MODE>(pB0, pB1, j, qrow0, r32, hi, tab, cfar);
    finishSM(pA0, pA1, alA, l_reg, pa0, pa1, pa2, pa3); SBAR();
    SLOAD(SO, (j + 2) * KVBLK); SBAR();
    pv_d0(o, vb0, pa0, pa1, pa2, pa3); partialSM(pB0, pB1, m_reg, mnB, alB);
    __syncthreads(); SWAIT(); SWRITE(0, SE);
    RESC(alB); __syncthreads();
    SBAR(); qkt(pA0, pA1, K_lds, qr, r32, hi); post_scores<MODE>(pA0, pA1, j + 1, qrow0, r32, hi, tab, cfar);
    finishSM(pB0, pB1, alB, l_reg, pa0, pa1, pa2, pa3); SBAR();
    if (j + 3 < NT) SLOAD(SE, (j + 3) * KVBLK); SBAR();
    pv_d0(o, vb0 + (int)SHM_V, pa0, pa1, pa2, pa3); partialSM(pA0, pA1, m_reg, mnA, alA);
    __syncthreads(); SWAIT(); SWRITE(1, SO);
    RESC(alA); __syncthreads();
  }
  SBAR(); qkt(pB0, pB1, K_lds + SHM_K, qr, r32, hi); post_scores<MODE>(pB0, pB1, NT - 1, qrow0, r32, hi, tab, cfar);
  finishSM(pA0, pA1, alA, l_reg, pa0, pa1, pa2, pa3); SBAR();
  pv_d0(o, vb0, pa0, pa1, pa2, pa3); partialSM(pB0, pB1, m_reg, mnB, alB);
  __syncthreads(); RESC(alB);
  finishSM(pB0, pB1, alB, l_reg, pa0, pa1, pa2, pa3); SBAR();
  pv_d0(o, vb0 + (int)SHM_V, pa0, pa1, pa2, pa3);
  if (hi == 0) li_l[r32] = l_reg; asm volatile("s_waitcnt lgkmcnt(0)" ::: "memory");
  float rli[16];
#pragma unroll
  for (int r = 0; r < 16; ++r) rli[r] = __builtin_amdgcn_rcpf(li_l[crow(r, hi)]);
  if constexpr (MODE == 0) {
    bf16* Ow = Ob + (long)(wid * QBLK) * ldo;
#pragma unroll
    for (int r = 0; r < 16; ++r) { const int orow = crow(r, hi);
#pragma unroll
      for (int d0 = 0; d0 < 4; ++d0) Ow[(long)orow * ldo + d0 * 32 + r32] = (bf16)f2bf(o[d0][r] * rli[r]); }
  } else {
    float* Ow = Of + (long)(wid * QBLK) * ldo;
#pragma unroll
    for (int r = 0; r < 16; ++r) { const int orow = crow(r, hi);
#pragma unroll
      for (int d0 = 0; d0 < 4; ++d0) Ow[(long)orow * ldo + d0 * 32 + r32] = o[d0][r] * rli[r]; }
  }
  __syncthreads();
#undef SLOAD
#undef SWRITE
#undef SWAIT
#undef RESC
}
}

#define XB_TMO      128
#define XB_XCNT(j)  (256  + 64 * (j))
#define XB_XSUB(j)  (1280 + 64 * (j))
#define XB_XGEN(j)  (2304 + 64 * (j))
#define XB_TOP      3328
#define XB_TOPGEN   3392
#define XCD_BAR_WORDS 3456
#define XB_SPIN_CAP (1u << 18)

__device__ __forceinline__ unsigned xb_ld(unsigned* p)              { return __hip_atomic_load(p, __ATOMIC_RELAXED, __HIP_MEMORY_SCOPE_AGENT); }
__device__ __forceinline__ unsigned xb_add(unsigned* p, unsigned v) { return __hip_atomic_fetch_add(p, v, __ATOMIC_RELAXED, __HIP_MEMORY_SCOPE_AGENT); }
__device__ __forceinline__ unsigned xb_xcc_id() { return (unsigned)__builtin_amdgcn_s_getreg((3 << 11) | 20) & 0xFu; }
#define XB_SPIN(cond, bar) do { unsigned _sp = 0; while (cond) { __builtin_amdgcn_s_sleep(1); \
    if ((++_sp & 255u) == 0u) { if (xb_ld(&(bar)[XB_TMO])) break; if (_sp > XB_SPIN_CAP) { atomicAdd(&(bar)[XB_TMO], 1u); break; } } } } while (0)

struct XcdBarrier {
    unsigned* bar; unsigned x;
    volatile LAS unsigned* st;
};

__device__ __forceinline__ XcdBarrier xcd_barrier_post(unsigned* bar, volatile LAS unsigned* st) {
    XcdBarrier b; b.bar = bar; b.x = xb_xcc_id(); b.st = st;
    if (threadIdx.x == 0) (void)xb_add(&bar[XB_XCNT(b.x)], 1u);
    return b;
}
__device__ __forceinline__ void xcd_barrier_complete(unsigned* bar, unsigned x, unsigned& nloc, unsigned& nx) {
    const unsigned G = gridDim.x * gridDim.y * gridDim.z;
    unsigned sum, cnt, mine, sp = 0u;
    for (;;) {
        sum = 0u; cnt = 0u; mine = 0u;
#pragma unroll
        for (unsigned j = 0; j < 16; ++j) { const unsigned c = xb_ld(&bar[XB_XCNT(j)]); sum += c; cnt += (c > 0u) ? 1u : 0u; mine = (j == x) ? c : mine; }
        if (sum == G) break;
        __builtin_amdgcn_s_sleep(1);
        if ((++sp & 255u) == 0u) { if (xb_ld(&bar[XB_TMO])) break; if (sp > XB_SPIN_CAP) { atomicAdd(&bar[XB_TMO], 1u); break; } }
    }
    nloc = mine > 0u ? mine : 1u; nx = cnt > 0u ? cnt : 1u;
}

__device__ __forceinline__ void xcd_barrier(const XcdBarrier& b) {
    asm volatile("s_waitcnt vmcnt(0)" ::: "memory");
    __syncthreads();
    if (threadIdx.x == 0) {
        unsigned* bar = b.bar;
        __builtin_amdgcn_s_waitcnt(0);
        unsigned nloc = b.st[0], nx = b.st[1];
        if (nloc == 0u) { xcd_barrier_complete(bar, b.x, nloc, nx); b.st[0] = nloc; b.st[1] = nx; }
        const unsigned old = xb_add(&bar[XB_XSUB(b.x)], 1u);
        const unsigned gen = old / nloc;
        if (old + 1u == (gen + 1u) * nloc) {
            __builtin_amdgcn_fence(__ATOMIC_RELEASE, "agent");
            asm volatile("s_waitcnt vmcnt(0)" ::: "memory");
            const unsigned og = xb_add(&bar[XB_TOP], 1u);
            const unsigned tg = og / nx;
            if (og + 1u == (tg + 1u) * nx) xb_add(&bar[XB_TOPGEN], 1u);
            else XB_SPIN(xb_ld(&bar[XB_TOPGEN]) == tg, bar);
            __builtin_amdgcn_fence(__ATOMIC_ACQUIRE, "agent");
            xb_add(&bar[XB_XGEN(b.x)], 1u);
            asm volatile("s_waitcnt vmcnt(0)" ::: "memory");
        } else {
            XB_SPIN(xb_ld(&bar[XB_XGEN(b.x)]) == gen, bar);
            __builtin_amdgcn_fence(__ATOMIC_ACQUIRE, "agent");
            asm volatile("s_waitcnt vmcnt(0)" ::: "memory");
        }
    }
    __syncthreads();
}


struct Args { const float* in[24]; float* out; unsigned char* ws; int ph_lo, ph_hi; };
enum { I_X = 0, I_MEM, I_AWIN, I_ALNG, I_ALNB, I_AWS, I_ABS, I_AWOUT, I_BWIN, I_BLAM, I_BSUBG, I_BWOUT, I_WKV, I_RELB, I_MEMWKV, I_LNG, I_LNB,
       I_WG1, I_BG1, I_WG2, I_BG2, I_W1, I_W3, I_W2 };
constexpr int NPH_LAYER = 9, NPHASES = 1 + DEPTH * NPH_LAYER;

struct Frame {
    LAS unsigned char* lds; char* ldsg;
    gu32* ctl; unsigned char* ws;
    int tid, lane, wave, G, c;
};

__device__ __forceinline__ void transpose_item(const float* W, int K, int N, bf16* WT, int drow0, LAS float* scr, int k0, int n0, int lane) {
#pragma unroll 8
    for (int i = 0; i < 32; ++i) { const int kk = 2 * i + (lane >> 5); scr[kk * 33 + (lane & 31)] = W[(size_t)(k0 + kk) * N + n0 + (lane & 31)]; }
    LDS_WAIT(); asm volatile("" ::: "memory");
    const int c = lane & 7;
#pragma unroll
    for (int j = 0; j < 4; ++j) { const int n = (lane >> 3) + 8 * j; const LAS float* s = scr + (8 * c) * 33 + n;
        v4u o; o.x = pk2(s[0 * 33], s[1 * 33]); o.y = pk2(s[2 * 33], s[3 * 33]); o.z = pk2(s[4 * 33], s[5 * 33]); o.w = pk2(s[6 * 33], s[7 * 33]);
        *(GAS v4u*)(WT + (size_t)(drow0 + n) * K + k0 + 8 * c) = o; }
    LDS_WAIT(); asm volatile("" ::: "memory");
}
__device__ __forceinline__ void transpose_item_fast(const float* W, int K, int N, bf16* WT, int drow0, LAS float* scr, int k0, int n0, int lane) {
    float t[32];
#pragma unroll
    for (int i = 0; i < 32; ++i) t[i] = W[(size_t)(k0 + 2 * i + (lane >> 5)) * N + n0 + (lane & 31)];
#pragma unroll
    for (int i = 0; i < 32; i += 8) asm volatile("" : "+v"(t[i]), "+v"(t[i + 1]), "+v"(t[i + 2]), "+v"(t[i + 3]), "+v"(t[i + 4]), "+v"(t[i + 5]), "+v"(t[i + 6]), "+v"(t[i + 7]));
#pragma unroll
    for (int i = 0; i < 32; ++i) scr[(2 * i + (lane >> 5)) * 33 + (lane & 31)] = t[i];
    LDS_WAIT(); asm volatile("" ::: "memory");
    const int c = lane & 7;
#pragma unroll
    for (int j = 0; j < 4; ++j) { const int n = (lane >> 3) + 8 * j; const LAS float* s = scr + (8 * c) * 33 + n;
        v4u o; o.x = pk2(s[0 * 33], s[1 * 33]); o.y = pk2(s[2 * 33], s[3 * 33]); o.z = pk2(s[4 * 33], s[5 * 33]); o.w = pk2(s[6 * 33], s[7 * 33]);
        *(GAS v4u*)(WT + (size_t)(drow0 + n) * K + k0 + 8 * c) = o; }
    LDS_WAIT(); asm volatile("" ::: "memory");
}
__device__ __forceinline__ void transpose_item_fp8(const float* W, int K, int N, unsigned char* WT, int drow0, LAS float* scr, int k0, int n0, int lane) {
    float t[32];
#pragma unroll
    for (int i = 0; i < 32; ++i) t[i] = W[(size_t)(k0 + 2 * i + (lane >> 5)) * N + n0 + (lane & 31)];
#pragma unroll
    for (int i = 0; i < 32; i += 8) asm volatile("" : "+v"(t[i]), "+v"(t[i + 1]), "+v"(t[i + 2]), "+v"(t[i + 3]), "+v"(t[i + 4]), "+v"(t[i + 5]), "+v"(t[i + 6]), "+v"(t[i + 7]));
#pragma unroll
    for (int i = 0; i < 32; ++i) scr[(2 * i + (lane >> 5)) * 33 + (lane & 31)] = t[i];
    LDS_WAIT(); asm volatile("" ::: "memory");
    const int c = lane & 7;
#pragma unroll
    for (int j = 0; j < 4; ++j) { const int n = (lane >> 3) + 8 * j; const LAS float* s = scr + (8 * c) * 33 + n;
        unsigned lo = 0u, hi = 0u;
        lo = __builtin_amdgcn_cvt_pk_fp8_f32(s[0 * 33] * 64.f, s[1 * 33] * 64.f, lo, false); lo = __builtin_amdgcn_cvt_pk_fp8_f32(s[2 * 33] * 64.f, s[3 * 33] * 64.f, lo, true);
        hi = __builtin_amdgcn_cvt_pk_fp8_f32(s[4 * 33] * 64.f, s[5 * 33] * 64.f, hi, false); hi = __builtin_amdgcn_cvt_pk_fp8_f32(s[6 * 33] * 64.f, s[7 * 33] * 64.f, hi, true);
        v2u o; o.x = lo; o.y = hi; *(GAS v2u*)(WT + (size_t)(drow0 + n) * K + k0 + 8 * c) = o; }
    LDS_WAIT(); asm volatile("" ::: "memory");
}
#ifndef CDRAIN
#define CDRAIN 8
#endif
#ifndef CSRV
#define CSRV 4
#endif
#ifndef CSRVA
#define CSRVA 32
#endif
#ifndef STOPU
#define STOPU 64
#endif
#ifndef QX
#define QX 6
#endif
#ifndef QA
#define QA 14
#endif
#ifndef QM
#define QM 7
#endif
#ifndef QB
#define QB 4
#endif
constexpr int NQ = 7, MOE_ITEMS = 3 * 32 * 512;
__device__ __forceinline__ int conv_qsize(int q) { return (q & 1) ? (q == 1 ? 5632 : (q == 3 ? 7168 : 4096)) : MOE_ITEMS; }
__device__ __forceinline__ void conv_item(Frame& F, const Args& a, int q, int it) {
    LAS float* scr = (LAS float*)(F.lds + RING_OFF + F.wave * 16384);
    if (q & 1) {
        const float* src; bf16* dst; int N, r = it;
        if (q == 1) { if (r < 3584) { N = 3584; src = a.in[I_AWIN] + (size_t)2048 * 3584; dst = (bf16*)(F.ws + WS_WAIN) + (size_t)2048 * 3584; } else { r -= 3584; N = 2048; src = a.in[I_AWOUT] + (size_t)2048 * 2048; dst = (bf16*)(F.ws + WS_WAOUT) + (size_t)2048 * 2048; } }
        else if (q == 3) { if (r < 2048) { N = 2048; src = a.in[I_BWIN]; dst = (bf16*)(F.ws + WS_WBIN0); } else if ((r -= 2048) < 3072) { N = 3072; src = a.in[I_WKV]; dst = (bf16*)(F.ws + WS_WKV); } else { r -= 3072; N = 2048; src = a.in[I_BWOUT]; dst = (bf16*)(F.ws + WS_WBOUT); } }
        else { if (r < 2048) { N = 2048; src = a.in[I_BWIN] + (size_t)2048 * 2048; dst = (bf16*)(F.ws + WS_WBIN1); } else { r -= 2048; N = 2048; src = a.in[I_BWOUT] + (size_t)2048 * 2048; dst = (bf16*)(F.ws + WS_WBOUT) + (size_t)2048 * 2048; } }
        const int nblk = N / 32, kb = r / nblk, nb = r - kb * nblk;
        transpose_item_fast(src, 2048, N, dst, 32 * nb, scr, 64 * kb, 32 * nb, F.lane);
        return;
    }
    const int L = q >> 1, seg = it >> 14, r0 = it & 16383, e = r0 >> 9, r = r0 & 511, mat = L * 32 + e;
    if (seg < 2) { const int kb = r >> 4, nb = r & 15, n0 = 32 * nb;
        transpose_item_fp8(a.in[seg == 0 ? I_W1 : I_W3] + (size_t)mat * 2048 * 512, 2048, 512, (unsigned char*)(F.ws + WS_W13) + (size_t)mat * 1024 * 2048, (n0 >> 7) * 256 + (n0 & 127) + (seg == 1 ? 128 : 0), scr, 64 * kb, n0, F.lane); }
    else { const int kb = r >> 6, nb = r & 63;
        transpose_item_fp8(a.in[I_W2] + (size_t)mat * 512 * 2048, 512, 2048, (unsigned char*)(F.ws + WS_W2) + (size_t)mat * 512 * 2048, 32 * nb, scr, 64 * kb, 32 * nb, F.lane); }
}
#ifndef F8MASK
#define F8MASK 4
#endif
#define F8L(l) (((F8MASK) >> (l)) & 1)
#ifndef F8OMASK
#define F8OMASK 12
#endif
#define F8OL(l) (((F8OMASK) >> (l)) & 1)
#ifndef CDEPTH
#define CDEPTH 3
#endif
struct CDesc { const float* src; unsigned char* dst; int N, K, drow0, k0, n0, f8; };
__device__ __forceinline__ CDesc conv_desc(Frame& F, const Args& a, int q, int it) {
    CDesc d;
    if (q & 1) {
        const float* src; unsigned char* dst; int N, r = it, f8 = F8L((q + 1) >> 1);
        if (q == 1) { if (r < 3584) { N = 3584; src = a.in[I_AWIN] + (size_t)2048 * 3584; dst = F.ws + WS_WAIN + (size_t)2048 * 3584 * 2; } else { r -= 3584; N = 2048; f8 = 0; src = a.in[I_AWOUT] + (size_t)2048 * 2048; dst = F.ws + WS_WAOUT + (size_t)2048 * 2048 * 2; } }
        else if (q == 3) { if (r < 2048) { N = 2048; src = a.in[I_BWIN]; dst = F.ws + WS_WBIN0; } else if ((r -= 2048) < 3072) { N = 3072; src = a.in[I_WKV]; dst = F.ws + WS_WBIN0 + (size_t)2048 * 2048 * (F8L(2) ? 1 : 2); } else { r -= 3072; N = 2048; f8 = F8OL(2); src = a.in[I_BWOUT]; dst = F.ws + WS_WBOUT; } }
        else { if (r < 2048) { N = 2048; src = a.in[I_BWIN] + (size_t)2048 * 2048; dst = F.ws + WS_WBIN1; } else { r -= 2048; N = 2048; f8 = F8OL(3); src = a.in[I_BWOUT] + (size_t)2048 * 2048; dst = F.ws + WS_WBOUT + (size_t)2048 * 2048 * 2; } }
        const int nblk = N / 32, kb = r / nblk, nb = r - kb * nblk;
        d.src = src; d.dst = dst; d.N = N; d.K = 2048; d.drow0 = 32 * nb; d.k0 = 64 * kb; d.n0 = 32 * nb; d.f8 = f8; return d;
    }
    const int L = q >> 1, seg = it >> 14, r0 = it & 16383, e = r0 >> 9, r = r0 & 511, mat = L * 32 + e;
    if (seg < 2) { const int kb = r >> 4, nb = r & 15, n0 = 32 * nb;
        d.src = a.in[seg == 0 ? I_W1 : I_W3] + (size_t)mat * 2048 * 512; d.dst = (unsigned char*)(F.ws + WS_W13) + (size_t)mat * 1024 * 2048; d.N = 512; d.K = 2048;
        d.drow0 = (n0 >> 7) * 256 + (n0 & 127) + (seg == 1 ? 128 : 0); d.k0 = 64 * kb; d.n0 = n0; d.f8 = 1; }
    else { const int kb = r >> 6, nb = r & 63;
        d.src = a.in[I_W2] + (size_t)mat * 512 * 2048; d.dst = (unsigned char*)(F.ws + WS_W2) + (size_t)mat * 512 * 2048; d.N = 2048; d.K = 512; d.drow0 = 32 * nb; d.k0 = 64 * kb; d.n0 = 32 * nb; d.f8 = 1; }
    return d;
}
#define CV_LOAD(t_, d_) do { const float* p_ = (d_).src + (size_t)((d_).k0 + (F.lane >> 3)) * (d_).N + (d_).n0 + 4 * (F.lane & 7); const size_t st_ = (size_t)8 * (d_).N; \
    _Pragma("unroll") for (int i_ = 0; i_ < 8; ++i_) (t_)[i_] = *(const GAS f32x4*)(p_ + st_ * i_); } while (0)
__device__ __forceinline__ void conv_process(Frame& F, f32x4 (&t)[8], const CDesc& d) {
    LAS float* scr = (LAS float*)(F.lds + RING_OFF + F.wave * 16384); const int lane = F.lane;
    asm volatile("" : "+v"(t[0]), "+v"(t[1]), "+v"(t[2]), "+v"(t[3]), "+v"(t[4]), "+v"(t[5]), "+v"(t[6]), "+v"(t[7]));
    { LAS float* w = scr + (lane >> 3) * 33 + 4 * (lane & 7);
#pragma unroll
      for (int i = 0; i < 8; ++i) { w[i * 8 * 33 + 0] = t[i].x; w[i * 8 * 33 + 1] = t[i].y; w[i * 8 * 33 + 2] = t[i].z; w[i * 8 * 33 + 3] = t[i].w; } }
    LDS_WAIT(); asm volatile("" ::: "memory");
    const int c = lane & 7;
    if (d.f8) {
#pragma unroll
        for (int j = 0; j < 4; ++j) { const int n = (lane >> 3) + 8 * j; const LAS float* s = scr + (8 * c) * 33 + n;
            unsigned lo = 0u, hi = 0u;
            lo = __builtin_amdgcn_cvt_pk_fp8_f32(s[0 * 33] * 64.f, s[1 * 33] * 64.f, lo, false); lo = __builtin_amdgcn_cvt_pk_fp8_f32(s[2 * 33] * 64.f, s[3 * 33] * 64.f, lo, true);
            hi = __builtin_amdgcn_cvt_pk_fp8_f32(s[4 * 33] * 64.f, s[5 * 33] * 64.f, hi, false); hi = __builtin_amdgcn_cvt_pk_fp8_f32(s[6 * 33] * 64.f, s[7 * 33] * 64.f, hi, true);
            v2u o; o.x = lo; o.y = hi; *(GAS v2u*)(d.dst + (size_t)(d.drow0 + n) * d.K + d.k0 + 8 * c) = o; }
    } else {
#pragma unroll
        for (int j = 0; j < 4; ++j) { const int n = (lane >> 3) + 8 * j; const LAS float* s = scr + (8 * c) * 33 + n;
            v4u o; o.x = pk2(s[0 * 33], s[1 * 33]); o.y = pk2(s[2 * 33], s[3 * 33]); o.z = pk2(s[4 * 33], s[5 * 33]); o.w = pk2(s[6 * 33], s[7 * 33]);
            *(GAS v4u*)((bf16*)d.dst + (size_t)(d.drow0 + n) * d.K + d.k0 + 8 * c) = o; }
    }
    LDS_WAIT(); asm volatile("" ::: "memory");
}
__device__ __forceinline__ void conv_range(Frame& F, const Args& a, int q, int first, int cnt) {
#if CDEPTH == 1
    for (int i = 0; i < cnt; ++i) conv_item(F, a, q, first + i);
#else
    f32x4 t[CDEPTH][8]; const int last = first + cnt - 1;
#pragma unroll
    for (int s = 0; s < CDEPTH - 1; ++s) { const int it = first + s < last ? first + s : last; const CDesc d = conv_desc(F, a, q, it); CV_LOAD(t[s], d); }
#pragma unroll 1
    for (int i0 = 0; i0 < cnt; i0 += CDEPTH) {
#pragma unroll
        for (int s = 0; s < CDEPTH; ++s) {
            { const int nx = first + i0 + s + CDEPTH - 1, it = nx < last ? nx : last; const CDesc d = conv_desc(F, a, q, it); CV_LOAD(t[(s + CDEPTH - 1) % CDEPTH], d); }
            asm volatile("" ::: "memory");
            if (i0 + s < cnt) { const CDesc d = conv_desc(F, a, q, first + i0 + s); conv_process(F, t[s], d); }
        }
    }
#endif
}
__device__ __forceinline__ void conv_filler(Frame& F, const Args& a, int q0, int n) {
    if (q0 >= NQ || n == 0) return;
#ifdef CONV_ALL_PRO
    return;
#endif
    LAS unsigned* bw = (LAS unsigned*)(F.lds + TAB_OFF + 384);
    __syncthreads();
    const bool drain = n < 0; const int per = drain ? CDRAIN : n; int q = q0;
    for (;;) {
        if (F.tid == 0) bw[0] = __hip_atomic_fetch_add(F.ctl + CW_CONV + 64 * q, (unsigned)(8 * per), RLX_AGENT);
        __syncthreads();
        const unsigned idx = bw[0];
        __syncthreads();
        const int qs = conv_qsize(q);
        if (idx >= (unsigned)qs) { if (drain || ++q >= NQ) break; continue; }
        { const int first = (int)idx + F.wave * per, cnt = (qs - first < per) ? qs - first : per; if (cnt > 0) conv_range(F, a, q, first, cnt); }
        if (!drain) break;
    }
}

__device__ __forceinline__ void prologue_phase(Frame& F, const Args& a) {
#ifdef TOUCH
    {
        const long nthr_ = (long)F.G * 512, gt_ = (long)F.c * 512 + F.tid; unsigned acc_ = 0u;
        for (long pg = gt_; pg < (long)(WS_END / 4096); pg += nthr_) acc_ += *(const GAS unsigned*)(F.ws + pg * 4096);
        for (long pg = gt_; pg < (long)((size_t)DEPTH * NE * D * FF * 4 / 4096); pg += nthr_) { acc_ += *(const GAS unsigned*)((const char*)a.in[I_W1] + pg * 4096); acc_ += *(const GAS unsigned*)((const char*)a.in[I_W3] + pg * 4096); acc_ += *(const GAS unsigned*)((const char*)a.in[I_W2] + pg * 4096); }
        if (acc_ == 0x12345679u) F.ctl[CW_TMO] = acc_;
    }
#endif
    LAS float* scr = (LAS float*)(F.lds + RING_OFF + F.wave * 16384);
    const int gw = F.c * NWAVES + F.wave, NGW = F.G * NWAVES;
    unsigned char* ws = F.ws;
    constexpr int S0 = 3584, S1 = 2048, S5 = 4 * 1024;
    constexpr int NITEMS = S0 + S1 + S5;
    for (int it = gw; it < NITEMS; it += NGW) {
        int r = it; const float* src; unsigned char* dst; int K = 2048, N; bool f8 = F8L(0);
        if (r < S0) { N = 3584; src = a.in[I_AWIN]; dst = ws + WS_WAIN; }
        else if ((r -= S0) < S1) { N = 2048; f8 = false; src = a.in[I_AWOUT]; dst = ws + WS_WAOUT; }
        else { r -= S1; const int mat = r >> 10; r &= 1023; N = 1024; src = a.in[I_MEMWKV] + (size_t)mat * K * N; dst = ws + WS_WMKV + (size_t)mat * K * N * (F8L(0) ? 1 : 2); }
        const int nblk = N / 32, kb = r / nblk, nb = r - kb * nblk;
        if (f8) transpose_item_fp8(src, K, N, dst, 32 * nb, scr, 64 * kb, 32 * nb, F.lane);
        else transpose_item_fast(src, K, N, (bf16*)dst, 32 * nb, scr, 64 * kb, 32 * nb, F.lane);
    }
#ifdef CONV_ALL_PRO
    for (int q = 0; q < NQ; ++q) { const int qs = conv_qsize(q); for (int it = gw * 4; it < qs; it += NGW * 4) conv_range(F, a, q, it, qs - it < 4 ? qs - it : 4); }
#endif
    const long nthr = (long)F.G * 512, gt = (long)F.c * 512 + F.tid;
    { float* wr = (float*)(ws + WS_WR);
      for (long i = gt; i < (long)DEPTH * 3 * 512 * 16 * 4; i += nthr) { const int j = (int)(i & 3), c = (int)((i >> 2) & 15), kg = (int)((i >> 6) & 511), r = (int)(i >> 15), nb = r % 3, l = r / 3;
          const int k = 4 * kg + j, o = 16 * nb + c; float v = 0.f;
          if (o < 4) v = a.in[I_WG1][((size_t)l * D + k) * 4 + o]; else if (o < 36) { const int g = (o - 4) >> 3, e = (o - 4) & 7; v = a.in[I_WG2][(((size_t)l * 4 + g) * D + k) * 8 + e]; }
          wr[i] = v; } }
    { const float* x = a.in[I_X]; bf16* xb = (bf16*)(ws + WS_XB);
      for (long i = gt; i < (long)T * D / 8; i += nthr) { const f32x4 v0 = *(const GAS f32x4*)(x + i * 8), v1 = *(const GAS f32x4*)(x + i * 8 + 4);
          v4u o; o.x = pk2(v0.x, v0.y); o.y = pk2(v0.z, v0.w); o.z = pk2(v1.x, v1.y); o.w = pk2(v1.z, v1.w); *(GAS v4u*)(xb + i * 8) = o;
          unsigned lo = 0u, hi = 0u; lo = __builtin_amdgcn_cvt_pk_fp8_f32(v0.x, v0.y, lo, false); lo = __builtin_amdgcn_cvt_pk_fp8_f32(v0.z, v0.w, lo, true); hi = __builtin_amdgcn_cvt_pk_fp8_f32(v1.x, v1.y, hi, false); hi = __builtin_amdgcn_cvt_pk_fp8_f32(v1.z, v1.w, hi, true);
          v2u qq; qq.x = lo; qq.y = hi; if (F8L(0)) *(GAS v2u*)(ws + WS_XQ + i * 8) = qq; } }
    { const float* x = a.in[I_MEM]; bf16* xb = (bf16*)(ws + WS_MEMB);
      for (long i = gt; i < (long)MEMT * D / 8; i += nthr) { const f32x4 v0 = *(const GAS f32x4*)(x + i * 8), v1 = *(const GAS f32x4*)(x + i * 8 + 4);
          v4u o; o.x = pk2(v0.x, v0.y); o.y = pk2(v0.z, v0.w); o.z = pk2(v1.x, v1.y); o.w = pk2(v1.z, v1.w); *(GAS v4u*)(xb + i * 8) = o;
          unsigned lo = 0u, hi = 0u; lo = __builtin_amdgcn_cvt_pk_fp8_f32(v0.x, v0.y, lo, false); lo = __builtin_amdgcn_cvt_pk_fp8_f32(v0.z, v0.w, lo, true); hi = __builtin_amdgcn_cvt_pk_fp8_f32(v1.x, v1.y, hi, false); hi = __builtin_amdgcn_cvt_pk_fp8_f32(v1.z, v1.w, hi, true);
          v2u qq; qq.x = lo; qq.y = hi; *(GAS v2u*)(ws + WS_MEMQ + i * 8) = qq; } }
}

#ifndef NCVMAX
#define NCVMAX 0
#endif
#ifndef NCVATT
#define NCVATT 96
#endif
__device__ __forceinline__ int conv_servers(int nu, int G, int fin) {
    if (fin || nu <= 0) return 0;
    const int rounds = (nu + G - 1) / G, gmin = (nu + rounds - 1) / rounds; int n = G - gmin; n = n < NCVMAX ? n : NCVMAX; return n & ~7;
}
__device__ __forceinline__ void conv_done(Frame& F, int p) { __syncthreads(); if (F.tid == 0) __hip_atomic_fetch_add(F.ctl + CW_DONE + 64 * p, 1u, RLX_AGENT); }
__device__ __forceinline__ void conv_server(Frame& F, const Args& a, int p, int q0, int ncomp) {
    int q = q0;
    for (;;) {
        if (q >= NQ) break;
        unsigned idx = 0xffffffffu;
        if (F.lane == 0) { if (__hip_atomic_load(F.ctl + CW_DONE + 64 * p, RLX_AGENT) < (unsigned)ncomp) idx = __hip_atomic_fetch_add(F.ctl + CW_CONV + 64 * q, (unsigned)CSRV, RLX_AGENT); }
        idx = (unsigned)__builtin_amdgcn_readfirstlane((int)idx);
        if (idx == 0xffffffffu) break;
        const int qs = conv_qsize(q);
        if (idx >= (unsigned)qs) { ++q; continue; }
        conv_range(F, a, q, (int)idx, (qs - (int)idx < CSRV) ? qs - (int)idx : CSRV);
    }
}
__device__ __forceinline__ void conv_server_q(Frame& F, const Args& a, gu32* head, unsigned stop_at, int q0) {
    int q = q0;
    for (;;) {
        if (q >= NQ) break;
        unsigned idx = 0xffffffffu;
        if (F.lane == 0) { if (__hip_atomic_load(head, RLX_AGENT) < stop_at) idx = __hip_atomic_fetch_add(F.ctl + CW_CONV + 64 * q, (unsigned)CSRVA, RLX_AGENT); }
        idx = (unsigned)__builtin_amdgcn_readfirstlane((int)idx);
        if (idx == 0xffffffffu) break;
        const int qs = conv_qsize(q);
        if (idx >= (unsigned)qs) { ++q; continue; }
        conv_range(F, a, q, (int)idx, (qs - (int)idx < CSRVA) ? qs - (int)idx : CSRVA);
    }
}
__device__ __forceinline__ void conv_note_fin(Frame& F, int p) {
    if (blockIdx.x == 0 && F.tid == 0) { unsigned all = 1u;
        for (int q = 0; q < NQ; ++q) all &= (__hip_atomic_load(F.ctl + CW_CONV + 64 * q, RLX_AGENT) >= (unsigned)conv_qsize(q)) ? 1u : 0u;
        __hip_atomic_store(F.ctl + CW_FIN + 64 * p, all, RLX_AGENT); }
}

__device__ __forceinline__ void sgu_unit(Frame& F, const Args& a, int l, int n, int g) {
    constexpr int LDW = 136;
    LAS float* stats = (LAS float*)(F.lds); LAS bf16* Wl = (LAS bf16*)(F.lds + 1024); LAS bf16* Vt = (LAS bf16*)(F.lds + 35840);
    const bf16* z = (const bf16*)(F.ws + WS_Z); bf16* cat = (bf16*)(F.ws + WS_CAT);
    const int tok0 = n * 128;
    for (int i = 0; i < 16; ++i) { const int tk = F.wave * 16 + i; const GAS v4u* rp = (const GAS v4u*)(z + (size_t)(tok0 + tk) * NINA + MIXW) + F.lane;
        v4u w[3]; float s = 0.f;
#pragma unroll
        for (int j = 0; j < 3; ++j) { w[j] = rp[64 * j]; s += (bflo(w[j].x) + bfhi(w[j].x)) + (bflo(w[j].y) + bfhi(w[j].y)) + (bflo(w[j].z) + bfhi(w[j].z)) + (bflo(w[j].w) + bfhi(w[j].w)); }
        const float mean = wave_sum(s) * (1.f / MIXW); float q = 0.f;
#pragma unroll
        for (int j = 0; j < 3; ++j) { float d;
            d = bflo(w[j].x) - mean; q += d * d; d = bfhi(w[j].x) - mean; q += d * d; d = bflo(w[j].y) - mean; q += d * d; d = bfhi(w[j].y) - mean; q += d * d;
            d = bflo(w[j].z) - mean; q += d * d; d = bfhi(w[j].z) - mean; q += d * d; d = bflo(w[j].w) - mean; q += d * d; d = bfhi(w[j].w) - mean; q += d * d; }
        const float rstd = 1.f / sqrtf(wave_sum(q) * (1.f / MIXW) + LN_EPS);
        if (F.lane == 0) { stats[2 * tk] = mean; stats[2 * tk + 1] = rstd; } }
    { const float* wsrc = a.in[I_AWS] + ((size_t)l * 4 + g) * 128 * 128;
      for (int p = F.tid; p < 128 * 32; p += 512) { const int i = p >> 5, j4 = (p & 31) * 4; f32x4 v = *(const GAS f32x4*)(wsrc + i * 128 + j4);
          if ((j4 >> 6) > (i >> 6)) v = (f32x4){0.f, 0.f, 0.f, 0.f};
          v2u o; o.x = pk2(v.x, v.y); o.y = pk2(v.z, v.w); *(LAS v2u*)(Wl + i * LDW + j4) = o; } }
    __syncthreads();
    { const float* lg = a.in[I_ALNG] + (size_t)l * MIXW + g * 384; const float* lb = a.in[I_ALNB] + (size_t)l * MIXW + g * 384;
      for (int p = F.tid; p < 128 * 48; p += 512) { const int j = p & 127, c8 = (p >> 7) * 8;
          const v4u w = *(const GAS v4u*)(z + (size_t)(tok0 + j) * NINA + MIXW + g * 384 + c8);
          const float mean = stats[2 * j], rstd = stats[2 * j + 1];
          const f32x4 g0 = *(const GAS f32x4*)(lg + c8), g1 = *(const GAS f32x4*)(lg + c8 + 4), b0 = *(const GAS f32x4*)(lb + c8), b1 = *(const GAS f32x4*)(lb + c8 + 4);
          float v[8] = {bflo(w.x), bfhi(w.x), bflo(w.y), bfhi(w.y), bflo(w.z), bfhi(w.z), bflo(w.w), bfhi(w.w)};
          const float gg[8] = {g0.x, g0.y, g0.z, g0.w, g1.x, g1.y, g1.z, g1.w}, bb[8] = {b0.x, b0.y, b0.z, b0.w, b1.x, b1.y, b1.z, b1.w};
#pragma unroll
          for (int e = 0; e < 8; ++e) Vt[(c8 + e) * LDW + j] = (bf16)f2bf((v[e] - mean) * rstd * gg[e] + bb[e]); } }
    __syncthreads();
    const int fr = F.lane & 15, fq = F.lane >> 4;
    f32x4 acc[8][3];
#pragma unroll
    for (int mb = 0; mb < 8; ++mb)
#pragma unroll
        for (int nb = 0; nb < 3; ++nb) acc[mb][nb] = (f32x4){0.f, 0.f, 0.f, 0.f};
#pragma unroll
    for (int ks = 0; ks < 4; ++ks) { bf16x8 bfr[3];
#pragma unroll
        for (int nb = 0; nb < 3; ++nb) bfr[nb] = *(const LAS bf16x8*)(Vt + (F.wave * 48 + nb * 16 + fr) * LDW + ks * 32 + fq * 8);
#pragma unroll
        for (int mb = 0; mb < 8; ++mb) { const bf16x8 afr = *(const LAS bf16x8*)(Wl + (mb * 16 + fr) * LDW + ks * 32 + fq * 8);
#pragma unroll
            for (int nb = 0; nb < 3; ++nb) acc[mb][nb] = __builtin_amdgcn_mfma_f32_16x16x32_bf16(bfr[nb], afr, acc[mb][nb], 0, 0, 0); } }
    const float* bs = a.in[I_ABS] + ((size_t)l * 4 + g) * 128;
#pragma unroll
    for (int mb = 0; mb < 8; ++mb) { const int i = mb * 16 + fr; const float bsv = bs[i]; const size_t tk = (size_t)(tok0 + i);
#pragma unroll
        for (int nb = 0; nb < 3; ++nb) { const int c = g * 384 + F.wave * 48 + nb * 16 + 4 * fq;
            const v2u uw = *(const GAS v2u*)(z + tk * NINA + c); const f32x4 gt = acc[mb][nb] + bsv;
            v2u o; o.x = pk2(bflo(uw.x) * gt.x, bfhi(uw.x) * gt.y); o.y = pk2(bflo(uw.y) * gt.z, bfhi(uw.y) * gt.w);
            *(GAS v2u*)(cat + tk * D + c) = o; } }
    __syncthreads();
}

__device__ __forceinline__ void memattn_unit(Frame& F, int l, int hm, int qb, int ldz, int qoff) {
    const bf16* z = (const bf16*)(F.ws + WS_Z); const bf16* kv = (const bf16*)(F.ws + WS_MEMKV) + (size_t)l * 256 * 1024; bf16* cat = (bf16*)(F.ws + WS_CAT);
    att::attn_body<0>(z + (size_t)qb * 256 * ldz + qoff + hm * 128, ldz, kv + hm * 128, kv + 512 + hm * 128, 1024,
                      cat + (size_t)qb * 256 * D + MIXW + hm * 128, nullptr, D, 4, 0, nullptr, 0.f, F.ldsg);
}

__device__ __forceinline__ int t5_bucket(int rel) {
    const int a = rel < 0 ? -rel : rel; int f;
    if (a < 8) f = a; else if (a < 12) f = 8; else if (a < 16) f = 9; else if (a < 23) f = 10; else if (a < 32) f = 11; else if (a < 46) f = 12; else if (a < 64) f = 13; else if (a < 91) f = 14; else f = 15;
    return (rel > 0 ? 16 : 0) + f;
}

namespace att2 {
using att::bf16x8; using att::s16x4; using att::f32x16; using att::u32x4; using att::crow; using att::cvtpk; using att::tr_read; using att::v_rd_base;
constexpr int KT = 32, ST_K = KT * 128 * 2, ST_V = KT * 256 * 2, STAGE = 2 * ST_K + ST_V, NST = 3;
constexpr int LDS_WS = NST * STAGE, LDS_TAB = LDS_WS + 2048, LDS_UNIT = LDS_TAB + 640, LDS_END = LDS_UNIT + 16;
constexpr int NUNITS = 576;
constexpr float THR2 = 8.f * 1.4426950408889634f;
__device__ __forceinline__ int swap23(int k) { return (k & ~0xC) | ((k & 4) << 1) | ((k & 8) >> 1); }
constexpr int v_off(int d0, int ks, int half) { return d0 * 512 + ks * 8192 + half * 4096; }

struct UnitTable { unsigned short u[NUNITS]; };
constexpr UnitTable make_units() {
    UnitTable t{}; int n = 0;
    for (int c = 256; c >= 4; c -= 2) {
        { const int b = (c - 2) / 2; if ((c - 2) % 2 == 0 && b >= 32 && b <= 63) for (int part = 1; part <= 2; ++part) for (int h = 0; h < 6; ++h) t.u[n++] = (unsigned short)(h | (b << 3) | (part << 9)); }
        if (c % 4 == 0) { const int b = c / 4 - 1; if (b >= 0 && b < 32) for (int h = 0; h < 6; ++h) t.u[n++] = (unsigned short)(h | (b << 3)); }
    }
    return t;
}
__device__ const UnitTable g_units = make_units();

__device__ __forceinline__ void diff_unit(const bf16* __restrict__ Q, const bf16* __restrict__ KD, const bf16* __restrict__ VD, float* Obuf  , int orow0,
                                          float* ML  , const float* relb, int h, int b, int t_lo, int t_hi, LAS char* lds) {
  int tid_ = threadIdx.x; asm volatile("" : "+v"(tid_));
  const int tid = tid_, wid = __builtin_amdgcn_readfirstlane(tid >> 6), lane = tid & 63, r32 = lane & 31, hi = lane >> 5, m = wid >> 2, rg = wid & 3;
  LAS float* wsw = (LAS float*)(lds + LDS_WS) + wid * 64; LAS float* li_l = wsw; LAS float* al_l = wsw + 32;
  LAS float* tab = (LAS float*)(lds + LDS_TAB);
  if (tid < att::TAB_N) tab[tid] = relb[t5_bucket(63 - tid) * 6 + h] * LOG2E;
  const float cfar = relb[15 * 6 + h] * LOG2E;
  const int qrow0 = b * 128 + rg * 32;
  bf16x8 qr[8];
  { const bf16* Qw = Q + (size_t)(qrow0 + r32) * 2048 + h * 256 + m * 128 + hi * 8;
#pragma unroll
    for (int d0 = 0; d0 < 8; ++d0) qr[d0] = *reinterpret_cast<const bf16x8*>(Qw + d0 * 16); }
  int ko[2], vo[2];
#pragma unroll
  for (int i = 0; i < 2; ++i) {
    const int p = wid * 64 + lane, row = p >> 4, cp = (p & 15) ^ (row & 7); ko[i] = row * 1536 + h * 256 + i * 128 + cp * 8; }
#pragma unroll
  for (int i = 0; i < 2; ++i) {
    const int p = (wid * 2 + i) * 64 + lane, sub = p >> 5, kg = sub >> 3, cblk = sub & 7, q = p & 31, kk = kg * 8 + (q >> 2), key = swap23(kk);
    vo[i] = key * 1536 + h * 256 + cblk * 32 + (q & 3) * 8; }
  const unsigned ldsb = (unsigned)(uintptr_t)lds;
#define A2_ISSUE(t, s) do { const size_t kb_ = (size_t)(t) * KT * 1536; LAS char* sb_ = lds + (s) * STAGE; \
    __builtin_amdgcn_global_load_lds((const unsigned*)(KD + kb_ + ko[0]), (LAS unsigned*)(sb_ + wid * 1024), 16, 0, 0); \
    __builtin_amdgcn_global_load_lds((const unsigned*)(KD + kb_ + ko[1]), (LAS unsigned*)(sb_ + ST_K + wid * 1024), 16, 0, 0); \
    __builtin_amdgcn_global_load_lds((const unsigned*)(VD + kb_ + vo[0]), (LAS unsigned*)(sb_ + 2 * ST_K + (wid * 2) * 1024), 16, 0, 0); \
    __builtin_amdgcn_global_load_lds((const unsigned*)(VD + kb_ + vo[1]), (LAS unsigned*)(sb_ + 2 * ST_K + (wid * 2 + 1) * 1024), 16, 0, 0); } while (0)
  const int vis = 2 * (2 * b + (rg >> 1) + 1);
  float m_reg = -1e30f, l_reg = 0.f; f32x16 o[8];
#pragma unroll
  for (int d = 0; d < 8; ++d) o[d] = f32x16{};
  asm volatile("s_waitcnt vmcnt(0)" ::: "memory");
  A2_ISSUE(t_lo, 0); if (t_lo + 1 < t_hi) A2_ISSUE(t_lo + 1, 1);
  int s = 0;
  for (int t = t_lo; t < t_hi; ++t) {
    if (t + 1 < t_hi) asm volatile("s_waitcnt vmcnt(4) lgkmcnt(0)" ::: "memory"); else asm volatile("s_waitcnt vmcnt(0) lgkmcnt(0)" ::: "memory");
    __builtin_amdgcn_s_barrier(); asm volatile("" ::: "memory");
    if (t + 2 < t_hi) { const int s2 = (s >= 1) ? s - 1 : s + 2; A2_ISSUE(t + 2, s2); }
    if (t < vis) {
      const LAS char* Ks = lds + s * STAGE + m * ST_K;
      f32x16 p = f32x16{};
#pragma unroll
      for (int d0 = 0; d0 < 8; ++d0) { const int cb = (d0 * 16 + hi * 8) * 2;
        const bf16x8 b0 = *(const LAS bf16x8*)(Ks + KSWZ(r32, cb));
        p = __builtin_amdgcn_mfma_f32_32x32x16_bf16(b0, qr[d0], p, 0, 0, 0); }
      if (qrow0 - (KT * t + KT - 1) >= 91) {
#pragma unroll
        for (int r = 0; r < 16; ++r) p[r] += cfar;
      } else { const int base = qrow0 + r32 - KT * t + 63;
#pragma unroll
        for (int r = 0; r < 16; ++r) { const int i0 = base - crow(r, hi); p[r] += tab[i0 < att::TAB_N - 1 ? i0 : att::TAB_N - 1]; } }
      float pmax = p[0];
#pragma unroll
      for (int r = 1; r < 16; ++r) pmax = fmaxf(pmax, p[r]);
      { auto rr = __builtin_amdgcn_permlane32_swap(__float_as_uint(pmax), __float_as_uint(pmax), false, false); pmax = fmaxf(__uint_as_float(rr[0]), __uint_as_float(rr[1])); }
      float mn, alpha;
      if (__builtin_expect(__all(pmax - m_reg <= THR2), 1)) { mn = m_reg; alpha = 1.f; }
      else { mn = fmaxf(m_reg, pmax); alpha = __builtin_amdgcn_exp2f(m_reg - mn); m_reg = mn; }
      float ps = 0.f;
#pragma unroll
      for (int r = 0; r < 16; ++r) { p[r] = __builtin_amdgcn_exp2f(p[r] - mn); ps += p[r]; }
      { auto rr = __builtin_amdgcn_permlane32_swap(__float_as_uint(ps), __float_as_uint(ps), false, false); ps = __uint_as_float(rr[0]) + __uint_as_float(rr[1]); }
      l_reg = l_reg * alpha + ps;
      bf16x8 pa0, pa1;
#define A2_PK4(P, BASE, OUT) do { unsigned a0 = cvtpk(P[BASE + 0], P[BASE + 1]), a1 = cvtpk(P[BASE + 2], P[BASE + 3]);   \
    unsigned b0_ = cvtpk(P[BASE + 4], P[BASE + 5]), b1_ = cvtpk(P[BASE + 6], P[BASE + 7]);                              \
    auto r0 = __builtin_amdgcn_permlane32_swap(a0, b0_, false, false); auto r1 = __builtin_amdgcn_permlane32_swap(a1, b1_, false, false); \
    u32x4 w = {r0[0], r1[0], r0[1], r1[1]}; OUT = *reinterpret_cast<bf16x8*>(&w); } while (0)
      A2_PK4(p, 0, pa0); A2_PK4(p, 8, pa1);
      if (__any(alpha < 1.f)) { if (hi == 0) al_l[r32] = alpha; asm volatile("s_waitcnt lgkmcnt(0)" ::: "memory");
#pragma unroll
        for (int d = 0; d < 8; ++d)
#pragma unroll
          for (int r = 0; r < 16; ++r) o[d][r] *= al_l[crow(r, hi)]; }
      const int vb = (int)(ldsb + s * STAGE + 2 * ST_K) + v_rd_base(lane);
      asm volatile("s_waitcnt lgkmcnt(0)" ::: "memory"); SBAR();
#define A2_PK(L, H) (bf16x8){L[0], L[1], L[2], L[3], H[0], H[1], H[2], H[3]}
#define A2_RD(D0, l0, h0, l1, h1) do { l0 = tr_read<v_off(D0, 0, 0)>(vb); h0 = tr_read<v_off(D0, 0, 1)>(vb); l1 = tr_read<v_off(D0, 1, 0)>(vb); h1 = tr_read<v_off(D0, 1, 1)>(vb); } while (0)
#define A2_MM(D0, l0, h0, l1, h1) do { o[D0] = __builtin_amdgcn_mfma_f32_32x32x16_bf16(pa0, A2_PK(l0, h0), o[D0], 0, 0, 0); o[D0] = __builtin_amdgcn_mfma_f32_32x32x16_bf16(pa1, A2_PK(l1, h1), o[D0], 0, 0, 0); } while (0)
      s16x4 xl0, xh0, xl1, xh1, yl0, yh0, yl1, yh1;
      A2_RD(0, xl0, xh0, xl1, xh1);
      A2_RD(1, yl0, yh0, yl1, yh1); asm volatile("s_waitcnt lgkmcnt(4)" ::: "memory"); SBAR(); A2_MM(0, xl0, xh0, xl1, xh1); SBAR();
      A2_RD(2, xl0, xh0, xl1, xh1); asm volatile("s_waitcnt lgkmcnt(4)" ::: "memory"); SBAR(); A2_MM(1, yl0, yh0, yl1, yh1); SBAR();
      A2_RD(3, yl0, yh0, yl1, yh1); asm volatile("s_waitcnt lgkmcnt(4)" ::: "memory"); SBAR(); A2_MM(2, xl0, xh0, xl1, xh1); SBAR();
      A2_RD(4, xl0, xh0, xl1, xh1); asm volatile("s_waitcnt lgkmcnt(4)" ::: "memory"); SBAR(); A2_MM(3, yl0, yh0, yl1, yh1); SBAR();
      A2_RD(5, yl0, yh0, yl1, yh1); asm volatile("s_waitcnt lgkmcnt(4)" ::: "memory"); SBAR(); A2_MM(4, xl0, xh0, xl1, xh1); SBAR();
      A2_RD(6, xl0, xh0, xl1, xh1); asm volatile("s_waitcnt lgkmcnt(4)" ::: "memory"); SBAR(); A2_MM(5, yl0, yh0, yl1, yh1); SBAR();
      A2_RD(7, yl0, yh0, yl1, yh1); asm volatile("s_waitcnt lgkmcnt(4)" ::: "memory"); SBAR(); A2_MM(6, xl0, xh0, xl1, xh1); SBAR();
      asm volatile("s_waitcnt lgkmcnt(0)" ::: "memory"); SBAR(); A2_MM(7, yl0, yh0, yl1, yh1); SBAR();
    }
    s = (s == 2) ? 0 : s + 1;
  }
  if (hi == 0) li_l[r32] = l_reg; asm volatile("s_waitcnt lgkmcnt(0)" ::: "memory");
  float rli[16];
#pragma unroll
  for (int r = 0; r < 16; ++r) rli[r] = __builtin_amdgcn_rcpf(li_l[crow(r, hi)]);
  float* Ow = Obuf + (size_t)(qrow0 - orow0) * 3072 + (h * 2 + m) * 256;
#pragma unroll
  for (int r = 0; r < 16; ++r) { const int orow = crow(r, hi);
#pragma unroll
    for (int d0 = 0; d0 < 8; ++d0) Ow[(size_t)orow * 3072 + d0 * 32 + r32] = o[d0][r] * rli[r]; }
  if (hi == 0) { float* mlp = ML + (((size_t)(qrow0 - orow0 + r32) * 6 + h) * 2 + m) * 2; mlp[0] = m_reg; mlp[1] = l_reg; }
  asm volatile("s_waitcnt vmcnt(0) lgkmcnt(0)" ::: "memory");
  __builtin_amdgcn_s_barrier(); asm volatile("" ::: "memory");
#undef A2_ISSUE
#undef A2_PK4
#undef A2_PK
#undef A2_RD
#undef A2_MM
}
}

namespace att3 {
using att::f32x16; using att::crow;
typedef int v8i __attribute__((ext_vector_type(8))); typedef int v4i __attribute__((ext_vector_type(4)));
constexpr int KT = 64, ST_K = KT * 128, ST_V = 256 * 64, STAGE = 2 * ST_K + ST_V, NST = 3;
static_assert(NST * STAGE == att2::LDS_WS, "same ring size as att2");
constexpr float THR2 = 2.f;
__device__ __forceinline__ v8i cat8(v4i a, v4i b) { return __builtin_shufflevector(a, b, 0, 1, 2, 3, 4, 5, 6, 7); }
__device__ __forceinline__ void diff_unit(const unsigned char* __restrict__ Q8, const unsigned char* __restrict__ K8, const unsigned char* __restrict__ VT, float* Obuf, int orow0,
                                          float* ML, const float* relb, int h, int b, int t_lo, int t_hi, LAS char* lds) {
  int tid_ = threadIdx.x; asm volatile("" : "+v"(tid_));
  const int tid = tid_, wid = __builtin_amdgcn_readfirstlane(tid >> 6), lane = tid & 63, r32 = lane & 31, hi = lane >> 5, m = wid >> 2, rg = wid & 3;
  LAS float* wsw = (LAS float*)(lds + att2::LDS_WS) + wid * 64; LAS float* li_l = wsw; LAS float* al_l = wsw + 32;
  LAS float* tab = (LAS float*)(lds + att2::LDS_TAB);
  if (tid < att::TAB_N) tab[tid] = relb[t5_bucket(63 - tid) * 6 + h] * LOG2E;
  const float cfar = relb[15 * 6 + h] * LOG2E;
  const int qrow0 = b * 128 + rg * 32;
  v8i q8[2];
  { const unsigned char* Qw = Q8 + (size_t)(qrow0 + r32) * 2048 + h * 256 + m * 128 + hi * 32;
#pragma unroll
    for (int c = 0; c < 2; ++c) q8[c] = cat8(*(const GAS v4i*)(Qw + 64 * c), *(const GAS v4i*)(Qw + 64 * c + 16)); }
  int ko, vo[2];
  { const int p = wid * 64 + lane, row = p >> 3, cp = (p & 7) ^ (row & 7); ko = row * 1536 + h * 256 + cp * 16; }
#pragma unroll
  for (int i = 0; i < 2; ++i) { const int p = (wid * 2 + i) * 64 + lane, d = p >> 2, cp = (p & 3) ^ ((d >> 1) & 3); vo[i] = d * 64 + cp * 16; }
  const unsigned char* VTh = VT + (size_t)h * 128 * 16384;
#define A3_ISSUE(t, s) do { const size_t kb_ = (size_t)(t) * KT * 1536; LAS char* sb_ = lds + (s) * STAGE; \
    __builtin_amdgcn_global_load_lds((const unsigned*)(K8 + kb_ + ko), (LAS unsigned*)(sb_ + wid * 1024), 16, 0, 0); \
    __builtin_amdgcn_global_load_lds((const unsigned*)(K8 + kb_ + ko + 128), (LAS unsigned*)(sb_ + ST_K + wid * 1024), 16, 0, 0); \
    __builtin_amdgcn_global_load_lds((const unsigned*)(VTh + (size_t)(t) * 16384 + vo[0]), (LAS unsigned*)(sb_ + 2 * ST_K + (wid * 2) * 1024), 16, 0, 0); \
    __builtin_amdgcn_global_load_lds((const unsigned*)(VTh + (size_t)(t) * 16384 + vo[1]), (LAS unsigned*)(sb_ + 2 * ST_K + (wid * 2 + 1) * 1024), 16, 0, 0); } while (0)
  const int vis = 2 * b + (rg >> 1) + 1;
  float m_reg = -1e30f, l_reg = 0.f; f32x16 o[8];
#pragma unroll
  for (int d = 0; d < 8; ++d) o[d] = f32x16{};
  const int kx = (r32 & 7), koff0 = r32 * 128 + (((2 * hi) ^ kx) << 4), koff1 = r32 * 128 + (((2 * hi + 1) ^ kx) << 4);
  const int vx = (r32 >> 1) & 3, voff0 = r32 * 64 + (((2 * hi) ^ vx) << 4), voff1 = r32 * 64 + (((2 * hi + 1) ^ vx) << 4);
  int sclP = 121, scl1 = 127; asm volatile("" : "+v"(sclP), "+v"(scl1));
  asm volatile("s_waitcnt vmcnt(0)" ::: "memory");
  A3_ISSUE(t_lo, 0); if (t_lo + 1 < t_hi) A3_ISSUE(t_lo + 1, 1);
  int s = 0;
  for (int t = t_lo; t < t_hi; ++t) {
    if (t + 1 < t_hi) asm volatile("s_waitcnt vmcnt(4) lgkmcnt(0)" ::: "memory"); else asm volatile("s_waitcnt vmcnt(0) lgkmcnt(0)" ::: "memory");
    __builtin_amdgcn_s_barrier(); asm volatile("" ::: "memory");
    if (t + 2 < t_hi) { const int s2 = (s >= 1) ? s - 1 : s + 2; A3_ISSUE(t + 2, s2); }
    if (t < vis) {
      const LAS char* Ks = lds + s * STAGE + m * ST_K;
      f32x16 p0 = f32x16{}, p1 = f32x16{};
#pragma unroll
      for (int c = 0; c < 2; ++c) {
        const int x0 = koff0 ^ (c << 6), x1 = koff1 ^ (c << 6);
        const v8i k0 = cat8(*(const LAS v4i*)(Ks + x0), *(const LAS v4i*)(Ks + x1));
        const v8i k1 = cat8(*(const LAS v4i*)(Ks + 4096 + x0), *(const LAS v4i*)(Ks + 4096 + x1));
        asm volatile("v_mfma_scale_f32_32x32x64_f8f6f4 %0, %1, %2, %0, %3, %3 op_sel_hi:[0,0,0]" : "+v"(p0) : "v"(k0), "v"(q8[c]), "v"(scl1));
        asm volatile("v_mfma_scale_f32_32x32x64_f8f6f4 %0, %1, %2, %0, %3, %3 op_sel_hi:[0,0,0]" : "+v"(p1) : "v"(k1), "v"(q8[c]), "v"(scl1)); }
      asm volatile("s_nop 15\n s_nop 7" : "+v"(p0), "+v"(p1));
      const bool far = qrow0 - (KT * t + KT - 1) >= 91;
      if (!far) { const int base = qrow0 + r32 - KT * t + 63;
#pragma unroll
        for (int r = 0; r < 16; ++r) { const int i0 = base - crow(r, hi), i1 = i0 - 32; p0[r] += tab[i0 < att::TAB_N - 1 ? i0 : att::TAB_N - 1]; p1[r] += tab[i1 < att::TAB_N - 1 ? i1 : att::TAB_N - 1]; } }
      const float cb = far ? cfar : 0.f;
      float pmax;
      asm("v_max3_f32 %0, %1, %2, %3" : "=v"(pmax) : "v"(p0[0]), "v"(p1[0]), "v"(p0[1]));
      asm("v_max3_f32 %0, %1, %2, %3" : "=v"(pmax) : "v"(pmax), "v"(p1[1]), "v"(p0[2]));
#pragma unroll
      for (int r = 2; r < 15; ++r) asm("v_max3_f32 %0, %1, %2, %3" : "=v"(pmax) : "v"(pmax), "v"(p1[r]), "v"(p0[r + 1]));
      asm("v_max_f32 %0, %1, %2" : "=v"(pmax) : "v"(pmax), "v"(p1[15]));
      pmax += cb;
      { auto rr = __builtin_amdgcn_permlane32_swap(__float_as_uint(pmax), __float_as_uint(pmax), false, false); asm("v_max_f32 %0, %1, %2" : "=v"(pmax) : "v"(__uint_as_float(rr[0])), "v"(__uint_as_float(rr[1]))); }
      float mn, alpha;
      if (__builtin_expect(__all(pmax - m_reg <= THR2), 1)) { mn = m_reg; alpha = 1.f; }
      else { mn = fmaxf(m_reg, pmax); alpha = __builtin_amdgcn_exp2f(m_reg - mn); m_reg = mn; }
      typedef float f32x2v __attribute__((ext_vector_type(2)));
      const float off = cb - (mn - 6.f); const f32x2v off2 = {off, off}; f32x2v ps2 = {0.f, 0.f};
#pragma unroll
      for (int r = 0; r < 16; r += 2) {
        f32x2v a = (f32x2v){p0[r], p0[r + 1]} + off2, c2 = (f32x2v){p1[r], p1[r + 1]} + off2;
        p0[r] = __builtin_amdgcn_exp2f(a.x); p0[r + 1] = __builtin_amdgcn_exp2f(a.y); p1[r] = __builtin_amdgcn_exp2f(c2.x); p1[r + 1] = __builtin_amdgcn_exp2f(c2.y);
        ps2 += (f32x2v){p0[r], p0[r + 1]}; ps2 += (f32x2v){p1[r], p1[r + 1]}; }
      float ps = ps2.x + ps2.y;
      { auto rr = __builtin_amdgcn_permlane32_swap(__float_as_uint(ps), __float_as_uint(ps), false, false); ps = __uint_as_float(rr[0]) + __uint_as_float(rr[1]); }
      l_reg = l_reg * alpha + ps;
      v8i pa;
#pragma unroll
      for (int g = 0; g < 4; ++g) { unsigned x = 0u, y = 0u;
        x = __builtin_amdgcn_cvt_pk_fp8_f32(p0[4 * g], p0[4 * g + 1], x, false); x = __builtin_amdgcn_cvt_pk_fp8_f32(p0[4 * g + 2], p0[4 * g + 3], x, true);
        y = __builtin_amdgcn_cvt_pk_fp8_f32(p1[4 * g], p1[4 * g + 1], y, false); y = __builtin_amdgcn_cvt_pk_fp8_f32(p1[4 * g + 2], p1[4 * g + 3], y, true);
        auto rr = __builtin_amdgcn_permlane32_swap(x, y, false, false); pa[2 * g] = (int)rr[0]; pa[2 * g + 1] = (int)rr[1]; }
      if (__any(alpha < 1.f)) { if (hi == 0) al_l[r32] = alpha; asm volatile("s_waitcnt lgkmcnt(0)" ::: "memory");
#pragma unroll
        for (int d = 0; d < 8; ++d)
#pragma unroll
          for (int r = 0; r < 16; ++r) o[d][r] *= al_l[crow(r, hi)]; }
      const LAS char* Vs = lds + s * STAGE + 2 * ST_K;
#define A3_RD(D0, V) do { V = cat8(*(const LAS v4i*)(Vs + (D0) * 2048 + voff0), *(const LAS v4i*)(Vs + (D0) * 2048 + voff1)); } while (0)
#define A3_MM(D0, V) asm volatile("v_mfma_scale_f32_32x32x64_f8f6f4 %0, %1, %2, %0, %3, %4 op_sel_hi:[0,0,0]" : "+v"(o[D0]) : "v"(pa), "v"(V), "v"(sclP), "v"(scl1))
      v8i va, vb;
      A3_RD(0, va);
      A3_RD(1, vb); A3_MM(0, va);
      A3_RD(2, va); A3_MM(1, vb);
      A3_RD(3, vb); A3_MM(2, va);
      A3_RD(4, va); A3_MM(3, vb);
      A3_RD(5, vb); A3_MM(4, va);
      A3_RD(6, va); A3_MM(5, vb);
      A3_RD(7, vb); A3_MM(6, va);
      A3_MM(7, vb);
    }
    s = (s == 2) ? 0 : s + 1;
  }
  asm volatile("s_nop 15\n s_nop 15" ::: "memory");
  if (hi == 0) li_l[r32] = l_reg; asm volatile("s_waitcnt lgkmcnt(0)" ::: "memory");
  float rli[16];
#pragma unroll
  for (int r = 0; r < 16; ++r) rli[r] = 64.f * __builtin_amdgcn_rcpf(li_l[crow(r, hi)]);
  float* Ow = Obuf + (size_t)(qrow0 - orow0) * 3072 + (h * 2 + m) * 256;
#pragma unroll
  for (int r = 0; r < 16; ++r) { const int orow = crow(r, hi);
#pragma unroll
    for (int d0 = 0; d0 < 8; ++d0) Ow[(size_t)orow * 3072 + d0 * 32 + r32] = o[d0][r] * rli[r]; }
  if (hi == 0) { float* mlp = ML + (((size_t)(qrow0 - orow0 + r32) * 6 + h) * 2 + m) * 2; mlp[0] = m_reg; mlp[1] = l_reg * (1.f / 64.f); }
  asm volatile("s_waitcnt vmcnt(0) lgkmcnt(0)" ::: "memory");
  __builtin_amdgcn_s_barrier(); asm volatile("" ::: "memory");
#undef A3_ISSUE
#undef A3_RD
#undef A3_MM
}
}

__device__ __forceinline__ void diffattn2_unit(Frame& F, const Args& a, unsigned code) {
    const int h = code & 7, b = (code >> 3) & 63, pc = code >> 9;
    float* ob = (float*)(F.ws + (pc == 2 ? WS_OP2 : WS_OP)); float* ml = (float*)(F.ws + WS_ML) + (pc == 2 ? (size_t)T * 6 * 2 * 2 : 0);
#ifdef ATT_BF16
    const int nt = 4 * b + 4, t_lo = (pc == 2) ? nt / 2 : 0, t_hi = (pc == 1) ? nt / 2 : nt;
    att2::diff_unit((const bf16*)(F.ws + WS_Z), (const bf16*)(F.ws + WS_KD), (const bf16*)(F.ws + WS_VD), ob, pc == 2 ? 4096 : 0, ml, a.in[I_RELB], h, b, t_lo, t_hi, (LAS char*)F.lds);
#else
    const int nt = 2 * b + 2, t_lo = (pc == 2) ? nt / 2 : 0, t_hi = (pc == 1) ? nt / 2 : nt;
    att3::diff_unit(F.ws + WS_ZQ, F.ws + WS_KD, F.ws + WS_VD, ob, pc == 2 ? 4096 : 0, ml, a.in[I_RELB], h, b, t_lo, t_hi, (LAS char*)F.lds);
#endif
}
__device__ __forceinline__ void diffcombine_phase(Frame& F, const Args& a, int l) {
    const int i = l - 2; const float* lp = a.in[I_BLAM] + (size_t)i * 4 * 128;
    float s1 = lp[F.lane] * lp[128 + F.lane] + lp[64 + F.lane] * lp[128 + 64 + F.lane], s2 = lp[256 + F.lane] * lp[384 + F.lane] + lp[256 + 64 + F.lane] * lp[384 + 64 + F.lane];
    s1 = wave_sum(s1); s2 = wave_sum(s2);
    const float lam_init = 0.8f - 0.6f * expf(-0.3f * (float)l);
    const float lam = expf(s1) - expf(s2) + lam_init;
    const float* op0 = (const float*)(F.ws + WS_OP); const float* op1 = (const float*)(F.ws + WS_OP2); const float* ml0 = (const float*)(F.ws + WS_ML); const float* ml1 = ml0 + (size_t)T * 6 * 2 * 2;
    bf16* cat = (bf16*)(F.ws + WS_CAT);
    const f32x4 gsub = *(const GAS f32x4*)(a.in[I_BSUBG] + (size_t)i * 256 + 4 * F.lane);
    const int gw = F.c * NWAVES + F.wave, NGW = F.G * NWAVES;
    for (int it = gw; it < T * 6; it += NGW) { const int tk = it / 6, h = it - tk * 6; f32x4 os[2];
#pragma unroll
        for (int m = 0; m < 2; ++m) { const size_t r0 = ((size_t)tk * 6 + h) * 2 + m; f32x4 oa = *(const GAS f32x4*)(op0 + r0 * 256 + 4 * F.lane);
            if (tk >= 4096) { const size_t r1 = ((size_t)(tk - 4096) * 6 + h) * 2 + m; const f32x4 ob = *(const GAS f32x4*)(op1 + r1 * 256 + 4 * F.lane);
                const float ma = ml0[r0 * 2], la = ml0[r0 * 2 + 1], mb = ml1[r1 * 2], lb = ml1[r1 * 2 + 1], M = fmaxf(ma, mb);
                const float wa = la * exp2f(ma - M), wb = lb * exp2f(mb - M), inv = 1.f / (wa + wb); oa = oa * (wa * inv) + ob * (wb * inv); }
            os[m] = oa; }
        const f32x4 o = os[0] - os[1] * lam; const float ss = wave_sum((o.x * o.x + o.y * o.y) + (o.z * o.z + o.w * o.w));
        const float r = (1.f - lam_init) / sqrtf(ss * (1.f / 256.f) + LN_EPS);
        v2u w; w.x = pk2(o.x * r * gsub.x, o.y * r * gsub.y); w.y = pk2(o.z * r * gsub.z, o.w * r * gsub.w);
        if (!F8OL(l)) *(GAS v2u*)(cat + (size_t)tk * D + h * 256 + 4 * F.lane) = w;
        { unsigned q8 = 0u; q8 = __builtin_amdgcn_cvt_pk_fp8_f32(o.x * r * gsub.x, o.y * r * gsub.y, q8, false); q8 = __builtin_amdgcn_cvt_pk_fp8_f32(o.z * r * gsub.z, o.w * r * gsub.w, q8, true);
          *(GAS unsigned*)(F.ws + WS_CATQ + (size_t)tk * D + h * 256 + 4 * F.lane) = q8; } }
    { const long nthr = (long)F.G * 512, gt = (long)F.c * 512 + F.tid;
      for (long i2 = gt; i2 < (long)T * 64; i2 += nthr) { const long tk = i2 >> 6; const int c8 = (int)(i2 & 63) * 8; const v4u w = *(const GAS v4u*)(cat + tk * D + MIXW + c8);
          unsigned lo = 0u, hi = 0u; lo = __builtin_amdgcn_cvt_pk_fp8_f32(bflo(w.x), bfhi(w.x), lo, false); lo = __builtin_amdgcn_cvt_pk_fp8_f32(bflo(w.y), bfhi(w.y), lo, true);
          hi = __builtin_amdgcn_cvt_pk_fp8_f32(bflo(w.z), bfhi(w.z), hi, false); hi = __builtin_amdgcn_cvt_pk_fp8_f32(bflo(w.w), bfhi(w.w), hi, true);
          v2u qq; qq.x = lo; qq.y = hi; *(GAS v2u*)(F.ws + WS_CATQ + tk * D + MIXW + c8) = qq; } }
}


__device__ __forceinline__ void ln1_router_phase(Frame& F, const Args& a, int l, int probe = 0) {
    const bf16* y = (const bf16*)(F.ws + WS_Y); bf16* x1b = (bf16*)(F.ws + WS_X1B);
    const float* lng = a.in[I_LNG] + ((size_t)l * 2 + 0) * D; const float* lnb = a.in[I_LNB] + ((size_t)l * 2 + 0) * D;
    const float* wr = (const float*)(F.ws + WS_WR) + (size_t)l * 3 * 512 * 16 * 4;
    int* tok_e = (int*)(F.ws + (probe ? WS_OP : WS_ROUTE)); int* tok_rank = tok_e + 2 * T; float* tok_gate = (float*)(tok_rank + 2 * T);
    gu32* cnt = F.ctl + (probe ? 65536 : CW_CNT) + 2048 * l;
    LAS float* P = (LAS float*)(F.lds);
    constexpr int X1ROW = 2 * D + 16;
    typedef float f32x4v __attribute__((ext_vector_type(4)));
    for (int tb = F.c; tb < T / 32; tb += F.G) {
#pragma unroll 2
        for (int i = 0; i < 4; ++i) { const int tk = tb * 32 + F.wave * 4 + i;
            const GAS v4u* yr = (const GAS v4u*)(y + (size_t)tk * D) + F.lane;
            float v[4][8]; float s = 0.f;
#pragma unroll
            for (int j = 0; j < 4; ++j) { const v4u w = yr[64 * j]; v[j][0] = bflo(w.x); v[j][1] = bfhi(w.x); v[j][2] = bflo(w.y); v[j][3] = bfhi(w.y); v[j][4] = bflo(w.z); v[j][5] = bfhi(w.z); v[j][6] = bflo(w.w); v[j][7] = bfhi(w.w);
#pragma unroll
                for (int e = 0; e < 8; ++e) s += v[j][e]; }
            const float mean = wave_sum(s) * (1.f / D); float s2 = 0.f;
#pragma unroll
            for (int j = 0; j < 4; ++j)
#pragma unroll
                for (int e = 0; e < 8; ++e) { v[j][e] -= mean; s2 += v[j][e] * v[j][e]; }
            const float rstd = 1.f / sqrtf(wave_sum(s2) * (1.f / D) + LN_EPS);
#pragma unroll
            for (int j = 0; j < 4; ++j) { const int d0 = 8 * F.lane + 512 * j; const f32x4 g0 = *(const GAS f32x4*)(lng + d0), g1 = *(const GAS f32x4*)(lng + d0 + 4), b0 = *(const GAS f32x4*)(lnb + d0), b1 = *(const GAS f32x4*)(lnb + d0 + 4);
                const float q0 = v[j][0] * rstd * g0.x + b0.x, q1 = v[j][1] * rstd * g0.y + b0.y, q2 = v[j][2] * rstd * g0.z + b0.z, q3 = v[j][3] * rstd * g0.w + b0.w;
                const float q4 = v[j][4] * rstd * g1.x + b1.x, q5 = v[j][5] * rstd * g1.y + b1.y, q6 = v[j][6] * rstd * g1.z + b1.z, q7 = v[j][7] * rstd * g1.w + b1.w;
                v4u w; w.x = pk2(q0, q1); w.y = pk2(q2, q3); w.z = pk2(q4, q5); w.w = pk2(q6, q7);
                *(GAS v4u*)(x1b + (size_t)tk * D + d0) = w;
                *(LAS v4u*)(F.lds + RING_OFF + (F.wave * 4 + i) * X1ROW + d0 * 2) = w;
                unsigned lo = 0u, hi = 0u; lo = __builtin_amdgcn_cvt_pk_fp8_f32(q0, q1, lo, false); lo = __builtin_amdgcn_cvt_pk_fp8_f32(q2, q3, lo, true);
                hi = __builtin_amdgcn_cvt_pk_fp8_f32(q4, q5, hi, false); hi = __builtin_amdgcn_cvt_pk_fp8_f32(q6, q7, hi, true);
                v2u qq; qq.x = lo; qq.y = hi; *(GAS v2u*)((unsigned char*)(F.ws + WS_X1F) + (size_t)tk * D + d0) = qq; } }
        __syncthreads();
        { const int mt = F.wave >> 2, kq = F.wave & 3, c = F.lane & 15, q = F.lane >> 4;
          const LAS unsigned char* ap = F.lds + RING_OFF + (mt * 16 + c) * X1ROW + (kq * 512 + 4 * q) * 2;
          const float* bp = wr + ((size_t)(kq * 128 + q) * 16 + c) * 4;
          f32x4v acc[3] = {{0.f, 0.f, 0.f, 0.f}, {0.f, 0.f, 0.f, 0.f}, {0.f, 0.f, 0.f, 0.f}};
#pragma unroll 8
          for (int ks = 0; ks < 32; ++ks) { const v2u aw = *(const LAS v2u*)(ap + 32 * ks); const f32x4 a4 = (f32x4){bflo(aw.x), bfhi(aw.x), bflo(aw.y), bfhi(aw.y)}; f32x4 b4[3];
#pragma unroll
              for (int nb = 0; nb < 3; ++nb) b4[nb] = *(const GAS f32x4*)(bp + ((size_t)nb * 512 + 4 * ks) * 64);
#pragma unroll
              for (int j = 0; j < 4; ++j)
#pragma unroll
                  for (int nb = 0; nb < 3; ++nb) acc[nb] = __builtin_amdgcn_mfma_f32_16x16x4f32(a4[j], b4[nb][j], acc[nb], 0, 0, 0); }
          __syncthreads();
#pragma unroll
          for (int nb = 0; nb < 3; ++nb)
#pragma unroll
              for (int r = 0; r < 4; ++r) P[((kq * 2 + mt) * 16 + 4 * q + r) * 48 + nb * 16 + c] = acc[nb][r]; }
        __syncthreads();
        if (F.tid < 64) { const int tsel = F.tid & 31, tk = tb * 32 + tsel, mt = tsel >> 4, ti = tsel & 15;
            const LAS f32x4* P4 = (const LAS f32x4*)P;
            const int rb = (mt * 16 + ti) * 12;
            const float* bg1 = a.in[I_BG1] + l * 4; const float* bg2 = a.in[I_BG2] + l * 32;
            const f32x4 s1 = (P4[rb] + P4[rb + 384]) + (P4[rb + 768] + P4[rb + 1152]);
            const float l10 = s1.x + bg1[0], l11 = s1.y + bg1[1], l12 = s1.z + bg1[2], l13 = s1.w + bg1[3];
            int grp = 0; float mx = l10;
            if (l11 > mx) { mx = l11; grp = 1; } if (l12 > mx) { mx = l12; grp = 2; } if (l13 > mx) { mx = l13; grp = 3; }
            const float psel = 1.f / (expf(l10 - mx) + expf(l11 - mx) + expf(l12 - mx) + expf(l13 - mx));
            const int ob = rb + 1 + 2 * grp;
            const f32x4 sa = (P4[ob] + P4[ob + 384]) + (P4[ob + 768] + P4[ob + 1152]), sb = (P4[ob + 1] + P4[ob + 385]) + (P4[ob + 769] + P4[ob + 1153]);
            const f32x4 ba = *(const GAS f32x4*)(bg2 + grp * 8), bb = *(const GAS f32x4*)(bg2 + grp * 8 + 4);
            const float l2[8] = {sa.x + ba.x, sa.y + ba.y, sa.z + ba.z, sa.w + ba.w, sb.x + bb.x, sb.y + bb.y, sb.z + bb.z, sb.w + bb.w};
            int i0 = 0; float v0 = l2[0];
#pragma unroll
            for (int e = 1; e < 8; ++e) if (l2[e] > v0) { v0 = l2[e]; i0 = e; }
            int i1 = -1; float v1 = -INFINITY;
#pragma unroll
            for (int e = 0; e < 8; ++e) if (e != i0 && l2[e] > v1) { v1 = l2[e]; i1 = e; }
            const float e1 = expf(v1 - v0), g0 = psel / (1.f + e1), g1 = psel * e1 / (1.f + e1);
            const int ex0 = grp * 8 + i0, ex1 = grp * 8 + i1;
            const int which = F.lane >> 5, ex = which ? ex1 : ex0; const float gg = which ? g1 : g0;
            int leader = F.lane, idx = 0, gcount = 1;
            { unsigned long long rem = ~0ull;
              while (rem) { const int l0 = __builtin_ctzll(rem); const int le = __builtin_amdgcn_readlane(ex, l0); const unsigned long long mm = __ballot(ex == le);
                  if (ex == le) { leader = l0; idx = __builtin_popcountll(mm & ((1ull << F.lane) - 1ull)); gcount = __builtin_popcountll(mm); }
                  rem &= ~mm; } }
            unsigned base = 0u; if (F.lane == leader) base = __hip_atomic_fetch_add(cnt + 64 * ex, (unsigned)gcount, RLX_AGENT);
            base = (unsigned)__shfl((int)base, leader);
            const int rk = (int)base + idx;
            { int* list = (int*)(F.ws + (probe ? WS_OP + 2 * MiB : WS_LIST)); list[ex * 8192 + rk] = tk; }
            tok_e[2 * tk + which] = ex; tok_rank[2 * tk + which] = rk; tok_gate[2 * tk + which] = gg; }
        __syncthreads();
    }
}
__device__ __forceinline__ void moe_table(Frame& F, int l) {
    LAS int* tstart = (LAS int*)(F.lds + TAB_OFF);
    if (F.tid == 0) { int acc = 0;
        for (int e = 0; e < 32; ++e) { tstart[e] = acc; const unsigned c = __hip_atomic_load(F.ctl + CW_CNT + 2048 * l + 64 * e, RLX_AGENT); tstart[36 + e] = (int)c; acc += (int)((c + 255u) >> 8); }
        tstart[32] = acc; }
    __syncthreads();
}
__device__ __forceinline__ void ln2_phase(Frame& F, const Args& a, int l) {
    const bf16* x1b = (const bf16*)(F.ws + WS_X1B); const unsigned char* yb8 = F.ws + WS_YB; bf16* xb = (bf16*)(F.ws + WS_XB);
    const float* lng = a.in[I_LNG] + ((size_t)l * 2 + 1) * D; const float* lnb = a.in[I_LNB] + ((size_t)l * 2 + 1) * D;
    moe_table(F, l); const LAS int* tstart = (const LAS int*)(F.lds + TAB_OFF);
    const int* tok_e = (const int*)(F.ws + WS_ROUTE); const int* tok_rank = tok_e + 2 * T; const float* tok_gate = (const float*)(F.ws + WS_ROUTE) + 4 * T;
    const int gw = F.c * NWAVES + F.wave, NGW = F.G * NWAVES;
    for (int t4 = gw; t4 < T / 4; t4 += NGW) { const int tk0 = t4 * 4;
        int ev = 0, rv = 0; float gv = 0.f;
        if (F.lane < 8) { ev = tok_e[2 * tk0 + F.lane]; rv = tok_rank[2 * tk0 + F.lane]; gv = tok_gate[2 * tk0 + F.lane]; }
        const int slotv = (F.lane < 8) ? tstart[ev] * 256 + rv : 0;
        v4u xr[2], xr2[2]; v2u ya[2], yc[2], ya2[2], yc2[2];
#define LN2_LOAD(i, XR, YA, YC, XR2, YA2, YC2) do { const int s0_ = __builtin_amdgcn_readlane(slotv, 2 * (i)), s1_ = __builtin_amdgcn_readlane(slotv, 2 * (i) + 1); \
        _Pragma("unroll") for (int j = 0; j < 2; ++j) { const int d0 = 8 * F.lane + 512 * j; XR[j] = *(const GAS v4u*)(x1b + (size_t)(tk0 + (i)) * D + d0); YA[j] = *(const GAS v2u*)(yb8 + (size_t)s0_ * D + d0); YC[j] = *(const GAS v2u*)(yb8 + (size_t)s1_ * D + d0); } \
        _Pragma("unroll") for (int j = 0; j < 2; ++j) { const int d0 = 8 * F.lane + 512 * (j + 2); XR2[j] = *(const GAS v4u*)(x1b + (size_t)(tk0 + (i)) * D + d0); YA2[j] = *(const GAS v2u*)(yb8 + (size_t)s0_ * D + d0); YC2[j] = *(const GAS v2u*)(yb8 + (size_t)s1_ * D + d0); } } while (0)
        LN2_LOAD(0, xr, ya, yc, xr2, ya2, yc2);
#pragma unroll
        for (int i = 0; i < 4; ++i) { const int tk = tk0 + i;
            const float g0 = (1.f / 16.f) * __builtin_bit_cast(float, __builtin_amdgcn_readlane(__builtin_bit_cast(int, gv), 2 * i)), g1 = (1.f / 16.f) * __builtin_bit_cast(float, __builtin_amdgcn_readlane(__builtin_bit_cast(int, gv), 2 * i + 1));
            float v[4][8]; float s = 0.f;
#pragma unroll
            for (int j = 0; j < 4; ++j) { const v4u X = j < 2 ? xr[j] : xr2[j - 2]; const v2u A = j < 2 ? ya[j] : ya2[j - 2], C = j < 2 ? yc[j] : yc2[j - 2];
#define Y8(W, B) __builtin_amdgcn_cvt_f32_fp8((int)(W), (B))
                v[j][0] = bflo(X.x) * DN_ALPHA + (g0 * Y8(A.x, 0) + g1 * Y8(C.x, 0)); v[j][1] = bfhi(X.x) * DN_ALPHA + (g0 * Y8(A.x, 1) + g1 * Y8(C.x, 1));
                v[j][2] = bflo(X.y) * DN_ALPHA + (g0 * Y8(A.x, 2) + g1 * Y8(C.x, 2)); v[j][3] = bfhi(X.y) * DN_ALPHA + (g0 * Y8(A.x, 3) + g1 * Y8(C.x, 3));
                v[j][4] = bflo(X.z) * DN_ALPHA + (g0 * Y8(A.y, 0) + g1 * Y8(C.y, 0)); v[j][5] = bfhi(X.z) * DN_ALPHA + (g0 * Y8(A.y, 1) + g1 * Y8(C.y, 1));
                v[j][6] = bflo(X.w) * DN_ALPHA + (g0 * Y8(A.y, 2) + g1 * Y8(C.y, 2)); v[j][7] = bfhi(X.w) * DN_ALPHA + (g0 * Y8(A.y, 3) + g1 * Y8(C.y, 3));
#undef Y8
#pragma unroll
                for (int e = 0; e < 8; ++e) s += v[j][e]; }
            if (i + 1 < 4) LN2_LOAD(i + 1, xr, ya, yc, xr2, ya2, yc2);
            const float mean = wave_sum(s) * (1.f / D); float s2 = 0.f;
#pragma unroll
            for (int j = 0; j < 4; ++j)
#pragma unroll
                for (int e = 0; e < 8; ++e) { v[j][e] -= mean; s2 += v[j][e] * v[j][e]; }
            const float rstd = 1.f / sqrtf(wave_sum(s2) * (1.f / D) + LN_EPS);
#pragma unroll
            for (int j = 0; j < 4; ++j) { const int d0 = 8 * F.lane + 512 * j; const f32x4 g0v = *(const GAS f32x4*)(lng + d0), g1v = *(const GAS f32x4*)(lng + d0 + 4), b0 = *(const GAS f32x4*)(lnb + d0), b1 = *(const GAS f32x4*)(lnb + d0 + 4);
                const f32x4 oa = (f32x4){v[j][0] * rstd * g0v.x + b0.x, v[j][1] * rstd * g0v.y + b0.y, v[j][2] * rstd * g0v.z + b0.z, v[j][3] * rstd * g0v.w + b0.w};
                const f32x4 ob = (f32x4){v[j][4] * rstd * g1v.x + b1.x, v[j][5] * rstd * g1v.y + b1.y, v[j][6] * rstd * g1v.z + b1.z, v[j][7] * rstd * g1v.w + b1.w};
                if (l == DEPTH - 1) { *(GAS f32x4*)(a.out + (size_t)tk * D + d0) = oa; *(GAS f32x4*)(a.out + (size_t)tk * D + d0 + 4) = ob; }
                else { v4u w; w.x = pk2(oa.x, oa.y); w.y = pk2(oa.z, oa.w); w.z = pk2(ob.x, ob.y); w.w = pk2(ob.z, ob.w); *(GAS v4u*)(xb + (size_t)tk * D + d0) = w;
                    unsigned lo = 0u, hi = 0u; lo = __builtin_amdgcn_cvt_pk_fp8_f32(oa.x, oa.y, lo, false); lo = __builtin_amdgcn_cvt_pk_fp8_f32(oa.z, oa.w, lo, true); hi = __builtin_amdgcn_cvt_pk_fp8_f32(ob.x, ob.y, hi, false); hi = __builtin_amdgcn_cvt_pk_fp8_f32(ob.z, ob.w, hi, true);
                    v2u qq; qq.x = lo; qq.y = hi; if (F8L(l + 1)) *(GAS v2u*)(F.ws + WS_XQ + (size_t)tk * D + d0) = qq; } }
        }
#undef LN2_LOAD
    }
}

__global__ void __launch_bounds__(NWAVES * 64, 2) fwd_kernel(Args args) {
    extern __shared__ __attribute__((aligned(16))) unsigned char lds[];
    Frame F;
    F.lds = (LAS unsigned char*)lds; F.ldsg = (char*)lds;
    F.tid = threadIdx.x; F.lane = F.tid & 63; F.wave = __builtin_amdgcn_readfirstlane(F.tid >> 6);
    F.G = gridDim.x; F.c = blockIdx.x; F.ws = args.ws; F.ctl = (gu32*)(args.ws + WS_CTL);
    volatile LAS unsigned* MISC = (volatile LAS unsigned*)(F.lds + MISC_OFF);
    for (int u = F.tid; u < (LDS_BYTES - LDSCTL_OFF) / 4; u += NWAVES * 64) ((LAS unsigned*)(F.lds + LDSCTL_OFF))[u] = 0u;
    __syncthreads();
    const int lo = args.ph_lo, hi = args.ph_hi; int lastp = -1;
    const bool multi = (hi - lo) > 1;
    XcdBarrier bar; bar.bar = (unsigned*)(F.ctl + CW_BAR); bar.x = 0; bar.st = nullptr;
    if (multi) bar = xcd_barrier_post((unsigned*)(F.ctl + CW_BAR), MISC + 8);
#ifndef REP_MASK
#define REP_MASK 0
#endif
#define REP(k) for (int rep_ = 0; rep_ <= ((REP_MASK >> (k)) & 1); ++rep_)
#define IN(p) (lo <= (p) && (p) < hi)
#ifdef PROBE_A
#define STAMP(i) do { if (blockIdx.x == 0 && threadIdx.x == 0) ((unsigned long long*)(args.ws + WS_TS))[(i)] = __builtin_amdgcn_s_memrealtime(); } while (0)
#else
#define STAMP(i) do { } while (0)
#endif
#define SEAM(p) do { conv_note_fin(F, (p)); lastp = (p); if ((p) + 1 < hi) xcd_barrier(bar); STAMP((p) + 1); } while (0)
#define CONVFIN() ((lastp >= 0) ? (int)__hip_atomic_load(F.ctl + CW_FIN + 64 * lastp, RLX_AGENT) : 0)
#define FRESH() do { int t_ = threadIdx.x; asm volatile("" : "+v"(t_)); F.tid = t_; F.lane = t_ & 63; F.wave = __builtin_amdgcn_readfirstlane(t_ >> 6); \
    GAS unsigned char* w_ = (GAS unsigned char*)args.ws; asm volatile("" : "+s"(w_)); F.ws = (unsigned char*)w_; F.ctl = (gu32*)(w_ + WS_CTL); } while (0)

    STAMP(0);
    if (IN(0)) { FRESH(); REP(9) prologue_phase(F, args); SEAM(0); }
#ifdef XBAR
    for (int xb_ = 0; xb_ < XBAR; ++xb_) xcd_barrier(bar);
#endif

#pragma unroll 1
    for (int l_ = 0; l_ < DEPTH; ++l_) {
        const int pb = 1 + NPH_LAYER * l_;
#pragma unroll 1
        for (int k_ = 0; k_ < NPH_LAYER; ++k_) {
            const int p = pb + k_;
            if (!IN(p) || k_ == 5 || (k_ == 2 && l_ < 2)) continue;
            int l = l_, k = k_; asm volatile("" : "+s"(l), "+s"(k));
            FRESH();
            int cq = NQ, cn = 0;
            switch (k) {
            case 0: {
                const int N = (l < 2) ? NINA : (l == 2 ? 5120 : 2048);
                const unsigned char* Bt = F.ws + ((l < 2) ? WS_WAIN + (size_t)l * NINA * D * 2 : (l == 2 ? WS_WBIN0 : WS_WBIN1));
                const int nu = (T / 256) * (N / 256) + (l == 0 ? 16 : 0); const bool f8 = F8L(l);
                pg8::EpiBf16X E{l < 2 ? 0 : 1, (bf16*)(F.ws + WS_Z), (bf16*)(F.ws + WS_KD), (bf16*)(F.ws + WS_VD), (bf16*)(F.ws + WS_MEMKV), nullptr, nullptr};
                if (f8) { pg8::Gemm g{nullptr, nullptr, T, N, D / 2}; pg8::DualOrder8 S; S.init(F.ws + WS_XQ, Bt, T, N, D / 2, F.G, F.c, F.ws + WS_MEMQ, F.ws + WS_WMKV, l == 0 ? 16 : 0);
                    REP(0) pg8::gemm_phase<pg8::EpiBf16X, pg8::DualOrder8, true, true>(F.lds + RING_OFF, g, S, E); }
                else { pg8::Gemm g{nullptr, nullptr, T, N, D}; pg8::DualOrder S; S.init(F.ws + WS_XB, Bt, T, N, D, F.G, F.c, F.ws + WS_MEMB, F.ws + WS_WMKV, l == 0 ? 16 : 0);
                    REP(0) pg8::gemm_phase<pg8::EpiBf16X, pg8::DualOrder, true, true>(F.lds + RING_OFF, g, S, E); }
                { const int mine = (nu - 1 - F.c) / F.G + 1, rounds = (nu + F.G - 1) / F.G; cq = 2 * l; cn = (rounds - mine) * (f8 ? (QA + 1) / 2 : QA); }
            } break;
            case 1: {
                if (l < 2) {
                    REP(1) for (int u = F.c; u < 256 + 128; u += F.G) {
                        if (u < 256) sgu_unit(F, args, l, u >> 2, u & 3);
                        else { const int r = u - 256; memattn_unit(F, l, r & 3, r >> 2, NINA, 2 * MIXW); }
                    }
                    if (F.c >= 128) { cq = 2 * l; cn = QX; }
                } else {
                    const int ncv = CONVFIN() ? 0 : NCVATT;
                    if (F.c >= F.G - ncv) { conv_server_q(F, args, F.ctl + CW_Q + 64 * l, (unsigned)(att2::NUNITS + 128 - STOPU), 2 * l); __syncthreads(); }
                    REP(2) { gu32* qh = F.ctl + CW_Q + 64 * l + 16 * rep_; LAS unsigned* uw = (LAS unsigned*)(F.lds + att2::LDS_UNIT);
                    for (;;) {
                        if (F.tid == 0) *uw = __hip_atomic_fetch_add(qh, 1u, RLX_AGENT);
                        __syncthreads();
                        const unsigned idx = *uw;
                        __syncthreads();
                        if (idx >= (unsigned)(att2::NUNITS + 128)) break;
                        if (idx < (unsigned)att2::NUNITS) diffattn2_unit(F, args, att2::g_units.u[idx]);
                        else { const int r = (int)idx - att2::NUNITS; memattn_unit(F, l, r & 3, r >> 2, 2048, MIXW); }
                    } }
                }
            } break;
            case 2: { REP(3) diffcombine_phase(F, args, l); } break;
            case 3: {
                pg8::EpiResBf16 E{(const bf16*)(F.ws + WS_XB), (bf16*)(F.ws + WS_Y), DN_ALPHA};
                const unsigned char* Wo = F.ws + (l < 2 ? WS_WAOUT + (size_t)l * D * D * 2 : WS_WBOUT + (size_t)(l - 2) * D * D * 2);
                if (F8OL(l)) { pg8::Gemm g{nullptr, nullptr, T, D, D / 2}; pg8::DenseOrder8 S; S.init(F.ws + WS_CATQ, Wo, T, D, D / 2, F.G, F.c);
                    REP(4) pg8::gemm_phase<pg8::EpiResBf16, pg8::DenseOrder8, true, true>(F.lds + RING_OFF, g, S, E); }
                else { pg8::Gemm g{nullptr, nullptr, T, D, D}; pg8::DenseOrder S; S.init(F.ws + WS_CAT, Wo, T, D, D, F.G, F.c);
                    REP(4) pg8::gemm_phase<pg8::EpiResBf16, pg8::DenseOrder, true, true>(F.lds + RING_OFF, g, S, E); }
            } break;
            case 4: {
                ln1_router_phase(F, args, l);
#ifdef REP_LN1
                ln1_router_phase(F, args, l, 1);
#endif
                cq = 2 * l; cn = -1;
            } break;
            case 6: {
                moe_table(F, l);
                const LAS int* tb = (const LAS int*)(F.lds + TAB_OFF);
                pg8::Gemm g{nullptr, nullptr, SLOTS, 1024, D / 2};
                pg8::MoeGatherOrder S{tb, tb + 36, (const int*)(F.ws + WS_LIST), 4, F.G, F.c, (const char*)(F.ws + WS_X1F), (const char*)(F.ws + WS_W13) + (size_t)l * NE * 1024 * 2048, (size_t)1024 * 2048, (size_t)256 * 2048, (unsigned)D};
                pg8::EpiMoe1 E{(bf16*)(F.ws + WS_H), tb, tb + 36};
                REP(6) pg8::gemm_phase<pg8::EpiMoe1, pg8::MoeGatherOrder, true, true>(F.lds + RING_OFF, g, S, E);
                { const int nu = __builtin_amdgcn_readfirstlane(((const LAS int*)(F.lds + TAB_OFF))[32]) * 4, mine = (F.c < nu) ? (nu - 1 - F.c) / F.G + 1 : 0, rounds = (nu + F.G - 1) / F.G; cq = 2 * l + 1; cn = (rounds - mine) * QM; }
            } break;
            case 7: {
                moe_table(F, l);
                pg8::Gemm g{nullptr, nullptr, SLOTS, D, FF / 2};
                pg8::MoeOrder8 S{(const PG8_LAS int*)(F.lds + TAB_OFF), 8, F.G, F.c, (const char*)(F.ws + WS_H), (const char*)(F.ws + WS_W2) + (size_t)l * NE * 2048 * 512, (size_t)256 * FF, (size_t)2048 * 512, (size_t)256 * 512};
                pg8::EpiBf16X E{3, (bf16*)(F.ws + WS_YB), nullptr, nullptr, nullptr, (const PG8_LAS int*)(F.lds + TAB_OFF), (const PG8_LAS int*)(F.lds + TAB_OFF) + 36};
                REP(7) pg8::gemm_phase<pg8::EpiBf16X, pg8::MoeOrder8, true, true>(F.lds + RING_OFF, g, S, E);
                { const int nu = __builtin_amdgcn_readfirstlane(((const LAS int*)(F.lds + TAB_OFF))[32]) * 8, mine = (F.c < nu) ? (nu - 1 - F.c) / F.G + 1 : 0, rounds = (nu + F.G - 1) / F.G; cq = 2 * l + 1; cn = (rounds - mine) * QB; }
            } break;
            default: {
                REP(8) ln2_phase(F, args, l);
                cq = 2 * l + 1; cn = -1;
            } break;
            }
            FRESH();
            conv_filler(F, args, cq, cn);
            SEAM(p);
        }
    }
#ifdef PROBE_A
    {
        VM_WAIT(); xcd_barrier(bar);
        const unsigned long long* ts = (const unsigned long long*)(args.ws + WS_TS);
        float da = 0.f, db = 0.f;
        for (int p = 0; p < NPHASES; ++p) { const int k = (p == 0) ? 9 : (p - 1) % NPH_LAYER; const float d = (float)(ts[p + 1] - ts[p]);
            if (k == PROBE_A || PROBE_A == 10) da += d; if (k == PROBE_B || PROBE_B == 10) db += d; }
        const float kk = sqrtf(da), vv = db;
        float* o = args.out; const long n = (long)T * D;
        for (long i = (long)blockIdx.x * 512 + threadIdx.x; i < n; i += (long)gridDim.x * 512) o[i] = (i == 0) ? vv : kk;
    }
#endif
#undef IN
#undef SEAM
}

#ifndef MK_ONE_LAUNCH
#define MK_ONE_LAUNCH 1
#endif
extern "C" void kernel_launch(void* const* d_in, const int* in_sizes, int n_in, void* d_out, int out_size, void* d_ws, size_t ws_size, hipStream_t stream) {
    static int grid = 0;
    if (grid == 0) {
        if (n_in != 24 || in_sizes[0] != T * D || out_size != T * D || ws_size < WS_END) { fprintf(stderr, "kernel_launch: unexpected shapes (n_in %d, in0 %d, out %d, ws %zu < %zu)\n", n_in, n_in > 0 ? in_sizes[0] : -1, out_size, ws_size, (size_t)WS_END); grid = -1; return; }
        int dev = 0, cus = 0, per_cu = 0;
        if (hipGetDevice(&dev) != hipSuccess || hipDeviceGetAttribute(&cus, hipDeviceAttributeMultiprocessorCount, dev) != hipSuccess) { grid = -1; return; }
        if (hipFuncSetAttribute((const void*)fwd_kernel, hipFuncAttributeMaxDynamicSharedMemorySize, LDS_BYTES) != hipSuccess) { fprintf(stderr, "kernel_launch: hipFuncSetAttribute failed\n"); grid = -1; return; }
        if (hipOccupancyMaxActiveBlocksPerMultiprocessor(&per_cu, (const void*)fwd_kernel, NWAVES * 64, LDS_BYTES) != hipSuccess || per_cu < 1) fprintf(stderr, "kernel_launch: occupancy query reports %d\n", per_cu);
        (void)hipGetLastError();
        grid = cus;
    }
    if (grid < 0) return;
    if (hipMemsetAsync((char*)d_ws + WS_CTL, 0, CTL_ZERO_BYTES, stream) != hipSuccess) return;
    Args a{};
    for (int i = 0; i < 24; ++i) a.in[i] = (const float*)d_in[i];
    a.out = (float*)d_out; a.ws = (unsigned char*)d_ws;
#if MK_ONE_LAUNCH
    a.ph_lo = 0; a.ph_hi = NPHASES;
    hipLaunchKernelGGL(fwd_kernel, dim3(grid), dim3(NWAVES * 64), LDS_BYTES, stream, a);
#else
    for (int p = 0; p < NPHASES; ++p) {
        const int k = (p - 1) % NPH_LAYER, l = (p - 1) / NPH_LAYER;
        if (p > 0 && k == 2 && l < 2) continue;
        a.ph_lo = p; a.ph_hi = p + 1;
        hipLaunchKernelGGL(fwd_kernel, dim3(grid), dim3(NWAVES * 64), LDS_BYTES, stream, a);
    }
#endif
    const hipError_t le = hipPeekAtLastError();
    if (le != hipSuccess) fprintf(stderr, "kernel_launch: launch failed: %s\n", hipGetErrorName(le));
}
```

```cpp
#define F8MASK 12
#define F8OMASK 12
#include <hip/hip_runtime.h>
#include <cstdio>
#include <cstdint>
namespace pg8 {
#define PG8_LAS __attribute__((address_space(3)))
typedef unsigned short bf16_t;
typedef short bf16x8 __attribute__((ext_vector_type(8)));
typedef float f32x4 __attribute__((ext_vector_type(4)));
typedef unsigned u32x4 __attribute__((ext_vector_type(4)));
constexpr int BM = 256, BK = 64, HALF = 128, HTB = HALF * BK * 2  , STAGE_BYTES = 8 * HTB, NXCD = 8, WGM = 8;

__host__ __device__ __forceinline__ int lds_byte(int r, int c) { const int st = (r >> 4) * 2 + (c >> 5), rr = r & 15, cc = c & 31, ob = rr * 64 + cc * 2; return st * 1024 + (ob ^ (((ob >> 9) & 1) << 5)); }
__host__ __device__ __forceinline__ void stage_rc(int b, int& R, int& C) { const int st = b / 1024, sb = b % 1024, swz = sb ^ (((sb >> 9) & 1) << 5); R = (st >> 1) * 16 + swz / 64; C = (st & 1) * 32 + (swz % 64) / 2; }
__host__ __device__ __forceinline__ int perm32(int rho) { const int n = rho >> 4, i = rho & 15; return 8 * (i >> 2) + 4 * n + (i & 3); }

typedef int pg8_v4i __attribute__((ext_vector_type(4))); typedef int pg8_v8i __attribute__((ext_vector_type(8)));
__device__ __forceinline__ pg8_v8i pg8_cat8(bf16x8 a, bf16x8 b) { return __builtin_shufflevector(__builtin_bit_cast(pg8_v4i, a), __builtin_bit_cast(pg8_v4i, b), 0, 1, 2, 3, 4, 5, 6, 7); }
struct Unit { int pm, pn, e; };
struct Gemm { const bf16_t* A; const bf16_t* Bt; int M, N, K; };

struct StaticOrder {
    static constexpr bool GATHER = false, F8 = false; static constexpr int SCALE_B = 127;
    int nM, nN, nwg, G, c;
    __host__ __device__ void init(int M, int N, int G_, int c_) { nM = M / BM; nN = N / BM; nwg = nM * nN; G = G_; c = c_; }
    __host__ __device__ bool next(int i, Unit& u) const {
        const long L = (long)i * G + c; if (L >= nwg) return false;
        int wgid = (int)L; { const int q = nwg / NXCD, r = nwg % NXCD, xcd = wgid % NXCD, off = wgid / NXCD; wgid = (xcd < r ? xcd * (q + 1) : r * (q + 1) + (xcd - r) * q) + off; }
        const int nig = WGM * nN, gid = wgid / nig, fm = gid * WGM, gsz = (nM - fm) < WGM ? (nM - fm) : WGM;
        u.pm = fm + ((wgid % nig) % gsz); u.pn = (wgid % nig) / gsz; return true;
    }
    __device__ __forceinline__ void a_ready(const Unit&) const {}
    __device__ __forceinline__ void done(const Unit&) const {}
};

__device__ __forceinline__ unsigned cvt_pk_bf16(float lo, float hi) { unsigned r; asm volatile("v_cvt_pk_bf16_f32 %0, %1, %2" : "=v"(r) : "v"(lo), "v"(hi)); return r; }
typedef float f32x2 __attribute__((ext_vector_type(2)));
__device__ __forceinline__ f32x2 gelu_pk(f32x2 v) {
    const f32x2 av = __builtin_elementwise_abs(v), d = av * 0.2316418882f + 1.0f;
    f32x2 t; t.x = __builtin_amdgcn_rcpf(d.x); t.y = __builtin_amdgcn_rcpf(d.y);
    f32x2 q = t * 0.5307027145f + (-0.7265760135f); q = q * t + 0.7107068705f; q = q * t + (-0.142248368f); q = q * t + 0.127414796f; q = q * t;
    const f32x2 s = (v * v) * (-0.72134752044f);
    f32x2 e; e.x = __builtin_amdgcn_exp2f(s.x); e.y = __builtin_amdgcn_exp2f(s.y);
    const f32x2 m = v * (q * e), r = v - m;
    f32x2 o; o.x = v.x < 0.f ? m.x : r.x; o.y = v.y < 0.f ? m.y : r.y; return o;
}

template <class Epi, class Sched, bool ALIGN_EPI = false, bool SP2 = false>
__device__ __forceinline__ void gemm_phase(PG8_LAS unsigned char* lds, const Gemm g, const Sched& S, const Epi& E) {
    int tid_ = threadIdx.x; asm volatile("" : "+v"(tid_));
    const int tid = tid_, wid = __builtin_amdgcn_readfirstlane(tid >> 6), lane = tid & 63, wr = wid >> 2, wc = wid & 3, fr = lane & 15, fq = lane >> 4;
    const int K = g.K, nt = K / BK;
    unsigned voffA[2], voffB[2];
#pragma unroll
    for (int i = 0; i < 2; ++i) { int R, C; stage_rc(tid * 16 + i * 8192, R, C); const int Rb = Epi::PERM ? ((R & ~31) + perm32(R & 31)) : R;
        voffA[i] = (unsigned)(R * K + C) * 2u; voffB[i] = (unsigned)(Rb * K + C) * 2u; }
    unsigned vAc[2][2], vAn[2][2];
    int gR[2], gC[2];
#pragma unroll
    for (int i = 0; i < 2; ++i) { stage_rc(tid * 16 + i * 8192, gR[i], gC[i]); }
    const size_t kstep = (size_t)(BK * 2);
    const size_t hstep = (size_t)HALF * K * 2;
        const unsigned ldsw = (unsigned)wid * 1024u;
    const int aoff = lds_byte(wr * 64 + fr, fq * 8), boff = lds_byte(wc * 32 + fr, fq * 8);
#define PG8_SA(b, h) (((b) * 2 + (h)) * HTB)
#define PG8_SB(b, h) ((4 + (b) * 2 + (h)) * HTB)
#define PG8_STAGE(bufoff, gbase, voff) do { _Pragma("unroll") for (int _i = 0; _i < 2; ++_i) \
        __builtin_amdgcn_global_load_lds((const unsigned*)((const char*)(gbase) + (voff)[_i]), (PG8_LAS unsigned*)(lds + (bufoff) + ldsw + _i * 8192), 16, 0, 0); } while (0)
#define PG8_STAGE_A(b, h, base, VS) do { if constexpr (Sched::GATHER) { PG8_STAGE(PG8_SA(b, h), base, VS[h]); } else { PG8_STAGE(PG8_SA(b, h), (base) + (h) * hstep, voffA); } } while (0)
#define PG8_STAGE_AN(b, h, base) do { if constexpr (Sched::GATHER) { unsigned vs_[2] = {last ? vAn[h][0] : vAc[h][0], last ? vAn[h][1] : vAc[h][1]}; PG8_STAGE(PG8_SA(b, h), base, vs_); } else { PG8_STAGE(PG8_SA(b, h), (base) + (h) * hstep, voffA); } } while (0)
#define PG8_LDA(dst, b, h) do { if constexpr (Sched::F8) { _Pragma("unroll") for (int m = 0; m < 4; ++m) { dst##8[m].lo = *(const PG8_LAS pg8_v4i*)(lds + PG8_SA(b, h) + aoff + m * 2048); dst##8[m].hi = *(const PG8_LAS pg8_v4i*)(lds + PG8_SA(b, h) + aoff + m * 2048 + 1024); } } \
        else { _Pragma("unroll") for (int m = 0; m < 4; ++m) _Pragma("unroll") for (int k = 0; k < 2; ++k) dst[m][k] = *(const PG8_LAS bf16x8*)(lds + PG8_SA(b, h) + aoff + m * 2048 + k * 1024); } } while (0)
#define PG8_LDB(dst, b, h) do { if constexpr (Sched::F8) { _Pragma("unroll") for (int n = 0; n < 2; ++n) { dst##8[n].lo = *(const PG8_LAS pg8_v4i*)(lds + PG8_SB(b, h) + boff + n * 2048); dst##8[n].hi = *(const PG8_LAS pg8_v4i*)(lds + PG8_SB(b, h) + boff + n * 2048 + 1024); } } \
        else { _Pragma("unroll") for (int n = 0; n < 2; ++n) _Pragma("unroll") for (int k = 0; k < 2; ++k) dst[n][k] = *(const PG8_LAS bf16x8*)(lds + PG8_SB(b, h) + boff + n * 2048 + k * 1024); } } while (0)
#define PG8_MMA(ai, bj, At, Bt) do { __builtin_amdgcn_s_setprio(1); if constexpr (Sched::F8) { \
        _Pragma("unroll") for (int m = 0; m < 4; ++m) _Pragma("unroll") for (int n = 0; n < 2; ++n) \
            asm volatile("v_mfma_scale_f32_16x16x128_f8f6f4 %0, %1, %2, %0, %3, %4 op_sel_hi:[0,0,0]" : "+v"(acc[ai][bj][m][n]) : "v"(Bt##8[n]), "v"(At##8[m]), "v"(sclB_), "v"(sclA_));     \
        } else { _Pragma("unroll") for (int m = 0; m < 4; ++m) _Pragma("unroll") for (int n = 0; n < 2; ++n) _Pragma("unroll") for (int k = 0; k < 2; ++k) \
        acc[ai][bj][m][n] = __builtin_amdgcn_mfma_f32_16x16x32_bf16(Bt[n][k], At[m][k], acc[ai][bj][m][n], 0, 0, 0); } __builtin_amdgcn_s_setprio(0); } while (0)
#define PG8_WAIT_V(n) asm volatile("s_waitcnt vmcnt(" #n ")" ::: "memory")
#define PG8_WAIT_L(n) asm volatile("s_waitcnt lgkmcnt(" #n ")" ::: "memory")
#define PG8_BAR __builtin_amdgcn_s_barrier()
#define PG8_SCHED __builtin_amdgcn_sched_barrier(0)
    Unit cur, nxt; int ui = 0;
    if (!S.next(0, cur)) return;
    f32x4 acc[2][2][4][2];
#pragma unroll
    for (int a = 0; a < 2; ++a)
#pragma unroll
        for (int b = 0; b < 2; ++b)
#pragma unroll
            for (int m = 0; m < 4; ++m)
#pragma unroll
                for (int n = 0; n < 2; ++n) acc[a][b][m][n] = (f32x4){0.f, 0.f, 0.f, 0.f};
    const int sclB_ = Sched::SCALE_B, sclA_ = 127;
    bf16x8 At[4][2], B0[2][2], B1[2][2]; pg8_v8i At8[4], B08[2], B18[2];
    const char* cA = S.aptr(cur); const char* cB = S.bptr(cur);
    S.a_ready(cur);
    if constexpr (Sched::GATHER) {
#pragma unroll
        for (int h = 0; h < 2; ++h)
#pragma unroll
            for (int i = 0; i < 2; ++i) { vAc[h][i] = S.rowoff(cur, h * HALF + gR[i]) + (unsigned)gC[i] * 2u; vAn[h][i] = vAc[h][i]; }
        asm volatile("s_waitcnt vmcnt(0)" ::: "memory");
    }
    if constexpr (SP2) {
        PG8_STAGE(PG8_SB(0, 0), cB, voffB); PG8_STAGE(PG8_SB(0, 1), cB + hstep, voffB); PG8_STAGE_A(0, 0, cA, vAc); PG8_STAGE_A(0, 1, cA, vAc);
        if (wr == 1) PG8_BAR;
        PG8_WAIT_V(2); PG8_BAR;
        PG8_STAGE(PG8_SB(1, 0), cB + kstep, voffB); PG8_STAGE_A(1, 0, cA + kstep, vAc); PG8_STAGE(PG8_SB(1, 1), cB + hstep + kstep, voffB);
        PG8_WAIT_V(6); PG8_BAR;
    } else {
        PG8_STAGE(PG8_SB(0, 0), cB, voffB); PG8_STAGE_A(0, 0, cA, vAc); PG8_STAGE(PG8_SB(0, 1), cB + hstep, voffB); PG8_STAGE_A(0, 1, cA, vAc);
        if (wr == 1) PG8_BAR;
        PG8_WAIT_V(4); PG8_BAR;
        PG8_STAGE(PG8_SB(1, 0), cB + kstep, voffB); PG8_STAGE_A(1, 0, cA + kstep, vAc); PG8_STAGE(PG8_SB(1, 1), cB + hstep + kstep, voffB);
        PG8_WAIT_V(6); PG8_BAR;
    }
    for (;;) {
        const bool has_next = S.next(ui + 1, nxt);
        const char* nA = has_next ? S.aptr(nxt) : cA; const char* nB = has_next ? S.bptr(nxt) : cB;
        if constexpr (Sched::GATHER) { if (has_next) {
#pragma unroll
            for (int h = 0; h < 2; ++h)
#pragma unroll
                for (int i = 0; i < 2; ++i) vAn[h][i] = S.rowoff(nxt, h * HALF + gR[i]) + (unsigned)gC[i] * 2u; } }
        for (int t = 0; t < nt; t += 2) {
            const bool last = (t == nt - 2);
            const char* a1 = cA + (size_t)(t + 1) * kstep;
            const char* a2 = last ? nA : cA + (size_t)(t + 2) * kstep; const char* b2 = last ? nB : cB + (size_t)(t + 2) * kstep;
            const char* a3 = a2 + kstep; const char* b3 = b2 + kstep;
            if (last && has_next) S.a_ready(nxt);
            if constexpr (SP2) {
            PG8_LDB(B0, 0, 0); PG8_LDB(B1, 0, 1); PG8_SCHED; PG8_LDA(At, 0, 0); PG8_STAGE_A(1, 1, a1, vAc);
            PG8_WAIT_V(8); PG8_WAIT_L(0); PG8_BAR; PG8_MMA(0, 0, At, B0); PG8_MMA(0, 1, At, B1); PG8_BAR; PG8_SCHED;
            PG8_LDA(At, 0, 1); PG8_STAGE(PG8_SB(0, 0), b2, voffB); PG8_STAGE(PG8_SB(0, 1), b2 + hstep, voffB); PG8_STAGE_AN(0, 0, a2);
            PG8_WAIT_V(8); PG8_WAIT_L(0); PG8_BAR; PG8_MMA(1, 0, At, B0); PG8_MMA(1, 1, At, B1); PG8_BAR; PG8_SCHED;
            PG8_LDB(B0, 1, 0); PG8_LDB(B1, 1, 1); PG8_SCHED; PG8_LDA(At, 1, 0); PG8_STAGE_AN(0, 1, a2);
            PG8_WAIT_V(8); PG8_WAIT_L(0); PG8_BAR; PG8_MMA(0, 0, At, B0); PG8_MMA(0, 1, At, B1); PG8_BAR; PG8_SCHED;
            PG8_LDA(At, 1, 1); PG8_STAGE(PG8_SB(1, 0), b3, voffB); PG8_STAGE(PG8_SB(1, 1), b3 + hstep, voffB); PG8_STAGE_AN(1, 0, a3);
            PG8_WAIT_V(8); PG8_WAIT_L(0); PG8_BAR; PG8_MMA(1, 0, At, B0); PG8_MMA(1, 1, At, B1); PG8_BAR; PG8_SCHED;
            } else {
            PG8_LDB(B0, 0, 0); PG8_SCHED; PG8_LDA(At, 0, 0); PG8_STAGE_A(1, 1, a1, vAc);
            PG8_WAIT_L(8); PG8_BAR; PG8_WAIT_L(0); PG8_MMA(0, 0, At, B0); PG8_BAR; PG8_SCHED;
            PG8_LDB(B1, 0, 1); PG8_STAGE(PG8_SB(0, 0), b2, voffB);
            PG8_BAR; PG8_WAIT_L(0); PG8_MMA(0, 1, At, B1); PG8_BAR;
            PG8_LDA(At, 0, 1); PG8_STAGE_AN(0, 0, a2);
            PG8_BAR; PG8_WAIT_L(0); PG8_MMA(1, 0, At, B0); PG8_BAR; PG8_SCHED;
            PG8_STAGE(PG8_SB(0, 1), b2 + hstep, voffB);
            PG8_WAIT_V(6); PG8_BAR; PG8_MMA(1, 1, At, B1); PG8_BAR;
            PG8_LDB(B0, 1, 0); PG8_SCHED; PG8_LDA(At, 1, 0); PG8_STAGE_AN(0, 1, a2);
            PG8_WAIT_L(8); PG8_BAR; PG8_WAIT_L(0); PG8_MMA(0, 0, At, B0); PG8_BAR; PG8_SCHED;
            PG8_LDB(B1, 1, 1); PG8_STAGE(PG8_SB(1, 0), b3, voffB);
            PG8_BAR; PG8_WAIT_L(0); PG8_MMA(0, 1, At, B1); PG8_BAR;
            PG8_LDA(At, 1, 1); PG8_STAGE_AN(1, 0, a3);
            PG8_BAR; PG8_WAIT_L(0); PG8_MMA(1, 0, At, B0); PG8_BAR; PG8_SCHED;
            PG8_STAGE(PG8_SB(1, 1), b3 + hstep, voffB);
            PG8_WAIT_V(6); PG8_BAR; PG8_MMA(1, 1, At, B1); PG8_BAR;
            }
        }
        if constexpr (ALIGN_EPI) { if (wr == 0) PG8_BAR; }
        if constexpr (!Epi::AFTER_DRAIN) { E(acc, cur, wr, wc, fr, fq); S.done(cur); }
        if (!has_next) break;
#pragma unroll
        for (int a = 0; a < 2; ++a)
#pragma unroll
            for (int b = 0; b < 2; ++b)
#pragma unroll
                for (int m = 0; m < 4; ++m)
#pragma unroll
                    for (int n = 0; n < 2; ++n) acc[a][b][m][n] = (f32x4){0.f, 0.f, 0.f, 0.f};
        cur = nxt; cA = nA; cB = nB; ++ui;
        if constexpr (Sched::GATHER) {
#pragma unroll
            for (int h = 0; h < 2; ++h)
#pragma unroll
                for (int i = 0; i < 2; ++i) vAc[h][i] = vAn[h][i]; }
        if constexpr (ALIGN_EPI) { if (wr == 1) PG8_BAR; }
    }
    PG8_WAIT_V(0);
    if constexpr (!ALIGN_EPI) { if (wr == 0) PG8_BAR; }
    PG8_BAR;
    if constexpr (Epi::AFTER_DRAIN) { E.fused(acc, cur, wr, wc, fr, fq, lds, wid, lane); S.done(cur); }
#undef PG8_SA
#undef PG8_SB
#undef PG8_STAGE
#undef PG8_STAGE_A
#undef PG8_STAGE_AN
#undef PG8_LDA
#undef PG8_LDB
#undef PG8_MMA
#undef PG8_WAIT_V
#undef PG8_WAIT_L
#undef PG8_BAR
#undef PG8_SCHED
}
}

constexpr int T = 8192, D = 2048, MIXW = 1536, MEMW = 512, NINA = 3584, DEPTH = 4, NE = 32, FF = 512, MEMT = 256;
constexpr int SLOTS = 24576;
constexpr float LN_EPS = 1e-5f;
constexpr float DN_ALPHA = 1.6817928305074292f;
constexpr float LOG2E = 1.4426950408889634f;
constexpr float QSCALE = 0.08838834764831845f * LOG2E;
constexpr int NWAVES = 8;

constexpr size_t MiB = 1u << 20;
constexpr size_t WS_CTL = 0, CTL_ZERO_BYTES = 1 * MiB;
constexpr size_t WS_WAIN = 2 * MiB, WS_WAOUT = 30 * MiB, WS_WBIN0 = 46 * MiB, WS_WKV = 54 * MiB, WS_WBIN1 = 66 * MiB, WS_WBOUT = 74 * MiB, WS_WMKV = 90 * MiB;
constexpr size_t WS_W13 = 106 * MiB, WS_W2 = 618 * MiB;
constexpr size_t WS_XB = 874 * MiB, WS_MEMB = 906 * MiB, WS_MEMKV = 907 * MiB, WS_Z = 910 * MiB, WS_KD = 966 * MiB, WS_VD = 990 * MiB, WS_CAT = 1014 * MiB;
constexpr size_t WS_XQ = 1206 * MiB, WS_ZQ = 1222 * MiB, WS_MEMQ = 1238 * MiB, WS_CATQ = 1246 * MiB;
constexpr size_t WS_Y = 1046 * MiB, WS_X1F = 1110 * MiB, WS_X1B = 1174 * MiB, WS_XF = 1206 * MiB, WS_XG = 1270 * MiB, WS_H = 1366 * MiB, WS_YB = 1390 * MiB, WS_OP = 1486 * MiB;
constexpr size_t WS_ROUTE = 1582 * MiB, WS_OP2 = 1583 * MiB, WS_ML = 1631 * MiB, WS_WR = 1634 * MiB, WS_TS = 1640 * MiB, WS_LIST = 1641 * MiB, WS_END = 1642 * MiB;
constexpr int CW_TMO = 0, CW_BAR = 4096, CW_CNT = 16384, CW_Q = 28672, CW_CONV = 29184, CW_DONE = 32768, CW_FIN = 40960;

constexpr int RING_OFF = 0, RING_BYTES = 131072;
constexpr int LDSCTL_OFF = 146432, MISC_OFF = LDSCTL_OFF + 320, TAB_OFF = LDSCTL_OFF + 512;
constexpr int LDS_BYTES = 147456;

#define GAS __attribute__((address_space(1)))
#define LAS __attribute__((address_space(3)))
typedef unsigned short bf16;
typedef unsigned v4u __attribute__((ext_vector_type(4)));
typedef unsigned v2u __attribute__((ext_vector_type(2)));
typedef float f32x4 __attribute__((ext_vector_type(4)));
typedef short bf16x8 __attribute__((ext_vector_type(8)));
typedef GAS unsigned gu32;
#define RLX_AGENT __ATOMIC_RELAXED, __HIP_MEMORY_SCOPE_AGENT
#define LDS_WAIT() asm volatile("s_waitcnt lgkmcnt(0)" ::: "memory")
#define VM_WAIT() asm volatile("s_waitcnt vmcnt(0)" ::: "memory")
__device__ __forceinline__ unsigned f2bf(float f) { unsigned u = __builtin_bit_cast(unsigned, f); return (u + 0x7fffu + ((u >> 16) & 1u)) >> 16; }
__device__ __forceinline__ unsigned pk2(float lo, float hi) { return f2bf(lo) | (f2bf(hi) << 16); }
__device__ __forceinline__ float bf2f(unsigned short b) { return __builtin_bit_cast(float, (unsigned)b << 16); }
__device__ __forceinline__ float bflo(unsigned w) { return __builtin_bit_cast(float, w << 16); }
__device__ __forceinline__ float bfhi(unsigned w) { return __builtin_bit_cast(float, w & 0xffff0000u); }
__device__ __forceinline__ float wave_sum(float v) {
#pragma unroll
    for (int o = 1; o < 64; o <<= 1) v += __shfl_xor(v, o);
    return v;
}

namespace pg8 {
struct DenseOrder {
    static constexpr bool GATHER = false, F8 = false; static constexpr int SCALE_B = 127;
    StaticOrder so; const char* A; const char* B; size_t astep, bstep;
    __device__ void init(const void* A_, const void* B_, int M, int N, int K, int G, int c) { so.init(M, N, G, c); A = (const char*)A_; B = (const char*)B_; astep = (size_t)256 * K * 2; bstep = astep; }
    __device__ __forceinline__ bool next(int i, Unit& u) const { u.e = 0; return so.next(i, u); }
    __device__ __forceinline__ const char* aptr(const Unit& u) const { return A + (size_t)u.pm * astep; }
    __device__ __forceinline__ const char* bptr(const Unit& u) const { return B + (size_t)u.pn * bstep; }
    __device__ __forceinline__ void a_ready(const Unit&) const {}
    __device__ __forceinline__ void done(const Unit&) const {}
};
struct DenseOrder8 {
    static constexpr bool GATHER = false, F8 = true; static constexpr int SCALE_B = 121;
    StaticOrder so; const char* A; const char* B; size_t astep, bstep;
    __device__ void init(const void* A_, const void* B_, int M, int N, int K, int G, int c) { so.init(M, N, G, c); A = (const char*)A_; B = (const char*)B_; astep = (size_t)256 * K * 2; bstep = astep; }
    __device__ __forceinline__ bool next(int i, Unit& u) const { u.e = 0; return so.next(i, u); }
    __device__ __forceinline__ const char* aptr(const Unit& u) const { return A + (size_t)u.pm * astep; }
    __device__ __forceinline__ const char* bptr(const Unit& u) const { return B + (size_t)u.pn * bstep; }
    __device__ __forceinline__ void a_ready(const Unit&) const {}
    __device__ __forceinline__ void done(const Unit&) const {}
};
struct DualOrder {
    static constexpr bool GATHER = false, F8 = false; static constexpr int SCALE_B = 127;
    StaticOrder so; int nwg2; const char* A; const char* B; const char* A2; const char* B2; size_t step;
    __device__ void init(const void* A_, const void* B_, int M, int N, int K, int G, int c, const void* A2_, const void* B2_, int nwg2_) { so.init(M, N, G, c); A = (const char*)A_; B = (const char*)B_; A2 = (const char*)A2_; B2 = (const char*)B2_; nwg2 = nwg2_; step = (size_t)256 * K * 2; }
    __device__ __forceinline__ bool next(int i, Unit& u) const { const int L = i * so.G + so.c; if (L < so.nwg) { u.e = 0; return so.next(i, u); } if (L - so.nwg >= nwg2) return false; u.e = 1; u.pm = 0; u.pn = L - so.nwg; return true; }
    __device__ __forceinline__ const char* aptr(const Unit& u) const { return u.e ? A2 : A + (size_t)u.pm * step; }
    __device__ __forceinline__ const char* bptr(const Unit& u) const { return (u.e ? B2 : B) + (size_t)u.pn * step; }
    __device__ __forceinline__ void a_ready(const Unit&) const {}
    __device__ __forceinline__ void done(const Unit&) const {}
};
struct DualOrder8 {
    static constexpr bool GATHER = false, F8 = true; static constexpr int SCALE_B = 121;
    StaticOrder so; int nwg2; const char* A; const char* B; const char* A2; const char* B2; size_t step;
    __device__ void init(const void* A_, const void* B_, int M, int N, int K, int G, int c, const void* A2_, const void* B2_, int nwg2_) { so.init(M, N, G, c); A = (const char*)A_; B = (const char*)B_; A2 = (const char*)A2_; B2 = (const char*)B2_; nwg2 = nwg2_; step = (size_t)256 * K * 2; }
    __device__ __forceinline__ bool next(int i, Unit& u) const { const int L = i * so.G + so.c; if (L < so.nwg) { u.e = 0; return so.next(i, u); } if (L - so.nwg >= nwg2) return false; u.e = 1; u.pm = 0; u.pn = L - so.nwg; return true; }
    __device__ __forceinline__ const char* aptr(const Unit& u) const { return u.e ? A2 : A + (size_t)u.pm * step; }
    __device__ __forceinline__ const char* bptr(const Unit& u) const { return (u.e ? B2 : B) + (size_t)u.pn * step; }
    __device__ __forceinline__ void a_ready(const Unit&) const {}
    __device__ __forceinline__ void done(const Unit&) const {}
};
struct MoeOrder {
    static constexpr bool GATHER = false, F8 = false; static constexpr int SCALE_B = 127;
    const PG8_LAS int* tstart; int ntn, G, c; const char* A; const char* W; size_t astep, wexp, wtile;
    __device__ __forceinline__ bool next(int i, Unit& u) const {
        const int L = i * G + c, total = tstart[32] * ntn; if (L >= total) return false;
        int wgid; { const int q = total / NXCD, r = total % NXCD, xcd = L % NXCD, off = L / NXCD; wgid = (xcd < r ? xcd * (q + 1) : r * (q + 1) + (xcd - r) * q) + off; }
        u.pm = wgid / ntn; u.pn = wgid - u.pm * ntn; int e = 0;
#pragma unroll
        for (int k = 1; k <= 31; ++k) e += (tstart[k] <= u.pm) ? 1 : 0;
        u.e = e; return true;
    }
    __device__ __forceinline__ const char* aptr(const Unit& u) const { return A + (size_t)u.pm * astep; }
    __device__ __forceinline__ const char* bptr(const Unit& u) const { return W + (size_t)u.e * wexp + (size_t)u.pn * wtile; }
    __device__ __forceinline__ void a_ready(const Unit&) const {}
    __device__ __forceinline__ void done(const Unit&) const {}
};

struct MoeOrder8 {
    static constexpr bool GATHER = false, F8 = true; static constexpr int SCALE_B = 121;
    const PG8_LAS int* tstart; int ntn, G, c; const char* A; const char* W; size_t astep, wexp, wtile;
    __device__ __forceinline__ bool next(int i, Unit& u) const {
        const int L = i * G + c, total = tstart[32] * ntn; if (L >= total) return false;
        int wgid; { const int q = total / NXCD, r = total % NXCD, xcd = L % NXCD, off = L / NXCD; wgid = (xcd < r ? xcd * (q + 1) : r * (q + 1) + (xcd - r) * q) + off; }
        u.pm = wgid / ntn; u.pn = wgid - u.pm * ntn; int e = 0;
#pragma unroll
        for (int k = 1; k <= 31; ++k) e += (tstart[k] <= u.pm) ? 1 : 0;
        u.e = e; return true;
    }
    __device__ __forceinline__ const char* aptr(const Unit& u) const { return A + (size_t)u.pm * astep; }
    __device__ __forceinline__ const char* bptr(const Unit& u) const { return W + (size_t)u.e * wexp + (size_t)u.pn * wtile; }
    __device__ __forceinline__ void a_ready(const Unit&) const {}
    __device__ __forceinline__ void done(const Unit&) const {}
};

struct MoeGatherOrder {
    static constexpr bool GATHER = true, F8 = true; static constexpr int SCALE_B = 121;
    const PG8_LAS int* tstart; const PG8_LAS int* cntl; const int* list; int ntn, G, c; const char* A; const char* W; size_t wexp, wtile; unsigned rowbytes;
    __device__ __forceinline__ bool next(int i, Unit& u) const {
        const int L = i * G + c, total = tstart[32] * ntn; if (L >= total) return false;
        int wgid; { const int q = total / NXCD, r = total % NXCD, xcd = L % NXCD, off = L / NXCD; wgid = (xcd < r ? xcd * (q + 1) : r * (q + 1) + (xcd - r) * q) + off; }
        u.pm = wgid / ntn; u.pn = wgid - u.pm * ntn; int e = 0;
#pragma unroll
        for (int k = 1; k <= 31; ++k) e += (tstart[k] <= u.pm) ? 1 : 0;
        u.e = e; return true;
    }
    __device__ __forceinline__ unsigned rowoff(const Unit& u, int r) const { const int rank = (u.pm - tstart[u.e]) * 256 + r; const int tok = list[u.e * 8192 + (rank < cntl[u.e] ? rank : 0)]; return (unsigned)tok * rowbytes; }
    __device__ __forceinline__ const char* aptr(const Unit&) const { return A; }
    __device__ __forceinline__ const char* bptr(const Unit& u) const { return W + (size_t)u.e * wexp + (size_t)u.pn * wtile; }
    __device__ __forceinline__ void a_ready(const Unit&) const {}
    __device__ __forceinline__ void done(const Unit&) const {}
};

typedef unsigned u32x2 __attribute__((ext_vector_type(2)));
struct EpiBf16X {
    static constexpr bool PERM = true, AFTER_DRAIN = false;
    int mode; bf16_t* p0; bf16_t* p1; bf16_t* p2; bf16_t* p3;
    const PG8_LAS int* tstart; const PG8_LAS int* cntl;
    __device__ __forceinline__ void operator()(const f32x4 (&acc)[2][2][4][2], const Unit& u, int wr, int wc, int fr, int fq) const {
#ifndef ATT_BF16
        if (mode == 1 && !u.e) {
            int tok0 = u.pm * BM + wr * 64 + fr, cc0 = wc * 32 + 8 * fq; asm volatile("" : "+v"(tok0), "+v"(cc0));
            if (u.pn >= 14) { const int colv = (u.pn - 14) * BM + cc0; unsigned char* vb = (unsigned char*)p2 + ((size_t)((colv >> 8) * 128 + (tok0 >> 6)) * 256 + (colv & 255)) * 64 + (tok0 & 63);
#pragma unroll
                for (int ai = 0; ai < 2; ++ai)
#pragma unroll
                    for (int m = 0; m < 4; ++m)
#pragma unroll
                        for (int bj = 0; bj < 2; ++bj) { const f32x4 v0 = acc[ai][bj][m][0], v1 = acc[ai][bj][m][1]; unsigned a_ = 0u, b_ = 0u;
                            a_ = __builtin_amdgcn_cvt_pk_fp8_f32(v0[0], v0[1], a_, false); a_ = __builtin_amdgcn_cvt_pk_fp8_f32(v0[2], v0[3], a_, true); b_ = __builtin_amdgcn_cvt_pk_fp8_f32(v1[0], v1[1], b_, false); b_ = __builtin_amdgcn_cvt_pk_fp8_f32(v1[2], v1[3], b_, true);
                            unsigned char* vp = vb + (size_t)(ai * 2) * 16384 + m * 16 + (size_t)bj * HALF * 64;
                            vp[0] = (unsigned char)a_; vp[64] = (unsigned char)(a_ >> 8); vp[128] = (unsigned char)(a_ >> 16); vp[192] = (unsigned char)(a_ >> 24);
                            vp[256] = (unsigned char)b_; vp[320] = (unsigned char)(b_ >> 8); vp[384] = (unsigned char)(b_ >> 16); vp[448] = (unsigned char)(b_ >> 24); }
                return; }
            if (u.pn >= 8) { unsigned char* kb = (unsigned char*)p1 + (size_t)tok0 * 1536 + (u.pn - 8) * BM + cc0;
#pragma unroll
                for (int ai = 0; ai < 2; ++ai)
#pragma unroll
                    for (int m = 0; m < 4; ++m)
#pragma unroll
                        for (int bj = 0; bj < 2; ++bj) { const f32x4 v0 = acc[ai][bj][m][0], v1 = acc[ai][bj][m][1]; unsigned a_ = 0u, b_ = 0u;
                            a_ = __builtin_amdgcn_cvt_pk_fp8_f32(v0[0], v0[1], a_, false); a_ = __builtin_amdgcn_cvt_pk_fp8_f32(v0[2], v0[3], a_, true); b_ = __builtin_amdgcn_cvt_pk_fp8_f32(v1[0], v1[1], b_, false); b_ = __builtin_amdgcn_cvt_pk_fp8_f32(v1[2], v1[3], b_, true);
                            u32x2 kk; kk.x = a_; kk.y = b_; *(u32x2*)(kb + (size_t)(ai * HALF + m * 16) * 1536 + bj * HALF) = kk; }
                return; }
            { unsigned char* qb = (unsigned char*)p0 + (WS_ZQ - WS_Z) + (size_t)tok0 * 2048 + u.pn * BM + cc0; bf16_t* zb = p0 + (size_t)tok0 * 2048 + u.pn * BM + cc0;
#pragma unroll
                for (int ai = 0; ai < 2; ++ai)
#pragma unroll
                    for (int m = 0; m < 4; ++m)
#pragma unroll
                        for (int bj = 0; bj < 2; ++bj) { const f32x4 v0 = acc[ai][bj][m][0] * QSCALE, v1 = acc[ai][bj][m][1] * QSCALE; unsigned a_ = 0u, b_ = 0u;
                            a_ = __builtin_amdgcn_cvt_pk_fp8_f32(v0[0], v0[1], a_, false); a_ = __builtin_amdgcn_cvt_pk_fp8_f32(v0[2], v0[3], a_, true); b_ = __builtin_amdgcn_cvt_pk_fp8_f32(v1[0], v1[1], b_, false); b_ = __builtin_amdgcn_cvt_pk_fp8_f32(v1[2], v1[3], b_, true);
                            const size_t o_ = (size_t)(ai * HALF + m * 16) * 2048 + bj * HALF;
                            u32x2 qq; qq.x = a_; qq.y = b_; *(u32x2*)(qb + o_) = qq;
                            if (u.pn >= 6) { u32x4 w; w.x = cvt_pk_bf16(v0[0], v0[1]); w.y = cvt_pk_bf16(v0[2], v0[3]); w.z = cvt_pk_bf16(v1[0], v1[1]); w.w = cvt_pk_bf16(v1[2], v1[3]); *(u32x4*)(zb + o_) = w; } }
                return; }
        }
#endif
        if (mode == 3) {
            int r0_ = wr * 64 + fr, c0_ = u.pn * BM + wc * 32 + 8 * fq; asm volatile("" : "+v"(r0_), "+v"(c0_));
            const int rlim = cntl[u.e] - (u.pm - tstart[u.e]) * BM;
            unsigned char* yb_ = (unsigned char*)p0 + (size_t)(u.pm * BM + r0_) * 2048 + c0_;
#pragma unroll
            for (int ai = 0; ai < 2; ++ai)
#pragma unroll
                for (int m = 0; m < 4; ++m) { if (r0_ + ai * HALF + m * 16 >= rlim) continue;
#pragma unroll
                    for (int bj = 0; bj < 2; ++bj) { const f32x4 v0 = acc[ai][bj][m][0] * 16.f, v1 = acc[ai][bj][m][1] * 16.f; unsigned a_ = 0u, b_ = 0u;
                        a_ = __builtin_amdgcn_cvt_pk_fp8_f32(v0[0], v0[1], a_, false); a_ = __builtin_amdgcn_cvt_pk_fp8_f32(v0[2], v0[3], a_, true); b_ = __builtin_amdgcn_cvt_pk_fp8_f32(v1[0], v1[1], b_, false); b_ = __builtin_amdgcn_cvt_pk_fp8_f32(v1[2], v1[3], b_, true);
                        u32x2 q_; q_.x = a_; q_.y = b_; *(u32x2*)(yb_ + (size_t)(ai * HALF + m * 16) * 2048 + bj * HALF) = q_; } }
            return; }
        bf16_t* base; int ldc, colt; bool act = false; float sc = 1.f;
        if (u.e && mode < 2) { base = p3 + (size_t)(u.pn >> 2) * (256 * 1024); ldc = 1024; colt = (u.pn & 3) * BM; }
        else if (mode == 0) { base = p0; ldc = 3584; colt = u.pn * BM; act = u.pn < 12; if (u.pn >= 12) sc = QSCALE; }
        else if (mode == 1) { if (u.pn < 8) { base = p0; ldc = 2048; colt = u.pn * BM; sc = QSCALE; }
                              else if (u.pn < 14) { base = p1; ldc = 1536; colt = (u.pn - 8) * BM; } else { base = p2; ldc = 1536; colt = (u.pn - 14) * BM; } }
        else { base = p0; ldc = 2048; colt = u.pn * BM; }
        const int row0 = u.pm * BM + wr * 64 + fr, col0 = colt + wc * 32 + 8 * fq;
        const int rlim = (mode == 3) ? cntl[u.e] - (u.pm - tstart[u.e]) * BM : BM;
#pragma unroll
        for (int ai = 0; ai < 2; ++ai)
#pragma unroll
            for (int m = 0; m < 4; ++m) { bf16_t* rowp = base + (size_t)(row0 + ai * HALF + m * 16) * ldc + col0;
                if (wr * 64 + fr + ai * HALF + m * 16 >= rlim) continue;
#pragma unroll
                for (int bj = 0; bj < 2; ++bj) { f32x4 v0 = acc[ai][bj][m][0], v1 = acc[ai][bj][m][1];
                    if (act) { f32x2 a = gelu_pk((f32x2){v0[0], v0[1]}), b = gelu_pk((f32x2){v0[2], v0[3]}), c = gelu_pk((f32x2){v1[0], v1[1]}), d = gelu_pk((f32x2){v1[2], v1[3]});
                        v0 = (f32x4){a.x, a.y, b.x, b.y}; v1 = (f32x4){c.x, c.y, d.x, d.y}; }
                    v0 = v0 * sc; v1 = v1 * sc; u32x4 w; w.x = cvt_pk_bf16(v0[0], v0[1]); w.y = cvt_pk_bf16(v0[2], v0[3]); w.z = cvt_pk_bf16(v1[0], v1[1]); w.w = cvt_pk_bf16(v1[2], v1[3]);
                    *(u32x4*)(rowp + bj * HALF) = w; } }
    }
};
struct EpiResBf16 {
    static constexpr bool PERM = true, AFTER_DRAIN = false;
    const bf16_t* xres; bf16_t* y; float alpha;
    __device__ __forceinline__ void operator()(const f32x4 (&acc)[2][2][4][2], const Unit& u, int wr, int wc, int fr, int fq) const {
        const int row0 = u.pm * BM + wr * 64 + fr, col0 = u.pn * BM + wc * 32 + 8 * fq;
#pragma unroll
        for (int ai = 0; ai < 2; ++ai)
#pragma unroll
            for (int m = 0; m < 4; ++m) { const size_t off = (size_t)(row0 + ai * HALF + m * 16) * 2048 + col0;
#pragma unroll
                for (int bj = 0; bj < 2; ++bj) { const u32x4 xr = *(const u32x4*)(xres + off + bj * HALF); const f32x4 v0 = acc[ai][bj][m][0], v1 = acc[ai][bj][m][1]; u32x4 w;
                    w.x = cvt_pk_bf16(__builtin_bit_cast(float, xr.x << 16) * alpha + v0[0], __builtin_bit_cast(float, xr.x & 0xffff0000u) * alpha + v0[1]);
                    w.y = cvt_pk_bf16(__builtin_bit_cast(float, xr.y << 16) * alpha + v0[2], __builtin_bit_cast(float, xr.y & 0xffff0000u) * alpha + v0[3]);
                    w.z = cvt_pk_bf16(__builtin_bit_cast(float, xr.z << 16) * alpha + v1[0], __builtin_bit_cast(float, xr.z & 0xffff0000u) * alpha + v1[1]);
                    w.w = cvt_pk_bf16(__builtin_bit_cast(float, xr.w << 16) * alpha + v1[2], __builtin_bit_cast(float, xr.w & 0xffff0000u) * alpha + v1[3]);
                    *(u32x4*)(y + off + bj * HALF) = w; } }
    }
};
struct EpiMoe1 {
    static constexpr bool PERM = true, AFTER_DRAIN = false;
    bf16_t* h; const PG8_LAS int* tstart; const PG8_LAS int* cntl;
    __device__ __forceinline__ void operator()(const f32x4 (&acc)[2][2][4][2], const Unit& u, int wr, int wc, int fr, int fq) const {
        const int row0 = u.pm * BM + wr * 64 + fr, col0 = u.pn * HALF + wc * 32 + 8 * fq;
        const int rlim = cntl[u.e] - (u.pm - tstart[u.e]) * BM;
#pragma unroll
        for (int ai = 0; ai < 2; ++ai)
#pragma unroll
            for (int m = 0; m < 4; ++m) { unsigned char* rowp = (unsigned char*)h + (size_t)(row0 + ai * HALF + m * 16) * 512 + col0; float o[8];
                if (wr * 64 + fr + ai * HALF + m * 16 >= rlim) continue;
#pragma unroll
                for (int n = 0; n < 2; ++n)
#pragma unroll
                    for (int x = 0; x < 4; ++x) { const float a = acc[ai][0][m][n][x], b = acc[ai][1][m][n][x];
                        o[n * 4 + x] = a * __builtin_amdgcn_rcpf(1.0f + __builtin_amdgcn_exp2f(-a * LOG2E)) * b; }
                unsigned lo = 0u, hi = 0u; lo = __builtin_amdgcn_cvt_pk_fp8_f32(o[0], o[1], lo, false); lo = __builtin_amdgcn_cvt_pk_fp8_f32(o[2], o[3], lo, true);
                hi = __builtin_amdgcn_cvt_pk_fp8_f32(o[4], o[5], hi, false); hi = __builtin_amdgcn_cvt_pk_fp8_f32(o[6], o[7], hi, true);
                typedef unsigned u32x2e __attribute__((ext_vector_type(2))); u32x2e w; w.x = lo; w.y = hi; *(u32x2e*)rowp = w; }
    }
};
}

namespace att {
using bf16x8 = __attribute__((ext_vector_type(8))) short;
using s16x4  = __attribute__((ext_vector_type(4))) short;
using f32x16 = __attribute__((ext_vector_type(16))) float;
using u32x4  = __attribute__((ext_vector_type(4))) unsigned;
constexpr int DH = 128, QBLK = 32, KVBLK = 64;
constexpr float THR2 = 8.f * 1.4426950408889634f;
constexpr size_t SHM_V = KVBLK * DH * 2, SHM_K = KVBLK * DH * 2, SHM_ATTN = 2 * SHM_V + 2 * SHM_K + NWAVES * 64 * 4;
constexpr int TAB_N = 160;
#define KSWZ(row, colB) ((row) * 256 + ((colB) ^ (((row) & 7) << 4)))
#define SBAR() __builtin_amdgcn_sched_barrier(0)
__device__ __forceinline__ int crow(int r, int hi) { return (r & 3) + 8 * (r >> 2) + 4 * hi; }
__device__ __forceinline__ unsigned cvtpk(float lo, float hi) { unsigned r; asm volatile("v_cvt_pk_bf16_f32 %0, %1, %2" : "=v"(r) : "v"(lo), "v"(hi)); return r; }

__device__ __forceinline__ void partialSM(f32x16& p0, f32x16& p1, float& m_reg, float& mn, float& alpha) {
  float pmax = p0[0];
#pragma unroll
  for (int r = 1; r < 16; ++r) pmax = fmaxf(pmax, p0[r]);
#pragma unroll
  for (int r = 0; r < 16; ++r) pmax = fmaxf(pmax, p1[r]);
  { auto rr = __builtin_amdgcn_permlane32_swap(__float_as_uint(pmax), __float_as_uint(pmax), false, false);
    pmax = fmaxf(__uint_as_float(rr[0]), __uint_as_float(rr[1])); }
  if (__builtin_expect(__all(pmax - m_reg <= THR2), 1)) { mn = m_reg; alpha = 1.f; }
  else { mn = fmaxf(m_reg, pmax); alpha = __builtin_amdgcn_exp2f(m_reg - mn); m_reg = mn; }
#pragma unroll
  for (int r = 0; r < 16; ++r) p0[r] = p0[r] - mn;
#pragma unroll
  for (int r = 0; r < 16; ++r) p1[r] = p1[r] - mn;
#pragma unroll
  for (int r = 0; r < 16; ++r) p0[r] = __builtin_amdgcn_exp2f(p0[r]);
}
__device__ __forceinline__ void finishSM(f32x16& p0, f32x16& p1, float alpha, float& l_reg, bf16x8& pa0, bf16x8& pa1, bf16x8& pa2, bf16x8& pa3) {
#pragma unroll
  for (int r = 0; r < 16; ++r) p1[r] = __builtin_amdgcn_exp2f(p1[r]);
  float ps = 0;
#pragma unroll
  for (int r = 0; r < 16; ++r) ps += p0[r];
#pragma unroll
  for (int r = 0; r < 16; ++r) ps += p1[r];
  { auto rr = __builtin_amdgcn_permlane32_swap(__float_as_uint(ps), __float_as_uint(ps), false, false);
    ps = __uint_as_float(rr[0]) + __uint_as_float(rr[1]); }
  l_reg = l_reg * alpha + ps;
#define PK4(P, BASE, OUT) do { unsigned a0 = cvtpk(P[BASE + 0], P[BASE + 1]), a1 = cvtpk(P[BASE + 2], P[BASE + 3]);   \
    unsigned b0 = cvtpk(P[BASE + 4], P[BASE + 5]), b1 = cvtpk(P[BASE + 6], P[BASE + 7]);                              \
    auto r0 = __builtin_amdgcn_permlane32_swap(a0, b0, false, false); auto r1 = __builtin_amdgcn_permlane32_swap(a1, b1, false, false); \
    u32x4 w = {r0[0], r1[0], r0[1], r1[1]}; OUT = *reinterpret_cast<bf16x8*>(&w); } while (0)
  PK4(p0, 0, pa0); PK4(p0, 8, pa1); PK4(p1, 0, pa2); PK4(p1, 8, pa3);
#undef PK4
}
__device__ __forceinline__ void qkt(f32x16& p0, f32x16& p1, const char* Ks, const bf16x8* qr, int r32, int hi) {
  p0 = f32x16{}; p1 = f32x16{};
#pragma unroll
  for (int d0 = 0; d0 < 8; ++d0) { const int cb = (d0 * 16 + hi * 8) * 2;
    bf16x8 b0 = *reinterpret_cast<const bf16x8*>(Ks + KSWZ(r32, cb));
    bf16x8 b1 = *reinterpret_cast<const bf16x8*>(Ks + KSWZ(32 + r32, cb));
    p0 = __builtin_amdgcn_mfma_f32_32x32x16_bf16(b0, qr[d0], p0, 0, 0, 0);
    p1 = __builtin_amdgcn_mfma_f32_32x32x16_bf16(b1, qr[d0], p1, 0, 0, 0); }
}
__device__ __forceinline__ int v_st(int k, int c) { const int kk = (k & ~0xC) | ((k & 4) << 1) | ((k & 8) >> 1); return ((kk >> 3) * 4 + (c >> 5)) * 512 + ((kk & 7) * 32 + (c & 31)) * 2; }
__device__ __forceinline__ int v_rd_base(int lane) { return ((lane & 3) << 3) | (((lane >> 2) & 3) << 6) | (((lane >> 4) & 1) << 5) | (((lane >> 5) & 1) << 8); }
constexpr int v_rd_off(int d0, int ks, int half) { return d0 * 512 + ks * 4096 + half * 2048; }
template <int OFF> __device__ __forceinline__ s16x4 tr_read(int vb) {
  s16x4 r; asm volatile("ds_read_b64_tr_b16 %0, %1 offset:%2" : "=&v"(r) : "v"(vb), "i"(OFF) : "memory"); return r;
}
template <int D0> __device__ __forceinline__ void pv_one(f32x16& od, int vb, bf16x8 pa0, bf16x8 pa1, bf16x8 pa2, bf16x8 pa3) {
  const s16x4 l0 = tr_read<v_rd_off(D0, 0, 0)>(vb), h0 = tr_read<v_rd_off(D0, 0, 1)>(vb), l1 = tr_read<v_rd_off(D0, 1, 0)>(vb), h1 = tr_read<v_rd_off(D0, 1, 1)>(vb);
  const s16x4 l2 = tr_read<v_rd_off(D0, 2, 0)>(vb), h2 = tr_read<v_rd_off(D0, 2, 1)>(vb), l3 = tr_read<v_rd_off(D0, 3, 0)>(vb), h3 = tr_read<v_rd_off(D0, 3, 1)>(vb);
  asm volatile("s_waitcnt lgkmcnt(0)" ::: "memory"); SBAR();
#define PK(L, H) (bf16x8){L[0], L[1], L[2], L[3], H[0], H[1], H[2], H[3]}
  od = __builtin_amdgcn_mfma_f32_32x32x16_bf16(pa0, PK(l0, h0), od, 0, 0, 0);
  od = __builtin_amdgcn_mfma_f32_32x32x16_bf16(pa1, PK(l1, h1), od, 0, 0, 0);
  od = __builtin_amdgcn_mfma_f32_32x32x16_bf16(pa2, PK(l2, h2), od, 0, 0, 0);
  od = __builtin_amdgcn_mfma_f32_32x32x16_bf16(pa3, PK(l3, h3), od, 0, 0, 0);
#undef PK
}
__device__ __forceinline__ void pv_d0(f32x16* o, int vb, bf16x8 pa0, bf16x8 pa1, bf16x8 pa2, bf16x8 pa3) {
  pv_one<0>(o[0], vb, pa0, pa1, pa2, pa3); pv_one<1>(o[1], vb, pa0, pa1, pa2, pa3); pv_one<2>(o[2], vb, pa0, pa1, pa2, pa3); pv_one<3>(o[3], vb, pa0, pa1, pa2, pa3);
}
template <int MODE> __device__ __forceinline__ void post_scores(f32x16& p0, f32x16& p1, int t, int qrow0, int r32, int hi, const float* tab, float cfar) {
  if constexpr (MODE == 1) {
    const int cw = qrow0 >> 6;
    if (t > cw) {
#pragma unroll
      for (int r = 0; r < 16; ++r) { p0[r] = -INFINITY; p1[r] = -INFINITY; }
    } else if (qrow0 - (64 * t + 63) >= 91) {
#pragma unroll
      for (int r = 0; r < 16; ++r) { p0[r] += cfar; p1[r] += cfar; }
    } else {
      const int base = qrow0 + r32 - 64 * t + 63;
#pragma unroll
      for (int r = 0; r < 16; ++r) { const int i0 = base - crow(r, hi); const int i1 = i0 - 32;
        p0[r] += tab[i0 < TAB_N - 1 ? i0 : TAB_N - 1]; p1[r] += tab[i1 < TAB_N - 1 ? i1 : TAB_N - 1]; }
    }
  }
}

template <int MODE>
__device__ __forceinline__ void attn_body(const bf16* __restrict__ Qb, int ldq, const bf16* __restrict__ Kh, const bf16* __restrict__ Vh, int ldk,
                                          bf16* Ob, float* Of, int ldo, int NT, int q0abs, const float* tab, float cfar, char* lds) {
  int tid_ = threadIdx.x; asm volatile("" : "+v"(tid_));
  const int tid = tid_, wid = tid >> 6, lane = tid & 63, r32 = lane & 31, hi = lane >> 5;
  char* V_lds = lds; char* K_lds = lds + 2 * SHM_V;
  float* ws = (float*)(lds + 2 * SHM_V + 2 * SHM_K) + wid * 64; float* li_l = ws; float* al_l = ws + 32;
  float m_reg = -1e30f, l_reg = 0; f32x16 o[4] = {}; bf16x8 qr[8];
  const int qrow0 = q0abs + wid * QBLK;
  const bf16* Qw = Qb + (long)(wid * QBLK + r32) * ldq + hi * 8;
#pragma unroll
  for (int d0 = 0; d0 < 8; ++d0) qr[d0] = *reinterpret_cast<const bf16x8*>(Qw + d0 * 16);
  const int sr = tid >> 4, sc = (tid & 15) * 8, vst0 = v_st(sr, sc), vst1 = v_st(32 + sr, sc);
  const int vb0 = (int)(uintptr_t)V_lds + v_rd_base(lane);
  struct { bf16x8 vs0, vs1, ks0, ks1; } sr_[2];
#define SLOAD(i, k0) do { sr_[i].vs0 = *reinterpret_cast<const bf16x8*>(&Vh[(long)((k0) + sr) * ldk + sc]); sr_[i].vs1 = *reinterpret_cast<const bf16x8*>(&Vh[(long)((k0) + 32 + sr) * ldk + sc]); \
    sr_[i].ks0 = *reinterpret_cast<const bf16x8*>(&Kh[(long)((k0) + sr) * ldk + sc]); sr_[i].ks1 = *reinterpret_cast<const bf16x8*>(&Kh[(long)((k0) + 32 + sr) * ldk + sc]); } while (0)
#define SWRITE(b, i) do { *(bf16x8*)(V_lds + (b) * SHM_V + vst0) = sr_[i].vs0;          \
    *(bf16x8*)(V_lds + (b) * SHM_V + vst1) = sr_[i].vs1; const int kc = sc * 2;               \
    *(bf16x8*)(K_lds + (b) * SHM_K + KSWZ(sr, kc)) = sr_[i].ks0;                       \
    *(bf16x8*)(K_lds + (b) * SHM_K + KSWZ(32 + sr, kc)) = sr_[i].ks1; } while (0)
#define SWAIT() asm volatile("s_waitcnt vmcnt(4)" ::: "memory")
#define RESC(a) do { if (__any((a) < 1.f)) { if (hi == 0) al_l[r32] = (a); asm volatile("s_waitcnt lgkmcnt(0)" ::: "memory"); \
    _Pragma("unroll") for (int d = 0; d < 4; ++d) _Pragma("unroll") for (int r = 0; r < 16; ++r) o[d][r] *= al_l[crow(r, hi)]; } } while (0)
  f32x16 pA0, pA1, pB0, pB1; float mnA, mnB, alA, alB; bf16x8 pa0, pa1, pa2, pa3;
  constexpr int SE = 0, SO = 1;
  SLOAD(SE, 0); asm volatile("s_waitcnt vmcnt(0)" ::: "memory"); SWRITE(0, SE); __syncthreads();
  qkt(pA0, pA1, K_lds, qr, r32, hi); post_scores<MODE>(pA0, pA1, 0, qrow0, r32, hi, tab, cfar); partialSM(pA0, pA1, m_reg, mnA, alA);
  SLOAD(SO, KVBLK); if (2 < NT) SLOAD(SE, 2 * KVBLK);
  SWAIT(); SWRITE(1, SO); __syncthreads();
  for (int j = 1; j + 1 < NT; j += 2) {
    SBAR(); qkt(pB0, pB1, K_lds + SHM_K, qr, r32, hi); post_scores<MODE>(pB0, pB1, j, qrow0, r32, hi, tab, cfar);
    finishSM(pA0, pA1, alA, l_reg, pa0, pa1, pa2, pa3); SBAR();
    SLOAD(SO, (j + 2) * KVBLK); SBAR();
    pv_d0(o, vb0, pa0, pa1, pa2, pa3); partialSM(pB0, pB1, m_reg, mnB, alB);
    __syncthreads(); SWAIT(); SWRITE(0, SE);
    RESC(alB); __syncthreads();
    SBAR(); qkt(pA0, pA1, K_lds, qr, r32, hi); post_scores<MODE>(pA0, pA1, j + 1, qrow0, r32, hi, tab, cfar);
    finishSM(pB0, pB1, alB, l_reg, pa0, pa1, pa2, pa3); SBAR();
    if (j + 3 < NT) SLOAD(SE, (j + 3) * KVBLK); SBAR();
    pv_d0(o, vb0 + (int)SHM_V, pa0, pa1, pa2, pa3); partialSM(pA0, pA1, m_reg, mnA, alA);
    __syncthreads(); SWAIT(); SWRITE(1, SO);
    RESC(alA); __syncthreads();
  }
  SBAR(); qkt(pB0, pB1, K_lds + SHM_K, qr, r32, hi); post_scores<MODE>(pB0, pB1, NT - 1, qrow0, r32, hi, tab, cfar);
  finishSM(pA0, pA1, alA, l_reg, pa0, pa1, pa2, pa3); SBAR();
  pv_d0(o, vb0, pa0, pa1, pa2, pa3); partialSM(pB0, pB1, m_reg, mnB, alB);
  __syncthreads(); RESC(alB);
  finishSM(pB0, pB1, alB, l_reg, pa0, pa1, pa2, pa3); SBAR();
  pv_d0(o, vb0 + (int)SHM_V, pa0, pa1, pa2, pa3);
  if (hi == 0) li_l[r32] = l_reg; asm volatile("s_waitcnt lgkmcnt(0)" ::: "memory");
  float rli[16];
#pragma unroll
  for (int r = 0; r < 16; ++r) rli[r] = __builtin_amdgcn_rcpf(li_l[crow(r, hi)]);
  if constexpr (MODE == 0) {
    bf16* Ow = Ob + (long)(wid * QBLK) * ldo;
#pragma unroll
    for (int r = 0; r < 16; ++r) { const int orow = crow(r, hi);
#pragma unroll
      for (int d0 = 0; d0 < 4; ++d0) Ow[(long)orow * ldo + d0 * 32 + r32] = (bf16)f2bf(o[d0][r] * rli[r]); }
  } else {
    float* Ow = Of + (long)(wid * QBLK) * ldo;
#pragma unroll
    for (int r = 0; r < 16; ++r) { const int orow = crow(r, hi);
#pragma unroll
      for (int d0 = 0; d0 < 4; ++d0) Ow[(long)orow * ldo + d0 * 32 + r32] = o[d0][r] * rli[r]; }
  }
  __syncthreads();
#undef SLOAD
#undef SWRITE
#undef SWAIT
#undef RESC
}
}

#define XB_TMO      128
#define XB_XCNT(j)  (256  + 64 * (j))
#define XB_XSUB(j)  (1280 + 64 * (j))
#define XB_XGEN(j)  (2304 + 64 * (j))
#define XB_TOP      3328
#define XB_TOPGEN   3392
#define XCD_BAR_WORDS 3456
#define XB_SPIN_CAP (1u << 18)

__device__ __forceinline__ unsigned xb_ld(unsigned* p)              { return __hip_atomic_load(p, __ATOMIC_RELAXED, __HIP_MEMORY_SCOPE_AGENT); }
__device__ __forceinline__ unsigned xb_add(unsigned* p, unsigned v) { return __hip_atomic_fetch_add(p, v, __ATOMIC_RELAXED, __HIP_MEMORY_SCOPE_AGENT); }
__device__ __forceinline__ unsigned xb_xcc_id() { return (unsigned)__builtin_amdgcn_s_getreg((3 << 11) | 20) & 0xFu; }
#define XB_SPIN(cond, bar) do { unsigned _sp = 0; while (cond) { __builtin_amdgcn_s_sleep(1); \
    if ((++_sp & 255u) == 0u) { if (xb_ld(&(bar)[XB_TMO])) break; if (_sp > XB_SPIN_CAP) { atomicAdd(&(bar)[XB_TMO], 1u); break; } } } } while (0)

struct XcdBarrier {
    unsigned* bar; unsigned x;
    volatile LAS unsigned* st;
};

__device__ __forceinline__ XcdBarrier xcd_barrier_post(unsigned* bar, volatile LAS unsigned* st) {
    XcdBarrier b; b.bar = bar; b.x = xb_xcc_id(); b.st = st;
    if (threadIdx.x == 0) (void)xb_add(&bar[XB_XCNT(b.x)], 1u);
    return b;
}
__device__ __forceinline__ void xcd_barrier_complete(unsigned* bar, unsigned x, unsigned& nloc, unsigned& nx) {
    const unsigned G = gridDim.x * gridDim.y * gridDim.z;
    unsigned sum, cnt, mine, sp = 0u;
    for (;;) {
        sum = 0u; cnt = 0u; mine = 0u;
#pragma unroll
        for (unsigned j = 0; j < 16; ++j) { const unsigned c = xb_ld(&bar[XB_XCNT(j)]); sum += c; cnt += (c > 0u) ? 1u : 0u; mine = (j == x) ? c : mine; }
        if (sum == G) break;
        __builtin_amdgcn_s_sleep(1);
        if ((++sp & 255u) == 0u) { if (xb_ld(&bar[XB_TMO])) break; if (sp > XB_SPIN_CAP) { atomicAdd(&bar[XB_TMO], 1u); break; } }
    }
    nloc = mine > 0u ? mine : 1u; nx = cnt > 0u ? cnt : 1u;
}

__device__ __forceinline__ void xcd_barrier(const XcdBarrier& b) {
    asm volatile("s_waitcnt vmcnt(0)" ::: "memory");
    __syncthreads();
    if (threadIdx.x == 0) {
        unsigned* bar = b.bar;
        __builtin_amdgcn_s_waitcnt(0);
        unsigned nloc = b.st[0], nx = b.st[1];
        if (nloc == 0u) { xcd_barrier_complete(bar, b.x, nloc, nx); b.st[0] = nloc; b.st[1] = nx; }
        const unsigned old = xb_add(&bar[XB_XSUB(b.x)], 1u);
        const unsigned gen = old / nloc;
        if (old + 1u == (gen + 1u) * nloc) {
            __builtin_amdgcn_fence(__ATOMIC_RELEASE, "agent");
            asm volatile("s_waitcnt vmcnt(0)" ::: "memory");
            const unsigned og = xb_add(&bar[XB_TOP], 1u);
            const unsigned tg = og / nx;
            if (og + 1u == (tg + 1u) * nx) xb_add(&bar[XB_TOPGEN], 1u);
            else XB_SPIN(xb_ld(&bar[XB_TOPGEN]) == tg, bar);
            __builtin_amdgcn_fence(__ATOMIC_ACQUIRE, "agent");
            xb_add(&bar[XB_XGEN(b.x)], 1u);
            asm volatile("s_waitcnt vmcnt(0)" ::: "memory");
        } else {
            XB_SPIN(xb_ld(&bar[XB_XGEN(b.x)]) == gen, bar);
            __builtin_amdgcn_fence(__ATOMIC_ACQUIRE, "agent");
            asm volatile("s_waitcnt vmcnt(0)" ::: "memory");
        }
    }
    __syncthreads();
}


struct Args { const float* in[24]; float* out; unsigned char* ws; int ph_lo, ph_hi; };
enum { I_X = 0, I_MEM, I_AWIN, I_ALNG, I_ALNB, I_AWS, I_ABS, I_AWOUT, I_BWIN, I_BLAM, I_BSUBG, I_BWOUT, I_WKV, I_RELB, I_MEMWKV, I_LNG, I_LNB,
       I_WG1, I_BG1, I_WG2, I_BG2, I_W1, I_W3, I_W2 };
constexpr int NPH_LAYER = 9, NPHASES = 1 + DEPTH * NPH_LAYER;

struct Frame {
    LAS unsigned char* lds; char* ldsg;
    gu32* ctl; unsigned char* ws;
    int tid, lane, wave, G, c;
};

__device__ __forceinline__ void transpose_item(const float* W, int K, int N, bf16* WT, int drow0, LAS float* scr, int k0, int n0, int lane) {
#pragma unroll 8
    for (int i = 0; i < 32; ++i) { const int kk = 2 * i + (lane >> 5); scr[kk * 33 + (lane & 31)] = W[(size_t)(k0 + kk) * N + n0 + (lane & 31)]; }
    LDS_WAIT(); asm volatile("" ::: "memory");
    const int c = lane & 7;
#pragma unroll
    for (int j = 0; j < 4; ++j) { const int n = (lane >> 3) + 8 * j; const LAS float* s = scr + (8 * c) * 33 + n;
        v4u o; o.x = pk2(s[0 * 33], s[1 * 33]); o.y = pk2(s[2 * 33], s[3 * 33]); o.z = pk2(s[4 * 33], s[5 * 33]); o.w = pk2(s[6 * 33], s[7 * 33]);
        *(GAS v4u*)(WT + (size_t)(drow0 + n) * K + k0 + 8 * c) = o; }
    LDS_WAIT(); asm volatile("" ::: "memory");
}
__device__ __forceinline__ void transpose_item_fast(const float* W, int K, int N, bf16* WT, int drow0, LAS float* scr, int k0, int n0, int lane) {
    float t[32];
#pragma unroll
    for (int i = 0; i < 32; ++i) t[i] = W[(size_t)(k0 + 2 * i + (lane >> 5)) * N + n0 + (lane & 31)];
#pragma unroll
    for (int i = 0; i < 32; i += 8) asm volatile("" : "+v"(t[i]), "+v"(t[i + 1]), "+v"(t[i + 2]), "+v"(t[i + 3]), "+v"(t[i + 4]), "+v"(t[i + 5]), "+v"(t[i + 6]), "+v"(t[i + 7]));
#pragma unroll
    for (int i = 0; i < 32; ++i) scr[(2 * i + (lane >> 5)) * 33 + (lane & 31)] = t[i];
    LDS_WAIT(); asm volatile("" ::: "memory");
    const int c = lane & 7;
#pragma unroll
    for (int j = 0; j < 4; ++j) { const int n = (lane >> 3) + 8 * j; const LAS float* s = scr + (8 * c) * 33 + n;
        v4u o; o.x = pk2(s[0 * 33], s[1 * 33]); o.y = pk2(s[2 * 33], s[3 * 33]); o.z = pk2(s[4 * 33], s[5 * 33]); o.w = pk2(s[6 * 33], s[7 * 33]);
        *(GAS v4u*)(WT + (size_t)(drow0 + n) * K + k0 + 8 * c) = o; }
    LDS_WAIT(); asm volatile("" ::: "memory");
}
__device__ __forceinline__ void transpose_item_fp8(const float* W, int K, int N, unsigned char* WT, int drow0, LAS float* scr, int k0, int n0, int lane) {
    float t[32];
#pragma unroll
    for (int i = 0; i < 32; ++i) t[i] = W[(size_t)(k0 + 2 * i + (lane >> 5)) * N + n0 + (lane & 31)];
#pragma unroll
    for (int i = 0; i < 32; i += 8) asm volatile("" : "+v"(t[i]), "+v"(t[i + 1]), "+v"(t[i + 2]), "+v"(t[i + 3]), "+v"(t[i + 4]), "+v"(t[i + 5]), "+v"(t[i + 6]), "+v"(t[i + 7]));
#pragma unroll
    for (int i = 0; i < 32; ++i) scr[(2 * i + (lane >> 5)) * 33 + (lane & 31)] = t[i];
    LDS_WAIT(); asm volatile("" ::: "memory");
    const int c = lane & 7;
#pragma unroll
    for (int j = 0; j < 4; ++j) { const int n = (lane >> 3) + 8 * j; const LAS float* s = scr + (8 * c) * 33 + n;
        unsigned lo = 0u, hi = 0u;
        lo = __builtin_amdgcn_cvt_pk_fp8_f32(s[0 * 33] * 64.f, s[1 * 33] * 64.f, lo, false); lo = __builtin_amdgcn_cvt_pk_fp8_f32(s[2 * 33] * 64.f, s[3 * 33] * 64.f, lo, true);
        hi = __builtin_amdgcn_cvt_pk_fp8_f32(s[4 * 33] * 64.f, s[5 * 33] * 64.f, hi, false); hi = __builtin_amdgcn_cvt_pk_fp8_f32(s[6 * 33] * 64.f, s[7 * 33] * 64.f, hi, true);
        v2u o; o.x = lo; o.y = hi; *(GAS v2u*)(WT + (size_t)(drow0 + n) * K + k0 + 8 * c) = o; }
    LDS_WAIT(); asm volatile("" ::: "memory");
}
#ifndef CDRAIN
#define CDRAIN 8
#endif
#ifndef CSRV
#define CSRV 4
#endif
#ifndef CSRVA
#define CSRVA 32
#endif
#ifndef STOPU
#define STOPU 64
#endif
#ifndef QX
#define QX 6
#endif
#ifndef QA
#define QA 14
#endif
#ifndef QM
#define QM 7
#endif
#ifndef QB
#define QB 4
#endif
constexpr int NQ = 7, MOE_ITEMS = 3 * 32 * 512;
__device__ __forceinline__ int conv_qsize(int q) { return (q & 1) ? (q == 1 ? 5632 : (q == 3 ? 7168 : 4096)) : MOE_ITEMS; }
__device__ __forceinline__ void conv_item(Frame& F, const Args& a, int q, int it) {
    LAS float* scr = (LAS float*)(F.lds + RING_OFF + F.wave * 16384);
    if (q & 1) {
        const float* src; bf16* dst; int N, r = it;
        if (q == 1) { if (r < 3584) { N = 3584; src = a.in[I_AWIN] + (size_t)2048 * 3584; dst = (bf16*)(F.ws + WS_WAIN) + (size_t)2048 * 3584; } else { r -= 3584; N = 2048; src = a.in[I_AWOUT] + (size_t)2048 * 2048; dst = (bf16*)(F.ws + WS_WAOUT) + (size_t)2048 * 2048; } }
        else if (q == 3) { if (r < 2048) { N = 2048; src = a.in[I_BWIN]; dst = (bf16*)(F.ws + WS_WBIN0); } else if ((r -= 2048) < 3072) { N = 3072; src = a.in[I_WKV]; dst = (bf16*)(F.ws + WS_WKV); } else { r -= 3072; N = 2048; src = a.in[I_BWOUT]; dst = (bf16*)(F.ws + WS_WBOUT); } }
        else { if (r < 2048) { N = 2048; src = a.in[I_BWIN] + (size_t)2048 * 2048; dst = (bf16*)(F.ws + WS_WBIN1); } else { r -= 2048; N = 2048; src = a.in[I_BWOUT] + (size_t)2048 * 2048; dst = (bf16*)(F.ws + WS_WBOUT) + (size_t)2048 * 2048; } }
        const int nblk = N / 32, kb = r / nblk, nb = r - kb * nblk;
        transpose_item_fast(src, 2048, N, dst, 32 * nb, scr, 64 * kb, 32 * nb, F.lane);
        return;
    }
    const int L = q >> 1, seg = it >> 14, r0 = it & 16383, e = r0 >> 9, r = r0 & 511, mat = L * 32 + e;
    if (seg < 2) { const int kb = r >> 4, nb = r & 15, n0 = 32 * nb;
        transpose_item_fp8(a.in[seg == 0 ? I_W1 : I_W3] + (size_t)mat * 2048 * 512, 2048, 512, (unsigned char*)(F.ws + WS_W13) + (size_t)mat * 1024 * 2048, (n0 >> 7) * 256 + (n0 & 127) + (seg == 1 ? 128 : 0), scr, 64 * kb, n0, F.lane); }
    else { const int kb = r >> 6, nb = r & 63;
        transpose_item_fp8(a.in[I_W2] + (size_t)mat * 512 * 2048, 512, 2048, (unsigned char*)(F.ws + WS_W2) + (size_t)mat * 512 * 2048, 32 * nb, scr, 64 * kb, 32 * nb, F.lane); }
}
#ifndef F8MASK
#define F8MASK 4
#endif
#define F8L(l) (((F8MASK) >> (l)) & 1)
#ifndef F8OMASK
#define F8OMASK 12
#endif
#define F8OL(l) (((F8OMASK) >> (l)) & 1)
#ifndef CDEPTH
#define CDEPTH 3
#endif
struct CDesc { const float* src; unsigned char* dst; int N, K, drow0, k0, n0, f8; };
__device__ __forceinline__ CDesc conv_desc(Frame& F, const Args& a, int q, int it) {
    CDesc d;
    if (q & 1) {
        const float* src; unsigned char* dst; int N, r = it, f8 = F8L((q + 1) >> 1);
        if (q == 1) { if (r < 3584) { N = 3584; src = a.in[I_AWIN] + (size_t)2048 * 3584; dst = F.ws + WS_WAIN + (size_t)2048 * 3584 * 2; } else { r -= 3584; N = 2048; f8 = 0; src = a.in[I_AWOUT] + (size_t)2048 * 2048; dst = F.ws + WS_WAOUT + (size_t)2048 * 2048 * 2; } }
        else if (q == 3) { if (r < 2048) { N = 2048; src = a.in[I_BWIN]; dst = F.ws + WS_WBIN0; } else if ((r -= 2048) < 3072) { N = 3072; src = a.in[I_WKV]; dst = F.ws + WS_WBIN0 + (size_t)2048 * 2048 * (F8L(2) ? 1 : 2); } else { r -= 3072; N = 2048; f8 = F8OL(2); src = a.in[I_BWOUT]; dst = F.ws + WS_WBOUT; } }
        else { if (r < 2048) { N = 2048; src = a.in[I_BWIN] + (size_t)2048 * 2048; dst = F.ws + WS_WBIN1; } else { r -= 2048; N = 2048; f8 = F8OL(3); src = a.in[I_BWOUT] + (size_t)2048 * 2048; dst = F.ws + WS_WBOUT + (size_t)2048 * 2048 * 2; } }
        const int nblk = N / 32, kb = r / nblk, nb = r - kb * nblk;
        d.src = src; d.dst = dst; d.N = N; d.K = 2048; d.drow0 = 32 * nb; d.k0 = 64 * kb; d.n0 = 32 * nb; d.f8 = f8; return d;
    }
    const int L = q >> 1, seg = it >> 14, r0 = it & 16383, e = r0 >> 9, r = r0 & 511, mat = L * 32 + e;
    if (seg < 2) { const int kb = r >> 4, nb = r & 15, n0 = 32 * nb;
        d.src = a.in[seg == 0 ? I_W1 : I_W3] + (size_t)mat * 2048 * 512; d.dst = (unsigned char*)(F.ws + WS_W13) + (size_t)mat * 1024 * 2048; d.N = 512; d.K = 2048;
        d.drow0 = (n0 >> 7) * 256 + (n0 & 127) + (seg == 1 ? 128 : 0); d.k0 = 64 * kb; d.n0 = n0; d.f8 = 1; }
    else { const int kb = r >> 6, nb = r & 63;
        d.src = a.in[I_W2] + (size_t)mat * 512 * 2048; d.dst = (unsigned char*)(F.ws + WS_W2) + (size_t)mat * 512 * 2048; d.N = 2048; d.K = 512; d.drow0 = 32 * nb; d.k0 = 64 * kb; d.n0 = 32 * nb; d.f8 = 1; }
    return d;
}
#define CV_LOAD(t_, d_) do { const float* p_ = (d_).src + (size_t)((d_).k0 + (F.lane >> 3)) * (d_).N + (d_).n0 + 4 * (F.lane & 7); const size_t st_ = (size_t)8 * (d_).N; \
    _Pragma("unroll") for (int i_ = 0; i_ < 8; ++i_) (t_)[i_] = *(const GAS f32x4*)(p_ + st_ * i_); } while (0)
__device__ __forceinline__ void conv_process(Frame& F, f32x4 (&t)[8], const CDesc& d) {
    LAS float* scr = (LAS float*)(F.lds + RING_OFF + F.wave * 16384); const int lane = F.lane;
    asm volatile("" : "+v"(t[0]), "+v"(t[1]), "+v"(t[2]), "+v"(t[3]), "+v"(t[4]), "+v"(t[5]), "+v"(t[6]), "+v"(t[7]));
    { LAS float* w = scr + (lane >> 3) * 33 + 4 * (lane & 7);
#pragma unroll
      for (int i = 0; i < 8; ++i) { w[i * 8 * 33 + 0] = t[i].x; w[i * 8 * 33 + 1] = t[i].y; w[i * 8 * 33 + 2] = t[i].z; w[i * 8 * 33 + 3] = t[i].w; } }
    LDS_WAIT(); asm volatile("" ::: "memory");
    const int c = lane & 7;
    if (d.f8) {
#pragma unroll
        for (int j = 0; j < 4; ++j) { const int n = (lane >> 3) + 8 * j; const LAS float* s = scr + (8 * c) * 33 + n;
            unsigned lo = 0u, hi = 0u;
            lo = __builtin_amdgcn_cvt_pk_fp8_f32(s[0 * 33] * 64.f, s[1 * 33] * 64.f, lo, false); lo = __builtin_amdgcn_cvt_pk_fp8_f32(s[2 * 33] * 64.f, s[3 * 33] * 64.f, lo, true);
            hi = __builtin_amdgcn_cvt_pk_fp8_f32(s[4 * 33] * 64.f, s[5 * 33] * 64.f, hi, false); hi = __builtin_amdgcn_cvt_pk_fp8_f32(s[6 * 33] * 64.f, s[7 * 33] * 64.f, hi, true);
            v2u o; o.x = lo; o.y = hi; *(GAS v2u*)(d.dst + (size_t)(d.drow0 + n) * d.K + d.k0 + 8 * c) = o; }
    } else {
#pragma unroll
        for (int j = 0; j < 4; ++j) { const int n = (lane >> 3) + 8 * j; const LAS float* s = scr + (8 * c) * 33 + n;
            v4u o; o.x = pk2(s[0 * 33], s[1 * 33]); o.y = pk2(s[2 * 33], s[3 * 33]); o.z = pk2(s[4 * 33], s[5 * 33]); o.w = pk2(s[6 * 33], s[7 * 33]);
            *(GAS v4u*)((bf16*)d.dst + (size_t)(d.drow0 + n) * d.K + d.k0 + 8 * c) = o; }
    }
    LDS_WAIT(); asm volatile("" ::: "memory");
}
__device__ __forceinline__ void conv_range(Frame& F, const Args& a, int q, int first, int cnt) {
#if CDEPTH == 1
    for (int i = 0; i < cnt; ++i) conv_item(F, a, q, first + i);
#else
    f32x4 t[CDEPTH][8]; const int last = first + cnt - 1;
#pragma unroll
    for (int s = 0; s < CDEPTH - 1; ++s) { const int it = first + s < last ? first + s : last; const CDesc d = conv_desc(F, a, q, it); CV_LOAD(t[s], d); }
#pragma unroll 1
    for (int i0 = 0; i0 < cnt; i0 += CDEPTH) {
#pragma unroll
        for (int s = 0; s < CDEPTH; ++s) {
            { const int nx = first + i0 + s + CDEPTH - 1, it = nx < last ? nx : last; const CDesc d = conv_desc(F, a, q, it); CV_LOAD(t[(s + CDEPTH - 1) % CDEPTH], d); }
            asm volatile("" ::: "memory");
            if (i0 + s < cnt) { const CDesc d = conv_desc(F, a, q, first + i0 + s); conv_process(F, t[s], d); }
        }
    }
#endif
}
__device__ __forceinline__ void conv_filler(Frame& F, const Args& a, int q0, int n) {
    if (q0 >= NQ || n == 0) return;
#ifdef CONV_ALL_PRO
    return;
#endif
    LAS unsigned* bw = (LAS unsigned*)(F.lds + TAB_OFF + 384);
    __syncthreads();
    const bool drain = n < 0; const int per = drain ? CDRAIN : n; int q = q0;
    for (;;) {
        if (F.tid == 0) bw[0] = __hip_atomic_fetch_add(F.ctl + CW_CONV + 64 * q, (unsigned)(8 * per), RLX_AGENT);
        __syncthreads();
        const unsigned idx = bw[0];
        __syncthreads();
        const int qs = conv_qsize(q);
        if (idx >= (unsigned)qs) { if (drain || ++q >= NQ) break; continue; }
        { const int first = (int)idx + F.wave * per, cnt = (qs - first < per) ? qs - first : per; if (cnt > 0) conv_range(F, a, q, first, cnt); }
        if (!drain) break;
    }
}

__device__ __forceinline__ void prologue_phase(Frame& F, const Args& a) {
#ifdef TOUCH
    {
        const long nthr_ = (long)F.G * 512, gt_ = (long)F.c * 512 + F.tid; unsigned acc_ = 0u;
        for (long pg = gt_; pg < (long)(WS_END / 4096); pg += nthr_) acc_ += *(const GAS unsigned*)(F.ws + pg * 4096);
        for (long pg = gt_; pg < (long)((size_t)DEPTH * NE * D * FF * 4 / 4096); pg += nthr_) { acc_ += *(const GAS unsigned*)((const char*)a.in[I_W1] + pg * 4096); acc_ += *(const GAS unsigned*)((const char*)a.in[I_W3] + pg * 4096); acc_ += *(const GAS unsigned*)((const char*)a.in[I_W2] + pg * 4096); }
        if (acc_ == 0x12345679u) F.ctl[CW_TMO] = acc_;
    }
#endif
    LAS float* scr = (LAS float*)(F.lds + RING_OFF + F.wave * 16384);
    const int gw = F.c * NWAVES + F.wave, NGW = F.G * NWAVES;
    unsigned char* ws = F.ws;
    constexpr int S0 = 3584, S1 = 2048, S5 = 4 * 1024;
    constexpr int NITEMS = S0 + S1 + S5;
    for (int it = gw; it < NITEMS; it += NGW) {
        int r = it; const float* src; unsigned char* dst; int K = 2048, N; bool f8 = F8L(0);
        if (r < S0) { N = 3584; src = a.in[I_AWIN]; dst = ws + WS_WAIN; }
        else if ((r -= S0) < S1) { N = 2048; f8 = false; src = a.in[I_AWOUT]; dst = ws + WS_WAOUT; }
        else { r -= S1; const int mat = r >> 10; r &= 1023; N = 1024; src = a.in[I_MEMWKV] + (size_t)mat * K * N; dst = ws + WS_WMKV + (size_t)mat * K * N * (F8L(0) ? 1 : 2); }
        const int nblk = N / 32, kb = r / nblk, nb = r - kb * nblk;
        if (f8) transpose_item_fp8(src, K, N, dst, 32 * nb, scr, 64 * kb, 32 * nb, F.lane);
        else transpose_item_fast(src, K, N, (bf16*)dst, 32 * nb, scr, 64 * kb, 32 * nb, F.lane);
    }
#ifdef CONV_ALL_PRO
    for (int q = 0; q < NQ; ++q) { const int qs = conv_qsize(q); for (int it = gw * 4; it < qs; it += NGW * 4) conv_range(F, a, q, it, qs - it < 4 ? qs - it : 4); }
#endif
    const long nthr = (long)F.G * 512, gt = (long)F.c * 512 + F.tid;
    { float* wr = (float*)(ws + WS_WR);
      for (long i = gt; i < (long)DEPTH * 3 * 512 * 16 * 4; i += nthr) { const int j = (int)(i & 3), c = (int)((i >> 2) & 15), kg = (int)((i >> 6) & 511), r = (int)(i >> 15), nb = r % 3, l = r / 3;
          const int k = 4 * kg + j, o = 16 * nb + c; float v = 0.f;
          if (o < 4) v = a.in[I_WG1][((size_t)l * D + k) * 4 + o]; else if (o < 36) { const int g = (o - 4) >> 3, e = (o - 4) & 7; v = a.in[I_WG2][(((size_t)l * 4 + g) * D + k) * 8 + e]; }
          wr[i] = v; } }
    { const float* x = a.in[I_X]; bf16* xb = (bf16*)(ws + WS_XB);
      for (long i = gt; i < (long)T * D / 8; i += nthr) { const f32x4 v0 = *(const GAS f32x4*)(x + i * 8), v1 = *(const GAS f32x4*)(x + i * 8 + 4);
          v4u o; o.x = pk2(v0.x, v0.y); o.y = pk2(v0.z, v0.w); o.z = pk2(v1.x, v1.y); o.w = pk2(v1.z, v1.w); *(GAS v4u*)(xb + i * 8) = o;
          unsigned lo = 0u, hi = 0u; lo = __builtin_amdgcn_cvt_pk_fp8_f32(v0.x, v0.y, lo, false); lo = __builtin_amdgcn_cvt_pk_fp8_f32(v0.z, v0.w, lo, true); hi = __builtin_amdgcn_cvt_pk_fp8_f32(v1.x, v1.y, hi, false); hi = __builtin_amdgcn_cvt_pk_fp8_f32(v1.z, v1.w, hi, true);
          v2u qq; qq.x = lo; qq.y = hi; if (F8L(0)) *(GAS v2u*)(ws + WS_XQ + i * 8) = qq; } }
    { const float* x = a.in[I_MEM]; bf16* xb = (bf16*)(ws + WS_MEMB);
      for (long i = gt; i < (long)MEMT * D / 8; i += nthr) { const f32x4 v0 = *(const GAS f32x4*)(x + i * 8), v1 = *(const GAS f32x4*)(x + i * 8 + 4);
          v4u o; o.x = pk2(v0.x, v0.y); o.y = pk2(v0.z, v0.w); o.z = pk2(v1.x, v1.y); o.w = pk2(v1.z, v1.w); *(GAS v4u*)(xb + i * 8) = o;
          unsigned lo = 0u, hi = 0u; lo = __builtin_amdgcn_cvt_pk_fp8_f32(v0.x, v0.y, lo, false); lo = __builtin_amdgcn_cvt_pk_fp8_f32(v0.z, v0.w, lo, true); hi = __builtin_amdgcn_cvt_pk_fp8_f32(v1.x, v1.y, hi, false); hi = __builtin_amdgcn_cvt_pk_fp8_f32(v1.z, v1.w, hi, true);
          v2u qq; qq.x = lo; qq.y = hi; *(GAS v2u*)(ws + WS_MEMQ + i * 8) = qq; } }
}

#ifndef NCVMAX
#define NCVMAX 0
#endif
#ifndef NCVATT
#define NCVATT 96
#endif
__device__ __forceinline__ int conv_servers(int nu, int G, int fin) {
    if (fin || nu <= 0) return 0;
    const int rounds = (nu + G - 1) / G, gmin = (nu + rounds - 1) / rounds; int n = G - gmin; n = n < NCVMAX ? n : NCVMAX; return n & ~7;
}
__device__ __forceinline__ void conv_done(Frame& F, int p) { __syncthreads(); if (F.tid == 0) __hip_atomic_fetch_add(F.ctl + CW_DONE + 64 * p, 1u, RLX_AGENT); }
__device__ __forceinline__ void conv_server(Frame& F, const Args& a, int p, int q0, int ncomp) {
    int q = q0;
    for (;;) {
        if (q >= NQ) break;
        unsigned idx = 0xffffffffu;
        if (F.lane == 0) { if (__hip_atomic_load(F.ctl + CW_DONE + 64 * p, RLX_AGENT) < (unsigned)ncomp) idx = __hip_atomic_fetch_add(F.ctl + CW_CONV + 64 * q, (unsigned)CSRV, RLX_AGENT); }
        idx = (unsigned)__builtin_amdgcn_readfirstlane((int)idx);
        if (idx == 0xffffffffu) break;
        const int qs = conv_qsize(q);
        if (idx >= (unsigned)qs) { ++q; continue; }
        conv_range(F, a, q, (int)idx, (qs - (int)idx < CSRV) ? qs - (int)idx : CSRV);
    }
}
__device__ __forceinline__ void conv_server_q(Frame& F, const Args& a, gu32* head, unsigned stop_at, int q0) {
    int q = q0;
    for (;;) {
        if (q >= NQ) break;
        unsigned idx = 0xffffffffu;
        if (F.lane == 0) { if (__hip_atomic_load(head, RLX_AGENT) < stop_at) idx = __hip_atomic_fetch_add(F.ctl + CW_CONV + 64 * q, (unsigned)CSRVA, RLX_AGENT); }
        idx = (unsigned)__builtin_amdgcn_readfirstlane((int)idx);
        if (idx == 0xffffffffu) break;
        const int qs = conv_qsize(q);
        if (idx >= (unsigned)qs) { ++q; continue; }
        conv_range(F, a, q, (int)idx, (qs - (int)idx < CSRVA) ? qs - (int)idx : CSRVA);
    }
}
__device__ __forceinline__ void conv_note_fin(Frame& F, int p) {
    if (blockIdx.x == 0 && F.tid == 0) { unsigned all = 1u;
        for (int q = 0; q < NQ; ++q) all &= (__hip_atomic_load(F.ctl + CW_CONV + 64 * q, RLX_AGENT) >= (unsigned)conv_qsize(q)) ? 1u : 0u;
        __hip_atomic_store(F.ctl + CW_FIN + 64 * p, all, RLX_AGENT); }
}

__device__ __forceinline__ void sgu_unit(Frame& F, const Args& a, int l, int n, int g) {
    constexpr int LDW = 136;
    LAS float* stats = (LAS float*)(F.lds); LAS bf16* Wl = (LAS bf16*)(F.lds + 1024); LAS bf16* Vt = (LAS bf16*)(F.lds + 35840);
    const bf16* z = (const bf16*)(F.ws + WS_Z); bf16* cat = (bf16*)(F.ws + WS_CAT);
    const int tok0 = n * 128;
    for (int i = 0; i < 16; ++i) { const int tk = F.wave * 16 + i; const GAS v4u* rp = (const GAS v4u*)(z + (size_t)(tok0 + tk) * NINA + MIXW) + F.lane;
        v4u w[3]; float s = 0.f;
#pragma unroll
        for (int j = 0; j < 3; ++j) { w[j] = rp[64 * j]; s += (bflo(w[j].x) + bfhi(w[j].x)) + (bflo(w[j].y) + bfhi(w[j].y)) + (bflo(w[j].z) + bfhi(w[j].z)) + (bflo(w[j].w) + bfhi(w[j].w)); }
        const float mean = wave_sum(s) * (1.f / MIXW); float q = 0.f;
#pragma unroll
        for (int j = 0; j < 3; ++j) { float d;
            d = bflo(w[j].x) - mean; q += d * d; d = bfhi(w[j].x) - mean; q += d * d; d = bflo(w[j].y) - mean; q += d * d; d = bfhi(w[j].y) - mean; q += d * d;
            d = bflo(w[j].z) - mean; q += d * d; d = bfhi(w[j].z) - mean; q += d * d; d = bflo(w[j].w) - mean; q += d * d; d = bfhi(w[j].w) - mean; q += d * d; }
        const float rstd = 1.f / sqrtf(wave_sum(q) * (1.f / MIXW) + LN_EPS);
        if (F.lane == 0) { stats[2 * tk] = mean; stats[2 * tk + 1] = rstd; } }
    { const float* wsrc = a.in[I_AWS] + ((size_t)l * 4 + g) * 128 * 128;
      for (int p = F.tid; p < 128 * 32; p += 512) { const int i = p >> 5, j4 = (p & 31) * 4; f32x4 v = *(const GAS f32x4*)(wsrc + i * 128 + j4);
          if ((j4 >> 6) > (i >> 6)) v = (f32x4){0.f, 0.f, 0.f, 0.f};
          v2u o; o.x = pk2(v.x, v.y); o.y = pk2(v.z, v.w); *(LAS v2u*)(Wl + i * LDW + j4) = o; } }
    __syncthreads();
    { const float* lg = a.in[I_ALNG] + (size_t)l * MIXW + g * 384; const float* lb = a.in[I_ALNB] + (size_t)l * MIXW + g * 384;
      for (int p = F.tid; p < 128 * 48; p += 512) { const int j = p & 127, c8 = (p >> 7) * 8;
          const v4u w = *(const GAS v4u*)(z + (size_t)(tok0 + j) * NINA + MIXW + g * 384 + c8);
          const float mean = stats[2 * j], rstd = stats[2 * j + 1];
          const f32x4 g0 = *(const GAS f32x4*)(lg + c8), g1 = *(const GAS f32x4*)(lg + c8 + 4), b0 = *(const GAS f32x4*)(lb + c8), b1 = *(const GAS f32x4*)(lb + c8 + 4);
          float v[8] = {bflo(w.x), bfhi(w.x), bflo(w.y), bfhi(w.y), bflo(w.z), bfhi(w.z), bflo(w.w), bfhi(w.w)};
          const float gg[8] = {g0.x, g0.y, g0.z, g0.w, g1.x, g1.y, g1.z, g1.w}, bb[8] = {b0.x, b0.y, b0.z, b0.w, b1.x, b1.y, b1.z, b1.w};
#pragma unroll
          for (int e = 0; e < 8; ++e) Vt[(c8 + e) * LDW + j] = (bf16)f2bf((v[e] - mean) * rstd * gg[e] + bb[e]); } }
    __syncthreads();
    const int fr = F.lane & 15, fq = F.lane >> 4;
    f32x4 acc[8][3];
#pragma unroll
    for (int mb = 0; mb < 8; ++mb)
#pragma unroll
        for (int nb = 0; nb < 3; ++nb) acc[mb][nb] = (f32x4){0.f, 0.f, 0.f, 0.f};
#pragma unroll
    for (int ks = 0; ks < 4; ++ks) { bf16x8 bfr[3];
#pragma unroll
        for (int nb = 0; nb < 3; ++nb) bfr[nb] = *(const LAS bf16x8*)(Vt + (F.wave * 48 + nb * 16 + fr) * LDW + ks * 32 + fq * 8);
#pragma unroll
        for (int mb = 0; mb < 8; ++mb) { const bf16x8 afr = *(const LAS bf16x8*)(Wl + (mb * 16 + fr) * LDW + ks * 32 + fq * 8);
#pragma unroll
            for (int nb = 0; nb < 3; ++nb) acc[mb][nb] = __builtin_amdgcn_mfma_f32_16x16x32_bf16(bfr[nb], afr, acc[mb][nb], 0, 0, 0); } }
    const float* bs = a.in[I_ABS] + ((size_t)l * 4 + g) * 128;
#pragma unroll
    for (int mb = 0; mb < 8; ++mb) { const int i = mb * 16 + fr; const float bsv = bs[i]; const size_t tk = (size_t)(tok0 + i);
#pragma unroll
        for (int nb = 0; nb < 3; ++nb) { const int c = g * 384 + F.wave * 48 + nb * 16 + 4 * fq;
            const v2u uw = *(const GAS v2u*)(z + tk * NINA + c); const f32x4 gt = acc[mb][nb] + bsv;
            v2u o; o.x = pk2(bflo(uw.x) * gt.x, bfhi(uw.x) * gt.y); o.y = pk2(bflo(uw.y) * gt.z, bfhi(uw.y) * gt.w);
            *(GAS v2u*)(cat + tk * D + c) = o; } }
    __syncthreads();
}

__device__ __forceinline__ void memattn_unit(Frame& F, int l, int hm, int qb, int ldz, int qoff) {
    const bf16* z = (const bf16*)(F.ws + WS_Z); const bf16* kv = (const bf16*)(F.ws + WS_MEMKV) + (size_t)l * 256 * 1024; bf16* cat = (bf16*)(F.ws + WS_CAT);
    att::attn_body<0>(z + (size_t)qb * 256 * ldz + qoff + hm * 128, ldz, kv + hm * 128, kv + 512 + hm * 128, 1024,
                      cat + (size_t)qb * 256 * D + MIXW + hm * 128, nullptr, D, 4, 0, nullptr, 0.f, F.ldsg);
}

__device__ __forceinline__ int t5_bucket(int rel) {
    const int a = rel < 0 ? -rel : rel; int f;
    if (a < 8) f = a; else if (a < 12) f = 8; else if (a < 16) f = 9; else if (a < 23) f = 10; else if (a < 32) f = 11; else if (a < 46) f = 12; else if (a < 64) f = 13; else if (a < 91) f = 14; else f = 15;
    return (rel > 0 ? 16 : 0) + f;
}

namespace att2 {
using att::bf16x8; using att::s16x4; using att::f32x16; using att::u32x4; using att::crow; using att::cvtpk; using att::tr_read; using att::v_rd_base;
constexpr int KT = 32, ST_K = KT * 128 * 2, ST_V = KT * 256 * 2, STAGE = 2 * ST_K + ST_V, NST = 3;
constexpr int LDS_WS = NST * STAGE, LDS_TAB = LDS_WS + 2048, LDS_UNIT = LDS_TAB + 640, LDS_END = LDS_UNIT + 16;
constexpr int NUNITS = 576;
constexpr float THR2 = 8.f * 1.4426950408889634f;
__device__ __forceinline__ int swap23(int k) { return (k & ~0xC) | ((k & 4) << 1) | ((k & 8) >> 1); }
constexpr int v_off(int d0, int ks, int half) { return d0 * 512 + ks * 8192 + half * 4096; }

struct UnitTable { unsigned short u[NUNITS]; };
constexpr UnitTable make_units() {
    UnitTable t{}; int n = 0;
    for (int c = 256; c >= 4; c -= 2) {
        { const int b = (c - 2) / 2; if ((c - 2) % 2 == 0 && b >= 32 && b <= 63) for (int part = 1; part <= 2; ++part) for (int h = 0; h < 6; ++h) t.u[n++] = (unsigned short)(h | (b << 3) | (part << 9)); }
        if (c % 4 == 0) { const int b = c / 4 - 1; if (b >= 0 && b < 32) for (int h = 0; h < 6; ++h) t.u[n++] = (unsigned short)(h | (b << 3)); }
    }
    return t;
}
__device__ const UnitTable g_units = make_units();

__device__ __forceinline__ void diff_unit(const bf16* __restrict__ Q, const bf16* __restrict__ KD, const bf16* __restrict__ VD, float* Obuf  , int orow0,
                                          float* ML  , const float* relb, int h, int b, int t_lo, int t_hi, LAS char* lds) {
  int tid_ = threadIdx.x; asm volatile("" : "+v"(tid_));
  const int tid = tid_, wid = __builtin_amdgcn_readfirstlane(tid >> 6), lane = tid & 63, r32 = lane & 31, hi = lane >> 5, m = wid >> 2, rg = wid & 3;
  LAS float* wsw = (LAS float*)(lds + LDS_WS) + wid * 64; LAS float* li_l = wsw; LAS float* al_l = wsw + 32;
  LAS float* tab = (LAS float*)(lds + LDS_TAB);
  if (tid < att::TAB_N) tab[tid] = relb[t5_bucket(63 - tid) * 6 + h] * LOG2E;
  const float cfar = relb[15 * 6 + h] * LOG2E;
  const int qrow0 = b * 128 + rg * 32;
  bf16x8 qr[8];
  { const bf16* Qw = Q + (size_t)(qrow0 + r32) * 2048 + h * 256 + m * 128 + hi * 8;
#pragma unroll
    for (int d0 = 0; d0 < 8; ++d0) qr[d0] = *reinterpret_cast<const bf16x8*>(Qw + d0 * 16); }
  int ko[2], vo[2];
#pragma unroll
  for (int i = 0; i < 2; ++i) {
    const int p = wid * 64 + lane, row = p >> 4, cp = (p & 15) ^ (row & 7); ko[i] = row * 1536 + h * 256 + i * 128 + cp * 8; }
#pragma unroll
  for (int i = 0; i < 2; ++i) {
    const int p = (wid * 2 + i) * 64 + lane, sub = p >> 5, kg = sub >> 3, cblk = sub & 7, q = p & 31, kk = kg * 8 + (q >> 2), key = swap23(kk);
    vo[i] = key * 1536 + h * 256 + cblk * 32 + (q & 3) * 8; }
  const unsigned ldsb = (unsigned)(uintptr_t)lds;
#define A2_ISSUE(t, s) do { const size_t kb_ = (size_t)(t) * KT * 1536; LAS char* sb_ = lds + (s) * STAGE; \
    __builtin_amdgcn_global_load_lds((const unsigned*)(KD + kb_ + ko[0]), (LAS unsigned*)(sb_ + wid * 1024), 16, 0, 0); \
    __builtin_amdgcn_global_load_lds((const unsigned*)(KD + kb_ + ko[1]), (LAS unsigned*)(sb_ + ST_K + wid * 1024), 16, 0, 0); \
    __builtin_amdgcn_global_load_lds((const unsigned*)(VD + kb_ + vo[0]), (LAS unsigned*)(sb_ + 2 * ST_K + (wid * 2) * 1024), 16, 0, 0); \
    __builtin_amdgcn_global_load_lds((const unsigned*)(VD + kb_ + vo[1]), (LAS unsigned*)(sb_ + 2 * ST_K + (wid * 2 + 1) * 1024), 16, 0, 0); } while (0)
  const int vis = 2 * (2 * b + (rg >> 1) + 1);
  float m_reg = -1e30f, l_reg = 0.f; f32x16 o[8];
#pragma unroll
  for (int d = 0; d < 8; ++d) o[d] = f32x16{};
  asm volatile("s_waitcnt vmcnt(0)" ::: "memory");
  A2_ISSUE(t_lo, 0); if (t_lo + 1 < t_hi) A2_ISSUE(t_lo + 1, 1);
  int s = 0;
  for (int t = t_lo; t < t_hi; ++t) {
    if (t + 1 < t_hi) asm volatile("s_waitcnt vmcnt(4) lgkmcnt(0)" ::: "memory"); else asm volatile("s_waitcnt vmcnt(0) lgkmcnt(0)" ::: "memory");
    __builtin_amdgcn_s_barrier(); asm volatile("" ::: "memory");
    if (t + 2 < t_hi) { const int s2 = (s >= 1) ? s - 1 : s + 2; A2_ISSUE(t + 2, s2); }
    if (t < vis) {
      const LAS char* Ks = lds + s * STAGE + m * ST_K;
      f32x16 p = f32x16{};
#pragma unroll
      for (int d0 = 0; d0 < 8; ++d0) { const int cb = (d0 * 16 + hi * 8) * 2;
        const bf16x8 b0 = *(const LAS bf16x8*)(Ks + KSWZ(r32, cb));
        p = __builtin_amdgcn_mfma_f32_32x32x16_bf16(b0, qr[d0], p, 0, 0, 0); }
      if (qrow0 - (KT * t + KT - 1) >= 91) {
#pragma unroll
        for (int r = 0; r < 16; ++r) p[r] += cfar;
      } else { const int base = qrow0 + r32 - KT * t + 63;
#pragma unroll
        for (int r = 0; r < 16; ++r) { const int i0 = base - crow(r, hi); p[r] += tab[i0 < att::TAB_N - 1 ? i0 : att::TAB_N - 1]; } }
      float pmax = p[0];
#pragma unroll
      for (int r = 1; r < 16; ++r) pmax = fmaxf(pmax, p[r]);
      { auto rr = __builtin_amdgcn_permlane32_swap(__float_as_uint(pmax), __float_as_uint(pmax), false, false); pmax = fmaxf(__uint_as_float(rr[0]), __uint_as_float(rr[1])); }
      float mn, alpha;
      if (__builtin_expect(__all(pmax - m_reg <= THR2), 1)) { mn = m_reg; alpha = 1.f; }
      else { mn = fmaxf(m_reg, pmax); alpha = __builtin_amdgcn_exp2f(m_reg - mn); m_reg = mn; }
      float ps = 0.f;
#pragma unroll
      for (int r = 0; r < 16; ++r) { p[r] = __builtin_amdgcn_exp2f(p[r] - mn); ps += p[r]; }
      { auto rr = __builtin_amdgcn_permlane32_swap(__float_as_uint(ps), __float_as_uint(ps), false, false); ps = __uint_as_float(rr[0]) + __uint_as_float(rr[1]); }
      l_reg = l_reg * alpha + ps;
      bf16x8 pa0, pa1;
#define A2_PK4(P, BASE, OUT) do { unsigned a0 = cvtpk(P[BASE + 0], P[BASE + 1]), a1 = cvtpk(P[BASE + 2], P[BASE + 3]);   \
    unsigned b0_ = cvtpk(P[BASE + 4], P[BASE + 5]), b1_ = cvtpk(P[BASE + 6], P[BASE + 7]);                              \
    auto r0 = __builtin_amdgcn_permlane32_swap(a0, b0_, false, false); auto r1 = __builtin_amdgcn_permlane32_swap(a1, b1_, false, false); \
    u32x4 w = {r0[0], r1[0], r0[1], r1[1]}; OUT = *reinterpret_cast<bf16x8*>(&w); } while (0)
      A2_PK4(p, 0, pa0); A2_PK4(p, 8, pa1);
      if (__any(alpha < 1.f)) { if (hi == 0) al_l[r32] = alpha; asm volatile("s_waitcnt lgkmcnt(0)" ::: "memory");
#pragma unroll
        for (int d = 0; d < 8; ++d)
#pragma unroll
          for (int r = 0; r < 16; ++r) o[d][r] *= al_l[crow(r, hi)]; }
      const int vb = (int)(ldsb + s * STAGE + 2 * ST_K) + v_rd_base(lane);
      asm volatile("s_waitcnt lgkmcnt(0)" ::: "memory"); SBAR();
#define A2_PK(L, H) (bf16x8){L[0], L[1], L[2], L[3], H[0], H[1], H[2], H[3]}
#define A2_RD(D0, l0, h0, l1, h1) do { l0 = tr_read<v_off(D0, 0, 0)>(vb); h0 = tr_read<v_off(D0, 0, 1)>(vb); l1 = tr_read<v_off(D0, 1, 0)>(vb); h1 = tr_read<v_off(D0, 1, 1)>(vb); } while (0)
#define A2_MM(D0, l0, h0, l1, h1) do { o[D0] = __builtin_amdgcn_mfma_f32_32x32x16_bf16(pa0, A2_PK(l0, h0), o[D0], 0, 0, 0); o[D0] = __builtin_amdgcn_mfma_f32_32x32x16_bf16(pa1, A2_PK(l1, h1), o[D0], 0, 0, 0); } while (0)
      s16x4 xl0, xh0, xl1, xh1, yl0, yh0, yl1, yh1;
      A2_RD(0, xl0, xh0, xl1, xh1);
      A2_RD(1, yl0, yh0, yl1, yh1); asm volatile("s_waitcnt lgkmcnt(4)" ::: "memory"); SBAR(); A2_MM(0, xl0, xh0, xl1, xh1); SBAR();
      A2_RD(2, xl0, xh0, xl1, xh1); asm volatile("s_waitcnt lgkmcnt(4)" ::: "memory"); SBAR(); A2_MM(1, yl0, yh0, yl1, yh1); SBAR();
      A2_RD(3, yl0, yh0, yl1, yh1); asm volatile("s_waitcnt lgkmcnt(4)" ::: "memory"); SBAR(); A2_MM(2, xl0, xh0, xl1, xh1); SBAR();
      A2_RD(4, xl0, xh0, xl1, xh1); asm volatile("s_waitcnt lgkmcnt(4)" ::: "memory"); SBAR(); A2_MM(3, yl0, yh0, yl1, yh1); SBAR();
      A2_RD(5, yl0, yh0, yl1, yh1); asm volatile("s_waitcnt lgkmcnt(4)" ::: "memory"); SBAR(); A2_MM(4, xl0, xh0, xl1, xh1); SBAR();
      A2_RD(6, xl0, xh0, xl1, xh1); asm volatile("s_waitcnt lgkmcnt(4)" ::: "memory"); SBAR(); A2_MM(5, yl0, yh0, yl1, yh1); SBAR();
      A2_RD(7, yl0, yh0, yl1, yh1); asm volatile("s_waitcnt lgkmcnt(4)" ::: "memory"); SBAR(); A2_MM(6, xl0, xh0, xl1, xh1); SBAR();
      asm volatile("s_waitcnt lgkmcnt(0)" ::: "memory"); SBAR(); A2_MM(7, yl0, yh0, yl1, yh1); SBAR();
    }
    s = (s == 2) ? 0 : s + 1;
  }
  if (hi == 0) li_l[r32] = l_reg; asm volatile("s_waitcnt lgkmcnt(0)" ::: "memory");
  float rli[16];
#pragma unroll
  for (int r = 0; r < 16; ++r) rli[r] = __builtin_amdgcn_rcpf(li_l[crow(r, hi)]);
  float* Ow = Obuf + (size_t)(qrow0 - orow0) * 3072 + (h * 2 + m) * 256;
#pragma unroll
  for (int r = 0; r < 16; ++r) { const int orow = crow(r, hi);
#pragma unroll
    for (int d0 = 0; d0 < 8; ++d0) Ow[(size_t)orow * 3072 + d0 * 32 + r32] = o[d0][r] * rli[r]; }
  if (hi == 0) { float* mlp = ML + (((size_t)(qrow0 - orow0 + r32) * 6 + h) * 2 + m) * 2; mlp[0] = m_reg; mlp[1] = l_reg; }
  asm volatile("s_waitcnt vmcnt(0) lgkmcnt(0)" ::: "memory");
  __builtin_amdgcn_s_barrier(); asm volatile("" ::: "memory");
#undef A2_ISSUE
#undef A2_PK4
#undef A2_PK
#undef A2_RD
#undef A2_MM
}
}

namespace att3 {
using att::f32x16; using att::crow;
typedef int v8i __attribute__((ext_vector_type(8))); typedef int v4i __attribute__((ext_vector_type(4)));
constexpr int KT = 64, ST_K = KT * 128, ST_V = 256 * 64, STAGE = ST_K + ST_V, NST = 4;
struct UnitTable { unsigned short u[att2::NUNITS]; };
constexpr UnitTable make_units() {
    UnitTable t{}; int n = 0;
    for (int L = 64; L >= 4; L -= 2) {
        if ((L - 2) % 2 == 0) { const int b = (L - 2) / 2; if (b >= 16 && b < 32) for (int part = 1; part <= 2; ++part) for (int hm = 0; hm < 12; ++hm) t.u[n++] = (unsigned short)((hm >> 1) | ((hm & 1) << 3) | (b << 4) | (part << 9)); }
        if (L % 4 == 0) { const int b = L / 4 - 1; if (b >= 0 && b < 16) for (int hm = 0; hm < 12; ++hm) t.u[n++] = (unsigned short)((hm >> 1) | ((hm & 1) << 3) | (b << 4)); }
    }
    return t;
}
__device__ const UnitTable g_units = make_units();
static_assert(NST * STAGE == att2::LDS_WS, "same ring size as att2");
constexpr float THR2 = 2.f;
__device__ __forceinline__ v8i cat8(v4i a, v4i b) { return __builtin_shufflevector(a, b, 0, 1, 2, 3, 4, 5, 6, 7); }
__device__ __forceinline__ void diff_unit(const unsigned char* __restrict__ Q8, const unsigned char* __restrict__ K8, const unsigned char* __restrict__ VT, float* Obuf, int orow0,
                                          float* ML, const float* relb, int h, int m, int b, int t_lo, int t_hi, LAS char* lds) {
  int tid_ = threadIdx.x; asm volatile("" : "+v"(tid_));
  const int tid = tid_, wid = __builtin_amdgcn_readfirstlane(tid >> 6), lane = tid & 63, r32 = lane & 31, hi = lane >> 5, rg = wid;
  LAS float* wsw = (LAS float*)(lds + att2::LDS_WS) + wid * 64; LAS float* li_l = wsw; LAS float* al_l = wsw + 32;
  LAS float* tab = (LAS float*)(lds + att2::LDS_TAB);
  if (tid < att::TAB_N) tab[tid] = relb[t5_bucket(63 - tid) * 6 + h] * LOG2E;
  const float cfar = relb[15 * 6 + h] * LOG2E;
  const int qrow0 = b * 256 + rg * 32;
  v8i q8[2];
  { const unsigned char* Qw = Q8 + (size_t)(qrow0 + r32) * 2048 + h * 256 + m * 128 + hi * 32;
#pragma unroll
    for (int c = 0; c < 2; ++c) q8[c] = cat8(*(const GAS v4i*)(Qw + 64 * c), *(const GAS v4i*)(Qw + 64 * c + 16)); }
  int ko, vo[2];
  { const int p = wid * 64 + lane, row = p >> 3, cp = (p & 7) ^ (row & 7); ko = row * 1536 + h * 256 + m * 128 + cp * 16; }
#pragma unroll
  for (int i = 0; i < 2; ++i) { const int p = (wid * 2 + i) * 64 + lane, d = p >> 2, cp = (p & 3) ^ ((d >> 1) & 3); vo[i] = d * 64 + cp * 16; }
  const unsigned char* VTh = VT + (size_t)h * 128 * 16384;
#define A3_ISSUE(t, s) do { const size_t kb_ = (size_t)(t) * KT * 1536; LAS char* sb_ = lds + (s) * STAGE; \
    __builtin_amdgcn_global_load_lds((const unsigned*)(K8 + kb_ + ko), (LAS unsigned*)(sb_ + wid * 1024), 16, 0, 0); \
    __builtin_amdgcn_global_load_lds((const unsigned*)(VTh + (size_t)(t) * 16384 + vo[0]), (LAS unsigned*)(sb_ + ST_K + (wid * 2) * 1024), 16, 0, 0); \
    __builtin_amdgcn_global_load_lds((const unsigned*)(VTh + (size_t)(t) * 16384 + vo[1]), (LAS unsigned*)(sb_ + ST_K + (wid * 2 + 1) * 1024), 16, 0, 0); } while (0)
  const int vis = 4 * b + (rg >> 1) + 1;
  float m_reg = -1e30f, l_reg = 0.f; f32x16 o[8];
#pragma unroll
  for (int d = 0; d < 8; ++d) o[d] = f32x16{};
  const int kx = (r32 & 7), koff0 = r32 * 128 + (((2 * hi) ^ kx) << 4), koff1 = r32 * 128 + (((2 * hi + 1) ^ kx) << 4);
  const int vx = (r32 >> 1) & 3, voff0 = r32 * 64 + (((2 * hi) ^ vx) << 4), voff1 = r32 * 64 + (((2 * hi + 1) ^ vx) << 4);
  int sclP = 121, scl1 = 127; asm volatile("" : "+v"(sclP), "+v"(scl1));
  asm volatile("s_waitcnt vmcnt(0)" ::: "memory");
  A3_ISSUE(t_lo, 0); if (t_lo + 1 < t_hi) A3_ISSUE(t_lo + 1, 1); if (t_lo + 2 < t_hi) A3_ISSUE(t_lo + 2, 2);
  int s = 0;
  for (int t = t_lo; t < t_hi; ++t) {
    if (t + 2 < t_hi) asm volatile("s_waitcnt vmcnt(6) lgkmcnt(0)" ::: "memory"); else if (t + 1 < t_hi) asm volatile("s_waitcnt vmcnt(3) lgkmcnt(0)" ::: "memory"); else asm volatile("s_waitcnt vmcnt(0) lgkmcnt(0)" ::: "memory");
    __builtin_amdgcn_s_barrier(); asm volatile("" ::: "memory");
    if (t + 3 < t_hi) A3_ISSUE(t + 3, (s + 3) & 3);
    if (t < vis) {
      const LAS char* Ks = lds + s * STAGE;
      f32x16 p0 = f32x16{}, p1 = f32x16{};
#pragma unroll
      for (int c = 0; c < 2; ++c) {
        const int x0 = koff0 ^ (c << 6), x1 = koff1 ^ (c << 6);
        const v8i k0 = cat8(*(const LAS v4i*)(Ks + x0), *(const LAS v4i*)(Ks + x1));
        const v8i k1 = cat8(*(const LAS v4i*)(Ks + 4096 + x0), *(const LAS v4i*)(Ks + 4096 + x1));
        asm volatile("v_mfma_scale_f32_32x32x64_f8f6f4 %0, %1, %2, %0, %3, %3 op_sel_hi:[0,0,0]" : "+v"(p0) : "v"(k0), "v"(q8[c]), "v"(scl1));
        asm volatile("v_mfma_scale_f32_32x32x64_f8f6f4 %0, %1, %2, %0, %3, %3 op_sel_hi:[0,0,0]" : "+v"(p1) : "v"(k1), "v"(q8[c]), "v"(scl1)); }
      asm volatile("s_nop 15\n s_nop 7" : "+v"(p0), "+v"(p1));
      const bool far = qrow0 - (KT * t + KT - 1) >= 91;
      if (!far) { const int base = qrow0 + r32 - KT * t + 63;
#pragma unroll
        for (int r = 0; r < 16; ++r) { const int i0 = base - crow(r, hi), i1 = i0 - 32; p0[r] += tab[i0 < att::TAB_N - 1 ? i0 : att::TAB_N - 1]; p1[r] += tab[i1 < att::TAB_N - 1 ? i1 : att::TAB_N - 1]; } }
      const float cb = far ? cfar : 0.f;
      float pmax;
      asm("v_max3_f32 %0, %1, %2, %3" : "=v"(pmax) : "v"(p0[0]), "v"(p1[0]), "v"(p0[1]));
      asm("v_max3_f32 %0, %1, %2, %3" : "=v"(pmax) : "v"(pmax), "v"(p1[1]), "v"(p0[2]));
#pragma unroll
      for (int r = 2; r < 15; ++r) asm("v_max3_f32 %0, %1, %2, %3" : "=v"(pmax) : "v"(pmax), "v"(p1[r]), "v"(p0[r + 1]));
      asm("v_max_f32 %0, %1, %2" : "=v"(pmax) : "v"(pmax), "v"(p1[15]));
      pmax += cb;
      { auto rr = __builtin_amdgcn_permlane32_swap(__float_as_uint(pmax), __float_as_uint(pmax), false, false); asm("v_max_f32 %0, %1, %2" : "=v"(pmax) : "v"(__uint_as_float(rr[0])), "v"(__uint_as_float(rr[1]))); }
      float mn, alpha;
      if (__builtin_expect(__all(pmax - m_reg <= THR2), 1)) { mn = m_reg; alpha = 1.f; }
      else { mn = fmaxf(m_reg, pmax); alpha = __builtin_amdgcn_exp2f(m_reg - mn); m_reg = mn; }
      typedef float f32x2v __attribute__((ext_vector_type(2)));
      const float off = cb - (mn - 6.f); const f32x2v off2 = {off, off}; f32x2v ps2 = {0.f, 0.f};
#pragma unroll
      for (int r = 0; r < 16; r += 2) {
        f32x2v a = (f32x2v){p0[r], p0[r + 1]} + off2, c2 = (f32x2v){p1[r], p1[r + 1]} + off2;
        p0[r] = __builtin_amdgcn_exp2f(a.x); p0[r + 1] = __builtin_amdgcn_exp2f(a.y); p1[r] = __builtin_amdgcn_exp2f(c2.x); p1[r + 1] = __builtin_amdgcn_exp2f(c2.y);
        ps2 += (f32x2v){p0[r], p0[r + 1]}; ps2 += (f32x2v){p1[r], p1[r + 1]}; }
      float ps = ps2.x + ps2.y;
      { auto rr = __builtin_amdgcn_permlane32_swap(__float_as_uint(ps), __float_as_uint(ps), false, false); ps = __uint_as_float(rr[0]) + __uint_as_float(rr[1]); }
      l_reg = l_reg * alpha + ps;
      v8i pa;
#pragma unroll
      for (int g = 0; g < 4; ++g) { unsigned x = 0u, y = 0u;
        x = __builtin_amdgcn_cvt_pk_fp8_f32(p0[4 * g], p0[4 * g + 1], x, false); x = __builtin_amdgcn_cvt_pk_fp8_f32(p0[4 * g + 2], p0[4 * g + 3], x, true);
        y = __builtin_amdgcn_cvt_pk_fp8_f32(p1[4 * g], p1[4 * g + 1], y, false); y = __builtin_amdgcn_cvt_pk_fp8_f32(p1[4 * g + 2], p1[4 * g + 3], y, true);
        auto rr = __builtin_amdgcn_permlane32_swap(x, y, false, false); pa[2 * g] = (int)rr[0]; pa[2 * g + 1] = (int)rr[1]; }
      if (__any(alpha < 1.f)) { if (hi == 0) al_l[r32] = alpha; asm volatile("s_waitcnt lgkmcnt(0)" ::: "memory");
#pragma unroll
        for (int d = 0; d < 8; ++d)
#pragma unroll
          for (int r = 0; r < 16; ++r) o[d][r] *= al_l[crow(r, hi)]; }
      const LAS char* Vs = lds + s * STAGE + ST_K;
#define A3_RD(D0, V) do { V = cat8(*(const LAS v4i*)(Vs + (D0) * 2048 + voff0), *(const LAS v4i*)(Vs + (D0) * 2048 + voff1)); } while (0)
#define A3_MM(D0, V) asm volatile("v_mfma_scale_f32_32x32x64_f8f6f4 %0, %1, %2, %0, %3, %4 op_sel_hi:[0,0,0]" : "+v"(o[D0]) : "v"(pa), "v"(V), "v"(sclP), "v"(scl1))
      v8i va, vb;
      A3_RD(0, va);
      A3_RD(1, vb); A3_MM(0, va);
      A3_RD(2, va); A3_MM(1, vb);
      A3_RD(3, vb); A3_MM(2, va);
      A3_RD(4, va); A3_MM(3, vb);
      A3_RD(5, vb); A3_MM(4, va);
      A3_RD(6, va); A3_MM(5, vb);
      A3_RD(7, vb); A3_MM(6, va);
      A3_MM(7, vb);
    }
    s = (s + 1) & 3;
  }
  asm volatile("s_nop 15\n s_nop 15" ::: "memory");
  if (hi == 0) li_l[r32] = l_reg; asm volatile("s_waitcnt lgkmcnt(0)" ::: "memory");
  float rli[16];
#pragma unroll
  for (int r = 0; r < 16; ++r) rli[r] = 64.f * __builtin_amdgcn_rcpf(li_l[crow(r, hi)]);
  float* Ow = Obuf + (size_t)(qrow0 - orow0) * 3072 + (h * 2 + m) * 256;
#pragma unroll
  for (int r = 0; r < 16; ++r) { const int orow = crow(r, hi);
#pragma unroll
    for (int d0 = 0; d0 < 8; ++d0) Ow[(size_t)orow * 3072 + d0 * 32 + r32] = o[d0][r] * rli[r]; }
  if (hi == 0) { float* mlp = ML + (((size_t)(qrow0 - orow0 + r32) * 6 + h) * 2 + m) * 2; mlp[0] = m_reg; mlp[1] = l_reg * (1.f / 64.f); }
  asm volatile("s_waitcnt vmcnt(0) lgkmcnt(0)" ::: "memory");
  __builtin_amdgcn_s_barrier(); asm volatile("" ::: "memory");
#undef A3_ISSUE
#undef A3_RD
#undef A3_MM
}
}

__device__ __forceinline__ void diffattn2_unit(Frame& F, const Args& a, unsigned code) {
    const int h = code & 7, m = (code >> 3) & 1, b = (code >> 4) & 31, pc = code >> 9;
    float* ob = (float*)(F.ws + (pc == 2 ? WS_OP2 : WS_OP)); float* ml = (float*)(F.ws + WS_ML) + (pc == 2 ? (size_t)T * 6 * 2 * 2 : 0);
    const int nt = 4 * b + 4, t_lo = (pc == 2) ? nt / 2 : 0, t_hi = (pc == 1) ? nt / 2 : nt;
    att3::diff_unit(F.ws + WS_ZQ, F.ws + WS_KD, F.ws + WS_VD, ob, pc == 2 ? 4096 : 0, ml, a.in[I_RELB], h, m, b, t_lo, t_hi, (LAS char*)F.lds);
}
__device__ __forceinline__ void diffcombine_phase(Frame& F, const Args& a, int l) {
    const int i = l - 2; const float* lp = a.in[I_BLAM] + (size_t)i * 4 * 128;
    float s1 = lp[F.lane] * lp[128 + F.lane] + lp[64 + F.lane] * lp[128 + 64 + F.lane], s2 = lp[256 + F.lane] * lp[384 + F.lane] + lp[256 + 64 + F.lane] * lp[384 + 64 + F.lane];
    s1 = wave_sum(s1); s2 = wave_sum(s2);
    const float lam_init = 0.8f - 0.6f * expf(-0.3f * (float)l);
    const float lam = expf(s1) - expf(s2) + lam_init;
    const float* op0 = (const float*)(F.ws + WS_OP); const float* op1 = (const float*)(F.ws + WS_OP2); const float* ml0 = (const float*)(F.ws + WS_ML); const float* ml1 = ml0 + (size_t)T * 6 * 2 * 2;
    bf16* cat = (bf16*)(F.ws + WS_CAT);
    const f32x4 gsub = *(const GAS f32x4*)(a.in[I_BSUBG] + (size_t)i * 256 + 4 * F.lane);
    const int gw = F.c * NWAVES + F.wave, NGW = F.G * NWAVES;
    for (int it = gw; it < T * 6; it += NGW) { const int tk = it / 6, h = it - tk * 6; f32x4 os[2];
#pragma unroll
        for (int m = 0; m < 2; ++m) { const size_t r0 = ((size_t)tk * 6 + h) * 2 + m; f32x4 oa = *(const GAS f32x4*)(op0 + r0 * 256 + 4 * F.lane);
            if (tk >= 4096) { const size_t r1 = ((size_t)(tk - 4096) * 6 + h) * 2 + m; const f32x4 ob = *(const GAS f32x4*)(op1 + r1 * 256 + 4 * F.lane);
                const float ma = ml0[r0 * 2], la = ml0[r0 * 2 + 1], mb = ml1[r1 * 2], lb = ml1[r1 * 2 + 1], M = fmaxf(ma, mb);
                const float wa = la * exp2f(ma - M), wb = lb * exp2f(mb - M), inv = 1.f / (wa + wb); oa = oa * (wa * inv) + ob * (wb * inv); }
            os[m] = oa; }
        const f32x4 o = os[0] - os[1] * lam; const float ss = wave_sum((o.x * o.x + o.y * o.y) + (o.z * o.z + o.w * o.w));
        const float r = (1.f - lam_init) / sqrtf(ss * (1.f / 256.f) + LN_EPS);
        v2u w; w.x = pk2(o.x * r * gsub.x, o.y * r * gsub.y); w.y = pk2(o.z * r * gsub.z, o.w * r * gsub.w);
        if (!F8OL(l)) *(GAS v2u*)(cat + (size_t)tk * D + h * 256 + 4 * F.lane) = w;
        { unsigned q8 = 0u; q8 = __builtin_amdgcn_cvt_pk_fp8_f32(o.x * r * gsub.x, o.y * r * gsub.y, q8, false); q8 = __builtin_amdgcn_cvt_pk_fp8_f32(o.z * r * gsub.z, o.w * r * gsub.w, q8, true);
          *(GAS unsigned*)(F.ws + WS_CATQ + (size_t)tk * D + h * 256 + 4 * F.lane) = q8; } }
    { const long nthr = (long)F.G * 512, gt = (long)F.c * 512 + F.tid;
      for (long i2 = gt; i2 < (long)T * 64; i2 += nthr) { const long tk = i2 >> 6; const int c8 = (int)(i2 & 63) * 8; const v4u w = *(const GAS v4u*)(cat + tk * D + MIXW + c8);
          unsigned lo = 0u, hi = 0u; lo = __builtin_amdgcn_cvt_pk_fp8_f32(bflo(w.x), bfhi(w.x), lo, false); lo = __builtin_amdgcn_cvt_pk_fp8_f32(bflo(w.y), bfhi(w.y), lo, true);
          hi = __builtin_amdgcn_cvt_pk_fp8_f32(bflo(w.z), bfhi(w.z), hi, false); hi = __builtin_amdgcn_cvt_pk_fp8_f32(bflo(w.w), bfhi(w.w), hi, true);
          v2u qq; qq.x = lo; qq.y = hi; *(GAS v2u*)(F.ws + WS_CATQ + tk * D + MIXW + c8) = qq; } }
}


__device__ __forceinline__ void ln1_router_phase(Frame& F, const Args& a, int l, int probe = 0) {
    const bf16* y = (const bf16*)(F.ws + WS_Y); bf16* x1b = (bf16*)(F.ws + WS_X1B);
    const float* lng = a.in[I_LNG] + ((size_t)l * 2 + 0) * D; const float* lnb = a.in[I_LNB] + ((size_t)l * 2 + 0) * D;
    const float* wr = (const float*)(F.ws + WS_WR) + (size_t)l * 3 * 512 * 16 * 4;
    int* tok_e = (int*)(F.ws + (probe ? WS_OP : WS_ROUTE)); int* tok_rank = tok_e + 2 * T; float* tok_gate = (float*)(tok_rank + 2 * T);
    gu32* cnt = F.ctl + (probe ? 65536 : CW_CNT) + 2048 * l;
    LAS float* P = (LAS float*)(F.lds);
    constexpr int X1ROW = 2 * D + 16;
    typedef float f32x4v __attribute__((ext_vector_type(4)));
    for (int tb = F.c; tb < T / 32; tb += F.G) {
#pragma unroll 2
        for (int i = 0; i < 4; ++i) { const int tk = tb * 32 + F.wave * 4 + i;
            const GAS v4u* yr = (const GAS v4u*)(y + (size_t)tk * D) + F.lane;
            float v[4][8]; float s = 0.f;
#pragma unroll
            for (int j = 0; j < 4; ++j) { const v4u w = yr[64 * j]; v[j][0] = bflo(w.x); v[j][1] = bfhi(w.x); v[j][2] = bflo(w.y); v[j][3] = bfhi(w.y); v[j][4] = bflo(w.z); v[j][5] = bfhi(w.z); v[j][6] = bflo(w.w); v[j][7] = bfhi(w.w);
#pragma unroll
                for (int e = 0; e < 8; ++e) s += v[j][e]; }
            const float mean = wave_sum(s) * (1.f / D); float s2 = 0.f;
#pragma unroll
            for (int j = 0; j < 4; ++j)
#pragma unroll
                for (int e = 0; e < 8; ++e) { v[j][e] -= mean; s2 += v[j][e] * v[j][e]; }
            const float rstd = 1.f / sqrtf(wave_sum(s2) * (1.f / D) + LN_EPS);
#pragma unroll
            for (int j = 0; j < 4; ++j) { const int d0 = 8 * F.lane + 512 * j; const f32x4 g0 = *(const GAS f32x4*)(lng + d0), g1 = *(const GAS f32x4*)(lng + d0 + 4), b0 = *(const GAS f32x4*)(lnb + d0), b1 = *(const GAS f32x4*)(lnb + d0 + 4);
                const float q0 = v[j][0] * rstd * g0.x + b0.x, q1 = v[j][1] * rstd * g0.y + b0.y, q2 = v[j][2] * rstd * g0.z + b0.z, q3 = v[j][3] * rstd * g0.w + b0.w;
                const float q4 = v[j][4] * rstd * g1.x + b1.x, q5 = v[j][5] * rstd * g1.y + b1.y, q6 = v[j][6] * rstd * g1.z + b1.z, q7 = v[j][7] * rstd * g1.w + b1.w;
                v4u w; w.x = pk2(q0, q1); w.y = pk2(q2, q3); w.z = pk2(q4, q5); w.w = pk2(q6, q7);
                *(GAS v4u*)(x1b + (size_t)tk * D + d0) = w;
                *(LAS v4u*)(F.lds + RING_OFF + (F.wave * 4 + i) * X1ROW + d0 * 2) = w;
                unsigned lo = 0u, hi = 0u; lo = __builtin_amdgcn_cvt_pk_fp8_f32(q0, q1, lo, false); lo = __builtin_amdgcn_cvt_pk_fp8_f32(q2, q3, lo, true);
                hi = __builtin_amdgcn_cvt_pk_fp8_f32(q4, q5, hi, false); hi = __builtin_amdgcn_cvt_pk_fp8_f32(q6, q7, hi, true);
                v2u qq; qq.x = lo; qq.y = hi; *(GAS v2u*)((unsigned char*)(F.ws + WS_X1F) + (size_t)tk * D + d0) = qq; } }
        __syncthreads();
        { const int mt = F.wave >> 2, kq = F.wave & 3, c = F.lane & 15, q = F.lane >> 4;
          const LAS unsigned char* ap = F.lds + RING_OFF + (mt * 16 + c) * X1ROW + (kq * 512 + 4 * q) * 2;
          const float* bp = wr + ((size_t)(kq * 128 + q) * 16 + c) * 4;
          f32x4v acc[3] = {{0.f, 0.f, 0.f, 0.f}, {0.f, 0.f, 0.f, 0.f}, {0.f, 0.f, 0.f, 0.f}};
#pragma unroll 8
          for (int ks = 0; ks < 32; ++ks) { const v2u aw = *(const LAS v2u*)(ap + 32 * ks); const f32x4 a4 = (f32x4){bflo(aw.x), bfhi(aw.x), bflo(aw.y), bfhi(aw.y)}; f32x4 b4[3];
#pragma unroll
              for (int nb = 0; nb < 3; ++nb) b4[nb] = *(const GAS f32x4*)(bp + ((size_t)nb * 512 + 4 * ks) * 64);
#pragma unroll
              for (int j = 0; j < 4; ++j)
#pragma unroll
                  for (int nb = 0; nb < 3; ++nb) acc[nb] = __builtin_amdgcn_mfma_f32_16x16x4f32(a4[j], b4[nb][j], acc[nb], 0, 0, 0); }
          __syncthreads();
#pragma unroll
          for (int nb = 0; nb < 3; ++nb)
#pragma unroll
              for (int r = 0; r < 4; ++r) P[((kq * 2 + mt) * 16 + 4 * q + r) * 48 + nb * 16 + c] = acc[nb][r]; }
        __syncthreads();
        if (F.tid < 64) { const int tsel = F.tid & 31, tk = tb * 32 + tsel, mt = tsel >> 4, ti = tsel & 15;
            const LAS f32x4* P4 = (const LAS f32x4*)P;
            const int rb = (mt * 16 + ti) * 12;
            const float* bg1 = a.in[I_BG1] + l * 4; const float* bg2 = a.in[I_BG2] + l * 32;
            const f32x4 s1 = (P4[rb] + P4[rb + 384]) + (P4[rb + 768] + P4[rb + 1152]);
            const float l10 = s1.x + bg1[0], l11 = s1.y + bg1[1], l12 = s1.z + bg1[2], l13 = s1.w + bg1[3];
            int grp = 0; float mx = l10;
            if (l11 > mx) { mx = l11; grp = 1; } if (l12 > mx) { mx = l12; grp = 2; } if (l13 > mx) { mx = l13; grp = 3; }
            const float psel = 1.f / (expf(l10 - mx) + expf(l11 - mx) + expf(l12 - mx) + expf(l13 - mx));
            const int ob = rb + 1 + 2 * grp;
            const f32x4 sa = (P4[ob] + P4[ob + 384]) + (P4[ob + 768] + P4[ob + 1152]), sb = (P4[ob + 1] + P4[ob + 385]) + (P4[ob + 769] + P4[ob + 1153]);
            const f32x4 ba = *(const GAS f32x4*)(bg2 + grp * 8), bb = *(const GAS f32x4*)(bg2 + grp * 8 + 4);
            const float l2[8] = {sa.x + ba.x, sa.y + ba.y, sa.z + ba.z, sa.w + ba.w, sb.x + bb.x, sb.y + bb.y, sb.z + bb.z, sb.w + bb.w};
            int i0 = 0; float v0 = l2[0];
#pragma unroll
            for (int e = 1; e < 8; ++e) if (l2[e] > v0) { v0 = l2[e]; i0 = e; }
            int i1 = -1; float v1 = -INFINITY;
#pragma unroll
            for (int e = 0; e < 8; ++e) if (e != i0 && l2[e] > v1) { v1 = l2[e]; i1 = e; }
            const float e1 = expf(v1 - v0), g0 = psel / (1.f + e1), g1 = psel * e1 / (1.f + e1);
            const int ex0 = grp * 8 + i0, ex1 = grp * 8 + i1;
            const int which = F.lane >> 5, ex = which ? ex1 : ex0; const float gg = which ? g1 : g0;
            int leader = F.lane, idx = 0, gcount = 1;
            { unsigned long long rem = ~0ull;
              while (rem) { const int l0 = __builtin_ctzll(rem); const int le = __builtin_amdgcn_readlane(ex, l0); const unsigned long long mm = __ballot(ex == le);
                  if (ex == le) { leader = l0; idx = __builtin_popcountll(mm & ((1ull << F.lane) - 1ull)); gcount = __builtin_popcountll(mm); }
                  rem &= ~mm; } }
            unsigned base = 0u; if (F.lane == leader) base = __hip_atomic_fetch_add(cnt + 64 * ex, (unsigned)gcount, RLX_AGENT);
            base = (unsigned)__shfl((int)base, leader);
            const int rk = (int)base + idx;
            { int* list = (int*)(F.ws + (probe ? WS_OP + 2 * MiB : WS_LIST)); list[ex * 8192 + rk] = tk; }
            tok_e[2 * tk + which] = ex; tok_rank[2 * tk + which] = rk; tok_gate[2 * tk + which] = gg; }
        __syncthreads();
    }
}
__device__ __forceinline__ void moe_table(Frame& F, int l) {
    LAS int* tstart = (LAS int*)(F.lds + TAB_OFF);
    if (F.tid == 0) { int acc = 0;
        for (int e = 0; e < 32; ++e) { tstart[e] = acc; const unsigned c = __hip_atomic_load(F.ctl + CW_CNT + 2048 * l + 64 * e, RLX_AGENT); tstart[36 + e] = (int)c; acc += (int)((c + 255u) >> 8); }
        tstart[32] = acc; }
    __syncthreads();
}
__device__ __forceinline__ void ln2_phase(Frame& F, const Args& a, int l) {
    const bf16* x1b = (const bf16*)(F.ws + WS_X1B); const unsigned char* yb8 = F.ws + WS_YB; bf16* xb = (bf16*)(F.ws + WS_XB);
    const float* lng = a.in[I_LNG] + ((size_t)l * 2 + 1) * D; const float* lnb = a.in[I_LNB] + ((size_t)l * 2 + 1) * D;
    moe_table(F, l); const LAS int* tstart = (const LAS int*)(F.lds + TAB_OFF);
    const int* tok_e = (const int*)(F.ws + WS_ROUTE); const int* tok_rank = tok_e + 2 * T; const float* tok_gate = (const float*)(F.ws + WS_ROUTE) + 4 * T;
    const int gw = F.c * NWAVES + F.wave, NGW = F.G * NWAVES;
    for (int t4 = gw; t4 < T / 4; t4 += NGW) { const int tk0 = t4 * 4;
        int ev = 0, rv = 0; float gv = 0.f;
        if (F.lane < 8) { ev = tok_e[2 * tk0 + F.lane]; rv = tok_rank[2 * tk0 + F.lane]; gv = tok_gate[2 * tk0 + F.lane]; }
        const int slotv = (F.lane < 8) ? tstart[ev] * 256 + rv : 0;
        v4u xr[2], xr2[2]; v2u ya[2], yc[2], ya2[2], yc2[2];
#define LN2_LOAD(i, XR, YA, YC, XR2, YA2, YC2) do { const int s0_ = __builtin_amdgcn_readlane(slotv, 2 * (i)), s1_ = __builtin_amdgcn_readlane(slotv, 2 * (i) + 1); \
        _Pragma("unroll") for (int j = 0; j < 2; ++j) { const int d0 = 8 * F.lane + 512 * j; XR[j] = *(const GAS v4u*)(x1b + (size_t)(tk0 + (i)) * D + d0); YA[j] = *(const GAS v2u*)(yb8 + (size_t)s0_ * D + d0); YC[j] = *(const GAS v2u*)(yb8 + (size_t)s1_ * D + d0); } \
        _Pragma("unroll") for (int j = 0; j < 2; ++j) { const int d0 = 8 * F.lane + 512 * (j + 2); XR2[j] = *(const GAS v4u*)(x1b + (size_t)(tk0 + (i)) * D + d0); YA2[j] = *(const GAS v2u*)(yb8 + (size_t)s0_ * D + d0); YC2[j] = *(const GAS v2u*)(yb8 + (size_t)s1_ * D + d0); } } while (0)
        LN2_LOAD(0, xr, ya, yc, xr2, ya2, yc2);
#pragma unroll
        for (int i = 0; i < 4; ++i) { const int tk = tk0 + i;
            const float g0 = (1.f / 16.f) * __builtin_bit_cast(float, __builtin_amdgcn_readlane(__builtin_bit_cast(int, gv), 2 * i)), g1 = (1.f / 16.f) * __builtin_bit_cast(float, __builtin_amdgcn_readlane(__builtin_bit_cast(int, gv), 2 * i + 1));
            float v[4][8]; float s = 0.f;
#pragma unroll
            for (int j = 0; j < 4; ++j) { const v4u X = j < 2 ? xr[j] : xr2[j - 2]; const v2u A = j < 2 ? ya[j] : ya2[j - 2], C = j < 2 ? yc[j] : yc2[j - 2];
#define Y8(W, B) __builtin_amdgcn_cvt_f32_fp8((int)(W), (B))
                v[j][0] = bflo(X.x) * DN_ALPHA + (g0 * Y8(A.x, 0) + g1 * Y8(C.x, 0)); v[j][1] = bfhi(X.x) * DN_ALPHA + (g0 * Y8(A.x, 1) + g1 * Y8(C.x, 1));
                v[j][2] = bflo(X.y) * DN_ALPHA + (g0 * Y8(A.x, 2) + g1 * Y8(C.x, 2)); v[j][3] = bfhi(X.y) * DN_ALPHA + (g0 * Y8(A.x, 3) + g1 * Y8(C.x, 3));
                v[j][4] = bflo(X.z) * DN_ALPHA + (g0 * Y8(A.y, 0) + g1 * Y8(C.y, 0)); v[j][5] = bfhi(X.z) * DN_ALPHA + (g0 * Y8(A.y, 1) + g1 * Y8(C.y, 1));
                v[j][6] = bflo(X.w) * DN_ALPHA + (g0 * Y8(A.y, 2) + g1 * Y8(C.y, 2)); v[j][7] = bfhi(X.w) * DN_ALPHA + (g0 * Y8(A.y, 3) + g1 * Y8(C.y, 3));
#undef Y8
#pragma unroll
                for (int e = 0; e < 8; ++e) s += v[j][e]; }
            if (i + 1 < 4) LN2_LOAD(i + 1, xr, ya, yc, xr2, ya2, yc2);
            const float mean = wave_sum(s) * (1.f / D); float s2 = 0.f;
#pragma unroll
            for (int j = 0; j < 4; ++j)
#pragma unroll
                for (int e = 0; e < 8; ++e) { v[j][e] -= mean; s2 += v[j][e] * v[j][e]; }
            const float rstd = 1.f / sqrtf(wave_sum(s2) * (1.f / D) + LN_EPS);
#pragma unroll
            for (int j = 0; j < 4; ++j) { const int d0 = 8 * F.lane + 512 * j; const f32x4 g0v = *(const GAS f32x4*)(lng + d0), g1v = *(const GAS f32x4*)(lng + d0 + 4), b0 = *(const GAS f32x4*)(lnb + d0), b1 = *(const GAS f32x4*)(lnb + d0 + 4);
                const f32x4 oa = (f32x4){v[j][0] * rstd * g0v.x + b0.x, v[j][1] * rstd * g0v.y + b0.y, v[j][2] * rstd * g0v.z + b0.z, v[j][3] * rstd * g0v.w + b0.w};
                const f32x4 ob = (f32x4){v[j][4] * rstd * g1v.x + b1.x, v[j][5] * rstd * g1v.y + b1.y, v[j][6] * rstd * g1v.z + b1.z, v[j][7] * rstd * g1v.w + b1.w};
                if (l == DEPTH - 1) { *(GAS f32x4*)(a.out + (size_t)tk * D + d0) = oa; *(GAS f32x4*)(a.out + (size_t)tk * D + d0 + 4) = ob; }
                else { v4u w; w.x = pk2(oa.x, oa.y); w.y = pk2(oa.z, oa.w); w.z = pk2(ob.x, ob.y); w.w = pk2(ob.z, ob.w); *(GAS v4u*)(xb + (size_t)tk * D + d0) = w;
                    unsigned lo = 0u, hi = 0u; lo = __builtin_amdgcn_cvt_pk_fp8_f32(oa.x, oa.y, lo, false); lo = __builtin_amdgcn_cvt_pk_fp8_f32(oa.z, oa.w, lo, true); hi = __builtin_amdgcn_cvt_pk_fp8_f32(ob.x, ob.y, hi, false); hi = __builtin_amdgcn_cvt_pk_fp8_f32(ob.z, ob.w, hi, true);
                    v2u qq; qq.x = lo; qq.y = hi; if (F8L(l + 1)) *(GAS v2u*)(F.ws + WS_XQ + (size_t)tk * D + d0) = qq; } }
        }
#undef LN2_LOAD
    }
}

__global__ void __launch_bounds__(NWAVES * 64, 2) fwd_kernel(Args args) {
    extern __shared__ __attribute__((aligned(16))) unsigned char lds[];
    Frame F;
    F.lds = (LAS unsigned char*)lds; F.ldsg = (char*)lds;
    F.tid = threadIdx.x; F.lane = F.tid & 63; F.wave = __builtin_amdgcn_readfirstlane(F.tid >> 6);
    F.G = gridDim.x; F.c = blockIdx.x; F.ws = args.ws; F.ctl = (gu32*)(args.ws + WS_CTL);
    volatile LAS unsigned* MISC = (volatile LAS unsigned*)(F.lds + MISC_OFF);
    for (int u = F.tid; u < (LDS_BYTES - LDSCTL_OFF) / 4; u += NWAVES * 64) ((LAS unsigned*)(F.lds + LDSCTL_OFF))[u] = 0u;
    __syncthreads();
    const int lo = args.ph_lo, hi = args.ph_hi; int lastp = -1;
    const bool multi = (hi - lo) > 1;
    XcdBarrier bar; bar.bar = (unsigned*)(F.ctl + CW_BAR); bar.x = 0; bar.st = nullptr;
    if (multi) bar = xcd_barrier_post((unsigned*)(F.ctl + CW_BAR), MISC + 8);
#ifndef REP_MASK
#define REP_MASK 0
#endif
#define REP(k) for (int rep_ = 0; rep_ <= ((REP_MASK >> (k)) & 1); ++rep_)
#define IN(p) (lo <= (p) && (p) < hi)
#ifdef PROBE_A
#define STAMP(i) do { if (blockIdx.x == 0 && threadIdx.x == 0) ((unsigned long long*)(args.ws + WS_TS))[(i)] = __builtin_amdgcn_s_memrealtime(); } while (0)
#else
#define STAMP(i) do { } while (0)
#endif
#define SEAM(p) do { conv_note_fin(F, (p)); lastp = (p); if ((p) + 1 < hi) xcd_barrier(bar); STAMP((p) + 1); } while (0)
#define CONVFIN() ((lastp >= 0) ? (int)__hip_atomic_load(F.ctl + CW_FIN + 64 * lastp, RLX_AGENT) : 0)
#define FRESH() do { int t_ = threadIdx.x; asm volatile("" : "+v"(t_)); F.tid = t_; F.lane = t_ & 63; F.wave = __builtin_amdgcn_readfirstlane(t_ >> 6); \
    GAS unsigned char* w_ = (GAS unsigned char*)args.ws; asm volatile("" : "+s"(w_)); F.ws = (unsigned char*)w_; F.ctl = (gu32*)(w_ + WS_CTL); } while (0)

    STAMP(0);
    if (IN(0)) { FRESH(); REP(9) prologue_phase(F, args); SEAM(0); }
#ifdef XBAR
    for (int xb_ = 0; xb_ < XBAR; ++xb_) xcd_barrier(bar);
#endif

#pragma unroll 1
    for (int l_ = 0; l_ < DEPTH; ++l_) {
        const int pb = 1 + NPH_LAYER * l_;
#pragma unroll 1
        for (int k_ = 0; k_ < NPH_LAYER; ++k_) {
            const int p = pb + k_;
            if (!IN(p) || k_ == 5 || (k_ == 2 && l_ < 2)) continue;
            int l = l_, k = k_; asm volatile("" : "+s"(l), "+s"(k));
            FRESH();
            int cq = NQ, cn = 0;
            switch (k) {
            case 0: {
                const int N = (l < 2) ? NINA : (l == 2 ? 5120 : 2048);
                const unsigned char* Bt = F.ws + ((l < 2) ? WS_WAIN + (size_t)l * NINA * D * 2 : (l == 2 ? WS_WBIN0 : WS_WBIN1));
                const int nu = (T / 256) * (N / 256) + (l == 0 ? 16 : 0); const bool f8 = F8L(l);
                pg8::EpiBf16X E{l < 2 ? 0 : 1, (bf16*)(F.ws + WS_Z), (bf16*)(F.ws + WS_KD), (bf16*)(F.ws + WS_VD), (bf16*)(F.ws + WS_MEMKV), nullptr, nullptr};
                if (f8) { pg8::Gemm g{nullptr, nullptr, T, N, D / 2}; pg8::DualOrder8 S; S.init(F.ws + WS_XQ, Bt, T, N, D / 2, F.G, F.c, F.ws + WS_MEMQ, F.ws + WS_WMKV, l == 0 ? 16 : 0);
                    REP(0) pg8::gemm_phase<pg8::EpiBf16X, pg8::DualOrder8, true, true>(F.lds + RING_OFF, g, S, E); }
                else { pg8::Gemm g{nullptr, nullptr, T, N, D}; pg8::DualOrder S; S.init(F.ws + WS_XB, Bt, T, N, D, F.G, F.c, F.ws + WS_MEMB, F.ws + WS_WMKV, l == 0 ? 16 : 0);
                    REP(0) pg8::gemm_phase<pg8::EpiBf16X, pg8::DualOrder, true, true>(F.lds + RING_OFF, g, S, E); }
                { const int mine = (nu - 1 - F.c) / F.G + 1, rounds = (nu + F.G - 1) / F.G; cq = 2 * l; cn = (rounds - mine) * (f8 ? (QA + 1) / 2 : QA); }
            } break;
            case 1: {
                if (l < 2) {
                    REP(1) for (int u = F.c; u < 256 + 128; u += F.G) {
                        if (u < 256) sgu_unit(F, args, l, u >> 2, u & 3);
                        else { const int r = u - 256; memattn_unit(F, l, r & 3, r >> 2, NINA, 2 * MIXW); }
                    }
                    if (F.c >= 128) { cq = 2 * l; cn = QX; }
                } else {
                    const int ncv = CONVFIN() ? 0 : NCVATT;
                    if (F.c >= F.G - ncv) { conv_server_q(F, args, F.ctl + CW_Q + 64 * l, (unsigned)(att2::NUNITS + 128 - STOPU), 2 * l); __syncthreads(); }
                    REP(2) { gu32* qh = F.ctl + CW_Q + 64 * l + 16 * rep_; LAS unsigned* uw = (LAS unsigned*)(F.lds + att2::LDS_UNIT);
                    for (;;) {
                        if (F.tid == 0) *uw = __hip_atomic_fetch_add(qh, 1u, RLX_AGENT);
                        __syncthreads();
                        const unsigned idx = *uw;
                        __syncthreads();
                        if (idx >= (unsigned)(att2::NUNITS + 128)) break;
                        if (idx < (unsigned)att2::NUNITS) diffattn2_unit(F, args, att3::g_units.u[idx]);
                        else { const int r = (int)idx - att2::NUNITS; memattn_unit(F, l, r & 3, r >> 2, 2048, MIXW); }
                    } }
                }
            } break;
            case 2: { REP(3) diffcombine_phase(F, args, l); } break;
            case 3: {
                pg8::EpiResBf16 E{(const bf16*)(F.ws + WS_XB), (bf16*)(F.ws + WS_Y), DN_ALPHA};
                const unsigned char* Wo = F.ws + (l < 2 ? WS_WAOUT + (size_t)l * D * D * 2 : WS_WBOUT + (size_t)(l - 2) * D * D * 2);
                if (F8OL(l)) { pg8::Gemm g{nullptr, nullptr, T, D, D / 2}; pg8::DenseOrder8 S; S.init(F.ws + WS_CATQ, Wo, T, D, D / 2, F.G, F.c);
                    REP(4) pg8::gemm_phase<pg8::EpiResBf16, pg8::DenseOrder8, true, true>(F.lds + RING_OFF, g, S, E); }
                else { pg8::Gemm g{nullptr, nullptr, T, D, D}; pg8::DenseOrder S; S.init(F.ws + WS_CAT, Wo, T, D, D, F.G, F.c);
                    REP(4) pg8::gemm_phase<pg8::EpiResBf16, pg8::DenseOrder, true, true>(F.lds + RING_OFF, g, S, E); }
            } break;
            case 4: {
                ln1_router_phase(F, args, l);
#ifdef REP_LN1
                ln1_router_phase(F, args, l, 1);
#endif
                cq = 2 * l; cn = -1;
            } break;
            case 6: {
                moe_table(F, l);
                const LAS int* tb = (const LAS int*)(F.lds + TAB_OFF);
                pg8::Gemm g{nullptr, nullptr, SLOTS, 1024, D / 2};
                pg8::MoeGatherOrder S{tb, tb + 36, (const int*)(F.ws + WS_LIST), 4, F.G, F.c, (const char*)(F.ws + WS_X1F), (const char*)(F.ws + WS_W13) + (size_t)l * NE * 1024 * 2048, (size_t)1024 * 2048, (size_t)256 * 2048, (unsigned)D};
                pg8::EpiMoe1 E{(bf16*)(F.ws + WS_H), tb, tb + 36};
                REP(6) pg8::gemm_phase<pg8::EpiMoe1, pg8::MoeGatherOrder, true, true>(F.lds + RING_OFF, g, S, E);
                { const int nu = __builtin_amdgcn_readfirstlane(((const LAS int*)(F.lds + TAB_OFF))[32]) * 4, mine = (F.c < nu) ? (nu - 1 - F.c) / F.G + 1 : 0, rounds = (nu + F.G - 1) / F.G; cq = 2 * l + 1; cn = (rounds - mine) * QM; }
            } break;
            case 7: {
                moe_table(F, l);
                pg8::Gemm g{nullptr, nullptr, SLOTS, D, FF / 2};
                pg8::MoeOrder8 S{(const PG8_LAS int*)(F.lds + TAB_OFF), 8, F.G, F.c, (const char*)(F.ws + WS_H), (const char*)(F.ws + WS_W2) + (size_t)l * NE * 2048 * 512, (size_t)256 * FF, (size_t)2048 * 512, (size_t)256 * 512};
                pg8::EpiBf16X E{3, (bf16*)(F.ws + WS_YB), nullptr, nullptr, nullptr, (const PG8_LAS int*)(F.lds + TAB_OFF), (const PG8_LAS int*)(F.lds + TAB_OFF) + 36};
                REP(7) pg8::gemm_phase<pg8::EpiBf16X, pg8::MoeOrder8, true, true>(F.lds + RING_OFF, g, S, E);
                { const int nu = __builtin_amdgcn_readfirstlane(((const LAS int*)(F.lds + TAB_OFF))[32]) * 8, mine = (F.c < nu) ? (nu - 1 - F.c) / F.G + 1 : 0, rounds = (nu + F.G - 1) / F.G; cq = 2 * l + 1; cn = (rounds - mine) * QB; }
            } break;
            default: {
                REP(8) ln2_phase(F, args, l);
                cq = 2 * l + 1; cn = -1;
            } break;
            }
            FRESH();
            conv_filler(F, args, cq, cn);
            SEAM(p);
        }
    }
#ifdef PROBE_A
    {
        VM_WAIT(); xcd_barrier(bar);
        const unsigned long long* ts = (const unsigned long long*)(args.ws + WS_TS);
        float da = 0.f, db = 0.f;
        for (int p = 0; p < NPHASES; ++p) { const int k = (p == 0) ? 9 : (p - 1) % NPH_LAYER; const float d = (float)(ts[p + 1] - ts[p]);
            if (k == PROBE_A || PROBE_A == 10) da += d; if (k == PROBE_B || PROBE_B == 10) db += d; }
        const float kk = sqrtf(da), vv = db;
        float* o = args.out; const long n = (long)T * D;
        for (long i = (long)blockIdx.x * 512 + threadIdx.x; i < n; i += (long)gridDim.x * 512) o[i] = (i == 0) ? vv : kk;
    }
#endif
#undef IN
#undef SEAM
}

#ifndef MK_ONE_LAUNCH
#define MK_ONE_LAUNCH 1
#endif
extern "C" void kernel_launch(void* const* d_in, const int* in_sizes, int n_in, void* d_out, int out_size, void* d_ws, size_t ws_size, hipStream_t stream) {
    static int grid = 0;
    if (grid == 0) {
        if (n_in != 24 || in_sizes[0] != T * D || out_size != T * D || ws_size < WS_END) { fprintf(stderr, "kernel_launch: unexpected shapes (n_in %d, in0 %d, out %d, ws %zu < %zu)\n", n_in, n_in > 0 ? in_sizes[0] : -1, out_size, ws_size, (size_t)WS_END); grid = -1; return; }
        int dev = 0, cus = 0, per_cu = 0;
        if (hipGetDevice(&dev) != hipSuccess || hipDeviceGetAttribute(&cus, hipDeviceAttributeMultiprocessorCount, dev) != hipSuccess) { grid = -1; return; }
        if (hipFuncSetAttribute((const void*)fwd_kernel, hipFuncAttributeMaxDynamicSharedMemorySize, LDS_BYTES) != hipSuccess) { fprintf(stderr, "kernel_launch: hipFuncSetAttribute failed\n"); grid = -1; return; }
        if (hipOccupancyMaxActiveBlocksPerMultiprocessor(&per_cu, (const void*)fwd_kernel, NWAVES * 64, LDS_BYTES) != hipSuccess || per_cu < 1) fprintf(stderr, "kernel_launch: occupancy query reports %d\n", per_cu);
        (void)hipGetLastError();
        grid = cus;
    }
    if (grid < 0) return;
    if (hipMemsetAsync((char*)d_ws + WS_CTL, 0, CTL_ZERO_BYTES, stream) != hipSuccess) return;
    Args a{};
    for (int i = 0; i < 24; ++i) a.in[i] = (const float*)d_in[i];
    a.out = (float*)d_out; a.ws = (unsigned char*)d_ws;
#if MK_ONE_LAUNCH
    a.ph_lo = 0; a.ph_hi = NPHASES;
    hipLaunchKernelGGL(fwd_kernel, dim3(grid), dim3(NWAVES * 64), LDS_BYTES, stream, a);
#else
    for (int p = 0; p < NPHASES; ++p) {
        const int k = (p - 1) % NPH_LAYER, l = (p - 1) / NPH_LAYER;
        if (p > 0 && k == 2 && l < 2) continue;
        a.ph_lo = p; a.ph_hi = p + 1;
        hipLaunchKernelGGL(fwd_kernel, dim3(grid), dim3(NWAVES * 64), LDS_BYTES, stream, a);
    }
#endif
    const hipError_t le = hipPeekAtLastError();
    if (le != hipSuccess) fprintf(stderr, "kernel_launch: launch failed: %s\n", hipGetErrorName(le));
}
```

```cpp
#define F8MASK 12
#define F8OMASK 12
#include <hip/hip_runtime.h>
#include <cstdio>
#include <cstdint>
namespace pg8 {
#define PG8_LAS __attribute__((address_space(3)))
typedef unsigned short bf16_t;
typedef short bf16x8 __attribute__((ext_vector_type(8)));
typedef float f32x4 __attribute__((ext_vector_type(4)));
typedef unsigned u32x4 __attribute__((ext_vector_type(4)));
constexpr int BM = 256, BK = 64, HALF = 128, HTB = HALF * BK * 2  , STAGE_BYTES = 8 * HTB, NXCD = 8, WGM = 8;

__host__ __device__ __forceinline__ int lds_byte(int r, int c) { const int st = (r >> 4) * 2 + (c >> 5), rr = r & 15, cc = c & 31, ob = rr * 64 + cc * 2; return st * 1024 + (ob ^ (((ob >> 9) & 1) << 5)); }
__host__ __device__ __forceinline__ void stage_rc(int b, int& R, int& C) { const int st = b / 1024, sb = b % 1024, swz = sb ^ (((sb >> 9) & 1) << 5); R = (st >> 1) * 16 + swz / 64; C = (st & 1) * 32 + (swz % 64) / 2; }
__host__ __device__ __forceinline__ int perm32(int rho) { const int n = rho >> 4, i = rho & 15; return 8 * (i >> 2) + 4 * n + (i & 3); }

typedef int pg8_v4i __attribute__((ext_vector_type(4))); typedef int pg8_v8i __attribute__((ext_vector_type(8)));
__device__ __forceinline__ pg8_v8i pg8_cat8(bf16x8 a, bf16x8 b) { return __builtin_shufflevector(__builtin_bit_cast(pg8_v4i, a), __builtin_bit_cast(pg8_v4i, b), 0, 1, 2, 3, 4, 5, 6, 7); }
struct Unit { int pm, pn, e; };
struct Gemm { const bf16_t* A; const bf16_t* Bt; int M, N, K; };

struct StaticOrder {
    static constexpr bool GATHER = false, F8 = false; static constexpr int SCALE_B = 127;
    int nM, nN, nwg, G, c;
    __host__ __device__ void init(int M, int N, int G_, int c_) { nM = M / BM; nN = N / BM; nwg = nM * nN; G = G_; c = c_; }
    __host__ __device__ bool next(int i, Unit& u) const {
        const long L = (long)i * G + c; if (L >= nwg) return false;
        int wgid = (int)L; { const int q = nwg / NXCD, r = nwg % NXCD, xcd = wgid % NXCD, off = wgid / NXCD; wgid = (xcd < r ? xcd * (q + 1) : r * (q + 1) + (xcd - r) * q) + off; }
        const int nig = WGM * nN, gid = wgid / nig, fm = gid * WGM, gsz = (nM - fm) < WGM ? (nM - fm) : WGM;
        u.pm = fm + ((wgid % nig) % gsz); u.pn = (wgid % nig) / gsz; return true;
    }
    __device__ __forceinline__ void a_ready(const Unit&) const {}
    __device__ __forceinline__ void done(const Unit&) const {}
};

__device__ __forceinline__ unsigned cvt_pk_bf16(float lo, float hi) { unsigned r; asm volatile("v_cvt_pk_bf16_f32 %0, %1, %2" : "=v"(r) : "v"(lo), "v"(hi)); return r; }
typedef float f32x2 __attribute__((ext_vector_type(2)));
__device__ __forceinline__ f32x2 gelu_pk(f32x2 v) {
    const f32x2 av = __builtin_elementwise_abs(v), d = av * 0.2316418882f + 1.0f;
    f32x2 t; t.x = __builtin_amdgcn_rcpf(d.x); t.y = __builtin_amdgcn_rcpf(d.y);
    f32x2 q = t * 0.5307027145f + (-0.7265760135f); q = q * t + 0.7107068705f; q = q * t + (-0.142248368f); q = q * t + 0.127414796f; q = q * t;
    const f32x2 s = (v * v) * (-0.72134752044f);
    f32x2 e; e.x = __builtin_amdgcn_exp2f(s.x); e.y = __builtin_amdgcn_exp2f(s.y);
    const f32x2 m = v * (q * e), r = v - m;
    f32x2 o; o.x = v.x < 0.f ? m.x : r.x; o.y = v.y < 0.f ? m.y : r.y; return o;
}

template <class Epi, class Sched, bool ALIGN_EPI = false, bool SP2 = false>
__device__ __forceinline__ void gemm_phase(PG8_LAS unsigned char* lds, const Gemm g, const Sched& S, const Epi& E) {
    int tid_ = threadIdx.x; asm volatile("" : "+v"(tid_));
    const int tid = tid_, wid = __builtin_amdgcn_readfirstlane(tid >> 6), lane = tid & 63, wr = wid >> 2, wc = wid & 3, fr = lane & 15, fq = lane >> 4;
    const int K = g.K, nt = K / BK;
    unsigned voffA[2], voffB[2];
#pragma unroll
    for (int i = 0; i < 2; ++i) { int R, C; stage_rc(tid * 16 + i * 8192, R, C); const int Rb = Epi::PERM ? ((R & ~31) + perm32(R & 31)) : R;
        voffA[i] = (unsigned)(R * K + C) * 2u; voffB[i] = (unsigned)(Rb * K + C) * 2u; }
    unsigned vAc[2][2], vAn[2][2];
    int gR[2], gC[2];
#pragma unroll
    for (int i = 0; i < 2; ++i) { stage_rc(tid * 16 + i * 8192, gR[i], gC[i]); }
    const size_t kstep = (size_t)(BK * 2);
    const size_t hstep = (size_t)HALF * K * 2;
        const unsigned ldsw = (unsigned)wid * 1024u;
    const int aoff = lds_byte(wr * 64 + fr, fq * 8), boff = lds_byte(wc * 32 + fr, fq * 8);
#define PG8_SA(b, h) (((b) * 2 + (h)) * HTB)
#define PG8_SB(b, h) ((4 + (b) * 2 + (h)) * HTB)
#define PG8_STAGE(bufoff, gbase, voff) do { _Pragma("unroll") for (int _i = 0; _i < 2; ++_i) \
        __builtin_amdgcn_global_load_lds((const unsigned*)((const char*)(gbase) + (voff)[_i]), (PG8_LAS unsigned*)(lds + (bufoff) + ldsw + _i * 8192), 16, 0, 0); } while (0)
#define PG8_STAGE_A(b, h, base, VS) do { if constexpr (Sched::GATHER) { PG8_STAGE(PG8_SA(b, h), base, VS[h]); } else { PG8_STAGE(PG8_SA(b, h), (base) + (h) * hstep, voffA); } } while (0)
#define PG8_STAGE_AN(b, h, base) do { if constexpr (Sched::GATHER) { unsigned vs_[2] = {last ? vAn[h][0] : vAc[h][0], last ? vAn[h][1] : vAc[h][1]}; PG8_STAGE(PG8_SA(b, h), base, vs_); } else { PG8_STAGE(PG8_SA(b, h), (base) + (h) * hstep, voffA); } } while (0)
#define PG8_LDA(dst, b, h) do { if constexpr (Sched::F8) { _Pragma("unroll") for (int m = 0; m < 4; ++m) { dst##8[m].lo = *(const PG8_LAS pg8_v4i*)(lds + PG8_SA(b, h) + aoff + m * 2048); dst##8[m].hi = *(const PG8_LAS pg8_v4i*)(lds + PG8_SA(b, h) + aoff + m * 2048 + 1024); } } \
        else { _Pragma("unroll") for (int m = 0; m < 4; ++m) _Pragma("unroll") for (int k = 0; k < 2; ++k) dst[m][k] = *(const PG8_LAS bf16x8*)(lds + PG8_SA(b, h) + aoff + m * 2048 + k * 1024); } } while (0)
#define PG8_LDB(dst, b, h) do { if constexpr (Sched::F8) { _Pragma("unroll") for (int n = 0; n < 2; ++n) { dst##8[n].lo = *(const PG8_LAS pg8_v4i*)(lds + PG8_SB(b, h) + boff + n * 2048); dst##8[n].hi = *(const PG8_LAS pg8_v4i*)(lds + PG8_SB(b, h) + boff + n * 2048 + 1024); } } \
        else { _Pragma("unroll") for (int n = 0; n < 2; ++n) _Pragma("unroll") for (int k = 0; k < 2; ++k) dst[n][k] = *(const PG8_LAS bf16x8*)(lds + PG8_SB(b, h) + boff + n * 2048 + k * 1024); } } while (0)
#define PG8_MMA(ai, bj, At, Bt) do { __builtin_amdgcn_s_setprio(1); if constexpr (Sched::F8) { \
        _Pragma("unroll") for (int m = 0; m < 4; ++m) _Pragma("unroll") for (int n = 0; n < 2; ++n) \
            asm volatile("v_mfma_scale_f32_16x16x128_f8f6f4 %0, %1, %2, %0, %3, %4 op_sel_hi:[0,0,0]" : "+v"(acc[ai][bj][m][n]) : "v"(Bt##8[n]), "v"(At##8[m]), "v"(sclB_), "v"(sclA_));     \
        } else { _Pragma("unroll") for (int m = 0; m < 4; ++m) _Pragma("unroll") for (int n = 0; n < 2; ++n) _Pragma("unroll") for (int k = 0; k < 2; ++k) \
        acc[ai][bj][m][n] = __builtin_amdgcn_mfma_f32_16x16x32_bf16(Bt[n][k], At[m][k], acc[ai][bj][m][n], 0, 0, 0); } __builtin_amdgcn_s_setprio(0); } while (0)
#define PG8_WAIT_V(n) asm volatile("s_waitcnt vmcnt(" #n ")" ::: "memory")
#define PG8_WAIT_L(n) asm volatile("s_waitcnt lgkmcnt(" #n ")" ::: "memory")
#define PG8_BAR __builtin_amdgcn_s_barrier()
#define PG8_SCHED __builtin_amdgcn_sched_barrier(0)
    Unit cur, nxt; int ui = 0;
    if (!S.next(0, cur)) return;
    f32x4 acc[2][2][4][2];
#pragma unroll
    for (int a = 0; a < 2; ++a)
#pragma unroll
        for (int b = 0; b < 2; ++b)
#pragma unroll
            for (int m = 0; m < 4; ++m)
#pragma unroll
                for (int n = 0; n < 2; ++n) acc[a][b][m][n] = (f32x4){0.f, 0.f, 0.f, 0.f};
    const int sclB_ = Sched::SCALE_B, sclA_ = 127;
    bf16x8 At[4][2], B0[2][2], B1[2][2]; pg8_v8i At8[4], B08[2], B18[2];
    const char* cA = S.aptr(cur); const char* cB = S.bptr(cur);
    S.a_ready(cur);
    if constexpr (Sched::GATHER) {
#pragma unroll
        for (int h = 0; h < 2; ++h)
#pragma unroll
            for (int i = 0; i < 2; ++i) { vAc[h][i] = S.rowoff(cur, h * HALF + gR[i]) + (unsigned)gC[i] * 2u; vAn[h][i] = vAc[h][i]; }
        asm volatile("s_waitcnt vmcnt(0)" ::: "memory");
    }
    if constexpr (SP2) {
        PG8_STAGE(PG8_SB(0, 0), cB, voffB); PG8_STAGE(PG8_SB(0, 1), cB + hstep, voffB); PG8_STAGE_A(0, 0, cA, vAc); PG8_STAGE_A(0, 1, cA, vAc);
        if (wr == 1) PG8_BAR;
        PG8_WAIT_V(2); PG8_BAR;
        PG8_STAGE(PG8_SB(1, 0), cB + kstep, voffB); PG8_STAGE_A(1, 0, cA + kstep, vAc); PG8_STAGE(PG8_SB(1, 1), cB + hstep + kstep, voffB);
        PG8_WAIT_V(6); PG8_BAR;
    } else {
        PG8_STAGE(PG8_SB(0, 0), cB, voffB); PG8_STAGE_A(0, 0, cA, vAc); PG8_STAGE(PG8_SB(0, 1), cB + hstep, voffB); PG8_STAGE_A(0, 1, cA, vAc);
        if (wr == 1) PG8_BAR;
        PG8_WAIT_V(4); PG8_BAR;
        PG8_STAGE(PG8_SB(1, 0), cB + kstep, voffB); PG8_STAGE_A(1, 0, cA + kstep, vAc); PG8_STAGE(PG8_SB(1, 1), cB + hstep + kstep, voffB);
        PG8_WAIT_V(6); PG8_BAR;
    }
    for (;;) {
        const bool has_next = S.next(ui + 1, nxt);
        const char* nA = has_next ? S.aptr(nxt) : cA; const char* nB = has_next ? S.bptr(nxt) : cB;
        if constexpr (Sched::GATHER) { if (has_next) {
#pragma unroll
            for (int h = 0; h < 2; ++h)
#pragma unroll
                for (int i = 0; i < 2; ++i) vAn[h][i] = S.rowoff(nxt, h * HALF + gR[i]) + (unsigned)gC[i] * 2u; } }
        for (int t = 0; t < nt; t += 2) {
            const bool last = (t == nt - 2);
            const char* a1 = cA + (size_t)(t + 1) * kstep;
            const char* a2 = last ? nA : cA + (size_t)(t + 2) * kstep; const char* b2 = last ? nB : cB + (size_t)(t + 2) * kstep;
            const char* a3 = a2 + kstep; const char* b3 = b2 + kstep;
            if (last && has_next) S.a_ready(nxt);
            if constexpr (SP2) {
            PG8_LDB(B0, 0, 0); PG8_LDB(B1, 0, 1); PG8_SCHED; PG8_LDA(At, 0, 0); PG8_STAGE_A(1, 1, a1, vAc);
            PG8_WAIT_V(8); PG8_WAIT_L(0); PG8_BAR; PG8_MMA(0, 0, At, B0); PG8_MMA(0, 1, At, B1); PG8_BAR; PG8_SCHED;
            PG8_LDA(At, 0, 1); PG8_STAGE(PG8_SB(0, 0), b2, voffB); PG8_STAGE(PG8_SB(0, 1), b2 + hstep, voffB); PG8_STAGE_AN(0, 0, a2);
            PG8_WAIT_V(8); PG8_WAIT_L(0); PG8_BAR; PG8_MMA(1, 0, At, B0); PG8_MMA(1, 1, At, B1); PG8_BAR; PG8_SCHED;
            PG8_LDB(B0, 1, 0); PG8_LDB(B1, 1, 1); PG8_SCHED; PG8_LDA(At, 1, 0); PG8_STAGE_AN(0, 1, a2);
            PG8_WAIT_V(8); PG8_WAIT_L(0); PG8_BAR; PG8_MMA(0, 0, At, B0); PG8_MMA(0, 1, At, B1); PG8_BAR; PG8_SCHED;
            PG8_LDA(At, 1, 1); PG8_STAGE(PG8_SB(1, 0), b3, voffB); PG8_STAGE(PG8_SB(1, 1), b3 + hstep, voffB); PG8_STAGE_AN(1, 0, a3);
            PG8_WAIT_V(8); PG8_WAIT_L(0); PG8_BAR; PG8_MMA(1, 0, At, B0); PG8_MMA(1, 1, At, B1); PG8_BAR; PG8_SCHED;
            } else {
            PG8_LDB(B0, 0, 0); PG8_SCHED; PG8_LDA(At, 0, 0); PG8_STAGE_A(1, 1, a1, vAc);
            PG8_WAIT_L(8); PG8_BAR; PG8_WAIT_L(0); PG8_MMA(0, 0, At, B0); PG8_BAR; PG8_SCHED;
            PG8_LDB(B1, 0, 1); PG8_STAGE(PG8_SB(0, 0), b2, voffB);
            PG8_BAR; PG8_WAIT_L(0); PG8_MMA(0, 1, At, B1); PG8_BAR;
            PG8_LDA(At, 0, 1); PG8_STAGE_AN(0, 0, a2);
            PG8_BAR; PG8_WAIT_L(0); PG8_MMA(1, 0, At, B0); PG8_BAR; PG8_SCHED;
            PG8_STAGE(PG8_SB(0, 1), b2 + hstep, voffB);
            PG8_WAIT_V(6); PG8_BAR; PG8_MMA(1, 1, At, B1); PG8_BAR;
            PG8_LDB(B0, 1, 0); PG8_SCHED; PG8_LDA(At, 1, 0); PG8_STAGE_AN(0, 1, a2);
            PG8_WAIT_L(8); PG8_BAR; PG8_WAIT_L(0); PG8_MMA(0, 0, At, B0); PG8_BAR; PG8_SCHED;
            PG8_LDB(B1, 1, 1); PG8_STAGE(PG8_SB(1, 0), b3, voffB);
            PG8_BAR; PG8_WAIT_L(0); PG8_MMA(0, 1, At, B1); PG8_BAR;
            PG8_LDA(At, 1, 1); PG8_STAGE_AN(1, 0, a3);
            PG8_BAR; PG8_WAIT_L(0); PG8_MMA(1, 0, At, B0); PG8_BAR; PG8_SCHED;
            PG8_STAGE(PG8_SB(1, 1), b3 + hstep, voffB);
            PG8_WAIT_V(6); PG8_BAR; PG8_MMA(1, 1, At, B1); PG8_BAR;
            }
        }
        if constexpr (ALIGN_EPI) { if (wr == 0) PG8_BAR; }
        if constexpr (!Epi::AFTER_DRAIN) { E(acc, cur, wr, wc, fr, fq); S.done(cur); }
        if (!has_next) break;
#pragma unroll
        for (int a = 0; a < 2; ++a)
#pragma unroll
            for (int b = 0; b < 2; ++b)
#pragma unroll
                for (int m = 0; m < 4; ++m)
#pragma unroll
                    for (int n = 0; n < 2; ++n) acc[a][b][m][n] = (f32x4){0.f, 0.f, 0.f, 0.f};
        cur = nxt; cA = nA; cB = nB; ++ui;
        if constexpr (Sched::GATHER) {
#pragma unroll
            for (int h = 0; h < 2; ++h)
#pragma unroll
                for (int i = 0; i < 2; ++i) vAc[h][i] = vAn[h][i]; }
        if constexpr (ALIGN_EPI) { if (wr == 1) PG8_BAR; }
    }
    PG8_WAIT_V(0);
    if constexpr (!ALIGN_EPI) { if (wr == 0) PG8_BAR; }
    PG8_BAR;
    if constexpr (Epi::AFTER_DRAIN) { E.fused(acc, cur, wr, wc, fr, fq, lds, wid, lane); S.done(cur); }
#undef PG8_SA
#undef PG8_SB
#undef PG8_STAGE
#undef PG8_STAGE_A
#undef PG8_STAGE_AN
#undef PG8_LDA
#undef PG8_LDB
#undef PG8_MMA
#undef PG8_WAIT_V
#undef PG8_WAIT_L
#undef PG8_BAR
#undef PG8_SCHED
}
}

constexpr int T = 8192, D = 2048, MIXW = 1536, MEMW = 512, NINA = 3584, DEPTH = 4, NE = 32, FF = 512, MEMT = 256;
constexpr int SLOTS = 24576;
constexpr float LN_EPS = 1e-5f;
constexpr float DN_ALPHA = 1.6817928305074292f;
constexpr float LOG2E = 1.4426950408889634f;
constexpr float QSCALE = 0.08838834764831845f * LOG2E;
constexpr int NWAVES = 8;

constexpr size_t MiB = 1u << 20;
constexpr size_t WS_CTL = 0, CTL_ZERO_BYTES = 1 * MiB;
constexpr size_t WS_WAIN = 2 * MiB, WS_WAOUT = 30 * MiB, WS_WBIN0 = 46 * MiB, WS_WKV = 54 * MiB, WS_WBIN1 = 66 * MiB, WS_WBOUT = 74 * MiB, WS_WMKV = 90 * MiB;
constexpr size_t WS_W13 = 106 * MiB, WS_W2 = 618 * MiB;
constexpr size_t WS_XB = 874 * MiB, WS_MEMB = 906 * MiB, WS_MEMKV = 907 * MiB, WS_Z = 910 * MiB, WS_KD = 966 * MiB, WS_VD = 990 * MiB, WS_CAT = 1014 * MiB;
constexpr size_t WS_XQ = 1206 * MiB, WS_ZQ = 1222 * MiB, WS_MEMQ = 1238 * MiB, WS_CATQ = 1246 * MiB;
constexpr size_t WS_Y = 1046 * MiB, WS_X1F = 1110 * MiB, WS_X1B = 1174 * MiB, WS_XF = 1206 * MiB, WS_XG = 1270 * MiB, WS_H = 1366 * MiB, WS_YB = 1390 * MiB, WS_OP = 1486 * MiB;
constexpr size_t WS_ROUTE = 1582 * MiB, WS_OP2 = 1583 * MiB, WS_ML = 1631 * MiB, WS_WR = 1634 * MiB, WS_TS = 1640 * MiB, WS_LIST = 1641 * MiB, WS_END = 1642 * MiB;
constexpr int CW_TMO = 0, CW_BAR = 4096, CW_CNT = 16384, CW_Q = 28672, CW_CONV = 29184, CW_DONE = 32768, CW_FIN = 40960;

constexpr int RING_OFF = 0, RING_BYTES = 131072;
constexpr int LDSCTL_OFF = 146432, MISC_OFF = LDSCTL_OFF + 320, TAB_OFF = LDSCTL_OFF + 512;
constexpr int LDS_BYTES = 147456;

#define GAS __attribute__((address_space(1)))
#define LAS __attribute__((address_space(3)))
typedef unsigned short bf16;
typedef unsigned v4u __attribute__((ext_vector_type(4)));
typedef unsigned v2u __attribute__((ext_vector_type(2)));
typedef float f32x4 __attribute__((ext_vector_type(4)));
typedef short bf16x8 __attribute__((ext_vector_type(8)));
typedef GAS unsigned gu32;
#define RLX_AGENT __ATOMIC_RELAXED, __HIP_MEMORY_SCOPE_AGENT
#define LDS_WAIT() asm volatile("s_waitcnt lgkmcnt(0)" ::: "memory")
#define VM_WAIT() asm volatile("s_waitcnt vmcnt(0)" ::: "memory")
__device__ __forceinline__ unsigned f2bf(float f) { unsigned u = __builtin_bit_cast(unsigned, f); return (u + 0x7fffu + ((u >> 16) & 1u)) >> 16; }
__device__ __forceinline__ unsigned pk2(float lo, float hi) { return f2bf(lo) | (f2bf(hi) << 16); }
__device__ __forceinline__ float bf2f(unsigned short b) { return __builtin_bit_cast(float, (unsigned)b << 16); }
__device__ __forceinline__ float bflo(unsigned w) { return __builtin_bit_cast(float, w << 16); }
__device__ __forceinline__ float bfhi(unsigned w) { return __builtin_bit_cast(float, w & 0xffff0000u); }
__device__ __forceinline__ float wave_sum(float v) {
#pragma unroll
    for (int o = 1; o < 64; o <<= 1) v += __shfl_xor(v, o);
    return v;
}

namespace pg8 {
struct DenseOrder {
    static constexpr bool GATHER = false, F8 = false; static constexpr int SCALE_B = 127;
    StaticOrder so; const char* A; const char* B; size_t astep, bstep;
    __device__ void init(const void* A_, const void* B_, int M, int N, int K, int G, int c) { so.init(M, N, G, c); A = (const char*)A_; B = (const char*)B_; astep = (size_t)256 * K * 2; bstep = astep; }
    __device__ __forceinline__ bool next(int i, Unit& u) const { u.e = 0; return so.next(i, u); }
    __device__ __forceinline__ const char* aptr(const Unit& u) const { return A + (size_t)u.pm * astep; }
    __device__ __forceinline__ const char* bptr(const Unit& u) const { return B + (size_t)u.pn * bstep; }
    __device__ __forceinline__ void a_ready(const Unit&) const {}
    __device__ __forceinline__ void done(const Unit&) const {}
};
struct DenseOrder8 {
    static constexpr bool GATHER = false, F8 = true; static constexpr int SCALE_B = 121;
    StaticOrder so; const char* A; const char* B; size_t astep, bstep;
    __device__ void init(const void* A_, const void* B_, int M, int N, int K, int G, int c) { so.init(M, N, G, c); A = (const char*)A_; B = (const char*)B_; astep = (size_t)256 * K * 2; bstep = astep; }
    __device__ __forceinline__ bool next(int i, Unit& u) const { u.e = 0; return so.next(i, u); }
    __device__ __forceinline__ const char* aptr(const Unit& u) const { return A + (size_t)u.pm * astep; }
    __device__ __forceinline__ const char* bptr(const Unit& u) const { return B + (size_t)u.pn * bstep; }
    __device__ __forceinline__ void a_ready(const Unit&) const {}
    __device__ __forceinline__ void done(const Unit&) const {}
};
struct DualOrder {
    static constexpr bool GATHER = false, F8 = false; static constexpr int SCALE_B = 127;
    StaticOrder so; int nwg2; const char* A; const char* B; const char* A2; const char* B2; size_t step;
    __device__ void init(const void* A_, const void* B_, int M, int N, int K, int G, int c, const void* A2_, const void* B2_, int nwg2_) { so.init(M, N, G, c); A = (const char*)A_; B = (const char*)B_; A2 = (const char*)A2_; B2 = (const char*)B2_; nwg2 = nwg2_; step = (size_t)256 * K * 2; }
    __device__ __forceinline__ bool next(int i, Unit& u) const { const int L = i * so.G + so.c; if (L < so.nwg) { u.e = 0; return so.next(i, u); } if (L - so.nwg >= nwg2) return false; u.e = 1; u.pm = 0; u.pn = L - so.nwg; return true; }
    __device__ __forceinline__ const char* aptr(const Unit& u) const { return u.e ? A2 : A + (size_t)u.pm * step; }
    __device__ __forceinline__ const char* bptr(const Unit& u) const { return (u.e ? B2 : B) + (size_t)u.pn * step; }
    __device__ __forceinline__ void a_ready(const Unit&) const {}
    __device__ __forceinline__ void done(const Unit&) const {}
};
struct DualOrder8 {
    static constexpr bool GATHER = false, F8 = true; static constexpr int SCALE_B = 121;
    StaticOrder so; int nwg2; const char* A; const char* B; const char* A2; const char* B2; size_t step;
    __device__ void init(const void* A_, const void* B_, int M, int N, int K, int G, int c, const void* A2_, const void* B2_, int nwg2_) { so.init(M, N, G, c); A = (const char*)A_; B = (const char*)B_; A2 = (const char*)A2_; B2 = (const char*)B2_; nwg2 = nwg2_; step = (size_t)256 * K * 2; }
    __device__ __forceinline__ bool next(int i, Unit& u) const { const int L = i * so.G + so.c; if (L < so.nwg) { u.e = 0; return so.next(i, u); } if (L - so.nwg >= nwg2) return false; u.e = 1; u.pm = 0; u.pn = L - so.nwg; return true; }
    __device__ __forceinline__ const char* aptr(const Unit& u) const { return u.e ? A2 : A + (size_t)u.pm * step; }
    __device__ __forceinline__ const char* bptr(const Unit& u) const { return (u.e ? B2 : B) + (size_t)u.pn * step; }
    __device__ __forceinline__ void a_ready(const Unit&) const {}
    __device__ __forceinline__ void done(const Unit&) const {}
};
struct MoeOrder {
    static constexpr bool GATHER = false, F8 = false; static constexpr int SCALE_B = 127;
    const PG8_LAS int* tstart; int ntn, G, c; const char* A; const char* W; size_t astep, wexp, wtile;
    __device__ __forceinline__ bool next(int i, Unit& u) const {
        const int L = i * G + c, total = tstart[32] * ntn; if (L >= total) return false;
        int wgid; { const int q = total / NXCD, r = total % NXCD, xcd = L % NXCD, off = L / NXCD; wgid = (xcd < r ? xcd * (q + 1) : r * (q + 1) + (xcd - r) * q) + off; }
        u.pm = wgid / ntn; u.pn = wgid - u.pm * ntn; int e = 0;
#pragma unroll
        for (int k = 1; k <= 31; ++k) e += (tstart[k] <= u.pm) ? 1 : 0;
        u.e = e; return true;
    }
    __device__ __forceinline__ const char* aptr(const Unit& u) const { return A + (size_t)u.pm * astep; }
    __device__ __forceinline__ const char* bptr(const Unit& u) const { return W + (size_t)u.e * wexp + (size_t)u.pn * wtile; }
    __device__ __forceinline__ void a_ready(const Unit&) const {}
    __device__ __forceinline__ void done(const Unit&) const {}
};

struct MoeOrder8 {
    static constexpr bool GATHER = false, F8 = true; static constexpr int SCALE_B = 121;
    const PG8_LAS int* tstart; int ntn, G, c; const char* A; const char* W; size_t astep, wexp, wtile;
    __device__ __forceinline__ bool next(int i, Unit& u) const {
        const int L = i * G + c, total = tstart[32] * ntn; if (L >= total) return false;
        int wgid; { const int q = total / NXCD, r = total % NXCD, xcd = L % NXCD, off = L / NXCD; wgid = (xcd < r ? xcd * (q + 1) : r * (q + 1) + (xcd - r) * q) + off; }
        u.pm = wgid / ntn; u.pn = wgid - u.pm * ntn; int e = 0;
#pragma unroll
        for (int k = 1; k <= 31; ++k) e += (tstart[k] <= u.pm) ? 1 : 0;
        u.e = e; return true;
    }
    __device__ __forceinline__ const char* aptr(const Unit& u) const { return A + (size_t)u.pm * astep; }
    __device__ __forceinline__ const char* bptr(const Unit& u) const { return W + (size_t)u.e * wexp + (size_t)u.pn * wtile; }
    __device__ __forceinline__ void a_ready(const Unit&) const {}
    __device__ __forceinline__ void done(const Unit&) const {}
};

struct MoeGatherOrder {
    static constexpr bool GATHER = true, F8 = true; static constexpr int SCALE_B = 121;
    const PG8_LAS int* tstart; const PG8_LAS int* cntl; const int* list; int ntn, G, c; const char* A; const char* W; size_t wexp, wtile; unsigned rowbytes;
    __device__ __forceinline__ bool next(int i, Unit& u) const {
        const int L = i * G + c, total = tstart[32] * ntn; if (L >= total) return false;
        int wgid; { const int q = total / NXCD, r = total % NXCD, xcd = L % NXCD, off = L / NXCD; wgid = (xcd < r ? xcd * (q + 1) : r * (q + 1) + (xcd - r) * q) + off; }
        u.pm = wgid / ntn; u.pn = wgid - u.pm * ntn; int e = 0;
#pragma unroll
        for (int k = 1; k <= 31; ++k) e += (tstart[k] <= u.pm) ? 1 : 0;
        u.e = e; return true;
    }
    __device__ __forceinline__ unsigned rowoff(const Unit& u, int r) const { const int rank = (u.pm - tstart[u.e]) * 256 + r; const int tok = list[u.e * 8192 + (rank < cntl[u.e] ? rank : 0)]; return (unsigned)tok * rowbytes; }
    __device__ __forceinline__ const char* aptr(const Unit&) const { return A; }
    __device__ __forceinline__ const char* bptr(const Unit& u) const { return W + (size_t)u.e * wexp + (size_t)u.pn * wtile; }
    __device__ __forceinline__ void a_ready(const Unit&) const {}
    __device__ __forceinline__ void done(const Unit&) const {}
};

typedef unsigned u32x2 __attribute__((ext_vector_type(2)));
struct EpiBf16X {
    static constexpr bool PERM = true, AFTER_DRAIN = false;
    int mode; bf16_t* p0; bf16_t* p1; bf16_t* p2; bf16_t* p3;
    const PG8_LAS int* tstart; const PG8_LAS int* cntl;
    __device__ __forceinline__ void operator()(const f32x4 (&acc)[2][2][4][2], const Unit& u, int wr, int wc, int fr, int fq) const {
#ifndef ATT_BF16
        if (mode == 1 && !u.e) {
            int tok0 = u.pm * BM + wr * 64 + fr, cc0 = wc * 32 + 8 * fq; asm volatile("" : "+v"(tok0), "+v"(cc0));
            if (u.pn >= 14) { const int colv = (u.pn - 14) * BM + cc0; unsigned char* vb = (unsigned char*)p2 + ((size_t)((colv >> 8) * 128 + (tok0 >> 6)) * 256 + (colv & 255)) * 64 + (tok0 & 63);
#pragma unroll
                for (int ai = 0; ai < 2; ++ai)
#pragma unroll
                    for (int m = 0; m < 4; ++m)
#pragma unroll
                        for (int bj = 0; bj < 2; ++bj) { const f32x4 v0 = acc[ai][bj][m][0], v1 = acc[ai][bj][m][1]; unsigned a_ = 0u, b_ = 0u;
                            a_ = __builtin_amdgcn_cvt_pk_fp8_f32(v0[0], v0[1], a_, false); a_ = __builtin_amdgcn_cvt_pk_fp8_f32(v0[2], v0[3], a_, true); b_ = __builtin_amdgcn_cvt_pk_fp8_f32(v1[0], v1[1], b_, false); b_ = __builtin_amdgcn_cvt_pk_fp8_f32(v1[2], v1[3], b_, true);
                            unsigned char* vp = vb + (size_t)(ai * 2) * 16384 + m * 16 + (size_t)bj * HALF * 64;
                            vp[0] = (unsigned char)a_; vp[64] = (unsigned char)(a_ >> 8); vp[128] = (unsigned char)(a_ >> 16); vp[192] = (unsigned char)(a_ >> 24);
                            vp[256] = (unsigned char)b_; vp[320] = (unsigned char)(b_ >> 8); vp[384] = (unsigned char)(b_ >> 16); vp[448] = (unsigned char)(b_ >> 24); }
                return; }
            if (u.pn >= 8) { unsigned char* kb = (unsigned char*)p1 + (size_t)tok0 * 1536 + (u.pn - 8) * BM + cc0;
#pragma unroll
                for (int ai = 0; ai < 2; ++ai)
#pragma unroll
                    for (int m = 0; m < 4; ++m)
#pragma unroll
                        for (int bj = 0; bj < 2; ++bj) { const f32x4 v0 = acc[ai][bj][m][0], v1 = acc[ai][bj][m][1]; unsigned a_ = 0u, b_ = 0u;
                            a_ = __builtin_amdgcn_cvt_pk_fp8_f32(v0[0], v0[1], a_, false); a_ = __builtin_amdgcn_cvt_pk_fp8_f32(v0[2], v0[3], a_, true); b_ = __builtin_amdgcn_cvt_pk_fp8_f32(v1[0], v1[1], b_, false); b_ = __builtin_amdgcn_cvt_pk_fp8_f32(v1[2], v1[3], b_, true);
                            u32x2 kk; kk.x = a_; kk.y = b_; *(u32x2*)(kb + (size_t)(ai * HALF + m * 16) * 1536 + bj * HALF) = kk; }
                return; }
            { unsigned char* qb = (unsigned char*)p0 + (WS_ZQ - WS_Z) + (size_t)tok0 * 2048 + u.pn * BM + cc0; bf16_t* zb = p0 + (size_t)tok0 * 2048 + u.pn * BM + cc0;
#pragma unroll
                for (int ai = 0; ai < 2; ++ai)
#pragma unroll
                    for (int m = 0; m < 4; ++m)
#pragma unroll
                        for (int bj = 0; bj < 2; ++bj) { const f32x4 v0 = acc[ai][bj][m][0] * QSCALE, v1 = acc[ai][bj][m][1] * QSCALE; unsigned a_ = 0u, b_ = 0u;
                            a_ = __builtin_amdgcn_cvt_pk_fp8_f32(v0[0], v0[1], a_, false); a_ = __builtin_amdgcn_cvt_pk_fp8_f32(v0[2], v0[3], a_, true); b_ = __builtin_amdgcn_cvt_pk_fp8_f32(v1[0], v1[1], b_, false); b_ = __builtin_amdgcn_cvt_pk_fp8_f32(v1[2], v1[3], b_, true);
                            const size_t o_ = (size_t)(ai * HALF + m * 16) * 2048 + bj * HALF;
                            u32x2 qq; qq.x = a_; qq.y = b_; *(u32x2*)(qb + o_) = qq;
                            if (u.pn >= 6) { u32x4 w; w.x = cvt_pk_bf16(v0[0], v0[1]); w.y = cvt_pk_bf16(v0[2], v0[3]); w.z = cvt_pk_bf16(v1[0], v1[1]); w.w = cvt_pk_bf16(v1[2], v1[3]); *(u32x4*)(zb + o_) = w; } }
                return; }
        }
#endif
        if (mode == 3) {
            int r0_ = wr * 64 + fr, c0_ = u.pn * BM + wc * 32 + 8 * fq; asm volatile("" : "+v"(r0_), "+v"(c0_));
            const int rlim = cntl[u.e] - (u.pm - tstart[u.e]) * BM;
            unsigned char* yb_ = (unsigned char*)p0 + (size_t)(u.pm * BM + r0_) * 2048 + c0_;
#pragma unroll
            for (int ai = 0; ai < 2; ++ai)
#pragma unroll
                for (int m = 0; m < 4; ++m) { if (r0_ + ai * HALF + m * 16 >= rlim) continue;
#pragma unroll
                    for (int bj = 0; bj < 2; ++bj) { const f32x4 v0 = acc[ai][bj][m][0] * 16.f, v1 = acc[ai][bj][m][1] * 16.f; unsigned a_ = 0u, b_ = 0u;
                        a_ = __builtin_amdgcn_cvt_pk_fp8_f32(v0[0], v0[1], a_, false); a_ = __builtin_amdgcn_cvt_pk_fp8_f32(v0[2], v0[3], a_, true); b_ = __builtin_amdgcn_cvt_pk_fp8_f32(v1[0], v1[1], b_, false); b_ = __builtin_amdgcn_cvt_pk_fp8_f32(v1[2], v1[3], b_, true);
                        u32x2 q_; q_.x = a_; q_.y = b_; *(u32x2*)(yb_ + (size_t)(ai * HALF + m * 16) * 2048 + bj * HALF) = q_; } }
            return; }
        bf16_t* base; int ldc, colt; bool act = false; float sc = 1.f;
        if (u.e && mode < 2) { base = p3 + (size_t)(u.pn >> 2) * (256 * 1024); ldc = 1024; colt = (u.pn & 3) * BM; }
        else if (mode == 0) { base = p0; ldc = 3584; colt = u.pn * BM; act = u.pn < 12; if (u.pn >= 12) sc = QSCALE; }
        else if (mode == 1) { if (u.pn < 8) { base = p0; ldc = 2048; colt = u.pn * BM; sc = QSCALE; }
                              else if (u.pn < 14) { base = p1; ldc = 1536; colt = (u.pn - 8) * BM; } else { base = p2; ldc = 1536; colt = (u.pn - 14) * BM; } }
        else { base = p0; ldc = 2048; colt = u.pn * BM; }
        const int row0 = u.pm * BM + wr * 64 + fr, col0 = colt + wc * 32 + 8 * fq;
        const int rlim = (mode == 3) ? cntl[u.e] - (u.pm - tstart[u.e]) * BM : BM;
#pragma unroll
        for (int ai = 0; ai < 2; ++ai)
#pragma unroll
            for (int m = 0; m < 4; ++m) { bf16_t* rowp = base + (size_t)(row0 + ai * HALF + m * 16) * ldc + col0;
                if (wr * 64 + fr + ai * HALF + m * 16 >= rlim) continue;
#pragma unroll
                for (int bj = 0; bj < 2; ++bj) { f32x4 v0 = acc[ai][bj][m][0], v1 = acc[ai][bj][m][1];
                    if (act) { f32x2 a = gelu_pk((f32x2){v0[0], v0[1]}), b = gelu_pk((f32x2){v0[2], v0[3]}), c = gelu_pk((f32x2){v1[0], v1[1]}), d = gelu_pk((f32x2){v1[2], v1[3]});
                        v0 = (f32x4){a.x, a.y, b.x, b.y}; v1 = (f32x4){c.x, c.y, d.x, d.y}; }
                    v0 = v0 * sc; v1 = v1 * sc; u32x4 w; w.x = cvt_pk_bf16(v0[0], v0[1]); w.y = cvt_pk_bf16(v0[2], v0[3]); w.z = cvt_pk_bf16(v1[0], v1[1]); w.w = cvt_pk_bf16(v1[2], v1[3]);
                    *(u32x4*)(rowp + bj * HALF) = w; } }
    }
};
struct EpiResBf16 {
    static constexpr bool PERM = true, AFTER_DRAIN = false;
    const bf16_t* xres; bf16_t* y; float alpha;
    __device__ __forceinline__ void operator()(const f32x4 (&acc)[2][2][4][2], const Unit& u, int wr, int wc, int fr, int fq) const {
        const int row0 = u.pm * BM + wr * 64 + fr, col0 = u.pn * BM + wc * 32 + 8 * fq;
#pragma unroll
        for (int ai = 0; ai < 2; ++ai)
#pragma unroll
            for (int m = 0; m < 4; ++m) { const size_t off = (size_t)(row0 + ai * HALF + m * 16) * 2048 + col0;
#pragma unroll
                for (int bj = 0; bj < 2; ++bj) { const u32x4 xr = *(const u32x4*)(xres + off + bj * HALF); const f32x4 v0 = acc[ai][bj][m][0], v1 = acc[ai][bj][m][1]; u32x4 w;
                    w.x = cvt_pk_bf16(__builtin_bit_cast(float, xr.x << 16) * alpha + v0[0], __builtin_bit_cast(float, xr.x & 0xffff0000u) * alpha + v0[1]);
                    w.y = cvt_pk_bf16(__builtin_bit_cast(float, xr.y << 16) * alpha + v0[2], __builtin_bit_cast(float, xr.y & 0xffff0000u) * alpha + v0[3]);
                    w.z = cvt_pk_bf16(__builtin_bit_cast(float, xr.z << 16) * alpha + v1[0], __builtin_bit_cast(float, xr.z & 0xffff0000u) * alpha + v1[1]);
                    w.w = cvt_pk_bf16(__builtin_bit_cast(float, xr.w << 16) * alpha + v1[2], __builtin_bit_cast(float, xr.w & 0xffff0000u) * alpha + v1[3]);
                    *(u32x4*)(y + off + bj * HALF) = w; } }
    }
};
struct EpiMoe1 {
    static constexpr bool PERM = true, AFTER_DRAIN = false;
    bf16_t* h; const PG8_LAS int* tstart; const PG8_LAS int* cntl;
    __device__ __forceinline__ void operator()(const f32x4 (&acc)[2][2][4][2], const Unit& u, int wr, int wc, int fr, int fq) const {
        const int row0 = u.pm * BM + wr * 64 + fr, col0 = u.pn * HALF + wc * 32 + 8 * fq;
        const int rlim = cntl[u.e] - (u.pm - tstart[u.e]) * BM;
#pragma unroll
        for (int ai = 0; ai < 2; ++ai)
#pragma unroll
            for (int m = 0; m < 4; ++m) { unsigned char* rowp = (unsigned char*)h + (size_t)(row0 + ai * HALF + m * 16) * 512 + col0; float o[8];
                if (wr * 64 + fr + ai * HALF + m * 16 >= rlim) continue;
#pragma unroll
                for (int n = 0; n < 2; ++n)
#pragma unroll
                    for (int x = 0; x < 4; ++x) { const float a = acc[ai][0][m][n][x], b = acc[ai][1][m][n][x];
                        o[n * 4 + x] = a * __builtin_amdgcn_rcpf(1.0f + __builtin_amdgcn_exp2f(-a * LOG2E)) * b; }
                unsigned lo = 0u, hi = 0u; lo = __builtin_amdgcn_cvt_pk_fp8_f32(o[0], o[1], lo, false); lo = __builtin_amdgcn_cvt_pk_fp8_f32(o[2], o[3], lo, true);
                hi = __builtin_amdgcn_cvt_pk_fp8_f32(o[4], o[5], hi, false); hi = __builtin_amdgcn_cvt_pk_fp8_f32(o[6], o[7], hi, true);
                typedef unsigned u32x2e __attribute__((ext_vector_type(2))); u32x2e w; w.x = lo; w.y = hi; *(u32x2e*)rowp = w; }
    }
};
}

namespace att {
using bf16x8 = __attribute__((ext_vector_type(8))) short;
using s16x4  = __attribute__((ext_vector_type(4))) short;
using f32x16 = __attribute__((ext_vector_type(16))) float;
using u32x4  = __attribute__((ext_vector_type(4))) unsigned;
constexpr int DH = 128, QBLK = 32, KVBLK = 64;
constexpr float THR2 = 8.f * 1.4426950408889634f;
constexpr size_t SHM_V = KVBLK * DH * 2, SHM_K = KVBLK * DH * 2, SHM_ATTN = 2 * SHM_V + 2 * SHM_K + NWAVES * 64 * 4;
constexpr int TAB_N = 160;
#define KSWZ(row, colB) ((row) * 256 + ((colB) ^ (((row) & 7) << 4)))
#define SBAR() __builtin_amdgcn_sched_barrier(0)
__device__ __forceinline__ int crow(int r, int hi) { return (r & 3) + 8 * (r >> 2) + 4 * hi; }
__device__ __forceinline__ unsigned cvtpk(float lo, float hi) { unsigned r; asm volatile("v_cvt_pk_bf16_f32 %0, %1, %2" : "=v"(r) : "v"(lo), "v"(hi)); return r; }

__device__ __forceinline__ void partialSM(f32x16& p0, f32x16& p1, float& m_reg, float& mn, float& alpha) {
  float pmax = p0[0];
#pragma unroll
  for (int r = 1; r < 16; ++r) pmax = fmaxf(pmax, p0[r]);
#pragma unroll
  for (int r = 0; r < 16; ++r) pmax = fmaxf(pmax, p1[r]);
  { auto rr = __builtin_amdgcn_permlane32_swap(__float_as_uint(pmax), __float_as_uint(pmax), false, false);
    pmax = fmaxf(__uint_as_float(rr[0]), __uint_as_float(rr[1])); }
  if (__builtin_expect(__all(pmax - m_reg <= THR2), 1)) { mn = m_reg; alpha = 1.f; }
  else { mn = fmaxf(m_reg, pmax); alpha = __builtin_amdgcn_exp2f(m_reg - mn); m_reg = mn; }
#pragma unroll
  for (int r = 0; r < 16; ++r) p0[r] = p0[r] - mn;
#pragma unroll
  for (int r = 0; r < 16; ++r) p1[r] = p1[r] - mn;
#pragma unroll
  for (int r = 0; r < 16; ++r) p0[r] = __builtin_amdgcn_exp2f(p0[r]);
}
__device__ __forceinline__ void finishSM(f32x16& p0, f32x16& p1, float alpha, float& l_reg, bf16x8& pa0, bf16x8& pa1, bf16x8& pa2, bf16x8& pa3) {
#pragma unroll
  for (int r = 0; r < 16; ++r) p1[r] = __builtin_amdgcn_exp2f(p1[r]);
  float ps = 0;
#pragma unroll
  for (int r = 0; r < 16; ++r) ps += p0[r];
#pragma unroll
  for (int r = 0; r < 16; ++r) ps += p1[r];
  { auto rr = __builtin_amdgcn_permlane32_swap(__float_as_uint(ps), __float_as_uint(ps), false, false);
    ps = __uint_as_float(rr[0]) + __uint_as_float(rr[1]); }
  l_reg = l_reg * alpha + ps;
#define PK4(P, BASE, OUT) do { unsigned a0 = cvtpk(P[BASE + 0], P[BASE + 1]), a1 = cvtpk(P[BASE + 2], P[BASE + 3]);   \
    unsigned b0 = cvtpk(P[BASE + 4], P[BASE + 5]), b1 = cvtpk(P[BASE + 6], P[BASE + 7]);                              \
    auto r0 = __builtin_amdgcn_permlane32_swap(a0, b0, false, false); auto r1 = __builtin_amdgcn_permlane32_swap(a1, b1, false, false); \
    u32x4 w = {r0[0], r1[0], r0[1], r1[1]}; OUT = *reinterpret_cast<bf16x8*>(&w); } while (0)
  PK4(p0, 0, pa0); PK4(p0, 8, pa1); PK4(p1, 0, pa2); PK4(p1, 8, pa3);
#undef PK4
}
__device__ __forceinline__ void qkt(f32x16& p0, f32x16& p1, const char* Ks, const bf16x8* qr, int r32, int hi) {
  p0 = f32x16{}; p1 = f32x16{};
#pragma unroll
  for (int d0 = 0; d0 < 8; ++d0) { const int cb = (d0 * 16 + hi * 8) * 2;
    bf16x8 b0 = *reinterpret_cast<const bf16x8*>(Ks + KSWZ(r32, cb));
    bf16x8 b1 = *reinterpret_cast<const bf16x8*>(Ks + KSWZ(32 + r32, cb));
    p0 = __builtin_amdgcn_mfma_f32_32x32x16_bf16(b0, qr[d0], p0, 0, 0, 0);
    p1 = __builtin_amdgcn_mfma_f32_32x32x16_bf16(b1, qr[d0], p1, 0, 0, 0); }
}
__device__ __forceinline__ int v_st(int k, int c) { const int kk = (k & ~0xC) | ((k & 4) << 1) | ((k & 8) >> 1); return ((kk >> 3) * 4 + (c >> 5)) * 512 + ((kk & 7) * 32 + (c & 31)) * 2; }
__device__ __forceinline__ int v_rd_base(int lane) { return ((lane & 3) << 3) | (((lane >> 2) & 3) << 6) | (((lane >> 4) & 1) << 5) | (((lane >> 5) & 1) << 8); }
constexpr int v_rd_off(int d0, int ks, int half) { return d0 * 512 + ks * 4096 + half * 2048; }
template <int OFF> __device__ __forceinline__ s16x4 tr_read(int vb) {
  s16x4 r; asm volatile("ds_read_b64_tr_b16 %0, %1 offset:%2" : "=&v"(r) : "v"(vb), "i"(OFF) : "memory"); return r;
}
template <int D0> __device__ __forceinline__ void pv_one(f32x16& od, int vb, bf16x8 pa0, bf16x8 pa1, bf16x8 pa2, bf16x8 pa3) {
  const s16x4 l0 = tr_read<v_rd_off(D0, 0, 0)>(vb), h0 = tr_read<v_rd_off(D0, 0, 1)>(vb), l1 = tr_read<v_rd_off(D0, 1, 0)>(vb), h1 = tr_read<v_rd_off(D0, 1, 1)>(vb);
  const s16x4 l2 = tr_read<v_rd_off(D0, 2, 0)>(vb), h2 = tr_read<v_rd_off(D0, 2, 1)>(vb), l3 = tr_read<v_rd_off(D0, 3, 0)>(vb), h3 = tr_read<v_rd_off(D0, 3, 1)>(vb);
  asm volatile("s_waitcnt lgkmcnt(0)" ::: "memory"); SBAR();
#define PK(L, H) (bf16x8){L[0], L[1], L[2], L[3], H[0], H[1], H[2], H[3]}
  od = __builtin_amdgcn_mfma_f32_32x32x16_bf16(pa0, PK(l0, h0), od, 0, 0, 0);
  od = __builtin_amdgcn_mfma_f32_32x32x16_bf16(pa1, PK(l1, h1), od, 0, 0, 0);
  od = __builtin_amdgcn_mfma_f32_32x32x16_bf16(pa2, PK(l2, h2), od, 0, 0, 0);
  od = __builtin_amdgcn_mfma_f32_32x32x16_bf16(pa3, PK(l3, h3), od, 0, 0, 0);
#undef PK
}
__device__ __forceinline__ void pv_d0(f32x16* o, int vb, bf16x8 pa0, bf16x8 pa1, bf16x8 pa2, bf16x8 pa3) {
  pv_one<0>(o[0], vb, pa0, pa1, pa2, pa3); pv_one<1>(o[1], vb, pa0, pa1, pa2, pa3); pv_one<2>(o[2], vb, pa0, pa1, pa2, pa3); pv_one<3>(o[3], vb, pa0, pa1, pa2, pa3);
}
template <int MODE> __device__ __forceinline__ void post_scores(f32x16& p0, f32x16& p1, int t, int qrow0, int r32, int hi, const float* tab, float cfar) {
  if constexpr (MODE == 1) {
    const int cw = qrow0 >> 6;
    if (t > cw) {
#pragma unroll
      for (int r = 0; r < 16; ++r) { p0[r] = -INFINITY; p1[r] = -INFINITY; }
    } else if (qrow0 - (64 * t + 63) >= 91) {
#pragma unroll
      for (int r = 0; r < 16; ++r) { p0[r] += cfar; p1[r] += cfar; }
    } else {
      const int base = qrow0 + r32 - 64 * t + 63;
#pragma unroll
      for (int r = 0; r < 16; ++r) { const int i0 = base - crow(r, hi); const int i1 = i0 - 32;
        p0[r] += tab[i0 < TAB_N - 1 ? i0 : TAB_N - 1]; p1[r] += tab[i1 < TAB_N - 1 ? i1 : TAB_N - 1]; }
    }
  }
}

template <int MODE>
__device__ __forceinline__ void attn_body(const bf16* __restrict__ Qb, int ldq, const bf16* __restrict__ Kh, const bf16* __restrict__ Vh, int ldk,
                                          bf16* Ob, float* Of, int ldo, int NT, int q0abs, const float* tab, float cfar, char* lds) {
  int tid_ = threadIdx.x; asm volatile("" : "+v"(tid_));
  const int tid = tid_, wid = tid >> 6, lane = tid & 63, r32 = lane & 31, hi = lane >> 5;
  char* V_lds = lds; char* K_lds = lds + 2 * SHM_V;
  float* ws = (float*)(lds + 2 * SHM_V + 2 * SHM_K) + wid * 64; float* li_l = ws; float* al_l = ws + 32;
  float m_reg = -1e30f, l_reg = 0; f32x16 o[4] = {}; bf16x8 qr[8];
  const int qrow0 = q0abs + wid * QBLK;
  const bf16* Qw = Qb + (long)(wid * QBLK + r32) * ldq + hi * 8;
#pragma unroll
  for (int d0 = 0; d0 < 8; ++d0) qr[d0] = *reinterpret_cast<const bf16x8*>(Qw + d0 * 16);
  const int sr = tid >> 4, sc = (tid & 15) * 8, vst0 = v_st(sr, sc), vst1 = v_st(32 + sr, sc);
  const int vb0 = (int)(uintptr_t)V_lds + v_rd_base(lane);
  struct { bf16x8 vs0, vs1, ks0, ks1; } sr_[2];
#define SLOAD(i, k0) do { sr_[i].vs0 = *reinterpret_cast<const bf16x8*>(&Vh[(long)((k0) + sr) * ldk + sc]); sr_[i].vs1 = *reinterpret_cast<const bf16x8*>(&Vh[(long)((k0) + 32 + sr) * ldk + sc]); \
    sr_[i].ks0 = *reinterpret_cast<const bf16x8*>(&Kh[(long)((k0) + sr) * ldk + sc]); sr_[i].ks1 = *reinterpret_cast<const bf16x8*>(&Kh[(long)((k0) + 32 + sr) * ldk + sc]); } while (0)
#define SWRITE(b, i) do { *(bf16x8*)(V_lds + (b) * SHM_V + vst0) = sr_[i].vs0;          \
    *(bf16x8*)(V_lds + (b) * SHM_V + vst1) = sr_[i].vs1; const int kc = sc * 2;               \
    *(bf16x8*)(K_lds + (b) * SHM_K + KSWZ(sr, kc)) = sr_[i].ks0;                       \
    *(bf16x8*)(K_lds + (b) * SHM_K + KSWZ(32 + sr, kc)) = sr_[i].ks1; } while (0)
#define SWAIT() asm volatile("s_waitcnt vmcnt(4)" ::: "memory")
#define RESC(a) do { if (__any((a) < 1.f)) { if (hi == 0) al_l[r32] = (a); asm volatile("s_waitcnt lgkmcnt(0)" ::: "memory"); \
    _Pragma("unroll") for (int d = 0; d < 4; ++d) _Pragma("unroll") for (int r = 0; r < 16; ++r) o[d][r] *= al_l[crow(r, hi)]; } } while (0)
  f32x16 pA0, pA1, pB0, pB1; float mnA, mnB, alA, alB; bf16x8 pa0, pa1, pa2, pa3;
  constexpr int SE = 0, SO = 1;
  SLOAD(SE, 0); asm volatile("s_waitcnt vmcnt(0)" ::: "memory"); SWRITE(0, SE); __syncthreads();
  qkt(pA0, pA1, K_lds, qr, r32, hi); post_scores<MODE>(pA0, pA1, 0, qrow0, r32, hi, tab, cfar); partialSM(pA0, pA1, m_reg, mnA, alA);
  SLOAD(SO, KVBLK); if (2 < NT) SLOAD(SE, 2 * KVBLK);
  SWAIT(); SWRITE(1, SO); __syncthreads();
  for (int j = 1; j + 1 < NT; j += 2) {
    SBAR(); qkt(pB0, pB1, K_lds + SHM_K, qr, r32, hi); post_scores<MODE>(pB0, pB1, j, qrow0, r32, hi, tab, cfar);
    finishSM(pA0, pA1, alA, l_reg, pa0, pa1, pa2, pa3); SBAR();
    SLOAD(SO, (j + 2) * KVBLK); SBAR();
    pv_d0(o, vb0, pa0, pa1, pa2, pa3); partialSM(pB0, pB1, m_reg, mnB, alB);
    __syncthreads(); SWAIT(); SWRITE(0, SE);
    RESC(alB); __syncthreads();
    SBAR(); qkt(pA0, pA1, K_lds, qr, r32, hi); post_scores<MODE>(pA0, pA1, j + 1, qrow0, r32, hi, tab, cfar);
    finishSM(pB0, pB1, alB, l_reg, pa0, pa1, pa2, pa3); SBAR();
    if (j + 3 < NT) SLOAD(SE, (j + 3) * KVBLK); SBAR();
    pv_d0(o, vb0 + (int)SHM_V, pa0, pa1, pa2, pa3); partialSM(pA0, pA1, m_reg, mnA, alA);
    __syncthreads(); SWAIT(); SWRITE(1, SO);
    RESC(alA); __syncthreads();
  }
  SBAR(); qkt(pB0, pB1, K_lds + SHM_K, qr, r32, hi); post_scores<MODE>(pB0, pB1, NT - 1, qrow0, r32, hi, tab, cfar);
  finishSM(pA0, pA1, alA, l_reg, pa0, pa1, pa2, pa3); SBAR();
  pv_d0(o, vb0, pa0, pa1, pa2, pa3); partialSM(pB0, pB1, m_reg, mnB, alB);
  __syncthreads(); RESC(alB);
  finishSM(pB0, pB1, alB, l_reg, pa0, pa1, pa2, pa3); SBAR();
  pv_d0(o, vb0 + (int)SHM_V, pa0, pa1, pa2, pa3);
  if (hi == 0) li_l[r32] = l_reg; asm volatile("s_waitcnt lgkmcnt(0)" ::: "memory");
  float rli[16];
#pragma unroll
  for (int r = 0; r < 16; ++r) rli[r] = __builtin_amdgcn_rcpf(li_l[crow(r, hi)]);
  if constexpr (MODE == 0) {
    bf16* Ow = Ob + (long)(wid * QBLK) * ldo;
#pragma unroll
    for (int r = 0; r < 16; ++r) { const int orow = crow(r, hi);
#pragma unroll
      for (int d0 = 0; d0 < 4; ++d0) Ow[(long)orow * ldo + d0 * 32 + r32] = (bf16)f2bf(o[d0][r] * rli[r]); }
  } else {
    float* Ow = Of + (long)(wid * QBLK) * ldo;
#pragma unroll
    for (int r = 0; r < 16; ++r) { const int orow = crow(r, hi);
#pragma unroll
      for (int d0 = 0; d0 < 4; ++d0) Ow[(long)orow * ldo + d0 * 32 + r32] = o[d0][r] * rli[r]; }
  }
  __syncthreads();
#undef SLOAD
#undef SWRITE
#undef SWAIT
#undef RESC
}
}

#define XB_TMO      128
#define XB_XCNT(j)  (256  + 64 * (j))
#define XB_XSUB(j)  (1280 + 64 * (j))
#define XB_XGEN(j)  (2304 + 64 * (j))
#define XB_TOP      3328
#define XB_TOPGEN   3392
#define XCD_BAR_WORDS 3456
#define XB_SPIN_CAP (1u << 18)

__device__ __forceinline__ unsigned xb_ld(unsigned* p)              { return __hip_atomic_load(p, __ATOMIC_RELAXED, __HIP_MEMORY_SCOPE_AGENT); }
__device__ __forceinline__ unsigned xb_add(unsigned* p, unsigned v) { return __hip_atomic_fetch_add(p, v, __ATOMIC_RELAXED, __HIP_MEMORY_SCOPE_AGENT); }
__device__ __forceinline__ unsigned xb_xcc_id() { return (unsigned)__builtin_amdgcn_s_getreg((3 << 11) | 20) & 0xFu; }
#define XB_SPIN(cond, bar) do { unsigned _sp = 0; while (cond) { __builtin_amdgcn_s_sleep(1); \
    if ((++_sp & 255u) == 0u) { if (xb_ld(&(bar)[XB_TMO])) break; if (_sp > XB_SPIN_CAP) { atomicAdd(&(bar)[XB_TMO], 1u); break; } } } } while (0)

struct XcdBarrier {
    unsigned* bar; unsigned x;
    volatile LAS unsigned* st;
};

__device__ __forceinline__ XcdBarrier xcd_barrier_post(unsigned* bar, volatile LAS unsigned* st) {
    XcdBarrier b; b.bar = bar; b.x = xb_xcc_id(); b.st = st;
    if (threadIdx.x == 0) (void)xb_add(&bar[XB_XCNT(b.x)], 1u);
    return b;
}
__device__ __forceinline__ void xcd_barrier_complete(unsigned* bar, unsigned x, unsigned& nloc, unsigned& nx) {
    const unsigned G = gridDim.x * gridDim.y * gridDim.z;
    unsigned sum, cnt, mine, sp = 0u;
    for (;;) {
        sum = 0u; cnt = 0u; mine = 0u;
#pragma unroll
        for (unsigned j = 0; j < 16; ++j) { const unsigned c = xb_ld(&bar[XB_XCNT(j)]); sum += c; cnt += (c > 0u) ? 1u : 0u; mine = (j == x) ? c : mine; }
        if (sum == G) break;
        __builtin_amdgcn_s_sleep(1);
        if ((++sp & 255u) == 0u) { if (xb_ld(&bar[XB_TMO])) break; if (sp > XB_SPIN_CAP) { atomicAdd(&bar[XB_TMO], 1u); break; } }
    }
    nloc = mine > 0u ? mine : 1u; nx = cnt > 0u ? cnt : 1u;
}

__device__ __forceinline__ void xcd_barrier(const XcdBarrier& b) {
    asm volatile("s_waitcnt vmcnt(0)" ::: "memory");
    __syncthreads();
    if (threadIdx.x == 0) {
        unsigned* bar = b.bar;
        __builtin_amdgcn_s_waitcnt(0);
        unsigned nloc = b.st[0], nx = b.st[1];
        if (nloc == 0u) { xcd_barrier_complete(bar, b.x, nloc, nx); b.st[0] = nloc; b.st[1] = nx; }
        const unsigned old = xb_add(&bar[XB_XSUB(b.x)], 1u);
        const unsigned gen = old / nloc;
        if (old + 1u == (gen + 1u) * nloc) {
            __builtin_amdgcn_fence(__ATOMIC_RELEASE, "agent");
            asm volatile("s_waitcnt vmcnt(0)" ::: "memory");
            const unsigned og = xb_add(&bar[XB_TOP], 1u);
            const unsigned tg = og / nx;
            if (og + 1u == (tg + 1u) * nx) xb_add(&bar[XB_TOPGEN], 1u);
            else XB_SPIN(xb_ld(&bar[XB_TOPGEN]) == tg, bar);
            __builtin_amdgcn_fence(__ATOMIC_ACQUIRE, "agent");
            xb_add(&bar[XB_XGEN(b.x)], 1u);
            asm volatile("s_waitcnt vmcnt(0)" ::: "memory");
        } else {
            XB_SPIN(xb_ld(&bar[XB_XGEN(b.x)]) == gen, bar);
            __builtin_amdgcn_fence(__ATOMIC_ACQUIRE, "agent");
            asm volatile("s_waitcnt vmcnt(0)" ::: "memory");
        }
    }
    __syncthreads();
}


struct Args { const float* in[24]; float* out; unsigned char* ws; int ph_lo, ph_hi; };
enum { I_X = 0, I_MEM, I_AWIN, I_ALNG, I_ALNB, I_AWS, I_ABS, I_AWOUT, I_BWIN, I_BLAM, I_BSUBG, I_BWOUT, I_WKV, I_RELB, I_MEMWKV, I_LNG, I_LNB,
       I_WG1, I_BG1, I_WG2, I_BG2, I_W1, I_W3, I_W2 };
constexpr int NPH_LAYER = 9, NPHASES = 1 + DEPTH * NPH_LAYER;

struct Frame {
    LAS unsigned char* lds; char* ldsg;
    gu32* ctl; unsigned char* ws;
    int tid, lane, wave, G, c;
};

__device__ __forceinline__ void transpose_item(const float* W, int K, int N, bf16* WT, int drow0, LAS float* scr, int k0, int n0, int lane) {
#pragma unroll 8
    for (int i = 0; i < 32; ++i) { const int kk = 2 * i + (lane >> 5); scr[kk * 33 + (lane & 31)] = W[(size_t)(k0 + kk) * N + n0 + (lane & 31)]; }
    LDS_WAIT(); asm volatile("" ::: "memory");
    const int c = lane & 7;
#pragma unroll
    for (int j = 0; j < 4; ++j) { const int n = (lane >> 3) + 8 * j; const LAS float* s = scr + (8 * c) * 33 + n;
        v4u o; o.x = pk2(s[0 * 33], s[1 * 33]); o.y = pk2(s[2 * 33], s[3 * 33]); o.z = pk2(s[4 * 33], s[5 * 33]); o.w = pk2(s[6 * 33], s[7 * 33]);
        *(GAS v4u*)(WT + (size_t)(drow0 + n) * K + k0 + 8 * c) = o; }
    LDS_WAIT(); asm volatile("" ::: "memory");
}
__device__ __forceinline__ void transpose_item_fast(const float* W, int K, int N, bf16* WT, int drow0, LAS float* scr, int k0, int n0, int lane) {
    float t[32];
#pragma unroll
    for (int i = 0; i < 32; ++i) t[i] = W[(size_t)(k0 + 2 * i + (lane >> 5)) * N + n0 + (lane & 31)];
#pragma unroll
    for (int i = 0; i < 32; i += 8) asm volatile("" : "+v"(t[i]), "+v"(t[i + 1]), "+v"(t[i + 2]), "+v"(t[i + 3]), "+v"(t[i + 4]), "+v"(t[i + 5]), "+v"(t[i + 6]), "+v"(t[i + 7]));
#pragma unroll
    for (int i = 0; i < 32; ++i) scr[(2 * i + (lane >> 5)) * 33 + (lane & 31)] = t[i];
    LDS_WAIT(); asm volatile("" ::: "memory");
    const int c = lane & 7;
#pragma unroll
    for (int j = 0; j < 4; ++j) { const int n = (lane >> 3) + 8 * j; const LAS float* s = scr + (8 * c) * 33 + n;
        v4u o; o.x = pk2(s[0 * 33], s[1 * 33]); o.y = pk2(s[2 * 33], s[3 * 33]); o.z = pk2(s[4 * 33], s[5 * 33]); o.w = pk2(s[6 * 33], s[7 * 33]);
        *(GAS v4u*)(WT + (size_t)(drow0 + n) * K + k0 + 8 * c) = o; }
    LDS_WAIT(); asm volatile("" ::: "memory");
}
__device__ __forceinline__ void transpose_item_fp8(const float* W, int K, int N, unsigned char* WT, int drow0, LAS float* scr, int k0, int n0, int lane) {
    float t[32];
#pragma unroll
    for (int i = 0; i < 32; ++i) t[i] = W[(size_t)(k0 + 2 * i + (lane >> 5)) * N + n0 + (lane & 31)];
#pragma unroll
    for (int i = 0; i < 32; i += 8) asm volatile("" : "+v"(t[i]), "+v"(t[i + 1]), "+v"(t[i + 2]), "+v"(t[i + 3]), "+v"(t[i + 4]), "+v"(t[i + 5]), "+v"(t[i + 6]), "+v"(t[i + 7]));
#pragma unroll
    for (int i = 0; i < 32; ++i) scr[(2 * i + (lane >> 5)) * 33 + (lane & 31)] = t[i];
    LDS_WAIT(); asm volatile("" ::: "memory");
    const int c = lane & 7;
#pragma unroll
    for (int j = 0; j < 4; ++j) { const int n = (lane >> 3) + 8 * j; const LAS float* s = scr + (8 * c) * 33 + n;
        unsigned lo = 0u, hi = 0u;
        lo = __builtin_amdgcn_cvt_pk_fp8_f32(s[0 * 33] * 64.f, s[1 * 33] * 64.f, lo, false); lo = __builtin_amdgcn_cvt_pk_fp8_f32(s[2 * 33] * 64.f, s[3 * 33] * 64.f, lo, true);
        hi = __builtin_amdgcn_cvt_pk_fp8_f32(s[4 * 33] * 64.f, s[5 * 33] * 64.f, hi, false); hi = __builtin_amdgcn_cvt_pk_fp8_f32(s[6 * 33] * 64.f, s[7 * 33] * 64.f, hi, true);
        v2u o; o.x = lo; o.y = hi; *(GAS v2u*)(WT + (size_t)(drow0 + n) * K + k0 + 8 * c) = o; }
    LDS_WAIT(); asm volatile("" ::: "memory");
}
#ifndef CDRAIN
#define CDRAIN 8
#endif
#ifndef CSRV
#define CSRV 4
#endif
#ifndef CSRVA
#define CSRVA 32
#endif
#ifndef STOPU
#define STOPU 64
#endif
#ifndef QX
#define QX 6
#endif
#ifndef QA
#define QA 14
#endif
#ifndef QM
#define QM 7
#endif
#ifndef QB
#define QB 4
#endif
constexpr int NQ = 7, MOE_ITEMS = 3 * 32 * 512;
__device__ __forceinline__ int conv_qsize(int q) { return (q & 1) ? (q == 1 ? 5632 : (q == 3 ? 7168 : 4096)) : MOE_ITEMS; }
__device__ __forceinline__ void conv_item(Frame& F, const Args& a, int q, int it) {
    LAS float* scr = (LAS float*)(F.lds + RING_OFF + F.wave * 16384);
    if (q & 1) {
        const float* src; bf16* dst; int N, r = it;
        if (q == 1) { if (r < 3584) { N = 3584; src = a.in[I_AWIN] + (size_t)2048 * 3584; dst = (bf16*)(F.ws + WS_WAIN) + (size_t)2048 * 3584; } else { r -= 3584; N = 2048; src = a.in[I_AWOUT] + (size_t)2048 * 2048; dst = (bf16*)(F.ws + WS_WAOUT) + (size_t)2048 * 2048; } }
        else if (q == 3) { if (r < 2048) { N = 2048; src = a.in[I_BWIN]; dst = (bf16*)(F.ws + WS_WBIN0); } else if ((r -= 2048) < 3072) { N = 3072; src = a.in[I_WKV]; dst = (bf16*)(F.ws + WS_WKV); } else { r -= 3072; N = 2048; src = a.in[I_BWOUT]; dst = (bf16*)(F.ws + WS_WBOUT); } }
        else { if (r < 2048) { N = 2048; src = a.in[I_BWIN] + (size_t)2048 * 2048; dst = (bf16*)(F.ws + WS_WBIN1); } else { r -= 2048; N = 2048; src = a.in[I_BWOUT] + (size_t)2048 * 2048; dst = (bf16*)(F.ws + WS_WBOUT) + (size_t)2048 * 2048; } }
        const int nblk = N / 32, kb = r / nblk, nb = r - kb * nblk;
        transpose_item_fast(src, 2048, N, dst, 32 * nb, scr, 64 * kb, 32 * nb, F.lane);
        return;
    }
    const int L = q >> 1, seg = it >> 14, r0 = it & 16383, e = r0 >> 9, r = r0 & 511, mat = L * 32 + e;
    if (seg < 2) { const int kb = r >> 4, nb = r & 15, n0 = 32 * nb;
        transpose_item_fp8(a.in[seg == 0 ? I_W1 : I_W3] + (size_t)mat * 2048 * 512, 2048, 512, (unsigned char*)(F.ws + WS_W13) + (size_t)mat * 1024 * 2048, (n0 >> 7) * 256 + (n0 & 127) + (seg == 1 ? 128 : 0), scr, 64 * kb, n0, F.lane); }
    else { const int kb = r >> 6, nb = r & 63;
        transpose_item_fp8(a.in[I_W2] + (size_t)mat * 512 * 2048, 512, 2048, (unsigned char*)(F.ws + WS_W2) + (size_t)mat * 512 * 2048, 32 * nb, scr, 64 * kb, 32 * nb, F.lane); }
}
#ifndef F8MASK
#define F8MASK 4
#endif
#define F8L(l) (((F8MASK) >> (l)) & 1)
#ifndef F8OMASK
#define F8OMASK 12
#endif
#define F8OL(l) (((F8OMASK) >> (l)) & 1)
#ifndef CDEPTH
#define CDEPTH 3
#endif
struct CDesc { const float* src; unsigned char* dst; int N, K, drow0, k0, n0, f8; };
__device__ __forceinline__ CDesc conv_desc(Frame& F, const Args& a, int q, int it) {
    CDesc d;
    if (q & 1) {
        const float* src; unsigned char* dst; int N, r = it, f8 = F8L((q + 1) >> 1);
        if (q == 1) { if (r < 3584) { N = 3584; src = a.in[I_AWIN] + (size_t)2048 * 3584; dst = F.ws + WS_WAIN + (size_t)2048 * 3584 * 2; } else { r -= 3584; N = 2048; f8 = 0; src = a.in[I_AWOUT] + (size_t)2048 * 2048; dst = F.ws + WS_WAOUT + (size_t)2048 * 2048 * 2; } }
        else if (q == 3) { if (r < 2048) { N = 2048; src = a.in[I_BWIN]; dst = F.ws + WS_WBIN0; } else if ((r -= 2048) < 3072) { N = 3072; src = a.in[I_WKV]; dst = F.ws + WS_WBIN0 + (size_t)2048 * 2048 * (F8L(2) ? 1 : 2); } else { r -= 3072; N = 2048; f8 = F8OL(2); src = a.in[I_BWOUT]; dst = F.ws + WS_WBOUT; } }
        else { if (r < 2048) { N = 2048; src = a.in[I_BWIN] + (size_t)2048 * 2048; dst = F.ws + WS_WBIN1; } else { r -= 2048; N = 2048; f8 = F8OL(3); src = a.in[I_BWOUT] + (size_t)2048 * 2048; dst = F.ws + WS_WBOUT + (size_t)2048 * 2048 * 2; } }
        const int nblk = N / 32, kb = r / nblk, nb = r - kb * nblk;
        d.src = src; d.dst = dst; d.N = N; d.K = 2048; d.drow0 = 32 * nb; d.k0 = 64 * kb; d.n0 = 32 * nb; d.f8 = f8; return d;
    }
    const int L = q >> 1, seg = it >> 14, r0 = it & 16383, e = r0 >> 9, r = r0 & 511, mat = L * 32 + e;
    if (seg < 2) { const int kb = r >> 4, nb = r & 15, n0 = 32 * nb;
        d.src = a.in[seg == 0 ? I_W1 : I_W3] + (size_t)mat * 2048 * 512; d.dst = (unsigned char*)(F.ws + WS_W13) + (size_t)mat * 1024 * 2048; d.N = 512; d.K = 2048;
        d.drow0 = (n0 >> 7) * 256 + (n0 & 127) + (seg == 1 ? 128 : 0); d.k0 = 64 * kb; d.n0 = n0; d.f8 = 1; }
    else { const int kb = r >> 6, nb = r & 63;
        d.src = a.in[I_W2] + (size_t)mat * 512 * 2048; d.dst = (unsigned char*)(F.ws + WS_W2) + (size_t)mat * 512 * 2048; d.N = 2048; d.K = 512; d.drow0 = 32 * nb; d.k0 = 64 * kb; d.n0 = 32 * nb; d.f8 = 1; }
    return d;
}
#define CV_LOAD(t_, d_) do { const float* p_ = (d_).src + (size_t)((d_).k0 + (F.lane >> 3)) * (d_).N + (d_).n0 + 4 * (F.lane & 7); const size_t st_ = (size_t)8 * (d_).N; \
    _Pragma("unroll") for (int i_ = 0; i_ < 8; ++i_) (t_)[i_] = *(const GAS f32x4*)(p_ + st_ * i_); } while (0)
__device__ __forceinline__ void conv_process(Frame& F, f32x4 (&t)[8], const CDesc& d) {
    LAS float* scr = (LAS float*)(F.lds + RING_OFF + F.wave * 16384); const int lane = F.lane;
    asm volatile("" : "+v"(t[0]), "+v"(t[1]), "+v"(t[2]), "+v"(t[3]), "+v"(t[4]), "+v"(t[5]), "+v"(t[6]), "+v"(t[7]));
    { LAS float* w = scr + (lane >> 3) * 33 + 4 * (lane & 7);
#pragma unroll
      for (int i = 0; i < 8; ++i) { w[i * 8 * 33 + 0] = t[i].x; w[i * 8 * 33 + 1] = t[i].y; w[i * 8 * 33 + 2] = t[i].z; w[i * 8 * 33 + 3] = t[i].w; } }
    LDS_WAIT(); asm volatile("" ::: "memory");
    const int c = lane & 7;
    if (d.f8) {
#pragma unroll
        for (int j = 0; j < 4; ++j) { const int n = (lane >> 3) + 8 * j; const LAS float* s = scr + (8 * c) * 33 + n;
            unsigned lo = 0u, hi = 0u;
            lo = __builtin_amdgcn_cvt_pk_fp8_f32(s[0 * 33] * 64.f, s[1 * 33] * 64.f, lo, false); lo = __builtin_amdgcn_cvt_pk_fp8_f32(s[2 * 33] * 64.f, s[3 * 33] * 64.f, lo, true);
            hi = __builtin_amdgcn_cvt_pk_fp8_f32(s[4 * 33] * 64.f, s[5 * 33] * 64.f, hi, false); hi = __builtin_amdgcn_cvt_pk_fp8_f32(s[6 * 33] * 64.f, s[7 * 33] * 64.f, hi, true);
            v2u o; o.x = lo; o.y = hi; *(GAS v2u*)(d.dst + (size_t)(d.drow0 + n) * d.K + d.k0 + 8 * c) = o; }
    } else {
#pragma unroll
        for (int j = 0; j < 4; ++j) { const int n = (lane >> 3) + 8 * j; const LAS float* s = scr + (8 * c) * 33 + n;
            v4u o; o.x = pk2(s[0 * 33], s[1 * 33]); o.y = pk2(s[2 * 33], s[3 * 33]); o.z = pk2(s[4 * 33], s[5 * 33]); o.w = pk2(s[6 * 33], s[7 * 33]);
            *(GAS v4u*)((bf16*)d.dst + (size_t)(d.drow0 + n) * d.K + d.k0 + 8 * c) = o; }
    }
    LDS_WAIT(); asm volatile("" ::: "memory");
}
__device__ __forceinline__ void conv_range(Frame& F, const Args& a, int q, int first, int cnt) {
#if CDEPTH == 1
    for (int i = 0; i < cnt; ++i) conv_item(F, a, q, first + i);
#else
    f32x4 t[CDEPTH][8]; const int last = first + cnt - 1;
#pragma unroll
    for (int s = 0; s < CDEPTH - 1; ++s) { const int it = first + s < last ? first + s : last; const CDesc d = conv_desc(F, a, q, it); CV_LOAD(t[s], d); }
#pragma unroll 1
    for (int i0 = 0; i0 < cnt; i0 += CDEPTH) {
#pragma unroll
        for (int s = 0; s < CDEPTH; ++s) {
            { const int nx = first + i0 + s + CDEPTH - 1, it = nx < last ? nx : last; const CDesc d = conv_desc(F, a, q, it); CV_LOAD(t[(s + CDEPTH - 1) % CDEPTH], d); }
            asm volatile("" ::: "memory");
            if (i0 + s < cnt) { const CDesc d = conv_desc(F, a, q, first + i0 + s); conv_process(F, t[s], d); }
        }
    }
#endif
}
__device__ __forceinline__ void conv_filler(Frame& F, const Args& a, int q0, int n) {
    if (q0 >= NQ || n == 0) return;
#ifdef CONV_ALL_PRO
    return;
#endif
    LAS unsigned* bw = (LAS unsigned*)(F.lds + TAB_OFF + 384);
    __syncthreads();
    const bool drain = n < 0; const int per = drain ? CDRAIN : n; int q = q0;
    for (;;) {
        if (F.tid == 0) bw[0] = __hip_atomic_fetch_add(F.ctl + CW_CONV + 64 * q, (unsigned)(8 * per), RLX_AGENT);
        __syncthreads();
        const unsigned idx = bw[0];
        __syncthreads();
        const int qs = conv_qsize(q);
        if (idx >= (unsigned)qs) { if (drain || ++q >= NQ) break; continue; }
        { const int first = (int)idx + F.wave * per, cnt = (qs - first < per) ? qs - first : per; if (cnt > 0) conv_range(F, a, q, first, cnt); }
        if (!drain) break;
    }
}

__device__ __forceinline__ void prologue_phase(Frame& F, const Args& a) {
#ifdef TOUCH
    {
        const long nthr_ = (long)F.G * 512, gt_ = (long)F.c * 512 + F.tid; unsigned acc_ = 0u;
        for (long pg = gt_; pg < (long)(WS_END / 4096); pg += nthr_) acc_ += *(const GAS unsigned*)(F.ws + pg * 4096);
        for (long pg = gt_; pg < (long)((size_t)DEPTH * NE * D * FF * 4 / 4096); pg += nthr_) { acc_ += *(const GAS unsigned*)((const char*)a.in[I_W1] + pg * 4096); acc_ += *(const GAS unsigned*)((const char*)a.in[I_W3] + pg * 4096); acc_ += *(const GAS unsigned*)((const char*)a.in[I_W2] + pg * 4096); }
        if (acc_ == 0x12345679u) F.ctl[CW_TMO] = acc_;
    }
#endif
    LAS float* scr = (LAS float*)(F.lds + RING_OFF + F.wave * 16384);
    const int gw = F.c * NWAVES + F.wave, NGW = F.G * NWAVES;
    unsigned char* ws = F.ws;
    constexpr int S0 = 3584, S1 = 2048, S5 = 4 * 1024;
    constexpr int NITEMS = S0 + S1 + S5;
    for (int it = gw; it < NITEMS; it += NGW) {
        int r = it; const float* src; unsigned char* dst; int K = 2048, N; bool f8 = F8L(0);
        if (r < S0) { N = 3584; src = a.in[I_AWIN]; dst = ws + WS_WAIN; }
        else if ((r -= S0) < S1) { N = 2048; f8 = false; src = a.in[I_AWOUT]; dst = ws + WS_WAOUT; }
        else { r -= S1; const int mat = r >> 10; r &= 1023; N = 1024; src = a.in[I_MEMWKV] + (size_t)mat * K * N; dst = ws + WS_WMKV + (size_t)mat * K * N * (F8L(0) ? 1 : 2); }
        const int nblk = N / 32, kb = r / nblk, nb = r - kb * nblk;
        if (f8) transpose_item_fp8(src, K, N, dst, 32 * nb, scr, 64 * kb, 32 * nb, F.lane);
        else transpose_item_fast(src, K, N, (bf16*)dst, 32 * nb, scr, 64 * kb, 32 * nb, F.lane);
    }
#ifdef CONV_ALL_PRO
    for (int q = 0; q < NQ; ++q) { const int qs = conv_qsize(q); for (int it = gw * 4; it < qs; it += NGW * 4) conv_range(F, a, q, it, qs - it < 4 ? qs - it : 4); }
#endif
    const long nthr = (long)F.G * 512, gt = (long)F.c * 512 + F.tid;
    { float* wr = (float*)(ws + WS_WR);
      for (long i = gt; i < (long)DEPTH * 3 * 512 * 16 * 4; i += nthr) { const int j = (int)(i & 3), c = (int)((i >> 2) & 15), kg = (int)((i >> 6) & 511), r = (int)(i >> 15), nb = r % 3, l = r / 3;
          const int k = 4 * kg + j, o = 16 * nb + c; float v = 0.f;
          if (o < 4) v = a.in[I_WG1][((size_t)l * D + k) * 4 + o]; else if (o < 36) { const int g = (o - 4) >> 3, e = (o - 4) & 7; v = a.in[I_WG2][(((size_t)l * 4 + g) * D + k) * 8 + e]; }
          wr[i] = v; } }
    { const float* x = a.in[I_X]; bf16* xb = (bf16*)(ws + WS_XB);
      for (long i = gt; i < (long)T * D / 8; i += nthr) { const f32x4 v0 = *(const GAS f32x4*)(x + i * 8), v1 = *(const GAS f32x4*)(x + i * 8 + 4);
          v4u o; o.x = pk2(v0.x, v0.y); o.y = pk2(v0.z, v0.w); o.z = pk2(v1.x, v1.y); o.w = pk2(v1.z, v1.w); *(GAS v4u*)(xb + i * 8) = o;
          unsigned lo = 0u, hi = 0u; lo = __builtin_amdgcn_cvt_pk_fp8_f32(v0.x, v0.y, lo, false); lo = __builtin_amdgcn_cvt_pk_fp8_f32(v0.z, v0.w, lo, true); hi = __builtin_amdgcn_cvt_pk_fp8_f32(v1.x, v1.y, hi, false); hi = __builtin_amdgcn_cvt_pk_fp8_f32(v1.z, v1.w, hi, true);
          v2u qq; qq.x = lo; qq.y = hi; if (F8L(0)) *(GAS v2u*)(ws + WS_XQ + i * 8) = qq; } }
    { const float* x = a.in[I_MEM]; bf16* xb = (bf16*)(ws + WS_MEMB);
      for (long i = gt; i < (long)MEMT * D / 8; i += nthr) { const f32x4 v0 = *(const GAS f32x4*)(x + i * 8), v1 = *(const GAS f32x4*)(x + i * 8 + 4);
          v4u o; o.x = pk2(v0.x, v0.y); o.y = pk2(v0.z, v0.w); o.z = pk2(v1.x, v1.y); o.w = pk2(v1.z, v1.w); *(GAS v4u*)(xb + i * 8) = o;
          unsigned lo = 0u, hi = 0u; lo = __builtin_amdgcn_cvt_pk_fp8_f32(v0.x, v0.y, lo, false); lo = __builtin_amdgcn_cvt_pk_fp8_f32(v0.z, v0.w, lo, true); hi = __builtin_amdgcn_cvt_pk_fp8_f32(v1.x, v1.y, hi, false); hi = __builtin_amdgcn_cvt_pk_fp8_f32(v1.z, v1.w, hi, true);
          v2u qq; qq.x = lo; qq.y = hi; *(GAS v2u*)(ws + WS_MEMQ + i * 8) = qq; } }
}

#ifndef NCVMAX
#define NCVMAX 0
#endif
#ifndef NCVATT
#define NCVATT 96
#endif
__device__ __forceinline__ int conv_servers(int nu, int G, int fin) {
    if (fin || nu <= 0) return 0;
    const int rounds = (nu + G - 1) / G, gmin = (nu + rounds - 1) / rounds; int n = G - gmin; n = n < NCVMAX ? n : NCVMAX; return n & ~7;
}
__device__ __forceinline__ void conv_done(Frame& F, int p) { __syncthreads(); if (F.tid == 0) __hip_atomic_fetch_add(F.ctl + CW_DONE + 64 * p, 1u, RLX_AGENT); }
__device__ __forceinline__ void conv_server(Frame& F, const Args& a, int p, int q0, int ncomp) {
    int q = q0;
    for (;;) {
        if (q >= NQ) break;
        unsigned idx = 0xffffffffu;
        if (F.lane == 0) { if (__hip_atomic_load(F.ctl + CW_DONE + 64 * p, RLX_AGENT) < (unsigned)ncomp) idx = __hip_atomic_fetch_add(F.ctl + CW_CONV + 64 * q, (unsigned)CSRV, RLX_AGENT); }
        idx = (unsigned)__builtin_amdgcn_readfirstlane((int)idx);
        if (idx == 0xffffffffu) break;
        const int qs = conv_qsize(q);
        if (idx >= (unsigned)qs) { ++q; continue; }
        conv_range(F, a, q, (int)idx, (qs - (int)idx < CSRV) ? qs - (int)idx : CSRV);
    }
}
__device__ __forceinline__ void conv_server_q(Frame& F, const Args& a, gu32* head, unsigned stop_at, int q0) {
    int q = q0;
    for (;;) {
        if (q >= NQ) break;
        unsigned idx = 0xffffffffu;
        if (F.lane == 0) { if (__hip_atomic_load(head, RLX_AGENT) < stop_at) idx = __hip_atomic_fetch_add(F.ctl + CW_CONV + 64 * q, (unsigned)CSRVA, RLX_AGENT); }
        idx = (unsigned)__builtin_amdgcn_readfirstlane((int)idx);
        if (idx == 0xffffffffu) break;
        const int qs = conv_qsize(q);
        if (idx >= (unsigned)qs) { ++q; continue; }
        conv_range(F, a, q, (int)idx, (qs - (int)idx < CSRVA) ? qs - (int)idx : CSRVA);
    }
}
__device__ __forceinline__ void conv_note_fin(Frame& F, int p) {
    if (blockIdx.x == 0 && F.tid < 64) {
        const int q = F.lane < NQ ? F.lane : 0;
        const bool ok = __hip_atomic_load(F.ctl + CW_CONV + 64 * q, RLX_AGENT) >= (unsigned)conv_qsize(q);
        const unsigned all = __all(ok) ? 1u : 0u;
        if (F.lane == 0) __hip_atomic_store(F.ctl + CW_FIN + 64 * p, all, RLX_AGENT); }
}

__device__ __forceinline__ void sgu_unit(Frame& F, const Args& a, int l, int n, int g) {
    constexpr int LDW = 136;
    LAS float* stats = (LAS float*)(F.lds); LAS bf16* Wl = (LAS bf16*)(F.lds + 1024); LAS bf16* Vt = (LAS bf16*)(F.lds + 35840);
    const bf16* z = (const bf16*)(F.ws + WS_Z); bf16* cat = (bf16*)(F.ws + WS_CAT);
    const int tok0 = n * 128;
    for (int i = 0; i < 16; ++i) { const int tk = F.wave * 16 + i; const GAS v4u* rp = (const GAS v4u*)(z + (size_t)(tok0 + tk) * NINA + MIXW) + F.lane;
        v4u w[3]; float s = 0.f;
#pragma unroll
        for (int j = 0; j < 3; ++j) { w[j] = rp[64 * j]; s += (bflo(w[j].x) + bfhi(w[j].x)) + (bflo(w[j].y) + bfhi(w[j].y)) + (bflo(w[j].z) + bfhi(w[j].z)) + (bflo(w[j].w) + bfhi(w[j].w)); }
        const float mean = wave_sum(s) * (1.f / MIXW); float q = 0.f;
#pragma unroll
        for (int j = 0; j < 3; ++j) { float d;
            d = bflo(w[j].x) - mean; q += d * d; d = bfhi(w[j].x) - mean; q += d * d; d = bflo(w[j].y) - mean; q += d * d; d = bfhi(w[j].y) - mean; q += d * d;
            d = bflo(w[j].z) - mean; q += d * d; d = bfhi(w[j].z) - mean; q += d * d; d = bflo(w[j].w) - mean; q += d * d; d = bfhi(w[j].w) - mean; q += d * d; }
        const float rstd = 1.f / sqrtf(wave_sum(q) * (1.f / MIXW) + LN_EPS);
        if (F.lane == 0) { stats[2 * tk] = mean; stats[2 * tk + 1] = rstd; } }
    { const float* wsrc = a.in[I_AWS] + ((size_t)l * 4 + g) * 128 * 128;
      for (int p = F.tid; p < 128 * 32; p += 512) { const int i = p >> 5, j4 = (p & 31) * 4; f32x4 v = *(const GAS f32x4*)(wsrc + i * 128 + j4);
          if ((j4 >> 6) > (i >> 6)) v = (f32x4){0.f, 0.f, 0.f, 0.f};
          v2u o; o.x = pk2(v.x, v.y); o.y = pk2(v.z, v.w); *(LAS v2u*)(Wl + i * LDW + j4) = o; } }
    __syncthreads();
    { const float* lg = a.in[I_ALNG] + (size_t)l * MIXW + g * 384; const float* lb = a.in[I_ALNB] + (size_t)l * MIXW + g * 384;
      for (int p = F.tid; p < 128 * 48; p += 512) { const int j = p & 127, c8 = (p >> 7) * 8;
          const v4u w = *(const GAS v4u*)(z + (size_t)(tok0 + j) * NINA + MIXW + g * 384 + c8);
          const float mean = stats[2 * j], rstd = stats[2 * j + 1];
          const f32x4 g0 = *(const GAS f32x4*)(lg + c8), g1 = *(const GAS f32x4*)(lg + c8 + 4), b0 = *(const GAS f32x4*)(lb + c8), b1 = *(const GAS f32x4*)(lb + c8 + 4);
          float v[8] = {bflo(w.x), bfhi(w.x), bflo(w.y), bfhi(w.y), bflo(w.z), bfhi(w.z), bflo(w.w), bfhi(w.w)};
          const float gg[8] = {g0.x, g0.y, g0.z, g0.w, g1.x, g1.y, g1.z, g1.w}, bb[8] = {b0.x, b0.y, b0.z, b0.w, b1.x, b1.y, b1.z, b1.w};
#pragma unroll
          for (int e = 0; e < 8; ++e) Vt[(c8 + e) * LDW + j] = (bf16)f2bf((v[e] - mean) * rstd * gg[e] + bb[e]); } }
    __syncthreads();
    const int fr = F.lane & 15, fq = F.lane >> 4;
    f32x4 acc[8][3];
#pragma unroll
    for (int mb = 0; mb < 8; ++mb)
#pragma unroll
        for (int nb = 0; nb < 3; ++nb) acc[mb][nb] = (f32x4){0.f, 0.f, 0.f, 0.f};
#pragma unroll
    for (int ks = 0; ks < 4; ++ks) { bf16x8 bfr[3];
#pragma unroll
        for (int nb = 0; nb < 3; ++nb) bfr[nb] = *(const LAS bf16x8*)(Vt + (F.wave * 48 + nb * 16 + fr) * LDW + ks * 32 + fq * 8);
#pragma unroll
        for (int mb = 0; mb < 8; ++mb) { const bf16x8 afr = *(const LAS bf16x8*)(Wl + (mb * 16 + fr) * LDW + ks * 32 + fq * 8);
#pragma unroll
            for (int nb = 0; nb < 3; ++nb) acc[mb][nb] = __builtin_amdgcn_mfma_f32_16x16x32_bf16(bfr[nb], afr, acc[mb][nb], 0, 0, 0); } }
    const float* bs = a.in[I_ABS] + ((size_t)l * 4 + g) * 128;
#pragma unroll
    for (int mb = 0; mb < 8; ++mb) { const int i = mb * 16 + fr; const float bsv = bs[i]; const size_t tk = (size_t)(tok0 + i);
#pragma unroll
        for (int nb = 0; nb < 3; ++nb) { const int c = g * 384 + F.wave * 48 + nb * 16 + 4 * fq;
            const v2u uw = *(const GAS v2u*)(z + tk * NINA + c); const f32x4 gt = acc[mb][nb] + bsv;
            v2u o; o.x = pk2(bflo(uw.x) * gt.x, bfhi(uw.x) * gt.y); o.y = pk2(bflo(uw.y) * gt.z, bfhi(uw.y) * gt.w);
            *(GAS v2u*)(cat + tk * D + c) = o; } }
    __syncthreads();
}

__device__ __forceinline__ void memattn_unit(Frame& F, int l, int hm, int qb, int ldz, int qoff) {
    const bf16* z = (const bf16*)(F.ws + WS_Z); const bf16* kv = (const bf16*)(F.ws + WS_MEMKV) + (size_t)l * 256 * 1024; bf16* cat = (bf16*)(F.ws + WS_CAT);
    att::attn_body<0>(z + (size_t)qb * 256 * ldz + qoff + hm * 128, ldz, kv + hm * 128, kv + 512 + hm * 128, 1024,
                      cat + (size_t)qb * 256 * D + MIXW + hm * 128, nullptr, D, 4, 0, nullptr, 0.f, F.ldsg);
}

__device__ __forceinline__ int t5_bucket(int rel) {
    const int a = rel < 0 ? -rel : rel; int f;
    if (a < 8) f = a; else if (a < 12) f = 8; else if (a < 16) f = 9; else if (a < 23) f = 10; else if (a < 32) f = 11; else if (a < 46) f = 12; else if (a < 64) f = 13; else if (a < 91) f = 14; else f = 15;
    return (rel > 0 ? 16 : 0) + f;
}

namespace att2 {
using att::bf16x8; using att::s16x4; using att::f32x16; using att::u32x4; using att::crow; using att::cvtpk; using att::tr_read; using att::v_rd_base;
constexpr int KT = 32, ST_K = KT * 128 * 2, ST_V = KT * 256 * 2, STAGE = 2 * ST_K + ST_V, NST = 3;
constexpr int LDS_WS = NST * STAGE, LDS_TAB = LDS_WS + 2048, LDS_UNIT = LDS_TAB + 640, LDS_END = LDS_UNIT + 16;
constexpr int NUNITS = 576;
constexpr float THR2 = 8.f * 1.4426950408889634f;
__device__ __forceinline__ int swap23(int k) { return (k & ~0xC) | ((k & 4) << 1) | ((k & 8) >> 1); }
constexpr int v_off(int d0, int ks, int half) { return d0 * 512 + ks * 8192 + half * 4096; }

struct UnitTable { unsigned short u[NUNITS]; };
constexpr UnitTable make_units() {
    UnitTable t{}; int n = 0;
    for (int c = 256; c >= 4; c -= 2) {
        { const int b = (c - 2) / 2; if ((c - 2) % 2 == 0 && b >= 32 && b <= 63) for (int part = 1; part <= 2; ++part) for (int h = 0; h < 6; ++h) t.u[n++] = (unsigned short)(h | (b << 3) | (part << 9)); }
        if (c % 4 == 0) { const int b = c / 4 - 1; if (b >= 0 && b < 32) for (int h = 0; h < 6; ++h) t.u[n++] = (unsigned short)(h | (b << 3)); }
    }
    return t;
}
__device__ const UnitTable g_units = make_units();

__device__ __forceinline__ void diff_unit(const bf16* __restrict__ Q, const bf16* __restrict__ KD, const bf16* __restrict__ VD, float* Obuf  , int orow0,
                                          float* ML  , const float* relb, int h, int b, int t_lo, int t_hi, LAS char* lds) {
  int tid_ = threadIdx.x; asm volatile("" : "+v"(tid_));
  const int tid = tid_, wid = __builtin_amdgcn_readfirstlane(tid >> 6), lane = tid & 63, r32 = lane & 31, hi = lane >> 5, m = wid >> 2, rg = wid & 3;
  LAS float* wsw = (LAS float*)(lds + LDS_WS) + wid * 64; LAS float* li_l = wsw; LAS float* al_l = wsw + 32;
  LAS float* tab = (LAS float*)(lds + LDS_TAB);
  if (tid < att::TAB_N) tab[tid] = relb[t5_bucket(63 - tid) * 6 + h] * LOG2E;
  const float cfar = relb[15 * 6 + h] * LOG2E;
  const int qrow0 = b * 128 + rg * 32;
  bf16x8 qr[8];
  { const bf16* Qw = Q + (size_t)(qrow0 + r32) * 2048 + h * 256 + m * 128 + hi * 8;
#pragma unroll
    for (int d0 = 0; d0 < 8; ++d0) qr[d0] = *reinterpret_cast<const bf16x8*>(Qw + d0 * 16); }
  int ko[2], vo[2];
#pragma unroll
  for (int i = 0; i < 2; ++i) {
    const int p = wid * 64 + lane, row = p >> 4, cp = (p & 15) ^ (row & 7); ko[i] = row * 1536 + h * 256 + i * 128 + cp * 8; }
#pragma unroll
  for (int i = 0; i < 2; ++i) {
    const int p = (wid * 2 + i) * 64 + lane, sub = p >> 5, kg = sub >> 3, cblk = sub & 7, q = p & 31, kk = kg * 8 + (q >> 2), key = swap23(kk);
    vo[i] = key * 1536 + h * 256 + cblk * 32 + (q & 3) * 8; }
  const unsigned ldsb = (unsigned)(uintptr_t)lds;
#define A2_ISSUE(t, s) do { const size_t kb_ = (size_t)(t) * KT * 1536; LAS char* sb_ = lds + (s) * STAGE; \
    __builtin_amdgcn_global_load_lds((const unsigned*)(KD + kb_ + ko[0]), (LAS unsigned*)(sb_ + wid * 1024), 16, 0, 0); \
    __builtin_amdgcn_global_load_lds((const unsigned*)(KD + kb_ + ko[1]), (LAS unsigned*)(sb_ + ST_K + wid * 1024), 16, 0, 0); \
    __builtin_amdgcn_global_load_lds((const unsigned*)(VD + kb_ + vo[0]), (LAS unsigned*)(sb_ + 2 * ST_K + (wid * 2) * 1024), 16, 0, 0); \
    __builtin_amdgcn_global_load_lds((const unsigned*)(VD + kb_ + vo[1]), (LAS unsigned*)(sb_ + 2 * ST_K + (wid * 2 + 1) * 1024), 16, 0, 0); } while (0)
  const int vis = 2 * (2 * b + (rg >> 1) + 1);
  float m_reg = -1e30f, l_reg = 0.f; f32x16 o[8];
#pragma unroll
  for (int d = 0; d < 8; ++d) o[d] = f32x16{};
  asm volatile("s_waitcnt vmcnt(0)" ::: "memory");
  A2_ISSUE(t_lo, 0); if (t_lo + 1 < t_hi) A2_ISSUE(t_lo + 1, 1);
  int s = 0;
  for (int t = t_lo; t < t_hi; ++t) {
    if (t + 1 < t_hi) asm volatile("s_waitcnt vmcnt(4) lgkmcnt(0)" ::: "memory"); else asm volatile("s_waitcnt vmcnt(0) lgkmcnt(0)" ::: "memory");
    __builtin_amdgcn_s_barrier(); asm volatile("" ::: "memory");
    if (t + 2 < t_hi) { const int s2 = (s >= 1) ? s - 1 : s + 2; A2_ISSUE(t + 2, s2); }
    if (t < vis) {
      const LAS char* Ks = lds + s * STAGE + m * ST_K;
      f32x16 p = f32x16{};
#pragma unroll
      for (int d0 = 0; d0 < 8; ++d0) { const int cb = (d0 * 16 + hi * 8) * 2;
        const bf16x8 b0 = *(const LAS bf16x8*)(Ks + KSWZ(r32, cb));
        p = __builtin_amdgcn_mfma_f32_32x32x16_bf16(b0, qr[d0], p, 0, 0, 0); }
      if (qrow0 - (KT * t + KT - 1) >= 91) {
#pragma unroll
        for (int r = 0; r < 16; ++r) p[r] += cfar;
      } else { const int base = qrow0 + r32 - KT * t + 63;
#pragma unroll
        for (int r = 0; r < 16; ++r) { const int i0 = base - crow(r, hi); p[r] += tab[i0 < att::TAB_N - 1 ? i0 : att::TAB_N - 1]; } }
      float pmax = p[0];
#pragma unroll
      for (int r = 1; r < 16; ++r) pmax = fmaxf(pmax, p[r]);
      { auto rr = __builtin_amdgcn_permlane32_swap(__float_as_uint(pmax), __float_as_uint(pmax), false, false); pmax = fmaxf(__uint_as_float(rr[0]), __uint_as_float(rr[1])); }
      float mn, alpha;
      if (__builtin_expect(__all(pmax - m_reg <= THR2), 1)) { mn = m_reg; alpha = 1.f; }
      else { mn = fmaxf(m_reg, pmax); alpha = __builtin_amdgcn_exp2f(m_reg - mn); m_reg = mn; }
      float ps = 0.f;
#pragma unroll
      for (int r = 0; r < 16; ++r) { p[r] = __builtin_amdgcn_exp2f(p[r] - mn); ps += p[r]; }
      { auto rr = __builtin_amdgcn_permlane32_swap(__float_as_uint(ps), __float_as_uint(ps), false, false); ps = __uint_as_float(rr[0]) + __uint_as_float(rr[1]); }
      l_reg = l_reg * alpha + ps;
      bf16x8 pa0, pa1;
#define A2_PK4(P, BASE, OUT) do { unsigned a0 = cvtpk(P[BASE + 0], P[BASE + 1]), a1 = cvtpk(P[BASE + 2], P[BASE + 3]);   \
    unsigned b0_ = cvtpk(P[BASE + 4], P[BASE + 5]), b1_ = cvtpk(P[BASE + 6], P[BASE + 7]);                              \
    auto r0 = __builtin_amdgcn_permlane32_swap(a0, b0_, false, false); auto r1 = __builtin_amdgcn_permlane32_swap(a1, b1_, false, false); \
    u32x4 w = {r0[0], r1[0], r0[1], r1[1]}; OUT = *reinterpret_cast<bf16x8*>(&w); } while (0)
      A2_PK4(p, 0, pa0); A2_PK4(p, 8, pa1);
      if (__any(alpha < 1.f)) { if (hi == 0) al_l[r32] = alpha; asm volatile("s_waitcnt lgkmcnt(0)" ::: "memory");
#pragma unroll
        for (int d = 0; d < 8; ++d)
#pragma unroll
          for (int r = 0; r < 16; ++r) o[d][r] *= al_l[crow(r, hi)]; }
      const int vb = (int)(ldsb + s * STAGE + 2 * ST_K) + v_rd_base(lane);
      asm volatile("s_waitcnt lgkmcnt(0)" ::: "memory"); SBAR();
#define A2_PK(L, H) (bf16x8){L[0], L[1], L[2], L[3], H[0], H[1], H[2], H[3]}
#define A2_RD(D0, l0, h0, l1, h1) do { l0 = tr_read<v_off(D0, 0, 0)>(vb); h0 = tr_read<v_off(D0, 0, 1)>(vb); l1 = tr_read<v_off(D0, 1, 0)>(vb); h1 = tr_read<v_off(D0, 1, 1)>(vb); } while (0)
#define A2_MM(D0, l0, h0, l1, h1) do { o[D0] = __builtin_amdgcn_mfma_f32_32x32x16_bf16(pa0, A2_PK(l0, h0), o[D0], 0, 0, 0); o[D0] = __builtin_amdgcn_mfma_f32_32x32x16_bf16(pa1, A2_PK(l1, h1), o[D0], 0, 0, 0); } while (0)
      s16x4 xl0, xh0, xl1, xh1, yl0, yh0, yl1, yh1;
      A2_RD(0, xl0, xh0, xl1, xh1);
      A2_RD(1, yl0, yh0, yl1, yh1); asm volatile("s_waitcnt lgkmcnt(4)" ::: "memory"); SBAR(); A2_MM(0, xl0, xh0, xl1, xh1); SBAR();
      A2_RD(2, xl0, xh0, xl1, xh1); asm volatile("s_waitcnt lgkmcnt(4)" ::: "memory"); SBAR(); A2_MM(1, yl0, yh0, yl1, yh1); SBAR();
      A2_RD(3, yl0, yh0, yl1, yh1); asm volatile("s_waitcnt lgkmcnt(4)" ::: "memory"); SBAR(); A2_MM(2, xl0, xh0, xl1, xh1); SBAR();
      A2_RD(4, xl0, xh0, xl1, xh1); asm volatile("s_waitcnt lgkmcnt(4)" ::: "memory"); SBAR(); A2_MM(3, yl0, yh0, yl1, yh1); SBAR();
      A2_RD(5, yl0, yh0, yl1, yh1); asm volatile("s_waitcnt lgkmcnt(4)" ::: "memory"); SBAR(); A2_MM(4, xl0, xh0, xl1, xh1); SBAR();
      A2_RD(6, xl0, xh0, xl1, xh1); asm volatile("s_waitcnt lgkmcnt(4)" ::: "memory"); SBAR(); A2_MM(5, yl0, yh0, yl1, yh1); SBAR();
      A2_RD(7, yl0, yh0, yl1, yh1); asm volatile("s_waitcnt lgkmcnt(4)" ::: "memory"); SBAR(); A2_MM(6, xl0, xh0, xl1, xh1); SBAR();
      asm volatile("s_waitcnt lgkmcnt(0)" ::: "memory"); SBAR(); A2_MM(7, yl0, yh0, yl1, yh1); SBAR();
    }
    s = (s == 2) ? 0 : s + 1;
  }
  if (hi == 0) li_l[r32] = l_reg; asm volatile("s_waitcnt lgkmcnt(0)" ::: "memory");
  float rli[16];
#pragma unroll
  for (int r = 0; r < 16; ++r) rli[r] = __builtin_amdgcn_rcpf(li_l[crow(r, hi)]);
  float* Ow = Obuf + (size_t)(qrow0 - orow0) * 3072 + (h * 2 + m) * 256;
#pragma unroll
  for (int r = 0; r < 16; ++r) { const int orow = crow(r, hi);
#pragma unroll
    for (int d0 = 0; d0 < 8; ++d0) Ow[(size_t)orow * 3072 + d0 * 32 + r32] = o[d0][r] * rli[r]; }
  if (hi == 0) { float* mlp = ML + (((size_t)(qrow0 - orow0 + r32) * 6 + h) * 2 + m) * 2; mlp[0] = m_reg; mlp[1] = l_reg; }
  asm volatile("s_waitcnt vmcnt(0) lgkmcnt(0)" ::: "memory");
  __builtin_amdgcn_s_barrier(); asm volatile("" ::: "memory");
#undef A2_ISSUE
#undef A2_PK4
#undef A2_PK
#undef A2_RD
#undef A2_MM
}
}

namespace att3 {
using att::f32x16; using att::crow;
typedef int v8i __attribute__((ext_vector_type(8))); typedef int v4i __attribute__((ext_vector_type(4)));
constexpr int KT = 64, ST_K = KT * 128, ST_V = 256 * 64, STAGE = ST_K + ST_V, NST = 4;
struct UnitTable { unsigned short u[att2::NUNITS]; };
constexpr UnitTable make_units() {
    UnitTable t{}; int n = 0;
    for (int L = 64; L >= 4; L -= 2) {
        if ((L - 2) % 2 == 0) { const int b = (L - 2) / 2; if (b >= 16 && b < 32) for (int part = 1; part <= 2; ++part) for (int hm = 0; hm < 12; ++hm) t.u[n++] = (unsigned short)((hm >> 1) | ((hm & 1) << 3) | (b << 4) | (part << 9)); }
        if (L % 4 == 0) { const int b = L / 4 - 1; if (b >= 0 && b < 16) for (int hm = 0; hm < 12; ++hm) t.u[n++] = (unsigned short)((hm >> 1) | ((hm & 1) << 3) | (b << 4)); }
    }
    return t;
}
__device__ const UnitTable g_units = make_units();
static_assert(NST * STAGE == att2::LDS_WS, "same ring size as att2");
constexpr float THR2 = 2.f;
__device__ __forceinline__ v8i cat8(v4i a, v4i b) { return __builtin_shufflevector(a, b, 0, 1, 2, 3, 4, 5, 6, 7); }
__device__ __forceinline__ void diff_unit(const unsigned char* __restrict__ Q8, const unsigned char* __restrict__ K8, const unsigned char* __restrict__ VT, float* Obuf, int orow0,
                                          float* ML, const float* relb, int h, int m, int b, int t_lo, int t_hi, LAS char* lds) {
  int tid_ = threadIdx.x; asm volatile("" : "+v"(tid_));
  const int tid = tid_, wid = __builtin_amdgcn_readfirstlane(tid >> 6), lane = tid & 63, r32 = lane & 31, hi = lane >> 5, rg = wid;
  LAS float* wsw = (LAS float*)(lds + att2::LDS_WS) + wid * 64; LAS float* li_l = wsw; LAS float* al_l = wsw + 32;
  LAS float* tab = (LAS float*)(lds + att2::LDS_TAB);
  if (tid < att::TAB_N) tab[tid] = relb[t5_bucket(63 - tid) * 6 + h] * LOG2E;
  const float cfar = relb[15 * 6 + h] * LOG2E;
  const int qrow0 = b * 256 + rg * 32;
  v8i q8[2];
  { const unsigned char* Qw = Q8 + (size_t)(qrow0 + r32) * 2048 + h * 256 + m * 128 + hi * 32;
#pragma unroll
    for (int c = 0; c < 2; ++c) q8[c] = cat8(*(const GAS v4i*)(Qw + 64 * c), *(const GAS v4i*)(Qw + 64 * c + 16)); }
  int ko, vo[2];
  { const int p = wid * 64 + lane, row = p >> 3, cp = (p & 7) ^ (row & 7); ko = row * 1536 + h * 256 + m * 128 + cp * 16; }
#pragma unroll
  for (int i = 0; i < 2; ++i) { const int p = (wid * 2 + i) * 64 + lane, d = p >> 2, cp = (p & 3) ^ ((d >> 1) & 3); vo[i] = d * 64 + cp * 16; }
  const unsigned char* VTh = VT + (size_t)h * 128 * 16384;
#define A3_ISSUE(t, s) do { const size_t kb_ = (size_t)(t) * KT * 1536; LAS char* sb_ = lds + (s) * STAGE; \
    __builtin_amdgcn_global_load_lds((const unsigned*)(K8 + kb_ + ko), (LAS unsigned*)(sb_ + wid * 1024), 16, 0, 0); \
    __builtin_amdgcn_global_load_lds((const unsigned*)(VTh + (size_t)(t) * 16384 + vo[0]), (LAS unsigned*)(sb_ + ST_K + (wid * 2) * 1024), 16, 0, 0); \
    __builtin_amdgcn_global_load_lds((const unsigned*)(VTh + (size_t)(t) * 16384 + vo[1]), (LAS unsigned*)(sb_ + ST_K + (wid * 2 + 1) * 1024), 16, 0, 0); } while (0)
  const int vis = 4 * b + (rg >> 1) + 1;
  float m_reg = -1e30f, l_reg = 0.f; f32x16 o[8];
#pragma unroll
  for (int d = 0; d < 8; ++d) o[d] = f32x16{};
  const int kx = (r32 & 7), koff0 = r32 * 128 + (((2 * hi) ^ kx) << 4), koff1 = r32 * 128 + (((2 * hi + 1) ^ kx) << 4);
  const int vx = (r32 >> 1) & 3, voff0 = r32 * 64 + (((2 * hi) ^ vx) << 4), voff1 = r32 * 64 + (((2 * hi + 1) ^ vx) << 4);
  int sclP = 121, scl1 = 127; asm volatile("" : "+v"(sclP), "+v"(scl1));
  asm volatile("s_waitcnt vmcnt(0)" ::: "memory");
  A3_ISSUE(t_lo, 0); if (t_lo + 1 < t_hi) A3_ISSUE(t_lo + 1, 1); if (t_lo + 2 < t_hi) A3_ISSUE(t_lo + 2, 2);
  int s = 0;
  for (int t = t_lo; t < t_hi; ++t) {
    if (t + 2 < t_hi) asm volatile("s_waitcnt vmcnt(6) lgkmcnt(0)" ::: "memory"); else if (t + 1 < t_hi) asm volatile("s_waitcnt vmcnt(3) lgkmcnt(0)" ::: "memory"); else asm volatile("s_waitcnt vmcnt(0) lgkmcnt(0)" ::: "memory");
    __builtin_amdgcn_s_barrier(); asm volatile("" ::: "memory");
    if (t + 3 < t_hi) A3_ISSUE(t + 3, (s + 3) & 3);
    if (t < vis) {
      const LAS char* Ks = lds + s * STAGE;
      f32x16 p0 = f32x16{}, p1 = f32x16{};
#pragma unroll
      for (int c = 0; c < 2; ++c) {
        const int x0 = koff0 ^ (c << 6), x1 = koff1 ^ (c << 6);
        const v8i k0 = cat8(*(const LAS v4i*)(Ks + x0), *(const LAS v4i*)(Ks + x1));
        const v8i k1 = cat8(*(const LAS v4i*)(Ks + 4096 + x0), *(const LAS v4i*)(Ks + 4096 + x1));
        asm volatile("v_mfma_scale_f32_32x32x64_f8f6f4 %0, %1, %2, %0, %3, %3 op_sel_hi:[0,0,0]" : "+v"(p0) : "v"(k0), "v"(q8[c]), "v"(scl1));
        asm volatile("v_mfma_scale_f32_32x32x64_f8f6f4 %0, %1, %2, %0, %3, %3 op_sel_hi:[0,0,0]" : "+v"(p1) : "v"(k1), "v"(q8[c]), "v"(scl1)); }
      asm volatile("s_nop 15\n s_nop 7" : "+v"(p0), "+v"(p1));
      const bool far = qrow0 - (KT * t + KT - 1) >= 91;
      if (!far) { const int base = qrow0 + r32 - KT * t + 63;
#pragma unroll
        for (int r = 0; r < 16; ++r) { const int i0 = base - crow(r, hi), i1 = i0 - 32; p0[r] += tab[i0 < att::TAB_N - 1 ? i0 : att::TAB_N - 1]; p1[r] += tab[i1 < att::TAB_N - 1 ? i1 : att::TAB_N - 1]; } }
      const float cb = far ? cfar : 0.f;
      float pmax;
      asm("v_max3_f32 %0, %1, %2, %3" : "=v"(pmax) : "v"(p0[0]), "v"(p1[0]), "v"(p0[1]));
      asm("v_max3_f32 %0, %1, %2, %3" : "=v"(pmax) : "v"(pmax), "v"(p1[1]), "v"(p0[2]));
#pragma unroll
      for (int r = 2; r < 15; ++r) asm("v_max3_f32 %0, %1, %2, %3" : "=v"(pmax) : "v"(pmax), "v"(p1[r]), "v"(p0[r + 1]));
      asm("v_max_f32 %0, %1, %2" : "=v"(pmax) : "v"(pmax), "v"(p1[15]));
      pmax += cb;
      { auto rr = __builtin_amdgcn_permlane32_swap(__float_as_uint(pmax), __float_as_uint(pmax), false, false); asm("v_max_f32 %0, %1, %2" : "=v"(pmax) : "v"(__uint_as_float(rr[0])), "v"(__uint_as_float(rr[1]))); }
      float mn, alpha;
      if (__builtin_expect(__all(pmax - m_reg <= THR2), 1)) { mn = m_reg; alpha = 1.f; }
      else { mn = fmaxf(m_reg, pmax); alpha = __builtin_amdgcn_exp2f(m_reg - mn); m_reg = mn; }
      typedef float f32x2v __attribute__((ext_vector_type(2)));
      const float off = cb - (mn - 6.f); const f32x2v off2 = {off, off}; f32x2v ps2 = {0.f, 0.f};
#pragma unroll
      for (int r = 0; r < 16; r += 2) {
        f32x2v a = (f32x2v){p0[r], p0[r + 1]} + off2, c2 = (f32x2v){p1[r], p1[r + 1]} + off2;
        p0[r] = __builtin_amdgcn_exp2f(a.x); p0[r + 1] = __builtin_amdgcn_exp2f(a.y); p1[r] = __builtin_amdgcn_exp2f(c2.x); p1[r + 1] = __builtin_amdgcn_exp2f(c2.y);
        ps2 += (f32x2v){p0[r], p0[r + 1]}; ps2 += (f32x2v){p1[r], p1[r + 1]}; }
      float ps = ps2.x + ps2.y;
      { auto rr = __builtin_amdgcn_permlane32_swap(__float_as_uint(ps), __float_as_uint(ps), false, false); ps = __uint_as_float(rr[0]) + __uint_as_float(rr[1]); }
      l_reg = l_reg * alpha + ps;
      v8i pa;
#pragma unroll
      for (int g = 0; g < 4; ++g) { unsigned x = 0u, y = 0u;
        x = __builtin_amdgcn_cvt_pk_fp8_f32(p0[4 * g], p0[4 * g + 1], x, false); x = __builtin_amdgcn_cvt_pk_fp8_f32(p0[4 * g + 2], p0[4 * g + 3], x, true);
        y = __builtin_amdgcn_cvt_pk_fp8_f32(p1[4 * g], p1[4 * g + 1], y, false); y = __builtin_amdgcn_cvt_pk_fp8_f32(p1[4 * g + 2], p1[4 * g + 3], y, true);
        auto rr = __builtin_amdgcn_permlane32_swap(x, y, false, false); pa[2 * g] = (int)rr[0]; pa[2 * g + 1] = (int)rr[1]; }
      if (__any(alpha < 1.f)) { if (hi == 0) al_l[r32] = alpha; asm volatile("s_waitcnt lgkmcnt(0)" ::: "memory");
#pragma unroll
        for (int d = 0; d < 8; ++d)
#pragma unroll
          for (int r = 0; r < 16; ++r) o[d][r] *= al_l[crow(r, hi)]; }
      const LAS char* Vs = lds + s * STAGE + ST_K;
#define A3_RD(D0, V) do { V = cat8(*(const LAS v4i*)(Vs + (D0) * 2048 + voff0), *(const LAS v4i*)(Vs + (D0) * 2048 + voff1)); } while (0)
#define A3_MM(D0, V) asm volatile("v_mfma_scale_f32_32x32x64_f8f6f4 %0, %1, %2, %0, %3, %4 op_sel_hi:[0,0,0]" : "+v"(o[D0]) : "v"(pa), "v"(V), "v"(sclP), "v"(scl1))
      v8i va, vb;
      A3_RD(0, va);
      A3_RD(1, vb); A3_MM(0, va);
      A3_RD(2, va); A3_MM(1, vb);
      A3_RD(3, vb); A3_MM(2, va);
      A3_RD(4, va); A3_MM(3, vb);
      A3_RD(5, vb); A3_MM(4, va);
      A3_RD(6, va); A3_MM(5, vb);
      A3_RD(7, vb); A3_MM(6, va);
      A3_MM(7, vb);
    }
    s = (s + 1) & 3;
  }
  asm volatile("s_nop 15\n s_nop 15" ::: "memory");
  if (hi == 0) li_l[r32] = l_reg; asm volatile("s_waitcnt lgkmcnt(0)" ::: "memory");
  float rli[16];
#pragma unroll
  for (int r = 0; r < 16; ++r) rli[r] = 64.f * __builtin_amdgcn_rcpf(li_l[crow(r, hi)]);
  float* Ow = Obuf + (size_t)(qrow0 - orow0) * 3072 + (h * 2 + m) * 256;
#pragma unroll
  for (int r = 0; r < 16; ++r) { const int orow = crow(r, hi);
#pragma unroll
    for (int d0 = 0; d0 < 8; ++d0) Ow[(size_t)orow * 3072 + d0 * 32 + r32] = o[d0][r] * rli[r]; }
  if (hi == 0) { float* mlp = ML + (((size_t)(qrow0 - orow0 + r32) * 6 + h) * 2 + m) * 2; mlp[0] = m_reg; mlp[1] = l_reg * (1.f / 64.f); }
  asm volatile("s_waitcnt vmcnt(0) lgkmcnt(0)" ::: "memory");
  __builtin_amdgcn_s_barrier(); asm volatile("" ::: "memory");
#undef A3_ISSUE
#undef A3_RD
#undef A3_MM
}
}

__device__ __forceinline__ void diffattn2_unit(Frame& F, const Args& a, unsigned code) {
    const int h = code & 7, m = (code >> 3) & 1, b = (code >> 4) & 31, pc = code >> 9;
    float* ob = (float*)(F.ws + (pc == 2 ? WS_OP2 : WS_OP)); float* ml = (float*)(F.ws + WS_ML) + (pc == 2 ? (size_t)T * 6 * 2 * 2 : 0);
    const int nt = 4 * b + 4, t_lo = (pc == 2) ? nt / 2 : 0, t_hi = (pc == 1) ? nt / 2 : nt;
    att3::diff_unit(F.ws + WS_ZQ, F.ws + WS_KD, F.ws + WS_VD, ob, pc == 2 ? 4096 : 0, ml, a.in[I_RELB], h, m, b, t_lo, t_hi, (LAS char*)F.lds);
}
__device__ __forceinline__ void diffcombine_phase(Frame& F, const Args& a, int l) {
    const int i = l - 2; const float* lp = a.in[I_BLAM] + (size_t)i * 4 * 128;
    float s1 = lp[F.lane] * lp[128 + F.lane] + lp[64 + F.lane] * lp[128 + 64 + F.lane], s2 = lp[256 + F.lane] * lp[384 + F.lane] + lp[256 + 64 + F.lane] * lp[384 + 64 + F.lane];
    s1 = wave_sum(s1); s2 = wave_sum(s2);
    const float lam_init = 0.8f - 0.6f * expf(-0.3f * (float)l);
    const float lam = expf(s1) - expf(s2) + lam_init;
    const float* op0 = (const float*)(F.ws + WS_OP); const float* op1 = (const float*)(F.ws + WS_OP2); const float* ml0 = (const float*)(F.ws + WS_ML); const float* ml1 = ml0 + (size_t)T * 6 * 2 * 2;
    bf16* cat = (bf16*)(F.ws + WS_CAT);
    const f32x4 gsub = *(const GAS f32x4*)(a.in[I_BSUBG] + (size_t)i * 256 + 4 * F.lane);
    const int gw = F.c * NWAVES + F.wave, NGW = F.G * NWAVES;
    for (int it = gw; it < T * 6; it += NGW) { const int tk = it / 6, h = it - tk * 6; f32x4 os[2];
#pragma unroll
        for (int m = 0; m < 2; ++m) { const size_t r0 = ((size_t)tk * 6 + h) * 2 + m; f32x4 oa = *(const GAS f32x4*)(op0 + r0 * 256 + 4 * F.lane);
            if (tk >= 4096) { const size_t r1 = ((size_t)(tk - 4096) * 6 + h) * 2 + m; const f32x4 ob = *(const GAS f32x4*)(op1 + r1 * 256 + 4 * F.lane);
                const float ma = ml0[r0 * 2], la = ml0[r0 * 2 + 1], mb = ml1[r1 * 2], lb = ml1[r1 * 2 + 1], M = fmaxf(ma, mb);
                const float wa = la * exp2f(ma - M), wb = lb * exp2f(mb - M), inv = 1.f / (wa + wb); oa = oa * (wa * inv) + ob * (wb * inv); }
            os[m] = oa; }
        const f32x4 o = os[0] - os[1] * lam; const float ss = wave_sum((o.x * o.x + o.y * o.y) + (o.z * o.z + o.w * o.w));
        const float r = (1.f - lam_init) / sqrtf(ss * (1.f / 256.f) + LN_EPS);
        v2u w; w.x = pk2(o.x * r * gsub.x, o.y * r * gsub.y); w.y = pk2(o.z * r * gsub.z, o.w * r * gsub.w);
        if (!F8OL(l)) *(GAS v2u*)(cat + (size_t)tk * D + h * 256 + 4 * F.lane) = w;
        { unsigned q8 = 0u; q8 = __builtin_amdgcn_cvt_pk_fp8_f32(o.x * r * gsub.x, o.y * r * gsub.y, q8, false); q8 = __builtin_amdgcn_cvt_pk_fp8_f32(o.z * r * gsub.z, o.w * r * gsub.w, q8, true);
          *(GAS unsigned*)(F.ws + WS_CATQ + (size_t)tk * D + h * 256 + 4 * F.lane) = q8; } }
    { const long nthr = (long)F.G * 512, gt = (long)F.c * 512 + F.tid;
      for (long i2 = gt; i2 < (long)T * 64; i2 += nthr) { const long tk = i2 >> 6; const int c8 = (int)(i2 & 63) * 8; const v4u w = *(const GAS v4u*)(cat + tk * D + MIXW + c8);
          unsigned lo = 0u, hi = 0u; lo = __builtin_amdgcn_cvt_pk_fp8_f32(bflo(w.x), bfhi(w.x), lo, false); lo = __builtin_amdgcn_cvt_pk_fp8_f32(bflo(w.y), bfhi(w.y), lo, true);
          hi = __builtin_amdgcn_cvt_pk_fp8_f32(bflo(w.z), bfhi(w.z), hi, false); hi = __builtin_amdgcn_cvt_pk_fp8_f32(bflo(w.w), bfhi(w.w), hi, true);
          v2u qq; qq.x = lo; qq.y = hi; *(GAS v2u*)(F.ws + WS_CATQ + tk * D + MIXW + c8) = qq; } }
}


__device__ __forceinline__ void ln1_router_phase(Frame& F, const Args& a, int l, int probe = 0) {
    const bf16* y = (const bf16*)(F.ws + WS_Y); bf16* x1b = (bf16*)(F.ws + WS_X1B);
    const float* lng = a.in[I_LNG] + ((size_t)l * 2 + 0) * D; const float* lnb = a.in[I_LNB] + ((size_t)l * 2 + 0) * D;
    const float* wr = (const float*)(F.ws + WS_WR) + (size_t)l * 3 * 512 * 16 * 4;
    int* tok_e = (int*)(F.ws + (probe ? WS_OP : WS_ROUTE)); int* tok_rank = tok_e + 2 * T; float* tok_gate = (float*)(tok_rank + 2 * T);
    gu32* cnt = F.ctl + (probe ? 65536 : CW_CNT) + 2048 * l;
    LAS float* P = (LAS float*)(F.lds);
    constexpr int X1ROW = 2 * D + 16;
    typedef float f32x4v __attribute__((ext_vector_type(4)));
    for (int tb = F.c; tb < T / 32; tb += F.G) {
#pragma unroll 2
        for (int i = 0; i < 4; ++i) { const int tk = tb * 32 + F.wave * 4 + i;
            const GAS v4u* yr = (const GAS v4u*)(y + (size_t)tk * D) + F.lane;
            float v[4][8]; float s = 0.f;
#pragma unroll
            for (int j = 0; j < 4; ++j) { const v4u w = yr[64 * j]; v[j][0] = bflo(w.x); v[j][1] = bfhi(w.x); v[j][2] = bflo(w.y); v[j][3] = bfhi(w.y); v[j][4] = bflo(w.z); v[j][5] = bfhi(w.z); v[j][6] = bflo(w.w); v[j][7] = bfhi(w.w);
#pragma unroll
                for (int e = 0; e < 8; ++e) s += v[j][e]; }
            const float mean = wave_sum(s) * (1.f / D); float s2 = 0.f;
#pragma unroll
            for (int j = 0; j < 4; ++j)
#pragma unroll
                for (int e = 0; e < 8; ++e) { v[j][e] -= mean; s2 += v[j][e] * v[j][e]; }
            const float rstd = 1.f / sqrtf(wave_sum(s2) * (1.f / D) + LN_EPS);
#pragma unroll
            for (int j = 0; j < 4; ++j) { const int d0 = 8 * F.lane + 512 * j; const f32x4 g0 = *(const GAS f32x4*)(lng + d0), g1 = *(const GAS f32x4*)(lng + d0 + 4), b0 = *(const GAS f32x4*)(lnb + d0), b1 = *(const GAS f32x4*)(lnb + d0 + 4);
                const float q0 = v[j][0] * rstd * g0.x + b0.x, q1 = v[j][1] * rstd * g0.y + b0.y, q2 = v[j][2] * rstd * g0.z + b0.z, q3 = v[j][3] * rstd * g0.w + b0.w;
                const float q4 = v[j][4] * rstd * g1.x + b1.x, q5 = v[j][5] * rstd * g1.y + b1.y, q6 = v[j][6] * rstd * g1.z + b1.z, q7 = v[j][7] * rstd * g1.w + b1.w;
                v4u w; w.x = pk2(q0, q1); w.y = pk2(q2, q3); w.z = pk2(q4, q5); w.w = pk2(q6, q7);
                *(GAS v4u*)(x1b + (size_t)tk * D + d0) = w;
                *(LAS v4u*)(F.lds + RING_OFF + (F.wave * 4 + i) * X1ROW + d0 * 2) = w;
                unsigned lo = 0u, hi = 0u; lo = __builtin_amdgcn_cvt_pk_fp8_f32(q0, q1, lo, false); lo = __builtin_amdgcn_cvt_pk_fp8_f32(q2, q3, lo, true);
                hi = __builtin_amdgcn_cvt_pk_fp8_f32(q4, q5, hi, false); hi = __builtin_amdgcn_cvt_pk_fp8_f32(q6, q7, hi, true);
                v2u qq; qq.x = lo; qq.y = hi; *(GAS v2u*)((unsigned char*)(F.ws + WS_X1F) + (size_t)tk * D + d0) = qq; } }
        __syncthreads();
        { const int mt = F.wave >> 2, kq = F.wave & 3, c = F.lane & 15, q = F.lane >> 4;
          const LAS unsigned char* ap = F.lds + RING_OFF + (mt * 16 + c) * X1ROW + (kq * 512 + 4 * q) * 2;
          const float* bp = wr + ((size_t)(kq * 128 + q) * 16 + c) * 4;
          f32x4v acc[3] = {{0.f, 0.f, 0.f, 0.f}, {0.f, 0.f, 0.f, 0.f}, {0.f, 0.f, 0.f, 0.f}};
#pragma unroll 8
          for (int ks = 0; ks < 32; ++ks) { const v2u aw = *(const LAS v2u*)(ap + 32 * ks); const f32x4 a4 = (f32x4){bflo(aw.x), bfhi(aw.x), bflo(aw.y), bfhi(aw.y)}; f32x4 b4[3];
#pragma unroll
              for (int nb = 0; nb < 3; ++nb) b4[nb] = *(const GAS f32x4*)(bp + ((size_t)nb * 512 + 4 * ks) * 64);
#pragma unroll
              for (int j = 0; j < 4; ++j)
#pragma unroll
                  for (int nb = 0; nb < 3; ++nb) acc[nb] = __builtin_amdgcn_mfma_f32_16x16x4f32(a4[j], b4[nb][j], acc[nb], 0, 0, 0); }
          __syncthreads();
#pragma unroll
          for (int nb = 0; nb < 3; ++nb)
#pragma unroll
              for (int r = 0; r < 4; ++r) P[((kq * 2 + mt) * 16 + 4 * q + r) * 48 + nb * 16 + c] = acc[nb][r]; }
        __syncthreads();
        if (F.tid < 64) { const int tsel = F.tid & 31, tk = tb * 32 + tsel, mt = tsel >> 4, ti = tsel & 15;
            const LAS f32x4* P4 = (const LAS f32x4*)P;
            const int rb = (mt * 16 + ti) * 12;
            const float* bg1 = a.in[I_BG1] + l * 4; const float* bg2 = a.in[I_BG2] + l * 32;
            const f32x4 s1 = (P4[rb] + P4[rb + 384]) + (P4[rb + 768] + P4[rb + 1152]);
            const float l10 = s1.x + bg1[0], l11 = s1.y + bg1[1], l12 = s1.z + bg1[2], l13 = s1.w + bg1[3];
            int grp = 0; float mx = l10;
            if (l11 > mx) { mx = l11; grp = 1; } if (l12 > mx) { mx = l12; grp = 2; } if (l13 > mx) { mx = l13; grp = 3; }
            const float psel = 1.f / (expf(l10 - mx) + expf(l11 - mx) + expf(l12 - mx) + expf(l13 - mx));
            const int ob = rb + 1 + 2 * grp;
            const f32x4 sa = (P4[ob] + P4[ob + 384]) + (P4[ob + 768] + P4[ob + 1152]), sb = (P4[ob + 1] + P4[ob + 385]) + (P4[ob + 769] + P4[ob + 1153]);
            const f32x4 ba = *(const GAS f32x4*)(bg2 + grp * 8), bb = *(const GAS f32x4*)(bg2 + grp * 8 + 4);
            const float l2[8] = {sa.x + ba.x, sa.y + ba.y, sa.z + ba.z, sa.w + ba.w, sb.x + bb.x, sb.y + bb.y, sb.z + bb.z, sb.w + bb.w};
            int i0 = 0; float v0 = l2[0];
#pragma unroll
            for (int e = 1; e < 8; ++e) if (l2[e] > v0) { v0 = l2[e]; i0 = e; }
            int i1 = -1; float v1 = -INFINITY;
#pragma unroll
            for (int e = 0; e < 8; ++e) if (e != i0 && l2[e] > v1) { v1 = l2[e]; i1 = e; }
            const float e1 = expf(v1 - v0), g0 = psel / (1.f + e1), g1 = psel * e1 / (1.f + e1);
            const int ex0 = grp * 8 + i0, ex1 = grp * 8 + i1;
            const int which = F.lane >> 5, ex = which ? ex1 : ex0; const float gg = which ? g1 : g0;
            int leader = F.lane, idx = 0, gcount = 1;
            { unsigned long long rem = ~0ull;
              while (rem) { const int l0 = __builtin_ctzll(rem); const int le = __builtin_amdgcn_readlane(ex, l0); const unsigned long long mm = __ballot(ex == le);
                  if (ex == le) { leader = l0; idx = __builtin_popcountll(mm & ((1ull << F.lane) - 1ull)); gcount = __builtin_popcountll(mm); }
                  rem &= ~mm; } }
            unsigned base = 0u; if (F.lane == leader) base = __hip_atomic_fetch_add(cnt + 64 * ex, (unsigned)gcount, RLX_AGENT);
            base = (unsigned)__shfl((int)base, leader);
            const int rk = (int)base + idx;
            { int* list = (int*)(F.ws + (probe ? WS_OP + 2 * MiB : WS_LIST)); list[ex * 8192 + rk] = tk; }
            tok_e[2 * tk + which] = ex; tok_rank[2 * tk + which] = rk; tok_gate[2 * tk + which] = gg; }
        __syncthreads();
    }
}
__device__ __forceinline__ void moe_table(Frame& F, int l) {
    LAS int* tstart = (LAS int*)(F.lds + TAB_OFF);
    if (F.tid < 64) {
        const int e = F.lane & 31;
        const unsigned c = __hip_atomic_load(F.ctl + CW_CNT + 2048 * l + 64 * e, RLX_AGENT);
        const int tiles = (int)((c + 255u) >> 8); int incl = tiles;
#pragma unroll
        for (int d = 1; d < 32; d <<= 1) { const int v = __shfl_up(incl, d, 32); if (e >= d) incl += v; }
        if (F.lane < 32) { tstart[e] = incl - tiles; tstart[36 + e] = (int)c; if (e == 31) tstart[32] = incl; }
    }
    __syncthreads();
}
__device__ __forceinline__ void ln2_phase(Frame& F, const Args& a, int l) {
    const bf16* x1b = (const bf16*)(F.ws + WS_X1B); const unsigned char* yb8 = F.ws + WS_YB; bf16* xb = (bf16*)(F.ws + WS_XB);
    const float* lng = a.in[I_LNG] + ((size_t)l * 2 + 1) * D; const float* lnb = a.in[I_LNB] + ((size_t)l * 2 + 1) * D;
    moe_table(F, l); const LAS int* tstart = (const LAS int*)(F.lds + TAB_OFF);
    const int* tok_e = (const int*)(F.ws + WS_ROUTE); const int* tok_rank = tok_e + 2 * T; const float* tok_gate = (const float*)(F.ws + WS_ROUTE) + 4 * T;
    const int gw = F.c * NWAVES + F.wave, NGW = F.G * NWAVES;
    for (int t4 = gw; t4 < T / 4; t4 += NGW) { const int tk0 = t4 * 4;
        int ev = 0, rv = 0; float gv = 0.f;
        if (F.lane < 8) { ev = tok_e[2 * tk0 + F.lane]; rv = tok_rank[2 * tk0 + F.lane]; gv = tok_gate[2 * tk0 + F.lane]; }
        const int slotv = (F.lane < 8) ? tstart[ev] * 256 + rv : 0;
        v4u xr[2], xr2[2]; v2u ya[2], yc[2], ya2[2], yc2[2];
#define LN2_LOAD(i, XR, YA, YC, XR2, YA2, YC2) do { const int s0_ = __builtin_amdgcn_readlane(slotv, 2 * (i)), s1_ = __builtin_amdgcn_readlane(slotv, 2 * (i) + 1); \
        _Pragma("unroll") for (int j = 0; j < 2; ++j) { const int d0 = 8 * F.lane + 512 * j; XR[j] = *(const GAS v4u*)(x1b + (size_t)(tk0 + (i)) * D + d0); YA[j] = *(const GAS v2u*)(yb8 + (size_t)s0_ * D + d0); YC[j] = *(const GAS v2u*)(yb8 + (size_t)s1_ * D + d0); } \
        _Pragma("unroll") for (int j = 0; j < 2; ++j) { const int d0 = 8 * F.lane + 512 * (j + 2); XR2[j] = *(const GAS v4u*)(x1b + (size_t)(tk0 + (i)) * D + d0); YA2[j] = *(const GAS v2u*)(yb8 + (size_t)s0_ * D + d0); YC2[j] = *(const GAS v2u*)(yb8 + (size_t)s1_ * D + d0); } } while (0)
        LN2_LOAD(0, xr, ya, yc, xr2, ya2, yc2);
#pragma unroll
        for (int i = 0; i < 4; ++i) { const int tk = tk0 + i;
            const float g0 = (1.f / 16.f) * __builtin_bit_cast(float, __builtin_amdgcn_readlane(__builtin_bit_cast(int, gv), 2 * i)), g1 = (1.f / 16.f) * __builtin_bit_cast(float, __builtin_amdgcn_readlane(__builtin_bit_cast(int, gv), 2 * i + 1));
            float v[4][8]; float s = 0.f;
#pragma unroll
            for (int j = 0; j < 4; ++j) { const v4u X = j < 2 ? xr[j] : xr2[j - 2]; const v2u A = j < 2 ? ya[j] : ya2[j - 2], C = j < 2 ? yc[j] : yc2[j - 2];
#define Y8(W, B) __builtin_amdgcn_cvt_f32_fp8((int)(W), (B))
                v[j][0] = bflo(X.x) * DN_ALPHA + (g0 * Y8(A.x, 0) + g1 * Y8(C.x, 0)); v[j][1] = bfhi(X.x) * DN_ALPHA + (g0 * Y8(A.x, 1) + g1 * Y8(C.x, 1));
                v[j][2] = bflo(X.y) * DN_ALPHA + (g0 * Y8(A.x, 2) + g1 * Y8(C.x, 2)); v[j][3] = bfhi(X.y) * DN_ALPHA + (g0 * Y8(A.x, 3) + g1 * Y8(C.x, 3));
                v[j][4] = bflo(X.z) * DN_ALPHA + (g0 * Y8(A.y, 0) + g1 * Y8(C.y, 0)); v[j][5] = bfhi(X.z) * DN_ALPHA + (g0 * Y8(A.y, 1) + g1 * Y8(C.y, 1));
                v[j][6] = bflo(X.w) * DN_ALPHA + (g0 * Y8(A.y, 2) + g1 * Y8(C.y, 2)); v[j][7] = bfhi(X.w) * DN_ALPHA + (g0 * Y8(A.y, 3) + g1 * Y8(C.y, 3));
#undef Y8
#pragma unroll
                for (int e = 0; e < 8; ++e) s += v[j][e]; }
            if (i + 1 < 4) LN2_LOAD(i + 1, xr, ya, yc, xr2, ya2, yc2);
            const float mean = wave_sum(s) * (1.f / D); float s2 = 0.f;
#pragma unroll
            for (int j = 0; j < 4; ++j)
#pragma unroll
                for (int e = 0; e < 8; ++e) { v[j][e] -= mean; s2 += v[j][e] * v[j][e]; }
            const float rstd = 1.f / sqrtf(wave_sum(s2) * (1.f / D) + LN_EPS);
#pragma unroll
            for (int j = 0; j < 4; ++j) { const int d0 = 8 * F.lane + 512 * j; const f32x4 g0v = *(const GAS f32x4*)(lng + d0), g1v = *(const GAS f32x4*)(lng + d0 + 4), b0 = *(const GAS f32x4*)(lnb + d0), b1 = *(const GAS f32x4*)(lnb + d0 + 4);
                const f32x4 oa = (f32x4){v[j][0] * rstd * g0v.x + b0.x, v[j][1] * rstd * g0v.y + b0.y, v[j][2] * rstd * g0v.z + b0.z, v[j][3] * rstd * g0v.w + b0.w};
                const f32x4 ob = (f32x4){v[j][4] * rstd * g1v.x + b1.x, v[j][5] * rstd * g1v.y + b1.y, v[j][6] * rstd * g1v.z + b1.z, v[j][7] * rstd * g1v.w + b1.w};
                if (l == DEPTH - 1) { *(GAS f32x4*)(a.out + (size_t)tk * D + d0) = oa; *(GAS f32x4*)(a.out + (size_t)tk * D + d0 + 4) = ob; }
                else { v4u w; w.x = pk2(oa.x, oa.y); w.y = pk2(oa.z, oa.w); w.z = pk2(ob.x, ob.y); w.w = pk2(ob.z, ob.w); *(GAS v4u*)(xb + (size_t)tk * D + d0) = w;
                    unsigned lo = 0u, hi = 0u; lo = __builtin_amdgcn_cvt_pk_fp8_f32(oa.x, oa.y, lo, false); lo = __builtin_amdgcn_cvt_pk_fp8_f32(oa.z, oa.w, lo, true); hi = __builtin_amdgcn_cvt_pk_fp8_f32(ob.x, ob.y, hi, false); hi = __builtin_amdgcn_cvt_pk_fp8_f32(ob.z, ob.w, hi, true);
                    v2u qq; qq.x = lo; qq.y = hi; if (F8L(l + 1)) *(GAS v2u*)(F.ws + WS_XQ + (size_t)tk * D + d0) = qq; } }
        }
#undef LN2_LOAD
    }
}

__global__ void __launch_bounds__(NWAVES * 64, 2) fwd_kernel(Args args) {
    extern __shared__ __attribute__((aligned(16))) unsigned char lds[];
    Frame F;
    F.lds = (LAS unsigned char*)lds; F.ldsg = (char*)lds;
    F.tid = threadIdx.x; F.lane = F.tid & 63; F.wave = __builtin_amdgcn_readfirstlane(F.tid >> 6);
    F.G = gridDim.x; F.c = blockIdx.x; F.ws = args.ws; F.ctl = (gu32*)(args.ws + WS_CTL);
    volatile LAS unsigned* MISC = (volatile LAS unsigned*)(F.lds + MISC_OFF);
    for (int u = F.tid; u < (LDS_BYTES - LDSCTL_OFF) / 4; u += NWAVES * 64) ((LAS unsigned*)(F.lds + LDSCTL_OFF))[u] = 0u;
    __syncthreads();
    const int lo = args.ph_lo, hi = args.ph_hi; int lastp = -1;
    const bool multi = (hi - lo) > 1;
    XcdBarrier bar; bar.bar = (unsigned*)(F.ctl + CW_BAR); bar.x = 0; bar.st = nullptr;
    if (multi) bar = xcd_barrier_post((unsigned*)(F.ctl + CW_BAR), MISC + 8);
#ifndef REP_MASK
#define REP_MASK 0
#endif
#define REP(k) for (int rep_ = 0; rep_ <= ((REP_MASK >> (k)) & 1); ++rep_)
#define IN(p) (lo <= (p) && (p) < hi)
#ifdef PROBE_A
#define STAMP(i) do { if (blockIdx.x == 0 && threadIdx.x == 0) ((unsigned long long*)(args.ws + WS_TS))[(i)] = __builtin_amdgcn_s_memrealtime(); } while (0)
#else
#define STAMP(i) do { } while (0)
#endif
#define SEAM(p) do { lastp = (p); if ((p) + 1 < hi) xcd_barrier(bar); STAMP((p) + 1); } while (0)
#define CONVFIN() ((lastp >= 0) ? (int)__hip_atomic_load(F.ctl + CW_FIN + 64 * lastp, RLX_AGENT) : 0)
#define FRESH() do { int t_ = threadIdx.x; asm volatile("" : "+v"(t_)); F.tid = t_; F.lane = t_ & 63; F.wave = __builtin_amdgcn_readfirstlane(t_ >> 6); \
    GAS unsigned char* w_ = (GAS unsigned char*)args.ws; asm volatile("" : "+s"(w_)); F.ws = (unsigned char*)w_; F.ctl = (gu32*)(w_ + WS_CTL); } while (0)

    STAMP(0);
    if (IN(0)) { FRESH(); REP(9) prologue_phase(F, args); SEAM(0); }
#ifdef XBAR
    for (int xb_ = 0; xb_ < XBAR; ++xb_) xcd_barrier(bar);
#endif

#pragma unroll 1
    for (int l_ = 0; l_ < DEPTH; ++l_) {
        const int pb = 1 + NPH_LAYER * l_;
#pragma unroll 1
        for (int k_ = 0; k_ < NPH_LAYER; ++k_) {
            const int p = pb + k_;
            if (!IN(p) || k_ == 5 || (k_ == 2 && l_ < 2)) continue;
            int l = l_, k = k_; asm volatile("" : "+s"(l), "+s"(k));
            FRESH();
            int cq = NQ, cn = 0;
            switch (k) {
            case 0: {
                const int N = (l < 2) ? NINA : (l == 2 ? 5120 : 2048);
                const unsigned char* Bt = F.ws + ((l < 2) ? WS_WAIN + (size_t)l * NINA * D * 2 : (l == 2 ? WS_WBIN0 : WS_WBIN1));
                const int nu = (T / 256) * (N / 256) + (l == 0 ? 16 : 0); const bool f8 = F8L(l);
                pg8::EpiBf16X E{l < 2 ? 0 : 1, (bf16*)(F.ws + WS_Z), (bf16*)(F.ws + WS_KD), (bf16*)(F.ws + WS_VD), (bf16*)(F.ws + WS_MEMKV), nullptr, nullptr};
                if (f8) { pg8::Gemm g{nullptr, nullptr, T, N, D / 2}; pg8::DualOrder8 S; S.init(F.ws + WS_XQ, Bt, T, N, D / 2, F.G, F.c, F.ws + WS_MEMQ, F.ws + WS_WMKV, l == 0 ? 16 : 0);
                    REP(0) pg8::gemm_phase<pg8::EpiBf16X, pg8::DualOrder8, true, true>(F.lds + RING_OFF, g, S, E); }
                else { pg8::Gemm g{nullptr, nullptr, T, N, D}; pg8::DualOrder S; S.init(F.ws + WS_XB, Bt, T, N, D, F.G, F.c, F.ws + WS_MEMB, F.ws + WS_WMKV, l == 0 ? 16 : 0);
                    REP(0) pg8::gemm_phase<pg8::EpiBf16X, pg8::DualOrder, true, true>(F.lds + RING_OFF, g, S, E); }
                { const int mine = (nu - 1 - F.c) / F.G + 1, rounds = (nu + F.G - 1) / F.G; cq = 2 * l; cn = (rounds - mine) * (f8 ? (QA + 1) / 2 : QA); }
            } break;
            case 1: {
                if (l < 2) {
                    REP(1) for (int u = F.c; u < 256 + 128; u += F.G) {
                        if (u < 256) sgu_unit(F, args, l, u >> 2, u & 3);
                        else { const int r = u - 256; memattn_unit(F, l, r & 3, r >> 2, NINA, 2 * MIXW); }
                    }
                    if (F.c >= 128) { cq = 2 * l; cn = QX; }
                } else {
                    const int ncv = CONVFIN() ? 0 : NCVATT;
                    if (F.c >= F.G - ncv) { conv_server_q(F, args, F.ctl + CW_Q + 64 * l, (unsigned)(att2::NUNITS + 128 - STOPU), 2 * l); __syncthreads(); }
                    REP(2) { gu32* qh = F.ctl + CW_Q + 64 * l + 16 * rep_; LAS unsigned* uw = (LAS unsigned*)(F.lds + att2::LDS_UNIT);
                    for (;;) {
                        if (F.tid == 0) *uw = __hip_atomic_fetch_add(qh, 1u, RLX_AGENT);
                        __syncthreads();
                        const unsigned idx = *uw;
                        __syncthreads();
                        if (idx >= (unsigned)(att2::NUNITS + 128)) break;
                        if (idx < (unsigned)att2::NUNITS) diffattn2_unit(F, args, att3::g_units.u[idx]);
                        else { const int r = (int)idx - att2::NUNITS; memattn_unit(F, l, r & 3, r >> 2, 2048, MIXW); }
                    } }
                }
            } break;
            case 2: { REP(3) diffcombine_phase(F, args, l); } break;
            case 3: {
                pg8::EpiResBf16 E{(const bf16*)(F.ws + WS_XB), (bf16*)(F.ws + WS_Y), DN_ALPHA};
                const unsigned char* Wo = F.ws + (l < 2 ? WS_WAOUT + (size_t)l * D * D * 2 : WS_WBOUT + (size_t)(l - 2) * D * D * 2);
                if (F8OL(l)) { pg8::Gemm g{nullptr, nullptr, T, D, D / 2}; pg8::DenseOrder8 S; S.init(F.ws + WS_CATQ, Wo, T, D, D / 2, F.G, F.c);
                    REP(4) pg8::gemm_phase<pg8::EpiResBf16, pg8::DenseOrder8, true, true>(F.lds + RING_OFF, g, S, E); }
                else { pg8::Gemm g{nullptr, nullptr, T, D, D}; pg8::DenseOrder S; S.init(F.ws + WS_CAT, Wo, T, D, D, F.G, F.c);
                    REP(4) pg8::gemm_phase<pg8::EpiResBf16, pg8::DenseOrder, true, true>(F.lds + RING_OFF, g, S, E); }
            } break;
            case 4: {
                ln1_router_phase(F, args, l);
#ifdef REP_LN1
                ln1_router_phase(F, args, l, 1);
#endif
                cq = 2 * l; cn = -1;
            } break;
            case 6: {
                moe_table(F, l);
                const LAS int* tb = (const LAS int*)(F.lds + TAB_OFF);
                pg8::Gemm g{nullptr, nullptr, SLOTS, 1024, D / 2};
                pg8::MoeGatherOrder S{tb, tb + 36, (const int*)(F.ws + WS_LIST), 4, F.G, F.c, (const char*)(F.ws + WS_X1F), (const char*)(F.ws + WS_W13) + (size_t)l * NE * 1024 * 2048, (size_t)1024 * 2048, (size_t)256 * 2048, (unsigned)D};
                pg8::EpiMoe1 E{(bf16*)(F.ws + WS_H), tb, tb + 36};
                REP(6) pg8::gemm_phase<pg8::EpiMoe1, pg8::MoeGatherOrder, true, true>(F.lds + RING_OFF, g, S, E);
                { const int nu = __builtin_amdgcn_readfirstlane(((const LAS int*)(F.lds + TAB_OFF))[32]) * 4, mine = (F.c < nu) ? (nu - 1 - F.c) / F.G + 1 : 0, rounds = (nu + F.G - 1) / F.G; cq = 2 * l + 1; cn = (rounds - mine) * QM; }
            } break;
            case 7: {
                moe_table(F, l);
                pg8::Gemm g{nullptr, nullptr, SLOTS, D, FF / 2};
                pg8::MoeOrder8 S{(const PG8_LAS int*)(F.lds + TAB_OFF), 8, F.G, F.c, (const char*)(F.ws + WS_H), (const char*)(F.ws + WS_W2) + (size_t)l * NE * 2048 * 512, (size_t)256 * FF, (size_t)2048 * 512, (size_t)256 * 512};
                pg8::EpiBf16X E{3, (bf16*)(F.ws + WS_YB), nullptr, nullptr, nullptr, (const PG8_LAS int*)(F.lds + TAB_OFF), (const PG8_LAS int*)(F.lds + TAB_OFF) + 36};
                REP(7) pg8::gemm_phase<pg8::EpiBf16X, pg8::MoeOrder8, true, true>(F.lds + RING_OFF, g, S, E);
                { const int nu = __builtin_amdgcn_readfirstlane(((const LAS int*)(F.lds + TAB_OFF))[32]) * 8, mine = (F.c < nu) ? (nu - 1 - F.c) / F.G + 1 : 0, rounds = (nu + F.G - 1) / F.G; cq = 2 * l + 1; cn = (rounds - mine) * QB; }
            } break;
            default: {
                REP(8) ln2_phase(F, args, l);
                cq = 2 * l + 1; cn = -1;
            } break;
            }
            FRESH();
            conv_filler(F, args, cq, cn);
            if (k == 0 && l >= 2) conv_note_fin(F, p);
            SEAM(p);
        }
    }
#ifdef PROBE_A
    {
        VM_WAIT(); xcd_barrier(bar);
        const unsigned long long* ts = (const unsigned long long*)(args.ws + WS_TS);
        float da = 0.f, db = 0.f;
        for (int p = 0; p < NPHASES; ++p) { const int k = (p == 0) ? 9 : (p - 1) % NPH_LAYER; const float d = (float)(ts[p + 1] - ts[p]);
            if (k == PROBE_A || PROBE_A == 10) da += d; if (k == PROBE_B || PROBE_B == 10) db += d; }
        const float kk = sqrtf(da), vv = db;
        float* o = args.out; const long n = (long)T * D;
        for (long i = (long)blockIdx.x * 512 + threadIdx.x; i < n; i += (long)gridDim.x * 512) o[i] = (i == 0) ? vv : kk;
    }
#endif
#undef IN
#undef SEAM
}

#ifndef MK_ONE_LAUNCH
#define MK_ONE_LAUNCH 1
#endif
extern "C" void kernel_launch(void* const* d_in, const int* in_sizes, int n_in, void* d_out, int out_size, void* d_ws, size_t ws_size, hipStream_t stream) {
    static int grid = 0;
    if (grid == 0) {
        if (n_in != 24 || in_sizes[0] != T * D || out_size != T * D || ws_size < WS_END) { fprintf(stderr, "kernel_launch: unexpected shapes (n_in %d, in0 %d, out %d, ws %zu < %zu)\n", n_in, n_in > 0 ? in_sizes[0] : -1, out_size, ws_size, (size_t)WS_END); grid = -1; return; }
        int dev = 0, cus = 0, per_cu = 0;
        if (hipGetDevice(&dev) != hipSuccess || hipDeviceGetAttribute(&cus, hipDeviceAttributeMultiprocessorCount, dev) != hipSuccess) { grid = -1; return; }
        if (hipFuncSetAttribute((const void*)fwd_kernel, hipFuncAttributeMaxDynamicSharedMemorySize, LDS_BYTES) != hipSuccess) { fprintf(stderr, "kernel_launch: hipFuncSetAttribute failed\n"); grid = -1; return; }
        if (hipOccupancyMaxActiveBlocksPerMultiprocessor(&per_cu, (const void*)fwd_kernel, NWAVES * 64, LDS_BYTES) != hipSuccess || per_cu < 1) fprintf(stderr, "kernel_launch: occupancy query reports %d\n", per_cu);
        (void)hipGetLastError();
        grid = cus;
    }
    if (grid < 0) return;
    if (hipMemsetAsync((char*)d_ws + WS_CTL, 0, CTL_ZERO_BYTES, stream) != hipSuccess) return;
    Args a{};
    for (int i = 0; i < 24; ++i) a.in[i] = (const float*)d_in[i];
    a.out = (float*)d_out; a.ws = (unsigned char*)d_ws;
#if MK_ONE_LAUNCH
    a.ph_lo = 0; a.ph_hi = NPHASES;
    hipLaunchKernelGGL(fwd_kernel, dim3(grid), dim3(NWAVES * 64), LDS_BYTES, stream, a);
#else
    for (int p = 0; p < NPHASES; ++p) {
        const int k = (p - 1) % NPH_LAYER, l = (p - 1) / NPH_LAYER;
        if (p > 0 && k == 2 && l < 2) continue;
        a.ph_lo = p; a.ph_hi = p + 1;
        hipLaunchKernelGGL(fwd_kernel, dim3(grid), dim3(NWAVES * 64), LDS_BYTES, stream, a);
    }
#endif
    const hipError_t le = hipPeekAtLastError();
    if (le != hipSuccess) fprintf(stderr, "kernel_launch: launch failed: %s\n", hipGetErrorName(le));
}
```

```cpp
#define F8MASK 12
#define F8OMASK 12
#define FLAT_RELEASE 1
#include <hip/hip_runtime.h>
#include <cstdio>
#include <cstdint>
namespace pg8 {
#define PG8_LAS __attribute__((address_space(3)))
typedef unsigned short bf16_t;
typedef short bf16x8 __attribute__((ext_vector_type(8)));
typedef float f32x4 __attribute__((ext_vector_type(4)));
typedef unsigned u32x4 __attribute__((ext_vector_type(4)));
constexpr int BM = 256, BK = 64, HALF = 128, HTB = HALF * BK * 2  , STAGE_BYTES = 8 * HTB, NXCD = 8, WGM = 8;

__host__ __device__ __forceinline__ int lds_byte(int r, int c) { const int st = (r >> 4) * 2 + (c >> 5), rr = r & 15, cc = c & 31, ob = rr * 64 + cc * 2; return st * 1024 + (ob ^ (((ob >> 9) & 1) << 5)); }
__host__ __device__ __forceinline__ void stage_rc(int b, int& R, int& C) { const int st = b / 1024, sb = b % 1024, swz = sb ^ (((sb >> 9) & 1) << 5); R = (st >> 1) * 16 + swz / 64; C = (st & 1) * 32 + (swz % 64) / 2; }
__host__ __device__ __forceinline__ int perm32(int rho) { const int n = rho >> 4, i = rho & 15; return 8 * (i >> 2) + 4 * n + (i & 3); }

typedef int pg8_v4i __attribute__((ext_vector_type(4))); typedef int pg8_v8i __attribute__((ext_vector_type(8)));
__device__ __forceinline__ pg8_v8i pg8_cat8(bf16x8 a, bf16x8 b) { return __builtin_shufflevector(__builtin_bit_cast(pg8_v4i, a), __builtin_bit_cast(pg8_v4i, b), 0, 1, 2, 3, 4, 5, 6, 7); }
struct Unit { int pm, pn, e; };
struct Gemm { const bf16_t* A; const bf16_t* Bt; int M, N, K; };

struct StaticOrder {
    static constexpr bool GATHER = false, F8 = false; static constexpr int SCALE_B = 127;
    int nM, nN, nwg, G, c;
    __host__ __device__ void init(int M, int N, int G_, int c_) { nM = M / BM; nN = N / BM; nwg = nM * nN; G = G_; c = c_; }
    __host__ __device__ bool next(int i, Unit& u) const {
        const long L = (long)i * G + c; if (L >= nwg) return false;
        int wgid = (int)L; { const int q = nwg / NXCD, r = nwg % NXCD, xcd = wgid % NXCD, off = wgid / NXCD; wgid = (xcd < r ? xcd * (q + 1) : r * (q + 1) + (xcd - r) * q) + off; }
        const int nig = WGM * nN, gid = wgid / nig, fm = gid * WGM, gsz = (nM - fm) < WGM ? (nM - fm) : WGM;
        u.pm = fm + ((wgid % nig) % gsz); u.pn = (wgid % nig) / gsz; return true;
    }
    __device__ __forceinline__ void a_ready(const Unit&) const {}
    __device__ __forceinline__ void done(const Unit&) const {}
};

__device__ __forceinline__ unsigned cvt_pk_bf16(float lo, float hi) { unsigned r; asm volatile("v_cvt_pk_bf16_f32 %0, %1, %2" : "=v"(r) : "v"(lo), "v"(hi)); return r; }
typedef float f32x2 __attribute__((ext_vector_type(2)));
__device__ __forceinline__ f32x2 gelu_pk(f32x2 v) {
    const f32x2 av = __builtin_elementwise_abs(v), d = av * 0.2316418882f + 1.0f;
    f32x2 t; t.x = __builtin_amdgcn_rcpf(d.x); t.y = __builtin_amdgcn_rcpf(d.y);
    f32x2 q = t * 0.5307027145f + (-0.7265760135f); q = q * t + 0.7107068705f; q = q * t + (-0.142248368f); q = q * t + 0.127414796f; q = q * t;
    const f32x2 s = (v * v) * (-0.72134752044f);
    f32x2 e; e.x = __builtin_amdgcn_exp2f(s.x); e.y = __builtin_amdgcn_exp2f(s.y);
    const f32x2 m = v * (q * e), r = v - m;
    f32x2 o; o.x = v.x < 0.f ? m.x : r.x; o.y = v.y < 0.f ? m.y : r.y; return o;
}

template <class Epi, class Sched, bool ALIGN_EPI = false, bool SP2 = false>
__device__ __forceinline__ void gemm_phase(PG8_LAS unsigned char* lds, const Gemm g, const Sched& S, const Epi& E) {
    int tid_ = threadIdx.x; asm volatile("" : "+v"(tid_));
    const int tid = tid_, wid = __builtin_amdgcn_readfirstlane(tid >> 6), lane = tid & 63, wr = wid >> 2, wc = wid & 3, fr = lane & 15, fq = lane >> 4;
    const int K = g.K, nt = K / BK;
    unsigned voffA[2], voffB[2];
#pragma unroll
    for (int i = 0; i < 2; ++i) { int R, C; stage_rc(tid * 16 + i * 8192, R, C); const int Rb = Epi::PERM ? ((R & ~31) + perm32(R & 31)) : R;
        voffA[i] = (unsigned)(R * K + C) * 2u; voffB[i] = (unsigned)(Rb * K + C) * 2u; }
    unsigned vAc[2][2], vAn[2][2];
    int gR[2], gC[2];
#pragma unroll
    for (int i = 0; i < 2; ++i) { stage_rc(tid * 16 + i * 8192, gR[i], gC[i]); }
    const size_t kstep = (size_t)(BK * 2);
    const size_t hstep = (size_t)HALF * K * 2;
        const unsigned ldsw = (unsigned)wid * 1024u;
    const int aoff = lds_byte(wr * 64 + fr, fq * 8), boff = lds_byte(wc * 32 + fr, fq * 8);
#define PG8_SA(b, h) (((b) * 2 + (h)) * HTB)
#define PG8_SB(b, h) ((4 + (b) * 2 + (h)) * HTB)
#define PG8_STAGE(bufoff, gbase, voff) do { _Pragma("unroll") for (int _i = 0; _i < 2; ++_i) \
        __builtin_amdgcn_global_load_lds((const unsigned*)((const char*)(gbase) + (voff)[_i]), (PG8_LAS unsigned*)(lds + (bufoff) + ldsw + _i * 8192), 16, 0, 0); } while (0)
#define PG8_STAGE_A(b, h, base, VS) do { if constexpr (Sched::GATHER) { PG8_STAGE(PG8_SA(b, h), base, VS[h]); } else { PG8_STAGE(PG8_SA(b, h), (base) + (h) * hstep, voffA); } } while (0)
#define PG8_STAGE_AN(b, h, base) do { if constexpr (Sched::GATHER) { unsigned vs_[2] = {last ? vAn[h][0] : vAc[h][0], last ? vAn[h][1] : vAc[h][1]}; PG8_STAGE(PG8_SA(b, h), base, vs_); } else { PG8_STAGE(PG8_SA(b, h), (base) + (h) * hstep, voffA); } } while (0)
#define PG8_LDA(dst, b, h) do { if constexpr (Sched::F8) { _Pragma("unroll") for (int m = 0; m < 4; ++m) { dst##8[m].lo = *(const PG8_LAS pg8_v4i*)(lds + PG8_SA(b, h) + aoff + m * 2048); dst##8[m].hi = *(const PG8_LAS pg8_v4i*)(lds + PG8_SA(b, h) + aoff + m * 2048 + 1024); } } \
        else { _Pragma("unroll") for (int m = 0; m < 4; ++m) _Pragma("unroll") for (int k = 0; k < 2; ++k) dst[m][k] = *(const PG8_LAS bf16x8*)(lds + PG8_SA(b, h) + aoff + m * 2048 + k * 1024); } } while (0)
#define PG8_LDB(dst, b, h) do { if constexpr (Sched::F8) { _Pragma("unroll") for (int n = 0; n < 2; ++n) { dst##8[n].lo = *(const PG8_LAS pg8_v4i*)(lds + PG8_SB(b, h) + boff + n * 2048); dst##8[n].hi = *(const PG8_LAS pg8_v4i*)(lds + PG8_SB(b, h) + boff + n * 2048 + 1024); } } \
        else { _Pragma("unroll") for (int n = 0; n < 2; ++n) _Pragma("unroll") for (int k = 0; k < 2; ++k) dst[n][k] = *(const PG8_LAS bf16x8*)(lds + PG8_SB(b, h) + boff + n * 2048 + k * 1024); } } while (0)
#define PG8_MMA(ai, bj, At, Bt) do { __builtin_amdgcn_s_setprio(1); if constexpr (Sched::F8) { \
        _Pragma("unroll") for (int m = 0; m < 4; ++m) _Pragma("unroll") for (int n = 0; n < 2; ++n) \
            asm volatile("v_mfma_scale_f32_16x16x128_f8f6f4 %0, %1, %2, %0, %3, %4 op_sel_hi:[0,0,0]" : "+v"(acc[ai][bj][m][n]) : "v"(Bt##8[n]), "v"(At##8[m]), "v"(sclB_), "v"(sclA_));     \
        } else { _Pragma("unroll") for (int m = 0; m < 4; ++m) _Pragma("unroll") for (int n = 0; n < 2; ++n) _Pragma("unroll") for (int k = 0; k < 2; ++k) \
        acc[ai][bj][m][n] = __builtin_amdgcn_mfma_f32_16x16x32_bf16(Bt[n][k], At[m][k], acc[ai][bj][m][n], 0, 0, 0); } __builtin_amdgcn_s_setprio(0); } while (0)
#define PG8_WAIT_V(n) asm volatile("s_waitcnt vmcnt(" #n ")" ::: "memory")
#define PG8_WAIT_L(n) asm volatile("s_waitcnt lgkmcnt(" #n ")" ::: "memory")
#define PG8_BAR __builtin_amdgcn_s_barrier()
#define PG8_SCHED __builtin_amdgcn_sched_barrier(0)
    Unit cur, nxt; int ui = 0;
    if (!S.next(0, cur)) return;
    f32x4 acc[2][2][4][2];
#pragma unroll
    for (int a = 0; a < 2; ++a)
#pragma unroll
        for (int b = 0; b < 2; ++b)
#pragma unroll
            for (int m = 0; m < 4; ++m)
#pragma unroll
                for (int n = 0; n < 2; ++n) acc[a][b][m][n] = (f32x4){0.f, 0.f, 0.f, 0.f};
    const int sclB_ = Sched::SCALE_B, sclA_ = 127;
    bf16x8 At[4][2], B0[2][2], B1[2][2]; pg8_v8i At8[4], B08[2], B18[2];
    const char* cA = S.aptr(cur); const char* cB = S.bptr(cur);
    S.a_ready(cur);
    if constexpr (Sched::GATHER) {
#pragma unroll
        for (int h = 0; h < 2; ++h)
#pragma unroll
            for (int i = 0; i < 2; ++i) { vAc[h][i] = S.rowoff(cur, h * HALF + gR[i]) + (unsigned)gC[i] * 2u; vAn[h][i] = vAc[h][i]; }
        asm volatile("s_waitcnt vmcnt(0)" ::: "memory");
    }
    if constexpr (SP2) {
        PG8_STAGE(PG8_SB(0, 0), cB, voffB); PG8_STAGE(PG8_SB(0, 1), cB + hstep, voffB); PG8_STAGE_A(0, 0, cA, vAc); PG8_STAGE_A(0, 1, cA, vAc);
        if (wr == 1) PG8_BAR;
        PG8_WAIT_V(2); PG8_BAR;
        PG8_STAGE(PG8_SB(1, 0), cB + kstep, voffB); PG8_STAGE_A(1, 0, cA + kstep, vAc); PG8_STAGE(PG8_SB(1, 1), cB + hstep + kstep, voffB);
        PG8_WAIT_V(6); PG8_BAR;
    } else {
        PG8_STAGE(PG8_SB(0, 0), cB, voffB); PG8_STAGE_A(0, 0, cA, vAc); PG8_STAGE(PG8_SB(0, 1), cB + hstep, voffB); PG8_STAGE_A(0, 1, cA, vAc);
        if (wr == 1) PG8_BAR;
        PG8_WAIT_V(4); PG8_BAR;
        PG8_STAGE(PG8_SB(1, 0), cB + kstep, voffB); PG8_STAGE_A(1, 0, cA + kstep, vAc); PG8_STAGE(PG8_SB(1, 1), cB + hstep + kstep, voffB);
        PG8_WAIT_V(6); PG8_BAR;
    }
    for (;;) {
        const bool has_next = S.next(ui + 1, nxt);
        const char* nA = has_next ? S.aptr(nxt) : cA; const char* nB = has_next ? S.bptr(nxt) : cB;
        if constexpr (Sched::GATHER) { if (has_next) {
#pragma unroll
            for (int h = 0; h < 2; ++h)
#pragma unroll
                for (int i = 0; i < 2; ++i) vAn[h][i] = S.rowoff(nxt, h * HALF + gR[i]) + (unsigned)gC[i] * 2u; } }
        for (int t = 0; t < nt; t += 2) {
            const bool last = (t == nt - 2);
            const char* a1 = cA + (size_t)(t + 1) * kstep;
            const char* a2 = last ? nA : cA + (size_t)(t + 2) * kstep; const char* b2 = last ? nB : cB + (size_t)(t + 2) * kstep;
            const char* a3 = a2 + kstep; const char* b3 = b2 + kstep;
            if (last && has_next) S.a_ready(nxt);
            if constexpr (SP2) {
            PG8_LDB(B0, 0, 0); PG8_LDB(B1, 0, 1); PG8_SCHED; PG8_LDA(At, 0, 0); PG8_STAGE_A(1, 1, a1, vAc);
            PG8_WAIT_V(8); PG8_WAIT_L(0); PG8_BAR; PG8_MMA(0, 0, At, B0); PG8_MMA(0, 1, At, B1); PG8_BAR; PG8_SCHED;
            PG8_LDA(At, 0, 1); PG8_STAGE(PG8_SB(0, 0), b2, voffB); PG8_STAGE(PG8_SB(0, 1), b2 + hstep, voffB); PG8_STAGE_AN(0, 0, a2);
            PG8_WAIT_V(8); PG8_WAIT_L(0); PG8_BAR; PG8_MMA(1, 0, At, B0); PG8_MMA(1, 1, At, B1); PG8_BAR; PG8_SCHED;
            PG8_LDB(B0, 1, 0); PG8_LDB(B1, 1, 1); PG8_SCHED; PG8_LDA(At, 1, 0); PG8_STAGE_AN(0, 1, a2);
            PG8_WAIT_V(8); PG8_WAIT_L(0); PG8_BAR; PG8_MMA(0, 0, At, B0); PG8_MMA(0, 1, At, B1); PG8_BAR; PG8_SCHED;
            PG8_LDA(At, 1, 1); PG8_STAGE(PG8_SB(1, 0), b3, voffB); PG8_STAGE(PG8_SB(1, 1), b3 + hstep, voffB); PG8_STAGE_AN(1, 0, a3);
            PG8_WAIT_V(8); PG8_WAIT_L(0); PG8_BAR; PG8_MMA(1, 0, At, B0); PG8_MMA(1, 1, At, B1); PG8_BAR; PG8_SCHED;
            } else {
            PG8_LDB(B0, 0, 0); PG8_SCHED; PG8_LDA(At, 0, 0); PG8_STAGE_A(1, 1, a1, vAc);
            PG8_WAIT_L(8); PG8_BAR; PG8_WAIT_L(0); PG8_MMA(0, 0, At, B0); PG8_BAR; PG8_SCHED;
            PG8_LDB(B1, 0, 1); PG8_STAGE(PG8_SB(0, 0), b2, voffB);
            PG8_BAR; PG8_WAIT_L(0); PG8_MMA(0, 1, At, B1); PG8_BAR;
            PG8_LDA(At, 0, 1); PG8_STAGE_AN(0, 0, a2);
            PG8_BAR; PG8_WAIT_L(0); PG8_MMA(1, 0, At, B0); PG8_BAR; PG8_SCHED;
            PG8_STAGE(PG8_SB(0, 1), b2 + hstep, voffB);
            PG8_WAIT_V(6); PG8_BAR; PG8_MMA(1, 1, At, B1); PG8_BAR;
            PG8_LDB(B0, 1, 0); PG8_SCHED; PG8_LDA(At, 1, 0); PG8_STAGE_AN(0, 1, a2);
            PG8_WAIT_L(8); PG8_BAR; PG8_WAIT_L(0); PG8_MMA(0, 0, At, B0); PG8_BAR; PG8_SCHED;
            PG8_LDB(B1, 1, 1); PG8_STAGE(PG8_SB(1, 0), b3, voffB);
            PG8_BAR; PG8_WAIT_L(0); PG8_MMA(0, 1, At, B1); PG8_BAR;
            PG8_LDA(At, 1, 1); PG8_STAGE_AN(1, 0, a3);
            PG8_BAR; PG8_WAIT_L(0); PG8_MMA(1, 0, At, B0); PG8_BAR; PG8_SCHED;
            PG8_STAGE(PG8_SB(1, 1), b3 + hstep, voffB);
            PG8_WAIT_V(6); PG8_BAR; PG8_MMA(1, 1, At, B1); PG8_BAR;
            }
        }
        if constexpr (ALIGN_EPI) { if (wr == 0) PG8_BAR; }
        if constexpr (!Epi::AFTER_DRAIN) { E(acc, cur, wr, wc, fr, fq); S.done(cur); }
        if (!has_next) break;
#pragma unroll
        for (int a = 0; a < 2; ++a)
#pragma unroll
            for (int b = 0; b < 2; ++b)
#pragma unroll
                for (int m = 0; m < 4; ++m)
#pragma unroll
                    for (int n = 0; n < 2; ++n) acc[a][b][m][n] = (f32x4){0.f, 0.f, 0.f, 0.f};
        cur = nxt; cA = nA; cB = nB; ++ui;
        if constexpr (Sched::GATHER) {
#pragma unroll
            for (int h = 0; h < 2; ++h)
#pragma unroll
                for (int i = 0; i < 2; ++i) vAc[h][i] = vAn[h][i]; }
        if constexpr (ALIGN_EPI) { if (wr == 1) PG8_BAR; }
    }
    PG8_WAIT_V(0);
    if constexpr (!ALIGN_EPI) { if (wr == 0) PG8_BAR; }
    PG8_BAR;
    if constexpr (Epi::AFTER_DRAIN) { E.fused(acc, cur, wr, wc, fr, fq, lds, wid, lane); S.done(cur); }
#undef PG8_SA
#undef PG8_SB
#undef PG8_STAGE
#undef PG8_STAGE_A
#undef PG8_STAGE_AN
#undef PG8_LDA
#undef PG8_LDB
#undef PG8_MMA
#undef PG8_WAIT_V
#undef PG8_WAIT_L
#undef PG8_BAR
#undef PG8_SCHED
}
}

constexpr int T = 8192, D = 2048, MIXW = 1536, MEMW = 512, NINA = 3584, DEPTH = 4, NE = 32, FF = 512, MEMT = 256;
constexpr int SLOTS = 24576;
constexpr float LN_EPS = 1e-5f;
constexpr float DN_ALPHA = 1.6817928305074292f;
constexpr float LOG2E = 1.4426950408889634f;
constexpr float QSCALE = 0.08838834764831845f * LOG2E;
constexpr int NWAVES = 8;

constexpr size_t MiB = 1u << 20;
constexpr size_t WS_CTL = 0, CTL_ZERO_BYTES = 1 * MiB;
constexpr size_t WS_WAIN = 2 * MiB, WS_WAOUT = 30 * MiB, WS_WBIN0 = 46 * MiB, WS_WKV = 54 * MiB, WS_WBIN1 = 66 * MiB, WS_WBOUT = 74 * MiB, WS_WMKV = 90 * MiB;
constexpr size_t WS_W13 = 106 * MiB, WS_W2 = 618 * MiB;
constexpr size_t WS_XB = 874 * MiB, WS_MEMB = 906 * MiB, WS_MEMKV = 907 * MiB, WS_Z = 910 * MiB, WS_KD = 966 * MiB, WS_VD = 990 * MiB, WS_CAT = 1014 * MiB;
constexpr size_t WS_XQ = 1206 * MiB, WS_ZQ = 1222 * MiB, WS_MEMQ = 1238 * MiB, WS_CATQ = 1246 * MiB;
constexpr size_t WS_Y = 1046 * MiB, WS_X1F = 1110 * MiB, WS_X1B = 1174 * MiB, WS_XF = 1206 * MiB, WS_XG = 1270 * MiB, WS_H = 1366 * MiB, WS_YB = 1390 * MiB, WS_OP = 1486 * MiB;
constexpr size_t WS_ROUTE = 1582 * MiB, WS_OP2 = 1583 * MiB, WS_ML = 1631 * MiB, WS_WR = 1634 * MiB, WS_TS = 1640 * MiB, WS_LIST = 1641 * MiB, WS_END = 1642 * MiB;
constexpr int CW_TMO = 0, CW_BAR = 4096, CW_CNT = 16384, CW_Q = 28672, CW_CONV = 29184, CW_DONE = 32768, CW_FIN = 40960;

constexpr int RING_OFF = 0, RING_BYTES = 131072;
constexpr int LDSCTL_OFF = 146432, MISC_OFF = LDSCTL_OFF + 320, TAB_OFF = LDSCTL_OFF + 512;
constexpr int LDS_BYTES = 147456;

#define GAS __attribute__((address_space(1)))
#define LAS __attribute__((address_space(3)))
typedef unsigned short bf16;
typedef unsigned v4u __attribute__((ext_vector_type(4)));
typedef unsigned v2u __attribute__((ext_vector_type(2)));
typedef float f32x4 __attribute__((ext_vector_type(4)));
typedef short bf16x8 __attribute__((ext_vector_type(8)));
typedef GAS unsigned gu32;
#define RLX_AGENT __ATOMIC_RELAXED, __HIP_MEMORY_SCOPE_AGENT
#define LDS_WAIT() asm volatile("s_waitcnt lgkmcnt(0)" ::: "memory")
#define VM_WAIT() asm volatile("s_waitcnt vmcnt(0)" ::: "memory")
__device__ __forceinline__ unsigned f2bf(float f) { unsigned u = __builtin_bit_cast(unsigned, f); return (u + 0x7fffu + ((u >> 16) & 1u)) >> 16; }
__device__ __forceinline__ unsigned pk2(float lo, float hi) { return f2bf(lo) | (f2bf(hi) << 16); }
__device__ __forceinline__ float bf2f(unsigned short b) { return __builtin_bit_cast(float, (unsigned)b << 16); }
__device__ __forceinline__ float bflo(unsigned w) { return __builtin_bit_cast(float, w << 16); }
__device__ __forceinline__ float bfhi(unsigned w) { return __builtin_bit_cast(float, w & 0xffff0000u); }
__device__ __forceinline__ float wave_sum(float v) {
#pragma unroll
    for (int o = 1; o < 64; o <<= 1) v += __shfl_xor(v, o);
    return v;
}

namespace pg8 {
struct DenseOrder {
    static constexpr bool GATHER = false, F8 = false; static constexpr int SCALE_B = 127;
    StaticOrder so; const char* A; const char* B; size_t astep, bstep;
    __device__ void init(const void* A_, const void* B_, int M, int N, int K, int G, int c) { so.init(M, N, G, c); A = (const char*)A_; B = (const char*)B_; astep = (size_t)256 * K * 2; bstep = astep; }
    __device__ __forceinline__ bool next(int i, Unit& u) const { u.e = 0; return so.next(i, u); }
    __device__ __forceinline__ const char* aptr(const Unit& u) const { return A + (size_t)u.pm * astep; }
    __device__ __forceinline__ const char* bptr(const Unit& u) const { return B + (size_t)u.pn * bstep; }
    __device__ __forceinline__ void a_ready(const Unit&) const {}
    __device__ __forceinline__ void done(const Unit&) const {}
};
struct DenseOrder8 {
    static constexpr bool GATHER = false, F8 = true; static constexpr int SCALE_B = 121;
    StaticOrder so; const char* A; const char* B; size_t astep, bstep;
    __device__ void init(const void* A_, const void* B_, int M, int N, int K, int G, int c) { so.init(M, N, G, c); A = (const char*)A_; B = (const char*)B_; astep = (size_t)256 * K * 2; bstep = astep; }
    __device__ __forceinline__ bool next(int i, Unit& u) const { u.e = 0; return so.next(i, u); }
    __device__ __forceinline__ const char* aptr(const Unit& u) const { return A + (size_t)u.pm * astep; }
    __device__ __forceinline__ const char* bptr(const Unit& u) const { return B + (size_t)u.pn * bstep; }
    __device__ __forceinline__ void a_ready(const Unit&) const {}
    __device__ __forceinline__ void done(const Unit&) const {}
};
struct DualOrder {
    static constexpr bool GATHER = false, F8 = false; static constexpr int SCALE_B = 127;
    StaticOrder so; int nwg2; const char* A; const char* B; const char* A2; const char* B2; size_t step;
    __device__ void init(const void* A_, const void* B_, int M, int N, int K, int G, int c, const void* A2_, const void* B2_, int nwg2_) { so.init(M, N, G, c); A = (const char*)A_; B = (const char*)B_; A2 = (const char*)A2_; B2 = (const char*)B2_; nwg2 = nwg2_; step = (size_t)256 * K * 2; }
    __device__ __forceinline__ bool next(int i, Unit& u) const { const int L = i * so.G + so.c; if (L < so.nwg) { u.e = 0; return so.next(i, u); } if (L - so.nwg >= nwg2) return false; u.e = 1; u.pm = 0; u.pn = L - so.nwg; return true; }
    __device__ __forceinline__ const char* aptr(const Unit& u) const { return u.e ? A2 : A + (size_t)u.pm * step; }
    __device__ __forceinline__ const char* bptr(const Unit& u) const { return (u.e ? B2 : B) + (size_t)u.pn * step; }
    __device__ __forceinline__ void a_ready(const Unit&) const {}
    __device__ __forceinline__ void done(const Unit&) const {}
};
struct DualOrder8 {
    static constexpr bool GATHER = false, F8 = true; static constexpr int SCALE_B = 121;
    StaticOrder so; int nwg2; const char* A; const char* B; const char* A2; const char* B2; size_t step;
    __device__ void init(const void* A_, const void* B_, int M, int N, int K, int G, int c, const void* A2_, const void* B2_, int nwg2_) { so.init(M, N, G, c); A = (const char*)A_; B = (const char*)B_; A2 = (const char*)A2_; B2 = (const char*)B2_; nwg2 = nwg2_; step = (size_t)256 * K * 2; }
    __device__ __forceinline__ bool next(int i, Unit& u) const { const int L = i * so.G + so.c; if (L < so.nwg) { u.e = 0; return so.next(i, u); } if (L - so.nwg >= nwg2) return false; u.e = 1; u.pm = 0; u.pn = L - so.nwg; return true; }
    __device__ __forceinline__ const char* aptr(const Unit& u) const { return u.e ? A2 : A + (size_t)u.pm * step; }
    __device__ __forceinline__ const char* bptr(const Unit& u) const { return (u.e ? B2 : B) + (size_t)u.pn * step; }
    __device__ __forceinline__ void a_ready(const Unit&) const {}
    __device__ __forceinline__ void done(const Unit&) const {}
};
struct MoeOrder {
    static constexpr bool GATHER = false, F8 = false; static constexpr int SCALE_B = 127;
    const PG8_LAS int* tstart; int ntn, G, c; const char* A; const char* W; size_t astep, wexp, wtile;
    __device__ __forceinline__ bool next(int i, Unit& u) const {
        const int L = i * G + c, total = tstart[32] * ntn; if (L >= total) return false;
        int wgid; { const int q = total / NXCD, r = total % NXCD, xcd = L % NXCD, off = L / NXCD; wgid = (xcd < r ? xcd * (q + 1) : r * (q + 1) + (xcd - r) * q) + off; }
        u.pm = wgid / ntn; u.pn = wgid - u.pm * ntn; int e = 0;
#pragma unroll
        for (int k = 1; k <= 31; ++k) e += (tstart[k] <= u.pm) ? 1 : 0;
        u.e = e; return true;
    }
    __device__ __forceinline__ const char* aptr(const Unit& u) const { return A + (size_t)u.pm * astep; }
    __device__ __forceinline__ const char* bptr(const Unit& u) const { return W + (size_t)u.e * wexp + (size_t)u.pn * wtile; }
    __device__ __forceinline__ void a_ready(const Unit&) const {}
    __device__ __forceinline__ void done(const Unit&) const {}
};

struct MoeOrder8 {
    static constexpr bool GATHER = false, F8 = true; static constexpr int SCALE_B = 121;
    const PG8_LAS int* tstart; int ntn, G, c; const char* A; const char* W; size_t astep, wexp, wtile;
    __device__ __forceinline__ bool next(int i, Unit& u) const {
        const int L = i * G + c, total = tstart[32] * ntn; if (L >= total) return false;
        int wgid; { const int q = total / NXCD, r = total % NXCD, xcd = L % NXCD, off = L / NXCD; wgid = (xcd < r ? xcd * (q + 1) : r * (q + 1) + (xcd - r) * q) + off; }
        u.pm = wgid / ntn; u.pn = wgid - u.pm * ntn; int e = 0;
#pragma unroll
        for (int k = 1; k <= 31; ++k) e += (tstart[k] <= u.pm) ? 1 : 0;
        u.e = e; return true;
    }
    __device__ __forceinline__ const char* aptr(const Unit& u) const { return A + (size_t)u.pm * astep; }
    __device__ __forceinline__ const char* bptr(const Unit& u) const { return W + (size_t)u.e * wexp + (size_t)u.pn * wtile; }
    __device__ __forceinline__ void a_ready(const Unit&) const {}
    __device__ __forceinline__ void done(const Unit&) const {}
};

struct MoeGatherOrder {
    static constexpr bool GATHER = true, F8 = true; static constexpr int SCALE_B = 121;
    const PG8_LAS int* tstart; const PG8_LAS int* cntl; const int* list; int ntn, G, c; const char* A; const char* W; size_t wexp, wtile; unsigned rowbytes;
    __device__ __forceinline__ bool next(int i, Unit& u) const {
        const int L = i * G + c, total = tstart[32] * ntn; if (L >= total) return false;
        int wgid; { const int q = total / NXCD, r = total % NXCD, xcd = L % NXCD, off = L / NXCD; wgid = (xcd < r ? xcd * (q + 1) : r * (q + 1) + (xcd - r) * q) + off; }
        u.pm = wgid / ntn; u.pn = wgid - u.pm * ntn; int e = 0;
#pragma unroll
        for (int k = 1; k <= 31; ++k) e += (tstart[k] <= u.pm) ? 1 : 0;
        u.e = e; return true;
    }
    __device__ __forceinline__ unsigned rowoff(const Unit& u, int r) const { const int rank = (u.pm - tstart[u.e]) * 256 + r; const int tok = list[u.e * 8192 + (rank < cntl[u.e] ? rank : 0)]; return (unsigned)tok * rowbytes; }
    __device__ __forceinline__ const char* aptr(const Unit&) const { return A; }
    __device__ __forceinline__ const char* bptr(const Unit& u) const { return W + (size_t)u.e * wexp + (size_t)u.pn * wtile; }
    __device__ __forceinline__ void a_ready(const Unit&) const {}
    __device__ __forceinline__ void done(const Unit&) const {}
};

typedef unsigned u32x2 __attribute__((ext_vector_type(2)));
struct EpiBf16X {
    static constexpr bool PERM = true, AFTER_DRAIN = false;
    int mode; bf16_t* p0; bf16_t* p1; bf16_t* p2; bf16_t* p3;
    const PG8_LAS int* tstart; const PG8_LAS int* cntl;
    __device__ __forceinline__ void operator()(const f32x4 (&acc)[2][2][4][2], const Unit& u, int wr, int wc, int fr, int fq) const {
#ifndef ATT_BF16
        if (mode == 1 && !u.e) {
            int tok0 = u.pm * BM + wr * 64 + fr, cc0 = wc * 32 + 8 * fq; asm volatile("" : "+v"(tok0), "+v"(cc0));
            if (u.pn >= 14) { const int colv = (u.pn - 14) * BM + cc0; unsigned char* vb = (unsigned char*)p2 + ((size_t)((colv >> 8) * 128 + (tok0 >> 6)) * 256 + (colv & 255)) * 64 + (tok0 & 63);
#pragma unroll
                for (int ai = 0; ai < 2; ++ai)
#pragma unroll
                    for (int m = 0; m < 4; ++m)
#pragma unroll
                        for (int bj = 0; bj < 2; ++bj) { const f32x4 v0 = acc[ai][bj][m][0], v1 = acc[ai][bj][m][1]; unsigned a_ = 0u, b_ = 0u;
                            a_ = __builtin_amdgcn_cvt_pk_fp8_f32(v0[0], v0[1], a_, false); a_ = __builtin_amdgcn_cvt_pk_fp8_f32(v0[2], v0[3], a_, true); b_ = __builtin_amdgcn_cvt_pk_fp8_f32(v1[0], v1[1], b_, false); b_ = __builtin_amdgcn_cvt_pk_fp8_f32(v1[2], v1[3], b_, true);
                            unsigned char* vp = vb + (size_t)(ai * 2) * 16384 + m * 16 + (size_t)bj * HALF * 64;
                            vp[0] = (unsigned char)a_; vp[64] = (unsigned char)(a_ >> 8); vp[128] = (unsigned char)(a_ >> 16); vp[192] = (unsigned char)(a_ >> 24);
                            vp[256] = (unsigned char)b_; vp[320] = (unsigned char)(b_ >> 8); vp[384] = (unsigned char)(b_ >> 16); vp[448] = (unsigned char)(b_ >> 24); }
                return; }
            if (u.pn >= 8) { unsigned char* kb = (unsigned char*)p1 + (size_t)tok0 * 1536 + (u.pn - 8) * BM + cc0;
#pragma unroll
                for (int ai = 0; ai < 2; ++ai)
#pragma unroll
                    for (int m = 0; m < 4; ++m)
#pragma unroll
                        for (int bj = 0; bj < 2; ++bj) { const f32x4 v0 = acc[ai][bj][m][0], v1 = acc[ai][bj][m][1]; unsigned a_ = 0u, b_ = 0u;
                            a_ = __builtin_amdgcn_cvt_pk_fp8_f32(v0[0], v0[1], a_, false); a_ = __builtin_amdgcn_cvt_pk_fp8_f32(v0[2], v0[3], a_, true); b_ = __builtin_amdgcn_cvt_pk_fp8_f32(v1[0], v1[1], b_, false); b_ = __builtin_amdgcn_cvt_pk_fp8_f32(v1[2], v1[3], b_, true);
                            u32x2 kk; kk.x = a_; kk.y = b_; *(u32x2*)(kb + (size_t)(ai * HALF + m * 16) * 1536 + bj * HALF) = kk; }
                return; }
            { unsigned char* qb = (unsigned char*)p0 + (WS_ZQ - WS_Z) + (size_t)tok0 * 2048 + u.pn * BM + cc0; bf16_t* zb = p0 + (size_t)tok0 * 2048 + u.pn * BM + cc0;
#pragma unroll
                for (int ai = 0; ai < 2; ++ai)
#pragma unroll
                    for (int m = 0; m < 4; ++m)
#pragma unroll
                        for (int bj = 0; bj < 2; ++bj) { const f32x4 v0 = acc[ai][bj][m][0] * QSCALE, v1 = acc[ai][bj][m][1] * QSCALE; unsigned a_ = 0u, b_ = 0u;
                            a_ = __builtin_amdgcn_cvt_pk_fp8_f32(v0[0], v0[1], a_, false); a_ = __builtin_amdgcn_cvt_pk_fp8_f32(v0[2], v0[3], a_, true); b_ = __builtin_amdgcn_cvt_pk_fp8_f32(v1[0], v1[1], b_, false); b_ = __builtin_amdgcn_cvt_pk_fp8_f32(v1[2], v1[3], b_, true);
                            const size_t o_ = (size_t)(ai * HALF + m * 16) * 2048 + bj * HALF;
                            u32x2 qq; qq.x = a_; qq.y = b_; *(u32x2*)(qb + o_) = qq;
                            if (u.pn >= 6) { u32x4 w; w.x = cvt_pk_bf16(v0[0], v0[1]); w.y = cvt_pk_bf16(v0[2], v0[3]); w.z = cvt_pk_bf16(v1[0], v1[1]); w.w = cvt_pk_bf16(v1[2], v1[3]); *(u32x4*)(zb + o_) = w; } }
                return; }
        }
#endif
        if (mode == 3) {
            int r0_ = wr * 64 + fr, c0_ = u.pn * BM + wc * 32 + 8 * fq; asm volatile("" : "+v"(r0_), "+v"(c0_));
            const int rlim = cntl[u.e] - (u.pm - tstart[u.e]) * BM;
            unsigned char* yb_ = (unsigned char*)p0 + (size_t)(u.pm * BM + r0_) * 2048 + c0_;
#pragma unroll
            for (int ai = 0; ai < 2; ++ai)
#pragma unroll
                for (int m = 0; m < 4; ++m) { if (r0_ + ai * HALF + m * 16 >= rlim) continue;
#pragma unroll
                    for (int bj = 0; bj < 2; ++bj) { const f32x4 v0 = acc[ai][bj][m][0] * 16.f, v1 = acc[ai][bj][m][1] * 16.f; unsigned a_ = 0u, b_ = 0u;
                        a_ = __builtin_amdgcn_cvt_pk_fp8_f32(v0[0], v0[1], a_, false); a_ = __builtin_amdgcn_cvt_pk_fp8_f32(v0[2], v0[3], a_, true); b_ = __builtin_amdgcn_cvt_pk_fp8_f32(v1[0], v1[1], b_, false); b_ = __builtin_amdgcn_cvt_pk_fp8_f32(v1[2], v1[3], b_, true);
                        u32x2 q_; q_.x = a_; q_.y = b_; *(u32x2*)(yb_ + (size_t)(ai * HALF + m * 16) * 2048 + bj * HALF) = q_; } }
            return; }
        bf16_t* base; int ldc, colt; bool act = false; float sc = 1.f;
        if (u.e && mode < 2) { base = p3 + (size_t)(u.pn >> 2) * (256 * 1024); ldc = 1024; colt = (u.pn & 3) * BM; }
        else if (mode == 0) { base = p0; ldc = 3584; colt = u.pn * BM; act = u.pn < 12; if (u.pn >= 12) sc = QSCALE; }
        else if (mode == 1) { if (u.pn < 8) { base = p0; ldc = 2048; colt = u.pn * BM; sc = QSCALE; }
                              else if (u.pn < 14) { base = p1; ldc = 1536; colt = (u.pn - 8) * BM; } else { base = p2; ldc = 1536; colt = (u.pn - 14) * BM; } }
        else { base = p0; ldc = 2048; colt = u.pn * BM; }
        const int row0 = u.pm * BM + wr * 64 + fr, col0 = colt + wc * 32 + 8 * fq;
        const int rlim = (mode == 3) ? cntl[u.e] - (u.pm - tstart[u.e]) * BM : BM;
#pragma unroll
        for (int ai = 0; ai < 2; ++ai)
#pragma unroll
            for (int m = 0; m < 4; ++m) { bf16_t* rowp = base + (size_t)(row0 + ai * HALF + m * 16) * ldc + col0;
                if (wr * 64 + fr + ai * HALF + m * 16 >= rlim) continue;
#pragma unroll
                for (int bj = 0; bj < 2; ++bj) { f32x4 v0 = acc[ai][bj][m][0], v1 = acc[ai][bj][m][1];
                    if (act) { f32x2 a = gelu_pk((f32x2){v0[0], v0[1]}), b = gelu_pk((f32x2){v0[2], v0[3]}), c = gelu_pk((f32x2){v1[0], v1[1]}), d = gelu_pk((f32x2){v1[2], v1[3]});
                        v0 = (f32x4){a.x, a.y, b.x, b.y}; v1 = (f32x4){c.x, c.y, d.x, d.y}; }
                    v0 = v0 * sc; v1 = v1 * sc; u32x4 w; w.x = cvt_pk_bf16(v0[0], v0[1]); w.y = cvt_pk_bf16(v0[2], v0[3]); w.z = cvt_pk_bf16(v1[0], v1[1]); w.w = cvt_pk_bf16(v1[2], v1[3]);
                    *(u32x4*)(rowp + bj * HALF) = w; } }
    }
};
struct EpiResBf16 {
    static constexpr bool PERM = true, AFTER_DRAIN = false;
    const bf16_t* xres; bf16_t* y; float alpha;
    __device__ __forceinline__ void operator()(const f32x4 (&acc)[2][2][4][2], const Unit& u, int wr, int wc, int fr, int fq) const {
        const int row0 = u.pm * BM + wr * 64 + fr, col0 = u.pn * BM + wc * 32 + 8 * fq;
#pragma unroll
        for (int ai = 0; ai < 2; ++ai)
#pragma unroll
            for (int m = 0; m < 4; ++m) { const size_t off = (size_t)(row0 + ai * HALF + m * 16) * 2048 + col0;
#pragma unroll
                for (int bj = 0; bj < 2; ++bj) { const u32x4 xr = *(const u32x4*)(xres + off + bj * HALF); const f32x4 v0 = acc[ai][bj][m][0], v1 = acc[ai][bj][m][1]; u32x4 w;
                    w.x = cvt_pk_bf16(__builtin_bit_cast(float, xr.x << 16) * alpha + v0[0], __builtin_bit_cast(float, xr.x & 0xffff0000u) * alpha + v0[1]);
                    w.y = cvt_pk_bf16(__builtin_bit_cast(float, xr.y << 16) * alpha + v0[2], __builtin_bit_cast(float, xr.y & 0xffff0000u) * alpha + v0[3]);
                    w.z = cvt_pk_bf16(__builtin_bit_cast(float, xr.z << 16) * alpha + v1[0], __builtin_bit_cast(float, xr.z & 0xffff0000u) * alpha + v1[1]);
                    w.w = cvt_pk_bf16(__builtin_bit_cast(float, xr.w << 16) * alpha + v1[2], __builtin_bit_cast(float, xr.w & 0xffff0000u) * alpha + v1[3]);
                    *(u32x4*)(y + off + bj * HALF) = w; } }
    }
};
struct EpiMoe1 {
    static constexpr bool PERM = true, AFTER_DRAIN = false;
    bf16_t* h; const PG8_LAS int* tstart; const PG8_LAS int* cntl;
    __device__ __forceinline__ void operator()(const f32x4 (&acc)[2][2][4][2], const Unit& u, int wr, int wc, int fr, int fq) const {
        const int row0 = u.pm * BM + wr * 64 + fr, col0 = u.pn * HALF + wc * 32 + 8 * fq;
        const int rlim = cntl[u.e] - (u.pm - tstart[u.e]) * BM;
#pragma unroll
        for (int ai = 0; ai < 2; ++ai)
#pragma unroll
            for (int m = 0; m < 4; ++m) { unsigned char* rowp = (unsigned char*)h + (size_t)(row0 + ai * HALF + m * 16) * 512 + col0; float o[8];
                if (wr * 64 + fr + ai * HALF + m * 16 >= rlim) continue;
#pragma unroll
                for (int n = 0; n < 2; ++n)
#pragma unroll
                    for (int x = 0; x < 4; ++x) { const float a = acc[ai][0][m][n][x], b = acc[ai][1][m][n][x];
                        o[n * 4 + x] = a * __builtin_amdgcn_rcpf(1.0f + __builtin_amdgcn_exp2f(-a * LOG2E)) * b; }
                unsigned lo = 0u, hi = 0u; lo = __builtin_amdgcn_cvt_pk_fp8_f32(o[0], o[1], lo, false); lo = __builtin_amdgcn_cvt_pk_fp8_f32(o[2], o[3], lo, true);
                hi = __builtin_amdgcn_cvt_pk_fp8_f32(o[4], o[5], hi, false); hi = __builtin_amdgcn_cvt_pk_fp8_f32(o[6], o[7], hi, true);
                typedef unsigned u32x2e __attribute__((ext_vector_type(2))); u32x2e w; w.x = lo; w.y = hi; *(u32x2e*)rowp = w; }
    }
};
}

namespace att {
using bf16x8 = __attribute__((ext_vector_type(8))) short;
using s16x4  = __attribute__((ext_vector_type(4))) short;
using f32x16 = __attribute__((ext_vector_type(16))) float;
using u32x4  = __attribute__((ext_vector_type(4))) unsigned;
constexpr int DH = 128, QBLK = 32, KVBLK = 64;
constexpr float THR2 = 8.f * 1.4426950408889634f;
constexpr size_t SHM_V = KVBLK * DH * 2, SHM_K = KVBLK * DH * 2, SHM_ATTN = 2 * SHM_V + 2 * SHM_K + NWAVES * 64 * 4;
constexpr int TAB_N = 160;
#define KSWZ(row, colB) ((row) * 256 + ((colB) ^ (((row) & 7) << 4)))
#define SBAR() __builtin_amdgcn_sched_barrier(0)
__device__ __forceinline__ int crow(int r, int hi) { return (r & 3) + 8 * (r >> 2) + 4 * hi; }
__device__ __forceinline__ unsigned cvtpk(float lo, float hi) { unsigned r; asm volatile("v_cvt_pk_bf16_f32 %0, %1, %2" : "=v"(r) : "v"(lo), "v"(hi)); return r; }

__device__ __forceinline__ void partialSM(f32x16& p0, f32x16& p1, float& m_reg, float& mn, float& alpha) {
  float pmax = p0[0];
#pragma unroll
  for (int r = 1; r < 16; ++r) pmax = fmaxf(pmax, p0[r]);
#pragma unroll
  for (int r = 0; r < 16; ++r) pmax = fmaxf(pmax, p1[r]);
  { auto rr = __builtin_amdgcn_permlane32_swap(__float_as_uint(pmax), __float_as_uint(pmax), false, false);
    pmax = fmaxf(__uint_as_float(rr[0]), __uint_as_float(rr[1])); }
  if (__builtin_expect(__all(pmax - m_reg <= THR2), 1)) { mn = m_reg; alpha = 1.f; }
  else { mn = fmaxf(m_reg, pmax); alpha = __builtin_amdgcn_exp2f(m_reg - mn); m_reg = mn; }
#pragma unroll
  for (int r = 0; r < 16; ++r) p0[r] = p0[r] - mn;
#pragma unroll
  for (int r = 0; r < 16; ++r) p1[r] = p1[r] - mn;
#pragma unroll
  for (int r = 0; r < 16; ++r) p0[r] = __builtin_amdgcn_exp2f(p0[r]);
}
__device__ __forceinline__ void finishSM(f32x16& p0, f32x16& p1, float alpha, float& l_reg, bf16x8& pa0, bf16x8& pa1, bf16x8& pa2, bf16x8& pa3) {
#pragma unroll
  for (int r = 0; r < 16; ++r) p1[r] = __builtin_amdgcn_exp2f(p1[r]);
  float ps = 0;
#pragma unroll
  for (int r = 0; r < 16; ++r) ps += p0[r];
#pragma unroll
  for (int r = 0; r < 16; ++r) ps += p1[r];
  { auto rr = __builtin_amdgcn_permlane32_swap(__float_as_uint(ps), __float_as_uint(ps), false, false);
    ps = __uint_as_float(rr[0]) + __uint_as_float(rr[1]); }
  l_reg = l_reg * alpha + ps;
#define PK4(P, BASE, OUT) do { unsigned a0 = cvtpk(P[BASE + 0], P[BASE + 1]), a1 = cvtpk(P[BASE + 2], P[BASE + 3]);   \
    unsigned b0 = cvtpk(P[BASE + 4], P[BASE + 5]), b1 = cvtpk(P[BASE + 6], P[BASE + 7]);                              \
    auto r0 = __builtin_amdgcn_permlane32_swap(a0, b0, false, false); auto r1 = __builtin_amdgcn_permlane32_swap(a1, b1, false, false); \
    u32x4 w = {r0[0], r1[0], r0[1], r1[1]}; OUT = *reinterpret_cast<bf16x8*>(&w); } while (0)
  PK4(p0, 0, pa0); PK4(p0, 8, pa1); PK4(p1, 0, pa2); PK4(p1, 8, pa3);
#undef PK4
}
__device__ __forceinline__ void qkt(f32x16& p0, f32x16& p1, const char* Ks, const bf16x8* qr, int r32, int hi) {
  p0 = f32x16{}; p1 = f32x16{};
#pragma unroll
  for (int d0 = 0; d0 < 8; ++d0) { const int cb = (d0 * 16 + hi * 8) * 2;
    bf16x8 b0 = *reinterpret_cast<const bf16x8*>(Ks + KSWZ(r32, cb));
    bf16x8 b1 = *reinterpret_cast<const bf16x8*>(Ks + KSWZ(32 + r32, cb));
    p0 = __builtin_amdgcn_mfma_f32_32x32x16_bf16(b0, qr[d0], p0, 0, 0, 0);
    p1 = __builtin_amdgcn_mfma_f32_32x32x16_bf16(b1, qr[d0], p1, 0, 0, 0); }
}
__device__ __forceinline__ int v_st(int k, int c) { const int kk = (k & ~0xC) | ((k & 4) << 1) | ((k & 8) >> 1); return ((kk >> 3) * 4 + (c >> 5)) * 512 + ((kk & 7) * 32 + (c & 31)) * 2; }
__device__ __forceinline__ int v_rd_base(int lane) { return ((lane & 3) << 3) | (((lane >> 2) & 3) << 6) | (((lane >> 4) & 1) << 5) | (((lane >> 5) & 1) << 8); }
constexpr int v_rd_off(int d0, int ks, int half) { return d0 * 512 + ks * 4096 + half * 2048; }
template <int OFF> __device__ __forceinline__ s16x4 tr_read(int vb) {
  s16x4 r; asm volatile("ds_read_b64_tr_b16 %0, %1 offset:%2" : "=&v"(r) : "v"(vb), "i"(OFF) : "memory"); return r;
}
template <int D0> __device__ __forceinline__ void pv_one(f32x16& od, int vb, bf16x8 pa0, bf16x8 pa1, bf16x8 pa2, bf16x8 pa3) {
  const s16x4 l0 = tr_read<v_rd_off(D0, 0, 0)>(vb), h0 = tr_read<v_rd_off(D0, 0, 1)>(vb), l1 = tr_read<v_rd_off(D0, 1, 0)>(vb), h1 = tr_read<v_rd_off(D0, 1, 1)>(vb);
  const s16x4 l2 = tr_read<v_rd_off(D0, 2, 0)>(vb), h2 = tr_read<v_rd_off(D0, 2, 1)>(vb), l3 = tr_read<v_rd_off(D0, 3, 0)>(vb), h3 = tr_read<v_rd_off(D0, 3, 1)>(vb);
  asm volatile("s_waitcnt lgkmcnt(0)" ::: "memory"); SBAR();
#define PK(L, H) (bf16x8){L[0], L[1], L[2], L[3], H[0], H[1], H[2], H[3]}
  od = __builtin_amdgcn_mfma_f32_32x32x16_bf16(pa0, PK(l0, h0), od, 0, 0, 0);
  od = __builtin_amdgcn_mfma_f32_32x32x16_bf16(pa1, PK(l1, h1), od, 0, 0, 0);
  od = __builtin_amdgcn_mfma_f32_32x32x16_bf16(pa2, PK(l2, h2), od, 0, 0, 0);
  od = __builtin_amdgcn_mfma_f32_32x32x16_bf16(pa3, PK(l3, h3), od, 0, 0, 0);
#undef PK
}
__device__ __forceinline__ void pv_d0(f32x16* o, int vb, bf16x8 pa0, bf16x8 pa1, bf16x8 pa2, bf16x8 pa3) {
  pv_one<0>(o[0], vb, pa0, pa1, pa2, pa3); pv_one<1>(o[1], vb, pa0, pa1, pa2, pa3); pv_one<2>(o[2], vb, pa0, pa1, pa2, pa3); pv_one<3>(o[3], vb, pa0, pa1, pa2, pa3);
}
template <int MODE> __device__ __forceinline__ void post_scores(f32x16& p0, f32x16& p1, int t, int qrow0, int r32, int hi, const float* tab, float cfar) {
  if constexpr (MODE == 1) {
    const int cw = qrow0 >> 6;
    if (t > cw) {
#pragma unroll
      for (int r = 0; r < 16; ++r) { p0[r] = -INFINITY; p1[r] = -INFINITY; }
    } else if (qrow0 - (64 * t + 63) >= 91) {
#pragma unroll
      for (int r = 0; r < 16; ++r) { p0[r] += cfar; p1[r] += cfar; }
    } else {
      const int base = qrow0 + r32 - 64 * t + 63;
#pragma unroll
      for (int r = 0; r < 16; ++r) { const int i0 = base - crow(r, hi); const int i1 = i0 - 32;
        p0[r] += tab[i0 < TAB_N - 1 ? i0 : TAB_N - 1]; p1[r] += tab[i1 < TAB_N - 1 ? i1 : TAB_N - 1]; }
    }
  }
}

template <int MODE>
__device__ __forceinline__ void attn_body(const bf16* __restrict__ Qb, int ldq, const bf16* __restrict__ Kh, const bf16* __restrict__ Vh, int ldk,
                                          bf16* Ob, float* Of, int ldo, int NT, int q0abs, const float* tab, float cfar, char* lds) {
  int tid_ = threadIdx.x; asm volatile("" : "+v"(tid_));
  const int tid = tid_, wid = tid >> 6, lane = tid & 63, r32 = lane & 31, hi = lane >> 5;
  char* V_lds = lds; char* K_lds = lds + 2 * SHM_V;
  float* ws = (float*)(lds + 2 * SHM_V + 2 * SHM_K) + wid * 64; float* li_l = ws; float* al_l = ws + 32;
  float m_reg = -1e30f, l_reg = 0; f32x16 o[4] = {}; bf16x8 qr[8];
  const int qrow0 = q0abs + wid * QBLK;
  const bf16* Qw = Qb + (long)(wid * QBLK + r32) * ldq + hi * 8;
#pragma unroll
  for (int d0 = 0; d0 < 8; ++d0) qr[d0] = *reinterpret_cast<const bf16x8*>(Qw + d0 * 16);
  const int sr = tid >> 4, sc = (tid & 15) * 8, vst0 = v_st(sr, sc), vst1 = v_st(32 + sr, sc);
  const int vb0 = (int)(uintptr_t)V_lds + v_rd_base(lane);
  struct { bf16x8 vs0, vs1, ks0, ks1; } sr_[2];
#define SLOAD(i, k0) do { sr_[i].vs0 = *reinterpret_cast<const bf16x8*>(&Vh[(long)((k0) + sr) * ldk + sc]); sr_[i].vs1 = *reinterpret_cast<const bf16x8*>(&Vh[(long)((k0) + 32 + sr) * ldk + sc]); \
    sr_[i].ks0 = *reinterpret_cast<const bf16x8*>(&Kh[(long)((k0) + sr) * ldk + sc]); sr_[i].ks1 = *reinterpret_cast<const bf16x8*>(&Kh[(long)((k0) + 32 + sr) * ldk + sc]); } while (0)
#define SWRITE(b, i) do { *(bf16x8*)(V_lds + (b) * SHM_V + vst0) = sr_[i].vs0;          \
    *(bf16x8*)(V_lds + (b) * SHM_V + vst1) = sr_[i].vs1; const int kc = sc * 2;               \
    *(bf16x8*)(K_lds + (b) * SHM_K + KSWZ(sr, kc)) = sr_[i].ks0;                       \
    *(bf16x8*)(K_lds + (b) * SHM_K + KSWZ(32 + sr, kc)) = sr_[i].ks1; } while (0)
#define SWAIT() asm volatile("s_waitcnt vmcnt(4)" ::: "memory")
#define RESC(a) do { if (__any((a) < 1.f)) { if (hi == 0) al_l[r32] = (a); asm volatile("s_waitcnt lgkmcnt(0)" ::: "memory"); \
    _Pragma("unroll") for (int d = 0; d < 4; ++d) _Pragma("unroll") for (int r = 0; r < 16; ++r) o[d][r] *= al_l[crow(r, hi)]; } } while (0)
  f32x16 pA0, pA1, pB0, pB1; float mnA, mnB, alA, alB; bf16x8 pa0, pa1, pa2, pa3;
  constexpr int SE = 0, SO = 1;
  SLOAD(SE, 0); asm volatile("s_waitcnt vmcnt(0)" ::: "memory"); SWRITE(0, SE); __syncthreads();
  qkt(pA0, pA1, K_lds, qr, r32, hi); post_scores<MODE>(pA0, pA1, 0, qrow0, r32, hi, tab, cfar); partialSM(pA0, pA1, m_reg, mnA, alA);
  SLOAD(SO, KVBLK); if (2 < NT) SLOAD(SE, 2 * KVBLK);
  SWAIT(); SWRITE(1, SO); __syncthreads();
  for (int j = 1; j + 1 < NT; j += 2) {
    SBAR(); qkt(pB0, pB1, K_lds + SHM_K, qr, r32, hi); post_scores<MODE>(pB0, pB1, j, qrow0, r32, hi, tab, cfar);
    finishSM(pA0, pA1, alA, l_reg, pa0, pa1, pa2, pa3); SBAR();
    SLOAD(SO, (j + 2) * KVBLK); SBAR();
    pv_d0(o, vb0, pa0, pa1, pa2, pa3); partialSM(pB0, pB1, m_reg, mnB, alB);
    __syncthreads(); SWAIT(); SWRITE(0, SE);
    RESC(alB); __syncthreads();
    SBAR(); qkt(pA0, pA1, K_lds, qr, r32, hi); post_scores<MODE>(pA0, pA1, j + 1, qrow0, r32, hi, tab, cfar);
    finishSM(pB0, pB1, alB, l_reg, pa0, pa1, pa2, pa3); SBAR();
    if (j + 3 < NT) SLOAD(SE, (j + 3) * KVBLK); SBAR();
    pv_d0(o, vb0 + (int)SHM_V, pa0, pa1, pa2, pa3); partialSM(pA0, pA1, m_reg, mnA, alA);
    __syncthreads(); SWAIT(); SWRITE(1, SO);
    RESC(alA); __syncthreads();
  }
  SBAR(); qkt(pB0, pB1, K_lds + SHM_K, qr, r32, hi); post_scores<MODE>(pB0, pB1, NT - 1, qrow0, r32, hi, tab, cfar);
  finishSM(pA0, pA1, alA, l_reg, pa0, pa1, pa2, pa3); SBAR();
  pv_d0(o, vb0, pa0, pa1, pa2, pa3); partialSM(pB0, pB1, m_reg, mnB, alB);
  __syncthreads(); RESC(alB);
  finishSM(pB0, pB1, alB, l_reg, pa0, pa1, pa2, pa3); SBAR();
  pv_d0(o, vb0 + (int)SHM_V, pa0, pa1, pa2, pa3);
  if (hi == 0) li_l[r32] = l_reg; asm volatile("s_waitcnt lgkmcnt(0)" ::: "memory");
  float rli[16];
#pragma unroll
  for (int r = 0; r < 16; ++r) rli[r] = __builtin_amdgcn_rcpf(li_l[crow(r, hi)]);
  if constexpr (MODE == 0) {
    bf16* Ow = Ob + (long)(wid * QBLK) * ldo;
#pragma unroll
    for (int r = 0; r < 16; ++r) { const int orow = crow(r, hi);
#pragma unroll
      for (int d0 = 0; d0 < 4; ++d0) Ow[(long)orow * ldo + d0 * 32 + r32] = (bf16)f2bf(o[d0][r] * rli[r]); }
  } else {
    float* Ow = Of + (long)(wid * QBLK) * ldo;
#pragma unroll
    for (int r = 0; r < 16; ++r) { const int orow = crow(r, hi);
#pragma unroll
      for (int d0 = 0; d0 < 4; ++d0) Ow[(long)orow * ldo + d0 * 32 + r32] = o[d0][r] * rli[r]; }
  }
  __syncthreads();
#undef SLOAD
#undef SWRITE
#undef SWAIT
#undef RESC
}
}

#define XB_TMO      128
#define XB_XCNT(j)  (256  + 64 * (j))
#define XB_XSUB(j)  (1280 + 64 * (j))
#define XB_XGEN(j)  (2304 + 64 * (j))
#define XB_TOP      3328
#define XB_TOPGEN   3392
#define XCD_BAR_WORDS 3456
#define XB_SPIN_CAP (1u << 18)

__device__ __forceinline__ unsigned xb_ld(unsigned* p)              { return __hip_atomic_load(p, __ATOMIC_RELAXED, __HIP_MEMORY_SCOPE_AGENT); }
__device__ __forceinline__ unsigned xb_add(unsigned* p, unsigned v) { return __hip_atomic_fetch_add(p, v, __ATOMIC_RELAXED, __HIP_MEMORY_SCOPE_AGENT); }
__device__ __forceinline__ unsigned xb_xcc_id() { return (unsigned)__builtin_amdgcn_s_getreg((3 << 11) | 20) & 0xFu; }
#define XB_SPIN(cond, bar) do { unsigned _sp = 0; while (cond) { __builtin_amdgcn_s_sleep(1); \
    if ((++_sp & 255u) == 0u) { if (xb_ld(&(bar)[XB_TMO])) break; if (_sp > XB_SPIN_CAP) { atomicAdd(&(bar)[XB_TMO], 1u); break; } } } } while (0)

struct XcdBarrier {
    unsigned* bar; unsigned x;
    volatile LAS unsigned* st;
};

__device__ __forceinline__ XcdBarrier xcd_barrier_post(unsigned* bar, volatile LAS unsigned* st) {
    XcdBarrier b; b.bar = bar; b.x = xb_xcc_id(); b.st = st;
    if (threadIdx.x == 0) (void)xb_add(&bar[XB_XCNT(b.x)], 1u);
    return b;
}
__device__ __forceinline__ void xcd_barrier_complete(unsigned* bar, unsigned x, unsigned& nloc, unsigned& nx) {
    const unsigned G = gridDim.x * gridDim.y * gridDim.z;
    unsigned sum, cnt, mine, sp = 0u;
    for (;;) {
        sum = 0u; cnt = 0u; mine = 0u;
#pragma unroll
        for (unsigned j = 0; j < 16; ++j) { const unsigned c = xb_ld(&bar[XB_XCNT(j)]); sum += c; cnt += (c > 0u) ? 1u : 0u; mine = (j == x) ? c : mine; }
        if (sum == G) break;
        __builtin_amdgcn_s_sleep(1);
        if ((++sp & 255u) == 0u) { if (xb_ld(&bar[XB_TMO])) break; if (sp > XB_SPIN_CAP) { atomicAdd(&bar[XB_TMO], 1u); break; } }
    }
    nloc = mine > 0u ? mine : 1u; nx = cnt > 0u ? cnt : 1u;
}

__device__ __forceinline__ void xcd_barrier(const XcdBarrier& b) {
    asm volatile("s_waitcnt vmcnt(0)" ::: "memory");
    __syncthreads();
    if (threadIdx.x == 0) {
        unsigned* bar = b.bar;
        __builtin_amdgcn_s_waitcnt(0);
        unsigned nloc = b.st[0], nx = b.st[1];
        if (nloc == 0u) { xcd_barrier_complete(bar, b.x, nloc, nx); b.st[0] = nloc; b.st[1] = nx; }
        const unsigned old = xb_add(&bar[XB_XSUB(b.x)], 1u);
        const unsigned gen = old / nloc;
        if (old + 1u == (gen + 1u) * nloc) {
            __builtin_amdgcn_fence(__ATOMIC_RELEASE, "agent");
            asm volatile("s_waitcnt vmcnt(0)" ::: "memory");
            const unsigned og = xb_add(&bar[XB_TOP], 1u);
            const unsigned tg = og / nx;
            if (og + 1u == (tg + 1u) * nx) xb_add(&bar[XB_TOPGEN], 1u);
            else XB_SPIN(xb_ld(&bar[XB_TOPGEN]) == tg, bar);
            __builtin_amdgcn_fence(__ATOMIC_ACQUIRE, "agent");
#ifndef FLAT_RELEASE
            xb_add(&bar[XB_XGEN(b.x)], 1u);
#endif
            asm volatile("s_waitcnt vmcnt(0)" ::: "memory");
        } else {
#ifdef FLAT_RELEASE
            XB_SPIN(xb_ld(&bar[XB_TOPGEN]) == gen, bar);
#else
            XB_SPIN(xb_ld(&bar[XB_XGEN(b.x)]) == gen, bar);
#endif
            __builtin_amdgcn_fence(__ATOMIC_ACQUIRE, "agent");
            asm volatile("s_waitcnt vmcnt(0)" ::: "memory");
        }
    }
    __syncthreads();
}


struct Args { const float* in[24]; float* out; unsigned char* ws; int ph_lo, ph_hi; };
enum { I_X = 0, I_MEM, I_AWIN, I_ALNG, I_ALNB, I_AWS, I_ABS, I_AWOUT, I_BWIN, I_BLAM, I_BSUBG, I_BWOUT, I_WKV, I_RELB, I_MEMWKV, I_LNG, I_LNB,
       I_WG1, I_BG1, I_WG2, I_BG2, I_W1, I_W3, I_W2 };
constexpr int NPH_LAYER = 9, NPHASES = 1 + DEPTH * NPH_LAYER;

struct Frame {
    LAS unsigned char* lds; char* ldsg;
    gu32* ctl; unsigned char* ws;
    int tid, lane, wave, G, c;
};

__device__ __forceinline__ void transpose_item(const float* W, int K, int N, bf16* WT, int drow0, LAS float* scr, int k0, int n0, int lane) {
#pragma unroll 8
    for (int i = 0; i < 32; ++i) { const int kk = 2 * i + (lane >> 5); scr[kk * 33 + (lane & 31)] = W[(size_t)(k0 + kk) * N + n0 + (lane & 31)]; }
    LDS_WAIT(); asm volatile("" ::: "memory");
    const int c = lane & 7;
#pragma unroll
    for (int j = 0; j < 4; ++j) { const int n = (lane >> 3) + 8 * j; const LAS float* s = scr + (8 * c) * 33 + n;
        v4u o; o.x = pk2(s[0 * 33], s[1 * 33]); o.y = pk2(s[2 * 33], s[3 * 33]); o.z = pk2(s[4 * 33], s[5 * 33]); o.w = pk2(s[6 * 33], s[7 * 33]);
        *(GAS v4u*)(WT + (size_t)(drow0 + n) * K + k0 + 8 * c) = o; }
    LDS_WAIT(); asm volatile("" ::: "memory");
}
__device__ __forceinline__ void transpose_item_fast(const float* W, int K, int N, bf16* WT, int drow0, LAS float* scr, int k0, int n0, int lane) {
    float t[32];
#pragma unroll
    for (int i = 0; i < 32; ++i) t[i] = W[(size_t)(k0 + 2 * i + (lane >> 5)) * N + n0 + (lane & 31)];
#pragma unroll
    for (int i = 0; i < 32; i += 8) asm volatile("" : "+v"(t[i]), "+v"(t[i + 1]), "+v"(t[i + 2]), "+v"(t[i + 3]), "+v"(t[i + 4]), "+v"(t[i + 5]), "+v"(t[i + 6]), "+v"(t[i + 7]));
#pragma unroll
    for (int i = 0; i < 32; ++i) scr[(2 * i + (lane >> 5)) * 33 + (lane & 31)] = t[i];
    LDS_WAIT(); asm volatile("" ::: "memory");
    const int c = lane & 7;
#pragma unroll
    for (int j = 0; j < 4; ++j) { const int n = (lane >> 3) + 8 * j; const LAS float* s = scr + (8 * c) * 33 + n;
        v4u o; o.x = pk2(s[0 * 33], s[1 * 33]); o.y = pk2(s[2 * 33], s[3 * 33]); o.z = pk2(s[4 * 33], s[5 * 33]); o.w = pk2(s[6 * 33], s[7 * 33]);
        *(GAS v4u*)(WT + (size_t)(drow0 + n) * K + k0 + 8 * c) = o; }
    LDS_WAIT(); asm volatile("" ::: "memory");
}
__device__ __forceinline__ void transpose_item_fp8(const float* W, int K, int N, unsigned char* WT, int drow0, LAS float* scr, int k0, int n0, int lane) {
    float t[32];
#pragma unroll
    for (int i = 0; i < 32; ++i) t[i] = W[(size_t)(k0 + 2 * i + (lane >> 5)) * N + n0 + (lane & 31)];
#pragma unroll
    for (int i = 0; i < 32; i += 8) asm volatile("" : "+v"(t[i]), "+v"(t[i + 1]), "+v"(t[i + 2]), "+v"(t[i + 3]), "+v"(t[i + 4]), "+v"(t[i + 5]), "+v"(t[i + 6]), "+v"(t[i + 7]));
#pragma unroll
    for (int i = 0; i < 32; ++i) scr[(2 * i + (lane >> 5)) * 33 + (lane & 31)] = t[i];
    LDS_WAIT(); asm volatile("" ::: "memory");
    const int c = lane & 7;
#pragma unroll
    for (int j = 0; j < 4; ++j) { const int n = (lane >> 3) + 8 * j; const LAS float* s = scr + (8 * c) * 33 + n;
        unsigned lo = 0u, hi = 0u;
        lo = __builtin_amdgcn_cvt_pk_fp8_f32(s[0 * 33] * 64.f, s[1 * 33] * 64.f, lo, false); lo = __builtin_amdgcn_cvt_pk_fp8_f32(s[2 * 33] * 64.f, s[3 * 33] * 64.f, lo, true);
        hi = __builtin_amdgcn_cvt_pk_fp8_f32(s[4 * 33] * 64.f, s[5 * 33] * 64.f, hi, false); hi = __builtin_amdgcn_cvt_pk_fp8_f32(s[6 * 33] * 64.f, s[7 * 33] * 64.f, hi, true);
        v2u o; o.x = lo; o.y = hi; *(GAS v2u*)(WT + (size_t)(drow0 + n) * K + k0 + 8 * c) = o; }
    LDS_WAIT(); asm volatile("" ::: "memory");
}
#ifndef CDRAIN
#define CDRAIN 8
#endif
#ifndef CSRV
#define CSRV 4
#endif
#ifndef CSRVA
#define CSRVA 32
#endif
#ifndef STOPU
#define STOPU 64
#endif
#ifndef QX
#define QX 6
#endif
#ifndef QA
#define QA 14
#endif
#ifndef QM
#define QM 7
#endif
#ifndef QB
#define QB 4
#endif
constexpr int NQ = 7, MOE_ITEMS = 3 * 32 * 512;
__device__ __forceinline__ int conv_qsize(int q) { return (q & 1) ? (q == 1 ? 5632 : (q == 3 ? 7168 : 4096)) : MOE_ITEMS; }
__device__ __forceinline__ void conv_item(Frame& F, const Args& a, int q, int it) {
    LAS float* scr = (LAS float*)(F.lds + RING_OFF + F.wave * 16384);
    if (q & 1) {
        const float* src; bf16* dst; int N, r = it;
        if (q == 1) { if (r < 3584) { N = 3584; src = a.in[I_AWIN] + (size_t)2048 * 3584; dst = (bf16*)(F.ws + WS_WAIN) + (size_t)2048 * 3584; } else { r -= 3584; N = 2048; src = a.in[I_AWOUT] + (size_t)2048 * 2048; dst = (bf16*)(F.ws + WS_WAOUT) + (size_t)2048 * 2048; } }
        else if (q == 3) { if (r < 2048) { N = 2048; src = a.in[I_BWIN]; dst = (bf16*)(F.ws + WS_WBIN0); } else if ((r -= 2048) < 3072) { N = 3072; src = a.in[I_WKV]; dst = (bf16*)(F.ws + WS_WKV); } else { r -= 3072; N = 2048; src = a.in[I_BWOUT]; dst = (bf16*)(F.ws + WS_WBOUT); } }
        else { if (r < 2048) { N = 2048; src = a.in[I_BWIN] + (size_t)2048 * 2048; dst = (bf16*)(F.ws + WS_WBIN1); } else { r -= 2048; N = 2048; src = a.in[I_BWOUT] + (size_t)2048 * 2048; dst = (bf16*)(F.ws + WS_WBOUT) + (size_t)2048 * 2048; } }
        const int nblk = N / 32, kb = r / nblk, nb = r - kb * nblk;
        transpose_item_fast(src, 2048, N, dst, 32 * nb, scr, 64 * kb, 32 * nb, F.lane);
        return;
    }
    const int L = q >> 1, seg = it >> 14, r0 = it & 16383, e = r0 >> 9, r = r0 & 511, mat = L * 32 + e;
    if (seg < 2) { const int kb = r >> 4, nb = r & 15, n0 = 32 * nb;
        transpose_item_fp8(a.in[seg == 0 ? I_W1 : I_W3] + (size_t)mat * 2048 * 512, 2048, 512, (unsigned char*)(F.ws + WS_W13) + (size_t)mat * 1024 * 2048, (n0 >> 7) * 256 + (n0 & 127) + (seg == 1 ? 128 : 0), scr, 64 * kb, n0, F.lane); }
    else { const int kb = r >> 6, nb = r & 63;
        transpose_item_fp8(a.in[I_W2] + (size_t)mat * 512 * 2048, 512, 2048, (unsigned char*)(F.ws + WS_W2) + (size_t)mat * 512 * 2048, 32 * nb, scr, 64 * kb, 32 * nb, F.lane); }
}
#ifndef F8MASK
#define F8MASK 4
#endif
#define F8L(l) (((F8MASK) >> (l)) & 1)
#ifndef F8OMASK
#define F8OMASK 12
#endif
#define F8OL(l) (((F8OMASK) >> (l)) & 1)
#ifndef CDEPTH
#define CDEPTH 3
#endif
struct CDesc { const float* src; unsigned char* dst; int N, K, drow0, k0, n0, f8; };
__device__ __forceinline__ CDesc conv_desc(Frame& F, const Args& a, int q, int it) {
    CDesc d;
    if (q & 1) {
        const float* src; unsigned char* dst; int N, r = it, f8 = F8L((q + 1) >> 1);
        if (q == 1) { if (r < 3584) { N = 3584; src = a.in[I_AWIN] + (size_t)2048 * 3584; dst = F.ws + WS_WAIN + (size_t)2048 * 3584 * 2; } else { r -= 3584; N = 2048; f8 = 0; src = a.in[I_AWOUT] + (size_t)2048 * 2048; dst = F.ws + WS_WAOUT + (size_t)2048 * 2048 * 2; } }
        else if (q == 3) { if (r < 2048) { N = 2048; src = a.in[I_BWIN]; dst = F.ws + WS_WBIN0; } else if ((r -= 2048) < 3072) { N = 3072; src = a.in[I_WKV]; dst = F.ws + WS_WBIN0 + (size_t)2048 * 2048 * (F8L(2) ? 1 : 2); } else { r -= 3072; N = 2048; f8 = F8OL(2); src = a.in[I_BWOUT]; dst = F.ws + WS_WBOUT; } }
        else { if (r < 2048) { N = 2048; src = a.in[I_BWIN] + (size_t)2048 * 2048; dst = F.ws + WS_WBIN1; } else { r -= 2048; N = 2048; f8 = F8OL(3); src = a.in[I_BWOUT] + (size_t)2048 * 2048; dst = F.ws + WS_WBOUT + (size_t)2048 * 2048 * 2; } }
        const int nblk = N / 32, kb = r / nblk, nb = r - kb * nblk;
        d.src = src; d.dst = dst; d.N = N; d.K = 2048; d.drow0 = 32 * nb; d.k0 = 64 * kb; d.n0 = 32 * nb; d.f8 = f8; return d;
    }
    const int L = q >> 1, seg = it >> 14, r0 = it & 16383, e = r0 >> 9, r = r0 & 511, mat = L * 32 + e;
    if (seg < 2) { const int kb = r >> 4, nb = r & 15, n0 = 32 * nb;
        d.src = a.in[seg == 0 ? I_W1 : I_W3] + (size_t)mat * 2048 * 512; d.dst = (unsigned char*)(F.ws + WS_W13) + (size_t)mat * 1024 * 2048; d.N = 512; d.K = 2048;
        d.drow0 = (n0 >> 7) * 256 + (n0 & 127) + (seg == 1 ? 128 : 0); d.k0 = 64 * kb; d.n0 = n0; d.f8 = 1; }
    else { const int kb = r >> 6, nb = r & 63;
        d.src = a.in[I_W2] + (size_t)mat * 512 * 2048; d.dst = (unsigned char*)(F.ws + WS_W2) + (size_t)mat * 512 * 2048; d.N = 2048; d.K = 512; d.drow0 = 32 * nb; d.k0 = 64 * kb; d.n0 = 32 * nb; d.f8 = 1; }
    return d;
}
#define CV_LOAD(t_, d_) do { const float* p_ = (d_).src + (size_t)((d_).k0 + (F.lane >> 3)) * (d_).N + (d_).n0 + 4 * (F.lane & 7); const size_t st_ = (size_t)8 * (d_).N; \
    _Pragma("unroll") for (int i_ = 0; i_ < 8; ++i_) (t_)[i_] = *(const GAS f32x4*)(p_ + st_ * i_); } while (0)
__device__ __forceinline__ void conv_process(Frame& F, f32x4 (&t)[8], const CDesc& d) {
    LAS float* scr = (LAS float*)(F.lds + RING_OFF + F.wave * 16384); const int lane = F.lane;
    asm volatile("" : "+v"(t[0]), "+v"(t[1]), "+v"(t[2]), "+v"(t[3]), "+v"(t[4]), "+v"(t[5]), "+v"(t[6]), "+v"(t[7]));
    { LAS float* w = scr + (lane >> 3) * 33 + 4 * (lane & 7);
#pragma unroll
      for (int i = 0; i < 8; ++i) { w[i * 8 * 33 + 0] = t[i].x; w[i * 8 * 33 + 1] = t[i].y; w[i * 8 * 33 + 2] = t[i].z; w[i * 8 * 33 + 3] = t[i].w; } }
    LDS_WAIT(); asm volatile("" ::: "memory");
    const int c = lane & 7;
    if (d.f8) {
#pragma unroll
        for (int j = 0; j < 4; ++j) { const int n = (lane >> 3) + 8 * j; const LAS float* s = scr + (8 * c) * 33 + n;
            unsigned lo = 0u, hi = 0u;
            lo = __builtin_amdgcn_cvt_pk_fp8_f32(s[0 * 33] * 64.f, s[1 * 33] * 64.f, lo, false); lo = __builtin_amdgcn_cvt_pk_fp8_f32(s[2 * 33] * 64.f, s[3 * 33] * 64.f, lo, true);
            hi = __builtin_amdgcn_cvt_pk_fp8_f32(s[4 * 33] * 64.f, s[5 * 33] * 64.f, hi, false); hi = __builtin_amdgcn_cvt_pk_fp8_f32(s[6 * 33] * 64.f, s[7 * 33] * 64.f, hi, true);
            v2u o; o.x = lo; o.y = hi; *(GAS v2u*)(d.dst + (size_t)(d.drow0 + n) * d.K + d.k0 + 8 * c) = o; }
    } else {
#pragma unroll
        for (int j = 0; j < 4; ++j) { const int n = (lane >> 3) + 8 * j; const LAS float* s = scr + (8 * c) * 33 + n;
            v4u o; o.x = pk2(s[0 * 33], s[1 * 33]); o.y = pk2(s[2 * 33], s[3 * 33]); o.z = pk2(s[4 * 33], s[5 * 33]); o.w = pk2(s[6 * 33], s[7 * 33]);
            *(GAS v4u*)((bf16*)d.dst + (size_t)(d.drow0 + n) * d.K + d.k0 + 8 * c) = o; }
    }
    LDS_WAIT(); asm volatile("" ::: "memory");
}
__device__ __forceinline__ void conv_range(Frame& F, const Args& a, int q, int first, int cnt) {
#if CDEPTH == 1
    for (int i = 0; i < cnt; ++i) conv_item(F, a, q, first + i);
#else
    f32x4 t[CDEPTH][8]; const int last = first + cnt - 1;
#pragma unroll
    for (int s = 0; s < CDEPTH - 1; ++s) { const int it = first + s < last ? first + s : last; const CDesc d = conv_desc(F, a, q, it); CV_LOAD(t[s], d); }
#pragma unroll 1
    for (int i0 = 0; i0 < cnt; i0 += CDEPTH) {
#pragma unroll
        for (int s = 0; s < CDEPTH; ++s) {
            { const int nx = first + i0 + s + CDEPTH - 1, it = nx < last ? nx : last; const CDesc d = conv_desc(F, a, q, it); CV_LOAD(t[(s + CDEPTH - 1) % CDEPTH], d); }
            asm volatile("" ::: "memory");
            if (i0 + s < cnt) { const CDesc d = conv_desc(F, a, q, first + i0 + s); conv_process(F, t[s], d); }
        }
    }
#endif
}
__device__ __forceinline__ void conv_filler(Frame& F, const Args& a, int q0, int n) {
    if (q0 >= NQ || n == 0) return;
#ifdef CONV_ALL_PRO
    return;
#endif
    LAS unsigned* bw = (LAS unsigned*)(F.lds + TAB_OFF + 384);
    __syncthreads();
    const bool drain = n < 0; const int per = drain ? CDRAIN : n; int q = q0;
    for (;;) {
        if (F.tid == 0) bw[0] = __hip_atomic_fetch_add(F.ctl + CW_CONV + 64 * q, (unsigned)(8 * per), RLX_AGENT);
        __syncthreads();
        const unsigned idx = bw[0];
        __syncthreads();
        const int qs = conv_qsize(q);
        if (idx >= (unsigned)qs) { if (drain || ++q >= NQ) break; continue; }
        { const int first = (int)idx + F.wave * per, cnt = (qs - first < per) ? qs - first : per; if (cnt > 0) conv_range(F, a, q, first, cnt); }
        if (!drain) break;
    }
}

__device__ __forceinline__ void prologue_phase(Frame& F, const Args& a) {
#ifdef TOUCH
    {
        const long nthr_ = (long)F.G * 512, gt_ = (long)F.c * 512 + F.tid; unsigned acc_ = 0u;
        for (long pg = gt_; pg < (long)(WS_END / 4096); pg += nthr_) acc_ += *(const GAS unsigned*)(F.ws + pg * 4096);
        for (long pg = gt_; pg < (long)((size_t)DEPTH * NE * D * FF * 4 / 4096); pg += nthr_) { acc_ += *(const GAS unsigned*)((const char*)a.in[I_W1] + pg * 4096); acc_ += *(const GAS unsigned*)((const char*)a.in[I_W3] + pg * 4096); acc_ += *(const GAS unsigned*)((const char*)a.in[I_W2] + pg * 4096); }
        if (acc_ == 0x12345679u) F.ctl[CW_TMO] = acc_;
    }
#endif
    LAS float* scr = (LAS float*)(F.lds + RING_OFF + F.wave * 16384);
    const int gw = F.c * NWAVES + F.wave, NGW = F.G * NWAVES;
    unsigned char* ws = F.ws;
    constexpr int S0 = 3584, S1 = 2048, S5 = 4 * 1024;
    constexpr int NITEMS = S0 + S1 + S5;
    for (int it = gw; it < NITEMS; it += NGW) {
        int r = it; const float* src; unsigned char* dst; int K = 2048, N; bool f8 = F8L(0);
        if (r < S0) { N = 3584; src = a.in[I_AWIN]; dst = ws + WS_WAIN; }
        else if ((r -= S0) < S1) { N = 2048; f8 = false; src = a.in[I_AWOUT]; dst = ws + WS_WAOUT; }
        else { r -= S1; const int mat = r >> 10; r &= 1023; N = 1024; src = a.in[I_MEMWKV] + (size_t)mat * K * N; dst = ws + WS_WMKV + (size_t)mat * K * N * (F8L(0) ? 1 : 2); }
        const int nblk = N / 32, kb = r / nblk, nb = r - kb * nblk;
        if (f8) transpose_item_fp8(src, K, N, dst, 32 * nb, scr, 64 * kb, 32 * nb, F.lane);
        else transpose_item_fast(src, K, N, (bf16*)dst, 32 * nb, scr, 64 * kb, 32 * nb, F.lane);
    }
#ifdef CONV_ALL_PRO
    for (int q = 0; q < NQ; ++q) { const int qs = conv_qsize(q); for (int it = gw * 4; it < qs; it += NGW * 4) conv_range(F, a, q, it, qs - it < 4 ? qs - it : 4); }
#endif
    const long nthr = (long)F.G * 512, gt = (long)F.c * 512 + F.tid;
    { float* wr = (float*)(ws + WS_WR);
      for (long i = gt; i < (long)DEPTH * 3 * 512 * 16 * 4; i += nthr) { const int j = (int)(i & 3), c = (int)((i >> 2) & 15), kg = (int)((i >> 6) & 511), r = (int)(i >> 15), nb = r % 3, l = r / 3;
          const int k = 4 * kg + j, o = 16 * nb + c; float v = 0.f;
          if (o < 4) v = a.in[I_WG1][((size_t)l * D + k) * 4 + o]; else if (o < 36) { const int g = (o - 4) >> 3, e = (o - 4) & 7; v = a.in[I_WG2][(((size_t)l * 4 + g) * D + k) * 8 + e]; }
          wr[i] = v; } }
    { const float* x = a.in[I_X]; bf16* xb = (bf16*)(ws + WS_XB);
      for (long i = gt; i < (long)T * D / 8; i += nthr) { const f32x4 v0 = *(const GAS f32x4*)(x + i * 8), v1 = *(const GAS f32x4*)(x + i * 8 + 4);
          v4u o; o.x = pk2(v0.x, v0.y); o.y = pk2(v0.z, v0.w); o.z = pk2(v1.x, v1.y); o.w = pk2(v1.z, v1.w); *(GAS v4u*)(xb + i * 8) = o;
          unsigned lo = 0u, hi = 0u; lo = __builtin_amdgcn_cvt_pk_fp8_f32(v0.x, v0.y, lo, false); lo = __builtin_amdgcn_cvt_pk_fp8_f32(v0.z, v0.w, lo, true); hi = __builtin_amdgcn_cvt_pk_fp8_f32(v1.x, v1.y, hi, false); hi = __builtin_amdgcn_cvt_pk_fp8_f32(v1.z, v1.w, hi, true);
          v2u qq; qq.x = lo; qq.y = hi; if (F8L(0)) *(GAS v2u*)(ws + WS_XQ + i * 8) = qq; } }
    { const float* x = a.in[I_MEM]; bf16* xb = (bf16*)(ws + WS_MEMB);
      for (long i = gt; i < (long)MEMT * D / 8; i += nthr) { const f32x4 v0 = *(const GAS f32x4*)(x + i * 8), v1 = *(const GAS f32x4*)(x + i * 8 + 4);
          v4u o; o.x = pk2(v0.x, v0.y); o.y = pk2(v0.z, v0.w); o.z = pk2(v1.x, v1.y); o.w = pk2(v1.z, v1.w); *(GAS v4u*)(xb + i * 8) = o;
          unsigned lo = 0u, hi = 0u; lo = __builtin_amdgcn_cvt_pk_fp8_f32(v0.x, v0.y, lo, false); lo = __builtin_amdgcn_cvt_pk_fp8_f32(v0.z, v0.w, lo, true); hi = __builtin_amdgcn_cvt_pk_fp8_f32(v1.x, v1.y, hi, false); hi = __builtin_amdgcn_cvt_pk_fp8_f32(v1.z, v1.w, hi, true);
          v2u qq; qq.x = lo; qq.y = hi; *(GAS v2u*)(ws + WS_MEMQ + i * 8) = qq; } }
}

#ifndef NCVMAX
#define NCVMAX 0
#endif
#ifndef NCVATT
#define NCVATT 96
#endif
__device__ __forceinline__ int conv_servers(int nu, int G, int fin) {
    if (fin || nu <= 0) return 0;
    const int rounds = (nu + G - 1) / G, gmin = (nu + rounds - 1) / rounds; int n = G - gmin; n = n < NCVMAX ? n : NCVMAX; return n & ~7;
}
__device__ __forceinline__ void conv_done(Frame& F, int p) { __syncthreads(); if (F.tid == 0) __hip_atomic_fetch_add(F.ctl + CW_DONE + 64 * p, 1u, RLX_AGENT); }
__device__ __forceinline__ void conv_server(Frame& F, const Args& a, int p, int q0, int ncomp) {
    int q = q0;
    for (;;) {
        if (q >= NQ) break;
        unsigned idx = 0xffffffffu;
        if (F.lane == 0) { if (__hip_atomic_load(F.ctl + CW_DONE + 64 * p, RLX_AGENT) < (unsigned)ncomp) idx = __hip_atomic_fetch_add(F.ctl + CW_CONV + 64 * q, (unsigned)CSRV, RLX_AGENT); }
        idx = (unsigned)__builtin_amdgcn_readfirstlane((int)idx);
        if (idx == 0xffffffffu) break;
        const int qs = conv_qsize(q);
        if (idx >= (unsigned)qs) { ++q; continue; }
        conv_range(F, a, q, (int)idx, (qs - (int)idx < CSRV) ? qs - (int)idx : CSRV);
    }
}
__device__ __forceinline__ void conv_server_q(Frame& F, const Args& a, gu32* head, unsigned stop_at, int q0) {
    int q = q0;
    for (;;) {
        if (q >= NQ) break;
        unsigned idx = 0xffffffffu;
        if (F.lane == 0) { if (__hip_atomic_load(head, RLX_AGENT) < stop_at) idx = __hip_atomic_fetch_add(F.ctl + CW_CONV + 64 * q, (unsigned)CSRVA, RLX_AGENT); }
        idx = (unsigned)__builtin_amdgcn_readfirstlane((int)idx);
        if (idx == 0xffffffffu) break;
        const int qs = conv_qsize(q);
        if (idx >= (unsigned)qs) { ++q; continue; }
        conv_range(F, a, q, (int)idx, (qs - (int)idx < CSRVA) ? qs - (int)idx : CSRVA);
    }
}
__device__ __forceinline__ void conv_note_fin(Frame& F, int p) {
    if (blockIdx.x == 0 && F.tid < 64) {
        const int q = F.lane < NQ ? F.lane : 0;
        const bool ok = __hip_atomic_load(F.ctl + CW_CONV + 64 * q, RLX_AGENT) >= (unsigned)conv_qsize(q);
        const unsigned all = __all(ok) ? 1u : 0u;
        if (F.lane == 0) __hip_atomic_store(F.ctl + CW_FIN + 64 * p, all, RLX_AGENT); }
}

__device__ __forceinline__ void sgu_unit(Frame& F, const Args& a, int l, int n, int g) {
    constexpr int LDW = 136;
    LAS float* stats = (LAS float*)(F.lds); LAS bf16* Wl = (LAS bf16*)(F.lds + 1024); LAS bf16* Vt = (LAS bf16*)(F.lds + 35840);
    const bf16* z = (const bf16*)(F.ws + WS_Z); bf16* cat = (bf16*)(F.ws + WS_CAT);
    const int tok0 = n * 128;
    for (int i = 0; i < 16; ++i) { const int tk = F.wave * 16 + i; const GAS v4u* rp = (const GAS v4u*)(z + (size_t)(tok0 + tk) * NINA + MIXW) + F.lane;
        v4u w[3]; float s = 0.f;
#pragma unroll
        for (int j = 0; j < 3; ++j) { w[j] = rp[64 * j]; s += (bflo(w[j].x) + bfhi(w[j].x)) + (bflo(w[j].y) + bfhi(w[j].y)) + (bflo(w[j].z) + bfhi(w[j].z)) + (bflo(w[j].w) + bfhi(w[j].w)); }
        const float mean = wave_sum(s) * (1.f / MIXW); float q = 0.f;
#pragma unroll
        for (int j = 0; j < 3; ++j) { float d;
            d = bflo(w[j].x) - mean; q += d * d; d = bfhi(w[j].x) - mean; q += d * d; d = bflo(w[j].y) - mean; q += d * d; d = bfhi(w[j].y) - mean; q += d * d;
            d = bflo(w[j].z) - mean; q += d * d; d = bfhi(w[j].z) - mean; q += d * d; d = bflo(w[j].w) - mean; q += d * d; d = bfhi(w[j].w) - mean; q += d * d; }
        const float rstd = 1.f / sqrtf(wave_sum(q) * (1.f / MIXW) + LN_EPS);
        if (F.lane == 0) { stats[2 * tk] = mean; stats[2 * tk + 1] = rstd; } }
    { const float* wsrc = a.in[I_AWS] + ((size_t)l * 4 + g) * 128 * 128;
      for (int p = F.tid; p < 128 * 32; p += 512) { const int i = p >> 5, j4 = (p & 31) * 4; f32x4 v = *(const GAS f32x4*)(wsrc + i * 128 + j4);
          if ((j4 >> 6) > (i >> 6)) v = (f32x4){0.f, 0.f, 0.f, 0.f};
          v2u o; o.x = pk2(v.x, v.y); o.y = pk2(v.z, v.w); *(LAS v2u*)(Wl + i * LDW + j4) = o; } }
    __syncthreads();
    { const float* lg = a.in[I_ALNG] + (size_t)l * MIXW + g * 384; const float* lb = a.in[I_ALNB] + (size_t)l * MIXW + g * 384;
      for (int p = F.tid; p < 128 * 48; p += 512) { const int j = p & 127, c8 = (p >> 7) * 8;
          const v4u w = *(const GAS v4u*)(z + (size_t)(tok0 + j) * NINA + MIXW + g * 384 + c8);
          const float mean = stats[2 * j], rstd = stats[2 * j + 1];
          const f32x4 g0 = *(const GAS f32x4*)(lg + c8), g1 = *(const GAS f32x4*)(lg + c8 + 4), b0 = *(const GAS f32x4*)(lb + c8), b1 = *(const GAS f32x4*)(lb + c8 + 4);
          float v[8] = {bflo(w.x), bfhi(w.x), bflo(w.y), bfhi(w.y), bflo(w.z), bfhi(w.z), bflo(w.w), bfhi(w.w)};
          const float gg[8] = {g0.x, g0.y, g0.z, g0.w, g1.x, g1.y, g1.z, g1.w}, bb[8] = {b0.x, b0.y, b0.z, b0.w, b1.x, b1.y, b1.z, b1.w};
#pragma unroll
          for (int e = 0; e < 8; ++e) Vt[(c8 + e) * LDW + j] = (bf16)f2bf((v[e] - mean) * rstd * gg[e] + bb[e]); } }
    __syncthreads();
    const int fr = F.lane & 15, fq = F.lane >> 4;
    f32x4 acc[8][3];
#pragma unroll
    for (int mb = 0; mb < 8; ++mb)
#pragma unroll
        for (int nb = 0; nb < 3; ++nb) acc[mb][nb] = (f32x4){0.f, 0.f, 0.f, 0.f};
#pragma unroll
    for (int ks = 0; ks < 4; ++ks) { bf16x8 bfr[3];
#pragma unroll
        for (int nb = 0; nb < 3; ++nb) bfr[nb] = *(const LAS bf16x8*)(Vt + (F.wave * 48 + nb * 16 + fr) * LDW + ks * 32 + fq * 8);
#pragma unroll
        for (int mb = 0; mb < 8; ++mb) { const bf16x8 afr = *(const LAS bf16x8*)(Wl + (mb * 16 + fr) * LDW + ks * 32 + fq * 8);
#pragma unroll
            for (int nb = 0; nb < 3; ++nb) acc[mb][nb] = __builtin_amdgcn_mfma_f32_16x16x32_bf16(bfr[nb], afr, acc[mb][nb], 0, 0, 0); } }
    const float* bs = a.in[I_ABS] + ((size_t)l * 4 + g) * 128;
#pragma unroll
    for (int mb = 0; mb < 8; ++mb) { const int i = mb * 16 + fr; const float bsv = bs[i]; const size_t tk = (size_t)(tok0 + i);
#pragma unroll
        for (int nb = 0; nb < 3; ++nb) { const int c = g * 384 + F.wave * 48 + nb * 16 + 4 * fq;
            const v2u uw = *(const GAS v2u*)(z + tk * NINA + c); const f32x4 gt = acc[mb][nb] + bsv;
            v2u o; o.x = pk2(bflo(uw.x) * gt.x, bfhi(uw.x) * gt.y); o.y = pk2(bflo(uw.y) * gt.z, bfhi(uw.y) * gt.w);
            *(GAS v2u*)(cat + tk * D + c) = o; } }
    __syncthreads();
}

__device__ __forceinline__ void memattn_unit(Frame& F, int l, int hm, int qb, int ldz, int qoff) {
    const bf16* z = (const bf16*)(F.ws + WS_Z); const bf16* kv = (const bf16*)(F.ws + WS_MEMKV) + (size_t)l * 256 * 1024; bf16* cat = (bf16*)(F.ws + WS_CAT);
    att::attn_body<0>(z + (size_t)qb * 256 * ldz + qoff + hm * 128, ldz, kv + hm * 128, kv + 512 + hm * 128, 1024,
                      cat + (size_t)qb * 256 * D + MIXW + hm * 128, nullptr, D, 4, 0, nullptr, 0.f, F.ldsg);
}

__device__ __forceinline__ int t5_bucket(int rel) {
    const int a = rel < 0 ? -rel : rel; int f;
    if (a < 8) f = a; else if (a < 12) f = 8; else if (a < 16) f = 9; else if (a < 23) f = 10; else if (a < 32) f = 11; else if (a < 46) f = 12; else if (a < 64) f = 13; else if (a < 91) f = 14; else f = 15;
    return (rel > 0 ? 16 : 0) + f;
}

namespace att2 {
using att::bf16x8; using att::s16x4; using att::f32x16; using att::u32x4; using att::crow; using att::cvtpk; using att::tr_read; using att::v_rd_base;
constexpr int KT = 32, ST_K = KT * 128 * 2, ST_V = KT * 256 * 2, STAGE = 2 * ST_K + ST_V, NST = 3;
constexpr int LDS_WS = NST * STAGE, LDS_TAB = LDS_WS + 2048, LDS_UNIT = LDS_TAB + 640, LDS_END = LDS_UNIT + 16;
constexpr int NUNITS = 576;
constexpr float THR2 = 8.f * 1.4426950408889634f;
__device__ __forceinline__ int swap23(int k) { return (k & ~0xC) | ((k & 4) << 1) | ((k & 8) >> 1); }
constexpr int v_off(int d0, int ks, int half) { return d0 * 512 + ks * 8192 + half * 4096; }

struct UnitTable { unsigned short u[NUNITS]; };
constexpr UnitTable make_units() {
    UnitTable t{}; int n = 0;
    for (int c = 256; c >= 4; c -= 2) {
        { const int b = (c - 2) / 2; if ((c - 2) % 2 == 0 && b >= 32 && b <= 63) for (int part = 1; part <= 2; ++part) for (int h = 0; h < 6; ++h) t.u[n++] = (unsigned short)(h | (b << 3) | (part << 9)); }
        if (c % 4 == 0) { const int b = c / 4 - 1; if (b >= 0 && b < 32) for (int h = 0; h < 6; ++h) t.u[n++] = (unsigned short)(h | (b << 3)); }
    }
    return t;
}
__device__ const UnitTable g_units = make_units();

__device__ __forceinline__ void diff_unit(const bf16* __restrict__ Q, const bf16* __restrict__ KD, const bf16* __restrict__ VD, float* Obuf  , int orow0,
                                          float* ML  , const float* relb, int h, int b, int t_lo, int t_hi, LAS char* lds) {
  int tid_ = threadIdx.x; asm volatile("" : "+v"(tid_));
  const int tid = tid_, wid = __builtin_amdgcn_readfirstlane(tid >> 6), lane = tid & 63, r32 = lane & 31, hi = lane >> 5, m = wid >> 2, rg = wid & 3;
  LAS float* wsw = (LAS float*)(lds + LDS_WS) + wid * 64; LAS float* li_l = wsw; LAS float* al_l = wsw + 32;
  LAS float* tab = (LAS float*)(lds + LDS_TAB);
  if (tid < att::TAB_N) tab[tid] = relb[t5_bucket(63 - tid) * 6 + h] * LOG2E;
  const float cfar = relb[15 * 6 + h] * LOG2E;
  const int qrow0 = b * 128 + rg * 32;
  bf16x8 qr[8];
  { const bf16* Qw = Q + (size_t)(qrow0 + r32) * 2048 + h * 256 + m * 128 + hi * 8;
#pragma unroll
    for (int d0 = 0; d0 < 8; ++d0) qr[d0] = *reinterpret_cast<const bf16x8*>(Qw + d0 * 16); }
  int ko[2], vo[2];
#pragma unroll
  for (int i = 0; i < 2; ++i) {
    const int p = wid * 64 + lane, row = p >> 4, cp = (p & 15) ^ (row & 7); ko[i] = row * 1536 + h * 256 + i * 128 + cp * 8; }
#pragma unroll
  for (int i = 0; i < 2; ++i) {
    const int p = (wid * 2 + i) * 64 + lane, sub = p >> 5, kg = sub >> 3, cblk = sub & 7, q = p & 31, kk = kg * 8 + (q >> 2), key = swap23(kk);
    vo[i] = key * 1536 + h * 256 + cblk * 32 + (q & 3) * 8; }
  const unsigned ldsb = (unsigned)(uintptr_t)lds;
#define A2_ISSUE(t, s) do { const size_t kb_ = (size_t)(t) * KT * 1536; LAS char* sb_ = lds + (s) * STAGE; \
    __builtin_amdgcn_global_load_lds((const unsigned*)(KD + kb_ + ko[0]), (LAS unsigned*)(sb_ + wid * 1024), 16, 0, 0); \
    __builtin_amdgcn_global_load_lds((const unsigned*)(KD + kb_ + ko[1]), (LAS unsigned*)(sb_ + ST_K + wid * 1024), 16, 0, 0); \
    __builtin_amdgcn_global_load_lds((const unsigned*)(VD + kb_ + vo[0]), (LAS unsigned*)(sb_ + 2 * ST_K + (wid * 2) * 1024), 16, 0, 0); \
    __builtin_amdgcn_global_load_lds((const unsigned*)(VD + kb_ + vo[1]), (LAS unsigned*)(sb_ + 2 * ST_K + (wid * 2 + 1) * 1024), 16, 0, 0); } while (0)
  const int vis = 2 * (2 * b + (rg >> 1) + 1);
  float m_reg = -1e30f, l_reg = 0.f; f32x16 o[8];
#pragma unroll
  for (int d = 0; d < 8; ++d) o[d] = f32x16{};
  asm volatile("s_waitcnt vmcnt(0)" ::: "memory");
  A2_ISSUE(t_lo, 0); if (t_lo + 1 < t_hi) A2_ISSUE(t_lo + 1, 1);
  int s = 0;
  for (int t = t_lo; t < t_hi; ++t) {
    if (t + 1 < t_hi) asm volatile("s_waitcnt vmcnt(4) lgkmcnt(0)" ::: "memory"); else asm volatile("s_waitcnt vmcnt(0) lgkmcnt(0)" ::: "memory");
    __builtin_amdgcn_s_barrier(); asm volatile("" ::: "memory");
    if (t + 2 < t_hi) { const int s2 = (s >= 1) ? s - 1 : s + 2; A2_ISSUE(t + 2, s2); }
    if (t < vis) {
      const LAS char* Ks = lds + s * STAGE + m * ST_K;
      f32x16 p = f32x16{};
#pragma unroll
      for (int d0 = 0; d0 < 8; ++d0) { const int cb = (d0 * 16 + hi * 8) * 2;
        const bf16x8 b0 = *(const LAS bf16x8*)(Ks + KSWZ(r32, cb));
        p = __builtin_amdgcn_mfma_f32_32x32x16_bf16(b0, qr[d0], p, 0, 0, 0); }
      if (qrow0 - (KT * t + KT - 1) >= 91) {
#pragma unroll
        for (int r = 0; r < 16; ++r) p[r] += cfar;
      } else { const int base = qrow0 + r32 - KT * t + 63;
#pragma unroll
        for (int r = 0; r < 16; ++r) { const int i0 = base - crow(r, hi); p[r] += tab[i0 < att::TAB_N - 1 ? i0 : att::TAB_N - 1]; } }
      float pmax = p[0];
#pragma unroll
      for (int r = 1; r < 16; ++r) pmax = fmaxf(pmax, p[r]);
      { auto rr = __builtin_amdgcn_permlane32_swap(__float_as_uint(pmax), __float_as_uint(pmax), false, false); pmax = fmaxf(__uint_as_float(rr[0]), __uint_as_float(rr[1])); }
      float mn, alpha;
      if (__builtin_expect(__all(pmax - m_reg <= THR2), 1)) { mn = m_reg; alpha = 1.f; }
      else { mn = fmaxf(m_reg, pmax); alpha = __builtin_amdgcn_exp2f(m_reg - mn); m_reg = mn; }
      float ps = 0.f;
#pragma unroll
      for (int r = 0; r < 16; ++r) { p[r] = __builtin_amdgcn_exp2f(p[r] - mn); ps += p[r]; }
      { auto rr = __builtin_amdgcn_permlane32_swap(__float_as_uint(ps), __float_as_uint(ps), false, false); ps = __uint_as_float(rr[0]) + __uint_as_float(rr[1]); }
      l_reg = l_reg * alpha + ps;
      bf16x8 pa0, pa1;
#define A2_PK4(P, BASE, OUT) do { unsigned a0 = cvtpk(P[BASE + 0], P[BASE + 1]), a1 = cvtpk(P[BASE + 2], P[BASE + 3]);   \
    unsigned b0_ = cvtpk(P[BASE + 4], P[BASE + 5]), b1_ = cvtpk(P[BASE + 6], P[BASE + 7]);                              \
    auto r0 = __builtin_amdgcn_permlane32_swap(a0, b0_, false, false); auto r1 = __builtin_amdgcn_permlane32_swap(a1, b1_, false, false); \
    u32x4 w = {r0[0], r1[0], r0[1], r1[1]}; OUT = *reinterpret_cast<bf16x8*>(&w); } while (0)
      A2_PK4(p, 0, pa0); A2_PK4(p, 8, pa1);
      if (__any(alpha < 1.f)) { if (hi == 0) al_l[r32] = alpha; asm volatile("s_waitcnt lgkmcnt(0)" ::: "memory");
#pragma unroll
        for (int d = 0; d < 8; ++d)
#pragma unroll
          for (int r = 0; r < 16; ++r) o[d][r] *= al_l[crow(r, hi)]; }
      const int vb = (int)(ldsb + s * STAGE + 2 * ST_K) + v_rd_base(lane);
      asm volatile("s_waitcnt lgkmcnt(0)" ::: "memory"); SBAR();
#define A2_PK(L, H) (bf16x8){L[0], L[1], L[2], L[3], H[0], H[1], H[2], H[3]}
#define A2_RD(D0, l0, h0, l1, h1) do { l0 = tr_read<v_off(D0, 0, 0)>(vb); h0 = tr_read<v_off(D0, 0, 1)>(vb); l1 = tr_read<v_off(D0, 1, 0)>(vb); h1 = tr_read<v_off(D0, 1, 1)>(vb); } while (0)
#define A2_MM(D0, l0, h0, l1, h1) do { o[D0] = __builtin_amdgcn_mfma_f32_32x32x16_bf16(pa0, A2_PK(l0, h0), o[D0], 0, 0, 0); o[D0] = __builtin_amdgcn_mfma_f32_32x32x16_bf16(pa1, A2_PK(l1, h1), o[D0], 0, 0, 0); } while (0)
      s16x4 xl0, xh0, xl1, xh1, yl0, yh0, yl1, yh1;
      A2_RD(0, xl0, xh0, xl1, xh1);
      A2_RD(1, yl0, yh0, yl1, yh1); asm volatile("s_waitcnt lgkmcnt(4)" ::: "memory"); SBAR(); A2_MM(0, xl0, xh0, xl1, xh1); SBAR();
      A2_RD(2, xl0, xh0, xl1, xh1); asm volatile("s_waitcnt lgkmcnt(4)" ::: "memory"); SBAR(); A2_MM(1, yl0, yh0, yl1, yh1); SBAR();
      A2_RD(3, yl0, yh0, yl1, yh1); asm volatile("s_waitcnt lgkmcnt(4)" ::: "memory"); SBAR(); A2_MM(2, xl0, xh0, xl1, xh1); SBAR();
      A2_RD(4, xl0, xh0, xl1, xh1); asm volatile("s_waitcnt lgkmcnt(4)" ::: "memory"); SBAR(); A2_MM(3, yl0, yh0, yl1, yh1); SBAR();
      A2_RD(5, yl0, yh0, yl1, yh1); asm volatile("s_waitcnt lgkmcnt(4)" ::: "memory"); SBAR(); A2_MM(4, xl0, xh0, xl1, xh1); SBAR();
      A2_RD(6, xl0, xh0, xl1, xh1); asm volatile("s_waitcnt lgkmcnt(4)" ::: "memory"); SBAR(); A2_MM(5, yl0, yh0, yl1, yh1); SBAR();
      A2_RD(7, yl0, yh0, yl1, yh1); asm volatile("s_waitcnt lgkmcnt(4)" ::: "memory"); SBAR(); A2_MM(6, xl0, xh0, xl1, xh1); SBAR();
      asm volatile("s_waitcnt lgkmcnt(0)" ::: "memory"); SBAR(); A2_MM(7, yl0, yh0, yl1, yh1); SBAR();
    }
    s = (s == 2) ? 0 : s + 1;
  }
  if (hi == 0) li_l[r32] = l_reg; asm volatile("s_waitcnt lgkmcnt(0)" ::: "memory");
  float rli[16];
#pragma unroll
  for (int r = 0; r < 16; ++r) rli[r] = __builtin_amdgcn_rcpf(li_l[crow(r, hi)]);
  float* Ow = Obuf + (size_t)(qrow0 - orow0) * 3072 + (h * 2 + m) * 256;
#pragma unroll
  for (int r = 0; r < 16; ++r) { const int orow = crow(r, hi);
#pragma unroll
    for (int d0 = 0; d0 < 8; ++d0) Ow[(size_t)orow * 3072 + d0 * 32 + r32] = o[d0][r] * rli[r]; }
  if (hi == 0) { float* mlp = ML + (((size_t)(qrow0 - orow0 + r32) * 6 + h) * 2 + m) * 2; mlp[0] = m_reg; mlp[1] = l_reg; }
  asm volatile("s_waitcnt vmcnt(0) lgkmcnt(0)" ::: "memory");
  __builtin_amdgcn_s_barrier(); asm volatile("" ::: "memory");
#undef A2_ISSUE
#undef A2_PK4
#undef A2_PK
#undef A2_RD
#undef A2_MM
}
}

namespace att3 {
using att::f32x16; using att::crow;
typedef int v8i __attribute__((ext_vector_type(8))); typedef int v4i __attribute__((ext_vector_type(4)));
constexpr int KT = 64, ST_K = KT * 128, ST_V = 256 * 64, STAGE = ST_K + ST_V, NST = 4;
struct UnitTable { unsigned short u[att2::NUNITS]; };
constexpr UnitTable make_units() {
    UnitTable t{}; int n = 0;
    for (int L = 64; L >= 4; L -= 2) {
        if ((L - 2) % 2 == 0) { const int b = (L - 2) / 2; if (b >= 16 && b < 32) for (int part = 1; part <= 2; ++part) for (int hm = 0; hm < 12; ++hm) t.u[n++] = (unsigned short)((hm >> 1) | ((hm & 1) << 3) | (b << 4) | (part << 9)); }
        if (L % 4 == 0) { const int b = L / 4 - 1; if (b >= 0 && b < 16) for (int hm = 0; hm < 12; ++hm) t.u[n++] = (unsigned short)((hm >> 1) | ((hm & 1) << 3) | (b << 4)); }
    }
    return t;
}
__device__ const UnitTable g_units = make_units();
static_assert(NST * STAGE == att2::LDS_WS, "same ring size as att2");
constexpr float THR2 = 2.f;
__device__ __forceinline__ v8i cat8(v4i a, v4i b) { return __builtin_shufflevector(a, b, 0, 1, 2, 3, 4, 5, 6, 7); }
__device__ __forceinline__ void diff_unit(const unsigned char* __restrict__ Q8, const unsigned char* __restrict__ K8, const unsigned char* __restrict__ VT, float* Obuf, int orow0,
                                          float* ML, const float* relb, int h, int m, int b, int t_lo, int t_hi, LAS char* lds) {
  int tid_ = threadIdx.x; asm volatile("" : "+v"(tid_));
  const int tid = tid_, wid = __builtin_amdgcn_readfirstlane(tid >> 6), lane = tid & 63, r32 = lane & 31, hi = lane >> 5, rg = wid;
  LAS float* wsw = (LAS float*)(lds + att2::LDS_WS) + wid * 64; LAS float* li_l = wsw; LAS float* al_l = wsw + 32;
  LAS float* tab = (LAS float*)(lds + att2::LDS_TAB);
  if (tid < att::TAB_N) tab[tid] = relb[t5_bucket(63 - tid) * 6 + h] * LOG2E;
  const float cfar = relb[15 * 6 + h] * LOG2E;
  const int qrow0 = b * 256 + rg * 32;
  v8i q8[2];
  { const unsigned char* Qw = Q8 + (size_t)(qrow0 + r32) * 2048 + h * 256 + m * 128 + hi * 32;
#pragma unroll
    for (int c = 0; c < 2; ++c) q8[c] = cat8(*(const GAS v4i*)(Qw + 64 * c), *(const GAS v4i*)(Qw + 64 * c + 16)); }
  int ko, vo[2];
  { const int p = wid * 64 + lane, row = p >> 3, cp = (p & 7) ^ (row & 7); ko = row * 1536 + h * 256 + m * 128 + cp * 16; }
#pragma unroll
  for (int i = 0; i < 2; ++i) { const int p = (wid * 2 + i) * 64 + lane, d = p >> 2, cp = (p & 3) ^ ((d >> 1) & 3); vo[i] = d * 64 + cp * 16; }
  const unsigned char* VTh = VT + (size_t)h * 128 * 16384;
#define A3_ISSUE(t, s) do { const size_t kb_ = (size_t)(t) * KT * 1536; LAS char* sb_ = lds + (s) * STAGE; \
    __builtin_amdgcn_global_load_lds((const unsigned*)(K8 + kb_ + ko), (LAS unsigned*)(sb_ + wid * 1024), 16, 0, 0); \
    __builtin_amdgcn_global_load_lds((const unsigned*)(VTh + (size_t)(t) * 16384 + vo[0]), (LAS unsigned*)(sb_ + ST_K + (wid * 2) * 1024), 16, 0, 0); \
    __builtin_amdgcn_global_load_lds((const unsigned*)(VTh + (size_t)(t) * 16384 + vo[1]), (LAS unsigned*)(sb_ + ST_K + (wid * 2 + 1) * 1024), 16, 0, 0); } while (0)
  const int vis = 4 * b + (rg >> 1) + 1;
  float m_reg = -1e30f, l_reg = 0.f; f32x16 o[8];
#pragma unroll
  for (int d = 0; d < 8; ++d) o[d] = f32x16{};
  const int kx = (r32 & 7), koff0 = r32 * 128 + (((2 * hi) ^ kx) << 4), koff1 = r32 * 128 + (((2 * hi + 1) ^ kx) << 4);
  const int vx = (r32 >> 1) & 3, voff0 = r32 * 64 + (((2 * hi) ^ vx) << 4), voff1 = r32 * 64 + (((2 * hi + 1) ^ vx) << 4);
  int sclP = 121, scl1 = 127; asm volatile("" : "+v"(sclP), "+v"(scl1));
  asm volatile("s_waitcnt vmcnt(0)" ::: "memory");
  A3_ISSUE(t_lo, 0); if (t_lo + 1 < t_hi) A3_ISSUE(t_lo + 1, 1); if (t_lo + 2 < t_hi) A3_ISSUE(t_lo + 2, 2);
  int s = 0;
  for (int t = t_lo; t < t_hi; ++t) {
    if (t + 2 < t_hi) asm volatile("s_waitcnt vmcnt(6) lgkmcnt(0)" ::: "memory"); else if (t + 1 < t_hi) asm volatile("s_waitcnt vmcnt(3) lgkmcnt(0)" ::: "memory"); else asm volatile("s_waitcnt vmcnt(0) lgkmcnt(0)" ::: "memory");
    __builtin_amdgcn_s_barrier(); asm volatile("" ::: "memory");
    if (t + 3 < t_hi) A3_ISSUE(t + 3, (s + 3) & 3);
    if (t < vis) {
      const LAS char* Ks = lds + s * STAGE;
      f32x16 p0 = f32x16{}, p1 = f32x16{};
#pragma unroll
      for (int c = 0; c < 2; ++c) {
        const int x0 = koff0 ^ (c << 6), x1 = koff1 ^ (c << 6);
        const v8i k0 = cat8(*(const LAS v4i*)(Ks + x0), *(const LAS v4i*)(Ks + x1));
        const v8i k1 = cat8(*(const LAS v4i*)(Ks + 4096 + x0), *(const LAS v4i*)(Ks + 4096 + x1));
        asm volatile("v_mfma_scale_f32_32x32x64_f8f6f4 %0, %1, %2, %0, %3, %3 op_sel_hi:[0,0,0]" : "+v"(p0) : "v"(k0), "v"(q8[c]), "v"(scl1));
        asm volatile("v_mfma_scale_f32_32x32x64_f8f6f4 %0, %1, %2, %0, %3, %3 op_sel_hi:[0,0,0]" : "+v"(p1) : "v"(k1), "v"(q8[c]), "v"(scl1)); }
      asm volatile("s_nop 15\n s_nop 7" : "+v"(p0), "+v"(p1));
      const bool far = qrow0 - (KT * t + KT - 1) >= 91;
      if (!far) { const int base = qrow0 + r32 - KT * t + 63;
#pragma unroll
        for (int r = 0; r < 16; ++r) { const int i0 = base - crow(r, hi), i1 = i0 - 32; p0[r] += tab[i0 < att::TAB_N - 1 ? i0 : att::TAB_N - 1]; p1[r] += tab[i1 < att::TAB_N - 1 ? i1 : att::TAB_N - 1]; } }
      const float cb = far ? cfar : 0.f;
      float pmax;
      asm("v_max3_f32 %0, %1, %2, %3" : "=v"(pmax) : "v"(p0[0]), "v"(p1[0]), "v"(p0[1]));
      asm("v_max3_f32 %0, %1, %2, %3" : "=v"(pmax) : "v"(pmax), "v"(p1[1]), "v"(p0[2]));
#pragma unroll
      for (int r = 2; r < 15; ++r) asm("v_max3_f32 %0, %1, %2, %3" : "=v"(pmax) : "v"(pmax), "v"(p1[r]), "v"(p0[r + 1]));
      asm("v_max_f32 %0, %1, %2" : "=v"(pmax) : "v"(pmax), "v"(p1[15]));
      pmax += cb;
      { auto rr = __builtin_amdgcn_permlane32_swap(__float_as_uint(pmax), __float_as_uint(pmax), false, false); asm("v_max_f32 %0, %1, %2" : "=v"(pmax) : "v"(__uint_as_float(rr[0])), "v"(__uint_as_float(rr[1]))); }
      float mn, alpha;
      if (__builtin_expect(__all(pmax - m_reg <= THR2), 1)) { mn = m_reg; alpha = 1.f; }
      else { mn = fmaxf(m_reg, pmax); alpha = __builtin_amdgcn_exp2f(m_reg - mn); m_reg = mn; }
      typedef float f32x2v __attribute__((ext_vector_type(2)));
      const float off = cb - (mn - 6.f); const f32x2v off2 = {off, off}; f32x2v ps2 = {0.f, 0.f};
#pragma unroll
      for (int r = 0; r < 16; r += 2) {
        f32x2v a = (f32x2v){p0[r], p0[r + 1]} + off2, c2 = (f32x2v){p1[r], p1[r + 1]} + off2;
        p0[r] = __builtin_amdgcn_exp2f(a.x); p0[r + 1] = __builtin_amdgcn_exp2f(a.y); p1[r] = __builtin_amdgcn_exp2f(c2.x); p1[r + 1] = __builtin_amdgcn_exp2f(c2.y);
        ps2 += (f32x2v){p0[r], p0[r + 1]}; ps2 += (f32x2v){p1[r], p1[r + 1]}; }
      float ps = ps2.x + ps2.y;
      { auto rr = __builtin_amdgcn_permlane32_swap(__float_as_uint(ps), __float_as_uint(ps), false, false); ps = __uint_as_float(rr[0]) + __uint_as_float(rr[1]); }
      l_reg = l_reg * alpha + ps;
      v8i pa;
#pragma unroll
      for (int g = 0; g < 4; ++g) { unsigned x = 0u, y = 0u;
        x = __builtin_amdgcn_cvt_pk_fp8_f32(p0[4 * g], p0[4 * g + 1], x, false); x = __builtin_amdgcn_cvt_pk_fp8_f32(p0[4 * g + 2], p0[4 * g + 3], x, true);
        y = __builtin_amdgcn_cvt_pk_fp8_f32(p1[4 * g], p1[4 * g + 1], y, false); y = __builtin_amdgcn_cvt_pk_fp8_f32(p1[4 * g + 2], p1[4 * g + 3], y, true);
        auto rr = __builtin_amdgcn_permlane32_swap(x, y, false, false); pa[2 * g] = (int)rr[0]; pa[2 * g + 1] = (int)rr[1]; }
      if (__any(alpha < 1.f)) { if (hi == 0) al_l[r32] = alpha; asm volatile("s_waitcnt lgkmcnt(0)" ::: "memory");
#pragma unroll
        for (int d = 0; d < 8; ++d)
#pragma unroll
          for (int r = 0; r < 16; ++r) o[d][r] *= al_l[crow(r, hi)]; }
      const LAS char* Vs = lds + s * STAGE + ST_K;
#define A3_RD(D0, V) do { V = cat8(*(const LAS v4i*)(Vs + (D0) * 2048 + voff0), *(const LAS v4i*)(Vs + (D0) * 2048 + voff1)); } while (0)
#define A3_MM(D0, V) asm volatile("v_mfma_scale_f32_32x32x64_f8f6f4 %0, %1, %2, %0, %3, %4 op_sel_hi:[0,0,0]" : "+v"(o[D0]) : "v"(pa), "v"(V), "v"(sclP), "v"(scl1))
      v8i va, vb;
      A3_RD(0, va);
      A3_RD(1, vb); A3_MM(0, va);
      A3_RD(2, va); A3_MM(1, vb);
      A3_RD(3, vb); A3_MM(2, va);
      A3_RD(4, va); A3_MM(3, vb);
      A3_RD(5, vb); A3_MM(4, va);
      A3_RD(6, va); A3_MM(5, vb);
      A3_RD(7, vb); A3_MM(6, va);
      A3_MM(7, vb);
    }
    s = (s + 1) & 3;
  }
  asm volatile("s_nop 15\n s_nop 15" ::: "memory");
  if (hi == 0) li_l[r32] = l_reg; asm volatile("s_waitcnt lgkmcnt(0)" ::: "memory");
  float rli[16];
#pragma unroll
  for (int r = 0; r < 16; ++r) rli[r] = 64.f * __builtin_amdgcn_rcpf(li_l[crow(r, hi)]);
  float* Ow = Obuf + (size_t)(qrow0 - orow0) * 3072 + (h * 2 + m) * 256;
#pragma unroll
  for (int r = 0; r < 16; ++r) { const int orow = crow(r, hi);
#pragma unroll
    for (int d0 = 0; d0 < 8; ++d0) Ow[(size_t)orow * 3072 + d0 * 32 + r32] = o[d0][r] * rli[r]; }
  if (hi == 0) { float* mlp = ML + (((size_t)(qrow0 - orow0 + r32) * 6 + h) * 2 + m) * 2; mlp[0] = m_reg; mlp[1] = l_reg * (1.f / 64.f); }
  asm volatile("s_waitcnt vmcnt(0) lgkmcnt(0)" ::: "memory");
  __builtin_amdgcn_s_barrier(); asm volatile("" ::: "memory");
#undef A3_ISSUE
#undef A3_RD
#undef A3_MM
}
}

__device__ __forceinline__ void diffattn2_unit(Frame& F, const Args& a, unsigned code) {
    const int h = code & 7, m = (code >> 3) & 1, b = (code >> 4) & 31, pc = code >> 9;
    float* ob = (float*)(F.ws + (pc == 2 ? WS_OP2 : WS_OP)); float* ml = (float*)(F.ws + WS_ML) + (pc == 2 ? (size_t)T * 6 * 2 * 2 : 0);
    const int nt = 4 * b + 4, t_lo = (pc == 2) ? nt / 2 : 0, t_hi = (pc == 1) ? nt / 2 : nt;
    att3::diff_unit(F.ws + WS_ZQ, F.ws + WS_KD, F.ws + WS_VD, ob, pc == 2 ? 4096 : 0, ml, a.in[I_RELB], h, m, b, t_lo, t_hi, (LAS char*)F.lds);
}
__device__ __forceinline__ void diffcombine_phase(Frame& F, const Args& a, int l) {
    const int i = l - 2; const float* lp = a.in[I_BLAM] + (size_t)i * 4 * 128;
    float s1 = lp[F.lane] * lp[128 + F.lane] + lp[64 + F.lane] * lp[128 + 64 + F.lane], s2 = lp[256 + F.lane] * lp[384 + F.lane] + lp[256 + 64 + F.lane] * lp[384 + 64 + F.lane];
    s1 = wave_sum(s1); s2 = wave_sum(s2);
    const float lam_init = 0.8f - 0.6f * expf(-0.3f * (float)l);
    const float lam = expf(s1) - expf(s2) + lam_init;
    const float* op0 = (const float*)(F.ws + WS_OP); const float* op1 = (const float*)(F.ws + WS_OP2); const float* ml0 = (const float*)(F.ws + WS_ML); const float* ml1 = ml0 + (size_t)T * 6 * 2 * 2;
    bf16* cat = (bf16*)(F.ws + WS_CAT);
    const f32x4 gsub = *(const GAS f32x4*)(a.in[I_BSUBG] + (size_t)i * 256 + 4 * F.lane);
    const int gw = F.c * NWAVES + F.wave, NGW = F.G * NWAVES;
    for (int it = gw; it < T * 6; it += NGW) { const int tk = it / 6, h = it - tk * 6; f32x4 os[2];
#pragma unroll
        for (int m = 0; m < 2; ++m) { const size_t r0 = ((size_t)tk * 6 + h) * 2 + m; f32x4 oa = *(const GAS f32x4*)(op0 + r0 * 256 + 4 * F.lane);
            if (tk >= 4096) { const size_t r1 = ((size_t)(tk - 4096) * 6 + h) * 2 + m; const f32x4 ob = *(const GAS f32x4*)(op1 + r1 * 256 + 4 * F.lane);
                const float ma = ml0[r0 * 2], la = ml0[r0 * 2 + 1], mb = ml1[r1 * 2], lb = ml1[r1 * 2 + 1], M = fmaxf(ma, mb);
                const float wa = la * exp2f(ma - M), wb = lb * exp2f(mb - M), inv = 1.f / (wa + wb); oa = oa * (wa * inv) + ob * (wb * inv); }
            os[m] = oa; }
        const f32x4 o = os[0] - os[1] * lam; const float ss = wave_sum((o.x * o.x + o.y * o.y) + (o.z * o.z + o.w * o.w));
        const float r = (1.f - lam_init) / sqrtf(ss * (1.f / 256.f) + LN_EPS);
        v2u w; w.x = pk2(o.x * r * gsub.x, o.y * r * gsub.y); w.y = pk2(o.z * r * gsub.z, o.w * r * gsub.w);
        if (!F8OL(l)) *(GAS v2u*)(cat + (size_t)tk * D + h * 256 + 4 * F.lane) = w;
        { unsigned q8 = 0u; q8 = __builtin_amdgcn_cvt_pk_fp8_f32(o.x * r * gsub.x, o.y * r * gsub.y, q8, false); q8 = __builtin_amdgcn_cvt_pk_fp8_f32(o.z * r * gsub.z, o.w * r * gsub.w, q8, true);
          *(GAS unsigned*)(F.ws + WS_CATQ + (size_t)tk * D + h * 256 + 4 * F.lane) = q8; } }
    { const long nthr = (long)F.G * 512, gt = (long)F.c * 512 + F.tid;
      for (long i2 = gt; i2 < (long)T * 64; i2 += nthr) { const long tk = i2 >> 6; const int c8 = (int)(i2 & 63) * 8; const v4u w = *(const GAS v4u*)(cat + tk * D + MIXW + c8);
          unsigned lo = 0u, hi = 0u; lo = __builtin_amdgcn_cvt_pk_fp8_f32(bflo(w.x), bfhi(w.x), lo, false); lo = __builtin_amdgcn_cvt_pk_fp8_f32(bflo(w.y), bfhi(w.y), lo, true);
          hi = __builtin_amdgcn_cvt_pk_fp8_f32(bflo(w.z), bfhi(w.z), hi, false); hi = __builtin_amdgcn_cvt_pk_fp8_f32(bflo(w.w), bfhi(w.w), hi, true);
          v2u qq; qq.x = lo; qq.y = hi; *(GAS v2u*)(F.ws + WS_CATQ + tk * D + MIXW + c8) = qq; } }
}


__device__ __forceinline__ void ln1_router_phase(Frame& F, const Args& a, int l, int probe = 0) {
    const bf16* y = (const bf16*)(F.ws + WS_Y); bf16* x1b = (bf16*)(F.ws + WS_X1B);
    const float* lng = a.in[I_LNG] + ((size_t)l * 2 + 0) * D; const float* lnb = a.in[I_LNB] + ((size_t)l * 2 + 0) * D;
    const float* wr = (const float*)(F.ws + WS_WR) + (size_t)l * 3 * 512 * 16 * 4;
    int* tok_e = (int*)(F.ws + (probe ? WS_OP : WS_ROUTE)); int* tok_rank = tok_e + 2 * T; float* tok_gate = (float*)(tok_rank + 2 * T);
    gu32* cnt = F.ctl + (probe ? 65536 : CW_CNT) + 2048 * l;
    LAS float* P = (LAS float*)(F.lds);
    constexpr int X1ROW = 2 * D + 16;
    typedef float f32x4v __attribute__((ext_vector_type(4)));
    for (int tb = F.c; tb < T / 32; tb += F.G) {
#pragma unroll 2
        for (int i = 0; i < 4; ++i) { const int tk = tb * 32 + F.wave * 4 + i;
            const GAS v4u* yr = (const GAS v4u*)(y + (size_t)tk * D) + F.lane;
            float v[4][8]; float s = 0.f;
#pragma unroll
            for (int j = 0; j < 4; ++j) { const v4u w = yr[64 * j]; v[j][0] = bflo(w.x); v[j][1] = bfhi(w.x); v[j][2] = bflo(w.y); v[j][3] = bfhi(w.y); v[j][4] = bflo(w.z); v[j][5] = bfhi(w.z); v[j][6] = bflo(w.w); v[j][7] = bfhi(w.w);
#pragma unroll
                for (int e = 0; e < 8; ++e) s += v[j][e]; }
            const float mean = wave_sum(s) * (1.f / D); float s2 = 0.f;
#pragma unroll
            for (int j = 0; j < 4; ++j)
#pragma unroll
                for (int e = 0; e < 8; ++e) { v[j][e] -= mean; s2 += v[j][e] * v[j][e]; }
            const float rstd = 1.f / sqrtf(wave_sum(s2) * (1.f / D) + LN_EPS);
#pragma unroll
            for (int j = 0; j < 4; ++j) { const int d0 = 8 * F.lane + 512 * j; const f32x4 g0 = *(const GAS f32x4*)(lng + d0), g1 = *(const GAS f32x4*)(lng + d0 + 4), b0 = *(const GAS f32x4*)(lnb + d0), b1 = *(const GAS f32x4*)(lnb + d0 + 4);
                const float q0 = v[j][0] * rstd * g0.x + b0.x, q1 = v[j][1] * rstd * g0.y + b0.y, q2 = v[j][2] * rstd * g0.z + b0.z, q3 = v[j][3] * rstd * g0.w + b0.w;
                const float q4 = v[j][4] * rstd * g1.x + b1.x, q5 = v[j][5] * rstd * g1.y + b1.y, q6 = v[j][6] * rstd * g1.z + b1.z, q7 = v[j][7] * rstd * g1.w + b1.w;
                v4u w; w.x = pk2(q0, q1); w.y = pk2(q2, q3); w.z = pk2(q4, q5); w.w = pk2(q6, q7);
                *(GAS v4u*)(x1b + (size_t)tk * D + d0) = w;
                *(LAS v4u*)(F.lds + RING_OFF + (F.wave * 4 + i) * X1ROW + d0 * 2) = w;
                unsigned lo = 0u, hi = 0u; lo = __builtin_amdgcn_cvt_pk_fp8_f32(q0, q1, lo, false); lo = __builtin_amdgcn_cvt_pk_fp8_f32(q2, q3, lo, true);
                hi = __builtin_amdgcn_cvt_pk_fp8_f32(q4, q5, hi, false); hi = __builtin_amdgcn_cvt_pk_fp8_f32(q6, q7, hi, true);
                v2u qq; qq.x = lo; qq.y = hi; *(GAS v2u*)((unsigned char*)(F.ws + WS_X1F) + (size_t)tk * D + d0) = qq; } }
        __syncthreads();
        { const int mt = F.wave >> 2, kq = F.wave & 3, c = F.lane & 15, q = F.lane >> 4;
          const LAS unsigned char* ap = F.lds + RING_OFF + (mt * 16 + c) * X1ROW + (kq * 512 + 4 * q) * 2;
          const float* bp = wr + ((size_t)(kq * 128 + q) * 16 + c) * 4;
          f32x4v acc[3] = {{0.f, 0.f, 0.f, 0.f}, {0.f, 0.f, 0.f, 0.f}, {0.f, 0.f, 0.f, 0.f}};
#pragma unroll 8
          for (int ks = 0; ks < 32; ++ks) { const v2u aw = *(const LAS v2u*)(ap + 32 * ks); const f32x4 a4 = (f32x4){bflo(aw.x), bfhi(aw.x), bflo(aw.y), bfhi(aw.y)}; f32x4 b4[3];
#pragma unroll
              for (int nb = 0; nb < 3; ++nb) b4[nb] = *(const GAS f32x4*)(bp + ((size_t)nb * 512 + 4 * ks) * 64);
#pragma unroll
              for (int j = 0; j < 4; ++j)
#pragma unroll
                  for (int nb = 0; nb < 3; ++nb) acc[nb] = __builtin_amdgcn_mfma_f32_16x16x4f32(a4[j], b4[nb][j], acc[nb], 0, 0, 0); }
          __syncthreads();
#pragma unroll
          for (int nb = 0; nb < 3; ++nb)
#pragma unroll
              for (int r = 0; r < 4; ++r) P[((kq * 2 + mt) * 16 + 4 * q + r) * 48 + nb * 16 + c] = acc[nb][r]; }
        __syncthreads();
        if (F.tid < 64) { const int tsel = F.tid & 31, tk = tb * 32 + tsel, mt = tsel >> 4, ti = tsel & 15;
            const LAS f32x4* P4 = (const LAS f32x4*)P;
            const int rb = (mt * 16 + ti) * 12;
            const float* bg1 = a.in[I_BG1] + l * 4; const float* bg2 = a.in[I_BG2] + l * 32;
            const f32x4 s1 = (P4[rb] + P4[rb + 384]) + (P4[rb + 768] + P4[rb + 1152]);
            const float l10 = s1.x + bg1[0], l11 = s1.y + bg1[1], l12 = s1.z + bg1[2], l13 = s1.w + bg1[3];
            int grp = 0; float mx = l10;
            if (l11 > mx) { mx = l11; grp = 1; } if (l12 > mx) { mx = l12; grp = 2; } if (l13 > mx) { mx = l13; grp = 3; }
            const float psel = 1.f / (expf(l10 - mx) + expf(l11 - mx) + expf(l12 - mx) + expf(l13 - mx));
            const int ob = rb + 1 + 2 * grp;
            const f32x4 sa = (P4[ob] + P4[ob + 384]) + (P4[ob + 768] + P4[ob + 1152]), sb = (P4[ob + 1] + P4[ob + 385]) + (P4[ob + 769] + P4[ob + 1153]);
            const f32x4 ba = *(const GAS f32x4*)(bg2 + grp * 8), bb = *(const GAS f32x4*)(bg2 + grp * 8 + 4);
            const float l2[8] = {sa.x + ba.x, sa.y + ba.y, sa.z + ba.z, sa.w + ba.w, sb.x + bb.x, sb.y + bb.y, sb.z + bb.z, sb.w + bb.w};
            int i0 = 0; float v0 = l2[0];
#pragma unroll
            for (int e = 1; e < 8; ++e) if (l2[e] > v0) { v0 = l2[e]; i0 = e; }
            int i1 = -1; float v1 = -INFINITY;
#pragma unroll
            for (int e = 0; e < 8; ++e) if (e != i0 && l2[e] > v1) { v1 = l2[e]; i1 = e; }
            const float e1 = expf(v1 - v0), g0 = psel / (1.f + e1), g1 = psel * e1 / (1.f + e1);
            const int ex0 = grp * 8 + i0, ex1 = grp * 8 + i1;
            const int which = F.lane >> 5, ex = which ? ex1 : ex0; const float gg = which ? g1 : g0;
            int leader = F.lane, idx = 0, gcount = 1;
            { unsigned long long rem = ~0ull;
              while (rem) { const int l0 = __builtin_ctzll(rem); const int le = __builtin_amdgcn_readlane(ex, l0); const unsigned long long mm = __ballot(ex == le);
                  if (ex == le) { leader = l0; idx = __builtin_popcountll(mm & ((1ull << F.lane) - 1ull)); gcount = __builtin_popcountll(mm); }
                  rem &= ~mm; } }
            unsigned base = 0u; if (F.lane == leader) base = __hip_atomic_fetch_add(cnt + 64 * ex, (unsigned)gcount, RLX_AGENT);
            base = (unsigned)__shfl((int)base, leader);
            const int rk = (int)base + idx;
            { int* list = (int*)(F.ws + (probe ? WS_OP + 2 * MiB : WS_LIST)); list[ex * 8192 + rk] = tk; }
            tok_e[2 * tk + which] = ex; tok_rank[2 * tk + which] = rk; tok_gate[2 * tk + which] = gg; }
        __syncthreads();
    }
}
__device__ __forceinline__ void moe_table(Frame& F, int l) {
    LAS int* tstart = (LAS int*)(F.lds + TAB_OFF);
    if (F.tid < 64) {
        const int e = F.lane & 31;
        const unsigned c = __hip_atomic_load(F.ctl + CW_CNT + 2048 * l + 64 * e, RLX_AGENT);
        const int tiles = (int)((c + 255u) >> 8); int incl = tiles;
#pragma unroll
        for (int d = 1; d < 32; d <<= 1) { const int v = __shfl_up(incl, d, 32); if (e >= d) incl += v; }
        if (F.lane < 32) { tstart[e] = incl - tiles; tstart[36 + e] = (int)c; if (e == 31) tstart[32] = incl; }
    }
    __syncthreads();
}
__device__ __forceinline__ void ln2_phase(Frame& F, const Args& a, int l) {
    const bf16* x1b = (const bf16*)(F.ws + WS_X1B); const unsigned char* yb8 = F.ws + WS_YB; bf16* xb = (bf16*)(F.ws + WS_XB);
    const float* lng = a.in[I_LNG] + ((size_t)l * 2 + 1) * D; const float* lnb = a.in[I_LNB] + ((size_t)l * 2 + 1) * D;
    moe_table(F, l); const LAS int* tstart = (const LAS int*)(F.lds + TAB_OFF);
    const int* tok_e = (const int*)(F.ws + WS_ROUTE); const int* tok_rank = tok_e + 2 * T; const float* tok_gate = (const float*)(F.ws + WS_ROUTE) + 4 * T;
    const int gw = F.c * NWAVES + F.wave, NGW = F.G * NWAVES;
    for (int t4 = gw; t4 < T / 4; t4 += NGW) { const int tk0 = t4 * 4;
        int ev = 0, rv = 0; float gv = 0.f;
        if (F.lane < 8) { ev = tok_e[2 * tk0 + F.lane]; rv = tok_rank[2 * tk0 + F.lane]; gv = tok_gate[2 * tk0 + F.lane]; }
        const int slotv = (F.lane < 8) ? tstart[ev] * 256 + rv : 0;
        v4u xr[2], xr2[2]; v2u ya[2], yc[2], ya2[2], yc2[2];
#define LN2_LOAD(i, XR, YA, YC, XR2, YA2, YC2) do { const int s0_ = __builtin_amdgcn_readlane(slotv, 2 * (i)), s1_ = __builtin_amdgcn_readlane(slotv, 2 * (i) + 1); \
        _Pragma("unroll") for (int j = 0; j < 2; ++j) { const int d0 = 8 * F.lane + 512 * j; XR[j] = *(const GAS v4u*)(x1b + (size_t)(tk0 + (i)) * D + d0); YA[j] = *(const GAS v2u*)(yb8 + (size_t)s0_ * D + d0); YC[j] = *(const GAS v2u*)(yb8 + (size_t)s1_ * D + d0); } \
        _Pragma("unroll") for (int j = 0; j < 2; ++j) { const int d0 = 8 * F.lane + 512 * (j + 2); XR2[j] = *(const GAS v4u*)(x1b + (size_t)(tk0 + (i)) * D + d0); YA2[j] = *(const GAS v2u*)(yb8 + (size_t)s0_ * D + d0); YC2[j] = *(const GAS v2u*)(yb8 + (size_t)s1_ * D + d0); } } while (0)
        LN2_LOAD(0, xr, ya, yc, xr2, ya2, yc2);
#pragma unroll
        for (int i = 0; i < 4; ++i) { const int tk = tk0 + i;
            const float g0 = (1.f / 16.f) * __builtin_bit_cast(float, __builtin_amdgcn_readlane(__builtin_bit_cast(int, gv), 2 * i)), g1 = (1.f / 16.f) * __builtin_bit_cast(float, __builtin_amdgcn_readlane(__builtin_bit_cast(int, gv), 2 * i + 1));
            float v[4][8]; float s = 0.f;
#pragma unroll
            for (int j = 0; j < 4; ++j) { const v4u X = j < 2 ? xr[j] : xr2[j - 2]; const v2u A = j < 2 ? ya[j] : ya2[j - 2], C = j < 2 ? yc[j] : yc2[j - 2];
#define Y8(W, B) __builtin_amdgcn_cvt_f32_fp8((int)(W), (B))
                v[j][0] = bflo(X.x) * DN_ALPHA + (g0 * Y8(A.x, 0) + g1 * Y8(C.x, 0)); v[j][1] = bfhi(X.x) * DN_ALPHA + (g0 * Y8(A.x, 1) + g1 * Y8(C.x, 1));
                v[j][2] = bflo(X.y) * DN_ALPHA + (g0 * Y8(A.x, 2) + g1 * Y8(C.x, 2)); v[j][3] = bfhi(X.y) * DN_ALPHA + (g0 * Y8(A.x, 3) + g1 * Y8(C.x, 3));
                v[j][4] = bflo(X.z) * DN_ALPHA + (g0 * Y8(A.y, 0) + g1 * Y8(C.y, 0)); v[j][5] = bfhi(X.z) * DN_ALPHA + (g0 * Y8(A.y, 1) + g1 * Y8(C.y, 1));
                v[j][6] = bflo(X.w) * DN_ALPHA + (g0 * Y8(A.y, 2) + g1 * Y8(C.y, 2)); v[j][7] = bfhi(X.w) * DN_ALPHA + (g0 * Y8(A.y, 3) + g1 * Y8(C.y, 3));
#undef Y8
#pragma unroll
                for (int e = 0; e < 8; ++e) s += v[j][e]; }
            if (i + 1 < 4) LN2_LOAD(i + 1, xr, ya, yc, xr2, ya2, yc2);
            const float mean = wave_sum(s) * (1.f / D); float s2 = 0.f;
#pragma unroll
            for (int j = 0; j < 4; ++j)
#pragma unroll
                for (int e = 0; e < 8; ++e) { v[j][e] -= mean; s2 += v[j][e] * v[j][e]; }
            const float rstd = 1.f / sqrtf(wave_sum(s2) * (1.f / D) + LN_EPS);
#pragma unroll
            for (int j = 0; j < 4; ++j) { const int d0 = 8 * F.lane + 512 * j; const f32x4 g0v = *(const GAS f32x4*)(lng + d0), g1v = *(const GAS f32x4*)(lng + d0 + 4), b0 = *(const GAS f32x4*)(lnb + d0), b1 = *(const GAS f32x4*)(lnb + d0 + 4);
                const f32x4 oa = (f32x4){v[j][0] * rstd * g0v.x + b0.x, v[j][1] * rstd * g0v.y + b0.y, v[j][2] * rstd * g0v.z + b0.z, v[j][3] * rstd * g0v.w + b0.w};
                const f32x4 ob = (f32x4){v[j][4] * rstd * g1v.x + b1.x, v[j][5] * rstd * g1v.y + b1.y, v[j][6] * rstd * g1v.z + b1.z, v[j][7] * rstd * g1v.w + b1.w};
                if (l == DEPTH - 1) { *(GAS f32x4*)(a.out + (size_t)tk * D + d0) = oa; *(GAS f32x4*)(a.out + (size_t)tk * D + d0 + 4) = ob; }
                else { v4u w; w.x = pk2(oa.x, oa.y); w.y = pk2(oa.z, oa.w); w.z = pk2(ob.x, ob.y); w.w = pk2(ob.z, ob.w); *(GAS v4u*)(xb + (size_t)tk * D + d0) = w;
                    unsigned lo = 0u, hi = 0u; lo = __builtin_amdgcn_cvt_pk_fp8_f32(oa.x, oa.y, lo, false); lo = __builtin_amdgcn_cvt_pk_fp8_f32(oa.z, oa.w, lo, true); hi = __builtin_amdgcn_cvt_pk_fp8_f32(ob.x, ob.y, hi, false); hi = __builtin_amdgcn_cvt_pk_fp8_f32(ob.z, ob.w, hi, true);
                    v2u qq; qq.x = lo; qq.y = hi; if (F8L(l + 1)) *(GAS v2u*)(F.ws + WS_XQ + (size_t)tk * D + d0) = qq; } }
        }
#undef LN2_LOAD
    }
}

__global__ void __launch_bounds__(NWAVES * 64, 2) fwd_kernel(Args args) {
    extern __shared__ __attribute__((aligned(16))) unsigned char lds[];
    Frame F;
    F.lds = (LAS unsigned char*)lds; F.ldsg = (char*)lds;
    F.tid = threadIdx.x; F.lane = F.tid & 63; F.wave = __builtin_amdgcn_readfirstlane(F.tid >> 6);
    F.G = gridDim.x; F.c = blockIdx.x; F.ws = args.ws; F.ctl = (gu32*)(args.ws + WS_CTL);
    volatile LAS unsigned* MISC = (volatile LAS unsigned*)(F.lds + MISC_OFF);
    for (int u = F.tid; u < (LDS_BYTES - LDSCTL_OFF) / 4; u += NWAVES * 64) ((LAS unsigned*)(F.lds + LDSCTL_OFF))[u] = 0u;
    __syncthreads();
    const int lo = args.ph_lo, hi = args.ph_hi; int lastp = -1;
    const bool multi = (hi - lo) > 1;
    XcdBarrier bar; bar.bar = (unsigned*)(F.ctl + CW_BAR); bar.x = 0; bar.st = nullptr;
    if (multi) bar = xcd_barrier_post((unsigned*)(F.ctl + CW_BAR), MISC + 8);
#ifndef REP_MASK
#define REP_MASK 0
#endif
#define REP(k) for (int rep_ = 0; rep_ <= ((REP_MASK >> (k)) & 1); ++rep_)
#define IN(p) (lo <= (p) && (p) < hi)
#ifdef PROBE_A
#define STAMP(i) do { if (blockIdx.x == 0 && threadIdx.x == 0) ((unsigned long long*)(args.ws + WS_TS))[(i)] = __builtin_amdgcn_s_memrealtime(); } while (0)
#else
#define STAMP(i) do { } while (0)
#endif
#define SEAM(p) do { lastp = (p); if ((p) + 1 < hi) xcd_barrier(bar); STAMP((p) + 1); } while (0)
#define CONVFIN() ((lastp >= 0) ? (int)__hip_atomic_load(F.ctl + CW_FIN + 64 * lastp, RLX_AGENT) : 0)
#define FRESH() do { int t_ = threadIdx.x; asm volatile("" : "+v"(t_)); F.tid = t_; F.lane = t_ & 63; F.wave = __builtin_amdgcn_readfirstlane(t_ >> 6); \
    GAS unsigned char* w_ = (GAS unsigned char*)args.ws; asm volatile("" : "+s"(w_)); F.ws = (unsigned char*)w_; F.ctl = (gu32*)(w_ + WS_CTL); } while (0)

    STAMP(0);
    if (IN(0)) { FRESH(); REP(9) prologue_phase(F, args); SEAM(0); }
#ifdef XBAR
    for (int xb_ = 0; xb_ < XBAR; ++xb_) xcd_barrier(bar);
#endif

#pragma unroll 1
    for (int l_ = 0; l_ < DEPTH; ++l_) {
        const int pb = 1 + NPH_LAYER * l_;
#pragma unroll 1
        for (int k_ = 0; k_ < NPH_LAYER; ++k_) {
            const int p = pb + k_;
            if (!IN(p) || k_ == 5 || (k_ == 2 && l_ < 2)) continue;
            int l = l_, k = k_; asm volatile("" : "+s"(l), "+s"(k));
            FRESH();
            int cq = NQ, cn = 0;
            switch (k) {
            case 0: {
                const int N = (l < 2) ? NINA : (l == 2 ? 5120 : 2048);
                const unsigned char* Bt = F.ws + ((l < 2) ? WS_WAIN + (size_t)l * NINA * D * 2 : (l == 2 ? WS_WBIN0 : WS_WBIN1));
                const int nu = (T / 256) * (N / 256) + (l == 0 ? 16 : 0); const bool f8 = F8L(l);
                pg8::EpiBf16X E{l < 2 ? 0 : 1, (bf16*)(F.ws + WS_Z), (bf16*)(F.ws + WS_KD), (bf16*)(F.ws + WS_VD), (bf16*)(F.ws + WS_MEMKV), nullptr, nullptr};
                if (f8) { pg8::Gemm g{nullptr, nullptr, T, N, D / 2}; pg8::DualOrder8 S; S.init(F.ws + WS_XQ, Bt, T, N, D / 2, F.G, F.c, F.ws + WS_MEMQ, F.ws + WS_WMKV, l == 0 ? 16 : 0);
                    REP(0) pg8::gemm_phase<pg8::EpiBf16X, pg8::DualOrder8, true, true>(F.lds + RING_OFF, g, S, E); }
                else { pg8::Gemm g{nullptr, nullptr, T, N, D}; pg8::DualOrder S; S.init(F.ws + WS_XB, Bt, T, N, D, F.G, F.c, F.ws + WS_MEMB, F.ws + WS_WMKV, l == 0 ? 16 : 0);
                    REP(0) pg8::gemm_phase<pg8::EpiBf16X, pg8::DualOrder, true, true>(F.lds + RING_OFF, g, S, E); }
                { const int mine = (nu - 1 - F.c) / F.G + 1, rounds = (nu + F.G - 1) / F.G; cq = 2 * l; cn = (rounds - mine) * (f8 ? (QA + 1) / 2 : QA); }
            } break;
            case 1: {
                if (l < 2) {
                    REP(1) for (int u = F.c; u < 256 + 128; u += F.G) {
                        if (u < 256) sgu_unit(F, args, l, u >> 2, u & 3);
                        else { const int r = u - 256; memattn_unit(F, l, r & 3, r >> 2, NINA, 2 * MIXW); }
                    }
                    if (F.c >= 128) { cq = 2 * l; cn = QX; }
                } else {
                    const int ncv = CONVFIN() ? 0 : NCVATT;
                    if (F.c >= F.G - ncv) { conv_server_q(F, args, F.ctl + CW_Q + 64 * l, (unsigned)(att2::NUNITS + 128 - STOPU), 2 * l); __syncthreads(); }
                    REP(2) { gu32* qh = F.ctl + CW_Q + 64 * l + 16 * rep_; LAS unsigned* uw = (LAS unsigned*)(F.lds + att2::LDS_UNIT);
                    for (;;) {
                        if (F.tid == 0) *uw = __hip_atomic_fetch_add(qh, 1u, RLX_AGENT);
                        __syncthreads();
                        const unsigned idx = *uw;
                        __syncthreads();
                        if (idx >= (unsigned)(att2::NUNITS + 128)) break;
                        if (idx < (unsigned)att2::NUNITS) diffattn2_unit(F, args, att3::g_units.u[idx]);
                        else { const int r = (int)idx - att2::NUNITS; memattn_unit(F, l, r & 3, r >> 2, 2048, MIXW); }
                    } }
                }
            } break;
            case 2: { REP(3) diffcombine_phase(F, args, l); } break;
            case 3: {
                pg8::EpiResBf16 E{(const bf16*)(F.ws + WS_XB), (bf16*)(F.ws + WS_Y), DN_ALPHA};
                const unsigned char* Wo = F.ws + (l < 2 ? WS_WAOUT + (size_t)l * D * D * 2 : WS_WBOUT + (size_t)(l - 2) * D * D * 2);
                if (F8OL(l)) { pg8::Gemm g{nullptr, nullptr, T, D, D / 2}; pg8::DenseOrder8 S; S.init(F.ws + WS_CATQ, Wo, T, D, D / 2, F.G, F.c);
                    REP(4) pg8::gemm_phase<pg8::EpiResBf16, pg8::DenseOrder8, true, true>(F.lds + RING_OFF, g, S, E); }
                else { pg8::Gemm g{nullptr, nullptr, T, D, D}; pg8::DenseOrder S; S.init(F.ws + WS_CAT, Wo, T, D, D, F.G, F.c);
                    REP(4) pg8::gemm_phase<pg8::EpiResBf16, pg8::DenseOrder, true, true>(F.lds + RING_OFF, g, S, E); }
            } break;
            case 4: {
                ln1_router_phase(F, args, l);
#ifdef REP_LN1
                ln1_router_phase(F, args, l, 1);
#endif
                cq = 2 * l; cn = -1;
            } break;
            case 6: {
                moe_table(F, l);
                const LAS int* tb = (const LAS int*)(F.lds + TAB_OFF);
                pg8::Gemm g{nullptr, nullptr, SLOTS, 1024, D / 2};
                pg8::MoeGatherOrder S{tb, tb + 36, (const int*)(F.ws + WS_LIST), 4, F.G, F.c, (const char*)(F.ws + WS_X1F), (const char*)(F.ws + WS_W13) + (size_t)l * NE * 1024 * 2048, (size_t)1024 * 2048, (size_t)256 * 2048, (unsigned)D};
                pg8::EpiMoe1 E{(bf16*)(F.ws + WS_H), tb, tb + 36};
                REP(6) pg8::gemm_phase<pg8::EpiMoe1, pg8::MoeGatherOrder, true, true>(F.lds + RING_OFF, g, S, E);
                { const int nu = __builtin_amdgcn_readfirstlane(((const LAS int*)(F.lds + TAB_OFF))[32]) * 4, mine = (F.c < nu) ? (nu - 1 - F.c) / F.G + 1 : 0, rounds = (nu + F.G - 1) / F.G; cq = 2 * l + 1; cn = (rounds - mine) * QM; }
            } break;
            case 7: {
                moe_table(F, l);
                pg8::Gemm g{nullptr, nullptr, SLOTS, D, FF / 2};
                pg8::MoeOrder8 S{(const PG8_LAS int*)(F.lds + TAB_OFF), 8, F.G, F.c, (const char*)(F.ws + WS_H), (const char*)(F.ws + WS_W2) + (size_t)l * NE * 2048 * 512, (size_t)256 * FF, (size_t)2048 * 512, (size_t)256 * 512};
                pg8::EpiBf16X E{3, (bf16*)(F.ws + WS_YB), nullptr, nullptr, nullptr, (const PG8_LAS int*)(F.lds + TAB_OFF), (const PG8_LAS int*)(F.lds + TAB_OFF) + 36};
                REP(7) pg8::gemm_phase<pg8::EpiBf16X, pg8::MoeOrder8, true, true>(F.lds + RING_OFF, g, S, E);
                { const int nu = __builtin_amdgcn_readfirstlane(((const LAS int*)(F.lds + TAB_OFF))[32]) * 8, mine = (F.c < nu) ? (nu - 1 - F.c) / F.G + 1 : 0, rounds = (nu + F.G - 1) / F.G; cq = 2 * l + 1; cn = (rounds - mine) * QB; }
            } break;
            default: {
                REP(8) ln2_phase(F, args, l);
                cq = 2 * l + 1; cn = -1;
            } break;
            }
            FRESH();
            conv_filler(F, args, cq, cn);
            if (k == 0 && l >= 2) conv_note_fin(F, p);
            SEAM(p);
        }
    }
#ifdef PROBE_A
    {
        VM_WAIT(); xcd_barrier(bar);
        const unsigned long long* ts = (const unsigned long long*)(args.ws + WS_TS);
        float da = 0.f, db = 0.f;
        for (int p = 0; p < NPHASES; ++p) { const int k = (p == 0) ? 9 : (p - 1) % NPH_LAYER; const float d = (float)(ts[p + 1] - ts[p]);
            if (k == PROBE_A || PROBE_A == 10) da += d; if (k == PROBE_B || PROBE_B == 10) db += d; }
        const float kk = sqrtf(da), vv = db;
        float* o = args.out; const long n = (long)T * D;
        for (long i = (long)blockIdx.x * 512 + threadIdx.x; i < n; i += (long)gridDim.x * 512) o[i] = (i == 0) ? vv : kk;
    }
#endif
#undef IN
#undef SEAM
}

#ifndef MK_ONE_LAUNCH
#define MK_ONE_LAUNCH 1
#endif
extern "C" void kernel_launch(void* const* d_in, const int* in_sizes, int n_in, void* d_out, int out_size, void* d_ws, size_t ws_size, hipStream_t stream) {
    static int grid = 0;
    if (grid == 0) {
        if (n_in != 24 || in_sizes[0] != T * D || out_size != T * D || ws_size < WS_END) { fprintf(stderr, "kernel_launch: unexpected shapes (n_in %d, in0 %d, out %d, ws %zu < %zu)\n", n_in, n_in > 0 ? in_sizes[0] : -1, out_size, ws_size, (size_t)WS_END); grid = -1; return; }
        int dev = 0, cus = 0, per_cu = 0;
        if (hipGetDevice(&dev) != hipSuccess || hipDeviceGetAttribute(&cus, hipDeviceAttributeMultiprocessorCount, dev) != hipSuccess) { grid = -1; return; }
        if (hipFuncSetAttribute((const void*)fwd_kernel, hipFuncAttributeMaxDynamicSharedMemorySize, LDS_BYTES) != hipSuccess) { fprintf(stderr, "kernel_launch: hipFuncSetAttribute failed\n"); grid = -1; return; }
        if (hipOccupancyMaxActiveBlocksPerMultiprocessor(&per_cu, (const void*)fwd_kernel, NWAVES * 64, LDS_BYTES) != hipSuccess || per_cu < 1) fprintf(stderr, "kernel_launch: occupancy query reports %d\n", per_cu);
        (void)hipGetLastError();
        grid = cus;
    }
    if (grid < 0) return;
    if (hipMemsetAsync((char*)d_ws + WS_CTL, 0, CTL_ZERO_BYTES, stream) != hipSuccess) return;
    Args a{};
    for (int i = 0; i < 24; ++i) a.in[i] = (const float*)d_in[i];
    a.out = (float*)d_out; a.ws = (unsigned char*)d_ws;
#if MK_ONE_LAUNCH
    a.ph_lo = 0; a.ph_hi = NPHASES;
    hipLaunchKernelGGL(fwd_kernel, dim3(grid), dim3(NWAVES * 64), LDS_BYTES, stream, a);
#else
    for (int p = 0; p < NPHASES; ++p) {
        const int k = (p - 1) % NPH_LAYER, l = (p - 1) / NPH_LAYER;
        if (p > 0 && k == 2 && l < 2) continue;
        a.ph_lo = p; a.ph_hi = p + 1;
        hipLaunchKernelGGL(fwd_kernel, dim3(grid), dim3(NWAVES * 64), LDS_BYTES, stream, a);
    }
#endif
    const hipError_t le = hipPeekAtLastError();
    if (le != hipSuccess) fprintf(stderr, "kernel_launch: launch failed: %s\n", hipGetErrorName(le));
}
```

```cpp
#define F8MASK 14
#define F8OMASK 12
#include <hip/hip_runtime.h>
#include <cstdio>
#include <cstdint>
namespace pg8 {
#define PG8_LAS __attribute__((address_space(3)))
typedef unsigned short bf16_t;
typedef short bf16x8 __attribute__((ext_vector_type(8)));
typedef float f32x4 __attribute__((ext_vector_type(4)));
typedef unsigned u32x4 __attribute__((ext_vector_type(4)));
constexpr int BM = 256, BK = 64, HALF = 128, HTB = HALF * BK * 2  , STAGE_BYTES = 8 * HTB, NXCD = 8, WGM = 8;

__host__ __device__ __forceinline__ int lds_byte(int r, int c) { const int st = (r >> 4) * 2 + (c >> 5), rr = r & 15, cc = c & 31, ob = rr * 64 + cc * 2; return st * 1024 + (ob ^ (((ob >> 9) & 1) << 5)); }
__host__ __device__ __forceinline__ void stage_rc(int b, int& R, int& C) { const int st = b / 1024, sb = b % 1024, swz = sb ^ (((sb >> 9) & 1) << 5); R = (st >> 1) * 16 + swz / 64; C = (st & 1) * 32 + (swz % 64) / 2; }
__host__ __device__ __forceinline__ int perm32(int rho) { const int n = rho >> 4, i = rho & 15; return 8 * (i >> 2) + 4 * n + (i & 3); }

typedef int pg8_v4i __attribute__((ext_vector_type(4))); typedef int pg8_v8i __attribute__((ext_vector_type(8)));
__device__ __forceinline__ pg8_v8i pg8_cat8(bf16x8 a, bf16x8 b) { return __builtin_shufflevector(__builtin_bit_cast(pg8_v4i, a), __builtin_bit_cast(pg8_v4i, b), 0, 1, 2, 3, 4, 5, 6, 7); }
struct Unit { int pm, pn, e, full; };
struct Gemm { const bf16_t* A; const bf16_t* Bt; int M, N, K; };

struct StaticOrder {
    static constexpr bool GATHER = false, SHORT = false, F8 = false; static constexpr int SCALE_B = 127;
    int nM, nN, nwg, G, c;
    __host__ __device__ void init(int M, int N, int G_, int c_) { nM = M / BM; nN = N / BM; nwg = nM * nN; G = G_; c = c_; }
    __host__ __device__ bool next(int i, Unit& u) const {
        const long L = (long)i * G + c; if (L >= nwg) return false;
        int wgid = (int)L; { const int q = nwg / NXCD, r = nwg % NXCD, xcd = wgid % NXCD, off = wgid / NXCD; wgid = (xcd < r ? xcd * (q + 1) : r * (q + 1) + (xcd - r) * q) + off; }
        const int nig = WGM * nN, gid = wgid / nig, fm = gid * WGM, gsz = (nM - fm) < WGM ? (nM - fm) : WGM;
        u.pm = fm + ((wgid % nig) % gsz); u.pn = (wgid % nig) / gsz; return true;
    }
    __device__ __forceinline__ void a_ready(const Unit&) const {}
    __device__ __forceinline__ void done(const Unit&) const {}
};

__device__ __forceinline__ unsigned cvt_pk_bf16(float lo, float hi) { unsigned r; asm volatile("v_cvt_pk_bf16_f32 %0, %1, %2" : "=v"(r) : "v"(lo), "v"(hi)); return r; }
typedef float f32x2 __attribute__((ext_vector_type(2)));
__device__ __forceinline__ f32x2 gelu_pk(f32x2 v) {
    const f32x2 av = __builtin_elementwise_abs(v), d = av * 0.2316418882f + 1.0f;
    f32x2 t; t.x = __builtin_amdgcn_rcpf(d.x); t.y = __builtin_amdgcn_rcpf(d.y);
    f32x2 q = t * 0.5307027145f + (-0.7265760135f); q = q * t + 0.7107068705f; q = q * t + (-0.142248368f); q = q * t + 0.127414796f; q = q * t;
    const f32x2 s = (v * v) * (-0.72134752044f);
    f32x2 e; e.x = __builtin_amdgcn_exp2f(s.x); e.y = __builtin_amdgcn_exp2f(s.y);
    const f32x2 m = v * (q * e), r = v - m;
    f32x2 o; o.x = v.x < 0.f ? m.x : r.x; o.y = v.y < 0.f ? m.y : r.y; return o;
}

template <class Epi, class Sched, bool ALIGN_EPI = false, bool SP2 = false>
__device__ __forceinline__ void gemm_phase(PG8_LAS unsigned char* lds, const Gemm g, const Sched& S, const Epi& E) {
    int tid_ = threadIdx.x; asm volatile("" : "+v"(tid_));
    const int tid = tid_, wid = __builtin_amdgcn_readfirstlane(tid >> 6), lane = tid & 63, wr = wid >> 2, wc = wid & 3, fr = lane & 15, fq = lane >> 4;
    const int K = g.K, nt = K / BK;
    unsigned voffA[2], voffB[2];
#pragma unroll
    for (int i = 0; i < 2; ++i) { int R, C; stage_rc(tid * 16 + i * 8192, R, C); const int Rb = Epi::PERM ? ((R & ~31) + perm32(R & 31)) : R;
        voffA[i] = (unsigned)(R * K + C) * 2u; voffB[i] = (unsigned)(Rb * K + C) * 2u; }
    unsigned vAc[2][2], vAn[2][2];
    int gR[2], gC[2];
#pragma unroll
    for (int i = 0; i < 2; ++i) { stage_rc(tid * 16 + i * 8192, gR[i], gC[i]); }
    const size_t kstep = (size_t)(BK * 2);
    const size_t hstep = (size_t)HALF * K * 2;
        const unsigned ldsw = (unsigned)wid * 1024u;
    const int aoff = lds_byte(wr * 64 + fr, fq * 8), boff = lds_byte(wc * 32 + fr, fq * 8);
#define PG8_SA(b, h) (((b) * 2 + (h)) * HTB)
#define PG8_SB(b, h) ((4 + (b) * 2 + (h)) * HTB)
#define PG8_STAGE(bufoff, gbase, voff) do { _Pragma("unroll") for (int _i = 0; _i < 2; ++_i) \
        __builtin_amdgcn_global_load_lds((const unsigned*)((const char*)(gbase) + (voff)[_i]), (PG8_LAS unsigned*)(lds + (bufoff) + ldsw + _i * 8192), 16, 0, 0); } while (0)
#define PG8_STAGE_A(b, h, base, VS) do { if constexpr (Sched::GATHER) { PG8_STAGE(PG8_SA(b, h), base, VS[h]); } else { PG8_STAGE(PG8_SA(b, h), (base) + (h) * hstep, voffA); } } while (0)
#define PG8_STAGE_AN(b, h, base) do { if constexpr (Sched::GATHER) { unsigned vs_[2] = {last ? vAn[h][0] : vAc[h][0], last ? vAn[h][1] : vAc[h][1]}; PG8_STAGE(PG8_SA(b, h), base, vs_); } else { PG8_STAGE(PG8_SA(b, h), (base) + (h) * hstep, voffA); } } while (0)
#define PG8_LDA(dst, b, h) do { if constexpr (Sched::F8) { _Pragma("unroll") for (int m = 0; m < 4; ++m) { dst##8[m].lo = *(const PG8_LAS pg8_v4i*)(lds + PG8_SA(b, h) + aoff + m * 2048); dst##8[m].hi = *(const PG8_LAS pg8_v4i*)(lds + PG8_SA(b, h) + aoff + m * 2048 + 1024); } } \
        else { _Pragma("unroll") for (int m = 0; m < 4; ++m) _Pragma("unroll") for (int k = 0; k < 2; ++k) dst[m][k] = *(const PG8_LAS bf16x8*)(lds + PG8_SA(b, h) + aoff + m * 2048 + k * 1024); } } while (0)
#define PG8_LDB(dst, b, h) do { if constexpr (Sched::F8) { _Pragma("unroll") for (int n = 0; n < 2; ++n) { dst##8[n].lo = *(const PG8_LAS pg8_v4i*)(lds + PG8_SB(b, h) + boff + n * 2048); dst##8[n].hi = *(const PG8_LAS pg8_v4i*)(lds + PG8_SB(b, h) + boff + n * 2048 + 1024); } } \
        else { _Pragma("unroll") for (int n = 0; n < 2; ++n) _Pragma("unroll") for (int k = 0; k < 2; ++k) dst[n][k] = *(const PG8_LAS bf16x8*)(lds + PG8_SB(b, h) + boff + n * 2048 + k * 1024); } } while (0)
#define PG8_MMA(ai, bj, At, Bt) do { __builtin_amdgcn_s_setprio(1); if constexpr (Sched::F8) { \
        _Pragma("unroll") for (int m = 0; m < 4; ++m) _Pragma("unroll") for (int n = 0; n < 2; ++n) \
            asm volatile("v_mfma_scale_f32_16x16x128_f8f6f4 %0, %1, %2, %0, %3, %4 op_sel_hi:[0,0,0]" : "+v"(acc[ai][bj][m][n]) : "v"(Bt##8[n]), "v"(At##8[m]), "v"(sclB_), "v"(sclA_));     \
        } else { _Pragma("unroll") for (int m = 0; m < 4; ++m) _Pragma("unroll") for (int n = 0; n < 2; ++n) _Pragma("unroll") for (int k = 0; k < 2; ++k) \
        acc[ai][bj][m][n] = __builtin_amdgcn_mfma_f32_16x16x32_bf16(Bt[n][k], At[m][k], acc[ai][bj][m][n], 0, 0, 0); } __builtin_amdgcn_s_setprio(0); } while (0)
#define PG8_WAIT_V(n) asm volatile("s_waitcnt vmcnt(" #n ")" ::: "memory")
#define PG8_WAIT_L(n) asm volatile("s_waitcnt lgkmcnt(" #n ")" ::: "memory")
#define PG8_BAR __builtin_amdgcn_s_barrier()
#define PG8_SCHED __builtin_amdgcn_sched_barrier(0)
    Unit cur, nxt; int ui = 0;
    if (!S.next(0, cur)) return;
    f32x4 acc[2][2][4][2];
#pragma unroll
    for (int a = 0; a < 2; ++a)
#pragma unroll
        for (int b = 0; b < 2; ++b)
#pragma unroll
            for (int m = 0; m < 4; ++m)
#pragma unroll
                for (int n = 0; n < 2; ++n) acc[a][b][m][n] = (f32x4){0.f, 0.f, 0.f, 0.f};
    const int sclB_ = Sched::SCALE_B, sclA_ = 127;
    bool half1 = true, half0 = true; if constexpr (Sched::SHORT) { half1 = cur.full >= 2; half0 = cur.full >= 1 || wr == 0; }
    bf16x8 At[4][2], B0[2][2], B1[2][2]; pg8_v8i At8[4], B08[2], B18[2];
    const char* cA = S.aptr(cur); const char* cB = S.bptr(cur);
    S.a_ready(cur);
    if constexpr (Sched::GATHER) {
#pragma unroll
        for (int h = 0; h < 2; ++h)
#pragma unroll
            for (int i = 0; i < 2; ++i) { vAc[h][i] = S.rowoff(cur, h * HALF + gR[i]) + (unsigned)gC[i] * 2u; vAn[h][i] = vAc[h][i]; }
        asm volatile("s_waitcnt vmcnt(0)" ::: "memory");
    }
    if constexpr (SP2) {
        PG8_STAGE(PG8_SB(0, 0), cB, voffB); PG8_STAGE(PG8_SB(0, 1), cB + hstep, voffB); PG8_STAGE_A(0, 0, cA, vAc); PG8_STAGE_A(0, 1, cA, vAc);
        if (wr == 1) PG8_BAR;
        PG8_WAIT_V(2); PG8_BAR;
        PG8_STAGE(PG8_SB(1, 0), cB + kstep, voffB); PG8_STAGE_A(1, 0, cA + kstep, vAc); PG8_STAGE(PG8_SB(1, 1), cB + hstep + kstep, voffB);
        PG8_WAIT_V(6); PG8_BAR;
    } else {
        PG8_STAGE(PG8_SB(0, 0), cB, voffB); PG8_STAGE_A(0, 0, cA, vAc); PG8_STAGE(PG8_SB(0, 1), cB + hstep, voffB); PG8_STAGE_A(0, 1, cA, vAc);
        if (wr == 1) PG8_BAR;
        PG8_WAIT_V(4); PG8_BAR;
        PG8_STAGE(PG8_SB(1, 0), cB + kstep, voffB); PG8_STAGE_A(1, 0, cA + kstep, vAc); PG8_STAGE(PG8_SB(1, 1), cB + hstep + kstep, voffB);
        PG8_WAIT_V(6); PG8_BAR;
    }
    for (;;) {
        const bool has_next = S.next(ui + 1, nxt);
        const char* nA = has_next ? S.aptr(nxt) : cA; const char* nB = has_next ? S.bptr(nxt) : cB;
        if constexpr (Sched::GATHER) { if (has_next) {
#pragma unroll
            for (int h = 0; h < 2; ++h)
#pragma unroll
                for (int i = 0; i < 2; ++i) vAn[h][i] = S.rowoff(nxt, h * HALF + gR[i]) + (unsigned)gC[i] * 2u; } }
        for (int t = 0; t < nt; t += 2) {
            const bool last = (t == nt - 2);
            const char* a1 = cA + (size_t)(t + 1) * kstep;
            const char* a2 = last ? nA : cA + (size_t)(t + 2) * kstep; const char* b2 = last ? nB : cB + (size_t)(t + 2) * kstep;
            const char* a3 = a2 + kstep; const char* b3 = b2 + kstep;
            if (last && has_next) S.a_ready(nxt);
            if constexpr (SP2) {
            PG8_LDB(B0, 0, 0); PG8_LDB(B1, 0, 1); PG8_SCHED; PG8_LDA(At, 0, 0); PG8_STAGE_A(1, 1, a1, vAc);
            PG8_WAIT_V(8); PG8_WAIT_L(0); PG8_BAR; if (half0) { PG8_MMA(0, 0, At, B0); PG8_MMA(0, 1, At, B1); } PG8_BAR; PG8_SCHED;
            PG8_LDA(At, 0, 1); PG8_STAGE(PG8_SB(0, 0), b2, voffB); PG8_STAGE(PG8_SB(0, 1), b2 + hstep, voffB); PG8_STAGE_AN(0, 0, a2);
            PG8_WAIT_V(8); PG8_WAIT_L(0); PG8_BAR; if (half1) { PG8_MMA(1, 0, At, B0); PG8_MMA(1, 1, At, B1); } PG8_BAR; PG8_SCHED;
            PG8_LDB(B0, 1, 0); PG8_LDB(B1, 1, 1); PG8_SCHED; PG8_LDA(At, 1, 0); PG8_STAGE_AN(0, 1, a2);
            PG8_WAIT_V(8); PG8_WAIT_L(0); PG8_BAR; if (half0) { PG8_MMA(0, 0, At, B0); PG8_MMA(0, 1, At, B1); } PG8_BAR; PG8_SCHED;
            PG8_LDA(At, 1, 1); PG8_STAGE(PG8_SB(1, 0), b3, voffB); PG8_STAGE(PG8_SB(1, 1), b3 + hstep, voffB); PG8_STAGE_AN(1, 0, a3);
            PG8_WAIT_V(8); PG8_WAIT_L(0); PG8_BAR; if (half1) { PG8_MMA(1, 0, At, B0); PG8_MMA(1, 1, At, B1); } PG8_BAR; PG8_SCHED;
            } else {
            PG8_LDB(B0, 0, 0); PG8_SCHED; PG8_LDA(At, 0, 0); PG8_STAGE_A(1, 1, a1, vAc);
            PG8_WAIT_L(8); PG8_BAR; PG8_WAIT_L(0); PG8_MMA(0, 0, At, B0); PG8_BAR; PG8_SCHED;
            PG8_LDB(B1, 0, 1); PG8_STAGE(PG8_SB(0, 0), b2, voffB);
            PG8_BAR; PG8_WAIT_L(0); PG8_MMA(0, 1, At, B1); PG8_BAR;
            PG8_LDA(At, 0, 1); PG8_STAGE_AN(0, 0, a2);
            PG8_BAR; PG8_WAIT_L(0); PG8_MMA(1, 0, At, B0); PG8_BAR; PG8_SCHED;
            PG8_STAGE(PG8_SB(0, 1), b2 + hstep, voffB);
            PG8_WAIT_V(6); PG8_BAR; PG8_MMA(1, 1, At, B1); PG8_BAR;
            PG8_LDB(B0, 1, 0); PG8_SCHED; PG8_LDA(At, 1, 0); PG8_STAGE_AN(0, 1, a2);
            PG8_WAIT_L(8); PG8_BAR; PG8_WAIT_L(0); PG8_MMA(0, 0, At, B0); PG8_BAR; PG8_SCHED;
            PG8_LDB(B1, 1, 1); PG8_STAGE(PG8_SB(1, 0), b3, voffB);
            PG8_BAR; PG8_WAIT_L(0); PG8_MMA(0, 1, At, B1); PG8_BAR;
            PG8_LDA(At, 1, 1); PG8_STAGE_AN(1, 0, a3);
            PG8_BAR; PG8_WAIT_L(0); PG8_MMA(1, 0, At, B0); PG8_BAR; PG8_SCHED;
            PG8_STAGE(PG8_SB(1, 1), b3 + hstep, voffB);
            PG8_WAIT_V(6); PG8_BAR; PG8_MMA(1, 1, At, B1); PG8_BAR;
            }
        }
        if constexpr (ALIGN_EPI) { if (wr == 0) PG8_BAR; }
        if constexpr (!Epi::AFTER_DRAIN) { E(acc, cur, wr, wc, fr, fq); S.done(cur); }
        if (!has_next) break;
#pragma unroll
        for (int a = 0; a < 2; ++a)
#pragma unroll
            for (int b = 0; b < 2; ++b)
#pragma unroll
                for (int m = 0; m < 4; ++m)
#pragma unroll
                    for (int n = 0; n < 2; ++n) acc[a][b][m][n] = (f32x4){0.f, 0.f, 0.f, 0.f};
        cur = nxt; cA = nA; cB = nB; ++ui;
        if constexpr (Sched::SHORT) { half1 = cur.full >= 2; half0 = cur.full >= 1 || wr == 0; }
        if constexpr (Sched::GATHER) {
#pragma unroll
            for (int h = 0; h < 2; ++h)
#pragma unroll
                for (int i = 0; i < 2; ++i) vAc[h][i] = vAn[h][i]; }
        if constexpr (ALIGN_EPI) { if (wr == 1) PG8_BAR; }
    }
    PG8_WAIT_V(0);
    if constexpr (!ALIGN_EPI) { if (wr == 0) PG8_BAR; }
    PG8_BAR;
    if constexpr (Epi::AFTER_DRAIN) { E.fused(acc, cur, wr, wc, fr, fq, lds, wid, lane); S.done(cur); }
#undef PG8_SA
#undef PG8_SB
#undef PG8_STAGE
#undef PG8_STAGE_A
#undef PG8_STAGE_AN
#undef PG8_LDA
#undef PG8_LDB
#undef PG8_MMA
#undef PG8_WAIT_V
#undef PG8_WAIT_L
#undef PG8_BAR
#undef PG8_SCHED
}
}

constexpr int T = 8192, D = 2048, MIXW = 1536, MEMW = 512, NINA = 3584, DEPTH = 4, NE = 32, FF = 512, MEMT = 256;
constexpr int SLOTS = 24576;
constexpr float LN_EPS = 1e-5f;
constexpr float DN_ALPHA = 1.6817928305074292f;
constexpr float LOG2E = 1.4426950408889634f;
constexpr float QSCALE = 0.08838834764831845f * LOG2E;
constexpr int NWAVES = 8;

constexpr size_t MiB = 1u << 20;
constexpr size_t WS_CTL = 0, CTL_ZERO_BYTES = 1 * MiB;
constexpr size_t WS_WAIN = 2 * MiB, WS_WAOUT = 30 * MiB, WS_WBIN0 = 46 * MiB, WS_WKV = 54 * MiB, WS_WBIN1 = 66 * MiB, WS_WBOUT = 74 * MiB, WS_WMKV = 90 * MiB;
constexpr size_t WS_W13 = 106 * MiB, WS_W2 = 618 * MiB;
constexpr size_t WS_XB = 874 * MiB, WS_MEMB = 906 * MiB, WS_MEMKV = 907 * MiB, WS_Z = 910 * MiB, WS_KD = 966 * MiB, WS_VD = 990 * MiB, WS_CAT = 1014 * MiB;
constexpr size_t WS_VSTAT = 1270 * MiB;
constexpr size_t WS_XQ = 1206 * MiB, WS_ZQ = 1222 * MiB, WS_MEMQ = 1238 * MiB, WS_CATQ = 1246 * MiB;
constexpr size_t WS_Y = 1046 * MiB, WS_X1F = 1110 * MiB, WS_X1B = 1174 * MiB, WS_XF = 1206 * MiB, WS_XG = 1270 * MiB, WS_H = 1366 * MiB, WS_YB = 1390 * MiB, WS_OP = 1486 * MiB;
constexpr size_t WS_ROUTE = 1582 * MiB, WS_OP2 = 1583 * MiB, WS_ML = 1631 * MiB, WS_WR = 1634 * MiB, WS_TS = 1640 * MiB, WS_LIST = 1641 * MiB, WS_END = 1642 * MiB;
constexpr int CW_TMO = 0, CW_BAR = 4096, CW_CNT = 16384, CW_Q = 28672, CW_CONV = 29184, CW_DONE = 32768, CW_FIN = 40960;

constexpr int RING_OFF = 0, RING_BYTES = 131072;
constexpr int LDSCTL_OFF = 146432, MISC_OFF = LDSCTL_OFF + 320, TAB_OFF = LDSCTL_OFF + 512;
constexpr int LDS_BYTES = 147456;

#define GAS __attribute__((address_space(1)))
#define LAS __attribute__((address_space(3)))
typedef unsigned short bf16;
typedef unsigned v4u __attribute__((ext_vector_type(4)));
typedef unsigned v2u __attribute__((ext_vector_type(2)));
typedef float f32x4 __attribute__((ext_vector_type(4)));
typedef short bf16x8 __attribute__((ext_vector_type(8)));
typedef GAS unsigned gu32;
#define RLX_AGENT __ATOMIC_RELAXED, __HIP_MEMORY_SCOPE_AGENT
#define LDS_WAIT() asm volatile("s_waitcnt lgkmcnt(0)" ::: "memory")
#define VM_WAIT() asm volatile("s_waitcnt vmcnt(0)" ::: "memory")
__device__ __forceinline__ unsigned f2bf(float f) { unsigned u = __builtin_bit_cast(unsigned, f); return (u + 0x7fffu + ((u >> 16) & 1u)) >> 16; }
__device__ __forceinline__ unsigned pk2(float lo, float hi) { return f2bf(lo) | (f2bf(hi) << 16); }
__device__ __forceinline__ float bf2f(unsigned short b) { return __builtin_bit_cast(float, (unsigned)b << 16); }
__device__ __forceinline__ float bflo(unsigned w) { return __builtin_bit_cast(float, w << 16); }
__device__ __forceinline__ float bfhi(unsigned w) { return __builtin_bit_cast(float, w & 0xffff0000u); }
__device__ __forceinline__ float wave_sum(float v) {
#pragma unroll
    for (int o = 1; o < 64; o <<= 1) v += __shfl_xor(v, o);
    return v;
}

namespace pg8 {
struct DenseOrder {
    static constexpr bool GATHER = false, SHORT = false, F8 = false; static constexpr int SCALE_B = 127;
    StaticOrder so; const char* A; const char* B; size_t astep, bstep;
    __device__ void init(const void* A_, const void* B_, int M, int N, int K, int G, int c) { so.init(M, N, G, c); A = (const char*)A_; B = (const char*)B_; astep = (size_t)256 * K * 2; bstep = astep; }
    __device__ __forceinline__ bool next(int i, Unit& u) const { u.e = 0; return so.next(i, u); }
    __device__ __forceinline__ const char* aptr(const Unit& u) const { return A + (size_t)u.pm * astep; }
    __device__ __forceinline__ const char* bptr(const Unit& u) const { return B + (size_t)u.pn * bstep; }
    __device__ __forceinline__ void a_ready(const Unit&) const {}
    __device__ __forceinline__ void done(const Unit&) const {}
};
struct DenseOrder8 {
    static constexpr bool GATHER = false, SHORT = false, F8 = true; static constexpr int SCALE_B = 121;
    StaticOrder so; const char* A; const char* B; size_t astep, bstep;
    __device__ void init(const void* A_, const void* B_, int M, int N, int K, int G, int c) { so.init(M, N, G, c); A = (const char*)A_; B = (const char*)B_; astep = (size_t)256 * K * 2; bstep = astep; }
    __device__ __forceinline__ bool next(int i, Unit& u) const { u.e = 0; return so.next(i, u); }
    __device__ __forceinline__ const char* aptr(const Unit& u) const { return A + (size_t)u.pm * astep; }
    __device__ __forceinline__ const char* bptr(const Unit& u) const { return B + (size_t)u.pn * bstep; }
    __device__ __forceinline__ void a_ready(const Unit&) const {}
    __device__ __forceinline__ void done(const Unit&) const {}
};
struct DualOrder {
    static constexpr bool GATHER = false, SHORT = false, F8 = false; static constexpr int SCALE_B = 127;
    StaticOrder so; int nwg2; const char* A; const char* B; const char* A2; const char* B2; size_t step;
    __device__ void init(const void* A_, const void* B_, int M, int N, int K, int G, int c, const void* A2_, const void* B2_, int nwg2_) { so.init(M, N, G, c); A = (const char*)A_; B = (const char*)B_; A2 = (const char*)A2_; B2 = (const char*)B2_; nwg2 = nwg2_; step = (size_t)256 * K * 2; }
    __device__ __forceinline__ bool next(int i, Unit& u) const { const int L = i * so.G + so.c; if (L < so.nwg) { u.e = 0; return so.next(i, u); } if (L - so.nwg >= nwg2) return false; u.e = 1; u.pm = 0; u.pn = L - so.nwg; return true; }
    __device__ __forceinline__ const char* aptr(const Unit& u) const { return u.e ? A2 : A + (size_t)u.pm * step; }
    __device__ __forceinline__ const char* bptr(const Unit& u) const { return (u.e ? B2 : B) + (size_t)u.pn * step; }
    __device__ __forceinline__ void a_ready(const Unit&) const {}
    __device__ __forceinline__ void done(const Unit&) const {}
};
struct DualOrder8 {
    static constexpr bool GATHER = false, SHORT = false, F8 = true; static constexpr int SCALE_B = 121;
    StaticOrder so; int nwg2; const char* A; const char* B; const char* A2; const char* B2; size_t step;
    __device__ void init(const void* A_, const void* B_, int M, int N, int K, int G, int c, const void* A2_, const void* B2_, int nwg2_) { so.init(M, N, G, c); A = (const char*)A_; B = (const char*)B_; A2 = (const char*)A2_; B2 = (const char*)B2_; nwg2 = nwg2_; step = (size_t)256 * K * 2; }
    __device__ __forceinline__ bool next(int i, Unit& u) const { const int L = i * so.G + so.c; if (L < so.nwg) { u.e = 0; return so.next(i, u); } if (L - so.nwg >= nwg2) return false; u.e = 1; u.pm = 0; u.pn = L - so.nwg; return true; }
    __device__ __forceinline__ const char* aptr(const Unit& u) const { return u.e ? A2 : A + (size_t)u.pm * step; }
    __device__ __forceinline__ const char* bptr(const Unit& u) const { return (u.e ? B2 : B) + (size_t)u.pn * step; }
    __device__ __forceinline__ void a_ready(const Unit&) const {}
    __device__ __forceinline__ void done(const Unit&) const {}
};
struct MoeOrder {
    static constexpr bool GATHER = false, SHORT = false, F8 = false; static constexpr int SCALE_B = 127;
    const PG8_LAS int* tstart; int ntn, G, c; const char* A; const char* W; size_t astep, wexp, wtile;
    __device__ __forceinline__ bool next(int i, Unit& u) const {
        const int L = i * G + c, total = tstart[32] * ntn; if (L >= total) return false;
        int wgid; { const int q = total / NXCD, r = total % NXCD, xcd = L % NXCD, off = L / NXCD; wgid = (xcd < r ? xcd * (q + 1) : r * (q + 1) + (xcd - r) * q) + off; }
        u.pm = wgid / ntn; u.pn = wgid - u.pm * ntn; int e = 0;
#pragma unroll
        for (int k = 1; k <= 31; ++k) e += (tstart[k] <= u.pm) ? 1 : 0;
        u.e = e; return true;
    }
    __device__ __forceinline__ const char* aptr(const Unit& u) const { return A + (size_t)u.pm * astep; }
    __device__ __forceinline__ const char* bptr(const Unit& u) const { return W + (size_t)u.e * wexp + (size_t)u.pn * wtile; }
    __device__ __forceinline__ void a_ready(const Unit&) const {}
    __device__ __forceinline__ void done(const Unit&) const {}
};

struct MoeOrder8 {
    static constexpr bool GATHER = false, SHORT = false, F8 = true; static constexpr int SCALE_B = 121;
    const PG8_LAS int* tstart; int ntn, G, c; const char* A; const char* W; size_t astep, wexp, wtile;
    __device__ __forceinline__ bool next(int i, Unit& u) const {
        const int L = i * G + c, total = tstart[32] * ntn; if (L >= total) return false;
        int wgid; { const int q = total / NXCD, r = total % NXCD, xcd = L % NXCD, off = L / NXCD; wgid = (xcd < r ? xcd * (q + 1) : r * (q + 1) + (xcd - r) * q) + off; }
        u.pm = wgid / ntn; u.pn = wgid - u.pm * ntn; int e = 0;
#pragma unroll
        for (int k = 1; k <= 31; ++k) e += (tstart[k] <= u.pm) ? 1 : 0;
        u.e = e; return true;
    }
    __device__ __forceinline__ const char* aptr(const Unit& u) const { return A + (size_t)u.pm * astep; }
    __device__ __forceinline__ const char* bptr(const Unit& u) const { return W + (size_t)u.e * wexp + (size_t)u.pn * wtile; }
    __device__ __forceinline__ void a_ready(const Unit&) const {}
    __device__ __forceinline__ void done(const Unit&) const {}
};

struct MoeGatherOrder {
    static constexpr bool GATHER = true, SHORT = true, F8 = true; static constexpr int SCALE_B = 121;
    const PG8_LAS int* tstart; const PG8_LAS int* cntl; const int* list; int ntn, G, c; const char* A; const char* W; size_t wexp, wtile; unsigned rowbytes;
    __device__ __forceinline__ bool next(int i, Unit& u) const {
        const int L = i * G + c, total = tstart[32] * ntn; if (L >= total) return false;
        const int nfu = tstart[33] * ntn; const bool isfull = L < nfu;
        const int base = isfull ? 0 : nfu, cntu = isfull ? nfu : total - nfu, Lr = L - base;
        int wgid; { const int q = cntu / NXCD, r = cntu % NXCD, xcd = Lr % NXCD, off = Lr / NXCD; wgid = base + (xcd < r ? xcd * (q + 1) : r * (q + 1) + (xcd - r) * q) + off; }
        const int jt = wgid / ntn; u.pn = wgid - jt * ntn; u.pm = (int)((const PG8_LAS unsigned char*)(tstart + 68))[jt]; int e = 0;
#pragma unroll
        for (int k = 1; k <= 31; ++k) e += (tstart[k] <= u.pm) ? 1 : 0;
        { const int nvalid = cntl[e] - (u.pm - tstart[e]) * 256; u.full = __builtin_amdgcn_readfirstlane(isfull ? 2 : (nvalid > 64 ? 1 : 0)); }
        u.e = __builtin_amdgcn_readfirstlane(e); u.pm = __builtin_amdgcn_readfirstlane(u.pm); u.pn = __builtin_amdgcn_readfirstlane(u.pn); return true;
    }
    __device__ __forceinline__ unsigned rowoff(const Unit& u, int r) const { const int rank = (u.pm - tstart[u.e]) * 256 + r; const int tok = list[u.e * 8192 + (rank < cntl[u.e] ? rank : 0)]; return (unsigned)tok * rowbytes; }
    __device__ __forceinline__ const char* aptr(const Unit&) const { return A; }
    __device__ __forceinline__ const char* bptr(const Unit& u) const { return W + (size_t)u.e * wexp + (size_t)u.pn * wtile; }
    __device__ __forceinline__ void a_ready(const Unit&) const {}
    __device__ __forceinline__ void done(const Unit&) const {}
};

typedef unsigned u32x2 __attribute__((ext_vector_type(2)));
struct EpiBf16X {
    static constexpr bool PERM = true, AFTER_DRAIN = false;
    int mode; bf16_t* p0; bf16_t* p1; bf16_t* p2; bf16_t* p3;
    const PG8_LAS int* tstart; const PG8_LAS int* cntl;
    __device__ __forceinline__ void operator()(const f32x4 (&acc)[2][2][4][2], const Unit& u, int wr, int wc, int fr, int fq) const {
#ifndef ATT_BF16
        if (mode == 1 && !u.e) {
            int tok0 = u.pm * BM + wr * 64 + fr, cc0 = wc * 32 + 8 * fq; asm volatile("" : "+v"(tok0), "+v"(cc0));
            if (u.pn >= 14) { const int colv = (u.pn - 14) * BM + cc0; unsigned char* vb = (unsigned char*)p2 + ((size_t)((colv >> 8) * 128 + (tok0 >> 6)) * 256 + (colv & 255)) * 64 + (tok0 & 63);
#pragma unroll
                for (int ai = 0; ai < 2; ++ai)
#pragma unroll
                    for (int m = 0; m < 4; ++m)
#pragma unroll
                        for (int bj = 0; bj < 2; ++bj) { const f32x4 v0 = acc[ai][bj][m][0], v1 = acc[ai][bj][m][1]; unsigned a_ = 0u, b_ = 0u;
                            a_ = __builtin_amdgcn_cvt_pk_fp8_f32(v0[0], v0[1], a_, false); a_ = __builtin_amdgcn_cvt_pk_fp8_f32(v0[2], v0[3], a_, true); b_ = __builtin_amdgcn_cvt_pk_fp8_f32(v1[0], v1[1], b_, false); b_ = __builtin_amdgcn_cvt_pk_fp8_f32(v1[2], v1[3], b_, true);
                            unsigned char* vp = vb + (size_t)(ai * 2) * 16384 + m * 16 + (size_t)bj * HALF * 64;
                            vp[0] = (unsigned char)a_; vp[64] = (unsigned char)(a_ >> 8); vp[128] = (unsigned char)(a_ >> 16); vp[192] = (unsigned char)(a_ >> 24);
                            vp[256] = (unsigned char)b_; vp[320] = (unsigned char)(b_ >> 8); vp[384] = (unsigned char)(b_ >> 16); vp[448] = (unsigned char)(b_ >> 24); }
                return; }
            if (u.pn >= 8) { unsigned char* kb = (unsigned char*)p1 + (size_t)tok0 * 1536 + (u.pn - 8) * BM + cc0;
#pragma unroll
                for (int ai = 0; ai < 2; ++ai)
#pragma unroll
                    for (int m = 0; m < 4; ++m)
#pragma unroll
                        for (int bj = 0; bj < 2; ++bj) { const f32x4 v0 = acc[ai][bj][m][0], v1 = acc[ai][bj][m][1]; unsigned a_ = 0u, b_ = 0u;
                            a_ = __builtin_amdgcn_cvt_pk_fp8_f32(v0[0], v0[1], a_, false); a_ = __builtin_amdgcn_cvt_pk_fp8_f32(v0[2], v0[3], a_, true); b_ = __builtin_amdgcn_cvt_pk_fp8_f32(v1[0], v1[1], b_, false); b_ = __builtin_amdgcn_cvt_pk_fp8_f32(v1[2], v1[3], b_, true);
                            u32x2 kk; kk.x = a_; kk.y = b_; *(u32x2*)(kb + (size_t)(ai * HALF + m * 16) * 1536 + bj * HALF) = kk; }
                return; }
            { unsigned char* qb = (unsigned char*)p0 + (WS_ZQ - WS_Z) + (size_t)tok0 * 2048 + u.pn * BM + cc0; bf16_t* zb = p0 + (size_t)tok0 * 2048 + u.pn * BM + cc0;
#pragma unroll
                for (int ai = 0; ai < 2; ++ai)
#pragma unroll
                    for (int m = 0; m < 4; ++m)
#pragma unroll
                        for (int bj = 0; bj < 2; ++bj) { const f32x4 v0 = acc[ai][bj][m][0] * QSCALE, v1 = acc[ai][bj][m][1] * QSCALE; unsigned a_ = 0u, b_ = 0u;
                            a_ = __builtin_amdgcn_cvt_pk_fp8_f32(v0[0], v0[1], a_, false); a_ = __builtin_amdgcn_cvt_pk_fp8_f32(v0[2], v0[3], a_, true); b_ = __builtin_amdgcn_cvt_pk_fp8_f32(v1[0], v1[1], b_, false); b_ = __builtin_amdgcn_cvt_pk_fp8_f32(v1[2], v1[3], b_, true);
                            const size_t o_ = (size_t)(ai * HALF + m * 16) * 2048 + bj * HALF;
                            u32x2 qq; qq.x = a_; qq.y = b_; *(u32x2*)(qb + o_) = qq;
                            if (u.pn >= 6) { u32x4 w; w.x = cvt_pk_bf16(v0[0], v0[1]); w.y = cvt_pk_bf16(v0[2], v0[3]); w.z = cvt_pk_bf16(v1[0], v1[1]); w.w = cvt_pk_bf16(v1[2], v1[3]); *(u32x4*)(zb + o_) = w; } }
                return; }
        }
#endif
        if (mode == 3) {
            int r0_ = wr * 64 + fr, c0_ = u.pn * BM + wc * 32 + 8 * fq; asm volatile("" : "+v"(r0_), "+v"(c0_));
            const int rlim = cntl[u.e] - (u.pm - tstart[u.e]) * BM;
            unsigned char* yb_ = (unsigned char*)p0 + (size_t)(u.pm * BM + r0_) * 2048 + c0_;
#pragma unroll
            for (int ai = 0; ai < 2; ++ai)
#pragma unroll
                for (int m = 0; m < 4; ++m) { if (r0_ + ai * HALF + m * 16 >= rlim) continue;
#pragma unroll
                    for (int bj = 0; bj < 2; ++bj) { const f32x4 v0 = acc[ai][bj][m][0] * 16.f, v1 = acc[ai][bj][m][1] * 16.f; unsigned a_ = 0u, b_ = 0u;
                        a_ = __builtin_amdgcn_cvt_pk_fp8_f32(v0[0], v0[1], a_, false); a_ = __builtin_amdgcn_cvt_pk_fp8_f32(v0[2], v0[3], a_, true); b_ = __builtin_amdgcn_cvt_pk_fp8_f32(v1[0], v1[1], b_, false); b_ = __builtin_amdgcn_cvt_pk_fp8_f32(v1[2], v1[3], b_, true);
                        u32x2 q_; q_.x = a_; q_.y = b_; *(u32x2*)(yb_ + (size_t)(ai * HALF + m * 16) * 2048 + bj * HALF) = q_; } }
            return; }
        bf16_t* base; int ldc, colt; bool act = false; float sc = 1.f;
        if (u.e && mode < 2) { base = p3 + (size_t)(u.pn >> 2) * (256 * 1024); ldc = 1024; colt = (u.pn & 3) * BM; }
        else if (mode == 0) { base = p0; ldc = 3584; colt = u.pn * BM; act = u.pn < 12; if (u.pn >= 12) sc = QSCALE; }
        else if (mode == 1) { if (u.pn < 8) { base = p0; ldc = 2048; colt = u.pn * BM; sc = QSCALE; }
                              else if (u.pn < 14) { base = p1; ldc = 1536; colt = (u.pn - 8) * BM; } else { base = p2; ldc = 1536; colt = (u.pn - 14) * BM; } }
        else { base = p0; ldc = 2048; colt = u.pn * BM; }
        const int row0 = u.pm * BM + wr * 64 + fr, col0 = colt + wc * 32 + 8 * fq;
        const int rlim = (mode == 3) ? cntl[u.e] - (u.pm - tstart[u.e]) * BM : BM;
        const bool vst = (mode == 0) && !u.e && u.pn >= 6 && u.pn < 12;
        float* vsp = (float*)((unsigned char*)p0 + (WS_VSTAT - WS_Z)) + ((size_t)((u.pn - 6) * 4 + wc) * 8192) * 2;
#pragma unroll
        for (int ai = 0; ai < 2; ++ai)
#pragma unroll
            for (int m = 0; m < 4; ++m) { bf16_t* rowp = base + (size_t)(row0 + ai * HALF + m * 16) * ldc + col0;
                if (wr * 64 + fr + ai * HALF + m * 16 >= rlim) continue;
                float s1_ = 0.f, s2_ = 0.f;
#pragma unroll
                for (int bj = 0; bj < 2; ++bj) { f32x4 v0 = acc[ai][bj][m][0], v1 = acc[ai][bj][m][1];
                    if (act) { f32x2 a = gelu_pk((f32x2){v0[0], v0[1]}), b = gelu_pk((f32x2){v0[2], v0[3]}), c = gelu_pk((f32x2){v1[0], v1[1]}), d = gelu_pk((f32x2){v1[2], v1[3]});
                        v0 = (f32x4){a.x, a.y, b.x, b.y}; v1 = (f32x4){c.x, c.y, d.x, d.y}; }
                    if (vst) { s1_ += (v0[0] + v0[1]) + (v0[2] + v0[3]) + (v1[0] + v1[1]) + (v1[2] + v1[3]); s2_ += (v0[0] * v0[0] + v0[1] * v0[1]) + (v0[2] * v0[2] + v0[3] * v0[3]) + (v1[0] * v1[0] + v1[1] * v1[1]) + (v1[2] * v1[2] + v1[3] * v1[3]); }
                    v0 = v0 * sc; v1 = v1 * sc; u32x4 w; w.x = cvt_pk_bf16(v0[0], v0[1]); w.y = cvt_pk_bf16(v0[2], v0[3]); w.z = cvt_pk_bf16(v1[0], v1[1]); w.w = cvt_pk_bf16(v1[2], v1[3]);
                    *(u32x4*)(rowp + bj * HALF) = w; }
                if (vst) { s1_ += __shfl_xor(s1_, 16); s2_ += __shfl_xor(s2_, 16); s1_ += __shfl_xor(s1_, 32); s2_ += __shfl_xor(s2_, 32);
                    if (fq == 0) { f32x2 st_; st_.x = s1_; st_.y = s2_; *(f32x2*)(vsp + (size_t)(row0 + ai * HALF + m * 16) * 2) = st_; } } }
    }
};
struct EpiResBf16 {
    static constexpr bool PERM = true, AFTER_DRAIN = false;
    const bf16_t* xres; bf16_t* y; float alpha;
    __device__ __forceinline__ void operator()(const f32x4 (&acc)[2][2][4][2], const Unit& u, int wr, int wc, int fr, int fq) const {
        const int row0 = u.pm * BM + wr * 64 + fr, col0 = u.pn * BM + wc * 32 + 8 * fq;
#pragma unroll
        for (int ai = 0; ai < 2; ++ai)
#pragma unroll
            for (int m = 0; m < 4; ++m) { const size_t off = (size_t)(row0 + ai * HALF + m * 16) * 2048 + col0;
#pragma unroll
                for (int bj = 0; bj < 2; ++bj) { const u32x4 xr = *(const u32x4*)(xres + off + bj * HALF); const f32x4 v0 = acc[ai][bj][m][0], v1 = acc[ai][bj][m][1]; u32x4 w;
                    w.x = cvt_pk_bf16(__builtin_bit_cast(float, xr.x << 16) * alpha + v0[0], __builtin_bit_cast(float, xr.x & 0xffff0000u) * alpha + v0[1]);
                    w.y = cvt_pk_bf16(__builtin_bit_cast(float, xr.y << 16) * alpha + v0[2], __builtin_bit_cast(float, xr.y & 0xffff0000u) * alpha + v0[3]);
                    w.z = cvt_pk_bf16(__builtin_bit_cast(float, xr.z << 16) * alpha + v1[0], __builtin_bit_cast(float, xr.z & 0xffff0000u) * alpha + v1[1]);
                    w.w = cvt_pk_bf16(__builtin_bit_cast(float, xr.w << 16) * alpha + v1[2], __builtin_bit_cast(float, xr.w & 0xffff0000u) * alpha + v1[3]);
                    *(u32x4*)(y + off + bj * HALF) = w; } }
    }
};
struct EpiMoe1 {
    static constexpr bool PERM = true, AFTER_DRAIN = false;
    bf16_t* h; const PG8_LAS int* tstart; const PG8_LAS int* cntl;
    __device__ __forceinline__ void operator()(const f32x4 (&acc)[2][2][4][2], const Unit& u, int wr, int wc, int fr, int fq) const {
        const int row0 = u.pm * BM + wr * 64 + fr, col0 = u.pn * HALF + wc * 32 + 8 * fq;
        const int rlim = cntl[u.e] - (u.pm - tstart[u.e]) * BM;
#pragma unroll
        for (int ai = 0; ai < 2; ++ai)
#pragma unroll
            for (int m = 0; m < 4; ++m) { unsigned char* rowp = (unsigned char*)h + (size_t)(row0 + ai * HALF + m * 16) * 512 + col0; float o[8];
                if (wr * 64 + fr + ai * HALF + m * 16 >= rlim) continue;
#pragma unroll
                for (int n = 0; n < 2; ++n)
#pragma unroll
                    for (int x = 0; x < 4; ++x) { const float a = acc[ai][0][m][n][x], b = acc[ai][1][m][n][x];
                        o[n * 4 + x] = a * __builtin_amdgcn_rcpf(1.0f + __builtin_amdgcn_exp2f(-a * LOG2E)) * b; }
                unsigned lo = 0u, hi = 0u; lo = __builtin_amdgcn_cvt_pk_fp8_f32(o[0], o[1], lo, false); lo = __builtin_amdgcn_cvt_pk_fp8_f32(o[2], o[3], lo, true);
                hi = __builtin_amdgcn_cvt_pk_fp8_f32(o[4], o[5], hi, false); hi = __builtin_amdgcn_cvt_pk_fp8_f32(o[6], o[7], hi, true);
                typedef unsigned u32x2e __attribute__((ext_vector_type(2))); u32x2e w; w.x = lo; w.y = hi; *(u32x2e*)rowp = w; }
    }
};
}

namespace att {
using bf16x8 = __attribute__((ext_vector_type(8))) short;
using s16x4  = __attribute__((ext_vector_type(4))) short;
using f32x16 = __attribute__((ext_vector_type(16))) float;
using u32x4  = __attribute__((ext_vector_type(4))) unsigned;
constexpr int DH = 128, QBLK = 32, KVBLK = 64;
constexpr float THR2 = 8.f * 1.4426950408889634f;
constexpr size_t SHM_V = KVBLK * DH * 2, SHM_K = KVBLK * DH * 2, SHM_ATTN = 2 * SHM_V + 2 * SHM_K + NWAVES * 64 * 4;
constexpr int TAB_N = 160;
#define KSWZ(row, colB) ((row) * 256 + ((colB) ^ (((row) & 7) << 4)))
#define SBAR() __builtin_amdgcn_sched_barrier(0)
__device__ __forceinline__ int crow(int r, int hi) { return (r & 3) + 8 * (r >> 2) + 4 * hi; }
__device__ __forceinline__ unsigned cvtpk(float lo, float hi) { unsigned r; asm volatile("v_cvt_pk_bf16_f32 %0, %1, %2" : "=v"(r) : "v"(lo), "v"(hi)); return r; }

__device__ __forceinline__ void partialSM(f32x16& p0, f32x16& p1, float& m_reg, float& mn, float& alpha) {
  float pmax = p0[0];
#pragma unroll
  for (int r = 1; r < 16; ++r) pmax = fmaxf(pmax, p0[r]);
#pragma unroll
  for (int r = 0; r < 16; ++r) pmax = fmaxf(pmax, p1[r]);
  { auto rr = __builtin_amdgcn_permlane32_swap(__float_as_uint(pmax), __float_as_uint(pmax), false, false);
    pmax = fmaxf(__uint_as_float(rr[0]), __uint_as_float(rr[1])); }
  if (__builtin_expect(__all(pmax - m_reg <= THR2), 1)) { mn = m_reg; alpha = 1.f; }
  else { mn = fmaxf(m_reg, pmax); alpha = __builtin_amdgcn_exp2f(m_reg - mn); m_reg = mn; }
#pragma unroll
  for (int r = 0; r < 16; ++r) p0[r] = p0[r] - mn;
#pragma unroll
  for (int r = 0; r < 16; ++r) p1[r] = p1[r] - mn;
#pragma unroll
  for (int r = 0; r < 16; ++r) p0[r] = __builtin_amdgcn_exp2f(p0[r]);
}
__device__ __forceinline__ void finishSM(f32x16& p0, f32x16& p1, float alpha, float& l_reg, bf16x8& pa0, bf16x8& pa1, bf16x8& pa2, bf16x8& pa3) {
#pragma unroll
  for (int r = 0; r < 16; ++r) p1[r] = __builtin_amdgcn_exp2f(p1[r]);
  float ps = 0;
#pragma unroll
  for (int r = 0; r < 16; ++r) ps += p0[r];
#pragma unroll
  for (int r = 0; r < 16; ++r) ps += p1[r];
  { auto rr = __builtin_amdgcn_permlane32_swap(__float_as_uint(ps), __float_as_uint(ps), false, false);
    ps = __uint_as_float(rr[0]) + __uint_as_float(rr[1]); }
  l_reg = l_reg * alpha + ps;
#define PK4(P, BASE, OUT) do { unsigned a0 = cvtpk(P[BASE + 0], P[BASE + 1]), a1 = cvtpk(P[BASE + 2], P[BASE + 3]);   \
    unsigned b0 = cvtpk(P[BASE + 4], P[BASE + 5]), b1 = cvtpk(P[BASE + 6], P[BASE + 7]);                              \
    auto r0 = __builtin_amdgcn_permlane32_swap(a0, b0, false, false); auto r1 = __builtin_amdgcn_permlane32_swap(a1, b1, false, false); \
    u32x4 w = {r0[0], r1[0], r0[1], r1[1]}; OUT = *reinterpret_cast<bf16x8*>(&w); } while (0)
  PK4(p0, 0, pa0); PK4(p0, 8, pa1); PK4(p1, 0, pa2); PK4(p1, 8, pa3);
#undef PK4
}
__device__ __forceinline__ void qkt(f32x16& p0, f32x16& p1, const char* Ks, const bf16x8* qr, int r32, int hi) {
  p0 = f32x16{}; p1 = f32x16{};
#pragma unroll
  for (int d0 = 0; d0 < 8; ++d0) { const int cb = (d0 * 16 + hi * 8) * 2;
    bf16x8 b0 = *reinterpret_cast<const bf16x8*>(Ks + KSWZ(r32, cb));
    bf16x8 b1 = *reinterpret_cast<const bf16x8*>(Ks + KSWZ(32 + r32, cb));
    p0 = __builtin_amdgcn_mfma_f32_32x32x16_bf16(b0, qr[d0], p0, 0, 0, 0);
    p1 = __builtin_amdgcn_mfma_f32_32x32x16_bf16(b1, qr[d0], p1, 0, 0, 0); }
}
__device__ __forceinline__ int v_st(int k, int c) { const int kk = (k & ~0xC) | ((k & 4) << 1) | ((k & 8) >> 1); return ((kk >> 3) * 4 + (c >> 5)) * 512 + ((kk & 7) * 32 + (c & 31)) * 2; }
__device__ __forceinline__ int v_rd_base(int lane) { return ((lane & 3) << 3) | (((lane >> 2) & 3) << 6) | (((lane >> 4) & 1) << 5) | (((lane >> 5) & 1) << 8); }
constexpr int v_rd_off(int d0, int ks, int half) { return d0 * 512 + ks * 4096 + half * 2048; }
template <int OFF> __device__ __forceinline__ s16x4 tr_read(int vb) {
  s16x4 r; asm volatile("ds_read_b64_tr_b16 %0, %1 offset:%2" : "=&v"(r) : "v"(vb), "i"(OFF) : "memory"); return r;
}
template <int D0> __device__ __forceinline__ void pv_one(f32x16& od, int vb, bf16x8 pa0, bf16x8 pa1, bf16x8 pa2, bf16x8 pa3) {
  const s16x4 l0 = tr_read<v_rd_off(D0, 0, 0)>(vb), h0 = tr_read<v_rd_off(D0, 0, 1)>(vb), l1 = tr_read<v_rd_off(D0, 1, 0)>(vb), h1 = tr_read<v_rd_off(D0, 1, 1)>(vb);
  const s16x4 l2 = tr_read<v_rd_off(D0, 2, 0)>(vb), h2 = tr_read<v_rd_off(D0, 2, 1)>(vb), l3 = tr_read<v_rd_off(D0, 3, 0)>(vb), h3 = tr_read<v_rd_off(D0, 3, 1)>(vb);
  asm volatile("s_waitcnt lgkmcnt(0)" ::: "memory"); SBAR();
#define PK(L, H) (bf16x8){L[0], L[1], L[2], L[3], H[0], H[1], H[2], H[3]}
  od = __builtin_amdgcn_mfma_f32_32x32x16_bf16(pa0, PK(l0, h0), od, 0, 0, 0);
  od = __builtin_amdgcn_mfma_f32_32x32x16_bf16(pa1, PK(l1, h1), od, 0, 0, 0);
  od = __builtin_amdgcn_mfma_f32_32x32x16_bf16(pa2, PK(l2, h2), od, 0, 0, 0);
  od = __builtin_amdgcn_mfma_f32_32x32x16_bf16(pa3, PK(l3, h3), od, 0, 0, 0);
#undef PK
}
__device__ __forceinline__ void pv_d0(f32x16* o, int vb, bf16x8 pa0, bf16x8 pa1, bf16x8 pa2, bf16x8 pa3) {
  pv_one<0>(o[0], vb, pa0, pa1, pa2, pa3); pv_one<1>(o[1], vb, pa0, pa1, pa2, pa3); pv_one<2>(o[2], vb, pa0, pa1, pa2, pa3); pv_one<3>(o[3], vb, pa0, pa1, pa2, pa3);
}
template <int MODE> __device__ __forceinline__ void post_scores(f32x16& p0, f32x16& p1, int t, int qrow0, int r32, int hi, const float* tab, float cfar) {
  if constexpr (MODE == 1) {
    const int cw = qrow0 >> 6;
    if (t > cw) {
#pragma unroll
      for (int r = 0; r < 16; ++r) { p0[r] = -INFINITY; p1[r] = -INFINITY; }
    } else if (qrow0 - (64 * t + 63) >= 91) {
#pragma unroll
      for (int r = 0; r < 16; ++r) { p0[r] += cfar; p1[r] += cfar; }
    } else {
      const int base = qrow0 + r32 - 64 * t + 63;
#pragma unroll
      for (int r = 0; r < 16; ++r) { const int i0 = base - crow(r, hi); const int i1 = i0 - 32;
        p0[r] += tab[i0 < TAB_N - 1 ? i0 : TAB_N - 1]; p1[r] += tab[i1 < TAB_N - 1 ? i1 : TAB_N - 1]; }
    }
  }
}

template <int MODE>
__device__ __forceinline__ void attn_body(const bf16* __restrict__ Qb, int ldq, const bf16* __restrict__ Kh, const bf16* __restrict__ Vh, int ldk,
                                          bf16* Ob, float* Of, int ldo, int NT, int q0abs, const float* tab, float cfar, char* lds) {
  int tid_ = threadIdx.x; asm volatile("" : "+v"(tid_));
  const int tid = tid_, wid = tid >> 6, lane = tid & 63, r32 = lane & 31, hi = lane >> 5;
  char* V_lds = lds; char* K_lds = lds + 2 * SHM_V;
  float* ws = (float*)(lds + 2 * SHM_V + 2 * SHM_K) + wid * 64; float* li_l = ws; float* al_l = ws + 32;
  float m_reg = -1e30f, l_reg = 0; f32x16 o[4] = {}; bf16x8 qr[8];
  const int qrow0 = q0abs + wid * QBLK;
  const bf16* Qw = Qb + (long)(wid * QBLK + r32) * ldq + hi * 8;
#pragma unroll
  for (int d0 = 0; d0 < 8; ++d0) qr[d0] = *reinterpret_cast<const bf16x8*>(Qw + d0 * 16);
  const int sr = tid >> 4, sc = (tid & 15) * 8, vst0 = v_st(sr, sc), vst1 = v_st(32 + sr, sc);
  const int vb0 = (int)(uintptr_t)V_lds + v_rd_base(lane);
  struct { bf16x8 vs0, vs1, ks0, ks1; } sr_[2];
#define SLOAD(i, k0) do { sr_[i].vs0 = *reinterpret_cast<const bf16x8*>(&Vh[(long)((k0) + sr) * ldk + sc]); sr_[i].vs1 = *reinterpret_cast<const bf16x8*>(&Vh[(long)((k0) + 32 + sr) * ldk + sc]); \
    sr_[i].ks0 = *reinterpret_cast<const bf16x8*>(&Kh[(long)((k0) + sr) * ldk + sc]); sr_[i].ks1 = *reinterpret_cast<const bf16x8*>(&Kh[(long)((k0) + 32 + sr) * ldk + sc]); } while (0)
#define SWRITE(b, i) do { *(bf16x8*)(V_lds + (b) * SHM_V + vst0) = sr_[i].vs0;          \
    *(bf16x8*)(V_lds + (b) * SHM_V + vst1) = sr_[i].vs1; const int kc = sc * 2;               \
    *(bf16x8*)(K_lds + (b) * SHM_K + KSWZ(sr, kc)) = sr_[i].ks0;                       \
    *(bf16x8*)(K_lds + (b) * SHM_K + KSWZ(32 + sr, kc)) = sr_[i].ks1; } while (0)
#define SWAIT() asm volatile("s_waitcnt vmcnt(4)" ::: "memory")
#define RESC(a) do { if (__any((a) < 1.f)) { if (hi == 0) al_l[r32] = (a); asm volatile("s_waitcnt lgkmcnt(0)" ::: "memory"); \
    _Pragma("unroll") for (int d = 0; d < 4; ++d) _Pragma("unroll") for (int r = 0; r < 16; ++r) o[d][r] *= al_l[crow(r, hi)]; } } while (0)
  f32x16 pA0, pA1, pB0, pB1; float mnA, mnB, alA, alB; bf16x8 pa0, pa1, pa2, pa3;
  constexpr int SE = 0, SO = 1;
  SLOAD(SE, 0); asm volatile("s_waitcnt vmcnt(0)" ::: "memory"); SWRITE(0, SE); __syncthreads();
  qkt(pA0, pA1, K_lds, qr, r32, hi); post_scores<MODE>(pA0, pA1, 0, qrow0, r32, hi, tab, cfar); partialSM(pA0, pA1, m_reg, mnA, alA);
  SLOAD(SO, KVBLK); if (2 < NT) SLOAD(SE, 2 * KVBLK);
  SWAIT(); SWRITE(1, SO); __syncthreads();
  for (int j = 1; j + 1 < NT; j += 2) {
    SBAR(); qkt(pB0, pB1, K_lds + SHM_K, qr, r32, hi); post_scores<MODE>(pB0, pB1, j, qrow0, r32, hi, tab, cfar);
    finishSM(pA0, pA1, alA, l_reg, pa0, pa1, pa2, pa3); SBAR();
    SLOAD(SO, (j + 2) * KVBLK); SBAR();
    pv_d0(o, vb0, pa0, pa1, pa2, pa3); partialSM(pB0, pB1, m_reg, mnB, alB);
    __syncthreads(); SWAIT(); SWRITE(0, SE);
    RESC(alB); __syncthreads();
    SBAR(); qkt(pA0, pA1, K_lds, qr, r32, hi); post_scores<MODE>(pA0, pA1, j + 1, qrow0, r32, hi, tab, cfar);
    finishSM(pB0, pB1, alB, l_reg, pa0, pa1, pa2, pa3); SBAR();
    if (j + 3 < NT) SLOAD(SE, (j + 3) * KVBLK); SBAR();
    pv_d0(o, vb0 + (int)SHM_V, pa0, pa1, pa2, pa3); partialSM(pA0, pA1, m_reg, mnA, alA);
    __syncthreads(); SWAIT(); SWRITE(1, SO);
    RESC(alA); __syncthreads();
  }
  SBAR(); qkt(pB0, pB1, K_lds + SHM_K, qr, r32, hi); post_scores<MODE>(pB0, pB1, NT - 1, qrow0, r32, hi, tab, cfar);
  finishSM(pA0, pA1, alA, l_reg, pa0, pa1, pa2, pa3); SBAR();
  pv_d0(o, vb0, pa0, pa1, pa2, pa3); partialSM(pB0, pB1, m_reg, mnB, alB);
  __syncthreads(); RESC(alB);
  finishSM(pB0, pB1, alB, l_reg, pa0, pa1, pa2, pa3); SBAR();
  pv_d0(o, vb0 + (int)SHM_V, pa0, pa1, pa2, pa3);
  if (hi == 0) li_l[r32] = l_reg; asm volatile("s_waitcnt lgkmcnt(0)" ::: "memory");
  float rli[16];
#pragma unroll
  for (int r = 0; r < 16; ++r) rli[r] = __builtin_amdgcn_rcpf(li_l[crow(r, hi)]);
  if constexpr (MODE == 0) {
    bf16* Ow = Ob + (long)(wid * QBLK) * ldo;
#pragma unroll
    for (int r = 0; r < 16; ++r) { const int orow = crow(r, hi);
#pragma unroll
      for (int d0 = 0; d0 < 4; ++d0) Ow[(long)orow * ldo + d0 * 32 + r32] = (bf16)f2bf(o[d0][r] * rli[r]); }
  } else {
    float* Ow = Of + (long)(wid * QBLK) * ldo;
#pragma unroll
    for (int r = 0; r < 16; ++r) { const int orow = crow(r, hi);
#pragma unroll
      for (int d0 = 0; d0 < 4; ++d0) Ow[(long)orow * ldo + d0 * 32 + r32] = o[d0][r] * rli[r]; }
  }
  __syncthreads();
#undef SLOAD
#undef SWRITE
#undef SWAIT
#undef RESC
}
}

#define XB_TMO      128
#define XB_XCNT(j)  (256  + 64 * (j))
#define XB_XSUB(j)  (1280 + 64 * (j))
#define XB_XGEN(j)  (2304 + 64 * (j))
#define XB_TOP      3328
#define XB_TOPGEN   3392
#define XCD_BAR_WORDS 3456
#define XB_SPIN_CAP (1u << 18)

__device__ __forceinline__ unsigned xb_ld(unsigned* p)              { return __hip_atomic_load(p, __ATOMIC_RELAXED, __HIP_MEMORY_SCOPE_AGENT); }
__device__ __forceinline__ unsigned xb_add(unsigned* p, unsigned v) { return __hip_atomic_fetch_add(p, v, __ATOMIC_RELAXED, __HIP_MEMORY_SCOPE_AGENT); }
__device__ __forceinline__ unsigned xb_xcc_id() { return (unsigned)__builtin_amdgcn_s_getreg((3 << 11) | 20) & 0xFu; }
#define XB_SPIN(cond, bar) do { unsigned _sp = 0; while (cond) { __builtin_amdgcn_s_sleep(1); \
    if ((++_sp & 255u) == 0u) { if (xb_ld(&(bar)[XB_TMO])) break; if (_sp > XB_SPIN_CAP) { atomicAdd(&(bar)[XB_TMO], 1u); break; } } } } while (0)

struct XcdBarrier {
    unsigned* bar; unsigned x;
    volatile LAS unsigned* st;
};

__device__ __forceinline__ XcdBarrier xcd_barrier_post(unsigned* bar, volatile LAS unsigned* st) {
    XcdBarrier b; b.bar = bar; b.x = xb_xcc_id(); b.st = st;
    if (threadIdx.x == 0) (void)xb_add(&bar[XB_XCNT(b.x)], 1u);
    return b;
}
__device__ __forceinline__ void xcd_barrier_complete(unsigned* bar, unsigned x, unsigned& nloc, unsigned& nx) {
    const unsigned G = gridDim.x * gridDim.y * gridDim.z;
    unsigned sum, cnt, mine, sp = 0u;
    for (;;) {
        sum = 0u; cnt = 0u; mine = 0u;
#pragma unroll
        for (unsigned j = 0; j < 16; ++j) { const unsigned c = xb_ld(&bar[XB_XCNT(j)]); sum += c; cnt += (c > 0u) ? 1u : 0u; mine = (j == x) ? c : mine; }
        if (sum == G) break;
        __builtin_amdgcn_s_sleep(1);
        if ((++sp & 255u) == 0u) { if (xb_ld(&bar[XB_TMO])) break; if (sp > XB_SPIN_CAP) { atomicAdd(&bar[XB_TMO], 1u); break; } }
    }
    nloc = mine > 0u ? mine : 1u; nx = cnt > 0u ? cnt : 1u;
}

__device__ __forceinline__ void xcd_barrier(const XcdBarrier& b) {
    asm volatile("s_waitcnt vmcnt(0)" ::: "memory");
    __syncthreads();
    if (threadIdx.x == 0) {
        unsigned* bar = b.bar;
        __builtin_amdgcn_s_waitcnt(0);
        asm volatile("buffer_inv sc1" ::: "memory");
        unsigned nloc = b.st[0], nx = b.st[1];
        if (nloc == 0u) { xcd_barrier_complete(bar, b.x, nloc, nx); b.st[0] = nloc; b.st[1] = nx; }
        const unsigned old = xb_add(&bar[XB_XSUB(b.x)], 1u);
        const unsigned gen = old / nloc;
        if (old + 1u == (gen + 1u) * nloc) {
            __builtin_amdgcn_fence(__ATOMIC_RELEASE, "agent");
            asm volatile("s_waitcnt vmcnt(0)" ::: "memory");
            const unsigned og = xb_add(&bar[XB_TOP], 1u);
            const unsigned tg = og / nx;
            if (og + 1u == (tg + 1u) * nx) xb_add(&bar[XB_TOPGEN], 1u);
            else XB_SPIN(xb_ld(&bar[XB_TOPGEN]) == tg, bar);
        } else {
            XB_SPIN(xb_ld(&bar[XB_TOPGEN]) == gen, bar);
        }
        asm volatile("s_waitcnt vmcnt(0)" ::: "memory");
    }
    __syncthreads();
}


struct Args { const float* in[24]; float* out; unsigned char* ws; int ph_lo, ph_hi; };
enum { I_X = 0, I_MEM, I_AWIN, I_ALNG, I_ALNB, I_AWS, I_ABS, I_AWOUT, I_BWIN, I_BLAM, I_BSUBG, I_BWOUT, I_WKV, I_RELB, I_MEMWKV, I_LNG, I_LNB,
       I_WG1, I_BG1, I_WG2, I_BG2, I_W1, I_W3, I_W2 };
constexpr int NPH_LAYER = 9, NPHASES = 1 + DEPTH * NPH_LAYER;

struct Frame {
    LAS unsigned char* lds; char* ldsg;
    gu32* ctl; unsigned char* ws;
    int tid, lane, wave, G, c;
};

__device__ __forceinline__ void transpose_item(const float* W, int K, int N, bf16* WT, int drow0, LAS float* scr, int k0, int n0, int lane) {
#pragma unroll 8
    for (int i = 0; i < 32; ++i) { const int kk = 2 * i + (lane >> 5); scr[kk * 33 + (lane & 31)] = W[(size_t)(k0 + kk) * N + n0 + (lane & 31)]; }
    LDS_WAIT(); asm volatile("" ::: "memory");
    const int c = lane & 7;
#pragma unroll
    for (int j = 0; j < 4; ++j) { const int n = (lane >> 3) + 8 * j; const LAS float* s = scr + (8 * c) * 33 + n;
        v4u o; o.x = pk2(s[0 * 33], s[1 * 33]); o.y = pk2(s[2 * 33], s[3 * 33]); o.z = pk2(s[4 * 33], s[5 * 33]); o.w = pk2(s[6 * 33], s[7 * 33]);
        *(GAS v4u*)(WT + (size_t)(drow0 + n) * K + k0 + 8 * c) = o; }
    LDS_WAIT(); asm volatile("" ::: "memory");
}
__device__ __forceinline__ void transpose_item_fast(const float* W, int K, int N, bf16* WT, int drow0, LAS float* scr, int k0, int n0, int lane) {
    float t[32];
#pragma unroll
    for (int i = 0; i < 32; ++i) t[i] = W[(size_t)(k0 + 2 * i + (lane >> 5)) * N + n0 + (lane & 31)];
#pragma unroll
    for (int i = 0; i < 32; i += 8) asm volatile("" : "+v"(t[i]), "+v"(t[i + 1]), "+v"(t[i + 2]), "+v"(t[i + 3]), "+v"(t[i + 4]), "+v"(t[i + 5]), "+v"(t[i + 6]), "+v"(t[i + 7]));
#pragma unroll
    for (int i = 0; i < 32; ++i) scr[(2 * i + (lane >> 5)) * 33 + (lane & 31)] = t[i];
    LDS_WAIT(); asm volatile("" ::: "memory");
    const int c = lane & 7;
#pragma unroll
    for (int j = 0; j < 4; ++j) { const int n = (lane >> 3) + 8 * j; const LAS float* s = scr + (8 * c) * 33 + n;
        v4u o; o.x = pk2(s[0 * 33], s[1 * 33]); o.y = pk2(s[2 * 33], s[3 * 33]); o.z = pk2(s[4 * 33], s[5 * 33]); o.w = pk2(s[6 * 33], s[7 * 33]);
        *(GAS v4u*)(WT + (size_t)(drow0 + n) * K + k0 + 8 * c) = o; }
    LDS_WAIT(); asm volatile("" ::: "memory");
}
__device__ __forceinline__ void transpose_item_fp8(const float* W, int K, int N, unsigned char* WT, int drow0, LAS float* scr, int k0, int n0, int lane) {
    float t[32];
#pragma unroll
    for (int i = 0; i < 32; ++i) t[i] = W[(size_t)(k0 + 2 * i + (lane >> 5)) * N + n0 + (lane & 31)];
#pragma unroll
    for (int i = 0; i < 32; i += 8) asm volatile("" : "+v"(t[i]), "+v"(t[i + 1]), "+v"(t[i + 2]), "+v"(t[i + 3]), "+v"(t[i + 4]), "+v"(t[i + 5]), "+v"(t[i + 6]), "+v"(t[i + 7]));
#pragma unroll
    for (int i = 0; i < 32; ++i) scr[(2 * i + (lane >> 5)) * 33 + (lane & 31)] = t[i];
    LDS_WAIT(); asm volatile("" ::: "memory");
    const int c = lane & 7;
#pragma unroll
    for (int j = 0; j < 4; ++j) { const int n = (lane >> 3) + 8 * j; const LAS float* s = scr + (8 * c) * 33 + n;
        unsigned lo = 0u, hi = 0u;
        lo = __builtin_amdgcn_cvt_pk_fp8_f32(s[0 * 33] * 64.f, s[1 * 33] * 64.f, lo, false); lo = __builtin_amdgcn_cvt_pk_fp8_f32(s[2 * 33] * 64.f, s[3 * 33] * 64.f, lo, true);
        hi = __builtin_amdgcn_cvt_pk_fp8_f32(s[4 * 33] * 64.f, s[5 * 33] * 64.f, hi, false); hi = __builtin_amdgcn_cvt_pk_fp8_f32(s[6 * 33] * 64.f, s[7 * 33] * 64.f, hi, true);
        v2u o; o.x = lo; o.y = hi; *(GAS v2u*)(WT + (size_t)(drow0 + n) * K + k0 + 8 * c) = o; }
    LDS_WAIT(); asm volatile("" ::: "memory");
}
#ifndef CDRAIN
#define CDRAIN 8
#endif
#ifndef CSRV
#define CSRV 4
#endif
#ifndef CSRVA
#define CSRVA 32
#endif
#ifndef STOPU
#define STOPU 64
#endif
#ifndef QX
#define QX 6
#endif
#ifndef QA
#define QA 14
#endif
#ifndef QM
#define QM 7
#endif
#ifndef QB
#define QB 4
#endif
constexpr int NQ = 7, MOE_ITEMS = 3 * 32 * 512;
__device__ __forceinline__ int conv_qsize(int q) { return (q & 1) ? (q == 1 ? 5632 : (q == 3 ? 7168 : 4096)) : MOE_ITEMS; }
__device__ __forceinline__ void conv_item(Frame& F, const Args& a, int q, int it) {
    LAS float* scr = (LAS float*)(F.lds + RING_OFF + F.wave * 16384);
    if (q & 1) {
        const float* src; bf16* dst; int N, r = it;
        if (q == 1) { if (r < 3584) { N = 3584; src = a.in[I_AWIN] + (size_t)2048 * 3584; dst = (bf16*)(F.ws + WS_WAIN) + (size_t)2048 * 3584; } else { r -= 3584; N = 2048; src = a.in[I_AWOUT] + (size_t)2048 * 2048; dst = (bf16*)(F.ws + WS_WAOUT) + (size_t)2048 * 2048; } }
        else if (q == 3) { if (r < 2048) { N = 2048; src = a.in[I_BWIN]; dst = (bf16*)(F.ws + WS_WBIN0); } else if ((r -= 2048) < 3072) { N = 3072; src = a.in[I_WKV]; dst = (bf16*)(F.ws + WS_WKV); } else { r -= 3072; N = 2048; src = a.in[I_BWOUT]; dst = (bf16*)(F.ws + WS_WBOUT); } }
        else { if (r < 2048) { N = 2048; src = a.in[I_BWIN] + (size_t)2048 * 2048; dst = (bf16*)(F.ws + WS_WBIN1); } else { r -= 2048; N = 2048; src = a.in[I_BWOUT] + (size_t)2048 * 2048; dst = (bf16*)(F.ws + WS_WBOUT) + (size_t)2048 * 2048; } }
        const int nblk = N / 32, kb = r / nblk, nb = r - kb * nblk;
        transpose_item_fast(src, 2048, N, dst, 32 * nb, scr, 64 * kb, 32 * nb, F.lane);
        return;
    }
    const int L = q >> 1, seg = it >> 14, r0 = it & 16383, e = r0 >> 9, r = r0 & 511, mat = L * 32 + e;
    if (seg < 2) { const int kb = r >> 4, nb = r & 15, n0 = 32 * nb;
        transpose_item_fp8(a.in[seg == 0 ? I_W1 : I_W3] + (size_t)mat * 2048 * 512, 2048, 512, (unsigned char*)(F.ws + WS_W13) + (size_t)mat * 1024 * 2048, (n0 >> 7) * 256 + (n0 & 127) + (seg == 1 ? 128 : 0), scr, 64 * kb, n0, F.lane); }
    else { const int kb = r >> 6, nb = r & 63;
        transpose_item_fp8(a.in[I_W2] + (size_t)mat * 512 * 2048, 512, 2048, (unsigned char*)(F.ws + WS_W2) + (size_t)mat * 512 * 2048, 32 * nb, scr, 64 * kb, 32 * nb, F.lane); }
}
#ifndef F8MASK
#define F8MASK 4
#endif
#define F8L(l) (((F8MASK) >> (l)) & 1)
#ifndef F8OMASK
#define F8OMASK 12
#endif
#define F8OL(l) (((F8OMASK) >> (l)) & 1)
#ifndef CDEPTH
#define CDEPTH 3
#endif
struct CDesc { const float* src; unsigned char* dst; int N, K, drow0, k0, n0, f8; };
__device__ __forceinline__ CDesc conv_desc(Frame& F, const Args& a, int q, int it) {
    CDesc d;
    if (q & 1) {
        const float* src; unsigned char* dst; int N, r = it, f8 = F8L((q + 1) >> 1);
        if (q == 1) { if (r < 3584) { N = 3584; src = a.in[I_AWIN] + (size_t)2048 * 3584; dst = F.ws + WS_WAIN + (size_t)2048 * 3584 * 2; } else { r -= 3584; N = 2048; f8 = 0; src = a.in[I_AWOUT] + (size_t)2048 * 2048; dst = F.ws + WS_WAOUT + (size_t)2048 * 2048 * 2; } }
        else if (q == 3) { if (r < 2048) { N = 2048; src = a.in[I_BWIN]; dst = F.ws + WS_WBIN0; } else if ((r -= 2048) < 3072) { N = 3072; src = a.in[I_WKV]; dst = F.ws + WS_WBIN0 + (size_t)2048 * 2048 * (F8L(2) ? 1 : 2); } else { r -= 3072; N = 2048; f8 = F8OL(2); src = a.in[I_BWOUT]; dst = F.ws + WS_WBOUT; } }
        else { if (r < 2048) { N = 2048; src = a.in[I_BWIN] + (size_t)2048 * 2048; dst = F.ws + WS_WBIN1; } else { r -= 2048; N = 2048; f8 = F8OL(3); src = a.in[I_BWOUT] + (size_t)2048 * 2048; dst = F.ws + WS_WBOUT + (size_t)2048 * 2048 * 2; } }
        const int nblk = N / 32, kb = r / nblk, nb = r - kb * nblk;
        d.src = src; d.dst = dst; d.N = N; d.K = 2048; d.drow0 = 32 * nb; d.k0 = 64 * kb; d.n0 = 32 * nb; d.f8 = f8; return d;
    }
    const int L = q >> 1, seg = it >> 14, r0 = it & 16383, e = r0 >> 9, r = r0 & 511, mat = L * 32 + e;
    if (seg < 2) { const int kb = r >> 4, nb = r & 15, n0 = 32 * nb;
        d.src = a.in[seg == 0 ? I_W1 : I_W3] + (size_t)mat * 2048 * 512; d.dst = (unsigned char*)(F.ws + WS_W13) + (size_t)mat * 1024 * 2048; d.N = 512; d.K = 2048;
        d.drow0 = (n0 >> 7) * 256 + (n0 & 127) + (seg == 1 ? 128 : 0); d.k0 = 64 * kb; d.n0 = n0; d.f8 = 1; }
    else { const int kb = r >> 6, nb = r & 63;
        d.src = a.in[I_W2] + (size_t)mat * 512 * 2048; d.dst = (unsigned char*)(F.ws + WS_W2) + (size_t)mat * 512 * 2048; d.N = 2048; d.K = 512; d.drow0 = 32 * nb; d.k0 = 64 * kb; d.n0 = 32 * nb; d.f8 = 1; }
    return d;
}
#define CV_LOAD(t_, d_) do { const float* p_ = (d_).src + (size_t)((d_).k0 + (F.lane >> 3)) * (d_).N + (d_).n0 + 4 * (F.lane & 7); const size_t st_ = (size_t)8 * (d_).N; \
    _Pragma("unroll") for (int i_ = 0; i_ < 8; ++i_) (t_)[i_] = *(const GAS f32x4*)(p_ + st_ * i_); } while (0)
__device__ __forceinline__ void conv_process(Frame& F, f32x4 (&t)[8], const CDesc& d) {
    LAS float* scr = (LAS float*)(F.lds + RING_OFF + F.wave * 16384); const int lane = F.lane;
    asm volatile("" : "+v"(t[0]), "+v"(t[1]), "+v"(t[2]), "+v"(t[3]), "+v"(t[4]), "+v"(t[5]), "+v"(t[6]), "+v"(t[7]));
    { LAS float* w = scr + (lane >> 3) * 33 + 4 * (lane & 7);
#pragma unroll
      for (int i = 0; i < 8; ++i) { w[i * 8 * 33 + 0] = t[i].x; w[i * 8 * 33 + 1] = t[i].y; w[i * 8 * 33 + 2] = t[i].z; w[i * 8 * 33 + 3] = t[i].w; } }
    LDS_WAIT(); asm volatile("" ::: "memory");
    const int c = lane & 7;
    if (d.f8) {
#pragma unroll
        for (int j = 0; j < 4; ++j) { const int n = (lane >> 3) + 8 * j; const LAS float* s = scr + (8 * c) * 33 + n;
            unsigned lo = 0u, hi = 0u;
            lo = __builtin_amdgcn_cvt_pk_fp8_f32(s[0 * 33] * 64.f, s[1 * 33] * 64.f, lo, false); lo = __builtin_amdgcn_cvt_pk_fp8_f32(s[2 * 33] * 64.f, s[3 * 33] * 64.f, lo, true);
            hi = __builtin_amdgcn_cvt_pk_fp8_f32(s[4 * 33] * 64.f, s[5 * 33] * 64.f, hi, false); hi = __builtin_amdgcn_cvt_pk_fp8_f32(s[6 * 33] * 64.f, s[7 * 33] * 64.f, hi, true);
            v2u o; o.x = lo; o.y = hi; *(GAS v2u*)(d.dst + (size_t)(d.drow0 + n) * d.K + d.k0 + 8 * c) = o; }
    } else {
#pragma unroll
        for (int j = 0; j < 4; ++j) { const int n = (lane >> 3) + 8 * j; const LAS float* s = scr + (8 * c) * 33 + n;
            v4u o; o.x = pk2(s[0 * 33], s[1 * 33]); o.y = pk2(s[2 * 33], s[3 * 33]); o.z = pk2(s[4 * 33], s[5 * 33]); o.w = pk2(s[6 * 33], s[7 * 33]);
            *(GAS v4u*)((bf16*)d.dst + (size_t)(d.drow0 + n) * d.K + d.k0 + 8 * c) = o; }
    }
    LDS_WAIT(); asm volatile("" ::: "memory");
}
__device__ __forceinline__ void conv_range(Frame& F, const Args& a, int q, int first, int cnt) {
#if CDEPTH == 1
    for (int i = 0; i < cnt; ++i) conv_item(F, a, q, first + i);
#else
    f32x4 t[CDEPTH][8]; const int last = first + cnt - 1;
#pragma unroll
    for (int s = 0; s < CDEPTH - 1; ++s) { const int it = first + s < last ? first + s : last; const CDesc d = conv_desc(F, a, q, it); CV_LOAD(t[s], d); }
#pragma unroll 1
    for (int i0 = 0; i0 < cnt; i0 += CDEPTH) {
#pragma unroll
        for (int s = 0; s < CDEPTH; ++s) {
            { const int nx = first + i0 + s + CDEPTH - 1, it = nx < last ? nx : last; const CDesc d = conv_desc(F, a, q, it); CV_LOAD(t[(s + CDEPTH - 1) % CDEPTH], d); }
            asm volatile("" ::: "memory");
            if (i0 + s < cnt) { const CDesc d = conv_desc(F, a, q, first + i0 + s); conv_process(F, t[s], d); }
        }
    }
#endif
}
__device__ __forceinline__ void conv_filler(Frame& F, const Args& a, int q0, int n) {
    if (q0 >= NQ || n == 0) return;
#ifdef CONV_ALL_PRO
    return;
#endif
    LAS unsigned* bw = (LAS unsigned*)(F.lds + TAB_OFF + 384);
    __syncthreads();
    const bool drain = n < 0; const int per = drain ? CDRAIN : n; int q = q0;
    for (;;) {
        if (F.tid == 0) bw[0] = __hip_atomic_fetch_add(F.ctl + CW_CONV + 64 * q, (unsigned)(8 * per), RLX_AGENT);
        __syncthreads();
        const unsigned idx = bw[0];
        __syncthreads();
        const int qs = conv_qsize(q);
        if (idx >= (unsigned)qs) { if (drain || ++q >= NQ) break; continue; }
        { const int first = (int)idx + F.wave * per, cnt = (qs - first < per) ? qs - first : per; if (cnt > 0) conv_range(F, a, q, first, cnt); }
        if (!drain) break;
    }
}

__device__ __forceinline__ void prologue_phase(Frame& F, const Args& a) {
#ifdef TOUCH
    {
        const long nthr_ = (long)F.G * 512, gt_ = (long)F.c * 512 + F.tid; unsigned acc_ = 0u;
        for (long pg = gt_; pg < (long)(WS_END / 4096); pg += nthr_) acc_ += *(const GAS unsigned*)(F.ws + pg * 4096);
        for (long pg = gt_; pg < (long)((size_t)DEPTH * NE * D * FF * 4 / 4096); pg += nthr_) { acc_ += *(const GAS unsigned*)((const char*)a.in[I_W1] + pg * 4096); acc_ += *(const GAS unsigned*)((const char*)a.in[I_W3] + pg * 4096); acc_ += *(const GAS unsigned*)((const char*)a.in[I_W2] + pg * 4096); }
        if (acc_ == 0x12345679u) F.ctl[CW_TMO] = acc_;
    }
#endif
    LAS float* scr = (LAS float*)(F.lds + RING_OFF + F.wave * 16384);
    const int gw = F.c * NWAVES + F.wave, NGW = F.G * NWAVES;
    unsigned char* ws = F.ws;
    constexpr int S0 = 3584, S1 = 2048, S5 = 4 * 1024;
    constexpr int NITEMS = S0 + S1 + S5;
    for (int it = gw; it < NITEMS; it += NGW) {
        int r = it; const float* src; unsigned char* dst; int K = 2048, N; bool f8 = F8L(0);
        if (r < S0) { N = 3584; src = a.in[I_AWIN]; dst = ws + WS_WAIN; }
        else if ((r -= S0) < S1) { N = 2048; f8 = false; src = a.in[I_AWOUT]; dst = ws + WS_WAOUT; }
        else { r -= S1; const int mat = r >> 10; r &= 1023; N = 1024; src = a.in[I_MEMWKV] + (size_t)mat * K * N; dst = ws + WS_WMKV + (size_t)mat * K * N * (F8L(0) ? 1 : 2); }
        const int nblk = N / 32, kb = r / nblk, nb = r - kb * nblk;
        if (f8) transpose_item_fp8(src, K, N, dst, 32 * nb, scr, 64 * kb, 32 * nb, F.lane);
        else transpose_item_fast(src, K, N, (bf16*)dst, 32 * nb, scr, 64 * kb, 32 * nb, F.lane);
    }
#ifdef CONV_ALL_PRO
    for (int q = 0; q < NQ; ++q) { const int qs = conv_qsize(q); for (int it = gw * 4; it < qs; it += NGW * 4) conv_range(F, a, q, it, qs - it < 4 ? qs - it : 4); }
#endif
    const long nthr = (long)F.G * 512, gt = (long)F.c * 512 + F.tid;
    { float* wr = (float*)(ws + WS_WR);
      for (long i = gt; i < (long)DEPTH * 3 * 512 * 16 * 4; i += nthr) { const int j = (int)(i & 3), c = (int)((i >> 2) & 15), kg = (int)((i >> 6) & 511), r = (int)(i >> 15), nb = r % 3, l = r / 3;
          const int k = 4 * kg + j, o = 16 * nb + c; float v = 0.f;
          if (o < 4) v = a.in[I_WG1][((size_t)l * D + k) * 4 + o]; else if (o < 36) { const int g = (o - 4) >> 3, e = (o - 4) & 7; v = a.in[I_WG2][(((size_t)l * 4 + g) * D + k) * 8 + e]; }
          wr[i] = v; } }
    { const float* x = a.in[I_X]; bf16* xb = (bf16*)(ws + WS_XB);
      for (long i = gt; i < (long)T * D / 8; i += nthr) { const f32x4 v0 = *(const GAS f32x4*)(x + i * 8), v1 = *(const GAS f32x4*)(x + i * 8 + 4);
          v4u o; o.x = pk2(v0.x, v0.y); o.y = pk2(v0.z, v0.w); o.z = pk2(v1.x, v1.y); o.w = pk2(v1.z, v1.w); *(GAS v4u*)(xb + i * 8) = o;
          unsigned lo = 0u, hi = 0u; lo = __builtin_amdgcn_cvt_pk_fp8_f32(v0.x, v0.y, lo, false); lo = __builtin_amdgcn_cvt_pk_fp8_f32(v0.z, v0.w, lo, true); hi = __builtin_amdgcn_cvt_pk_fp8_f32(v1.x, v1.y, hi, false); hi = __builtin_amdgcn_cvt_pk_fp8_f32(v1.z, v1.w, hi, true);
          v2u qq; qq.x = lo; qq.y = hi; if (F8L(0)) *(GAS v2u*)(ws + WS_XQ + i * 8) = qq; } }
    { const float* x = a.in[I_MEM]; bf16* xb = (bf16*)(ws + WS_MEMB);
      for (long i = gt; i < (long)MEMT * D / 8; i += nthr) { const f32x4 v0 = *(const GAS f32x4*)(x + i * 8), v1 = *(const GAS f32x4*)(x + i * 8 + 4);
          v4u o; o.x = pk2(v0.x, v0.y); o.y = pk2(v0.z, v0.w); o.z = pk2(v1.x, v1.y); o.w = pk2(v1.z, v1.w); *(GAS v4u*)(xb + i * 8) = o;
          unsigned lo = 0u, hi = 0u; lo = __builtin_amdgcn_cvt_pk_fp8_f32(v0.x, v0.y, lo, false); lo = __builtin_amdgcn_cvt_pk_fp8_f32(v0.z, v0.w, lo, true); hi = __builtin_amdgcn_cvt_pk_fp8_f32(v1.x, v1.y, hi, false); hi = __builtin_amdgcn_cvt_pk_fp8_f32(v1.z, v1.w, hi, true);
          v2u qq; qq.x = lo; qq.y = hi; *(GAS v2u*)(ws + WS_MEMQ + i * 8) = qq; } }
}

#ifndef NCVMAX
#define NCVMAX 0
#endif
#ifndef NCVATT
#define NCVATT 96
#endif
__device__ __forceinline__ int conv_servers(int nu, int G, int fin) {
    if (fin || nu <= 0) return 0;
    const int rounds = (nu + G - 1) / G, gmin = (nu + rounds - 1) / rounds; int n = G - gmin; n = n < NCVMAX ? n : NCVMAX; return n & ~7;
}
__device__ __forceinline__ void conv_done(Frame& F, int p) { __syncthreads(); if (F.tid == 0) __hip_atomic_fetch_add(F.ctl + CW_DONE + 64 * p, 1u, RLX_AGENT); }
__device__ __forceinline__ void conv_server(Frame& F, const Args& a, int p, int q0, int ncomp) {
    int q = q0;
    for (;;) {
        if (q >= NQ) break;
        unsigned idx = 0xffffffffu;
        if (F.lane == 0) { if (__hip_atomic_load(F.ctl + CW_DONE + 64 * p, RLX_AGENT) < (unsigned)ncomp) idx = __hip_atomic_fetch_add(F.ctl + CW_CONV + 64 * q, (unsigned)CSRV, RLX_AGENT); }
        idx = (unsigned)__builtin_amdgcn_readfirstlane((int)idx);
        if (idx == 0xffffffffu) break;
        const int qs = conv_qsize(q);
        if (idx >= (unsigned)qs) { ++q; continue; }
        conv_range(F, a, q, (int)idx, (qs - (int)idx < CSRV) ? qs - (int)idx : CSRV);
    }
}
__device__ __forceinline__ void conv_server_q(Frame& F, const Args& a, gu32* head, unsigned stop_at, int q0) {
    int q = q0;
    for (;;) {
        if (q >= NQ) break;
        unsigned idx = 0xffffffffu;
        if (F.lane == 0) { if (__hip_atomic_load(head, RLX_AGENT) < stop_at) idx = __hip_atomic_fetch_add(F.ctl + CW_CONV + 64 * q, (unsigned)CSRVA, RLX_AGENT); }
        idx = (unsigned)__builtin_amdgcn_readfirstlane((int)idx);
        if (idx == 0xffffffffu) break;
        const int qs = conv_qsize(q);
        if (idx >= (unsigned)qs) { ++q; continue; }
        conv_range(F, a, q, (int)idx, (qs - (int)idx < CSRVA) ? qs - (int)idx : CSRVA);
    }
}
__device__ __forceinline__ void conv_note_fin(Frame& F, int p) {
    if (blockIdx.x == 0 && F.tid < 64) {
        const int q = F.lane < NQ ? F.lane : 0;
        const bool ok = __hip_atomic_load(F.ctl + CW_CONV + 64 * q, RLX_AGENT) >= (unsigned)conv_qsize(q);
        const unsigned all = __all(ok) ? 1u : 0u;
        if (F.lane == 0) __hip_atomic_store(F.ctl + CW_FIN + 64 * p, all, RLX_AGENT); }
}

__device__ __forceinline__ void sgu_unit(Frame& F, const Args& a, int l, int n, int g) {
    constexpr int LDW = 136;
    LAS float* stats = (LAS float*)(F.lds); LAS bf16* Wl = (LAS bf16*)(F.lds + 1024); LAS bf16* Vt = (LAS bf16*)(F.lds + 35840);
    const bf16* z = (const bf16*)(F.ws + WS_Z); bf16* cat = (bf16*)(F.ws + WS_CAT);
    const int tok0 = n * 128;
    if (F.tid < 128) { const float* vs = (const float*)(F.ws + WS_VSTAT) + (size_t)(tok0 + F.tid) * 2; float s = 0.f, q = 0.f;
#pragma unroll
        for (int p = 0; p < 24; ++p) { const pg8::f32x2 st_ = *(const GAS pg8::f32x2*)(vs + (size_t)p * 8192 * 2); s += st_.x; q += st_.y; }
        const float mean = s * (1.f / MIXW), var = fmaxf(q * (1.f / MIXW) - mean * mean, 0.f);
        stats[2 * F.tid] = mean; stats[2 * F.tid + 1] = 1.f / sqrtf(var + LN_EPS); }
    { const float* wsrc = a.in[I_AWS] + ((size_t)l * 4 + g) * 128 * 128;
      for (int p = F.tid; p < 128 * 32; p += 512) { const int i = p >> 5, j4 = (p & 31) * 4; f32x4 v = *(const GAS f32x4*)(wsrc + i * 128 + j4);
          if ((j4 >> 6) > (i >> 6)) v = (f32x4){0.f, 0.f, 0.f, 0.f};
          v2u o; o.x = pk2(v.x, v.y); o.y = pk2(v.z, v.w); *(LAS v2u*)(Wl + i * LDW + j4) = o; } }
    __syncthreads();
    { const float* lg = a.in[I_ALNG] + (size_t)l * MIXW + g * 384; const float* lb = a.in[I_ALNB] + (size_t)l * MIXW + g * 384;
      for (int p = F.tid; p < 128 * 48; p += 512) { const int j = p & 127, c8 = (p >> 7) * 8;
          const v4u w = *(const GAS v4u*)(z + (size_t)(tok0 + j) * NINA + MIXW + g * 384 + c8);
          const float mean = stats[2 * j], rstd = stats[2 * j + 1];
          const f32x4 g0 = *(const GAS f32x4*)(lg + c8), g1 = *(const GAS f32x4*)(lg + c8 + 4), b0 = *(const GAS f32x4*)(lb + c8), b1 = *(const GAS f32x4*)(lb + c8 + 4);
          float v[8] = {bflo(w.x), bfhi(w.x), bflo(w.y), bfhi(w.y), bflo(w.z), bfhi(w.z), bflo(w.w), bfhi(w.w)};
          const float gg[8] = {g0.x, g0.y, g0.z, g0.w, g1.x, g1.y, g1.z, g1.w}, bb[8] = {b0.x, b0.y, b0.z, b0.w, b1.x, b1.y, b1.z, b1.w};
#pragma unroll
          for (int e = 0; e < 8; ++e) Vt[(c8 + e) * LDW + j] = (bf16)f2bf((v[e] - mean) * rstd * gg[e] + bb[e]); } }
    __syncthreads();
    const int fr = F.lane & 15, fq = F.lane >> 4;
    f32x4 acc[8][3];
#pragma unroll
    for (int mb = 0; mb < 8; ++mb)
#pragma unroll
        for (int nb = 0; nb < 3; ++nb) acc[mb][nb] = (f32x4){0.f, 0.f, 0.f, 0.f};
#pragma unroll
    for (int ks = 0; ks < 4; ++ks) { bf16x8 bfr[3];
#pragma unroll
        for (int nb = 0; nb < 3; ++nb) bfr[nb] = *(const LAS bf16x8*)(Vt + (F.wave * 48 + nb * 16 + fr) * LDW + ks * 32 + fq * 8);
#pragma unroll
        for (int mb = 0; mb < 8; ++mb) { const bf16x8 afr = *(const LAS bf16x8*)(Wl + (mb * 16 + fr) * LDW + ks * 32 + fq * 8);
#pragma unroll
            for (int nb = 0; nb < 3; ++nb) acc[mb][nb] = __builtin_amdgcn_mfma_f32_16x16x32_bf16(bfr[nb], afr, acc[mb][nb], 0, 0, 0); } }
    const float* bs = a.in[I_ABS] + ((size_t)l * 4 + g) * 128;
#pragma unroll
    for (int mb = 0; mb < 8; ++mb) { const int i = mb * 16 + fr; const float bsv = bs[i]; const size_t tk = (size_t)(tok0 + i);
#pragma unroll
        for (int nb = 0; nb < 3; ++nb) { const int c = g * 384 + F.wave * 48 + nb * 16 + 4 * fq;
            const v2u uw = *(const GAS v2u*)(z + tk * NINA + c); const f32x4 gt = acc[mb][nb] + bsv;
            v2u o; o.x = pk2(bflo(uw.x) * gt.x, bfhi(uw.x) * gt.y); o.y = pk2(bflo(uw.y) * gt.z, bfhi(uw.y) * gt.w);
            *(GAS v2u*)(cat + tk * D + c) = o; } }
    __syncthreads();
}

__device__ __forceinline__ void memattn_unit(Frame& F, int l, int hm, int qb, int ldz, int qoff) {
    const bf16* z = (const bf16*)(F.ws + WS_Z); const bf16* kv = (const bf16*)(F.ws + WS_MEMKV) + (size_t)l * 256 * 1024; bf16* cat = (bf16*)(F.ws + WS_CAT);
    att::attn_body<0>(z + (size_t)qb * 256 * ldz + qoff + hm * 128, ldz, kv + hm * 128, kv + 512 + hm * 128, 1024,
                      cat + (size_t)qb * 256 * D + MIXW + hm * 128, nullptr, D, 4, 0, nullptr, 0.f, F.ldsg);
}

__device__ __forceinline__ int t5_bucket(int rel) {
    const int a = rel < 0 ? -rel : rel; int f;
    if (a < 8) f = a; else if (a < 12) f = 8; else if (a < 16) f = 9; else if (a < 23) f = 10; else if (a < 32) f = 11; else if (a < 46) f = 12; else if (a < 64) f = 13; else if (a < 91) f = 14; else f = 15;
    return (rel > 0 ? 16 : 0) + f;
}

namespace att2 {
using att::bf16x8; using att::s16x4; using att::f32x16; using att::u32x4; using att::crow; using att::cvtpk; using att::tr_read; using att::v_rd_base;
constexpr int KT = 32, ST_K = KT * 128 * 2, ST_V = KT * 256 * 2, STAGE = 2 * ST_K + ST_V, NST = 3;
constexpr int LDS_WS = NST * STAGE, LDS_TAB = LDS_WS + 2048, LDS_UNIT = LDS_TAB + 640, LDS_END = LDS_UNIT + 16;
constexpr int NUNITS = 576;
constexpr float THR2 = 8.f * 1.4426950408889634f;
__device__ __forceinline__ int swap23(int k) { return (k & ~0xC) | ((k & 4) << 1) | ((k & 8) >> 1); }
constexpr int v_off(int d0, int ks, int half) { return d0 * 512 + ks * 8192 + half * 4096; }

struct UnitTable { unsigned short u[NUNITS]; };
constexpr UnitTable make_units() {
    UnitTable t{}; int n = 0;
    for (int c = 256; c >= 4; c -= 2) {
        { const int b = (c - 2) / 2; if ((c - 2) % 2 == 0 && b >= 32 && b <= 63) for (int part = 1; part <= 2; ++part) for (int h = 0; h < 6; ++h) t.u[n++] = (unsigned short)(h | (b << 3) | (part << 9)); }
        if (c % 4 == 0) { const int b = c / 4 - 1; if (b >= 0 && b < 32) for (int h = 0; h < 6; ++h) t.u[n++] = (unsigned short)(h | (b << 3)); }
    }
    return t;
}
__device__ const UnitTable g_units = make_units();

__device__ __forceinline__ void diff_unit(const bf16* __restrict__ Q, const bf16* __restrict__ KD, const bf16* __restrict__ VD, float* Obuf  , int orow0,
                                          float* ML  , const float* relb, int h, int b, int t_lo, int t_hi, LAS char* lds) {
  int tid_ = threadIdx.x; asm volatile("" : "+v"(tid_));
  const int tid = tid_, wid = __builtin_amdgcn_readfirstlane(tid >> 6), lane = tid & 63, r32 = lane & 31, hi = lane >> 5, m = wid >> 2, rg = wid & 3;
  LAS float* wsw = (LAS float*)(lds + LDS_WS) + wid * 64; LAS float* li_l = wsw; LAS float* al_l = wsw + 32;
  LAS float* tab = (LAS float*)(lds + LDS_TAB);
  if (tid < att::TAB_N) tab[tid] = relb[t5_bucket(63 - tid) * 6 + h] * LOG2E;
  const float cfar = relb[15 * 6 + h] * LOG2E;
  const int qrow0 = b * 128 + rg * 32;
  bf16x8 qr[8];
  { const bf16* Qw = Q + (size_t)(qrow0 + r32) * 2048 + h * 256 + m * 128 + hi * 8;
#pragma unroll
    for (int d0 = 0; d0 < 8; ++d0) qr[d0] = *reinterpret_cast<const bf16x8*>(Qw + d0 * 16); }
  int ko[2], vo[2];
#pragma unroll
  for (int i = 0; i < 2; ++i) {
    const int p = wid * 64 + lane, row = p >> 4, cp = (p & 15) ^ (row & 7); ko[i] = row * 1536 + h * 256 + i * 128 + cp * 8; }
#pragma unroll
  for (int i = 0; i < 2; ++i) {
    const int p = (wid * 2 + i) * 64 + lane, sub = p >> 5, kg = sub >> 3, cblk = sub & 7, q = p & 31, kk = kg * 8 + (q >> 2), key = swap23(kk);
    vo[i] = key * 1536 + h * 256 + cblk * 32 + (q & 3) * 8; }
  const unsigned ldsb = (unsigned)(uintptr_t)lds;
#define A2_ISSUE(t, s) do { const size_t kb_ = (size_t)(t) * KT * 1536; LAS char* sb_ = lds + (s) * STAGE; \
    __builtin_amdgcn_global_load_lds((const unsigned*)(KD + kb_ + ko[0]), (LAS unsigned*)(sb_ + wid * 1024), 16, 0, 0); \
    __builtin_amdgcn_global_load_lds((const unsigned*)(KD + kb_ + ko[1]), (LAS unsigned*)(sb_ + ST_K + wid * 1024), 16, 0, 0); \
    __builtin_amdgcn_global_load_lds((const unsigned*)(VD + kb_ + vo[0]), (LAS unsigned*)(sb_ + 2 * ST_K + (wid * 2) * 1024), 16, 0, 0); \
    __builtin_amdgcn_global_load_lds((const unsigned*)(VD + kb_ + vo[1]), (LAS unsigned*)(sb_ + 2 * ST_K + (wid * 2 + 1) * 1024), 16, 0, 0); } while (0)
  const int vis = 2 * (2 * b + (rg >> 1) + 1);
  float m_reg = -1e30f, l_reg = 0.f; f32x16 o[8];
#pragma unroll
  for (int d = 0; d < 8; ++d) o[d] = f32x16{};
  asm volatile("s_waitcnt vmcnt(0)" ::: "memory");
  A2_ISSUE(t_lo, 0); if (t_lo + 1 < t_hi) A2_ISSUE(t_lo + 1, 1);
  int s = 0;
  for (int t = t_lo; t < t_hi; ++t) {
    if (t + 1 < t_hi) asm volatile("s_waitcnt vmcnt(4) lgkmcnt(0)" ::: "memory"); else asm volatile("s_waitcnt vmcnt(0) lgkmcnt(0)" ::: "memory");
    __builtin_amdgcn_s_barrier(); asm volatile("" ::: "memory");
    if (t + 2 < t_hi) { const int s2 = (s >= 1) ? s - 1 : s + 2; A2_ISSUE(t + 2, s2); }
    if (t < vis) {
      const LAS char* Ks = lds + s * STAGE + m * ST_K;
      f32x16 p = f32x16{};
#pragma unroll
      for (int d0 = 0; d0 < 8; ++d0) { const int cb = (d0 * 16 + hi * 8) * 2;
        const bf16x8 b0 = *(const LAS bf16x8*)(Ks + KSWZ(r32, cb));
        p = __builtin_amdgcn_mfma_f32_32x32x16_bf16(b0, qr[d0], p, 0, 0, 0); }
      if (qrow0 - (KT * t + KT - 1) >= 91) {
#pragma unroll
        for (int r = 0; r < 16; ++r) p[r] += cfar;
      } else { const int base = qrow0 + r32 - KT * t + 63;
#pragma unroll
        for (int r = 0; r < 16; ++r) { const int i0 = base - crow(r, hi); p[r] += tab[i0 < att::TAB_N - 1 ? i0 : att::TAB_N - 1]; } }
      float pmax = p[0];
#pragma unroll
      for (int r = 1; r < 16; ++r) pmax = fmaxf(pmax, p[r]);
      { auto rr = __builtin_amdgcn_permlane32_swap(__float_as_uint(pmax), __float_as_uint(pmax), false, false); pmax = fmaxf(__uint_as_float(rr[0]), __uint_as_float(rr[1])); }
      float mn, alpha;
      if (__builtin_expect(__all(pmax - m_reg <= THR2), 1)) { mn = m_reg; alpha = 1.f; }
      else { mn = fmaxf(m_reg, pmax); alpha = __builtin_amdgcn_exp2f(m_reg - mn); m_reg = mn; }
      float ps = 0.f;
#pragma unroll
      for (int r = 0; r < 16; ++r) { p[r] = __builtin_amdgcn_exp2f(p[r] - mn); ps += p[r]; }
      { auto rr = __builtin_amdgcn_permlane32_swap(__float_as_uint(ps), __float_as_uint(ps), false, false); ps = __uint_as_float(rr[0]) + __uint_as_float(rr[1]); }
      l_reg = l_reg * alpha + ps;
      bf16x8 pa0, pa1;
#define A2_PK4(P, BASE, OUT) do { unsigned a0 = cvtpk(P[BASE + 0], P[BASE + 1]), a1 = cvtpk(P[BASE + 2], P[BASE + 3]);   \
    unsigned b0_ = cvtpk(P[BASE + 4], P[BASE + 5]), b1_ = cvtpk(P[BASE + 6], P[BASE + 7]);                              \
    auto r0 = __builtin_amdgcn_permlane32_swap(a0, b0_, false, false); auto r1 = __builtin_amdgcn_permlane32_swap(a1, b1_, false, false); \
    u32x4 w = {r0[0], r1[0], r0[1], r1[1]}; OUT = *reinterpret_cast<bf16x8*>(&w); } while (0)
      A2_PK4(p, 0, pa0); A2_PK4(p, 8, pa1);
      if (__any(alpha < 1.f)) { if (hi == 0) al_l[r32] = alpha; asm volatile("s_waitcnt lgkmcnt(0)" ::: "memory");
#pragma unroll
        for (int d = 0; d < 8; ++d)
#pragma unroll
          for (int r = 0; r < 16; ++r) o[d][r] *= al_l[crow(r, hi)]; }
      const int vb = (int)(ldsb + s * STAGE + 2 * ST_K) + v_rd_base(lane);
      asm volatile("s_waitcnt lgkmcnt(0)" ::: "memory"); SBAR();
#define A2_PK(L, H) (bf16x8){L[0], L[1], L[2], L[3], H[0], H[1], H[2], H[3]}
#define A2_RD(D0, l0, h0, l1, h1) do { l0 = tr_read<v_off(D0, 0, 0)>(vb); h0 = tr_read<v_off(D0, 0, 1)>(vb); l1 = tr_read<v_off(D0, 1, 0)>(vb); h1 = tr_read<v_off(D0, 1, 1)>(vb); } while (0)
#define A2_MM(D0, l0, h0, l1, h1) do { o[D0] = __builtin_amdgcn_mfma_f32_32x32x16_bf16(pa0, A2_PK(l0, h0), o[D0], 0, 0, 0); o[D0] = __builtin_amdgcn_mfma_f32_32x32x16_bf16(pa1, A2_PK(l1, h1), o[D0], 0, 0, 0); } while (0)
      s16x4 xl0, xh0, xl1, xh1, yl0, yh0, yl1, yh1;
      A2_RD(0, xl0, xh0, xl1, xh1);
      A2_RD(1, yl0, yh0, yl1, yh1); asm volatile("s_waitcnt lgkmcnt(4)" ::: "memory"); SBAR(); A2_MM(0, xl0, xh0, xl1, xh1); SBAR();
      A2_RD(2, xl0, xh0, xl1, xh1); asm volatile("s_waitcnt lgkmcnt(4)" ::: "memory"); SBAR(); A2_MM(1, yl0, yh0, yl1, yh1); SBAR();
      A2_RD(3, yl0, yh0, yl1, yh1); asm volatile("s_waitcnt lgkmcnt(4)" ::: "memory"); SBAR(); A2_MM(2, xl0, xh0, xl1, xh1); SBAR();
      A2_RD(4, xl0, xh0, xl1, xh1); asm volatile("s_waitcnt lgkmcnt(4)" ::: "memory"); SBAR(); A2_MM(3, yl0, yh0, yl1, yh1); SBAR();
      A2_RD(5, yl0, yh0, yl1, yh1); asm volatile("s_waitcnt lgkmcnt(4)" ::: "memory"); SBAR(); A2_MM(4, xl0, xh0, xl1, xh1); SBAR();
      A2_RD(6, xl0, xh0, xl1, xh1); asm volatile("s_waitcnt lgkmcnt(4)" ::: "memory"); SBAR(); A2_MM(5, yl0, yh0, yl1, yh1); SBAR();
      A2_RD(7, yl0, yh0, yl1, yh1); asm volatile("s_waitcnt lgkmcnt(4)" ::: "memory"); SBAR(); A2_MM(6, xl0, xh0, xl1, xh1); SBAR();
      asm volatile("s_waitcnt lgkmcnt(0)" ::: "memory"); SBAR(); A2_MM(7, yl0, yh0, yl1, yh1); SBAR();
    }
    s = (s == 2) ? 0 : s + 1;
  }
  if (hi == 0) li_l[r32] = l_reg; asm volatile("s_waitcnt lgkmcnt(0)" ::: "memory");
  float rli[16];
#pragma unroll
  for (int r = 0; r < 16; ++r) rli[r] = __builtin_amdgcn_rcpf(li_l[crow(r, hi)]);
  float* Ow = Obuf + (size_t)(qrow0 - orow0) * 3072 + (h * 2 + m) * 256;
#pragma unroll
  for (int r = 0; r < 16; ++r) { const int orow = crow(r, hi);
#pragma unroll
    for (int d0 = 0; d0 < 8; ++d0) Ow[(size_t)orow * 3072 + d0 * 32 + r32] = o[d0][r] * rli[r]; }
  if (hi == 0) { float* mlp = ML + (((size_t)(qrow0 - orow0 + r32) * 6 + h) * 2 + m) * 2; mlp[0] = m_reg; mlp[1] = l_reg; }
  asm volatile("s_waitcnt vmcnt(0) lgkmcnt(0)" ::: "memory");
  __builtin_amdgcn_s_barrier(); asm volatile("" ::: "memory");
#undef A2_ISSUE
#undef A2_PK4
#undef A2_PK
#undef A2_RD
#undef A2_MM
}
}

namespace att3 {
using att::f32x16; using att::crow;
typedef int v8i __attribute__((ext_vector_type(8))); typedef int v4i __attribute__((ext_vector_type(4)));
constexpr int KT = 64, ST_K = KT * 128, ST_V = 256 * 64, STAGE = ST_K + ST_V, NST = 4;
struct UnitTable { unsigned short u[att2::NUNITS]; };
constexpr UnitTable make_units() {
    UnitTable t{}; int n = 0;
    for (int L = 64; L >= 4; L -= 2) {
        if ((L - 2) % 2 == 0) { const int b = (L - 2) / 2; if (b >= 16 && b < 32) for (int part = 1; part <= 2; ++part) for (int hm = 0; hm < 12; ++hm) t.u[n++] = (unsigned short)((hm >> 1) | ((hm & 1) << 3) | (b << 4) | (part << 9)); }
        if (L % 4 == 0) { const int b = L / 4 - 1; if (b >= 0 && b < 16) for (int hm = 0; hm < 12; ++hm) t.u[n++] = (unsigned short)((hm >> 1) | ((hm & 1) << 3) | (b << 4)); }
    }
    return t;
}
__device__ const UnitTable g_units = make_units();
static_assert(NST * STAGE == att2::LDS_WS, "same ring size as att2");
constexpr float THR2 = 2.f;
__device__ __forceinline__ v8i cat8(v4i a, v4i b) { return __builtin_shufflevector(a, b, 0, 1, 2, 3, 4, 5, 6, 7); }
__device__ __forceinline__ void diff_unit(const unsigned char* __restrict__ Q8, const unsigned char* __restrict__ K8, const unsigned char* __restrict__ VT, float* Obuf, int orow0,
                                          float* ML, const float* relb, int h, int m, int b, int t_lo, int t_hi, LAS char* lds) {
  int tid_ = threadIdx.x; asm volatile("" : "+v"(tid_));
  const int tid = tid_, wid = __builtin_amdgcn_readfirstlane(tid >> 6), lane = tid & 63, r32 = lane & 31, hi = lane >> 5, rg = wid;
  LAS float* wsw = (LAS float*)(lds + att2::LDS_WS) + wid * 64; LAS float* li_l = wsw; LAS float* al_l = wsw + 32;
  LAS float* tab = (LAS float*)(lds + att2::LDS_TAB);
  if (tid < att::TAB_N) tab[tid] = relb[t5_bucket(63 - tid) * 6 + h] * LOG2E;
  const float cfar = relb[15 * 6 + h] * LOG2E;
  const int qrow0 = b * 256 + rg * 32;
  v8i q8[2];
  { const unsigned char* Qw = Q8 + (size_t)(qrow0 + r32) * 2048 + h * 256 + m * 128 + hi * 32;
#pragma unroll
    for (int c = 0; c < 2; ++c) q8[c] = cat8(*(const GAS v4i*)(Qw + 64 * c), *(const GAS v4i*)(Qw + 64 * c + 16)); }
  int ko, vo[2];
  { const int p = wid * 64 + lane, row = p >> 3, cp = (p & 7) ^ (row & 7); ko = row * 1536 + h * 256 + m * 128 + cp * 16; }
#pragma unroll
  for (int i = 0; i < 2; ++i) { const int p = (wid * 2 + i) * 64 + lane, d = p >> 2, cp = (p & 3) ^ ((d >> 1) & 3); vo[i] = d * 64 + cp * 16; }
  const unsigned char* VTh = VT + (size_t)h * 128 * 16384;
#define A3_ISSUE(t, s) do { const size_t kb_ = (size_t)(t) * KT * 1536; LAS char* sb_ = lds + (s) * STAGE; \
    __builtin_amdgcn_global_load_lds((const unsigned*)(K8 + kb_ + ko), (LAS unsigned*)(sb_ + wid * 1024), 16, 0, 0); \
    __builtin_amdgcn_global_load_lds((const unsigned*)(VTh + (size_t)(t) * 16384 + vo[0]), (LAS unsigned*)(sb_ + ST_K + (wid * 2) * 1024), 16, 0, 0); \
    __builtin_amdgcn_global_load_lds((const unsigned*)(VTh + (size_t)(t) * 16384 + vo[1]), (LAS unsigned*)(sb_ + ST_K + (wid * 2 + 1) * 1024), 16, 0, 0); } while (0)
  const int vis = 4 * b + (rg >> 1) + 1;
  float m_reg = -1e30f, l_reg = 0.f; f32x16 o[8];
#pragma unroll
  for (int d = 0; d < 8; ++d) o[d] = f32x16{};
  const int kx = (r32 & 7), koff0 = r32 * 128 + (((2 * hi) ^ kx) << 4), koff1 = r32 * 128 + (((2 * hi + 1) ^ kx) << 4);
  const int vx = (r32 >> 1) & 3, voff0 = r32 * 64 + (((2 * hi) ^ vx) << 4), voff1 = r32 * 64 + (((2 * hi + 1) ^ vx) << 4);
  int sclP = 121, scl1 = 127; asm volatile("" : "+v"(sclP), "+v"(scl1));
  asm volatile("s_waitcnt vmcnt(0)" ::: "memory");
  A3_ISSUE(t_lo, 0); if (t_lo + 1 < t_hi) A3_ISSUE(t_lo + 1, 1); if (t_lo + 2 < t_hi) A3_ISSUE(t_lo + 2, 2);
  int s = 0;
  for (int t = t_lo; t < t_hi; ++t) {
    if (t + 2 < t_hi) asm volatile("s_waitcnt vmcnt(6) lgkmcnt(0)" ::: "memory"); else if (t + 1 < t_hi) asm volatile("s_waitcnt vmcnt(3) lgkmcnt(0)" ::: "memory"); else asm volatile("s_waitcnt vmcnt(0) lgkmcnt(0)" ::: "memory");
    __builtin_amdgcn_s_barrier(); asm volatile("" ::: "memory");
    if (t + 3 < t_hi) A3_ISSUE(t + 3, (s + 3) & 3);
    if (t < vis) {
      const LAS char* Ks = lds + s * STAGE;
      f32x16 p0 = f32x16{}, p1 = f32x16{};
#pragma unroll
      for (int c = 0; c < 2; ++c) {
        const int x0 = koff0 ^ (c << 6), x1 = koff1 ^ (c << 6);
        const v8i k0 = cat8(*(const LAS v4i*)(Ks + x0), *(const LAS v4i*)(Ks + x1));
        const v8i k1 = cat8(*(const LAS v4i*)(Ks + 4096 + x0), *(const LAS v4i*)(Ks + 4096 + x1));
        asm volatile("v_mfma_scale_f32_32x32x64_f8f6f4 %0, %1, %2, %0, %3, %3 op_sel_hi:[0,0,0]" : "+v"(p0) : "v"(k0), "v"(q8[c]), "v"(scl1));
        asm volatile("v_mfma_scale_f32_32x32x64_f8f6f4 %0, %1, %2, %0, %3, %3 op_sel_hi:[0,0,0]" : "+v"(p1) : "v"(k1), "v"(q8[c]), "v"(scl1)); }
      asm volatile("s_nop 15\n s_nop 7" : "+v"(p0), "+v"(p1));
      const bool far = qrow0 - (KT * t + KT - 1) >= 91;
      if (!far) { const int base = qrow0 + r32 - KT * t + 63;
#pragma unroll
        for (int r = 0; r < 16; ++r) { const int i0 = base - crow(r, hi), i1 = i0 - 32; p0[r] += tab[i0 < att::TAB_N - 1 ? i0 : att::TAB_N - 1]; p1[r] += tab[i1 < att::TAB_N - 1 ? i1 : att::TAB_N - 1]; } }
      const float cb = far ? cfar : 0.f;
      float pmax;
      asm("v_max3_f32 %0, %1, %2, %3" : "=v"(pmax) : "v"(p0[0]), "v"(p1[0]), "v"(p0[1]));
      asm("v_max3_f32 %0, %1, %2, %3" : "=v"(pmax) : "v"(pmax), "v"(p1[1]), "v"(p0[2]));
#pragma unroll
      for (int r = 2; r < 15; ++r) asm("v_max3_f32 %0, %1, %2, %3" : "=v"(pmax) : "v"(pmax), "v"(p1[r]), "v"(p0[r + 1]));
      asm("v_max_f32 %0, %1, %2" : "=v"(pmax) : "v"(pmax), "v"(p1[15]));
      pmax += cb;
      { auto rr = __builtin_amdgcn_permlane32_swap(__float_as_uint(pmax), __float_as_uint(pmax), false, false); asm("v_max_f32 %0, %1, %2" : "=v"(pmax) : "v"(__uint_as_float(rr[0])), "v"(__uint_as_float(rr[1]))); }
      float mn, alpha;
      if (__builtin_expect(__all(pmax - m_reg <= THR2), 1)) { mn = m_reg; alpha = 1.f; }
      else { mn = fmaxf(m_reg, pmax); alpha = __builtin_amdgcn_exp2f(m_reg - mn); m_reg = mn; }
      typedef float f32x2v __attribute__((ext_vector_type(2)));
      const float off = cb - (mn - 6.f); const f32x2v off2 = {off, off}; f32x2v ps2 = {0.f, 0.f};
#pragma unroll
      for (int r = 0; r < 16; r += 2) {
        f32x2v a = (f32x2v){p0[r], p0[r + 1]} + off2, c2 = (f32x2v){p1[r], p1[r + 1]} + off2;
        p0[r] = __builtin_amdgcn_exp2f(a.x); p0[r + 1] = __builtin_amdgcn_exp2f(a.y); p1[r] = __builtin_amdgcn_exp2f(c2.x); p1[r + 1] = __builtin_amdgcn_exp2f(c2.y);
        ps2 += (f32x2v){p0[r], p0[r + 1]}; ps2 += (f32x2v){p1[r], p1[r + 1]}; }
      float ps = ps2.x + ps2.y;
      { auto rr = __builtin_amdgcn_permlane32_swap(__float_as_uint(ps), __float_as_uint(ps), false, false); ps = __uint_as_float(rr[0]) + __uint_as_float(rr[1]); }
      l_reg = l_reg * alpha + ps;
      v8i pa;
#pragma unroll
      for (int g = 0; g < 4; ++g) { unsigned x = 0u, y = 0u;
        x = __builtin_amdgcn_cvt_pk_fp8_f32(p0[4 * g], p0[4 * g + 1], x, false); x = __builtin_amdgcn_cvt_pk_fp8_f32(p0[4 * g + 2], p0[4 * g + 3], x, true);
        y = __builtin_amdgcn_cvt_pk_fp8_f32(p1[4 * g], p1[4 * g + 1], y, false); y = __builtin_amdgcn_cvt_pk_fp8_f32(p1[4 * g + 2], p1[4 * g + 3], y, true);
        auto rr = __builtin_amdgcn_permlane32_swap(x, y, false, false); pa[2 * g] = (int)rr[0]; pa[2 * g + 1] = (int)rr[1]; }
      if (__any(alpha < 1.f)) { if (hi == 0) al_l[r32] = alpha; asm volatile("s_waitcnt lgkmcnt(0)" ::: "memory");
#pragma unroll
        for (int d = 0; d < 8; ++d)
#pragma unroll
          for (int r = 0; r < 16; ++r) o[d][r] *= al_l[crow(r, hi)]; }
      const LAS char* Vs = lds + s * STAGE + ST_K;
#define A3_RD(D0, V) do { V = cat8(*(const LAS v4i*)(Vs + (D0) * 2048 + voff0), *(const LAS v4i*)(Vs + (D0) * 2048 + voff1)); } while (0)
#define A3_MM(D0, V) asm volatile("v_mfma_scale_f32_32x32x64_f8f6f4 %0, %1, %2, %0, %3, %4 op_sel_hi:[0,0,0]" : "+v"(o[D0]) : "v"(pa), "v"(V), "v"(sclP), "v"(scl1))
      v8i va, vb;
      A3_RD(0, va);
      A3_RD(1, vb); A3_MM(0, va);
      A3_RD(2, va); A3_MM(1, vb);
      A3_RD(3, vb); A3_MM(2, va);
      A3_RD(4, va); A3_MM(3, vb);
      A3_RD(5, vb); A3_MM(4, va);
      A3_RD(6, va); A3_MM(5, vb);
      A3_RD(7, vb); A3_MM(6, va);
      A3_MM(7, vb);
    }
    s = (s + 1) & 3;
  }
  asm volatile("s_nop 15\n s_nop 15" ::: "memory");
  if (hi == 0) li_l[r32] = l_reg; asm volatile("s_waitcnt lgkmcnt(0)" ::: "memory");
  float rli[16];
#pragma unroll
  for (int r = 0; r < 16; ++r) rli[r] = 64.f * __builtin_amdgcn_rcpf(li_l[crow(r, hi)]);
  float* Ow = Obuf + (size_t)(qrow0 - orow0) * 3072 + (h * 2 + m) * 256;
#pragma unroll
  for (int r = 0; r < 16; ++r) { const int orow = crow(r, hi);
#pragma unroll
    for (int d0 = 0; d0 < 8; ++d0) Ow[(size_t)orow * 3072 + d0 * 32 + r32] = o[d0][r] * rli[r]; }
  if (hi == 0) { float* mlp = ML + (((size_t)(qrow0 - orow0 + r32) * 6 + h) * 2 + m) * 2; mlp[0] = m_reg; mlp[1] = l_reg * (1.f / 64.f); }
  asm volatile("s_waitcnt vmcnt(0) lgkmcnt(0)" ::: "memory");
  __builtin_amdgcn_s_barrier(); asm volatile("" ::: "memory");
#undef A3_ISSUE
#undef A3_RD
#undef A3_MM
}
}

__device__ __forceinline__ void diffattn2_unit(Frame& F, const Args& a, unsigned code) {
    const int h = code & 7, m = (code >> 3) & 1, b = (code >> 4) & 31, pc = code >> 9;
    float* ob = (float*)(F.ws + (pc == 2 ? WS_OP2 : WS_OP)); float* ml = (float*)(F.ws + WS_ML) + (pc == 2 ? (size_t)T * 6 * 2 * 2 : 0);
    const int nt = 4 * b + 4, t_lo = (pc == 2) ? nt / 2 : 0, t_hi = (pc == 1) ? nt / 2 : nt;
    att3::diff_unit(F.ws + WS_ZQ, F.ws + WS_KD, F.ws + WS_VD, ob, pc == 2 ? 4096 : 0, ml, a.in[I_RELB], h, m, b, t_lo, t_hi, (LAS char*)F.lds);
}
__device__ __forceinline__ void diffcombine_phase(Frame& F, const Args& a, int l) {
    const int i = l - 2; const float* lp = a.in[I_BLAM] + (size_t)i * 4 * 128;
    float s1 = lp[F.lane] * lp[128 + F.lane] + lp[64 + F.lane] * lp[128 + 64 + F.lane], s2 = lp[256 + F.lane] * lp[384 + F.lane] + lp[256 + 64 + F.lane] * lp[384 + 64 + F.lane];
    s1 = wave_sum(s1); s2 = wave_sum(s2);
    const float lam_init = 0.8f - 0.6f * expf(-0.3f * (float)l);
    const float lam = expf(s1) - expf(s2) + lam_init;
    const float* op0 = (const float*)(F.ws + WS_OP); const float* op1 = (const float*)(F.ws + WS_OP2); const float* ml0 = (const float*)(F.ws + WS_ML); const float* ml1 = ml0 + (size_t)T * 6 * 2 * 2;
    bf16* cat = (bf16*)(F.ws + WS_CAT);
    const f32x4 gsub = *(const GAS f32x4*)(a.in[I_BSUBG] + (size_t)i * 256 + 4 * F.lane);
    const int gw = F.c * NWAVES + F.wave, NGW = F.G * NWAVES;
    for (int it = gw; it < T * 6; it += NGW) { const int tk = it / 6, h = it - tk * 6; f32x4 os[2];
#pragma unroll
        for (int m = 0; m < 2; ++m) { const size_t r0 = ((size_t)tk * 6 + h) * 2 + m; f32x4 oa = *(const GAS f32x4*)(op0 + r0 * 256 + 4 * F.lane);
            if (tk >= 4096) { const size_t r1 = ((size_t)(tk - 4096) * 6 + h) * 2 + m; const f32x4 ob = *(const GAS f32x4*)(op1 + r1 * 256 + 4 * F.lane);
                const float ma = ml0[r0 * 2], la = ml0[r0 * 2 + 1], mb = ml1[r1 * 2], lb = ml1[r1 * 2 + 1], M = fmaxf(ma, mb);
                const float wa = la * exp2f(ma - M), wb = lb * exp2f(mb - M), inv = 1.f / (wa + wb); oa = oa * (wa * inv) + ob * (wb * inv); }
            os[m] = oa; }
        const f32x4 o = os[0] - os[1] * lam; const float ss = wave_sum((o.x * o.x + o.y * o.y) + (o.z * o.z + o.w * o.w));
        const float r = (1.f - lam_init) / sqrtf(ss * (1.f / 256.f) + LN_EPS);
        v2u w; w.x = pk2(o.x * r * gsub.x, o.y * r * gsub.y); w.y = pk2(o.z * r * gsub.z, o.w * r * gsub.w);
        if (!F8OL(l)) *(GAS v2u*)(cat + (size_t)tk * D + h * 256 + 4 * F.lane) = w;
        { unsigned q8 = 0u; q8 = __builtin_amdgcn_cvt_pk_fp8_f32(o.x * r * gsub.x, o.y * r * gsub.y, q8, false); q8 = __builtin_amdgcn_cvt_pk_fp8_f32(o.z * r * gsub.z, o.w * r * gsub.w, q8, true);
          *(GAS unsigned*)(F.ws + WS_CATQ + (size_t)tk * D + h * 256 + 4 * F.lane) = q8; } }
    { const long nthr = (long)F.G * 512, gt = (long)F.c * 512 + F.tid;
      for (long i2 = gt; i2 < (long)T * 64; i2 += nthr) { const long tk = i2 >> 6; const int c8 = (int)(i2 & 63) * 8; const v4u w = *(const GAS v4u*)(cat + tk * D + MIXW + c8);
          unsigned lo = 0u, hi = 0u; lo = __builtin_amdgcn_cvt_pk_fp8_f32(bflo(w.x), bfhi(w.x), lo, false); lo = __builtin_amdgcn_cvt_pk_fp8_f32(bflo(w.y), bfhi(w.y), lo, true);
          hi = __builtin_amdgcn_cvt_pk_fp8_f32(bflo(w.z), bfhi(w.z), hi, false); hi = __builtin_amdgcn_cvt_pk_fp8_f32(bflo(w.w), bfhi(w.w), hi, true);
          v2u qq; qq.x = lo; qq.y = hi; *(GAS v2u*)(F.ws + WS_CATQ + tk * D + MIXW + c8) = qq; } }
}


__device__ __forceinline__ void ln1_router_phase(Frame& F, const Args& a, int l, int probe = 0) {
    const bf16* y = (const bf16*)(F.ws + WS_Y); bf16* x1b = (bf16*)(F.ws + WS_X1B);
    const float* lng = a.in[I_LNG] + ((size_t)l * 2 + 0) * D; const float* lnb = a.in[I_LNB] + ((size_t)l * 2 + 0) * D;
    const float* wr = (const float*)(F.ws + WS_WR) + (size_t)l * 3 * 512 * 16 * 4;
    int* tok_e = (int*)(F.ws + (probe ? WS_OP : WS_ROUTE)); int* tok_rank = tok_e + 2 * T; float* tok_gate = (float*)(tok_rank + 2 * T);
    gu32* cnt = F.ctl + (probe ? 65536 : CW_CNT) + 2048 * l;
    LAS float* P = (LAS float*)(F.lds);
    constexpr int X1ROW = 2 * D + 16;
    typedef float f32x4v __attribute__((ext_vector_type(4)));
    for (int tb = F.c; tb < T / 32; tb += F.G) {
        f32x4 Gg[4][2], Bb[4][2];
#pragma unroll
        for (int j = 0; j < 4; ++j) { const int d0 = 8 * F.lane + 512 * j; Gg[j][0] = *(const GAS f32x4*)(lng + d0); Gg[j][1] = *(const GAS f32x4*)(lng + d0 + 4); Bb[j][0] = *(const GAS f32x4*)(lnb + d0); Bb[j][1] = *(const GAS f32x4*)(lnb + d0 + 4); }
#pragma unroll 2
        for (int i = 0; i < 4; ++i) { const int tk = tb * 32 + F.wave * 4 + i;
            const GAS v4u* yr = (const GAS v4u*)(y + (size_t)tk * D) + F.lane;
            float v[4][8]; float s = 0.f;
#pragma unroll
            for (int j = 0; j < 4; ++j) { const v4u w = yr[64 * j]; v[j][0] = bflo(w.x); v[j][1] = bfhi(w.x); v[j][2] = bflo(w.y); v[j][3] = bfhi(w.y); v[j][4] = bflo(w.z); v[j][5] = bfhi(w.z); v[j][6] = bflo(w.w); v[j][7] = bfhi(w.w);
#pragma unroll
                for (int e = 0; e < 8; ++e) s += v[j][e]; }
            const float mean = wave_sum(s) * (1.f / D); float s2 = 0.f;
#pragma unroll
            for (int j = 0; j < 4; ++j)
#pragma unroll
                for (int e = 0; e < 8; ++e) { v[j][e] -= mean; s2 += v[j][e] * v[j][e]; }
            const float rstd = 1.f / sqrtf(wave_sum(s2) * (1.f / D) + LN_EPS);
#pragma unroll
            for (int j = 0; j < 4; ++j) { const int d0 = 8 * F.lane + 512 * j; const f32x4 g0 = Gg[j][0], g1 = Gg[j][1], b0 = Bb[j][0], b1 = Bb[j][1];
                const float q0 = v[j][0] * rstd * g0.x + b0.x, q1 = v[j][1] * rstd * g0.y + b0.y, q2 = v[j][2] * rstd * g0.z + b0.z, q3 = v[j][3] * rstd * g0.w + b0.w;
                const float q4 = v[j][4] * rstd * g1.x + b1.x, q5 = v[j][5] * rstd * g1.y + b1.y, q6 = v[j][6] * rstd * g1.z + b1.z, q7 = v[j][7] * rstd * g1.w + b1.w;
                v4u w; w.x = pk2(q0, q1); w.y = pk2(q2, q3); w.z = pk2(q4, q5); w.w = pk2(q6, q7);
                *(GAS v4u*)(x1b + (size_t)tk * D + d0) = w;
                *(LAS v4u*)(F.lds + RING_OFF + (F.wave * 4 + i) * X1ROW + d0 * 2) = w;
                unsigned lo = 0u, hi = 0u; lo = __builtin_amdgcn_cvt_pk_fp8_f32(q0, q1, lo, false); lo = __builtin_amdgcn_cvt_pk_fp8_f32(q2, q3, lo, true);
                hi = __builtin_amdgcn_cvt_pk_fp8_f32(q4, q5, hi, false); hi = __builtin_amdgcn_cvt_pk_fp8_f32(q6, q7, hi, true);
                v2u qq; qq.x = lo; qq.y = hi; *(GAS v2u*)((unsigned char*)(F.ws + WS_X1F) + (size_t)tk * D + d0) = qq; } }
        __syncthreads();
        { const int mt = F.wave >> 2, kq = F.wave & 3, c = F.lane & 15, q = F.lane >> 4;
          const LAS unsigned char* ap = F.lds + RING_OFF + (mt * 16 + c) * X1ROW + (kq * 512 + 4 * q) * 2;
          const float* bp = wr + ((size_t)(kq * 128 + q) * 16 + c) * 4;
          f32x4v acc[3] = {{0.f, 0.f, 0.f, 0.f}, {0.f, 0.f, 0.f, 0.f}, {0.f, 0.f, 0.f, 0.f}};
#pragma unroll 1
          for (int ks0 = 0; ks0 < 32; ks0 += 8) { f32x4 bb[8][3];
#pragma unroll
              for (int u = 0; u < 8; ++u)
#pragma unroll
                  for (int nb = 0; nb < 3; ++nb) bb[u][nb] = *(const GAS f32x4*)(bp + ((size_t)nb * 512 + 4 * (ks0 + u)) * 64);
              asm volatile("" ::: "memory");
#pragma unroll
              for (int u = 0; u < 8; ++u) { const v2u aw = *(const LAS v2u*)(ap + 32 * (ks0 + u)); const f32x4 a4 = (f32x4){bflo(aw.x), bfhi(aw.x), bflo(aw.y), bfhi(aw.y)};
#pragma unroll
                  for (int j = 0; j < 4; ++j)
#pragma unroll
                      for (int nb = 0; nb < 3; ++nb) acc[nb] = __builtin_amdgcn_mfma_f32_16x16x4f32(a4[j], bb[u][nb][j], acc[nb], 0, 0, 0); } }
          __syncthreads();
#pragma unroll
          for (int nb = 0; nb < 3; ++nb)
#pragma unroll
              for (int r = 0; r < 4; ++r) P[((kq * 2 + mt) * 16 + 4 * q + r) * 48 + nb * 16 + c] = acc[nb][r]; }
        __syncthreads();
        if (F.tid < 64) { const int tsel = F.tid & 31, tk = tb * 32 + tsel, mt = tsel >> 4, ti = tsel & 15;
            const LAS f32x4* P4 = (const LAS f32x4*)P;
            const int rb = (mt * 16 + ti) * 12;
            const float* bg1 = a.in[I_BG1] + l * 4; const float* bg2 = a.in[I_BG2] + l * 32;
            const f32x4 s1 = (P4[rb] + P4[rb + 384]) + (P4[rb + 768] + P4[rb + 1152]);
            const float l10 = s1.x + bg1[0], l11 = s1.y + bg1[1], l12 = s1.z + bg1[2], l13 = s1.w + bg1[3];
            int grp = 0; float mx = l10;
            if (l11 > mx) { mx = l11; grp = 1; } if (l12 > mx) { mx = l12; grp = 2; } if (l13 > mx) { mx = l13; grp = 3; }
            const float psel = 1.f / (expf(l10 - mx) + expf(l11 - mx) + expf(l12 - mx) + expf(l13 - mx));
            const int ob = rb + 1 + 2 * grp;
            const f32x4 sa = (P4[ob] + P4[ob + 384]) + (P4[ob + 768] + P4[ob + 1152]), sb = (P4[ob + 1] + P4[ob + 385]) + (P4[ob + 769] + P4[ob + 1153]);
            const f32x4 ba = *(const GAS f32x4*)(bg2 + grp * 8), bb = *(const GAS f32x4*)(bg2 + grp * 8 + 4);
            const float l2[8] = {sa.x + ba.x, sa.y + ba.y, sa.z + ba.z, sa.w + ba.w, sb.x + bb.x, sb.y + bb.y, sb.z + bb.z, sb.w + bb.w};
            int i0 = 0; float v0 = l2[0];
#pragma unroll
            for (int e = 1; e < 8; ++e) if (l2[e] > v0) { v0 = l2[e]; i0 = e; }
            int i1 = -1; float v1 = -INFINITY;
#pragma unroll
            for (int e = 0; e < 8; ++e) if (e != i0 && l2[e] > v1) { v1 = l2[e]; i1 = e; }
            const float e1 = expf(v1 - v0), g0 = psel / (1.f + e1), g1 = psel * e1 / (1.f + e1);
            const int ex0 = grp * 8 + i0, ex1 = grp * 8 + i1;
            const int which = F.lane >> 5, ex = which ? ex1 : ex0; const float gg = which ? g1 : g0;
            int leader = F.lane, idx = 0, gcount = 1;
            { unsigned long long rem = ~0ull;
              while (rem) { const int l0 = __builtin_ctzll(rem); const int le = __builtin_amdgcn_readlane(ex, l0); const unsigned long long mm = __ballot(ex == le);
                  if (ex == le) { leader = l0; idx = __builtin_popcountll(mm & ((1ull << F.lane) - 1ull)); gcount = __builtin_popcountll(mm); }
                  rem &= ~mm; } }
            unsigned base = 0u; if (F.lane == leader) base = __hip_atomic_fetch_add(cnt + 64 * ex, (unsigned)gcount, RLX_AGENT);
            base = (unsigned)__shfl((int)base, leader);
            const int rk = (int)base + idx;
            { int* list = (int*)(F.ws + (probe ? WS_OP + 2 * MiB : WS_LIST)); list[ex * 8192 + rk] = tk; }
            tok_e[2 * tk + which] = ex; tok_rank[2 * tk + which] = rk; tok_gate[2 * tk + which] = gg; }
        __syncthreads();
    }
}
__device__ __forceinline__ void moe_table(Frame& F, int l) {
    LAS int* tstart = (LAS int*)(F.lds + TAB_OFF);
    if (F.tid < 64) {
        const int e = F.lane & 31;
        const unsigned c = __hip_atomic_load(F.ctl + CW_CNT + 2048 * l + 64 * e, RLX_AGENT);
        const int tiles = (int)((c + 255u) >> 8);
        const int rem = (tiles > 0 && ((c - 1u) & 255u) < 128u) ? 1 : 0, nfull = tiles - rem;
        int incl = tiles | (nfull << 8) | (rem << 16);
#pragma unroll
        for (int d = 1; d < 32; d <<= 1) { const int v = __shfl_up(incl, d, 32); if (e >= d) incl += v; }
        const int nF = (__builtin_amdgcn_readlane(incl, 31) >> 8) & 255, tin = incl & 255, fin = (incl >> 8) & 255, rin = (incl >> 16) & 255;
        if (F.lane < 32) { tstart[e] = tin - tiles; tstart[36 + e] = (int)c; if (e == 31) { tstart[32] = tin; tstart[33] = nF; }
            LAS unsigned char* perm = (LAS unsigned char*)(tstart + 68); const int t0 = tin - tiles;
            for (int t = 0; t < nfull; ++t) perm[fin - nfull + t] = (unsigned char)(t0 + t);
            if (rem) perm[nF + rin - 1] = (unsigned char)(t0 + tiles - 1); }
    }
    __syncthreads();
}
__device__ __forceinline__ void ln2_phase(Frame& F, const Args& a, int l) {
    const bf16* x1b = (const bf16*)(F.ws + WS_X1B); const unsigned char* yb8 = F.ws + WS_YB; bf16* xb = (bf16*)(F.ws + WS_XB);
    const float* lng = a.in[I_LNG] + ((size_t)l * 2 + 1) * D; const float* lnb = a.in[I_LNB] + ((size_t)l * 2 + 1) * D;
    moe_table(F, l); const LAS int* tstart = (const LAS int*)(F.lds + TAB_OFF);
    const int* tok_e = (const int*)(F.ws + WS_ROUTE); const int* tok_rank = tok_e + 2 * T; const float* tok_gate = (const float*)(F.ws + WS_ROUTE) + 4 * T;
    const int gw = F.c * NWAVES + F.wave, NGW = F.G * NWAVES;
    f32x4 Gg[4][2], Bb[4][2];
#pragma unroll
    for (int j = 0; j < 4; ++j) { const int d0 = 8 * F.lane + 512 * j; Gg[j][0] = *(const GAS f32x4*)(lng + d0); Gg[j][1] = *(const GAS f32x4*)(lng + d0 + 4); Bb[j][0] = *(const GAS f32x4*)(lnb + d0); Bb[j][1] = *(const GAS f32x4*)(lnb + d0 + 4); }
    for (int t4 = gw; t4 < T / 4; t4 += NGW) { const int tk0 = t4 * 4;
        int ev = 0, rv = 0; float gv = 0.f;
        if (F.lane < 8) { ev = tok_e[2 * tk0 + F.lane]; rv = tok_rank[2 * tk0 + F.lane]; gv = tok_gate[2 * tk0 + F.lane]; }
        const int slotv = (F.lane < 8) ? tstart[ev] * 256 + rv : 0;
        v4u xr[2], xr2[2]; v2u ya[2], yc[2], ya2[2], yc2[2];
#define LN2_LOAD(i, XR, YA, YC, XR2, YA2, YC2) do { const int s0_ = __builtin_amdgcn_readlane(slotv, 2 * (i)), s1_ = __builtin_amdgcn_readlane(slotv, 2 * (i) + 1); \
        _Pragma("unroll") for (int j = 0; j < 2; ++j) { const int d0 = 8 * F.lane + 512 * j; XR[j] = *(const GAS v4u*)(x1b + (size_t)(tk0 + (i)) * D + d0); YA[j] = *(const GAS v2u*)(yb8 + (size_t)s0_ * D + d0); YC[j] = *(const GAS v2u*)(yb8 + (size_t)s1_ * D + d0); } \
        _Pragma("unroll") for (int j = 0; j < 2; ++j) { const int d0 = 8 * F.lane + 512 * (j + 2); XR2[j] = *(const GAS v4u*)(x1b + (size_t)(tk0 + (i)) * D + d0); YA2[j] = *(const GAS v2u*)(yb8 + (size_t)s0_ * D + d0); YC2[j] = *(const GAS v2u*)(yb8 + (size_t)s1_ * D + d0); } } while (0)
        LN2_LOAD(0, xr, ya, yc, xr2, ya2, yc2); asm volatile("" ::: "memory");
#pragma unroll
        for (int i = 0; i < 4; ++i) { const int tk = tk0 + i;
            const float g0 = (1.f / 16.f) * __builtin_bit_cast(float, __builtin_amdgcn_readlane(__builtin_bit_cast(int, gv), 2 * i)), g1 = (1.f / 16.f) * __builtin_bit_cast(float, __builtin_amdgcn_readlane(__builtin_bit_cast(int, gv), 2 * i + 1));
            float v[4][8]; float s = 0.f;
#pragma unroll
            for (int j = 0; j < 4; ++j) { const v4u X = j < 2 ? xr[j] : xr2[j - 2]; const v2u A = j < 2 ? ya[j] : ya2[j - 2], C = j < 2 ? yc[j] : yc2[j - 2];
#define Y8(W, B) __builtin_amdgcn_cvt_f32_fp8((int)(W), (B))
                v[j][0] = bflo(X.x) * DN_ALPHA + (g0 * Y8(A.x, 0) + g1 * Y8(C.x, 0)); v[j][1] = bfhi(X.x) * DN_ALPHA + (g0 * Y8(A.x, 1) + g1 * Y8(C.x, 1));
                v[j][2] = bflo(X.y) * DN_ALPHA + (g0 * Y8(A.x, 2) + g1 * Y8(C.x, 2)); v[j][3] = bfhi(X.y) * DN_ALPHA + (g0 * Y8(A.x, 3) + g1 * Y8(C.x, 3));
                v[j][4] = bflo(X.z) * DN_ALPHA + (g0 * Y8(A.y, 0) + g1 * Y8(C.y, 0)); v[j][5] = bfhi(X.z) * DN_ALPHA + (g0 * Y8(A.y, 1) + g1 * Y8(C.y, 1));
                v[j][6] = bflo(X.w) * DN_ALPHA + (g0 * Y8(A.y, 2) + g1 * Y8(C.y, 2)); v[j][7] = bfhi(X.w) * DN_ALPHA + (g0 * Y8(A.y, 3) + g1 * Y8(C.y, 3));
#undef Y8
#pragma unroll
                for (int e = 0; e < 8; ++e) s += v[j][e]; }
            if (i + 1 < 4) { LN2_LOAD(i + 1, xr, ya, yc, xr2, ya2, yc2); asm volatile("" ::: "memory"); }
            const float mean = wave_sum(s) * (1.f / D); float s2 = 0.f;
#pragma unroll
            for (int j = 0; j < 4; ++j)
#pragma unroll
                for (int e = 0; e < 8; ++e) { v[j][e] -= mean; s2 += v[j][e] * v[j][e]; }
            const float rstd = 1.f / sqrtf(wave_sum(s2) * (1.f / D) + LN_EPS);
#pragma unroll
            for (int j = 0; j < 4; ++j) { const int d0 = 8 * F.lane + 512 * j; const f32x4 g0v = Gg[j][0], g1v = Gg[j][1], b0 = Bb[j][0], b1 = Bb[j][1];
                const f32x4 oa = (f32x4){v[j][0] * rstd * g0v.x + b0.x, v[j][1] * rstd * g0v.y + b0.y, v[j][2] * rstd * g0v.z + b0.z, v[j][3] * rstd * g0v.w + b0.w};
                const f32x4 ob = (f32x4){v[j][4] * rstd * g1v.x + b1.x, v[j][5] * rstd * g1v.y + b1.y, v[j][6] * rstd * g1v.z + b1.z, v[j][7] * rstd * g1v.w + b1.w};
                if (l == DEPTH - 1) { *(GAS f32x4*)(a.out + (size_t)tk * D + d0) = oa; *(GAS f32x4*)(a.out + (size_t)tk * D + d0 + 4) = ob; }
                else { v4u w; w.x = pk2(oa.x, oa.y); w.y = pk2(oa.z, oa.w); w.z = pk2(ob.x, ob.y); w.w = pk2(ob.z, ob.w); *(GAS v4u*)(xb + (size_t)tk * D + d0) = w;
                    unsigned lo = 0u, hi = 0u; lo = __builtin_amdgcn_cvt_pk_fp8_f32(oa.x, oa.y, lo, false); lo = __builtin_amdgcn_cvt_pk_fp8_f32(oa.z, oa.w, lo, true); hi = __builtin_amdgcn_cvt_pk_fp8_f32(ob.x, ob.y, hi, false); hi = __builtin_amdgcn_cvt_pk_fp8_f32(ob.z, ob.w, hi, true);
                    v2u qq; qq.x = lo; qq.y = hi; if (F8L(l + 1)) *(GAS v2u*)(F.ws + WS_XQ + (size_t)tk * D + d0) = qq; } }
        }
#undef LN2_LOAD
    }
}

__global__ void __launch_bounds__(NWAVES * 64, 2) fwd_kernel(Args args) {
    extern __shared__ __attribute__((aligned(16))) unsigned char lds[];
    Frame F;
    F.lds = (LAS unsigned char*)lds; F.ldsg = (char*)lds;
    F.tid = threadIdx.x; F.lane = F.tid & 63; F.wave = __builtin_amdgcn_readfirstlane(F.tid >> 6);
    F.G = gridDim.x; F.c = blockIdx.x; F.ws = args.ws; F.ctl = (gu32*)(args.ws + WS_CTL);
    volatile LAS unsigned* MISC = (volatile LAS unsigned*)(F.lds + MISC_OFF);
    for (int u = F.tid; u < (LDS_BYTES - LDSCTL_OFF) / 4; u += NWAVES * 64) ((LAS unsigned*)(F.lds + LDSCTL_OFF))[u] = 0u;
    __syncthreads();
    const int lo = args.ph_lo, hi = args.ph_hi; int lastp = -1;
    const bool multi = (hi - lo) > 1;
    XcdBarrier bar; bar.bar = (unsigned*)(F.ctl + CW_BAR); bar.x = 0; bar.st = nullptr;
    if (multi) bar = xcd_barrier_post((unsigned*)(F.ctl + CW_BAR), MISC + 8);
#ifndef REP_MASK
#define REP_MASK 0
#endif
#define REP(k) for (int rep_ = 0; rep_ <= ((REP_MASK >> (k)) & 1); ++rep_)
#define IN(p) (lo <= (p) && (p) < hi)
#ifdef PROBE_A
#define STAMP(i) do { if (blockIdx.x == 0 && threadIdx.x == 0) ((unsigned long long*)(args.ws + WS_TS))[(i)] = __builtin_amdgcn_s_memrealtime(); } while (0)
#else
#define STAMP(i) do { } while (0)
#endif
#define SEAM(p) do { lastp = (p); if ((p) + 1 < hi) xcd_barrier(bar); STAMP((p) + 1); } while (0)
#define CONVFIN() ((lastp >= 0) ? (int)__hip_atomic_load(F.ctl + CW_FIN + 64 * lastp, RLX_AGENT) : 0)
#define FRESH() do { int t_ = threadIdx.x; asm volatile("" : "+v"(t_)); F.tid = t_; F.lane = t_ & 63; F.wave = __builtin_amdgcn_readfirstlane(t_ >> 6); \
    GAS unsigned char* w_ = (GAS unsigned char*)args.ws; asm volatile("" : "+s"(w_)); F.ws = (unsigned char*)w_; F.ctl = (gu32*)(w_ + WS_CTL); } while (0)

    STAMP(0);
    if (IN(0)) { FRESH(); REP(9) prologue_phase(F, args); SEAM(0); }
#ifdef XBAR
    for (int xb_ = 0; xb_ < XBAR; ++xb_) xcd_barrier(bar);
#endif

#pragma unroll 1
    for (int l_ = 0; l_ < DEPTH; ++l_) {
        const int pb = 1 + NPH_LAYER * l_;
#pragma unroll 1
        for (int k_ = 0; k_ < NPH_LAYER; ++k_) {
            const int p = pb + k_;
            if (!IN(p) || k_ == 5 || (k_ == 2 && l_ < 2)) continue;
            int l = l_, k = k_; asm volatile("" : "+s"(l), "+s"(k));
            FRESH();
            int cq = NQ, cn = 0;
            switch (k) {
            case 0: {
                const int N = (l < 2) ? NINA : (l == 2 ? 5120 : 2048);
                const unsigned char* Bt = F.ws + ((l < 2) ? WS_WAIN + (size_t)l * NINA * D * 2 : (l == 2 ? WS_WBIN0 : WS_WBIN1));
                const int nu = (T / 256) * (N / 256) + (l == 0 ? 16 : 0); const bool f8 = F8L(l);
                pg8::EpiBf16X E{l < 2 ? 0 : 1, (bf16*)(F.ws + WS_Z), (bf16*)(F.ws + WS_KD), (bf16*)(F.ws + WS_VD), (bf16*)(F.ws + WS_MEMKV), nullptr, nullptr};
                if (f8) { pg8::Gemm g{nullptr, nullptr, T, N, D / 2}; pg8::DualOrder8 S; S.init(F.ws + WS_XQ, Bt, T, N, D / 2, F.G, F.c, F.ws + WS_MEMQ, F.ws + WS_WMKV, l == 0 ? 16 : 0);
                    REP(0) pg8::gemm_phase<pg8::EpiBf16X, pg8::DualOrder8, true, true>(F.lds + RING_OFF, g, S, E); }
                else { pg8::Gemm g{nullptr, nullptr, T, N, D}; pg8::DualOrder S; S.init(F.ws + WS_XB, Bt, T, N, D, F.G, F.c, F.ws + WS_MEMB, F.ws + WS_WMKV, l == 0 ? 16 : 0);
                    REP(0) pg8::gemm_phase<pg8::EpiBf16X, pg8::DualOrder, true, true>(F.lds + RING_OFF, g, S, E); }
                { const int mine = (nu - 1 - F.c) / F.G + 1, rounds = (nu + F.G - 1) / F.G; cq = 2 * l; cn = (rounds - mine) * (f8 ? (QA + 1) / 2 : QA); }
            } break;
            case 1: {
                if (l < 2) {
                    REP(1) for (int u = F.c; u < 256 + 128; u += F.G) {
                        if (u < 256) sgu_unit(F, args, l, u >> 2, u & 3);
                        else { const int r = u - 256; memattn_unit(F, l, r & 3, r >> 2, NINA, 2 * MIXW); }
                    }
                    if (F.c >= 128) { cq = 2 * l; cn = QX; }
                } else {
                    const int ncv = CONVFIN() ? 0 : NCVATT;
                    if (F.c >= F.G - ncv) { conv_server_q(F, args, F.ctl + CW_Q + 64 * l, (unsigned)(att2::NUNITS + 128 - STOPU), 2 * l); __syncthreads(); }
                    REP(2) { gu32* qh = F.ctl + CW_Q + 64 * l + 16 * rep_; LAS unsigned* uw = (LAS unsigned*)(F.lds + att2::LDS_UNIT);
                    for (;;) {
                        if (F.tid == 0) *uw = __hip_atomic_fetch_add(qh, 1u, RLX_AGENT);
                        __syncthreads();
                        const unsigned idx = *uw;
                        __syncthreads();
                        if (idx >= (unsigned)(att2::NUNITS + 128)) break;
                        if (idx < (unsigned)att2::NUNITS) diffattn2_unit(F, args, att3::g_units.u[idx]);
                        else { const int r = (int)idx - att2::NUNITS; memattn_unit(F, l, r & 3, r >> 2, 2048, MIXW); }
                    } }
                }
            } break;
            case 2: { REP(3) diffcombine_phase(F, args, l); } break;
            case 3: {
                pg8::EpiResBf16 E{(const bf16*)(F.ws + WS_XB), (bf16*)(F.ws + WS_Y), DN_ALPHA};
                const unsigned char* Wo = F.ws + (l < 2 ? WS_WAOUT + (size_t)l * D * D * 2 : WS_WBOUT + (size_t)(l - 2) * D * D * 2);
                if (F8OL(l)) { pg8::Gemm g{nullptr, nullptr, T, D, D / 2}; pg8::DenseOrder8 S; S.init(F.ws + WS_CATQ, Wo, T, D, D / 2, F.G, F.c);
                    REP(4) pg8::gemm_phase<pg8::EpiResBf16, pg8::DenseOrder8, true, true>(F.lds + RING_OFF, g, S, E); }
                else { pg8::Gemm g{nullptr, nullptr, T, D, D}; pg8::DenseOrder S; S.init(F.ws + WS_CAT, Wo, T, D, D, F.G, F.c);
                    REP(4) pg8::gemm_phase<pg8::EpiResBf16, pg8::DenseOrder, true, true>(F.lds + RING_OFF, g, S, E); }
            } break;
            case 4: {
                ln1_router_phase(F, args, l);
#ifdef REP_LN1
                ln1_router_phase(F, args, l, 1);
#endif
                cq = 2 * l; cn = -1;
            } break;
            case 6: {
                moe_table(F, l);
                const LAS int* tb = (const LAS int*)(F.lds + TAB_OFF);
                pg8::Gemm g{nullptr, nullptr, SLOTS, 1024, D / 2};
                pg8::MoeGatherOrder S{tb, tb + 36, (const int*)(F.ws + WS_LIST), 4, F.G, F.c, (const char*)(F.ws + WS_X1F), (const char*)(F.ws + WS_W13) + (size_t)l * NE * 1024 * 2048, (size_t)1024 * 2048, (size_t)256 * 2048, (unsigned)D};
                pg8::EpiMoe1 E{(bf16*)(F.ws + WS_H), tb, tb + 36};
                REP(6) pg8::gemm_phase<pg8::EpiMoe1, pg8::MoeGatherOrder, true, true>(F.lds + RING_OFF, g, S, E);
                { const int nu = __builtin_amdgcn_readfirstlane(((const LAS int*)(F.lds + TAB_OFF))[32]) * 4, mine = (F.c < nu) ? (nu - 1 - F.c) / F.G + 1 : 0, rounds = (nu + F.G - 1) / F.G; cq = 2 * l + 1; cn = (rounds - mine) * QM; }
            } break;
            case 7: {
                moe_table(F, l);
                pg8::Gemm g{nullptr, nullptr, SLOTS, D, FF / 2};
                pg8::MoeOrder8 S{(const PG8_LAS int*)(F.lds + TAB_OFF), 8, F.G, F.c, (const char*)(F.ws + WS_H), (const char*)(F.ws + WS_W2) + (size_t)l * NE * 2048 * 512, (size_t)256 * FF, (size_t)2048 * 512, (size_t)256 * 512};
                pg8::EpiBf16X E{3, (bf16*)(F.ws + WS_YB), nullptr, nullptr, nullptr, (const PG8_LAS int*)(F.lds + TAB_OFF), (const PG8_LAS int*)(F.lds + TAB_OFF) + 36};
                REP(7) pg8::gemm_phase<pg8::EpiBf16X, pg8::MoeOrder8, true, true>(F.lds + RING_OFF, g, S, E);
                { const int nu = __builtin_amdgcn_readfirstlane(((const LAS int*)(F.lds + TAB_OFF))[32]) * 8, mine = (F.c < nu) ? (nu - 1 - F.c) / F.G + 1 : 0, rounds = (nu + F.G - 1) / F.G; cq = 2 * l + 1; cn = (rounds - mine) * QB; }
            } break;
            default: {
                REP(8) ln2_phase(F, args, l);
                cq = 2 * l + 1; cn = -1;
            } break;
            }
            FRESH();
            conv_filler(F, args, cq, cn);
            if (k == 0 && l >= 2) conv_note_fin(F, p);
            SEAM(p);
        }
    }
#ifdef PROBE_A
    {
        VM_WAIT(); xcd_barrier(bar);
        const unsigned long long* ts = (const unsigned long long*)(args.ws + WS_TS);
        float da = 0.f, db = 0.f;
        for (int p = 0; p < NPHASES; ++p) { const int k = (p == 0) ? 9 : (p - 1) % NPH_LAYER; const float d = (float)(ts[p + 1] - ts[p]);
            if (k == PROBE_A || PROBE_A == 10) da += d; if (k == PROBE_B || PROBE_B == 10) db += d; }
        const float kk = sqrtf(da), vv = db;
        float* o = args.out; const long n = (long)T * D;
        for (long i = (long)blockIdx.x * 512 + threadIdx.x; i < n; i += (long)gridDim.x * 512) o[i] = (i == 0) ? vv : kk;
    }
#endif
#undef IN
#undef SEAM
}

#ifndef MK_ONE_LAUNCH
#define MK_ONE_LAUNCH 1
#endif
extern "C" void kernel_launch(void* const* d_in, const int* in_sizes, int n_in, void* d_out, int out_size, void* d_ws, size_t ws_size, hipStream_t stream) {
    static int grid = 0;
    if (grid == 0) {
        if (n_in != 24 || in_sizes[0] != T * D || out_size != T * D || ws_size < WS_END) { fprintf(stderr, "kernel_launch: unexpected shapes (n_in %d, in0 %d, out %d, ws %zu < %zu)\n", n_in, n_in > 0 ? in_sizes[0] : -1, out_size, ws_size, (size_t)WS_END); grid = -1; return; }
        int dev = 0, cus = 0, per_cu = 0;
        if (hipGetDevice(&dev) != hipSuccess || hipDeviceGetAttribute(&cus, hipDeviceAttributeMultiprocessorCount, dev) != hipSuccess) { grid = -1; return; }
        if (hipFuncSetAttribute((const void*)fwd_kernel, hipFuncAttributeMaxDynamicSharedMemorySize, LDS_BYTES) != hipSuccess) { fprintf(stderr, "kernel_launch: hipFuncSetAttribute failed\n"); grid = -1; return; }
        if (hipOccupancyMaxActiveBlocksPerMultiprocessor(&per_cu, (const void*)fwd_kernel, NWAVES * 64, LDS_BYTES) != hipSuccess || per_cu < 1) fprintf(stderr, "kernel_launch: occupancy query reports %d\n", per_cu);
        (void)hipGetLastError();
        grid = cus;
    }
    if (grid < 0) return;
    if (hipMemsetAsync((char*)d_ws + WS_CTL, 0, CTL_ZERO_BYTES, stream) != hipSuccess) return;
    Args a{};
    for (int i = 0; i < 24; ++i) a.in[i] = (const float*)d_in[i];
    a.out = (float*)d_out; a.ws = (unsigned char*)d_ws;
#if MK_ONE_LAUNCH
    a.ph_lo = 0; a.ph_hi = NPHASES;
    hipLaunchKernelGGL(fwd_kernel, dim3(grid), dim3(NWAVES * 64), LDS_BYTES, stream, a);
#else
    for (int p = 0; p < NPHASES; ++p) {
        const int k = (p - 1) % NPH_LAYER, l = (p - 1) / NPH_LAYER;
        if (p > 0 && k == 2 && l < 2) continue;
        a.ph_lo = p; a.ph_hi = p + 1;
        hipLaunchKernelGGL(fwd_kernel, dim3(grid), dim3(NWAVES * 64), LDS_BYTES, stream, a);
    }
#endif
    const hipError_t le = hipPeekAtLastError();
    if (le != hipSuccess) fprintf(stderr, "kernel_launch: launch failed: %s\n", hipGetErrorName(le));
}
```
